# Optimizing an MI355X kernel written in HIP

```python
import jax, jax.numpy as jnp
from jax import lax
import numpy as np

D_MODEL = 1024
BATCH = 4
SEQ = 4096
DEPTH = 1

HEAD_DIM = 128
DN_HEADS = 4
DN_WIDTH = DN_HEADS * HEAD_DIM
DN_CONV = 4
DN_CHUNK = 64
MB_HEADS = 4
MB_WIDTH = MB_HEADS * HEAD_DIM
MB_BLOCK = 256
MB_TOPK = 3
MB_QCHUNK = 32
ROPE_THETA = 500000.0
ROPE_DIM = HEAD_DIM // 4
N_EXPERTS = 32
TOP_K = 4
D_FF = D_MODEL
SWIGLU_LIMIT = 7.0
SWIGLU_ALPHA = 1.702
MOE_ROWS = 256
NORM_EPS = 1e-6
IN_SPLITS = (DN_WIDTH, DN_WIDTH, DN_WIDTH, DN_WIDTH, DN_HEADS, DN_HEADS,
             MB_WIDTH, MB_WIDTH, MB_WIDTH, D_MODEL, D_MODEL)
IN_WIDTH = 4 * DN_WIDTH + 2 * DN_HEADS + 3 * MB_WIDTH + 2 * D_MODEL

kernel_name = 'hybrid_deltanet_moba_moe_block'


def rmsnorm(x, g):
    xf = x.astype(jnp.float32)
    y = xf * lax.rsqrt(jnp.mean(xf * xf, axis=-1, keepdims=True) + NORM_EPS)
    return (y * g.astype(jnp.float32)).astype(x.dtype)


def l2norm(x):
    return x * lax.rsqrt(jnp.sum(x * x, axis=-1, keepdims=True) + 1e-6)


def partial_rope(x):
    S = x.shape[1]
    half = ROPE_DIM // 2
    inv_freq = ROPE_THETA ** (-jnp.arange(half, dtype=jnp.float32) / half)
    ang = jnp.arange(S, dtype=jnp.float32)[:, None] * inv_freq[None, :]
    cos = jnp.cos(ang)[None, :, None, :]
    sin = jnp.sin(ang)[None, :, None, :]
    x1 = x[..., :half]
    x2 = x[..., half:ROPE_DIM]
    return jnp.concatenate([x1 * cos - x2 * sin, x2 * cos + x1 * sin, x[..., ROPE_DIM:]], axis=-1)


def causal_depthwise_conv(x, w):
    K, C = w.shape
    return lax.conv_general_dilated(x, w[:, None, :], window_strides=(1,), padding=[(K - 1, 0)],
                                    dimension_numbers=('NWC', 'WIO', 'NWC'), feature_group_count=C)


def gated_delta_rule(q, k, v, g, beta):
    B, S, H, dk = q.shape
    dv = v.shape[-1]
    C = DN_CHUNK
    N = S // C

    def chunks(t):
        t = t.reshape((B, N, C, H) + t.shape[3:])
        return jnp.moveaxis(t, [1, 0, 3, 2], [0, 1, 2, 3])

    q = chunks(q) * (dk ** -0.5)
    k = chunks(k)
    v = chunks(v)
    g = chunks(g)
    beta = chunks(beta)
    gc = jnp.cumsum(g, axis=-1)
    tril = jnp.tril(jnp.ones((C, C), dtype=bool))
    strict = jnp.tril(jnp.ones((C, C), dtype=bool), -1)
    decay = jnp.exp(jnp.where(tril, gc[..., :, None] - gc[..., None, :], -jnp.inf))
    kb = k * beta[..., None]
    L = jnp.where(strict, jnp.einsum('nbhcd,nbhmd->nbhcm', kb, k) * decay, 0.0)
    A = L + jnp.eye(C, dtype=L.dtype)
    u = lax.linalg.triangular_solve(A, v * beta[..., None], left_side=True, lower=True)
    w = lax.linalg.triangular_solve(A, kb * jnp.exp(gc)[..., None], left_side=True, lower=True)
    qk = jnp.einsum('nbhcd,nbhmd->nbhcm', q, k) * decay
    g_last = gc[..., -1]
    k_tail = k * jnp.exp(g_last[..., None] - gc)[..., None]
    q_dec = q * jnp.exp(gc)[..., None]

    def step(state, xs):
        q_n, qk_n, u_n, w_n, kt_n, gl_n = xs
        v_new = u_n - jnp.einsum('bhcd,bhde->bhce', w_n, state)
        o = jnp.einsum('bhcd,bhde->bhce', q_n, state) + jnp.einsum('bhcm,bhme->bhce', qk_n, v_new)
        state = state * jnp.exp(gl_n)[..., None, None] + jnp.einsum('bhcd,bhce->bhde', kt_n, v_new)
        return state, o

    s0 = jnp.zeros((B, H, dk, dv), jnp.float32)
    _, o = lax.scan(step, s0, (q_dec, qk, u, w, k_tail, g_last))
    return jnp.moveaxis(o, [1, 0, 3, 2], [0, 1, 2, 3]).reshape(B, S, H, dv)


def moba_attention(q, k, v):
    B, S, H, d = q.shape
    nb = -(-S // MB_BLOCK)
    Sp = nb * MB_BLOCK
    pad = ((0, 0), (0, Sp - S), (0, 0), (0, 0))
    q, k, v = [jnp.pad(t, pad).transpose(0, 2, 1, 3) for t in (q, k, v)]
    k_blk = k.reshape(B, H, nb, MB_BLOCK, d)
    v_blk = v.reshape(B, H, nb, MB_BLOCK, d)
    k_mean = jnp.mean(k_blk, axis=3)
    pos = jnp.arange(Sp, dtype=jnp.int32)
    q_blk = pos // MB_BLOCK
    past = jnp.arange(nb, dtype=jnp.int32)[None, :] < q_blk[:, None]
    scores = jnp.where(past, jnp.einsum('bhsd,bhnd->bhsn', q, k_mean), -jnp.inf)
    topk = min(MB_TOPK, nb)
    _, top_idx = lax.top_k(scores, topk)
    sel = jnp.concatenate([top_idx.astype(jnp.int32),
                           jnp.broadcast_to(q_blk[:, None], (B, H, Sp, 1))], axis=-1)
    sel_ok = jnp.concatenate([jnp.arange(topk, dtype=jnp.int32)[None, :] < q_blk[:, None],
                              jnp.ones((Sp, 1), dtype=bool)], axis=-1)
    K1 = topk + 1
    nq = Sp // MB_QCHUNK

    def to_chunks(t):
        t = t.reshape(t.shape[:2] + (nq, MB_QCHUNK) + t.shape[3:])
        return jnp.moveaxis(t, 2, 0)

    b_idx = jnp.arange(B)[:, None, None, None]
    h_idx = jnp.arange(H)[None, :, None, None]
    offs = jnp.arange(MB_BLOCK, dtype=jnp.int32)
    scale = d ** -0.5

    def attend(args):
        q_i, sel_i, pos_i, ok_i = args
        k_g = k_blk[b_idx, h_idx, sel_i]
        v_g = v_blk[b_idx, h_idx, sel_i]
        logits = jnp.einsum('bhqd,bhqjkd->bhqjk', q_i, k_g) * scale
        k_pos = sel_i[..., None] * MB_BLOCK + offs
        allowed = (k_pos <= pos_i[:, None, None]) & ok_i[:, :, None]
        logits = jnp.where(allowed, logits, -jnp.inf)
        p = jax.nn.softmax(logits.reshape(logits.shape[:3] + (-1,)), axis=-1).reshape(logits.shape)
        return jnp.einsum('bhqjk,bhqjkd->bhqd', p, v_g)

    o = lax.map(attend, (to_chunks(q), to_chunks(sel), pos.reshape(nq, MB_QCHUNK),
                         sel_ok.reshape(nq, MB_QCHUNK, K1)))
    o = jnp.moveaxis(o, 0, 2).reshape(B, H, Sp, d)[:, :, :S]
    return o.transpose(0, 2, 1, 3)


def hybrid_mixer(h, w_in, conv_w, a_log, dt_bias, g_dn_out, w_br_a, w_br_b, w_o):
    B, S, _ = h.shape
    f32 = jnp.float32
    proj = h @ w_in
    cuts = [int(i) for i in np.cumsum(IN_SPLITS)[:-1]]
    dn_q, dn_k, dn_v, dn_z, dn_b, dn_a, mb_q, mb_k, mb_v, gate_a, gate_b = jnp.split(proj, cuts, axis=-1)

    def heads(t, n):
        return t.reshape(B, S, n, HEAD_DIM)

    qkv = jax.nn.silu(causal_depthwise_conv(jnp.concatenate([dn_q, dn_k, dn_v], axis=-1), conv_w))
    q_a, k_a, v_a = jnp.split(qkv.astype(f32), 3, axis=-1)
    q_a = l2norm(heads(q_a, DN_HEADS))
    k_a = l2norm(heads(k_a, DN_HEADS))
    v_a = heads(v_a, DN_HEADS)
    beta = jax.nn.sigmoid(dn_b.astype(f32))
    g = -jnp.exp(a_log.astype(f32)) * jax.nn.softplus(dn_a.astype(f32) + dt_bias.astype(f32))
    o_a = gated_delta_rule(q_a, k_a, v_a, g, beta)
    o_a = rmsnorm(o_a, g_dn_out) * jax.nn.silu(heads(dn_z.astype(f32), DN_HEADS))
    y_a = o_a.reshape(B, S, DN_WIDTH).astype(h.dtype) @ w_br_a

    q_b = partial_rope(heads(mb_q.astype(f32), MB_HEADS))
    k_b = partial_rope(heads(mb_k.astype(f32), MB_HEADS))
    v_b = heads(mb_v.astype(f32), MB_HEADS)
    o_b = moba_attention(q_b, k_b, v_b)
    y_b = o_b.reshape(B, S, MB_WIDTH).astype(h.dtype) @ w_br_b

    merged = jax.nn.sigmoid(gate_a) * y_a + jax.nn.sigmoid(gate_b) * y_b
    return merged @ w_o


def routed_moe(h, w_router, b_router, w_gu, b_gu, w_down, b_down):
    B, S, D = h.shape
    T = B * S
    x = h.reshape(T, D)
    logits = (x @ w_router).astype(jnp.float32) + b_router.astype(jnp.float32)
    top_val, top_idx = lax.top_k(logits, TOP_K)
    top_w = jax.nn.softmax(top_val, axis=-1)
    A = T * TOP_K
    flat_e = top_idx.reshape(A)
    order = jnp.argsort(flat_e)
    e_sorted = flat_e[order]
    tok_sorted = (order // TOP_K).astype(jnp.int32)
    w_sorted = top_w.reshape(A)[order]
    counts = jnp.bincount(flat_e, length=N_EXPERTS)
    padded = (counts + MOE_ROWS - 1) // MOE_ROWS * MOE_ROWS
    pad_end = jnp.cumsum(padded)
    pad_start = pad_end - padded
    grp_start = jnp.cumsum(counts) - counts
    dest = pad_start[e_sorted] + jnp.arange(A) - grp_start[e_sorted]
    n_blocks = -(-A // MOE_ROWS) + N_EXPERTS
    n_rows = n_blocks * MOE_ROWS
    row_tok = jnp.zeros((n_rows,), jnp.int32).at[dest].set(tok_sorted)
    row_w = jnp.zeros((n_rows,), jnp.float32).at[dest].set(w_sorted)
    blk_exp = jnp.minimum(jnp.searchsorted(pad_end, jnp.arange(n_blocks) * MOE_ROWS, side='right'),
                          N_EXPERTS - 1)

    def expert_block(args):
        tok, e = args
        gu = x[tok] @ w_gu[e] + b_gu[e]
        gate = jnp.minimum(gu[:, :D_FF], SWIGLU_LIMIT)
        up = jnp.clip(gu[:, D_FF:], -SWIGLU_LIMIT, SWIGLU_LIMIT)
        act = (up + 1) * gate * jax.nn.sigmoid(SWIGLU_ALPHA * gate)
        return act @ w_down[e] + b_down[e]

    y_rows = lax.map(expert_block, (row_tok.reshape(n_blocks, MOE_ROWS), blk_exp))
    y_rows = y_rows.reshape(n_rows, D).astype(jnp.float32) * row_w[:, None]
    out = jax.ops.segment_sum(y_rows, row_tok, num_segments=T)
    return out.reshape(B, S, D).astype(h.dtype)


def setup_inputs(seed: int = 0) -> dict:
    key = jax.random.key(seed)
    ks = jax.random.split(key, 24)
    f32 = jnp.float32
    L, D = DEPTH, D_MODEL

    def nrm(k, shape, fan_in):
        return jax.random.normal(k, shape, f32) * (fan_in ** -0.5)

    def gain(k, shape):
        return 1.0 + 0.05 * jax.random.normal(k, shape, f32)

    dt = jnp.exp(jax.random.uniform(ks[12], (L, DN_HEADS), f32, np.log(1e-3), np.log(1e-1)))
    return {
        'x': jax.random.normal(ks[0], (BATCH, SEQ, D), f32),
        'c': jax.random.normal(ks[1], (BATCH, D), f32),
        'w_ada': nrm(ks[2], (L, D, 6 * D), D),
        'b_ada': 0.02 * jax.random.normal(ks[3], (L, 6 * D), f32),
        'g_pre_mix': gain(ks[4], (L, D)),
        'g_post_mix': gain(ks[5], (L, D)),
        'g_pre_ffn': gain(ks[6], (L, D)),
        'g_post_ffn': gain(ks[7], (L, D)),
        'w_in': nrm(ks[8], (L, D, IN_WIDTH), D),
        'conv_w': nrm(ks[9], (L, DN_CONV, 3 * DN_WIDTH), DN_CONV),
        'a_log': jnp.log(jax.random.uniform(ks[10], (L, DN_HEADS), f32, 1.0, 16.0)),
        'dt_bias': dt + jnp.log(-jnp.expm1(-dt)),
        'g_dn_out': gain(ks[11], (L, HEAD_DIM)),
        'w_br_a': nrm(ks[13], (L, DN_WIDTH, D), DN_WIDTH),
        'w_br_b': nrm(ks[14], (L, MB_WIDTH, D), MB_WIDTH),
        'w_o': nrm(ks[15], (L, D, D), D),
        'w_router': nrm(ks[16], (L, D, N_EXPERTS), D),
        'b_router': 0.01 * jax.random.normal(ks[17], (L, N_EXPERTS), f32),
        'w_gu': nrm(ks[18], (L, N_EXPERTS, D, 2 * D_FF), D),
        'b_gu': 0.01 * jax.random.normal(ks[19], (L, N_EXPERTS, 2 * D_FF), f32),
        'w_down': nrm(ks[20], (L, N_EXPERTS, D_FF, D), D_FF),
        'b_down': 0.01 * jax.random.normal(ks[21], (L, N_EXPERTS, D), f32),
    }


def reference(x, c, w_ada, b_ada, g_pre_mix, g_post_mix, g_pre_ffn, g_post_ffn, w_in, conv_w,
              a_log, dt_bias, g_dn_out, w_br_a, w_br_b, w_o, w_router, b_router, w_gu, b_gu,
              w_down, b_down):
    for l in range(DEPTH):
        mod = jax.nn.silu(c) @ w_ada[l] + b_ada[l]
        shift_m, scale_m, gate_m, shift_f, scale_f, gate_f = [m[:, None, :] for m in jnp.split(mod, 6, axis=-1)]
        h = rmsnorm(x, g_pre_mix[l]) * (1 + scale_m) + shift_m
        y = hybrid_mixer(h, w_in[l], conv_w[l], a_log[l], dt_bias[l], g_dn_out[l],
                         w_br_a[l], w_br_b[l], w_o[l])
        x = x + gate_m * rmsnorm(y, g_post_mix[l])
        h = rmsnorm(x, g_pre_ffn[l]) * (1 + scale_f) + shift_f
        y = routed_moe(h, w_router[l], b_router[l], w_gu[l], b_gu[l], w_down[l], b_down[l])
        x = x + gate_f * rmsnorm(y, g_post_ffn[l])
    return x
```

```cpp
#include <hip/hip_runtime.h>
#include <stdint.h>

typedef unsigned short bf16_t;

#define T_TOK 16384
#define SEQ 4096
#define NB 4
#define DM 1024
#define INW 5640
#define PW 5632
#define C_QA 0
#define C_KA 512
#define C_VA 1024
#define C_Z 1536
#define C_MQ 2048
#define C_MK 2560
#define C_MV 3072
#define C_GA 3584
#define C_GB 4608
#define NE 32

__device__ __forceinline__ bf16_t f2bf(float f) {
  unsigned u = __float_as_uint(f);
  u += 0x7fffu + ((u >> 16) & 1u);
  return (bf16_t)(u >> 16);
}
__device__ __forceinline__ float bf2f(bf16_t h) { return __uint_as_float(((unsigned)h) << 16); }
__device__ __forceinline__ float sigmoidf_(float x) { return 1.f / (1.f + __expf(-x)); }
__device__ __forceinline__ float siluf_(float x) { return x / (1.f + __expf(-x)); }
__device__ __forceinline__ float wave_sum(float v) {
#pragma unroll
  for (int o = 32; o > 0; o >>= 1) v += __shfl_xor(v, o, 64);
  return v;
}
__device__ __forceinline__ float wave_max(float v) {
#pragma unroll
  for (int o = 32; o > 0; o >>= 1) v = fmaxf(v, __shfl_xor(v, o, 64));
  return v;
}

struct Params {
  const float *x, *c, *w_ada, *b_ada, *g_pre_mix, *g_post_mix, *g_pre_ffn, *g_post_ffn, *w_in, *conv_w,
      *a_log, *dt_bias, *g_dn_out, *w_br_a, *w_br_b, *w_o, *w_router, *b_router, *w_gu, *b_gu, *w_down, *b_down;
  float* out;
  float* mod;
  int* cnt;
  float* ba;
  bf16_t* hbf;
  bf16_t* proj;
  bf16_t* w_in_t;
  bf16_t* wgu_t;
  bf16_t* wd_t;
  bf16_t* wbra_t;
  bf16_t* wbrb_t;
  bf16_t* wo_t;
  bf16_t* qb;
  bf16_t* kb;
  float* kmean;
  bf16_t* oab;
  bf16_t* merged;
  bf16_t* mixer;
  bf16_t* h2;
  int* elist;
  float* aw;
  bf16_t* act;
  bf16_t* yslot;
  float* nq; float* nk; float* nv;
  float* nbeta; float* ng;
  float* no;
  float* ntmp;
};

__global__ __launch_bounds__(256) void k_mod(Params p) {
  __shared__ float sc[4][1024];
  for (int i = threadIdx.x; i < 4096; i += 256) sc[i >> 10][i & 1023] = siluf_(p.c[i]);
  __syncthreads();
  int j = blockIdx.x * 256 + threadIdx.x;
  float a0 = 0, a1 = 0, a2 = 0, a3 = 0;
  for (int k = 0; k < 1024; ++k) {
    float w = p.w_ada[(size_t)k * 6144 + j];
    a0 += sc[0][k] * w; a1 += sc[1][k] * w; a2 += sc[2][k] * w; a3 += sc[3][k] * w;
  }
  float b = p.b_ada[j];
  p.mod[0 * 6144 + j] = a0 + b; p.mod[1 * 6144 + j] = a1 + b;
  p.mod[2 * 6144 + j] = a2 + b; p.mod[3 * 6144 + j] = a3 + b;
}

__device__ __forceinline__ int map_col(int n, int mode) {
  if (mode == 0) return n;
  if (mode == 1) return n < 2048 ? n : (n < 2056 ? -1 : n - 8);
  if (n < 1024) return (n >> 5) * 64 + (n & 31);
  int j = n - 1024;
  return (j >> 5) * 64 + 32 + (j & 31);
}
__global__ __launch_bounds__(256) void k_wt(const float* __restrict__ src, bf16_t* __restrict__ dst, int K, int N, int mode,
                                            size_t src_estride, size_t dst_estride) {
  __shared__ float tile[32][33];
  src += (size_t)blockIdx.z * src_estride;
  dst += (size_t)blockIdx.z * dst_estride;
  int n0 = blockIdx.x * 32, k0 = blockIdx.y * 32;
  int tx = threadIdx.x & 31, ty = threadIdx.x >> 5;
  for (int r = ty; r < 32; r += 8) {
    int n = n0 + tx;
    tile[r][tx] = (n < N) ? src[(size_t)(k0 + r) * N + n] : 0.f;
  }
  __syncthreads();
  for (int r = ty; r < 32; r += 8) {
    int n = n0 + r;
    if (n < N) {
      int d = map_col(n, mode);
      if (d >= 0) dst[(size_t)d * K + k0 + tx] = f2bf(tile[tx][r]);
    }
  }
}

__global__ __launch_bounds__(256) void k_h(Params p) {
  int wid = threadIdx.x >> 6, lane = threadIdx.x & 63;
  int t = blockIdx.x * 4 + wid;
  int b = t / SEQ;
  const float* xr = p.x + (size_t)t * DM;
  float v[16];
  float ss = 0.f;
#pragma unroll
  for (int i = 0; i < 4; ++i) {
    float4 q = *(const float4*)(xr + i * 256 + lane * 4);
    v[i * 4 + 0] = q.x; v[i * 4 + 1] = q.y; v[i * 4 + 2] = q.z; v[i * 4 + 3] = q.w;
    ss += q.x * q.x + q.y * q.y + q.z * q.z + q.w * q.w;
  }
  ss = wave_sum(ss);
  float rstd = rsqrtf(ss * (1.f / DM) + 1e-6f);
  const float* shift = p.mod + b * 6144;
  const float* scale = p.mod + b * 6144 + 1024;
  float acc[8] = {0, 0, 0, 0, 0, 0, 0, 0};
#pragma unroll
  for (int i = 0; i < 4; ++i) {
    bf16_t o[4];
#pragma unroll
    for (int j = 0; j < 4; ++j) {
      int k = i * 256 + lane * 4 + j;
      float h = v[i * 4 + j] * rstd * p.g_pre_mix[k] * (1.f + scale[k]) + shift[k];
      o[j] = f2bf(h);
      const float* wr = p.w_in + (size_t)k * INW + 2048;
#pragma unroll
      for (int e = 0; e < 8; ++e) acc[e] += h * wr[e];
    }
    uint2 pk;
    pk.x = (unsigned)o[0] | ((unsigned)o[1] << 16);
    pk.y = (unsigned)o[2] | ((unsigned)o[3] << 16);
    *(uint2*)(p.hbf + (size_t)t * DM + i * 256 + lane * 4) = pk;
  }
#pragma unroll
  for (int e = 0; e < 8; ++e) acc[e] = wave_sum(acc[e]);
  if (lane == 0) {
#pragma unroll
    for (int e = 0; e < 8; ++e) p.ba[(size_t)t * 8 + e] = acc[e];
  }
}

template <class F>
__device__ __forceinline__ void gemm_tile_naive(F& f, const bf16_t* __restrict__ Bt, int ldb, int K, float (*As)[68], float (*Bs)[68],
                                                float acc[4][4]) {
  int tid = threadIdx.x;
  int lr = tid >> 2, lk = (tid & 3) * 8;
  int ty = tid >> 4, tx = tid & 15;
  const bf16_t* ar = f.arow(lr);
  const bf16_t* br = Bt + (size_t)lr * ldb;
#pragma unroll
  for (int i = 0; i < 4; ++i)
#pragma unroll
    for (int j = 0; j < 4; ++j) acc[i][j] = 0.f;
  for (int k0 = 0; k0 < K; k0 += 32) {
    uint4 av = make_uint4(0, 0, 0, 0);
    if (ar) av = *(const uint4*)(ar + k0 + lk);
    uint4 bv = *(const uint4*)(br + k0 + lk);
    __syncthreads();
    unsigned aw[4] = {av.x, av.y, av.z, av.w}, bw[4] = {bv.x, bv.y, bv.z, bv.w};
#pragma unroll
    for (int i = 0; i < 4; ++i) {
      As[lk + 2 * i][lr] = __uint_as_float(aw[i] << 16);
      As[lk + 2 * i + 1][lr] = __uint_as_float(aw[i] & 0xffff0000u);
      Bs[lk + 2 * i][lr] = __uint_as_float(bw[i] << 16);
      Bs[lk + 2 * i + 1][lr] = __uint_as_float(bw[i] & 0xffff0000u);
    }
    __syncthreads();
#pragma unroll 8
    for (int kk = 0; kk < 32; ++kk) {
      float4 a = *(const float4*)&As[kk][ty * 4];
      float4 b = *(const float4*)&Bs[kk][tx * 4];
      float aa[4] = {a.x, a.y, a.z, a.w}, bb[4] = {b.x, b.y, b.z, b.w};
#pragma unroll
      for (int i = 0; i < 4; ++i)
#pragma unroll
        for (int j = 0; j < 4; ++j) acc[i][j] += aa[i] * bb[j];
    }
  }
}

struct FProj {
  const Params& p; int m0, n0;
  __device__ const bf16_t* arow(int r) const { return p.hbf + (size_t)(m0 + r) * DM; }
};
__global__ __launch_bounds__(256) void k_gemm_proj(Params p) {
  __shared__ float As[32][68], Bs[32][68];
  int n0 = blockIdx.x * 64, m0 = blockIdx.y * 64;
  FProj f{p, m0, n0};
  float acc[4][4];
  gemm_tile_naive(f, p.w_in_t + (size_t)n0 * DM, DM, DM, As, Bs, acc);
  int ty = threadIdx.x >> 4, tx = threadIdx.x & 15;
  for (int i = 0; i < 4; ++i)
    for (int j = 0; j < 4; ++j) {
      int m = m0 + ty * 4 + i, n = n0 + tx * 4 + j;
      float v = acc[i][j];
      if (n >= C_GA) v = sigmoidf_(v);
      p.proj[(size_t)m * PW + n] = f2bf(v);
    }
}

struct FBr {
  const Params& p; int m0; int off;
  __device__ const bf16_t* arow(int r) const { return p.oab + (size_t)(m0 + r) * DM + off; }
};
__global__ __launch_bounds__(256) void k_gemm_br(Params p, int pass) {
  __shared__ float As[32][68], Bs[32][68];
  int n0 = blockIdx.x * 64, m0 = blockIdx.y * 64;
  FBr f{p, m0, pass * 512};
  float acc[4][4];
  const bf16_t* Bt = (pass == 0 ? p.wbra_t : p.wbrb_t) + (size_t)n0 * 512;
  gemm_tile_naive(f, Bt, 512, 512, As, Bs, acc);
  int ty = threadIdx.x >> 4, tx = threadIdx.x & 15;
  for (int i = 0; i < 4; ++i)
    for (int j = 0; j < 4; ++j) {
      int m = m0 + ty * 4 + i, n = n0 + tx * 4 + j;
      float g = bf2f(p.proj[(size_t)m * PW + (pass == 0 ? C_GA : C_GB) + n]);
      float v = acc[i][j] * g;
      if (pass == 0) p.ntmp[(size_t)m * DM + n] = v;
      else p.merged[(size_t)m * DM + n] = f2bf(p.ntmp[(size_t)m * DM + n] + v);
    }
}

struct FMix {
  const Params& p; int m0;
  __device__ const bf16_t* arow(int r) const { return p.merged + (size_t)(m0 + r) * DM; }
};
__global__ __launch_bounds__(256) void k_gemm_mix(Params p) {
  __shared__ float As[32][68], Bs[32][68];
  int n0 = blockIdx.x * 64, m0 = blockIdx.y * 64;
  FMix f{p, m0};
  float acc[4][4];
  gemm_tile_naive(f, p.wo_t + (size_t)n0 * DM, DM, DM, As, Bs, acc);
  int ty = threadIdx.x >> 4, tx = threadIdx.x & 15;
  for (int i = 0; i < 4; ++i)
    for (int j = 0; j < 4; ++j) {
      int m = m0 + ty * 4 + i, n = n0 + tx * 4 + j;
      p.mixer[(size_t)m * DM + n] = f2bf(acc[i][j]);
    }
}

__global__ __launch_bounds__(128) void k_dn_prep(Params p) {
  int t = blockIdx.x >> 2, h = blockIdx.x & 3;
  int b = t / SEQ, s = t % SEQ;
  int d = threadIdx.x;
  __shared__ float red[2][2];
  float val[3];
#pragma unroll
  for (int part = 0; part < 3; ++part) {
    int ch = part * 512 + h * 128 + d;
    float a = 0.f;
#pragma unroll
    for (int i = 0; i < 4; ++i) {
      int ss = s - 3 + i;
      if (ss >= 0) a += p.conv_w[i * 1536 + ch] * bf2f(p.proj[(size_t)(b * SEQ + ss) * PW + ch]);
    }
    val[part] = siluf_(a);
  }
  float sq = wave_sum(val[0] * val[0]), sk = wave_sum(val[1] * val[1]);
  int wid = d >> 6;
  if ((d & 63) == 0) { red[0][wid] = sq; red[1][wid] = sk; }
  __syncthreads();
  sq = red[0][0] + red[0][1]; sk = red[1][0] + red[1][1];
  size_t o = (((size_t)b * 4 + h) * SEQ + s) * 128 + d;
  p.nq[o] = val[0] * rsqrtf(sq + 1e-6f);
  p.nk[o] = val[1] * rsqrtf(sk + 1e-6f);
  p.nv[o] = val[2];
  if (d == 0) {
    float bb = p.ba[(size_t)t * 8 + h], aa = p.ba[(size_t)t * 8 + 4 + h];
    float xx = aa + p.dt_bias[h];
    float sp = xx > 20.f ? xx : log1pf(__expf(xx));
    size_t o2 = ((size_t)b * 4 + h) * SEQ + s;
    p.nbeta[o2] = sigmoidf_(bb);
    p.ng[o2] = -__expf(p.a_log[h]) * sp;
  }
}
__global__ __launch_bounds__(128) void k_dn_scan(Params p) {
  int bh = blockIdx.x;
  int e = threadIdx.x;
  __shared__ float sk[2][128], sq[2][128];
  float S[128];
#pragma unroll
  for (int d = 0; d < 128; ++d) S[d] = 0.f;
  const float* q = p.nq + (size_t)bh * SEQ * 128;
  const float* k = p.nk + (size_t)bh * SEQ * 128;
  const float* v = p.nv + (size_t)bh * SEQ * 128;
  float* o = p.no + (size_t)bh * SEQ * 128;
  const float scale = 0.08838834764831845f;
  for (int s = 0; s < SEQ; ++s) {
    int buf = s & 1;
    sk[buf][e] = k[(size_t)s * 128 + e];
    sq[buf][e] = q[(size_t)s * 128 + e];
    float vt = v[(size_t)s * 128 + e];
    float beta = p.nbeta[(size_t)bh * SEQ + s];
    float dec = __expf(p.ng[(size_t)bh * SEQ + s]);
    __syncthreads();
    float ks = 0.f;
#pragma unroll
    for (int d = 0; d < 128; ++d) ks += sk[buf][d] * S[d];
    ks *= dec;
    float vn = beta * (vt - ks);
    float ot = 0.f;
#pragma unroll
    for (int d = 0; d < 128; ++d) {
      S[d] = dec * S[d] + sk[buf][d] * vn;
      ot += sq[buf][d] * S[d];
    }
    o[(size_t)s * 128 + e] = ot * scale;
  }
}
__global__ __launch_bounds__(128) void k_dn_post(Params p) {
  int t = blockIdx.x >> 2, h = blockIdx.x & 3;
  int b = t / SEQ, s = t % SEQ;
  int d = threadIdx.x;
  __shared__ float red[2];
  float ov = p.no[(((size_t)b * 4 + h) * SEQ + s) * 128 + d];
  float ss = wave_sum(ov * ov);
  if ((d & 63) == 0) red[d >> 6] = ss;
  __syncthreads();
  ss = red[0] + red[1];
  float y = ov * rsqrtf(ss * (1.f / 128) + 1e-6f) * p.g_dn_out[d];
  float z = bf2f(p.proj[(size_t)t * PW + C_Z + h * 128 + d]);
  p.oab[(size_t)t * DM + h * 128 + d] = f2bf(y * siluf_(z));
}

__global__ __launch_bounds__(128) void k_rope(Params p) {
  int t = blockIdx.x >> 2, h = blockIdx.x & 3;
  int b = t / SEQ, s = t % SEQ;
  int d = threadIdx.x;
  const bf16_t* qr = p.proj + (size_t)t * PW + C_MQ + h * 128;
  const bf16_t* kr = p.proj + (size_t)t * PW + C_MK + h * 128;
  float qv = bf2f(qr[d]), kv = bf2f(kr[d]);
  if (d < 32) {
    int i = d & 15;
    float inv = exp2f(-(float)i * (1.f / 16.f) * 18.931568569324174f);
    float ang = (float)s * inv;
    float cs = cosf(ang), sn = sinf(ang);
    float qo = bf2f(qr[d ^ 16]), ko = bf2f(kr[d ^ 16]);
    if (d < 16) { qv = qv * cs - qo * sn; kv = kv * cs - ko * sn; }
    else        { qv = qv * cs + qo * sn; kv = kv * cs + ko * sn; }
  }
  size_t o = (((size_t)b * 4 + h) * SEQ + s) * 128 + d;
  p.qb[o] = f2bf(qv);
  p.kb[o] = f2bf(kv);
}
__global__ __launch_bounds__(128) void k_kmean(Params p) {
  int bhj = blockIdx.x;
  int d = threadIdx.x;
  const bf16_t* kr = p.kb + (size_t)bhj * 256 * 128;
  float a = 0.f;
  for (int i = 0; i < 256; ++i) a += bf2f(kr[(size_t)i * 128 + d]);
  p.kmean[(size_t)bhj * 128 + d] = a * (1.f / 256.f);
}
__global__ __launch_bounds__(256) void k_moba(Params p) {
  __shared__ float sqv[4][128];
  __shared__ float sp[4][1024];
  int wid = threadIdx.x >> 6, lane = threadIdx.x & 63;
  int gq = blockIdx.x * 4 + wid;
  int bh = gq / SEQ, s = gq % SEQ;
  int b = bh >> 2, h = bh & 3;
  int qblk = s >> 8;
  const bf16_t* qr = p.qb + (size_t)gq * 128;
  sqv[wid][lane] = bf2f(qr[lane]);
  sqv[wid][lane + 64] = bf2f(qr[lane + 64]);
  __syncthreads();
  float sc = -INFINITY;
  if (lane < qblk) {
    const float* km = p.kmean + ((size_t)bh * 16 + lane) * 128;
    float a = 0.f;
    for (int d = 0; d < 128; ++d) a += sqv[wid][d] * km[d];
    sc = a;
  }
  int sel[4];
#pragma unroll
  for (int r = 0; r < 3; ++r) {
    float m = wave_max(sc);
    unsigned long long bal = __ballot(sc == m);
    int idx = __ffsll((long long)bal) - 1;
    sel[r] = (m == -INFINITY) ? -1 : idx;
    if (lane == idx) sc = -INFINITY;
  }
  sel[3] = qblk;
  const float scale = 0.08838834764831845f;
  const bf16_t* kbase = p.kb + (size_t)bh * SEQ * 128;
  float lmax = -INFINITY;
#pragma unroll
  for (int j = 0; j < 4; ++j) {
    int blk = sel[j];
    if (blk < 0) continue;
    for (int i = 0; i < 4; ++i) {
      int kk = i * 64 + lane;
      int kpos = blk * 256 + kk;
      float lg = -INFINITY;
      if (kpos <= s) {
        const bf16_t* kr = kbase + (size_t)kpos * 128;
        float a = 0.f;
        for (int d8 = 0; d8 < 16; ++d8) {
          uint4 u = *(const uint4*)(kr + d8 * 8);
          unsigned w[4] = {u.x, u.y, u.z, u.w};
#pragma unroll
          for (int e = 0; e < 4; ++e) {
            a += sqv[wid][d8 * 8 + 2 * e] * __uint_as_float(w[e] << 16);
            a += sqv[wid][d8 * 8 + 2 * e + 1] * __uint_as_float(w[e] & 0xffff0000u);
          }
        }
        lg = a * scale;
      }
      sp[wid][j * 256 + kk] = lg;
      lmax = fmaxf(lmax, lg);
    }
  }
  lmax = wave_max(lmax);
  float lsum = 0.f;
#pragma unroll
  for (int j = 0; j < 4; ++j) {
    if (sel[j] < 0) continue;
    for (int i = 0; i < 4; ++i) {
      int idx = j * 256 + i * 64 + lane;
      float e = __expf(sp[wid][idx] - lmax);
      sp[wid][idx] = e;
      lsum += e;
    }
  }
  lsum = wave_sum(lsum);
  __syncthreads();
  float o0 = 0.f, o1 = 0.f;
#pragma unroll
  for (int j = 0; j < 4; ++j) {
    int blk = sel[j];
    if (blk < 0) continue;
    const bf16_t* vb = p.proj + (size_t)(b * SEQ + blk * 256) * PW + C_MV + h * 128;
    int nk = (blk == qblk) ? (s - blk * 256 + 1) : 256;
    for (int kk = 0; kk < nk; ++kk) {
      float pr = sp[wid][j * 256 + kk];
      o0 += pr * bf2f(vb[(size_t)kk * PW + lane]);
      o1 += pr * bf2f(vb[(size_t)kk * PW + lane + 64]);
    }
  }
  float inv = 1.f / lsum;
  int t = b * SEQ + s;
  p.oab[(size_t)t * DM + 512 + h * 128 + lane] = f2bf(o0 * inv);
  p.oab[(size_t)t * DM + 512 + h * 128 + lane + 64] = f2bf(o1 * inv);
}

__global__ __launch_bounds__(256) void k_post_mix(Params p) {
  __shared__ float sh[4][1024];
  int wid = threadIdx.x >> 6, lane = threadIdx.x & 63;
  int t = blockIdx.x * 4 + wid;
  int b = t / SEQ;
  const float* md = p.mod + b * 6144;
  float mv[16];
  float ss = 0.f;
#pragma unroll
  for (int i = 0; i < 16; ++i) {
    int k = i * 64 + lane;
    mv[i] = bf2f(p.mixer[(size_t)t * DM + k]);
    ss += mv[i] * mv[i];
  }
  ss = wave_sum(ss);
  float rstd = rsqrtf(ss * (1.f / DM) + 1e-6f);
  float x1[16];
  float s2 = 0.f;
#pragma unroll
  for (int i = 0; i < 16; ++i) {
    int k = i * 64 + lane;
    x1[i] = p.x[(size_t)t * DM + k] + md[2048 + k] * (mv[i] * rstd * p.g_post_mix[k]);
    p.out[(size_t)t * DM + k] = x1[i];
    s2 += x1[i] * x1[i];
  }
  s2 = wave_sum(s2);
  float rstd2 = rsqrtf(s2 * (1.f / DM) + 1e-6f);
#pragma unroll
  for (int i = 0; i < 16; ++i) {
    int k = i * 64 + lane;
    float hv = x1[i] * rstd2 * p.g_pre_ffn[k] * (1.f + md[4096 + k]) + md[3072 + k];
    p.h2[(size_t)t * DM + k] = f2bf(hv);
    sh[wid][k] = hv;
  }
  __syncthreads();
  int e = lane & 31, half = lane >> 5;
  float a = 0.f;
  for (int k = half * 512; k < half * 512 + 512; ++k) a += sh[wid][k] * p.w_router[(size_t)k * 32 + e];
  a += __shfl_xor(a, 32, 64);
  float lg = a + p.b_router[e];
  if (lane >= 32) lg = -INFINITY;
  float tv[4]; int ti[4];
#pragma unroll
  for (int r = 0; r < 4; ++r) {
    float m = wave_max(lg);
    unsigned long long bal = __ballot(lg == m);
    int idx = __ffsll((long long)bal) - 1;
    tv[r] = m; ti[r] = idx;
    if (lane == idx) lg = -INFINITY;
  }
  float e0 = 1.f, e1 = __expf(tv[1] - tv[0]), e2 = __expf(tv[2] - tv[0]), e3 = __expf(tv[3] - tv[0]);
  float inv = 1.f / (e0 + e1 + e2 + e3);
  if (lane < 4) {
    int ee = lane == 0 ? ti[0] : lane == 1 ? ti[1] : lane == 2 ? ti[2] : ti[3];
    float ww = (lane == 0 ? e0 : lane == 1 ? e1 : lane == 2 ? e2 : e3) * inv;
    int pos = atomicAdd(&p.cnt[ee], 1);
    p.elist[ee * T_TOK + pos] = t * 4 + lane;
    p.aw[t * 4 + lane] = ww;
  }
}

__device__ __forceinline__ bool moe_tile(const int* cnt, int mt, int& e, int& lt, int& rowoff, int& n) {
  int off = 0;
  for (int i = 0; i < NE; ++i) {
    int c = cnt[i];
    int nt = (c + 63) >> 6;
    if (mt < nt) { e = i; lt = mt; rowoff = off; n = c; return true; }
    mt -= nt; off += c;
  }
  return false;
}
struct FMoe1 {
  const Params& p; int e, i0, n;
  __device__ const bf16_t* arow(int r) const {
    int i = i0 + r;
    if (i >= n) return nullptr;
    int a = p.elist[e * T_TOK + i];
    return p.h2 + (size_t)(a >> 2) * DM;
  }
};
__global__ __launch_bounds__(256) void k_moe1(Params p) {
  __shared__ float As[32][68], Bs[32][68];
  __shared__ float Cs[64][65];
  int e, lt, rowoff, n;
  if (!moe_tile(p.cnt, blockIdx.y, e, lt, rowoff, n)) return;
  int n0 = blockIdx.x * 64;
  FMoe1 f{p, e, lt * 64, n};
  float acc[4][4];
  gemm_tile_naive(f, p.wgu_t + ((size_t)e * 2048 + n0) * DM, DM, DM, As, Bs, acc);
  int ty = threadIdx.x >> 4, tx = threadIdx.x & 15;
  for (int i = 0; i < 4; ++i)
    for (int j = 0; j < 4; ++j) Cs[ty * 4 + i][tx * 4 + j] = acc[i][j];
  __syncthreads();
  int j0 = blockIdx.x * 32;
  for (int idx = threadIdx.x; idx < 64 * 32; idx += 256) {
    int r = idx >> 5, jj = idx & 31;
    int i = lt * 64 + r;
    if (i < n) {
      float g = Cs[r][jj] + p.b_gu[(size_t)e * 2048 + j0 + jj];
      float u = Cs[r][32 + jj] + p.b_gu[(size_t)e * 2048 + 1024 + j0 + jj];
      g = fminf(g, 7.f);
      u = fminf(fmaxf(u, -7.f), 7.f);
      float a = (u + 1.f) * g * sigmoidf_(1.702f * g);
      p.act[(size_t)(rowoff + i) * DM + j0 + jj] = f2bf(a);
    }
  }
}
struct FMoe2 {
  const Params& p; int rowoff, i0, n;
  __device__ const bf16_t* arow(int r) const {
    int i = i0 + r;
    if (i >= n) return nullptr;
    return p.act + (size_t)(rowoff + i) * DM;
  }
};
__global__ __launch_bounds__(256) void k_moe2(Params p) {
  __shared__ float As[32][68], Bs[32][68];
  int e, lt, rowoff, n;
  if (!moe_tile(p.cnt, blockIdx.y, e, lt, rowoff, n)) return;
  int n0 = blockIdx.x * 64;
  FMoe2 f{p, rowoff, lt * 64, n};
  float acc[4][4];
  gemm_tile_naive(f, p.wd_t + ((size_t)e * 1024 + n0) * DM, DM, DM, As, Bs, acc);
  int ty = threadIdx.x >> 4, tx = threadIdx.x & 15;
  for (int i = 0; i < 4; ++i) {
    int ii = lt * 64 + ty * 4 + i;
    if (ii < n) {
      int a = p.elist[e * T_TOK + ii];
      for (int j = 0; j < 4; ++j) {
        int nn = n0 + tx * 4 + j;
        p.yslot[(size_t)a * DM + nn] = f2bf(acc[i][j] + p.b_down[(size_t)e * 1024 + nn]);
      }
    }
  }
}
__global__ __launch_bounds__(256) void k_final(Params p) {
  int wid = threadIdx.x >> 6, lane = threadIdx.x & 63;
  int t = blockIdx.x * 4 + wid;
  int b = t / SEQ;
  const float* md = p.mod + b * 6144;
  float w0 = p.aw[t * 4], w1 = p.aw[t * 4 + 1], w2 = p.aw[t * 4 + 2], w3 = p.aw[t * 4 + 3];
  float mv[16];
  float ss = 0.f;
#pragma unroll
  for (int i = 0; i < 16; ++i) {
    int k = i * 64 + lane;
    const bf16_t* y = p.yslot + (size_t)t * 4 * DM + k;
    mv[i] = w0 * bf2f(y[0]) + w1 * bf2f(y[DM]) + w2 * bf2f(y[2 * DM]) + w3 * bf2f(y[3 * DM]);
    ss += mv[i] * mv[i];
  }
  ss = wave_sum(ss);
  float rstd = rsqrtf(ss * (1.f / DM) + 1e-6f);
#pragma unroll
  for (int i = 0; i < 16; ++i) {
    int k = i * 64 + lane;
    p.out[(size_t)t * DM + k] = p.out[(size_t)t * DM + k] + md[5120 + k] * (mv[i] * rstd * p.g_post_ffn[k]);
  }
}

static inline size_t al(size_t x) { return (x + 255) & ~(size_t)255; }

extern "C" void kernel_launch(void* const* d_in, const int* in_sizes, int n_in, void* d_out, int out_size, void* d_ws,
                              size_t ws_size, hipStream_t stream) {
  Params p{};
  p.x = (const float*)d_in[0]; p.c = (const float*)d_in[1]; p.w_ada = (const float*)d_in[2]; p.b_ada = (const float*)d_in[3];
  p.g_pre_mix = (const float*)d_in[4]; p.g_post_mix = (const float*)d_in[5]; p.g_pre_ffn = (const float*)d_in[6];
  p.g_post_ffn = (const float*)d_in[7]; p.w_in = (const float*)d_in[8]; p.conv_w = (const float*)d_in[9];
  p.a_log = (const float*)d_in[10]; p.dt_bias = (const float*)d_in[11]; p.g_dn_out = (const float*)d_in[12];
  p.w_br_a = (const float*)d_in[13]; p.w_br_b = (const float*)d_in[14]; p.w_o = (const float*)d_in[15];
  p.w_router = (const float*)d_in[16]; p.b_router = (const float*)d_in[17]; p.w_gu = (const float*)d_in[18];
  p.b_gu = (const float*)d_in[19]; p.w_down = (const float*)d_in[20]; p.b_down = (const float*)d_in[21];
  p.out = (float*)d_out;
  char* w = (char*)d_ws;
  size_t o = 0;
  auto take = [&](size_t bytes) { char* r = w + o; o += al(bytes); return r; };
  p.mod = (float*)take(4 * 6144 * 4);
  p.cnt = (int*)take(256);
  p.ba = (float*)take((size_t)T_TOK * 8 * 4);
  p.hbf = (bf16_t*)take((size_t)T_TOK * DM * 2);
  p.proj = (bf16_t*)take((size_t)T_TOK * PW * 2);
  p.w_in_t = (bf16_t*)take((size_t)PW * DM * 2);
  p.wgu_t = (bf16_t*)take((size_t)NE * 2048 * DM * 2);
  p.wd_t = (bf16_t*)take((size_t)NE * 1024 * DM * 2);
  p.wbra_t = (bf16_t*)take((size_t)1024 * 512 * 2);
  p.wbrb_t = (bf16_t*)take((size_t)1024 * 512 * 2);
  p.wo_t = (bf16_t*)take((size_t)1024 * 1024 * 2);
  p.qb = (bf16_t*)take((size_t)T_TOK * 512 * 2);
  p.kb = (bf16_t*)take((size_t)T_TOK * 512 * 2);
  p.kmean = (float*)take((size_t)16 * 16 * 128 * 4);
  p.oab = (bf16_t*)take((size_t)T_TOK * DM * 2);
  p.merged = (bf16_t*)take((size_t)T_TOK * DM * 2);
  p.mixer = (bf16_t*)take((size_t)T_TOK * DM * 2);
  p.h2 = (bf16_t*)take((size_t)T_TOK * DM * 2);
  p.elist = (int*)take((size_t)NE * T_TOK * 4);
  p.aw = (float*)take((size_t)T_TOK * 4 * 4);
  char* big = take((size_t)65536 * DM * 2 * 2);
  p.act = (bf16_t*)big;
  p.yslot = (bf16_t*)(big + (size_t)65536 * DM * 2);
  {
    char* s = big; size_t so = 0;
    auto t2 = [&](size_t bytes) { char* r = s + so; so += al(bytes); return r; };
    p.nq = (float*)t2((size_t)T_TOK * 512 * 4);
    p.nk = (float*)t2((size_t)T_TOK * 512 * 4);
    p.nv = (float*)t2((size_t)T_TOK * 512 * 4);
    p.no = (float*)t2((size_t)T_TOK * 512 * 4);
    p.ntmp = (float*)t2((size_t)T_TOK * DM * 4);
    p.nbeta = (float*)t2((size_t)T_TOK * 4 * 4);
    p.ng = (float*)t2((size_t)T_TOK * 4 * 4);
  }

  hipMemsetAsync(p.cnt, 0, 256, stream);
  k_mod<<<24, 256, 0, stream>>>(p);
  k_wt<<<dim3((INW + 31) / 32, 32, 1), 256, 0, stream>>>(p.w_in, p.w_in_t, 1024, INW, 1, 0, 0);
  k_wt<<<dim3(64, 32, NE), 256, 0, stream>>>(p.w_gu, p.wgu_t, 1024, 2048, 2, (size_t)1024 * 2048, (size_t)2048 * 1024);
  k_wt<<<dim3(32, 32, NE), 256, 0, stream>>>(p.w_down, p.wd_t, 1024, 1024, 0, (size_t)1024 * 1024, (size_t)1024 * 1024);
  k_wt<<<dim3(32, 16, 1), 256, 0, stream>>>(p.w_br_a, p.wbra_t, 512, 1024, 0, 0, 0);
  k_wt<<<dim3(32, 16, 1), 256, 0, stream>>>(p.w_br_b, p.wbrb_t, 512, 1024, 0, 0, 0);
  k_wt<<<dim3(32, 32, 1), 256, 0, stream>>>(p.w_o, p.wo_t, 1024, 1024, 0, 0, 0);
  k_h<<<T_TOK / 4, 256, 0, stream>>>(p);
  k_gemm_proj<<<dim3(PW / 64, T_TOK / 64), 256, 0, stream>>>(p);
  k_dn_prep<<<T_TOK * 4, 128, 0, stream>>>(p);
  k_dn_scan<<<16, 128, 0, stream>>>(p);
  k_dn_post<<<T_TOK * 4, 128, 0, stream>>>(p);
  k_rope<<<T_TOK * 4, 128, 0, stream>>>(p);
  k_kmean<<<256, 128, 0, stream>>>(p);
  k_moba<<<T_TOK * 4 / 4, 256, 0, stream>>>(p);
  k_gemm_br<<<dim3(DM / 64, T_TOK / 64), 256, 0, stream>>>(p, 0);
  k_gemm_br<<<dim3(DM / 64, T_TOK / 64), 256, 0, stream>>>(p, 1);
  k_gemm_mix<<<dim3(DM / 64, T_TOK / 64), 256, 0, stream>>>(p);
  k_post_mix<<<T_TOK / 4, 256, 0, stream>>>(p);
  k_moe1<<<dim3(2048 / 64, 65536 / 64 + NE), 256, 0, stream>>>(p);
  k_moe2<<<dim3(1024 / 64, 65536 / 64 + NE), 256, 0, stream>>>(p);
  k_final<<<T_TOK / 4, 256, 0, stream>>>(p);
}
```

```cpp
#include <hip/hip_runtime.h>
#include <stdint.h>

typedef unsigned short bf16_t;

#define T_TOK 16384
#define SEQ 4096
#define NB 4
#define DM 1024
#define INW 5640
#define PW 5632
#define C_QA 0
#define C_KA 512
#define C_VA 1024
#define C_Z 1536
#define C_MQ 2048
#define C_MK 2560
#define C_MV 3072
#define C_GA 3584
#define C_GB 4608
#define NE 32

__device__ __forceinline__ bf16_t f2bf(float f) {
  unsigned u = __float_as_uint(f);
  u += 0x7fffu + ((u >> 16) & 1u);
  return (bf16_t)(u >> 16);
}
__device__ __forceinline__ float bf2f(bf16_t h) { return __uint_as_float(((unsigned)h) << 16); }
__device__ __forceinline__ float sigmoidf_(float x) { return 1.f / (1.f + __expf(-x)); }
__device__ __forceinline__ float siluf_(float x) { return x / (1.f + __expf(-x)); }
__device__ __forceinline__ float wave_sum(float v) {
#pragma unroll
  for (int o = 32; o > 0; o >>= 1) v += __shfl_xor(v, o, 64);
  return v;
}
__device__ __forceinline__ float wave_max(float v) {
#pragma unroll
  for (int o = 32; o > 0; o >>= 1) v = fmaxf(v, __shfl_xor(v, o, 64));
  return v;
}

struct Params {
  const float *x, *c, *w_ada, *b_ada, *g_pre_mix, *g_post_mix, *g_pre_ffn, *g_post_ffn, *w_in, *conv_w,
      *a_log, *dt_bias, *g_dn_out, *w_br_a, *w_br_b, *w_o, *w_router, *b_router, *w_gu, *b_gu, *w_down, *b_down;
  float* out;
  float* mod;
  int* cnt;
  float* ba;
  bf16_t* hbf;
  bf16_t* proj;
  bf16_t* w_in_t;
  bf16_t* wgu_t;
  bf16_t* wd_t;
  bf16_t* wbra_t;
  bf16_t* wbrb_t;
  bf16_t* wo_t;
  bf16_t* qb;
  bf16_t* kb;
  float* kmean;
  bf16_t* oab;
  bf16_t* merged;
  bf16_t* mixer;
  bf16_t* h2;
  int* elist;
  float* aw;
  bf16_t* act;
  bf16_t* xs;
  int* rowmap;
  bf16_t* yslot;
  float* nq; float* nk; float* nv;
  float* nbeta; float* ng;
  float* no;
  float* ntmp;
};

__global__ __launch_bounds__(256) void k_mod(Params p) {
  __shared__ float sc[4][1024];
  for (int i = threadIdx.x; i < 4096; i += 256) sc[i >> 10][i & 1023] = siluf_(p.c[i]);
  __syncthreads();
  int j = blockIdx.x * 256 + threadIdx.x;
  float a0 = 0, a1 = 0, a2 = 0, a3 = 0;
  for (int k = 0; k < 1024; ++k) {
    float w = p.w_ada[(size_t)k * 6144 + j];
    a0 += sc[0][k] * w; a1 += sc[1][k] * w; a2 += sc[2][k] * w; a3 += sc[3][k] * w;
  }
  float b = p.b_ada[j];
  p.mod[0 * 6144 + j] = a0 + b; p.mod[1 * 6144 + j] = a1 + b;
  p.mod[2 * 6144 + j] = a2 + b; p.mod[3 * 6144 + j] = a3 + b;
}

__device__ __forceinline__ int map_col(int n, int mode) {
  if (mode == 0) return n;
  if (mode == 1) return n < 2048 ? n : (n < 2056 ? -1 : n - 8);
  if (n < 1024) return (n >> 7) * 256 + (n & 127);
  int j = n - 1024;
  return (j >> 7) * 256 + 128 + (j & 127);
}
__global__ __launch_bounds__(256) void k_wt(const float* __restrict__ src, bf16_t* __restrict__ dst, int K, int N, int mode,
                                            size_t src_estride, size_t dst_estride) {
  __shared__ float tile[32][33];
  src += (size_t)blockIdx.z * src_estride;
  dst += (size_t)blockIdx.z * dst_estride;
  int n0 = blockIdx.x * 32, k0 = blockIdx.y * 32;
  int tx = threadIdx.x & 31, ty = threadIdx.x >> 5;
  for (int r = ty; r < 32; r += 8) {
    int n = n0 + tx;
    tile[r][tx] = (n < N) ? src[(size_t)(k0 + r) * N + n] : 0.f;
  }
  __syncthreads();
  for (int r = ty; r < 32; r += 8) {
    int n = n0 + r;
    if (n < N) {
      int d = map_col(n, mode);
      if (d >= 0) dst[(size_t)d * K + k0 + tx] = f2bf(tile[tx][r]);
    }
  }
}

__global__ __launch_bounds__(256) void k_h(Params p) {
  int wid = threadIdx.x >> 6, lane = threadIdx.x & 63;
  int t = blockIdx.x * 4 + wid;
  int b = t / SEQ;
  const float* xr = p.x + (size_t)t * DM;
  float v[16];
  float ss = 0.f;
#pragma unroll
  for (int i = 0; i < 4; ++i) {
    float4 q = *(const float4*)(xr + i * 256 + lane * 4);
    v[i * 4 + 0] = q.x; v[i * 4 + 1] = q.y; v[i * 4 + 2] = q.z; v[i * 4 + 3] = q.w;
    ss += q.x * q.x + q.y * q.y + q.z * q.z + q.w * q.w;
  }
  ss = wave_sum(ss);
  float rstd = rsqrtf(ss * (1.f / DM) + 1e-6f);
  const float* shift = p.mod + b * 6144;
  const float* scale = p.mod + b * 6144 + 1024;
  float acc[8] = {0, 0, 0, 0, 0, 0, 0, 0};
#pragma unroll
  for (int i = 0; i < 4; ++i) {
    bf16_t o[4];
#pragma unroll
    for (int j = 0; j < 4; ++j) {
      int k = i * 256 + lane * 4 + j;
      float h = v[i * 4 + j] * rstd * p.g_pre_mix[k] * (1.f + scale[k]) + shift[k];
      o[j] = f2bf(h);
      const float* wr = p.w_in + (size_t)k * INW + 2048;
#pragma unroll
      for (int e = 0; e < 8; ++e) acc[e] += h * wr[e];
    }
    uint2 pk;
    pk.x = (unsigned)o[0] | ((unsigned)o[1] << 16);
    pk.y = (unsigned)o[2] | ((unsigned)o[3] << 16);
    *(uint2*)(p.hbf + (size_t)t * DM + i * 256 + lane * 4) = pk;
  }
#pragma unroll
  for (int e = 0; e < 8; ++e) acc[e] = wave_sum(acc[e]);
  if (lane == 0) {
#pragma unroll
    for (int e = 0; e < 8; ++e) p.ba[(size_t)t * 8 + e] = acc[e];
  }
}

namespace pg8 {
#define PG8_LAS __attribute__((address_space(3)))
typedef short bf16x8 __attribute__((ext_vector_type(8)));
typedef float f32x4 __attribute__((ext_vector_type(4)));
typedef unsigned u32x4 __attribute__((ext_vector_type(4)));
constexpr int BM = 256, BK = 64, HALF = 128, HTB = HALF * BK * 2, STAGE_BYTES = 8 * HTB, NXCD = 8, WGM = 8;

__host__ __device__ __forceinline__ int lds_byte(int r, int c) { const int st = (r >> 4) * 2 + (c >> 5), rr = r & 15, cc = c & 31, ob = rr * 64 + cc * 2; return st * 1024 + (ob ^ (((ob >> 9) & 1) << 5)); }
__host__ __device__ __forceinline__ void stage_rc(int b, int& R, int& C) { const int st = b / 1024, sb = b % 1024, swz = sb ^ (((sb >> 9) & 1) << 5); R = (st >> 1) * 16 + swz / 64; C = (st & 1) * 32 + (swz % 64) / 2; }
__host__ __device__ __forceinline__ int perm32(int rho) { const int n = rho >> 4, i = rho & 15; return 8 * (i >> 2) + 4 * n + (i & 3); }

struct Unit { int pm, pn, z; };
__device__ __forceinline__ unsigned cvt_pk_bf16(float lo, float hi) { unsigned r; asm volatile("v_cvt_pk_bf16_f32 %0, %1, %2" : "=v"(r) : "v"(lo), "v"(hi)); return r; }

struct TileOrder {
    int nM, nN, nwg, G, c;
    __device__ void init(int nM_, int nN_, int G_, int c_) { nM = nM_; nN = nN_; nwg = nM * nN; G = G_; c = c_; }
    __device__ bool tile(int i, int& pm, int& pn) const {
        const long L = (long)i * G + c; if (L >= nwg) return false;
        int wgid = (int)L; { const int q = nwg / NXCD, r = nwg % NXCD, xcd = wgid % NXCD, off = wgid / NXCD; wgid = (xcd < r ? xcd * (q + 1) : r * (q + 1) + (xcd - r) * q) + off; }
        const int nig = WGM * nN, gid = wgid / nig, fm = gid * WGM, gsz = (nM - fm) < WGM ? (nM - fm) : WGM;
        pm = fm + ((wgid % nig) % gsz); pn = (wgid % nig) / gsz; return true;
    }
};

template <class Epi, class Sched>
__device__ __forceinline__ void gemm_phase(PG8_LAS unsigned char* lds, const int lda, const int ldb, const int K, const Sched& S, const Epi& E) {
    const int tid = threadIdx.x, wid = __builtin_amdgcn_readfirstlane(tid >> 6), lane = tid & 63, wr = wid >> 2, wc = wid & 3, fr = lane & 15, fq = lane >> 4;
    const int nt = K / BK;
    unsigned voffA[2], voffB[2];
#pragma unroll
    for (int i = 0; i < 2; ++i) { int R, C; stage_rc(tid * 16 + i * 8192, R, C); const int Rb = Epi::PERM ? ((R & ~31) + perm32(R & 31)) : R;
        voffA[i] = (unsigned)(R * lda + C) * 2u; voffB[i] = (unsigned)(Rb * ldb + C) * 2u; }
    const size_t kstep = (size_t)(BK * 2);
    const size_t hstepA = (size_t)HALF * lda * 2, hstepB = (size_t)HALF * ldb * 2;
    const unsigned ldsw = (unsigned)wid * 1024u;
    const int aoff = lds_byte(wr * 64 + fr, fq * 8), boff = lds_byte(wc * 32 + fr, fq * 8);
#define PG8_SA(b, h) (((b) * 2 + (h)) * HTB)
#define PG8_SB(b, h) ((4 + (b) * 2 + (h)) * HTB)
#define PG8_STAGE(bufoff, gbase, voff) do { _Pragma("unroll") for (int _i = 0; _i < 2; ++_i) \
        __builtin_amdgcn_global_load_lds((const unsigned*)((const char*)(gbase) + (voff)[_i]), (PG8_LAS unsigned*)(lds + (bufoff) + ldsw + _i * 8192), 16, 0, 0); } while (0)
#define PG8_LDA(dst, b, h) do { _Pragma("unroll") for (int m = 0; m < 4; ++m) _Pragma("unroll") for (int k = 0; k < 2; ++k) dst[m][k] = *(const PG8_LAS bf16x8*)(lds + PG8_SA(b, h) + aoff + m * 2048 + k * 1024); } while (0)
#define PG8_LDB(dst, b, h) do { _Pragma("unroll") for (int n = 0; n < 2; ++n) _Pragma("unroll") for (int k = 0; k < 2; ++k) dst[n][k] = *(const PG8_LAS bf16x8*)(lds + PG8_SB(b, h) + boff + n * 2048 + k * 1024); } while (0)
#define PG8_MMA(ai, bj, At, Bt) do { __builtin_amdgcn_s_setprio(1); _Pragma("unroll") for (int m = 0; m < 4; ++m) _Pragma("unroll") for (int n = 0; n < 2; ++n) _Pragma("unroll") for (int k = 0; k < 2; ++k) \
        acc[ai][bj][m][n] = __builtin_amdgcn_mfma_f32_16x16x32_bf16(Bt[n][k], At[m][k], acc[ai][bj][m][n], 0, 0, 0); __builtin_amdgcn_s_setprio(0); } while (0)
#define PG8_WAIT_V(n) asm volatile("s_waitcnt vmcnt(" #n ")" ::: "memory")
#define PG8_WAIT_L(n) asm volatile("s_waitcnt lgkmcnt(" #n ")" ::: "memory")
#define PG8_BAR __builtin_amdgcn_s_barrier()
#define PG8_SCHED __builtin_amdgcn_sched_barrier(0)
    Unit cur, nxt; int ui = 0;
    if (!S.next(0, cur)) return;
    f32x4 acc[2][2][4][2];
#pragma unroll
    for (int a = 0; a < 2; ++a)
#pragma unroll
        for (int b = 0; b < 2; ++b)
#pragma unroll
            for (int m = 0; m < 4; ++m)
#pragma unroll
                for (int n = 0; n < 2; ++n) acc[a][b][m][n] = (f32x4){0.f, 0.f, 0.f, 0.f};
    bf16x8 At[4][2], B0[2][2], B1[2][2];
    const char* cA = S.a_ptr(cur); const char* cB = S.b_ptr(cur);
    PG8_STAGE(PG8_SB(0, 0), cB, voffB); PG8_STAGE(PG8_SA(0, 0), cA, voffA); PG8_STAGE(PG8_SB(0, 1), cB + hstepB, voffB); PG8_STAGE(PG8_SA(0, 1), cA + hstepA, voffA);
    if (wr == 1) PG8_BAR;
    PG8_WAIT_V(4); PG8_BAR;
    PG8_STAGE(PG8_SB(1, 0), cB + kstep, voffB); PG8_STAGE(PG8_SA(1, 0), cA + kstep, voffA); PG8_STAGE(PG8_SB(1, 1), cB + hstepB + kstep, voffB);
    PG8_WAIT_V(6); PG8_BAR;
    for (;;) {
        const bool has_next = S.next(ui + 1, nxt);
        const char* nA = has_next ? S.a_ptr(nxt) : cA; const char* nB = has_next ? S.b_ptr(nxt) : cB;
        for (int t = 0; t < nt; t += 2) {
            const bool last = (t == nt - 2);
            const char* a1 = cA + (size_t)(t + 1) * kstep;
            const char* a2 = last ? nA : cA + (size_t)(t + 2) * kstep; const char* b2 = last ? nB : cB + (size_t)(t + 2) * kstep;
            const char* a3 = a2 + kstep; const char* b3 = b2 + kstep;
            PG8_LDB(B0, 0, 0); PG8_SCHED; PG8_LDA(At, 0, 0); PG8_STAGE(PG8_SA(1, 1), a1 + hstepA, voffA);
            PG8_WAIT_L(8); PG8_BAR; PG8_WAIT_L(0); PG8_MMA(0, 0, At, B0); PG8_BAR; PG8_SCHED;
            PG8_LDB(B1, 0, 1); PG8_STAGE(PG8_SB(0, 0), b2, voffB);
            PG8_BAR; PG8_WAIT_L(0); PG8_MMA(0, 1, At, B1); PG8_BAR;
            PG8_LDA(At, 0, 1); PG8_STAGE(PG8_SA(0, 0), a2, voffA);
            PG8_BAR; PG8_WAIT_L(0); PG8_MMA(1, 0, At, B0); PG8_BAR; PG8_SCHED;
            PG8_STAGE(PG8_SB(0, 1), b2 + hstepB, voffB);
            PG8_WAIT_V(6); PG8_BAR; PG8_MMA(1, 1, At, B1); PG8_BAR;
            PG8_LDB(B0, 1, 0); PG8_SCHED; PG8_LDA(At, 1, 0); PG8_STAGE(PG8_SA(0, 1), a2 + hstepA, voffA);
            PG8_WAIT_L(8); PG8_BAR; PG8_WAIT_L(0); PG8_MMA(0, 0, At, B0); PG8_BAR; PG8_SCHED;
            PG8_LDB(B1, 1, 1); PG8_STAGE(PG8_SB(1, 0), b3, voffB);
            PG8_BAR; PG8_WAIT_L(0); PG8_MMA(0, 1, At, B1); PG8_BAR;
            PG8_LDA(At, 1, 1); PG8_STAGE(PG8_SA(1, 0), a3, voffA);
            PG8_BAR; PG8_WAIT_L(0); PG8_MMA(1, 0, At, B0); PG8_BAR; PG8_SCHED;
            PG8_STAGE(PG8_SB(1, 1), b3 + hstepB, voffB);
            PG8_WAIT_V(6); PG8_BAR; PG8_MMA(1, 1, At, B1); PG8_BAR;
        }
        E(acc, cur, wr, wc, fr, fq);
        if (!has_next) break;
#pragma unroll
        for (int a = 0; a < 2; ++a)
#pragma unroll
            for (int b = 0; b < 2; ++b)
#pragma unroll
                for (int m = 0; m < 4; ++m)
#pragma unroll
                    for (int n = 0; n < 2; ++n) acc[a][b][m][n] = (f32x4){0.f, 0.f, 0.f, 0.f};
        cur = nxt; cA = nA; cB = nB; ++ui;
    }
    PG8_WAIT_V(0);
    if (wr == 0) PG8_BAR;
    PG8_BAR;
#undef PG8_SA
#undef PG8_SB
#undef PG8_STAGE
#undef PG8_LDA
#undef PG8_LDB
#undef PG8_MMA
#undef PG8_WAIT_V
#undef PG8_WAIT_L
#undef PG8_BAR
#undef PG8_SCHED
}
}
using pg8::f32x4; using pg8::u32x4; using pg8::Unit;

#define GEMM_LDS (pg8::STAGE_BYTES + 1024)

struct SchedProj : pg8::TileOrder {
  const char* A; const char* B;
  __device__ bool next(int i, Unit& u) const { u.z = 0; return tile(i, u.pm, u.pn); }
  __device__ const char* a_ptr(const Unit& u) const { return A + (size_t)u.pm * 256 * DM * 2; }
  __device__ const char* b_ptr(const Unit& u) const { return B + (size_t)u.pn * 256 * DM * 2; }
};
struct EpiProj {
  static constexpr bool PERM = true;
  bf16_t* O;
  __device__ __forceinline__ void operator()(const f32x4 (&acc)[2][2][4][2], const Unit& u, int wr, int wc, int fr, int fq) const {
    const int row0 = u.pm * 256 + wr * 64 + fr, col0 = u.pn * 256 + wc * 32 + 8 * fq;
    const bool gate = u.pn >= (C_GA / 256);
#pragma unroll
    for (int ai = 0; ai < 2; ++ai)
#pragma unroll
      for (int m = 0; m < 4; ++m) {
        bf16_t* rowp = O + (size_t)(row0 + ai * 128 + m * 16) * PW + col0;
#pragma unroll
        for (int bj = 0; bj < 2; ++bj) {
          f32x4 v0 = acc[ai][bj][m][0], v1 = acc[ai][bj][m][1];
          if (gate) {
#pragma unroll
            for (int j = 0; j < 4; ++j) { v0[j] = sigmoidf_(v0[j]); v1[j] = sigmoidf_(v1[j]); }
          }
          u32x4 w; w.x = pg8::cvt_pk_bf16(v0[0], v0[1]); w.y = pg8::cvt_pk_bf16(v0[2], v0[3]); w.z = pg8::cvt_pk_bf16(v1[0], v1[1]); w.w = pg8::cvt_pk_bf16(v1[2], v1[3]);
          *(u32x4*)(rowp + bj * 128) = w;
        }
      }
  }
};
__device__ void ph_proj(const Params& p, PG8_LAS unsigned char* lds, int nblk, int bid) {
  SchedProj S; S.init(T_TOK / 256, PW / 256, nblk, bid); S.A = (const char*)p.hbf; S.B = (const char*)p.w_in_t;
  EpiProj E{p.proj};
  pg8::gemm_phase(lds, DM, DM, DM, S, E);
}

struct SchedBr : pg8::TileOrder {
  const char* A; const char* Ba; const char* Bb;
  __device__ bool next(int i, Unit& u) const { u.z = i & 1; return tile(i >> 1, u.pm, u.pn); }
  __device__ const char* a_ptr(const Unit& u) const { return A + (size_t)u.pm * 256 * DM * 2 + u.z * 512 * 2; }
  __device__ const char* b_ptr(const Unit& u) const { return (u.z ? Bb : Ba) + (size_t)u.pn * 256 * 512 * 2; }
};
__device__ __forceinline__ void unpack8(const u32x4 w, float (&f)[8]) {
  f[0] = __uint_as_float(w.x << 16); f[1] = __uint_as_float(w.x & 0xffff0000u); f[2] = __uint_as_float(w.y << 16); f[3] = __uint_as_float(w.y & 0xffff0000u);
  f[4] = __uint_as_float(w.z << 16); f[5] = __uint_as_float(w.z & 0xffff0000u); f[6] = __uint_as_float(w.w << 16); f[7] = __uint_as_float(w.w & 0xffff0000u);
}
struct EpiBr {
  static constexpr bool PERM = true;
  const bf16_t* proj; bf16_t* O;
  __device__ __forceinline__ void operator()(const f32x4 (&acc)[2][2][4][2], const Unit& u, int wr, int wc, int fr, int fq) const {
    const int row0 = u.pm * 256 + wr * 64 + fr, col0 = u.pn * 256 + wc * 32 + 8 * fq;
    const int gcol = (u.z ? C_GB : C_GA) + col0;
#pragma unroll
    for (int ai = 0; ai < 2; ++ai)
#pragma unroll
      for (int m = 0; m < 4; ++m) {
        const size_t row = (size_t)(row0 + ai * 128 + m * 16);
        bf16_t* rowp = O + row * DM + col0;
        const bf16_t* gp = proj + row * PW + gcol;
#pragma unroll
        for (int bj = 0; bj < 2; ++bj) {
          float g[8]; unpack8(*(const u32x4*)(gp + bj * 128), g);
          f32x4 v0 = acc[ai][bj][m][0], v1 = acc[ai][bj][m][1];
          float r[8];
#pragma unroll
          for (int j = 0; j < 4; ++j) { r[j] = v0[j] * g[j]; r[4 + j] = v1[j] * g[4 + j]; }
          if (u.z) {
            float pv[8]; unpack8(*(const u32x4*)(rowp + bj * 128), pv);
#pragma unroll
            for (int j = 0; j < 8; ++j) r[j] += pv[j];
          }
          u32x4 w; w.x = pg8::cvt_pk_bf16(r[0], r[1]); w.y = pg8::cvt_pk_bf16(r[2], r[3]); w.z = pg8::cvt_pk_bf16(r[4], r[5]); w.w = pg8::cvt_pk_bf16(r[6], r[7]);
          *(u32x4*)(rowp + bj * 128) = w;
        }
      }
  }
};
__device__ void ph_br(const Params& p, PG8_LAS unsigned char* lds, int nblk, int bid) {
  SchedBr S; S.init(T_TOK / 256, DM / 256, nblk, bid); S.A = (const char*)p.oab; S.Ba = (const char*)p.wbra_t; S.Bb = (const char*)p.wbrb_t;
  EpiBr E{p.proj, p.merged};
  pg8::gemm_phase(lds, DM, 512, 512, S, E);
}

struct SchedMix : pg8::TileOrder {
  const char* A; const char* B;
  __device__ bool next(int i, Unit& u) const { u.z = 0; return tile(i, u.pm, u.pn); }
  __device__ const char* a_ptr(const Unit& u) const { return A + (size_t)u.pm * 256 * DM * 2; }
  __device__ const char* b_ptr(const Unit& u) const { return B + (size_t)u.pn * 256 * DM * 2; }
};
struct EpiMix {
  static constexpr bool PERM = true;
  bf16_t* O;
  __device__ __forceinline__ void operator()(const f32x4 (&acc)[2][2][4][2], const Unit& u, int wr, int wc, int fr, int fq) const {
    const int row0 = u.pm * 256 + wr * 64 + fr, col0 = u.pn * 256 + wc * 32 + 8 * fq;
#pragma unroll
    for (int ai = 0; ai < 2; ++ai)
#pragma unroll
      for (int m = 0; m < 4; ++m) {
        bf16_t* rowp = O + (size_t)(row0 + ai * 128 + m * 16) * DM + col0;
#pragma unroll
        for (int bj = 0; bj < 2; ++bj) {
          const f32x4 v0 = acc[ai][bj][m][0], v1 = acc[ai][bj][m][1];
          u32x4 w; w.x = pg8::cvt_pk_bf16(v0[0], v0[1]); w.y = pg8::cvt_pk_bf16(v0[2], v0[3]); w.z = pg8::cvt_pk_bf16(v1[0], v1[1]); w.w = pg8::cvt_pk_bf16(v1[2], v1[3]);
          *(u32x4*)(rowp + bj * 128) = w;
        }
      }
  }
};
__device__ void ph_mix(const Params& p, PG8_LAS unsigned char* lds, int nblk, int bid) {
  SchedMix S; S.init(T_TOK / 256, DM / 256, nblk, bid); S.A = (const char*)p.merged; S.B = (const char*)p.wo_t;
  EpiMix E{p.mixer};
  pg8::gemm_phase(lds, DM, DM, DM, S, E);
}

struct SchedMoe {
  const PG8_LAS int* tb; int NT; int G, c; int nwg;
  const char* A; const char* B; size_t bexp;
  __device__ bool next(int i, Unit& u) const {
    const long L = (long)i * G + c; if (L >= nwg) return false;
    int wgid = (int)L; { const int q = nwg / 8, r = nwg % 8, xcd = wgid % 8, off = wgid / 8; wgid = (xcd < r ? xcd * (q + 1) : r * (q + 1) + (xcd - r) * q) + off; }
    int e = 0;
#pragma unroll 1
    for (int k = 1; k < NE; ++k) if (wgid >= tb[k]) e = k;
    const int q = wgid - tb[e]; const int tiles = tb[33 + e + 1] - tb[33 + e];
    u.pm = tb[33 + e] + q % tiles; u.pn = q / tiles; u.z = e; return true;
  }
  __device__ const char* a_ptr(const Unit& u) const { return A + (size_t)u.pm * 256 * DM * 2; }
  __device__ const char* b_ptr(const Unit& u) const { return B + (size_t)u.z * bexp + (size_t)u.pn * 256 * DM * 2; }
};
__device__ __forceinline__ void moe_table(const Params& p, PG8_LAS int* tb, int NT) {
  if (threadIdx.x == 0) {
    int ub = 0, tbp = 0;
    for (int e = 0; e < NE; ++e) { tb[e] = ub; tb[33 + e] = tbp; const int t = (p.cnt[e] + 255) >> 8; ub += t * NT; tbp += t; }
    tb[NE] = ub; tb[33 + NE] = tbp;
  }
  __syncthreads();
}
struct EpiMoe1 {
  static constexpr bool PERM = true;
  const float* b_gu; bf16_t* act;
  __device__ __forceinline__ void operator()(const f32x4 (&acc)[2][2][4][2], const Unit& u, int wr, int wc, int fr, int fq) const {
    const int row0 = u.pm * 256 + wr * 64 + fr, jc = u.pn * 128 + wc * 32 + 8 * fq;
    const float* bg = b_gu + (size_t)u.z * 2048 + jc;
    float bgv[8], buv[8];
#pragma unroll
    for (int j = 0; j < 8; ++j) { bgv[j] = bg[j]; buv[j] = bg[1024 + j]; }
#pragma unroll
    for (int ai = 0; ai < 2; ++ai)
#pragma unroll
      for (int m = 0; m < 4; ++m) {
        bf16_t* rowp = act + (size_t)(row0 + ai * 128 + m * 16) * DM + jc;
        float r[8];
#pragma unroll
        for (int n = 0; n < 2; ++n)
#pragma unroll
          for (int j = 0; j < 4; ++j) {
            float g = acc[ai][0][m][n][j] + bgv[n * 4 + j], up = acc[ai][1][m][n][j] + buv[n * 4 + j];
            g = fminf(g, 7.f); up = fminf(fmaxf(up, -7.f), 7.f);
            r[n * 4 + j] = (up + 1.f) * g * sigmoidf_(1.702f * g);
          }
        u32x4 w; w.x = pg8::cvt_pk_bf16(r[0], r[1]); w.y = pg8::cvt_pk_bf16(r[2], r[3]); w.z = pg8::cvt_pk_bf16(r[4], r[5]); w.w = pg8::cvt_pk_bf16(r[6], r[7]);
        *(u32x4*)rowp = w;
      }
  }
};
__device__ void ph_moe1(const Params& p, PG8_LAS unsigned char* lds, int nblk, int bid) {
  PG8_LAS int* tb = (PG8_LAS int*)(lds + pg8::STAGE_BYTES);
  moe_table(p, tb, 8);
  SchedMoe S; S.tb = tb; S.NT = 8; S.G = nblk; S.c = bid; S.nwg = tb[NE]; S.A = (const char*)p.xs; S.B = (const char*)p.wgu_t; S.bexp = (size_t)2048 * DM * 2;
  EpiMoe1 E{p.b_gu, p.act};
  pg8::gemm_phase(lds, DM, DM, DM, S, E);
}
struct EpiMoe2 {
  static constexpr bool PERM = true;
  const float* b_down; const int* rowmap; bf16_t* yslot;
  __device__ __forceinline__ void operator()(const f32x4 (&acc)[2][2][4][2], const Unit& u, int wr, int wc, int fr, int fq) const {
    const int row0 = u.pm * 256 + wr * 64 + fr, col0 = u.pn * 256 + wc * 32 + 8 * fq;
    const float* bd = b_down + (size_t)u.z * 1024 + col0;
    float bv[2][8];
#pragma unroll
    for (int bj = 0; bj < 2; ++bj)
#pragma unroll
      for (int j = 0; j < 8; ++j) bv[bj][j] = bd[bj * 128 + j];
#pragma unroll
    for (int ai = 0; ai < 2; ++ai)
#pragma unroll
      for (int m = 0; m < 4; ++m) {
        const int a = rowmap[row0 + ai * 128 + m * 16];
        if (a >= 0) {
          bf16_t* rowp = yslot + (size_t)a * DM + col0;
#pragma unroll
          for (int bj = 0; bj < 2; ++bj) {
            const f32x4 v0 = acc[ai][bj][m][0], v1 = acc[ai][bj][m][1];
            u32x4 w; w.x = pg8::cvt_pk_bf16(v0[0] + bv[bj][0], v0[1] + bv[bj][1]); w.y = pg8::cvt_pk_bf16(v0[2] + bv[bj][2], v0[3] + bv[bj][3]);
            w.z = pg8::cvt_pk_bf16(v1[0] + bv[bj][4], v1[1] + bv[bj][5]); w.w = pg8::cvt_pk_bf16(v1[2] + bv[bj][6], v1[3] + bv[bj][7]);
            *(u32x4*)(rowp + bj * 128) = w;
          }
        }
      }
  }
};
__device__ void ph_moe2(const Params& p, PG8_LAS unsigned char* lds, int nblk, int bid) {
  PG8_LAS int* tb = (PG8_LAS int*)(lds + pg8::STAGE_BYTES);
  moe_table(p, tb, 4);
  SchedMoe S; S.tb = tb; S.NT = 4; S.G = nblk; S.c = bid; S.nwg = tb[NE]; S.A = (const char*)p.act; S.B = (const char*)p.wd_t; S.bexp = (size_t)1024 * DM * 2;
  EpiMoe2 E{p.b_down, p.rowmap, p.yslot};
  pg8::gemm_phase(lds, DM, DM, DM, S, E);
}

template <int PH>
__global__ __launch_bounds__(512) void k_gemm(Params p) {
  extern __shared__ __attribute__((aligned(16))) unsigned char shm[];
  PG8_LAS unsigned char* lds = (PG8_LAS unsigned char*)shm;
  if (PH == 0) ph_proj(p, lds, gridDim.x, blockIdx.x);
  if (PH == 1) ph_br(p, lds, gridDim.x, blockIdx.x);
  if (PH == 2) ph_mix(p, lds, gridDim.x, blockIdx.x);
  if (PH == 3) ph_moe1(p, lds, gridDim.x, blockIdx.x);
  if (PH == 4) ph_moe2(p, lds, gridDim.x, blockIdx.x);
}

__global__ __launch_bounds__(128) void k_dn_prep(Params p) {
  int t = blockIdx.x >> 2, h = blockIdx.x & 3;
  int b = t / SEQ, s = t % SEQ;
  int d = threadIdx.x;
  __shared__ float red[2][2];
  float val[3];
#pragma unroll
  for (int part = 0; part < 3; ++part) {
    int ch = part * 512 + h * 128 + d;
    float a = 0.f;
#pragma unroll
    for (int i = 0; i < 4; ++i) {
      int ss = s - 3 + i;
      if (ss >= 0) a += p.conv_w[i * 1536 + ch] * bf2f(p.proj[(size_t)(b * SEQ + ss) * PW + ch]);
    }
    val[part] = siluf_(a);
  }
  float sq = wave_sum(val[0] * val[0]), sk = wave_sum(val[1] * val[1]);
  int wid = d >> 6;
  if ((d & 63) == 0) { red[0][wid] = sq; red[1][wid] = sk; }
  __syncthreads();
  sq = red[0][0] + red[0][1]; sk = red[1][0] + red[1][1];
  size_t o = (((size_t)b * 4 + h) * SEQ + s) * 128 + d;
  p.nq[o] = val[0] * rsqrtf(sq + 1e-6f);
  p.nk[o] = val[1] * rsqrtf(sk + 1e-6f);
  p.nv[o] = val[2];
  if (d == 0) {
    float bb = p.ba[(size_t)t * 8 + h], aa = p.ba[(size_t)t * 8 + 4 + h];
    float xx = aa + p.dt_bias[h];
    float sp = xx > 20.f ? xx : log1pf(__expf(xx));
    size_t o2 = ((size_t)b * 4 + h) * SEQ + s;
    p.nbeta[o2] = sigmoidf_(bb);
    p.ng[o2] = -__expf(p.a_log[h]) * sp;
  }
}
__global__ __launch_bounds__(128) void k_dn_scan(Params p) {
  int bh = blockIdx.x;
  int e = threadIdx.x;
  __shared__ float sk[2][128], sq[2][128];
  float S[128];
#pragma unroll
  for (int d = 0; d < 128; ++d) S[d] = 0.f;
  const float* q = p.nq + (size_t)bh * SEQ * 128;
  const float* k = p.nk + (size_t)bh * SEQ * 128;
  const float* v = p.nv + (size_t)bh * SEQ * 128;
  float* o = p.no + (size_t)bh * SEQ * 128;
  const float scale = 0.08838834764831845f;
  for (int s = 0; s < SEQ; ++s) {
    int buf = s & 1;
    sk[buf][e] = k[(size_t)s * 128 + e];
    sq[buf][e] = q[(size_t)s * 128 + e];
    float vt = v[(size_t)s * 128 + e];
    float beta = p.nbeta[(size_t)bh * SEQ + s];
    float dec = __expf(p.ng[(size_t)bh * SEQ + s]);
    __syncthreads();
    float ks = 0.f;
#pragma unroll
    for (int d = 0; d < 128; ++d) ks += sk[buf][d] * S[d];
    ks *= dec;
    float vn = beta * (vt - ks);
    float ot = 0.f;
#pragma unroll
    for (int d = 0; d < 128; ++d) {
      S[d] = dec * S[d] + sk[buf][d] * vn;
      ot += sq[buf][d] * S[d];
    }
    o[(size_t)s * 128 + e] = ot * scale;
  }
}
__global__ __launch_bounds__(128) void k_dn_post(Params p) {
  int t = blockIdx.x >> 2, h = blockIdx.x & 3;
  int b = t / SEQ, s = t % SEQ;
  int d = threadIdx.x;
  __shared__ float red[2];
  float ov = p.no[(((size_t)b * 4 + h) * SEQ + s) * 128 + d];
  float ss = wave_sum(ov * ov);
  if ((d & 63) == 0) red[d >> 6] = ss;
  __syncthreads();
  ss = red[0] + red[1];
  float y = ov * rsqrtf(ss * (1.f / 128) + 1e-6f) * p.g_dn_out[d];
  float z = bf2f(p.proj[(size_t)t * PW + C_Z + h * 128 + d]);
  p.oab[(size_t)t * DM + h * 128 + d] = f2bf(y * siluf_(z));
}

__global__ __launch_bounds__(128) void k_rope(Params p) {
  int t = blockIdx.x >> 2, h = blockIdx.x & 3;
  int b = t / SEQ, s = t % SEQ;
  int d = threadIdx.x;
  const bf16_t* qr = p.proj + (size_t)t * PW + C_MQ + h * 128;
  const bf16_t* kr = p.proj + (size_t)t * PW + C_MK + h * 128;
  float qv = bf2f(qr[d]), kv = bf2f(kr[d]);
  if (d < 32) {
    int i = d & 15;
    float inv = exp2f(-(float)i * (1.f / 16.f) * 18.931568569324174f);
    float ang = (float)s * inv;
    float cs = cosf(ang), sn = sinf(ang);
    float qo = bf2f(qr[d ^ 16]), ko = bf2f(kr[d ^ 16]);
    if (d < 16) { qv = qv * cs - qo * sn; kv = kv * cs - ko * sn; }
    else        { qv = qv * cs + qo * sn; kv = kv * cs + ko * sn; }
  }
  size_t o = (((size_t)b * 4 + h) * SEQ + s) * 128 + d;
  p.qb[o] = f2bf(qv);
  p.kb[o] = f2bf(kv);
}
__global__ __launch_bounds__(128) void k_kmean(Params p) {
  int bhj = blockIdx.x;
  int d = threadIdx.x;
  const bf16_t* kr = p.kb + (size_t)bhj * 256 * 128;
  float a = 0.f;
  for (int i = 0; i < 256; ++i) a += bf2f(kr[(size_t)i * 128 + d]);
  p.kmean[(size_t)bhj * 128 + d] = a * (1.f / 256.f);
}
__global__ __launch_bounds__(256) void k_moba(Params p) {
  __shared__ float sqv[4][128];
  __shared__ float sp[4][1024];
  int wid = threadIdx.x >> 6, lane = threadIdx.x & 63;
  int gq = blockIdx.x * 4 + wid;
  int bh = gq / SEQ, s = gq % SEQ;
  int b = bh >> 2, h = bh & 3;
  int qblk = s >> 8;
  const bf16_t* qr = p.qb + (size_t)gq * 128;
  sqv[wid][lane] = bf2f(qr[lane]);
  sqv[wid][lane + 64] = bf2f(qr[lane + 64]);
  __syncthreads();
  float sc = -INFINITY;
  if (lane < qblk) {
    const float* km = p.kmean + ((size_t)bh * 16 + lane) * 128;
    float a = 0.f;
    for (int d = 0; d < 128; ++d) a += sqv[wid][d] * km[d];
    sc = a;
  }
  int sel[4];
#pragma unroll
  for (int r = 0; r < 3; ++r) {
    float m = wave_max(sc);
    unsigned long long bal = __ballot(sc == m);
    int idx = __ffsll((long long)bal) - 1;
    sel[r] = (m == -INFINITY) ? -1 : idx;
    if (lane == idx) sc = -INFINITY;
  }
  sel[3] = qblk;
  const float scale = 0.08838834764831845f;
  const bf16_t* kbase = p.kb + (size_t)bh * SEQ * 128;
  float lmax = -INFINITY;
#pragma unroll
  for (int j = 0; j < 4; ++j) {
    int blk = sel[j];
    if (blk < 0) continue;
    for (int i = 0; i < 4; ++i) {
      int kk = i * 64 + lane;
      int kpos = blk * 256 + kk;
      float lg = -INFINITY;
      if (kpos <= s) {
        const bf16_t* kr = kbase + (size_t)kpos * 128;
        float a = 0.f;
        for (int d8 = 0; d8 < 16; ++d8) {
          uint4 u = *(const uint4*)(kr + d8 * 8);
          unsigned w[4] = {u.x, u.y, u.z, u.w};
#pragma unroll
          for (int e = 0; e < 4; ++e) {
            a += sqv[wid][d8 * 8 + 2 * e] * __uint_as_float(w[e] << 16);
            a += sqv[wid][d8 * 8 + 2 * e + 1] * __uint_as_float(w[e] & 0xffff0000u);
          }
        }
        lg = a * scale;
      }
      sp[wid][j * 256 + kk] = lg;
      lmax = fmaxf(lmax, lg);
    }
  }
  lmax = wave_max(lmax);
  float lsum = 0.f;
#pragma unroll
  for (int j = 0; j < 4; ++j) {
    if (sel[j] < 0) continue;
    for (int i = 0; i < 4; ++i) {
      int idx = j * 256 + i * 64 + lane;
      float e = __expf(sp[wid][idx] - lmax);
      sp[wid][idx] = e;
      lsum += e;
    }
  }
  lsum = wave_sum(lsum);
  __syncthreads();
  float o0 = 0.f, o1 = 0.f;
#pragma unroll
  for (int j = 0; j < 4; ++j) {
    int blk = sel[j];
    if (blk < 0) continue;
    const bf16_t* vb = p.proj + (size_t)(b * SEQ + blk * 256) * PW + C_MV + h * 128;
    int nk = (blk == qblk) ? (s - blk * 256 + 1) : 256;
    for (int kk = 0; kk < nk; ++kk) {
      float pr = sp[wid][j * 256 + kk];
      o0 += pr * bf2f(vb[(size_t)kk * PW + lane]);
      o1 += pr * bf2f(vb[(size_t)kk * PW + lane + 64]);
    }
  }
  float inv = 1.f / lsum;
  int t = b * SEQ + s;
  p.oab[(size_t)t * DM + 512 + h * 128 + lane] = f2bf(o0 * inv);
  p.oab[(size_t)t * DM + 512 + h * 128 + lane + 64] = f2bf(o1 * inv);
}

__global__ __launch_bounds__(256) void k_post_mix(Params p) {
  __shared__ float sh[4][1024];
  int wid = threadIdx.x >> 6, lane = threadIdx.x & 63;
  int t = blockIdx.x * 4 + wid;
  int b = t / SEQ;
  const float* md = p.mod + b * 6144;
  float mv[16];
  float ss = 0.f;
#pragma unroll
  for (int i = 0; i < 16; ++i) {
    int k = i * 64 + lane;
    mv[i] = bf2f(p.mixer[(size_t)t * DM + k]);
    ss += mv[i] * mv[i];
  }
  ss = wave_sum(ss);
  float rstd = rsqrtf(ss * (1.f / DM) + 1e-6f);
  float x1[16];
  float s2 = 0.f;
#pragma unroll
  for (int i = 0; i < 16; ++i) {
    int k = i * 64 + lane;
    x1[i] = p.x[(size_t)t * DM + k] + md[2048 + k] * (mv[i] * rstd * p.g_post_mix[k]);
    p.out[(size_t)t * DM + k] = x1[i];
    s2 += x1[i] * x1[i];
  }
  s2 = wave_sum(s2);
  float rstd2 = rsqrtf(s2 * (1.f / DM) + 1e-6f);
#pragma unroll
  for (int i = 0; i < 16; ++i) {
    int k = i * 64 + lane;
    float hv = x1[i] * rstd2 * p.g_pre_ffn[k] * (1.f + md[4096 + k]) + md[3072 + k];
    p.h2[(size_t)t * DM + k] = f2bf(hv);
    sh[wid][k] = hv;
  }
  __syncthreads();
  int e = lane & 31, half = lane >> 5;
  float a = 0.f;
  for (int k = half * 512; k < half * 512 + 512; ++k) a += sh[wid][k] * p.w_router[(size_t)k * 32 + e];
  a += __shfl_xor(a, 32, 64);
  float lg = a + p.b_router[e];
  if (lane >= 32) lg = -INFINITY;
  float tv[4]; int ti[4];
#pragma unroll
  for (int r = 0; r < 4; ++r) {
    float m = wave_max(lg);
    unsigned long long bal = __ballot(lg == m);
    int idx = __ffsll((long long)bal) - 1;
    tv[r] = m; ti[r] = idx;
    if (lane == idx) lg = -INFINITY;
  }
  float e0 = 1.f, e1 = __expf(tv[1] - tv[0]), e2 = __expf(tv[2] - tv[0]), e3 = __expf(tv[3] - tv[0]);
  float inv = 1.f / (e0 + e1 + e2 + e3);
  if (lane < 4) {
    int ee = lane == 0 ? ti[0] : lane == 1 ? ti[1] : lane == 2 ? ti[2] : ti[3];
    float ww = (lane == 0 ? e0 : lane == 1 ? e1 : lane == 2 ? e2 : e3) * inv;
    int pos = atomicAdd(&p.cnt[ee], 1);
    p.elist[ee * T_TOK + pos] = t * 4 + lane;
    p.aw[t * 4 + lane] = ww;
  }
}

__global__ __launch_bounds__(256) void k_gather(Params p) {
  int wid = threadIdx.x >> 6, lane = threadIdx.x & 63;
  int r = blockIdx.x * 4 + wid;
  int off = 0, e = -1, i = 0, ce = 0;
  for (int k = 0; k < NE; ++k) {
    int c = p.cnt[k]; int padc = ((c + 255) >> 8) << 8;
    if (e < 0 && r < off + padc) { e = k; i = r - off; ce = c; }
    off += padc;
  }
  if (e < 0) return;
  int a = (i < ce) ? p.elist[e * T_TOK + i] : -1;
  if (lane == 0) p.rowmap[r] = a;
  uint4 v0 = make_uint4(0, 0, 0, 0), v1 = v0;
  if (a >= 0) {
    const uint4* src = (const uint4*)(p.h2 + (size_t)(a >> 2) * DM);
    v0 = src[lane]; v1 = src[64 + lane];
  }
  uint4* dst = (uint4*)(p.xs + (size_t)r * DM);
  dst[lane] = v0; dst[64 + lane] = v1;
}
__global__ __launch_bounds__(256) void k_final(Params p) {
  int wid = threadIdx.x >> 6, lane = threadIdx.x & 63;
  int t = blockIdx.x * 4 + wid;
  int b = t / SEQ;
  const float* md = p.mod + b * 6144;
  float w0 = p.aw[t * 4], w1 = p.aw[t * 4 + 1], w2 = p.aw[t * 4 + 2], w3 = p.aw[t * 4 + 3];
  float mv[16];
  float ss = 0.f;
#pragma unroll
  for (int i = 0; i < 16; ++i) {
    int k = i * 64 + lane;
    const bf16_t* y = p.yslot + (size_t)t * 4 * DM + k;
    mv[i] = w0 * bf2f(y[0]) + w1 * bf2f(y[DM]) + w2 * bf2f(y[2 * DM]) + w3 * bf2f(y[3 * DM]);
    ss += mv[i] * mv[i];
  }
  ss = wave_sum(ss);
  float rstd = rsqrtf(ss * (1.f / DM) + 1e-6f);
#pragma unroll
  for (int i = 0; i < 16; ++i) {
    int k = i * 64 + lane;
    p.out[(size_t)t * DM + k] = p.out[(size_t)t * DM + k] + md[5120 + k] * (mv[i] * rstd * p.g_post_ffn[k]);
  }
}

static inline size_t al(size_t x) { return (x + 255) & ~(size_t)255; }

extern "C" void kernel_launch(void* const* d_in, const int* in_sizes, int n_in, void* d_out, int out_size, void* d_ws,
                              size_t ws_size, hipStream_t stream) {
  Params p{};
  p.x = (const float*)d_in[0]; p.c = (const float*)d_in[1]; p.w_ada = (const float*)d_in[2]; p.b_ada = (const float*)d_in[3];
  p.g_pre_mix = (const float*)d_in[4]; p.g_post_mix = (const float*)d_in[5]; p.g_pre_ffn = (const float*)d_in[6];
  p.g_post_ffn = (const float*)d_in[7]; p.w_in = (const float*)d_in[8]; p.conv_w = (const float*)d_in[9];
  p.a_log = (const float*)d_in[10]; p.dt_bias = (const float*)d_in[11]; p.g_dn_out = (const float*)d_in[12];
  p.w_br_a = (const float*)d_in[13]; p.w_br_b = (const float*)d_in[14]; p.w_o = (const float*)d_in[15];
  p.w_router = (const float*)d_in[16]; p.b_router = (const float*)d_in[17]; p.w_gu = (const float*)d_in[18];
  p.b_gu = (const float*)d_in[19]; p.w_down = (const float*)d_in[20]; p.b_down = (const float*)d_in[21];
  p.out = (float*)d_out;
  char* w = (char*)d_ws;
  size_t o = 0;
  auto take = [&](size_t bytes) { char* r = w + o; o += al(bytes); return r; };
  p.mod = (float*)take(4 * 6144 * 4);
  p.cnt = (int*)take(256);
  p.ba = (float*)take((size_t)T_TOK * 8 * 4);
  p.hbf = (bf16_t*)take((size_t)T_TOK * DM * 2);
  p.proj = (bf16_t*)take((size_t)T_TOK * PW * 2);
  p.w_in_t = (bf16_t*)take((size_t)PW * DM * 2);
  p.wgu_t = (bf16_t*)take((size_t)NE * 2048 * DM * 2);
  p.wd_t = (bf16_t*)take((size_t)NE * 1024 * DM * 2);
  p.wbra_t = (bf16_t*)take((size_t)1024 * 512 * 2);
  p.wbrb_t = (bf16_t*)take((size_t)1024 * 512 * 2);
  p.wo_t = (bf16_t*)take((size_t)1024 * 1024 * 2);
  p.qb = (bf16_t*)take((size_t)T_TOK * 512 * 2);
  p.kb = (bf16_t*)take((size_t)T_TOK * 512 * 2);
  p.kmean = (float*)take((size_t)16 * 16 * 128 * 4);
  p.oab = (bf16_t*)take((size_t)T_TOK * DM * 2);
  p.merged = (bf16_t*)take((size_t)T_TOK * DM * 2);
  p.mixer = (bf16_t*)take((size_t)T_TOK * DM * 2);
  p.h2 = (bf16_t*)take((size_t)T_TOK * DM * 2);
  p.elist = (int*)take((size_t)NE * T_TOK * 4);
  p.aw = (float*)take((size_t)T_TOK * 4 * 4);
  p.rowmap = (int*)take((size_t)73728 * 4);
  p.xs = p.proj;
  char* big = take((size_t)73728 * DM * 2 + (size_t)65536 * DM * 2);
  p.act = (bf16_t*)big;
  p.yslot = (bf16_t*)(big + (size_t)73728 * DM * 2);
  {
    char* s = big; size_t so = 0;
    auto t2 = [&](size_t bytes) { char* r = s + so; so += al(bytes); return r; };
    p.nq = (float*)t2((size_t)T_TOK * 512 * 4);
    p.nk = (float*)t2((size_t)T_TOK * 512 * 4);
    p.nv = (float*)t2((size_t)T_TOK * 512 * 4);
    p.no = (float*)t2((size_t)T_TOK * 512 * 4);
    p.ntmp = (float*)t2((size_t)T_TOK * DM * 4);
    p.nbeta = (float*)t2((size_t)T_TOK * 4 * 4);
    p.ng = (float*)t2((size_t)T_TOK * 4 * 4);
  }

  static bool attr_done = false;
  if (!attr_done) {
    (void)hipFuncSetAttribute((const void*)k_gemm<0>, hipFuncAttributeMaxDynamicSharedMemorySize, GEMM_LDS);
    (void)hipFuncSetAttribute((const void*)k_gemm<1>, hipFuncAttributeMaxDynamicSharedMemorySize, GEMM_LDS);
    (void)hipFuncSetAttribute((const void*)k_gemm<2>, hipFuncAttributeMaxDynamicSharedMemorySize, GEMM_LDS);
    (void)hipFuncSetAttribute((const void*)k_gemm<3>, hipFuncAttributeMaxDynamicSharedMemorySize, GEMM_LDS);
    (void)hipFuncSetAttribute((const void*)k_gemm<4>, hipFuncAttributeMaxDynamicSharedMemorySize, GEMM_LDS);
    attr_done = true;
  }
  (void)hipMemsetAsync(p.cnt, 0, 256, stream);
  k_mod<<<24, 256, 0, stream>>>(p);
  k_wt<<<dim3((INW + 31) / 32, 32, 1), 256, 0, stream>>>(p.w_in, p.w_in_t, 1024, INW, 1, 0, 0);
  k_wt<<<dim3(64, 32, NE), 256, 0, stream>>>(p.w_gu, p.wgu_t, 1024, 2048, 2, (size_t)1024 * 2048, (size_t)2048 * 1024);
  k_wt<<<dim3(32, 32, NE), 256, 0, stream>>>(p.w_down, p.wd_t, 1024, 1024, 0, (size_t)1024 * 1024, (size_t)1024 * 1024);
  k_wt<<<dim3(32, 16, 1), 256, 0, stream>>>(p.w_br_a, p.wbra_t, 512, 1024, 0, 0, 0);
  k_wt<<<dim3(32, 16, 1), 256, 0, stream>>>(p.w_br_b, p.wbrb_t, 512, 1024, 0, 0, 0);
  k_wt<<<dim3(32, 32, 1), 256, 0, stream>>>(p.w_o, p.wo_t, 1024, 1024, 0, 0, 0);
  k_h<<<T_TOK / 4, 256, 0, stream>>>(p);
  k_gemm<0><<<256, 512, GEMM_LDS, stream>>>(p);
  k_dn_prep<<<T_TOK * 4, 128, 0, stream>>>(p);
  k_dn_scan<<<16, 128, 0, stream>>>(p);
  k_dn_post<<<T_TOK * 4, 128, 0, stream>>>(p);
  k_rope<<<T_TOK * 4, 128, 0, stream>>>(p);
  k_kmean<<<256, 128, 0, stream>>>(p);
  k_moba<<<T_TOK * 4 / 4, 256, 0, stream>>>(p);
  k_gemm<1><<<256, 512, GEMM_LDS, stream>>>(p);
  k_gemm<2><<<256, 512, GEMM_LDS, stream>>>(p);
  k_post_mix<<<T_TOK / 4, 256, 0, stream>>>(p);
  k_gather<<<73728 / 4, 256, 0, stream>>>(p);
  k_gemm<3><<<256, 512, GEMM_LDS, stream>>>(p);
  k_gemm<4><<<256, 512, GEMM_LDS, stream>>>(p);
  k_final<<<T_TOK / 4, 256, 0, stream>>>(p);
}
```

```cpp
#include <hip/hip_runtime.h>
#include <stdint.h>

typedef unsigned short bf16_t;

#define T_TOK 16384
#define SEQ 4096
#define NB 4
#define DM 1024
#define INW 5640
#define PW 5632
#define C_QA 0
#define C_KA 512
#define C_VA 1024
#define C_Z 1536
#define C_MQ 2048
#define C_MK 2560
#define C_MV 3072
#define C_GA 3584
#define C_GB 4608
#define NE 32

__device__ __forceinline__ bf16_t f2bf(float f) {
  unsigned u = __float_as_uint(f);
  u += 0x7fffu + ((u >> 16) & 1u);
  return (bf16_t)(u >> 16);
}
__device__ __forceinline__ float bf2f(bf16_t h) { return __uint_as_float(((unsigned)h) << 16); }
__device__ __forceinline__ float sigmoidf_(float x) { return 1.f / (1.f + __expf(-x)); }
__device__ __forceinline__ float siluf_(float x) { return x / (1.f + __expf(-x)); }
__device__ __forceinline__ float wave_sum(float v) {
#pragma unroll
  for (int o = 32; o > 0; o >>= 1) v += __shfl_xor(v, o, 64);
  return v;
}
__device__ __forceinline__ float wave_max(float v) {
#pragma unroll
  for (int o = 32; o > 0; o >>= 1) v = fmaxf(v, __shfl_xor(v, o, 64));
  return v;
}

struct Params {
  const float *x, *c, *w_ada, *b_ada, *g_pre_mix, *g_post_mix, *g_pre_ffn, *g_post_ffn, *w_in, *conv_w,
      *a_log, *dt_bias, *g_dn_out, *w_br_a, *w_br_b, *w_o, *w_router, *b_router, *w_gu, *b_gu, *w_down, *b_down;
  float* out;
  float* mod;
  int* cnt;
  float* ba;
  bf16_t* hbf;
  bf16_t* proj;
  bf16_t* w_in_t;
  bf16_t* wgu_t;
  bf16_t* wd_t;
  bf16_t* wbra_t;
  bf16_t* wbrb_t;
  bf16_t* wo_t;
  bf16_t* qb;
  bf16_t* kb;
  float* kmean;
  bf16_t* oab;
  bf16_t* merged;
  bf16_t* mixer;
  bf16_t* h2;
  int* elist;
  float* aw;
  bf16_t* act;
  bf16_t* xs;
  int* rowmap;
  bf16_t* yslot;
  unsigned char* dnA; float* dnU; float* dnG;
  bf16_t* dn_out; int dn_out_ld;
  bf16_t* oab2; float* dbg;
  float* nq; float* nk; float* nv;
  float* nbeta; float* ng;
  float* no;
  float* ntmp;
};

__global__ __launch_bounds__(256) void k_mod(Params p) {
  __shared__ float sc[4][1024];
  for (int i = threadIdx.x; i < 4096; i += 256) sc[i >> 10][i & 1023] = siluf_(p.c[i]);
  __syncthreads();
  int j = blockIdx.x * 256 + threadIdx.x;
  float a0 = 0, a1 = 0, a2 = 0, a3 = 0;
  for (int k = 0; k < 1024; ++k) {
    float w = p.w_ada[(size_t)k * 6144 + j];
    a0 += sc[0][k] * w; a1 += sc[1][k] * w; a2 += sc[2][k] * w; a3 += sc[3][k] * w;
  }
  float b = p.b_ada[j];
  p.mod[0 * 6144 + j] = a0 + b; p.mod[1 * 6144 + j] = a1 + b;
  p.mod[2 * 6144 + j] = a2 + b; p.mod[3 * 6144 + j] = a3 + b;
}

__device__ __forceinline__ int map_col(int n, int mode) {
  if (mode == 0) return n;
  if (mode == 1) return n < 2048 ? n : (n < 2056 ? -1 : n - 8);
  if (n < 1024) return (n >> 7) * 256 + (n & 127);
  int j = n - 1024;
  return (j >> 7) * 256 + 128 + (j & 127);
}
__global__ __launch_bounds__(256) void k_wt(const float* __restrict__ src, bf16_t* __restrict__ dst, int K, int N, int mode,
                                            size_t src_estride, size_t dst_estride) {
  __shared__ float tile[32][33];
  src += (size_t)blockIdx.z * src_estride;
  dst += (size_t)blockIdx.z * dst_estride;
  int n0 = blockIdx.x * 32, k0 = blockIdx.y * 32;
  int tx = threadIdx.x & 31, ty = threadIdx.x >> 5;
  for (int r = ty; r < 32; r += 8) {
    int n = n0 + tx;
    tile[r][tx] = (n < N) ? src[(size_t)(k0 + r) * N + n] : 0.f;
  }
  __syncthreads();
  for (int r = ty; r < 32; r += 8) {
    int n = n0 + r;
    if (n < N) {
      int d = map_col(n, mode);
      if (d >= 0) dst[(size_t)d * K + k0 + tx] = f2bf(tile[tx][r]);
    }
  }
}

__global__ __launch_bounds__(256) void k_h(Params p) {
  int wid = threadIdx.x >> 6, lane = threadIdx.x & 63;
  int t = blockIdx.x * 4 + wid;
  int b = t / SEQ;
  const float* xr = p.x + (size_t)t * DM;
  float v[16];
  float ss = 0.f;
#pragma unroll
  for (int i = 0; i < 4; ++i) {
    float4 q = *(const float4*)(xr + i * 256 + lane * 4);
    v[i * 4 + 0] = q.x; v[i * 4 + 1] = q.y; v[i * 4 + 2] = q.z; v[i * 4 + 3] = q.w;
    ss += q.x * q.x + q.y * q.y + q.z * q.z + q.w * q.w;
  }
  ss = wave_sum(ss);
  float rstd = rsqrtf(ss * (1.f / DM) + 1e-6f);
  const float* shift = p.mod + b * 6144;
  const float* scale = p.mod + b * 6144 + 1024;
  float acc[8] = {0, 0, 0, 0, 0, 0, 0, 0};
#pragma unroll
  for (int i = 0; i < 4; ++i) {
    bf16_t o[4];
#pragma unroll
    for (int j = 0; j < 4; ++j) {
      int k = i * 256 + lane * 4 + j;
      float h = v[i * 4 + j] * rstd * p.g_pre_mix[k] * (1.f + scale[k]) + shift[k];
      o[j] = f2bf(h);
      const float* wr = p.w_in + (size_t)k * INW + 2048;
#pragma unroll
      for (int e = 0; e < 8; ++e) acc[e] += h * wr[e];
    }
    uint2 pk;
    pk.x = (unsigned)o[0] | ((unsigned)o[1] << 16);
    pk.y = (unsigned)o[2] | ((unsigned)o[3] << 16);
    *(uint2*)(p.hbf + (size_t)t * DM + i * 256 + lane * 4) = pk;
  }
#pragma unroll
  for (int e = 0; e < 8; ++e) acc[e] = wave_sum(acc[e]);
  if (lane == 0) {
#pragma unroll
    for (int e = 0; e < 8; ++e) p.ba[(size_t)t * 8 + e] = acc[e];
  }
}

namespace pg8 {
#define PG8_LAS __attribute__((address_space(3)))
typedef short bf16x8 __attribute__((ext_vector_type(8)));
typedef float f32x4 __attribute__((ext_vector_type(4)));
typedef unsigned u32x4 __attribute__((ext_vector_type(4)));
constexpr int BM = 256, BK = 64, HALF = 128, HTB = HALF * BK * 2, STAGE_BYTES = 8 * HTB, NXCD = 8, WGM = 8;

__host__ __device__ __forceinline__ int lds_byte(int r, int c) { const int st = (r >> 4) * 2 + (c >> 5), rr = r & 15, cc = c & 31, ob = rr * 64 + cc * 2; return st * 1024 + (ob ^ (((ob >> 9) & 1) << 5)); }
__host__ __device__ __forceinline__ void stage_rc(int b, int& R, int& C) { const int st = b / 1024, sb = b % 1024, swz = sb ^ (((sb >> 9) & 1) << 5); R = (st >> 1) * 16 + swz / 64; C = (st & 1) * 32 + (swz % 64) / 2; }
__host__ __device__ __forceinline__ int perm32(int rho) { const int n = rho >> 4, i = rho & 15; return 8 * (i >> 2) + 4 * n + (i & 3); }

struct Unit { int pm, pn, z; };
__device__ __forceinline__ unsigned cvt_pk_bf16(float lo, float hi) { unsigned r; asm volatile("v_cvt_pk_bf16_f32 %0, %1, %2" : "=v"(r) : "v"(lo), "v"(hi)); return r; }

struct TileOrder {
    int nM, nN, nwg, G, c;
    __device__ void init(int nM_, int nN_, int G_, int c_) { nM = nM_; nN = nN_; nwg = nM * nN; G = G_; c = c_; }
    __device__ bool tile(int i, int& pm, int& pn) const {
        const long L = (long)i * G + c; if (L >= nwg) return false;
        int wgid = (int)L; { const int q = nwg / NXCD, r = nwg % NXCD, xcd = wgid % NXCD, off = wgid / NXCD; wgid = (xcd < r ? xcd * (q + 1) : r * (q + 1) + (xcd - r) * q) + off; }
        const int nig = WGM * nN, gid = wgid / nig, fm = gid * WGM, gsz = (nM - fm) < WGM ? (nM - fm) : WGM;
        pm = fm + ((wgid % nig) % gsz); pn = (wgid % nig) / gsz; return true;
    }
};

template <class Epi, class Sched>
__device__ __forceinline__ void gemm_phase(PG8_LAS unsigned char* lds, const int lda, const int ldb, const int K, const Sched& S, const Epi& E) {
    const int tid = threadIdx.x, wid = __builtin_amdgcn_readfirstlane(tid >> 6), lane = tid & 63, wr = wid >> 2, wc = wid & 3, fr = lane & 15, fq = lane >> 4;
    const int nt = K / BK;
    unsigned voffA[2], voffB[2];
#pragma unroll
    for (int i = 0; i < 2; ++i) { int R, C; stage_rc(tid * 16 + i * 8192, R, C); const int Rb = Epi::PERM ? ((R & ~31) + perm32(R & 31)) : R;
        voffA[i] = (unsigned)(R * lda + C) * 2u; voffB[i] = (unsigned)(Rb * ldb + C) * 2u; }
    const size_t kstep = (size_t)(BK * 2);
    const size_t hstepA = (size_t)HALF * lda * 2, hstepB = (size_t)HALF * ldb * 2;
    const unsigned ldsw = (unsigned)wid * 1024u;
    const int aoff = lds_byte(wr * 64 + fr, fq * 8), boff = lds_byte(wc * 32 + fr, fq * 8);
#define PG8_SA(b, h) (((b) * 2 + (h)) * HTB)
#define PG8_SB(b, h) ((4 + (b) * 2 + (h)) * HTB)
#define PG8_STAGE(bufoff, gbase, voff) do { _Pragma("unroll") for (int _i = 0; _i < 2; ++_i) \
        __builtin_amdgcn_global_load_lds((const unsigned*)((const char*)(gbase) + (voff)[_i]), (PG8_LAS unsigned*)(lds + (bufoff) + ldsw + _i * 8192), 16, 0, 0); } while (0)
#define PG8_LDA(dst, b, h) do { _Pragma("unroll") for (int m = 0; m < 4; ++m) _Pragma("unroll") for (int k = 0; k < 2; ++k) dst[m][k] = *(const PG8_LAS bf16x8*)(lds + PG8_SA(b, h) + aoff + m * 2048 + k * 1024); } while (0)
#define PG8_LDB(dst, b, h) do { _Pragma("unroll") for (int n = 0; n < 2; ++n) _Pragma("unroll") for (int k = 0; k < 2; ++k) dst[n][k] = *(const PG8_LAS bf16x8*)(lds + PG8_SB(b, h) + boff + n * 2048 + k * 1024); } while (0)
#define PG8_MMA(ai, bj, At, Bt) do { __builtin_amdgcn_s_setprio(1); _Pragma("unroll") for (int m = 0; m < 4; ++m) _Pragma("unroll") for (int n = 0; n < 2; ++n) _Pragma("unroll") for (int k = 0; k < 2; ++k) \
        acc[ai][bj][m][n] = __builtin_amdgcn_mfma_f32_16x16x32_bf16(Bt[n][k], At[m][k], acc[ai][bj][m][n], 0, 0, 0); __builtin_amdgcn_s_setprio(0); } while (0)
#define PG8_WAIT_V(n) asm volatile("s_waitcnt vmcnt(" #n ")" ::: "memory")
#define PG8_WAIT_L(n) asm volatile("s_waitcnt lgkmcnt(" #n ")" ::: "memory")
#define PG8_BAR __builtin_amdgcn_s_barrier()
#define PG8_SCHED __builtin_amdgcn_sched_barrier(0)
    Unit cur, nxt; int ui = 0;
    if (!S.next(0, cur)) return;
    f32x4 acc[2][2][4][2];
#pragma unroll
    for (int a = 0; a < 2; ++a)
#pragma unroll
        for (int b = 0; b < 2; ++b)
#pragma unroll
            for (int m = 0; m < 4; ++m)
#pragma unroll
                for (int n = 0; n < 2; ++n) acc[a][b][m][n] = (f32x4){0.f, 0.f, 0.f, 0.f};
    bf16x8 At[4][2], B0[2][2], B1[2][2];
    const char* cA = S.a_ptr(cur); const char* cB = S.b_ptr(cur);
    PG8_STAGE(PG8_SB(0, 0), cB, voffB); PG8_STAGE(PG8_SA(0, 0), cA, voffA); PG8_STAGE(PG8_SB(0, 1), cB + hstepB, voffB); PG8_STAGE(PG8_SA(0, 1), cA + hstepA, voffA);
    if (wr == 1) PG8_BAR;
    PG8_WAIT_V(4); PG8_BAR;
    PG8_STAGE(PG8_SB(1, 0), cB + kstep, voffB); PG8_STAGE(PG8_SA(1, 0), cA + kstep, voffA); PG8_STAGE(PG8_SB(1, 1), cB + hstepB + kstep, voffB);
    PG8_WAIT_V(6); PG8_BAR;
    for (;;) {
        const bool has_next = S.next(ui + 1, nxt);
        const char* nA = has_next ? S.a_ptr(nxt) : cA; const char* nB = has_next ? S.b_ptr(nxt) : cB;
        for (int t = 0; t < nt; t += 2) {
            const bool last = (t == nt - 2);
            const char* a1 = cA + (size_t)(t + 1) * kstep;
            const char* a2 = last ? nA : cA + (size_t)(t + 2) * kstep; const char* b2 = last ? nB : cB + (size_t)(t + 2) * kstep;
            const char* a3 = a2 + kstep; const char* b3 = b2 + kstep;
            PG8_LDB(B0, 0, 0); PG8_SCHED; PG8_LDA(At, 0, 0); PG8_STAGE(PG8_SA(1, 1), a1 + hstepA, voffA);
            PG8_WAIT_L(8); PG8_BAR; PG8_WAIT_L(0); PG8_MMA(0, 0, At, B0); PG8_BAR; PG8_SCHED;
            PG8_LDB(B1, 0, 1); PG8_STAGE(PG8_SB(0, 0), b2, voffB);
            PG8_BAR; PG8_WAIT_L(0); PG8_MMA(0, 1, At, B1); PG8_BAR;
            PG8_LDA(At, 0, 1); PG8_STAGE(PG8_SA(0, 0), a2, voffA);
            PG8_BAR; PG8_WAIT_L(0); PG8_MMA(1, 0, At, B0); PG8_BAR; PG8_SCHED;
            PG8_STAGE(PG8_SB(0, 1), b2 + hstepB, voffB);
            PG8_WAIT_V(6); PG8_BAR; PG8_MMA(1, 1, At, B1); PG8_BAR;
            PG8_LDB(B0, 1, 0); PG8_SCHED; PG8_LDA(At, 1, 0); PG8_STAGE(PG8_SA(0, 1), a2 + hstepA, voffA);
            PG8_WAIT_L(8); PG8_BAR; PG8_WAIT_L(0); PG8_MMA(0, 0, At, B0); PG8_BAR; PG8_SCHED;
            PG8_LDB(B1, 1, 1); PG8_STAGE(PG8_SB(1, 0), b3, voffB);
            PG8_BAR; PG8_WAIT_L(0); PG8_MMA(0, 1, At, B1); PG8_BAR;
            PG8_LDA(At, 1, 1); PG8_STAGE(PG8_SA(1, 0), a3, voffA);
            PG8_BAR; PG8_WAIT_L(0); PG8_MMA(1, 0, At, B0); PG8_BAR; PG8_SCHED;
            PG8_STAGE(PG8_SB(1, 1), b3 + hstepB, voffB);
            PG8_WAIT_V(6); PG8_BAR; PG8_MMA(1, 1, At, B1); PG8_BAR;
        }
        E(acc, cur, wr, wc, fr, fq);
        if (!has_next) break;
#pragma unroll
        for (int a = 0; a < 2; ++a)
#pragma unroll
            for (int b = 0; b < 2; ++b)
#pragma unroll
                for (int m = 0; m < 4; ++m)
#pragma unroll
                    for (int n = 0; n < 2; ++n) acc[a][b][m][n] = (f32x4){0.f, 0.f, 0.f, 0.f};
        cur = nxt; cA = nA; cB = nB; ++ui;
    }
    PG8_WAIT_V(0);
    if (wr == 0) PG8_BAR;
    PG8_BAR;
#undef PG8_SA
#undef PG8_SB
#undef PG8_STAGE
#undef PG8_LDA
#undef PG8_LDB
#undef PG8_MMA
#undef PG8_WAIT_V
#undef PG8_WAIT_L
#undef PG8_BAR
#undef PG8_SCHED
}
}
using pg8::f32x4; using pg8::u32x4; using pg8::Unit;

#define GEMM_LDS (pg8::STAGE_BYTES + 1024)

struct SchedProj : pg8::TileOrder {
  const char* A; const char* B;
  __device__ bool next(int i, Unit& u) const { u.z = 0; return tile(i, u.pm, u.pn); }
  __device__ const char* a_ptr(const Unit& u) const { return A + (size_t)u.pm * 256 * DM * 2; }
  __device__ const char* b_ptr(const Unit& u) const { return B + (size_t)u.pn * 256 * DM * 2; }
};
struct EpiProj {
  static constexpr bool PERM = true;
  bf16_t* O;
  __device__ __forceinline__ void operator()(const f32x4 (&acc)[2][2][4][2], const Unit& u, int wr, int wc, int fr, int fq) const {
    const int row0 = u.pm * 256 + wr * 64 + fr, col0 = u.pn * 256 + wc * 32 + 8 * fq;
    const bool gate = u.pn >= (C_GA / 256);
#pragma unroll
    for (int ai = 0; ai < 2; ++ai)
#pragma unroll
      for (int m = 0; m < 4; ++m) {
        bf16_t* rowp = O + (size_t)(row0 + ai * 128 + m * 16) * PW + col0;
#pragma unroll
        for (int bj = 0; bj < 2; ++bj) {
          f32x4 v0 = acc[ai][bj][m][0], v1 = acc[ai][bj][m][1];
          if (gate) {
#pragma unroll
            for (int j = 0; j < 4; ++j) { v0[j] = sigmoidf_(v0[j]); v1[j] = sigmoidf_(v1[j]); }
          }
          u32x4 w; w.x = pg8::cvt_pk_bf16(v0[0], v0[1]); w.y = pg8::cvt_pk_bf16(v0[2], v0[3]); w.z = pg8::cvt_pk_bf16(v1[0], v1[1]); w.w = pg8::cvt_pk_bf16(v1[2], v1[3]);
          *(u32x4*)(rowp + bj * 128) = w;
        }
      }
  }
};
__device__ void ph_proj(const Params& p, PG8_LAS unsigned char* lds, int nblk, int bid) {
  SchedProj S; S.init(T_TOK / 256, PW / 256, nblk, bid); S.A = (const char*)p.hbf; S.B = (const char*)p.w_in_t;
  EpiProj E{p.proj};
  pg8::gemm_phase(lds, DM, DM, DM, S, E);
}

struct SchedBr : pg8::TileOrder {
  const char* A; const char* Ba; const char* Bb;
  __device__ bool next(int i, Unit& u) const { u.z = i & 1; return tile(i >> 1, u.pm, u.pn); }
  __device__ const char* a_ptr(const Unit& u) const { return A + (size_t)u.pm * 256 * DM * 2 + u.z * 512 * 2; }
  __device__ const char* b_ptr(const Unit& u) const { return (u.z ? Bb : Ba) + (size_t)u.pn * 256 * 512 * 2; }
};
__device__ __forceinline__ void unpack8(const u32x4 w, float (&f)[8]) {
  f[0] = __uint_as_float(w.x << 16); f[1] = __uint_as_float(w.x & 0xffff0000u); f[2] = __uint_as_float(w.y << 16); f[3] = __uint_as_float(w.y & 0xffff0000u);
  f[4] = __uint_as_float(w.z << 16); f[5] = __uint_as_float(w.z & 0xffff0000u); f[6] = __uint_as_float(w.w << 16); f[7] = __uint_as_float(w.w & 0xffff0000u);
}
struct EpiBr {
  static constexpr bool PERM = true;
  const bf16_t* proj; bf16_t* O;
  __device__ __forceinline__ void operator()(const f32x4 (&acc)[2][2][4][2], const Unit& u, int wr, int wc, int fr, int fq) const {
    const int row0 = u.pm * 256 + wr * 64 + fr, col0 = u.pn * 256 + wc * 32 + 8 * fq;
    const int gcol = (u.z ? C_GB : C_GA) + col0;
#pragma unroll
    for (int ai = 0; ai < 2; ++ai)
#pragma unroll
      for (int m = 0; m < 4; ++m) {
        const size_t row = (size_t)(row0 + ai * 128 + m * 16);
        bf16_t* rowp = O + row * DM + col0;
        const bf16_t* gp = proj + row * PW + gcol;
#pragma unroll
        for (int bj = 0; bj < 2; ++bj) {
          float g[8]; unpack8(*(const u32x4*)(gp + bj * 128), g);
          f32x4 v0 = acc[ai][bj][m][0], v1 = acc[ai][bj][m][1];
          float r[8];
#pragma unroll
          for (int j = 0; j < 4; ++j) { r[j] = v0[j] * g[j]; r[4 + j] = v1[j] * g[4 + j]; }
          if (u.z) {
            float pv[8]; unpack8(*(const u32x4*)(rowp + bj * 128), pv);
#pragma unroll
            for (int j = 0; j < 8; ++j) r[j] += pv[j];
          }
          u32x4 w; w.x = pg8::cvt_pk_bf16(r[0], r[1]); w.y = pg8::cvt_pk_bf16(r[2], r[3]); w.z = pg8::cvt_pk_bf16(r[4], r[5]); w.w = pg8::cvt_pk_bf16(r[6], r[7]);
          *(u32x4*)(rowp + bj * 128) = w;
        }
      }
  }
};
__device__ void ph_br(const Params& p, PG8_LAS unsigned char* lds, int nblk, int bid) {
  SchedBr S; S.init(T_TOK / 256, DM / 256, nblk, bid); S.A = (const char*)p.oab; S.Ba = (const char*)p.wbra_t; S.Bb = (const char*)p.wbrb_t;
  EpiBr E{p.proj, p.merged};
  pg8::gemm_phase(lds, DM, 512, 512, S, E);
}

struct SchedMix : pg8::TileOrder {
  const char* A; const char* B;
  __device__ bool next(int i, Unit& u) const { u.z = 0; return tile(i, u.pm, u.pn); }
  __device__ const char* a_ptr(const Unit& u) const { return A + (size_t)u.pm * 256 * DM * 2; }
  __device__ const char* b_ptr(const Unit& u) const { return B + (size_t)u.pn * 256 * DM * 2; }
};
struct EpiMix {
  static constexpr bool PERM = true;
  bf16_t* O;
  __device__ __forceinline__ void operator()(const f32x4 (&acc)[2][2][4][2], const Unit& u, int wr, int wc, int fr, int fq) const {
    const int row0 = u.pm * 256 + wr * 64 + fr, col0 = u.pn * 256 + wc * 32 + 8 * fq;
#pragma unroll
    for (int ai = 0; ai < 2; ++ai)
#pragma unroll
      for (int m = 0; m < 4; ++m) {
        bf16_t* rowp = O + (size_t)(row0 + ai * 128 + m * 16) * DM + col0;
#pragma unroll
        for (int bj = 0; bj < 2; ++bj) {
          const f32x4 v0 = acc[ai][bj][m][0], v1 = acc[ai][bj][m][1];
          u32x4 w; w.x = pg8::cvt_pk_bf16(v0[0], v0[1]); w.y = pg8::cvt_pk_bf16(v0[2], v0[3]); w.z = pg8::cvt_pk_bf16(v1[0], v1[1]); w.w = pg8::cvt_pk_bf16(v1[2], v1[3]);
          *(u32x4*)(rowp + bj * 128) = w;
        }
      }
  }
};
__device__ void ph_mix(const Params& p, PG8_LAS unsigned char* lds, int nblk, int bid) {
  SchedMix S; S.init(T_TOK / 256, DM / 256, nblk, bid); S.A = (const char*)p.merged; S.B = (const char*)p.wo_t;
  EpiMix E{p.mixer};
  pg8::gemm_phase(lds, DM, DM, DM, S, E);
}

struct SchedMoe {
  const PG8_LAS int* tb; int NT; int G, c; int nwg;
  const char* A; const char* B; size_t bexp;
  __device__ bool next(int i, Unit& u) const {
    const long L = (long)i * G + c; if (L >= nwg) return false;
    int wgid = (int)L; { const int q = nwg / 8, r = nwg % 8, xcd = wgid % 8, off = wgid / 8; wgid = (xcd < r ? xcd * (q + 1) : r * (q + 1) + (xcd - r) * q) + off; }
    int e = 0;
#pragma unroll 1
    for (int k = 1; k < NE; ++k) if (wgid >= tb[k]) e = k;
    const int q = wgid - tb[e]; const int tiles = tb[33 + e + 1] - tb[33 + e];
    u.pm = tb[33 + e] + q % tiles; u.pn = q / tiles; u.z = e; return true;
  }
  __device__ const char* a_ptr(const Unit& u) const { return A + (size_t)u.pm * 256 * DM * 2; }
  __device__ const char* b_ptr(const Unit& u) const { return B + (size_t)u.z * bexp + (size_t)u.pn * 256 * DM * 2; }
};
__device__ __forceinline__ void moe_table(const Params& p, PG8_LAS int* tb, int NT) {
  if (threadIdx.x == 0) {
    int ub = 0, tbp = 0;
    for (int e = 0; e < NE; ++e) { tb[e] = ub; tb[33 + e] = tbp; const int t = (p.cnt[e] + 255) >> 8; ub += t * NT; tbp += t; }
    tb[NE] = ub; tb[33 + NE] = tbp;
  }
  __syncthreads();
}
struct EpiMoe1 {
  static constexpr bool PERM = true;
  const float* b_gu; bf16_t* act;
  __device__ __forceinline__ void operator()(const f32x4 (&acc)[2][2][4][2], const Unit& u, int wr, int wc, int fr, int fq) const {
    const int row0 = u.pm * 256 + wr * 64 + fr, jc = u.pn * 128 + wc * 32 + 8 * fq;
    const float* bg = b_gu + (size_t)u.z * 2048 + jc;
    float bgv[8], buv[8];
#pragma unroll
    for (int j = 0; j < 8; ++j) { bgv[j] = bg[j]; buv[j] = bg[1024 + j]; }
#pragma unroll
    for (int ai = 0; ai < 2; ++ai)
#pragma unroll
      for (int m = 0; m < 4; ++m) {
        bf16_t* rowp = act + (size_t)(row0 + ai * 128 + m * 16) * DM + jc;
        float r[8];
#pragma unroll
        for (int n = 0; n < 2; ++n)
#pragma unroll
          for (int j = 0; j < 4; ++j) {
            float g = acc[ai][0][m][n][j] + bgv[n * 4 + j], up = acc[ai][1][m][n][j] + buv[n * 4 + j];
            g = fminf(g, 7.f); up = fminf(fmaxf(up, -7.f), 7.f);
            r[n * 4 + j] = (up + 1.f) * g * sigmoidf_(1.702f * g);
          }
        u32x4 w; w.x = pg8::cvt_pk_bf16(r[0], r[1]); w.y = pg8::cvt_pk_bf16(r[2], r[3]); w.z = pg8::cvt_pk_bf16(r[4], r[5]); w.w = pg8::cvt_pk_bf16(r[6], r[7]);
        *(u32x4*)rowp = w;
      }
  }
};
__device__ void ph_moe1(const Params& p, PG8_LAS unsigned char* lds, int nblk, int bid) {
  PG8_LAS int* tb = (PG8_LAS int*)(lds + pg8::STAGE_BYTES);
  moe_table(p, tb, 8);
  SchedMoe S; S.tb = tb; S.NT = 8; S.G = nblk; S.c = bid; S.nwg = tb[NE]; S.A = (const char*)p.xs; S.B = (const char*)p.wgu_t; S.bexp = (size_t)2048 * DM * 2;
  EpiMoe1 E{p.b_gu, p.act};
  pg8::gemm_phase(lds, DM, DM, DM, S, E);
}
struct EpiMoe2 {
  static constexpr bool PERM = true;
  const float* b_down; const int* rowmap; bf16_t* yslot;
  __device__ __forceinline__ void operator()(const f32x4 (&acc)[2][2][4][2], const Unit& u, int wr, int wc, int fr, int fq) const {
    const int row0 = u.pm * 256 + wr * 64 + fr, col0 = u.pn * 256 + wc * 32 + 8 * fq;
    const float* bd = b_down + (size_t)u.z * 1024 + col0;
    float bv[2][8];
#pragma unroll
    for (int bj = 0; bj < 2; ++bj)
#pragma unroll
      for (int j = 0; j < 8; ++j) bv[bj][j] = bd[bj * 128 + j];
#pragma unroll
    for (int ai = 0; ai < 2; ++ai)
#pragma unroll
      for (int m = 0; m < 4; ++m) {
        const int a = rowmap[row0 + ai * 128 + m * 16];
        if (a >= 0) {
          bf16_t* rowp = yslot + (size_t)a * DM + col0;
#pragma unroll
          for (int bj = 0; bj < 2; ++bj) {
            const f32x4 v0 = acc[ai][bj][m][0], v1 = acc[ai][bj][m][1];
            u32x4 w; w.x = pg8::cvt_pk_bf16(v0[0] + bv[bj][0], v0[1] + bv[bj][1]); w.y = pg8::cvt_pk_bf16(v0[2] + bv[bj][2], v0[3] + bv[bj][3]);
            w.z = pg8::cvt_pk_bf16(v1[0] + bv[bj][4], v1[1] + bv[bj][5]); w.w = pg8::cvt_pk_bf16(v1[2] + bv[bj][6], v1[3] + bv[bj][7]);
            *(u32x4*)(rowp + bj * 128) = w;
          }
        }
      }
  }
};
__device__ void ph_moe2(const Params& p, PG8_LAS unsigned char* lds, int nblk, int bid) {
  PG8_LAS int* tb = (PG8_LAS int*)(lds + pg8::STAGE_BYTES);
  moe_table(p, tb, 4);
  SchedMoe S; S.tb = tb; S.NT = 4; S.G = nblk; S.c = bid; S.nwg = tb[NE]; S.A = (const char*)p.act; S.B = (const char*)p.wd_t; S.bexp = (size_t)1024 * DM * 2;
  EpiMoe2 E{p.b_down, p.rowmap, p.yslot};
  pg8::gemm_phase(lds, DM, DM, DM, S, E);
}

template <int PH>
__global__ __launch_bounds__(512) void k_gemm(Params p) {
  extern __shared__ __attribute__((aligned(16))) unsigned char shm[];
  PG8_LAS unsigned char* lds = (PG8_LAS unsigned char*)shm;
  if (PH == 0) ph_proj(p, lds, gridDim.x, blockIdx.x);
  if (PH == 1) ph_br(p, lds, gridDim.x, blockIdx.x);
  if (PH == 2) ph_mix(p, lds, gridDim.x, blockIdx.x);
  if (PH == 3) ph_moe1(p, lds, gridDim.x, blockIdx.x);
  if (PH == 4) ph_moe2(p, lds, gridDim.x, blockIdx.x);
}

typedef short bf16x8 __attribute__((ext_vector_type(8)));
typedef __bf16 bf16x2_t __attribute__((ext_vector_type(2)));
typedef float f32x2_t __attribute__((ext_vector_type(2)));
typedef unsigned u32x2 __attribute__((ext_vector_type(2)));
#define LAS __attribute__((address_space(3)))
#define MFMA16(a, b, c) __builtin_amdgcn_mfma_f32_16x16x32_bf16((a), (b), (c), 0, 0, 0)
__device__ __forceinline__ unsigned pk2(float a, float b) { f32x2_t v = {a, b}; bf16x2_t r = __builtin_convertvector(v, bf16x2_t); return __builtin_bit_cast(unsigned, r); }
__device__ __forceinline__ bf16x8 pack8(float a0, float a1, float a2, float a3, float a4, float a5, float a6, float a7) {
  u32x4 w; w.x = pk2(a0, a1); w.y = pk2(a2, a3); w.z = pk2(a4, a5); w.w = pk2(a6, a7);
  return __builtin_bit_cast(bf16x8, w);
}
__device__ __forceinline__ bf16_t f2bf_hw(float a) { return (bf16_t)(pk2(a, 0.f) & 0xffffu); }

#define DN_ABYTES 57344
#define DN_UFLOATS 8192
#define F_WN 0
#define F_QD 16
#define F_QK 32
#define F_KT 40

#define DP_KH 0
#define DP_QT 17408
#define DP_KHT 34816
#define DP_VT 53248
#define DP_TU 71680
#define DP_TW 80896
#define DP_LF 90112
#define DP_GC 107520
#define DP_BETA 107776
#define DP_CW 108032
#define DP_TOTAL 114176

template <int KS>
__device__ __forceinline__ f32x4 prod16(const LAS bf16_t* A, int lda, int arow0, const LAS bf16_t* Bt, int ldb, int brow0, f32x4 acc, int lane) {
  const int r = lane & 15, q = lane >> 4;
#pragma unroll
  for (int ks = 0; ks < KS; ++ks) {
    const bf16x8 a = *(const LAS bf16x8*)(A + (arow0 + r) * lda + 32 * ks + 8 * q);
    const bf16x8 b = *(const LAS bf16x8*)(Bt + (brow0 + r) * ldb + 32 * ks + 8 * q);
    acc = MFMA16(a, b, acc);
  }
  return acc;
}
__device__ __forceinline__ void tile_store_rm(LAS bf16_t* X, int ld, int row0, int col0, const f32x4 v, int lane) {
  const int r = lane & 15, q = lane >> 4;
#pragma unroll
  for (int i = 0; i < 4; ++i) X[(row0 + 4 * q + i) * ld + col0 + r] = f2bf_hw(v[i]);
}
__device__ __forceinline__ void tile_store_tr(LAS bf16_t* Xt, int ld, int row0, int col0, const f32x4 v, int lane) {
  const int r = lane & 15, q = lane >> 4;
  u32x2 w; w.x = pk2(v[0], v[1]); w.y = pk2(v[2], v[3]);
  *(LAS u32x2*)(Xt + (col0 + r) * ld + row0 + 4 * q) = w;
}

__device__ void dn_prep_chunk(const Params& p, LAS unsigned char* lds, int ci, bool load_cw) {
  const int tid = threadIdx.x, lane = tid & 63, w = tid >> 6, r16 = lane & 15, q4 = lane >> 4;
  const int bh = ci >> 6, n = ci & 63, b = bh >> 2, h = bh & 3;
  LAS bf16_t* Kh = (LAS bf16_t*)(lds + DP_KH); LAS bf16_t* Qt = (LAS bf16_t*)(lds + DP_QT);
  LAS bf16_t* KhT = (LAS bf16_t*)(lds + DP_KHT); LAS bf16_t* VT = (LAS bf16_t*)(lds + DP_VT);
  LAS bf16_t* Tu = (LAS bf16_t*)(lds + DP_TU); LAS bf16_t* Tw = (LAS bf16_t*)(lds + DP_TW); LAS float* Lf = (LAS float*)(lds + DP_LF);
  LAS float* gcb = (LAS float*)(lds + DP_GC); LAS float* betab = (LAS float*)(lds + DP_BETA); LAS float* cw = (LAS float*)(lds + DP_CW);
  unsigned char* gA = (unsigned char*)p.dnA + (size_t)ci * DN_ABYTES;
  float* gU = p.dnU + (size_t)ci * DN_UFLOATS;

  if (load_cw) {
    for (int i = tid; i < 4 * 384; i += 512) { const int tap = i / 384, cc = i % 384, part = cc >> 7, d = cc & 127; cw[i] = p.conv_w[tap * 1536 + part * 512 + h * 128 + d]; }
  }
  __syncthreads();
  const int c = tid >> 3, g = tid & 7;
  const int s = n * 64 + c;
  const size_t t = (size_t)b * SEQ + s;
  float qv[16], kv[16], vv[16];
#pragma unroll
  for (int j = 0; j < 16; ++j) { qv[j] = 0.f; kv[j] = 0.f; vv[j] = 0.f; }
#pragma unroll
  for (int tap = 0; tap < 4; ++tap) {
    const int ss = s - 3 + tap;
    if (ss >= 0) {
      const bf16_t* row = p.proj + (t - 3 + tap) * PW + h * 128 + 16 * g;
      float x[8];
#pragma unroll
      for (int part = 0; part < 3; ++part) {
#pragma unroll
        for (int hh = 0; hh < 2; ++hh) {
          unpack8(*(const u32x4*)(row + part * 512 + 8 * hh), x);
#pragma unroll
          for (int j = 0; j < 8; ++j) {
            const float wv = cw[tap * 384 + part * 128 + 16 * g + 8 * hh + j];
            if (part == 0) qv[8 * hh + j] += wv * x[j];
            if (part == 1) kv[8 * hh + j] += wv * x[j];
            if (part == 2) vv[8 * hh + j] += wv * x[j];
          }
        }
      }
    }
    asm volatile("" ::: "memory");
  }
  float sq = 0.f, sk = 0.f;
#pragma unroll
  for (int j = 0; j < 16; ++j) { qv[j] = siluf_(qv[j]); kv[j] = siluf_(kv[j]); vv[j] = siluf_(vv[j]); sq += qv[j] * qv[j]; sk += kv[j] * kv[j]; }
  sq += __shfl_xor(sq, 1, 64); sq += __shfl_xor(sq, 2, 64); sq += __shfl_xor(sq, 4, 64);
  sk += __shfl_xor(sk, 1, 64); sk += __shfl_xor(sk, 2, 64); sk += __shfl_xor(sk, 4, 64);
  const float rq = rsqrtf(sq + 1e-6f) * 0.08838834764831845f, rk = rsqrtf(sk + 1e-6f);
#pragma unroll
  for (int j = 0; j < 16; ++j) { qv[j] *= rq; kv[j] *= rk; }
  if (g == 0) {
    const float bb = p.ba[t * 8 + h], aa = p.ba[t * 8 + 4 + h];
    const float xx = aa + p.dt_bias[h];
    const float sp = xx > 20.f ? xx : log1pf(__expf(xx));
    betab[c] = sigmoidf_(bb);
    gcb[c] = -__expf(p.a_log[h]) * sp;
  }
  {
    u32x4 w0, w1;
    w0.x = pk2(kv[0], kv[1]); w0.y = pk2(kv[2], kv[3]); w0.z = pk2(kv[4], kv[5]); w0.w = pk2(kv[6], kv[7]);
    w1.x = pk2(kv[8], kv[9]); w1.y = pk2(kv[10], kv[11]); w1.z = pk2(kv[12], kv[13]); w1.w = pk2(kv[14], kv[15]);
    *(LAS u32x4*)(Kh + c * 136 + 16 * g) = w0; *(LAS u32x4*)(Kh + c * 136 + 16 * g + 8) = w1;
    w0.x = pk2(qv[0], qv[1]); w0.y = pk2(qv[2], qv[3]); w0.z = pk2(qv[4], qv[5]); w0.w = pk2(qv[6], qv[7]);
    w1.x = pk2(qv[8], qv[9]); w1.y = pk2(qv[10], qv[11]); w1.z = pk2(qv[12], qv[13]); w1.w = pk2(qv[14], qv[15]);
    *(LAS u32x4*)(Qt + c * 136 + 16 * g) = w0; *(LAS u32x4*)(Qt + c * 136 + 16 * g + 8) = w1;
#pragma unroll
    for (int j = 0; j < 16; ++j) { KhT[(16 * g + j) * 72 + c] = f2bf_hw(kv[j]); VT[(16 * g + j) * 72 + c] = f2bf_hw(vv[j]); }
  }
  __syncthreads();
  if (w == 0) {
    float v = gcb[lane];
#pragma unroll
    for (int o = 1; o < 64; o <<= 1) { const float u = __shfl_up(v, o, 64); if (lane >= o) v += u; }
    gcb[lane] = v;
  }
  __syncthreads();
  const float gc_c = gcb[c], gl = gcb[63];
  {
    const float eg = __expf(gc_c);
    unsigned char* fb = gA + (size_t)(F_QD + (c >> 4) * 4 + (g >> 1)) * 1024 + (g & 1) * 8;
#pragma unroll
    for (int qq = 0; qq < 4; ++qq) {
      u32x2 wv; wv.x = pk2(qv[4 * qq] * eg, qv[4 * qq + 1] * eg); wv.y = pk2(qv[4 * qq + 2] * eg, qv[4 * qq + 3] * eg);
      *(u32x2*)(fb + ((c & 15) + 16 * qq) * 16) = wv;
    }
  }
  const int rt = w >> 1, ct0 = 2 * (w & 1);
#pragma unroll
  for (int tt = 0; tt < 2; ++tt) {
    const int ct = ct0 + tt;
    f32x4 gacc = {0.f, 0.f, 0.f, 0.f};
    gacc = prod16<4>(Kh, 136, 16 * rt, Kh, 136, 16 * ct, gacc, lane);
    const int m = 16 * ct + r16; const float gc_m = gcb[m];
#pragma unroll
    for (int i = 0; i < 4; ++i) {
      const int cc = 16 * rt + 4 * q4 + i;
      Lf[cc * 68 + m] = (m < cc) ? betab[cc] * gacc[i] * __expf(gcb[cc] - gc_m) : 0.f;
    }
    f32x4 qacc = {0.f, 0.f, 0.f, 0.f};
    qacc = prod16<4>(Kh, 136, 16 * rt, Qt, 136, 16 * ct, qacc, lane);
    const int cq = 16 * ct + r16; const float gc_cq = gcb[cq];
    float o4[4];
#pragma unroll
    for (int i = 0; i < 4; ++i) { const int mm = 16 * rt + 4 * q4 + i; o4[i] = (mm <= cq) ? qacc[i] * __expf(gc_cq - gcb[mm]) : 0.f; }
    u32x2 wv; wv.x = pk2(o4[0], o4[1]); wv.y = pk2(o4[2], o4[3]);
    *(u32x2*)(gA + (size_t)(F_QK + ct * 2 + (rt >> 1)) * 1024 + (r16 + 16 * q4) * 16 + (rt & 1) * 8) = wv;
  }
  __syncthreads();
  if (w == 0) {
    float T[64];
    int lo = lane; asm volatile("" : "+v"(lo));
    const float bm = betab[lo], bem = bm * __expf(gcb[lo]);
#pragma unroll
    for (int i = 0; i < 64; ++i) {
      float a0 = (i == lo) ? 1.f : 0.f, a1 = 0.f, a2 = 0.f, a3 = 0.f;
#pragma unroll
      for (int k4 = 0; k4 < (i + 3) / 4; ++k4) {
        const f32x4 l = *(const LAS f32x4*)(Lf + i * 68 + 4 * k4);
        if (4 * k4 + 0 < i) a0 -= l[0] * T[4 * k4 + 0];
        if (4 * k4 + 1 < i) a1 -= l[1] * T[4 * k4 + 1];
        if (4 * k4 + 2 < i) a2 -= l[2] * T[4 * k4 + 2];
        if (4 * k4 + 3 < i) a3 -= l[3] * T[4 * k4 + 3];
      }
      T[i] = (a0 + a1) + (a2 + a3);
      Tu[i * 72 + lo] = f2bf_hw(T[i] * bm);
      Tw[i * 72 + lo] = f2bf_hw(T[i] * bem);
      asm volatile("" ::: "memory");
    }
  }
  __syncthreads();
#pragma unroll
  for (int rr = 0; rr < 4; ++rr) {
    f32x4 u = {0.f, 0.f, 0.f, 0.f};
    u = prod16<2>(Tu, 72, 16 * rr, VT, 72, 16 * w, u, lane);
    *(f32x4*)(gU + ((w * 4 + rr) * 64 + lane) * 4) = u;
    f32x4 wt = {0.f, 0.f, 0.f, 0.f};
    wt = prod16<2>(KhT, 72, 16 * w, Tw, 72, 16 * rr, wt, lane);
    u32x2 wv; wv.x = pk2(-wt[0], -wt[1]); wv.y = pk2(-wt[2], -wt[3]);
    *(u32x2*)(gA + (size_t)(F_WN + rr * 4 + (w >> 1)) * 1024 + (r16 + 16 * q4) * 16 + (w & 1) * 8) = wv;
  }
#pragma unroll
  for (int it = 0; it < 4; ++it) {
    const int idx = tid + it * 512; const int d = idx >> 4, m4 = idx & 15;
    const u32x2 raw = *(const LAS u32x2*)(KhT + d * 72 + 4 * m4);
    const float k0 = __uint_as_float(raw.x << 16), k1 = __uint_as_float(raw.x & 0xffff0000u), k2 = __uint_as_float(raw.y << 16), k3 = __uint_as_float(raw.y & 0xffff0000u);
    const float e0 = __expf(gl - gcb[4 * m4]), e1 = __expf(gl - gcb[4 * m4 + 1]), e2 = __expf(gl - gcb[4 * m4 + 2]), e3 = __expf(gl - gcb[4 * m4 + 3]);
    u32x2 wv; wv.x = pk2(k0 * e0, k1 * e1); wv.y = pk2(k2 * e2, k3 * e3);
    *(u32x2*)(gA + (size_t)(F_KT + (d >> 4) * 2 + (m4 >> 3)) * 1024 + ((d & 15) + 16 * (m4 & 3)) * 16 + ((m4 >> 2) & 1) * 8) = wv;
  }
  if (tid == 0) p.dnG[ci] = __expf(gl);
}

__global__ __launch_bounds__(512) void k_dn_prep2(Params p) {
  extern __shared__ __attribute__((aligned(16))) unsigned char shm[];
  LAS unsigned char* lds = (LAS unsigned char*)shm;
  bool first = true;
  for (int ci = blockIdx.x; ci < 1024; ci += gridDim.x) { dn_prep_chunk(p, lds, ci, first); first = false; }
}

#define DS_A0 0
#define DS_A1 57344
#define DS_OT 114688
#define DS_TOTAL (114688 + 64 * 132 * 4)
__device__ void dn_scan_bh(const Params& p, LAS unsigned char* lds, int bh) {
  const int tid = threadIdx.x, lane = tid & 63, w = __builtin_amdgcn_readfirstlane(tid >> 6), r16 = lane & 15, q4 = lane >> 4;
  const int b = bh >> 2, h = bh & 3;
  LAS float* Ot = (LAS float*)(lds + DS_OT);
  const unsigned char* gA = (const unsigned char*)p.dnA + (size_t)bh * 64 * DN_ABYTES;
  const float* gU = p.dnU + (size_t)bh * 64 * DN_UFLOATS;
  const float* gG = p.dnG + bh * 64;
  auto issue_A = [&](int n, int buf) {
#pragma unroll
    for (int i = 0; i < 7; ++i) {
      const int f = w * 7 + i;
      __builtin_amdgcn_global_load_lds((const unsigned*)(gA + (size_t)n * DN_ABYTES + f * 1024 + lane * 16), (LAS unsigned*)(lds + (buf ? DS_A1 : DS_A0) + f * 1024), 16, 0, 0);
    }
  };
  auto post = [&](int n) {
    const int row = tid >> 3, seg = tid & 7;
    const size_t t = (size_t)b * SEQ + n * 64 + row;
    float o[16]; float ss = 0.f;
#pragma unroll
    for (int j4 = 0; j4 < 4; ++j4) { const f32x4 v = *(const LAS f32x4*)(Ot + row * 132 + 16 * seg + 4 * j4); o[4 * j4] = v[0]; o[4 * j4 + 1] = v[1]; o[4 * j4 + 2] = v[2]; o[4 * j4 + 3] = v[3]; }
#pragma unroll
    for (int j = 0; j < 16; ++j) ss += o[j] * o[j];
    ss += __shfl_xor(ss, 1, 64); ss += __shfl_xor(ss, 2, 64); ss += __shfl_xor(ss, 4, 64);
    const float rstd = rsqrtf(ss * (1.f / 128.f) + 1e-6f);
    const bf16_t* zp = p.proj + t * PW + C_Z + h * 128 + 16 * seg;
    float z0[8], z1[8]; unpack8(*(const u32x4*)zp, z0); unpack8(*(const u32x4*)(zp + 8), z1);
    float y[16];
#pragma unroll
    for (int j = 0; j < 8; ++j) { y[j] = o[j] * rstd * p.g_dn_out[16 * seg + j] * siluf_(z0[j]); y[8 + j] = o[8 + j] * rstd * p.g_dn_out[16 * seg + 8 + j] * siluf_(z1[j]); }
    u32x4 w0, w1;
    w0.x = pk2(y[0], y[1]); w0.y = pk2(y[2], y[3]); w0.z = pk2(y[4], y[5]); w0.w = pk2(y[6], y[7]);
    w1.x = pk2(y[8], y[9]); w1.y = pk2(y[10], y[11]); w1.z = pk2(y[12], y[13]); w1.w = pk2(y[14], y[15]);
    bf16_t* op = p.dn_out + t * p.dn_out_ld + h * 128 + 16 * seg;
    *(u32x4*)op = w0; *(u32x4*)(op + 8) = w1;
  };
  issue_A(0, 0);
  f32x4 Un[4];
#pragma unroll
  for (int rr = 0; rr < 4; ++rr) Un[rr] = *(const f32x4*)(gU + ((w * 4 + rr) * 64 + lane) * 4);
  f32x4 S[8];
#pragma unroll
  for (int dt = 0; dt < 8; ++dt) S[dt] = (f32x4){0.f, 0.f, 0.f, 0.f};
  asm volatile("s_waitcnt vmcnt(0)" ::: "memory");
  __syncthreads();
#pragma unroll 1
  for (int n = 0; n < 64; ++n) {
    const LAS unsigned char* Ab = lds + ((n & 1) ? DS_A1 : DS_A0);
    if (n + 1 < 64) issue_A(n + 1, (n + 1) & 1);
    f32x4 Vn[4];
#pragma unroll
    for (int rr = 0; rr < 4; ++rr) Vn[rr] = Un[rr];
    if (n + 1 < 64) {
#pragma unroll
      for (int rr = 0; rr < 4; ++rr) Un[rr] = *(const f32x4*)(gU + (size_t)(n + 1) * DN_UFLOATS + ((w * 4 + rr) * 64 + lane) * 4);
    }
    const float gdec = gG[n];
    if (n > 0) post(n - 1);
    bf16x8 Sb[4];
#pragma unroll
    for (int ks = 0; ks < 4; ++ks) Sb[ks] = pack8(S[2 * ks][0], S[2 * ks][1], S[2 * ks][2], S[2 * ks][3], S[2 * ks + 1][0], S[2 * ks + 1][1], S[2 * ks + 1][2], S[2 * ks + 1][3]);
    f32x4 O[4];
#pragma unroll
    for (int rr = 0; rr < 4; ++rr) {
      O[rr] = (f32x4){0.f, 0.f, 0.f, 0.f};
#pragma unroll
      for (int ks = 0; ks < 4; ++ks) {
        const bf16x8 aw = *(const LAS bf16x8*)(Ab + (F_WN + rr * 4 + ks) * 1024 + lane * 16);
        Vn[rr] = MFMA16(aw, Sb[ks], Vn[rr]);
        const bf16x8 aq = *(const LAS bf16x8*)(Ab + (F_QD + rr * 4 + ks) * 1024 + lane * 16);
        O[rr] = MFMA16(aq, Sb[ks], O[rr]);
      }
    }
    bf16x8 Vb[2];
#pragma unroll
    for (int ks = 0; ks < 2; ++ks) Vb[ks] = pack8(Vn[2 * ks][0], Vn[2 * ks][1], Vn[2 * ks][2], Vn[2 * ks][3], Vn[2 * ks + 1][0], Vn[2 * ks + 1][1], Vn[2 * ks + 1][2], Vn[2 * ks + 1][3]);
#pragma unroll
    for (int rr = 0; rr < 4; ++rr)
#pragma unroll
      for (int ks = 0; ks < 2; ++ks) {
        const bf16x8 a = *(const LAS bf16x8*)(Ab + (F_QK + rr * 2 + ks) * 1024 + lane * 16);
        O[rr] = MFMA16(a, Vb[ks], O[rr]);
      }
#pragma unroll
    for (int dt = 0; dt < 8; ++dt) {
      S[dt] *= gdec;
#pragma unroll
      for (int ks = 0; ks < 2; ++ks) {
        const bf16x8 a = *(const LAS bf16x8*)(Ab + (F_KT + dt * 2 + ks) * 1024 + lane * 16);
        S[dt] = MFMA16(a, Vb[ks], S[dt]);
      }
    }
    __syncthreads();
#pragma unroll
    for (int rr = 0; rr < 4; ++rr)
#pragma unroll
      for (int i = 0; i < 4; ++i) Ot[(16 * rr + 4 * q4 + i) * 132 + 16 * w + r16] = O[rr][i];
    asm volatile("s_waitcnt vmcnt(0)" ::: "memory");
    __syncthreads();
  }
  post(63);
  __syncthreads();
}
__global__ __launch_bounds__(512) void k_dn_scan2(Params p) {
  extern __shared__ __attribute__((aligned(16))) unsigned char shm[];
  dn_scan_bh(p, (LAS unsigned char*)shm, blockIdx.x);
}

__global__ __launch_bounds__(256) void k_cmp(const bf16_t* a, int lda, const bf16_t* b, int ldb, int rows, int cols, float* stats) {
  float d2 = 0.f, r2 = 0.f;
  for (size_t i = (size_t)blockIdx.x * 256 + threadIdx.x; i < (size_t)rows * cols; i += (size_t)gridDim.x * 256) {
    size_t r = i / cols, c = i % cols;
    float x = bf2f(a[r * lda + c]), y = bf2f(b[r * ldb + c]);
    if (!(x - x == 0.f)) x = 1e4f;
    d2 += (x - y) * (x - y); r2 += y * y;
  }
  d2 = wave_sum(d2); r2 = wave_sum(r2);
  if ((threadIdx.x & 63) == 0) { atomicAdd(stats, d2); atomicAdd(stats + 1, r2); }
}
__global__ __launch_bounds__(256) void k_perturb(float* out, size_t n, const float* stats) {
  float rel = sqrtf(stats[0] / fmaxf(stats[1], 1e-30f));
  if (!(rel <= 0.02f)) {
    if (!(rel < 1e6f)) rel = 1e6f;
    for (size_t i = (size_t)blockIdx.x * 256 + threadIdx.x; i < n; i += (size_t)gridDim.x * 256) out[i] += 10.f * rel;
  }
}
__global__ __launch_bounds__(128) void k_dn_prep(Params p) {
  int t = blockIdx.x >> 2, h = blockIdx.x & 3;
  int b = t / SEQ, s = t % SEQ;
  int d = threadIdx.x;
  __shared__ float red[2][2];
  float val[3];
#pragma unroll
  for (int part = 0; part < 3; ++part) {
    int ch = part * 512 + h * 128 + d;
    float a = 0.f;
#pragma unroll
    for (int i = 0; i < 4; ++i) {
      int ss = s - 3 + i;
      if (ss >= 0) a += p.conv_w[i * 1536 + ch] * bf2f(p.proj[(size_t)(b * SEQ + ss) * PW + ch]);
    }
    val[part] = siluf_(a);
  }
  float sq = wave_sum(val[0] * val[0]), sk = wave_sum(val[1] * val[1]);
  int wid = d >> 6;
  if ((d & 63) == 0) { red[0][wid] = sq; red[1][wid] = sk; }
  __syncthreads();
  sq = red[0][0] + red[0][1]; sk = red[1][0] + red[1][1];
  size_t o = (((size_t)b * 4 + h) * SEQ + s) * 128 + d;
  p.nq[o] = val[0] * rsqrtf(sq + 1e-6f);
  p.nk[o] = val[1] * rsqrtf(sk + 1e-6f);
  p.nv[o] = val[2];
  if (d == 0) {
    float bb = p.ba[(size_t)t * 8 + h], aa = p.ba[(size_t)t * 8 + 4 + h];
    float xx = aa + p.dt_bias[h];
    float sp = xx > 20.f ? xx : log1pf(__expf(xx));
    size_t o2 = ((size_t)b * 4 + h) * SEQ + s;
    p.nbeta[o2] = sigmoidf_(bb);
    p.ng[o2] = -__expf(p.a_log[h]) * sp;
  }
}
__global__ __launch_bounds__(128) void k_dn_scan(Params p) {
  int bh = blockIdx.x;
  int e = threadIdx.x;
  __shared__ float sk[2][128], sq[2][128];
  float S[128];
#pragma unroll
  for (int d = 0; d < 128; ++d) S[d] = 0.f;
  const float* q = p.nq + (size_t)bh * SEQ * 128;
  const float* k = p.nk + (size_t)bh * SEQ * 128;
  const float* v = p.nv + (size_t)bh * SEQ * 128;
  float* o = p.no + (size_t)bh * SEQ * 128;
  const float scale = 0.08838834764831845f;
  for (int s = 0; s < SEQ; ++s) {
    int buf = s & 1;
    sk[buf][e] = k[(size_t)s * 128 + e];
    sq[buf][e] = q[(size_t)s * 128 + e];
    float vt = v[(size_t)s * 128 + e];
    float beta = p.nbeta[(size_t)bh * SEQ + s];
    float dec = __expf(p.ng[(size_t)bh * SEQ + s]);
    __syncthreads();
    float ks = 0.f;
#pragma unroll
    for (int d = 0; d < 128; ++d) ks += sk[buf][d] * S[d];
    ks *= dec;
    float vn = beta * (vt - ks);
    float ot = 0.f;
#pragma unroll
    for (int d = 0; d < 128; ++d) {
      S[d] = dec * S[d] + sk[buf][d] * vn;
      ot += sq[buf][d] * S[d];
    }
    o[(size_t)s * 128 + e] = ot * scale;
  }
}
__global__ __launch_bounds__(128) void k_dn_post(Params p) {
  int t = blockIdx.x >> 2, h = blockIdx.x & 3;
  int b = t / SEQ, s = t % SEQ;
  int d = threadIdx.x;
  __shared__ float red[2];
  float ov = p.no[(((size_t)b * 4 + h) * SEQ + s) * 128 + d];
  float ss = wave_sum(ov * ov);
  if ((d & 63) == 0) red[d >> 6] = ss;
  __syncthreads();
  ss = red[0] + red[1];
  float y = ov * rsqrtf(ss * (1.f / 128) + 1e-6f) * p.g_dn_out[d];
  float z = bf2f(p.proj[(size_t)t * PW + C_Z + h * 128 + d]);
  p.oab[(size_t)t * DM + h * 128 + d] = f2bf(y * siluf_(z));
}

__global__ __launch_bounds__(128) void k_rope(Params p) {
  int t = blockIdx.x >> 2, h = blockIdx.x & 3;
  int b = t / SEQ, s = t % SEQ;
  int d = threadIdx.x;
  const bf16_t* qr = p.proj + (size_t)t * PW + C_MQ + h * 128;
  const bf16_t* kr = p.proj + (size_t)t * PW + C_MK + h * 128;
  float qv = bf2f(qr[d]), kv = bf2f(kr[d]);
  if (d < 32) {
    int i = d & 15;
    float inv = exp2f(-(float)i * (1.f / 16.f) * 18.931568569324174f);
    float ang = (float)s * inv;
    float cs = cosf(ang), sn = sinf(ang);
    float qo = bf2f(qr[d ^ 16]), ko = bf2f(kr[d ^ 16]);
    if (d < 16) { qv = qv * cs - qo * sn; kv = kv * cs - ko * sn; }
    else        { qv = qv * cs + qo * sn; kv = kv * cs + ko * sn; }
  }
  size_t o = (((size_t)b * 4 + h) * SEQ + s) * 128 + d;
  p.qb[o] = f2bf(qv);
  p.kb[o] = f2bf(kv);
}
__global__ __launch_bounds__(128) void k_kmean(Params p) {
  int bhj = blockIdx.x;
  int d = threadIdx.x;
  const bf16_t* kr = p.kb + (size_t)bhj * 256 * 128;
  float a = 0.f;
  for (int i = 0; i < 256; ++i) a += bf2f(kr[(size_t)i * 128 + d]);
  p.kmean[(size_t)bhj * 128 + d] = a * (1.f / 256.f);
}
__global__ __launch_bounds__(256) void k_moba(Params p) {
  __shared__ float sqv[4][128];
  __shared__ float sp[4][1024];
  int wid = threadIdx.x >> 6, lane = threadIdx.x & 63;
  int gq = blockIdx.x * 4 + wid;
  int bh = gq / SEQ, s = gq % SEQ;
  int b = bh >> 2, h = bh & 3;
  int qblk = s >> 8;
  const bf16_t* qr = p.qb + (size_t)gq * 128;
  sqv[wid][lane] = bf2f(qr[lane]);
  sqv[wid][lane + 64] = bf2f(qr[lane + 64]);
  __syncthreads();
  float sc = -INFINITY;
  if (lane < qblk) {
    const float* km = p.kmean + ((size_t)bh * 16 + lane) * 128;
    float a = 0.f;
    for (int d = 0; d < 128; ++d) a += sqv[wid][d] * km[d];
    sc = a;
  }
  int sel[4];
#pragma unroll
  for (int r = 0; r < 3; ++r) {
    float m = wave_max(sc);
    unsigned long long bal = __ballot(sc == m);
    int idx = __ffsll((long long)bal) - 1;
    sel[r] = (m == -INFINITY) ? -1 : idx;
    if (lane == idx) sc = -INFINITY;
  }
  sel[3] = qblk;
  const float scale = 0.08838834764831845f;
  const bf16_t* kbase = p.kb + (size_t)bh * SEQ * 128;
  float lmax = -INFINITY;
#pragma unroll
  for (int j = 0; j < 4; ++j) {
    int blk = sel[j];
    if (blk < 0) continue;
    for (int i = 0; i < 4; ++i) {
      int kk = i * 64 + lane;
      int kpos = blk * 256 + kk;
      float lg = -INFINITY;
      if (kpos <= s) {
        const bf16_t* kr = kbase + (size_t)kpos * 128;
        float a = 0.f;
        for (int d8 = 0; d8 < 16; ++d8) {
          uint4 u = *(const uint4*)(kr + d8 * 8);
          unsigned w[4] = {u.x, u.y, u.z, u.w};
#pragma unroll
          for (int e = 0; e < 4; ++e) {
            a += sqv[wid][d8 * 8 + 2 * e] * __uint_as_float(w[e] << 16);
            a += sqv[wid][d8 * 8 + 2 * e + 1] * __uint_as_float(w[e] & 0xffff0000u);
          }
        }
        lg = a * scale;
      }
      sp[wid][j * 256 + kk] = lg;
      lmax = fmaxf(lmax, lg);
    }
  }
  lmax = wave_max(lmax);
  float lsum = 0.f;
#pragma unroll
  for (int j = 0; j < 4; ++j) {
    if (sel[j] < 0) continue;
    for (int i = 0; i < 4; ++i) {
      int idx = j * 256 + i * 64 + lane;
      float e = __expf(sp[wid][idx] - lmax);
      sp[wid][idx] = e;
      lsum += e;
    }
  }
  lsum = wave_sum(lsum);
  __syncthreads();
  float o0 = 0.f, o1 = 0.f;
#pragma unroll
  for (int j = 0; j < 4; ++j) {
    int blk = sel[j];
    if (blk < 0) continue;
    const bf16_t* vb = p.proj + (size_t)(b * SEQ + blk * 256) * PW + C_MV + h * 128;
    int nk = (blk == qblk) ? (s - blk * 256 + 1) : 256;
    for (int kk = 0; kk < nk; ++kk) {
      float pr = sp[wid][j * 256 + kk];
      o0 += pr * bf2f(vb[(size_t)kk * PW + lane]);
      o1 += pr * bf2f(vb[(size_t)kk * PW + lane + 64]);
    }
  }
  float inv = 1.f / lsum;
  int t = b * SEQ + s;
  p.oab[(size_t)t * DM + 512 + h * 128 + lane] = f2bf(o0 * inv);
  p.oab[(size_t)t * DM + 512 + h * 128 + lane + 64] = f2bf(o1 * inv);
}

__global__ __launch_bounds__(256) void k_post_mix(Params p) {
  __shared__ float sh[4][1024];
  int wid = threadIdx.x >> 6, lane = threadIdx.x & 63;
  int t = blockIdx.x * 4 + wid;
  int b = t / SEQ;
  const float* md = p.mod + b * 6144;
  float mv[16];
  float ss = 0.f;
#pragma unroll
  for (int i = 0; i < 16; ++i) {
    int k = i * 64 + lane;
    mv[i] = bf2f(p.mixer[(size_t)t * DM + k]);
    ss += mv[i] * mv[i];
  }
  ss = wave_sum(ss);
  float rstd = rsqrtf(ss * (1.f / DM) + 1e-6f);
  float x1[16];
  float s2 = 0.f;
#pragma unroll
  for (int i = 0; i < 16; ++i) {
    int k = i * 64 + lane;
    x1[i] = p.x[(size_t)t * DM + k] + md[2048 + k] * (mv[i] * rstd * p.g_post_mix[k]);
    p.out[(size_t)t * DM + k] = x1[i];
    s2 += x1[i] * x1[i];
  }
  s2 = wave_sum(s2);
  float rstd2 = rsqrtf(s2 * (1.f / DM) + 1e-6f);
#pragma unroll
  for (int i = 0; i < 16; ++i) {
    int k = i * 64 + lane;
    float hv = x1[i] * rstd2 * p.g_pre_ffn[k] * (1.f + md[4096 + k]) + md[3072 + k];
    p.h2[(size_t)t * DM + k] = f2bf(hv);
    sh[wid][k] = hv;
  }
  __syncthreads();
  int e = lane & 31, half = lane >> 5;
  float a = 0.f;
  for (int k = half * 512; k < half * 512 + 512; ++k) a += sh[wid][k] * p.w_router[(size_t)k * 32 + e];
  a += __shfl_xor(a, 32, 64);
  float lg = a + p.b_router[e];
  if (lane >= 32) lg = -INFINITY;
  float tv[4]; int ti[4];
#pragma unroll
  for (int r = 0; r < 4; ++r) {
    float m = wave_max(lg);
    unsigned long long bal = __ballot(lg == m);
    int idx = __ffsll((long long)bal) - 1;
    tv[r] = m; ti[r] = idx;
    if (lane == idx) lg = -INFINITY;
  }
  float e0 = 1.f, e1 = __expf(tv[1] - tv[0]), e2 = __expf(tv[2] - tv[0]), e3 = __expf(tv[3] - tv[0]);
  float inv = 1.f / (e0 + e1 + e2 + e3);
  if (lane < 4) {
    int ee = lane == 0 ? ti[0] : lane == 1 ? ti[1] : lane == 2 ? ti[2] : ti[3];
    float ww = (lane == 0 ? e0 : lane == 1 ? e1 : lane == 2 ? e2 : e3) * inv;
    int pos = atomicAdd(&p.cnt[ee], 1);
    p.elist[ee * T_TOK + pos] = t * 4 + lane;
    p.aw[t * 4 + lane] = ww;
  }
}

__global__ __launch_bounds__(256) void k_gather(Params p) {
  int wid = threadIdx.x >> 6, lane = threadIdx.x & 63;
  int r = blockIdx.x * 4 + wid;
  int off = 0, e = -1, i = 0, ce = 0;
  for (int k = 0; k < NE; ++k) {
    int c = p.cnt[k]; int padc = ((c + 255) >> 8) << 8;
    if (e < 0 && r < off + padc) { e = k; i = r - off; ce = c; }
    off += padc;
  }
  if (e < 0) return;
  int a = (i < ce) ? p.elist[e * T_TOK + i] : -1;
  if (lane == 0) p.rowmap[r] = a;
  uint4 v0 = make_uint4(0, 0, 0, 0), v1 = v0;
  if (a >= 0) {
    const uint4* src = (const uint4*)(p.h2 + (size_t)(a >> 2) * DM);
    v0 = src[lane]; v1 = src[64 + lane];
  }
  uint4* dst = (uint4*)(p.xs + (size_t)r * DM);
  dst[lane] = v0; dst[64 + lane] = v1;
}
__global__ __launch_bounds__(256) void k_final(Params p) {
  int wid = threadIdx.x >> 6, lane = threadIdx.x & 63;
  int t = blockIdx.x * 4 + wid;
  int b = t / SEQ;
  const float* md = p.mod + b * 6144;
  float w0 = p.aw[t * 4], w1 = p.aw[t * 4 + 1], w2 = p.aw[t * 4 + 2], w3 = p.aw[t * 4 + 3];
  float mv[16];
  float ss = 0.f;
#pragma unroll
  for (int i = 0; i < 16; ++i) {
    int k = i * 64 + lane;
    const bf16_t* y = p.yslot + (size_t)t * 4 * DM + k;
    mv[i] = w0 * bf2f(y[0]) + w1 * bf2f(y[DM]) + w2 * bf2f(y[2 * DM]) + w3 * bf2f(y[3 * DM]);
    ss += mv[i] * mv[i];
  }
  ss = wave_sum(ss);
  float rstd = rsqrtf(ss * (1.f / DM) + 1e-6f);
#pragma unroll
  for (int i = 0; i < 16; ++i) {
    int k = i * 64 + lane;
    p.out[(size_t)t * DM + k] = p.out[(size_t)t * DM + k] + md[5120 + k] * (mv[i] * rstd * p.g_post_ffn[k]);
  }
}

static inline size_t al(size_t x) { return (x + 255) & ~(size_t)255; }

extern "C" void kernel_launch(void* const* d_in, const int* in_sizes, int n_in, void* d_out, int out_size, void* d_ws,
                              size_t ws_size, hipStream_t stream) {
  Params p{};
  p.x = (const float*)d_in[0]; p.c = (const float*)d_in[1]; p.w_ada = (const float*)d_in[2]; p.b_ada = (const float*)d_in[3];
  p.g_pre_mix = (const float*)d_in[4]; p.g_post_mix = (const float*)d_in[5]; p.g_pre_ffn = (const float*)d_in[6];
  p.g_post_ffn = (const float*)d_in[7]; p.w_in = (const float*)d_in[8]; p.conv_w = (const float*)d_in[9];
  p.a_log = (const float*)d_in[10]; p.dt_bias = (const float*)d_in[11]; p.g_dn_out = (const float*)d_in[12];
  p.w_br_a = (const float*)d_in[13]; p.w_br_b = (const float*)d_in[14]; p.w_o = (const float*)d_in[15];
  p.w_router = (const float*)d_in[16]; p.b_router = (const float*)d_in[17]; p.w_gu = (const float*)d_in[18];
  p.b_gu = (const float*)d_in[19]; p.w_down = (const float*)d_in[20]; p.b_down = (const float*)d_in[21];
  p.out = (float*)d_out;
  char* w = (char*)d_ws;
  size_t o = 0;
  auto take = [&](size_t bytes) { char* r = w + o; o += al(bytes); return r; };
  p.mod = (float*)take(4 * 6144 * 4);
  p.cnt = (int*)take(256);
  p.ba = (float*)take((size_t)T_TOK * 8 * 4);
  p.hbf = (bf16_t*)take((size_t)T_TOK * DM * 2);
  p.proj = (bf16_t*)take((size_t)T_TOK * PW * 2);
  p.w_in_t = (bf16_t*)take((size_t)PW * DM * 2);
  p.wgu_t = (bf16_t*)take((size_t)NE * 2048 * DM * 2);
  p.wd_t = (bf16_t*)take((size_t)NE * 1024 * DM * 2);
  p.wbra_t = (bf16_t*)take((size_t)1024 * 512 * 2);
  p.wbrb_t = (bf16_t*)take((size_t)1024 * 512 * 2);
  p.wo_t = (bf16_t*)take((size_t)1024 * 1024 * 2);
  p.qb = (bf16_t*)take((size_t)T_TOK * 512 * 2);
  p.kb = (bf16_t*)take((size_t)T_TOK * 512 * 2);
  p.kmean = (float*)take((size_t)16 * 16 * 128 * 4);
  p.oab = (bf16_t*)take((size_t)T_TOK * DM * 2);
  p.merged = (bf16_t*)take((size_t)T_TOK * DM * 2);
  p.mixer = (bf16_t*)take((size_t)T_TOK * DM * 2);
  p.h2 = (bf16_t*)take((size_t)T_TOK * DM * 2);
  p.elist = (int*)take((size_t)NE * T_TOK * 4);
  p.aw = (float*)take((size_t)T_TOK * 4 * 4);
  p.rowmap = (int*)take((size_t)73728 * 4);
  p.dnA = (unsigned char*)take((size_t)1024 * DN_ABYTES);
  p.dnU = (float*)take((size_t)1024 * DN_UFLOATS * 4);
  p.dnG = (float*)take(4096);
  p.oab2 = (bf16_t*)take((size_t)T_TOK * 512 * 2);
  p.dbg = (float*)take(256);
  p.dn_out = p.oab; p.dn_out_ld = DM;
  p.xs = p.proj;
  char* big = take((size_t)73728 * DM * 2 + (size_t)65536 * DM * 2);
  p.act = (bf16_t*)big;
  p.yslot = (bf16_t*)(big + (size_t)73728 * DM * 2);
  {
    char* s = big; size_t so = 0;
    auto t2 = [&](size_t bytes) { char* r = s + so; so += al(bytes); return r; };
    p.nq = (float*)t2((size_t)T_TOK * 512 * 4);
    p.nk = (float*)t2((size_t)T_TOK * 512 * 4);
    p.nv = (float*)t2((size_t)T_TOK * 512 * 4);
    p.no = (float*)t2((size_t)T_TOK * 512 * 4);
    p.ntmp = (float*)t2((size_t)T_TOK * DM * 4);
    p.nbeta = (float*)t2((size_t)T_TOK * 4 * 4);
    p.ng = (float*)t2((size_t)T_TOK * 4 * 4);
  }

  static bool attr_done = false;
  if (!attr_done) {
    (void)hipFuncSetAttribute((const void*)k_gemm<0>, hipFuncAttributeMaxDynamicSharedMemorySize, GEMM_LDS);
    (void)hipFuncSetAttribute((const void*)k_gemm<1>, hipFuncAttributeMaxDynamicSharedMemorySize, GEMM_LDS);
    (void)hipFuncSetAttribute((const void*)k_gemm<2>, hipFuncAttributeMaxDynamicSharedMemorySize, GEMM_LDS);
    (void)hipFuncSetAttribute((const void*)k_gemm<3>, hipFuncAttributeMaxDynamicSharedMemorySize, GEMM_LDS);
    (void)hipFuncSetAttribute((const void*)k_gemm<4>, hipFuncAttributeMaxDynamicSharedMemorySize, GEMM_LDS);
    (void)hipFuncSetAttribute((const void*)k_dn_prep2, hipFuncAttributeMaxDynamicSharedMemorySize, DP_TOTAL);
    (void)hipFuncSetAttribute((const void*)k_dn_scan2, hipFuncAttributeMaxDynamicSharedMemorySize, DS_TOTAL);
    attr_done = true;
  }
  (void)hipMemsetAsync(p.cnt, 0, 256, stream);
  (void)hipMemsetAsync(p.dbg, 0, 256, stream);
  k_mod<<<24, 256, 0, stream>>>(p);
  k_wt<<<dim3((INW + 31) / 32, 32, 1), 256, 0, stream>>>(p.w_in, p.w_in_t, 1024, INW, 1, 0, 0);
  k_wt<<<dim3(64, 32, NE), 256, 0, stream>>>(p.w_gu, p.wgu_t, 1024, 2048, 2, (size_t)1024 * 2048, (size_t)2048 * 1024);
  k_wt<<<dim3(32, 32, NE), 256, 0, stream>>>(p.w_down, p.wd_t, 1024, 1024, 0, (size_t)1024 * 1024, (size_t)1024 * 1024);
  k_wt<<<dim3(32, 16, 1), 256, 0, stream>>>(p.w_br_a, p.wbra_t, 512, 1024, 0, 0, 0);
  k_wt<<<dim3(32, 16, 1), 256, 0, stream>>>(p.w_br_b, p.wbrb_t, 512, 1024, 0, 0, 0);
  k_wt<<<dim3(32, 32, 1), 256, 0, stream>>>(p.w_o, p.wo_t, 1024, 1024, 0, 0, 0);
  k_h<<<T_TOK / 4, 256, 0, stream>>>(p);
  k_gemm<0><<<256, 512, GEMM_LDS, stream>>>(p);
  k_dn_prep2<<<256, 512, DP_TOTAL, stream>>>(p);
  k_dn_scan2<<<16, 512, DS_TOTAL, stream>>>(p);
  k_rope<<<T_TOK * 4, 128, 0, stream>>>(p);
  k_kmean<<<256, 128, 0, stream>>>(p);
  k_moba<<<T_TOK * 4 / 4, 256, 0, stream>>>(p);
  k_gemm<1><<<256, 512, GEMM_LDS, stream>>>(p);
  k_gemm<2><<<256, 512, GEMM_LDS, stream>>>(p);
  k_post_mix<<<T_TOK / 4, 256, 0, stream>>>(p);
  k_gather<<<73728 / 4, 256, 0, stream>>>(p);
  k_gemm<3><<<256, 512, GEMM_LDS, stream>>>(p);
  k_gemm<4><<<256, 512, GEMM_LDS, stream>>>(p);
  k_final<<<T_TOK / 4, 256, 0, stream>>>(p);
  k_perturb<<<1024, 256, 0, stream>>>(p.out, (size_t)T_TOK * DM, p.dbg);
}
```

```cpp
#include <hip/hip_runtime.h>
#include <stdint.h>

typedef unsigned short bf16_t;

#define T_TOK 16384
#define SEQ 4096
#define NB 4
#define DM 1024
#define INW 5640
#define PW 5632
#define C_QA 0
#define C_KA 512
#define C_VA 1024
#define C_Z 1536
#define C_MQ 2048
#define C_MK 2560
#define C_MV 3072
#define C_GA 3584
#define C_GB 4608
#define NE 32

__device__ __forceinline__ bf16_t f2bf(float f) {
  unsigned u = __float_as_uint(f);
  u += 0x7fffu + ((u >> 16) & 1u);
  return (bf16_t)(u >> 16);
}
__device__ __forceinline__ float bf2f(bf16_t h) { return __uint_as_float(((unsigned)h) << 16); }
__device__ __forceinline__ float sigmoidf_(float x) { return 1.f / (1.f + __expf(-x)); }
__device__ __forceinline__ float siluf_(float x) { return x / (1.f + __expf(-x)); }
__device__ __forceinline__ float wave_sum(float v) {
#pragma unroll
  for (int o = 32; o > 0; o >>= 1) v += __shfl_xor(v, o, 64);
  return v;
}
__device__ __forceinline__ float wave_max(float v) {
#pragma unroll
  for (int o = 32; o > 0; o >>= 1) v = fmaxf(v, __shfl_xor(v, o, 64));
  return v;
}

struct Params {
  const float *x, *c, *w_ada, *b_ada, *g_pre_mix, *g_post_mix, *g_pre_ffn, *g_post_ffn, *w_in, *conv_w,
      *a_log, *dt_bias, *g_dn_out, *w_br_a, *w_br_b, *w_o, *w_router, *b_router, *w_gu, *b_gu, *w_down, *b_down;
  float* out;
  float* mod;
  int* cnt;
  float* ba;
  bf16_t* hbf;
  bf16_t* proj;
  bf16_t* w_in_t;
  bf16_t* wgu_t;
  bf16_t* wd_t;
  bf16_t* wbra_t;
  bf16_t* wbrb_t;
  bf16_t* wo_t;
  bf16_t* qb;
  bf16_t* kb;
  float* kmean;
  bf16_t* oab;
  bf16_t* merged;
  bf16_t* mixer;
  bf16_t* h2;
  int* elist;
  float* aw;
  bf16_t* act;
  bf16_t* xs;
  int* rowmap;
  bf16_t* yslot;
  unsigned char* dnA; float* dnU; float* dnG;
  bf16_t* dn_out; int dn_out_ld;
  bf16_t* oab2; float* dbg;
  bf16_t* Kp; bf16_t* Vp; int* wq;
  bf16_t* mb_out; int mb_out_ld; int mb_out_off;
  float* nq; float* nk; float* nv;
  float* nbeta; float* ng;
  float* no;
  float* ntmp;
};

__global__ __launch_bounds__(256) void k_mod(Params p) {
  __shared__ float sc[4][1024];
  for (int i = threadIdx.x; i < 4096; i += 256) sc[i >> 10][i & 1023] = siluf_(p.c[i]);
  __syncthreads();
  int j = blockIdx.x * 256 + threadIdx.x;
  float a0 = 0, a1 = 0, a2 = 0, a3 = 0;
  for (int k = 0; k < 1024; ++k) {
    float w = p.w_ada[(size_t)k * 6144 + j];
    a0 += sc[0][k] * w; a1 += sc[1][k] * w; a2 += sc[2][k] * w; a3 += sc[3][k] * w;
  }
  float b = p.b_ada[j];
  p.mod[0 * 6144 + j] = a0 + b; p.mod[1 * 6144 + j] = a1 + b;
  p.mod[2 * 6144 + j] = a2 + b; p.mod[3 * 6144 + j] = a3 + b;
}

__device__ __forceinline__ int map_col(int n, int mode) {
  if (mode == 0) return n;
  if (mode == 1) return n < 2048 ? n : (n < 2056 ? -1 : n - 8);
  if (n < 1024) return (n >> 7) * 256 + (n & 127);
  int j = n - 1024;
  return (j >> 7) * 256 + 128 + (j & 127);
}
__global__ __launch_bounds__(256) void k_wt(const float* __restrict__ src, bf16_t* __restrict__ dst, int K, int N, int mode,
                                            size_t src_estride, size_t dst_estride) {
  __shared__ float tile[32][33];
  src += (size_t)blockIdx.z * src_estride;
  dst += (size_t)blockIdx.z * dst_estride;
  int n0 = blockIdx.x * 32, k0 = blockIdx.y * 32;
  int tx = threadIdx.x & 31, ty = threadIdx.x >> 5;
  for (int r = ty; r < 32; r += 8) {
    int n = n0 + tx;
    tile[r][tx] = (n < N) ? src[(size_t)(k0 + r) * N + n] : 0.f;
  }
  __syncthreads();
  for (int r = ty; r < 32; r += 8) {
    int n = n0 + r;
    if (n < N) {
      int d = map_col(n, mode);
      if (d >= 0) dst[(size_t)d * K + k0 + tx] = f2bf(tile[tx][r]);
    }
  }
}

__global__ __launch_bounds__(256) void k_h(Params p) {
  int wid = threadIdx.x >> 6, lane = threadIdx.x & 63;
  int t = blockIdx.x * 4 + wid;
  int b = t / SEQ;
  const float* xr = p.x + (size_t)t * DM;
  float v[16];
  float ss = 0.f;
#pragma unroll
  for (int i = 0; i < 4; ++i) {
    float4 q = *(const float4*)(xr + i * 256 + lane * 4);
    v[i * 4 + 0] = q.x; v[i * 4 + 1] = q.y; v[i * 4 + 2] = q.z; v[i * 4 + 3] = q.w;
    ss += q.x * q.x + q.y * q.y + q.z * q.z + q.w * q.w;
  }
  ss = wave_sum(ss);
  float rstd = rsqrtf(ss * (1.f / DM) + 1e-6f);
  const float* shift = p.mod + b * 6144;
  const float* scale = p.mod + b * 6144 + 1024;
  float acc[8] = {0, 0, 0, 0, 0, 0, 0, 0};
#pragma unroll
  for (int i = 0; i < 4; ++i) {
    bf16_t o[4];
#pragma unroll
    for (int j = 0; j < 4; ++j) {
      int k = i * 256 + lane * 4 + j;
      float h = v[i * 4 + j] * rstd * p.g_pre_mix[k] * (1.f + scale[k]) + shift[k];
      o[j] = f2bf(h);
      const float* wr = p.w_in + (size_t)k * INW + 2048;
#pragma unroll
      for (int e = 0; e < 8; ++e) acc[e] += h * wr[e];
    }
    uint2 pk;
    pk.x = (unsigned)o[0] | ((unsigned)o[1] << 16);
    pk.y = (unsigned)o[2] | ((unsigned)o[3] << 16);
    *(uint2*)(p.hbf + (size_t)t * DM + i * 256 + lane * 4) = pk;
  }
#pragma unroll
  for (int e = 0; e < 8; ++e) acc[e] = wave_sum(acc[e]);
  if (lane == 0) {
#pragma unroll
    for (int e = 0; e < 8; ++e) p.ba[(size_t)t * 8 + e] = acc[e];
  }
}

namespace pg8 {
#define PG8_LAS __attribute__((address_space(3)))
typedef short bf16x8 __attribute__((ext_vector_type(8)));
typedef float f32x4 __attribute__((ext_vector_type(4)));
typedef unsigned u32x4 __attribute__((ext_vector_type(4)));
constexpr int BM = 256, BK = 64, HALF = 128, HTB = HALF * BK * 2, STAGE_BYTES = 8 * HTB, NXCD = 8, WGM = 8;

__host__ __device__ __forceinline__ int lds_byte(int r, int c) { const int st = (r >> 4) * 2 + (c >> 5), rr = r & 15, cc = c & 31, ob = rr * 64 + cc * 2; return st * 1024 + (ob ^ (((ob >> 9) & 1) << 5)); }
__host__ __device__ __forceinline__ void stage_rc(int b, int& R, int& C) { const int st = b / 1024, sb = b % 1024, swz = sb ^ (((sb >> 9) & 1) << 5); R = (st >> 1) * 16 + swz / 64; C = (st & 1) * 32 + (swz % 64) / 2; }
__host__ __device__ __forceinline__ int perm32(int rho) { const int n = rho >> 4, i = rho & 15; return 8 * (i >> 2) + 4 * n + (i & 3); }

struct Unit { int pm, pn, z; };
__device__ __forceinline__ unsigned cvt_pk_bf16(float lo, float hi) { unsigned r; asm volatile("v_cvt_pk_bf16_f32 %0, %1, %2" : "=v"(r) : "v"(lo), "v"(hi)); return r; }

struct TileOrder {
    int nM, nN, nwg, G, c;
    __device__ void init(int nM_, int nN_, int G_, int c_) { nM = nM_; nN = nN_; nwg = nM * nN; G = G_; c = c_; }
    __device__ bool tile(int i, int& pm, int& pn) const {
        const long L = (long)i * G + c; if (L >= nwg) return false;
        int wgid = (int)L; { const int q = nwg / NXCD, r = nwg % NXCD, xcd = wgid % NXCD, off = wgid / NXCD; wgid = (xcd < r ? xcd * (q + 1) : r * (q + 1) + (xcd - r) * q) + off; }
        const int nig = WGM * nN, gid = wgid / nig, fm = gid * WGM, gsz = (nM - fm) < WGM ? (nM - fm) : WGM;
        pm = fm + ((wgid % nig) % gsz); pn = (wgid % nig) / gsz; return true;
    }
};

template <class Epi, class Sched>
__device__ __forceinline__ void gemm_phase(PG8_LAS unsigned char* lds, const int lda, const int ldb, const int K, const Sched& S, const Epi& E) {
    const int tid = threadIdx.x, wid = __builtin_amdgcn_readfirstlane(tid >> 6), lane = tid & 63, wr = wid >> 2, wc = wid & 3, fr = lane & 15, fq = lane >> 4;
    const int nt = K / BK;
    unsigned voffA[2], voffB[2];
#pragma unroll
    for (int i = 0; i < 2; ++i) { int R, C; stage_rc(tid * 16 + i * 8192, R, C); const int Rb = Epi::PERM ? ((R & ~31) + perm32(R & 31)) : R;
        voffA[i] = (unsigned)(R * lda + C) * 2u; voffB[i] = (unsigned)(Rb * ldb + C) * 2u; }
    const size_t kstep = (size_t)(BK * 2);
    const size_t hstepA = (size_t)HALF * lda * 2, hstepB = (size_t)HALF * ldb * 2;
    const unsigned ldsw = (unsigned)wid * 1024u;
    const int aoff = lds_byte(wr * 64 + fr, fq * 8), boff = lds_byte(wc * 32 + fr, fq * 8);
#define PG8_SA(b, h) (((b) * 2 + (h)) * HTB)
#define PG8_SB(b, h) ((4 + (b) * 2 + (h)) * HTB)
#define PG8_STAGE(bufoff, gbase, voff) do { _Pragma("unroll") for (int _i = 0; _i < 2; ++_i) \
        __builtin_amdgcn_global_load_lds((const unsigned*)((const char*)(gbase) + (voff)[_i]), (PG8_LAS unsigned*)(lds + (bufoff) + ldsw + _i * 8192), 16, 0, 0); } while (0)
#define PG8_LDA(dst, b, h) do { _Pragma("unroll") for (int m = 0; m < 4; ++m) _Pragma("unroll") for (int k = 0; k < 2; ++k) dst[m][k] = *(const PG8_LAS bf16x8*)(lds + PG8_SA(b, h) + aoff + m * 2048 + k * 1024); } while (0)
#define PG8_LDB(dst, b, h) do { _Pragma("unroll") for (int n = 0; n < 2; ++n) _Pragma("unroll") for (int k = 0; k < 2; ++k) dst[n][k] = *(const PG8_LAS bf16x8*)(lds + PG8_SB(b, h) + boff + n * 2048 + k * 1024); } while (0)
#define PG8_MMA(ai, bj, At, Bt) do { __builtin_amdgcn_s_setprio(1); _Pragma("unroll") for (int m = 0; m < 4; ++m) _Pragma("unroll") for (int n = 0; n < 2; ++n) _Pragma("unroll") for (int k = 0; k < 2; ++k) \
        acc[ai][bj][m][n] = __builtin_amdgcn_mfma_f32_16x16x32_bf16(Bt[n][k], At[m][k], acc[ai][bj][m][n], 0, 0, 0); __builtin_amdgcn_s_setprio(0); } while (0)
#define PG8_WAIT_V(n) asm volatile("s_waitcnt vmcnt(" #n ")" ::: "memory")
#define PG8_WAIT_L(n) asm volatile("s_waitcnt lgkmcnt(" #n ")" ::: "memory")
#define PG8_BAR __builtin_amdgcn_s_barrier()
#define PG8_SCHED __builtin_amdgcn_sched_barrier(0)
    Unit cur, nxt; int ui = 0;
    if (!S.next(0, cur)) return;
    f32x4 acc[2][2][4][2];
#pragma unroll
    for (int a = 0; a < 2; ++a)
#pragma unroll
        for (int b = 0; b < 2; ++b)
#pragma unroll
            for (int m = 0; m < 4; ++m)
#pragma unroll
                for (int n = 0; n < 2; ++n) acc[a][b][m][n] = (f32x4){0.f, 0.f, 0.f, 0.f};
    bf16x8 At[4][2], B0[2][2], B1[2][2];
    const char* cA = S.a_ptr(cur); const char* cB = S.b_ptr(cur);
    PG8_STAGE(PG8_SB(0, 0), cB, voffB); PG8_STAGE(PG8_SA(0, 0), cA, voffA); PG8_STAGE(PG8_SB(0, 1), cB + hstepB, voffB); PG8_STAGE(PG8_SA(0, 1), cA + hstepA, voffA);
    if (wr == 1) PG8_BAR;
    PG8_WAIT_V(4); PG8_BAR;
    PG8_STAGE(PG8_SB(1, 0), cB + kstep, voffB); PG8_STAGE(PG8_SA(1, 0), cA + kstep, voffA); PG8_STAGE(PG8_SB(1, 1), cB + hstepB + kstep, voffB);
    PG8_WAIT_V(6); PG8_BAR;
    for (;;) {
        const bool has_next = S.next(ui + 1, nxt);
        const char* nA = has_next ? S.a_ptr(nxt) : cA; const char* nB = has_next ? S.b_ptr(nxt) : cB;
        for (int t = 0; t < nt; t += 2) {
            const bool last = (t == nt - 2);
            const char* a1 = cA + (size_t)(t + 1) * kstep;
            const char* a2 = last ? nA : cA + (size_t)(t + 2) * kstep; const char* b2 = last ? nB : cB + (size_t)(t + 2) * kstep;
            const char* a3 = a2 + kstep; const char* b3 = b2 + kstep;
            PG8_LDB(B0, 0, 0); PG8_SCHED; PG8_LDA(At, 0, 0); PG8_STAGE(PG8_SA(1, 1), a1 + hstepA, voffA);
            PG8_WAIT_L(8); PG8_BAR; PG8_WAIT_L(0); PG8_MMA(0, 0, At, B0); PG8_BAR; PG8_SCHED;
            PG8_LDB(B1, 0, 1); PG8_STAGE(PG8_SB(0, 0), b2, voffB);
            PG8_BAR; PG8_WAIT_L(0); PG8_MMA(0, 1, At, B1); PG8_BAR;
            PG8_LDA(At, 0, 1); PG8_STAGE(PG8_SA(0, 0), a2, voffA);
            PG8_BAR; PG8_WAIT_L(0); PG8_MMA(1, 0, At, B0); PG8_BAR; PG8_SCHED;
            PG8_STAGE(PG8_SB(0, 1), b2 + hstepB, voffB);
            PG8_WAIT_V(6); PG8_BAR; PG8_MMA(1, 1, At, B1); PG8_BAR;
            PG8_LDB(B0, 1, 0); PG8_SCHED; PG8_LDA(At, 1, 0); PG8_STAGE(PG8_SA(0, 1), a2 + hstepA, voffA);
            PG8_WAIT_L(8); PG8_BAR; PG8_WAIT_L(0); PG8_MMA(0, 0, At, B0); PG8_BAR; PG8_SCHED;
            PG8_LDB(B1, 1, 1); PG8_STAGE(PG8_SB(1, 0), b3, voffB);
            PG8_BAR; PG8_WAIT_L(0); PG8_MMA(0, 1, At, B1); PG8_BAR;
            PG8_LDA(At, 1, 1); PG8_STAGE(PG8_SA(1, 0), a3, voffA);
            PG8_BAR; PG8_WAIT_L(0); PG8_MMA(1, 0, At, B0); PG8_BAR; PG8_SCHED;
            PG8_STAGE(PG8_SB(1, 1), b3 + hstepB, voffB);
            PG8_WAIT_V(6); PG8_BAR; PG8_MMA(1, 1, At, B1); PG8_BAR;
        }
        E(acc, cur, wr, wc, fr, fq);
        if (!has_next) break;
#pragma unroll
        for (int a = 0; a < 2; ++a)
#pragma unroll
            for (int b = 0; b < 2; ++b)
#pragma unroll
                for (int m = 0; m < 4; ++m)
#pragma unroll
                    for (int n = 0; n < 2; ++n) acc[a][b][m][n] = (f32x4){0.f, 0.f, 0.f, 0.f};
        cur = nxt; cA = nA; cB = nB; ++ui;
    }
    PG8_WAIT_V(0);
    if (wr == 0) PG8_BAR;
    PG8_BAR;
#undef PG8_SA
#undef PG8_SB
#undef PG8_STAGE
#undef PG8_LDA
#undef PG8_LDB
#undef PG8_MMA
#undef PG8_WAIT_V
#undef PG8_WAIT_L
#undef PG8_BAR
#undef PG8_SCHED
}
}
using pg8::f32x4; using pg8::u32x4; using pg8::Unit;

#define GEMM_LDS (pg8::STAGE_BYTES + 1024)

struct SchedProj : pg8::TileOrder {
  const char* A; const char* B;
  __device__ bool next(int i, Unit& u) const { u.z = 0; return tile(i, u.pm, u.pn); }
  __device__ const char* a_ptr(const Unit& u) const { return A + (size_t)u.pm * 256 * DM * 2; }
  __device__ const char* b_ptr(const Unit& u) const { return B + (size_t)u.pn * 256 * DM * 2; }
};
struct EpiProj {
  static constexpr bool PERM = true;
  bf16_t* O;
  __device__ __forceinline__ void operator()(const f32x4 (&acc)[2][2][4][2], const Unit& u, int wr, int wc, int fr, int fq) const {
    const int row0 = u.pm * 256 + wr * 64 + fr, col0 = u.pn * 256 + wc * 32 + 8 * fq;
    const bool gate = u.pn >= (C_GA / 256);
#pragma unroll
    for (int ai = 0; ai < 2; ++ai)
#pragma unroll
      for (int m = 0; m < 4; ++m) {
        bf16_t* rowp = O + (size_t)(row0 + ai * 128 + m * 16) * PW + col0;
#pragma unroll
        for (int bj = 0; bj < 2; ++bj) {
          f32x4 v0 = acc[ai][bj][m][0], v1 = acc[ai][bj][m][1];
          if (gate) {
#pragma unroll
            for (int j = 0; j < 4; ++j) { v0[j] = sigmoidf_(v0[j]); v1[j] = sigmoidf_(v1[j]); }
          }
          u32x4 w; w.x = pg8::cvt_pk_bf16(v0[0], v0[1]); w.y = pg8::cvt_pk_bf16(v0[2], v0[3]); w.z = pg8::cvt_pk_bf16(v1[0], v1[1]); w.w = pg8::cvt_pk_bf16(v1[2], v1[3]);
          *(u32x4*)(rowp + bj * 128) = w;
        }
      }
  }
};
__device__ void ph_proj(const Params& p, PG8_LAS unsigned char* lds, int nblk, int bid) {
  SchedProj S; S.init(T_TOK / 256, PW / 256, nblk, bid); S.A = (const char*)p.hbf; S.B = (const char*)p.w_in_t;
  EpiProj E{p.proj};
  pg8::gemm_phase(lds, DM, DM, DM, S, E);
}

struct SchedBr : pg8::TileOrder {
  const char* A; const char* Ba; const char* Bb;
  __device__ bool next(int i, Unit& u) const { u.z = i & 1; return tile(i >> 1, u.pm, u.pn); }
  __device__ const char* a_ptr(const Unit& u) const { return A + (size_t)u.pm * 256 * DM * 2 + u.z * 512 * 2; }
  __device__ const char* b_ptr(const Unit& u) const { return (u.z ? Bb : Ba) + (size_t)u.pn * 256 * 512 * 2; }
};
__device__ __forceinline__ void unpack8(const u32x4 w, float (&f)[8]) {
  f[0] = __uint_as_float(w.x << 16); f[1] = __uint_as_float(w.x & 0xffff0000u); f[2] = __uint_as_float(w.y << 16); f[3] = __uint_as_float(w.y & 0xffff0000u);
  f[4] = __uint_as_float(w.z << 16); f[5] = __uint_as_float(w.z & 0xffff0000u); f[6] = __uint_as_float(w.w << 16); f[7] = __uint_as_float(w.w & 0xffff0000u);
}
struct EpiBr {
  static constexpr bool PERM = true;
  const bf16_t* proj; bf16_t* O;
  __device__ __forceinline__ void operator()(const f32x4 (&acc)[2][2][4][2], const Unit& u, int wr, int wc, int fr, int fq) const {
    const int row0 = u.pm * 256 + wr * 64 + fr, col0 = u.pn * 256 + wc * 32 + 8 * fq;
    const int gcol = (u.z ? C_GB : C_GA) + col0;
#pragma unroll
    for (int ai = 0; ai < 2; ++ai)
#pragma unroll
      for (int m = 0; m < 4; ++m) {
        const size_t row = (size_t)(row0 + ai * 128 + m * 16);
        bf16_t* rowp = O + row * DM + col0;
        const bf16_t* gp = proj + row * PW + gcol;
#pragma unroll
        for (int bj = 0; bj < 2; ++bj) {
          float g[8]; unpack8(*(const u32x4*)(gp + bj * 128), g);
          f32x4 v0 = acc[ai][bj][m][0], v1 = acc[ai][bj][m][1];
          float r[8];
#pragma unroll
          for (int j = 0; j < 4; ++j) { r[j] = v0[j] * g[j]; r[4 + j] = v1[j] * g[4 + j]; }
          if (u.z) {
            float pv[8]; unpack8(*(const u32x4*)(rowp + bj * 128), pv);
#pragma unroll
            for (int j = 0; j < 8; ++j) r[j] += pv[j];
          }
          u32x4 w; w.x = pg8::cvt_pk_bf16(r[0], r[1]); w.y = pg8::cvt_pk_bf16(r[2], r[3]); w.z = pg8::cvt_pk_bf16(r[4], r[5]); w.w = pg8::cvt_pk_bf16(r[6], r[7]);
          *(u32x4*)(rowp + bj * 128) = w;
        }
      }
  }
};
__device__ void ph_br(const Params& p, PG8_LAS unsigned char* lds, int nblk, int bid) {
  SchedBr S; S.init(T_TOK / 256, DM / 256, nblk, bid); S.A = (const char*)p.oab; S.Ba = (const char*)p.wbra_t; S.Bb = (const char*)p.wbrb_t;
  EpiBr E{p.proj, p.merged};
  pg8::gemm_phase(lds, DM, 512, 512, S, E);
}

struct SchedMix : pg8::TileOrder {
  const char* A; const char* B;
  __device__ bool next(int i, Unit& u) const { u.z = 0; return tile(i, u.pm, u.pn); }
  __device__ const char* a_ptr(const Unit& u) const { return A + (size_t)u.pm * 256 * DM * 2; }
  __device__ const char* b_ptr(const Unit& u) const { return B + (size_t)u.pn * 256 * DM * 2; }
};
struct EpiMix {
  static constexpr bool PERM = true;
  bf16_t* O;
  __device__ __forceinline__ void operator()(const f32x4 (&acc)[2][2][4][2], const Unit& u, int wr, int wc, int fr, int fq) const {
    const int row0 = u.pm * 256 + wr * 64 + fr, col0 = u.pn * 256 + wc * 32 + 8 * fq;
#pragma unroll
    for (int ai = 0; ai < 2; ++ai)
#pragma unroll
      for (int m = 0; m < 4; ++m) {
        bf16_t* rowp = O + (size_t)(row0 + ai * 128 + m * 16) * DM + col0;
#pragma unroll
        for (int bj = 0; bj < 2; ++bj) {
          const f32x4 v0 = acc[ai][bj][m][0], v1 = acc[ai][bj][m][1];
          u32x4 w; w.x = pg8::cvt_pk_bf16(v0[0], v0[1]); w.y = pg8::cvt_pk_bf16(v0[2], v0[3]); w.z = pg8::cvt_pk_bf16(v1[0], v1[1]); w.w = pg8::cvt_pk_bf16(v1[2], v1[3]);
          *(u32x4*)(rowp + bj * 128) = w;
        }
      }
  }
};
__device__ void ph_mix(const Params& p, PG8_LAS unsigned char* lds, int nblk, int bid) {
  SchedMix S; S.init(T_TOK / 256, DM / 256, nblk, bid); S.A = (const char*)p.merged; S.B = (const char*)p.wo_t;
  EpiMix E{p.mixer};
  pg8::gemm_phase(lds, DM, DM, DM, S, E);
}

struct SchedMoe {
  const PG8_LAS int* tb; int NT; int G, c; int nwg;
  const char* A; const char* B; size_t bexp;
  __device__ bool next(int i, Unit& u) const {
    const long L = (long)i * G + c; if (L >= nwg) return false;
    int wgid = (int)L; { const int q = nwg / 8, r = nwg % 8, xcd = wgid % 8, off = wgid / 8; wgid = (xcd < r ? xcd * (q + 1) : r * (q + 1) + (xcd - r) * q) + off; }
    int e = 0;
#pragma unroll 1
    for (int k = 1; k < NE; ++k) if (wgid >= tb[k]) e = k;
    const int q = wgid - tb[e]; const int tiles = tb[33 + e + 1] - tb[33 + e];
    u.pm = tb[33 + e] + q % tiles; u.pn = q / tiles; u.z = e; return true;
  }
  __device__ const char* a_ptr(const Unit& u) const { return A + (size_t)u.pm * 256 * DM * 2; }
  __device__ const char* b_ptr(const Unit& u) const { return B + (size_t)u.z * bexp + (size_t)u.pn * 256 * DM * 2; }
};
__device__ __forceinline__ void moe_table(const Params& p, PG8_LAS int* tb, int NT) {
  if (threadIdx.x == 0) {
    int ub = 0, tbp = 0;
    for (int e = 0; e < NE; ++e) { tb[e] = ub; tb[33 + e] = tbp; const int t = (p.cnt[e] + 255) >> 8; ub += t * NT; tbp += t; }
    tb[NE] = ub; tb[33 + NE] = tbp;
  }
  __syncthreads();
}
struct EpiMoe1 {
  static constexpr bool PERM = true;
  const float* b_gu; bf16_t* act;
  __device__ __forceinline__ void operator()(const f32x4 (&acc)[2][2][4][2], const Unit& u, int wr, int wc, int fr, int fq) const {
    const int row0 = u.pm * 256 + wr * 64 + fr, jc = u.pn * 128 + wc * 32 + 8 * fq;
    const float* bg = b_gu + (size_t)u.z * 2048 + jc;
    float bgv[8], buv[8];
#pragma unroll
    for (int j = 0; j < 8; ++j) { bgv[j] = bg[j]; buv[j] = bg[1024 + j]; }
#pragma unroll
    for (int ai = 0; ai < 2; ++ai)
#pragma unroll
      for (int m = 0; m < 4; ++m) {
        bf16_t* rowp = act + (size_t)(row0 + ai * 128 + m * 16) * DM + jc;
        float r[8];
#pragma unroll
        for (int n = 0; n < 2; ++n)
#pragma unroll
          for (int j = 0; j < 4; ++j) {
            float g = acc[ai][0][m][n][j] + bgv[n * 4 + j], up = acc[ai][1][m][n][j] + buv[n * 4 + j];
            g = fminf(g, 7.f); up = fminf(fmaxf(up, -7.f), 7.f);
            r[n * 4 + j] = (up + 1.f) * g * sigmoidf_(1.702f * g);
          }
        u32x4 w; w.x = pg8::cvt_pk_bf16(r[0], r[1]); w.y = pg8::cvt_pk_bf16(r[2], r[3]); w.z = pg8::cvt_pk_bf16(r[4], r[5]); w.w = pg8::cvt_pk_bf16(r[6], r[7]);
        *(u32x4*)rowp = w;
      }
  }
};
__device__ void ph_moe1(const Params& p, PG8_LAS unsigned char* lds, int nblk, int bid) {
  PG8_LAS int* tb = (PG8_LAS int*)(lds + pg8::STAGE_BYTES);
  moe_table(p, tb, 8);
  SchedMoe S; S.tb = tb; S.NT = 8; S.G = nblk; S.c = bid; S.nwg = tb[NE]; S.A = (const char*)p.xs; S.B = (const char*)p.wgu_t; S.bexp = (size_t)2048 * DM * 2;
  EpiMoe1 E{p.b_gu, p.act};
  pg8::gemm_phase(lds, DM, DM, DM, S, E);
}
struct EpiMoe2 {
  static constexpr bool PERM = true;
  const float* b_down; const int* rowmap; bf16_t* yslot;
  __device__ __forceinline__ void operator()(const f32x4 (&acc)[2][2][4][2], const Unit& u, int wr, int wc, int fr, int fq) const {
    const int row0 = u.pm * 256 + wr * 64 + fr, col0 = u.pn * 256 + wc * 32 + 8 * fq;
    const float* bd = b_down + (size_t)u.z * 1024 + col0;
    float bv[2][8];
#pragma unroll
    for (int bj = 0; bj < 2; ++bj)
#pragma unroll
      for (int j = 0; j < 8; ++j) bv[bj][j] = bd[bj * 128 + j];
#pragma unroll
    for (int ai = 0; ai < 2; ++ai)
#pragma unroll
      for (int m = 0; m < 4; ++m) {
        const int a = rowmap[row0 + ai * 128 + m * 16];
        if (a >= 0) {
          bf16_t* rowp = yslot + (size_t)a * DM + col0;
#pragma unroll
          for (int bj = 0; bj < 2; ++bj) {
            const f32x4 v0 = acc[ai][bj][m][0], v1 = acc[ai][bj][m][1];
            u32x4 w; w.x = pg8::cvt_pk_bf16(v0[0] + bv[bj][0], v0[1] + bv[bj][1]); w.y = pg8::cvt_pk_bf16(v0[2] + bv[bj][2], v0[3] + bv[bj][3]);
            w.z = pg8::cvt_pk_bf16(v1[0] + bv[bj][4], v1[1] + bv[bj][5]); w.w = pg8::cvt_pk_bf16(v1[2] + bv[bj][6], v1[3] + bv[bj][7]);
            *(u32x4*)(rowp + bj * 128) = w;
          }
        }
      }
  }
};
__device__ void ph_moe2(const Params& p, PG8_LAS unsigned char* lds, int nblk, int bid) {
  PG8_LAS int* tb = (PG8_LAS int*)(lds + pg8::STAGE_BYTES);
  moe_table(p, tb, 4);
  SchedMoe S; S.tb = tb; S.NT = 4; S.G = nblk; S.c = bid; S.nwg = tb[NE]; S.A = (const char*)p.act; S.B = (const char*)p.wd_t; S.bexp = (size_t)1024 * DM * 2;
  EpiMoe2 E{p.b_down, p.rowmap, p.yslot};
  pg8::gemm_phase(lds, DM, DM, DM, S, E);
}

template <int PH>
__global__ __launch_bounds__(512) void k_gemm(Params p) {
  extern __shared__ __attribute__((aligned(16))) unsigned char shm[];
  PG8_LAS unsigned char* lds = (PG8_LAS unsigned char*)shm;
  if (PH == 0) ph_proj(p, lds, gridDim.x, blockIdx.x);
  if (PH == 1) ph_br(p, lds, gridDim.x, blockIdx.x);
  if (PH == 2) ph_mix(p, lds, gridDim.x, blockIdx.x);
  if (PH == 3) ph_moe1(p, lds, gridDim.x, blockIdx.x);
  if (PH == 4) ph_moe2(p, lds, gridDim.x, blockIdx.x);
}

typedef short bf16x8 __attribute__((ext_vector_type(8)));
typedef __bf16 bf16x2_t __attribute__((ext_vector_type(2)));
typedef float f32x2_t __attribute__((ext_vector_type(2)));
typedef unsigned u32x2 __attribute__((ext_vector_type(2)));
#define LAS __attribute__((address_space(3)))
#define MFMA16(a, b, c) __builtin_amdgcn_mfma_f32_16x16x32_bf16((a), (b), (c), 0, 0, 0)
__device__ __forceinline__ unsigned pk2(float a, float b) { f32x2_t v = {a, b}; bf16x2_t r = __builtin_convertvector(v, bf16x2_t); return __builtin_bit_cast(unsigned, r); }
__device__ __forceinline__ bf16x8 pack8(float a0, float a1, float a2, float a3, float a4, float a5, float a6, float a7) {
  u32x4 w; w.x = pk2(a0, a1); w.y = pk2(a2, a3); w.z = pk2(a4, a5); w.w = pk2(a6, a7);
  return __builtin_bit_cast(bf16x8, w);
}
__device__ __forceinline__ bf16_t f2bf_hw(float a) { return (bf16_t)(pk2(a, 0.f) & 0xffffu); }

#define DN_ABYTES 57344
#define DN_UFLOATS 8192
#define F_WN 0
#define F_QD 16
#define F_QK 32
#define F_KT 40

#define DP_KH 0
#define DP_QT 17408
#define DP_KHT 34816
#define DP_VT 53248
#define DP_TU 71680
#define DP_TW 80896
#define DP_LF 90112
#define DP_GC 107520
#define DP_BETA 107776
#define DP_CW 108032
#define DP_TOTAL 114176

template <int KS>
__device__ __forceinline__ f32x4 prod16(const LAS bf16_t* A, int lda, int arow0, const LAS bf16_t* Bt, int ldb, int brow0, f32x4 acc, int lane) {
  const int r = lane & 15, q = lane >> 4;
#pragma unroll
  for (int ks = 0; ks < KS; ++ks) {
    const bf16x8 a = *(const LAS bf16x8*)(A + (arow0 + r) * lda + 32 * ks + 8 * q);
    const bf16x8 b = *(const LAS bf16x8*)(Bt + (brow0 + r) * ldb + 32 * ks + 8 * q);
    acc = MFMA16(a, b, acc);
  }
  return acc;
}
__device__ __forceinline__ void tile_store_rm(LAS bf16_t* X, int ld, int row0, int col0, const f32x4 v, int lane) {
  const int r = lane & 15, q = lane >> 4;
#pragma unroll
  for (int i = 0; i < 4; ++i) X[(row0 + 4 * q + i) * ld + col0 + r] = f2bf_hw(v[i]);
}
__device__ __forceinline__ void tile_store_tr(LAS bf16_t* Xt, int ld, int row0, int col0, const f32x4 v, int lane) {
  const int r = lane & 15, q = lane >> 4;
  u32x2 w; w.x = pk2(v[0], v[1]); w.y = pk2(v[2], v[3]);
  *(LAS u32x2*)(Xt + (col0 + r) * ld + row0 + 4 * q) = w;
}

__device__ void dn_prep_chunk(const Params& p, LAS unsigned char* lds, int ci, bool load_cw) {
  const int tid = threadIdx.x, lane = tid & 63, w = tid >> 6, r16 = lane & 15, q4 = lane >> 4;
  const int bh = ci >> 6, n = ci & 63, b = bh >> 2, h = bh & 3;
  LAS bf16_t* Kh = (LAS bf16_t*)(lds + DP_KH); LAS bf16_t* Qt = (LAS bf16_t*)(lds + DP_QT);
  LAS bf16_t* KhT = (LAS bf16_t*)(lds + DP_KHT); LAS bf16_t* VT = (LAS bf16_t*)(lds + DP_VT);
  LAS bf16_t* Tu = (LAS bf16_t*)(lds + DP_TU); LAS bf16_t* Tw = (LAS bf16_t*)(lds + DP_TW); LAS float* Lf = (LAS float*)(lds + DP_LF);
  LAS float* gcb = (LAS float*)(lds + DP_GC); LAS float* betab = (LAS float*)(lds + DP_BETA); LAS float* cw = (LAS float*)(lds + DP_CW);
  unsigned char* gA = (unsigned char*)p.dnA + (size_t)ci * DN_ABYTES;
  float* gU = p.dnU + (size_t)ci * DN_UFLOATS;

  if (load_cw) {
    for (int i = tid; i < 4 * 384; i += 512) { const int tap = i / 384, cc = i % 384, part = cc >> 7, d = cc & 127; cw[i] = p.conv_w[tap * 1536 + part * 512 + h * 128 + d]; }
  }
  __syncthreads();
  const int c = tid >> 3, g = tid & 7;
  const int s = n * 64 + c;
  const size_t t = (size_t)b * SEQ + s;
  float qv[16], kv[16], vv[16];
#pragma unroll
  for (int j = 0; j < 16; ++j) { qv[j] = 0.f; kv[j] = 0.f; vv[j] = 0.f; }
#pragma unroll
  for (int tap = 0; tap < 4; ++tap) {
    const int ss = s - 3 + tap;
    if (ss >= 0) {
      const bf16_t* row = p.proj + (t - 3 + tap) * PW + h * 128 + 16 * g;
      float x[8];
#pragma unroll
      for (int part = 0; part < 3; ++part) {
#pragma unroll
        for (int hh = 0; hh < 2; ++hh) {
          unpack8(*(const u32x4*)(row + part * 512 + 8 * hh), x);
#pragma unroll
          for (int j = 0; j < 8; ++j) {
            const float wv = cw[tap * 384 + part * 128 + 16 * g + 8 * hh + j];
            if (part == 0) qv[8 * hh + j] += wv * x[j];
            if (part == 1) kv[8 * hh + j] += wv * x[j];
            if (part == 2) vv[8 * hh + j] += wv * x[j];
          }
        }
      }
    }
    asm volatile("" ::: "memory");
  }
  float sq = 0.f, sk = 0.f;
#pragma unroll
  for (int j = 0; j < 16; ++j) { qv[j] = siluf_(qv[j]); kv[j] = siluf_(kv[j]); vv[j] = siluf_(vv[j]); sq += qv[j] * qv[j]; sk += kv[j] * kv[j]; }
  sq += __shfl_xor(sq, 1, 64); sq += __shfl_xor(sq, 2, 64); sq += __shfl_xor(sq, 4, 64);
  sk += __shfl_xor(sk, 1, 64); sk += __shfl_xor(sk, 2, 64); sk += __shfl_xor(sk, 4, 64);
  const float rq = rsqrtf(sq + 1e-6f) * 0.08838834764831845f, rk = rsqrtf(sk + 1e-6f);
#pragma unroll
  for (int j = 0; j < 16; ++j) { qv[j] *= rq; kv[j] *= rk; }
  if (g == 0) {
    const float bb = p.ba[t * 8 + h], aa = p.ba[t * 8 + 4 + h];
    const float xx = aa + p.dt_bias[h];
    const float sp = xx > 20.f ? xx : log1pf(__expf(xx));
    betab[c] = sigmoidf_(bb);
    gcb[c] = -__expf(p.a_log[h]) * sp;
  }
  {
    u32x4 w0, w1;
    w0.x = pk2(kv[0], kv[1]); w0.y = pk2(kv[2], kv[3]); w0.z = pk2(kv[4], kv[5]); w0.w = pk2(kv[6], kv[7]);
    w1.x = pk2(kv[8], kv[9]); w1.y = pk2(kv[10], kv[11]); w1.z = pk2(kv[12], kv[13]); w1.w = pk2(kv[14], kv[15]);
    *(LAS u32x4*)(Kh + c * 136 + 16 * g) = w0; *(LAS u32x4*)(Kh + c * 136 + 16 * g + 8) = w1;
    w0.x = pk2(qv[0], qv[1]); w0.y = pk2(qv[2], qv[3]); w0.z = pk2(qv[4], qv[5]); w0.w = pk2(qv[6], qv[7]);
    w1.x = pk2(qv[8], qv[9]); w1.y = pk2(qv[10], qv[11]); w1.z = pk2(qv[12], qv[13]); w1.w = pk2(qv[14], qv[15]);
    *(LAS u32x4*)(Qt + c * 136 + 16 * g) = w0; *(LAS u32x4*)(Qt + c * 136 + 16 * g + 8) = w1;
#pragma unroll
    for (int j = 0; j < 16; ++j) { KhT[(16 * g + j) * 72 + c] = f2bf_hw(kv[j]); VT[(16 * g + j) * 72 + c] = f2bf_hw(vv[j]); }
  }
  __syncthreads();
  if (w == 0) {
    float v = gcb[lane];
#pragma unroll
    for (int o = 1; o < 64; o <<= 1) { const float u = __shfl_up(v, o, 64); if (lane >= o) v += u; }
    gcb[lane] = v;
  }
  __syncthreads();
  const float gc_c = gcb[c], gl = gcb[63];
  {
    const float eg = __expf(gc_c);
    unsigned char* fb = gA + (size_t)(F_QD + (c >> 4) * 4 + (g >> 1)) * 1024 + (g & 1) * 8;
#pragma unroll
    for (int qq = 0; qq < 4; ++qq) {
      u32x2 wv; wv.x = pk2(qv[4 * qq] * eg, qv[4 * qq + 1] * eg); wv.y = pk2(qv[4 * qq + 2] * eg, qv[4 * qq + 3] * eg);
      *(u32x2*)(fb + ((c & 15) + 16 * qq) * 16) = wv;
    }
  }
  const int rt = w >> 1, ct0 = 2 * (w & 1);
#pragma unroll
  for (int tt = 0; tt < 2; ++tt) {
    const int ct = ct0 + tt;
    f32x4 gacc = {0.f, 0.f, 0.f, 0.f};
    gacc = prod16<4>(Kh, 136, 16 * rt, Kh, 136, 16 * ct, gacc, lane);
    const int m = 16 * ct + r16; const float gc_m = gcb[m];
#pragma unroll
    for (int i = 0; i < 4; ++i) {
      const int cc = 16 * rt + 4 * q4 + i;
      Lf[cc * 68 + m] = (m < cc) ? betab[cc] * gacc[i] * __expf(gcb[cc] - gc_m) : 0.f;
    }
    f32x4 qacc = {0.f, 0.f, 0.f, 0.f};
    qacc = prod16<4>(Kh, 136, 16 * rt, Qt, 136, 16 * ct, qacc, lane);
    const int cq = 16 * ct + r16; const float gc_cq = gcb[cq];
    float o4[4];
#pragma unroll
    for (int i = 0; i < 4; ++i) { const int mm = 16 * rt + 4 * q4 + i; o4[i] = (mm <= cq) ? qacc[i] * __expf(gc_cq - gcb[mm]) : 0.f; }
    u32x2 wv; wv.x = pk2(o4[0], o4[1]); wv.y = pk2(o4[2], o4[3]);
    *(u32x2*)(gA + (size_t)(F_QK + ct * 2 + (rt >> 1)) * 1024 + (r16 + 16 * q4) * 16 + (rt & 1) * 8) = wv;
  }
  __syncthreads();
  if (w == 0) {
    float T[64];
    int lo = lane; asm volatile("" : "+v"(lo));
    const float bm = betab[lo], bem = bm * __expf(gcb[lo]);
#pragma unroll
    for (int i = 0; i < 64; ++i) {
      float a0 = (i == lo) ? 1.f : 0.f, a1 = 0.f, a2 = 0.f, a3 = 0.f;
#pragma unroll
      for (int k4 = 0; k4 < (i + 3) / 4; ++k4) {
        const f32x4 l = *(const LAS f32x4*)(Lf + i * 68 + 4 * k4);
        if (4 * k4 + 0 < i) a0 -= l[0] * T[4 * k4 + 0];
        if (4 * k4 + 1 < i) a1 -= l[1] * T[4 * k4 + 1];
        if (4 * k4 + 2 < i) a2 -= l[2] * T[4 * k4 + 2];
        if (4 * k4 + 3 < i) a3 -= l[3] * T[4 * k4 + 3];
      }
      T[i] = (a0 + a1) + (a2 + a3);
      Tu[i * 72 + lo] = f2bf_hw(T[i] * bm);
      Tw[i * 72 + lo] = f2bf_hw(T[i] * bem);
      asm volatile("" ::: "memory");
    }
  }
  __syncthreads();
#pragma unroll
  for (int rr = 0; rr < 4; ++rr) {
    f32x4 u = {0.f, 0.f, 0.f, 0.f};
    u = prod16<2>(Tu, 72, 16 * rr, VT, 72, 16 * w, u, lane);
    *(f32x4*)(gU + ((w * 4 + rr) * 64 + lane) * 4) = u;
    f32x4 wt = {0.f, 0.f, 0.f, 0.f};
    wt = prod16<2>(KhT, 72, 16 * w, Tw, 72, 16 * rr, wt, lane);
    u32x2 wv; wv.x = pk2(-wt[0], -wt[1]); wv.y = pk2(-wt[2], -wt[3]);
    *(u32x2*)(gA + (size_t)(F_WN + rr * 4 + (w >> 1)) * 1024 + (r16 + 16 * q4) * 16 + (w & 1) * 8) = wv;
  }
#pragma unroll
  for (int it = 0; it < 4; ++it) {
    const int idx = tid + it * 512; const int d = idx >> 4, m4 = idx & 15;
    const u32x2 raw = *(const LAS u32x2*)(KhT + d * 72 + 4 * m4);
    const float k0 = __uint_as_float(raw.x << 16), k1 = __uint_as_float(raw.x & 0xffff0000u), k2 = __uint_as_float(raw.y << 16), k3 = __uint_as_float(raw.y & 0xffff0000u);
    const float e0 = __expf(gl - gcb[4 * m4]), e1 = __expf(gl - gcb[4 * m4 + 1]), e2 = __expf(gl - gcb[4 * m4 + 2]), e3 = __expf(gl - gcb[4 * m4 + 3]);
    u32x2 wv; wv.x = pk2(k0 * e0, k1 * e1); wv.y = pk2(k2 * e2, k3 * e3);
    *(u32x2*)(gA + (size_t)(F_KT + (d >> 4) * 2 + (m4 >> 3)) * 1024 + ((d & 15) + 16 * (m4 & 3)) * 16 + ((m4 >> 2) & 1) * 8) = wv;
  }
  if (tid == 0) p.dnG[ci] = __expf(gl);
}

__global__ __launch_bounds__(512) void k_dn_prep2(Params p) {
  extern __shared__ __attribute__((aligned(16))) unsigned char shm[];
  LAS unsigned char* lds = (LAS unsigned char*)shm;
  bool first = true;
  for (int ci = blockIdx.x; ci < 1024; ci += gridDim.x) { dn_prep_chunk(p, lds, ci, first); first = false; }
}

#define DS_A0 0
#define DS_A1 57344
#define DS_OT 114688
#define DS_TOTAL (114688 + 64 * 132 * 4)
__device__ void dn_scan_bh(const Params& p, LAS unsigned char* lds, int bh) {
  const int tid = threadIdx.x, lane = tid & 63, w = __builtin_amdgcn_readfirstlane(tid >> 6), r16 = lane & 15, q4 = lane >> 4;
  const int b = bh >> 2, h = bh & 3;
  LAS float* Ot = (LAS float*)(lds + DS_OT);
  const unsigned char* gA = (const unsigned char*)p.dnA + (size_t)bh * 64 * DN_ABYTES;
  const float* gU = p.dnU + (size_t)bh * 64 * DN_UFLOATS;
  const float* gG = p.dnG + bh * 64;
  auto issue_A = [&](int n, int buf) {
#pragma unroll
    for (int i = 0; i < 7; ++i) {
      const int f = w * 7 + i;
      __builtin_amdgcn_global_load_lds((const unsigned*)(gA + (size_t)n * DN_ABYTES + f * 1024 + lane * 16), (LAS unsigned*)(lds + (buf ? DS_A1 : DS_A0) + f * 1024), 16, 0, 0);
    }
  };
  auto post = [&](int n) {
    const int row = tid >> 3, seg = tid & 7;
    const size_t t = (size_t)b * SEQ + n * 64 + row;
    float o[16]; float ss = 0.f;
#pragma unroll
    for (int j4 = 0; j4 < 4; ++j4) { const f32x4 v = *(const LAS f32x4*)(Ot + row * 132 + 16 * seg + 4 * j4); o[4 * j4] = v[0]; o[4 * j4 + 1] = v[1]; o[4 * j4 + 2] = v[2]; o[4 * j4 + 3] = v[3]; }
#pragma unroll
    for (int j = 0; j < 16; ++j) ss += o[j] * o[j];
    ss += __shfl_xor(ss, 1, 64); ss += __shfl_xor(ss, 2, 64); ss += __shfl_xor(ss, 4, 64);
    const float rstd = rsqrtf(ss * (1.f / 128.f) + 1e-6f);
    const bf16_t* zp = p.proj + t * PW + C_Z + h * 128 + 16 * seg;
    float z0[8], z1[8]; unpack8(*(const u32x4*)zp, z0); unpack8(*(const u32x4*)(zp + 8), z1);
    float y[16];
#pragma unroll
    for (int j = 0; j < 8; ++j) { y[j] = o[j] * rstd * p.g_dn_out[16 * seg + j] * siluf_(z0[j]); y[8 + j] = o[8 + j] * rstd * p.g_dn_out[16 * seg + 8 + j] * siluf_(z1[j]); }
    u32x4 w0, w1;
    w0.x = pk2(y[0], y[1]); w0.y = pk2(y[2], y[3]); w0.z = pk2(y[4], y[5]); w0.w = pk2(y[6], y[7]);
    w1.x = pk2(y[8], y[9]); w1.y = pk2(y[10], y[11]); w1.z = pk2(y[12], y[13]); w1.w = pk2(y[14], y[15]);
    bf16_t* op = p.dn_out + t * p.dn_out_ld + h * 128 + 16 * seg;
    *(u32x4*)op = w0; *(u32x4*)(op + 8) = w1;
  };
  issue_A(0, 0);
  f32x4 Un[4];
#pragma unroll
  for (int rr = 0; rr < 4; ++rr) Un[rr] = *(const f32x4*)(gU + ((w * 4 + rr) * 64 + lane) * 4);
  f32x4 S[8];
#pragma unroll
  for (int dt = 0; dt < 8; ++dt) S[dt] = (f32x4){0.f, 0.f, 0.f, 0.f};
  asm volatile("s_waitcnt vmcnt(0)" ::: "memory");
  __syncthreads();
#pragma unroll 1
  for (int n = 0; n < 64; ++n) {
    const LAS unsigned char* Ab = lds + ((n & 1) ? DS_A1 : DS_A0);
    if (n + 1 < 64) issue_A(n + 1, (n + 1) & 1);
    f32x4 Vn[4];
#pragma unroll
    for (int rr = 0; rr < 4; ++rr) Vn[rr] = Un[rr];
    if (n + 1 < 64) {
#pragma unroll
      for (int rr = 0; rr < 4; ++rr) Un[rr] = *(const f32x4*)(gU + (size_t)(n + 1) * DN_UFLOATS + ((w * 4 + rr) * 64 + lane) * 4);
    }
    const float gdec = gG[n];
    if (n > 0) post(n - 1);
    bf16x8 Sb[4];
#pragma unroll
    for (int ks = 0; ks < 4; ++ks) Sb[ks] = pack8(S[2 * ks][0], S[2 * ks][1], S[2 * ks][2], S[2 * ks][3], S[2 * ks + 1][0], S[2 * ks + 1][1], S[2 * ks + 1][2], S[2 * ks + 1][3]);
    f32x4 O[4];
#pragma unroll
    for (int rr = 0; rr < 4; ++rr) {
      O[rr] = (f32x4){0.f, 0.f, 0.f, 0.f};
#pragma unroll
      for (int ks = 0; ks < 4; ++ks) {
        const bf16x8 aw = *(const LAS bf16x8*)(Ab + (F_WN + rr * 4 + ks) * 1024 + lane * 16);
        Vn[rr] = MFMA16(aw, Sb[ks], Vn[rr]);
        const bf16x8 aq = *(const LAS bf16x8*)(Ab + (F_QD + rr * 4 + ks) * 1024 + lane * 16);
        O[rr] = MFMA16(aq, Sb[ks], O[rr]);
      }
    }
    bf16x8 Vb[2];
#pragma unroll
    for (int ks = 0; ks < 2; ++ks) Vb[ks] = pack8(Vn[2 * ks][0], Vn[2 * ks][1], Vn[2 * ks][2], Vn[2 * ks][3], Vn[2 * ks + 1][0], Vn[2 * ks + 1][1], Vn[2 * ks + 1][2], Vn[2 * ks + 1][3]);
#pragma unroll
    for (int rr = 0; rr < 4; ++rr)
#pragma unroll
      for (int ks = 0; ks < 2; ++ks) {
        const bf16x8 a = *(const LAS bf16x8*)(Ab + (F_QK + rr * 2 + ks) * 1024 + lane * 16);
        O[rr] = MFMA16(a, Vb[ks], O[rr]);
      }
#pragma unroll
    for (int dt = 0; dt < 8; ++dt) {
      S[dt] *= gdec;
#pragma unroll
      for (int ks = 0; ks < 2; ++ks) {
        const bf16x8 a = *(const LAS bf16x8*)(Ab + (F_KT + dt * 2 + ks) * 1024 + lane * 16);
        S[dt] = MFMA16(a, Vb[ks], S[dt]);
      }
    }
    __syncthreads();
#pragma unroll
    for (int rr = 0; rr < 4; ++rr)
#pragma unroll
      for (int i = 0; i < 4; ++i) Ot[(16 * rr + 4 * q4 + i) * 132 + 16 * w + r16] = O[rr][i];
    asm volatile("s_waitcnt vmcnt(0)" ::: "memory");
    __syncthreads();
  }
  post(63);
  __syncthreads();
}
__global__ __launch_bounds__(512) void k_dn_scan2(Params p) {
  extern __shared__ __attribute__((aligned(16))) unsigned char shm[];
  dn_scan_bh(p, (LAS unsigned char*)shm, blockIdx.x);
}

typedef float f32x16 __attribute__((ext_vector_type(16)));
#define MFMA32(a, b, c) __builtin_amdgcn_mfma_f32_32x32x16_bf16((a), (b), (c), 0, 0, 0)
#define MP_VL 0
#define MP_RED 65536
#define MP_TOTAL (65536 + 4096)

__device__ void moba_prep_block(const Params& p, LAS unsigned char* lds, int item) {
  const int tid = threadIdx.x, lane = tid & 63, w = tid >> 6;
  const int bh = item >> 4, jb = item & 15, b = bh >> 2, h = bh & 3;
  LAS bf16_t* Vl = (LAS bf16_t*)(lds + MP_VL);
  LAS float* red = (LAS float*)(lds + MP_RED);
  __syncthreads();
#pragma unroll
  for (int it = 0; it < 8; ++it) {
    const int idx = tid + 512 * it, row = idx >> 4, ch = idx & 15;
    const u32x4 v = *(const u32x4*)(p.proj + ((size_t)b * SEQ + 256 * jb + row) * PW + C_MV + h * 128 + 8 * ch);
    *(LAS u32x4*)(Vl + row * 128 + 8 * ch) = v;
  }
  {
    const int r = tid >> 1, hh = tid & 1;
    const int pos = 256 * jb + r;
    const size_t t = (size_t)b * SEQ + pos;
    float cs[8], sn[8];
#pragma unroll
    for (int jj = 0; jj < 8; ++jj) {
      const float inv = exp2f(-(float)(8 * hh + jj) * (1.f / 16.f) * 18.931568569324174f);
      const float ang = (float)pos * inv;
      cs[jj] = cosf(ang); sn[jj] = sinf(ang);
    }
    float kacc[64];
#pragma unroll
    for (int which = 0; which < 2; ++which) {
      const bf16_t* src = p.proj + t * PW + (which ? C_MQ : C_MK) + h * 128 + 8 * hh;
      float x0[8], x1[8];
      unpack8(*(const u32x4*)(src), x0); unpack8(*(const u32x4*)(src + 16), x1);
      float y0[8], y1[8];
#pragma unroll
      for (int jj = 0; jj < 8; ++jj) { y0[jj] = x0[jj] * cs[jj] - x1[jj] * sn[jj]; y1[jj] = x1[jj] * cs[jj] + x0[jj] * sn[jj]; }
      u32x4 o[8];
      o[0].x = pk2(y0[0], y0[1]); o[0].y = pk2(y0[2], y0[3]); o[0].z = pk2(y0[4], y0[5]); o[0].w = pk2(y0[6], y0[7]);
      o[1].x = pk2(y1[0], y1[1]); o[1].y = pk2(y1[2], y1[3]); o[1].z = pk2(y1[4], y1[5]); o[1].w = pk2(y1[6], y1[7]);
#pragma unroll
      for (int ks = 2; ks < 8; ++ks) o[ks] = *(const u32x4*)(src + 16 * ks);
      if (which == 0) {
#pragma unroll
        for (int jj = 0; jj < 8; ++jj) { kacc[jj] = y0[jj]; kacc[8 + jj] = y1[jj]; }
#pragma unroll
        for (int ks = 2; ks < 8; ++ks) { float f[8]; unpack8(o[ks], f);
#pragma unroll
          for (int jj = 0; jj < 8; ++jj) kacc[8 * ks + jj] = f[jj]; }
        unsigned char* dst = (unsigned char*)p.Kp + ((size_t)(bh * 128 + 8 * jb + (r >> 5)) * 8192) + ((r & 31) + 32 * hh) * 16;
#pragma unroll
        for (int ks = 0; ks < 8; ++ks) *(u32x4*)(dst + ks * 1024) = o[ks];
      } else {
        bf16_t* dst = p.qb + ((size_t)bh * SEQ + pos) * 128 + 8 * hh;
#pragma unroll
        for (int ks = 0; ks < 8; ++ks) *(u32x4*)(dst + 16 * ks) = o[ks];
      }
    }
#pragma unroll
    for (int e = 0; e < 64; ++e) {
      float v = kacc[e];
      v += __shfl_xor(v, 2, 64); v += __shfl_xor(v, 4, 64); v += __shfl_xor(v, 8, 64); v += __shfl_xor(v, 16, 64); v += __shfl_xor(v, 32, 64);
      kacc[e] = v;
    }
    if (lane < 2) {
#pragma unroll
      for (int e = 0; e < 64; ++e) red[(w * 2 + lane) * 64 + e] = kacc[e];
    }
  }
  __syncthreads();
  if (tid < 128) {
    const int d = tid, hh = (d >> 3) & 1, ks = d >> 4, jj = d & 7;
    float a = 0.f;
#pragma unroll
    for (int ww = 0; ww < 8; ++ww) a += red[(ww * 2 + hh) * 64 + ks * 8 + jj];
    p.kmean[((size_t)bh * 16 + jb) * 128 + d] = a * (1.f / 256.f);
  }
#pragma unroll
  for (int it = 0; it < 8; ++it) {
    const int o = tid + 512 * it, ln = o & 63, frag = o >> 6, tl = frag >> 3, dt = (frag >> 1) & 3, s = frag & 1;
    const int r = ln & 31, hh = ln >> 5, d = 32 * dt + r;
    unsigned short e[8];
#pragma unroll
    for (int jj = 0; jj < 8; ++jj) { const int key = 32 * tl + 16 * s + 8 * (jj >> 2) + 4 * hh + (jj & 3); e[jj] = Vl[key * 128 + d]; }
    u32x4 wv; wv.x = e[0] | ((unsigned)e[1] << 16); wv.y = e[2] | ((unsigned)e[3] << 16); wv.z = e[4] | ((unsigned)e[5] << 16); wv.w = e[6] | ((unsigned)e[7] << 16);
    *(u32x4*)((unsigned char*)p.Vp + ((size_t)(bh * 128 + 8 * jb + tl) * 8192) + (dt * 2 + s) * 1024 + ln * 16) = wv;
  }
}
__global__ __launch_bounds__(512) void k_moba_prep(Params p) {
  extern __shared__ __attribute__((aligned(16))) unsigned char shm[];
  for (int item = blockIdx.x; item < 256; item += gridDim.x) moba_prep_block(p, (LAS unsigned char*)shm, item);
}

__device__ __forceinline__ int crow32(int reg, int hh) { return (reg & 3) + 8 * (reg >> 2) + 4 * hh; }
__device__ void moba_item(const Params& p, LAS float* km, int bh, int ib, int sub, int lane) {
  const int q = lane & 31, hh = lane >> 5;
  const int b = bh >> 2, h = bh & 3;
  const int s0 = 256 * ib + 32 * sub;
  const bf16_t* qrow = p.qb + ((size_t)bh * SEQ + s0 + q) * 128 + 8 * hh;
  bf16x8 Qf[8];
#pragma unroll
  for (int ks = 0; ks < 8; ++ks) Qf[ks] = *(const bf16x8*)(qrow + 16 * ks);
  unsigned selmask = 0;
  if (ib > 0) {
    for (int idx = lane; idx < ib * 32; idx += 64) ((LAS f32x4*)km)[idx] = ((const f32x4*)(p.kmean + (size_t)bh * 16 * 128))[idx];
    float qf[64];
#pragma unroll
    for (int ks = 0; ks < 8; ++ks) { float f[8]; unpack8(__builtin_bit_cast(u32x4, Qf[ks]), f);
#pragma unroll
      for (int jj = 0; jj < 8; ++jj) qf[8 * ks + jj] = f[jj]; }
    float sc[16];
#pragma unroll
    for (int j = 0; j < 16; ++j) {
      sc[j] = -INFINITY;
      if (j < ib) {
        float a = 0.f;
#pragma unroll
        for (int ks = 0; ks < 8; ++ks) {
          const f32x4 k0 = *(const LAS f32x4*)(km + j * 128 + 16 * ks + 8 * hh), k1 = *(const LAS f32x4*)(km + j * 128 + 16 * ks + 8 * hh + 4);
          a += qf[8 * ks] * k0[0] + qf[8 * ks + 1] * k0[1] + qf[8 * ks + 2] * k0[2] + qf[8 * ks + 3] * k0[3];
          a += qf[8 * ks + 4] * k1[0] + qf[8 * ks + 5] * k1[1] + qf[8 * ks + 6] * k1[2] + qf[8 * ks + 7] * k1[3];
        }
        a += __shfl_xor(a, 32, 64);
        sc[j] = a;
      }
    }
#pragma unroll
    for (int r = 0; r < 3; ++r) {
      if (r < ib) {
        float best = -INFINITY; int bi = 0;
#pragma unroll
        for (int j = 0; j < 16; ++j) if (sc[j] > best) { best = sc[j]; bi = j; }
        selmask |= 1u << bi;
#pragma unroll
        for (int j = 0; j < 16; ++j) if (j == bi) sc[j] = -INFINITY;
      }
    }
  }
  const float cscale = 0.08838834764831845f * 1.4426950408889634f;
  float m = -1e30f, l = 0.f;
  f32x16 O[4];
#pragma unroll
  for (int dt = 0; dt < 4; ++dt)
#pragma unroll
    for (int r = 0; r < 16; ++r) O[dt][r] = 0.f;
  const unsigned char* kbase = (const unsigned char*)p.Kp + (size_t)bh * 128 * 8192 + lane * 16;
  const unsigned char* vbase = (const unsigned char*)p.Vp + (size_t)bh * 128 * 8192 + lane * 16;
  auto tile = [&](int kt, int mode, bool selbit) {
    bf16x8 Kf[8], Vf[8];
#pragma unroll
    for (int ks = 0; ks < 8; ++ks) Kf[ks] = *(const bf16x8*)(kbase + (size_t)kt * 8192 + ks * 1024);
#pragma unroll
    for (int f = 0; f < 8; ++f) Vf[f] = *(const bf16x8*)(vbase + (size_t)kt * 8192 + f * 1024);
    f32x16 S;
#pragma unroll
    for (int r = 0; r < 16; ++r) S[r] = 0.f;
#pragma unroll
    for (int ks = 0; ks < 8; ++ks) S = MFMA32(Kf[ks], Qf[ks], S);
    float sv[16]; float mx = -INFINITY;
#pragma unroll
    for (int r = 0; r < 16; ++r) {
      float v = S[r] * cscale;
      if (mode == 1 && crow32(r, hh) > q) v = -INFINITY;
      if (mode == 2 && !selbit) v = -INFINITY;
      sv[r] = v; mx = fmaxf(mx, v);
    }
    mx = fmaxf(mx, __shfl_xor(mx, 32, 64));
    const float mn = fmaxf(m, mx);
    const float alpha = exp2f(m - mn);
    float ps = 0.f;
#pragma unroll
    for (int r = 0; r < 16; ++r) { sv[r] = exp2f(sv[r] - mn); ps += sv[r]; }
    l = l * alpha + ps; m = mn;
    if (__ballot(alpha != 1.f) != 0ull) {
#pragma unroll
      for (int dt = 0; dt < 4; ++dt)
#pragma unroll
        for (int r = 0; r < 16; ++r) O[dt][r] *= alpha;
    }
    const bf16x8 P0 = pack8(sv[0], sv[1], sv[2], sv[3], sv[4], sv[5], sv[6], sv[7]);
    const bf16x8 P1 = pack8(sv[8], sv[9], sv[10], sv[11], sv[12], sv[13], sv[14], sv[15]);
#pragma unroll
    for (int dt = 0; dt < 4; ++dt) { O[dt] = MFMA32(Vf[dt * 2], P0, O[dt]); O[dt] = MFMA32(Vf[dt * 2 + 1], P1, O[dt]); }
  };
  for (int tl = 0; tl < sub; ++tl) tile(8 * ib + tl, 0, true);
  tile(8 * ib + sub, 1, true);
  for (int j = 0; j < ib; ++j) {
    const bool sb = (selmask >> j) & 1u;
    if (__ballot(sb) != 0ull) {
#pragma unroll 1
      for (int tl = 0; tl < 8; ++tl) tile(8 * j + tl, 2, sb);
    }
  }
  l += __shfl_xor(l, 32, 64);
  const float inv = 1.f / l;
  bf16_t* orow = p.mb_out + ((size_t)b * SEQ + s0 + q) * p.mb_out_ld + p.mb_out_off + h * 128;
#pragma unroll
  for (int dt = 0; dt < 4; ++dt)
#pragma unroll
    for (int g4 = 0; g4 < 4; ++g4) {
      u32x2 wv; wv.x = pk2(O[dt][4 * g4] * inv, O[dt][4 * g4 + 1] * inv); wv.y = pk2(O[dt][4 * g4 + 2] * inv, O[dt][4 * g4 + 3] * inv);
      *(u32x2*)(orow + 32 * dt + 8 * g4 + 4 * hh) = wv;
    }
}
__device__ void moba_worker(const Params& p, LAS unsigned char* lds) {
  const int lane = threadIdx.x & 63, w = threadIdx.x >> 6;
  LAS float* km = (LAS float*)(lds + w * 8192);
  for (;;) {
    int idx = 0;
    if (lane == 0) idx = atomicAdd(p.wq, 1);
    idx = __builtin_amdgcn_readfirstlane(idx);
    if (idx >= 2048) break;
    const int ib = 15 - (idx >> 7), rem = idx & 127, bh = rem >> 3, sub = 7 - (rem & 7);
    moba_item(p, km, bh, ib, sub, lane);
  }
}
__global__ __launch_bounds__(512) void k_moba2(Params p) {
  extern __shared__ __attribute__((aligned(16))) unsigned char shm[];
  moba_worker(p, (LAS unsigned char*)shm);
}

__global__ __launch_bounds__(256) void k_cmp(const bf16_t* a, int lda, const bf16_t* b, int ldb, int rows, int cols, float* stats) {
  float d2 = 0.f, r2 = 0.f;
  for (size_t i = (size_t)blockIdx.x * 256 + threadIdx.x; i < (size_t)rows * cols; i += (size_t)gridDim.x * 256) {
    size_t r = i / cols, c = i % cols;
    float x = bf2f(a[r * lda + c]), y = bf2f(b[r * ldb + c]);
    if (!(x - x == 0.f)) x = 1e4f;
    d2 += (x - y) * (x - y); r2 += y * y;
  }
  d2 = wave_sum(d2); r2 = wave_sum(r2);
  if ((threadIdx.x & 63) == 0) { atomicAdd(stats, d2); atomicAdd(stats + 1, r2); }
}
__global__ __launch_bounds__(256) void k_perturb(float* out, size_t n, const float* stats) {
  float rel = sqrtf(stats[0] / fmaxf(stats[1], 1e-30f));
  if (!(rel <= 0.02f)) {
    if (!(rel < 1e6f)) rel = 1e6f;
    for (size_t i = (size_t)blockIdx.x * 256 + threadIdx.x; i < n; i += (size_t)gridDim.x * 256) out[i] += 10.f * rel;
  }
}
__global__ __launch_bounds__(128) void k_dn_prep(Params p) {
  int t = blockIdx.x >> 2, h = blockIdx.x & 3;
  int b = t / SEQ, s = t % SEQ;
  int d = threadIdx.x;
  __shared__ float red[2][2];
  float val[3];
#pragma unroll
  for (int part = 0; part < 3; ++part) {
    int ch = part * 512 + h * 128 + d;
    float a = 0.f;
#pragma unroll
    for (int i = 0; i < 4; ++i) {
      int ss = s - 3 + i;
      if (ss >= 0) a += p.conv_w[i * 1536 + ch] * bf2f(p.proj[(size_t)(b * SEQ + ss) * PW + ch]);
    }
    val[part] = siluf_(a);
  }
  float sq = wave_sum(val[0] * val[0]), sk = wave_sum(val[1] * val[1]);
  int wid = d >> 6;
  if ((d & 63) == 0) { red[0][wid] = sq; red[1][wid] = sk; }
  __syncthreads();
  sq = red[0][0] + red[0][1]; sk = red[1][0] + red[1][1];
  size_t o = (((size_t)b * 4 + h) * SEQ + s) * 128 + d;
  p.nq[o] = val[0] * rsqrtf(sq + 1e-6f);
  p.nk[o] = val[1] * rsqrtf(sk + 1e-6f);
  p.nv[o] = val[2];
  if (d == 0) {
    float bb = p.ba[(size_t)t * 8 + h], aa = p.ba[(size_t)t * 8 + 4 + h];
    float xx = aa + p.dt_bias[h];
    float sp = xx > 20.f ? xx : log1pf(__expf(xx));
    size_t o2 = ((size_t)b * 4 + h) * SEQ + s;
    p.nbeta[o2] = sigmoidf_(bb);
    p.ng[o2] = -__expf(p.a_log[h]) * sp;
  }
}
__global__ __launch_bounds__(128) void k_dn_scan(Params p) {
  int bh = blockIdx.x;
  int e = threadIdx.x;
  __shared__ float sk[2][128], sq[2][128];
  float S[128];
#pragma unroll
  for (int d = 0; d < 128; ++d) S[d] = 0.f;
  const float* q = p.nq + (size_t)bh * SEQ * 128;
  const float* k = p.nk + (size_t)bh * SEQ * 128;
  const float* v = p.nv + (size_t)bh * SEQ * 128;
  float* o = p.no + (size_t)bh * SEQ * 128;
  const float scale = 0.08838834764831845f;
  for (int s = 0; s < SEQ; ++s) {
    int buf = s & 1;
    sk[buf][e] = k[(size_t)s * 128 + e];
    sq[buf][e] = q[(size_t)s * 128 + e];
    float vt = v[(size_t)s * 128 + e];
    float beta = p.nbeta[(size_t)bh * SEQ + s];
    float dec = __expf(p.ng[(size_t)bh * SEQ + s]);
    __syncthreads();
    float ks = 0.f;
#pragma unroll
    for (int d = 0; d < 128; ++d) ks += sk[buf][d] * S[d];
    ks *= dec;
    float vn = beta * (vt - ks);
    float ot = 0.f;
#pragma unroll
    for (int d = 0; d < 128; ++d) {
      S[d] = dec * S[d] + sk[buf][d] * vn;
      ot += sq[buf][d] * S[d];
    }
    o[(size_t)s * 128 + e] = ot * scale;
  }
}
__global__ __launch_bounds__(128) void k_dn_post(Params p) {
  int t = blockIdx.x >> 2, h = blockIdx.x & 3;
  int b = t / SEQ, s = t % SEQ;
  int d = threadIdx.x;
  __shared__ float red[2];
  float ov = p.no[(((size_t)b * 4 + h) * SEQ + s) * 128 + d];
  float ss = wave_sum(ov * ov);
  if ((d & 63) == 0) red[d >> 6] = ss;
  __syncthreads();
  ss = red[0] + red[1];
  float y = ov * rsqrtf(ss * (1.f / 128) + 1e-6f) * p.g_dn_out[d];
  float z = bf2f(p.proj[(size_t)t * PW + C_Z + h * 128 + d]);
  p.oab[(size_t)t * DM + h * 128 + d] = f2bf(y * siluf_(z));
}

__global__ __launch_bounds__(128) void k_rope(Params p) {
  int t = blockIdx.x >> 2, h = blockIdx.x & 3;
  int b = t / SEQ, s = t % SEQ;
  int d = threadIdx.x;
  const bf16_t* qr = p.proj + (size_t)t * PW + C_MQ + h * 128;
  const bf16_t* kr = p.proj + (size_t)t * PW + C_MK + h * 128;
  float qv = bf2f(qr[d]), kv = bf2f(kr[d]);
  if (d < 32) {
    int i = d & 15;
    float inv = exp2f(-(float)i * (1.f / 16.f) * 18.931568569324174f);
    float ang = (float)s * inv;
    float cs = cosf(ang), sn = sinf(ang);
    float qo = bf2f(qr[d ^ 16]), ko = bf2f(kr[d ^ 16]);
    if (d < 16) { qv = qv * cs - qo * sn; kv = kv * cs - ko * sn; }
    else        { qv = qv * cs + qo * sn; kv = kv * cs + ko * sn; }
  }
  size_t o = (((size_t)b * 4 + h) * SEQ + s) * 128 + d;
  p.qb[o] = f2bf(qv);
  p.kb[o] = f2bf(kv);
}
__global__ __launch_bounds__(128) void k_kmean(Params p) {
  int bhj = blockIdx.x;
  int d = threadIdx.x;
  const bf16_t* kr = p.kb + (size_t)bhj * 256 * 128;
  float a = 0.f;
  for (int i = 0; i < 256; ++i) a += bf2f(kr[(size_t)i * 128 + d]);
  p.kmean[(size_t)bhj * 128 + d] = a * (1.f / 256.f);
}
__global__ __launch_bounds__(256) void k_moba(Params p) {
  __shared__ float sqv[4][128];
  __shared__ float sp[4][1024];
  int wid = threadIdx.x >> 6, lane = threadIdx.x & 63;
  int gq = blockIdx.x * 4 + wid;
  int bh = gq / SEQ, s = gq % SEQ;
  int b = bh >> 2, h = bh & 3;
  int qblk = s >> 8;
  const bf16_t* qr = p.qb + (size_t)gq * 128;
  sqv[wid][lane] = bf2f(qr[lane]);
  sqv[wid][lane + 64] = bf2f(qr[lane + 64]);
  __syncthreads();
  float sc = -INFINITY;
  if (lane < qblk) {
    const float* km = p.kmean + ((size_t)bh * 16 + lane) * 128;
    float a = 0.f;
    for (int d = 0; d < 128; ++d) a += sqv[wid][d] * km[d];
    sc = a;
  }
  int sel[4];
#pragma unroll
  for (int r = 0; r < 3; ++r) {
    float m = wave_max(sc);
    unsigned long long bal = __ballot(sc == m);
    int idx = __ffsll((long long)bal) - 1;
    sel[r] = (m == -INFINITY) ? -1 : idx;
    if (lane == idx) sc = -INFINITY;
  }
  sel[3] = qblk;
  const float scale = 0.08838834764831845f;
  const bf16_t* kbase = p.kb + (size_t)bh * SEQ * 128;
  float lmax = -INFINITY;
#pragma unroll
  for (int j = 0; j < 4; ++j) {
    int blk = sel[j];
    if (blk < 0) continue;
    for (int i = 0; i < 4; ++i) {
      int kk = i * 64 + lane;
      int kpos = blk * 256 + kk;
      float lg = -INFINITY;
      if (kpos <= s) {
        const bf16_t* kr = kbase + (size_t)kpos * 128;
        float a = 0.f;
        for (int d8 = 0; d8 < 16; ++d8) {
          uint4 u = *(const uint4*)(kr + d8 * 8);
          unsigned w[4] = {u.x, u.y, u.z, u.w};
#pragma unroll
          for (int e = 0; e < 4; ++e) {
            a += sqv[wid][d8 * 8 + 2 * e] * __uint_as_float(w[e] << 16);
            a += sqv[wid][d8 * 8 + 2 * e + 1] * __uint_as_float(w[e] & 0xffff0000u);
          }
        }
        lg = a * scale;
      }
      sp[wid][j * 256 + kk] = lg;
      lmax = fmaxf(lmax, lg);
    }
  }
  lmax = wave_max(lmax);
  float lsum = 0.f;
#pragma unroll
  for (int j = 0; j < 4; ++j) {
    if (sel[j] < 0) continue;
    for (int i = 0; i < 4; ++i) {
      int idx = j * 256 + i * 64 + lane;
      float e = __expf(sp[wid][idx] - lmax);
      sp[wid][idx] = e;
      lsum += e;
    }
  }
  lsum = wave_sum(lsum);
  __syncthreads();
  float o0 = 0.f, o1 = 0.f;
#pragma unroll
  for (int j = 0; j < 4; ++j) {
    int blk = sel[j];
    if (blk < 0) continue;
    const bf16_t* vb = p.proj + (size_t)(b * SEQ + blk * 256) * PW + C_MV + h * 128;
    int nk = (blk == qblk) ? (s - blk * 256 + 1) : 256;
    for (int kk = 0; kk < nk; ++kk) {
      float pr = sp[wid][j * 256 + kk];
      o0 += pr * bf2f(vb[(size_t)kk * PW + lane]);
      o1 += pr * bf2f(vb[(size_t)kk * PW + lane + 64]);
    }
  }
  float inv = 1.f / lsum;
  int t = b * SEQ + s;
  p.oab[(size_t)t * DM + 512 + h * 128 + lane] = f2bf(o0 * inv);
  p.oab[(size_t)t * DM + 512 + h * 128 + lane + 64] = f2bf(o1 * inv);
}

__global__ __launch_bounds__(256) void k_post_mix(Params p) {
  __shared__ float sh[4][1024];
  int wid = threadIdx.x >> 6, lane = threadIdx.x & 63;
  int t = blockIdx.x * 4 + wid;
  int b = t / SEQ;
  const float* md = p.mod + b * 6144;
  float mv[16];
  float ss = 0.f;
#pragma unroll
  for (int i = 0; i < 16; ++i) {
    int k = i * 64 + lane;
    mv[i] = bf2f(p.mixer[(size_t)t * DM + k]);
    ss += mv[i] * mv[i];
  }
  ss = wave_sum(ss);
  float rstd = rsqrtf(ss * (1.f / DM) + 1e-6f);
  float x1[16];
  float s2 = 0.f;
#pragma unroll
  for (int i = 0; i < 16; ++i) {
    int k = i * 64 + lane;
    x1[i] = p.x[(size_t)t * DM + k] + md[2048 + k] * (mv[i] * rstd * p.g_post_mix[k]);
    p.out[(size_t)t * DM + k] = x1[i];
    s2 += x1[i] * x1[i];
  }
  s2 = wave_sum(s2);
  float rstd2 = rsqrtf(s2 * (1.f / DM) + 1e-6f);
#pragma unroll
  for (int i = 0; i < 16; ++i) {
    int k = i * 64 + lane;
    float hv = x1[i] * rstd2 * p.g_pre_ffn[k] * (1.f + md[4096 + k]) + md[3072 + k];
    p.h2[(size_t)t * DM + k] = f2bf(hv);
    sh[wid][k] = hv;
  }
  __syncthreads();
  int e = lane & 31, half = lane >> 5;
  float a = 0.f;
  for (int k = half * 512; k < half * 512 + 512; ++k) a += sh[wid][k] * p.w_router[(size_t)k * 32 + e];
  a += __shfl_xor(a, 32, 64);
  float lg = a + p.b_router[e];
  if (lane >= 32) lg = -INFINITY;
  float tv[4]; int ti[4];
#pragma unroll
  for (int r = 0; r < 4; ++r) {
    float m = wave_max(lg);
    unsigned long long bal = __ballot(lg == m);
    int idx = __ffsll((long long)bal) - 1;
    tv[r] = m; ti[r] = idx;
    if (lane == idx) lg = -INFINITY;
  }
  float e0 = 1.f, e1 = __expf(tv[1] - tv[0]), e2 = __expf(tv[2] - tv[0]), e3 = __expf(tv[3] - tv[0]);
  float inv = 1.f / (e0 + e1 + e2 + e3);
  if (lane < 4) {
    int ee = lane == 0 ? ti[0] : lane == 1 ? ti[1] : lane == 2 ? ti[2] : ti[3];
    float ww = (lane == 0 ? e0 : lane == 1 ? e1 : lane == 2 ? e2 : e3) * inv;
    int pos = atomicAdd(&p.cnt[ee], 1);
    p.elist[ee * T_TOK + pos] = t * 4 + lane;
    p.aw[t * 4 + lane] = ww;
  }
}

__global__ __launch_bounds__(256) void k_gather(Params p) {
  int wid = threadIdx.x >> 6, lane = threadIdx.x & 63;
  int r = blockIdx.x * 4 + wid;
  int off = 0, e = -1, i = 0, ce = 0;
  for (int k = 0; k < NE; ++k) {
    int c = p.cnt[k]; int padc = ((c + 255) >> 8) << 8;
    if (e < 0 && r < off + padc) { e = k; i = r - off; ce = c; }
    off += padc;
  }
  if (e < 0) return;
  int a = (i < ce) ? p.elist[e * T_TOK + i] : -1;
  if (lane == 0) p.rowmap[r] = a;
  uint4 v0 = make_uint4(0, 0, 0, 0), v1 = v0;
  if (a >= 0) {
    const uint4* src = (const uint4*)(p.h2 + (size_t)(a >> 2) * DM);
    v0 = src[lane]; v1 = src[64 + lane];
  }
  uint4* dst = (uint4*)(p.xs + (size_t)r * DM);
  dst[lane] = v0; dst[64 + lane] = v1;
}
__global__ __launch_bounds__(256) void k_final(Params p) {
  int wid = threadIdx.x >> 6, lane = threadIdx.x & 63;
  int t = blockIdx.x * 4 + wid;
  int b = t / SEQ;
  const float* md = p.mod + b * 6144;
  float w0 = p.aw[t * 4], w1 = p.aw[t * 4 + 1], w2 = p.aw[t * 4 + 2], w3 = p.aw[t * 4 + 3];
  float mv[16];
  float ss = 0.f;
#pragma unroll
  for (int i = 0; i < 16; ++i) {
    int k = i * 64 + lane;
    const bf16_t* y = p.yslot + (size_t)t * 4 * DM + k;
    mv[i] = w0 * bf2f(y[0]) + w1 * bf2f(y[DM]) + w2 * bf2f(y[2 * DM]) + w3 * bf2f(y[3 * DM]);
    ss += mv[i] * mv[i];
  }
  ss = wave_sum(ss);
  float rstd = rsqrtf(ss * (1.f / DM) + 1e-6f);
#pragma unroll
  for (int i = 0; i < 16; ++i) {
    int k = i * 64 + lane;
    p.out[(size_t)t * DM + k] = p.out[(size_t)t * DM + k] + md[5120 + k] * (mv[i] * rstd * p.g_post_ffn[k]);
  }
}

static inline size_t al(size_t x) { return (x + 255) & ~(size_t)255; }

extern "C" void kernel_launch(void* const* d_in, const int* in_sizes, int n_in, void* d_out, int out_size, void* d_ws,
                              size_t ws_size, hipStream_t stream) {
  Params p{};
  p.x = (const float*)d_in[0]; p.c = (const float*)d_in[1]; p.w_ada = (const float*)d_in[2]; p.b_ada = (const float*)d_in[3];
  p.g_pre_mix = (const float*)d_in[4]; p.g_post_mix = (const float*)d_in[5]; p.g_pre_ffn = (const float*)d_in[6];
  p.g_post_ffn = (const float*)d_in[7]; p.w_in = (const float*)d_in[8]; p.conv_w = (const float*)d_in[9];
  p.a_log = (const float*)d_in[10]; p.dt_bias = (const float*)d_in[11]; p.g_dn_out = (const float*)d_in[12];
  p.w_br_a = (const float*)d_in[13]; p.w_br_b = (const float*)d_in[14]; p.w_o = (const float*)d_in[15];
  p.w_router = (const float*)d_in[16]; p.b_router = (const float*)d_in[17]; p.w_gu = (const float*)d_in[18];
  p.b_gu = (const float*)d_in[19]; p.w_down = (const float*)d_in[20]; p.b_down = (const float*)d_in[21];
  p.out = (float*)d_out;
  char* w = (char*)d_ws;
  size_t o = 0;
  auto take = [&](size_t bytes) { char* r = w + o; o += al(bytes); return r; };
  p.mod = (float*)take(4 * 6144 * 4);
  p.cnt = (int*)take(256);
  p.ba = (float*)take((size_t)T_TOK * 8 * 4);
  p.hbf = (bf16_t*)take((size_t)T_TOK * DM * 2);
  p.proj = (bf16_t*)take((size_t)T_TOK * PW * 2);
  p.w_in_t = (bf16_t*)take((size_t)PW * DM * 2);
  p.wgu_t = (bf16_t*)take((size_t)NE * 2048 * DM * 2);
  p.wd_t = (bf16_t*)take((size_t)NE * 1024 * DM * 2);
  p.wbra_t = (bf16_t*)take((size_t)1024 * 512 * 2);
  p.wbrb_t = (bf16_t*)take((size_t)1024 * 512 * 2);
  p.wo_t = (bf16_t*)take((size_t)1024 * 1024 * 2);
  p.qb = (bf16_t*)take((size_t)T_TOK * 512 * 2);
  p.kb = (bf16_t*)take((size_t)T_TOK * 512 * 2);
  p.kmean = (float*)take((size_t)16 * 16 * 128 * 4);
  p.oab = (bf16_t*)take((size_t)T_TOK * DM * 2);
  p.merged = (bf16_t*)take((size_t)T_TOK * DM * 2);
  p.mixer = (bf16_t*)take((size_t)T_TOK * DM * 2);
  p.h2 = (bf16_t*)take((size_t)T_TOK * DM * 2);
  p.elist = (int*)take((size_t)NE * T_TOK * 4);
  p.aw = (float*)take((size_t)T_TOK * 4 * 4);
  p.rowmap = (int*)take((size_t)73728 * 4);
  p.dnA = (unsigned char*)take((size_t)1024 * DN_ABYTES);
  p.dnU = (float*)take((size_t)1024 * DN_UFLOATS * 4);
  p.dnG = (float*)take(4096);
  p.oab2 = (bf16_t*)take((size_t)T_TOK * 512 * 2);
  p.dbg = (float*)take(256);
  p.dn_out = p.oab; p.dn_out_ld = DM;
  p.Kp = (bf16_t*)take((size_t)16 * 128 * 8192);
  p.Vp = (bf16_t*)take((size_t)16 * 128 * 8192);
  p.wq = p.cnt + 32;
  p.mb_out = p.oab; p.mb_out_ld = DM; p.mb_out_off = 512;
  p.xs = p.proj;
  char* big = take((size_t)73728 * DM * 2 + (size_t)65536 * DM * 2);
  p.act = (bf16_t*)big;
  p.yslot = (bf16_t*)(big + (size_t)73728 * DM * 2);
  {
    char* s = big; size_t so = 0;
    auto t2 = [&](size_t bytes) { char* r = s + so; so += al(bytes); return r; };
    p.nq = (float*)t2((size_t)T_TOK * 512 * 4);
    p.nk = (float*)t2((size_t)T_TOK * 512 * 4);
    p.nv = (float*)t2((size_t)T_TOK * 512 * 4);
    p.no = (float*)t2((size_t)T_TOK * 512 * 4);
    p.ntmp = (float*)t2((size_t)T_TOK * DM * 4);
    p.nbeta = (float*)t2((size_t)T_TOK * 4 * 4);
    p.ng = (float*)t2((size_t)T_TOK * 4 * 4);
  }

  static bool attr_done = false;
  if (!attr_done) {
    (void)hipFuncSetAttribute((const void*)k_gemm<0>, hipFuncAttributeMaxDynamicSharedMemorySize, GEMM_LDS);
    (void)hipFuncSetAttribute((const void*)k_gemm<1>, hipFuncAttributeMaxDynamicSharedMemorySize, GEMM_LDS);
    (void)hipFuncSetAttribute((const void*)k_gemm<2>, hipFuncAttributeMaxDynamicSharedMemorySize, GEMM_LDS);
    (void)hipFuncSetAttribute((const void*)k_gemm<3>, hipFuncAttributeMaxDynamicSharedMemorySize, GEMM_LDS);
    (void)hipFuncSetAttribute((const void*)k_gemm<4>, hipFuncAttributeMaxDynamicSharedMemorySize, GEMM_LDS);
    (void)hipFuncSetAttribute((const void*)k_dn_prep2, hipFuncAttributeMaxDynamicSharedMemorySize, DP_TOTAL);
    (void)hipFuncSetAttribute((const void*)k_dn_scan2, hipFuncAttributeMaxDynamicSharedMemorySize, DS_TOTAL);
    (void)hipFuncSetAttribute((const void*)k_moba_prep, hipFuncAttributeMaxDynamicSharedMemorySize, MP_TOTAL);
    (void)hipFuncSetAttribute((const void*)k_moba2, hipFuncAttributeMaxDynamicSharedMemorySize, 65536);
    attr_done = true;
  }
  (void)hipMemsetAsync(p.cnt, 0, 256, stream);
  (void)hipMemsetAsync(p.dbg, 0, 256, stream);
  k_mod<<<24, 256, 0, stream>>>(p);
  k_wt<<<dim3((INW + 31) / 32, 32, 1), 256, 0, stream>>>(p.w_in, p.w_in_t, 1024, INW, 1, 0, 0);
  k_wt<<<dim3(64, 32, NE), 256, 0, stream>>>(p.w_gu, p.wgu_t, 1024, 2048, 2, (size_t)1024 * 2048, (size_t)2048 * 1024);
  k_wt<<<dim3(32, 32, NE), 256, 0, stream>>>(p.w_down, p.wd_t, 1024, 1024, 0, (size_t)1024 * 1024, (size_t)1024 * 1024);
  k_wt<<<dim3(32, 16, 1), 256, 0, stream>>>(p.w_br_a, p.wbra_t, 512, 1024, 0, 0, 0);
  k_wt<<<dim3(32, 16, 1), 256, 0, stream>>>(p.w_br_b, p.wbrb_t, 512, 1024, 0, 0, 0);
  k_wt<<<dim3(32, 32, 1), 256, 0, stream>>>(p.w_o, p.wo_t, 1024, 1024, 0, 0, 0);
  k_h<<<T_TOK / 4, 256, 0, stream>>>(p);
  k_gemm<0><<<256, 512, GEMM_LDS, stream>>>(p);
  k_dn_prep2<<<256, 512, DP_TOTAL, stream>>>(p);
  k_dn_scan2<<<16, 512, DS_TOTAL, stream>>>(p);
  k_moba_prep<<<256, 512, MP_TOTAL, stream>>>(p);
  k_moba2<<<256, 512, 65536, stream>>>(p);
  k_gemm<1><<<256, 512, GEMM_LDS, stream>>>(p);
  k_gemm<2><<<256, 512, GEMM_LDS, stream>>>(p);
  k_post_mix<<<T_TOK / 4, 256, 0, stream>>>(p);
  k_gather<<<73728 / 4, 256, 0, stream>>>(p);
  k_gemm<3><<<256, 512, GEMM_LDS, stream>>>(p);
  k_gemm<4><<<256, 512, GEMM_LDS, stream>>>(p);
  k_final<<<T_TOK / 4, 256, 0, stream>>>(p);
  k_perturb<<<1024, 256, 0, stream>>>(p.out, (size_t)T_TOK * DM, p.dbg);
}
```

```cpp
#include <hip/hip_runtime.h>
#include <hip/hip_cooperative_groups.h>
#include <cstdio>
namespace cg = cooperative_groups;
#include <stdint.h>

typedef unsigned short bf16_t;

#define T_TOK 16384
#define SEQ 4096
#define NB 4
#define DM 1024
#define INW 5640
#define PW 5632
#define C_QA 0
#define C_KA 512
#define C_VA 1024
#define C_Z 1536
#define C_MQ 2048
#define C_MK 2560
#define C_MV 3072
#define C_GA 3584
#define C_GB 4608
#define NE 32

__device__ __forceinline__ bf16_t f2bf(float f) {
  unsigned u = __float_as_uint(f);
  u += 0x7fffu + ((u >> 16) & 1u);
  return (bf16_t)(u >> 16);
}
__device__ __forceinline__ float bf2f(bf16_t h) { return __uint_as_float(((unsigned)h) << 16); }
__device__ __forceinline__ float sigmoidf_(float x) { return 1.f / (1.f + __expf(-x)); }
__device__ __forceinline__ float siluf_(float x) { return x / (1.f + __expf(-x)); }
__device__ __forceinline__ float wave_sum(float v) {
#pragma unroll
  for (int o = 32; o > 0; o >>= 1) v += __shfl_xor(v, o, 64);
  return v;
}
__device__ __forceinline__ float wave_max(float v) {
#pragma unroll
  for (int o = 32; o > 0; o >>= 1) v = fmaxf(v, __shfl_xor(v, o, 64));
  return v;
}

struct Params {
  const float *x, *c, *w_ada, *b_ada, *g_pre_mix, *g_post_mix, *g_pre_ffn, *g_post_ffn, *w_in, *conv_w,
      *a_log, *dt_bias, *g_dn_out, *w_br_a, *w_br_b, *w_o, *w_router, *b_router, *w_gu, *b_gu, *w_down, *b_down;
  float* out;
  float* mod;
  int* cnt;
  float* ba;
  bf16_t* hbf;
  bf16_t* proj;
  bf16_t* w_in_t;
  bf16_t* wgu_t;
  bf16_t* wd_t;
  bf16_t* wbra_t;
  bf16_t* wbrb_t;
  bf16_t* wo_t;
  bf16_t* qb;
  bf16_t* kb;
  float* kmean;
  bf16_t* oab;
  bf16_t* merged;
  bf16_t* mixer;
  bf16_t* h2;
  int* elist;
  float* aw;
  bf16_t* act;
  bf16_t* xs;
  int* rowmap;
  bf16_t* yslot;
  unsigned char* dnA; float* dnU; float* dnG;
  bf16_t* dn_out; int dn_out_ld;
  bf16_t* oab2; float* dbg;
  bf16_t* Kp; bf16_t* Vp; int* wq;
  bf16_t* mb_out; int mb_out_ld; int mb_out_off;
  float* nq; float* nk; float* nv;
  float* nbeta; float* ng;
  float* no;
  float* ntmp;
};

__device__ __forceinline__ int map_col(int n, int mode) {
  if (mode == 0) return n;
  if (mode == 1) return n < 2048 ? n : (n < 2056 ? -1 : n - 8);
  if (n < 1024) return (n >> 7) * 256 + (n & 127);
  int j = n - 1024;
  return (j >> 7) * 256 + 128 + (j & 127);
}
namespace pg8 {
#define PG8_LAS __attribute__((address_space(3)))
typedef short bf16x8 __attribute__((ext_vector_type(8)));
typedef float f32x4 __attribute__((ext_vector_type(4)));
typedef unsigned u32x4 __attribute__((ext_vector_type(4)));
constexpr int BM = 256, BK = 64, HALF = 128, HTB = HALF * BK * 2, STAGE_BYTES = 8 * HTB, NXCD = 8, WGM = 8;

__host__ __device__ __forceinline__ int lds_byte(int r, int c) { const int st = (r >> 4) * 2 + (c >> 5), rr = r & 15, cc = c & 31, ob = rr * 64 + cc * 2; return st * 1024 + (ob ^ (((ob >> 9) & 1) << 5)); }
__host__ __device__ __forceinline__ void stage_rc(int b, int& R, int& C) { const int st = b / 1024, sb = b % 1024, swz = sb ^ (((sb >> 9) & 1) << 5); R = (st >> 1) * 16 + swz / 64; C = (st & 1) * 32 + (swz % 64) / 2; }
__host__ __device__ __forceinline__ int perm32(int rho) { const int n = rho >> 4, i = rho & 15; return 8 * (i >> 2) + 4 * n + (i & 3); }

struct Unit { int pm, pn, z; };
__device__ __forceinline__ unsigned cvt_pk_bf16(float lo, float hi) { unsigned r; asm volatile("v_cvt_pk_bf16_f32 %0, %1, %2" : "=v"(r) : "v"(lo), "v"(hi)); return r; }

struct TileOrder {
    int nM, nN, nwg, G, c;
    __device__ void init(int nM_, int nN_, int G_, int c_) { nM = nM_; nN = nN_; nwg = nM * nN; G = G_; c = c_; }
    __device__ bool tile(int i, int& pm, int& pn) const {
        const long L = (long)i * G + c; if (L >= nwg) return false;
        int wgid = (int)L; { const int q = nwg / NXCD, r = nwg % NXCD, xcd = wgid % NXCD, off = wgid / NXCD; wgid = (xcd < r ? xcd * (q + 1) : r * (q + 1) + (xcd - r) * q) + off; }
        const int nig = WGM * nN, gid = wgid / nig, fm = gid * WGM, gsz = (nM - fm) < WGM ? (nM - fm) : WGM;
        pm = fm + ((wgid % nig) % gsz); pn = (wgid % nig) / gsz; return true;
    }
};

template <class Epi, class Sched>
__device__ __forceinline__ void gemm_phase(PG8_LAS unsigned char* lds, const int lda, const int ldb, const int K, const Sched& S, const Epi& E) {
    const int tid = threadIdx.x, wid = __builtin_amdgcn_readfirstlane(tid >> 6), lane = tid & 63, wr = wid >> 2, wc = wid & 3, fr = lane & 15, fq = lane >> 4;
    const int nt = K / BK;
    unsigned voffA[2], voffB[2];
#pragma unroll
    for (int i = 0; i < 2; ++i) { int R, C; stage_rc(tid * 16 + i * 8192, R, C); const int Rb = Epi::PERM ? ((R & ~31) + perm32(R & 31)) : R;
        voffA[i] = (unsigned)(R * lda + C) * 2u; voffB[i] = (unsigned)(Rb * ldb + C) * 2u; }
    const size_t kstep = (size_t)(BK * 2);
    const size_t hstepA = (size_t)HALF * lda * 2, hstepB = (size_t)HALF * ldb * 2;
    const unsigned ldsw = (unsigned)wid * 1024u;
    const int aoff = lds_byte(wr * 64 + fr, fq * 8), boff = lds_byte(wc * 32 + fr, fq * 8);
#define PG8_SA(b, h) (((b) * 2 + (h)) * HTB)
#define PG8_SB(b, h) ((4 + (b) * 2 + (h)) * HTB)
#define PG8_STAGE(bufoff, gbase, voff) do { _Pragma("unroll") for (int _i = 0; _i < 2; ++_i) \
        __builtin_amdgcn_global_load_lds((const unsigned*)((const char*)(gbase) + (voff)[_i]), (PG8_LAS unsigned*)(lds + (bufoff) + ldsw + _i * 8192), 16, 0, 0); } while (0)
#define PG8_LDA(dst, b, h) do { _Pragma("unroll") for (int m = 0; m < 4; ++m) _Pragma("unroll") for (int k = 0; k < 2; ++k) dst[m][k] = *(const PG8_LAS bf16x8*)(lds + PG8_SA(b, h) + aoff + m * 2048 + k * 1024); } while (0)
#define PG8_LDB(dst, b, h) do { _Pragma("unroll") for (int n = 0; n < 2; ++n) _Pragma("unroll") for (int k = 0; k < 2; ++k) dst[n][k] = *(const PG8_LAS bf16x8*)(lds + PG8_SB(b, h) + boff + n * 2048 + k * 1024); } while (0)
#define PG8_MMA(ai, bj, At, Bt) do { __builtin_amdgcn_s_setprio(1); _Pragma("unroll") for (int m = 0; m < 4; ++m) _Pragma("unroll") for (int n = 0; n < 2; ++n) _Pragma("unroll") for (int k = 0; k < 2; ++k) \
        acc[ai][bj][m][n] = __builtin_amdgcn_mfma_f32_16x16x32_bf16(Bt[n][k], At[m][k], acc[ai][bj][m][n], 0, 0, 0); __builtin_amdgcn_s_setprio(0); } while (0)
#define PG8_WAIT_V(n) asm volatile("s_waitcnt vmcnt(" #n ")" ::: "memory")
#define PG8_WAIT_L(n) asm volatile("s_waitcnt lgkmcnt(" #n ")" ::: "memory")
#define PG8_BAR __builtin_amdgcn_s_barrier()
#define PG8_SCHED __builtin_amdgcn_sched_barrier(0)
    Unit cur, nxt; int ui = 0;
    if (!S.next(0, cur)) return;
    f32x4 acc[2][2][4][2];
#pragma unroll
    for (int a = 0; a < 2; ++a)
#pragma unroll
        for (int b = 0; b < 2; ++b)
#pragma unroll
            for (int m = 0; m < 4; ++m)
#pragma unroll
                for (int n = 0; n < 2; ++n) acc[a][b][m][n] = (f32x4){0.f, 0.f, 0.f, 0.f};
    bf16x8 At[4][2], B0[2][2], B1[2][2];
    const char* cA = S.a_ptr(cur); const char* cB = S.b_ptr(cur);
    PG8_STAGE(PG8_SB(0, 0), cB, voffB); PG8_STAGE(PG8_SA(0, 0), cA, voffA); PG8_STAGE(PG8_SB(0, 1), cB + hstepB, voffB); PG8_STAGE(PG8_SA(0, 1), cA + hstepA, voffA);
    if (wr == 1) PG8_BAR;
    PG8_WAIT_V(4); PG8_BAR;
    PG8_STAGE(PG8_SB(1, 0), cB + kstep, voffB); PG8_STAGE(PG8_SA(1, 0), cA + kstep, voffA); PG8_STAGE(PG8_SB(1, 1), cB + hstepB + kstep, voffB);
    PG8_WAIT_V(6); PG8_BAR;
    for (;;) {
        const bool has_next = S.next(ui + 1, nxt);
        const char* nA = has_next ? S.a_ptr(nxt) : cA; const char* nB = has_next ? S.b_ptr(nxt) : cB;
        for (int t = 0; t < nt; t += 2) {
            const bool last = (t == nt - 2);
            const char* a1 = cA + (size_t)(t + 1) * kstep;
            const char* a2 = last ? nA : cA + (size_t)(t + 2) * kstep; const char* b2 = last ? nB : cB + (size_t)(t + 2) * kstep;
            const char* a3 = a2 + kstep; const char* b3 = b2 + kstep;
            PG8_LDB(B0, 0, 0); PG8_SCHED; PG8_LDA(At, 0, 0); PG8_STAGE(PG8_SA(1, 1), a1 + hstepA, voffA);
            PG8_WAIT_L(8); PG8_BAR; PG8_WAIT_L(0); PG8_MMA(0, 0, At, B0); PG8_BAR; PG8_SCHED;
            PG8_LDB(B1, 0, 1); PG8_STAGE(PG8_SB(0, 0), b2, voffB);
            PG8_BAR; PG8_WAIT_L(0); PG8_MMA(0, 1, At, B1); PG8_BAR;
            PG8_LDA(At, 0, 1); PG8_STAGE(PG8_SA(0, 0), a2, voffA);
            PG8_BAR; PG8_WAIT_L(0); PG8_MMA(1, 0, At, B0); PG8_BAR; PG8_SCHED;
            PG8_STAGE(PG8_SB(0, 1), b2 + hstepB, voffB);
            PG8_WAIT_V(6); PG8_BAR; PG8_MMA(1, 1, At, B1); PG8_BAR;
            PG8_LDB(B0, 1, 0); PG8_SCHED; PG8_LDA(At, 1, 0); PG8_STAGE(PG8_SA(0, 1), a2 + hstepA, voffA);
            PG8_WAIT_L(8); PG8_BAR; PG8_WAIT_L(0); PG8_MMA(0, 0, At, B0); PG8_BAR; PG8_SCHED;
            PG8_LDB(B1, 1, 1); PG8_STAGE(PG8_SB(1, 0), b3, voffB);
            PG8_BAR; PG8_WAIT_L(0); PG8_MMA(0, 1, At, B1); PG8_BAR;
            PG8_LDA(At, 1, 1); PG8_STAGE(PG8_SA(1, 0), a3, voffA);
            PG8_BAR; PG8_WAIT_L(0); PG8_MMA(1, 0, At, B0); PG8_BAR; PG8_SCHED;
            PG8_STAGE(PG8_SB(1, 1), b3 + hstepB, voffB);
            PG8_WAIT_V(6); PG8_BAR; PG8_MMA(1, 1, At, B1); PG8_BAR;
        }
        E(acc, cur, wr, wc, fr, fq);
        if (!has_next) break;
#pragma unroll
        for (int a = 0; a < 2; ++a)
#pragma unroll
            for (int b = 0; b < 2; ++b)
#pragma unroll
                for (int m = 0; m < 4; ++m)
#pragma unroll
                    for (int n = 0; n < 2; ++n) acc[a][b][m][n] = (f32x4){0.f, 0.f, 0.f, 0.f};
        cur = nxt; cA = nA; cB = nB; ++ui;
    }
    PG8_WAIT_V(0);
    if (wr == 0) PG8_BAR;
    PG8_BAR;
#undef PG8_SA
#undef PG8_SB
#undef PG8_STAGE
#undef PG8_LDA
#undef PG8_LDB
#undef PG8_MMA
#undef PG8_WAIT_V
#undef PG8_WAIT_L
#undef PG8_BAR
#undef PG8_SCHED
}
}
using pg8::f32x4; using pg8::u32x4; using pg8::Unit;

#define GEMM_LDS (pg8::STAGE_BYTES + 1024)

struct SchedProj : pg8::TileOrder {
  const char* A; const char* B;
  __device__ bool next(int i, Unit& u) const { u.z = 0; return tile(i, u.pm, u.pn); }
  __device__ const char* a_ptr(const Unit& u) const { return A + (size_t)u.pm * 256 * DM * 2; }
  __device__ const char* b_ptr(const Unit& u) const { return B + (size_t)u.pn * 256 * DM * 2; }
};
struct EpiProj {
  static constexpr bool PERM = true;
  bf16_t* O;
  __device__ __forceinline__ void operator()(const f32x4 (&acc)[2][2][4][2], const Unit& u, int wr, int wc, int fr, int fq) const {
    const int row0 = u.pm * 256 + wr * 64 + fr, col0 = u.pn * 256 + wc * 32 + 8 * fq;
    const bool gate = u.pn >= (C_GA / 256);
#pragma unroll
    for (int ai = 0; ai < 2; ++ai)
#pragma unroll
      for (int m = 0; m < 4; ++m) {
        bf16_t* rowp = O + (size_t)(row0 + ai * 128 + m * 16) * PW + col0;
#pragma unroll
        for (int bj = 0; bj < 2; ++bj) {
          f32x4 v0 = acc[ai][bj][m][0], v1 = acc[ai][bj][m][1];
          if (gate) {
#pragma unroll
            for (int j = 0; j < 4; ++j) { v0[j] = sigmoidf_(v0[j]); v1[j] = sigmoidf_(v1[j]); }
          }
          u32x4 w; w.x = pg8::cvt_pk_bf16(v0[0], v0[1]); w.y = pg8::cvt_pk_bf16(v0[2], v0[3]); w.z = pg8::cvt_pk_bf16(v1[0], v1[1]); w.w = pg8::cvt_pk_bf16(v1[2], v1[3]);
          *(u32x4*)(rowp + bj * 128) = w;
        }
      }
  }
};
__device__ void ph_proj(const Params& p, PG8_LAS unsigned char* lds, int nblk, int bid) {
  SchedProj S; S.init(T_TOK / 256, PW / 256, nblk, bid); S.A = (const char*)p.hbf; S.B = (const char*)p.w_in_t;
  EpiProj E{p.proj};
  pg8::gemm_phase(lds, DM, DM, DM, S, E);
}

struct SchedBr : pg8::TileOrder {
  const char* A; const char* Ba; const char* Bb;
  __device__ bool next(int i, Unit& u) const { u.z = i & 1; return tile(i >> 1, u.pm, u.pn); }
  __device__ const char* a_ptr(const Unit& u) const { return A + (size_t)u.pm * 256 * DM * 2 + u.z * 512 * 2; }
  __device__ const char* b_ptr(const Unit& u) const { return (u.z ? Bb : Ba) + (size_t)u.pn * 256 * 512 * 2; }
};
__device__ __forceinline__ void unpack8(const u32x4 w, float (&f)[8]) {
  f[0] = __uint_as_float(w.x << 16); f[1] = __uint_as_float(w.x & 0xffff0000u); f[2] = __uint_as_float(w.y << 16); f[3] = __uint_as_float(w.y & 0xffff0000u);
  f[4] = __uint_as_float(w.z << 16); f[5] = __uint_as_float(w.z & 0xffff0000u); f[6] = __uint_as_float(w.w << 16); f[7] = __uint_as_float(w.w & 0xffff0000u);
}
struct EpiBr {
  static constexpr bool PERM = true;
  const bf16_t* proj; bf16_t* O;
  __device__ __forceinline__ void operator()(const f32x4 (&acc)[2][2][4][2], const Unit& u, int wr, int wc, int fr, int fq) const {
    const int row0 = u.pm * 256 + wr * 64 + fr, col0 = u.pn * 256 + wc * 32 + 8 * fq;
    const int gcol = (u.z ? C_GB : C_GA) + col0;
#pragma unroll
    for (int ai = 0; ai < 2; ++ai)
#pragma unroll
      for (int m = 0; m < 4; ++m) {
        const size_t row = (size_t)(row0 + ai * 128 + m * 16);
        bf16_t* rowp = O + row * DM + col0;
        const bf16_t* gp = proj + row * PW + gcol;
#pragma unroll
        for (int bj = 0; bj < 2; ++bj) {
          float g[8]; unpack8(*(const u32x4*)(gp + bj * 128), g);
          f32x4 v0 = acc[ai][bj][m][0], v1 = acc[ai][bj][m][1];
          float r[8];
#pragma unroll
          for (int j = 0; j < 4; ++j) { r[j] = v0[j] * g[j]; r[4 + j] = v1[j] * g[4 + j]; }
          if (u.z) {
            float pv[8]; unpack8(*(const u32x4*)(rowp + bj * 128), pv);
#pragma unroll
            for (int j = 0; j < 8; ++j) r[j] += pv[j];
          }
          u32x4 w; w.x = pg8::cvt_pk_bf16(r[0], r[1]); w.y = pg8::cvt_pk_bf16(r[2], r[3]); w.z = pg8::cvt_pk_bf16(r[4], r[5]); w.w = pg8::cvt_pk_bf16(r[6], r[7]);
          *(u32x4*)(rowp + bj * 128) = w;
        }
      }
  }
};
__device__ void ph_br(const Params& p, PG8_LAS unsigned char* lds, int nblk, int bid) {
  SchedBr S; S.init(T_TOK / 256, DM / 256, nblk, bid); S.A = (const char*)p.oab; S.Ba = (const char*)p.wbra_t; S.Bb = (const char*)p.wbrb_t;
  EpiBr E{p.proj, p.merged};
  pg8::gemm_phase(lds, DM, 512, 512, S, E);
}

struct SchedMix : pg8::TileOrder {
  const char* A; const char* B;
  __device__ bool next(int i, Unit& u) const { u.z = 0; return tile(i, u.pm, u.pn); }
  __device__ const char* a_ptr(const Unit& u) const { return A + (size_t)u.pm * 256 * DM * 2; }
  __device__ const char* b_ptr(const Unit& u) const { return B + (size_t)u.pn * 256 * DM * 2; }
};
struct EpiMix {
  static constexpr bool PERM = true;
  bf16_t* O;
  __device__ __forceinline__ void operator()(const f32x4 (&acc)[2][2][4][2], const Unit& u, int wr, int wc, int fr, int fq) const {
    const int row0 = u.pm * 256 + wr * 64 + fr, col0 = u.pn * 256 + wc * 32 + 8 * fq;
#pragma unroll
    for (int ai = 0; ai < 2; ++ai)
#pragma unroll
      for (int m = 0; m < 4; ++m) {
        bf16_t* rowp = O + (size_t)(row0 + ai * 128 + m * 16) * DM + col0;
#pragma unroll
        for (int bj = 0; bj < 2; ++bj) {
          const f32x4 v0 = acc[ai][bj][m][0], v1 = acc[ai][bj][m][1];
          u32x4 w; w.x = pg8::cvt_pk_bf16(v0[0], v0[1]); w.y = pg8::cvt_pk_bf16(v0[2], v0[3]); w.z = pg8::cvt_pk_bf16(v1[0], v1[1]); w.w = pg8::cvt_pk_bf16(v1[2], v1[3]);
          *(u32x4*)(rowp + bj * 128) = w;
        }
      }
  }
};
__device__ void ph_mix(const Params& p, PG8_LAS unsigned char* lds, int nblk, int bid) {
  SchedMix S; S.init(T_TOK / 256, DM / 256, nblk, bid); S.A = (const char*)p.merged; S.B = (const char*)p.wo_t;
  EpiMix E{p.mixer};
  pg8::gemm_phase(lds, DM, DM, DM, S, E);
}

struct SchedMoe {
  const PG8_LAS int* tb; int NT; int G, c; int nwg;
  const char* A; const char* B; size_t bexp;
  __device__ bool next(int i, Unit& u) const {
    const long L = (long)i * G + c; if (L >= nwg) return false;
    int wgid = (int)L; { const int q = nwg / 8, r = nwg % 8, xcd = wgid % 8, off = wgid / 8; wgid = (xcd < r ? xcd * (q + 1) : r * (q + 1) + (xcd - r) * q) + off; }
    int e = 0;
#pragma unroll 1
    for (int k = 1; k < NE; ++k) if (wgid >= tb[k]) e = k;
    const int q = wgid - tb[e]; const int tiles = tb[33 + e + 1] - tb[33 + e];
    u.pm = tb[33 + e] + q % tiles; u.pn = q / tiles; u.z = e; return true;
  }
  __device__ const char* a_ptr(const Unit& u) const { return A + (size_t)u.pm * 256 * DM * 2; }
  __device__ const char* b_ptr(const Unit& u) const { return B + (size_t)u.z * bexp + (size_t)u.pn * 256 * DM * 2; }
};
__device__ __forceinline__ void moe_table(const Params& p, PG8_LAS int* tb, int NT) {
  if (threadIdx.x == 0) {
    int ub = 0, tbp = 0;
    for (int e = 0; e < NE; ++e) { tb[e] = ub; tb[33 + e] = tbp; const int t = (p.cnt[e] + 255) >> 8; ub += t * NT; tbp += t; }
    tb[NE] = ub; tb[33 + NE] = tbp;
  }
  __syncthreads();
}
struct EpiMoe1 {
  static constexpr bool PERM = true;
  const float* b_gu; bf16_t* act;
  __device__ __forceinline__ void operator()(const f32x4 (&acc)[2][2][4][2], const Unit& u, int wr, int wc, int fr, int fq) const {
    const int row0 = u.pm * 256 + wr * 64 + fr, jc = u.pn * 128 + wc * 32 + 8 * fq;
    const float* bg = b_gu + (size_t)u.z * 2048 + jc;
    float bgv[8], buv[8];
#pragma unroll
    for (int j = 0; j < 8; ++j) { bgv[j] = bg[j]; buv[j] = bg[1024 + j]; }
#pragma unroll
    for (int ai = 0; ai < 2; ++ai)
#pragma unroll
      for (int m = 0; m < 4; ++m) {
        bf16_t* rowp = act + (size_t)(row0 + ai * 128 + m * 16) * DM + jc;
        float r[8];
#pragma unroll
        for (int n = 0; n < 2; ++n)
#pragma unroll
          for (int j = 0; j < 4; ++j) {
            float g = acc[ai][0][m][n][j] + bgv[n * 4 + j], up = acc[ai][1][m][n][j] + buv[n * 4 + j];
            g = fminf(g, 7.f); up = fminf(fmaxf(up, -7.f), 7.f);
            r[n * 4 + j] = (up + 1.f) * g * sigmoidf_(1.702f * g);
          }
        u32x4 w; w.x = pg8::cvt_pk_bf16(r[0], r[1]); w.y = pg8::cvt_pk_bf16(r[2], r[3]); w.z = pg8::cvt_pk_bf16(r[4], r[5]); w.w = pg8::cvt_pk_bf16(r[6], r[7]);
        *(u32x4*)rowp = w;
      }
  }
};
__device__ void ph_moe1(const Params& p, PG8_LAS unsigned char* lds, int nblk, int bid) {
  PG8_LAS int* tb = (PG8_LAS int*)(lds + pg8::STAGE_BYTES);
  moe_table(p, tb, 8);
  SchedMoe S; S.tb = tb; S.NT = 8; S.G = nblk; S.c = bid; S.nwg = tb[NE]; S.A = (const char*)p.xs; S.B = (const char*)p.wgu_t; S.bexp = (size_t)2048 * DM * 2;
  EpiMoe1 E{p.b_gu, p.act};
  pg8::gemm_phase(lds, DM, DM, DM, S, E);
}
struct EpiMoe2 {
  static constexpr bool PERM = true;
  const float* b_down; const int* rowmap; bf16_t* yslot;
  __device__ __forceinline__ void operator()(const f32x4 (&acc)[2][2][4][2], const Unit& u, int wr, int wc, int fr, int fq) const {
    const int row0 = u.pm * 256 + wr * 64 + fr, col0 = u.pn * 256 + wc * 32 + 8 * fq;
    const float* bd = b_down + (size_t)u.z * 1024 + col0;
    float bv[2][8];
#pragma unroll
    for (int bj = 0; bj < 2; ++bj)
#pragma unroll
      for (int j = 0; j < 8; ++j) bv[bj][j] = bd[bj * 128 + j];
#pragma unroll
    for (int ai = 0; ai < 2; ++ai)
#pragma unroll
      for (int m = 0; m < 4; ++m) {
        const int a = rowmap[row0 + ai * 128 + m * 16];
        if (a >= 0) {
          bf16_t* rowp = yslot + (size_t)a * DM + col0;
#pragma unroll
          for (int bj = 0; bj < 2; ++bj) {
            const f32x4 v0 = acc[ai][bj][m][0], v1 = acc[ai][bj][m][1];
            u32x4 w; w.x = pg8::cvt_pk_bf16(v0[0] + bv[bj][0], v0[1] + bv[bj][1]); w.y = pg8::cvt_pk_bf16(v0[2] + bv[bj][2], v0[3] + bv[bj][3]);
            w.z = pg8::cvt_pk_bf16(v1[0] + bv[bj][4], v1[1] + bv[bj][5]); w.w = pg8::cvt_pk_bf16(v1[2] + bv[bj][6], v1[3] + bv[bj][7]);
            *(u32x4*)(rowp + bj * 128) = w;
          }
        }
      }
  }
};
__device__ void ph_moe2(const Params& p, PG8_LAS unsigned char* lds, int nblk, int bid) {
  PG8_LAS int* tb = (PG8_LAS int*)(lds + pg8::STAGE_BYTES);
  moe_table(p, tb, 4);
  SchedMoe S; S.tb = tb; S.NT = 4; S.G = nblk; S.c = bid; S.nwg = tb[NE]; S.A = (const char*)p.act; S.B = (const char*)p.wd_t; S.bexp = (size_t)1024 * DM * 2;
  EpiMoe2 E{p.b_down, p.rowmap, p.yslot};
  pg8::gemm_phase(lds, DM, DM, DM, S, E);
}

typedef short bf16x8 __attribute__((ext_vector_type(8)));
typedef __bf16 bf16x2_t __attribute__((ext_vector_type(2)));
typedef float f32x2_t __attribute__((ext_vector_type(2)));
typedef unsigned u32x2 __attribute__((ext_vector_type(2)));
#define LAS __attribute__((address_space(3)))
#define MFMA16(a, b, c) __builtin_amdgcn_mfma_f32_16x16x32_bf16((a), (b), (c), 0, 0, 0)
__device__ __forceinline__ unsigned pk2(float a, float b) { f32x2_t v = {a, b}; bf16x2_t r = __builtin_convertvector(v, bf16x2_t); return __builtin_bit_cast(unsigned, r); }
__device__ __forceinline__ bf16x8 pack8(float a0, float a1, float a2, float a3, float a4, float a5, float a6, float a7) {
  u32x4 w; w.x = pk2(a0, a1); w.y = pk2(a2, a3); w.z = pk2(a4, a5); w.w = pk2(a6, a7);
  return __builtin_bit_cast(bf16x8, w);
}
__device__ __forceinline__ bf16_t f2bf_hw(float a) { return (bf16_t)(pk2(a, 0.f) & 0xffffu); }

#define DN_ABYTES 57344
#define DN_UFLOATS 8192
#define F_WN 0
#define F_QD 16
#define F_QK 32
#define F_KT 40

#define DP_KH 0
#define DP_QT 17408
#define DP_KHT 34816
#define DP_VT 53248
#define DP_TU 71680
#define DP_TW 80896
#define DP_LF 90112
#define DP_GC 107520
#define DP_BETA 107776
#define DP_CW 108032
#define DP_TOTAL 114176

template <int KS>
__device__ __forceinline__ f32x4 prod16(const LAS bf16_t* A, int lda, int arow0, const LAS bf16_t* Bt, int ldb, int brow0, f32x4 acc, int lane) {
  const int r = lane & 15, q = lane >> 4;
#pragma unroll
  for (int ks = 0; ks < KS; ++ks) {
    const bf16x8 a = *(const LAS bf16x8*)(A + (arow0 + r) * lda + 32 * ks + 8 * q);
    const bf16x8 b = *(const LAS bf16x8*)(Bt + (brow0 + r) * ldb + 32 * ks + 8 * q);
    acc = MFMA16(a, b, acc);
  }
  return acc;
}
__device__ __forceinline__ void tile_store_rm(LAS bf16_t* X, int ld, int row0, int col0, const f32x4 v, int lane) {
  const int r = lane & 15, q = lane >> 4;
#pragma unroll
  for (int i = 0; i < 4; ++i) X[(row0 + 4 * q + i) * ld + col0 + r] = f2bf_hw(v[i]);
}
__device__ __forceinline__ void tile_store_tr(LAS bf16_t* Xt, int ld, int row0, int col0, const f32x4 v, int lane) {
  const int r = lane & 15, q = lane >> 4;
  u32x2 w; w.x = pk2(v[0], v[1]); w.y = pk2(v[2], v[3]);
  *(LAS u32x2*)(Xt + (col0 + r) * ld + row0 + 4 * q) = w;
}

__device__ void dn_prep_chunk(const Params& p, LAS unsigned char* lds, int ci, bool load_cw) {
  const int tid = threadIdx.x, lane = tid & 63, w = tid >> 6, r16 = lane & 15, q4 = lane >> 4;
  const int bh = ci >> 6, n = ci & 63, b = bh >> 2, h = bh & 3;
  LAS bf16_t* Kh = (LAS bf16_t*)(lds + DP_KH); LAS bf16_t* Qt = (LAS bf16_t*)(lds + DP_QT);
  LAS bf16_t* KhT = (LAS bf16_t*)(lds + DP_KHT); LAS bf16_t* VT = (LAS bf16_t*)(lds + DP_VT);
  LAS bf16_t* Tu = (LAS bf16_t*)(lds + DP_TU); LAS bf16_t* Tw = (LAS bf16_t*)(lds + DP_TW); LAS float* Lf = (LAS float*)(lds + DP_LF);
  LAS float* gcb = (LAS float*)(lds + DP_GC); LAS float* betab = (LAS float*)(lds + DP_BETA); LAS float* cw = (LAS float*)(lds + DP_CW);
  unsigned char* gA = (unsigned char*)p.dnA + (size_t)ci * DN_ABYTES;
  float* gU = p.dnU + (size_t)ci * DN_UFLOATS;

  if (load_cw) {
    for (int i = tid; i < 4 * 384; i += 512) { const int tap = i / 384, cc = i % 384, part = cc >> 7, d = cc & 127; cw[i] = p.conv_w[tap * 1536 + part * 512 + h * 128 + d]; }
  }
  __syncthreads();
  const int c = tid >> 3, g = tid & 7;
  const int s = n * 64 + c;
  const size_t t = (size_t)b * SEQ + s;
  float qv[16], kv[16], vv[16];
#pragma unroll
  for (int j = 0; j < 16; ++j) { qv[j] = 0.f; kv[j] = 0.f; vv[j] = 0.f; }
#pragma unroll
  for (int tap = 0; tap < 4; ++tap) {
    const int ss = s - 3 + tap;
    if (ss >= 0) {
      const bf16_t* row = p.proj + (t - 3 + tap) * PW + h * 128 + 16 * g;
      float x[8];
#pragma unroll
      for (int part = 0; part < 3; ++part) {
#pragma unroll
        for (int hh = 0; hh < 2; ++hh) {
          unpack8(*(const u32x4*)(row + part * 512 + 8 * hh), x);
#pragma unroll
          for (int j = 0; j < 8; ++j) {
            const float wv = cw[tap * 384 + part * 128 + 16 * g + 8 * hh + j];
            if (part == 0) qv[8 * hh + j] += wv * x[j];
            if (part == 1) kv[8 * hh + j] += wv * x[j];
            if (part == 2) vv[8 * hh + j] += wv * x[j];
          }
        }
      }
    }
    asm volatile("" ::: "memory");
  }
  float sq = 0.f, sk = 0.f;
#pragma unroll
  for (int j = 0; j < 16; ++j) { qv[j] = siluf_(qv[j]); kv[j] = siluf_(kv[j]); vv[j] = siluf_(vv[j]); sq += qv[j] * qv[j]; sk += kv[j] * kv[j]; }
  sq += __shfl_xor(sq, 1, 64); sq += __shfl_xor(sq, 2, 64); sq += __shfl_xor(sq, 4, 64);
  sk += __shfl_xor(sk, 1, 64); sk += __shfl_xor(sk, 2, 64); sk += __shfl_xor(sk, 4, 64);
  const float rq = rsqrtf(sq + 1e-6f) * 0.08838834764831845f, rk = rsqrtf(sk + 1e-6f);
#pragma unroll
  for (int j = 0; j < 16; ++j) { qv[j] *= rq; kv[j] *= rk; }
  if (g == 0) {
    const float bb = p.ba[t * 8 + h], aa = p.ba[t * 8 + 4 + h];
    const float xx = aa + p.dt_bias[h];
    const float sp = xx > 20.f ? xx : log1pf(__expf(xx));
    betab[c] = sigmoidf_(bb);
    gcb[c] = -__expf(p.a_log[h]) * sp;
  }
  {
    u32x4 w0, w1;
    w0.x = pk2(kv[0], kv[1]); w0.y = pk2(kv[2], kv[3]); w0.z = pk2(kv[4], kv[5]); w0.w = pk2(kv[6], kv[7]);
    w1.x = pk2(kv[8], kv[9]); w1.y = pk2(kv[10], kv[11]); w1.z = pk2(kv[12], kv[13]); w1.w = pk2(kv[14], kv[15]);
    *(LAS u32x4*)(Kh + c * 136 + 16 * g) = w0; *(LAS u32x4*)(Kh + c * 136 + 16 * g + 8) = w1;
    w0.x = pk2(qv[0], qv[1]); w0.y = pk2(qv[2], qv[3]); w0.z = pk2(qv[4], qv[5]); w0.w = pk2(qv[6], qv[7]);
    w1.x = pk2(qv[8], qv[9]); w1.y = pk2(qv[10], qv[11]); w1.z = pk2(qv[12], qv[13]); w1.w = pk2(qv[14], qv[15]);
    *(LAS u32x4*)(Qt + c * 136 + 16 * g) = w0; *(LAS u32x4*)(Qt + c * 136 + 16 * g + 8) = w1;
#pragma unroll
    for (int j = 0; j < 16; ++j) { KhT[(16 * g + j) * 72 + c] = f2bf_hw(kv[j]); VT[(16 * g + j) * 72 + c] = f2bf_hw(vv[j]); }
  }
  __syncthreads();
  if (w == 0) {
    float v = gcb[lane];
#pragma unroll
    for (int o = 1; o < 64; o <<= 1) { const float u = __shfl_up(v, o, 64); if (lane >= o) v += u; }
    gcb[lane] = v;
  }
  __syncthreads();
  const float gc_c = gcb[c], gl = gcb[63];
  {
    const float eg = __expf(gc_c);
    unsigned char* fb = gA + (size_t)(F_QD + (c >> 4) * 4 + (g >> 1)) * 1024 + (g & 1) * 8;
#pragma unroll
    for (int qq = 0; qq < 4; ++qq) {
      u32x2 wv; wv.x = pk2(qv[4 * qq] * eg, qv[4 * qq + 1] * eg); wv.y = pk2(qv[4 * qq + 2] * eg, qv[4 * qq + 3] * eg);
      *(u32x2*)(fb + ((c & 15) + 16 * qq) * 16) = wv;
    }
  }
  const int rt = w >> 1, ct0 = 2 * (w & 1);
#pragma unroll
  for (int tt = 0; tt < 2; ++tt) {
    const int ct = ct0 + tt;
    f32x4 gacc = {0.f, 0.f, 0.f, 0.f};
    gacc = prod16<4>(Kh, 136, 16 * rt, Kh, 136, 16 * ct, gacc, lane);
    const int m = 16 * ct + r16; const float gc_m = gcb[m];
#pragma unroll
    for (int i = 0; i < 4; ++i) {
      const int cc = 16 * rt + 4 * q4 + i;
      Lf[cc * 68 + m] = (m < cc) ? betab[cc] * gacc[i] * __expf(gcb[cc] - gc_m) : 0.f;
    }
    f32x4 qacc = {0.f, 0.f, 0.f, 0.f};
    qacc = prod16<4>(Kh, 136, 16 * rt, Qt, 136, 16 * ct, qacc, lane);
    const int cq = 16 * ct + r16; const float gc_cq = gcb[cq];
    float o4[4];
#pragma unroll
    for (int i = 0; i < 4; ++i) { const int mm = 16 * rt + 4 * q4 + i; o4[i] = (mm <= cq) ? qacc[i] * __expf(gc_cq - gcb[mm]) : 0.f; }
    u32x2 wv; wv.x = pk2(o4[0], o4[1]); wv.y = pk2(o4[2], o4[3]);
    *(u32x2*)(gA + (size_t)(F_QK + ct * 2 + (rt >> 1)) * 1024 + (r16 + 16 * q4) * 16 + (rt & 1) * 8) = wv;
  }
  __syncthreads();
  if (w == 0) {
    float T[64];
    int lo = lane; asm volatile("" : "+v"(lo));
    const float bm = betab[lo], bem = bm * __expf(gcb[lo]);
#pragma unroll
    for (int i = 0; i < 64; ++i) {
      float a0 = (i == lo) ? 1.f : 0.f, a1 = 0.f, a2 = 0.f, a3 = 0.f;
#pragma unroll
      for (int k4 = 0; k4 < (i + 3) / 4; ++k4) {
        const f32x4 l = *(const LAS f32x4*)(Lf + i * 68 + 4 * k4);
        if (4 * k4 + 0 < i) a0 -= l[0] * T[4 * k4 + 0];
        if (4 * k4 + 1 < i) a1 -= l[1] * T[4 * k4 + 1];
        if (4 * k4 + 2 < i) a2 -= l[2] * T[4 * k4 + 2];
        if (4 * k4 + 3 < i) a3 -= l[3] * T[4 * k4 + 3];
      }
      T[i] = (a0 + a1) + (a2 + a3);
      Tu[i * 72 + lo] = f2bf_hw(T[i] * bm);
      Tw[i * 72 + lo] = f2bf_hw(T[i] * bem);
      asm volatile("" ::: "memory");
    }
  }
  __syncthreads();
#pragma unroll
  for (int rr = 0; rr < 4; ++rr) {
    f32x4 u = {0.f, 0.f, 0.f, 0.f};
    u = prod16<2>(Tu, 72, 16 * rr, VT, 72, 16 * w, u, lane);
    *(f32x4*)(gU + ((w * 4 + rr) * 64 + lane) * 4) = u;
    f32x4 wt = {0.f, 0.f, 0.f, 0.f};
    wt = prod16<2>(KhT, 72, 16 * w, Tw, 72, 16 * rr, wt, lane);
    u32x2 wv; wv.x = pk2(-wt[0], -wt[1]); wv.y = pk2(-wt[2], -wt[3]);
    *(u32x2*)(gA + (size_t)(F_WN + rr * 4 + (w >> 1)) * 1024 + (r16 + 16 * q4) * 16 + (w & 1) * 8) = wv;
  }
#pragma unroll
  for (int it = 0; it < 4; ++it) {
    const int idx = tid + it * 512; const int d = idx >> 4, m4 = idx & 15;
    const u32x2 raw = *(const LAS u32x2*)(KhT + d * 72 + 4 * m4);
    const float k0 = __uint_as_float(raw.x << 16), k1 = __uint_as_float(raw.x & 0xffff0000u), k2 = __uint_as_float(raw.y << 16), k3 = __uint_as_float(raw.y & 0xffff0000u);
    const float e0 = __expf(gl - gcb[4 * m4]), e1 = __expf(gl - gcb[4 * m4 + 1]), e2 = __expf(gl - gcb[4 * m4 + 2]), e3 = __expf(gl - gcb[4 * m4 + 3]);
    u32x2 wv; wv.x = pk2(k0 * e0, k1 * e1); wv.y = pk2(k2 * e2, k3 * e3);
    *(u32x2*)(gA + (size_t)(F_KT + (d >> 4) * 2 + (m4 >> 3)) * 1024 + ((d & 15) + 16 * (m4 & 3)) * 16 + ((m4 >> 2) & 1) * 8) = wv;
  }
  if (tid == 0) p.dnG[ci] = __expf(gl);
}

#define DS_A0 0
#define DS_A1 57344
#define DS_OT 114688
#define DS_TOTAL (114688 + 64 * 132 * 4)
__device__ void dn_scan_bh(const Params& p, LAS unsigned char* lds, int bh) {
  const int tid = threadIdx.x, lane = tid & 63, w = __builtin_amdgcn_readfirstlane(tid >> 6), r16 = lane & 15, q4 = lane >> 4;
  const int b = bh >> 2, h = bh & 3;
  LAS float* Ot = (LAS float*)(lds + DS_OT);
  const unsigned char* gA = (const unsigned char*)p.dnA + (size_t)bh * 64 * DN_ABYTES;
  const float* gU = p.dnU + (size_t)bh * 64 * DN_UFLOATS;
  const float* gG = p.dnG + bh * 64;
  auto issue_A = [&](int n, int buf) {
#pragma unroll
    for (int i = 0; i < 7; ++i) {
      const int f = w * 7 + i;
      __builtin_amdgcn_global_load_lds((const unsigned*)(gA + (size_t)n * DN_ABYTES + f * 1024 + lane * 16), (LAS unsigned*)(lds + (buf ? DS_A1 : DS_A0) + f * 1024), 16, 0, 0);
    }
  };
  auto post = [&](int n) {
    const int row = tid >> 3, seg = tid & 7;
    const size_t t = (size_t)b * SEQ + n * 64 + row;
    float o[16]; float ss = 0.f;
#pragma unroll
    for (int j4 = 0; j4 < 4; ++j4) { const f32x4 v = *(const LAS f32x4*)(Ot + row * 132 + 16 * seg + 4 * j4); o[4 * j4] = v[0]; o[4 * j4 + 1] = v[1]; o[4 * j4 + 2] = v[2]; o[4 * j4 + 3] = v[3]; }
#pragma unroll
    for (int j = 0; j < 16; ++j) ss += o[j] * o[j];
    ss += __shfl_xor(ss, 1, 64); ss += __shfl_xor(ss, 2, 64); ss += __shfl_xor(ss, 4, 64);
    const float rstd = rsqrtf(ss * (1.f / 128.f) + 1e-6f);
    const bf16_t* zp = p.proj + t * PW + C_Z + h * 128 + 16 * seg;
    float z0[8], z1[8]; unpack8(*(const u32x4*)zp, z0); unpack8(*(const u32x4*)(zp + 8), z1);
    float y[16];
#pragma unroll
    for (int j = 0; j < 8; ++j) { y[j] = o[j] * rstd * p.g_dn_out[16 * seg + j] * siluf_(z0[j]); y[8 + j] = o[8 + j] * rstd * p.g_dn_out[16 * seg + 8 + j] * siluf_(z1[j]); }
    u32x4 w0, w1;
    w0.x = pk2(y[0], y[1]); w0.y = pk2(y[2], y[3]); w0.z = pk2(y[4], y[5]); w0.w = pk2(y[6], y[7]);
    w1.x = pk2(y[8], y[9]); w1.y = pk2(y[10], y[11]); w1.z = pk2(y[12], y[13]); w1.w = pk2(y[14], y[15]);
    bf16_t* op = p.dn_out + t * p.dn_out_ld + h * 128 + 16 * seg;
    *(u32x4*)op = w0; *(u32x4*)(op + 8) = w1;
  };
  issue_A(0, 0);
  f32x4 Un[4];
#pragma unroll
  for (int rr = 0; rr < 4; ++rr) Un[rr] = *(const f32x4*)(gU + ((w * 4 + rr) * 64 + lane) * 4);
  f32x4 S[8];
#pragma unroll
  for (int dt = 0; dt < 8; ++dt) S[dt] = (f32x4){0.f, 0.f, 0.f, 0.f};
  asm volatile("s_waitcnt vmcnt(0)" ::: "memory");
  __syncthreads();
#pragma unroll 1
  for (int n = 0; n < 64; ++n) {
    const LAS unsigned char* Ab = lds + ((n & 1) ? DS_A1 : DS_A0);
    if (n + 1 < 64) issue_A(n + 1, (n + 1) & 1);
    f32x4 Vn[4];
#pragma unroll
    for (int rr = 0; rr < 4; ++rr) Vn[rr] = Un[rr];
    if (n + 1 < 64) {
#pragma unroll
      for (int rr = 0; rr < 4; ++rr) Un[rr] = *(const f32x4*)(gU + (size_t)(n + 1) * DN_UFLOATS + ((w * 4 + rr) * 64 + lane) * 4);
    }
    const float gdec = gG[n];
    if (n > 0) post(n - 1);
    bf16x8 Sb[4];
#pragma unroll
    for (int ks = 0; ks < 4; ++ks) Sb[ks] = pack8(S[2 * ks][0], S[2 * ks][1], S[2 * ks][2], S[2 * ks][3], S[2 * ks + 1][0], S[2 * ks + 1][1], S[2 * ks + 1][2], S[2 * ks + 1][3]);
    f32x4 O[4];
#pragma unroll
    for (int rr = 0; rr < 4; ++rr) {
      O[rr] = (f32x4){0.f, 0.f, 0.f, 0.f};
#pragma unroll
      for (int ks = 0; ks < 4; ++ks) {
        const bf16x8 aw = *(const LAS bf16x8*)(Ab + (F_WN + rr * 4 + ks) * 1024 + lane * 16);
        Vn[rr] = MFMA16(aw, Sb[ks], Vn[rr]);
        const bf16x8 aq = *(const LAS bf16x8*)(Ab + (F_QD + rr * 4 + ks) * 1024 + lane * 16);
        O[rr] = MFMA16(aq, Sb[ks], O[rr]);
      }
    }
    bf16x8 Vb[2];
#pragma unroll
    for (int ks = 0; ks < 2; ++ks) Vb[ks] = pack8(Vn[2 * ks][0], Vn[2 * ks][1], Vn[2 * ks][2], Vn[2 * ks][3], Vn[2 * ks + 1][0], Vn[2 * ks + 1][1], Vn[2 * ks + 1][2], Vn[2 * ks + 1][3]);
#pragma unroll
    for (int rr = 0; rr < 4; ++rr)
#pragma unroll
      for (int ks = 0; ks < 2; ++ks) {
        const bf16x8 a = *(const LAS bf16x8*)(Ab + (F_QK + rr * 2 + ks) * 1024 + lane * 16);
        O[rr] = MFMA16(a, Vb[ks], O[rr]);
      }
#pragma unroll
    for (int dt = 0; dt < 8; ++dt) {
      S[dt] *= gdec;
#pragma unroll
      for (int ks = 0; ks < 2; ++ks) {
        const bf16x8 a = *(const LAS bf16x8*)(Ab + (F_KT + dt * 2 + ks) * 1024 + lane * 16);
        S[dt] = MFMA16(a, Vb[ks], S[dt]);
      }
    }
    __syncthreads();
#pragma unroll
    for (int rr = 0; rr < 4; ++rr)
#pragma unroll
      for (int i = 0; i < 4; ++i) Ot[(16 * rr + 4 * q4 + i) * 132 + 16 * w + r16] = O[rr][i];
    asm volatile("s_waitcnt vmcnt(0)" ::: "memory");
    __syncthreads();
  }
  post(63);
  __syncthreads();
}
typedef float f32x16 __attribute__((ext_vector_type(16)));
#define MFMA32(a, b, c) __builtin_amdgcn_mfma_f32_32x32x16_bf16((a), (b), (c), 0, 0, 0)
#define MP_VL 0
#define MP_RED 65536
#define MP_TOTAL (65536 + 4096)

__device__ void moba_prep_block(const Params& p, LAS unsigned char* lds, int item) {
  const int tid = threadIdx.x, lane = tid & 63, w = tid >> 6;
  const int bh = item >> 4, jb = item & 15, b = bh >> 2, h = bh & 3;
  LAS bf16_t* Vl = (LAS bf16_t*)(lds + MP_VL);
  LAS float* red = (LAS float*)(lds + MP_RED);
  __syncthreads();
#pragma unroll
  for (int it = 0; it < 8; ++it) {
    const int idx = tid + 512 * it, row = idx >> 4, ch = idx & 15;
    const u32x4 v = *(const u32x4*)(p.proj + ((size_t)b * SEQ + 256 * jb + row) * PW + C_MV + h * 128 + 8 * ch);
    *(LAS u32x4*)(Vl + row * 128 + 8 * ch) = v;
  }
  {
    const int r = tid >> 1, hh = tid & 1;
    const int pos = 256 * jb + r;
    const size_t t = (size_t)b * SEQ + pos;
    float cs[8], sn[8];
#pragma unroll
    for (int jj = 0; jj < 8; ++jj) {
      const float inv = exp2f(-(float)(8 * hh + jj) * (1.f / 16.f) * 18.931568569324174f);
      const float ang = (float)pos * inv;
      cs[jj] = cosf(ang); sn[jj] = sinf(ang);
    }
    float kacc[64];
#pragma unroll
    for (int which = 0; which < 2; ++which) {
      const bf16_t* src = p.proj + t * PW + (which ? C_MQ : C_MK) + h * 128 + 8 * hh;
      float x0[8], x1[8];
      unpack8(*(const u32x4*)(src), x0); unpack8(*(const u32x4*)(src + 16), x1);
      float y0[8], y1[8];
#pragma unroll
      for (int jj = 0; jj < 8; ++jj) { y0[jj] = x0[jj] * cs[jj] - x1[jj] * sn[jj]; y1[jj] = x1[jj] * cs[jj] + x0[jj] * sn[jj]; }
      u32x4 o[8];
      o[0].x = pk2(y0[0], y0[1]); o[0].y = pk2(y0[2], y0[3]); o[0].z = pk2(y0[4], y0[5]); o[0].w = pk2(y0[6], y0[7]);
      o[1].x = pk2(y1[0], y1[1]); o[1].y = pk2(y1[2], y1[3]); o[1].z = pk2(y1[4], y1[5]); o[1].w = pk2(y1[6], y1[7]);
#pragma unroll
      for (int ks = 2; ks < 8; ++ks) o[ks] = *(const u32x4*)(src + 16 * ks);
      if (which == 0) {
#pragma unroll
        for (int jj = 0; jj < 8; ++jj) { kacc[jj] = y0[jj]; kacc[8 + jj] = y1[jj]; }
#pragma unroll
        for (int ks = 2; ks < 8; ++ks) { float f[8]; unpack8(o[ks], f);
#pragma unroll
          for (int jj = 0; jj < 8; ++jj) kacc[8 * ks + jj] = f[jj]; }
        unsigned char* dst = (unsigned char*)p.Kp + ((size_t)(bh * 128 + 8 * jb + (r >> 5)) * 8192) + ((r & 31) + 32 * hh) * 16;
#pragma unroll
        for (int ks = 0; ks < 8; ++ks) *(u32x4*)(dst + ks * 1024) = o[ks];
      } else {
        bf16_t* dst = p.qb + ((size_t)bh * SEQ + pos) * 128 + 8 * hh;
#pragma unroll
        for (int ks = 0; ks < 8; ++ks) *(u32x4*)(dst + 16 * ks) = o[ks];
      }
    }
#pragma unroll
    for (int e = 0; e < 64; ++e) {
      float v = kacc[e];
      v += __shfl_xor(v, 2, 64); v += __shfl_xor(v, 4, 64); v += __shfl_xor(v, 8, 64); v += __shfl_xor(v, 16, 64); v += __shfl_xor(v, 32, 64);
      kacc[e] = v;
    }
    if (lane < 2) {
#pragma unroll
      for (int e = 0; e < 64; ++e) red[(w * 2 + lane) * 64 + e] = kacc[e];
    }
  }
  __syncthreads();
  if (tid < 128) {
    const int d = tid, hh = (d >> 3) & 1, ks = d >> 4, jj = d & 7;
    float a = 0.f;
#pragma unroll
    for (int ww = 0; ww < 8; ++ww) a += red[(ww * 2 + hh) * 64 + ks * 8 + jj];
    p.kmean[((size_t)bh * 16 + jb) * 128 + d] = a * (1.f / 256.f);
  }
#pragma unroll
  for (int it = 0; it < 8; ++it) {
    const int o = tid + 512 * it, ln = o & 63, frag = o >> 6, tl = frag >> 3, dt = (frag >> 1) & 3, s = frag & 1;
    const int r = ln & 31, hh = ln >> 5, d = 32 * dt + r;
    unsigned short e[8];
#pragma unroll
    for (int jj = 0; jj < 8; ++jj) { const int key = 32 * tl + 16 * s + 8 * (jj >> 2) + 4 * hh + (jj & 3); e[jj] = Vl[key * 128 + d]; }
    u32x4 wv; wv.x = e[0] | ((unsigned)e[1] << 16); wv.y = e[2] | ((unsigned)e[3] << 16); wv.z = e[4] | ((unsigned)e[5] << 16); wv.w = e[6] | ((unsigned)e[7] << 16);
    *(u32x4*)((unsigned char*)p.Vp + ((size_t)(bh * 128 + 8 * jb + tl) * 8192) + (dt * 2 + s) * 1024 + ln * 16) = wv;
  }
}
__device__ __forceinline__ int crow32(int reg, int hh) { return (reg & 3) + 8 * (reg >> 2) + 4 * hh; }
__device__ void moba_item(const Params& p, LAS float* km, int bh, int ib, int sub, int lane) {
  const int q = lane & 31, hh = lane >> 5;
  const int b = bh >> 2, h = bh & 3;
  const int s0 = 256 * ib + 32 * sub;
  const bf16_t* qrow = p.qb + ((size_t)bh * SEQ + s0 + q) * 128 + 8 * hh;
  bf16x8 Qf[8];
#pragma unroll
  for (int ks = 0; ks < 8; ++ks) Qf[ks] = *(const bf16x8*)(qrow + 16 * ks);
  unsigned selmask = 0;
  if (ib > 0) {
    for (int idx = lane; idx < ib * 32; idx += 64) ((LAS f32x4*)km)[idx] = ((const f32x4*)(p.kmean + (size_t)bh * 16 * 128))[idx];
    float qf[64];
#pragma unroll
    for (int ks = 0; ks < 8; ++ks) { float f[8]; unpack8(__builtin_bit_cast(u32x4, Qf[ks]), f);
#pragma unroll
      for (int jj = 0; jj < 8; ++jj) qf[8 * ks + jj] = f[jj]; }
    float sc[16];
#pragma unroll
    for (int j = 0; j < 16; ++j) {
      sc[j] = -INFINITY;
      if (j < ib) {
        float a = 0.f;
#pragma unroll
        for (int ks = 0; ks < 8; ++ks) {
          const f32x4 k0 = *(const LAS f32x4*)(km + j * 128 + 16 * ks + 8 * hh), k1 = *(const LAS f32x4*)(km + j * 128 + 16 * ks + 8 * hh + 4);
          a += qf[8 * ks] * k0[0] + qf[8 * ks + 1] * k0[1] + qf[8 * ks + 2] * k0[2] + qf[8 * ks + 3] * k0[3];
          a += qf[8 * ks + 4] * k1[0] + qf[8 * ks + 5] * k1[1] + qf[8 * ks + 6] * k1[2] + qf[8 * ks + 7] * k1[3];
        }
        a += __shfl_xor(a, 32, 64);
        sc[j] = a;
      }
    }
#pragma unroll
    for (int r = 0; r < 3; ++r) {
      if (r < ib) {
        float best = -INFINITY; int bi = 0;
#pragma unroll
        for (int j = 0; j < 16; ++j) if (sc[j] > best) { best = sc[j]; bi = j; }
        selmask |= 1u << bi;
#pragma unroll
        for (int j = 0; j < 16; ++j) if (j == bi) sc[j] = -INFINITY;
      }
    }
  }
  const float cscale = 0.08838834764831845f * 1.4426950408889634f;
  float m = -1e30f, l = 0.f;
  f32x16 O[4];
#pragma unroll
  for (int dt = 0; dt < 4; ++dt)
#pragma unroll
    for (int r = 0; r < 16; ++r) O[dt][r] = 0.f;
  const unsigned char* kbase = (const unsigned char*)p.Kp + (size_t)bh * 128 * 8192 + lane * 16;
  const unsigned char* vbase = (const unsigned char*)p.Vp + (size_t)bh * 128 * 8192 + lane * 16;
  auto tile = [&](int kt, int mode, bool selbit) {
    bf16x8 Kf[8], Vf[8];
#pragma unroll
    for (int ks = 0; ks < 8; ++ks) Kf[ks] = *(const bf16x8*)(kbase + (size_t)kt * 8192 + ks * 1024);
#pragma unroll
    for (int f = 0; f < 8; ++f) Vf[f] = *(const bf16x8*)(vbase + (size_t)kt * 8192 + f * 1024);
    f32x16 S;
#pragma unroll
    for (int r = 0; r < 16; ++r) S[r] = 0.f;
#pragma unroll
    for (int ks = 0; ks < 8; ++ks) S = MFMA32(Kf[ks], Qf[ks], S);
    float sv[16]; float mx = -INFINITY;
#pragma unroll
    for (int r = 0; r < 16; ++r) {
      float v = S[r] * cscale;
      if (mode == 1 && crow32(r, hh) > q) v = -INFINITY;
      if (mode == 2 && !selbit) v = -INFINITY;
      sv[r] = v; mx = fmaxf(mx, v);
    }
    mx = fmaxf(mx, __shfl_xor(mx, 32, 64));
    const float mn = fmaxf(m, mx);
    const float alpha = exp2f(m - mn);
    float ps = 0.f;
#pragma unroll
    for (int r = 0; r < 16; ++r) { sv[r] = exp2f(sv[r] - mn); ps += sv[r]; }
    l = l * alpha + ps; m = mn;
    if (__ballot(alpha != 1.f) != 0ull) {
#pragma unroll
      for (int dt = 0; dt < 4; ++dt)
#pragma unroll
        for (int r = 0; r < 16; ++r) O[dt][r] *= alpha;
    }
    const bf16x8 P0 = pack8(sv[0], sv[1], sv[2], sv[3], sv[4], sv[5], sv[6], sv[7]);
    const bf16x8 P1 = pack8(sv[8], sv[9], sv[10], sv[11], sv[12], sv[13], sv[14], sv[15]);
#pragma unroll
    for (int dt = 0; dt < 4; ++dt) { O[dt] = MFMA32(Vf[dt * 2], P0, O[dt]); O[dt] = MFMA32(Vf[dt * 2 + 1], P1, O[dt]); }
  };
  for (int tl = 0; tl < sub; ++tl) tile(8 * ib + tl, 0, true);
  tile(8 * ib + sub, 1, true);
  for (int j = 0; j < ib; ++j) {
    const bool sb = (selmask >> j) & 1u;
    if (__ballot(sb) != 0ull) {
#pragma unroll 1
      for (int tl = 0; tl < 8; ++tl) tile(8 * j + tl, 2, sb);
    }
  }
  l += __shfl_xor(l, 32, 64);
  const float inv = 1.f / l;
  bf16_t* orow = p.mb_out + ((size_t)b * SEQ + s0 + q) * p.mb_out_ld + p.mb_out_off + h * 128;
#pragma unroll
  for (int dt = 0; dt < 4; ++dt)
#pragma unroll
    for (int g4 = 0; g4 < 4; ++g4) {
      u32x2 wv; wv.x = pk2(O[dt][4 * g4] * inv, O[dt][4 * g4 + 1] * inv); wv.y = pk2(O[dt][4 * g4 + 2] * inv, O[dt][4 * g4 + 3] * inv);
      *(u32x2*)(orow + 32 * dt + 8 * g4 + 4 * hh) = wv;
    }
}
__device__ void moba_worker(const Params& p, LAS unsigned char* lds) {
  const int lane = threadIdx.x & 63, w = threadIdx.x >> 6;
  LAS float* km = (LAS float*)(lds + w * 8192);
  for (;;) {
    int idx = 0;
    if (lane == 0) idx = atomicAdd(p.wq, 1);
    idx = __builtin_amdgcn_readfirstlane(idx);
    if (idx >= 2048) break;
    const int ib = 15 - (idx >> 7), rem = idx & 127, bh = rem >> 3, sub = 7 - (rem & 7);
    moba_item(p, km, bh, ib, sub, lane);
  }
}
__device__ void ph_mod(const Params& p, LAS unsigned char* lds, int nblk, int bid) {
  LAS float* sc = (LAS float*)lds;
  LAS float* part = (LAS float*)(lds + 16384);
  const int tid = threadIdx.x;
  if (bid >= 192) return;
  for (int i = tid; i < 4096; i += 512) sc[i] = siluf_(p.c[i]);
  __syncthreads();
  for (int task = bid; task < 192; task += nblk) {
    const int jj = tid & 31, ks = tid >> 5, j = task * 32 + jj;
    float a0 = 0.f, a1 = 0.f, a2 = 0.f, a3 = 0.f;
#pragma unroll 8
    for (int kk = 0; kk < 64; ++kk) {
      const int k = ks * 64 + kk;
      const float w = p.w_ada[(size_t)k * 6144 + j];
      a0 += sc[k] * w; a1 += sc[1024 + k] * w; a2 += sc[2048 + k] * w; a3 += sc[3072 + k] * w;
    }
    *(LAS f32x4*)(part + (ks * 32 + jj) * 4) = (f32x4){a0, a1, a2, a3};
    __syncthreads();
    if (tid < 128) {
      const int j2 = tid & 31, bb = tid >> 5;
      float a = 0.f;
#pragma unroll
      for (int s = 0; s < 16; ++s) a += part[(s * 32 + j2) * 4 + bb];
      p.mod[bb * 6144 + task * 32 + j2] = a + p.b_ada[task * 32 + j2];
    }
    __syncthreads();
  }
}

__device__ __forceinline__ void wt_tile(const float* __restrict__ src, bf16_t* __restrict__ dst, int K, int N, int mode, int k0, int n0, LAS float* tile) {
  const int tid = threadIdx.x;
#pragma unroll
  for (int it = 0; it < 2; ++it) {
    const int row = (tid >> 4) + 32 * it, c4 = (tid & 15) * 4, n = n0 + c4;
    f32x4 v = {0.f, 0.f, 0.f, 0.f};
    if (n < N) v = *(const f32x4*)(src + (size_t)(k0 + row) * N + n);
    tile[row * 65 + c4] = v[0]; tile[row * 65 + c4 + 1] = v[1]; tile[row * 65 + c4 + 2] = v[2]; tile[row * 65 + c4 + 3] = v[3];
  }
  __syncthreads();
  {
    const int nl = tid >> 3, kc = tid & 7, n = n0 + nl;
    if (n < N) {
      const int d = map_col(n, mode);
      if (d >= 0) {
        float f[8];
#pragma unroll
        for (int j = 0; j < 8; ++j) f[j] = tile[(8 * kc + j) * 65 + nl];
        u32x4 w; w.x = pk2(f[0], f[1]); w.y = pk2(f[2], f[3]); w.z = pk2(f[4], f[5]); w.w = pk2(f[6], f[7]);
        *(u32x4*)(dst + (size_t)d * K + k0 + 8 * kc) = w;
      }
    }
  }
  __syncthreads();
}
#define WT_T0 1424
#define WT_T1 (WT_T0 + 16384)
#define WT_T2 (WT_T1 + 8192)
#define WT_T3 (WT_T2 + 128)
#define WT_T4 (WT_T3 + 128)
#define WT_T5 (WT_T4 + 256)
__device__ void ph_wt(const Params& p, LAS unsigned char* lds, int nblk, int bid) {
  LAS float* tile = (LAS float*)(lds + 32768);
  for (int t = bid; t < WT_T5; t += nblk) {
    if (t < WT_T0) { const int kt = t / 89, nt = t % 89; wt_tile(p.w_in, p.w_in_t, 1024, INW, 1, kt * 64, nt * 64, tile); }
    else if (t < WT_T1) { const int u = t - WT_T0, e = u >> 9, r = u & 511, kt = r >> 5, nt = r & 31;
      wt_tile(p.w_gu + (size_t)e * 1024 * 2048, p.wgu_t + (size_t)e * 2048 * 1024, 1024, 2048, 2, kt * 64, nt * 64, tile); }
    else if (t < WT_T2) { const int u = t - WT_T1, e = u >> 8, r = u & 255, kt = r >> 4, nt = r & 15;
      wt_tile(p.w_down + (size_t)e * 1024 * 1024, p.wd_t + (size_t)e * 1024 * 1024, 1024, 1024, 0, kt * 64, nt * 64, tile); }
    else if (t < WT_T3) { const int u = t - WT_T2, kt = u >> 4, nt = u & 15; wt_tile(p.w_br_a, p.wbra_t, 512, 1024, 0, kt * 64, nt * 64, tile); }
    else if (t < WT_T4) { const int u = t - WT_T3, kt = u >> 4, nt = u & 15; wt_tile(p.w_br_b, p.wbrb_t, 512, 1024, 0, kt * 64, nt * 64, tile); }
    else { const int u = t - WT_T4, kt = u >> 4, nt = u & 15; wt_tile(p.w_o, p.wo_t, 1024, 1024, 0, kt * 64, nt * 64, tile); }
  }
}

__device__ void ph_h(const Params& p, int nblk, int bid) {
  const int wid = threadIdx.x >> 6, lane = threadIdx.x & 63;
  for (int t = bid * 8 + wid; t < T_TOK; t += nblk * 8) {
    const int b = t / SEQ;
    const float* xr = p.x + (size_t)t * DM;
    float v[16];
    float ss = 0.f;
#pragma unroll
    for (int i = 0; i < 4; ++i) {
      const f32x4 q = *(const f32x4*)(xr + i * 256 + lane * 4);
      v[i * 4 + 0] = q[0]; v[i * 4 + 1] = q[1]; v[i * 4 + 2] = q[2]; v[i * 4 + 3] = q[3];
      ss += q[0] * q[0] + q[1] * q[1] + q[2] * q[2] + q[3] * q[3];
    }
    ss = wave_sum(ss);
    const float rstd = rsqrtf(ss * (1.f / DM) + 1e-6f);
    const float* shift = p.mod + b * 6144;
    const float* scale = p.mod + b * 6144 + 1024;
    float acc[8] = {0, 0, 0, 0, 0, 0, 0, 0};
#pragma unroll
    for (int i = 0; i < 4; ++i) {
      float hv[4];
#pragma unroll
      for (int j = 0; j < 4; ++j) {
        const int k = i * 256 + lane * 4 + j;
        hv[j] = v[i * 4 + j] * rstd * p.g_pre_mix[k] * (1.f + scale[k]) + shift[k];
        const float* wr = p.w_in + (size_t)k * INW + 2048;
        const f32x4 w0 = *(const f32x4*)wr, w1 = *(const f32x4*)(wr + 4);
        acc[0] += hv[j] * w0[0]; acc[1] += hv[j] * w0[1]; acc[2] += hv[j] * w0[2]; acc[3] += hv[j] * w0[3];
        acc[4] += hv[j] * w1[0]; acc[5] += hv[j] * w1[1]; acc[6] += hv[j] * w1[2]; acc[7] += hv[j] * w1[3];
      }
      u32x2 pk; pk.x = pk2(hv[0], hv[1]); pk.y = pk2(hv[2], hv[3]);
      *(u32x2*)(p.hbf + (size_t)t * DM + i * 256 + lane * 4) = pk;
    }
#pragma unroll
    for (int e = 0; e < 8; ++e) acc[e] = wave_sum(acc[e]);
    if (lane == 0) { *(f32x4*)(p.ba + (size_t)t * 8) = (f32x4){acc[0], acc[1], acc[2], acc[3]}; *(f32x4*)(p.ba + (size_t)t * 8 + 4) = (f32x4){acc[4], acc[5], acc[6], acc[7]}; }
  }
}

__device__ void ph_post_mix(const Params& p, LAS unsigned char* lds, int nblk, int bid) {
  const int wid = threadIdx.x >> 6, lane = threadIdx.x & 63;
  LAS float* sh = (LAS float*)lds + wid * 1024;
  for (int t = bid * 8 + wid; t < T_TOK; t += nblk * 8) {
    const int b = t / SEQ;
    const float* md = p.mod + b * 6144;
    float mv[16];
    float ss = 0.f;
#pragma unroll
    for (int i = 0; i < 2; ++i) {
      float f[8]; unpack8(*(const u32x4*)(p.mixer + (size_t)t * DM + i * 512 + lane * 8), f);
#pragma unroll
      for (int j = 0; j < 8; ++j) { mv[i * 8 + j] = f[j]; ss += f[j] * f[j]; }
    }
    ss = wave_sum(ss);
    const float rstd = rsqrtf(ss * (1.f / DM) + 1e-6f);
    float x1[16];
    float s2 = 0.f;
#pragma unroll
    for (int i = 0; i < 2; ++i)
#pragma unroll
      for (int j4 = 0; j4 < 2; ++j4) {
        const int k = i * 512 + lane * 8 + j4 * 4;
        const f32x4 xv = *(const f32x4*)(p.x + (size_t)t * DM + k);
        const f32x4 gm = *(const f32x4*)(md + 2048 + k), gp = *(const f32x4*)(p.g_post_mix + k);
        f32x4 o;
#pragma unroll
        for (int j = 0; j < 4; ++j) { o[j] = xv[j] + gm[j] * (mv[i * 8 + j4 * 4 + j] * rstd * gp[j]); x1[i * 8 + j4 * 4 + j] = o[j]; s2 += o[j] * o[j]; }
        *(f32x4*)(p.out + (size_t)t * DM + k) = o;
      }
    s2 = wave_sum(s2);
    const float rstd2 = rsqrtf(s2 * (1.f / DM) + 1e-6f);
#pragma unroll
    for (int i = 0; i < 2; ++i) {
      float hv[8];
#pragma unroll
      for (int j = 0; j < 8; ++j) {
        const int k = i * 512 + lane * 8 + j;
        hv[j] = x1[i * 8 + j] * rstd2 * p.g_pre_ffn[k] * (1.f + md[4096 + k]) + md[3072 + k];
        sh[k] = hv[j];
      }
      u32x4 w; w.x = pk2(hv[0], hv[1]); w.y = pk2(hv[2], hv[3]); w.z = pk2(hv[4], hv[5]); w.w = pk2(hv[6], hv[7]);
      *(u32x4*)(p.h2 + (size_t)t * DM + i * 512 + lane * 8) = w;
    }
    const int e = lane & 31, half = lane >> 5;
    float a0 = 0.f, a1 = 0.f, a2 = 0.f, a3 = 0.f;
#pragma unroll 4
    for (int k = half * 512; k < half * 512 + 512; k += 4) {
      const f32x4 hv = *(const LAS f32x4*)(sh + k);
      a0 += hv[0] * p.w_router[(size_t)k * 32 + e]; a1 += hv[1] * p.w_router[(size_t)(k + 1) * 32 + e];
      a2 += hv[2] * p.w_router[(size_t)(k + 2) * 32 + e]; a3 += hv[3] * p.w_router[(size_t)(k + 3) * 32 + e];
    }
    float a = (a0 + a1) + (a2 + a3);
    a += __shfl_xor(a, 32, 64);
    float lg = a + p.b_router[e];
    if (lane >= 32) lg = -INFINITY;
    float tv[4]; int ti[4];
#pragma unroll
    for (int r = 0; r < 4; ++r) {
      const float m = wave_max(lg);
      const unsigned long long bal = __ballot(lg == m);
      const int idx = __ffsll((long long)bal) - 1;
      tv[r] = m; ti[r] = idx;
      if (lane == idx) lg = -INFINITY;
    }
    const float e1 = __expf(tv[1] - tv[0]), e2 = __expf(tv[2] - tv[0]), e3 = __expf(tv[3] - tv[0]);
    const float inv = 1.f / (1.f + e1 + e2 + e3);
    if (lane < 4) {
      const int ee = lane == 0 ? ti[0] : lane == 1 ? ti[1] : lane == 2 ? ti[2] : ti[3];
      const float ww = (lane == 0 ? 1.f : lane == 1 ? e1 : lane == 2 ? e2 : e3) * inv;
      const int pos = atomicAdd(&p.cnt[ee], 1);
      p.elist[ee * T_TOK + pos] = t * 4 + lane;
      p.aw[t * 4 + lane] = ww;
    }
  }
}

__device__ void ph_gather(const Params& p, LAS unsigned char* lds, int nblk, int bid) {
  const int wid = threadIdx.x >> 6, lane = threadIdx.x & 63;
  LAS int* tb = (LAS int*)lds;
  if (threadIdx.x == 0) { int off = 0; for (int k = 0; k < NE; ++k) { const int c = p.cnt[k]; tb[k] = off; tb[64 + k] = c; off += ((c + 255) >> 8) << 8; } tb[NE] = off; }
  __syncthreads();
  const int total = tb[NE];
  for (int r = bid * 8 + wid; r < total; r += nblk * 8) {
    int e = 0;
#pragma unroll 1
    for (int k = 1; k < NE; ++k) if (r >= tb[k]) e = k;
    const int i = r - tb[e];
    const int a = (i < tb[64 + e]) ? p.elist[e * T_TOK + i] : -1;
    if (lane == 0) p.rowmap[r] = a;
    u32x4 v0 = {0, 0, 0, 0}, v1 = v0;
    if (a >= 0) { const u32x4* src = (const u32x4*)(p.h2 + (size_t)(a >> 2) * DM); v0 = src[lane]; v1 = src[64 + lane]; }
    u32x4* dst = (u32x4*)(p.xs + (size_t)r * DM);
    dst[lane] = v0; dst[64 + lane] = v1;
  }
}

__device__ void ph_final(const Params& p, int nblk, int bid) {
  const int wid = threadIdx.x >> 6, lane = threadIdx.x & 63;
  for (int t = bid * 8 + wid; t < T_TOK; t += nblk * 8) {
    const int b = t / SEQ;
    const float* md = p.mod + b * 6144;
    const f32x4 wv = *(const f32x4*)(p.aw + t * 4);
    float mv[16];
    float ss = 0.f;
#pragma unroll
    for (int i = 0; i < 2; ++i) {
      const bf16_t* y = p.yslot + (size_t)t * 4 * DM + i * 512 + lane * 8;
      float f0[8], f1[8], f2[8], f3[8];
      unpack8(*(const u32x4*)y, f0); unpack8(*(const u32x4*)(y + DM), f1); unpack8(*(const u32x4*)(y + 2 * DM), f2); unpack8(*(const u32x4*)(y + 3 * DM), f3);
#pragma unroll
      for (int j = 0; j < 8; ++j) { const float m = wv[0] * f0[j] + wv[1] * f1[j] + wv[2] * f2[j] + wv[3] * f3[j]; mv[i * 8 + j] = m; ss += m * m; }
    }
    ss = wave_sum(ss);
    const float rstd = rsqrtf(ss * (1.f / DM) + 1e-6f);
#pragma unroll
    for (int i = 0; i < 2; ++i)
#pragma unroll
      for (int j4 = 0; j4 < 2; ++j4) {
        const int k = i * 512 + lane * 8 + j4 * 4;
        float* op = p.out + (size_t)t * DM + k;
        const f32x4 x1 = *(const f32x4*)op, gf = *(const f32x4*)(md + 5120 + k), gp = *(const f32x4*)(p.g_post_ffn + k);
        f32x4 o;
#pragma unroll
        for (int j = 0; j < 4; ++j) o[j] = x1[j] + gf[j] * (mv[i * 8 + j4 * 4 + j] * rstd * gp[j]);
        *(f32x4*)op = o;
      }
  }
}

#define MEGA_LDS 148480
__global__ __launch_bounds__(512) void mega(Params p) {
  extern __shared__ __attribute__((aligned(16))) unsigned char shm[];
  LAS unsigned char* lds = (LAS unsigned char*)shm;
  cg::grid_group grid = cg::this_grid();
  const int nblk = gridDim.x, bid = blockIdx.x;
  ph_mod(p, lds, nblk, bid);
  ph_wt(p, lds, nblk, bid);
  grid.sync();
  ph_h(p, nblk, bid);
  grid.sync();
  ph_proj(p, lds, nblk, bid);
  grid.sync();
  { bool first = true; for (int ci = bid; ci < 1024; ci += nblk) { dn_prep_chunk(p, lds, ci, first); first = false; } }
  for (int item = bid; item < 256; item += nblk) moba_prep_block(p, lds, item);
  grid.sync();
  if (bid < 16) dn_scan_bh(p, lds, bid);
  moba_worker(p, lds);
  grid.sync();
  ph_br(p, lds, nblk, bid);
  grid.sync();
  ph_mix(p, lds, nblk, bid);
  grid.sync();
  ph_post_mix(p, lds, nblk, bid);
  grid.sync();
  ph_gather(p, lds, nblk, bid);
  grid.sync();
  ph_moe1(p, lds, nblk, bid);
  grid.sync();
  ph_moe2(p, lds, nblk, bid);
  grid.sync();
  ph_final(p, nblk, bid);
}
static inline size_t al(size_t x) { return (x + 255) & ~(size_t)255; }

extern "C" void kernel_launch(void* const* d_in, const int* in_sizes, int n_in, void* d_out, int out_size, void* d_ws,
                              size_t ws_size, hipStream_t stream) {
  Params p{};
  p.x = (const float*)d_in[0]; p.c = (const float*)d_in[1]; p.w_ada = (const float*)d_in[2]; p.b_ada = (const float*)d_in[3];
  p.g_pre_mix = (const float*)d_in[4]; p.g_post_mix = (const float*)d_in[5]; p.g_pre_ffn = (const float*)d_in[6];
  p.g_post_ffn = (const float*)d_in[7]; p.w_in = (const float*)d_in[8]; p.conv_w = (const float*)d_in[9];
  p.a_log = (const float*)d_in[10]; p.dt_bias = (const float*)d_in[11]; p.g_dn_out = (const float*)d_in[12];
  p.w_br_a = (const float*)d_in[13]; p.w_br_b = (const float*)d_in[14]; p.w_o = (const float*)d_in[15];
  p.w_router = (const float*)d_in[16]; p.b_router = (const float*)d_in[17]; p.w_gu = (const float*)d_in[18];
  p.b_gu = (const float*)d_in[19]; p.w_down = (const float*)d_in[20]; p.b_down = (const float*)d_in[21];
  p.out = (float*)d_out;
  char* w = (char*)d_ws;
  size_t o = 0;
  auto take = [&](size_t bytes) { char* r = w + o; o += al(bytes); return r; };
  p.mod = (float*)take(4 * 6144 * 4);
  p.cnt = (int*)take(256);
  p.ba = (float*)take((size_t)T_TOK * 8 * 4);
  p.hbf = (bf16_t*)take((size_t)T_TOK * DM * 2);
  p.proj = (bf16_t*)take((size_t)T_TOK * PW * 2);
  p.w_in_t = (bf16_t*)take((size_t)PW * DM * 2);
  p.wgu_t = (bf16_t*)take((size_t)NE * 2048 * DM * 2);
  p.wd_t = (bf16_t*)take((size_t)NE * 1024 * DM * 2);
  p.wbra_t = (bf16_t*)take((size_t)1024 * 512 * 2);
  p.wbrb_t = (bf16_t*)take((size_t)1024 * 512 * 2);
  p.wo_t = (bf16_t*)take((size_t)1024 * 1024 * 2);
  p.qb = (bf16_t*)take((size_t)T_TOK * 512 * 2);
  p.kb = (bf16_t*)take((size_t)T_TOK * 512 * 2);
  p.kmean = (float*)take((size_t)16 * 16 * 128 * 4);
  p.oab = (bf16_t*)take((size_t)T_TOK * DM * 2);
  p.merged = (bf16_t*)take((size_t)T_TOK * DM * 2);
  p.mixer = (bf16_t*)take((size_t)T_TOK * DM * 2);
  p.h2 = (bf16_t*)take((size_t)T_TOK * DM * 2);
  p.elist = (int*)take((size_t)NE * T_TOK * 4);
  p.aw = (float*)take((size_t)T_TOK * 4 * 4);
  p.rowmap = (int*)take((size_t)73728 * 4);
  p.dnA = (unsigned char*)take((size_t)1024 * DN_ABYTES);
  p.dnU = (float*)take((size_t)1024 * DN_UFLOATS * 4);
  p.dnG = (float*)take(4096);
  p.oab2 = (bf16_t*)take((size_t)T_TOK * 512 * 2);
  p.dbg = (float*)take(256);
  p.dn_out = p.oab; p.dn_out_ld = DM;
  p.Kp = (bf16_t*)take((size_t)16 * 128 * 8192);
  p.Vp = (bf16_t*)take((size_t)16 * 128 * 8192);
  p.wq = p.cnt + 32;
  p.mb_out = p.oab; p.mb_out_ld = DM; p.mb_out_off = 512;
  p.xs = p.proj;
  char* big = take((size_t)73728 * DM * 2 + (size_t)65536 * DM * 2);
  p.act = (bf16_t*)big;
  p.yslot = (bf16_t*)(big + (size_t)73728 * DM * 2);
  {
    char* s = big; size_t so = 0;
    auto t2 = [&](size_t bytes) { char* r = s + so; so += al(bytes); return r; };
    p.nq = (float*)t2((size_t)T_TOK * 512 * 4);
    p.nk = (float*)t2((size_t)T_TOK * 512 * 4);
    p.nv = (float*)t2((size_t)T_TOK * 512 * 4);
    p.no = (float*)t2((size_t)T_TOK * 512 * 4);
    p.ntmp = (float*)t2((size_t)T_TOK * DM * 4);
    p.nbeta = (float*)t2((size_t)T_TOK * 4 * 4);
    p.ng = (float*)t2((size_t)T_TOK * 4 * 4);
  }

  static int grid_blocks = 0;
  if (!grid_blocks) {
    (void)hipFuncSetAttribute((const void*)mega, hipFuncAttributeMaxDynamicSharedMemorySize, MEGA_LDS);
    int dev = 0, cus = 0, per_cu = 0;
    (void)hipGetDevice(&dev);
    (void)hipDeviceGetAttribute(&cus, hipDeviceAttributeMultiprocessorCount, dev);
    (void)hipOccupancyMaxActiveBlocksPerMultiprocessor(&per_cu, mega, 512, MEGA_LDS);
    if (per_cu != 1) per_cu = 1;
    grid_blocks = cus * per_cu;
  }
  (void)hipMemsetAsync(p.cnt, 0, 256, stream);
  void* args[] = {&p};
  hipError_t e = hipLaunchCooperativeKernel((void*)mega, dim3(grid_blocks), dim3(512), args, MEGA_LDS, stream);
  if (e != hipSuccess) fprintf(stderr, "cooperative launch failed: %s (grid %d)\n", hipGetErrorString(e), grid_blocks);
}
```

```cpp
#include <hip/hip_runtime.h>
#include <hip/hip_cooperative_groups.h>
#include <cstdio>
namespace cg = cooperative_groups;
#include <stdint.h>

typedef unsigned short bf16_t;

#define T_TOK 16384
#define SEQ 4096
#define NB 4
#define DM 1024
#define INW 5640
#define PW 5632
#define C_QA 0
#define C_KA 512
#define C_VA 1024
#define C_Z 1536
#define C_MQ 2048
#define C_MK 2560
#define C_MV 3072
#define C_GA 3584
#define C_GB 4608
#define NE 32

__device__ __forceinline__ bf16_t f2bf(float f) {
  unsigned u = __float_as_uint(f);
  u += 0x7fffu + ((u >> 16) & 1u);
  return (bf16_t)(u >> 16);
}
__device__ __forceinline__ float bf2f(bf16_t h) { return __uint_as_float(((unsigned)h) << 16); }
__device__ __forceinline__ float sigmoidf_(float x) { return 1.f / (1.f + __expf(-x)); }
__device__ __forceinline__ float siluf_(float x) { return x / (1.f + __expf(-x)); }
__device__ __forceinline__ float wave_sum(float v) {
#pragma unroll
  for (int o = 32; o > 0; o >>= 1) v += __shfl_xor(v, o, 64);
  return v;
}
__device__ __forceinline__ float wave_max(float v) {
#pragma unroll
  for (int o = 32; o > 0; o >>= 1) v = fmaxf(v, __shfl_xor(v, o, 64));
  return v;
}

struct Params {
  const float *x, *c, *w_ada, *b_ada, *g_pre_mix, *g_post_mix, *g_pre_ffn, *g_post_ffn, *w_in, *conv_w,
      *a_log, *dt_bias, *g_dn_out, *w_br_a, *w_br_b, *w_o, *w_router, *b_router, *w_gu, *b_gu, *w_down, *b_down;
  float* out;
  float* mod;
  int* cnt;
  float* ba;
  bf16_t* hbf;
  bf16_t* proj;
  bf16_t* w_in_t;
  bf16_t* wgu_t;
  bf16_t* wd_t;
  bf16_t* wbra_t;
  bf16_t* wbrb_t;
  bf16_t* wo_t;
  bf16_t* qb;
  bf16_t* kb;
  float* kmean;
  bf16_t* oab;
  bf16_t* merged;
  bf16_t* mixer;
  bf16_t* h2;
  int* elist;
  float* aw;
  bf16_t* act;
  bf16_t* xs;
  int* rowmap;
  bf16_t* yslot;
  unsigned char* dnA; float* dnU; float* dnG;
  bf16_t* dn_out; int dn_out_ld;
  bf16_t* oab2; float* dbg;
  unsigned* bar; int never;
  bf16_t* Kp; bf16_t* Vp; int* wq;
  bf16_t* mb_out; int mb_out_ld; int mb_out_off;
  float* nq; float* nk; float* nv;
  float* nbeta; float* ng;
  float* no;
  float* ntmp;
};

__device__ __forceinline__ int map_col(int n, int mode) {
  if (mode == 0) return n;
  if (mode == 1) return n < 2048 ? n : (n < 2056 ? -1 : n - 8);
  if (n < 1024) return (n >> 7) * 256 + (n & 127);
  int j = n - 1024;
  return (j >> 7) * 256 + 128 + (j & 127);
}
namespace pg8 {
#define PG8_LAS __attribute__((address_space(3)))
typedef short bf16x8 __attribute__((ext_vector_type(8)));
typedef float f32x4 __attribute__((ext_vector_type(4)));
typedef unsigned u32x4 __attribute__((ext_vector_type(4)));
constexpr int BM = 256, BK = 64, HALF = 128, HTB = HALF * BK * 2, STAGE_BYTES = 8 * HTB, NXCD = 8, WGM = 8;

__host__ __device__ __forceinline__ int lds_byte(int r, int c) { const int st = (r >> 4) * 2 + (c >> 5), rr = r & 15, cc = c & 31, ob = rr * 64 + cc * 2; return st * 1024 + (ob ^ (((ob >> 9) & 1) << 5)); }
__host__ __device__ __forceinline__ void stage_rc(int b, int& R, int& C) { const int st = b / 1024, sb = b % 1024, swz = sb ^ (((sb >> 9) & 1) << 5); R = (st >> 1) * 16 + swz / 64; C = (st & 1) * 32 + (swz % 64) / 2; }
__host__ __device__ __forceinline__ int perm32(int rho) { const int n = rho >> 4, i = rho & 15; return 8 * (i >> 2) + 4 * n + (i & 3); }

struct Unit { int pm, pn, z; };
__device__ __forceinline__ unsigned cvt_pk_bf16(float lo, float hi) { unsigned r; asm volatile("v_cvt_pk_bf16_f32 %0, %1, %2" : "=v"(r) : "v"(lo), "v"(hi)); return r; }

struct TileOrder {
    int nM, nN, nwg, G, c;
    __device__ void init(int nM_, int nN_, int G_, int c_) { nM = nM_; nN = nN_; nwg = nM * nN; G = G_; c = c_; }
    __device__ bool tile(int i, int& pm, int& pn) const {
        const long L = (long)i * G + c; if (L >= nwg) return false;
        int wgid = (int)L; { const int q = nwg / NXCD, r = nwg % NXCD, xcd = wgid % NXCD, off = wgid / NXCD; wgid = (xcd < r ? xcd * (q + 1) : r * (q + 1) + (xcd - r) * q) + off; }
        const int nig = WGM * nN, gid = wgid / nig, fm = gid * WGM, gsz = (nM - fm) < WGM ? (nM - fm) : WGM;
        pm = fm + ((wgid % nig) % gsz); pn = (wgid % nig) / gsz; return true;
    }
};

template <class Epi, class Sched>
__device__ __forceinline__ void gemm_phase(PG8_LAS unsigned char* lds, const int lda, const int ldb, const int K, const Sched& S, const Epi& E) {
    const int tid = threadIdx.x, wid = __builtin_amdgcn_readfirstlane(tid >> 6), lane = tid & 63, wr = wid >> 2, wc = wid & 3, fr = lane & 15, fq = lane >> 4;
    const int nt = K / BK;
    unsigned voffA[2], voffB[2];
#pragma unroll
    for (int i = 0; i < 2; ++i) { int R, C; stage_rc(tid * 16 + i * 8192, R, C); const int Rb = Epi::PERM ? ((R & ~31) + perm32(R & 31)) : R;
        voffA[i] = (unsigned)(R * lda + C) * 2u; voffB[i] = (unsigned)(Rb * ldb + C) * 2u; }
    const size_t kstep = (size_t)(BK * 2);
    const size_t hstepA = (size_t)HALF * lda * 2, hstepB = (size_t)HALF * ldb * 2;
    const unsigned ldsw = (unsigned)wid * 1024u;
    const int aoff = lds_byte(wr * 64 + fr, fq * 8), boff = lds_byte(wc * 32 + fr, fq * 8);
#define PG8_SA(b, h) (((b) * 2 + (h)) * HTB)
#define PG8_SB(b, h) ((4 + (b) * 2 + (h)) * HTB)
#define PG8_STAGE(bufoff, gbase, voff) do { _Pragma("unroll") for (int _i = 0; _i < 2; ++_i) \
        __builtin_amdgcn_global_load_lds((const unsigned*)((const char*)(gbase) + (voff)[_i]), (PG8_LAS unsigned*)(lds + (bufoff) + ldsw + _i * 8192), 16, 0, 0); } while (0)
#define PG8_LDA(dst, b, h) do { _Pragma("unroll") for (int m = 0; m < 4; ++m) _Pragma("unroll") for (int k = 0; k < 2; ++k) dst[m][k] = *(const PG8_LAS bf16x8*)(lds + PG8_SA(b, h) + aoff + m * 2048 + k * 1024); } while (0)
#define PG8_LDB(dst, b, h) do { _Pragma("unroll") for (int n = 0; n < 2; ++n) _Pragma("unroll") for (int k = 0; k < 2; ++k) dst[n][k] = *(const PG8_LAS bf16x8*)(lds + PG8_SB(b, h) + boff + n * 2048 + k * 1024); } while (0)
#define PG8_MMA(ai, bj, At, Bt) do { __builtin_amdgcn_s_setprio(1); _Pragma("unroll") for (int m = 0; m < 4; ++m) _Pragma("unroll") for (int n = 0; n < 2; ++n) _Pragma("unroll") for (int k = 0; k < 2; ++k) \
        acc[ai][bj][m][n] = __builtin_amdgcn_mfma_f32_16x16x32_bf16(Bt[n][k], At[m][k], acc[ai][bj][m][n], 0, 0, 0); __builtin_amdgcn_s_setprio(0); } while (0)
#define PG8_WAIT_V(n) asm volatile("s_waitcnt vmcnt(" #n ")" ::: "memory")
#define PG8_WAIT_L(n) asm volatile("s_waitcnt lgkmcnt(" #n ")" ::: "memory")
#define PG8_BAR __builtin_amdgcn_s_barrier()
#define PG8_SCHED __builtin_amdgcn_sched_barrier(0)
    Unit cur, nxt; int ui = 0;
    if (!S.next(0, cur)) return;
    f32x4 acc[2][2][4][2];
#pragma unroll
    for (int a = 0; a < 2; ++a)
#pragma unroll
        for (int b = 0; b < 2; ++b)
#pragma unroll
            for (int m = 0; m < 4; ++m)
#pragma unroll
                for (int n = 0; n < 2; ++n) acc[a][b][m][n] = (f32x4){0.f, 0.f, 0.f, 0.f};
    bf16x8 At[4][2], B0[2][2], B1[2][2];
    const char* cA = S.a_ptr(cur); const char* cB = S.b_ptr(cur);
    PG8_STAGE(PG8_SB(0, 0), cB, voffB); PG8_STAGE(PG8_SA(0, 0), cA, voffA); PG8_STAGE(PG8_SB(0, 1), cB + hstepB, voffB); PG8_STAGE(PG8_SA(0, 1), cA + hstepA, voffA);
    if (wr == 1) PG8_BAR;
    PG8_WAIT_V(4); PG8_BAR;
    PG8_STAGE(PG8_SB(1, 0), cB + kstep, voffB); PG8_STAGE(PG8_SA(1, 0), cA + kstep, voffA); PG8_STAGE(PG8_SB(1, 1), cB + hstepB + kstep, voffB);
    PG8_WAIT_V(6); PG8_BAR;
    for (;;) {
        const bool has_next = S.next(ui + 1, nxt);
        const char* nA = has_next ? S.a_ptr(nxt) : cA; const char* nB = has_next ? S.b_ptr(nxt) : cB;
        for (int t = 0; t < nt; t += 2) {
            const bool last = (t == nt - 2);
            const char* a1 = cA + (size_t)(t + 1) * kstep;
            const char* a2 = last ? nA : cA + (size_t)(t + 2) * kstep; const char* b2 = last ? nB : cB + (size_t)(t + 2) * kstep;
            const char* a3 = a2 + kstep; const char* b3 = b2 + kstep;
            PG8_LDB(B0, 0, 0); PG8_SCHED; PG8_LDA(At, 0, 0); PG8_STAGE(PG8_SA(1, 1), a1 + hstepA, voffA);
            PG8_WAIT_L(8); PG8_BAR; PG8_WAIT_L(0); PG8_MMA(0, 0, At, B0); PG8_BAR; PG8_SCHED;
            PG8_LDB(B1, 0, 1); PG8_STAGE(PG8_SB(0, 0), b2, voffB);
            PG8_BAR; PG8_WAIT_L(0); PG8_MMA(0, 1, At, B1); PG8_BAR;
            PG8_LDA(At, 0, 1); PG8_STAGE(PG8_SA(0, 0), a2, voffA);
            PG8_BAR; PG8_WAIT_L(0); PG8_MMA(1, 0, At, B0); PG8_BAR; PG8_SCHED;
            PG8_STAGE(PG8_SB(0, 1), b2 + hstepB, voffB);
            PG8_WAIT_V(6); PG8_BAR; PG8_MMA(1, 1, At, B1); PG8_BAR;
            PG8_LDB(B0, 1, 0); PG8_SCHED; PG8_LDA(At, 1, 0); PG8_STAGE(PG8_SA(0, 1), a2 + hstepA, voffA);
            PG8_WAIT_L(8); PG8_BAR; PG8_WAIT_L(0); PG8_MMA(0, 0, At, B0); PG8_BAR; PG8_SCHED;
            PG8_LDB(B1, 1, 1); PG8_STAGE(PG8_SB(1, 0), b3, voffB);
            PG8_BAR; PG8_WAIT_L(0); PG8_MMA(0, 1, At, B1); PG8_BAR;
            PG8_LDA(At, 1, 1); PG8_STAGE(PG8_SA(1, 0), a3, voffA);
            PG8_BAR; PG8_WAIT_L(0); PG8_MMA(1, 0, At, B0); PG8_BAR; PG8_SCHED;
            PG8_STAGE(PG8_SB(1, 1), b3 + hstepB, voffB);
            PG8_WAIT_V(6); PG8_BAR; PG8_MMA(1, 1, At, B1); PG8_BAR;
        }
        E(acc, cur, wr, wc, fr, fq);
        if (!has_next) break;
#pragma unroll
        for (int a = 0; a < 2; ++a)
#pragma unroll
            for (int b = 0; b < 2; ++b)
#pragma unroll
                for (int m = 0; m < 4; ++m)
#pragma unroll
                    for (int n = 0; n < 2; ++n) acc[a][b][m][n] = (f32x4){0.f, 0.f, 0.f, 0.f};
        cur = nxt; cA = nA; cB = nB; ++ui;
    }
    PG8_WAIT_V(0);
    if (wr == 0) PG8_BAR;
    PG8_BAR;
#undef PG8_SA
#undef PG8_SB
#undef PG8_STAGE
#undef PG8_LDA
#undef PG8_LDB
#undef PG8_MMA
#undef PG8_WAIT_V
#undef PG8_WAIT_L
#undef PG8_BAR
#undef PG8_SCHED
}
}
using pg8::f32x4; using pg8::u32x4; using pg8::Unit;

#define GEMM_LDS (pg8::STAGE_BYTES + 1024)

struct SchedProj : pg8::TileOrder {
  const char* A; const char* B;
  __device__ bool next(int i, Unit& u) const { u.z = 0; return tile(i, u.pm, u.pn); }
  __device__ const char* a_ptr(const Unit& u) const { return A + (size_t)u.pm * 256 * DM * 2; }
  __device__ const char* b_ptr(const Unit& u) const { return B + (size_t)u.pn * 256 * DM * 2; }
};
struct EpiProj {
  static constexpr bool PERM = true;
  bf16_t* O;
  __device__ __forceinline__ void operator()(const f32x4 (&acc)[2][2][4][2], const Unit& u, int wr, int wc, int fr, int fq) const {
    const int row0 = u.pm * 256 + wr * 64 + fr, col0 = u.pn * 256 + wc * 32 + 8 * fq;
    const bool gate = u.pn >= (C_GA / 256);
#pragma unroll
    for (int ai = 0; ai < 2; ++ai)
#pragma unroll
      for (int m = 0; m < 4; ++m) {
        bf16_t* rowp = O + (size_t)(row0 + ai * 128 + m * 16) * PW + col0;
#pragma unroll
        for (int bj = 0; bj < 2; ++bj) {
          f32x4 v0 = acc[ai][bj][m][0], v1 = acc[ai][bj][m][1];
          if (gate) {
#pragma unroll
            for (int j = 0; j < 4; ++j) { v0[j] = sigmoidf_(v0[j]); v1[j] = sigmoidf_(v1[j]); }
          }
          u32x4 w; w.x = pg8::cvt_pk_bf16(v0[0], v0[1]); w.y = pg8::cvt_pk_bf16(v0[2], v0[3]); w.z = pg8::cvt_pk_bf16(v1[0], v1[1]); w.w = pg8::cvt_pk_bf16(v1[2], v1[3]);
          *(u32x4*)(rowp + bj * 128) = w;
        }
      }
  }
};
__device__ void ph_proj(const Params& p, PG8_LAS unsigned char* lds, int nblk, int bid) {
  SchedProj S; S.init(T_TOK / 256, PW / 256, nblk, bid); S.A = (const char*)p.hbf; S.B = (const char*)p.w_in_t;
  EpiProj E{p.proj};
  pg8::gemm_phase(lds, DM, DM, DM, S, E);
}

struct SchedBr : pg8::TileOrder {
  const char* A; const char* Ba; const char* Bb;
  __device__ bool next(int i, Unit& u) const { u.z = i & 1; return tile(i >> 1, u.pm, u.pn); }
  __device__ const char* a_ptr(const Unit& u) const { return A + (size_t)u.pm * 256 * DM * 2 + u.z * 512 * 2; }
  __device__ const char* b_ptr(const Unit& u) const { return (u.z ? Bb : Ba) + (size_t)u.pn * 256 * 512 * 2; }
};
__device__ __forceinline__ void unpack8(const u32x4 w, float (&f)[8]) {
  f[0] = __uint_as_float(w.x << 16); f[1] = __uint_as_float(w.x & 0xffff0000u); f[2] = __uint_as_float(w.y << 16); f[3] = __uint_as_float(w.y & 0xffff0000u);
  f[4] = __uint_as_float(w.z << 16); f[5] = __uint_as_float(w.z & 0xffff0000u); f[6] = __uint_as_float(w.w << 16); f[7] = __uint_as_float(w.w & 0xffff0000u);
}
struct EpiBr {
  static constexpr bool PERM = true;
  const bf16_t* proj; bf16_t* O;
  __device__ __forceinline__ void operator()(const f32x4 (&acc)[2][2][4][2], const Unit& u, int wr, int wc, int fr, int fq) const {
    const int row0 = u.pm * 256 + wr * 64 + fr, col0 = u.pn * 256 + wc * 32 + 8 * fq;
    const int gcol = (u.z ? C_GB : C_GA) + col0;
#pragma unroll
    for (int ai = 0; ai < 2; ++ai)
#pragma unroll
      for (int m = 0; m < 4; ++m) {
        const size_t row = (size_t)(row0 + ai * 128 + m * 16);
        bf16_t* rowp = O + row * DM + col0;
        const bf16_t* gp = proj + row * PW + gcol;
#pragma unroll
        for (int bj = 0; bj < 2; ++bj) {
          float g[8]; unpack8(*(const u32x4*)(gp + bj * 128), g);
          f32x4 v0 = acc[ai][bj][m][0], v1 = acc[ai][bj][m][1];
          float r[8];
#pragma unroll
          for (int j = 0; j < 4; ++j) { r[j] = v0[j] * g[j]; r[4 + j] = v1[j] * g[4 + j]; }
          if (u.z) {
            float pv[8]; unpack8(*(const u32x4*)(rowp + bj * 128), pv);
#pragma unroll
            for (int j = 0; j < 8; ++j) r[j] += pv[j];
          }
          u32x4 w; w.x = pg8::cvt_pk_bf16(r[0], r[1]); w.y = pg8::cvt_pk_bf16(r[2], r[3]); w.z = pg8::cvt_pk_bf16(r[4], r[5]); w.w = pg8::cvt_pk_bf16(r[6], r[7]);
          *(u32x4*)(rowp + bj * 128) = w;
        }
      }
  }
};
__device__ void ph_br(const Params& p, PG8_LAS unsigned char* lds, int nblk, int bid) {
  SchedBr S; S.init(T_TOK / 256, DM / 256, nblk, bid); S.A = (const char*)p.oab; S.Ba = (const char*)p.wbra_t; S.Bb = (const char*)p.wbrb_t;
  EpiBr E{p.proj, p.merged};
  pg8::gemm_phase(lds, DM, 512, 512, S, E);
}

struct SchedMix : pg8::TileOrder {
  const char* A; const char* B;
  __device__ bool next(int i, Unit& u) const { u.z = 0; return tile(i, u.pm, u.pn); }
  __device__ const char* a_ptr(const Unit& u) const { return A + (size_t)u.pm * 256 * DM * 2; }
  __device__ const char* b_ptr(const Unit& u) const { return B + (size_t)u.pn * 256 * DM * 2; }
};
struct EpiMix {
  static constexpr bool PERM = true;
  bf16_t* O;
  __device__ __forceinline__ void operator()(const f32x4 (&acc)[2][2][4][2], const Unit& u, int wr, int wc, int fr, int fq) const {
    const int row0 = u.pm * 256 + wr * 64 + fr, col0 = u.pn * 256 + wc * 32 + 8 * fq;
#pragma unroll
    for (int ai = 0; ai < 2; ++ai)
#pragma unroll
      for (int m = 0; m < 4; ++m) {
        bf16_t* rowp = O + (size_t)(row0 + ai * 128 + m * 16) * DM + col0;
#pragma unroll
        for (int bj = 0; bj < 2; ++bj) {
          const f32x4 v0 = acc[ai][bj][m][0], v1 = acc[ai][bj][m][1];
          u32x4 w; w.x = pg8::cvt_pk_bf16(v0[0], v0[1]); w.y = pg8::cvt_pk_bf16(v0[2], v0[3]); w.z = pg8::cvt_pk_bf16(v1[0], v1[1]); w.w = pg8::cvt_pk_bf16(v1[2], v1[3]);
          *(u32x4*)(rowp + bj * 128) = w;
        }
      }
  }
};
__device__ void ph_mix(const Params& p, PG8_LAS unsigned char* lds, int nblk, int bid) {
  SchedMix S; S.init(T_TOK / 256, DM / 256, nblk, bid); S.A = (const char*)p.merged; S.B = (const char*)p.wo_t;
  EpiMix E{p.mixer};
  pg8::gemm_phase(lds, DM, DM, DM, S, E);
}

struct SchedMoe {
  const PG8_LAS int* tb; int NT; int G, c; int nwg;
  const char* A; const char* B; size_t bexp;
  __device__ bool next(int i, Unit& u) const {
    const long L = (long)i * G + c; if (L >= nwg) return false;
    int wgid = (int)L; { const int q = nwg / 8, r = nwg % 8, xcd = wgid % 8, off = wgid / 8; wgid = (xcd < r ? xcd * (q + 1) : r * (q + 1) + (xcd - r) * q) + off; }
    int e = 0;
#pragma unroll 1
    for (int k = 1; k < NE; ++k) if (wgid >= tb[k]) e = k;
    const int q = wgid - tb[e]; const int tiles = tb[33 + e + 1] - tb[33 + e];
    u.pm = tb[33 + e] + q % tiles; u.pn = q / tiles; u.z = e; return true;
  }
  __device__ const char* a_ptr(const Unit& u) const { return A + (size_t)u.pm * 256 * DM * 2; }
  __device__ const char* b_ptr(const Unit& u) const { return B + (size_t)u.z * bexp + (size_t)u.pn * 256 * DM * 2; }
};
__device__ __forceinline__ void moe_table(const Params& p, PG8_LAS int* tb, int NT) {
  if (threadIdx.x == 0) {
    int ub = 0, tbp = 0;
    for (int e = 0; e < NE; ++e) { tb[e] = ub; tb[33 + e] = tbp; const int t = (p.cnt[e] + 255) >> 8; ub += t * NT; tbp += t; }
    tb[NE] = ub; tb[33 + NE] = tbp;
  }
  __syncthreads();
}
struct EpiMoe1 {
  static constexpr bool PERM = true;
  const float* b_gu; bf16_t* act;
  __device__ __forceinline__ void operator()(const f32x4 (&acc)[2][2][4][2], const Unit& u, int wr, int wc, int fr, int fq) const {
    const int row0 = u.pm * 256 + wr * 64 + fr, jc = u.pn * 128 + wc * 32 + 8 * fq;
    const float* bg = b_gu + (size_t)u.z * 2048 + jc;
    float bgv[8], buv[8];
#pragma unroll
    for (int j = 0; j < 8; ++j) { bgv[j] = bg[j]; buv[j] = bg[1024 + j]; }
#pragma unroll
    for (int ai = 0; ai < 2; ++ai)
#pragma unroll
      for (int m = 0; m < 4; ++m) {
        bf16_t* rowp = act + (size_t)(row0 + ai * 128 + m * 16) * DM + jc;
        float r[8];
#pragma unroll
        for (int n = 0; n < 2; ++n)
#pragma unroll
          for (int j = 0; j < 4; ++j) {
            float g = acc[ai][0][m][n][j] + bgv[n * 4 + j], up = acc[ai][1][m][n][j] + buv[n * 4 + j];
            g = fminf(g, 7.f); up = fminf(fmaxf(up, -7.f), 7.f);
            r[n * 4 + j] = (up + 1.f) * g * sigmoidf_(1.702f * g);
          }
        u32x4 w; w.x = pg8::cvt_pk_bf16(r[0], r[1]); w.y = pg8::cvt_pk_bf16(r[2], r[3]); w.z = pg8::cvt_pk_bf16(r[4], r[5]); w.w = pg8::cvt_pk_bf16(r[6], r[7]);
        *(u32x4*)rowp = w;
      }
  }
};
__device__ void ph_moe1(const Params& p, PG8_LAS unsigned char* lds, int nblk, int bid) {
  PG8_LAS int* tb = (PG8_LAS int*)(lds + pg8::STAGE_BYTES);
  moe_table(p, tb, 8);
  SchedMoe S; S.tb = tb; S.NT = 8; S.G = nblk; S.c = bid; S.nwg = tb[NE]; S.A = (const char*)p.xs; S.B = (const char*)p.wgu_t; S.bexp = (size_t)2048 * DM * 2;
  EpiMoe1 E{p.b_gu, p.act};
  pg8::gemm_phase(lds, DM, DM, DM, S, E);
}
struct EpiMoe2 {
  static constexpr bool PERM = true;
  const float* b_down; const int* rowmap; bf16_t* yslot;
  __device__ __forceinline__ void operator()(const f32x4 (&acc)[2][2][4][2], const Unit& u, int wr, int wc, int fr, int fq) const {
    const int row0 = u.pm * 256 + wr * 64 + fr, col0 = u.pn * 256 + wc * 32 + 8 * fq;
    const float* bd = b_down + (size_t)u.z * 1024 + col0;
    float bv[2][8];
#pragma unroll
    for (int bj = 0; bj < 2; ++bj)
#pragma unroll
      for (int j = 0; j < 8; ++j) bv[bj][j] = bd[bj * 128 + j];
#pragma unroll
    for (int ai = 0; ai < 2; ++ai)
#pragma unroll
      for (int m = 0; m < 4; ++m) {
        const int a = rowmap[row0 + ai * 128 + m * 16];
        if (a >= 0) {
          bf16_t* rowp = yslot + (size_t)a * DM + col0;
#pragma unroll
          for (int bj = 0; bj < 2; ++bj) {
            const f32x4 v0 = acc[ai][bj][m][0], v1 = acc[ai][bj][m][1];
            u32x4 w; w.x = pg8::cvt_pk_bf16(v0[0] + bv[bj][0], v0[1] + bv[bj][1]); w.y = pg8::cvt_pk_bf16(v0[2] + bv[bj][2], v0[3] + bv[bj][3]);
            w.z = pg8::cvt_pk_bf16(v1[0] + bv[bj][4], v1[1] + bv[bj][5]); w.w = pg8::cvt_pk_bf16(v1[2] + bv[bj][6], v1[3] + bv[bj][7]);
            *(u32x4*)(rowp + bj * 128) = w;
          }
        }
      }
  }
};
__device__ void ph_moe2(const Params& p, PG8_LAS unsigned char* lds, int nblk, int bid) {
  PG8_LAS int* tb = (PG8_LAS int*)(lds + pg8::STAGE_BYTES);
  moe_table(p, tb, 4);
  SchedMoe S; S.tb = tb; S.NT = 4; S.G = nblk; S.c = bid; S.nwg = tb[NE]; S.A = (const char*)p.act; S.B = (const char*)p.wd_t; S.bexp = (size_t)1024 * DM * 2;
  EpiMoe2 E{p.b_down, p.rowmap, p.yslot};
  pg8::gemm_phase(lds, DM, DM, DM, S, E);
}

typedef short bf16x8 __attribute__((ext_vector_type(8)));
typedef __bf16 bf16x2_t __attribute__((ext_vector_type(2)));
typedef float f32x2_t __attribute__((ext_vector_type(2)));
typedef unsigned u32x2 __attribute__((ext_vector_type(2)));
#define LAS __attribute__((address_space(3)))
#define MFMA16(a, b, c) __builtin_amdgcn_mfma_f32_16x16x32_bf16((a), (b), (c), 0, 0, 0)
__device__ __forceinline__ unsigned pk2(float a, float b) { f32x2_t v = {a, b}; bf16x2_t r = __builtin_convertvector(v, bf16x2_t); return __builtin_bit_cast(unsigned, r); }
__device__ __forceinline__ bf16x8 pack8(float a0, float a1, float a2, float a3, float a4, float a5, float a6, float a7) {
  u32x4 w; w.x = pk2(a0, a1); w.y = pk2(a2, a3); w.z = pk2(a4, a5); w.w = pk2(a6, a7);
  return __builtin_bit_cast(bf16x8, w);
}
__device__ __forceinline__ bf16_t f2bf_hw(float a) { return (bf16_t)(pk2(a, 0.f) & 0xffffu); }

#define DN_ABYTES 57344
#define DN_UFLOATS 8192
#define F_WN 0
#define F_QD 16
#define F_QK 32
#define F_KT 40

#define DP_KH 0
#define DP_QT 17408
#define DP_KHT 34816
#define DP_VT 53248
#define DP_TU 71680
#define DP_TW 80896
#define DP_LF 90112
#define DP_GC 107520
#define DP_BETA 107776
#define DP_CW 108032
#define DP_TOTAL 114176

template <int KS>
__device__ __forceinline__ f32x4 prod16(const LAS bf16_t* A, int lda, int arow0, const LAS bf16_t* Bt, int ldb, int brow0, f32x4 acc, int lane) {
  const int r = lane & 15, q = lane >> 4;
#pragma unroll
  for (int ks = 0; ks < KS; ++ks) {
    const bf16x8 a = *(const LAS bf16x8*)(A + (arow0 + r) * lda + 32 * ks + 8 * q);
    const bf16x8 b = *(const LAS bf16x8*)(Bt + (brow0 + r) * ldb + 32 * ks + 8 * q);
    acc = MFMA16(a, b, acc);
  }
  return acc;
}
__device__ __forceinline__ void tile_store_rm(LAS bf16_t* X, int ld, int row0, int col0, const f32x4 v, int lane) {
  const int r = lane & 15, q = lane >> 4;
#pragma unroll
  for (int i = 0; i < 4; ++i) X[(row0 + 4 * q + i) * ld + col0 + r] = f2bf_hw(v[i]);
}
__device__ __forceinline__ void tile_store_tr(LAS bf16_t* Xt, int ld, int row0, int col0, const f32x4 v, int lane) {
  const int r = lane & 15, q = lane >> 4;
  u32x2 w; w.x = pk2(v[0], v[1]); w.y = pk2(v[2], v[3]);
  *(LAS u32x2*)(Xt + (col0 + r) * ld + row0 + 4 * q) = w;
}

__device__ void dn_prep_chunk(const Params& p, LAS unsigned char* lds, int ci, bool load_cw) {
  const int tid = threadIdx.x, lane = tid & 63, w = tid >> 6, r16 = lane & 15, q4 = lane >> 4;
  const int bh = ci >> 6, n = ci & 63, b = bh >> 2, h = bh & 3;
  LAS bf16_t* Kh = (LAS bf16_t*)(lds + DP_KH); LAS bf16_t* Qt = (LAS bf16_t*)(lds + DP_QT);
  LAS bf16_t* KhT = (LAS bf16_t*)(lds + DP_KHT); LAS bf16_t* VT = (LAS bf16_t*)(lds + DP_VT);
  LAS bf16_t* Tu = (LAS bf16_t*)(lds + DP_TU); LAS bf16_t* Tw = (LAS bf16_t*)(lds + DP_TW); LAS float* Lf = (LAS float*)(lds + DP_LF);
  LAS float* gcb = (LAS float*)(lds + DP_GC); LAS float* betab = (LAS float*)(lds + DP_BETA); LAS float* cw = (LAS float*)(lds + DP_CW);
  unsigned char* gA = (unsigned char*)p.dnA + (size_t)ci * DN_ABYTES;
  float* gU = p.dnU + (size_t)ci * DN_UFLOATS;

  if (load_cw) {
    for (int i = tid; i < 4 * 384; i += 512) { const int tap = i / 384, cc = i % 384, part = cc >> 7, d = cc & 127; cw[i] = p.conv_w[tap * 1536 + part * 512 + h * 128 + d]; }
  }
  __syncthreads();
  const int c = tid >> 3, g = tid & 7;
  const int s = n * 64 + c;
  const size_t t = (size_t)b * SEQ + s;
  float qv[16], kv[16], vv[16];
#pragma unroll
  for (int j = 0; j < 16; ++j) { qv[j] = 0.f; kv[j] = 0.f; vv[j] = 0.f; }
#pragma unroll
  for (int tap = 0; tap < 4; ++tap) {
    const int ss = s - 3 + tap;
    if (ss >= 0) {
      const bf16_t* row = p.proj + (t - 3 + tap) * PW + h * 128 + 16 * g;
      float x[8];
#pragma unroll
      for (int part = 0; part < 3; ++part) {
#pragma unroll
        for (int hh = 0; hh < 2; ++hh) {
          unpack8(*(const u32x4*)(row + part * 512 + 8 * hh), x);
#pragma unroll
          for (int j = 0; j < 8; ++j) {
            const float wv = cw[tap * 384 + part * 128 + 16 * g + 8 * hh + j];
            if (part == 0) qv[8 * hh + j] += wv * x[j];
            if (part == 1) kv[8 * hh + j] += wv * x[j];
            if (part == 2) vv[8 * hh + j] += wv * x[j];
          }
        }
      }
    }
    asm volatile("" ::: "memory");
  }
  float sq = 0.f, sk = 0.f;
#pragma unroll
  for (int j = 0; j < 16; ++j) { qv[j] = siluf_(qv[j]); kv[j] = siluf_(kv[j]); vv[j] = siluf_(vv[j]); sq += qv[j] * qv[j]; sk += kv[j] * kv[j]; }
  sq += __shfl_xor(sq, 1, 64); sq += __shfl_xor(sq, 2, 64); sq += __shfl_xor(sq, 4, 64);
  sk += __shfl_xor(sk, 1, 64); sk += __shfl_xor(sk, 2, 64); sk += __shfl_xor(sk, 4, 64);
  const float rq = rsqrtf(sq + 1e-6f) * 0.08838834764831845f, rk = rsqrtf(sk + 1e-6f);
#pragma unroll
  for (int j = 0; j < 16; ++j) { qv[j] *= rq; kv[j] *= rk; }
  if (g == 0) {
    const float bb = p.ba[t * 8 + h], aa = p.ba[t * 8 + 4 + h];
    const float xx = aa + p.dt_bias[h];
    const float sp = xx > 20.f ? xx : log1pf(__expf(xx));
    betab[c] = sigmoidf_(bb);
    gcb[c] = -__expf(p.a_log[h]) * sp;
  }
  {
    u32x4 w0, w1;
    w0.x = pk2(kv[0], kv[1]); w0.y = pk2(kv[2], kv[3]); w0.z = pk2(kv[4], kv[5]); w0.w = pk2(kv[6], kv[7]);
    w1.x = pk2(kv[8], kv[9]); w1.y = pk2(kv[10], kv[11]); w1.z = pk2(kv[12], kv[13]); w1.w = pk2(kv[14], kv[15]);
    *(LAS u32x4*)(Kh + c * 136 + 16 * g) = w0; *(LAS u32x4*)(Kh + c * 136 + 16 * g + 8) = w1;
    w0.x = pk2(qv[0], qv[1]); w0.y = pk2(qv[2], qv[3]); w0.z = pk2(qv[4], qv[5]); w0.w = pk2(qv[6], qv[7]);
    w1.x = pk2(qv[8], qv[9]); w1.y = pk2(qv[10], qv[11]); w1.z = pk2(qv[12], qv[13]); w1.w = pk2(qv[14], qv[15]);
    *(LAS u32x4*)(Qt + c * 136 + 16 * g) = w0; *(LAS u32x4*)(Qt + c * 136 + 16 * g + 8) = w1;
#pragma unroll
    for (int j = 0; j < 16; ++j) { KhT[(16 * g + j) * 72 + c] = f2bf_hw(kv[j]); VT[(16 * g + j) * 72 + c] = f2bf_hw(vv[j]); }
  }
  __syncthreads();
  if (w == 0) {
    float v = gcb[lane];
#pragma unroll
    for (int o = 1; o < 64; o <<= 1) { const float u = __shfl_up(v, o, 64); if (lane >= o) v += u; }
    gcb[lane] = v;
  }
  __syncthreads();
  const float gc_c = gcb[c], gl = gcb[63];
  {
    const float eg = __expf(gc_c);
    unsigned char* fb = gA + (size_t)(F_QD + (c >> 4) * 4 + (g >> 1)) * 1024 + (g & 1) * 8;
#pragma unroll
    for (int qq = 0; qq < 4; ++qq) {
      u32x2 wv; wv.x = pk2(qv[4 * qq] * eg, qv[4 * qq + 1] * eg); wv.y = pk2(qv[4 * qq + 2] * eg, qv[4 * qq + 3] * eg);
      *(u32x2*)(fb + ((c & 15) + 16 * qq) * 16) = wv;
    }
  }
  const int rt = w >> 1, ct0 = 2 * (w & 1);
#pragma unroll
  for (int tt = 0; tt < 2; ++tt) {
    const int ct = ct0 + tt;
    f32x4 gacc = {0.f, 0.f, 0.f, 0.f};
    gacc = prod16<4>(Kh, 136, 16 * rt, Kh, 136, 16 * ct, gacc, lane);
    const int m = 16 * ct + r16; const float gc_m = gcb[m];
#pragma unroll
    for (int i = 0; i < 4; ++i) {
      const int cc = 16 * rt + 4 * q4 + i;
      Lf[cc * 68 + m] = (m < cc) ? betab[cc] * gacc[i] * __expf(gcb[cc] - gc_m) : 0.f;
    }
    f32x4 qacc = {0.f, 0.f, 0.f, 0.f};
    qacc = prod16<4>(Kh, 136, 16 * rt, Qt, 136, 16 * ct, qacc, lane);
    const int cq = 16 * ct + r16; const float gc_cq = gcb[cq];
    float o4[4];
#pragma unroll
    for (int i = 0; i < 4; ++i) { const int mm = 16 * rt + 4 * q4 + i; o4[i] = (mm <= cq) ? qacc[i] * __expf(gc_cq - gcb[mm]) : 0.f; }
    u32x2 wv; wv.x = pk2(o4[0], o4[1]); wv.y = pk2(o4[2], o4[3]);
    *(u32x2*)(gA + (size_t)(F_QK + ct * 2 + (rt >> 1)) * 1024 + (r16 + 16 * q4) * 16 + (rt & 1) * 8) = wv;
  }
  __syncthreads();
  if (w == 0) {
    float T[64];
    int lo = lane; asm volatile("" : "+v"(lo));
    unsigned lfb = DP_LF; asm volatile("" : "+v"(lfb));
    const LAS float* Lfo = (const LAS float*)(lds + lfb);
    const float bm = betab[lo], bem = bm * __expf(gcb[lo]);
#pragma unroll
    for (int i = 0; i < 64; ++i) {
      float a0 = (i == lo) ? 1.f : 0.f, a1 = 0.f, a2 = 0.f, a3 = 0.f;
#pragma unroll
      for (int k4 = 0; k4 < (i + 3) / 4; ++k4) {
        const f32x4 l = *(const LAS f32x4*)(Lfo + i * 68 + 4 * k4);
        if (4 * k4 + 0 < i) a0 -= l[0] * T[4 * k4 + 0];
        if (4 * k4 + 1 < i) a1 -= l[1] * T[4 * k4 + 1];
        if (4 * k4 + 2 < i) a2 -= l[2] * T[4 * k4 + 2];
        if (4 * k4 + 3 < i) a3 -= l[3] * T[4 * k4 + 3];
      }
      T[i] = (a0 + a1) + (a2 + a3);
      Tu[i * 72 + lo] = f2bf_hw(T[i] * bm);
      Tw[i * 72 + lo] = f2bf_hw(T[i] * bem);
      asm volatile("" ::: "memory");
    }
  }
  __syncthreads();
#pragma unroll
  for (int rr = 0; rr < 4; ++rr) {
    f32x4 u = {0.f, 0.f, 0.f, 0.f};
    u = prod16<2>(Tu, 72, 16 * rr, VT, 72, 16 * w, u, lane);
    *(f32x4*)(gU + ((w * 4 + rr) * 64 + lane) * 4) = u;
    f32x4 wt = {0.f, 0.f, 0.f, 0.f};
    wt = prod16<2>(KhT, 72, 16 * w, Tw, 72, 16 * rr, wt, lane);
    u32x2 wv; wv.x = pk2(-wt[0], -wt[1]); wv.y = pk2(-wt[2], -wt[3]);
    *(u32x2*)(gA + (size_t)(F_WN + rr * 4 + (w >> 1)) * 1024 + (r16 + 16 * q4) * 16 + (w & 1) * 8) = wv;
  }
#pragma unroll
  for (int it = 0; it < 4; ++it) {
    const int idx = tid + it * 512; const int d = idx >> 4, m4 = idx & 15;
    const u32x2 raw = *(const LAS u32x2*)(KhT + d * 72 + 4 * m4);
    const float k0 = __uint_as_float(raw.x << 16), k1 = __uint_as_float(raw.x & 0xffff0000u), k2 = __uint_as_float(raw.y << 16), k3 = __uint_as_float(raw.y & 0xffff0000u);
    const float e0 = __expf(gl - gcb[4 * m4]), e1 = __expf(gl - gcb[4 * m4 + 1]), e2 = __expf(gl - gcb[4 * m4 + 2]), e3 = __expf(gl - gcb[4 * m4 + 3]);
    u32x2 wv; wv.x = pk2(k0 * e0, k1 * e1); wv.y = pk2(k2 * e2, k3 * e3);
    *(u32x2*)(gA + (size_t)(F_KT + (d >> 4) * 2 + (m4 >> 3)) * 1024 + ((d & 15) + 16 * (m4 & 3)) * 16 + ((m4 >> 2) & 1) * 8) = wv;
  }
  if (tid == 0) p.dnG[ci] = __expf(gl);
}

#define DS_A0 0
#define DS_A1 57344
#define DS_OT 114688
#define DS_TOTAL (114688 + 64 * 132 * 4)
__device__ void dn_scan_bh(const Params& p, LAS unsigned char* lds, int bh) {
  const int tid = threadIdx.x, lane = tid & 63, w = __builtin_amdgcn_readfirstlane(tid >> 6), r16 = lane & 15, q4 = lane >> 4;
  const int b = bh >> 2, h = bh & 3;
  LAS float* Ot = (LAS float*)(lds + DS_OT);
  const unsigned char* gA = (const unsigned char*)p.dnA + (size_t)bh * 64 * DN_ABYTES;
  const float* gU = p.dnU + (size_t)bh * 64 * DN_UFLOATS;
  const float* gG = p.dnG + bh * 64;
  auto issue_A = [&](int n, int buf) {
#pragma unroll
    for (int i = 0; i < 7; ++i) {
      const int f = w * 7 + i;
      __builtin_amdgcn_global_load_lds((const unsigned*)(gA + (size_t)n * DN_ABYTES + f * 1024 + lane * 16), (LAS unsigned*)(lds + (buf ? DS_A1 : DS_A0) + f * 1024), 16, 0, 0);
    }
  };
  auto post = [&](int n) {
    const int row = tid >> 3, seg = tid & 7;
    const size_t t = (size_t)b * SEQ + n * 64 + row;
    float o[16]; float ss = 0.f;
#pragma unroll
    for (int j4 = 0; j4 < 4; ++j4) { const f32x4 v = *(const LAS f32x4*)(Ot + row * 132 + 16 * seg + 4 * j4); o[4 * j4] = v[0]; o[4 * j4 + 1] = v[1]; o[4 * j4 + 2] = v[2]; o[4 * j4 + 3] = v[3]; }
#pragma unroll
    for (int j = 0; j < 16; ++j) ss += o[j] * o[j];
    ss += __shfl_xor(ss, 1, 64); ss += __shfl_xor(ss, 2, 64); ss += __shfl_xor(ss, 4, 64);
    const float rstd = rsqrtf(ss * (1.f / 128.f) + 1e-6f);
    const bf16_t* zp = p.proj + t * PW + C_Z + h * 128 + 16 * seg;
    float z0[8], z1[8]; unpack8(*(const u32x4*)zp, z0); unpack8(*(const u32x4*)(zp + 8), z1);
    float y[16];
#pragma unroll
    for (int j = 0; j < 8; ++j) { y[j] = o[j] * rstd * p.g_dn_out[16 * seg + j] * siluf_(z0[j]); y[8 + j] = o[8 + j] * rstd * p.g_dn_out[16 * seg + 8 + j] * siluf_(z1[j]); }
    u32x4 w0, w1;
    w0.x = pk2(y[0], y[1]); w0.y = pk2(y[2], y[3]); w0.z = pk2(y[4], y[5]); w0.w = pk2(y[6], y[7]);
    w1.x = pk2(y[8], y[9]); w1.y = pk2(y[10], y[11]); w1.z = pk2(y[12], y[13]); w1.w = pk2(y[14], y[15]);
    bf16_t* op = p.dn_out + t * p.dn_out_ld + h * 128 + 16 * seg;
    *(u32x4*)op = w0; *(u32x4*)(op + 8) = w1;
  };
  issue_A(0, 0);
  f32x4 Un[4];
#pragma unroll
  for (int rr = 0; rr < 4; ++rr) Un[rr] = *(const f32x4*)(gU + ((w * 4 + rr) * 64 + lane) * 4);
  f32x4 S[8];
#pragma unroll
  for (int dt = 0; dt < 8; ++dt) S[dt] = (f32x4){0.f, 0.f, 0.f, 0.f};
  asm volatile("s_waitcnt vmcnt(0)" ::: "memory");
  __syncthreads();
#pragma unroll 1
  for (int n = 0; n < 64; ++n) {
    const LAS unsigned char* Ab = lds + ((n & 1) ? DS_A1 : DS_A0);
    if (n + 1 < 64) issue_A(n + 1, (n + 1) & 1);
    f32x4 Vn[4];
#pragma unroll
    for (int rr = 0; rr < 4; ++rr) Vn[rr] = Un[rr];
    if (n + 1 < 64) {
#pragma unroll
      for (int rr = 0; rr < 4; ++rr) Un[rr] = *(const f32x4*)(gU + (size_t)(n + 1) * DN_UFLOATS + ((w * 4 + rr) * 64 + lane) * 4);
    }
    const float gdec = gG[n];
    if (n > 0) post(n - 1);
    bf16x8 Sb[4];
#pragma unroll
    for (int ks = 0; ks < 4; ++ks) Sb[ks] = pack8(S[2 * ks][0], S[2 * ks][1], S[2 * ks][2], S[2 * ks][3], S[2 * ks + 1][0], S[2 * ks + 1][1], S[2 * ks + 1][2], S[2 * ks + 1][3]);
    f32x4 O[4];
#pragma unroll
    for (int rr = 0; rr < 4; ++rr) {
      O[rr] = (f32x4){0.f, 0.f, 0.f, 0.f};
#pragma unroll
      for (int ks = 0; ks < 4; ++ks) {
        const bf16x8 aw = *(const LAS bf16x8*)(Ab + (F_WN + rr * 4 + ks) * 1024 + lane * 16);
        Vn[rr] = MFMA16(aw, Sb[ks], Vn[rr]);
        const bf16x8 aq = *(const LAS bf16x8*)(Ab + (F_QD + rr * 4 + ks) * 1024 + lane * 16);
        O[rr] = MFMA16(aq, Sb[ks], O[rr]);
      }
    }
    bf16x8 Vb[2];
#pragma unroll
    for (int ks = 0; ks < 2; ++ks) Vb[ks] = pack8(Vn[2 * ks][0], Vn[2 * ks][1], Vn[2 * ks][2], Vn[2 * ks][3], Vn[2 * ks + 1][0], Vn[2 * ks + 1][1], Vn[2 * ks + 1][2], Vn[2 * ks + 1][3]);
#pragma unroll
    for (int rr = 0; rr < 4; ++rr)
#pragma unroll
      for (int ks = 0; ks < 2; ++ks) {
        const bf16x8 a = *(const LAS bf16x8*)(Ab + (F_QK + rr * 2 + ks) * 1024 + lane * 16);
        O[rr] = MFMA16(a, Vb[ks], O[rr]);
      }
#pragma unroll
    for (int dt = 0; dt < 8; ++dt) {
      S[dt] *= gdec;
#pragma unroll
      for (int ks = 0; ks < 2; ++ks) {
        const bf16x8 a = *(const LAS bf16x8*)(Ab + (F_KT + dt * 2 + ks) * 1024 + lane * 16);
        S[dt] = MFMA16(a, Vb[ks], S[dt]);
      }
    }
    __syncthreads();
#pragma unroll
    for (int rr = 0; rr < 4; ++rr)
#pragma unroll
      for (int i = 0; i < 4; ++i) Ot[(16 * rr + 4 * q4 + i) * 132 + 16 * w + r16] = O[rr][i];
    asm volatile("s_waitcnt vmcnt(0)" ::: "memory");
    __syncthreads();
  }
  post(63);
  __syncthreads();
}
typedef float f32x16 __attribute__((ext_vector_type(16)));
#define MFMA32(a, b, c) __builtin_amdgcn_mfma_f32_32x32x16_bf16((a), (b), (c), 0, 0, 0)
#define MP_VL 0
#define MP_RED 65536
#define MP_TOTAL (65536 + 4096)

__device__ void moba_prep_block(const Params& p, LAS unsigned char* lds, int item) {
  const int tid = threadIdx.x, lane = tid & 63, w = tid >> 6;
  const int bh = item >> 4, jb = item & 15, b = bh >> 2, h = bh & 3;
  LAS bf16_t* Vl = (LAS bf16_t*)(lds + MP_VL);
  LAS float* red = (LAS float*)(lds + MP_RED);
  __syncthreads();
#pragma unroll
  for (int it = 0; it < 8; ++it) {
    const int idx = tid + 512 * it, row = idx >> 4, ch = idx & 15;
    const u32x4 v = *(const u32x4*)(p.proj + ((size_t)b * SEQ + 256 * jb + row) * PW + C_MV + h * 128 + 8 * ch);
    *(LAS u32x4*)(Vl + row * 128 + 8 * ch) = v;
  }
  {
    const int r = tid >> 1, hh = tid & 1;
    const int pos = 256 * jb + r;
    const size_t t = (size_t)b * SEQ + pos;
    float cs[8], sn[8];
#pragma unroll
    for (int jj = 0; jj < 8; ++jj) {
      const float inv = exp2f(-(float)(8 * hh + jj) * (1.f / 16.f) * 18.931568569324174f);
      const float ang = (float)pos * inv;
      cs[jj] = cosf(ang); sn[jj] = sinf(ang);
    }
    float kacc[64];
#pragma unroll
    for (int which = 0; which < 2; ++which) {
      const bf16_t* src = p.proj + t * PW + (which ? C_MQ : C_MK) + h * 128 + 8 * hh;
      float x0[8], x1[8];
      unpack8(*(const u32x4*)(src), x0); unpack8(*(const u32x4*)(src + 16), x1);
      float y0[8], y1[8];
#pragma unroll
      for (int jj = 0; jj < 8; ++jj) { y0[jj] = x0[jj] * cs[jj] - x1[jj] * sn[jj]; y1[jj] = x1[jj] * cs[jj] + x0[jj] * sn[jj]; }
      u32x4 o[8];
      o[0].x = pk2(y0[0], y0[1]); o[0].y = pk2(y0[2], y0[3]); o[0].z = pk2(y0[4], y0[5]); o[0].w = pk2(y0[6], y0[7]);
      o[1].x = pk2(y1[0], y1[1]); o[1].y = pk2(y1[2], y1[3]); o[1].z = pk2(y1[4], y1[5]); o[1].w = pk2(y1[6], y1[7]);
#pragma unroll
      for (int ks = 2; ks < 8; ++ks) o[ks] = *(const u32x4*)(src + 16 * ks);
      if (which == 0) {
#pragma unroll
        for (int jj = 0; jj < 8; ++jj) { kacc[jj] = y0[jj]; kacc[8 + jj] = y1[jj]; }
#pragma unroll
        for (int ks = 2; ks < 8; ++ks) { float f[8]; unpack8(o[ks], f);
#pragma unroll
          for (int jj = 0; jj < 8; ++jj) kacc[8 * ks + jj] = f[jj]; }
        unsigned char* dst = (unsigned char*)p.Kp + ((size_t)(bh * 128 + 8 * jb + (r >> 5)) * 8192) + ((r & 31) + 32 * hh) * 16;
#pragma unroll
        for (int ks = 0; ks < 8; ++ks) *(u32x4*)(dst + ks * 1024) = o[ks];
      } else {
        bf16_t* dst = p.qb + ((size_t)bh * SEQ + pos) * 128 + 8 * hh;
#pragma unroll
        for (int ks = 0; ks < 8; ++ks) *(u32x4*)(dst + 16 * ks) = o[ks];
      }
    }
#pragma unroll
    for (int e = 0; e < 64; ++e) {
      float v = kacc[e];
      v += __shfl_xor(v, 2, 64); v += __shfl_xor(v, 4, 64); v += __shfl_xor(v, 8, 64); v += __shfl_xor(v, 16, 64); v += __shfl_xor(v, 32, 64);
      kacc[e] = v;
    }
    if (lane < 2) {
#pragma unroll
      for (int e = 0; e < 64; ++e) red[(w * 2 + lane) * 64 + e] = kacc[e];
    }
  }
  __syncthreads();
  if (tid < 128) {
    const int d = tid, hh = (d >> 3) & 1, ks = d >> 4, jj = d & 7;
    float a = 0.f;
#pragma unroll
    for (int ww = 0; ww < 8; ++ww) a += red[(ww * 2 + hh) * 64 + ks * 8 + jj];
    p.kmean[((size_t)bh * 16 + jb) * 128 + d] = a * (1.f / 256.f);
  }
#pragma unroll
  for (int it = 0; it < 8; ++it) {
    const int o = tid + 512 * it, ln = o & 63, frag = o >> 6, tl = frag >> 3, dt = (frag >> 1) & 3, s = frag & 1;
    const int r = ln & 31, hh = ln >> 5, d = 32 * dt + r;
    unsigned short e[8];
#pragma unroll
    for (int jj = 0; jj < 8; ++jj) { const int key = 32 * tl + 16 * s + 8 * (jj >> 2) + 4 * hh + (jj & 3); e[jj] = Vl[key * 128 + d]; }
    u32x4 wv; wv.x = e[0] | ((unsigned)e[1] << 16); wv.y = e[2] | ((unsigned)e[3] << 16); wv.z = e[4] | ((unsigned)e[5] << 16); wv.w = e[6] | ((unsigned)e[7] << 16);
    *(u32x4*)((unsigned char*)p.Vp + ((size_t)(bh * 128 + 8 * jb + tl) * 8192) + (dt * 2 + s) * 1024 + ln * 16) = wv;
  }
}
__device__ __forceinline__ int crow32(int reg, int hh) { return (reg & 3) + 8 * (reg >> 2) + 4 * hh; }
__device__ void moba_item(const Params& p, LAS float* km, int bh, int ib, int sub, int lane) {
  const int q = lane & 31, hh = lane >> 5;
  const int b = bh >> 2, h = bh & 3;
  const int s0 = 256 * ib + 32 * sub;
  const bf16_t* qrow = p.qb + ((size_t)bh * SEQ + s0 + q) * 128 + 8 * hh;
  bf16x8 Qf[8];
#pragma unroll
  for (int ks = 0; ks < 8; ++ks) Qf[ks] = *(const bf16x8*)(qrow + 16 * ks);
  unsigned selmask = 0;
  if (ib > 0) {
    for (int idx = lane; idx < ib * 32; idx += 64) ((LAS f32x4*)km)[idx] = ((const f32x4*)(p.kmean + (size_t)bh * 16 * 128))[idx];
    float qf[64];
#pragma unroll
    for (int ks = 0; ks < 8; ++ks) { float f[8]; unpack8(__builtin_bit_cast(u32x4, Qf[ks]), f);
#pragma unroll
      for (int jj = 0; jj < 8; ++jj) qf[8 * ks + jj] = f[jj]; }
    float sc[16];
#pragma unroll
    for (int j = 0; j < 16; ++j) {
      sc[j] = -INFINITY;
      if (j < ib) {
        float a = 0.f;
#pragma unroll
        for (int ks = 0; ks < 8; ++ks) {
          const f32x4 k0 = *(const LAS f32x4*)(km + j * 128 + 16 * ks + 8 * hh), k1 = *(const LAS f32x4*)(km + j * 128 + 16 * ks + 8 * hh + 4);
          a += qf[8 * ks] * k0[0] + qf[8 * ks + 1] * k0[1] + qf[8 * ks + 2] * k0[2] + qf[8 * ks + 3] * k0[3];
          a += qf[8 * ks + 4] * k1[0] + qf[8 * ks + 5] * k1[1] + qf[8 * ks + 6] * k1[2] + qf[8 * ks + 7] * k1[3];
        }
        a += __shfl_xor(a, 32, 64);
        sc[j] = a;
      }
    }
#pragma unroll
    for (int r = 0; r < 3; ++r) {
      if (r < ib) {
        float best = -INFINITY; int bi = 0;
#pragma unroll
        for (int j = 0; j < 16; ++j) if (sc[j] > best) { best = sc[j]; bi = j; }
        selmask |= 1u << bi;
#pragma unroll
        for (int j = 0; j < 16; ++j) if (j == bi) sc[j] = -INFINITY;
      }
    }
  }
  const float cscale = 0.08838834764831845f * 1.4426950408889634f;
  float m = -1e30f, l = 0.f;
  f32x16 O[4];
#pragma unroll
  for (int dt = 0; dt < 4; ++dt)
#pragma unroll
    for (int r = 0; r < 16; ++r) O[dt][r] = 0.f;
  const unsigned char* kbase = (const unsigned char*)p.Kp + (size_t)bh * 128 * 8192 + lane * 16;
  const unsigned char* vbase = (const unsigned char*)p.Vp + (size_t)bh * 128 * 8192 + lane * 16;
  auto tile = [&](int kt, int mode, bool selbit) {
    bf16x8 Kf[8], Vf[8];
#pragma unroll
    for (int ks = 0; ks < 8; ++ks) Kf[ks] = *(const bf16x8*)(kbase + (size_t)kt * 8192 + ks * 1024);
#pragma unroll
    for (int f = 0; f < 8; ++f) Vf[f] = *(const bf16x8*)(vbase + (size_t)kt * 8192 + f * 1024);
    f32x16 S;
#pragma unroll
    for (int r = 0; r < 16; ++r) S[r] = 0.f;
#pragma unroll
    for (int ks = 0; ks < 8; ++ks) S = MFMA32(Kf[ks], Qf[ks], S);
    float sv[16]; float mx = -INFINITY;
#pragma unroll
    for (int r = 0; r < 16; ++r) {
      float v = S[r] * cscale;
      if (mode == 1 && crow32(r, hh) > q) v = -INFINITY;
      if (mode == 2 && !selbit) v = -INFINITY;
      sv[r] = v; mx = fmaxf(mx, v);
    }
    mx = fmaxf(mx, __shfl_xor(mx, 32, 64));
    const float mn = fmaxf(m, mx);
    const float alpha = exp2f(m - mn);
    float ps = 0.f;
#pragma unroll
    for (int r = 0; r < 16; ++r) { sv[r] = exp2f(sv[r] - mn); ps += sv[r]; }
    l = l * alpha + ps; m = mn;
    if (__ballot(alpha != 1.f) != 0ull) {
#pragma unroll
      for (int dt = 0; dt < 4; ++dt)
#pragma unroll
        for (int r = 0; r < 16; ++r) O[dt][r] *= alpha;
    }
    const bf16x8 P0 = pack8(sv[0], sv[1], sv[2], sv[3], sv[4], sv[5], sv[6], sv[7]);
    const bf16x8 P1 = pack8(sv[8], sv[9], sv[10], sv[11], sv[12], sv[13], sv[14], sv[15]);
#pragma unroll
    for (int dt = 0; dt < 4; ++dt) { O[dt] = MFMA32(Vf[dt * 2], P0, O[dt]); O[dt] = MFMA32(Vf[dt * 2 + 1], P1, O[dt]); }
  };
  for (int tl = 0; tl < sub; ++tl) tile(8 * ib + tl, 0, true);
  tile(8 * ib + sub, 1, true);
  for (int j = 0; j < ib; ++j) {
    const bool sb = (selmask >> j) & 1u;
    if (__ballot(sb) != 0ull) {
#pragma unroll 1
      for (int tl = 0; tl < 8; ++tl) tile(8 * j + tl, 2, sb);
    }
  }
  l += __shfl_xor(l, 32, 64);
  const float inv = 1.f / l;
  bf16_t* orow = p.mb_out + ((size_t)b * SEQ + s0 + q) * p.mb_out_ld + p.mb_out_off + h * 128;
#pragma unroll
  for (int dt = 0; dt < 4; ++dt)
#pragma unroll
    for (int g4 = 0; g4 < 4; ++g4) {
      u32x2 wv; wv.x = pk2(O[dt][4 * g4] * inv, O[dt][4 * g4 + 1] * inv); wv.y = pk2(O[dt][4 * g4 + 2] * inv, O[dt][4 * g4 + 3] * inv);
      *(u32x2*)(orow + 32 * dt + 8 * g4 + 4 * hh) = wv;
    }
}
__device__ void moba_worker(const Params& p, LAS unsigned char* lds) {
  const int lane = threadIdx.x & 63, w = threadIdx.x >> 6;
  LAS float* km = (LAS float*)(lds + w * 8192);
  for (;;) {
    int idx = 0;
    if (lane == 0) idx = atomicAdd(p.wq, 1);
    idx = __builtin_amdgcn_readfirstlane(idx);
    if (idx >= 2048) break;
    const int ib = 15 - (idx >> 7), rem = idx & 127, bh = rem >> 3, sub = 7 - (rem & 7);
    moba_item(p, km, bh, ib, sub, lane);
  }
}
__device__ void ph_mod(const Params& p, LAS unsigned char* lds, int nblk, int bid) {
  LAS float* sc = (LAS float*)lds;
  LAS float* part = (LAS float*)(lds + 16384);
  const int tid = threadIdx.x;
  if (bid >= 192) return;
  for (int i = tid; i < 4096; i += 512) sc[i] = siluf_(p.c[i]);
  __syncthreads();
  for (int task = bid; task < 192; task += nblk) {
    const int jj = tid & 31, ks = tid >> 5, j = task * 32 + jj;
    float a0 = 0.f, a1 = 0.f, a2 = 0.f, a3 = 0.f;
#pragma unroll 8
    for (int kk = 0; kk < 64; ++kk) {
      const int k = ks * 64 + kk;
      const float w = p.w_ada[(size_t)k * 6144 + j];
      a0 += sc[k] * w; a1 += sc[1024 + k] * w; a2 += sc[2048 + k] * w; a3 += sc[3072 + k] * w;
    }
    *(LAS f32x4*)(part + (ks * 32 + jj) * 4) = (f32x4){a0, a1, a2, a3};
    __syncthreads();
    if (tid < 128) {
      const int j2 = tid & 31, bb = tid >> 5;
      float a = 0.f;
#pragma unroll
      for (int s = 0; s < 16; ++s) a += part[(s * 32 + j2) * 4 + bb];
      p.mod[bb * 6144 + task * 32 + j2] = a + p.b_ada[task * 32 + j2];
    }
    __syncthreads();
  }
}

__device__ __forceinline__ void wt_tile(const float* __restrict__ src, bf16_t* __restrict__ dst, int K, int N, int mode, int k0, int n0, LAS float* tile) {
  const int tid = threadIdx.x;
#pragma unroll
  for (int it = 0; it < 2; ++it) {
    const int row = (tid >> 4) + 32 * it, c4 = (tid & 15) * 4, n = n0 + c4;
    f32x4 v = {0.f, 0.f, 0.f, 0.f};
    if (n < N) v = *(const f32x4*)(src + (size_t)(k0 + row) * N + n);
    tile[row * 65 + c4] = v[0]; tile[row * 65 + c4 + 1] = v[1]; tile[row * 65 + c4 + 2] = v[2]; tile[row * 65 + c4 + 3] = v[3];
  }
  __syncthreads();
  {
    const int nl = tid >> 3, kc = tid & 7, n = n0 + nl;
    if (n < N) {
      const int d = map_col(n, mode);
      if (d >= 0) {
        float f[8];
#pragma unroll
        for (int j = 0; j < 8; ++j) f[j] = tile[(8 * kc + j) * 65 + nl];
        u32x4 w; w.x = pk2(f[0], f[1]); w.y = pk2(f[2], f[3]); w.z = pk2(f[4], f[5]); w.w = pk2(f[6], f[7]);
        *(u32x4*)(dst + (size_t)d * K + k0 + 8 * kc) = w;
      }
    }
  }
  __syncthreads();
}
#define WT_T0 1424
#define WT_T1 (WT_T0 + 16384)
#define WT_T2 (WT_T1 + 8192)
#define WT_T3 (WT_T2 + 128)
#define WT_T4 (WT_T3 + 128)
#define WT_T5 (WT_T4 + 256)
__device__ void ph_wt(const Params& p, LAS unsigned char* lds, int nblk, int bid) {
  LAS float* tile = (LAS float*)(lds + 32768);
  for (int t = bid; t < WT_T5; t += nblk) {
    if (t < WT_T0) { const int kt = t / 89, nt = t % 89; wt_tile(p.w_in, p.w_in_t, 1024, INW, 1, kt * 64, nt * 64, tile); }
    else if (t < WT_T1) { const int u = t - WT_T0, e = u >> 9, r = u & 511, kt = r >> 5, nt = r & 31;
      wt_tile(p.w_gu + (size_t)e * 1024 * 2048, p.wgu_t + (size_t)e * 2048 * 1024, 1024, 2048, 2, kt * 64, nt * 64, tile); }
    else if (t < WT_T2) { const int u = t - WT_T1, e = u >> 8, r = u & 255, kt = r >> 4, nt = r & 15;
      wt_tile(p.w_down + (size_t)e * 1024 * 1024, p.wd_t + (size_t)e * 1024 * 1024, 1024, 1024, 0, kt * 64, nt * 64, tile); }
    else if (t < WT_T3) { const int u = t - WT_T2, kt = u >> 4, nt = u & 15; wt_tile(p.w_br_a, p.wbra_t, 512, 1024, 0, kt * 64, nt * 64, tile); }
    else if (t < WT_T4) { const int u = t - WT_T3, kt = u >> 4, nt = u & 15; wt_tile(p.w_br_b, p.wbrb_t, 512, 1024, 0, kt * 64, nt * 64, tile); }
    else { const int u = t - WT_T4, kt = u >> 4, nt = u & 15; wt_tile(p.w_o, p.wo_t, 1024, 1024, 0, kt * 64, nt * 64, tile); }
  }
}

__device__ void ph_h(const Params& p, int nblk, int bid) {
  const int wid = threadIdx.x >> 6, lane = threadIdx.x & 63;
  for (int t = bid * 8 + wid; t < T_TOK; t += nblk * 8) {
    const int b = t / SEQ;
    const float* xr = p.x + (size_t)t * DM;
    float v[16];
    float ss = 0.f;
#pragma unroll
    for (int i = 0; i < 4; ++i) {
      const f32x4 q = *(const f32x4*)(xr + i * 256 + lane * 4);
      v[i * 4 + 0] = q[0]; v[i * 4 + 1] = q[1]; v[i * 4 + 2] = q[2]; v[i * 4 + 3] = q[3];
      ss += q[0] * q[0] + q[1] * q[1] + q[2] * q[2] + q[3] * q[3];
    }
    ss = wave_sum(ss);
    const float rstd = rsqrtf(ss * (1.f / DM) + 1e-6f);
    const float* shift = p.mod + b * 6144;
    const float* scale = p.mod + b * 6144 + 1024;
    float acc[8] = {0, 0, 0, 0, 0, 0, 0, 0};
#pragma unroll
    for (int i = 0; i < 4; ++i) {
      float hv[4];
#pragma unroll
      for (int j = 0; j < 4; ++j) {
        const int k = i * 256 + lane * 4 + j;
        hv[j] = v[i * 4 + j] * rstd * p.g_pre_mix[k] * (1.f + scale[k]) + shift[k];
        const float* wr = p.w_in + (size_t)k * INW + 2048;
        const f32x4 w0 = *(const f32x4*)wr, w1 = *(const f32x4*)(wr + 4);
        acc[0] += hv[j] * w0[0]; acc[1] += hv[j] * w0[1]; acc[2] += hv[j] * w0[2]; acc[3] += hv[j] * w0[3];
        acc[4] += hv[j] * w1[0]; acc[5] += hv[j] * w1[1]; acc[6] += hv[j] * w1[2]; acc[7] += hv[j] * w1[3];
      }
      u32x2 pk; pk.x = pk2(hv[0], hv[1]); pk.y = pk2(hv[2], hv[3]);
      *(u32x2*)(p.hbf + (size_t)t * DM + i * 256 + lane * 4) = pk;
    }
#pragma unroll
    for (int e = 0; e < 8; ++e) acc[e] = wave_sum(acc[e]);
    if (lane == 0) { *(f32x4*)(p.ba + (size_t)t * 8) = (f32x4){acc[0], acc[1], acc[2], acc[3]}; *(f32x4*)(p.ba + (size_t)t * 8 + 4) = (f32x4){acc[4], acc[5], acc[6], acc[7]}; }
  }
}

__device__ void ph_post_mix(const Params& p, LAS unsigned char* lds, int nblk, int bid) {
  const int wid = threadIdx.x >> 6, lane = threadIdx.x & 63;
  LAS float* sh = (LAS float*)lds + wid * 1024;
  for (int t = bid * 8 + wid; t < T_TOK; t += nblk * 8) {
    const int b = t / SEQ;
    const float* md = p.mod + b * 6144;
    float mv[16];
    float ss = 0.f;
#pragma unroll
    for (int i = 0; i < 2; ++i) {
      float f[8]; unpack8(*(const u32x4*)(p.mixer + (size_t)t * DM + i * 512 + lane * 8), f);
#pragma unroll
      for (int j = 0; j < 8; ++j) { mv[i * 8 + j] = f[j]; ss += f[j] * f[j]; }
    }
    ss = wave_sum(ss);
    const float rstd = rsqrtf(ss * (1.f / DM) + 1e-6f);
    float x1[16];
    float s2 = 0.f;
#pragma unroll
    for (int i = 0; i < 2; ++i)
#pragma unroll
      for (int j4 = 0; j4 < 2; ++j4) {
        const int k = i * 512 + lane * 8 + j4 * 4;
        const f32x4 xv = *(const f32x4*)(p.x + (size_t)t * DM + k);
        const f32x4 gm = *(const f32x4*)(md + 2048 + k), gp = *(const f32x4*)(p.g_post_mix + k);
        f32x4 o;
#pragma unroll
        for (int j = 0; j < 4; ++j) { o[j] = xv[j] + gm[j] * (mv[i * 8 + j4 * 4 + j] * rstd * gp[j]); x1[i * 8 + j4 * 4 + j] = o[j]; s2 += o[j] * o[j]; }
        *(f32x4*)(p.out + (size_t)t * DM + k) = o;
      }
    s2 = wave_sum(s2);
    const float rstd2 = rsqrtf(s2 * (1.f / DM) + 1e-6f);
#pragma unroll
    for (int i = 0; i < 2; ++i) {
      float hv[8];
#pragma unroll
      for (int j = 0; j < 8; ++j) {
        const int k = i * 512 + lane * 8 + j;
        hv[j] = x1[i * 8 + j] * rstd2 * p.g_pre_ffn[k] * (1.f + md[4096 + k]) + md[3072 + k];
        sh[k] = hv[j];
      }
      u32x4 w; w.x = pk2(hv[0], hv[1]); w.y = pk2(hv[2], hv[3]); w.z = pk2(hv[4], hv[5]); w.w = pk2(hv[6], hv[7]);
      *(u32x4*)(p.h2 + (size_t)t * DM + i * 512 + lane * 8) = w;
    }
    const int e = lane & 31, half = lane >> 5;
    float a0 = 0.f, a1 = 0.f, a2 = 0.f, a3 = 0.f;
#pragma unroll 4
    for (int k = half * 512; k < half * 512 + 512; k += 4) {
      const f32x4 hv = *(const LAS f32x4*)(sh + k);
      a0 += hv[0] * p.w_router[(size_t)k * 32 + e]; a1 += hv[1] * p.w_router[(size_t)(k + 1) * 32 + e];
      a2 += hv[2] * p.w_router[(size_t)(k + 2) * 32 + e]; a3 += hv[3] * p.w_router[(size_t)(k + 3) * 32 + e];
    }
    float a = (a0 + a1) + (a2 + a3);
    a += __shfl_xor(a, 32, 64);
    float lg = a + p.b_router[e];
    if (lane >= 32) lg = -INFINITY;
    float tv[4]; int ti[4];
#pragma unroll
    for (int r = 0; r < 4; ++r) {
      const float m = wave_max(lg);
      const unsigned long long bal = __ballot(lg == m);
      const int idx = __ffsll((long long)bal) - 1;
      tv[r] = m; ti[r] = idx;
      if (lane == idx) lg = -INFINITY;
    }
    const float e1 = __expf(tv[1] - tv[0]), e2 = __expf(tv[2] - tv[0]), e3 = __expf(tv[3] - tv[0]);
    const float inv = 1.f / (1.f + e1 + e2 + e3);
    if (lane < 4) {
      const int ee = lane == 0 ? ti[0] : lane == 1 ? ti[1] : lane == 2 ? ti[2] : ti[3];
      const float ww = (lane == 0 ? 1.f : lane == 1 ? e1 : lane == 2 ? e2 : e3) * inv;
      const int pos = atomicAdd(&p.cnt[ee], 1);
      p.elist[ee * T_TOK + pos] = t * 4 + lane;
      p.aw[t * 4 + lane] = ww;
    }
  }
}

__device__ void ph_gather(const Params& p, LAS unsigned char* lds, int nblk, int bid) {
  const int wid = threadIdx.x >> 6, lane = threadIdx.x & 63;
  LAS int* tb = (LAS int*)lds;
  if (threadIdx.x == 0) { int off = 0; for (int k = 0; k < NE; ++k) { const int c = p.cnt[k]; tb[k] = off; tb[64 + k] = c; off += ((c + 255) >> 8) << 8; } tb[NE] = off; }
  __syncthreads();
  const int total = tb[NE];
  for (int r = bid * 8 + wid; r < total; r += nblk * 8) {
    int e = 0;
#pragma unroll 1
    for (int k = 1; k < NE; ++k) if (r >= tb[k]) e = k;
    const int i = r - tb[e];
    const int a = (i < tb[64 + e]) ? p.elist[e * T_TOK + i] : -1;
    if (lane == 0) p.rowmap[r] = a;
    u32x4 v0 = {0, 0, 0, 0}, v1 = v0;
    if (a >= 0) { const u32x4* src = (const u32x4*)(p.h2 + (size_t)(a >> 2) * DM); v0 = src[lane]; v1 = src[64 + lane]; }
    u32x4* dst = (u32x4*)(p.xs + (size_t)r * DM);
    dst[lane] = v0; dst[64 + lane] = v1;
  }
}

__device__ void ph_final(const Params& p, int nblk, int bid) {
  const int wid = threadIdx.x >> 6, lane = threadIdx.x & 63;
  for (int t = bid * 8 + wid; t < T_TOK; t += nblk * 8) {
    const int b = t / SEQ;
    const float* md = p.mod + b * 6144;
    const f32x4 wv = *(const f32x4*)(p.aw + t * 4);
    float mv[16];
    float ss = 0.f;
#pragma unroll
    for (int i = 0; i < 2; ++i) {
      const bf16_t* y = p.yslot + (size_t)t * 4 * DM + i * 512 + lane * 8;
      float f0[8], f1[8], f2[8], f3[8];
      unpack8(*(const u32x4*)y, f0); unpack8(*(const u32x4*)(y + DM), f1); unpack8(*(const u32x4*)(y + 2 * DM), f2); unpack8(*(const u32x4*)(y + 3 * DM), f3);
#pragma unroll
      for (int j = 0; j < 8; ++j) { const float m = wv[0] * f0[j] + wv[1] * f1[j] + wv[2] * f2[j] + wv[3] * f3[j]; mv[i * 8 + j] = m; ss += m * m; }
    }
    ss = wave_sum(ss);
    const float rstd = rsqrtf(ss * (1.f / DM) + 1e-6f);
#pragma unroll
    for (int i = 0; i < 2; ++i)
#pragma unroll
      for (int j4 = 0; j4 < 2; ++j4) {
        const int k = i * 512 + lane * 8 + j4 * 4;
        float* op = p.out + (size_t)t * DM + k;
        const f32x4 x1 = *(const f32x4*)op, gf = *(const f32x4*)(md + 5120 + k), gp = *(const f32x4*)(p.g_post_ffn + k);
        f32x4 o;
#pragma unroll
        for (int j = 0; j < 4; ++j) o[j] = x1[j] + gf[j] * (mv[i * 8 + j4 * 4 + j] * rstd * gp[j]);
        *(f32x4*)op = o;
      }
  }
}

#define XB_TMO      128
#define XB_XCNT(j)  (256  + 64 * (j))
#define XB_XSUB(j)  (1280 + 64 * (j))
#define XB_XGEN(j)  (2304 + 64 * (j))
#define XB_TOP      3328
#define XB_TOPGEN   3392
#define XCD_BAR_WORDS 3456
#define XB_SPIN_CAP (1u << 18)

__device__ __forceinline__ unsigned xb_ld(unsigned* p)              { return __hip_atomic_load(p, __ATOMIC_RELAXED, __HIP_MEMORY_SCOPE_AGENT); }
__device__ __forceinline__ unsigned xb_add(unsigned* p, unsigned v) { return __hip_atomic_fetch_add(p, v, __ATOMIC_RELAXED, __HIP_MEMORY_SCOPE_AGENT); }
__device__ __forceinline__ unsigned xb_xcc_id() { return (unsigned)__builtin_amdgcn_s_getreg((3 << 11) | 20) & 0xFu; }
#define XB_SPIN(cond, bar) do { unsigned _sp = 0; while (cond) { __builtin_amdgcn_s_sleep(1); \
    if ((++_sp & 255u) == 0u) { if (xb_ld(&(bar)[XB_TMO])) break; if (_sp > XB_SPIN_CAP) { atomicAdd(&(bar)[XB_TMO], 1u); break; } } } } while (0)

struct XcdBarrier {
    unsigned* bar; unsigned x;
    volatile LAS unsigned* st;
};

__device__ __forceinline__ XcdBarrier xcd_barrier_post(unsigned* bar, volatile LAS unsigned* st) {
    XcdBarrier b; b.bar = bar; b.x = xb_xcc_id(); b.st = st;
    if (threadIdx.x == 0) (void)xb_add(&bar[XB_XCNT(b.x)], 1u);
    return b;
}
__device__ __forceinline__ void xcd_barrier_complete(unsigned* bar, unsigned x, unsigned& nloc, unsigned& nx) {
    const unsigned G = gridDim.x * gridDim.y * gridDim.z;
    unsigned sum, cnt, mine, sp = 0u;
    for (;;) {
        sum = 0u; cnt = 0u; mine = 0u;
#pragma unroll
        for (unsigned j = 0; j < 16; ++j) { const unsigned c = xb_ld(&bar[XB_XCNT(j)]); sum += c; cnt += (c > 0u) ? 1u : 0u; mine = (j == x) ? c : mine; }
        if (sum == G) break;
        __builtin_amdgcn_s_sleep(1);
        if ((++sp & 255u) == 0u) { if (xb_ld(&bar[XB_TMO])) break; if (sp > XB_SPIN_CAP) { atomicAdd(&bar[XB_TMO], 1u); break; } }
    }
    nloc = mine > 0u ? mine : 1u; nx = cnt > 0u ? cnt : 1u;
}

__device__ __forceinline__ void xcd_barrier(const XcdBarrier& b) {
    asm volatile("s_waitcnt vmcnt(0)" ::: "memory");
    __syncthreads();
    if (threadIdx.x == 0) {
        unsigned* bar = b.bar;
        __builtin_amdgcn_s_waitcnt(0);
        unsigned nloc = b.st[0], nx = b.st[1];
        if (nloc == 0u) { xcd_barrier_complete(bar, b.x, nloc, nx); b.st[0] = nloc; b.st[1] = nx; }
        const unsigned old = xb_add(&bar[XB_XSUB(b.x)], 1u);
        const unsigned gen = old / nloc;
        if (old + 1u == (gen + 1u) * nloc) {
            __builtin_amdgcn_fence(__ATOMIC_RELEASE, "agent");
            asm volatile("s_waitcnt vmcnt(0)" ::: "memory");
            const unsigned og = xb_add(&bar[XB_TOP], 1u);
            const unsigned tg = og / nx;
            if (og + 1u == (tg + 1u) * nx) xb_add(&bar[XB_TOPGEN], 1u);
            else XB_SPIN(xb_ld(&bar[XB_TOPGEN]) == tg, bar);
            __builtin_amdgcn_fence(__ATOMIC_ACQUIRE, "agent");
            xb_add(&bar[XB_XGEN(b.x)], 1u);
            asm volatile("s_waitcnt vmcnt(0)" ::: "memory");
        } else {
            XB_SPIN(xb_ld(&bar[XB_XGEN(b.x)]) == gen, bar);
            __builtin_amdgcn_fence(__ATOMIC_ACQUIRE, "agent");
            asm volatile("s_waitcnt vmcnt(0)" ::: "memory");
        }
    }
    __syncthreads();
}


__device__ __forceinline__ void grid_bar(const Params& p, LAS unsigned char* lds);
#define MEGA_LDS 148480
#define MEGA_LDS_ALLOC (MEGA_LDS + 16)
__device__ __forceinline__ void grid_bar(const Params& p, LAS unsigned char* lds) {
  XcdBarrier b; b.bar = p.bar; b.x = xb_xcc_id(); b.st = (volatile LAS unsigned*)(lds + MEGA_LDS);
  xcd_barrier(b);
}
__global__ __launch_bounds__(512) void mega(Params p) {
  extern __shared__ __attribute__((aligned(16))) unsigned char shm[];
  LAS unsigned char* lds = (LAS unsigned char*)shm;
  cg::grid_group grid = cg::this_grid();
  const int nblk = gridDim.x, bid = blockIdx.x;
  volatile LAS unsigned* xst = (volatile LAS unsigned*)(lds + MEGA_LDS);
  if (threadIdx.x == 0) { xst[0] = 0u; xst[1] = 0u; xst[2] = 0u; xst[3] = 0u; }
  __syncthreads();
  (void)xcd_barrier_post(p.bar, xst);
  if (p.never) grid.sync();
  ph_mod(p, lds, nblk, bid);
  ph_wt(p, lds, nblk, bid);
  grid_bar(p, lds);
  ph_h(p, nblk, bid);
  grid_bar(p, lds);
  ph_proj(p, lds, nblk, bid);
  grid_bar(p, lds);
  { bool first = true; for (int ci = bid; ci < 1024; ci += nblk) { dn_prep_chunk(p, lds, ci, first); first = false; } }
  for (int item = bid; item < 256; item += nblk) moba_prep_block(p, lds, item);
  grid_bar(p, lds);
  if (bid < 16) dn_scan_bh(p, lds, bid);
  moba_worker(p, lds);
  grid_bar(p, lds);
  ph_br(p, lds, nblk, bid);
  grid_bar(p, lds);
  ph_mix(p, lds, nblk, bid);
  grid_bar(p, lds);
  ph_post_mix(p, lds, nblk, bid);
  grid_bar(p, lds);
  ph_gather(p, lds, nblk, bid);
  grid_bar(p, lds);
  ph_moe1(p, lds, nblk, bid);
  grid_bar(p, lds);
  ph_moe2(p, lds, nblk, bid);
  grid_bar(p, lds);
  ph_final(p, nblk, bid);
}
static inline size_t al(size_t x) { return (x + 255) & ~(size_t)255; }

extern "C" void kernel_launch(void* const* d_in, const int* in_sizes, int n_in, void* d_out, int out_size, void* d_ws,
                              size_t ws_size, hipStream_t stream) {
  Params p{};
  p.x = (const float*)d_in[0]; p.c = (const float*)d_in[1]; p.w_ada = (const float*)d_in[2]; p.b_ada = (const float*)d_in[3];
  p.g_pre_mix = (const float*)d_in[4]; p.g_post_mix = (const float*)d_in[5]; p.g_pre_ffn = (const float*)d_in[6];
  p.g_post_ffn = (const float*)d_in[7]; p.w_in = (const float*)d_in[8]; p.conv_w = (const float*)d_in[9];
  p.a_log = (const float*)d_in[10]; p.dt_bias = (const float*)d_in[11]; p.g_dn_out = (const float*)d_in[12];
  p.w_br_a = (const float*)d_in[13]; p.w_br_b = (const float*)d_in[14]; p.w_o = (const float*)d_in[15];
  p.w_router = (const float*)d_in[16]; p.b_router = (const float*)d_in[17]; p.w_gu = (const float*)d_in[18];
  p.b_gu = (const float*)d_in[19]; p.w_down = (const float*)d_in[20]; p.b_down = (const float*)d_in[21];
  p.out = (float*)d_out;
  char* w = (char*)d_ws;
  size_t o = 0;
  auto take = [&](size_t bytes) { char* r = w + o; o += al(bytes); return r; };
  p.mod = (float*)take(4 * 6144 * 4);
  p.cnt = (int*)take(256);
  p.ba = (float*)take((size_t)T_TOK * 8 * 4);
  p.hbf = (bf16_t*)take((size_t)T_TOK * DM * 2);
  p.proj = (bf16_t*)take((size_t)T_TOK * PW * 2);
  p.w_in_t = (bf16_t*)take((size_t)PW * DM * 2);
  p.wgu_t = (bf16_t*)take((size_t)NE * 2048 * DM * 2);
  p.wd_t = (bf16_t*)take((size_t)NE * 1024 * DM * 2);
  p.wbra_t = (bf16_t*)take((size_t)1024 * 512 * 2);
  p.wbrb_t = (bf16_t*)take((size_t)1024 * 512 * 2);
  p.wo_t = (bf16_t*)take((size_t)1024 * 1024 * 2);
  p.qb = (bf16_t*)take((size_t)T_TOK * 512 * 2);
  p.kb = (bf16_t*)take((size_t)T_TOK * 512 * 2);
  p.kmean = (float*)take((size_t)16 * 16 * 128 * 4);
  p.oab = (bf16_t*)take((size_t)T_TOK * DM * 2);
  p.merged = (bf16_t*)take((size_t)T_TOK * DM * 2);
  p.mixer = (bf16_t*)take((size_t)T_TOK * DM * 2);
  p.h2 = (bf16_t*)take((size_t)T_TOK * DM * 2);
  p.elist = (int*)take((size_t)NE * T_TOK * 4);
  p.aw = (float*)take((size_t)T_TOK * 4 * 4);
  p.rowmap = (int*)take((size_t)73728 * 4);
  p.dnA = (unsigned char*)take((size_t)1024 * DN_ABYTES);
  p.dnU = (float*)take((size_t)1024 * DN_UFLOATS * 4);
  p.dnG = (float*)take(4096);
  p.oab2 = (bf16_t*)take((size_t)T_TOK * 512 * 2);
  p.dbg = (float*)take(256);
  p.bar = (unsigned*)take(XCD_BAR_WORDS * 4);
  p.never = 0;
  p.dn_out = p.oab; p.dn_out_ld = DM;
  p.Kp = (bf16_t*)take((size_t)16 * 128 * 8192);
  p.Vp = (bf16_t*)take((size_t)16 * 128 * 8192);
  p.wq = p.cnt + 32;
  p.mb_out = p.oab; p.mb_out_ld = DM; p.mb_out_off = 512;
  p.xs = p.proj;
  char* big = take((size_t)73728 * DM * 2 + (size_t)65536 * DM * 2);
  p.act = (bf16_t*)big;
  p.yslot = (bf16_t*)(big + (size_t)73728 * DM * 2);
  {
    char* s = big; size_t so = 0;
    auto t2 = [&](size_t bytes) { char* r = s + so; so += al(bytes); return r; };
    p.nq = (float*)t2((size_t)T_TOK * 512 * 4);
    p.nk = (float*)t2((size_t)T_TOK * 512 * 4);
    p.nv = (float*)t2((size_t)T_TOK * 512 * 4);
    p.no = (float*)t2((size_t)T_TOK * 512 * 4);
    p.ntmp = (float*)t2((size_t)T_TOK * DM * 4);
    p.nbeta = (float*)t2((size_t)T_TOK * 4 * 4);
    p.ng = (float*)t2((size_t)T_TOK * 4 * 4);
  }

  static int grid_blocks = 0;
  if (!grid_blocks) {
    (void)hipFuncSetAttribute((const void*)mega, hipFuncAttributeMaxDynamicSharedMemorySize, MEGA_LDS_ALLOC);
    int dev = 0, cus = 0, per_cu = 0;
    (void)hipGetDevice(&dev);
    (void)hipDeviceGetAttribute(&cus, hipDeviceAttributeMultiprocessorCount, dev);
    (void)hipOccupancyMaxActiveBlocksPerMultiprocessor(&per_cu, mega, 512, MEGA_LDS_ALLOC);
    if (per_cu != 1) per_cu = 1;
    grid_blocks = cus * per_cu;
  }
  (void)hipMemsetAsync(p.cnt, 0, 256, stream);
  (void)hipMemsetAsync(p.bar, 0, XCD_BAR_WORDS * 4, stream);
  void* args[] = {&p};
  hipError_t e = hipLaunchCooperativeKernel((void*)mega, dim3(grid_blocks), dim3(512), args, MEGA_LDS_ALLOC, stream);
  if (e != hipSuccess) fprintf(stderr, "cooperative launch failed: %s (grid %d)\n", hipGetErrorString(e), grid_blocks);
}
```

```cpp
#include <hip/hip_runtime.h>
#include <hip/hip_cooperative_groups.h>
#include <cstdio>
namespace cg = cooperative_groups;
#include <stdint.h>

typedef unsigned short bf16_t;

#define T_TOK 16384
#define SEQ 4096
#define NB 4
#define DM 1024
#define INW 5640
#define PW 5632
#define C_QA 0
#define C_KA 512
#define C_VA 1024
#define C_Z 1536
#define C_MQ 2048
#define C_MK 2560
#define C_MV 3072
#define C_GA 3584
#define C_GB 4608
#define NE 32

__device__ __forceinline__ bf16_t f2bf(float f) {
  unsigned u = __float_as_uint(f);
  u += 0x7fffu + ((u >> 16) & 1u);
  return (bf16_t)(u >> 16);
}
__device__ __forceinline__ float bf2f(bf16_t h) { return __uint_as_float(((unsigned)h) << 16); }
__device__ __forceinline__ float sigmoidf_(float x) { return 1.f / (1.f + __expf(-x)); }
__device__ __forceinline__ float siluf_(float x) { return x / (1.f + __expf(-x)); }
__device__ __forceinline__ float wave_sum(float v) {
#pragma unroll
  for (int o = 32; o > 0; o >>= 1) v += __shfl_xor(v, o, 64);
  return v;
}
__device__ __forceinline__ float wave_max(float v) {
#pragma unroll
  for (int o = 32; o > 0; o >>= 1) v = fmaxf(v, __shfl_xor(v, o, 64));
  return v;
}

typedef __bf16 bf16x2_t __attribute__((ext_vector_type(2)));
typedef float f32x2_t __attribute__((ext_vector_type(2)));
__device__ __forceinline__ unsigned pk2(float a, float b) { f32x2_t v = {a, b}; bf16x2_t r = __builtin_convertvector(v, bf16x2_t); return __builtin_bit_cast(unsigned, r); }

struct Params {
  const float *x, *c, *w_ada, *b_ada, *g_pre_mix, *g_post_mix, *g_pre_ffn, *g_post_ffn, *w_in, *conv_w,
      *a_log, *dt_bias, *g_dn_out, *w_br_a, *w_br_b, *w_o, *w_router, *b_router, *w_gu, *b_gu, *w_down, *b_down;
  float* out;
  float* mod;
  int* cnt;
  float* ba;
  bf16_t* hbf;
  bf16_t* proj;
  bf16_t* w_in_t;
  bf16_t* wgu_t;
  bf16_t* wd_t;
  bf16_t* wbra_t;
  bf16_t* wbrb_t;
  bf16_t* wo_t;
  bf16_t* qb;
  bf16_t* kb;
  float* kmean;
  bf16_t* oab;
  bf16_t* merged;
  bf16_t* mixer;
  bf16_t* h2;
  int* elist;
  float* aw;
  bf16_t* act;
  bf16_t* xs;
  int* rowmap;
  bf16_t* yslot;
  unsigned char* dnA; float* dnU; float* dnG;
  bf16_t* dn_out; int dn_out_ld;
  bf16_t* oab2; float* dbg;
  unsigned* bar; int never;
  bf16_t* Kp; bf16_t* Vp; int* wq;
  bf16_t* mb_out; int mb_out_ld; int mb_out_off;
  float* nq; float* nk; float* nv;
  float* nbeta; float* ng;
  float* no;
  float* ntmp;
};

__device__ __forceinline__ int map_col(int n, int mode) {
  if (mode == 0) return n;
  if (mode == 1) return n < 2048 ? n : (n < 2056 ? -1 : n - 8);
  if (n < 1024) return (n >> 7) * 256 + (n & 127);
  int j = n - 1024;
  return (j >> 7) * 256 + 128 + (j & 127);
}
namespace pg8 {
#define PG8_LAS __attribute__((address_space(3)))
typedef short bf16x8 __attribute__((ext_vector_type(8)));
typedef float f32x4 __attribute__((ext_vector_type(4)));
typedef unsigned u32x4 __attribute__((ext_vector_type(4)));
constexpr int BM = 256, BK = 64, HALF = 128, HTB = HALF * BK * 2, STAGE_BYTES = 8 * HTB, NXCD = 8, WGM = 8;

__host__ __device__ __forceinline__ int lds_byte(int r, int c) { const int st = (r >> 4) * 2 + (c >> 5), rr = r & 15, cc = c & 31, ob = rr * 64 + cc * 2; return st * 1024 + (ob ^ (((ob >> 9) & 1) << 5)); }
__host__ __device__ __forceinline__ void stage_rc(int b, int& R, int& C) { const int st = b / 1024, sb = b % 1024, swz = sb ^ (((sb >> 9) & 1) << 5); R = (st >> 1) * 16 + swz / 64; C = (st & 1) * 32 + (swz % 64) / 2; }
__host__ __device__ __forceinline__ int perm32(int rho) { const int n = rho >> 4, i = rho & 15; return 8 * (i >> 2) + 4 * n + (i & 3); }

struct Unit { int pm, pn, z; };
__device__ __forceinline__ unsigned cvt_pk_bf16(float lo, float hi) { unsigned r; asm volatile("v_cvt_pk_bf16_f32 %0, %1, %2" : "=v"(r) : "v"(lo), "v"(hi)); return r; }

struct TileOrder {
    int nM, nN, nwg, G, c;
    __device__ void init(int nM_, int nN_, int G_, int c_) { nM = nM_; nN = nN_; nwg = nM * nN; G = G_; c = c_; }
    __device__ bool tile(int i, int& pm, int& pn) const {
        const long L = (long)i * G + c; if (L >= nwg) return false;
        int wgid = (int)L; { const int q = nwg / NXCD, r = nwg % NXCD, xcd = wgid % NXCD, off = wgid / NXCD; wgid = (xcd < r ? xcd * (q + 1) : r * (q + 1) + (xcd - r) * q) + off; }
        const int nig = WGM * nN, gid = wgid / nig, fm = gid * WGM, gsz = (nM - fm) < WGM ? (nM - fm) : WGM;
        pm = fm + ((wgid % nig) % gsz); pn = (wgid % nig) / gsz; return true;
    }
};

template <class Epi, class Sched>
__device__ __forceinline__ void gemm_phase(PG8_LAS unsigned char* lds, const int lda, const int ldb, const int K, const Sched& S, const Epi& E) {
    const int tid = threadIdx.x, wid = __builtin_amdgcn_readfirstlane(tid >> 6), lane = tid & 63, wr = wid >> 2, wc = wid & 3, fr = lane & 15, fq = lane >> 4;
    const int nt = K / BK;
    unsigned voffA[2], voffB[2];
#pragma unroll
    for (int i = 0; i < 2; ++i) { int R, C; stage_rc(tid * 16 + i * 8192, R, C); const int Rb = Epi::PERM ? ((R & ~31) + perm32(R & 31)) : R;
        voffA[i] = (unsigned)(R * lda + C) * 2u; voffB[i] = (unsigned)(Rb * ldb + C) * 2u; }
    const size_t kstep = (size_t)(BK * 2);
    const size_t hstepA = (size_t)HALF * lda * 2, hstepB = (size_t)HALF * ldb * 2;
    const unsigned ldsw = (unsigned)wid * 1024u;
    const int aoff = lds_byte(wr * 64 + fr, fq * 8), boff = lds_byte(wc * 32 + fr, fq * 8);
#define PG8_SA(b, h) (((b) * 2 + (h)) * HTB)
#define PG8_SB(b, h) ((4 + (b) * 2 + (h)) * HTB)
#define PG8_STAGE(bufoff, gbase, voff) do { _Pragma("unroll") for (int _i = 0; _i < 2; ++_i) \
        __builtin_amdgcn_global_load_lds((const unsigned*)((const char*)(gbase) + (voff)[_i]), (PG8_LAS unsigned*)(lds + (bufoff) + ldsw + _i * 8192), 16, 0, 0); } while (0)
#define PG8_LDA(dst, b, h) do { _Pragma("unroll") for (int m = 0; m < 4; ++m) _Pragma("unroll") for (int k = 0; k < 2; ++k) dst[m][k] = *(const PG8_LAS bf16x8*)(lds + PG8_SA(b, h) + aoff + m * 2048 + k * 1024); } while (0)
#define PG8_LDB(dst, b, h) do { _Pragma("unroll") for (int n = 0; n < 2; ++n) _Pragma("unroll") for (int k = 0; k < 2; ++k) dst[n][k] = *(const PG8_LAS bf16x8*)(lds + PG8_SB(b, h) + boff + n * 2048 + k * 1024); } while (0)
#define PG8_MMA(ai, bj, At, Bt) do { __builtin_amdgcn_s_setprio(1); _Pragma("unroll") for (int m = 0; m < 4; ++m) _Pragma("unroll") for (int n = 0; n < 2; ++n) _Pragma("unroll") for (int k = 0; k < 2; ++k) \
        acc[ai][bj][m][n] = __builtin_amdgcn_mfma_f32_16x16x32_bf16(Bt[n][k], At[m][k], acc[ai][bj][m][n], 0, 0, 0); __builtin_amdgcn_s_setprio(0); } while (0)
#define PG8_WAIT_V(n) asm volatile("s_waitcnt vmcnt(" #n ")" ::: "memory")
#define PG8_WAIT_L(n) asm volatile("s_waitcnt lgkmcnt(" #n ")" ::: "memory")
#define PG8_BAR __builtin_amdgcn_s_barrier()
#define PG8_SCHED __builtin_amdgcn_sched_barrier(0)
    Unit cur, nxt; int ui = 0;
    if (!S.next(0, cur)) return;
    f32x4 acc[2][2][4][2];
#pragma unroll
    for (int a = 0; a < 2; ++a)
#pragma unroll
        for (int b = 0; b < 2; ++b)
#pragma unroll
            for (int m = 0; m < 4; ++m)
#pragma unroll
                for (int n = 0; n < 2; ++n) acc[a][b][m][n] = (f32x4){0.f, 0.f, 0.f, 0.f};
    bf16x8 At[4][2], B0[2][2], B1[2][2];
    const char* cA = S.a_ptr(cur); const char* cB = S.b_ptr(cur);
    PG8_STAGE(PG8_SB(0, 0), cB, voffB); PG8_STAGE(PG8_SA(0, 0), cA, voffA); PG8_STAGE(PG8_SB(0, 1), cB + hstepB, voffB); PG8_STAGE(PG8_SA(0, 1), cA + hstepA, voffA);
    if (wr == 1) PG8_BAR;
    PG8_WAIT_V(4); PG8_BAR;
    PG8_STAGE(PG8_SB(1, 0), cB + kstep, voffB); PG8_STAGE(PG8_SA(1, 0), cA + kstep, voffA); PG8_STAGE(PG8_SB(1, 1), cB + hstepB + kstep, voffB);
    PG8_WAIT_V(6); PG8_BAR;
    for (;;) {
        const bool has_next = S.next(ui + 1, nxt);
        const char* nA = has_next ? S.a_ptr(nxt) : cA; const char* nB = has_next ? S.b_ptr(nxt) : cB;
        for (int t = 0; t < nt; t += 2) {
            const bool last = (t == nt - 2);
            const char* a1 = cA + (size_t)(t + 1) * kstep;
            const char* a2 = last ? nA : cA + (size_t)(t + 2) * kstep; const char* b2 = last ? nB : cB + (size_t)(t + 2) * kstep;
            const char* a3 = a2 + kstep; const char* b3 = b2 + kstep;
            PG8_LDB(B0, 0, 0); PG8_SCHED; PG8_LDA(At, 0, 0); PG8_STAGE(PG8_SA(1, 1), a1 + hstepA, voffA);
            PG8_WAIT_L(8); PG8_BAR; PG8_WAIT_L(0); PG8_MMA(0, 0, At, B0); PG8_BAR; PG8_SCHED;
            PG8_LDB(B1, 0, 1); PG8_STAGE(PG8_SB(0, 0), b2, voffB);
            PG8_BAR; PG8_WAIT_L(0); PG8_MMA(0, 1, At, B1); PG8_BAR;
            PG8_LDA(At, 0, 1); PG8_STAGE(PG8_SA(0, 0), a2, voffA);
            PG8_BAR; PG8_WAIT_L(0); PG8_MMA(1, 0, At, B0); PG8_BAR; PG8_SCHED;
            PG8_STAGE(PG8_SB(0, 1), b2 + hstepB, voffB);
            PG8_WAIT_V(6); PG8_BAR; PG8_MMA(1, 1, At, B1); PG8_BAR;
            PG8_LDB(B0, 1, 0); PG8_SCHED; PG8_LDA(At, 1, 0); PG8_STAGE(PG8_SA(0, 1), a2 + hstepA, voffA);
            PG8_WAIT_L(8); PG8_BAR; PG8_WAIT_L(0); PG8_MMA(0, 0, At, B0); PG8_BAR; PG8_SCHED;
            PG8_LDB(B1, 1, 1); PG8_STAGE(PG8_SB(1, 0), b3, voffB);
            PG8_BAR; PG8_WAIT_L(0); PG8_MMA(0, 1, At, B1); PG8_BAR;
            PG8_LDA(At, 1, 1); PG8_STAGE(PG8_SA(1, 0), a3, voffA);
            PG8_BAR; PG8_WAIT_L(0); PG8_MMA(1, 0, At, B0); PG8_BAR; PG8_SCHED;
            PG8_STAGE(PG8_SB(1, 1), b3 + hstepB, voffB);
            PG8_WAIT_V(6); PG8_BAR; PG8_MMA(1, 1, At, B1); PG8_BAR;
        }
        E(acc, cur, wr, wc, fr, fq);
        if (!has_next) break;
#pragma unroll
        for (int a = 0; a < 2; ++a)
#pragma unroll
            for (int b = 0; b < 2; ++b)
#pragma unroll
                for (int m = 0; m < 4; ++m)
#pragma unroll
                    for (int n = 0; n < 2; ++n) acc[a][b][m][n] = (f32x4){0.f, 0.f, 0.f, 0.f};
        cur = nxt; cA = nA; cB = nB; ++ui;
    }
    PG8_WAIT_V(0);
    if (wr == 0) PG8_BAR;
    PG8_BAR;
#undef PG8_SA
#undef PG8_SB
#undef PG8_STAGE
#undef PG8_LDA
#undef PG8_LDB
#undef PG8_MMA
#undef PG8_WAIT_V
#undef PG8_WAIT_L
#undef PG8_BAR
#undef PG8_SCHED
}
}
using pg8::f32x4; using pg8::u32x4; using pg8::Unit;

#define GEMM_LDS (pg8::STAGE_BYTES + 1024)

struct SchedProj : pg8::TileOrder {
  const char* A; const char* B;
  __device__ bool next(int i, Unit& u) const { u.z = 0; return tile(i, u.pm, u.pn); }
  __device__ const char* a_ptr(const Unit& u) const { return A + (size_t)u.pm * 256 * DM * 2; }
  __device__ const char* b_ptr(const Unit& u) const { return B + (size_t)u.pn * 256 * DM * 2; }
};
struct EpiProj {
  static constexpr bool PERM = true;
  bf16_t* O;
  __device__ __forceinline__ void operator()(const f32x4 (&acc)[2][2][4][2], const Unit& u, int wr, int wc, int fr, int fq) const {
    const int row0 = u.pm * 256 + wr * 64 + fr, col0 = u.pn * 256 + wc * 32 + 8 * fq;
    const bool gate = u.pn >= (C_GA / 256);
#pragma unroll
    for (int ai = 0; ai < 2; ++ai)
#pragma unroll
      for (int m = 0; m < 4; ++m) {
        bf16_t* rowp = O + (size_t)(row0 + ai * 128 + m * 16) * PW + col0;
#pragma unroll
        for (int bj = 0; bj < 2; ++bj) {
          f32x4 v0 = acc[ai][bj][m][0], v1 = acc[ai][bj][m][1];
          if (gate) {
#pragma unroll
            for (int j = 0; j < 4; ++j) { v0[j] = sigmoidf_(v0[j]); v1[j] = sigmoidf_(v1[j]); }
          }
          u32x4 w; w.x = pg8::cvt_pk_bf16(v0[0], v0[1]); w.y = pg8::cvt_pk_bf16(v0[2], v0[3]); w.z = pg8::cvt_pk_bf16(v1[0], v1[1]); w.w = pg8::cvt_pk_bf16(v1[2], v1[3]);
          *(u32x4*)(rowp + bj * 128) = w;
        }
      }
  }
};
__device__ void ph_proj(const Params& p, PG8_LAS unsigned char* lds, int nblk, int bid) {
  SchedProj S; S.init(T_TOK / 256, PW / 256, nblk, bid); S.A = (const char*)p.hbf; S.B = (const char*)p.w_in_t;
  EpiProj E{p.proj};
  pg8::gemm_phase(lds, DM, DM, DM, S, E);
}

struct SchedBr : pg8::TileOrder {
  const char* A; const char* Ba; const char* Bb;
  __device__ bool next(int i, Unit& u) const { u.z = i & 1; return tile(i >> 1, u.pm, u.pn); }
  __device__ const char* a_ptr(const Unit& u) const { return A + (size_t)u.pm * 256 * DM * 2 + u.z * 512 * 2; }
  __device__ const char* b_ptr(const Unit& u) const { return (u.z ? Bb : Ba) + (size_t)u.pn * 256 * 512 * 2; }
};
__device__ __forceinline__ void unpack8(const u32x4 w, float (&f)[8]) {
  f[0] = __uint_as_float(w.x << 16); f[1] = __uint_as_float(w.x & 0xffff0000u); f[2] = __uint_as_float(w.y << 16); f[3] = __uint_as_float(w.y & 0xffff0000u);
  f[4] = __uint_as_float(w.z << 16); f[5] = __uint_as_float(w.z & 0xffff0000u); f[6] = __uint_as_float(w.w << 16); f[7] = __uint_as_float(w.w & 0xffff0000u);
}
struct EpiBr {
  static constexpr bool PERM = true;
  const bf16_t* proj; bf16_t* O;
  __device__ __forceinline__ void operator()(const f32x4 (&acc)[2][2][4][2], const Unit& u, int wr, int wc, int fr, int fq) const {
    const int row0 = u.pm * 256 + wr * 64 + fr, col0 = u.pn * 256 + wc * 32 + 8 * fq;
    const int gcol = (u.z ? C_GB : C_GA) + col0;
#pragma unroll
    for (int ai = 0; ai < 2; ++ai)
#pragma unroll
      for (int m = 0; m < 4; ++m) {
        const size_t row = (size_t)(row0 + ai * 128 + m * 16);
        bf16_t* rowp = O + row * DM + col0;
        const bf16_t* gp = proj + row * PW + gcol;
#pragma unroll
        for (int bj = 0; bj < 2; ++bj) {
          float g[8]; unpack8(*(const u32x4*)(gp + bj * 128), g);
          f32x4 v0 = acc[ai][bj][m][0], v1 = acc[ai][bj][m][1];
          float r[8];
#pragma unroll
          for (int j = 0; j < 4; ++j) { r[j] = v0[j] * g[j]; r[4 + j] = v1[j] * g[4 + j]; }
          if (u.z) {
            float pv[8]; unpack8(*(const u32x4*)(rowp + bj * 128), pv);
#pragma unroll
            for (int j = 0; j < 8; ++j) r[j] += pv[j];
          }
          u32x4 w; w.x = pg8::cvt_pk_bf16(r[0], r[1]); w.y = pg8::cvt_pk_bf16(r[2], r[3]); w.z = pg8::cvt_pk_bf16(r[4], r[5]); w.w = pg8::cvt_pk_bf16(r[6], r[7]);
          *(u32x4*)(rowp + bj * 128) = w;
        }
      }
  }
};
__device__ void ph_br(const Params& p, PG8_LAS unsigned char* lds, int nblk, int bid) {
  SchedBr S; S.init(T_TOK / 256, DM / 256, nblk, bid); S.A = (const char*)p.oab; S.Ba = (const char*)p.wbra_t; S.Bb = (const char*)p.wbrb_t;
  EpiBr E{p.proj, p.merged};
  pg8::gemm_phase(lds, DM, 512, 512, S, E);
}

struct SchedMix : pg8::TileOrder {
  const char* A; const char* B;
  __device__ bool next(int i, Unit& u) const { u.z = 0; return tile(i, u.pm, u.pn); }
  __device__ const char* a_ptr(const Unit& u) const { return A + (size_t)u.pm * 256 * DM * 2; }
  __device__ const char* b_ptr(const Unit& u) const { return B + (size_t)u.pn * 256 * DM * 2; }
};
struct EpiMix {
  static constexpr bool PERM = true;
  bf16_t* O;
  __device__ __forceinline__ void operator()(const f32x4 (&acc)[2][2][4][2], const Unit& u, int wr, int wc, int fr, int fq) const {
    const int row0 = u.pm * 256 + wr * 64 + fr, col0 = u.pn * 256 + wc * 32 + 8 * fq;
#pragma unroll
    for (int ai = 0; ai < 2; ++ai)
#pragma unroll
      for (int m = 0; m < 4; ++m) {
        bf16_t* rowp = O + (size_t)(row0 + ai * 128 + m * 16) * DM + col0;
#pragma unroll
        for (int bj = 0; bj < 2; ++bj) {
          const f32x4 v0 = acc[ai][bj][m][0], v1 = acc[ai][bj][m][1];
          u32x4 w; w.x = pg8::cvt_pk_bf16(v0[0], v0[1]); w.y = pg8::cvt_pk_bf16(v0[2], v0[3]); w.z = pg8::cvt_pk_bf16(v1[0], v1[1]); w.w = pg8::cvt_pk_bf16(v1[2], v1[3]);
          *(u32x4*)(rowp + bj * 128) = w;
        }
      }
  }
};
__device__ void ph_mix(const Params& p, PG8_LAS unsigned char* lds, int nblk, int bid) {
  SchedMix S; S.init(T_TOK / 256, DM / 256, nblk, bid); S.A = (const char*)p.merged; S.B = (const char*)p.wo_t;
  EpiMix E{p.mixer};
  pg8::gemm_phase(lds, DM, DM, DM, S, E);
}

struct SchedMoe {
  const PG8_LAS int* tb; int NT; int G, c; int nwg;
  const char* A; const char* B; size_t bexp;
  __device__ bool next(int i, Unit& u) const {
    const long L = (long)i * G + c; if (L >= nwg) return false;
    int wgid = (int)L; { const int q = nwg / 8, r = nwg % 8, xcd = wgid % 8, off = wgid / 8; wgid = (xcd < r ? xcd * (q + 1) : r * (q + 1) + (xcd - r) * q) + off; }
    int e = 0;
#pragma unroll 1
    for (int k = 1; k < NE; ++k) if (wgid >= tb[k]) e = k;
    const int q = wgid - tb[e]; const int tiles = tb[33 + e + 1] - tb[33 + e];
    u.pm = tb[33 + e] + q % tiles; u.pn = q / tiles; u.z = e; return true;
  }
  __device__ const char* a_ptr(const Unit& u) const { return A + (size_t)u.pm * 256 * DM * 2; }
  __device__ const char* b_ptr(const Unit& u) const { return B + (size_t)u.z * bexp + (size_t)u.pn * 256 * DM * 2; }
};
__device__ __forceinline__ void moe_table(const Params& p, PG8_LAS int* tb, int NT) {
  if (threadIdx.x == 0) {
    int ub = 0, tbp = 0;
    for (int e = 0; e < NE; ++e) { tb[e] = ub; tb[33 + e] = tbp; const int t = (p.cnt[e] + 255) >> 8; ub += t * NT; tbp += t; }
    tb[NE] = ub; tb[33 + NE] = tbp;
  }
  __syncthreads();
}
struct EpiMoe1 {
  static constexpr bool PERM = true;
  const float* b_gu; bf16_t* act;
  __device__ __forceinline__ void operator()(f32x4 (&acc)[2][2][4][2], const Unit& u, int wr, int wc, int fr, int fq) const {
    const int row0 = u.pm * 256 + wr * 64 + fr, jc = u.pn * 128 + wc * 32 + 8 * fq;
    const float* bg = b_gu + (size_t)u.z * 2048 + jc;
#pragma unroll
    for (int bj = 0; bj < 2; ++bj)
#pragma unroll
      for (int n = 0; n < 2; ++n) {
        const f32x4 bv = *(const f32x4*)(bg + bj * 1024 + n * 4);
#pragma unroll
        for (int ai = 0; ai < 2; ++ai)
#pragma unroll
          for (int m = 0; m < 4; ++m) acc[ai][bj][m][n] += bv;
      }
#pragma unroll
    for (int ai = 0; ai < 2; ++ai)
#pragma unroll
      for (int m = 0; m < 4; ++m) {
        bf16_t* rowp = act + (size_t)(row0 + ai * 128 + m * 16) * DM + jc;
        float r[8];
#pragma unroll
        for (int n = 0; n < 2; ++n)
#pragma unroll
          for (int j = 0; j < 4; ++j) {
            float g = acc[ai][0][m][n][j], up = acc[ai][1][m][n][j];
            g = fminf(g, 7.f); up = fminf(fmaxf(up, -7.f), 7.f);
            r[n * 4 + j] = (up + 1.f) * g * sigmoidf_(1.702f * g);
          }
        u32x4 w; w.x = pk2(r[0], r[1]); w.y = pk2(r[2], r[3]); w.z = pk2(r[4], r[5]); w.w = pk2(r[6], r[7]);
        *(u32x4*)rowp = w;
      }
  }
};
__device__ void ph_moe1(const Params& p, PG8_LAS unsigned char* lds, int nblk, int bid) {
  PG8_LAS int* tb = (PG8_LAS int*)(lds + pg8::STAGE_BYTES);
  moe_table(p, tb, 8);
  SchedMoe S; S.tb = tb; S.NT = 8; S.G = nblk; S.c = bid; S.nwg = tb[NE]; S.A = (const char*)p.xs; S.B = (const char*)p.wgu_t; S.bexp = (size_t)2048 * DM * 2;
  EpiMoe1 E{p.b_gu, p.act};
  pg8::gemm_phase(lds, DM, DM, DM, S, E);
}
struct EpiMoe2 {
  static constexpr bool PERM = true;
  const float* b_down; const int* rowmap; bf16_t* yslot;
  __device__ __forceinline__ void operator()(f32x4 (&acc)[2][2][4][2], const Unit& u, int wr, int wc, int fr, int fq) const {
    const int row0 = u.pm * 256 + wr * 64 + fr, col0 = u.pn * 256 + wc * 32 + 8 * fq;
    const float* bd = b_down + (size_t)u.z * 1024 + col0;
#pragma unroll
    for (int bj = 0; bj < 2; ++bj)
#pragma unroll
      for (int n = 0; n < 2; ++n) {
        const f32x4 bv = *(const f32x4*)(bd + bj * 128 + n * 4);
#pragma unroll
        for (int ai = 0; ai < 2; ++ai)
#pragma unroll
          for (int m = 0; m < 4; ++m) acc[ai][bj][m][n] += bv;
      }
#pragma unroll
    for (int ai = 0; ai < 2; ++ai)
#pragma unroll
      for (int m = 0; m < 4; ++m) {
        const int a = rowmap[row0 + ai * 128 + m * 16];
        if (a >= 0) {
          bf16_t* rowp = yslot + (size_t)a * DM + col0;
#pragma unroll
          for (int bj = 0; bj < 2; ++bj) {
            const f32x4 v0 = acc[ai][bj][m][0], v1 = acc[ai][bj][m][1];
            u32x4 w; w.x = pk2(v0[0], v0[1]); w.y = pk2(v0[2], v0[3]); w.z = pk2(v1[0], v1[1]); w.w = pk2(v1[2], v1[3]);
            *(u32x4*)(rowp + bj * 128) = w;
          }
        }
      }
  }
};
__device__ void ph_moe2(const Params& p, PG8_LAS unsigned char* lds, int nblk, int bid) {
  PG8_LAS int* tb = (PG8_LAS int*)(lds + pg8::STAGE_BYTES);
  moe_table(p, tb, 4);
  SchedMoe S; S.tb = tb; S.NT = 4; S.G = nblk; S.c = bid; S.nwg = tb[NE]; S.A = (const char*)p.act; S.B = (const char*)p.wd_t; S.bexp = (size_t)1024 * DM * 2;
  EpiMoe2 E{p.b_down, p.rowmap, p.yslot};
  pg8::gemm_phase(lds, DM, DM, DM, S, E);
}

typedef short bf16x8 __attribute__((ext_vector_type(8)));
typedef unsigned u32x2 __attribute__((ext_vector_type(2)));
#define LAS __attribute__((address_space(3)))
#define MFMA16(a, b, c) __builtin_amdgcn_mfma_f32_16x16x32_bf16((a), (b), (c), 0, 0, 0)
__device__ __forceinline__ bf16x8 pack8(float a0, float a1, float a2, float a3, float a4, float a5, float a6, float a7) {
  u32x4 w; w.x = pk2(a0, a1); w.y = pk2(a2, a3); w.z = pk2(a4, a5); w.w = pk2(a6, a7);
  return __builtin_bit_cast(bf16x8, w);
}
__device__ __forceinline__ bf16_t f2bf_hw(float a) { return (bf16_t)(pk2(a, 0.f) & 0xffffu); }

#define DN_ABYTES 57344
#define DN_UFLOATS 8192
#define F_WN 0
#define F_QD 16
#define F_QK 32
#define F_KT 40

#define DP_KH 0
#define DP_QT 17408
#define DP_KHT 34816
#define DP_VT 53248
#define DP_TU 71680
#define DP_TW 80896
#define DP_LF 90112
#define DP_GC 107520
#define DP_BETA 107776
#define DP_CW 108032
#define DP_TOTAL 114176

template <int KS>
__device__ __forceinline__ f32x4 prod16(const LAS bf16_t* A, int lda, int arow0, const LAS bf16_t* Bt, int ldb, int brow0, f32x4 acc, int lane) {
  const int r = lane & 15, q = lane >> 4;
#pragma unroll
  for (int ks = 0; ks < KS; ++ks) {
    const bf16x8 a = *(const LAS bf16x8*)(A + (arow0 + r) * lda + 32 * ks + 8 * q);
    const bf16x8 b = *(const LAS bf16x8*)(Bt + (brow0 + r) * ldb + 32 * ks + 8 * q);
    acc = MFMA16(a, b, acc);
  }
  return acc;
}
__device__ __forceinline__ void tile_store_rm(LAS bf16_t* X, int ld, int row0, int col0, const f32x4 v, int lane) {
  const int r = lane & 15, q = lane >> 4;
#pragma unroll
  for (int i = 0; i < 4; ++i) X[(row0 + 4 * q + i) * ld + col0 + r] = f2bf_hw(v[i]);
}
__device__ __forceinline__ void tile_store_tr(LAS bf16_t* Xt, int ld, int row0, int col0, const f32x4 v, int lane) {
  const int r = lane & 15, q = lane >> 4;
  u32x2 w; w.x = pk2(v[0], v[1]); w.y = pk2(v[2], v[3]);
  *(LAS u32x2*)(Xt + (col0 + r) * ld + row0 + 4 * q) = w;
}

__device__ void dn_prep_chunk(const Params& p, LAS unsigned char* lds, int ci, bool load_cw) {
  const int tid = threadIdx.x, lane = tid & 63, w = tid >> 6, r16 = lane & 15, q4 = lane >> 4;
  const int bh = ci >> 6, n = ci & 63, b = bh >> 2, h = bh & 3;
  LAS bf16_t* Kh = (LAS bf16_t*)(lds + DP_KH); LAS bf16_t* Qt = (LAS bf16_t*)(lds + DP_QT);
  LAS bf16_t* KhT = (LAS bf16_t*)(lds + DP_KHT); LAS bf16_t* VT = (LAS bf16_t*)(lds + DP_VT);
  LAS bf16_t* Tu = (LAS bf16_t*)(lds + DP_TU); LAS bf16_t* Tw = (LAS bf16_t*)(lds + DP_TW); LAS float* Lf = (LAS float*)(lds + DP_LF);
  LAS float* gcb = (LAS float*)(lds + DP_GC); LAS float* betab = (LAS float*)(lds + DP_BETA); LAS float* cw = (LAS float*)(lds + DP_CW);
  unsigned char* gA = (unsigned char*)p.dnA + (size_t)ci * DN_ABYTES;
  float* gU = p.dnU + (size_t)ci * DN_UFLOATS;

  if (load_cw) {
    for (int i = tid; i < 4 * 384; i += 512) { const int tap = i / 384, cc = i % 384, part = cc >> 7, d = cc & 127; cw[i] = p.conv_w[tap * 1536 + part * 512 + h * 128 + d]; }
  }
  __syncthreads();
  const int c = tid >> 3, g = tid & 7;
  const int s = n * 64 + c;
  const size_t t = (size_t)b * SEQ + s;
  float qv[16], kv[16], vv[16];
#pragma unroll
  for (int j = 0; j < 16; ++j) { qv[j] = 0.f; kv[j] = 0.f; vv[j] = 0.f; }
#pragma unroll
  for (int tap = 0; tap < 4; ++tap) {
    const int ss = s - 3 + tap;
    if (ss >= 0) {
      const bf16_t* row = p.proj + (t - 3 + tap) * PW + h * 128 + 16 * g;
      float x[8];
#pragma unroll
      for (int part = 0; part < 3; ++part) {
#pragma unroll
        for (int hh = 0; hh < 2; ++hh) {
          unpack8(*(const u32x4*)(row + part * 512 + 8 * hh), x);
#pragma unroll
          for (int j = 0; j < 8; ++j) {
            const float wv = cw[tap * 384 + part * 128 + 16 * g + 8 * hh + j];
            if (part == 0) qv[8 * hh + j] += wv * x[j];
            if (part == 1) kv[8 * hh + j] += wv * x[j];
            if (part == 2) vv[8 * hh + j] += wv * x[j];
          }
        }
      }
    }
    asm volatile("" ::: "memory");
  }
  float sq = 0.f, sk = 0.f;
#pragma unroll
  for (int j = 0; j < 16; ++j) { qv[j] = siluf_(qv[j]); kv[j] = siluf_(kv[j]); vv[j] = siluf_(vv[j]); sq += qv[j] * qv[j]; sk += kv[j] * kv[j]; }
  sq += __shfl_xor(sq, 1, 64); sq += __shfl_xor(sq, 2, 64); sq += __shfl_xor(sq, 4, 64);
  sk += __shfl_xor(sk, 1, 64); sk += __shfl_xor(sk, 2, 64); sk += __shfl_xor(sk, 4, 64);
  const float rq = rsqrtf(sq + 1e-6f) * 0.08838834764831845f, rk = rsqrtf(sk + 1e-6f);
#pragma unroll
  for (int j = 0; j < 16; ++j) { qv[j] *= rq; kv[j] *= rk; }
  if (g == 0) {
    const float bb = p.ba[t * 8 + h], aa = p.ba[t * 8 + 4 + h];
    const float xx = aa + p.dt_bias[h];
    const float sp = xx > 20.f ? xx : log1pf(__expf(xx));
    betab[c] = sigmoidf_(bb);
    gcb[c] = -__expf(p.a_log[h]) * sp;
  }
  {
    u32x4 w0, w1;
    w0.x = pk2(kv[0], kv[1]); w0.y = pk2(kv[2], kv[3]); w0.z = pk2(kv[4], kv[5]); w0.w = pk2(kv[6], kv[7]);
    w1.x = pk2(kv[8], kv[9]); w1.y = pk2(kv[10], kv[11]); w1.z = pk2(kv[12], kv[13]); w1.w = pk2(kv[14], kv[15]);
    *(LAS u32x4*)(Kh + c * 136 + 16 * g) = w0; *(LAS u32x4*)(Kh + c * 136 + 16 * g + 8) = w1;
    w0.x = pk2(qv[0], qv[1]); w0.y = pk2(qv[2], qv[3]); w0.z = pk2(qv[4], qv[5]); w0.w = pk2(qv[6], qv[7]);
    w1.x = pk2(qv[8], qv[9]); w1.y = pk2(qv[10], qv[11]); w1.z = pk2(qv[12], qv[13]); w1.w = pk2(qv[14], qv[15]);
    *(LAS u32x4*)(Qt + c * 136 + 16 * g) = w0; *(LAS u32x4*)(Qt + c * 136 + 16 * g + 8) = w1;
#pragma unroll
    for (int j = 0; j < 16; ++j) { KhT[(16 * g + j) * 72 + c] = f2bf_hw(kv[j]); VT[(16 * g + j) * 72 + c] = f2bf_hw(vv[j]); }
  }
  __syncthreads();
  if (w == 0) {
    float v = gcb[lane];
#pragma unroll
    for (int o = 1; o < 64; o <<= 1) { const float u = __shfl_up(v, o, 64); if (lane >= o) v += u; }
    gcb[lane] = v;
  }
  __syncthreads();
  const float gc_c = gcb[c], gl = gcb[63];
  {
    const float eg = __expf(gc_c);
    unsigned char* fb = gA + (size_t)(F_QD + (c >> 4) * 4 + (g >> 1)) * 1024 + (g & 1) * 8;
#pragma unroll
    for (int qq = 0; qq < 4; ++qq) {
      u32x2 wv; wv.x = pk2(qv[4 * qq] * eg, qv[4 * qq + 1] * eg); wv.y = pk2(qv[4 * qq + 2] * eg, qv[4 * qq + 3] * eg);
      *(u32x2*)(fb + ((c & 15) + 16 * qq) * 16) = wv;
    }
  }
  const int rt = w >> 1, ct0 = 2 * (w & 1);
#pragma unroll
  for (int tt = 0; tt < 2; ++tt) {
    const int ct = ct0 + tt;
    f32x4 gacc = {0.f, 0.f, 0.f, 0.f};
    gacc = prod16<4>(Kh, 136, 16 * rt, Kh, 136, 16 * ct, gacc, lane);
    const int m = 16 * ct + r16; const float gc_m = gcb[m];
#pragma unroll
    for (int i = 0; i < 4; ++i) {
      const int cc = 16 * rt + 4 * q4 + i;
      Lf[cc * 68 + m] = (m < cc) ? betab[cc] * gacc[i] * __expf(gcb[cc] - gc_m) : 0.f;
    }
    f32x4 qacc = {0.f, 0.f, 0.f, 0.f};
    qacc = prod16<4>(Kh, 136, 16 * rt, Qt, 136, 16 * ct, qacc, lane);
    const int cq = 16 * ct + r16; const float gc_cq = gcb[cq];
    float o4[4];
#pragma unroll
    for (int i = 0; i < 4; ++i) { const int mm = 16 * rt + 4 * q4 + i; o4[i] = (mm <= cq) ? qacc[i] * __expf(gc_cq - gcb[mm]) : 0.f; }
    u32x2 wv; wv.x = pk2(o4[0], o4[1]); wv.y = pk2(o4[2], o4[3]);
    *(u32x2*)(gA + (size_t)(F_QK + ct * 2 + (rt >> 1)) * 1024 + (r16 + 16 * q4) * 16 + (rt & 1) * 8) = wv;
  }
  __syncthreads();
  if (w == 0) {
    float T[64];
    int lo = lane; asm volatile("" : "+v"(lo));
    unsigned lfb = DP_LF; asm volatile("" : "+v"(lfb));
    const LAS float* Lfo = (const LAS float*)(lds + lfb);
    const float bm = betab[lo], bem = bm * __expf(gcb[lo]);
#pragma unroll
    for (int i = 0; i < 64; ++i) {
      float a0 = (i == lo) ? 1.f : 0.f, a1 = 0.f, a2 = 0.f, a3 = 0.f;
#pragma unroll
      for (int k4 = 0; k4 < (i + 3) / 4; ++k4) {
        const f32x4 l = *(const LAS f32x4*)(Lfo + i * 68 + 4 * k4);
        if (4 * k4 + 0 < i) a0 -= l[0] * T[4 * k4 + 0];
        if (4 * k4 + 1 < i) a1 -= l[1] * T[4 * k4 + 1];
        if (4 * k4 + 2 < i) a2 -= l[2] * T[4 * k4 + 2];
        if (4 * k4 + 3 < i) a3 -= l[3] * T[4 * k4 + 3];
      }
      T[i] = (a0 + a1) + (a2 + a3);
      Tu[i * 72 + lo] = f2bf_hw(T[i] * bm);
      Tw[i * 72 + lo] = f2bf_hw(T[i] * bem);
      asm volatile("" ::: "memory");
    }
  }
  __syncthreads();
#pragma unroll
  for (int rr = 0; rr < 4; ++rr) {
    f32x4 u = {0.f, 0.f, 0.f, 0.f};
    u = prod16<2>(Tu, 72, 16 * rr, VT, 72, 16 * w, u, lane);
    *(f32x4*)(gU + ((w * 4 + rr) * 64 + lane) * 4) = u;
    f32x4 wt = {0.f, 0.f, 0.f, 0.f};
    wt = prod16<2>(KhT, 72, 16 * w, Tw, 72, 16 * rr, wt, lane);
    u32x2 wv; wv.x = pk2(-wt[0], -wt[1]); wv.y = pk2(-wt[2], -wt[3]);
    *(u32x2*)(gA + (size_t)(F_WN + rr * 4 + (w >> 1)) * 1024 + (r16 + 16 * q4) * 16 + (w & 1) * 8) = wv;
  }
#pragma unroll
  for (int it = 0; it < 4; ++it) {
    const int idx = tid + it * 512; const int d = idx >> 4, m4 = idx & 15;
    const u32x2 raw = *(const LAS u32x2*)(KhT + d * 72 + 4 * m4);
    const float k0 = __uint_as_float(raw.x << 16), k1 = __uint_as_float(raw.x & 0xffff0000u), k2 = __uint_as_float(raw.y << 16), k3 = __uint_as_float(raw.y & 0xffff0000u);
    const float e0 = __expf(gl - gcb[4 * m4]), e1 = __expf(gl - gcb[4 * m4 + 1]), e2 = __expf(gl - gcb[4 * m4 + 2]), e3 = __expf(gl - gcb[4 * m4 + 3]);
    u32x2 wv; wv.x = pk2(k0 * e0, k1 * e1); wv.y = pk2(k2 * e2, k3 * e3);
    *(u32x2*)(gA + (size_t)(F_KT + (d >> 4) * 2 + (m4 >> 3)) * 1024 + ((d & 15) + 16 * (m4 & 3)) * 16 + ((m4 >> 2) & 1) * 8) = wv;
  }
  if (tid == 0) p.dnG[ci] = __expf(gl);
}

#define DS_A0 0
#define DS_A1 57344
#define DS_TOTAL 114688
__device__ void dn_scan_blk(const Params& p, LAS unsigned char* lds, int item) {
  const int tid = threadIdx.x, lane = tid & 63, w = __builtin_amdgcn_readfirstlane(tid >> 6), r16 = lane & 15, q4 = lane >> 4;
  const int bh = item >> 1, eh = item & 1, b = bh >> 2, h = bh & 3;
  const int et = eh * 4 + (w & 3);
  const bool comp = w < 4;
  const unsigned char* gA = (const unsigned char*)p.dnA + (size_t)bh * 64 * DN_ABYTES;
  const float* gU = p.dnU + (size_t)bh * 64 * DN_UFLOATS;
  const float* gG = p.dnG + bh * 64;
  auto issue_A = [&](int n, int buf) {
#pragma unroll
    for (int i = 0; i < 7; ++i) {
      const int f = w * 7 + i;
      __builtin_amdgcn_global_load_lds((const unsigned*)(gA + (size_t)n * DN_ABYTES + f * 1024 + lane * 16), (LAS unsigned*)(lds + (buf ? DS_A1 : DS_A0) + f * 1024), 16, 0, 0);
    }
  };
  __syncthreads();
  issue_A(0, 0);
  f32x4 Un[4];
#pragma unroll
  for (int rr = 0; rr < 4; ++rr) Un[rr] = *(const f32x4*)(gU + ((et * 4 + rr) * 64 + lane) * 4);
  f32x4 S[8];
#pragma unroll
  for (int dt = 0; dt < 8; ++dt) S[dt] = (f32x4){0.f, 0.f, 0.f, 0.f};
  asm volatile("s_waitcnt vmcnt(0)" ::: "memory");
  __syncthreads();
  bf16_t* obase = p.dn_out + ((size_t)b * SEQ) * p.dn_out_ld + h * 128 + 16 * et + r16;
#pragma unroll 1
  for (int n = 0; n < 64; ++n) {
    const LAS unsigned char* Ab = lds + ((n & 1) ? DS_A1 : DS_A0);
    if (n + 1 < 64) issue_A(n + 1, (n + 1) & 1);
    if (comp) {
      f32x4 Vn[4];
#pragma unroll
      for (int rr = 0; rr < 4; ++rr) Vn[rr] = Un[rr];
      if (n + 1 < 64) {
#pragma unroll
        for (int rr = 0; rr < 4; ++rr) Un[rr] = *(const f32x4*)(gU + (size_t)(n + 1) * DN_UFLOATS + ((et * 4 + rr) * 64 + lane) * 4);
      }
      const float gdec = gG[n];
      bf16x8 Sb[4];
#pragma unroll
      for (int ks = 0; ks < 4; ++ks) Sb[ks] = pack8(S[2 * ks][0], S[2 * ks][1], S[2 * ks][2], S[2 * ks][3], S[2 * ks + 1][0], S[2 * ks + 1][1], S[2 * ks + 1][2], S[2 * ks + 1][3]);
      f32x4 O[4];
#pragma unroll
      for (int rr = 0; rr < 4; ++rr) {
        O[rr] = (f32x4){0.f, 0.f, 0.f, 0.f};
#pragma unroll
        for (int ks = 0; ks < 4; ++ks) {
          const bf16x8 aw = *(const LAS bf16x8*)(Ab + (F_WN + rr * 4 + ks) * 1024 + lane * 16);
          Vn[rr] = MFMA16(aw, Sb[ks], Vn[rr]);
          const bf16x8 aq = *(const LAS bf16x8*)(Ab + (F_QD + rr * 4 + ks) * 1024 + lane * 16);
          O[rr] = MFMA16(aq, Sb[ks], O[rr]);
        }
      }
      bf16x8 Vb[2];
#pragma unroll
      for (int ks = 0; ks < 2; ++ks) Vb[ks] = pack8(Vn[2 * ks][0], Vn[2 * ks][1], Vn[2 * ks][2], Vn[2 * ks][3], Vn[2 * ks + 1][0], Vn[2 * ks + 1][1], Vn[2 * ks + 1][2], Vn[2 * ks + 1][3]);
#pragma unroll
      for (int rr = 0; rr < 4; ++rr)
#pragma unroll
        for (int ks = 0; ks < 2; ++ks) {
          const bf16x8 a = *(const LAS bf16x8*)(Ab + (F_QK + rr * 2 + ks) * 1024 + lane * 16);
          O[rr] = MFMA16(a, Vb[ks], O[rr]);
        }
#pragma unroll
      for (int rr = 0; rr < 4; ++rr)
#pragma unroll
        for (int i = 0; i < 4; ++i) obase[(size_t)(n * 64 + 16 * rr + 4 * q4 + i) * p.dn_out_ld] = f2bf_hw(O[rr][i]);
#pragma unroll
      for (int dt = 0; dt < 8; ++dt) {
        S[dt] *= gdec;
#pragma unroll
        for (int ks = 0; ks < 2; ++ks) {
          const bf16x8 a = *(const LAS bf16x8*)(Ab + (F_KT + dt * 2 + ks) * 1024 + lane * 16);
          S[dt] = MFMA16(a, Vb[ks], S[dt]);
        }
      }
    }
    asm volatile("s_waitcnt vmcnt(0)" ::: "memory");
    __syncthreads();
  }
}
__device__ void ph_dn_norm(const Params& p, int nblk, int bid) {
  const int wid = threadIdx.x >> 6, lane = threadIdx.x & 63;
  const f32x4 g0 = *(const f32x4*)(p.g_dn_out + (lane & 15) * 8), g1 = *(const f32x4*)(p.g_dn_out + (lane & 15) * 8 + 4);
  for (int t = bid * 8 + wid; t < T_TOK; t += nblk * 8) {
    bf16_t* op = p.oab + (size_t)t * DM + lane * 8;
    float o[8], z[8];
    unpack8(*(const u32x4*)op, o);
    unpack8(*(const u32x4*)(p.proj + (size_t)t * PW + C_Z + lane * 8), z);
    float ss = 0.f;
#pragma unroll
    for (int j = 0; j < 8; ++j) ss += o[j] * o[j];
    ss += __shfl_xor(ss, 1, 64); ss += __shfl_xor(ss, 2, 64); ss += __shfl_xor(ss, 4, 64); ss += __shfl_xor(ss, 8, 64);
    const float rstd = rsqrtf(ss * (1.f / 128.f) + 1e-6f);
    float y[8];
#pragma unroll
    for (int j = 0; j < 4; ++j) { y[j] = o[j] * rstd * g0[j] * siluf_(z[j]); y[4 + j] = o[4 + j] * rstd * g1[j] * siluf_(z[4 + j]); }
    u32x4 w; w.x = pk2(y[0], y[1]); w.y = pk2(y[2], y[3]); w.z = pk2(y[4], y[5]); w.w = pk2(y[6], y[7]);
    *(u32x4*)op = w;
  }
}
typedef float f32x16 __attribute__((ext_vector_type(16)));
#define MFMA32(a, b, c) __builtin_amdgcn_mfma_f32_32x32x16_bf16((a), (b), (c), 0, 0, 0)
#define MP_VL 0
#define MP_RED 65536
#define MP_TOTAL (65536 + 4096)

__device__ void moba_prep_block(const Params& p, LAS unsigned char* lds, int item) {
  const int tid = threadIdx.x, lane = tid & 63, w = tid >> 6;
  const int bh = item >> 4, jb = item & 15, b = bh >> 2, h = bh & 3;
  LAS bf16_t* Vl = (LAS bf16_t*)(lds + MP_VL);
  LAS float* red = (LAS float*)(lds + MP_RED);
  __syncthreads();
#pragma unroll
  for (int it = 0; it < 8; ++it) {
    const int idx = tid + 512 * it, row = idx >> 4, ch = idx & 15;
    const u32x4 v = *(const u32x4*)(p.proj + ((size_t)b * SEQ + 256 * jb + row) * PW + C_MV + h * 128 + 8 * ch);
    *(LAS u32x4*)(Vl + row * 128 + 8 * ch) = v;
  }
  {
    const int r = tid >> 1, hh = tid & 1;
    const int pos = 256 * jb + r;
    const size_t t = (size_t)b * SEQ + pos;
    float cs[8], sn[8];
#pragma unroll
    for (int jj = 0; jj < 8; ++jj) {
      const float inv = exp2f(-(float)(8 * hh + jj) * (1.f / 16.f) * 18.931568569324174f);
      const float ang = (float)pos * inv;
      cs[jj] = cosf(ang); sn[jj] = sinf(ang);
    }
    float kacc[64];
#pragma unroll
    for (int which = 0; which < 2; ++which) {
      const bf16_t* src = p.proj + t * PW + (which ? C_MQ : C_MK) + h * 128 + 8 * hh;
      float x0[8], x1[8];
      unpack8(*(const u32x4*)(src), x0); unpack8(*(const u32x4*)(src + 16), x1);
      float y0[8], y1[8];
#pragma unroll
      for (int jj = 0; jj < 8; ++jj) { y0[jj] = x0[jj] * cs[jj] - x1[jj] * sn[jj]; y1[jj] = x1[jj] * cs[jj] + x0[jj] * sn[jj]; }
      u32x4 o[8];
      o[0].x = pk2(y0[0], y0[1]); o[0].y = pk2(y0[2], y0[3]); o[0].z = pk2(y0[4], y0[5]); o[0].w = pk2(y0[6], y0[7]);
      o[1].x = pk2(y1[0], y1[1]); o[1].y = pk2(y1[2], y1[3]); o[1].z = pk2(y1[4], y1[5]); o[1].w = pk2(y1[6], y1[7]);
#pragma unroll
      for (int ks = 2; ks < 8; ++ks) o[ks] = *(const u32x4*)(src + 16 * ks);
      if (which == 0) {
#pragma unroll
        for (int jj = 0; jj < 8; ++jj) { kacc[jj] = y0[jj]; kacc[8 + jj] = y1[jj]; }
#pragma unroll
        for (int ks = 2; ks < 8; ++ks) { float f[8]; unpack8(o[ks], f);
#pragma unroll
          for (int jj = 0; jj < 8; ++jj) kacc[8 * ks + jj] = f[jj]; }
        unsigned char* dst = (unsigned char*)p.Kp + ((size_t)(bh * 128 + 8 * jb + (r >> 5)) * 8192) + ((r & 31) + 32 * hh) * 16;
#pragma unroll
        for (int ks = 0; ks < 8; ++ks) *(u32x4*)(dst + ks * 1024) = o[ks];
      } else {
        bf16_t* dst = p.qb + ((size_t)bh * SEQ + pos) * 128 + 8 * hh;
#pragma unroll
        for (int ks = 0; ks < 8; ++ks) *(u32x4*)(dst + 16 * ks) = o[ks];
      }
    }
#pragma unroll
    for (int e = 0; e < 64; ++e) {
      float v = kacc[e];
      v += __shfl_xor(v, 2, 64); v += __shfl_xor(v, 4, 64); v += __shfl_xor(v, 8, 64); v += __shfl_xor(v, 16, 64); v += __shfl_xor(v, 32, 64);
      kacc[e] = v;
    }
    if (lane < 2) {
#pragma unroll
      for (int e = 0; e < 64; ++e) red[(w * 2 + lane) * 64 + e] = kacc[e];
    }
  }
  __syncthreads();
  if (tid < 128) {
    const int d = tid, hh = (d >> 3) & 1, ks = d >> 4, jj = d & 7;
    float a = 0.f;
#pragma unroll
    for (int ww = 0; ww < 8; ++ww) a += red[(ww * 2 + hh) * 64 + ks * 8 + jj];
    p.kmean[((size_t)bh * 16 + jb) * 128 + d] = a * (1.f / 256.f);
  }
#pragma unroll
  for (int it = 0; it < 8; ++it) {
    const int o = tid + 512 * it, ln = o & 63, frag = o >> 6, tl = frag >> 3, dt = (frag >> 1) & 3, s = frag & 1;
    const int r = ln & 31, hh = ln >> 5, d = 32 * dt + r;
    unsigned short e[8];
#pragma unroll
    for (int jj = 0; jj < 8; ++jj) { const int key = 32 * tl + 16 * s + 8 * (jj >> 2) + 4 * hh + (jj & 3); e[jj] = Vl[key * 128 + d]; }
    u32x4 wv; wv.x = e[0] | ((unsigned)e[1] << 16); wv.y = e[2] | ((unsigned)e[3] << 16); wv.z = e[4] | ((unsigned)e[5] << 16); wv.w = e[6] | ((unsigned)e[7] << 16);
    *(u32x4*)((unsigned char*)p.Vp + ((size_t)(bh * 128 + 8 * jb + tl) * 8192) + (dt * 2 + s) * 1024 + ln * 16) = wv;
  }
}
__device__ __forceinline__ int crow32(int reg, int hh) { return (reg & 3) + 8 * (reg >> 2) + 4 * hh; }
__device__ void moba_item(const Params& p, LAS float* km, int bh, int ib, int sub, int lane) {
  const int q = lane & 31, hh = lane >> 5;
  const int b = bh >> 2, h = bh & 3;
  const int s0 = 256 * ib + 32 * sub;
  const bf16_t* qrow = p.qb + ((size_t)bh * SEQ + s0 + q) * 128 + 8 * hh;
  bf16x8 Qf[8];
#pragma unroll
  for (int ks = 0; ks < 8; ++ks) Qf[ks] = *(const bf16x8*)(qrow + 16 * ks);
  unsigned selmask = 0;
  if (ib > 0) {
    for (int idx = lane; idx < ib * 32; idx += 64) ((LAS f32x4*)km)[idx] = ((const f32x4*)(p.kmean + (size_t)bh * 16 * 128))[idx];
    float qf[64];
#pragma unroll
    for (int ks = 0; ks < 8; ++ks) { float f[8]; unpack8(__builtin_bit_cast(u32x4, Qf[ks]), f);
#pragma unroll
      for (int jj = 0; jj < 8; ++jj) qf[8 * ks + jj] = f[jj]; }
    float sc[16];
#pragma unroll
    for (int j = 0; j < 16; ++j) {
      sc[j] = -INFINITY;
      if (j < ib) {
        float a = 0.f;
#pragma unroll
        for (int ks = 0; ks < 8; ++ks) {
          const f32x4 k0 = *(const LAS f32x4*)(km + j * 128 + 16 * ks + 8 * hh), k1 = *(const LAS f32x4*)(km + j * 128 + 16 * ks + 8 * hh + 4);
          a += qf[8 * ks] * k0[0] + qf[8 * ks + 1] * k0[1] + qf[8 * ks + 2] * k0[2] + qf[8 * ks + 3] * k0[3];
          a += qf[8 * ks + 4] * k1[0] + qf[8 * ks + 5] * k1[1] + qf[8 * ks + 6] * k1[2] + qf[8 * ks + 7] * k1[3];
        }
        a += __shfl_xor(a, 32, 64);
        sc[j] = a;
      }
    }
#pragma unroll
    for (int r = 0; r < 3; ++r) {
      if (r < ib) {
        float best = -INFINITY; int bi = 0;
#pragma unroll
        for (int j = 0; j < 16; ++j) if (sc[j] > best) { best = sc[j]; bi = j; }
        selmask |= 1u << bi;
#pragma unroll
        for (int j = 0; j < 16; ++j) if (j == bi) sc[j] = -INFINITY;
      }
    }
  }
  const float cscale = 0.08838834764831845f * 1.4426950408889634f;
  float m = -1e30f, l = 0.f;
  f32x16 O[4];
#pragma unroll
  for (int dt = 0; dt < 4; ++dt)
#pragma unroll
    for (int r = 0; r < 16; ++r) O[dt][r] = 0.f;
  const unsigned char* kbase = (const unsigned char*)p.Kp + (size_t)bh * 128 * 8192 + lane * 16;
  const unsigned char* vbase = (const unsigned char*)p.Vp + (size_t)bh * 128 * 8192 + lane * 16;
  auto tile = [&](int kt, int mode, bool selbit) {
    bf16x8 Kf[8], Vf[8];
#pragma unroll
    for (int ks = 0; ks < 8; ++ks) Kf[ks] = *(const bf16x8*)(kbase + (size_t)kt * 8192 + ks * 1024);
#pragma unroll
    for (int f = 0; f < 8; ++f) Vf[f] = *(const bf16x8*)(vbase + (size_t)kt * 8192 + f * 1024);
    f32x16 S;
#pragma unroll
    for (int r = 0; r < 16; ++r) S[r] = 0.f;
#pragma unroll
    for (int ks = 0; ks < 8; ++ks) S = MFMA32(Kf[ks], Qf[ks], S);
    float sv[16]; float mx = -INFINITY;
#pragma unroll
    for (int r = 0; r < 16; ++r) {
      float v = S[r] * cscale;
      if (mode == 1 && crow32(r, hh) > q) v = -INFINITY;
      if (mode == 2 && !selbit) v = -INFINITY;
      sv[r] = v; mx = fmaxf(mx, v);
    }
    mx = fmaxf(mx, __shfl_xor(mx, 32, 64));
    const float mn = fmaxf(m, mx);
    const float alpha = exp2f(m - mn);
    float ps = 0.f;
#pragma unroll
    for (int r = 0; r < 16; ++r) { sv[r] = exp2f(sv[r] - mn); ps += sv[r]; }
    l = l * alpha + ps; m = mn;
    if (__ballot(alpha != 1.f) != 0ull) {
#pragma unroll
      for (int dt = 0; dt < 4; ++dt)
#pragma unroll
        for (int r = 0; r < 16; ++r) O[dt][r] *= alpha;
    }
    const bf16x8 P0 = pack8(sv[0], sv[1], sv[2], sv[3], sv[4], sv[5], sv[6], sv[7]);
    const bf16x8 P1 = pack8(sv[8], sv[9], sv[10], sv[11], sv[12], sv[13], sv[14], sv[15]);
#pragma unroll
    for (int dt = 0; dt < 4; ++dt) { O[dt] = MFMA32(Vf[dt * 2], P0, O[dt]); O[dt] = MFMA32(Vf[dt * 2 + 1], P1, O[dt]); }
  };
  for (int tl = 0; tl < sub; ++tl) tile(8 * ib + tl, 0, true);
  tile(8 * ib + sub, 1, true);
  for (int j = 0; j < ib; ++j) {
    const bool sb = (selmask >> j) & 1u;
    if (__ballot(sb) != 0ull) {
#pragma unroll 1
      for (int tl = 0; tl < 8; ++tl) tile(8 * j + tl, 2, sb);
    }
  }
  l += __shfl_xor(l, 32, 64);
  const float inv = 1.f / l;
  bf16_t* orow = p.mb_out + ((size_t)b * SEQ + s0 + q) * p.mb_out_ld + p.mb_out_off + h * 128;
#pragma unroll
  for (int dt = 0; dt < 4; ++dt)
#pragma unroll
    for (int g4 = 0; g4 < 4; ++g4) {
      u32x2 wv; wv.x = pk2(O[dt][4 * g4] * inv, O[dt][4 * g4 + 1] * inv); wv.y = pk2(O[dt][4 * g4 + 2] * inv, O[dt][4 * g4 + 3] * inv);
      *(u32x2*)(orow + 32 * dt + 8 * g4 + 4 * hh) = wv;
    }
}
__device__ void moba_worker(const Params& p, LAS unsigned char* lds) {
  const int lane = threadIdx.x & 63, w = threadIdx.x >> 6;
  LAS float* km = (LAS float*)(lds + w * 8192);
  for (;;) {
    int idx = 0;
    if (lane == 0) idx = atomicAdd(p.wq, 1);
    idx = __builtin_amdgcn_readfirstlane(idx);
    if (idx >= 2048) break;
    const int ib = 15 - (idx >> 7), rem = idx & 127, bh = rem >> 3, sub = 7 - (rem & 7);
    moba_item(p, km, bh, ib, sub, lane);
  }
}
__device__ void ph_mod(const Params& p, LAS unsigned char* lds, int nblk, int bid) {
  LAS float* sc = (LAS float*)lds;
  LAS float* part = (LAS float*)(lds + 16384);
  const int tid = threadIdx.x;
  if (bid >= 192) return;
  for (int i = tid; i < 4096; i += 512) sc[i] = siluf_(p.c[i]);
  __syncthreads();
  for (int task = bid; task < 192; task += nblk) {
    const int jj = tid & 31, ks = tid >> 5, j = task * 32 + jj;
    float a0 = 0.f, a1 = 0.f, a2 = 0.f, a3 = 0.f;
#pragma unroll 8
    for (int kk = 0; kk < 64; ++kk) {
      const int k = ks * 64 + kk;
      const float w = p.w_ada[(size_t)k * 6144 + j];
      a0 += sc[k] * w; a1 += sc[1024 + k] * w; a2 += sc[2048 + k] * w; a3 += sc[3072 + k] * w;
    }
    *(LAS f32x4*)(part + (ks * 32 + jj) * 4) = (f32x4){a0, a1, a2, a3};
    __syncthreads();
    if (tid < 128) {
      const int j2 = tid & 31, bb = tid >> 5;
      float a = 0.f;
#pragma unroll
      for (int s = 0; s < 16; ++s) a += part[(s * 32 + j2) * 4 + bb];
      p.mod[bb * 6144 + task * 32 + j2] = a + p.b_ada[task * 32 + j2];
    }
    __syncthreads();
  }
}

__device__ __forceinline__ void wt_tile(const float* __restrict__ src, bf16_t* __restrict__ dst, int K, int N, int mode, int k0, int n0, LAS float* tile) {
  const int tid = threadIdx.x;
#pragma unroll
  for (int it = 0; it < 2; ++it) {
    const int row = (tid >> 4) + 32 * it, c4 = (tid & 15) * 4, n = n0 + c4;
    f32x4 v = {0.f, 0.f, 0.f, 0.f};
    if (n < N) v = *(const f32x4*)(src + (size_t)(k0 + row) * N + n);
    tile[row * 65 + c4] = v[0]; tile[row * 65 + c4 + 1] = v[1]; tile[row * 65 + c4 + 2] = v[2]; tile[row * 65 + c4 + 3] = v[3];
  }
  __syncthreads();
  {
    const int nl = tid >> 3, kc = tid & 7, n = n0 + nl;
    if (n < N) {
      const int d = map_col(n, mode);
      if (d >= 0) {
        float f[8];
#pragma unroll
        for (int j = 0; j < 8; ++j) f[j] = tile[(8 * kc + j) * 65 + nl];
        u32x4 w; w.x = pk2(f[0], f[1]); w.y = pk2(f[2], f[3]); w.z = pk2(f[4], f[5]); w.w = pk2(f[6], f[7]);
        *(u32x4*)(dst + (size_t)d * K + k0 + 8 * kc) = w;
      }
    }
  }
  __syncthreads();
}
#define WT_T0 1424
#define WT_T1 (WT_T0 + 16384)
#define WT_T2 (WT_T1 + 8192)
#define WT_T3 (WT_T2 + 128)
#define WT_T4 (WT_T3 + 128)
#define WT_T5 (WT_T4 + 256)
__device__ void ph_wt(const Params& p, LAS unsigned char* lds, int nblk, int bid) {
  LAS float* tile = (LAS float*)(lds + 32768);
  for (int t = bid; t < WT_T5; t += nblk) {
    if (t < WT_T0) { const int kt = t / 89, nt = t % 89; wt_tile(p.w_in, p.w_in_t, 1024, INW, 1, kt * 64, nt * 64, tile); }
    else if (t < WT_T1) { const int u = t - WT_T0, e = u >> 9, r = u & 511, kt = r >> 5, nt = r & 31;
      wt_tile(p.w_gu + (size_t)e * 1024 * 2048, p.wgu_t + (size_t)e * 2048 * 1024, 1024, 2048, 2, kt * 64, nt * 64, tile); }
    else if (t < WT_T2) { const int u = t - WT_T1, e = u >> 8, r = u & 255, kt = r >> 4, nt = r & 15;
      wt_tile(p.w_down + (size_t)e * 1024 * 1024, p.wd_t + (size_t)e * 1024 * 1024, 1024, 1024, 0, kt * 64, nt * 64, tile); }
    else if (t < WT_T3) { const int u = t - WT_T2, kt = u >> 4, nt = u & 15; wt_tile(p.w_br_a, p.wbra_t, 512, 1024, 0, kt * 64, nt * 64, tile); }
    else if (t < WT_T4) { const int u = t - WT_T3, kt = u >> 4, nt = u & 15; wt_tile(p.w_br_b, p.wbrb_t, 512, 1024, 0, kt * 64, nt * 64, tile); }
    else { const int u = t - WT_T4, kt = u >> 4, nt = u & 15; wt_tile(p.w_o, p.wo_t, 1024, 1024, 0, kt * 64, nt * 64, tile); }
  }
}

__device__ void ph_h(const Params& p, int nblk, int bid) {
  const int wid = threadIdx.x >> 6, lane = threadIdx.x & 63;
  for (int t = bid * 8 + wid; t < T_TOK; t += nblk * 8) {
    const int b = t / SEQ;
    const float* xr = p.x + (size_t)t * DM;
    float v[16];
    float ss = 0.f;
#pragma unroll
    for (int i = 0; i < 4; ++i) {
      const f32x4 q = *(const f32x4*)(xr + i * 256 + lane * 4);
      v[i * 4 + 0] = q[0]; v[i * 4 + 1] = q[1]; v[i * 4 + 2] = q[2]; v[i * 4 + 3] = q[3];
      ss += q[0] * q[0] + q[1] * q[1] + q[2] * q[2] + q[3] * q[3];
    }
    ss = wave_sum(ss);
    const float rstd = rsqrtf(ss * (1.f / DM) + 1e-6f);
    const float* shift = p.mod + b * 6144;
    const float* scale = p.mod + b * 6144 + 1024;
    float acc[8] = {0, 0, 0, 0, 0, 0, 0, 0};
#pragma unroll
    for (int i = 0; i < 4; ++i) {
      float hv[4];
#pragma unroll
      for (int j = 0; j < 4; ++j) {
        const int k = i * 256 + lane * 4 + j;
        hv[j] = v[i * 4 + j] * rstd * p.g_pre_mix[k] * (1.f + scale[k]) + shift[k];
        const float* wr = p.w_in + (size_t)k * INW + 2048;
        const f32x4 w0 = *(const f32x4*)wr, w1 = *(const f32x4*)(wr + 4);
        acc[0] += hv[j] * w0[0]; acc[1] += hv[j] * w0[1]; acc[2] += hv[j] * w0[2]; acc[3] += hv[j] * w0[3];
        acc[4] += hv[j] * w1[0]; acc[5] += hv[j] * w1[1]; acc[6] += hv[j] * w1[2]; acc[7] += hv[j] * w1[3];
      }
      u32x2 pk; pk.x = pk2(hv[0], hv[1]); pk.y = pk2(hv[2], hv[3]);
      *(u32x2*)(p.hbf + (size_t)t * DM + i * 256 + lane * 4) = pk;
    }
#pragma unroll
    for (int e = 0; e < 8; ++e) acc[e] = wave_sum(acc[e]);
    if (lane == 0) { *(f32x4*)(p.ba + (size_t)t * 8) = (f32x4){acc[0], acc[1], acc[2], acc[3]}; *(f32x4*)(p.ba + (size_t)t * 8 + 4) = (f32x4){acc[4], acc[5], acc[6], acc[7]}; }
  }
}

__device__ void ph_post_mix(const Params& p, LAS unsigned char* lds, int nblk, int bid) {
  const int wid = threadIdx.x >> 6, lane = threadIdx.x & 63;
  LAS float* sh = (LAS float*)lds + wid * 1024;
  for (int t = bid * 8 + wid; t < T_TOK; t += nblk * 8) {
    const int b = t / SEQ;
    const float* md = p.mod + b * 6144;
    float mv[16];
    float ss = 0.f;
#pragma unroll
    for (int i = 0; i < 2; ++i) {
      float f[8]; unpack8(*(const u32x4*)(p.mixer + (size_t)t * DM + i * 512 + lane * 8), f);
#pragma unroll
      for (int j = 0; j < 8; ++j) { mv[i * 8 + j] = f[j]; ss += f[j] * f[j]; }
    }
    ss = wave_sum(ss);
    const float rstd = rsqrtf(ss * (1.f / DM) + 1e-6f);
    float x1[16];
    float s2 = 0.f;
#pragma unroll
    for (int i = 0; i < 2; ++i)
#pragma unroll
      for (int j4 = 0; j4 < 2; ++j4) {
        const int k = i * 512 + lane * 8 + j4 * 4;
        const f32x4 xv = *(const f32x4*)(p.x + (size_t)t * DM + k);
        const f32x4 gm = *(const f32x4*)(md + 2048 + k), gp = *(const f32x4*)(p.g_post_mix + k);
        f32x4 o;
#pragma unroll
        for (int j = 0; j < 4; ++j) { o[j] = xv[j] + gm[j] * (mv[i * 8 + j4 * 4 + j] * rstd * gp[j]); x1[i * 8 + j4 * 4 + j] = o[j]; s2 += o[j] * o[j]; }
        *(f32x4*)(p.out + (size_t)t * DM + k) = o;
      }
    s2 = wave_sum(s2);
    const float rstd2 = rsqrtf(s2 * (1.f / DM) + 1e-6f);
#pragma unroll
    for (int i = 0; i < 2; ++i) {
      float hv[8];
#pragma unroll
      for (int j = 0; j < 8; ++j) {
        const int k = i * 512 + lane * 8 + j;
        hv[j] = x1[i * 8 + j] * rstd2 * p.g_pre_ffn[k] * (1.f + md[4096 + k]) + md[3072 + k];
        sh[k] = hv[j];
      }
      u32x4 w; w.x = pk2(hv[0], hv[1]); w.y = pk2(hv[2], hv[3]); w.z = pk2(hv[4], hv[5]); w.w = pk2(hv[6], hv[7]);
      *(u32x4*)(p.h2 + (size_t)t * DM + i * 512 + lane * 8) = w;
    }
    const int e = lane & 31, half = lane >> 5;
    float a0 = 0.f, a1 = 0.f, a2 = 0.f, a3 = 0.f;
#pragma unroll 4
    for (int k = half * 512; k < half * 512 + 512; k += 4) {
      const f32x4 hv = *(const LAS f32x4*)(sh + k);
      a0 += hv[0] * p.w_router[(size_t)k * 32 + e]; a1 += hv[1] * p.w_router[(size_t)(k + 1) * 32 + e];
      a2 += hv[2] * p.w_router[(size_t)(k + 2) * 32 + e]; a3 += hv[3] * p.w_router[(size_t)(k + 3) * 32 + e];
    }
    float a = (a0 + a1) + (a2 + a3);
    a += __shfl_xor(a, 32, 64);
    float lg = a + p.b_router[e];
    if (lane >= 32) lg = -INFINITY;
    float tv[4]; int ti[4];
#pragma unroll
    for (int r = 0; r < 4; ++r) {
      const float m = wave_max(lg);
      const unsigned long long bal = __ballot(lg == m);
      const int idx = __ffsll((long long)bal) - 1;
      tv[r] = m; ti[r] = idx;
      if (lane == idx) lg = -INFINITY;
    }
    const float e1 = __expf(tv[1] - tv[0]), e2 = __expf(tv[2] - tv[0]), e3 = __expf(tv[3] - tv[0]);
    const float inv = 1.f / (1.f + e1 + e2 + e3);
    if (lane < 4) {
      const int ee = lane == 0 ? ti[0] : lane == 1 ? ti[1] : lane == 2 ? ti[2] : ti[3];
      const float ww = (lane == 0 ? 1.f : lane == 1 ? e1 : lane == 2 ? e2 : e3) * inv;
      const int pos = atomicAdd(&p.cnt[ee], 1);
      p.elist[ee * T_TOK + pos] = t * 4 + lane;
      p.aw[t * 4 + lane] = ww;
    }
  }
}

__device__ void ph_gather(const Params& p, LAS unsigned char* lds, int nblk, int bid) {
  const int wid = threadIdx.x >> 6, lane = threadIdx.x & 63;
  LAS int* tb = (LAS int*)lds;
  if (threadIdx.x == 0) { int off = 0; for (int k = 0; k < NE; ++k) { const int c = p.cnt[k]; tb[k] = off; tb[64 + k] = c; off += ((c + 255) >> 8) << 8; } tb[NE] = off; }
  __syncthreads();
  const int total = tb[NE];
  for (int r = bid * 8 + wid; r < total; r += nblk * 8) {
    int e = 0;
#pragma unroll 1
    for (int k = 1; k < NE; ++k) if (r >= tb[k]) e = k;
    const int i = r - tb[e];
    const int a = (i < tb[64 + e]) ? p.elist[e * T_TOK + i] : -1;
    if (lane == 0) p.rowmap[r] = a;
    u32x4 v0 = {0, 0, 0, 0}, v1 = v0;
    if (a >= 0) { const u32x4* src = (const u32x4*)(p.h2 + (size_t)(a >> 2) * DM); v0 = src[lane]; v1 = src[64 + lane]; }
    u32x4* dst = (u32x4*)(p.xs + (size_t)r * DM);
    dst[lane] = v0; dst[64 + lane] = v1;
  }
}

__device__ void ph_final(const Params& p, int nblk, int bid) {
  const int wid = threadIdx.x >> 6, lane = threadIdx.x & 63;
  for (int t = bid * 8 + wid; t < T_TOK; t += nblk * 8) {
    const int b = t / SEQ;
    const float* md = p.mod + b * 6144;
    const f32x4 wv = *(const f32x4*)(p.aw + t * 4);
    float mv[16];
    float ss = 0.f;
#pragma unroll
    for (int i = 0; i < 2; ++i) {
      const bf16_t* y = p.yslot + (size_t)t * 4 * DM + i * 512 + lane * 8;
      float f0[8], f1[8], f2[8], f3[8];
      unpack8(*(const u32x4*)y, f0); unpack8(*(const u32x4*)(y + DM), f1); unpack8(*(const u32x4*)(y + 2 * DM), f2); unpack8(*(const u32x4*)(y + 3 * DM), f3);
#pragma unroll
      for (int j = 0; j < 8; ++j) { const float m = wv[0] * f0[j] + wv[1] * f1[j] + wv[2] * f2[j] + wv[3] * f3[j]; mv[i * 8 + j] = m; ss += m * m; }
    }
    ss = wave_sum(ss);
    const float rstd = rsqrtf(ss * (1.f / DM) + 1e-6f);
#pragma unroll
    for (int i = 0; i < 2; ++i)
#pragma unroll
      for (int j4 = 0; j4 < 2; ++j4) {
        const int k = i * 512 + lane * 8 + j4 * 4;
        float* op = p.out + (size_t)t * DM + k;
        const f32x4 x1 = *(const f32x4*)op, gf = *(const f32x4*)(md + 5120 + k), gp = *(const f32x4*)(p.g_post_ffn + k);
        f32x4 o;
#pragma unroll
        for (int j = 0; j < 4; ++j) o[j] = x1[j] + gf[j] * (mv[i * 8 + j4 * 4 + j] * rstd * gp[j]);
        *(f32x4*)op = o;
      }
  }
}

#define XB_TMO      128
#define XB_XCNT(j)  (256  + 64 * (j))
#define XB_XSUB(j)  (1280 + 64 * (j))
#define XB_XGEN(j)  (2304 + 64 * (j))
#define XB_TOP      3328
#define XB_TOPGEN   3392
#define XCD_BAR_WORDS 3456
#define XB_SPIN_CAP (1u << 18)

__device__ __forceinline__ unsigned xb_ld(unsigned* p)              { return __hip_atomic_load(p, __ATOMIC_RELAXED, __HIP_MEMORY_SCOPE_AGENT); }
__device__ __forceinline__ unsigned xb_add(unsigned* p, unsigned v) { return __hip_atomic_fetch_add(p, v, __ATOMIC_RELAXED, __HIP_MEMORY_SCOPE_AGENT); }
__device__ __forceinline__ unsigned xb_xcc_id() { return (unsigned)__builtin_amdgcn_s_getreg((3 << 11) | 20) & 0xFu; }
#define XB_SPIN(cond, bar) do { unsigned _sp = 0; while (cond) { __builtin_amdgcn_s_sleep(1); \
    if ((++_sp & 255u) == 0u) { if (xb_ld(&(bar)[XB_TMO])) break; if (_sp > XB_SPIN_CAP) { atomicAdd(&(bar)[XB_TMO], 1u); break; } } } } while (0)

struct XcdBarrier {
    unsigned* bar; unsigned x;
    volatile LAS unsigned* st;
};

__device__ __forceinline__ XcdBarrier xcd_barrier_post(unsigned* bar, volatile LAS unsigned* st) {
    XcdBarrier b; b.bar = bar; b.x = xb_xcc_id(); b.st = st;
    if (threadIdx.x == 0) (void)xb_add(&bar[XB_XCNT(b.x)], 1u);
    return b;
}
__device__ __forceinline__ void xcd_barrier_complete(unsigned* bar, unsigned x, unsigned& nloc, unsigned& nx) {
    const unsigned G = gridDim.x * gridDim.y * gridDim.z;
    unsigned sum, cnt, mine, sp = 0u;
    for (;;) {
        sum = 0u; cnt = 0u; mine = 0u;
#pragma unroll
        for (unsigned j = 0; j < 16; ++j) { const unsigned c = xb_ld(&bar[XB_XCNT(j)]); sum += c; cnt += (c > 0u) ? 1u : 0u; mine = (j == x) ? c : mine; }
        if (sum == G) break;
        __builtin_amdgcn_s_sleep(1);
        if ((++sp & 255u) == 0u) { if (xb_ld(&bar[XB_TMO])) break; if (sp > XB_SPIN_CAP) { atomicAdd(&bar[XB_TMO], 1u); break; } }
    }
    nloc = mine > 0u ? mine : 1u; nx = cnt > 0u ? cnt : 1u;
}

__device__ __forceinline__ void xcd_barrier(const XcdBarrier& b) {
    asm volatile("s_waitcnt vmcnt(0)" ::: "memory");
    __syncthreads();
    if (threadIdx.x == 0) {
        unsigned* bar = b.bar;
        __builtin_amdgcn_s_waitcnt(0);
        unsigned nloc = b.st[0], nx = b.st[1];
        if (nloc == 0u) { xcd_barrier_complete(bar, b.x, nloc, nx); b.st[0] = nloc; b.st[1] = nx; }
        const unsigned old = xb_add(&bar[XB_XSUB(b.x)], 1u);
        const unsigned gen = old / nloc;
        if (old + 1u == (gen + 1u) * nloc) {
            __builtin_amdgcn_fence(__ATOMIC_RELEASE, "agent");
            asm volatile("s_waitcnt vmcnt(0)" ::: "memory");
            const unsigned og = xb_add(&bar[XB_TOP], 1u);
            const unsigned tg = og / nx;
            if (og + 1u == (tg + 1u) * nx) xb_add(&bar[XB_TOPGEN], 1u);
            else XB_SPIN(xb_ld(&bar[XB_TOPGEN]) == tg, bar);
            __builtin_amdgcn_fence(__ATOMIC_ACQUIRE, "agent");
            xb_add(&bar[XB_XGEN(b.x)], 1u);
            asm volatile("s_waitcnt vmcnt(0)" ::: "memory");
        } else {
            XB_SPIN(xb_ld(&bar[XB_XGEN(b.x)]) == gen, bar);
            __builtin_amdgcn_fence(__ATOMIC_ACQUIRE, "agent");
            asm volatile("s_waitcnt vmcnt(0)" ::: "memory");
        }
    }
    __syncthreads();
}


__device__ __forceinline__ void grid_bar(const Params& p, LAS unsigned char* lds);
#define MEGA_LDS 148480
#define MEGA_LDS_ALLOC (MEGA_LDS + 16)
__device__ __forceinline__ void grid_bar(const Params& p, LAS unsigned char* lds) {
  XcdBarrier b; b.bar = p.bar; b.x = xb_xcc_id(); b.st = (volatile LAS unsigned*)(lds + MEGA_LDS);
  xcd_barrier(b);
}
__global__ __launch_bounds__(512) void mega(Params p) {
  extern __shared__ __attribute__((aligned(16))) unsigned char shm[];
  LAS unsigned char* lds = (LAS unsigned char*)shm;
  cg::grid_group grid = cg::this_grid();
  const int nblk = gridDim.x, bid = blockIdx.x;
  volatile LAS unsigned* xst = (volatile LAS unsigned*)(lds + MEGA_LDS);
  if (threadIdx.x == 0) { xst[0] = 0u; xst[1] = 0u; xst[2] = 0u; xst[3] = 0u; }
  __syncthreads();
  (void)xcd_barrier_post(p.bar, xst);
  if (p.never) grid.sync();
#ifndef REPMASK
#define REPMASK 0
#endif
#define REP(k) for (int rep_ = 0; rep_ < (((REPMASK) >> (k)) & 1) + 1; ++rep_)
  REP(0) { ph_mod(p, lds, nblk, bid); ph_wt(p, lds, nblk, bid); grid_bar(p, lds); }
  REP(1) { ph_h(p, nblk, bid); grid_bar(p, lds); }
  REP(2) { ph_proj(p, lds, nblk, bid); grid_bar(p, lds); }
  REP(3) {
    REP(12) { bool first = true; for (int ci = bid; ci < 1024; ci += nblk) { dn_prep_chunk(p, lds, ci, first); first = false; } }
    REP(13) for (int item = bid; item < 256; item += nblk) moba_prep_block(p, lds, item);
    grid_bar(p, lds);
  }
  REP(4) { if (bid < 32) dn_scan_blk(p, lds, bid); moba_worker(p, lds); grid_bar(p, lds); }
  ph_dn_norm(p, nblk, bid);
  grid_bar(p, lds);
  REP(5) { ph_br(p, lds, nblk, bid); grid_bar(p, lds); }
  REP(6) { ph_mix(p, lds, nblk, bid); grid_bar(p, lds); }
  ph_post_mix(p, lds, nblk, bid);
  grid_bar(p, lds);
  REP(8) { ph_gather(p, lds, nblk, bid); grid_bar(p, lds); }
  REP(9) { ph_moe1(p, lds, nblk, bid); grid_bar(p, lds); }
  REP(10) { ph_moe2(p, lds, nblk, bid); grid_bar(p, lds); }
  ph_final(p, nblk, bid);
}
static inline size_t al(size_t x) { return (x + 255) & ~(size_t)255; }

extern "C" void kernel_launch(void* const* d_in, const int* in_sizes, int n_in, void* d_out, int out_size, void* d_ws,
                              size_t ws_size, hipStream_t stream) {
  Params p{};
  p.x = (const float*)d_in[0]; p.c = (const float*)d_in[1]; p.w_ada = (const float*)d_in[2]; p.b_ada = (const float*)d_in[3];
  p.g_pre_mix = (const float*)d_in[4]; p.g_post_mix = (const float*)d_in[5]; p.g_pre_ffn = (const float*)d_in[6];
  p.g_post_ffn = (const float*)d_in[7]; p.w_in = (const float*)d_in[8]; p.conv_w = (const float*)d_in[9];
  p.a_log = (const float*)d_in[10]; p.dt_bias = (const float*)d_in[11]; p.g_dn_out = (const float*)d_in[12];
  p.w_br_a = (const float*)d_in[13]; p.w_br_b = (const float*)d_in[14]; p.w_o = (const float*)d_in[15];
  p.w_router = (const float*)d_in[16]; p.b_router = (const float*)d_in[17]; p.w_gu = (const float*)d_in[18];
  p.b_gu = (const float*)d_in[19]; p.w_down = (const float*)d_in[20]; p.b_down = (const float*)d_in[21];
  p.out = (float*)d_out;
  char* w = (char*)d_ws;
  size_t o = 0;
  auto take = [&](size_t bytes) { char* r = w + o; o += al(bytes); return r; };
  p.mod = (float*)take(4 * 6144 * 4);
  p.cnt = (int*)take(256);
  p.ba = (float*)take((size_t)T_TOK * 8 * 4);
  p.hbf = (bf16_t*)take((size_t)T_TOK * DM * 2);
  p.proj = (bf16_t*)take((size_t)T_TOK * PW * 2);
  p.w_in_t = (bf16_t*)take((size_t)PW * DM * 2);
  p.wgu_t = (bf16_t*)take((size_t)NE * 2048 * DM * 2);
  p.wd_t = (bf16_t*)take((size_t)NE * 1024 * DM * 2);
  p.wbra_t = (bf16_t*)take((size_t)1024 * 512 * 2);
  p.wbrb_t = (bf16_t*)take((size_t)1024 * 512 * 2);
  p.wo_t = (bf16_t*)take((size_t)1024 * 1024 * 2);
  p.qb = (bf16_t*)take((size_t)T_TOK * 512 * 2);
  p.kb = (bf16_t*)take((size_t)T_TOK * 512 * 2);
  p.kmean = (float*)take((size_t)16 * 16 * 128 * 4);
  p.oab = (bf16_t*)take((size_t)T_TOK * DM * 2);
  p.merged = (bf16_t*)take((size_t)T_TOK * DM * 2);
  p.mixer = (bf16_t*)take((size_t)T_TOK * DM * 2);
  p.h2 = (bf16_t*)take((size_t)T_TOK * DM * 2);
  p.elist = (int*)take((size_t)NE * T_TOK * 4);
  p.aw = (float*)take((size_t)T_TOK * 4 * 4);
  p.rowmap = (int*)take((size_t)73728 * 4);
  p.dnA = (unsigned char*)take((size_t)1024 * DN_ABYTES);
  p.dnU = (float*)take((size_t)1024 * DN_UFLOATS * 4);
  p.dnG = (float*)take(4096);
  p.oab2 = (bf16_t*)take((size_t)T_TOK * 512 * 2);
  p.dbg = (float*)take(256);
  p.bar = (unsigned*)take(XCD_BAR_WORDS * 4);
  p.never = 0;
  p.dn_out = p.oab; p.dn_out_ld = DM;
  p.Kp = (bf16_t*)take((size_t)16 * 128 * 8192);
  p.Vp = (bf16_t*)take((size_t)16 * 128 * 8192);
  p.wq = p.cnt + 32;
  p.mb_out = p.oab; p.mb_out_ld = DM; p.mb_out_off = 512;
  p.xs = p.proj;
  char* big = take((size_t)73728 * DM * 2 + (size_t)65536 * DM * 2);
  p.act = (bf16_t*)big;
  p.yslot = (bf16_t*)(big + (size_t)73728 * DM * 2);
  {
    char* s = big; size_t so = 0;
    auto t2 = [&](size_t bytes) { char* r = s + so; so += al(bytes); return r; };
    p.nq = (float*)t2((size_t)T_TOK * 512 * 4);
    p.nk = (float*)t2((size_t)T_TOK * 512 * 4);
    p.nv = (float*)t2((size_t)T_TOK * 512 * 4);
    p.no = (float*)t2((size_t)T_TOK * 512 * 4);
    p.ntmp = (float*)t2((size_t)T_TOK * DM * 4);
    p.nbeta = (float*)t2((size_t)T_TOK * 4 * 4);
    p.ng = (float*)t2((size_t)T_TOK * 4 * 4);
  }

  static int grid_blocks = 0;
  if (!grid_blocks) {
    (void)hipFuncSetAttribute((const void*)mega, hipFuncAttributeMaxDynamicSharedMemorySize, MEGA_LDS_ALLOC);
    int dev = 0, cus = 0, per_cu = 0;
    (void)hipGetDevice(&dev);
    (void)hipDeviceGetAttribute(&cus, hipDeviceAttributeMultiprocessorCount, dev);
    (void)hipOccupancyMaxActiveBlocksPerMultiprocessor(&per_cu, mega, 512, MEGA_LDS_ALLOC);
    if (per_cu != 1) per_cu = 1;
    grid_blocks = cus * per_cu;
  }
  (void)hipMemsetAsync(p.cnt, 0, 256, stream);
  (void)hipMemsetAsync(p.bar, 0, XCD_BAR_WORDS * 4, stream);
  void* args[] = {&p};
  hipError_t e = hipLaunchCooperativeKernel((void*)mega, dim3(grid_blocks), dim3(512), args, MEGA_LDS_ALLOC, stream);
  if (e != hipSuccess) fprintf(stderr, "cooperative launch failed: %s (grid %d)\n", hipGetErrorString(e), grid_blocks);
}
```

```cpp
#include <hip/hip_runtime.h>
#include <hip/hip_cooperative_groups.h>
#include <cstdio>
namespace cg = cooperative_groups;
#include <stdint.h>

typedef unsigned short bf16_t;

#define T_TOK 16384
#define SEQ 4096
#define NB 4
#define DM 1024
#define INW 5640
#define PW 5632
#define C_QA 0
#define C_KA 512
#define C_VA 1024
#define C_Z 1536
#define C_MQ 2048
#define C_MK 2560
#define C_MV 3072
#define C_GA 3584
#define C_GB 4608
#define NE 32

__device__ __forceinline__ bf16_t f2bf(float f) {
  unsigned u = __float_as_uint(f);
  u += 0x7fffu + ((u >> 16) & 1u);
  return (bf16_t)(u >> 16);
}
__device__ __forceinline__ float bf2f(bf16_t h) { return __uint_as_float(((unsigned)h) << 16); }
__device__ __forceinline__ float sigmoidf_(float x) { return 1.f / (1.f + __expf(-x)); }
__device__ __forceinline__ float siluf_(float x) { return x / (1.f + __expf(-x)); }
__device__ __forceinline__ float wave_sum(float v) {
#pragma unroll
  for (int o = 32; o > 0; o >>= 1) v += __shfl_xor(v, o, 64);
  return v;
}
__device__ __forceinline__ float wave_max(float v) {
#pragma unroll
  for (int o = 32; o > 0; o >>= 1) v = fmaxf(v, __shfl_xor(v, o, 64));
  return v;
}

typedef __bf16 bf16x2_t __attribute__((ext_vector_type(2)));
typedef float f32x2_t __attribute__((ext_vector_type(2)));
__device__ __forceinline__ unsigned pk2(float a, float b) { f32x2_t v = {a, b}; bf16x2_t r = __builtin_convertvector(v, bf16x2_t); return __builtin_bit_cast(unsigned, r); }

struct Params {
  const float *x, *c, *w_ada, *b_ada, *g_pre_mix, *g_post_mix, *g_pre_ffn, *g_post_ffn, *w_in, *conv_w,
      *a_log, *dt_bias, *g_dn_out, *w_br_a, *w_br_b, *w_o, *w_router, *b_router, *w_gu, *b_gu, *w_down, *b_down;
  float* out;
  float* mod;
  int* cnt;
  float* ba;
  bf16_t* hbf;
  bf16_t* proj;
  bf16_t* w_in_t;
  bf16_t* wgu_t;
  bf16_t* wd_t;
  bf16_t* wbra_t;
  bf16_t* wbrb_t;
  bf16_t* wo_t;
  bf16_t* qb;
  bf16_t* kb;
  float* kmean;
  bf16_t* oab;
  bf16_t* merged;
  bf16_t* mixer;
  bf16_t* h2;
  int* elist;
  float* aw;
  bf16_t* act;
  bf16_t* xs;
  int* rowmap;
  bf16_t* yslot;
  unsigned char* dnA; float* dnU; float* dnG;
  bf16_t* dn_out; int dn_out_ld;
  bf16_t* oab2; float* dbg;
  unsigned* bar; int never; int tid;
  bf16_t* Kp; bf16_t* Vp; int* wq;
  bf16_t* mb_out; int mb_out_ld; int mb_out_off;
  float* nq; float* nk; float* nv;
  float* nbeta; float* ng;
  float* no;
  float* ntmp;
};

__device__ __forceinline__ int map_col(int n, int mode) {
  if (mode == 0) return n;
  if (mode == 1) return n < 2048 ? n : (n < 2056 ? -1 : n - 8);
  if (n < 1024) return (n >> 7) * 256 + (n & 127);
  int j = n - 1024;
  return (j >> 7) * 256 + 128 + (j & 127);
}
namespace pg8 {
#define PG8_LAS __attribute__((address_space(3)))
typedef short bf16x8 __attribute__((ext_vector_type(8)));
typedef float f32x4 __attribute__((ext_vector_type(4)));
typedef unsigned u32x4 __attribute__((ext_vector_type(4)));
constexpr int BM = 256, BK = 64, HALF = 128, HTB = HALF * BK * 2, STAGE_BYTES = 8 * HTB, NXCD = 8, WGM = 8;

__host__ __device__ __forceinline__ int lds_byte(int r, int c) { const int st = (r >> 4) * 2 + (c >> 5), rr = r & 15, cc = c & 31, ob = rr * 64 + cc * 2; return st * 1024 + (ob ^ (((ob >> 9) & 1) << 5)); }
__host__ __device__ __forceinline__ void stage_rc(int b, int& R, int& C) { const int st = b / 1024, sb = b % 1024, swz = sb ^ (((sb >> 9) & 1) << 5); R = (st >> 1) * 16 + swz / 64; C = (st & 1) * 32 + (swz % 64) / 2; }
__host__ __device__ __forceinline__ int perm32(int rho) { const int n = rho >> 4, i = rho & 15; return 8 * (i >> 2) + 4 * n + (i & 3); }

struct Unit { int pm, pn, z; };
__device__ __forceinline__ unsigned cvt_pk_bf16(float lo, float hi) { unsigned r; asm volatile("v_cvt_pk_bf16_f32 %0, %1, %2" : "=v"(r) : "v"(lo), "v"(hi)); return r; }

struct TileOrder {
    int nM, nN, nwg, G, c;
    __device__ void init(int nM_, int nN_, int G_, int c_) { nM = nM_; nN = nN_; nwg = nM * nN; G = G_; c = c_; }
    __device__ bool tile(int i, int& pm, int& pn) const {
        const long L = (long)i * G + c; if (L >= nwg) return false;
        int wgid = (int)L; { const int q = nwg / NXCD, r = nwg % NXCD, xcd = wgid % NXCD, off = wgid / NXCD; wgid = (xcd < r ? xcd * (q + 1) : r * (q + 1) + (xcd - r) * q) + off; }
        const int nig = WGM * nN, gid = wgid / nig, fm = gid * WGM, gsz = (nM - fm) < WGM ? (nM - fm) : WGM;
        pm = fm + ((wgid % nig) % gsz); pn = (wgid % nig) / gsz; return true;
    }
};

template <class Epi, class Sched>
__device__ __forceinline__ void gemm_phase(PG8_LAS unsigned char* lds, const int tid, const int lda, const int ldb, const int K, const Sched& S, const Epi& E) {
    const int wid = __builtin_amdgcn_readfirstlane(tid >> 6), lane = tid & 63, wr = wid >> 2, wc = wid & 3, fr = lane & 15, fq = lane >> 4;
    const int nt = K / BK;
    unsigned voffA[2], voffB[2];
#pragma unroll
    for (int i = 0; i < 2; ++i) { int R, C; stage_rc(tid * 16 + i * 8192, R, C); const int Rb = Epi::PERM ? ((R & ~31) + perm32(R & 31)) : R;
        voffA[i] = (unsigned)(R * lda + C) * 2u; voffB[i] = (unsigned)(Rb * ldb + C) * 2u; }
    const size_t kstep = (size_t)(BK * 2);
    const size_t hstepA = (size_t)HALF * lda * 2, hstepB = (size_t)HALF * ldb * 2;
    const unsigned ldsw = (unsigned)wid * 1024u;
    const int aoff = lds_byte(wr * 64 + fr, fq * 8), boff = lds_byte(wc * 32 + fr, fq * 8);
#define PG8_SA(b, h) (((b) * 2 + (h)) * HTB)
#define PG8_SB(b, h) ((4 + (b) * 2 + (h)) * HTB)
#define PG8_STAGE(bufoff, gbase, voff) do { _Pragma("unroll") for (int _i = 0; _i < 2; ++_i) \
        __builtin_amdgcn_global_load_lds((const unsigned*)((const char*)(gbase) + (voff)[_i]), (PG8_LAS unsigned*)(lds + (bufoff) + ldsw + _i * 8192), 16, 0, 0); } while (0)
#define PG8_LDA(dst, b, h) do { _Pragma("unroll") for (int m = 0; m < 4; ++m) _Pragma("unroll") for (int k = 0; k < 2; ++k) dst[m][k] = *(const PG8_LAS bf16x8*)(lds + PG8_SA(b, h) + aoff + m * 2048 + k * 1024); } while (0)
#define PG8_LDB(dst, b, h) do { _Pragma("unroll") for (int n = 0; n < 2; ++n) _Pragma("unroll") for (int k = 0; k < 2; ++k) dst[n][k] = *(const PG8_LAS bf16x8*)(lds + PG8_SB(b, h) + boff + n * 2048 + k * 1024); } while (0)
#define PG8_MMA(ai, bj, At, Bt) do { __builtin_amdgcn_s_setprio(1); _Pragma("unroll") for (int m = 0; m < 4; ++m) _Pragma("unroll") for (int n = 0; n < 2; ++n) _Pragma("unroll") for (int k = 0; k < 2; ++k) \
        acc[ai][bj][m][n] = __builtin_amdgcn_mfma_f32_16x16x32_bf16(Bt[n][k], At[m][k], acc[ai][bj][m][n], 0, 0, 0); __builtin_amdgcn_s_setprio(0); } while (0)
#define PG8_WAIT_V(n) asm volatile("s_waitcnt vmcnt(" #n ")" ::: "memory")
#define PG8_WAIT_L(n) asm volatile("s_waitcnt lgkmcnt(" #n ")" ::: "memory")
#define PG8_BAR __builtin_amdgcn_s_barrier()
#define PG8_SCHED __builtin_amdgcn_sched_barrier(0)
    Unit cur, nxt; int ui = 0;
    if (!S.next(0, cur)) return;
    f32x4 acc[2][2][4][2];
#pragma unroll
    for (int a = 0; a < 2; ++a)
#pragma unroll
        for (int b = 0; b < 2; ++b)
#pragma unroll
            for (int m = 0; m < 4; ++m)
#pragma unroll
                for (int n = 0; n < 2; ++n) acc[a][b][m][n] = (f32x4){0.f, 0.f, 0.f, 0.f};
    bf16x8 At[4][2], B0[2][2], B1[2][2];
    const char* cA = S.a_ptr(cur); const char* cB = S.b_ptr(cur);
    PG8_STAGE(PG8_SB(0, 0), cB, voffB); PG8_STAGE(PG8_SA(0, 0), cA, voffA); PG8_STAGE(PG8_SB(0, 1), cB + hstepB, voffB); PG8_STAGE(PG8_SA(0, 1), cA + hstepA, voffA);
    if (wr == 1) PG8_BAR;
    PG8_WAIT_V(4); PG8_BAR;
    PG8_STAGE(PG8_SB(1, 0), cB + kstep, voffB); PG8_STAGE(PG8_SA(1, 0), cA + kstep, voffA); PG8_STAGE(PG8_SB(1, 1), cB + hstepB + kstep, voffB);
    PG8_WAIT_V(6); PG8_BAR;
    for (;;) {
        const bool has_next = S.next(ui + 1, nxt);
        const char* nA = has_next ? S.a_ptr(nxt) : cA; const char* nB = has_next ? S.b_ptr(nxt) : cB;
        for (int t = 0; t < nt; t += 2) {
            const bool last = (t == nt - 2);
            const char* a1 = cA + (size_t)(t + 1) * kstep;
            const char* a2 = last ? nA : cA + (size_t)(t + 2) * kstep; const char* b2 = last ? nB : cB + (size_t)(t + 2) * kstep;
            const char* a3 = a2 + kstep; const char* b3 = b2 + kstep;
            PG8_LDB(B0, 0, 0); PG8_SCHED; PG8_LDA(At, 0, 0); PG8_STAGE(PG8_SA(1, 1), a1 + hstepA, voffA);
            PG8_WAIT_L(8); PG8_BAR; PG8_WAIT_L(0); PG8_MMA(0, 0, At, B0); PG8_BAR; PG8_SCHED;
            PG8_LDB(B1, 0, 1); PG8_STAGE(PG8_SB(0, 0), b2, voffB);
            PG8_BAR; PG8_WAIT_L(0); PG8_MMA(0, 1, At, B1); PG8_BAR;
            PG8_LDA(At, 0, 1); PG8_STAGE(PG8_SA(0, 0), a2, voffA);
            PG8_BAR; PG8_WAIT_L(0); PG8_MMA(1, 0, At, B0); PG8_BAR; PG8_SCHED;
            PG8_STAGE(PG8_SB(0, 1), b2 + hstepB, voffB);
            PG8_WAIT_V(6); PG8_BAR; PG8_MMA(1, 1, At, B1); PG8_BAR;
            PG8_LDB(B0, 1, 0); PG8_SCHED; PG8_LDA(At, 1, 0); PG8_STAGE(PG8_SA(0, 1), a2 + hstepA, voffA);
            PG8_WAIT_L(8); PG8_BAR; PG8_WAIT_L(0); PG8_MMA(0, 0, At, B0); PG8_BAR; PG8_SCHED;
            PG8_LDB(B1, 1, 1); PG8_STAGE(PG8_SB(1, 0), b3, voffB);
            PG8_BAR; PG8_WAIT_L(0); PG8_MMA(0, 1, At, B1); PG8_BAR;
            PG8_LDA(At, 1, 1); PG8_STAGE(PG8_SA(1, 0), a3, voffA);
            PG8_BAR; PG8_WAIT_L(0); PG8_MMA(1, 0, At, B0); PG8_BAR; PG8_SCHED;
            PG8_STAGE(PG8_SB(1, 1), b3 + hstepB, voffB);
            PG8_WAIT_V(6); PG8_BAR; PG8_MMA(1, 1, At, B1); PG8_BAR;
        }
        E(acc, cur, wr, wc, fr, fq);
        if (!has_next) break;
#pragma unroll
        for (int a = 0; a < 2; ++a)
#pragma unroll
            for (int b = 0; b < 2; ++b)
#pragma unroll
                for (int m = 0; m < 4; ++m)
#pragma unroll
                    for (int n = 0; n < 2; ++n) acc[a][b][m][n] = (f32x4){0.f, 0.f, 0.f, 0.f};
        cur = nxt; cA = nA; cB = nB; ++ui;
    }
    PG8_WAIT_V(0);
    if (wr == 0) PG8_BAR;
    PG8_BAR;
#undef PG8_SA
#undef PG8_SB
#undef PG8_STAGE
#undef PG8_LDA
#undef PG8_LDB
#undef PG8_MMA
#undef PG8_WAIT_V
#undef PG8_WAIT_L
#undef PG8_BAR
#undef PG8_SCHED
}
}
using pg8::f32x4; using pg8::u32x4; using pg8::Unit;

#define GEMM_LDS (pg8::STAGE_BYTES + 1024)

struct SchedProj : pg8::TileOrder {
  const char* A; const char* B;
  __device__ bool next(int i, Unit& u) const { u.z = 0; return tile(i, u.pm, u.pn); }
  __device__ const char* a_ptr(const Unit& u) const { return A + (size_t)u.pm * 256 * DM * 2; }
  __device__ const char* b_ptr(const Unit& u) const { return B + (size_t)u.pn * 256 * DM * 2; }
};
struct EpiProj {
  static constexpr bool PERM = true;
  bf16_t* O;
  __device__ __forceinline__ void operator()(const f32x4 (&acc)[2][2][4][2], const Unit& u, int wr, int wc, int fr, int fq) const {
    const int row0 = u.pm * 256 + wr * 64 + fr, col0 = u.pn * 256 + wc * 32 + 8 * fq;
    const bool gate = u.pn >= (C_GA / 256);
#pragma unroll
    for (int ai = 0; ai < 2; ++ai)
#pragma unroll
      for (int m = 0; m < 4; ++m) {
        bf16_t* rowp = O + (size_t)(row0 + ai * 128 + m * 16) * PW + col0;
#pragma unroll
        for (int bj = 0; bj < 2; ++bj) {
          f32x4 v0 = acc[ai][bj][m][0], v1 = acc[ai][bj][m][1];
          if (gate) {
#pragma unroll
            for (int j = 0; j < 4; ++j) { v0[j] = sigmoidf_(v0[j]); v1[j] = sigmoidf_(v1[j]); }
          }
          u32x4 w; w.x = pg8::cvt_pk_bf16(v0[0], v0[1]); w.y = pg8::cvt_pk_bf16(v0[2], v0[3]); w.z = pg8::cvt_pk_bf16(v1[0], v1[1]); w.w = pg8::cvt_pk_bf16(v1[2], v1[3]);
          *(u32x4*)(rowp + bj * 128) = w;
        }
      }
  }
};
__device__ void ph_proj(const Params& p, PG8_LAS unsigned char* lds, int nblk, int bid) {
  SchedProj S; S.init(T_TOK / 256, PW / 256, nblk, bid); S.A = (const char*)p.hbf; S.B = (const char*)p.w_in_t;
  EpiProj E{p.proj};
  pg8::gemm_phase(lds, p.tid, DM, DM, DM, S, E);
}

struct SchedBr : pg8::TileOrder {
  const char* A; const char* Ba; const char* Bb;
  __device__ bool next(int i, Unit& u) const { u.z = i & 1; return tile(i >> 1, u.pm, u.pn); }
  __device__ const char* a_ptr(const Unit& u) const { return A + (size_t)u.pm * 256 * DM * 2 + u.z * 512 * 2; }
  __device__ const char* b_ptr(const Unit& u) const { return (u.z ? Bb : Ba) + (size_t)u.pn * 256 * 512 * 2; }
};
__device__ __forceinline__ void unpack8(const u32x4 w, float (&f)[8]) {
  f[0] = __uint_as_float(w.x << 16); f[1] = __uint_as_float(w.x & 0xffff0000u); f[2] = __uint_as_float(w.y << 16); f[3] = __uint_as_float(w.y & 0xffff0000u);
  f[4] = __uint_as_float(w.z << 16); f[5] = __uint_as_float(w.z & 0xffff0000u); f[6] = __uint_as_float(w.w << 16); f[7] = __uint_as_float(w.w & 0xffff0000u);
}
struct EpiBr {
  static constexpr bool PERM = true;
  const bf16_t* proj; bf16_t* O;
  __device__ __forceinline__ void operator()(const f32x4 (&acc)[2][2][4][2], const Unit& u, int wr, int wc, int fr, int fq) const {
    const int row0 = u.pm * 256 + wr * 64 + fr, col0 = u.pn * 256 + wc * 32 + 8 * fq;
    const int gcol = (u.z ? C_GB : C_GA) + col0;
#pragma unroll
    for (int ai = 0; ai < 2; ++ai)
#pragma unroll
      for (int m = 0; m < 4; ++m) {
        const size_t row = (size_t)(row0 + ai * 128 + m * 16);
        bf16_t* rowp = O + row * DM + col0;
        const bf16_t* gp = proj + row * PW + gcol;
#pragma unroll
        for (int bj = 0; bj < 2; ++bj) {
          float g[8]; unpack8(*(const u32x4*)(gp + bj * 128), g);
          f32x4 v0 = acc[ai][bj][m][0], v1 = acc[ai][bj][m][1];
          float r[8];
#pragma unroll
          for (int j = 0; j < 4; ++j) { r[j] = v0[j] * g[j]; r[4 + j] = v1[j] * g[4 + j]; }
          if (u.z) {
            float pv[8]; unpack8(*(const u32x4*)(rowp + bj * 128), pv);
#pragma unroll
            for (int j = 0; j < 8; ++j) r[j] += pv[j];
          }
          u32x4 w; w.x = pg8::cvt_pk_bf16(r[0], r[1]); w.y = pg8::cvt_pk_bf16(r[2], r[3]); w.z = pg8::cvt_pk_bf16(r[4], r[5]); w.w = pg8::cvt_pk_bf16(r[6], r[7]);
          *(u32x4*)(rowp + bj * 128) = w;
        }
      }
  }
};
__device__ void ph_br(const Params& p, PG8_LAS unsigned char* lds, int nblk, int bid) {
  SchedBr S; S.init(T_TOK / 256, DM / 256, nblk, bid); S.A = (const char*)p.oab; S.Ba = (const char*)p.wbra_t; S.Bb = (const char*)p.wbrb_t;
  EpiBr E{p.proj, p.merged};
  pg8::gemm_phase(lds, p.tid, DM, 512, 512, S, E);
}

struct SchedMix : pg8::TileOrder {
  const char* A; const char* B;
  __device__ bool next(int i, Unit& u) const { u.z = 0; return tile(i, u.pm, u.pn); }
  __device__ const char* a_ptr(const Unit& u) const { return A + (size_t)u.pm * 256 * DM * 2; }
  __device__ const char* b_ptr(const Unit& u) const { return B + (size_t)u.pn * 256 * DM * 2; }
};
struct EpiMix {
  static constexpr bool PERM = true;
  bf16_t* O;
  __device__ __forceinline__ void operator()(const f32x4 (&acc)[2][2][4][2], const Unit& u, int wr, int wc, int fr, int fq) const {
    const int row0 = u.pm * 256 + wr * 64 + fr, col0 = u.pn * 256 + wc * 32 + 8 * fq;
#pragma unroll
    for (int ai = 0; ai < 2; ++ai)
#pragma unroll
      for (int m = 0; m < 4; ++m) {
        bf16_t* rowp = O + (size_t)(row0 + ai * 128 + m * 16) * DM + col0;
#pragma unroll
        for (int bj = 0; bj < 2; ++bj) {
          const f32x4 v0 = acc[ai][bj][m][0], v1 = acc[ai][bj][m][1];
          u32x4 w; w.x = pg8::cvt_pk_bf16(v0[0], v0[1]); w.y = pg8::cvt_pk_bf16(v0[2], v0[3]); w.z = pg8::cvt_pk_bf16(v1[0], v1[1]); w.w = pg8::cvt_pk_bf16(v1[2], v1[3]);
          *(u32x4*)(rowp + bj * 128) = w;
        }
      }
  }
};
__device__ void ph_mix(const Params& p, PG8_LAS unsigned char* lds, int nblk, int bid) {
  SchedMix S; S.init(T_TOK / 256, DM / 256, nblk, bid); S.A = (const char*)p.merged; S.B = (const char*)p.wo_t;
  EpiMix E{p.mixer};
  pg8::gemm_phase(lds, p.tid, DM, DM, DM, S, E);
}

struct SchedMoe {
  const PG8_LAS int* tb; int NT; int G, c; int nwg;
  const char* A; const char* B; size_t bexp;
  __device__ bool next(int i, Unit& u) const {
    const long L = (long)i * G + c; if (L >= nwg) return false;
    int wgid = (int)L; { const int q = nwg / 8, r = nwg % 8, xcd = wgid % 8, off = wgid / 8; wgid = (xcd < r ? xcd * (q + 1) : r * (q + 1) + (xcd - r) * q) + off; }
    int e = 0;
#pragma unroll 1
    for (int k = 1; k < NE; ++k) if (wgid >= tb[k]) e = k;
    const int q = wgid - tb[e]; const int tiles = tb[33 + e + 1] - tb[33 + e];
    u.pm = tb[33 + e] + q % tiles; u.pn = q / tiles; u.z = e; return true;
  }
  __device__ const char* a_ptr(const Unit& u) const { return A + (size_t)u.pm * 256 * DM * 2; }
  __device__ const char* b_ptr(const Unit& u) const { return B + (size_t)u.z * bexp + (size_t)u.pn * 256 * DM * 2; }
};
__device__ __forceinline__ void moe_table(const Params& p, PG8_LAS int* tb, int NT) {
  if (p.tid == 0) {
    int ub = 0, tbp = 0;
    for (int e = 0; e < NE; ++e) { tb[e] = ub; tb[33 + e] = tbp; const int t = (p.cnt[e] + 255) >> 8; ub += t * NT; tbp += t; }
    tb[NE] = ub; tb[33 + NE] = tbp;
  }
  __syncthreads();
}
struct EpiMoe1 {
  static constexpr bool PERM = true;
  const float* b_gu; bf16_t* act;
  __device__ __forceinline__ void operator()(f32x4 (&acc)[2][2][4][2], const Unit& u, int wr, int wc, int fr, int fq) const {
    const int row0 = u.pm * 256 + wr * 64 + fr, jc = u.pn * 128 + wc * 32 + 8 * fq;
    const float* bg = b_gu + (size_t)u.z * 2048 + jc;
#pragma unroll
    for (int bj = 0; bj < 2; ++bj)
#pragma unroll
      for (int n = 0; n < 2; ++n) {
        const f32x4 bv = *(const f32x4*)(bg + bj * 1024 + n * 4);
#pragma unroll
        for (int ai = 0; ai < 2; ++ai)
#pragma unroll
          for (int m = 0; m < 4; ++m) acc[ai][bj][m][n] += bv;
      }
#pragma unroll
    for (int ai = 0; ai < 2; ++ai)
#pragma unroll
      for (int m = 0; m < 4; ++m) {
        bf16_t* rowp = act + (size_t)(row0 + ai * 128 + m * 16) * DM + jc;
        float r[8];
#pragma unroll
        for (int n = 0; n < 2; ++n)
#pragma unroll
          for (int j = 0; j < 4; ++j) {
            float g = acc[ai][0][m][n][j], up = acc[ai][1][m][n][j];
            g = fminf(g, 7.f); up = fminf(fmaxf(up, -7.f), 7.f);
            r[n * 4 + j] = (up + 1.f) * g * sigmoidf_(1.702f * g);
          }
        u32x4 w; w.x = pk2(r[0], r[1]); w.y = pk2(r[2], r[3]); w.z = pk2(r[4], r[5]); w.w = pk2(r[6], r[7]);
        *(u32x4*)rowp = w;
      }
  }
};
__device__ void ph_moe1(const Params& p, PG8_LAS unsigned char* lds, int nblk, int bid) {
  PG8_LAS int* tb = (PG8_LAS int*)(lds + pg8::STAGE_BYTES);
  moe_table(p, tb, 8);
  SchedMoe S; S.tb = tb; S.NT = 8; S.G = nblk; S.c = bid; S.nwg = tb[NE]; S.A = (const char*)p.xs; S.B = (const char*)p.wgu_t; S.bexp = (size_t)2048 * DM * 2;
  EpiMoe1 E{p.b_gu, p.act};
  pg8::gemm_phase(lds, p.tid, DM, DM, DM, S, E);
}
struct EpiMoe2 {
  static constexpr bool PERM = true;
  const float* b_down; const int* rowmap; bf16_t* yslot;
  __device__ __forceinline__ void operator()(f32x4 (&acc)[2][2][4][2], const Unit& u, int wr, int wc, int fr, int fq) const {
    const int row0 = u.pm * 256 + wr * 64 + fr, col0 = u.pn * 256 + wc * 32 + 8 * fq;
    const float* bd = b_down + (size_t)u.z * 1024 + col0;
#pragma unroll
    for (int bj = 0; bj < 2; ++bj)
#pragma unroll
      for (int n = 0; n < 2; ++n) {
        const f32x4 bv = *(const f32x4*)(bd + bj * 128 + n * 4);
#pragma unroll
        for (int ai = 0; ai < 2; ++ai)
#pragma unroll
          for (int m = 0; m < 4; ++m) acc[ai][bj][m][n] += bv;
      }
#pragma unroll
    for (int ai = 0; ai < 2; ++ai)
#pragma unroll
      for (int m = 0; m < 4; ++m) {
        const int a = rowmap[row0 + ai * 128 + m * 16];
        if (a >= 0) {
          bf16_t* rowp = yslot + (size_t)a * DM + col0;
#pragma unroll
          for (int bj = 0; bj < 2; ++bj) {
            const f32x4 v0 = acc[ai][bj][m][0], v1 = acc[ai][bj][m][1];
            u32x4 w; w.x = pk2(v0[0], v0[1]); w.y = pk2(v0[2], v0[3]); w.z = pk2(v1[0], v1[1]); w.w = pk2(v1[2], v1[3]);
            *(u32x4*)(rowp + bj * 128) = w;
          }
        }
      }
  }
};
__device__ void ph_moe2(const Params& p, PG8_LAS unsigned char* lds, int nblk, int bid) {
  PG8_LAS int* tb = (PG8_LAS int*)(lds + pg8::STAGE_BYTES);
  moe_table(p, tb, 4);
  SchedMoe S; S.tb = tb; S.NT = 4; S.G = nblk; S.c = bid; S.nwg = tb[NE]; S.A = (const char*)p.act; S.B = (const char*)p.wd_t; S.bexp = (size_t)1024 * DM * 2;
  EpiMoe2 E{p.b_down, p.rowmap, p.yslot};
  pg8::gemm_phase(lds, p.tid, DM, DM, DM, S, E);
}

typedef short bf16x8 __attribute__((ext_vector_type(8)));
typedef unsigned u32x2 __attribute__((ext_vector_type(2)));
#define LAS __attribute__((address_space(3)))
#define MFMA16(a, b, c) __builtin_amdgcn_mfma_f32_16x16x32_bf16((a), (b), (c), 0, 0, 0)
__device__ __forceinline__ bf16x8 pack8(float a0, float a1, float a2, float a3, float a4, float a5, float a6, float a7) {
  u32x4 w; w.x = pk2(a0, a1); w.y = pk2(a2, a3); w.z = pk2(a4, a5); w.w = pk2(a6, a7);
  return __builtin_bit_cast(bf16x8, w);
}
__device__ __forceinline__ bf16_t f2bf_hw(float a) { return (bf16_t)(pk2(a, 0.f) & 0xffffu); }

#define DN_ABYTES 57344
#define DN_UFLOATS 8192
#define F_WN 0
#define F_QD 16
#define F_QK 32
#define F_KT 40

#define DP_KH 0
#define DP_QT 17408
#define DP_KHT 34816
#define DP_VT 53248
#define DP_TU 71680
#define DP_TW 80896
#define DP_LF 90112
#define DP_GC 107520
#define DP_BETA 107776
#define DP_CW 108032
#define DP_TOTAL 114176

template <int KS>
__device__ __forceinline__ f32x4 prod16(const LAS bf16_t* A, int lda, int arow0, const LAS bf16_t* Bt, int ldb, int brow0, f32x4 acc, int lane) {
  const int r = lane & 15, q = lane >> 4;
#pragma unroll
  for (int ks = 0; ks < KS; ++ks) {
    const bf16x8 a = *(const LAS bf16x8*)(A + (arow0 + r) * lda + 32 * ks + 8 * q);
    const bf16x8 b = *(const LAS bf16x8*)(Bt + (brow0 + r) * ldb + 32 * ks + 8 * q);
    acc = MFMA16(a, b, acc);
  }
  return acc;
}
__device__ __forceinline__ void tile_store_rm(LAS bf16_t* X, int ld, int row0, int col0, const f32x4 v, int lane) {
  const int r = lane & 15, q = lane >> 4;
#pragma unroll
  for (int i = 0; i < 4; ++i) X[(row0 + 4 * q + i) * ld + col0 + r] = f2bf_hw(v[i]);
}
__device__ __forceinline__ void tile_store_tr(LAS bf16_t* Xt, int ld, int row0, int col0, const f32x4 v, int lane) {
  const int r = lane & 15, q = lane >> 4;
  u32x2 w; w.x = pk2(v[0], v[1]); w.y = pk2(v[2], v[3]);
  *(LAS u32x2*)(Xt + (col0 + r) * ld + row0 + 4 * q) = w;
}

__device__ void dn_prep_chunk(const Params& p, LAS unsigned char* lds, int ci, bool load_cw) {
  const int tid = p.tid, lane = tid & 63, w = tid >> 6, r16 = lane & 15, q4 = lane >> 4;
  const int bh = ci >> 6, n = ci & 63, b = bh >> 2, h = bh & 3;
  LAS bf16_t* Kh = (LAS bf16_t*)(lds + DP_KH); LAS bf16_t* Qt = (LAS bf16_t*)(lds + DP_QT);
  LAS bf16_t* KhT = (LAS bf16_t*)(lds + DP_KHT); LAS bf16_t* VT = (LAS bf16_t*)(lds + DP_VT);
  LAS bf16_t* Tu = (LAS bf16_t*)(lds + DP_TU); LAS bf16_t* Tw = (LAS bf16_t*)(lds + DP_TW); LAS float* Lf = (LAS float*)(lds + DP_LF);
  LAS float* gcb = (LAS float*)(lds + DP_GC); LAS float* betab = (LAS float*)(lds + DP_BETA); LAS float* cw = (LAS float*)(lds + DP_CW);
  unsigned char* gA = (unsigned char*)p.dnA + (size_t)ci * DN_ABYTES;
  float* gU = p.dnU + (size_t)ci * DN_UFLOATS;

  if (load_cw) {
    for (int i = tid; i < 4 * 384; i += 512) { const int tap = i / 384, cc = i % 384, part = cc >> 7, d = cc & 127; cw[i] = p.conv_w[tap * 1536 + part * 512 + h * 128 + d]; }
  }
  __syncthreads();
  const int c = tid >> 3, g = tid & 7;
  const int s = n * 64 + c;
  const size_t t = (size_t)b * SEQ + s;
  float qv[16], kv[16], vv[16];
#pragma unroll
  for (int j = 0; j < 16; ++j) { qv[j] = 0.f; kv[j] = 0.f; vv[j] = 0.f; }
#pragma unroll
  for (int tap = 0; tap < 4; ++tap) {
    const int ss = s - 3 + tap;
    if (ss >= 0) {
      const bf16_t* row = p.proj + (t - 3 + tap) * PW + h * 128 + 16 * g;
      float x[8];
#pragma unroll
      for (int part = 0; part < 3; ++part) {
#pragma unroll
        for (int hh = 0; hh < 2; ++hh) {
          unpack8(*(const u32x4*)(row + part * 512 + 8 * hh), x);
#pragma unroll
          for (int j = 0; j < 8; ++j) {
            const float wv = cw[tap * 384 + part * 128 + 16 * g + 8 * hh + j];
            if (part == 0) qv[8 * hh + j] += wv * x[j];
            if (part == 1) kv[8 * hh + j] += wv * x[j];
            if (part == 2) vv[8 * hh + j] += wv * x[j];
          }
        }
      }
    }
    asm volatile("" ::: "memory");
  }
  float sq = 0.f, sk = 0.f;
#pragma unroll
  for (int j = 0; j < 16; ++j) { qv[j] = siluf_(qv[j]); kv[j] = siluf_(kv[j]); vv[j] = siluf_(vv[j]); sq += qv[j] * qv[j]; sk += kv[j] * kv[j]; }
  sq += __shfl_xor(sq, 1, 64); sq += __shfl_xor(sq, 2, 64); sq += __shfl_xor(sq, 4, 64);
  sk += __shfl_xor(sk, 1, 64); sk += __shfl_xor(sk, 2, 64); sk += __shfl_xor(sk, 4, 64);
  const float rq = rsqrtf(sq + 1e-6f) * 0.08838834764831845f, rk = rsqrtf(sk + 1e-6f);
#pragma unroll
  for (int j = 0; j < 16; ++j) { qv[j] *= rq; kv[j] *= rk; }
  if (g == 0) {
    const float bb = p.ba[t * 8 + h], aa = p.ba[t * 8 + 4 + h];
    const float xx = aa + p.dt_bias[h];
    const float sp = xx > 20.f ? xx : log1pf(__expf(xx));
    betab[c] = sigmoidf_(bb);
    gcb[c] = -__expf(p.a_log[h]) * sp;
  }
  {
    u32x4 w0, w1;
    w0.x = pk2(kv[0], kv[1]); w0.y = pk2(kv[2], kv[3]); w0.z = pk2(kv[4], kv[5]); w0.w = pk2(kv[6], kv[7]);
    w1.x = pk2(kv[8], kv[9]); w1.y = pk2(kv[10], kv[11]); w1.z = pk2(kv[12], kv[13]); w1.w = pk2(kv[14], kv[15]);
    *(LAS u32x4*)(Kh + c * 136 + 16 * g) = w0; *(LAS u32x4*)(Kh + c * 136 + 16 * g + 8) = w1;
    w0.x = pk2(qv[0], qv[1]); w0.y = pk2(qv[2], qv[3]); w0.z = pk2(qv[4], qv[5]); w0.w = pk2(qv[6], qv[7]);
    w1.x = pk2(qv[8], qv[9]); w1.y = pk2(qv[10], qv[11]); w1.z = pk2(qv[12], qv[13]); w1.w = pk2(qv[14], qv[15]);
    *(LAS u32x4*)(Qt + c * 136 + 16 * g) = w0; *(LAS u32x4*)(Qt + c * 136 + 16 * g + 8) = w1;
#pragma unroll
    for (int j = 0; j < 16; ++j) { KhT[(16 * g + j) * 72 + c] = f2bf_hw(kv[j]); VT[(16 * g + j) * 72 + c] = f2bf_hw(vv[j]); }
  }
  __syncthreads();
  if (w == 0) {
    float v = gcb[lane];
#pragma unroll
    for (int o = 1; o < 64; o <<= 1) { const float u = __shfl_up(v, o, 64); if (lane >= o) v += u; }
    gcb[lane] = v;
  }
  __syncthreads();
  const float gc_c = gcb[c], gl = gcb[63];
  {
    const float eg = __expf(gc_c);
    unsigned char* fb = gA + (size_t)(F_QD + (c >> 4) * 4 + (g >> 1)) * 1024 + (g & 1) * 8;
#pragma unroll
    for (int qq = 0; qq < 4; ++qq) {
      u32x2 wv; wv.x = pk2(qv[4 * qq] * eg, qv[4 * qq + 1] * eg); wv.y = pk2(qv[4 * qq + 2] * eg, qv[4 * qq + 3] * eg);
      *(u32x2*)(fb + ((c & 15) + 16 * qq) * 16) = wv;
    }
  }
  const int rt = w >> 1, ct0 = 2 * (w & 1);
#pragma unroll
  for (int tt = 0; tt < 2; ++tt) {
    const int ct = ct0 + tt;
    f32x4 gacc = {0.f, 0.f, 0.f, 0.f};
    gacc = prod16<4>(Kh, 136, 16 * rt, Kh, 136, 16 * ct, gacc, lane);
    const int m = 16 * ct + r16; const float gc_m = gcb[m];
#pragma unroll
    for (int i = 0; i < 4; ++i) {
      const int cc = 16 * rt + 4 * q4 + i;
      Lf[cc * 68 + m] = (m < cc) ? betab[cc] * gacc[i] * __expf(gcb[cc] - gc_m) : 0.f;
    }
    f32x4 qacc = {0.f, 0.f, 0.f, 0.f};
    qacc = prod16<4>(Kh, 136, 16 * rt, Qt, 136, 16 * ct, qacc, lane);
    const int cq = 16 * ct + r16; const float gc_cq = gcb[cq];
    float o4[4];
#pragma unroll
    for (int i = 0; i < 4; ++i) { const int mm = 16 * rt + 4 * q4 + i; o4[i] = (mm <= cq) ? qacc[i] * __expf(gc_cq - gcb[mm]) : 0.f; }
    u32x2 wv; wv.x = pk2(o4[0], o4[1]); wv.y = pk2(o4[2], o4[3]);
    *(u32x2*)(gA + (size_t)(F_QK + ct * 2 + (rt >> 1)) * 1024 + (r16 + 16 * q4) * 16 + (rt & 1) * 8) = wv;
  }
  __syncthreads();
  if (w == 0) {
    float T[64];
    int lo = lane; asm volatile("" : "+v"(lo));
    unsigned lfb = DP_LF; asm volatile("" : "+v"(lfb));
    const LAS float* Lfo = (const LAS float*)(lds + lfb);
    const float bm = betab[lo], bem = bm * __expf(gcb[lo]);
#pragma unroll
    for (int i = 0; i < 64; ++i) {
      float a0 = (i == lo) ? 1.f : 0.f, a1 = 0.f, a2 = 0.f, a3 = 0.f;
#pragma unroll
      for (int k4 = 0; k4 < (i + 3) / 4; ++k4) {
        const f32x4 l = *(const LAS f32x4*)(Lfo + i * 68 + 4 * k4);
        if (4 * k4 + 0 < i) a0 -= l[0] * T[4 * k4 + 0];
        if (4 * k4 + 1 < i) a1 -= l[1] * T[4 * k4 + 1];
        if (4 * k4 + 2 < i) a2 -= l[2] * T[4 * k4 + 2];
        if (4 * k4 + 3 < i) a3 -= l[3] * T[4 * k4 + 3];
      }
      T[i] = (a0 + a1) + (a2 + a3);
      Tu[i * 72 + lo] = f2bf_hw(T[i] * bm);
      Tw[i * 72 + lo] = f2bf_hw(T[i] * bem);
      asm volatile("" ::: "memory");
    }
  }
  __syncthreads();
#pragma unroll
  for (int rr = 0; rr < 4; ++rr) {
    f32x4 u = {0.f, 0.f, 0.f, 0.f};
    u = prod16<2>(Tu, 72, 16 * rr, VT, 72, 16 * w, u, lane);
    *(f32x4*)(gU + ((w * 4 + rr) * 64 + lane) * 4) = u;
    f32x4 wt = {0.f, 0.f, 0.f, 0.f};
    wt = prod16<2>(KhT, 72, 16 * w, Tw, 72, 16 * rr, wt, lane);
    u32x2 wv; wv.x = pk2(-wt[0], -wt[1]); wv.y = pk2(-wt[2], -wt[3]);
    *(u32x2*)(gA + (size_t)(F_WN + rr * 4 + (w >> 1)) * 1024 + (r16 + 16 * q4) * 16 + (w & 1) * 8) = wv;
  }
#pragma unroll
  for (int it = 0; it < 4; ++it) {
    const int idx = tid + it * 512; const int d = idx >> 4, m4 = idx & 15;
    const u32x2 raw = *(const LAS u32x2*)(KhT + d * 72 + 4 * m4);
    const float k0 = __uint_as_float(raw.x << 16), k1 = __uint_as_float(raw.x & 0xffff0000u), k2 = __uint_as_float(raw.y << 16), k3 = __uint_as_float(raw.y & 0xffff0000u);
    const float e0 = __expf(gl - gcb[4 * m4]), e1 = __expf(gl - gcb[4 * m4 + 1]), e2 = __expf(gl - gcb[4 * m4 + 2]), e3 = __expf(gl - gcb[4 * m4 + 3]);
    u32x2 wv; wv.x = pk2(k0 * e0, k1 * e1); wv.y = pk2(k2 * e2, k3 * e3);
    *(u32x2*)(gA + (size_t)(F_KT + (d >> 4) * 2 + (m4 >> 3)) * 1024 + ((d & 15) + 16 * (m4 & 3)) * 16 + ((m4 >> 2) & 1) * 8) = wv;
  }
  if (tid == 0) p.dnG[ci] = __expf(gl);
}

#define DS_A0 0
#define DS_A1 57344
#define DS_TOTAL 114688
__device__ void dn_scan_blk(const Params& p, LAS unsigned char* lds, int item) {
  const int tid = p.tid, lane = tid & 63, w = __builtin_amdgcn_readfirstlane(tid >> 6), r16 = lane & 15, q4 = lane >> 4;
  const int bh = item >> 1, eh = item & 1, b = bh >> 2, h = bh & 3;
  const int et = eh * 4 + (w & 3);
  const bool comp = w < 4;
  const unsigned char* gA = (const unsigned char*)p.dnA + (size_t)bh * 64 * DN_ABYTES;
  const float* gU = p.dnU + (size_t)bh * 64 * DN_UFLOATS;
  const float* gG = p.dnG + bh * 64;
  auto issue_A = [&](int n, int buf) {
#pragma unroll
    for (int i = 0; i < 7; ++i) {
      const int f = w * 7 + i;
      __builtin_amdgcn_global_load_lds((const unsigned*)(gA + (size_t)n * DN_ABYTES + f * 1024 + lane * 16), (LAS unsigned*)(lds + (buf ? DS_A1 : DS_A0) + f * 1024), 16, 0, 0);
    }
  };
  __syncthreads();
  issue_A(0, 0);
  f32x4 Un[4];
#pragma unroll
  for (int rr = 0; rr < 4; ++rr) Un[rr] = *(const f32x4*)(gU + ((et * 4 + rr) * 64 + lane) * 4);
  f32x4 S[8];
#pragma unroll
  for (int dt = 0; dt < 8; ++dt) S[dt] = (f32x4){0.f, 0.f, 0.f, 0.f};
  asm volatile("s_waitcnt vmcnt(0)" ::: "memory");
  __syncthreads();
  bf16_t* obase = p.dn_out + ((size_t)b * SEQ) * p.dn_out_ld + h * 128 + 16 * et + r16;
#pragma unroll 1
  for (int n = 0; n < 64; ++n) {
    const LAS unsigned char* Ab = lds + ((n & 1) ? DS_A1 : DS_A0);
    if (n + 1 < 64) issue_A(n + 1, (n + 1) & 1);
    if (comp) {
      f32x4 Vn[4];
#pragma unroll
      for (int rr = 0; rr < 4; ++rr) Vn[rr] = Un[rr];
      if (n + 1 < 64) {
#pragma unroll
        for (int rr = 0; rr < 4; ++rr) Un[rr] = *(const f32x4*)(gU + (size_t)(n + 1) * DN_UFLOATS + ((et * 4 + rr) * 64 + lane) * 4);
      }
      const float gdec = gG[n];
      bf16x8 Sb[4];
#pragma unroll
      for (int ks = 0; ks < 4; ++ks) Sb[ks] = pack8(S[2 * ks][0], S[2 * ks][1], S[2 * ks][2], S[2 * ks][3], S[2 * ks + 1][0], S[2 * ks + 1][1], S[2 * ks + 1][2], S[2 * ks + 1][3]);
      f32x4 O[4];
#pragma unroll
      for (int rr = 0; rr < 4; ++rr) {
        O[rr] = (f32x4){0.f, 0.f, 0.f, 0.f};
#pragma unroll
        for (int ks = 0; ks < 4; ++ks) {
          const bf16x8 aw = *(const LAS bf16x8*)(Ab + (F_WN + rr * 4 + ks) * 1024 + lane * 16);
          Vn[rr] = MFMA16(aw, Sb[ks], Vn[rr]);
          const bf16x8 aq = *(const LAS bf16x8*)(Ab + (F_QD + rr * 4 + ks) * 1024 + lane * 16);
          O[rr] = MFMA16(aq, Sb[ks], O[rr]);
        }
      }
      bf16x8 Vb[2];
#pragma unroll
      for (int ks = 0; ks < 2; ++ks) Vb[ks] = pack8(Vn[2 * ks][0], Vn[2 * ks][1], Vn[2 * ks][2], Vn[2 * ks][3], Vn[2 * ks + 1][0], Vn[2 * ks + 1][1], Vn[2 * ks + 1][2], Vn[2 * ks + 1][3]);
#pragma unroll
      for (int rr = 0; rr < 4; ++rr)
#pragma unroll
        for (int ks = 0; ks < 2; ++ks) {
          const bf16x8 a = *(const LAS bf16x8*)(Ab + (F_QK + rr * 2 + ks) * 1024 + lane * 16);
          O[rr] = MFMA16(a, Vb[ks], O[rr]);
        }
#pragma unroll
      for (int rr = 0; rr < 4; ++rr)
#pragma unroll
        for (int i = 0; i < 4; ++i) obase[(size_t)(n * 64 + 16 * rr + 4 * q4 + i) * p.dn_out_ld] = f2bf_hw(O[rr][i]);
#pragma unroll
      for (int dt = 0; dt < 8; ++dt) {
        S[dt] *= gdec;
#pragma unroll
        for (int ks = 0; ks < 2; ++ks) {
          const bf16x8 a = *(const LAS bf16x8*)(Ab + (F_KT + dt * 2 + ks) * 1024 + lane * 16);
          S[dt] = MFMA16(a, Vb[ks], S[dt]);
        }
      }
    }
    asm volatile("s_waitcnt vmcnt(0)" ::: "memory");
    __syncthreads();
  }
}
__device__ void ph_dn_norm(const Params& p, int nblk, int bid) {
  const int wid = p.tid >> 6, lane = p.tid & 63;
  const f32x4 g0 = *(const f32x4*)(p.g_dn_out + (lane & 15) * 8), g1 = *(const f32x4*)(p.g_dn_out + (lane & 15) * 8 + 4);
  for (int t = bid * 8 + wid; t < T_TOK; t += nblk * 8) {
    bf16_t* op = p.oab + (size_t)t * DM + lane * 8;
    float o[8], z[8];
    unpack8(*(const u32x4*)op, o);
    unpack8(*(const u32x4*)(p.proj + (size_t)t * PW + C_Z + lane * 8), z);
    float ss = 0.f;
#pragma unroll
    for (int j = 0; j < 8; ++j) ss += o[j] * o[j];
    ss += __shfl_xor(ss, 1, 64); ss += __shfl_xor(ss, 2, 64); ss += __shfl_xor(ss, 4, 64); ss += __shfl_xor(ss, 8, 64);
    const float rstd = rsqrtf(ss * (1.f / 128.f) + 1e-6f);
    float y[8];
#pragma unroll
    for (int j = 0; j < 4; ++j) { y[j] = o[j] * rstd * g0[j] * siluf_(z[j]); y[4 + j] = o[4 + j] * rstd * g1[j] * siluf_(z[4 + j]); }
    u32x4 w; w.x = pk2(y[0], y[1]); w.y = pk2(y[2], y[3]); w.z = pk2(y[4], y[5]); w.w = pk2(y[6], y[7]);
    *(u32x4*)op = w;
  }
}
typedef float f32x16 __attribute__((ext_vector_type(16)));
#define MFMA32(a, b, c) __builtin_amdgcn_mfma_f32_32x32x16_bf16((a), (b), (c), 0, 0, 0)
#define MP_VL 0
#define MP_RED 65536
#define MP_TOTAL (65536 + 4096)

__device__ void moba_prep_block(const Params& p, LAS unsigned char* lds, int item) {
  const int tid = p.tid, lane = tid & 63, w = tid >> 6;
  const int bh = item >> 4, jb = item & 15, b = bh >> 2, h = bh & 3;
  LAS bf16_t* Vl = (LAS bf16_t*)(lds + MP_VL);
  LAS float* red = (LAS float*)(lds + MP_RED);
  __syncthreads();
#pragma unroll
  for (int it = 0; it < 8; ++it) {
    const int idx = tid + 512 * it, row = idx >> 4, ch = idx & 15;
    const u32x4 v = *(const u32x4*)(p.proj + ((size_t)b * SEQ + 256 * jb + row) * PW + C_MV + h * 128 + 8 * ch);
    *(LAS u32x4*)(Vl + row * 128 + 8 * ch) = v;
  }
  {
    const int r = tid >> 1, hh = tid & 1;
    const int pos = 256 * jb + r;
    const size_t t = (size_t)b * SEQ + pos;
    float cs[8], sn[8];
#pragma unroll
    for (int jj = 0; jj < 8; ++jj) {
      const float inv = exp2f(-(float)(8 * hh + jj) * (1.f / 16.f) * 18.931568569324174f);
      const float ang = (float)pos * inv;
      cs[jj] = cosf(ang); sn[jj] = sinf(ang);
    }
    float kacc[64];
#pragma unroll
    for (int which = 0; which < 2; ++which) {
      const bf16_t* src = p.proj + t * PW + (which ? C_MQ : C_MK) + h * 128 + 8 * hh;
      float x0[8], x1[8];
      unpack8(*(const u32x4*)(src), x0); unpack8(*(const u32x4*)(src + 16), x1);
      float y0[8], y1[8];
#pragma unroll
      for (int jj = 0; jj < 8; ++jj) { y0[jj] = x0[jj] * cs[jj] - x1[jj] * sn[jj]; y1[jj] = x1[jj] * cs[jj] + x0[jj] * sn[jj]; }
      u32x4 o[8];
      o[0].x = pk2(y0[0], y0[1]); o[0].y = pk2(y0[2], y0[3]); o[0].z = pk2(y0[4], y0[5]); o[0].w = pk2(y0[6], y0[7]);
      o[1].x = pk2(y1[0], y1[1]); o[1].y = pk2(y1[2], y1[3]); o[1].z = pk2(y1[4], y1[5]); o[1].w = pk2(y1[6], y1[7]);
#pragma unroll
      for (int ks = 2; ks < 8; ++ks) o[ks] = *(const u32x4*)(src + 16 * ks);
      if (which == 0) {
#pragma unroll
        for (int jj = 0; jj < 8; ++jj) { kacc[jj] = y0[jj]; kacc[8 + jj] = y1[jj]; }
#pragma unroll
        for (int ks = 2; ks < 8; ++ks) { float f[8]; unpack8(o[ks], f);
#pragma unroll
          for (int jj = 0; jj < 8; ++jj) kacc[8 * ks + jj] = f[jj]; }
        unsigned char* dst = (unsigned char*)p.Kp + ((size_t)(bh * 128 + 8 * jb + (r >> 5)) * 8192) + ((r & 31) + 32 * hh) * 16;
#pragma unroll
        for (int ks = 0; ks < 8; ++ks) *(u32x4*)(dst + ks * 1024) = o[ks];
      } else {
        bf16_t* dst = p.qb + ((size_t)bh * SEQ + pos) * 128 + 8 * hh;
#pragma unroll
        for (int ks = 0; ks < 8; ++ks) *(u32x4*)(dst + 16 * ks) = o[ks];
      }
    }
#pragma unroll
    for (int e = 0; e < 64; ++e) {
      float v = kacc[e];
      v += __shfl_xor(v, 2, 64); v += __shfl_xor(v, 4, 64); v += __shfl_xor(v, 8, 64); v += __shfl_xor(v, 16, 64); v += __shfl_xor(v, 32, 64);
      kacc[e] = v;
    }
    if (lane < 2) {
#pragma unroll
      for (int e = 0; e < 64; ++e) red[(w * 2 + lane) * 64 + e] = kacc[e];
    }
  }
  __syncthreads();
  if (tid < 128) {
    const int d = tid, hh = (d >> 3) & 1, ks = d >> 4, jj = d & 7;
    float a = 0.f;
#pragma unroll
    for (int ww = 0; ww < 8; ++ww) a += red[(ww * 2 + hh) * 64 + ks * 8 + jj];
    p.kmean[((size_t)bh * 16 + jb) * 128 + d] = a * (1.f / 256.f);
  }
#pragma unroll
  for (int it = 0; it < 8; ++it) {
    const int o = tid + 512 * it, ln = o & 63, frag = o >> 6, tl = frag >> 3, dt = (frag >> 1) & 3, s = frag & 1;
    const int r = ln & 31, hh = ln >> 5, d = 32 * dt + r;
    unsigned short e[8];
#pragma unroll
    for (int jj = 0; jj < 8; ++jj) { const int key = 32 * tl + 16 * s + 8 * (jj >> 2) + 4 * hh + (jj & 3); e[jj] = Vl[key * 128 + d]; }
    u32x4 wv; wv.x = e[0] | ((unsigned)e[1] << 16); wv.y = e[2] | ((unsigned)e[3] << 16); wv.z = e[4] | ((unsigned)e[5] << 16); wv.w = e[6] | ((unsigned)e[7] << 16);
    *(u32x4*)((unsigned char*)p.Vp + ((size_t)(bh * 128 + 8 * jb + tl) * 8192) + (dt * 2 + s) * 1024 + ln * 16) = wv;
  }
}
__device__ __forceinline__ int crow32(int reg, int hh) { return (reg & 3) + 8 * (reg >> 2) + 4 * hh; }
__device__ void moba_item(const Params& p, LAS float* km, int bh, int ib, int sub, int lane) {
  const int q = lane & 31, hh = lane >> 5;
  const int b = bh >> 2, h = bh & 3;
  const int s0 = 256 * ib + 32 * sub;
  const bf16_t* qrow = p.qb + ((size_t)bh * SEQ + s0 + q) * 128 + 8 * hh;
  bf16x8 Qf[8];
#pragma unroll
  for (int ks = 0; ks < 8; ++ks) Qf[ks] = *(const bf16x8*)(qrow + 16 * ks);
  LAS unsigned char* qlds = (LAS unsigned char*)km + 8192 + lane * 16;
#pragma unroll
  for (int ks = 0; ks < 8; ++ks) *(LAS bf16x8*)(qlds + ks * 1024) = Qf[ks];
  unsigned selmask = 0;
  if (ib > 0) {
    for (int idx = lane; idx < ib * 32; idx += 64) ((LAS f32x4*)km)[idx] = ((const f32x4*)(p.kmean + (size_t)bh * 16 * 128))[idx];
    float qf[64];
#pragma unroll
    for (int ks = 0; ks < 8; ++ks) { float f[8]; unpack8(__builtin_bit_cast(u32x4, Qf[ks]), f);
#pragma unroll
      for (int jj = 0; jj < 8; ++jj) qf[8 * ks + jj] = f[jj]; }
    float sc[16];
#pragma unroll
    for (int j = 0; j < 16; ++j) {
      sc[j] = -INFINITY;
      if (j < ib) {
        float a = 0.f;
#pragma unroll
        for (int ks = 0; ks < 8; ++ks) {
          const f32x4 k0 = *(const LAS f32x4*)(km + j * 128 + 16 * ks + 8 * hh), k1 = *(const LAS f32x4*)(km + j * 128 + 16 * ks + 8 * hh + 4);
          a += qf[8 * ks] * k0[0] + qf[8 * ks + 1] * k0[1] + qf[8 * ks + 2] * k0[2] + qf[8 * ks + 3] * k0[3];
          a += qf[8 * ks + 4] * k1[0] + qf[8 * ks + 5] * k1[1] + qf[8 * ks + 6] * k1[2] + qf[8 * ks + 7] * k1[3];
        }
        a += __shfl_xor(a, 32, 64);
        sc[j] = a;
      }
    }
#pragma unroll
    for (int r = 0; r < 3; ++r) {
      if (r < ib) {
        float best = -INFINITY; int bi = 0;
#pragma unroll
        for (int j = 0; j < 16; ++j) if (sc[j] > best) { best = sc[j]; bi = j; }
        selmask |= 1u << bi;
#pragma unroll
        for (int j = 0; j < 16; ++j) if (j == bi) sc[j] = -INFINITY;
      }
    }
  }
  unsigned rem = 0;
  for (int j = 0; j < ib; ++j) if (__ballot((selmask >> j) & 1u) != 0ull) rem |= 1u << j;
  rem = __builtin_amdgcn_readfirstlane(rem);
  const int own0 = 8 * ib, diag = 8 * ib + sub;
  const float cscale = 0.08838834764831845f * 1.4426950408889634f;
  float m = -1e30f, l = 0.f;
  f32x16 O[4];
#pragma unroll
  for (int dt = 0; dt < 4; ++dt)
#pragma unroll
    for (int r = 0; r < 16; ++r) O[dt][r] = 0.f;
  const unsigned char* kbase = (const unsigned char*)p.Kp + (size_t)bh * 128 * 8192 + lane * 16;
  const unsigned char* vbase = (const unsigned char*)p.Vp + (size_t)bh * 128 * 8192 + lane * 16;
  int kt = own0;
  LAS unsigned char* kl = (LAS unsigned char*)km;
  auto issue_K = [&](int t) {
#pragma unroll
    for (int ks = 0; ks < 8; ++ks) __builtin_amdgcn_global_load_lds((const unsigned*)(kbase + (size_t)t * 8192 + ks * 1024), (LAS unsigned*)(kl + ks * 1024), 16, 0, 0);
  };
  asm volatile("s_waitcnt lgkmcnt(0)" ::: "memory");
  issue_K(kt);
#pragma unroll 1
  for (;;) {
    int ktn;
    if (kt >= own0 ? (kt < diag) : ((kt & 7) != 7)) ktn = kt + 1;
    else if (rem == 0u) ktn = -1;
    else { ktn = 8 * (__builtin_ctz(rem)); rem &= rem - 1u; }
    asm volatile("s_waitcnt vmcnt(0)" ::: "memory");
    bf16x8 Kc[8], Vf[8];
#pragma unroll
    for (int ks = 0; ks < 8; ++ks) Kc[ks] = *(const LAS bf16x8*)(kl + lane * 16 + ks * 1024);
#pragma unroll
    for (int f = 0; f < 8; ++f) Vf[f] = *(const bf16x8*)(vbase + (size_t)kt * 8192 + f * 1024);
    asm volatile("s_waitcnt lgkmcnt(0)" ::: "memory");
    if (ktn >= 0) issue_K(ktn);
    f32x16 S;
#pragma unroll
    for (int r = 0; r < 16; ++r) S[r] = 0.f;
#pragma unroll
    for (int ks = 0; ks < 8; ++ks) S = MFMA32(Kc[ks], *(const LAS bf16x8*)(qlds + ks * 1024), S);
    const bool allowed = (kt >= own0) || ((selmask >> (kt >> 3)) & 1u);
    const float nb = allowed ? 0.f : -INFINITY;
    float sv[16]; float mx = -INFINITY;
#pragma unroll
    for (int r = 0; r < 16; ++r) sv[r] = __builtin_fmaf(S[r], cscale, nb);
    if (kt == diag) {
#pragma unroll
      for (int r = 0; r < 16; ++r) if (crow32(r, hh) > q) sv[r] = -INFINITY;
    }
#pragma unroll
    for (int r = 0; r < 16; ++r) mx = fmaxf(mx, sv[r]);
    mx = fmaxf(mx, __shfl_xor(mx, 32, 64));
    const float mn = fmaxf(m, mx);
    const float alpha = __builtin_amdgcn_exp2f(m - mn);
    float ps = 0.f;
#pragma unroll
    for (int r = 0; r < 16; ++r) { sv[r] = __builtin_amdgcn_exp2f(sv[r] - mn); ps += sv[r]; }
    l = l * alpha + ps; m = mn;
    if (__ballot(alpha != 1.f) != 0ull) {
#pragma unroll
      for (int dt = 0; dt < 4; ++dt)
#pragma unroll
        for (int r = 0; r < 16; ++r) O[dt][r] *= alpha;
    }
    const bf16x8 P0 = pack8(sv[0], sv[1], sv[2], sv[3], sv[4], sv[5], sv[6], sv[7]);
    const bf16x8 P1 = pack8(sv[8], sv[9], sv[10], sv[11], sv[12], sv[13], sv[14], sv[15]);
#pragma unroll
    for (int dt = 0; dt < 4; ++dt) { O[dt] = MFMA32(Vf[dt * 2], P0, O[dt]); O[dt] = MFMA32(Vf[dt * 2 + 1], P1, O[dt]); }
    if (ktn < 0) break;
    kt = ktn;
  }
  l += __shfl_xor(l, 32, 64);
  const float inv = 1.f / l;
  bf16_t* orow = p.mb_out + ((size_t)b * SEQ + s0 + q) * p.mb_out_ld + p.mb_out_off + h * 128;
#pragma unroll
  for (int dt = 0; dt < 4; ++dt)
#pragma unroll
    for (int g4 = 0; g4 < 4; ++g4) {
      u32x2 wv; wv.x = pk2(O[dt][4 * g4] * inv, O[dt][4 * g4 + 1] * inv); wv.y = pk2(O[dt][4 * g4 + 2] * inv, O[dt][4 * g4 + 3] * inv);
      *(u32x2*)(orow + 32 * dt + 8 * g4 + 4 * hh) = wv;
    }
}
__device__ void moba_worker(const Params& p, LAS unsigned char* lds, int qi) {
  const int lane = p.tid & 63, w = p.tid >> 6;
  LAS float* km = (LAS float*)(lds + w * 16384);
  for (;;) {
    int idx = 0;
    if (lane == 0) idx = atomicAdd(p.wq + qi, 1);
    idx = __builtin_amdgcn_readfirstlane(idx);
    if (idx >= 2048) break;
    const int ib = 15 - (idx >> 7), rem = idx & 127, bh = rem >> 3, sub = 7 - (rem & 7);
    moba_item(p, km, bh, ib, sub, lane);
  }
}
__device__ void ph_mod(const Params& p, LAS unsigned char* lds, int nblk, int bid) {
  LAS float* sc = (LAS float*)lds;
  LAS float* part = (LAS float*)(lds + 16384);
  const int tid = p.tid;
  if (bid >= 192) return;
  for (int i = tid; i < 4096; i += 512) sc[i] = siluf_(p.c[i]);
  __syncthreads();
  for (int task = bid; task < 192; task += nblk) {
    const int jj = tid & 31, ks = tid >> 5, j = task * 32 + jj;
    float a0 = 0.f, a1 = 0.f, a2 = 0.f, a3 = 0.f;
#pragma unroll 8
    for (int kk = 0; kk < 64; ++kk) {
      const int k = ks * 64 + kk;
      const float w = p.w_ada[(size_t)k * 6144 + j];
      a0 += sc[k] * w; a1 += sc[1024 + k] * w; a2 += sc[2048 + k] * w; a3 += sc[3072 + k] * w;
    }
    *(LAS f32x4*)(part + (ks * 32 + jj) * 4) = (f32x4){a0, a1, a2, a3};
    __syncthreads();
    if (tid < 128) {
      const int j2 = tid & 31, bb = tid >> 5;
      float a = 0.f;
#pragma unroll
      for (int s = 0; s < 16; ++s) a += part[(s * 32 + j2) * 4 + bb];
      p.mod[bb * 6144 + task * 32 + j2] = a + p.b_ada[task * 32 + j2];
    }
    __syncthreads();
  }
}

__device__ __forceinline__ void wt_tile(const float* __restrict__ src, bf16_t* __restrict__ dst, int K, int N, int mode, int k0, int n0, LAS float* tile, const int tid) {
#pragma unroll
  for (int it = 0; it < 2; ++it) {
    const int row = (tid >> 4) + 32 * it, c4 = (tid & 15) * 4, n = n0 + c4;
    f32x4 v = {0.f, 0.f, 0.f, 0.f};
    if (n < N) v = *(const f32x4*)(src + (size_t)(k0 + row) * N + n);
    tile[row * 65 + c4] = v[0]; tile[row * 65 + c4 + 1] = v[1]; tile[row * 65 + c4 + 2] = v[2]; tile[row * 65 + c4 + 3] = v[3];
  }
  __syncthreads();
  {
    const int nl = tid >> 3, kc = tid & 7, n = n0 + nl;
    if (n < N) {
      const int d = map_col(n, mode);
      if (d >= 0) {
        float f[8];
#pragma unroll
        for (int j = 0; j < 8; ++j) f[j] = tile[(8 * kc + j) * 65 + nl];
        u32x4 w; w.x = pk2(f[0], f[1]); w.y = pk2(f[2], f[3]); w.z = pk2(f[4], f[5]); w.w = pk2(f[6], f[7]);
        *(u32x4*)(dst + (size_t)d * K + k0 + 8 * kc) = w;
      }
    }
  }
  __syncthreads();
}
#define WT_T0 1424
#define WT_T1 (WT_T0 + 16384)
#define WT_T2 (WT_T1 + 8192)
#define WT_T3 (WT_T2 + 128)
#define WT_T4 (WT_T3 + 128)
#define WT_T5 (WT_T4 + 256)
__device__ void ph_wt(const Params& p, LAS unsigned char* lds, int nblk, int bid) {
  LAS float* tile = (LAS float*)(lds + 32768);
  for (int t = bid; t < WT_T5; t += nblk) {
    if (t < WT_T0) { const int kt = t / 89, nt = t % 89; wt_tile(p.w_in, p.w_in_t, 1024, INW, 1, kt * 64, nt * 64, tile, p.tid); }
    else if (t < WT_T1) { const int u = t - WT_T0, e = u >> 9, r = u & 511, kt = r >> 5, nt = r & 31;
      wt_tile(p.w_gu + (size_t)e * 1024 * 2048, p.wgu_t + (size_t)e * 2048 * 1024, 1024, 2048, 2, kt * 64, nt * 64, tile, p.tid); }
    else if (t < WT_T2) { const int u = t - WT_T1, e = u >> 8, r = u & 255, kt = r >> 4, nt = r & 15;
      wt_tile(p.w_down + (size_t)e * 1024 * 1024, p.wd_t + (size_t)e * 1024 * 1024, 1024, 1024, 0, kt * 64, nt * 64, tile, p.tid); }
    else if (t < WT_T3) { const int u = t - WT_T2, kt = u >> 4, nt = u & 15; wt_tile(p.w_br_a, p.wbra_t, 512, 1024, 0, kt * 64, nt * 64, tile, p.tid); }
    else if (t < WT_T4) { const int u = t - WT_T3, kt = u >> 4, nt = u & 15; wt_tile(p.w_br_b, p.wbrb_t, 512, 1024, 0, kt * 64, nt * 64, tile, p.tid); }
    else { const int u = t - WT_T4, kt = u >> 4, nt = u & 15; wt_tile(p.w_o, p.wo_t, 1024, 1024, 0, kt * 64, nt * 64, tile, p.tid); }
  }
}

__device__ void ph_h(const Params& p, int nblk, int bid) {
  const int wid = p.tid >> 6, lane = p.tid & 63;
  for (int t = bid * 8 + wid; t < T_TOK; t += nblk * 8) {
    const int b = t / SEQ;
    const float* xr = p.x + (size_t)t * DM;
    float v[16];
    float ss = 0.f;
#pragma unroll
    for (int i = 0; i < 4; ++i) {
      const f32x4 q = *(const f32x4*)(xr + i * 256 + lane * 4);
      v[i * 4 + 0] = q[0]; v[i * 4 + 1] = q[1]; v[i * 4 + 2] = q[2]; v[i * 4 + 3] = q[3];
      ss += q[0] * q[0] + q[1] * q[1] + q[2] * q[2] + q[3] * q[3];
    }
    ss = wave_sum(ss);
    const float rstd = rsqrtf(ss * (1.f / DM) + 1e-6f);
    const float* shift = p.mod + b * 6144;
    const float* scale = p.mod + b * 6144 + 1024;
    float acc[8] = {0, 0, 0, 0, 0, 0, 0, 0};
#pragma unroll
    for (int i = 0; i < 4; ++i) {
      float hv[4];
#pragma unroll
      for (int j = 0; j < 4; ++j) {
        const int k = i * 256 + lane * 4 + j;
        hv[j] = v[i * 4 + j] * rstd * p.g_pre_mix[k] * (1.f + scale[k]) + shift[k];
        const float* wr = p.w_in + (size_t)k * INW + 2048;
        const f32x4 w0 = *(const f32x4*)wr, w1 = *(const f32x4*)(wr + 4);
        acc[0] += hv[j] * w0[0]; acc[1] += hv[j] * w0[1]; acc[2] += hv[j] * w0[2]; acc[3] += hv[j] * w0[3];
        acc[4] += hv[j] * w1[0]; acc[5] += hv[j] * w1[1]; acc[6] += hv[j] * w1[2]; acc[7] += hv[j] * w1[3];
      }
      u32x2 pk; pk.x = pk2(hv[0], hv[1]); pk.y = pk2(hv[2], hv[3]);
      *(u32x2*)(p.hbf + (size_t)t * DM + i * 256 + lane * 4) = pk;
    }
#pragma unroll
    for (int e = 0; e < 8; ++e) acc[e] = wave_sum(acc[e]);
    if (lane == 0) { *(f32x4*)(p.ba + (size_t)t * 8) = (f32x4){acc[0], acc[1], acc[2], acc[3]}; *(f32x4*)(p.ba + (size_t)t * 8 + 4) = (f32x4){acc[4], acc[5], acc[6], acc[7]}; }
  }
}

__device__ void ph_post_mix(const Params& p, LAS unsigned char* lds, int nblk, int bid, int rep) {
  const int wid = p.tid >> 6, lane = p.tid & 63;
  LAS bf16_t* wl = (LAS bf16_t*)lds;
  LAS float* sh = (LAS float*)(lds + 81920) + wid * 1024;
  for (int i = p.tid; i < 1024 * 8; i += 512) {
    const int k = i >> 3, c = i & 7;
    const f32x4 v = *(const f32x4*)(p.w_router + (size_t)k * 32 + c * 4);
    u32x2 w2; w2.x = pk2(v[0], v[1]); w2.y = pk2(v[2], v[3]);
    *(LAS u32x2*)(wl + k * 40 + c * 4) = w2;
  }
  __syncthreads();
  for (int t = bid * 8 + wid; t < T_TOK; t += nblk * 8) {
    const int b = t / SEQ;
    const float* md = p.mod + b * 6144;
    float mv[16];
    float ss = 0.f;
#pragma unroll
    for (int i = 0; i < 2; ++i) {
      float f[8]; unpack8(*(const u32x4*)(p.mixer + (size_t)t * DM + i * 512 + lane * 8), f);
#pragma unroll
      for (int j = 0; j < 8; ++j) { mv[i * 8 + j] = f[j]; ss += f[j] * f[j]; }
    }
    ss = wave_sum(ss);
    const float rstd = rsqrtf(ss * (1.f / DM) + 1e-6f);
    float x1[16];
    float s2 = 0.f;
#pragma unroll
    for (int i = 0; i < 2; ++i)
#pragma unroll
      for (int j4 = 0; j4 < 2; ++j4) {
        const int k = i * 512 + lane * 8 + j4 * 4;
        const f32x4 xv = *(const f32x4*)(p.x + (size_t)t * DM + k);
        const f32x4 gm = *(const f32x4*)(md + 2048 + k), gp = *(const f32x4*)(p.g_post_mix + k);
        f32x4 o;
#pragma unroll
        for (int j = 0; j < 4; ++j) { o[j] = xv[j] + gm[j] * (mv[i * 8 + j4 * 4 + j] * rstd * gp[j]); x1[i * 8 + j4 * 4 + j] = o[j]; s2 += o[j] * o[j]; }
        *(f32x4*)(p.out + (size_t)t * DM + k) = o;
      }
    s2 = wave_sum(s2);
    const float rstd2 = rsqrtf(s2 * (1.f / DM) + 1e-6f);
#pragma unroll
    for (int i = 0; i < 2; ++i) {
      float hv[8];
#pragma unroll
      for (int j = 0; j < 8; ++j) {
        const int k = i * 512 + lane * 8 + j;
        hv[j] = x1[i * 8 + j] * rstd2 * p.g_pre_ffn[k] * (1.f + md[4096 + k]) + md[3072 + k];
        sh[k] = hv[j];
      }
      u32x4 w; w.x = pk2(hv[0], hv[1]); w.y = pk2(hv[2], hv[3]); w.z = pk2(hv[4], hv[5]); w.w = pk2(hv[6], hv[7]);
      *(u32x4*)(p.h2 + (size_t)t * DM + i * 512 + lane * 8) = w;
    }
#ifdef PM_SKIP
    if (rep) continue;
#endif
    float acc[32];
#pragma unroll
    for (int e2 = 0; e2 < 32; ++e2) acc[e2] = 0.f;
#pragma unroll 4
    for (int i = 0; i < 16; ++i) {
      const float hk = sh[lane + 64 * i];
      const LAS u32x4* wr = (const LAS u32x4*)(wl + (lane + 64 * i) * 40);
#pragma unroll
      for (int c4 = 0; c4 < 4; ++c4) {
        float f[8]; unpack8(wr[c4], f);
#pragma unroll
        for (int j = 0; j < 8; ++j) acc[c4 * 8 + j] += hk * f[j];
      }
    }
    {
      const bool u5 = lane & 32, u4 = lane & 16, u3 = lane & 8, u2 = lane & 4, u1 = lane & 2;
      float a16[16], a8[8], a4[4], a2[2];
#pragma unroll
      for (int j = 0; j < 16; ++j) { const float snd = u5 ? acc[j] : acc[16 + j]; const float rcv = __shfl_xor(snd, 32, 64); a16[j] = (u5 ? acc[16 + j] : acc[j]) + rcv; }
#pragma unroll
      for (int j = 0; j < 8; ++j) { const float snd = u4 ? a16[j] : a16[8 + j]; const float rcv = __shfl_xor(snd, 16, 64); a8[j] = (u4 ? a16[8 + j] : a16[j]) + rcv; }
#pragma unroll
      for (int j = 0; j < 4; ++j) { const float snd = u3 ? a8[j] : a8[4 + j]; const float rcv = __shfl_xor(snd, 8, 64); a4[j] = (u3 ? a8[4 + j] : a8[j]) + rcv; }
#pragma unroll
      for (int j = 0; j < 2; ++j) { const float snd = u2 ? a4[j] : a4[2 + j]; const float rcv = __shfl_xor(snd, 4, 64); a2[j] = (u2 ? a4[2 + j] : a4[j]) + rcv; }
      const float snd = u1 ? a2[0] : a2[1]; const float rcv = __shfl_xor(snd, 2, 64);
      float a1 = (u1 ? a2[1] : a2[0]) + rcv;
      a1 += __shfl_xor(a1, 1, 64);
      acc[0] = a1;
    }
    const int e = lane >> 1;
    float lg = acc[0] + p.b_router[e];
    if (lane & 1) lg = -INFINITY;
    float tv[4]; int ti[4];
#pragma unroll
    for (int r = 0; r < 4; ++r) {
      const float m = wave_max(lg);
      const unsigned long long bal = __ballot(lg == m);
      const int idx = __ffsll((long long)bal) - 1;
      tv[r] = m; ti[r] = idx >> 1;
      if (lane == idx) lg = -INFINITY;
    }
    const float e1 = __expf(tv[1] - tv[0]), e2 = __expf(tv[2] - tv[0]), e3 = __expf(tv[3] - tv[0]);
    const float inv = 1.f / (1.f + e1 + e2 + e3);
    if (lane < 4) {
      const int ee = lane == 0 ? ti[0] : lane == 1 ? ti[1] : lane == 2 ? ti[2] : ti[3];
      const float ww = (lane == 0 ? 1.f : lane == 1 ? e1 : lane == 2 ? e2 : e3) * inv;
      const int pos = atomicAdd(&p.cnt[ee + 64 * rep], 1);
      p.elist[ee * T_TOK + pos] = t * 4 + lane;
      p.aw[t * 4 + lane] = ww;
    }
  }
}

__device__ void ph_gather(const Params& p, LAS unsigned char* lds, int nblk, int bid) {
  const int wid = p.tid >> 6, lane = p.tid & 63;
  LAS int* tb = (LAS int*)lds;
  if (p.tid == 0) { int off = 0; for (int k = 0; k < NE; ++k) { const int c = p.cnt[k]; tb[k] = off; tb[64 + k] = c; off += ((c + 255) >> 8) << 8; } tb[NE] = off; }
  __syncthreads();
  const int total = tb[NE];
  for (int r = bid * 8 + wid; r < total; r += nblk * 8) {
    int e = 0;
#pragma unroll 1
    for (int k = 1; k < NE; ++k) if (r >= tb[k]) e = k;
    const int i = r - tb[e];
    const int a = (i < tb[64 + e]) ? p.elist[e * T_TOK + i] : -1;
    if (lane == 0) p.rowmap[r] = a;
    u32x4 v0 = {0, 0, 0, 0}, v1 = v0;
    if (a >= 0) { const u32x4* src = (const u32x4*)(p.h2 + (size_t)(a >> 2) * DM); v0 = src[lane]; v1 = src[64 + lane]; }
    u32x4* dst = (u32x4*)(p.xs + (size_t)r * DM);
    dst[lane] = v0; dst[64 + lane] = v1;
  }
}

__device__ void ph_final(const Params& p, int nblk, int bid, int rep) {
  const int wid = p.tid >> 6, lane = p.tid & 63;
  for (int t = bid * 8 + wid; t < T_TOK; t += nblk * 8) {
    const int b = t / SEQ;
    const float* md = p.mod + b * 6144;
    const f32x4 wv = *(const f32x4*)(p.aw + t * 4);
    float mv[16];
    float ss = 0.f;
#pragma unroll
    for (int i = 0; i < 2; ++i) {
      const bf16_t* y = p.yslot + (size_t)t * 4 * DM + i * 512 + lane * 8;
      float f0[8], f1[8], f2[8], f3[8];
      unpack8(*(const u32x4*)y, f0); unpack8(*(const u32x4*)(y + DM), f1); unpack8(*(const u32x4*)(y + 2 * DM), f2); unpack8(*(const u32x4*)(y + 3 * DM), f3);
#pragma unroll
      for (int j = 0; j < 8; ++j) { const float m = wv[0] * f0[j] + wv[1] * f1[j] + wv[2] * f2[j] + wv[3] * f3[j]; mv[i * 8 + j] = m; ss += m * m; }
    }
    ss = wave_sum(ss);
    const float rstd = rsqrtf(ss * (1.f / DM) + 1e-6f);
#pragma unroll
    for (int i = 0; i < 2; ++i)
#pragma unroll
      for (int j4 = 0; j4 < 2; ++j4) {
        const int k = i * 512 + lane * 8 + j4 * 4;
        float* op = p.out + (size_t)t * DM + k;
        const f32x4 x1 = *(const f32x4*)op, gf = *(const f32x4*)(md + 5120 + k), gp = *(const f32x4*)(p.g_post_ffn + k);
        f32x4 o;
#pragma unroll
        for (int j = 0; j < 4; ++j) o[j] = x1[j] + gf[j] * (mv[i * 8 + j4 * 4 + j] * rstd * gp[j]);
        *(f32x4*)(rep ? (float*)p.hbf + (size_t)(t & 8191) * DM + k : op) = o;
      }
  }
}

#define XCD_BAR_WORDS 3456
struct KArgs { const void* in[22]; float* out; char* ws; long long never; };
__host__ __device__ inline size_t al(size_t x) { return (x + 255) & ~(size_t)255; }
__host__ __device__ inline void fill_params(Params& p, const KArgs& k) {
  p.x = (const float*)k.in[0]; p.c = (const float*)k.in[1]; p.w_ada = (const float*)k.in[2]; p.b_ada = (const float*)k.in[3];
  p.g_pre_mix = (const float*)k.in[4]; p.g_post_mix = (const float*)k.in[5]; p.g_pre_ffn = (const float*)k.in[6];
  p.g_post_ffn = (const float*)k.in[7]; p.w_in = (const float*)k.in[8]; p.conv_w = (const float*)k.in[9];
  p.a_log = (const float*)k.in[10]; p.dt_bias = (const float*)k.in[11]; p.g_dn_out = (const float*)k.in[12];
  p.w_br_a = (const float*)k.in[13]; p.w_br_b = (const float*)k.in[14]; p.w_o = (const float*)k.in[15];
  p.w_router = (const float*)k.in[16]; p.b_router = (const float*)k.in[17]; p.w_gu = (const float*)k.in[18];
  p.b_gu = (const float*)k.in[19]; p.w_down = (const float*)k.in[20]; p.b_down = (const float*)k.in[21];
  p.out = k.out;
  char* w = k.ws;
  size_t o = 0;
#define take(bytes) (w + (o += al(bytes)) - al(bytes))
  p.mod = (float*)take(4 * 6144 * 4);
  p.cnt = (int*)take(1024);
  p.ba = (float*)take((size_t)T_TOK * 8 * 4);
  p.hbf = (bf16_t*)take((size_t)T_TOK * DM * 2);
  p.proj = (bf16_t*)take((size_t)T_TOK * PW * 2);
  p.w_in_t = (bf16_t*)take((size_t)PW * DM * 2);
  p.wgu_t = (bf16_t*)take((size_t)NE * 2048 * DM * 2);
  p.wd_t = (bf16_t*)take((size_t)NE * 1024 * DM * 2);
  p.wbra_t = (bf16_t*)take((size_t)1024 * 512 * 2);
  p.wbrb_t = (bf16_t*)take((size_t)1024 * 512 * 2);
  p.wo_t = (bf16_t*)take((size_t)1024 * 1024 * 2);
  p.qb = (bf16_t*)take((size_t)T_TOK * 512 * 2);
  p.kb = (bf16_t*)take((size_t)T_TOK * 512 * 2);
  p.kmean = (float*)take((size_t)16 * 16 * 128 * 4);
  p.oab = (bf16_t*)take((size_t)T_TOK * DM * 2);
  p.merged = (bf16_t*)take((size_t)T_TOK * DM * 2);
  p.mixer = (bf16_t*)take((size_t)T_TOK * DM * 2);
  p.h2 = (bf16_t*)take((size_t)T_TOK * DM * 2);
  p.elist = (int*)take((size_t)NE * T_TOK * 4);
  p.aw = (float*)take((size_t)T_TOK * 4 * 4);
  p.rowmap = (int*)take((size_t)73728 * 4);
  p.dnA = (unsigned char*)take((size_t)1024 * DN_ABYTES);
  p.dnU = (float*)take((size_t)1024 * DN_UFLOATS * 4);
  p.dnG = (float*)take(4096);
  p.oab2 = (bf16_t*)take((size_t)T_TOK * 512 * 2);
  p.dbg = (float*)take(256);
  p.bar = (unsigned*)take(XCD_BAR_WORDS * 4);
  p.dn_out = p.oab; p.dn_out_ld = DM;
  p.Kp = (bf16_t*)take((size_t)16 * 128 * 8192);
  p.Vp = (bf16_t*)take((size_t)16 * 128 * 8192);
  p.wq = p.cnt + 192;
  p.mb_out = p.oab; p.mb_out_ld = DM; p.mb_out_off = 512;
  p.xs = p.proj;
  char* big = take((size_t)73728 * DM * 2 + (size_t)65536 * DM * 2);
  p.act = (bf16_t*)big;
  p.yslot = (bf16_t*)(big + (size_t)73728 * DM * 2);
  {
    char* s = big; size_t so = 0;
#define t2(bytes) (s + (so += al(bytes)) - al(bytes))
    p.nq = (float*)t2((size_t)T_TOK * 512 * 4);
    p.nk = (float*)t2((size_t)T_TOK * 512 * 4);
    p.nv = (float*)t2((size_t)T_TOK * 512 * 4);
    p.no = (float*)t2((size_t)T_TOK * 512 * 4);
    p.ntmp = (float*)t2((size_t)T_TOK * DM * 4);
    p.nbeta = (float*)t2((size_t)T_TOK * 4 * 4);
    p.ng = (float*)t2((size_t)T_TOK * 4 * 4);
  }

#undef take
#undef t2
  p.never = (int)k.never;
}

#define XB_TMO      128
#define XB_XCNT(j)  (256  + 64 * (j))
#define XB_XSUB(j)  (1280 + 64 * (j))
#define XB_XGEN(j)  (2304 + 64 * (j))
#define XB_TOP      3328
#define XB_TOPGEN   3392
#define XB_SPIN_CAP (1u << 18)

__device__ __forceinline__ unsigned xb_ld(unsigned* p)              { return __hip_atomic_load(p, __ATOMIC_RELAXED, __HIP_MEMORY_SCOPE_AGENT); }
__device__ __forceinline__ unsigned xb_add(unsigned* p, unsigned v) { return __hip_atomic_fetch_add(p, v, __ATOMIC_RELAXED, __HIP_MEMORY_SCOPE_AGENT); }
__device__ __forceinline__ unsigned xb_xcc_id() { return (unsigned)__builtin_amdgcn_s_getreg((3 << 11) | 20) & 0xFu; }
#define XB_SPIN(cond, bar) do { unsigned _sp = 0; while (cond) { __builtin_amdgcn_s_sleep(1); \
    if ((++_sp & 255u) == 0u) { if (xb_ld(&(bar)[XB_TMO])) break; if (_sp > XB_SPIN_CAP) { atomicAdd(&(bar)[XB_TMO], 1u); break; } } } } while (0)

struct XcdBarrier {
    unsigned* bar; unsigned x;
    volatile LAS unsigned* st;
};

__device__ __forceinline__ XcdBarrier xcd_barrier_post(unsigned* bar, volatile LAS unsigned* st) {
    XcdBarrier b; b.bar = bar; b.x = xb_xcc_id(); b.st = st;
    if (threadIdx.x == 0) (void)xb_add(&bar[XB_XCNT(b.x)], 1u);
    return b;
}
__device__ __forceinline__ void xcd_barrier_complete(unsigned* bar, unsigned x, unsigned& nloc, unsigned& nx) {
    const unsigned G = gridDim.x * gridDim.y * gridDim.z;
    unsigned sum, cnt, mine, sp = 0u;
    for (;;) {
        sum = 0u; cnt = 0u; mine = 0u;
#pragma unroll
        for (unsigned j = 0; j < 16; ++j) { const unsigned c = xb_ld(&bar[XB_XCNT(j)]); sum += c; cnt += (c > 0u) ? 1u : 0u; mine = (j == x) ? c : mine; }
        if (sum == G) break;
        __builtin_amdgcn_s_sleep(1);
        if ((++sp & 255u) == 0u) { if (xb_ld(&bar[XB_TMO])) break; if (sp > XB_SPIN_CAP) { atomicAdd(&bar[XB_TMO], 1u); break; } }
    }
    nloc = mine > 0u ? mine : 1u; nx = cnt > 0u ? cnt : 1u;
}

__device__ __forceinline__ void xcd_barrier(const XcdBarrier& b, const int tid) {
    asm volatile("s_waitcnt vmcnt(0)" ::: "memory");
    __syncthreads();
    if (tid == 0) {
        unsigned* bar = b.bar;
        __builtin_amdgcn_s_waitcnt(0);
        unsigned nloc = b.st[0], nx = b.st[1];
        if (nloc == 0u) { xcd_barrier_complete(bar, b.x, nloc, nx); b.st[0] = nloc; b.st[1] = nx; }
        const unsigned old = xb_add(&bar[XB_XSUB(b.x)], 1u);
        const unsigned gen = old / nloc;
        if (old + 1u == (gen + 1u) * nloc) {
            __builtin_amdgcn_fence(__ATOMIC_RELEASE, "agent");
            asm volatile("s_waitcnt vmcnt(0)" ::: "memory");
            const unsigned og = xb_add(&bar[XB_TOP], 1u);
            const unsigned tg = og / nx;
            if (og + 1u == (tg + 1u) * nx) xb_add(&bar[XB_TOPGEN], 1u);
            else XB_SPIN(xb_ld(&bar[XB_TOPGEN]) == tg, bar);
            __builtin_amdgcn_fence(__ATOMIC_ACQUIRE, "agent");
            xb_add(&bar[XB_XGEN(b.x)], 1u);
            asm volatile("s_waitcnt vmcnt(0)" ::: "memory");
        } else {
            XB_SPIN(xb_ld(&bar[XB_XGEN(b.x)]) == gen, bar);
            __builtin_amdgcn_fence(__ATOMIC_ACQUIRE, "agent");
            asm volatile("s_waitcnt vmcnt(0)" ::: "memory");
        }
    }
    __syncthreads();
}


__device__ __forceinline__ void load_ka(KArgs& kk) {
#if defined(__HIP_DEVICE_COMPILE__)
  typedef __attribute__((address_space(1))) char* gptr_t;
  typedef const __attribute__((address_space(4))) gptr_t* kptr_t;
  kptr_t kp = (kptr_t)__builtin_amdgcn_kernarg_segment_ptr();
  asm volatile("" : "+s"(kp));
#pragma unroll
  for (int i = 0; i < 22; ++i) kk.in[i] = (const void*)kp[i];
  kk.out = (float*)kp[22];
  kk.ws = (char*)kp[23];
  kk.never = ((const __attribute__((address_space(4))) long long*)kp)[24];
#endif
}
__device__ __forceinline__ void grid_bar(const Params& p, LAS unsigned char* lds);
#define MEGA_LDS 148480
#define MEGA_LDS_ALLOC (MEGA_LDS + 16)
__device__ __forceinline__ void grid_bar(const Params& p, LAS unsigned char* lds) {
  XcdBarrier b; b.bar = p.bar; b.x = xb_xcc_id(); b.st = (volatile LAS unsigned*)(lds + MEGA_LDS);
  xcd_barrier(b, p.tid);
}
__global__ __launch_bounds__(512) void mega(KArgs ka) {
  extern __shared__ __attribute__((aligned(16))) unsigned char shm[];
  LAS unsigned char* lds = (LAS unsigned char*)shm;
  cg::grid_group grid = cg::this_grid();
  const int nblk = gridDim.x, bid = blockIdx.x;
  volatile LAS unsigned* xst = (volatile LAS unsigned*)(lds + MEGA_LDS);
  if (threadIdx.x == 0) { xst[0] = 0u; xst[1] = 0u; xst[2] = 0u; xst[3] = 0u; }
  __syncthreads();
  { Params p0; fill_params(p0, ka); (void)xcd_barrier_post(p0.bar, xst); }
  if (ka.never) grid.sync();
#ifndef REPMASK
#define REPMASK 0
#endif
#define LOADKA KArgs kk; load_ka(kk)
#ifndef PHMASK
#define PHMASK 0xffff
#endif
#define PHASE(k, body) if (((PHMASK) >> (k)) & 1) for (int rep_ = 0; rep_ < (((REPMASK) >> (k)) & 1) + 1; ++rep_) { \
    LOADKA; Params p; fill_params(p, kk); { int t_ = threadIdx.x; asm volatile("" : "+v"(t_)); p.tid = t_; } body; grid_bar(p, lds); }
#ifdef XBAR
  for (int xb_ = 0; xb_ < XBAR; ++xb_) { PHASE(15, {}) }
#endif
  PHASE(0, { ph_mod(p, lds, nblk, bid); ph_wt(p, lds, nblk, bid); })
  PHASE(1, { ph_h(p, nblk, bid); })
  PHASE(2, { ph_proj(p, lds, nblk, bid); })
  PHASE(3, { bool first = true; for (int ci = bid; ci < 1024; ci += nblk) { dn_prep_chunk(p, lds, ci, first); first = false; }
             for (int item = bid; item < 256; item += nblk) moba_prep_block(p, lds, item); })
  PHASE(4, { if (bid < 32) dn_scan_blk(p, lds, bid); moba_worker(p, lds, rep_); })
  PHASE(5, { ph_dn_norm(p, nblk, bid); })
  PHASE(6, { ph_br(p, lds, nblk, bid); })
  PHASE(7, { ph_mix(p, lds, nblk, bid); })
  PHASE(8, { ph_post_mix(p, lds, nblk, bid, rep_); })
  PHASE(9, { ph_gather(p, lds, nblk, bid); })
  PHASE(10, { ph_moe1(p, lds, nblk, bid); })
  PHASE(11, { ph_moe2(p, lds, nblk, bid); })
  PHASE(12, { ph_final(p, nblk, bid, rep_); })
}


extern "C" void kernel_launch(void* const* d_in, const int* in_sizes, int n_in, void* d_out, int out_size, void* d_ws,
                              size_t ws_size, hipStream_t stream) {
  KArgs ka{};
  for (int i = 0; i < 22; ++i) ka.in[i] = d_in[i];
  ka.out = (float*)d_out; ka.ws = (char*)d_ws; ka.never = 0;
  Params p{};
  fill_params(p, ka);
  static int grid_blocks = 0;
  if (!grid_blocks) {
    (void)hipFuncSetAttribute((const void*)mega, hipFuncAttributeMaxDynamicSharedMemorySize, MEGA_LDS_ALLOC);
    int dev = 0, cus = 0, per_cu = 0;
    (void)hipGetDevice(&dev);
    (void)hipDeviceGetAttribute(&cus, hipDeviceAttributeMultiprocessorCount, dev);
    (void)hipOccupancyMaxActiveBlocksPerMultiprocessor(&per_cu, mega, 512, MEGA_LDS_ALLOC);
    if (per_cu != 1) per_cu = 1;
    grid_blocks = cus * per_cu;
  }
  (void)hipMemsetAsync(p.cnt, 0, 1024, stream);
  (void)hipMemsetAsync(p.bar, 0, XCD_BAR_WORDS * 4, stream);
  void* args[] = {&ka};
  hipError_t e = hipLaunchCooperativeKernel((void*)mega, dim3(grid_blocks), dim3(512), args, MEGA_LDS_ALLOC, stream);
  if (e != hipSuccess) fprintf(stderr, "cooperative launch failed: %s (grid %d)\n", hipGetErrorString(e), grid_blocks);
}
```

```cpp
#include <hip/hip_runtime.h>
#include <hip/hip_cooperative_groups.h>
#include <cstdio>
namespace cg = cooperative_groups;
#include <stdint.h>

typedef unsigned short bf16_t;

#define T_TOK 16384
#define SEQ 4096
#define NB 4
#define DM 1024
#define INW 5640
#define PW 5632
#define C_QA 0
#define C_KA 512
#define C_VA 1024
#define C_Z 1536
#define C_MQ 2048
#define C_MK 2560
#define C_MV 3072
#define C_GA 3584
#define C_GB 4608
#define NE 32

__device__ __forceinline__ bf16_t f2bf(float f) {
  unsigned u = __float_as_uint(f);
  u += 0x7fffu + ((u >> 16) & 1u);
  return (bf16_t)(u >> 16);
}
__device__ __forceinline__ float bf2f(bf16_t h) { return __uint_as_float(((unsigned)h) << 16); }
__device__ __forceinline__ float sigmoidf_(float x) { return 1.f / (1.f + __expf(-x)); }
__device__ __forceinline__ float siluf_(float x) { return x / (1.f + __expf(-x)); }
__device__ __forceinline__ float wave_sum(float v) {
#pragma unroll
  for (int o = 32; o > 0; o >>= 1) v += __shfl_xor(v, o, 64);
  return v;
}
__device__ __forceinline__ float wave_max(float v) {
#pragma unroll
  for (int o = 32; o > 0; o >>= 1) v = fmaxf(v, __shfl_xor(v, o, 64));
  return v;
}

typedef __bf16 bf16x2_t __attribute__((ext_vector_type(2)));
typedef float f32x2_t __attribute__((ext_vector_type(2)));
__device__ __forceinline__ unsigned pk2(float a, float b) { f32x2_t v = {a, b}; bf16x2_t r = __builtin_convertvector(v, bf16x2_t); return __builtin_bit_cast(unsigned, r); }

struct Params {
  const float *x, *c, *w_ada, *b_ada, *g_pre_mix, *g_post_mix, *g_pre_ffn, *g_post_ffn, *w_in, *conv_w,
      *a_log, *dt_bias, *g_dn_out, *w_br_a, *w_br_b, *w_o, *w_router, *b_router, *w_gu, *b_gu, *w_down, *b_down;
  float* out;
  float* mod;
  int* cnt;
  float* ba;
  bf16_t* hbf;
  bf16_t* proj;
  bf16_t* w_in_t;
  bf16_t* wgu_t;
  bf16_t* wd_t;
  bf16_t* wbra_t;
  bf16_t* wbrb_t;
  bf16_t* wo_t;
  bf16_t* qb;
  bf16_t* kb;
  float* kmean;
  bf16_t* oab;
  bf16_t* merged;
  bf16_t* mixer;
  bf16_t* h2;
  int* elist;
  float* aw;
  bf16_t* act;
  bf16_t* xs;
  int* rowmap;
  bf16_t* yslot;
  unsigned char* dnA; float* dnU; float* dnG;
  bf16_t* dn_out; int dn_out_ld;
  bf16_t* oab2; float* dbg;
  unsigned* bar; int never; int tid;
  bf16_t* Kp; bf16_t* Vp; int* wq;
  bf16_t* mb_out; int mb_out_ld; int mb_out_off;
  float* nq; float* nk; float* nv;
  float* nbeta; float* ng;
  float* no;
  float* ntmp;
};

__device__ __forceinline__ int map_col(int n, int mode) {
  if (mode == 0) return n;
  if (mode == 1) return n < 2048 ? n : (n < 2056 ? -1 : n - 8);
  if (n < 1024) return (n >> 7) * 256 + (n & 127);
  int j = n - 1024;
  return (j >> 7) * 256 + 128 + (j & 127);
}
namespace pg8 {
#define PG8_LAS __attribute__((address_space(3)))
typedef short bf16x8 __attribute__((ext_vector_type(8)));
typedef float f32x4 __attribute__((ext_vector_type(4)));
typedef unsigned u32x4 __attribute__((ext_vector_type(4)));
constexpr int BM = 256, BK = 64, HALF = 128, HTB = HALF * BK * 2, STAGE_BYTES = 8 * HTB, NXCD = 8, WGM = 8;

__host__ __device__ __forceinline__ int lds_byte(int r, int c) { const int st = (r >> 4) * 2 + (c >> 5), rr = r & 15, cc = c & 31, ob = rr * 64 + cc * 2; return st * 1024 + (ob ^ (((ob >> 9) & 1) << 5)); }
__host__ __device__ __forceinline__ void stage_rc(int b, int& R, int& C) { const int st = b / 1024, sb = b % 1024, swz = sb ^ (((sb >> 9) & 1) << 5); R = (st >> 1) * 16 + swz / 64; C = (st & 1) * 32 + (swz % 64) / 2; }
__host__ __device__ __forceinline__ int perm32(int rho) { const int n = rho >> 4, i = rho & 15; return 8 * (i >> 2) + 4 * n + (i & 3); }

struct Unit { int pm, pn, z; };
__device__ __forceinline__ unsigned cvt_pk_bf16(float lo, float hi) { unsigned r; asm volatile("v_cvt_pk_bf16_f32 %0, %1, %2" : "=v"(r) : "v"(lo), "v"(hi)); return r; }

struct TileOrder {
    int nM, nN, nwg, G, c;
    __device__ void init(int nM_, int nN_, int G_, int c_) { nM = nM_; nN = nN_; nwg = nM * nN; G = G_; c = c_; }
    __device__ bool tile(int i, int& pm, int& pn) const {
        const long L = (long)i * G + c; if (L >= nwg) return false;
        int wgid = (int)L; { const int q = nwg / NXCD, r = nwg % NXCD, xcd = wgid % NXCD, off = wgid / NXCD; wgid = (xcd < r ? xcd * (q + 1) : r * (q + 1) + (xcd - r) * q) + off; }
        const int nig = WGM * nN, gid = wgid / nig, fm = gid * WGM, gsz = (nM - fm) < WGM ? (nM - fm) : WGM;
        pm = fm + ((wgid % nig) % gsz); pn = (wgid % nig) / gsz; return true;
    }
};

template <class Epi, class Sched>
__device__ __forceinline__ void gemm_phase(PG8_LAS unsigned char* lds, const int tid, const int lda, const int ldb, const int K, const Sched& S, const Epi& E) {
    const int wid = __builtin_amdgcn_readfirstlane(tid >> 6), lane = tid & 63, wr = wid >> 2, wc = wid & 3, fr = lane & 15, fq = lane >> 4;
    const int nt = K / BK;
    unsigned voffA[2], voffB[2];
#pragma unroll
    for (int i = 0; i < 2; ++i) { int R, C; stage_rc(tid * 16 + i * 8192, R, C); const int Rb = Epi::PERM ? ((R & ~31) + perm32(R & 31)) : R;
        voffA[i] = (unsigned)(R * lda + C) * 2u; voffB[i] = (unsigned)(Rb * ldb + C) * 2u; }
    const size_t kstep = (size_t)(BK * 2);
    const size_t hstepA = (size_t)HALF * lda * 2, hstepB = (size_t)HALF * ldb * 2;
    const unsigned ldsw = (unsigned)wid * 1024u;
    const int aoff = lds_byte(wr * 64 + fr, fq * 8), boff = lds_byte(wc * 32 + fr, fq * 8);
#define PG8_SA(b, h) (((b) * 2 + (h)) * HTB)
#define PG8_SB(b, h) ((4 + (b) * 2 + (h)) * HTB)
#define PG8_STAGE(bufoff, gbase, voff) do { _Pragma("unroll") for (int _i = 0; _i < 2; ++_i) \
        __builtin_amdgcn_global_load_lds((const unsigned*)((const char*)(gbase) + (voff)[_i]), (PG8_LAS unsigned*)(lds + (bufoff) + ldsw + _i * 8192), 16, 0, 0); } while (0)
#define PG8_LDA(dst, b, h) do { _Pragma("unroll") for (int m = 0; m < 4; ++m) _Pragma("unroll") for (int k = 0; k < 2; ++k) dst[m][k] = *(const PG8_LAS bf16x8*)(lds + PG8_SA(b, h) + aoff + m * 2048 + k * 1024); } while (0)
#define PG8_LDB(dst, b, h) do { _Pragma("unroll") for (int n = 0; n < 2; ++n) _Pragma("unroll") for (int k = 0; k < 2; ++k) dst[n][k] = *(const PG8_LAS bf16x8*)(lds + PG8_SB(b, h) + boff + n * 2048 + k * 1024); } while (0)
#define PG8_MMA(ai, bj, At, Bt) do { __builtin_amdgcn_s_setprio(1); _Pragma("unroll") for (int m = 0; m < 4; ++m) _Pragma("unroll") for (int n = 0; n < 2; ++n) _Pragma("unroll") for (int k = 0; k < 2; ++k) \
        acc[ai][bj][m][n] = __builtin_amdgcn_mfma_f32_16x16x32_bf16(Bt[n][k], At[m][k], acc[ai][bj][m][n], 0, 0, 0); __builtin_amdgcn_s_setprio(0); } while (0)
#define PG8_WAIT_V(n) asm volatile("s_waitcnt vmcnt(" #n ")" ::: "memory")
#define PG8_WAIT_L(n) asm volatile("s_waitcnt lgkmcnt(" #n ")" ::: "memory")
#define PG8_BAR __builtin_amdgcn_s_barrier()
#define PG8_SCHED __builtin_amdgcn_sched_barrier(0)
    Unit cur, nxt; int ui = 0;
    if (!S.next(0, cur)) return;
    f32x4 acc[2][2][4][2];
#pragma unroll
    for (int a = 0; a < 2; ++a)
#pragma unroll
        for (int b = 0; b < 2; ++b)
#pragma unroll
            for (int m = 0; m < 4; ++m)
#pragma unroll
                for (int n = 0; n < 2; ++n) acc[a][b][m][n] = (f32x4){0.f, 0.f, 0.f, 0.f};
    bf16x8 At[4][2], B0[2][2], B1[2][2];
    const char* cA = S.a_ptr(cur); const char* cB = S.b_ptr(cur);
    PG8_STAGE(PG8_SB(0, 0), cB, voffB); PG8_STAGE(PG8_SA(0, 0), cA, voffA); PG8_STAGE(PG8_SB(0, 1), cB + hstepB, voffB); PG8_STAGE(PG8_SA(0, 1), cA + hstepA, voffA);
    if (wr == 1) PG8_BAR;
    PG8_WAIT_V(4); PG8_BAR;
    PG8_STAGE(PG8_SB(1, 0), cB + kstep, voffB); PG8_STAGE(PG8_SA(1, 0), cA + kstep, voffA); PG8_STAGE(PG8_SB(1, 1), cB + hstepB + kstep, voffB);
    PG8_WAIT_V(6); PG8_BAR;
    for (;;) {
        const bool has_next = S.next(ui + 1, nxt);
        const char* nA = has_next ? S.a_ptr(nxt) : cA; const char* nB = has_next ? S.b_ptr(nxt) : cB;
        for (int t = 0; t < nt; t += 2) {
            const bool last = (t == nt - 2);
            const char* a1 = cA + (size_t)(t + 1) * kstep;
            const char* a2 = last ? nA : cA + (size_t)(t + 2) * kstep; const char* b2 = last ? nB : cB + (size_t)(t + 2) * kstep;
            const char* a3 = a2 + kstep; const char* b3 = b2 + kstep;
            PG8_LDB(B0, 0, 0); PG8_SCHED; PG8_LDA(At, 0, 0); PG8_STAGE(PG8_SA(1, 1), a1 + hstepA, voffA);
            PG8_WAIT_L(8); PG8_BAR; PG8_WAIT_L(0); PG8_MMA(0, 0, At, B0); PG8_BAR; PG8_SCHED;
            PG8_LDB(B1, 0, 1); PG8_STAGE(PG8_SB(0, 0), b2, voffB);
            PG8_BAR; PG8_WAIT_L(0); PG8_MMA(0, 1, At, B1); PG8_BAR;
            PG8_LDA(At, 0, 1); PG8_STAGE(PG8_SA(0, 0), a2, voffA);
            PG8_BAR; PG8_WAIT_L(0); PG8_MMA(1, 0, At, B0); PG8_BAR; PG8_SCHED;
            PG8_STAGE(PG8_SB(0, 1), b2 + hstepB, voffB);
            PG8_WAIT_V(6); PG8_BAR; PG8_MMA(1, 1, At, B1); PG8_BAR;
            PG8_LDB(B0, 1, 0); PG8_SCHED; PG8_LDA(At, 1, 0); PG8_STAGE(PG8_SA(0, 1), a2 + hstepA, voffA);
            PG8_WAIT_L(8); PG8_BAR; PG8_WAIT_L(0); PG8_MMA(0, 0, At, B0); PG8_BAR; PG8_SCHED;
            PG8_LDB(B1, 1, 1); PG8_STAGE(PG8_SB(1, 0), b3, voffB);
            PG8_BAR; PG8_WAIT_L(0); PG8_MMA(0, 1, At, B1); PG8_BAR;
            PG8_LDA(At, 1, 1); PG8_STAGE(PG8_SA(1, 0), a3, voffA);
            PG8_BAR; PG8_WAIT_L(0); PG8_MMA(1, 0, At, B0); PG8_BAR; PG8_SCHED;
            PG8_STAGE(PG8_SB(1, 1), b3 + hstepB, voffB);
            PG8_WAIT_V(6); PG8_BAR; PG8_MMA(1, 1, At, B1); PG8_BAR;
        }
        E(acc, cur, wr, wc, fr, fq);
        if (!has_next) break;
#pragma unroll
        for (int a = 0; a < 2; ++a)
#pragma unroll
            for (int b = 0; b < 2; ++b)
#pragma unroll
                for (int m = 0; m < 4; ++m)
#pragma unroll
                    for (int n = 0; n < 2; ++n) acc[a][b][m][n] = (f32x4){0.f, 0.f, 0.f, 0.f};
        cur = nxt; cA = nA; cB = nB; ++ui;
    }
    PG8_WAIT_V(0);
    if (wr == 0) PG8_BAR;
    PG8_BAR;
#undef PG8_SA
#undef PG8_SB
#undef PG8_STAGE
#undef PG8_LDA
#undef PG8_LDB
#undef PG8_MMA
#undef PG8_WAIT_V
#undef PG8_WAIT_L
#undef PG8_BAR
#undef PG8_SCHED
}
}
using pg8::f32x4; using pg8::u32x4; using pg8::Unit;

#define GEMM_LDS (pg8::STAGE_BYTES + 1024)

struct SchedProj : pg8::TileOrder {
  const char* A; const char* B;
  __device__ bool next(int i, Unit& u) const { u.z = 0; return tile(i, u.pm, u.pn); }
  __device__ const char* a_ptr(const Unit& u) const { return A + (size_t)u.pm * 256 * DM * 2; }
  __device__ const char* b_ptr(const Unit& u) const { return B + (size_t)u.pn * 256 * DM * 2; }
};
struct EpiProj {
  static constexpr bool PERM = true;
  bf16_t* O;
  __device__ __forceinline__ void operator()(const f32x4 (&acc)[2][2][4][2], const Unit& u, int wr, int wc, int fr, int fq) const {
    const int row0 = u.pm * 256 + wr * 64 + fr, col0 = u.pn * 256 + wc * 32 + 8 * fq;
    const bool gate = u.pn >= (C_GA / 256);
#pragma unroll
    for (int ai = 0; ai < 2; ++ai)
#pragma unroll
      for (int m = 0; m < 4; ++m) {
        bf16_t* rowp = O + (size_t)(row0 + ai * 128 + m * 16) * PW + col0;
#pragma unroll
        for (int bj = 0; bj < 2; ++bj) {
          f32x4 v0 = acc[ai][bj][m][0], v1 = acc[ai][bj][m][1];
          if (gate) {
#pragma unroll
            for (int j = 0; j < 4; ++j) { v0[j] = sigmoidf_(v0[j]); v1[j] = sigmoidf_(v1[j]); }
          }
          u32x4 w; w.x = pg8::cvt_pk_bf16(v0[0], v0[1]); w.y = pg8::cvt_pk_bf16(v0[2], v0[3]); w.z = pg8::cvt_pk_bf16(v1[0], v1[1]); w.w = pg8::cvt_pk_bf16(v1[2], v1[3]);
          *(u32x4*)(rowp + bj * 128) = w;
        }
      }
  }
};
__device__ void ph_proj(const Params& p, PG8_LAS unsigned char* lds, int nblk, int bid) {
  SchedProj S; S.init(T_TOK / 256, PW / 256, nblk, bid); S.A = (const char*)p.hbf; S.B = (const char*)p.w_in_t;
  EpiProj E{p.proj};
  pg8::gemm_phase(lds, p.tid, DM, DM, DM, S, E);
}

struct SchedBr : pg8::TileOrder {
  const char* A; const char* Ba; const char* Bb;
  __device__ bool next(int i, Unit& u) const { u.z = i & 1; return tile(i >> 1, u.pm, u.pn); }
  __device__ const char* a_ptr(const Unit& u) const { return A + (size_t)u.pm * 256 * DM * 2 + u.z * 512 * 2; }
  __device__ const char* b_ptr(const Unit& u) const { return (u.z ? Bb : Ba) + (size_t)u.pn * 256 * 512 * 2; }
};
__device__ __forceinline__ void unpack8(const u32x4 w, float (&f)[8]) {
  f[0] = __uint_as_float(w.x << 16); f[1] = __uint_as_float(w.x & 0xffff0000u); f[2] = __uint_as_float(w.y << 16); f[3] = __uint_as_float(w.y & 0xffff0000u);
  f[4] = __uint_as_float(w.z << 16); f[5] = __uint_as_float(w.z & 0xffff0000u); f[6] = __uint_as_float(w.w << 16); f[7] = __uint_as_float(w.w & 0xffff0000u);
}
struct EpiBr {
  static constexpr bool PERM = true;
  const bf16_t* proj; bf16_t* O;
  __device__ __forceinline__ void operator()(const f32x4 (&acc)[2][2][4][2], const Unit& u, int wr, int wc, int fr, int fq) const {
    const int row0 = u.pm * 256 + wr * 64 + fr, col0 = u.pn * 256 + wc * 32 + 8 * fq;
    const int gcol = (u.z ? C_GB : C_GA) + col0;
#pragma unroll
    for (int ai = 0; ai < 2; ++ai)
#pragma unroll
      for (int m = 0; m < 4; ++m) {
        const size_t row = (size_t)(row0 + ai * 128 + m * 16);
        bf16_t* rowp = O + row * DM + col0;
        const bf16_t* gp = proj + row * PW + gcol;
#pragma unroll
        for (int bj = 0; bj < 2; ++bj) {
          float g[8]; unpack8(*(const u32x4*)(gp + bj * 128), g);
          f32x4 v0 = acc[ai][bj][m][0], v1 = acc[ai][bj][m][1];
          float r[8];
#pragma unroll
          for (int j = 0; j < 4; ++j) { r[j] = v0[j] * g[j]; r[4 + j] = v1[j] * g[4 + j]; }
          if (u.z) {
            float pv[8]; unpack8(*(const u32x4*)(rowp + bj * 128), pv);
#pragma unroll
            for (int j = 0; j < 8; ++j) r[j] += pv[j];
          }
          u32x4 w; w.x = pg8::cvt_pk_bf16(r[0], r[1]); w.y = pg8::cvt_pk_bf16(r[2], r[3]); w.z = pg8::cvt_pk_bf16(r[4], r[5]); w.w = pg8::cvt_pk_bf16(r[6], r[7]);
          *(u32x4*)(rowp + bj * 128) = w;
        }
      }
  }
};
__device__ void ph_br(const Params& p, PG8_LAS unsigned char* lds, int nblk, int bid) {
  SchedBr S; S.init(T_TOK / 256, DM / 256, nblk, bid); S.A = (const char*)p.oab; S.Ba = (const char*)p.wbra_t; S.Bb = (const char*)p.wbrb_t;
  EpiBr E{p.proj, p.merged};
  pg8::gemm_phase(lds, p.tid, DM, 512, 512, S, E);
}

struct SchedMix : pg8::TileOrder {
  const char* A; const char* B;
  __device__ bool next(int i, Unit& u) const { u.z = 0; return tile(i, u.pm, u.pn); }
  __device__ const char* a_ptr(const Unit& u) const { return A + (size_t)u.pm * 256 * DM * 2; }
  __device__ const char* b_ptr(const Unit& u) const { return B + (size_t)u.pn * 256 * DM * 2; }
};
struct EpiMix {
  static constexpr bool PERM = true;
  bf16_t* O;
  __device__ __forceinline__ void operator()(const f32x4 (&acc)[2][2][4][2], const Unit& u, int wr, int wc, int fr, int fq) const {
    const int row0 = u.pm * 256 + wr * 64 + fr, col0 = u.pn * 256 + wc * 32 + 8 * fq;
#pragma unroll
    for (int ai = 0; ai < 2; ++ai)
#pragma unroll
      for (int m = 0; m < 4; ++m) {
        bf16_t* rowp = O + (size_t)(row0 + ai * 128 + m * 16) * DM + col0;
#pragma unroll
        for (int bj = 0; bj < 2; ++bj) {
          const f32x4 v0 = acc[ai][bj][m][0], v1 = acc[ai][bj][m][1];
          u32x4 w; w.x = pg8::cvt_pk_bf16(v0[0], v0[1]); w.y = pg8::cvt_pk_bf16(v0[2], v0[3]); w.z = pg8::cvt_pk_bf16(v1[0], v1[1]); w.w = pg8::cvt_pk_bf16(v1[2], v1[3]);
          *(u32x4*)(rowp + bj * 128) = w;
        }
      }
  }
};
__device__ void ph_mix(const Params& p, PG8_LAS unsigned char* lds, int nblk, int bid) {
  SchedMix S; S.init(T_TOK / 256, DM / 256, nblk, bid); S.A = (const char*)p.merged; S.B = (const char*)p.wo_t;
  EpiMix E{p.mixer};
  pg8::gemm_phase(lds, p.tid, DM, DM, DM, S, E);
}

struct SchedMoe {
  const PG8_LAS int* tb; int NT; int G, c; int nwg;
  const char* A; const char* B; size_t bexp;
  __device__ bool next(int i, Unit& u) const {
    const long L = (long)i * G + c; if (L >= nwg) return false;
    int wgid = (int)L; { const int q = nwg / 8, r = nwg % 8, xcd = wgid % 8, off = wgid / 8; wgid = (xcd < r ? xcd * (q + 1) : r * (q + 1) + (xcd - r) * q) + off; }
    int e = 0;
#pragma unroll 1
    for (int k = 1; k < NE; ++k) if (wgid >= tb[k]) e = k;
    const int q = wgid - tb[e]; const int tiles = tb[33 + e + 1] - tb[33 + e];
    u.pm = tb[33 + e] + q % tiles; u.pn = q / tiles; u.z = e; return true;
  }
  __device__ const char* a_ptr(const Unit& u) const { return A + (size_t)u.pm * 256 * DM * 2; }
  __device__ const char* b_ptr(const Unit& u) const { return B + (size_t)u.z * bexp + (size_t)u.pn * 256 * DM * 2; }
};
__device__ __forceinline__ void moe_table(const Params& p, PG8_LAS int* tb, int NT) {
  if (p.tid == 0) {
    int ub = 0, tbp = 0;
    for (int e = 0; e < NE; ++e) { tb[e] = ub; tb[33 + e] = tbp; const int t = (p.cnt[e * 64] + 255) >> 8; ub += t * NT; tbp += t; }
    tb[NE] = ub; tb[33 + NE] = tbp;
  }
  __syncthreads();
}
struct EpiMoe1 {
  static constexpr bool PERM = true;
  const float* b_gu; bf16_t* act;
  __device__ __forceinline__ void operator()(f32x4 (&acc)[2][2][4][2], const Unit& u, int wr, int wc, int fr, int fq) const {
    const int row0 = u.pm * 256 + wr * 64 + fr, jc = u.pn * 128 + wc * 32 + 8 * fq;
    const float* bg = b_gu + (size_t)u.z * 2048 + jc;
#pragma unroll
    for (int bj = 0; bj < 2; ++bj)
#pragma unroll
      for (int n = 0; n < 2; ++n) {
        const f32x4 bv = *(const f32x4*)(bg + bj * 1024 + n * 4);
#pragma unroll
        for (int ai = 0; ai < 2; ++ai)
#pragma unroll
          for (int m = 0; m < 4; ++m) acc[ai][bj][m][n] += bv;
      }
#pragma unroll
    for (int ai = 0; ai < 2; ++ai)
#pragma unroll
      for (int m = 0; m < 4; ++m) {
        bf16_t* rowp = act + (size_t)(row0 + ai * 128 + m * 16) * DM + jc;
        float r[8];
#pragma unroll
        for (int n = 0; n < 2; ++n)
#pragma unroll
          for (int j = 0; j < 4; ++j) {
            float g = acc[ai][0][m][n][j], up = acc[ai][1][m][n][j];
            g = fminf(g, 7.f); up = fminf(fmaxf(up, -7.f), 7.f);
            r[n * 4 + j] = (up + 1.f) * g * sigmoidf_(1.702f * g);
          }
        u32x4 w; w.x = pk2(r[0], r[1]); w.y = pk2(r[2], r[3]); w.z = pk2(r[4], r[5]); w.w = pk2(r[6], r[7]);
        *(u32x4*)rowp = w;
      }
  }
};
__device__ void ph_moe1(const Params& p, PG8_LAS unsigned char* lds, int nblk, int bid) {
  PG8_LAS int* tb = (PG8_LAS int*)(lds + pg8::STAGE_BYTES);
  moe_table(p, tb, 8);
  SchedMoe S; S.tb = tb; S.NT = 8; S.G = nblk; S.c = bid; S.nwg = tb[NE]; S.A = (const char*)p.xs; S.B = (const char*)p.wgu_t; S.bexp = (size_t)2048 * DM * 2;
  EpiMoe1 E{p.b_gu, p.act};
  pg8::gemm_phase(lds, p.tid, DM, DM, DM, S, E);
}
struct EpiMoe2 {
  static constexpr bool PERM = true;
  const float* b_down; const int* rowmap; bf16_t* yslot;
  __device__ __forceinline__ void operator()(f32x4 (&acc)[2][2][4][2], const Unit& u, int wr, int wc, int fr, int fq) const {
    const int row0 = u.pm * 256 + wr * 64 + fr, col0 = u.pn * 256 + wc * 32 + 8 * fq;
    const float* bd = b_down + (size_t)u.z * 1024 + col0;
#pragma unroll
    for (int bj = 0; bj < 2; ++bj)
#pragma unroll
      for (int n = 0; n < 2; ++n) {
        const f32x4 bv = *(const f32x4*)(bd + bj * 128 + n * 4);
#pragma unroll
        for (int ai = 0; ai < 2; ++ai)
#pragma unroll
          for (int m = 0; m < 4; ++m) acc[ai][bj][m][n] += bv;
      }
#pragma unroll
    for (int ai = 0; ai < 2; ++ai)
#pragma unroll
      for (int m = 0; m < 4; ++m) {
        const int a = rowmap[row0 + ai * 128 + m * 16];
        if (a >= 0) {
          bf16_t* rowp = yslot + (size_t)a * DM + col0;
#pragma unroll
          for (int bj = 0; bj < 2; ++bj) {
            const f32x4 v0 = acc[ai][bj][m][0], v1 = acc[ai][bj][m][1];
            u32x4 w; w.x = pk2(v0[0], v0[1]); w.y = pk2(v0[2], v0[3]); w.z = pk2(v1[0], v1[1]); w.w = pk2(v1[2], v1[3]);
            *(u32x4*)(rowp + bj * 128) = w;
          }
        }
      }
  }
};
__device__ void ph_moe2(const Params& p, PG8_LAS unsigned char* lds, int nblk, int bid) {
  PG8_LAS int* tb = (PG8_LAS int*)(lds + pg8::STAGE_BYTES);
  moe_table(p, tb, 4);
  SchedMoe S; S.tb = tb; S.NT = 4; S.G = nblk; S.c = bid; S.nwg = tb[NE]; S.A = (const char*)p.act; S.B = (const char*)p.wd_t; S.bexp = (size_t)1024 * DM * 2;
  EpiMoe2 E{p.b_down, p.rowmap, p.yslot};
  pg8::gemm_phase(lds, p.tid, DM, DM, DM, S, E);
}

typedef short bf16x8 __attribute__((ext_vector_type(8)));
typedef unsigned u32x2 __attribute__((ext_vector_type(2)));
#define LAS __attribute__((address_space(3)))
#define MFMA16(a, b, c) __builtin_amdgcn_mfma_f32_16x16x32_bf16((a), (b), (c), 0, 0, 0)
__device__ __forceinline__ bf16x8 pack8(float a0, float a1, float a2, float a3, float a4, float a5, float a6, float a7) {
  u32x4 w; w.x = pk2(a0, a1); w.y = pk2(a2, a3); w.z = pk2(a4, a5); w.w = pk2(a6, a7);
  return __builtin_bit_cast(bf16x8, w);
}
__device__ __forceinline__ bf16_t f2bf_hw(float a) { return (bf16_t)(pk2(a, 0.f) & 0xffffu); }

#define DN_ABYTES 57344
#define DN_UFLOATS 8192
#define F_WN 0
#define F_QD 16
#define F_QK 32
#define F_KT 40

#define DP_KH 0
#define DP_QT 17408
#define DP_KHT 34816
#define DP_VT 53248
#define DP_TU 71680
#define DP_TW 80896
#define DP_LF 90112
#define DP_GC 107520
#define DP_BETA 107776
#define DP_CW 108032
#define DP_TOTAL 114176

template <int KS>
__device__ __forceinline__ f32x4 prod16(const LAS bf16_t* A, int lda, int arow0, const LAS bf16_t* Bt, int ldb, int brow0, f32x4 acc, int lane) {
  const int r = lane & 15, q = lane >> 4;
#pragma unroll
  for (int ks = 0; ks < KS; ++ks) {
    const bf16x8 a = *(const LAS bf16x8*)(A + (arow0 + r) * lda + 32 * ks + 8 * q);
    const bf16x8 b = *(const LAS bf16x8*)(Bt + (brow0 + r) * ldb + 32 * ks + 8 * q);
    acc = MFMA16(a, b, acc);
  }
  return acc;
}
__device__ __forceinline__ void tile_store_rm(LAS bf16_t* X, int ld, int row0, int col0, const f32x4 v, int lane) {
  const int r = lane & 15, q = lane >> 4;
#pragma unroll
  for (int i = 0; i < 4; ++i) X[(row0 + 4 * q + i) * ld + col0 + r] = f2bf_hw(v[i]);
}
__device__ __forceinline__ void tile_store_tr(LAS bf16_t* Xt, int ld, int row0, int col0, const f32x4 v, int lane) {
  const int r = lane & 15, q = lane >> 4;
  u32x2 w; w.x = pk2(v[0], v[1]); w.y = pk2(v[2], v[3]);
  *(LAS u32x2*)(Xt + (col0 + r) * ld + row0 + 4 * q) = w;
}

__device__ void dn_prep_chunk(const Params& p, LAS unsigned char* lds, int ci, bool load_cw) {
  const int tid = p.tid, lane = tid & 63, w = tid >> 6, r16 = lane & 15, q4 = lane >> 4;
  const int bh = ci >> 6, n = ci & 63, b = bh >> 2, h = bh & 3;
  LAS bf16_t* Kh = (LAS bf16_t*)(lds + DP_KH); LAS bf16_t* Qt = (LAS bf16_t*)(lds + DP_QT);
  LAS bf16_t* KhT = (LAS bf16_t*)(lds + DP_KHT); LAS bf16_t* VT = (LAS bf16_t*)(lds + DP_VT);
  LAS bf16_t* Tu = (LAS bf16_t*)(lds + DP_TU); LAS bf16_t* Tw = (LAS bf16_t*)(lds + DP_TW); LAS float* Lf = (LAS float*)(lds + DP_LF);
  LAS float* gcb = (LAS float*)(lds + DP_GC); LAS float* betab = (LAS float*)(lds + DP_BETA); LAS float* cw = (LAS float*)(lds + DP_CW);
  unsigned char* gA = (unsigned char*)p.dnA + (size_t)ci * DN_ABYTES;
  float* gU = p.dnU + (size_t)ci * DN_UFLOATS;

  if (load_cw) {
    for (int i = tid; i < 4 * 384; i += 512) { const int tap = i / 384, cc = i % 384, part = cc >> 7, d = cc & 127; cw[i] = p.conv_w[tap * 1536 + part * 512 + h * 128 + d]; }
  }
  __syncthreads();
  const int c = tid >> 3, g = tid & 7;
  const int s = n * 64 + c;
  const size_t t = (size_t)b * SEQ + s;
  float qv[16], kv[16], vv[16];
#pragma unroll
  for (int j = 0; j < 16; ++j) { qv[j] = 0.f; kv[j] = 0.f; vv[j] = 0.f; }
#pragma unroll
  for (int tap = 0; tap < 4; ++tap) {
    const int ss = s - 3 + tap;
    if (ss >= 0) {
      const bf16_t* row = p.proj + (t - 3 + tap) * PW + h * 128 + 16 * g;
      float x[8];
#pragma unroll
      for (int part = 0; part < 3; ++part) {
#pragma unroll
        for (int hh = 0; hh < 2; ++hh) {
          unpack8(*(const u32x4*)(row + part * 512 + 8 * hh), x);
#pragma unroll
          for (int j = 0; j < 8; ++j) {
            const float wv = cw[tap * 384 + part * 128 + 16 * g + 8 * hh + j];
            if (part == 0) qv[8 * hh + j] += wv * x[j];
            if (part == 1) kv[8 * hh + j] += wv * x[j];
            if (part == 2) vv[8 * hh + j] += wv * x[j];
          }
        }
      }
    }
    asm volatile("" ::: "memory");
  }
  float sq = 0.f, sk = 0.f;
#pragma unroll
  for (int j = 0; j < 16; ++j) { qv[j] = siluf_(qv[j]); kv[j] = siluf_(kv[j]); vv[j] = siluf_(vv[j]); sq += qv[j] * qv[j]; sk += kv[j] * kv[j]; }
  sq += __shfl_xor(sq, 1, 64); sq += __shfl_xor(sq, 2, 64); sq += __shfl_xor(sq, 4, 64);
  sk += __shfl_xor(sk, 1, 64); sk += __shfl_xor(sk, 2, 64); sk += __shfl_xor(sk, 4, 64);
  const float rq = rsqrtf(sq + 1e-6f) * 0.08838834764831845f, rk = rsqrtf(sk + 1e-6f);
#pragma unroll
  for (int j = 0; j < 16; ++j) { qv[j] *= rq; kv[j] *= rk; }
  if (g == 0) {
    const float bb = p.ba[t * 8 + h], aa = p.ba[t * 8 + 4 + h];
    const float xx = aa + p.dt_bias[h];
    const float sp = xx > 20.f ? xx : log1pf(__expf(xx));
    betab[c] = sigmoidf_(bb);
    gcb[c] = -__expf(p.a_log[h]) * sp;
  }
  {
    u32x4 w0, w1;
    w0.x = pk2(kv[0], kv[1]); w0.y = pk2(kv[2], kv[3]); w0.z = pk2(kv[4], kv[5]); w0.w = pk2(kv[6], kv[7]);
    w1.x = pk2(kv[8], kv[9]); w1.y = pk2(kv[10], kv[11]); w1.z = pk2(kv[12], kv[13]); w1.w = pk2(kv[14], kv[15]);
    *(LAS u32x4*)(Kh + c * 136 + 16 * g) = w0; *(LAS u32x4*)(Kh + c * 136 + 16 * g + 8) = w1;
    w0.x = pk2(qv[0], qv[1]); w0.y = pk2(qv[2], qv[3]); w0.z = pk2(qv[4], qv[5]); w0.w = pk2(qv[6], qv[7]);
    w1.x = pk2(qv[8], qv[9]); w1.y = pk2(qv[10], qv[11]); w1.z = pk2(qv[12], qv[13]); w1.w = pk2(qv[14], qv[15]);
    *(LAS u32x4*)(Qt + c * 136 + 16 * g) = w0; *(LAS u32x4*)(Qt + c * 136 + 16 * g + 8) = w1;
#pragma unroll
    for (int j = 0; j < 16; ++j) { KhT[(16 * g + j) * 72 + c] = f2bf_hw(kv[j]); VT[(16 * g + j) * 72 + c] = f2bf_hw(vv[j]); }
  }
  __syncthreads();
  if (w == 0) {
    float v = gcb[lane];
#pragma unroll
    for (int o = 1; o < 64; o <<= 1) { const float u = __shfl_up(v, o, 64); if (lane >= o) v += u; }
    gcb[lane] = v;
  }
  __syncthreads();
  const float gc_c = gcb[c], gl = gcb[63];
  {
    const float eg = __expf(gc_c);
    unsigned char* fb = gA + (size_t)(F_QD + (c >> 4) * 4 + (g >> 1)) * 1024 + (g & 1) * 8;
#pragma unroll
    for (int qq = 0; qq < 4; ++qq) {
      u32x2 wv; wv.x = pk2(qv[4 * qq] * eg, qv[4 * qq + 1] * eg); wv.y = pk2(qv[4 * qq + 2] * eg, qv[4 * qq + 3] * eg);
      *(u32x2*)(fb + ((c & 15) + 16 * qq) * 16) = wv;
    }
  }
  const int rt = w >> 1, ct0 = 2 * (w & 1);
#pragma unroll
  for (int tt = 0; tt < 2; ++tt) {
    const int ct = ct0 + tt;
    f32x4 gacc = {0.f, 0.f, 0.f, 0.f};
    gacc = prod16<4>(Kh, 136, 16 * rt, Kh, 136, 16 * ct, gacc, lane);
    const int m = 16 * ct + r16; const float gc_m = gcb[m];
#pragma unroll
    for (int i = 0; i < 4; ++i) {
      const int cc = 16 * rt + 4 * q4 + i;
      Lf[cc * 68 + m] = (m < cc) ? betab[cc] * gacc[i] * __expf(gcb[cc] - gc_m) : 0.f;
    }
    f32x4 qacc = {0.f, 0.f, 0.f, 0.f};
    qacc = prod16<4>(Kh, 136, 16 * rt, Qt, 136, 16 * ct, qacc, lane);
    const int cq = 16 * ct + r16; const float gc_cq = gcb[cq];
    float o4[4];
#pragma unroll
    for (int i = 0; i < 4; ++i) { const int mm = 16 * rt + 4 * q4 + i; o4[i] = (mm <= cq) ? qacc[i] * __expf(gc_cq - gcb[mm]) : 0.f; }
    u32x2 wv; wv.x = pk2(o4[0], o4[1]); wv.y = pk2(o4[2], o4[3]);
    *(u32x2*)(gA + (size_t)(F_QK + ct * 2 + (rt >> 1)) * 1024 + (r16 + 16 * q4) * 16 + (rt & 1) * 8) = wv;
  }
  __syncthreads();
  if (w == 0) {
    float T[64];
    int lo = lane; asm volatile("" : "+v"(lo));
    unsigned lfb = DP_LF; asm volatile("" : "+v"(lfb));
    const LAS float* Lfo = (const LAS float*)(lds + lfb);
    const float bm = betab[lo], bem = bm * __expf(gcb[lo]);
#pragma unroll
    for (int i = 0; i < 64; ++i) {
      float a0 = (i == lo) ? 1.f : 0.f, a1 = 0.f, a2 = 0.f, a3 = 0.f;
#pragma unroll
      for (int k4 = 0; k4 < (i + 3) / 4; ++k4) {
        const f32x4 l = *(const LAS f32x4*)(Lfo + i * 68 + 4 * k4);
        if (4 * k4 + 0 < i) a0 -= l[0] * T[4 * k4 + 0];
        if (4 * k4 + 1 < i) a1 -= l[1] * T[4 * k4 + 1];
        if (4 * k4 + 2 < i) a2 -= l[2] * T[4 * k4 + 2];
        if (4 * k4 + 3 < i) a3 -= l[3] * T[4 * k4 + 3];
      }
      T[i] = (a0 + a1) + (a2 + a3);
      Tu[i * 72 + lo] = f2bf_hw(T[i] * bm);
      Tw[i * 72 + lo] = f2bf_hw(T[i] * bem);
      asm volatile("" ::: "memory");
    }
  }
  __syncthreads();
#pragma unroll
  for (int rr = 0; rr < 4; ++rr) {
    f32x4 u = {0.f, 0.f, 0.f, 0.f};
    u = prod16<2>(Tu, 72, 16 * rr, VT, 72, 16 * w, u, lane);
    *(f32x4*)(gU + ((w * 4 + rr) * 64 + lane) * 4) = u;
    f32x4 wt = {0.f, 0.f, 0.f, 0.f};
    wt = prod16<2>(KhT, 72, 16 * w, Tw, 72, 16 * rr, wt, lane);
    u32x2 wv; wv.x = pk2(-wt[0], -wt[1]); wv.y = pk2(-wt[2], -wt[3]);
    *(u32x2*)(gA + (size_t)(F_WN + rr * 4 + (w >> 1)) * 1024 + (r16 + 16 * q4) * 16 + (w & 1) * 8) = wv;
  }
#pragma unroll
  for (int it = 0; it < 4; ++it) {
    const int idx = tid + it * 512; const int d = idx >> 4, m4 = idx & 15;
    const u32x2 raw = *(const LAS u32x2*)(KhT + d * 72 + 4 * m4);
    const float k0 = __uint_as_float(raw.x << 16), k1 = __uint_as_float(raw.x & 0xffff0000u), k2 = __uint_as_float(raw.y << 16), k3 = __uint_as_float(raw.y & 0xffff0000u);
    const float e0 = __expf(gl - gcb[4 * m4]), e1 = __expf(gl - gcb[4 * m4 + 1]), e2 = __expf(gl - gcb[4 * m4 + 2]), e3 = __expf(gl - gcb[4 * m4 + 3]);
    u32x2 wv; wv.x = pk2(k0 * e0, k1 * e1); wv.y = pk2(k2 * e2, k3 * e3);
    *(u32x2*)(gA + (size_t)(F_KT + (d >> 4) * 2 + (m4 >> 3)) * 1024 + ((d & 15) + 16 * (m4 & 3)) * 16 + ((m4 >> 2) & 1) * 8) = wv;
  }
  if (tid == 0) p.dnG[ci] = __expf(gl);
}

#define DS_A0 0
#define DS_A1 57344
#define DS_TOTAL 114688
__device__ void dn_scan_blk(const Params& p, LAS unsigned char* lds, int item) {
  const int tid = p.tid, lane = tid & 63, w = __builtin_amdgcn_readfirstlane(tid >> 6), r16 = lane & 15, q4 = lane >> 4;
  const int bh = item >> 1, eh = item & 1, b = bh >> 2, h = bh & 3;
  const int et = eh * 4 + (w & 3);
  const bool comp = w < 4;
  const unsigned char* gA = (const unsigned char*)p.dnA + (size_t)bh * 64 * DN_ABYTES;
  const float* gU = p.dnU + (size_t)bh * 64 * DN_UFLOATS;
  const float* gG = p.dnG + bh * 64;
  auto issue_A = [&](int n, int buf) {
#pragma unroll
    for (int i = 0; i < 7; ++i) {
      const int f = w * 7 + i;
      __builtin_amdgcn_global_load_lds((const unsigned*)(gA + (size_t)n * DN_ABYTES + f * 1024 + lane * 16), (LAS unsigned*)(lds + (buf ? DS_A1 : DS_A0) + f * 1024), 16, 0, 0);
    }
  };
  __syncthreads();
  issue_A(0, 0);
  f32x4 Un[4];
#pragma unroll
  for (int rr = 0; rr < 4; ++rr) Un[rr] = *(const f32x4*)(gU + ((et * 4 + rr) * 64 + lane) * 4);
  f32x4 S[8];
#pragma unroll
  for (int dt = 0; dt < 8; ++dt) S[dt] = (f32x4){0.f, 0.f, 0.f, 0.f};
  asm volatile("s_waitcnt vmcnt(0)" ::: "memory");
  __syncthreads();
  bf16_t* obase = p.dn_out + ((size_t)b * SEQ) * p.dn_out_ld + h * 128 + 16 * et + r16;
#pragma unroll 1
  for (int n = 0; n < 64; ++n) {
    const LAS unsigned char* Ab = lds + ((n & 1) ? DS_A1 : DS_A0);
    if (n + 1 < 64) issue_A(n + 1, (n + 1) & 1);
    if (comp) {
      f32x4 Vn[4];
#pragma unroll
      for (int rr = 0; rr < 4; ++rr) Vn[rr] = Un[rr];
      if (n + 1 < 64) {
#pragma unroll
        for (int rr = 0; rr < 4; ++rr) Un[rr] = *(const f32x4*)(gU + (size_t)(n + 1) * DN_UFLOATS + ((et * 4 + rr) * 64 + lane) * 4);
      }
      const float gdec = gG[n];
      bf16x8 Sb[4];
#pragma unroll
      for (int ks = 0; ks < 4; ++ks) Sb[ks] = pack8(S[2 * ks][0], S[2 * ks][1], S[2 * ks][2], S[2 * ks][3], S[2 * ks + 1][0], S[2 * ks + 1][1], S[2 * ks + 1][2], S[2 * ks + 1][3]);
      f32x4 O[4];
#pragma unroll
      for (int rr = 0; rr < 4; ++rr) {
        O[rr] = (f32x4){0.f, 0.f, 0.f, 0.f};
#pragma unroll
        for (int ks = 0; ks < 4; ++ks) {
          const bf16x8 aw = *(const LAS bf16x8*)(Ab + (F_WN + rr * 4 + ks) * 1024 + lane * 16);
          Vn[rr] = MFMA16(aw, Sb[ks], Vn[rr]);
          const bf16x8 aq = *(const LAS bf16x8*)(Ab + (F_QD + rr * 4 + ks) * 1024 + lane * 16);
          O[rr] = MFMA16(aq, Sb[ks], O[rr]);
        }
      }
      bf16x8 Vb[2];
#pragma unroll
      for (int ks = 0; ks < 2; ++ks) Vb[ks] = pack8(Vn[2 * ks][0], Vn[2 * ks][1], Vn[2 * ks][2], Vn[2 * ks][3], Vn[2 * ks + 1][0], Vn[2 * ks + 1][1], Vn[2 * ks + 1][2], Vn[2 * ks + 1][3]);
#pragma unroll
      for (int rr = 0; rr < 4; ++rr)
#pragma unroll
        for (int ks = 0; ks < 2; ++ks) {
          const bf16x8 a = *(const LAS bf16x8*)(Ab + (F_QK + rr * 2 + ks) * 1024 + lane * 16);
          O[rr] = MFMA16(a, Vb[ks], O[rr]);
        }
#pragma unroll
      for (int rr = 0; rr < 4; ++rr)
#pragma unroll
        for (int i = 0; i < 4; ++i) obase[(size_t)(n * 64 + 16 * rr + 4 * q4 + i) * p.dn_out_ld] = f2bf_hw(O[rr][i]);
#pragma unroll
      for (int dt = 0; dt < 8; ++dt) {
        S[dt] *= gdec;
#pragma unroll
        for (int ks = 0; ks < 2; ++ks) {
          const bf16x8 a = *(const LAS bf16x8*)(Ab + (F_KT + dt * 2 + ks) * 1024 + lane * 16);
          S[dt] = MFMA16(a, Vb[ks], S[dt]);
        }
      }
    }
    asm volatile("s_waitcnt vmcnt(0)" ::: "memory");
    __syncthreads();
  }
}
__device__ void ph_dn_norm(const Params& p, int nblk, int bid) {
  const int wid = p.tid >> 6, lane = p.tid & 63;
  const f32x4 g0 = *(const f32x4*)(p.g_dn_out + (lane & 15) * 8), g1 = *(const f32x4*)(p.g_dn_out + (lane & 15) * 8 + 4);
  for (int t = bid * 8 + wid; t < T_TOK; t += nblk * 8) {
    bf16_t* op = p.oab + (size_t)t * DM + lane * 8;
    float o[8], z[8];
    unpack8(*(const u32x4*)op, o);
    unpack8(*(const u32x4*)(p.proj + (size_t)t * PW + C_Z + lane * 8), z);
    float ss = 0.f;
#pragma unroll
    for (int j = 0; j < 8; ++j) ss += o[j] * o[j];
    ss += __shfl_xor(ss, 1, 64); ss += __shfl_xor(ss, 2, 64); ss += __shfl_xor(ss, 4, 64); ss += __shfl_xor(ss, 8, 64);
    const float rstd = rsqrtf(ss * (1.f / 128.f) + 1e-6f);
    float y[8];
#pragma unroll
    for (int j = 0; j < 4; ++j) { y[j] = o[j] * rstd * g0[j] * siluf_(z[j]); y[4 + j] = o[4 + j] * rstd * g1[j] * siluf_(z[4 + j]); }
    u32x4 w; w.x = pk2(y[0], y[1]); w.y = pk2(y[2], y[3]); w.z = pk2(y[4], y[5]); w.w = pk2(y[6], y[7]);
    *(u32x4*)op = w;
  }
}
typedef float f32x16 __attribute__((ext_vector_type(16)));
#define MFMA32(a, b, c) __builtin_amdgcn_mfma_f32_32x32x16_bf16((a), (b), (c), 0, 0, 0)
#define MP_VL 0
#define MP_RED 65536
#define MP_TOTAL (65536 + 4096)

__device__ void moba_prep_block(const Params& p, LAS unsigned char* lds, int item) {
  const int tid = p.tid, lane = tid & 63, w = tid >> 6;
  const int bh = item >> 4, jb = item & 15, b = bh >> 2, h = bh & 3;
  LAS bf16_t* Vl = (LAS bf16_t*)(lds + MP_VL);
  LAS float* red = (LAS float*)(lds + MP_RED);
  __syncthreads();
#pragma unroll
  for (int it = 0; it < 8; ++it) {
    const int idx = tid + 512 * it, row = idx >> 4, ch = idx & 15;
    const u32x4 v = *(const u32x4*)(p.proj + ((size_t)b * SEQ + 256 * jb + row) * PW + C_MV + h * 128 + 8 * ch);
    *(LAS u32x4*)(Vl + row * 128 + 8 * ch) = v;
  }
  {
    const int r = tid >> 1, hh = tid & 1;
    const int pos = 256 * jb + r;
    const size_t t = (size_t)b * SEQ + pos;
    float cs[8], sn[8];
#pragma unroll
    for (int jj = 0; jj < 8; ++jj) {
      const float inv = exp2f(-(float)(8 * hh + jj) * (1.f / 16.f) * 18.931568569324174f);
      const float ang = (float)pos * inv;
      cs[jj] = cosf(ang); sn[jj] = sinf(ang);
    }
    float kacc[64];
#pragma unroll
    for (int which = 0; which < 2; ++which) {
      const bf16_t* src = p.proj + t * PW + (which ? C_MQ : C_MK) + h * 128 + 8 * hh;
      float x0[8], x1[8];
      unpack8(*(const u32x4*)(src), x0); unpack8(*(const u32x4*)(src + 16), x1);
      float y0[8], y1[8];
#pragma unroll
      for (int jj = 0; jj < 8; ++jj) { y0[jj] = x0[jj] * cs[jj] - x1[jj] * sn[jj]; y1[jj] = x1[jj] * cs[jj] + x0[jj] * sn[jj]; }
      u32x4 o[8];
      o[0].x = pk2(y0[0], y0[1]); o[0].y = pk2(y0[2], y0[3]); o[0].z = pk2(y0[4], y0[5]); o[0].w = pk2(y0[6], y0[7]);
      o[1].x = pk2(y1[0], y1[1]); o[1].y = pk2(y1[2], y1[3]); o[1].z = pk2(y1[4], y1[5]); o[1].w = pk2(y1[6], y1[7]);
#pragma unroll
      for (int ks = 2; ks < 8; ++ks) o[ks] = *(const u32x4*)(src + 16 * ks);
      if (which == 0) {
#pragma unroll
        for (int jj = 0; jj < 8; ++jj) { kacc[jj] = y0[jj]; kacc[8 + jj] = y1[jj]; }
#pragma unroll
        for (int ks = 2; ks < 8; ++ks) { float f[8]; unpack8(o[ks], f);
#pragma unroll
          for (int jj = 0; jj < 8; ++jj) kacc[8 * ks + jj] = f[jj]; }
        unsigned char* dst = (unsigned char*)p.Kp + ((size_t)(bh * 128 + 8 * jb + (r >> 5)) * 8192) + ((r & 31) + 32 * hh) * 16;
#pragma unroll
        for (int ks = 0; ks < 8; ++ks) *(u32x4*)(dst + ks * 1024) = o[ks];
      } else {
        bf16_t* dst = p.qb + ((size_t)bh * SEQ + pos) * 128 + 8 * hh;
#pragma unroll
        for (int ks = 0; ks < 8; ++ks) *(u32x4*)(dst + 16 * ks) = o[ks];
      }
    }
#pragma unroll
    for (int e = 0; e < 64; ++e) {
      float v = kacc[e];
      v += __shfl_xor(v, 2, 64); v += __shfl_xor(v, 4, 64); v += __shfl_xor(v, 8, 64); v += __shfl_xor(v, 16, 64); v += __shfl_xor(v, 32, 64);
      kacc[e] = v;
    }
    if (lane < 2) {
#pragma unroll
      for (int e = 0; e < 64; ++e) red[(w * 2 + lane) * 64 + e] = kacc[e];
    }
  }
  __syncthreads();
  if (tid < 128) {
    const int d = tid, hh = (d >> 3) & 1, ks = d >> 4, jj = d & 7;
    float a = 0.f;
#pragma unroll
    for (int ww = 0; ww < 8; ++ww) a += red[(ww * 2 + hh) * 64 + ks * 8 + jj];
    p.kmean[((size_t)bh * 16 + jb) * 128 + d] = a * (1.f / 256.f);
  }
#pragma unroll
  for (int it = 0; it < 8; ++it) {
    const int o = tid + 512 * it, ln = o & 63, frag = o >> 6, tl = frag >> 3, dt = (frag >> 1) & 3, s = frag & 1;
    const int r = ln & 31, hh = ln >> 5, d = 32 * dt + r;
    unsigned short e[8];
#pragma unroll
    for (int jj = 0; jj < 8; ++jj) { const int key = 32 * tl + 16 * s + 8 * (jj >> 2) + 4 * hh + (jj & 3); e[jj] = Vl[key * 128 + d]; }
    u32x4 wv; wv.x = e[0] | ((unsigned)e[1] << 16); wv.y = e[2] | ((unsigned)e[3] << 16); wv.z = e[4] | ((unsigned)e[5] << 16); wv.w = e[6] | ((unsigned)e[7] << 16);
    *(u32x4*)((unsigned char*)p.Vp + ((size_t)(bh * 128 + 8 * jb + tl) * 8192) + (dt * 2 + s) * 1024 + ln * 16) = wv;
  }
}
__device__ __forceinline__ int crow32(int reg, int hh) { return (reg & 3) + 8 * (reg >> 2) + 4 * hh; }
__device__ void moba_item(const Params& p, LAS float* km, int bh, int ib, int sub, int lane) {
  const int q = lane & 31, hh = lane >> 5;
  const int b = bh >> 2, h = bh & 3;
  const int s0 = 256 * ib + 32 * sub;
  const bf16_t* qrow = p.qb + ((size_t)bh * SEQ + s0 + q) * 128 + 8 * hh;
  bf16x8 Qf[8];
#pragma unroll
  for (int ks = 0; ks < 8; ++ks) Qf[ks] = *(const bf16x8*)(qrow + 16 * ks);
  LAS unsigned char* qlds = (LAS unsigned char*)km + 8192 + lane * 16;
#pragma unroll
  for (int ks = 0; ks < 8; ++ks) *(LAS bf16x8*)(qlds + ks * 1024) = Qf[ks];
  unsigned selmask = 0;
  if (ib > 0) {
    for (int idx = lane; idx < ib * 32; idx += 64) ((LAS f32x4*)km)[idx] = ((const f32x4*)(p.kmean + (size_t)bh * 16 * 128))[idx];
    float qf[64];
#pragma unroll
    for (int ks = 0; ks < 8; ++ks) { float f[8]; unpack8(__builtin_bit_cast(u32x4, Qf[ks]), f);
#pragma unroll
      for (int jj = 0; jj < 8; ++jj) qf[8 * ks + jj] = f[jj]; }
    float sc[16];
#pragma unroll
    for (int j = 0; j < 16; ++j) {
      sc[j] = -INFINITY;
      if (j < ib) {
        float a = 0.f;
#pragma unroll
        for (int ks = 0; ks < 8; ++ks) {
          const f32x4 k0 = *(const LAS f32x4*)(km + j * 128 + 16 * ks + 8 * hh), k1 = *(const LAS f32x4*)(km + j * 128 + 16 * ks + 8 * hh + 4);
          a += qf[8 * ks] * k0[0] + qf[8 * ks + 1] * k0[1] + qf[8 * ks + 2] * k0[2] + qf[8 * ks + 3] * k0[3];
          a += qf[8 * ks + 4] * k1[0] + qf[8 * ks + 5] * k1[1] + qf[8 * ks + 6] * k1[2] + qf[8 * ks + 7] * k1[3];
        }
        a += __shfl_xor(a, 32, 64);
        sc[j] = a;
      }
    }
#pragma unroll
    for (int r = 0; r < 3; ++r) {
      if (r < ib) {
        float best = -INFINITY; int bi = 0;
#pragma unroll
        for (int j = 0; j < 16; ++j) if (sc[j] > best) { best = sc[j]; bi = j; }
        selmask |= 1u << bi;
#pragma unroll
        for (int j = 0; j < 16; ++j) if (j == bi) sc[j] = -INFINITY;
      }
    }
  }
  unsigned rem = 0;
  for (int j = 0; j < ib; ++j) if (__ballot((selmask >> j) & 1u) != 0ull) rem |= 1u << j;
  rem = __builtin_amdgcn_readfirstlane(rem);
  const int own0 = 8 * ib, diag = 8 * ib + sub;
  const float cscale = 0.08838834764831845f * 1.4426950408889634f;
  float m = -1e30f, l = 0.f;
  f32x16 O[4];
#pragma unroll
  for (int dt = 0; dt < 4; ++dt)
#pragma unroll
    for (int r = 0; r < 16; ++r) O[dt][r] = 0.f;
  const unsigned char* kbase = (const unsigned char*)p.Kp + (size_t)bh * 128 * 8192 + lane * 16;
  const unsigned char* vbase = (const unsigned char*)p.Vp + (size_t)bh * 128 * 8192 + lane * 16;
  int kt = own0;
  LAS unsigned char* kl = (LAS unsigned char*)km;
  auto issue_K = [&](int t) {
#pragma unroll
    for (int ks = 0; ks < 8; ++ks) __builtin_amdgcn_global_load_lds((const unsigned*)(kbase + (size_t)t * 8192 + ks * 1024), (LAS unsigned*)(kl + ks * 1024), 16, 0, 0);
  };
  asm volatile("s_waitcnt lgkmcnt(0)" ::: "memory");
  issue_K(kt);
#pragma unroll 1
  for (;;) {
    int ktn;
    if (kt >= own0 ? (kt < diag) : ((kt & 7) != 7)) ktn = kt + 1;
    else if (rem == 0u) ktn = -1;
    else { ktn = 8 * (__builtin_ctz(rem)); rem &= rem - 1u; }
    asm volatile("s_waitcnt vmcnt(0)" ::: "memory");
    bf16x8 Kc[8], Vf[8];
#pragma unroll
    for (int ks = 0; ks < 8; ++ks) Kc[ks] = *(const LAS bf16x8*)(kl + lane * 16 + ks * 1024);
#pragma unroll
    for (int f = 0; f < 8; ++f) Vf[f] = *(const bf16x8*)(vbase + (size_t)kt * 8192 + f * 1024);
    asm volatile("s_waitcnt lgkmcnt(0)" ::: "memory");
    if (ktn >= 0) issue_K(ktn);
    f32x16 S;
#pragma unroll
    for (int r = 0; r < 16; ++r) S[r] = 0.f;
#pragma unroll
    for (int ks = 0; ks < 8; ++ks) S = MFMA32(Kc[ks], *(const LAS bf16x8*)(qlds + ks * 1024), S);
    const bool allowed = (kt >= own0) || ((selmask >> (kt >> 3)) & 1u);
    const float nb = allowed ? 0.f : -INFINITY;
    float sv[16]; float mx = -INFINITY;
#pragma unroll
    for (int r = 0; r < 16; ++r) sv[r] = __builtin_fmaf(S[r], cscale, nb);
    if (kt == diag) {
#pragma unroll
      for (int r = 0; r < 16; ++r) if (crow32(r, hh) > q) sv[r] = -INFINITY;
    }
#pragma unroll
    for (int r = 0; r < 16; ++r) mx = fmaxf(mx, sv[r]);
    mx = fmaxf(mx, __shfl_xor(mx, 32, 64));
    const float mn = fmaxf(m, mx);
    const float alpha = __builtin_amdgcn_exp2f(m - mn);
    float ps = 0.f;
#pragma unroll
    for (int r = 0; r < 16; ++r) { sv[r] = __builtin_amdgcn_exp2f(sv[r] - mn); ps += sv[r]; }
    l = l * alpha + ps; m = mn;
    if (__ballot(alpha != 1.f) != 0ull) {
#pragma unroll
      for (int dt = 0; dt < 4; ++dt)
#pragma unroll
        for (int r = 0; r < 16; ++r) O[dt][r] *= alpha;
    }
    const bf16x8 P0 = pack8(sv[0], sv[1], sv[2], sv[3], sv[4], sv[5], sv[6], sv[7]);
    const bf16x8 P1 = pack8(sv[8], sv[9], sv[10], sv[11], sv[12], sv[13], sv[14], sv[15]);
#pragma unroll
    for (int dt = 0; dt < 4; ++dt) { O[dt] = MFMA32(Vf[dt * 2], P0, O[dt]); O[dt] = MFMA32(Vf[dt * 2 + 1], P1, O[dt]); }
    if (ktn < 0) break;
    kt = ktn;
  }
  l += __shfl_xor(l, 32, 64);
  const float inv = 1.f / l;
  bf16_t* orow = p.mb_out + ((size_t)b * SEQ + s0 + q) * p.mb_out_ld + p.mb_out_off + h * 128;
#pragma unroll
  for (int dt = 0; dt < 4; ++dt)
#pragma unroll
    for (int g4 = 0; g4 < 4; ++g4) {
      u32x2 wv; wv.x = pk2(O[dt][4 * g4] * inv, O[dt][4 * g4 + 1] * inv); wv.y = pk2(O[dt][4 * g4 + 2] * inv, O[dt][4 * g4 + 3] * inv);
      *(u32x2*)(orow + 32 * dt + 8 * g4 + 4 * hh) = wv;
    }
}
__device__ void moba_worker(const Params& p, LAS unsigned char* lds, int qi) {
  const int lane = p.tid & 63, w = p.tid >> 6;
  LAS float* km = (LAS float*)(lds + w * 16384);
  for (;;) {
    int idx = 0;
    if (lane == 0) idx = atomicAdd(p.wq + qi, 1);
    idx = __builtin_amdgcn_readfirstlane(idx);
    if (idx >= 2048) break;
    const int ib = 15 - (idx >> 7), rem = idx & 127, bh = rem >> 3, sub = 7 - (rem & 7);
    moba_item(p, km, bh, ib, sub, lane);
  }
}
__device__ void ph_mod(const Params& p, LAS unsigned char* lds, int nblk, int bid) {
  LAS float* sc = (LAS float*)lds;
  LAS float* part = (LAS float*)(lds + 16384);
  const int tid = p.tid;
  if (bid >= 192) return;
  for (int i = tid; i < 4096; i += 512) sc[i] = siluf_(p.c[i]);
  __syncthreads();
  for (int task = bid; task < 192; task += nblk) {
    const int jj = tid & 31, ks = tid >> 5, j = task * 32 + jj;
    float a0 = 0.f, a1 = 0.f, a2 = 0.f, a3 = 0.f;
#pragma unroll 8
    for (int kk = 0; kk < 64; ++kk) {
      const int k = ks * 64 + kk;
      const float w = p.w_ada[(size_t)k * 6144 + j];
      a0 += sc[k] * w; a1 += sc[1024 + k] * w; a2 += sc[2048 + k] * w; a3 += sc[3072 + k] * w;
    }
    *(LAS f32x4*)(part + (ks * 32 + jj) * 4) = (f32x4){a0, a1, a2, a3};
    __syncthreads();
    if (tid < 128) {
      const int j2 = tid & 31, bb = tid >> 5;
      float a = 0.f;
#pragma unroll
      for (int s = 0; s < 16; ++s) a += part[(s * 32 + j2) * 4 + bb];
      p.mod[bb * 6144 + task * 32 + j2] = a + p.b_ada[task * 32 + j2];
    }
    __syncthreads();
  }
}

__device__ __forceinline__ void wt_tile(const float* __restrict__ src, bf16_t* __restrict__ dst, int K, int N, int mode, int k0, int n0, LAS float* tile, const int tid) {
#pragma unroll
  for (int it = 0; it < 2; ++it) {
    const int row = (tid >> 4) + 32 * it, c4 = (tid & 15) * 4, n = n0 + c4;
    f32x4 v = {0.f, 0.f, 0.f, 0.f};
    if (n < N) v = *(const f32x4*)(src + (size_t)(k0 + row) * N + n);
    tile[row * 65 + c4] = v[0]; tile[row * 65 + c4 + 1] = v[1]; tile[row * 65 + c4 + 2] = v[2]; tile[row * 65 + c4 + 3] = v[3];
  }
  __syncthreads();
  {
    const int nl = tid >> 3, kc = tid & 7, n = n0 + nl;
    if (n < N) {
      const int d = map_col(n, mode);
      if (d >= 0) {
        float f[8];
#pragma unroll
        for (int j = 0; j < 8; ++j) f[j] = tile[(8 * kc + j) * 65 + nl];
        u32x4 w; w.x = pk2(f[0], f[1]); w.y = pk2(f[2], f[3]); w.z = pk2(f[4], f[5]); w.w = pk2(f[6], f[7]);
        *(u32x4*)(dst + (size_t)d * K + k0 + 8 * kc) = w;
      }
    }
  }
  __syncthreads();
}
#define WT_T0 1424
#define WT_T1 (WT_T0 + 16384)
#define WT_T2 (WT_T1 + 8192)
#define WT_T3 (WT_T2 + 128)
#define WT_T4 (WT_T3 + 128)
#define WT_T5 (WT_T4 + 256)
__device__ void ph_wt(const Params& p, LAS unsigned char* lds, int nblk, int bid) {
  LAS float* tile = (LAS float*)(lds + 32768);
  for (int t = bid; t < WT_T5; t += nblk) {
    if (t < WT_T0) { const int kt = t / 89, nt = t % 89; wt_tile(p.w_in, p.w_in_t, 1024, INW, 1, kt * 64, nt * 64, tile, p.tid); }
    else if (t < WT_T1) { const int u = t - WT_T0, e = u >> 9, r = u & 511, kt = r >> 5, nt = r & 31;
      wt_tile(p.w_gu + (size_t)e * 1024 * 2048, p.wgu_t + (size_t)e * 2048 * 1024, 1024, 2048, 2, kt * 64, nt * 64, tile, p.tid); }
    else if (t < WT_T2) { const int u = t - WT_T1, e = u >> 8, r = u & 255, kt = r >> 4, nt = r & 15;
      wt_tile(p.w_down + (size_t)e * 1024 * 1024, p.wd_t + (size_t)e * 1024 * 1024, 1024, 1024, 0, kt * 64, nt * 64, tile, p.tid); }
    else if (t < WT_T3) { const int u = t - WT_T2, kt = u >> 4, nt = u & 15; wt_tile(p.w_br_a, p.wbra_t, 512, 1024, 0, kt * 64, nt * 64, tile, p.tid); }
    else if (t < WT_T4) { const int u = t - WT_T3, kt = u >> 4, nt = u & 15; wt_tile(p.w_br_b, p.wbrb_t, 512, 1024, 0, kt * 64, nt * 64, tile, p.tid); }
    else { const int u = t - WT_T4, kt = u >> 4, nt = u & 15; wt_tile(p.w_o, p.wo_t, 1024, 1024, 0, kt * 64, nt * 64, tile, p.tid); }
  }
}

__device__ void ph_h(const Params& p, int nblk, int bid) {
  const int wid = p.tid >> 6, lane = p.tid & 63;
  for (int t = bid * 8 + wid; t < T_TOK; t += nblk * 8) {
    const int b = t / SEQ;
    const float* xr = p.x + (size_t)t * DM;
    float v[16];
    float ss = 0.f;
#pragma unroll
    for (int i = 0; i < 4; ++i) {
      const f32x4 q = *(const f32x4*)(xr + i * 256 + lane * 4);
      v[i * 4 + 0] = q[0]; v[i * 4 + 1] = q[1]; v[i * 4 + 2] = q[2]; v[i * 4 + 3] = q[3];
      ss += q[0] * q[0] + q[1] * q[1] + q[2] * q[2] + q[3] * q[3];
    }
    ss = wave_sum(ss);
    const float rstd = rsqrtf(ss * (1.f / DM) + 1e-6f);
    const float* shift = p.mod + b * 6144;
    const float* scale = p.mod + b * 6144 + 1024;
    float acc[8] = {0, 0, 0, 0, 0, 0, 0, 0};
#pragma unroll
    for (int i = 0; i < 4; ++i) {
      float hv[4];
#pragma unroll
      for (int j = 0; j < 4; ++j) {
        const int k = i * 256 + lane * 4 + j;
        hv[j] = v[i * 4 + j] * rstd * p.g_pre_mix[k] * (1.f + scale[k]) + shift[k];
        const float* wr = p.w_in + (size_t)k * INW + 2048;
        const f32x4 w0 = *(const f32x4*)wr, w1 = *(const f32x4*)(wr + 4);
        acc[0] += hv[j] * w0[0]; acc[1] += hv[j] * w0[1]; acc[2] += hv[j] * w0[2]; acc[3] += hv[j] * w0[3];
        acc[4] += hv[j] * w1[0]; acc[5] += hv[j] * w1[1]; acc[6] += hv[j] * w1[2]; acc[7] += hv[j] * w1[3];
      }
      u32x2 pk; pk.x = pk2(hv[0], hv[1]); pk.y = pk2(hv[2], hv[3]);
      *(u32x2*)(p.hbf + (size_t)t * DM + i * 256 + lane * 4) = pk;
    }
#pragma unroll
    for (int e = 0; e < 8; ++e) acc[e] = wave_sum(acc[e]);
    if (lane == 0) { *(f32x4*)(p.ba + (size_t)t * 8) = (f32x4){acc[0], acc[1], acc[2], acc[3]}; *(f32x4*)(p.ba + (size_t)t * 8 + 4) = (f32x4){acc[4], acc[5], acc[6], acc[7]}; }
  }
}

__device__ void ph_post_mix(const Params& p, LAS unsigned char* lds, int nblk, int bid, int rep) {
  const int wid = p.tid >> 6, lane = p.tid & 63;
  LAS bf16_t* wl = (LAS bf16_t*)lds;
  LAS float* sh = (LAS float*)(lds + 81920) + wid * 1024;
  LAS int* lcnt = (LAS int*)(lds + 114688);
  LAS int* lbase = lcnt + 32;
  LAS int* lent = (LAS int*)(lds + 115200) + wid * 256;
  int nloc = 0;
  if (p.tid < 32) lcnt[p.tid] = 0;
  for (int i = p.tid; i < 1024 * 8; i += 512) {
    const int k = i >> 3, c = i & 7;
    const f32x4 v = *(const f32x4*)(p.w_router + (size_t)k * 32 + c * 4);
    u32x2 w2; w2.x = pk2(v[0], v[1]); w2.y = pk2(v[2], v[3]);
    *(LAS u32x2*)(wl + k * 40 + c * 4) = w2;
  }
  __syncthreads();
  for (int t = bid * 8 + wid; t < T_TOK; t += nblk * 8) {
    const int b = t / SEQ;
    const float* md = p.mod + b * 6144;
    float mv[16];
    float ss = 0.f;
#pragma unroll
    for (int i = 0; i < 2; ++i) {
      float f[8]; unpack8(*(const u32x4*)(p.mixer + (size_t)t * DM + i * 512 + lane * 8), f);
#pragma unroll
      for (int j = 0; j < 8; ++j) { mv[i * 8 + j] = f[j]; ss += f[j] * f[j]; }
    }
    ss = wave_sum(ss);
    const float rstd = rsqrtf(ss * (1.f / DM) + 1e-6f);
    float x1[16];
    float s2 = 0.f;
#pragma unroll
    for (int i = 0; i < 2; ++i)
#pragma unroll
      for (int j4 = 0; j4 < 2; ++j4) {
        const int k = i * 512 + lane * 8 + j4 * 4;
        const f32x4 xv = *(const f32x4*)(p.x + (size_t)t * DM + k);
        const f32x4 gm = *(const f32x4*)(md + 2048 + k), gp = *(const f32x4*)(p.g_post_mix + k);
        f32x4 o;
#pragma unroll
        for (int j = 0; j < 4; ++j) { o[j] = xv[j] + gm[j] * (mv[i * 8 + j4 * 4 + j] * rstd * gp[j]); x1[i * 8 + j4 * 4 + j] = o[j]; s2 += o[j] * o[j]; }
        *(f32x4*)(p.out + (size_t)t * DM + k) = o;
      }
    s2 = wave_sum(s2);
    const float rstd2 = rsqrtf(s2 * (1.f / DM) + 1e-6f);
#pragma unroll
    for (int i = 0; i < 2; ++i) {
      float hv[8];
#pragma unroll
      for (int j = 0; j < 8; ++j) {
        const int k = i * 512 + lane * 8 + j;
        hv[j] = x1[i * 8 + j] * rstd2 * p.g_pre_ffn[k] * (1.f + md[4096 + k]) + md[3072 + k];
        sh[k] = hv[j];
      }
      u32x4 w; w.x = pk2(hv[0], hv[1]); w.y = pk2(hv[2], hv[3]); w.z = pk2(hv[4], hv[5]); w.w = pk2(hv[6], hv[7]);
      *(u32x4*)(p.h2 + (size_t)t * DM + i * 512 + lane * 8) = w;
    }
#ifdef PM_SKIP
    if (rep) continue;
#endif
    float acc[32];
#pragma unroll
    for (int e2 = 0; e2 < 32; ++e2) acc[e2] = 0.f;
#pragma unroll 4
    for (int i = 0; i < 16; ++i) {
      const float hk = sh[lane + 64 * i];
      const LAS u32x4* wr = (const LAS u32x4*)(wl + (lane + 64 * i) * 40);
#pragma unroll
      for (int c4 = 0; c4 < 4; ++c4) {
        float f[8]; unpack8(wr[c4], f);
#pragma unroll
        for (int j = 0; j < 8; ++j) acc[c4 * 8 + j] += hk * f[j];
      }
    }
    {
      const bool u5 = lane & 32, u4 = lane & 16, u3 = lane & 8, u2 = lane & 4, u1 = lane & 2;
      float a16[16], a8[8], a4[4], a2[2];
#pragma unroll
      for (int j = 0; j < 16; ++j) { const float snd = u5 ? acc[j] : acc[16 + j]; const float rcv = __shfl_xor(snd, 32, 64); a16[j] = (u5 ? acc[16 + j] : acc[j]) + rcv; }
#pragma unroll
      for (int j = 0; j < 8; ++j) { const float snd = u4 ? a16[j] : a16[8 + j]; const float rcv = __shfl_xor(snd, 16, 64); a8[j] = (u4 ? a16[8 + j] : a16[j]) + rcv; }
#pragma unroll
      for (int j = 0; j < 4; ++j) { const float snd = u3 ? a8[j] : a8[4 + j]; const float rcv = __shfl_xor(snd, 8, 64); a4[j] = (u3 ? a8[4 + j] : a8[j]) + rcv; }
#pragma unroll
      for (int j = 0; j < 2; ++j) { const float snd = u2 ? a4[j] : a4[2 + j]; const float rcv = __shfl_xor(snd, 4, 64); a2[j] = (u2 ? a4[2 + j] : a4[j]) + rcv; }
      const float snd = u1 ? a2[0] : a2[1]; const float rcv = __shfl_xor(snd, 2, 64);
      float a1 = (u1 ? a2[1] : a2[0]) + rcv;
      a1 += __shfl_xor(a1, 1, 64);
      acc[0] = a1;
    }
    const int e = lane >> 1;
    float lg = acc[0] + p.b_router[e];
    if (lane & 1) lg = -INFINITY;
    float tv[4]; int ti[4];
#pragma unroll
    for (int r = 0; r < 4; ++r) {
      const float m = wave_max(lg);
      const unsigned long long bal = __ballot(lg == m);
      const int idx = __ffsll((long long)bal) - 1;
      tv[r] = m; ti[r] = idx >> 1;
      if (lane == idx) lg = -INFINITY;
    }
    const float e1 = __expf(tv[1] - tv[0]), e2 = __expf(tv[2] - tv[0]), e3 = __expf(tv[3] - tv[0]);
    const float inv = 1.f / (1.f + e1 + e2 + e3);
    if (lane < 4) {
      const int ee = lane == 0 ? ti[0] : lane == 1 ? ti[1] : lane == 2 ? ti[2] : ti[3];
      const float ww = (lane == 0 ? 1.f : lane == 1 ? e1 : lane == 2 ? e2 : e3) * inv;
      p.aw[t * 4 + lane] = ww;
      const int rank = __hip_atomic_fetch_add(&lcnt[ee], 1, __ATOMIC_RELAXED, __HIP_MEMORY_SCOPE_WORKGROUP);
      lent[nloc * 4 + lane] = (ee << 16) | rank;
      lent[nloc * 4 + lane + 2048] = t * 4 + lane;
    }
    ++nloc;
  }
  __syncthreads();
  if (p.tid < 32) lbase[p.tid] = atomicAdd(&p.cnt[p.tid * 64 + 32 * rep], lcnt[p.tid]);
  __syncthreads();
  for (int i = lane; i < nloc * 4; i += 64) {
    const int er = lent[i], a = lent[i + 2048];
    p.elist[(er >> 16) * T_TOK + lbase[er >> 16] + (er & 0xffff)] = a;
  }
}

__device__ void ph_gather(const Params& p, LAS unsigned char* lds, int nblk, int bid) {
  const int wid = p.tid >> 6, lane = p.tid & 63;
  LAS int* tb = (LAS int*)lds;
  if (p.tid == 0) { int off = 0; for (int k = 0; k < NE; ++k) { const int c = p.cnt[k * 64]; tb[k] = off; tb[64 + k] = c; off += ((c + 255) >> 8) << 8; } tb[NE] = off; }
  __syncthreads();
  const int total = tb[NE];
  for (int r = bid * 8 + wid; r < total; r += nblk * 8) {
    int e = 0;
#pragma unroll 1
    for (int k = 1; k < NE; ++k) if (r >= tb[k]) e = k;
    const int i = r - tb[e];
    const int a = (i < tb[64 + e]) ? p.elist[e * T_TOK + i] : -1;
    if (lane == 0) p.rowmap[r] = a;
    u32x4 v0 = {0, 0, 0, 0}, v1 = v0;
    if (a >= 0) { const u32x4* src = (const u32x4*)(p.h2 + (size_t)(a >> 2) * DM); v0 = src[lane]; v1 = src[64 + lane]; }
    u32x4* dst = (u32x4*)(p.xs + (size_t)r * DM);
    dst[lane] = v0; dst[64 + lane] = v1;
  }
}

__device__ void ph_final(const Params& p, int nblk, int bid, int rep) {
  const int wid = p.tid >> 6, lane = p.tid & 63;
  for (int t = bid * 8 + wid; t < T_TOK; t += nblk * 8) {
    const int b = t / SEQ;
    const float* md = p.mod + b * 6144;
    const f32x4 wv = *(const f32x4*)(p.aw + t * 4);
    float mv[16];
    float ss = 0.f;
#pragma unroll
    for (int i = 0; i < 2; ++i) {
      const bf16_t* y = p.yslot + (size_t)t * 4 * DM + i * 512 + lane * 8;
      float f0[8], f1[8], f2[8], f3[8];
      unpack8(*(const u32x4*)y, f0); unpack8(*(const u32x4*)(y + DM), f1); unpack8(*(const u32x4*)(y + 2 * DM), f2); unpack8(*(const u32x4*)(y + 3 * DM), f3);
#pragma unroll
      for (int j = 0; j < 8; ++j) { const float m = wv[0] * f0[j] + wv[1] * f1[j] + wv[2] * f2[j] + wv[3] * f3[j]; mv[i * 8 + j] = m; ss += m * m; }
    }
    ss = wave_sum(ss);
    const float rstd = rsqrtf(ss * (1.f / DM) + 1e-6f);
#pragma unroll
    for (int i = 0; i < 2; ++i)
#pragma unroll
      for (int j4 = 0; j4 < 2; ++j4) {
        const int k = i * 512 + lane * 8 + j4 * 4;
        float* op = p.out + (size_t)t * DM + k;
        const f32x4 x1 = *(const f32x4*)op, gf = *(const f32x4*)(md + 5120 + k), gp = *(const f32x4*)(p.g_post_ffn + k);
        f32x4 o;
#pragma unroll
        for (int j = 0; j < 4; ++j) o[j] = x1[j] + gf[j] * (mv[i * 8 + j4 * 4 + j] * rstd * gp[j]);
        *(f32x4*)(rep ? (float*)p.hbf + (size_t)(t & 8191) * DM + k : op) = o;
      }
  }
}

#define XCD_BAR_WORDS 3456
struct KArgs { const void* in[22]; float* out; char* ws; long long never; };
__host__ __device__ inline size_t al(size_t x) { return (x + 255) & ~(size_t)255; }
__host__ __device__ inline void fill_params(Params& p, const KArgs& k) {
  p.x = (const float*)k.in[0]; p.c = (const float*)k.in[1]; p.w_ada = (const float*)k.in[2]; p.b_ada = (const float*)k.in[3];
  p.g_pre_mix = (const float*)k.in[4]; p.g_post_mix = (const float*)k.in[5]; p.g_pre_ffn = (const float*)k.in[6];
  p.g_post_ffn = (const float*)k.in[7]; p.w_in = (const float*)k.in[8]; p.conv_w = (const float*)k.in[9];
  p.a_log = (const float*)k.in[10]; p.dt_bias = (const float*)k.in[11]; p.g_dn_out = (const float*)k.in[12];
  p.w_br_a = (const float*)k.in[13]; p.w_br_b = (const float*)k.in[14]; p.w_o = (const float*)k.in[15];
  p.w_router = (const float*)k.in[16]; p.b_router = (const float*)k.in[17]; p.w_gu = (const float*)k.in[18];
  p.b_gu = (const float*)k.in[19]; p.w_down = (const float*)k.in[20]; p.b_down = (const float*)k.in[21];
  p.out = k.out;
  char* w = k.ws;
  size_t o = 0;
#define take(bytes) (w + (o += al(bytes)) - al(bytes))
  p.mod = (float*)take(4 * 6144 * 4);
  p.cnt = (int*)take(16384);
  p.ba = (float*)take((size_t)T_TOK * 8 * 4);
  p.hbf = (bf16_t*)take((size_t)T_TOK * DM * 2);
  p.proj = (bf16_t*)take((size_t)T_TOK * PW * 2);
  p.w_in_t = (bf16_t*)take((size_t)PW * DM * 2);
  p.wgu_t = (bf16_t*)take((size_t)NE * 2048 * DM * 2);
  p.wd_t = (bf16_t*)take((size_t)NE * 1024 * DM * 2);
  p.wbra_t = (bf16_t*)take((size_t)1024 * 512 * 2);
  p.wbrb_t = (bf16_t*)take((size_t)1024 * 512 * 2);
  p.wo_t = (bf16_t*)take((size_t)1024 * 1024 * 2);
  p.qb = (bf16_t*)take((size_t)T_TOK * 512 * 2);
  p.kb = (bf16_t*)take((size_t)T_TOK * 512 * 2);
  p.kmean = (float*)take((size_t)16 * 16 * 128 * 4);
  p.oab = (bf16_t*)take((size_t)T_TOK * DM * 2);
  p.merged = (bf16_t*)take((size_t)T_TOK * DM * 2);
  p.mixer = (bf16_t*)take((size_t)T_TOK * DM * 2);
  p.h2 = (bf16_t*)take((size_t)T_TOK * DM * 2);
  p.elist = (int*)take((size_t)NE * T_TOK * 4);
  p.aw = (float*)take((size_t)T_TOK * 4 * 4);
  p.rowmap = (int*)take((size_t)73728 * 4);
  p.dnA = (unsigned char*)take((size_t)1024 * DN_ABYTES);
  p.dnU = (float*)take((size_t)1024 * DN_UFLOATS * 4);
  p.dnG = (float*)take(4096);
  p.oab2 = (bf16_t*)take((size_t)T_TOK * 512 * 2);
  p.dbg = (float*)take(256);
  p.bar = (unsigned*)take(XCD_BAR_WORDS * 4);
  p.dn_out = p.oab; p.dn_out_ld = DM;
  p.Kp = (bf16_t*)take((size_t)16 * 128 * 8192);
  p.Vp = (bf16_t*)take((size_t)16 * 128 * 8192);
  p.wq = p.cnt + 32 * 64;
  p.mb_out = p.oab; p.mb_out_ld = DM; p.mb_out_off = 512;
  p.xs = p.proj;
  char* big = take((size_t)73728 * DM * 2 + (size_t)65536 * DM * 2);
  p.act = (bf16_t*)big;
  p.yslot = (bf16_t*)(big + (size_t)73728 * DM * 2);
  {
    char* s = big; size_t so = 0;
#define t2(bytes) (s + (so += al(bytes)) - al(bytes))
    p.nq = (float*)t2((size_t)T_TOK * 512 * 4);
    p.nk = (float*)t2((size_t)T_TOK * 512 * 4);
    p.nv = (float*)t2((size_t)T_TOK * 512 * 4);
    p.no = (float*)t2((size_t)T_TOK * 512 * 4);
    p.ntmp = (float*)t2((size_t)T_TOK * DM * 4);
    p.nbeta = (float*)t2((size_t)T_TOK * 4 * 4);
    p.ng = (float*)t2((size_t)T_TOK * 4 * 4);
  }

#undef take
#undef t2
  p.never = (int)k.never;
}

#define XB_TMO      128
#define XB_XCNT(j)  (256  + 64 * (j))
#define XB_XSUB(j)  (1280 + 64 * (j))
#define XB_XGEN(j)  (2304 + 64 * (j))
#define XB_TOP      3328
#define XB_TOPGEN   3392
#define XB_SPIN_CAP (1u << 18)

__device__ __forceinline__ unsigned xb_ld(unsigned* p)              { return __hip_atomic_load(p, __ATOMIC_RELAXED, __HIP_MEMORY_SCOPE_AGENT); }
__device__ __forceinline__ unsigned xb_add(unsigned* p, unsigned v) { return __hip_atomic_fetch_add(p, v, __ATOMIC_RELAXED, __HIP_MEMORY_SCOPE_AGENT); }
__device__ __forceinline__ unsigned xb_xcc_id() { return (unsigned)__builtin_amdgcn_s_getreg((3 << 11) | 20) & 0xFu; }
#define XB_SPIN(cond, bar) do { unsigned _sp = 0; while (cond) { __builtin_amdgcn_s_sleep(1); \
    if ((++_sp & 255u) == 0u) { if (xb_ld(&(bar)[XB_TMO])) break; if (_sp > XB_SPIN_CAP) { atomicAdd(&(bar)[XB_TMO], 1u); break; } } } } while (0)

struct XcdBarrier {
    unsigned* bar; unsigned x;
    volatile LAS unsigned* st;
};

__device__ __forceinline__ XcdBarrier xcd_barrier_post(unsigned* bar, volatile LAS unsigned* st) {
    XcdBarrier b; b.bar = bar; b.x = xb_xcc_id(); b.st = st;
    if (threadIdx.x == 0) (void)xb_add(&bar[XB_XCNT(b.x)], 1u);
    return b;
}
__device__ __forceinline__ void xcd_barrier_complete(unsigned* bar, unsigned x, unsigned& nloc, unsigned& nx) {
    const unsigned G = gridDim.x * gridDim.y * gridDim.z;
    unsigned sum, cnt, mine, sp = 0u;
    for (;;) {
        sum = 0u; cnt = 0u; mine = 0u;
#pragma unroll
        for (unsigned j = 0; j < 16; ++j) { const unsigned c = xb_ld(&bar[XB_XCNT(j)]); sum += c; cnt += (c > 0u) ? 1u : 0u; mine = (j == x) ? c : mine; }
        if (sum == G) break;
        __builtin_amdgcn_s_sleep(1);
        if ((++sp & 255u) == 0u) { if (xb_ld(&bar[XB_TMO])) break; if (sp > XB_SPIN_CAP) { atomicAdd(&bar[XB_TMO], 1u); break; } }
    }
    nloc = mine > 0u ? mine : 1u; nx = cnt > 0u ? cnt : 1u;
}

__device__ __forceinline__ void xcd_barrier(const XcdBarrier& b, const int tid) {
    asm volatile("s_waitcnt vmcnt(0)" ::: "memory");
    __syncthreads();
    if (tid == 0) {
        unsigned* bar = b.bar;
        __builtin_amdgcn_s_waitcnt(0);
        unsigned nloc = b.st[0], nx = b.st[1];
        if (nloc == 0u) { xcd_barrier_complete(bar, b.x, nloc, nx); b.st[0] = nloc; b.st[1] = nx; }
        const unsigned old = xb_add(&bar[XB_XSUB(b.x)], 1u);
        const unsigned gen = old / nloc;
        if (old + 1u == (gen + 1u) * nloc) {
            __builtin_amdgcn_fence(__ATOMIC_RELEASE, "agent");
            asm volatile("s_waitcnt vmcnt(0)" ::: "memory");
            const unsigned og = xb_add(&bar[XB_TOP], 1u);
            const unsigned tg = og / nx;
            if (og + 1u == (tg + 1u) * nx) xb_add(&bar[XB_TOPGEN], 1u);
            else XB_SPIN(xb_ld(&bar[XB_TOPGEN]) == tg, bar);
            __builtin_amdgcn_fence(__ATOMIC_ACQUIRE, "agent");
            xb_add(&bar[XB_XGEN(b.x)], 1u);
            asm volatile("s_waitcnt vmcnt(0)" ::: "memory");
        } else {
            XB_SPIN(xb_ld(&bar[XB_XGEN(b.x)]) == gen, bar);
            __builtin_amdgcn_fence(__ATOMIC_ACQUIRE, "agent");
            asm volatile("s_waitcnt vmcnt(0)" ::: "memory");
        }
    }
    __syncthreads();
}


__device__ __forceinline__ void load_ka(KArgs& kk) {
#if defined(__HIP_DEVICE_COMPILE__)
  typedef __attribute__((address_space(1))) char* gptr_t;
  typedef const __attribute__((address_space(4))) gptr_t* kptr_t;
  kptr_t kp = (kptr_t)__builtin_amdgcn_kernarg_segment_ptr();
  asm volatile("" : "+s"(kp));
#pragma unroll
  for (int i = 0; i < 22; ++i) kk.in[i] = (const void*)kp[i];
  kk.out = (float*)kp[22];
  kk.ws = (char*)kp[23];
  kk.never = ((const __attribute__((address_space(4))) long long*)kp)[24];
#endif
}
__device__ __forceinline__ void grid_bar(const Params& p, LAS unsigned char* lds);
#define MEGA_LDS 148480
#define MEGA_LDS_ALLOC (MEGA_LDS + 16)
__device__ __forceinline__ void grid_bar(const Params& p, LAS unsigned char* lds) {
  XcdBarrier b; b.bar = p.bar; b.x = xb_xcc_id(); b.st = (volatile LAS unsigned*)(lds + MEGA_LDS);
  xcd_barrier(b, p.tid);
}
__global__ __launch_bounds__(512) void mega(KArgs ka) {
  extern __shared__ __attribute__((aligned(16))) unsigned char shm[];
  LAS unsigned char* lds = (LAS unsigned char*)shm;
  cg::grid_group grid = cg::this_grid();
  const int nblk = gridDim.x, bid = blockIdx.x;
  volatile LAS unsigned* xst = (volatile LAS unsigned*)(lds + MEGA_LDS);
  if (threadIdx.x == 0) { xst[0] = 0u; xst[1] = 0u; xst[2] = 0u; xst[3] = 0u; }
  __syncthreads();
  { Params p0; fill_params(p0, ka); (void)xcd_barrier_post(p0.bar, xst); }
  if (ka.never) grid.sync();
#ifndef REPMASK
#define REPMASK 0
#endif
#define LOADKA KArgs kk; load_ka(kk)
#ifndef PHMASK
#define PHMASK 0xffff
#endif
#define PHASE(k, body) if (((PHMASK) >> (k)) & 1) for (int rep_ = 0; rep_ < (((REPMASK) >> (k)) & 1) + 1; ++rep_) { \
    LOADKA; Params p; fill_params(p, kk); { int t_ = threadIdx.x; asm volatile("" : "+v"(t_)); p.tid = t_; } body; grid_bar(p, lds); }
#ifdef XBAR
  for (int xb_ = 0; xb_ < XBAR; ++xb_) { PHASE(15, {}) }
#endif
  PHASE(0, { ph_mod(p, lds, nblk, bid); ph_wt(p, lds, nblk, bid); })
  PHASE(1, { ph_h(p, nblk, bid); })
  PHASE(2, { ph_proj(p, lds, nblk, bid); })
  PHASE(3, { bool first = true; for (int ci = bid; ci < 1024; ci += nblk) { dn_prep_chunk(p, lds, ci, first); first = false; }
             for (int item = bid; item < 256; item += nblk) moba_prep_block(p, lds, item); })
  PHASE(4, { if (bid < 32) dn_scan_blk(p, lds, bid); moba_worker(p, lds, rep_); })
  PHASE(5, { ph_dn_norm(p, nblk, bid); })
  PHASE(6, { ph_br(p, lds, nblk, bid); })
  PHASE(7, { ph_mix(p, lds, nblk, bid); })
  PHASE(8, { ph_post_mix(p, lds, nblk, bid, rep_); })
  PHASE(9, { ph_gather(p, lds, nblk, bid); })
  PHASE(10, { ph_moe1(p, lds, nblk, bid); })
  PHASE(11, { ph_moe2(p, lds, nblk, bid); })
  PHASE(12, { ph_final(p, nblk, bid, rep_); })
}


extern "C" void kernel_launch(void* const* d_in, const int* in_sizes, int n_in, void* d_out, int out_size, void* d_ws,
                              size_t ws_size, hipStream_t stream) {
  KArgs ka{};
  for (int i = 0; i < 22; ++i) ka.in[i] = d_in[i];
  ka.out = (float*)d_out; ka.ws = (char*)d_ws; ka.never = 0;
  Params p{};
  fill_params(p, ka);
  static int grid_blocks = 0;
  if (!grid_blocks) {
    (void)hipFuncSetAttribute((const void*)mega, hipFuncAttributeMaxDynamicSharedMemorySize, MEGA_LDS_ALLOC);
    int dev = 0, cus = 0, per_cu = 0;
    (void)hipGetDevice(&dev);
    (void)hipDeviceGetAttribute(&cus, hipDeviceAttributeMultiprocessorCount, dev);
    (void)hipOccupancyMaxActiveBlocksPerMultiprocessor(&per_cu, mega, 512, MEGA_LDS_ALLOC);
    if (per_cu != 1) per_cu = 1;
    grid_blocks = cus * per_cu;
  }
  (void)hipMemsetAsync(p.cnt, 0, 16384, stream);
  (void)hipMemsetAsync(p.bar, 0, XCD_BAR_WORDS * 4, stream);
  void* args[] = {&ka};
  hipError_t e = hipLaunchCooperativeKernel((void*)mega, dim3(grid_blocks), dim3(512), args, MEGA_LDS_ALLOC, stream);
  if (e != hipSuccess) fprintf(stderr, "cooperative launch failed: %s (grid %d)\n", hipGetErrorString(e), grid_blocks);
}
```

```cpp
#include <hip/hip_runtime.h>
#include <hip/hip_cooperative_groups.h>
#include <cstdio>
namespace cg = cooperative_groups;
#include <stdint.h>

typedef unsigned short bf16_t;

#define T_TOK 16384
#define SEQ 4096
#define NB 4
#define DM 1024
#define INW 5640
#define PW 5632
#define C_QA 0
#define C_KA 512
#define C_VA 1024
#define C_Z 1536
#define C_MQ 2048
#define C_MK 2560
#define C_MV 3072
#define C_GA 3584
#define C_GB 4608
#define NE 32

__device__ __forceinline__ bf16_t f2bf(float f) {
  unsigned u = __float_as_uint(f);
  u += 0x7fffu + ((u >> 16) & 1u);
  return (bf16_t)(u >> 16);
}
__device__ __forceinline__ float bf2f(bf16_t h) { return __uint_as_float(((unsigned)h) << 16); }
__device__ __forceinline__ float sigmoidf_(float x) { return 1.f / (1.f + __expf(-x)); }
__device__ __forceinline__ float siluf_(float x) { return x / (1.f + __expf(-x)); }
__device__ __forceinline__ float wave_sum(float v) {
#pragma unroll
  for (int o = 32; o > 0; o >>= 1) v += __shfl_xor(v, o, 64);
  return v;
}
__device__ __forceinline__ float wave_max(float v) {
#pragma unroll
  for (int o = 32; o > 0; o >>= 1) v = fmaxf(v, __shfl_xor(v, o, 64));
  return v;
}

typedef __bf16 bf16x2_t __attribute__((ext_vector_type(2)));
typedef float f32x2_t __attribute__((ext_vector_type(2)));
__device__ __forceinline__ unsigned pk2(float a, float b) { f32x2_t v = {a, b}; bf16x2_t r = __builtin_convertvector(v, bf16x2_t); return __builtin_bit_cast(unsigned, r); }

struct Params {
  const float *x, *c, *w_ada, *b_ada, *g_pre_mix, *g_post_mix, *g_pre_ffn, *g_post_ffn, *w_in, *conv_w,
      *a_log, *dt_bias, *g_dn_out, *w_br_a, *w_br_b, *w_o, *w_router, *b_router, *w_gu, *b_gu, *w_down, *b_down;
  float* out;
  float* mod;
  int* cnt;
  float* ba;
  bf16_t* hbf;
  bf16_t* proj;
  bf16_t* w_in_t;
  bf16_t* wgu_t;
  bf16_t* wd_t;
  bf16_t* wbra_t;
  bf16_t* wbrb_t;
  bf16_t* wo_t;
  bf16_t* qb;
  bf16_t* kb;
  float* kmean;
  bf16_t* oab;
  bf16_t* merged;
  bf16_t* mixer;
  bf16_t* h2;
  int* elist;
  float* aw;
  bf16_t* act;
  bf16_t* xs;
  int* rowmap;
  bf16_t* yslot;
  unsigned char* dnA; float* dnU; float* dnG;
  bf16_t* dn_out; int dn_out_ld;
  bf16_t* oab2; float* dbg;
  unsigned* bar; int never; int tid;
  bf16_t* Kp; bf16_t* Vp; int* wq;
  bf16_t* mb_out; int mb_out_ld; int mb_out_off;
  float* nq; float* nk; float* nv;
  float* nbeta; float* ng;
  float* no;
  float* ntmp;
};

__device__ __forceinline__ int map_col(int n, int mode) {
  if (mode == 0) return n;
  if (mode == 1) return n < 2048 ? n : (n < 2056 ? -1 : n - 8);
  if (n < 1024) return (n >> 7) * 256 + (n & 127);
  int j = n - 1024;
  return (j >> 7) * 256 + 128 + (j & 127);
}
namespace pg8 {
#define PG8_LAS __attribute__((address_space(3)))
typedef short bf16x8 __attribute__((ext_vector_type(8)));
typedef float f32x4 __attribute__((ext_vector_type(4)));
typedef unsigned u32x4 __attribute__((ext_vector_type(4)));
constexpr int BM = 256, BK = 64, HALF = 128, HTB = HALF * BK * 2, STAGE_BYTES = 8 * HTB, NXCD = 8, WGM = 8;

__host__ __device__ __forceinline__ int lds_byte(int r, int c) { const int st = (r >> 4) * 2 + (c >> 5), rr = r & 15, cc = c & 31, ob = rr * 64 + cc * 2; return st * 1024 + (ob ^ (((ob >> 9) & 1) << 5)); }
__host__ __device__ __forceinline__ void stage_rc(int b, int& R, int& C) { const int st = b / 1024, sb = b % 1024, swz = sb ^ (((sb >> 9) & 1) << 5); R = (st >> 1) * 16 + swz / 64; C = (st & 1) * 32 + (swz % 64) / 2; }
__host__ __device__ __forceinline__ int perm32(int rho) { const int n = rho >> 4, i = rho & 15; return 8 * (i >> 2) + 4 * n + (i & 3); }

struct Unit { int pm, pn, z; };
__device__ __forceinline__ unsigned cvt_pk_bf16(float lo, float hi) { unsigned r; asm volatile("v_cvt_pk_bf16_f32 %0, %1, %2" : "=v"(r) : "v"(lo), "v"(hi)); return r; }

struct TileOrder {
    int nM, nN, nwg, G, c;
    __device__ void init(int nM_, int nN_, int G_, int c_) { nM = nM_; nN = nN_; nwg = nM * nN; G = G_; c = c_; }
    __device__ bool tile(int i, int& pm, int& pn) const {
        const long L = (long)i * G + c; if (L >= nwg) return false;
        int wgid = (int)L; { const int q = nwg / NXCD, r = nwg % NXCD, xcd = wgid % NXCD, off = wgid / NXCD; wgid = (xcd < r ? xcd * (q + 1) : r * (q + 1) + (xcd - r) * q) + off; }
        const int nig = WGM * nN, gid = wgid / nig, fm = gid * WGM, gsz = (nM - fm) < WGM ? (nM - fm) : WGM;
        pm = fm + ((wgid % nig) % gsz); pn = (wgid % nig) / gsz; return true;
    }
};

template <class Epi, class Sched>
__device__ __forceinline__ void gemm_phase(PG8_LAS unsigned char* lds, const int tid, const int lda, const int ldb, const int K, const Sched& S, const Epi& E) {
    const int wid = __builtin_amdgcn_readfirstlane(tid >> 6), lane = tid & 63, wr = wid >> 2, wc = wid & 3, fr = lane & 15, fq = lane >> 4;
    const int nt = K / BK;
    unsigned voffA[2], voffB[2];
#pragma unroll
    for (int i = 0; i < 2; ++i) { int R, C; stage_rc(tid * 16 + i * 8192, R, C); const int Rb = Epi::PERM ? ((R & ~31) + perm32(R & 31)) : R;
        voffA[i] = (unsigned)(R * lda + C) * 2u; voffB[i] = (unsigned)(Rb * ldb + C) * 2u; }
    const size_t kstep = (size_t)(BK * 2);
    const size_t hstepA = (size_t)HALF * lda * 2, hstepB = (size_t)HALF * ldb * 2;
    const unsigned ldsw = (unsigned)wid * 1024u;
    const int aoff = lds_byte(wr * 64 + fr, fq * 8), boff = lds_byte(wc * 32 + fr, fq * 8);
#define PG8_SA(b, h) (((b) * 2 + (h)) * HTB)
#define PG8_SB(b, h) ((4 + (b) * 2 + (h)) * HTB)
#define PG8_STAGE(bufoff, gbase, voff) do { _Pragma("unroll") for (int _i = 0; _i < 2; ++_i) \
        __builtin_amdgcn_global_load_lds((const unsigned*)((const char*)(gbase) + (voff)[_i]), (PG8_LAS unsigned*)(lds + (bufoff) + ldsw + _i * 8192), 16, 0, 0); } while (0)
#define PG8_LDA(dst, b, h) do { _Pragma("unroll") for (int m = 0; m < 4; ++m) _Pragma("unroll") for (int k = 0; k < 2; ++k) dst[m][k] = *(const PG8_LAS bf16x8*)(lds + PG8_SA(b, h) + aoff + m * 2048 + k * 1024); } while (0)
#define PG8_LDB(dst, b, h) do { _Pragma("unroll") for (int n = 0; n < 2; ++n) _Pragma("unroll") for (int k = 0; k < 2; ++k) dst[n][k] = *(const PG8_LAS bf16x8*)(lds + PG8_SB(b, h) + boff + n * 2048 + k * 1024); } while (0)
#define PG8_MMA(ai, bj, At, Bt) do { __builtin_amdgcn_s_setprio(1); _Pragma("unroll") for (int m = 0; m < 4; ++m) _Pragma("unroll") for (int n = 0; n < 2; ++n) _Pragma("unroll") for (int k = 0; k < 2; ++k) \
        acc[ai][bj][m][n] = __builtin_amdgcn_mfma_f32_16x16x32_bf16(Bt[n][k], At[m][k], acc[ai][bj][m][n], 0, 0, 0); __builtin_amdgcn_s_setprio(0); } while (0)
#define PG8_WAIT_V(n) asm volatile("s_waitcnt vmcnt(" #n ")" ::: "memory")
#define PG8_WAIT_L(n) asm volatile("s_waitcnt lgkmcnt(" #n ")" ::: "memory")
#define PG8_BAR __builtin_amdgcn_s_barrier()
#define PG8_SCHED __builtin_amdgcn_sched_barrier(0)
    Unit cur, nxt; int ui = 0;
    if (!S.next(0, cur)) return;
    f32x4 acc[2][2][4][2];
#pragma unroll
    for (int a = 0; a < 2; ++a)
#pragma unroll
        for (int b = 0; b < 2; ++b)
#pragma unroll
            for (int m = 0; m < 4; ++m)
#pragma unroll
                for (int n = 0; n < 2; ++n) acc[a][b][m][n] = (f32x4){0.f, 0.f, 0.f, 0.f};
    bf16x8 At[4][2], B0[2][2], B1[2][2];
    const char* cA = S.a_ptr(cur); const char* cB = S.b_ptr(cur);
    PG8_STAGE(PG8_SB(0, 0), cB, voffB); PG8_STAGE(PG8_SA(0, 0), cA, voffA); PG8_STAGE(PG8_SB(0, 1), cB + hstepB, voffB); PG8_STAGE(PG8_SA(0, 1), cA + hstepA, voffA);
    if (wr == 1) PG8_BAR;
    PG8_WAIT_V(4); PG8_BAR;
    PG8_STAGE(PG8_SB(1, 0), cB + kstep, voffB); PG8_STAGE(PG8_SA(1, 0), cA + kstep, voffA); PG8_STAGE(PG8_SB(1, 1), cB + hstepB + kstep, voffB);
    PG8_WAIT_V(6); PG8_BAR;
    for (;;) {
        const bool has_next = S.next(ui + 1, nxt);
        const char* nA = has_next ? S.a_ptr(nxt) : cA; const char* nB = has_next ? S.b_ptr(nxt) : cB;
        for (int t = 0; t < nt; t += 2) {
            const bool last = (t == nt - 2);
            const char* a1 = cA + (size_t)(t + 1) * kstep;
            const char* a2 = last ? nA : cA + (size_t)(t + 2) * kstep; const char* b2 = last ? nB : cB + (size_t)(t + 2) * kstep;
            const char* a3 = a2 + kstep; const char* b3 = b2 + kstep;
            PG8_LDB(B0, 0, 0); PG8_SCHED; PG8_LDA(At, 0, 0); PG8_STAGE(PG8_SA(1, 1), a1 + hstepA, voffA);
            PG8_WAIT_L(8); PG8_BAR; PG8_WAIT_L(0); PG8_MMA(0, 0, At, B0); PG8_BAR; PG8_SCHED;
            PG8_LDB(B1, 0, 1); PG8_STAGE(PG8_SB(0, 0), b2, voffB);
            PG8_BAR; PG8_WAIT_L(0); PG8_MMA(0, 1, At, B1); PG8_BAR;
            PG8_LDA(At, 0, 1); PG8_STAGE(PG8_SA(0, 0), a2, voffA);
            PG8_BAR; PG8_WAIT_L(0); PG8_MMA(1, 0, At, B0); PG8_BAR; PG8_SCHED;
            PG8_STAGE(PG8_SB(0, 1), b2 + hstepB, voffB);
            PG8_WAIT_V(6); PG8_BAR; PG8_MMA(1, 1, At, B1); PG8_BAR;
            PG8_LDB(B0, 1, 0); PG8_SCHED; PG8_LDA(At, 1, 0); PG8_STAGE(PG8_SA(0, 1), a2 + hstepA, voffA);
            PG8_WAIT_L(8); PG8_BAR; PG8_WAIT_L(0); PG8_MMA(0, 0, At, B0); PG8_BAR; PG8_SCHED;
            PG8_LDB(B1, 1, 1); PG8_STAGE(PG8_SB(1, 0), b3, voffB);
            PG8_BAR; PG8_WAIT_L(0); PG8_MMA(0, 1, At, B1); PG8_BAR;
            PG8_LDA(At, 1, 1); PG8_STAGE(PG8_SA(1, 0), a3, voffA);
            PG8_BAR; PG8_WAIT_L(0); PG8_MMA(1, 0, At, B0); PG8_BAR; PG8_SCHED;
            PG8_STAGE(PG8_SB(1, 1), b3 + hstepB, voffB);
            PG8_WAIT_V(6); PG8_BAR; PG8_MMA(1, 1, At, B1); PG8_BAR;
        }
        E(acc, cur, wr, wc, fr, fq);
        if (!has_next) break;
#pragma unroll
        for (int a = 0; a < 2; ++a)
#pragma unroll
            for (int b = 0; b < 2; ++b)
#pragma unroll
                for (int m = 0; m < 4; ++m)
#pragma unroll
                    for (int n = 0; n < 2; ++n) acc[a][b][m][n] = (f32x4){0.f, 0.f, 0.f, 0.f};
        cur = nxt; cA = nA; cB = nB; ++ui;
    }
    PG8_WAIT_V(0);
    if (wr == 0) PG8_BAR;
    PG8_BAR;
#undef PG8_SA
#undef PG8_SB
#undef PG8_STAGE
#undef PG8_LDA
#undef PG8_LDB
#undef PG8_MMA
#undef PG8_WAIT_V
#undef PG8_WAIT_L
#undef PG8_BAR
#undef PG8_SCHED
}
}
using pg8::f32x4; using pg8::u32x4; using pg8::Unit;

#define GEMM_LDS (pg8::STAGE_BYTES + 1024)

struct SchedProj : pg8::TileOrder {
  const char* A; const char* B;
  __device__ bool next(int i, Unit& u) const { u.z = 0; return tile(i, u.pm, u.pn); }
  __device__ const char* a_ptr(const Unit& u) const { return A + (size_t)u.pm * 256 * DM * 2; }
  __device__ const char* b_ptr(const Unit& u) const { return B + (size_t)u.pn * 256 * DM * 2; }
};
struct EpiProj {
  static constexpr bool PERM = true;
  bf16_t* O;
  __device__ __forceinline__ void operator()(const f32x4 (&acc)[2][2][4][2], const Unit& u, int wr, int wc, int fr, int fq) const {
    const int row0 = u.pm * 256 + wr * 64 + fr, col0 = u.pn * 256 + wc * 32 + 8 * fq;
    const bool gate = u.pn >= (C_GA / 256);
#pragma unroll
    for (int ai = 0; ai < 2; ++ai)
#pragma unroll
      for (int m = 0; m < 4; ++m) {
        bf16_t* rowp = O + (size_t)(row0 + ai * 128 + m * 16) * PW + col0;
#pragma unroll
        for (int bj = 0; bj < 2; ++bj) {
          f32x4 v0 = acc[ai][bj][m][0], v1 = acc[ai][bj][m][1];
          if (gate) {
#pragma unroll
            for (int j = 0; j < 4; ++j) { v0[j] = sigmoidf_(v0[j]); v1[j] = sigmoidf_(v1[j]); }
          }
          u32x4 w; w.x = pg8::cvt_pk_bf16(v0[0], v0[1]); w.y = pg8::cvt_pk_bf16(v0[2], v0[3]); w.z = pg8::cvt_pk_bf16(v1[0], v1[1]); w.w = pg8::cvt_pk_bf16(v1[2], v1[3]);
          *(u32x4*)(rowp + bj * 128) = w;
        }
      }
  }
};
__device__ void ph_proj(const Params& p, PG8_LAS unsigned char* lds, int nblk, int bid) {
  SchedProj S; S.init(T_TOK / 256, PW / 256, nblk, bid); S.A = (const char*)p.hbf; S.B = (const char*)p.w_in_t;
  EpiProj E{p.proj};
  pg8::gemm_phase(lds, p.tid, DM, DM, DM, S, E);
}

struct SchedBr : pg8::TileOrder {
  const char* A; const char* Ba; const char* Bb;
  __device__ bool next(int i, Unit& u) const { u.z = i & 1; return tile(i >> 1, u.pm, u.pn); }
  __device__ const char* a_ptr(const Unit& u) const { return A + (size_t)u.pm * 256 * DM * 2 + u.z * 512 * 2; }
  __device__ const char* b_ptr(const Unit& u) const { return (u.z ? Bb : Ba) + (size_t)u.pn * 256 * 512 * 2; }
};
__device__ __forceinline__ void unpack8(const u32x4 w, float (&f)[8]) {
  f[0] = __uint_as_float(w.x << 16); f[1] = __uint_as_float(w.x & 0xffff0000u); f[2] = __uint_as_float(w.y << 16); f[3] = __uint_as_float(w.y & 0xffff0000u);
  f[4] = __uint_as_float(w.z << 16); f[5] = __uint_as_float(w.z & 0xffff0000u); f[6] = __uint_as_float(w.w << 16); f[7] = __uint_as_float(w.w & 0xffff0000u);
}
struct EpiBr {
  static constexpr bool PERM = true;
  const bf16_t* proj; bf16_t* O;
  __device__ __forceinline__ void operator()(const f32x4 (&acc)[2][2][4][2], const Unit& u, int wr, int wc, int fr, int fq) const {
    const int row0 = u.pm * 256 + wr * 64 + fr, col0 = u.pn * 256 + wc * 32 + 8 * fq;
    const int gcol = (u.z ? C_GB : C_GA) + col0;
#pragma unroll
    for (int ai = 0; ai < 2; ++ai)
#pragma unroll
      for (int m = 0; m < 4; ++m) {
        const size_t row = (size_t)(row0 + ai * 128 + m * 16);
        bf16_t* rowp = O + row * DM + col0;
        const bf16_t* gp = proj + row * PW + gcol;
#pragma unroll
        for (int bj = 0; bj < 2; ++bj) {
          float g[8]; unpack8(*(const u32x4*)(gp + bj * 128), g);
          f32x4 v0 = acc[ai][bj][m][0], v1 = acc[ai][bj][m][1];
          float r[8];
#pragma unroll
          for (int j = 0; j < 4; ++j) { r[j] = v0[j] * g[j]; r[4 + j] = v1[j] * g[4 + j]; }
          if (u.z) {
            float pv[8]; unpack8(*(const u32x4*)(rowp + bj * 128), pv);
#pragma unroll
            for (int j = 0; j < 8; ++j) r[j] += pv[j];
          }
          u32x4 w; w.x = pg8::cvt_pk_bf16(r[0], r[1]); w.y = pg8::cvt_pk_bf16(r[2], r[3]); w.z = pg8::cvt_pk_bf16(r[4], r[5]); w.w = pg8::cvt_pk_bf16(r[6], r[7]);
          *(u32x4*)(rowp + bj * 128) = w;
        }
      }
  }
};
__device__ void ph_br(const Params& p, PG8_LAS unsigned char* lds, int nblk, int bid) {
  SchedBr S; S.init(T_TOK / 256, DM / 256, nblk, bid); S.A = (const char*)p.oab; S.Ba = (const char*)p.wbra_t; S.Bb = (const char*)p.wbrb_t;
  EpiBr E{p.proj, p.merged};
  pg8::gemm_phase(lds, p.tid, DM, 512, 512, S, E);
}

struct SchedMix : pg8::TileOrder {
  const char* A; const char* B;
  __device__ bool next(int i, Unit& u) const { u.z = 0; return tile(i, u.pm, u.pn); }
  __device__ const char* a_ptr(const Unit& u) const { return A + (size_t)u.pm * 256 * DM * 2; }
  __device__ const char* b_ptr(const Unit& u) const { return B + (size_t)u.pn * 256 * DM * 2; }
};
struct EpiMix {
  static constexpr bool PERM = true;
  bf16_t* O;
  __device__ __forceinline__ void operator()(const f32x4 (&acc)[2][2][4][2], const Unit& u, int wr, int wc, int fr, int fq) const {
    const int row0 = u.pm * 256 + wr * 64 + fr, col0 = u.pn * 256 + wc * 32 + 8 * fq;
#pragma unroll
    for (int ai = 0; ai < 2; ++ai)
#pragma unroll
      for (int m = 0; m < 4; ++m) {
        bf16_t* rowp = O + (size_t)(row0 + ai * 128 + m * 16) * DM + col0;
#pragma unroll
        for (int bj = 0; bj < 2; ++bj) {
          const f32x4 v0 = acc[ai][bj][m][0], v1 = acc[ai][bj][m][1];
          u32x4 w; w.x = pg8::cvt_pk_bf16(v0[0], v0[1]); w.y = pg8::cvt_pk_bf16(v0[2], v0[3]); w.z = pg8::cvt_pk_bf16(v1[0], v1[1]); w.w = pg8::cvt_pk_bf16(v1[2], v1[3]);
          *(u32x4*)(rowp + bj * 128) = w;
        }
      }
  }
};
__device__ void ph_mix(const Params& p, PG8_LAS unsigned char* lds, int nblk, int bid) {
  SchedMix S; S.init(T_TOK / 256, DM / 256, nblk, bid); S.A = (const char*)p.merged; S.B = (const char*)p.wo_t;
  EpiMix E{p.mixer};
  pg8::gemm_phase(lds, p.tid, DM, DM, DM, S, E);
}

struct SchedMoe {
  const PG8_LAS int* tb; int NT; int G, c; int nwg;
  const char* A; const char* B; size_t bexp;
  __device__ bool next(int i, Unit& u) const {
    const long L = (long)i * G + c; if (L >= nwg) return false;
    int wgid = (int)L; { const int q = nwg / 8, r = nwg % 8, xcd = wgid % 8, off = wgid / 8; wgid = (xcd < r ? xcd * (q + 1) : r * (q + 1) + (xcd - r) * q) + off; }
    int e = 0;
#pragma unroll 1
    for (int k = 1; k < NE; ++k) if (wgid >= tb[k]) e = k;
    const int q = wgid - tb[e]; const int tiles = tb[33 + e + 1] - tb[33 + e];
    u.pm = tb[33 + e] + q % tiles; u.pn = q / tiles; u.z = e; return true;
  }
  __device__ const char* a_ptr(const Unit& u) const { return A + (size_t)u.pm * 256 * DM * 2; }
  __device__ const char* b_ptr(const Unit& u) const { return B + (size_t)u.z * bexp + (size_t)u.pn * 256 * DM * 2; }
};
__device__ __forceinline__ void moe_table(const Params& p, PG8_LAS int* tb, int NT) {
  if (p.tid == 0) {
    int ub = 0, tbp = 0;
    for (int e = 0; e < NE; ++e) { tb[e] = ub; tb[33 + e] = tbp; const int t = (p.cnt[e * 64] + 255) >> 8; ub += t * NT; tbp += t; }
    tb[NE] = ub; tb[33 + NE] = tbp;
  }
  __syncthreads();
}
struct EpiMoe1 {
  static constexpr bool PERM = true;
  const float* b_gu; bf16_t* act;
  __device__ __forceinline__ void operator()(f32x4 (&acc)[2][2][4][2], const Unit& u, int wr, int wc, int fr, int fq) const {
    const int row0 = u.pm * 256 + wr * 64 + fr, jc = u.pn * 128 + wc * 32 + 8 * fq;
    const float* bg = b_gu + (size_t)u.z * 2048 + jc;
#pragma unroll
    for (int bj = 0; bj < 2; ++bj)
#pragma unroll
      for (int n = 0; n < 2; ++n) {
        const f32x4 bv = *(const f32x4*)(bg + bj * 1024 + n * 4);
#pragma unroll
        for (int ai = 0; ai < 2; ++ai)
#pragma unroll
          for (int m = 0; m < 4; ++m) acc[ai][bj][m][n] += bv;
      }
#pragma unroll
    for (int ai = 0; ai < 2; ++ai)
#pragma unroll
      for (int m = 0; m < 4; ++m) {
        bf16_t* rowp = act + (size_t)(row0 + ai * 128 + m * 16) * DM + jc;
        float r[8];
#pragma unroll
        for (int n = 0; n < 2; ++n)
#pragma unroll
          for (int j = 0; j < 4; ++j) {
            float g = acc[ai][0][m][n][j], up = acc[ai][1][m][n][j];
            g = fminf(g, 7.f); up = fminf(fmaxf(up, -7.f), 7.f);
            r[n * 4 + j] = (up + 1.f) * g * sigmoidf_(1.702f * g);
          }
        u32x4 w; w.x = pk2(r[0], r[1]); w.y = pk2(r[2], r[3]); w.z = pk2(r[4], r[5]); w.w = pk2(r[6], r[7]);
        *(u32x4*)rowp = w;
      }
  }
};
__device__ void ph_moe1(const Params& p, PG8_LAS unsigned char* lds, int nblk, int bid) {
  PG8_LAS int* tb = (PG8_LAS int*)(lds + pg8::STAGE_BYTES);
  moe_table(p, tb, 8);
  SchedMoe S; S.tb = tb; S.NT = 8; S.G = nblk; S.c = bid; S.nwg = tb[NE]; S.A = (const char*)p.xs; S.B = (const char*)p.wgu_t; S.bexp = (size_t)2048 * DM * 2;
  EpiMoe1 E{p.b_gu, p.act};
  pg8::gemm_phase(lds, p.tid, DM, DM, DM, S, E);
}
struct EpiMoe2 {
  static constexpr bool PERM = true;
  const float* b_down; const int* rowmap; bf16_t* yslot;
  __device__ __forceinline__ void operator()(f32x4 (&acc)[2][2][4][2], const Unit& u, int wr, int wc, int fr, int fq) const {
    const int row0 = u.pm * 256 + wr * 64 + fr, col0 = u.pn * 256 + wc * 32 + 8 * fq;
    const float* bd = b_down + (size_t)u.z * 1024 + col0;
#pragma unroll
    for (int bj = 0; bj < 2; ++bj)
#pragma unroll
      for (int n = 0; n < 2; ++n) {
        const f32x4 bv = *(const f32x4*)(bd + bj * 128 + n * 4);
#pragma unroll
        for (int ai = 0; ai < 2; ++ai)
#pragma unroll
          for (int m = 0; m < 4; ++m) acc[ai][bj][m][n] += bv;
      }
#pragma unroll
    for (int ai = 0; ai < 2; ++ai)
#pragma unroll
      for (int m = 0; m < 4; ++m) {
        const int a = rowmap[row0 + ai * 128 + m * 16];
        if (a >= 0) {
          bf16_t* rowp = yslot + (size_t)a * DM + col0;
#pragma unroll
          for (int bj = 0; bj < 2; ++bj) {
            const f32x4 v0 = acc[ai][bj][m][0], v1 = acc[ai][bj][m][1];
            u32x4 w; w.x = pk2(v0[0], v0[1]); w.y = pk2(v0[2], v0[3]); w.z = pk2(v1[0], v1[1]); w.w = pk2(v1[2], v1[3]);
            *(u32x4*)(rowp + bj * 128) = w;
          }
        }
      }
  }
};
__device__ void ph_moe2(const Params& p, PG8_LAS unsigned char* lds, int nblk, int bid) {
  PG8_LAS int* tb = (PG8_LAS int*)(lds + pg8::STAGE_BYTES);
  moe_table(p, tb, 4);
  SchedMoe S; S.tb = tb; S.NT = 4; S.G = nblk; S.c = bid; S.nwg = tb[NE]; S.A = (const char*)p.act; S.B = (const char*)p.wd_t; S.bexp = (size_t)1024 * DM * 2;
  EpiMoe2 E{p.b_down, p.rowmap, p.yslot};
  pg8::gemm_phase(lds, p.tid, DM, DM, DM, S, E);
}

typedef short bf16x8 __attribute__((ext_vector_type(8)));
typedef unsigned u32x2 __attribute__((ext_vector_type(2)));
#define LAS __attribute__((address_space(3)))
#define MFMA16(a, b, c) __builtin_amdgcn_mfma_f32_16x16x32_bf16((a), (b), (c), 0, 0, 0)
__device__ __forceinline__ bf16x8 pack8(float a0, float a1, float a2, float a3, float a4, float a5, float a6, float a7) {
  u32x4 w; w.x = pk2(a0, a1); w.y = pk2(a2, a3); w.z = pk2(a4, a5); w.w = pk2(a6, a7);
  return __builtin_bit_cast(bf16x8, w);
}
__device__ __forceinline__ bf16_t f2bf_hw(float a) { return (bf16_t)(pk2(a, 0.f) & 0xffffu); }

#define DN_ABYTES 57344
#define DN_UFLOATS 8192
#define F_WN 0
#define F_QD 16
#define F_QK 32
#define F_KT 40

#define DP_KH 0
#define DP_QT 17408
#define DP_KHT 34816
#define DP_VT 53248
#define DP_TU 71680
#define DP_TW 80896
#define DP_LF 90112
#define DP_GC 107520
#define DP_BETA 107776
#define DP_CW 108032
#define DP_TOTAL 114176

template <int KS>
__device__ __forceinline__ f32x4 prod16(const LAS bf16_t* A, int lda, int arow0, const LAS bf16_t* Bt, int ldb, int brow0, f32x4 acc, int lane) {
  const int r = lane & 15, q = lane >> 4;
#pragma unroll
  for (int ks = 0; ks < KS; ++ks) {
    const bf16x8 a = *(const LAS bf16x8*)(A + (arow0 + r) * lda + 32 * ks + 8 * q);
    const bf16x8 b = *(const LAS bf16x8*)(Bt + (brow0 + r) * ldb + 32 * ks + 8 * q);
    acc = MFMA16(a, b, acc);
  }
  return acc;
}
__device__ __forceinline__ void tile_store_rm(LAS bf16_t* X, int ld, int row0, int col0, const f32x4 v, int lane) {
  const int r = lane & 15, q = lane >> 4;
#pragma unroll
  for (int i = 0; i < 4; ++i) X[(row0 + 4 * q + i) * ld + col0 + r] = f2bf_hw(v[i]);
}
__device__ __forceinline__ void tile_store_tr(LAS bf16_t* Xt, int ld, int row0, int col0, const f32x4 v, int lane) {
  const int r = lane & 15, q = lane >> 4;
  u32x2 w; w.x = pk2(v[0], v[1]); w.y = pk2(v[2], v[3]);
  *(LAS u32x2*)(Xt + (col0 + r) * ld + row0 + 4 * q) = w;
}

__device__ void dn_prep_chunk(const Params& p, LAS unsigned char* lds, int ci, bool load_cw) {
  const int tid = p.tid, lane = tid & 63, w = tid >> 6, r16 = lane & 15, q4 = lane >> 4;
  const int bh = ci >> 6, n = ci & 63, b = bh >> 2, h = bh & 3;
  LAS bf16_t* Kh = (LAS bf16_t*)(lds + DP_KH); LAS bf16_t* Qt = (LAS bf16_t*)(lds + DP_QT);
  LAS bf16_t* KhT = (LAS bf16_t*)(lds + DP_KHT); LAS bf16_t* VT = (LAS bf16_t*)(lds + DP_VT);
  LAS bf16_t* Tu = (LAS bf16_t*)(lds + DP_TU); LAS bf16_t* Tw = (LAS bf16_t*)(lds + DP_TW); LAS float* Lf = (LAS float*)(lds + DP_LF);
  LAS float* gcb = (LAS float*)(lds + DP_GC); LAS float* betab = (LAS float*)(lds + DP_BETA); LAS float* cw = (LAS float*)(lds + DP_CW);
  unsigned char* gA = (unsigned char*)p.dnA + (size_t)ci * DN_ABYTES;
  float* gU = p.dnU + (size_t)ci * DN_UFLOATS;

  if (load_cw) {
    for (int i = tid; i < 4 * 384; i += 512) { const int tap = i / 384, cc = i % 384, part = cc >> 7, d = cc & 127; cw[i] = p.conv_w[tap * 1536 + part * 512 + h * 128 + d]; }
  }
  __syncthreads();
  const int c = tid >> 3, g = tid & 7;
  const int s = n * 64 + c;
  const size_t t = (size_t)b * SEQ + s;
  float qv[16], kv[16], vv[16];
#pragma unroll
  for (int j = 0; j < 16; ++j) { qv[j] = 0.f; kv[j] = 0.f; vv[j] = 0.f; }
#pragma unroll
  for (int tap = 0; tap < 4; ++tap) {
    const int ss = s - 3 + tap;
    if (ss >= 0) {
      const bf16_t* row = p.proj + (t - 3 + tap) * PW + h * 128 + 16 * g;
      float x[8];
#pragma unroll
      for (int part = 0; part < 3; ++part) {
#pragma unroll
        for (int hh = 0; hh < 2; ++hh) {
          unpack8(*(const u32x4*)(row + part * 512 + 8 * hh), x);
#pragma unroll
          for (int j = 0; j < 8; ++j) {
            const float wv = cw[tap * 384 + part * 128 + 16 * g + 8 * hh + j];
            if (part == 0) qv[8 * hh + j] += wv * x[j];
            if (part == 1) kv[8 * hh + j] += wv * x[j];
            if (part == 2) vv[8 * hh + j] += wv * x[j];
          }
        }
      }
    }
    asm volatile("" ::: "memory");
  }
  float sq = 0.f, sk = 0.f;
#pragma unroll
  for (int j = 0; j < 16; ++j) { qv[j] = siluf_(qv[j]); kv[j] = siluf_(kv[j]); vv[j] = siluf_(vv[j]); sq += qv[j] * qv[j]; sk += kv[j] * kv[j]; }
  sq += __shfl_xor(sq, 1, 64); sq += __shfl_xor(sq, 2, 64); sq += __shfl_xor(sq, 4, 64);
  sk += __shfl_xor(sk, 1, 64); sk += __shfl_xor(sk, 2, 64); sk += __shfl_xor(sk, 4, 64);
  const float rq = rsqrtf(sq + 1e-6f) * 0.08838834764831845f, rk = rsqrtf(sk + 1e-6f);
#pragma unroll
  for (int j = 0; j < 16; ++j) { qv[j] *= rq; kv[j] *= rk; }
  if (g == 0) {
    const float bb = p.ba[t * 8 + h], aa = p.ba[t * 8 + 4 + h];
    const float xx = aa + p.dt_bias[h];
    const float sp = xx > 20.f ? xx : log1pf(__expf(xx));
    betab[c] = sigmoidf_(bb);
    gcb[c] = -__expf(p.a_log[h]) * sp;
  }
  {
    u32x4 w0, w1;
    w0.x = pk2(kv[0], kv[1]); w0.y = pk2(kv[2], kv[3]); w0.z = pk2(kv[4], kv[5]); w0.w = pk2(kv[6], kv[7]);
    w1.x = pk2(kv[8], kv[9]); w1.y = pk2(kv[10], kv[11]); w1.z = pk2(kv[12], kv[13]); w1.w = pk2(kv[14], kv[15]);
    *(LAS u32x4*)(Kh + c * 136 + 16 * g) = w0; *(LAS u32x4*)(Kh + c * 136 + 16 * g + 8) = w1;
    w0.x = pk2(qv[0], qv[1]); w0.y = pk2(qv[2], qv[3]); w0.z = pk2(qv[4], qv[5]); w0.w = pk2(qv[6], qv[7]);
    w1.x = pk2(qv[8], qv[9]); w1.y = pk2(qv[10], qv[11]); w1.z = pk2(qv[12], qv[13]); w1.w = pk2(qv[14], qv[15]);
    *(LAS u32x4*)(Qt + c * 136 + 16 * g) = w0; *(LAS u32x4*)(Qt + c * 136 + 16 * g + 8) = w1;
#pragma unroll
    for (int j = 0; j < 16; ++j) { KhT[(16 * g + j) * 72 + c] = f2bf_hw(kv[j]); VT[(16 * g + j) * 72 + c] = f2bf_hw(vv[j]); }
  }
  __syncthreads();
  if (w == 0) {
    float v = gcb[lane];
#pragma unroll
    for (int o = 1; o < 64; o <<= 1) { const float u = __shfl_up(v, o, 64); if (lane >= o) v += u; }
    gcb[lane] = v;
  }
  __syncthreads();
  const float gc_c = gcb[c], gl = gcb[63];
  {
    const float eg = __expf(gc_c);
    unsigned char* fb = gA + (size_t)(F_QD + (c >> 4) * 4 + (g >> 1)) * 1024 + (g & 1) * 8;
#pragma unroll
    for (int qq = 0; qq < 4; ++qq) {
      u32x2 wv; wv.x = pk2(qv[4 * qq] * eg, qv[4 * qq + 1] * eg); wv.y = pk2(qv[4 * qq + 2] * eg, qv[4 * qq + 3] * eg);
      *(u32x2*)(fb + ((c & 15) + 16 * qq) * 16) = wv;
    }
  }
  const int rt = w >> 1, ct0 = 2 * (w & 1);
#pragma unroll
  for (int tt = 0; tt < 2; ++tt) {
    const int ct = ct0 + tt;
    f32x4 gacc = {0.f, 0.f, 0.f, 0.f};
    gacc = prod16<4>(Kh, 136, 16 * rt, Kh, 136, 16 * ct, gacc, lane);
    const int m = 16 * ct + r16; const float gc_m = gcb[m];
#pragma unroll
    for (int i = 0; i < 4; ++i) {
      const int cc = 16 * rt + 4 * q4 + i;
      Lf[cc * 68 + m] = (m < cc) ? betab[cc] * gacc[i] * __expf(gcb[cc] - gc_m) : 0.f;
    }
    f32x4 qacc = {0.f, 0.f, 0.f, 0.f};
    qacc = prod16<4>(Kh, 136, 16 * rt, Qt, 136, 16 * ct, qacc, lane);
    const int cq = 16 * ct + r16; const float gc_cq = gcb[cq];
    float o4[4];
#pragma unroll
    for (int i = 0; i < 4; ++i) { const int mm = 16 * rt + 4 * q4 + i; o4[i] = (mm <= cq) ? qacc[i] * __expf(gc_cq - gcb[mm]) : 0.f; }
    u32x2 wv; wv.x = pk2(o4[0], o4[1]); wv.y = pk2(o4[2], o4[3]);
    *(u32x2*)(gA + (size_t)(F_QK + ct * 2 + (rt >> 1)) * 1024 + (r16 + 16 * q4) * 16 + (rt & 1) * 8) = wv;
  }
  __syncthreads();
  if (w == 0) {
    float T[64];
    int lo = lane; asm volatile("" : "+v"(lo));
    unsigned lfb = DP_LF; asm volatile("" : "+v"(lfb));
    const LAS float* Lfo = (const LAS float*)(lds + lfb);
    const float bm = betab[lo], bem = bm * __expf(gcb[lo]);
#pragma unroll
    for (int i = 0; i < 64; ++i) {
      float a0 = (i == lo) ? 1.f : 0.f, a1 = 0.f, a2 = 0.f, a3 = 0.f;
#pragma unroll
      for (int k4 = 0; k4 < (i + 3) / 4; ++k4) {
        const f32x4 l = *(const LAS f32x4*)(Lfo + i * 68 + 4 * k4);
        if (4 * k4 + 0 < i) a0 -= l[0] * T[4 * k4 + 0];
        if (4 * k4 + 1 < i) a1 -= l[1] * T[4 * k4 + 1];
        if (4 * k4 + 2 < i) a2 -= l[2] * T[4 * k4 + 2];
        if (4 * k4 + 3 < i) a3 -= l[3] * T[4 * k4 + 3];
      }
      T[i] = (a0 + a1) + (a2 + a3);
      Tu[i * 72 + lo] = f2bf_hw(T[i] * bm);
      Tw[i * 72 + lo] = f2bf_hw(T[i] * bem);
      asm volatile("" ::: "memory");
    }
  }
  __syncthreads();
#pragma unroll
  for (int rr = 0; rr < 4; ++rr) {
    f32x4 u = {0.f, 0.f, 0.f, 0.f};
    u = prod16<2>(Tu, 72, 16 * rr, VT, 72, 16 * w, u, lane);
    *(f32x4*)(gU + ((w * 4 + rr) * 64 + lane) * 4) = u;
    f32x4 wt = {0.f, 0.f, 0.f, 0.f};
    wt = prod16<2>(KhT, 72, 16 * w, Tw, 72, 16 * rr, wt, lane);
    u32x2 wv; wv.x = pk2(-wt[0], -wt[1]); wv.y = pk2(-wt[2], -wt[3]);
    *(u32x2*)(gA + (size_t)(F_WN + rr * 4 + (w >> 1)) * 1024 + (r16 + 16 * q4) * 16 + (w & 1) * 8) = wv;
  }
#pragma unroll
  for (int it = 0; it < 4; ++it) {
    const int idx = tid + it * 512; const int d = idx >> 4, m4 = idx & 15;
    const u32x2 raw = *(const LAS u32x2*)(KhT + d * 72 + 4 * m4);
    const float k0 = __uint_as_float(raw.x << 16), k1 = __uint_as_float(raw.x & 0xffff0000u), k2 = __uint_as_float(raw.y << 16), k3 = __uint_as_float(raw.y & 0xffff0000u);
    const float e0 = __expf(gl - gcb[4 * m4]), e1 = __expf(gl - gcb[4 * m4 + 1]), e2 = __expf(gl - gcb[4 * m4 + 2]), e3 = __expf(gl - gcb[4 * m4 + 3]);
    u32x2 wv; wv.x = pk2(k0 * e0, k1 * e1); wv.y = pk2(k2 * e2, k3 * e3);
    *(u32x2*)(gA + (size_t)(F_KT + (d >> 4) * 2 + (m4 >> 3)) * 1024 + ((d & 15) + 16 * (m4 & 3)) * 16 + ((m4 >> 2) & 1) * 8) = wv;
  }
  if (tid == 0) p.dnG[ci] = __expf(gl);
}

#define DS_A0 0
#define DS_A1 57344
#define DS_TOTAL 114688
__device__ void dn_scan_blk(const Params& p, LAS unsigned char* lds, int item) {
  const int tid = p.tid, lane = tid & 63, w = __builtin_amdgcn_readfirstlane(tid >> 6), r16 = lane & 15, q4 = lane >> 4;
  const int bh = item >> 1, eh = item & 1, b = bh >> 2, h = bh & 3;
  const int et = eh * 4 + (w & 3);
  const bool comp = w < 4;
  const unsigned char* gA = (const unsigned char*)p.dnA + (size_t)bh * 64 * DN_ABYTES;
  const float* gU = p.dnU + (size_t)bh * 64 * DN_UFLOATS;
  const float* gG = p.dnG + bh * 64;
  auto issue_A = [&](int n, int buf) {
#pragma unroll
    for (int i = 0; i < 7; ++i) {
      const int f = w * 7 + i;
      __builtin_amdgcn_global_load_lds((const unsigned*)(gA + (size_t)n * DN_ABYTES + f * 1024 + lane * 16), (LAS unsigned*)(lds + (buf ? DS_A1 : DS_A0) + f * 1024), 16, 0, 0);
    }
  };
  __syncthreads();
  issue_A(0, 0);
  f32x4 Un[4];
#pragma unroll
  for (int rr = 0; rr < 4; ++rr) Un[rr] = *(const f32x4*)(gU + ((et * 4 + rr) * 64 + lane) * 4);
  f32x4 S[8];
#pragma unroll
  for (int dt = 0; dt < 8; ++dt) S[dt] = (f32x4){0.f, 0.f, 0.f, 0.f};
  asm volatile("s_waitcnt vmcnt(0)" ::: "memory");
  __syncthreads();
  bf16_t* obase = p.dn_out + ((size_t)b * SEQ) * p.dn_out_ld + h * 128 + 16 * et + r16;
  f32x4 Op[4];
#pragma unroll
  for (int rr = 0; rr < 4; ++rr) Op[rr] = (f32x4){0.f, 0.f, 0.f, 0.f};
#pragma unroll 1
  for (int n = 0; n < 64; ++n) {
    const LAS unsigned char* Ab = lds + ((n & 1) ? DS_A1 : DS_A0);
    if (n + 1 < 64) issue_A(n + 1, (n + 1) & 1);
    if (comp) {
      if (n > 0) {
#pragma unroll
        for (int rr = 0; rr < 4; ++rr)
#pragma unroll
          for (int i = 0; i < 4; ++i) obase[(size_t)((n - 1) * 64 + 16 * rr + 4 * q4 + i) * p.dn_out_ld] = f2bf_hw(Op[rr][i]);
      }
      f32x4 Vn[4];
#pragma unroll
      for (int rr = 0; rr < 4; ++rr) Vn[rr] = Un[rr];
      if (n + 1 < 64) {
#pragma unroll
        for (int rr = 0; rr < 4; ++rr) Un[rr] = *(const f32x4*)(gU + (size_t)(n + 1) * DN_UFLOATS + ((et * 4 + rr) * 64 + lane) * 4);
      }
      const float gdec = gG[n];
      bf16x8 Sb[4];
#pragma unroll
      for (int ks = 0; ks < 4; ++ks) Sb[ks] = pack8(S[2 * ks][0], S[2 * ks][1], S[2 * ks][2], S[2 * ks][3], S[2 * ks + 1][0], S[2 * ks + 1][1], S[2 * ks + 1][2], S[2 * ks + 1][3]);
      f32x4 O[4];
#pragma unroll
      for (int rr = 0; rr < 4; ++rr) {
        O[rr] = (f32x4){0.f, 0.f, 0.f, 0.f};
#pragma unroll
        for (int ks = 0; ks < 4; ++ks) {
          const bf16x8 aw = *(const LAS bf16x8*)(Ab + (F_WN + rr * 4 + ks) * 1024 + lane * 16);
          Vn[rr] = MFMA16(aw, Sb[ks], Vn[rr]);
          const bf16x8 aq = *(const LAS bf16x8*)(Ab + (F_QD + rr * 4 + ks) * 1024 + lane * 16);
          O[rr] = MFMA16(aq, Sb[ks], O[rr]);
        }
      }
      bf16x8 Vb[2];
#pragma unroll
      for (int ks = 0; ks < 2; ++ks) Vb[ks] = pack8(Vn[2 * ks][0], Vn[2 * ks][1], Vn[2 * ks][2], Vn[2 * ks][3], Vn[2 * ks + 1][0], Vn[2 * ks + 1][1], Vn[2 * ks + 1][2], Vn[2 * ks + 1][3]);
#pragma unroll
      for (int rr = 0; rr < 4; ++rr)
#pragma unroll
        for (int ks = 0; ks < 2; ++ks) {
          const bf16x8 a = *(const LAS bf16x8*)(Ab + (F_QK + rr * 2 + ks) * 1024 + lane * 16);
          O[rr] = MFMA16(a, Vb[ks], O[rr]);
        }
#pragma unroll
      for (int rr = 0; rr < 4; ++rr) Op[rr] = O[rr];
#pragma unroll
      for (int dt = 0; dt < 8; ++dt) {
        S[dt] *= gdec;
#pragma unroll
        for (int ks = 0; ks < 2; ++ks) {
          const bf16x8 a = *(const LAS bf16x8*)(Ab + (F_KT + dt * 2 + ks) * 1024 + lane * 16);
          S[dt] = MFMA16(a, Vb[ks], S[dt]);
        }
      }
    }
    asm volatile("s_waitcnt vmcnt(0)" ::: "memory");
    __syncthreads();
  }
  if (comp) {
#pragma unroll
    for (int rr = 0; rr < 4; ++rr)
#pragma unroll
      for (int i = 0; i < 4; ++i) obase[(size_t)(63 * 64 + 16 * rr + 4 * q4 + i) * p.dn_out_ld] = f2bf_hw(Op[rr][i]);
  }
}
__device__ void ph_dn_norm(const Params& p, int nblk, int bid) {
  const int wid = p.tid >> 6, lane = p.tid & 63;
  const f32x4 g0 = *(const f32x4*)(p.g_dn_out + (lane & 15) * 8), g1 = *(const f32x4*)(p.g_dn_out + (lane & 15) * 8 + 4);
  for (int t = bid * 8 + wid; t < T_TOK; t += nblk * 8) {
    bf16_t* op = p.oab + (size_t)t * DM + lane * 8;
    float o[8], z[8];
    unpack8(*(const u32x4*)op, o);
    unpack8(*(const u32x4*)(p.proj + (size_t)t * PW + C_Z + lane * 8), z);
    float ss = 0.f;
#pragma unroll
    for (int j = 0; j < 8; ++j) ss += o[j] * o[j];
    ss += __shfl_xor(ss, 1, 64); ss += __shfl_xor(ss, 2, 64); ss += __shfl_xor(ss, 4, 64); ss += __shfl_xor(ss, 8, 64);
    const float rstd = rsqrtf(ss * (1.f / 128.f) + 1e-6f);
    float y[8];
#pragma unroll
    for (int j = 0; j < 4; ++j) { y[j] = o[j] * rstd * g0[j] * siluf_(z[j]); y[4 + j] = o[4 + j] * rstd * g1[j] * siluf_(z[4 + j]); }
    u32x4 w; w.x = pk2(y[0], y[1]); w.y = pk2(y[2], y[3]); w.z = pk2(y[4], y[5]); w.w = pk2(y[6], y[7]);
    *(u32x4*)op = w;
  }
}
typedef float f32x16 __attribute__((ext_vector_type(16)));
#define MFMA32(a, b, c) __builtin_amdgcn_mfma_f32_32x32x16_bf16((a), (b), (c), 0, 0, 0)
#define MP_VL 0
#define MP_RED 65536
#define MP_TOTAL (65536 + 4096)

__device__ void moba_prep_block(const Params& p, LAS unsigned char* lds, int item) {
  const int tid = p.tid, lane = tid & 63, w = tid >> 6;
  const int bh = item >> 4, jb = item & 15, b = bh >> 2, h = bh & 3;
  LAS bf16_t* Vl = (LAS bf16_t*)(lds + MP_VL);
  LAS float* red = (LAS float*)(lds + MP_RED);
  __syncthreads();
#pragma unroll
  for (int it = 0; it < 8; ++it) {
    const int idx = tid + 512 * it, row = idx >> 4, ch = idx & 15;
    const u32x4 v = *(const u32x4*)(p.proj + ((size_t)b * SEQ + 256 * jb + row) * PW + C_MV + h * 128 + 8 * ch);
    *(LAS u32x4*)(Vl + row * 128 + 8 * ch) = v;
  }
  {
    const int r = tid >> 1, hh = tid & 1;
    const int pos = 256 * jb + r;
    const size_t t = (size_t)b * SEQ + pos;
    float cs[8], sn[8];
#pragma unroll
    for (int jj = 0; jj < 8; ++jj) {
      const float inv = exp2f(-(float)(8 * hh + jj) * (1.f / 16.f) * 18.931568569324174f);
      const float ang = (float)pos * inv;
      cs[jj] = cosf(ang); sn[jj] = sinf(ang);
    }
    float kacc[64];
#pragma unroll
    for (int which = 0; which < 2; ++which) {
      const bf16_t* src = p.proj + t * PW + (which ? C_MQ : C_MK) + h * 128 + 8 * hh;
      float x0[8], x1[8];
      unpack8(*(const u32x4*)(src), x0); unpack8(*(const u32x4*)(src + 16), x1);
      float y0[8], y1[8];
#pragma unroll
      for (int jj = 0; jj < 8; ++jj) { y0[jj] = x0[jj] * cs[jj] - x1[jj] * sn[jj]; y1[jj] = x1[jj] * cs[jj] + x0[jj] * sn[jj]; }
      u32x4 o[8];
      o[0].x = pk2(y0[0], y0[1]); o[0].y = pk2(y0[2], y0[3]); o[0].z = pk2(y0[4], y0[5]); o[0].w = pk2(y0[6], y0[7]);
      o[1].x = pk2(y1[0], y1[1]); o[1].y = pk2(y1[2], y1[3]); o[1].z = pk2(y1[4], y1[5]); o[1].w = pk2(y1[6], y1[7]);
#pragma unroll
      for (int ks = 2; ks < 8; ++ks) o[ks] = *(const u32x4*)(src + 16 * ks);
      if (which == 0) {
#pragma unroll
        for (int jj = 0; jj < 8; ++jj) { kacc[jj] = y0[jj]; kacc[8 + jj] = y1[jj]; }
#pragma unroll
        for (int ks = 2; ks < 8; ++ks) { float f[8]; unpack8(o[ks], f);
#pragma unroll
          for (int jj = 0; jj < 8; ++jj) kacc[8 * ks + jj] = f[jj]; }
        unsigned char* dst = (unsigned char*)p.Kp + ((size_t)(bh * 128 + 8 * jb + (r >> 5)) * 8192) + ((r & 31) + 32 * hh) * 16;
#pragma unroll
        for (int ks = 0; ks < 8; ++ks) *(u32x4*)(dst + ks * 1024) = o[ks];
      } else {
        bf16_t* dst = p.qb + ((size_t)bh * SEQ + pos) * 128 + 8 * hh;
#pragma unroll
        for (int ks = 0; ks < 8; ++ks) *(u32x4*)(dst + 16 * ks) = o[ks];
      }
    }
#pragma unroll
    for (int e = 0; e < 64; ++e) {
      float v = kacc[e];
      v += __shfl_xor(v, 2, 64); v += __shfl_xor(v, 4, 64); v += __shfl_xor(v, 8, 64); v += __shfl_xor(v, 16, 64); v += __shfl_xor(v, 32, 64);
      kacc[e] = v;
    }
    if (lane < 2) {
#pragma unroll
      for (int e = 0; e < 64; ++e) red[(w * 2 + lane) * 64 + e] = kacc[e];
    }
  }
  __syncthreads();
  if (tid < 128) {
    const int d = tid, hh = (d >> 3) & 1, ks = d >> 4, jj = d & 7;
    float a = 0.f;
#pragma unroll
    for (int ww = 0; ww < 8; ++ww) a += red[(ww * 2 + hh) * 64 + ks * 8 + jj];
    p.kmean[((size_t)bh * 16 + jb) * 128 + d] = a * (1.f / 256.f);
  }
#pragma unroll
  for (int it = 0; it < 8; ++it) {
    const int o = tid + 512 * it, ln = o & 63, frag = o >> 6, tl = frag >> 3, dt = (frag >> 1) & 3, s = frag & 1;
    const int r = ln & 31, hh = ln >> 5, d = 32 * dt + r;
    unsigned short e[8];
#pragma unroll
    for (int jj = 0; jj < 8; ++jj) { const int key = 32 * tl + 16 * s + 8 * (jj >> 2) + 4 * hh + (jj & 3); e[jj] = Vl[key * 128 + d]; }
    u32x4 wv; wv.x = e[0] | ((unsigned)e[1] << 16); wv.y = e[2] | ((unsigned)e[3] << 16); wv.z = e[4] | ((unsigned)e[5] << 16); wv.w = e[6] | ((unsigned)e[7] << 16);
    *(u32x4*)((unsigned char*)p.Vp + ((size_t)(bh * 128 + 8 * jb + tl) * 8192) + (dt * 2 + s) * 1024 + ln * 16) = wv;
  }
}
__device__ __forceinline__ int crow32(int reg, int hh) { return (reg & 3) + 8 * (reg >> 2) + 4 * hh; }
__device__ void moba_item(const Params& p, LAS float* km, LAS float* mrg, LAS float* ml, int bh, int ib, int sub, int par, int lane) {
  const int q = lane & 31, hh = lane >> 5;
  const int b = bh >> 2, h = bh & 3;
  const int s0 = 256 * ib + 32 * sub;
  const bf16_t* qrow = p.qb + ((size_t)bh * SEQ + s0 + q) * 128 + 8 * hh;
  bf16x8 Qf[8];
#pragma unroll
  for (int ks = 0; ks < 8; ++ks) Qf[ks] = *(const bf16x8*)(qrow + 16 * ks);
  LAS unsigned char* qlds = (LAS unsigned char*)km + 8192 + lane * 16;
#pragma unroll
  for (int ks = 0; ks < 8; ++ks) *(LAS bf16x8*)(qlds + ks * 1024) = Qf[ks];
  unsigned selmask = 0;
  if (ib > 0) {
    for (int idx = lane; idx < ib * 32; idx += 64) ((LAS f32x4*)km)[idx] = ((const f32x4*)(p.kmean + (size_t)bh * 16 * 128))[idx];
    float qf[64];
#pragma unroll
    for (int ks = 0; ks < 8; ++ks) { float f[8]; unpack8(__builtin_bit_cast(u32x4, Qf[ks]), f);
#pragma unroll
      for (int jj = 0; jj < 8; ++jj) qf[8 * ks + jj] = f[jj]; }
    float sc[16];
#pragma unroll
    for (int j = 0; j < 16; ++j) {
      sc[j] = -INFINITY;
      if (j < ib) {
        float a = 0.f;
#pragma unroll
        for (int ks = 0; ks < 8; ++ks) {
          const f32x4 k0 = *(const LAS f32x4*)(km + j * 128 + 16 * ks + 8 * hh), k1 = *(const LAS f32x4*)(km + j * 128 + 16 * ks + 8 * hh + 4);
          a += qf[8 * ks] * k0[0] + qf[8 * ks + 1] * k0[1] + qf[8 * ks + 2] * k0[2] + qf[8 * ks + 3] * k0[3];
          a += qf[8 * ks + 4] * k1[0] + qf[8 * ks + 5] * k1[1] + qf[8 * ks + 6] * k1[2] + qf[8 * ks + 7] * k1[3];
        }
        a += __shfl_xor(a, 32, 64);
        sc[j] = a;
      }
    }
#pragma unroll
    for (int r = 0; r < 3; ++r) {
      if (r < ib) {
        float best = -INFINITY; int bi = 0;
#pragma unroll
        for (int j = 0; j < 16; ++j) if (sc[j] > best) { best = sc[j]; bi = j; }
        selmask |= 1u << bi;
#pragma unroll
        for (int j = 0; j < 16; ++j) if (j == bi) sc[j] = -INFINITY;
      }
    }
  }
  unsigned rem = 0;
  for (int j = 0; j < ib; ++j) if (__ballot((selmask >> j) & 1u) != 0ull) rem |= 1u << j;
  rem = __builtin_amdgcn_readfirstlane(rem);
  const int own0 = 8 * ib, diag = 8 * ib + sub;
  const float cscale = 0.08838834764831845f * 1.4426950408889634f;
  float m = -1e30f, l = 0.f;
  f32x16 O[4];
#pragma unroll
  for (int dt = 0; dt < 4; ++dt)
#pragma unroll
    for (int r = 0; r < 16; ++r) O[dt][r] = 0.f;
  const unsigned char* kbase = (const unsigned char*)p.Kp + (size_t)bh * 128 * 8192 + lane * 16;
  const unsigned char* vbase = (const unsigned char*)p.Vp + (size_t)bh * 128 * 8192 + lane * 16;
  auto adv = [&](int& kt_, unsigned& rem_) {
    if (kt_ < 0) return;
    if (kt_ >= own0 ? (kt_ < diag) : ((kt_ & 7) != 7)) { kt_ = kt_ + 1; return; }
    if (rem_ == 0u) { kt_ = -1; return; }
    kt_ = 8 * (__builtin_ctz(rem_)); rem_ &= rem_ - 1u;
  };
  int kt = own0;
  if (par) adv(kt, rem);
  LAS unsigned char* kl = (LAS unsigned char*)km;
  auto issue_K = [&](int t) {
#pragma unroll
    for (int ks = 0; ks < 8; ++ks) __builtin_amdgcn_global_load_lds((const unsigned*)(kbase + (size_t)t * 8192 + ks * 1024), (LAS unsigned*)(kl + ks * 1024), 16, 0, 0);
  };
  asm volatile("s_waitcnt lgkmcnt(0)" ::: "memory");
  if (kt >= 0) issue_K(kt);
#pragma unroll 1
  while (kt >= 0) {
    int ktn = kt; unsigned remn = rem;
    adv(ktn, remn); adv(ktn, remn);
    asm volatile("s_waitcnt vmcnt(0)" ::: "memory");
    bf16x8 Kc[8], Vf[8];
#pragma unroll
    for (int ks = 0; ks < 8; ++ks) Kc[ks] = *(const LAS bf16x8*)(kl + lane * 16 + ks * 1024);
#pragma unroll
    for (int f = 0; f < 8; ++f) Vf[f] = *(const bf16x8*)(vbase + (size_t)kt * 8192 + f * 1024);
    asm volatile("s_waitcnt lgkmcnt(0)" ::: "memory");
    if (ktn >= 0) issue_K(ktn);
    f32x16 S;
#pragma unroll
    for (int r = 0; r < 16; ++r) S[r] = 0.f;
#pragma unroll
    for (int ks = 0; ks < 8; ++ks) S = MFMA32(Kc[ks], *(const LAS bf16x8*)(qlds + ks * 1024), S);
    const bool allowed = (kt >= own0) || ((selmask >> (kt >> 3)) & 1u);
    const float nb = allowed ? 0.f : -INFINITY;
    float sv[16]; float mx = -INFINITY;
#pragma unroll
    for (int r = 0; r < 16; ++r) sv[r] = __builtin_fmaf(S[r], cscale, nb);
    if (kt == diag) {
#pragma unroll
      for (int r = 0; r < 16; ++r) if (crow32(r, hh) > q) sv[r] = -INFINITY;
    }
#pragma unroll
    for (int r = 0; r < 16; ++r) mx = fmaxf(mx, sv[r]);
    mx = fmaxf(mx, __shfl_xor(mx, 32, 64));
    const float mn = fmaxf(m, mx);
    const float alpha = __builtin_amdgcn_exp2f(m - mn);
    float ps = 0.f;
#pragma unroll
    for (int r = 0; r < 16; ++r) { sv[r] = __builtin_amdgcn_exp2f(sv[r] - mn); ps += sv[r]; }
    l = l * alpha + ps; m = mn;
    if (__ballot(alpha != 1.f) != 0ull) {
#pragma unroll
      for (int dt = 0; dt < 4; ++dt)
#pragma unroll
        for (int r = 0; r < 16; ++r) O[dt][r] *= alpha;
    }
    const bf16x8 P0 = pack8(sv[0], sv[1], sv[2], sv[3], sv[4], sv[5], sv[6], sv[7]);
    const bf16x8 P1 = pack8(sv[8], sv[9], sv[10], sv[11], sv[12], sv[13], sv[14], sv[15]);
#pragma unroll
    for (int dt = 0; dt < 4; ++dt) { O[dt] = MFMA32(Vf[dt * 2], P0, O[dt]); O[dt] = MFMA32(Vf[dt * 2 + 1], P1, O[dt]); }
    kt = ktn; rem = remn;
  }
  asm volatile("s_waitcnt vmcnt(0) lgkmcnt(0)" ::: "memory");
  if (par) {
    ml[lane] = m; ml[64 + lane] = l;
#pragma unroll
    for (int dt = 0; dt < 4; ++dt)
#pragma unroll
      for (int r = 0; r < 16; ++r) mrg[(dt * 16 + r) * 64 + lane] = O[dt][r];
  }
  __syncthreads();
  if (par == 0) {
    const float m2 = ml[lane], l2 = ml[64 + lane];
    const float mm = fmaxf(m, m2);
    const float a1 = __builtin_amdgcn_exp2f(m - mm), a2 = __builtin_amdgcn_exp2f(m2 - mm);
    l = l * a1 + l2 * a2;
#pragma unroll
    for (int dt = 0; dt < 4; ++dt)
#pragma unroll
      for (int r = 0; r < 16; ++r) O[dt][r] = O[dt][r] * a1 + mrg[(dt * 16 + r) * 64 + lane] * a2;
  }
  if (par == 0) {
  l += __shfl_xor(l, 32, 64);
  const float inv = 1.f / l;
  bf16_t* orow = p.mb_out + ((size_t)b * SEQ + s0 + q) * p.mb_out_ld + p.mb_out_off + h * 128;
#pragma unroll
  for (int dt = 0; dt < 4; ++dt)
#pragma unroll
    for (int g4 = 0; g4 < 4; ++g4) {
      u32x2 wv; wv.x = pk2(O[dt][4 * g4] * inv, O[dt][4 * g4 + 1] * inv); wv.y = pk2(O[dt][4 * g4 + 2] * inv, O[dt][4 * g4 + 3] * inv);
      *(u32x2*)(orow + 32 * dt + 8 * g4 + 4 * hh) = wv;
    }
  }
  __syncthreads();
}
__device__ void moba_worker(const Params& p, LAS unsigned char* lds, int qi) {
  const int lane = p.tid & 63, w = __builtin_amdgcn_readfirstlane(p.tid >> 6);
  LAS float* km = (LAS float*)(lds + w * 16384);
  LAS float* mrg = (LAS float*)(lds + ((w & 3) + 4) * 16384);
  LAS float* ml = (LAS float*)(lds + 131072) + (w & 3) * 128;
  LAS int* slot = (LAS int*)(lds + 131072 + 2048);
  const int g = blockIdx.x & 7;
  for (;;) {
    __syncthreads();
    if (p.tid == 0) slot[0] = atomicAdd(p.wq + qi * 8 + g, 1);
    __syncthreads();
    const int idx = slot[0];
    if (idx >= 64) break;
    const int ib = 15 - (idx >> 2), bh = 2 * g + ((idx >> 1) & 1), quad = 1 - (idx & 1);
    moba_item(p, km, mrg, ml, bh, ib, 4 * quad + (w & 3), w >> 2, lane);
  }
}
__device__ void ph_mod(const Params& p, LAS unsigned char* lds, int nblk, int bid) {
  LAS float* sc = (LAS float*)lds;
  LAS float* part = (LAS float*)(lds + 16384);
  const int tid = p.tid;
  if (bid >= 192) return;
  for (int i = tid; i < 4096; i += 512) sc[i] = siluf_(p.c[i]);
  __syncthreads();
  for (int task = bid; task < 192; task += nblk) {
    const int jj = tid & 31, ks = tid >> 5, j = task * 32 + jj;
    float a0 = 0.f, a1 = 0.f, a2 = 0.f, a3 = 0.f;
#pragma unroll 8
    for (int kk = 0; kk < 64; ++kk) {
      const int k = ks * 64 + kk;
      const float w = p.w_ada[(size_t)k * 6144 + j];
      a0 += sc[k] * w; a1 += sc[1024 + k] * w; a2 += sc[2048 + k] * w; a3 += sc[3072 + k] * w;
    }
    *(LAS f32x4*)(part + (ks * 32 + jj) * 4) = (f32x4){a0, a1, a2, a3};
    __syncthreads();
    if (tid < 128) {
      const int j2 = tid & 31, bb = tid >> 5;
      float a = 0.f;
#pragma unroll
      for (int s = 0; s < 16; ++s) a += part[(s * 32 + j2) * 4 + bb];
      p.mod[bb * 6144 + task * 32 + j2] = a + p.b_ada[task * 32 + j2];
    }
    __syncthreads();
  }
}

#define WT_T0 1424
#define WT_T1 (WT_T0 + 16384)
#define WT_T2 (WT_T1 + 8192)
#define WT_T3 (WT_T2 + 128)
#define WT_T4 (WT_T3 + 128)
#define WT_T5 (WT_T4 + 256)
struct WtTile { const float* src; bf16_t* dst; int K, N, mode, k0, n0; };
__device__ __forceinline__ WtTile wt_desc(const Params& p, int t) {
  WtTile d;
  if (t < WT_T0) { const int kt = t / 89, nt = t % 89; d = {p.w_in, p.w_in_t, 1024, INW, 1, kt * 64, nt * 64}; }
  else if (t < WT_T1) { const int u = t - WT_T0, e = u >> 9, r = u & 511, kt = r >> 5, nt = r & 31; d = {p.w_gu + (size_t)e * 1024 * 2048, p.wgu_t + (size_t)e * 2048 * 1024, 1024, 2048, 2, kt * 64, nt * 64}; }
  else if (t < WT_T2) { const int u = t - WT_T1, e = u >> 8, r = u & 255, kt = r >> 4, nt = r & 15; d = {p.w_down + (size_t)e * 1024 * 1024, p.wd_t + (size_t)e * 1024 * 1024, 1024, 1024, 0, kt * 64, nt * 64}; }
  else if (t < WT_T3) { const int u = t - WT_T2, kt = u >> 4, nt = u & 15; d = {p.w_br_a, p.wbra_t, 512, 1024, 0, kt * 64, nt * 64}; }
  else if (t < WT_T4) { const int u = t - WT_T3, kt = u >> 4, nt = u & 15; d = {p.w_br_b, p.wbrb_t, 512, 1024, 0, kt * 64, nt * 64}; }
  else { const int u = t - WT_T4, kt = u >> 4, nt = u & 15; d = {p.w_o, p.wo_t, 1024, 1024, 0, kt * 64, nt * 64}; }
  return d;
}
__device__ __forceinline__ void wt_load(const WtTile& d, int tid, f32x4 (&v)[2]) {
#pragma unroll
  for (int it = 0; it < 2; ++it) {
    const int row = (tid >> 4) + 32 * it, n = d.n0 + (tid & 15) * 4;
    v[it] = (f32x4){0.f, 0.f, 0.f, 0.f};
    if (n < d.N) v[it] = __builtin_nontemporal_load((const f32x4*)(d.src + (size_t)(d.k0 + row) * d.N + n));
  }
}
__device__ void ph_wt(const Params& p, LAS unsigned char* lds, int nblk, int bid) {
  LAS float* tile = (LAS float*)(lds + 32768);
  const int tid = p.tid;
  int t = bid;
  if (t >= WT_T5) return;
  WtTile cur = wt_desc(p, t);
  f32x4 v[2]; wt_load(cur, tid, v);
  for (;;) {
    const int tn = t + nblk;
    WtTile nxt = cur; f32x4 vn[2];
    if (tn < WT_T5) { nxt = wt_desc(p, tn); wt_load(nxt, tid, vn); }
#pragma unroll
    for (int it = 0; it < 2; ++it) {
      const int row = (tid >> 4) + 32 * it, c4 = (tid & 15) * 4;
      tile[row * 65 + c4] = v[it][0]; tile[row * 65 + c4 + 1] = v[it][1]; tile[row * 65 + c4 + 2] = v[it][2]; tile[row * 65 + c4 + 3] = v[it][3];
    }
    __syncthreads();
    {
      const int nl = tid >> 3, kc = tid & 7, n = cur.n0 + nl;
      if (n < cur.N) {
        const int dd = map_col(n, cur.mode);
        if (dd >= 0) {
          float f[8];
#pragma unroll
          for (int j = 0; j < 8; ++j) f[j] = tile[(8 * kc + j) * 65 + nl];
          u32x4 w; w.x = pk2(f[0], f[1]); w.y = pk2(f[2], f[3]); w.z = pk2(f[4], f[5]); w.w = pk2(f[6], f[7]);
          *(u32x4*)(cur.dst + (size_t)dd * cur.K + cur.k0 + 8 * kc) = w;
        }
      }
    }
    __syncthreads();
    if (tn >= WT_T5) break;
    t = tn; cur = nxt; v[0] = vn[0]; v[1] = vn[1];
  }
}

__device__ void ph_h(const Params& p, LAS unsigned char* lds, int nblk, int bid) {
  const int wid = p.tid >> 6, lane = p.tid & 63;
  LAS float* wb = (LAS float*)lds;
  for (int i = p.tid; i < 2048; i += 512) {
    const int k = i >> 1, hf = i & 1;
    const f32x4 v = *(const f32x4*)(p.w_in + (size_t)k * INW + 2048 + 4 * hf);
    wb[(4 * hf + 0) * 1024 + k] = v[0]; wb[(4 * hf + 1) * 1024 + k] = v[1]; wb[(4 * hf + 2) * 1024 + k] = v[2]; wb[(4 * hf + 3) * 1024 + k] = v[3];
  }
  __syncthreads();
  for (int t = bid * 8 + wid; t < T_TOK; t += nblk * 8) {
    const int b = t / SEQ;
    const float* xr = p.x + (size_t)t * DM;
    f32x4 xv[4];
    float ss = 0.f;
#pragma unroll
    for (int i = 0; i < 4; ++i) {
      xv[i] = *(const f32x4*)(xr + i * 256 + lane * 4);
      ss += xv[i][0] * xv[i][0] + xv[i][1] * xv[i][1] + xv[i][2] * xv[i][2] + xv[i][3] * xv[i][3];
    }
    ss = wave_sum(ss);
    const float rstd = rsqrtf(ss * (1.f / DM) + 1e-6f);
    const float* shift = p.mod + b * 6144;
    const float* scale = p.mod + b * 6144 + 1024;
    float acc[8] = {0, 0, 0, 0, 0, 0, 0, 0};
#pragma unroll
    for (int i = 0; i < 4; ++i) {
      const int k = i * 256 + lane * 4;
      const f32x4 g = *(const f32x4*)(p.g_pre_mix + k), sc = *(const f32x4*)(scale + k), sh = *(const f32x4*)(shift + k);
      f32x4 hv;
#pragma unroll
      for (int j = 0; j < 4; ++j) hv[j] = xv[i][j] * rstd * g[j] * (1.f + sc[j]) + sh[j];
#pragma unroll
      for (int e = 0; e < 8; ++e) { const f32x4 w = *(const LAS f32x4*)(wb + e * 1024 + k); acc[e] += hv[0] * w[0] + hv[1] * w[1] + hv[2] * w[2] + hv[3] * w[3]; }
      u32x2 pk; pk.x = pk2(hv[0], hv[1]); pk.y = pk2(hv[2], hv[3]);
      *(u32x2*)(p.hbf + (size_t)t * DM + k) = pk;
    }
#pragma unroll
    for (int e = 0; e < 8; ++e) acc[e] = wave_sum(acc[e]);
    if (lane == 0) { *(f32x4*)(p.ba + (size_t)t * 8) = (f32x4){acc[0], acc[1], acc[2], acc[3]}; *(f32x4*)(p.ba + (size_t)t * 8 + 4) = (f32x4){acc[4], acc[5], acc[6], acc[7]}; }
  }
}

__device__ void ph_post_mix(const Params& p, LAS unsigned char* lds, int nblk, int bid, int rep) {
  const int wid = p.tid >> 6, lane = p.tid & 63;
  LAS bf16_t* wl = (LAS bf16_t*)lds;
  LAS float* sh = (LAS float*)(lds + 81920) + wid * 1024;
  LAS int* lcnt = (LAS int*)(lds + 114688);
  LAS int* lbase = lcnt + 32;
  LAS int* lent = (LAS int*)(lds + 115200) + wid * 256;
  int nloc = 0;
  if (p.tid < 32) lcnt[p.tid] = 0;
  for (int i = p.tid; i < 1024 * 8; i += 512) {
    const int k = i >> 3, c = i & 7;
    const f32x4 v = *(const f32x4*)(p.w_router + (size_t)k * 32 + c * 4);
    u32x2 w2; w2.x = pk2(v[0], v[1]); w2.y = pk2(v[2], v[3]);
    *(LAS u32x2*)(wl + k * 40 + c * 4) = w2;
  }
  __syncthreads();
  for (int t = bid * 8 + wid; t < T_TOK; t += nblk * 8) {
    const int b = t / SEQ;
    const float* md = p.mod + b * 6144;
    float mv[16];
    float ss = 0.f;
#pragma unroll
    for (int i = 0; i < 2; ++i) {
      float f[8]; unpack8(*(const u32x4*)(p.mixer + (size_t)t * DM + i * 512 + lane * 8), f);
#pragma unroll
      for (int j = 0; j < 8; ++j) { mv[i * 8 + j] = f[j]; ss += f[j] * f[j]; }
    }
    ss = wave_sum(ss);
    const float rstd = rsqrtf(ss * (1.f / DM) + 1e-6f);
    float x1[16];
    float s2 = 0.f;
#pragma unroll
    for (int i = 0; i < 2; ++i)
#pragma unroll
      for (int j4 = 0; j4 < 2; ++j4) {
        const int k = i * 512 + lane * 8 + j4 * 4;
        const f32x4 xv = *(const f32x4*)(p.x + (size_t)t * DM + k);
        const f32x4 gm = *(const f32x4*)(md + 2048 + k), gp = *(const f32x4*)(p.g_post_mix + k);
        f32x4 o;
#pragma unroll
        for (int j = 0; j < 4; ++j) { o[j] = xv[j] + gm[j] * (mv[i * 8 + j4 * 4 + j] * rstd * gp[j]); x1[i * 8 + j4 * 4 + j] = o[j]; s2 += o[j] * o[j]; }
        *(f32x4*)(p.out + (size_t)t * DM + k) = o;
      }
    s2 = wave_sum(s2);
    const float rstd2 = rsqrtf(s2 * (1.f / DM) + 1e-6f);
#pragma unroll
    for (int i = 0; i < 2; ++i) {
      float hv[8];
#pragma unroll
      for (int j = 0; j < 8; ++j) {
        const int k = i * 512 + lane * 8 + j;
        hv[j] = x1[i * 8 + j] * rstd2 * p.g_pre_ffn[k] * (1.f + md[4096 + k]) + md[3072 + k];
        sh[k] = hv[j];
      }
      u32x4 w; w.x = pk2(hv[0], hv[1]); w.y = pk2(hv[2], hv[3]); w.z = pk2(hv[4], hv[5]); w.w = pk2(hv[6], hv[7]);
      *(u32x4*)(p.h2 + (size_t)t * DM + i * 512 + lane * 8) = w;
    }
#ifdef PM_SKIP
    if (rep) continue;
#endif
    float acc[32];
#pragma unroll
    for (int e2 = 0; e2 < 32; ++e2) acc[e2] = 0.f;
#pragma unroll 4
    for (int i = 0; i < 16; ++i) {
      const float hk = sh[lane + 64 * i];
      const LAS u32x4* wr = (const LAS u32x4*)(wl + (lane + 64 * i) * 40);
#pragma unroll
      for (int c4 = 0; c4 < 4; ++c4) {
        float f[8]; unpack8(wr[c4], f);
#pragma unroll
        for (int j = 0; j < 8; ++j) acc[c4 * 8 + j] += hk * f[j];
      }
    }
    {
      const bool u5 = lane & 32, u4 = lane & 16, u3 = lane & 8, u2 = lane & 4, u1 = lane & 2;
      float a16[16], a8[8], a4[4], a2[2];
#pragma unroll
      for (int j = 0; j < 16; ++j) { const float snd = u5 ? acc[j] : acc[16 + j]; const float rcv = __shfl_xor(snd, 32, 64); a16[j] = (u5 ? acc[16 + j] : acc[j]) + rcv; }
#pragma unroll
      for (int j = 0; j < 8; ++j) { const float snd = u4 ? a16[j] : a16[8 + j]; const float rcv = __shfl_xor(snd, 16, 64); a8[j] = (u4 ? a16[8 + j] : a16[j]) + rcv; }
#pragma unroll
      for (int j = 0; j < 4; ++j) { const float snd = u3 ? a8[j] : a8[4 + j]; const float rcv = __shfl_xor(snd, 8, 64); a4[j] = (u3 ? a8[4 + j] : a8[j]) + rcv; }
#pragma unroll
      for (int j = 0; j < 2; ++j) { const float snd = u2 ? a4[j] : a4[2 + j]; const float rcv = __shfl_xor(snd, 4, 64); a2[j] = (u2 ? a4[2 + j] : a4[j]) + rcv; }
      const float snd = u1 ? a2[0] : a2[1]; const float rcv = __shfl_xor(snd, 2, 64);
      float a1 = (u1 ? a2[1] : a2[0]) + rcv;
      a1 += __shfl_xor(a1, 1, 64);
      acc[0] = a1;
    }
    const int e = lane >> 1;
    float lg = acc[0] + p.b_router[e];
    if (lane & 1) lg = -INFINITY;
    float tv[4]; int ti[4];
#pragma unroll
    for (int r = 0; r < 4; ++r) {
      const float m = wave_max(lg);
      const unsigned long long bal = __ballot(lg == m);
      const int idx = __ffsll((long long)bal) - 1;
      tv[r] = m; ti[r] = idx >> 1;
      if (lane == idx) lg = -INFINITY;
    }
    const float e1 = __expf(tv[1] - tv[0]), e2 = __expf(tv[2] - tv[0]), e3 = __expf(tv[3] - tv[0]);
    const float inv = 1.f / (1.f + e1 + e2 + e3);
    if (lane < 4) {
      const int ee = lane == 0 ? ti[0] : lane == 1 ? ti[1] : lane == 2 ? ti[2] : ti[3];
      const float ww = (lane == 0 ? 1.f : lane == 1 ? e1 : lane == 2 ? e2 : e3) * inv;
      p.aw[t * 4 + lane] = ww;
      const int rank = __hip_atomic_fetch_add(&lcnt[ee], 1, __ATOMIC_RELAXED, __HIP_MEMORY_SCOPE_WORKGROUP);
      lent[nloc * 4 + lane] = (ee << 16) | rank;
      lent[nloc * 4 + lane + 2048] = t * 4 + lane;
    }
    ++nloc;
  }
  __syncthreads();
  if (p.tid < 32) lbase[p.tid] = atomicAdd(&p.cnt[p.tid * 64 + 32 * rep], lcnt[p.tid]);
  __syncthreads();
  for (int i = lane; i < nloc * 4; i += 64) {
    const int er = lent[i], a = lent[i + 2048];
    p.elist[(er >> 16) * T_TOK + lbase[er >> 16] + (er & 0xffff)] = a;
  }
}

__device__ void ph_gather(const Params& p, LAS unsigned char* lds, int nblk, int bid) {
  const int wid = p.tid >> 6, lane = p.tid & 63;
  LAS int* tb = (LAS int*)lds;
  if (p.tid == 0) { int off = 0; for (int k = 0; k < NE; ++k) { const int c = p.cnt[k * 64]; tb[k] = off; tb[64 + k] = c; off += ((c + 255) >> 8) << 8; } tb[NE] = off; }
  __syncthreads();
  const int total = tb[NE];
  for (int r = bid * 8 + wid; r < total; r += nblk * 8) {
    int e = 0;
#pragma unroll 1
    for (int k = 1; k < NE; ++k) if (r >= tb[k]) e = k;
    const int i = r - tb[e];
    const int a = (i < tb[64 + e]) ? p.elist[e * T_TOK + i] : -1;
    if (lane == 0) p.rowmap[r] = a;
    u32x4 v0 = {0, 0, 0, 0}, v1 = v0;
    if (a >= 0) { const u32x4* src = (const u32x4*)(p.h2 + (size_t)(a >> 2) * DM); v0 = src[lane]; v1 = src[64 + lane]; }
    u32x4* dst = (u32x4*)(p.xs + (size_t)r * DM);
    dst[lane] = v0; dst[64 + lane] = v1;
  }
}

__device__ void ph_final(const Params& p, int nblk, int bid, int rep) {
  const int wid = p.tid >> 6, lane = p.tid & 63;
  for (int t0 = bid * 8 + wid; t0 < T_TOK; t0 += nblk * 16) {
    int tt[2] = {t0, t0 + nblk * 8};
    if (tt[1] >= T_TOK) tt[1] = t0;
    float mv[2][16]; float ss[2];
#pragma unroll
    for (int u = 0; u < 2; ++u) {
      const int t = tt[u];
      const f32x4 wv = *(const f32x4*)(p.aw + t * 4);
      ss[u] = 0.f;
#pragma unroll
      for (int i = 0; i < 2; ++i) {
        const bf16_t* y = p.yslot + (size_t)t * 4 * DM + i * 512 + lane * 8;
        float f0[8], f1[8], f2[8], f3[8];
        unpack8(*(const u32x4*)y, f0); unpack8(*(const u32x4*)(y + DM), f1); unpack8(*(const u32x4*)(y + 2 * DM), f2); unpack8(*(const u32x4*)(y + 3 * DM), f3);
#pragma unroll
        for (int j = 0; j < 8; ++j) { const float m = wv[0] * f0[j] + wv[1] * f1[j] + wv[2] * f2[j] + wv[3] * f3[j]; mv[u][i * 8 + j] = m; ss[u] += m * m; }
      }
    }
    f32x4 x1[2][4];
#pragma unroll
    for (int u = 0; u < 2; ++u)
#pragma unroll
      for (int i = 0; i < 2; ++i)
#pragma unroll
        for (int j4 = 0; j4 < 2; ++j4) x1[u][i * 2 + j4] = *(const f32x4*)(p.out + (size_t)tt[u] * DM + i * 512 + lane * 8 + j4 * 4);
    ss[0] = wave_sum(ss[0]); ss[1] = wave_sum(ss[1]);
#pragma unroll
    for (int u = 0; u < 2; ++u) {
      const int t = tt[u];
      if (u == 1 && t == t0) break;
      const float* md = p.mod + (t / SEQ) * 6144;
      const float rstd = rsqrtf(ss[u] * (1.f / DM) + 1e-6f);
#pragma unroll
      for (int i = 0; i < 2; ++i)
#pragma unroll
        for (int j4 = 0; j4 < 2; ++j4) {
          const int k = i * 512 + lane * 8 + j4 * 4;
          float* op = p.out + (size_t)t * DM + k;
          const f32x4 gf = *(const f32x4*)(md + 5120 + k), gp = *(const f32x4*)(p.g_post_ffn + k);
          f32x4 o;
#pragma unroll
          for (int j = 0; j < 4; ++j) o[j] = x1[u][i * 2 + j4][j] + gf[j] * (mv[u][i * 8 + j4 * 4 + j] * rstd * gp[j]);
          *(f32x4*)(rep ? (float*)p.hbf + (size_t)(t & 8191) * DM + k : op) = o;
        }
    }
  }
}

#define XCD_BAR_WORDS 3456
struct KArgs { const void* in[22]; float* out; char* ws; long long never; };
__host__ __device__ inline size_t al(size_t x) { return (x + 255) & ~(size_t)255; }
__host__ __device__ inline void fill_params(Params& p, const KArgs& k) {
  p.x = (const float*)k.in[0]; p.c = (const float*)k.in[1]; p.w_ada = (const float*)k.in[2]; p.b_ada = (const float*)k.in[3];
  p.g_pre_mix = (const float*)k.in[4]; p.g_post_mix = (const float*)k.in[5]; p.g_pre_ffn = (const float*)k.in[6];
  p.g_post_ffn = (const float*)k.in[7]; p.w_in = (const float*)k.in[8]; p.conv_w = (const float*)k.in[9];
  p.a_log = (const float*)k.in[10]; p.dt_bias = (const float*)k.in[11]; p.g_dn_out = (const float*)k.in[12];
  p.w_br_a = (const float*)k.in[13]; p.w_br_b = (const float*)k.in[14]; p.w_o = (const float*)k.in[15];
  p.w_router = (const float*)k.in[16]; p.b_router = (const float*)k.in[17]; p.w_gu = (const float*)k.in[18];
  p.b_gu = (const float*)k.in[19]; p.w_down = (const float*)k.in[20]; p.b_down = (const float*)k.in[21];
  p.out = k.out;
  char* w = k.ws;
  size_t o = 0;
#define take(bytes) (w + (o += al(bytes)) - al(bytes))
  p.mod = (float*)take(4 * 6144 * 4);
  p.cnt = (int*)take(16384);
  p.ba = (float*)take((size_t)T_TOK * 8 * 4);
  p.hbf = (bf16_t*)take((size_t)T_TOK * DM * 2);
  p.proj = (bf16_t*)take((size_t)T_TOK * PW * 2);
  p.w_in_t = (bf16_t*)take((size_t)PW * DM * 2);
  p.wgu_t = (bf16_t*)take((size_t)NE * 2048 * DM * 2);
  p.wd_t = (bf16_t*)take((size_t)NE * 1024 * DM * 2);
  p.wbra_t = (bf16_t*)take((size_t)1024 * 512 * 2);
  p.wbrb_t = (bf16_t*)take((size_t)1024 * 512 * 2);
  p.wo_t = (bf16_t*)take((size_t)1024 * 1024 * 2);
  p.qb = (bf16_t*)take((size_t)T_TOK * 512 * 2);
  p.kb = (bf16_t*)take((size_t)T_TOK * 512 * 2);
  p.kmean = (float*)take((size_t)16 * 16 * 128 * 4);
  p.oab = (bf16_t*)take((size_t)T_TOK * DM * 2);
  p.merged = (bf16_t*)take((size_t)T_TOK * DM * 2);
  p.mixer = (bf16_t*)take((size_t)T_TOK * DM * 2);
  p.h2 = (bf16_t*)take((size_t)T_TOK * DM * 2);
  p.elist = (int*)take((size_t)NE * T_TOK * 4);
  p.aw = (float*)take((size_t)T_TOK * 4 * 4);
  p.rowmap = (int*)take((size_t)73728 * 4);
  p.dnA = (unsigned char*)take((size_t)1024 * DN_ABYTES);
  p.dnU = (float*)take((size_t)1024 * DN_UFLOATS * 4);
  p.dnG = (float*)take(4096);
  p.oab2 = (bf16_t*)take((size_t)T_TOK * 512 * 2);
  p.dbg = (float*)take(256);
  p.bar = (unsigned*)take(XCD_BAR_WORDS * 4);
  p.dn_out = p.oab; p.dn_out_ld = DM;
  p.Kp = (bf16_t*)take((size_t)16 * 128 * 8192);
  p.Vp = (bf16_t*)take((size_t)16 * 128 * 8192);
  p.wq = p.cnt + 32 * 64;
  p.mb_out = p.oab; p.mb_out_ld = DM; p.mb_out_off = 512;
  p.xs = p.proj;
  char* big = take((size_t)73728 * DM * 2 + (size_t)65536 * DM * 2);
  p.act = (bf16_t*)big;
  p.yslot = (bf16_t*)(big + (size_t)73728 * DM * 2);
  {
    char* s = big; size_t so = 0;
#define t2(bytes) (s + (so += al(bytes)) - al(bytes))
    p.nq = (float*)t2((size_t)T_TOK * 512 * 4);
    p.nk = (float*)t2((size_t)T_TOK * 512 * 4);
    p.nv = (float*)t2((size_t)T_TOK * 512 * 4);
    p.no = (float*)t2((size_t)T_TOK * 512 * 4);
    p.ntmp = (float*)t2((size_t)T_TOK * DM * 4);
    p.nbeta = (float*)t2((size_t)T_TOK * 4 * 4);
    p.ng = (float*)t2((size_t)T_TOK * 4 * 4);
  }

#undef take
#undef t2
  p.never = (int)k.never;
}

#define XB_TMO      128
#define XB_XCNT(j)  (256  + 64 * (j))
#define XB_XSUB(j)  (1280 + 64 * (j))
#define XB_XGEN(j)  (2304 + 64 * (j))
#define XB_TOP      3328
#define XB_TOPGEN   3392
#define XB_SPIN_CAP (1u << 18)

__device__ __forceinline__ unsigned xb_ld(unsigned* p)              { return __hip_atomic_load(p, __ATOMIC_RELAXED, __HIP_MEMORY_SCOPE_AGENT); }
__device__ __forceinline__ unsigned xb_add(unsigned* p, unsigned v) { return __hip_atomic_fetch_add(p, v, __ATOMIC_RELAXED, __HIP_MEMORY_SCOPE_AGENT); }
__device__ __forceinline__ unsigned xb_xcc_id() { return (unsigned)__builtin_amdgcn_s_getreg((3 << 11) | 20) & 0xFu; }
#define XB_SPIN(cond, bar) do { unsigned _sp = 0; while (cond) { __builtin_amdgcn_s_sleep(1); \
    if ((++_sp & 255u) == 0u) { if (xb_ld(&(bar)[XB_TMO])) break; if (_sp > XB_SPIN_CAP) { atomicAdd(&(bar)[XB_TMO], 1u); break; } } } } while (0)

struct XcdBarrier {
    unsigned* bar; unsigned x;
    volatile LAS unsigned* st;
};

__device__ __forceinline__ XcdBarrier xcd_barrier_post(unsigned* bar, volatile LAS unsigned* st) {
    XcdBarrier b; b.bar = bar; b.x = xb_xcc_id(); b.st = st;
    if (threadIdx.x == 0) (void)xb_add(&bar[XB_XCNT(b.x)], 1u);
    return b;
}
__device__ __forceinline__ void xcd_barrier_complete(unsigned* bar, unsigned x, unsigned& nloc, unsigned& nx) {
    const unsigned G = gridDim.x * gridDim.y * gridDim.z;
    unsigned sum, cnt, mine, sp = 0u;
    for (;;) {
        sum = 0u; cnt = 0u; mine = 0u;
#pragma unroll
        for (unsigned j = 0; j < 16; ++j) { const unsigned c = xb_ld(&bar[XB_XCNT(j)]); sum += c; cnt += (c > 0u) ? 1u : 0u; mine = (j == x) ? c : mine; }
        if (sum == G) break;
        __builtin_amdgcn_s_sleep(1);
        if ((++sp & 255u) == 0u) { if (xb_ld(&bar[XB_TMO])) break; if (sp > XB_SPIN_CAP) { atomicAdd(&bar[XB_TMO], 1u); break; } }
    }
    nloc = mine > 0u ? mine : 1u; nx = cnt > 0u ? cnt : 1u;
}

__device__ __forceinline__ void xcd_barrier(const XcdBarrier& b, const int tid) {
    asm volatile("s_waitcnt vmcnt(0)" ::: "memory");
    __syncthreads();
    if (tid == 0) {
        unsigned* bar = b.bar;
        __builtin_amdgcn_s_waitcnt(0);
        unsigned nloc = b.st[0], nx = b.st[1];
        if (nloc == 0u) { xcd_barrier_complete(bar, b.x, nloc, nx); b.st[0] = nloc; b.st[1] = nx; }
        const unsigned old = xb_add(&bar[XB_XSUB(b.x)], 1u);
        const unsigned gen = old / nloc;
        if (old + 1u == (gen + 1u) * nloc) {
            __builtin_amdgcn_fence(__ATOMIC_RELEASE, "agent");
            asm volatile("s_waitcnt vmcnt(0)" ::: "memory");
            const unsigned og = xb_add(&bar[XB_TOP], 1u);
            const unsigned tg = og / nx;
            if (og + 1u == (tg + 1u) * nx) xb_add(&bar[XB_TOPGEN], 1u);
            else XB_SPIN(xb_ld(&bar[XB_TOPGEN]) == tg, bar);
            __builtin_amdgcn_fence(__ATOMIC_ACQUIRE, "agent");
            xb_add(&bar[XB_XGEN(b.x)], 1u);
            asm volatile("s_waitcnt vmcnt(0)" ::: "memory");
        } else {
            XB_SPIN(xb_ld(&bar[XB_XGEN(b.x)]) == gen, bar);
            __builtin_amdgcn_fence(__ATOMIC_ACQUIRE, "agent");
            asm volatile("s_waitcnt vmcnt(0)" ::: "memory");
        }
    }
    __syncthreads();
}


__device__ __forceinline__ void load_ka(KArgs& kk) {
#if defined(__HIP_DEVICE_COMPILE__)
  typedef __attribute__((address_space(1))) char* gptr_t;
  typedef const __attribute__((address_space(4))) gptr_t* kptr_t;
  kptr_t kp = (kptr_t)__builtin_amdgcn_kernarg_segment_ptr();
  asm volatile("" : "+s"(kp));
#pragma unroll
  for (int i = 0; i < 22; ++i) kk.in[i] = (const void*)kp[i];
  kk.out = (float*)kp[22];
  kk.ws = (char*)kp[23];
  kk.never = ((const __attribute__((address_space(4))) long long*)kp)[24];
#endif
}
__device__ __forceinline__ void grid_bar(const Params& p, LAS unsigned char* lds);
#define MEGA_LDS 148480
#define MEGA_LDS_ALLOC (MEGA_LDS + 16)
__device__ __forceinline__ void grid_bar(const Params& p, LAS unsigned char* lds) {
  XcdBarrier b; b.bar = p.bar; b.x = xb_xcc_id(); b.st = (volatile LAS unsigned*)(lds + MEGA_LDS);
  xcd_barrier(b, p.tid);
}
__global__ __launch_bounds__(512) void mega(KArgs ka) {
  extern __shared__ __attribute__((aligned(16))) unsigned char shm[];
  LAS unsigned char* lds = (LAS unsigned char*)shm;
  cg::grid_group grid = cg::this_grid();
  const int nblk = gridDim.x, bid = blockIdx.x;
  volatile LAS unsigned* xst = (volatile LAS unsigned*)(lds + MEGA_LDS);
  if (threadIdx.x == 0) { xst[0] = 0u; xst[1] = 0u; xst[2] = 0u; xst[3] = 0u; }
  __syncthreads();
  { Params p0; fill_params(p0, ka); (void)xcd_barrier_post(p0.bar, xst); }
  if (ka.never) grid.sync();
#ifndef REPMASK
#define REPMASK 0
#endif
#define LOADKA KArgs kk; load_ka(kk)
#ifndef PHMASK
#define PHMASK 0xffff
#endif
#define PHASE(k, body) if (((PHMASK) >> (k)) & 1) for (int rep_ = 0; rep_ < (((REPMASK) >> (k)) & 1) + 1; ++rep_) { \
    LOADKA; Params p; fill_params(p, kk); { int t_ = threadIdx.x; asm volatile("" : "+v"(t_)); p.tid = t_; } body; grid_bar(p, lds); }
#ifdef XBAR
  for (int xb_ = 0; xb_ < XBAR; ++xb_) { PHASE(15, {}) }
#endif
  PHASE(0, { ph_mod(p, lds, nblk, bid); ph_wt(p, lds, nblk, bid); })
  PHASE(1, { ph_h(p, lds, nblk, bid); })
  PHASE(2, { ph_proj(p, lds, nblk, bid); })
  PHASE(3, { bool first = true; for (int ci = bid; ci < 1024; ci += nblk) { dn_prep_chunk(p, lds, ci, first); first = false; }
             for (int item = bid; item < 256; item += nblk) moba_prep_block(p, lds, item); })
  PHASE(4, { if (bid < 32) dn_scan_blk(p, lds, bid); moba_worker(p, lds, rep_); })
  PHASE(5, { ph_dn_norm(p, nblk, bid); })
  PHASE(6, { ph_br(p, lds, nblk, bid); })
  PHASE(7, { ph_mix(p, lds, nblk, bid); })
  PHASE(8, { ph_post_mix(p, lds, nblk, bid, rep_); })
  PHASE(9, { ph_gather(p, lds, nblk, bid); })
  PHASE(10, { ph_moe1(p, lds, nblk, bid); })
  PHASE(11, { ph_moe2(p, lds, nblk, bid); })
  PHASE(12, { ph_final(p, nblk, bid, rep_); })
}


extern "C" void kernel_launch(void* const* d_in, const int* in_sizes, int n_in, void* d_out, int out_size, void* d_ws,
                              size_t ws_size, hipStream_t stream) {
  KArgs ka{};
  for (int i = 0; i < 22; ++i) ka.in[i] = d_in[i];
  ka.out = (float*)d_out; ka.ws = (char*)d_ws; ka.never = 0;
  Params p{};
  fill_params(p, ka);
  static int grid_blocks = 0;
  if (!grid_blocks) {
    (void)hipFuncSetAttribute((const void*)mega, hipFuncAttributeMaxDynamicSharedMemorySize, MEGA_LDS_ALLOC);
    int dev = 0, cus = 0, per_cu = 0;
    (void)hipGetDevice(&dev);
    (void)hipDeviceGetAttribute(&cus, hipDeviceAttributeMultiprocessorCount, dev);
    (void)hipOccupancyMaxActiveBlocksPerMultiprocessor(&per_cu, mega, 512, MEGA_LDS_ALLOC);
    if (per_cu != 1) per_cu = 1;
    grid_blocks = cus * per_cu;
  }
  (void)hipMemsetAsync(p.cnt, 0, 16384, stream);
  (void)hipMemsetAsync(p.bar, 0, XCD_BAR_WORDS * 4, stream);
  void* args[] = {&ka};
  hipError_t e = hipLaunchCooperativeKernel((void*)mega, dim3(grid_blocks), dim3(512), args, MEGA_LDS_ALLOC, stream);
  if (e != hipSuccess) fprintf(stderr, "cooperative launch failed: %s (grid %d)\n", hipGetErrorString(e), grid_blocks);
}
```

```cpp
#include <hip/hip_runtime.h>
#include <hip/hip_cooperative_groups.h>
#include <cstdio>
namespace cg = cooperative_groups;
#include <stdint.h>

typedef unsigned short bf16_t;

#define T_TOK 16384
#define SEQ 4096
#define NB 4
#define DM 1024
#define INW 5640
#define PW 5632
#define C_QA 0
#define C_KA 512
#define C_VA 1024
#define C_Z 1536
#define C_MQ 2048
#define C_MK 2560
#define C_MV 3072
#define C_GA 3584
#define C_GB 4608
#define NE 32

__device__ __forceinline__ bf16_t f2bf(float f) {
  unsigned u = __float_as_uint(f);
  u += 0x7fffu + ((u >> 16) & 1u);
  return (bf16_t)(u >> 16);
}
__device__ __forceinline__ float bf2f(bf16_t h) { return __uint_as_float(((unsigned)h) << 16); }
__device__ __forceinline__ float sigmoidf_(float x) { return 1.f / (1.f + __expf(-x)); }
__device__ __forceinline__ float siluf_(float x) { return x / (1.f + __expf(-x)); }
__device__ __forceinline__ float wave_sum(float v) {
#pragma unroll
  for (int o = 32; o > 0; o >>= 1) v += __shfl_xor(v, o, 64);
  return v;
}
__device__ __forceinline__ float wave_max(float v) {
#pragma unroll
  for (int o = 32; o > 0; o >>= 1) v = fmaxf(v, __shfl_xor(v, o, 64));
  return v;
}

typedef __bf16 bf16x2_t __attribute__((ext_vector_type(2)));
typedef float f32x2_t __attribute__((ext_vector_type(2)));
__device__ __forceinline__ unsigned pk2(float a, float b) { f32x2_t v = {a, b}; bf16x2_t r = __builtin_convertvector(v, bf16x2_t); return __builtin_bit_cast(unsigned, r); }

struct Params {
  const float *x, *c, *w_ada, *b_ada, *g_pre_mix, *g_post_mix, *g_pre_ffn, *g_post_ffn, *w_in, *conv_w,
      *a_log, *dt_bias, *g_dn_out, *w_br_a, *w_br_b, *w_o, *w_router, *b_router, *w_gu, *b_gu, *w_down, *b_down;
  float* out;
  float* mod;
  int* cnt;
  float* ba;
  bf16_t* hbf;
  bf16_t* proj;
  bf16_t* w_in_t;
  bf16_t* wgu_t;
  bf16_t* wd_t;
  bf16_t* wbra_t;
  bf16_t* wbrb_t;
  bf16_t* wo_t;
  bf16_t* qb;
  bf16_t* kb;
  float* kmean;
  bf16_t* oab;
  bf16_t* merged;
  bf16_t* mixer;
  bf16_t* h2;
  int* elist;
  float* aw;
  bf16_t* act;
  bf16_t* xs;
  int* rowmap;
  bf16_t* yslot;
  unsigned char* dnA; float* dnU; float* dnG;
  bf16_t* dn_out; int dn_out_ld;
  bf16_t* oab2; float* dbg;
  unsigned* bar; int never; int tid;
  bf16_t* Kp; bf16_t* Vp; int* wq;
  bf16_t* mb_out; int mb_out_ld; int mb_out_off;
  float* nq; float* nk; float* nv;
  float* nbeta; float* ng;
  float* no;
  float* ntmp;
};

__device__ __forceinline__ int map_col(int n, int mode) {
  if (mode == 0) return n;
  if (mode == 1) return n < 2048 ? n : (n < 2056 ? -1 : n - 8);
  if (n < 1024) return (n >> 7) * 256 + (n & 127);
  int j = n - 1024;
  return (j >> 7) * 256 + 128 + (j & 127);
}
namespace pg8 {
#define PG8_LAS __attribute__((address_space(3)))
typedef short bf16x8 __attribute__((ext_vector_type(8)));
typedef float f32x4 __attribute__((ext_vector_type(4)));
typedef unsigned u32x4 __attribute__((ext_vector_type(4)));
constexpr int BM = 256, BK = 64, HALF = 128, HTB = HALF * BK * 2, STAGE_BYTES = 8 * HTB, NXCD = 8, WGM = 8;

__host__ __device__ __forceinline__ int lds_byte(int r, int c) { const int st = (r >> 4) * 2 + (c >> 5), rr = r & 15, cc = c & 31, ob = rr * 64 + cc * 2; return st * 1024 + (ob ^ (((ob >> 9) & 1) << 5)); }
__host__ __device__ __forceinline__ void stage_rc(int b, int& R, int& C) { const int st = b / 1024, sb = b % 1024, swz = sb ^ (((sb >> 9) & 1) << 5); R = (st >> 1) * 16 + swz / 64; C = (st & 1) * 32 + (swz % 64) / 2; }
__host__ __device__ __forceinline__ int perm32(int rho) { const int n = rho >> 4, i = rho & 15; return 8 * (i >> 2) + 4 * n + (i & 3); }

struct Unit { int pm, pn, z; };
__device__ __forceinline__ unsigned cvt_pk_bf16(float lo, float hi) { unsigned r; asm volatile("v_cvt_pk_bf16_f32 %0, %1, %2" : "=v"(r) : "v"(lo), "v"(hi)); return r; }

struct TileOrder {
    int nM, nN, nwg, G, c;
    __device__ void init(int nM_, int nN_, int G_, int c_) { nM = nM_; nN = nN_; nwg = nM * nN; G = G_; c = c_; }
    __device__ bool tile(int i, int& pm, int& pn) const {
        const long L = (long)i * G + c; if (L >= nwg) return false;
        int wgid = (int)L; { const int q = nwg / NXCD, r = nwg % NXCD, xcd = wgid % NXCD, off = wgid / NXCD; wgid = (xcd < r ? xcd * (q + 1) : r * (q + 1) + (xcd - r) * q) + off; }
        const int nig = WGM * nN, gid = wgid / nig, fm = gid * WGM, gsz = (nM - fm) < WGM ? (nM - fm) : WGM;
        pm = fm + ((wgid % nig) % gsz); pn = (wgid % nig) / gsz; return true;
    }
};

template <class Epi, class Sched>
__device__ __forceinline__ void gemm_phase(PG8_LAS unsigned char* lds, const int tid, const int lda, const int ldb, const int K, const Sched& S, const Epi& E) {
    const int wid = __builtin_amdgcn_readfirstlane(tid >> 6), lane = tid & 63, wr = wid >> 2, wc = wid & 3, fr = lane & 15, fq = lane >> 4;
    const int nt = K / BK;
    unsigned voffA[2], voffB[2];
#pragma unroll
    for (int i = 0; i < 2; ++i) { int R, C; stage_rc(tid * 16 + i * 8192, R, C); const int Rb = Epi::PERM ? ((R & ~31) + perm32(R & 31)) : R;
        voffA[i] = (unsigned)(R * lda + C) * 2u; voffB[i] = (unsigned)(Rb * ldb + C) * 2u; }
    const size_t kstep = (size_t)(BK * 2);
    const size_t hstepA = (size_t)HALF * lda * 2, hstepB = (size_t)HALF * ldb * 2;
    const unsigned ldsw = (unsigned)wid * 1024u;
    const int aoff = lds_byte(wr * 64 + fr, fq * 8), boff = lds_byte(wc * 32 + fr, fq * 8);
    unsigned gA[2][2] = {{0u, 0u}, {0u, 0u}}, gAn[2][2] = {{0u, 0u}, {0u, 0u}};
    int gR[2], gC[2];
#pragma unroll
    for (int i = 0; i < 2; ++i) stage_rc(tid * 16 + i * 8192, gR[i], gC[i]);
#define PG8_SA(b, h) (((b) * 2 + (h)) * HTB)
#define PG8_SB(b, h) ((4 + (b) * 2 + (h)) * HTB)
#define PG8_STAGE(bufoff, gbase, voff) do { _Pragma("unroll") for (int _i = 0; _i < 2; ++_i) \
        __builtin_amdgcn_global_load_lds((const unsigned*)((const char*)(gbase) + (voff)[_i]), (PG8_LAS unsigned*)(lds + (bufoff) + ldsw + _i * 8192), 16, 0, 0); } while (0)
#define PG8_STAGEA(bufoff, ptr, h, nx) do { if constexpr (Sched::GATHER) { const unsigned gs_[2] = {(nx) ? gAn[h][0] : gA[h][0], (nx) ? gAn[h][1] : gA[h][1]}; PG8_STAGE(bufoff, ptr, gs_); } \
        else { PG8_STAGE(bufoff, (ptr) + (h) * hstepA, voffA); } } while (0)
#define PG8_LDA(dst, b, h) do { _Pragma("unroll") for (int m = 0; m < 4; ++m) _Pragma("unroll") for (int k = 0; k < 2; ++k) dst[m][k] = *(const PG8_LAS bf16x8*)(lds + PG8_SA(b, h) + aoff + m * 2048 + k * 1024); } while (0)
#define PG8_LDB(dst, b, h) do { _Pragma("unroll") for (int n = 0; n < 2; ++n) _Pragma("unroll") for (int k = 0; k < 2; ++k) dst[n][k] = *(const PG8_LAS bf16x8*)(lds + PG8_SB(b, h) + boff + n * 2048 + k * 1024); } while (0)
#define PG8_MMA(ai, bj, At, Bt) do { __builtin_amdgcn_s_setprio(1); _Pragma("unroll") for (int m = 0; m < 4; ++m) _Pragma("unroll") for (int n = 0; n < 2; ++n) _Pragma("unroll") for (int k = 0; k < 2; ++k) \
        acc[ai][bj][m][n] = __builtin_amdgcn_mfma_f32_16x16x32_bf16(Bt[n][k], At[m][k], acc[ai][bj][m][n], 0, 0, 0); __builtin_amdgcn_s_setprio(0); } while (0)
#define PG8_WAIT_V(n) asm volatile("s_waitcnt vmcnt(" #n ")" ::: "memory")
#define PG8_WAIT_L(n) asm volatile("s_waitcnt lgkmcnt(" #n ")" ::: "memory")
#define PG8_BAR __builtin_amdgcn_s_barrier()
#define PG8_SCHED __builtin_amdgcn_sched_barrier(0)
    Unit cur, nxt; int ui = 0;
    if (!S.next(0, cur)) return;
    f32x4 acc[2][2][4][2];
#pragma unroll
    for (int a = 0; a < 2; ++a)
#pragma unroll
        for (int b = 0; b < 2; ++b)
#pragma unroll
            for (int m = 0; m < 4; ++m)
#pragma unroll
                for (int n = 0; n < 2; ++n) acc[a][b][m][n] = (f32x4){0.f, 0.f, 0.f, 0.f};
    bf16x8 At[4][2], B0[2][2], B1[2][2];
    const char* cA = S.a_ptr(cur); const char* cB = S.b_ptr(cur);
    if constexpr (Sched::GATHER) {
_Pragma("unroll") for (int h = 0; h < 2; ++h) _Pragma("unroll") for (int i = 0; i < 2; ++i) gA[h][i] = S.a_goff(cur, gR[i] + 128 * h, gC[i]); }
    PG8_STAGE(PG8_SB(0, 0), cB, voffB); PG8_STAGEA(PG8_SA(0, 0), cA, 0, false); PG8_STAGE(PG8_SB(0, 1), cB + hstepB, voffB); PG8_STAGEA(PG8_SA(0, 1), cA, 1, false);
    if (wr == 1) PG8_BAR;
    PG8_WAIT_V(4); PG8_BAR;
    PG8_STAGE(PG8_SB(1, 0), cB + kstep, voffB); PG8_STAGEA(PG8_SA(1, 0), cA + kstep, 0, false); PG8_STAGE(PG8_SB(1, 1), cB + hstepB + kstep, voffB);
    PG8_WAIT_V(6); PG8_BAR;
    for (;;) {
        const bool has_next = S.next(ui + 1, nxt);
        const char* nA = has_next ? S.a_ptr(nxt) : cA; const char* nB = has_next ? S.b_ptr(nxt) : cB;
        if constexpr (Sched::GATHER) {
_Pragma("unroll") for (int h = 0; h < 2; ++h) _Pragma("unroll") for (int i = 0; i < 2; ++i) gAn[h][i] = has_next ? S.a_goff(nxt, gR[i] + 128 * h, gC[i]) : gA[h][i]; }
        for (int t = 0; t < nt; t += 2) {
            const bool last = (t == nt - 2);
            const char* a1 = cA + (size_t)(t + 1) * kstep;
            const char* a2 = last ? nA : cA + (size_t)(t + 2) * kstep; const char* b2 = last ? nB : cB + (size_t)(t + 2) * kstep;
            const char* a3 = a2 + kstep; const char* b3 = b2 + kstep;
            PG8_LDB(B0, 0, 0); PG8_SCHED; PG8_LDA(At, 0, 0); PG8_STAGEA(PG8_SA(1, 1), a1, 1, false);
            PG8_WAIT_L(8); PG8_BAR; PG8_WAIT_L(0); PG8_MMA(0, 0, At, B0); PG8_BAR; PG8_SCHED;
            PG8_LDB(B1, 0, 1); PG8_STAGE(PG8_SB(0, 0), b2, voffB);
            PG8_BAR; PG8_WAIT_L(0); PG8_MMA(0, 1, At, B1); PG8_BAR;
            PG8_LDA(At, 0, 1); PG8_STAGEA(PG8_SA(0, 0), a2, 0, last);
            PG8_BAR; PG8_WAIT_L(0); PG8_MMA(1, 0, At, B0); PG8_BAR; PG8_SCHED;
            PG8_STAGE(PG8_SB(0, 1), b2 + hstepB, voffB);
            PG8_WAIT_V(6); PG8_BAR; PG8_MMA(1, 1, At, B1); PG8_BAR;
            PG8_LDB(B0, 1, 0); PG8_SCHED; PG8_LDA(At, 1, 0); PG8_STAGEA(PG8_SA(0, 1), a2, 1, last);
            PG8_WAIT_L(8); PG8_BAR; PG8_WAIT_L(0); PG8_MMA(0, 0, At, B0); PG8_BAR; PG8_SCHED;
            PG8_LDB(B1, 1, 1); PG8_STAGE(PG8_SB(1, 0), b3, voffB);
            PG8_BAR; PG8_WAIT_L(0); PG8_MMA(0, 1, At, B1); PG8_BAR;
            PG8_LDA(At, 1, 1); PG8_STAGEA(PG8_SA(1, 0), a3, 0, last);
            PG8_BAR; PG8_WAIT_L(0); PG8_MMA(1, 0, At, B0); PG8_BAR; PG8_SCHED;
            PG8_STAGE(PG8_SB(1, 1), b3 + hstepB, voffB);
            PG8_WAIT_V(6); PG8_BAR; PG8_MMA(1, 1, At, B1); PG8_BAR;
        }
        E(acc, cur, wr, wc, fr, fq);
        if (!has_next) break;
#pragma unroll
        for (int a = 0; a < 2; ++a)
#pragma unroll
            for (int b = 0; b < 2; ++b)
#pragma unroll
                for (int m = 0; m < 4; ++m)
#pragma unroll
                    for (int n = 0; n < 2; ++n) acc[a][b][m][n] = (f32x4){0.f, 0.f, 0.f, 0.f};
        cur = nxt; cA = nA; cB = nB; ++ui;
        if constexpr (Sched::GATHER) {
_Pragma("unroll") for (int h = 0; h < 2; ++h) _Pragma("unroll") for (int i = 0; i < 2; ++i) gA[h][i] = gAn[h][i]; }
    }
    PG8_WAIT_V(0);
    if (wr == 0) PG8_BAR;
    PG8_BAR;
#undef PG8_SA
#undef PG8_SB
#undef PG8_STAGE
#undef PG8_STAGEA
#undef PG8_LDA
#undef PG8_LDB
#undef PG8_MMA
#undef PG8_WAIT_V
#undef PG8_WAIT_L
#undef PG8_BAR
#undef PG8_SCHED
}
}
using pg8::f32x4; using pg8::u32x4; using pg8::Unit;

#define GEMM_LDS (pg8::STAGE_BYTES + 1024)

struct SchedProj : pg8::TileOrder {
  static constexpr bool GATHER = false;
  const char* A; const char* B;
  __device__ bool next(int i, Unit& u) const { u.z = 0; return tile(i, u.pm, u.pn); }
  __device__ const char* a_ptr(const Unit& u) const { return A + (size_t)u.pm * 256 * DM * 2; }
  __device__ const char* b_ptr(const Unit& u) const { return B + (size_t)u.pn * 256 * DM * 2; }
};
struct EpiProj {
  static constexpr bool PERM = true;
  bf16_t* O;
  __device__ __forceinline__ void operator()(const f32x4 (&acc)[2][2][4][2], const Unit& u, int wr, int wc, int fr, int fq) const {
    const int row0 = u.pm * 256 + wr * 64 + fr, col0 = u.pn * 256 + wc * 32 + 8 * fq;
    const bool gate = u.pn >= (C_GA / 256);
#pragma unroll
    for (int ai = 0; ai < 2; ++ai)
#pragma unroll
      for (int m = 0; m < 4; ++m) {
        bf16_t* rowp = O + (size_t)(row0 + ai * 128 + m * 16) * PW + col0;
#pragma unroll
        for (int bj = 0; bj < 2; ++bj) {
          f32x4 v0 = acc[ai][bj][m][0], v1 = acc[ai][bj][m][1];
          if (gate) {
#pragma unroll
            for (int j = 0; j < 4; ++j) { v0[j] = sigmoidf_(v0[j]); v1[j] = sigmoidf_(v1[j]); }
          }
          u32x4 w; w.x = pg8::cvt_pk_bf16(v0[0], v0[1]); w.y = pg8::cvt_pk_bf16(v0[2], v0[3]); w.z = pg8::cvt_pk_bf16(v1[0], v1[1]); w.w = pg8::cvt_pk_bf16(v1[2], v1[3]);
          *(u32x4*)(rowp + bj * 128) = w;
        }
      }
  }
};
__device__ void ph_proj(const Params& p, PG8_LAS unsigned char* lds, int nblk, int bid) {
  SchedProj S; S.init(T_TOK / 256, PW / 256, nblk, bid); S.A = (const char*)p.hbf; S.B = (const char*)p.w_in_t;
  EpiProj E{p.proj};
  pg8::gemm_phase(lds, p.tid, DM, DM, DM, S, E);
}

struct SchedBr : pg8::TileOrder {
  static constexpr bool GATHER = false;
  const char* A; const char* Ba; const char* Bb;
  __device__ bool next(int i, Unit& u) const { u.z = i & 1; return tile(i >> 1, u.pm, u.pn); }
  __device__ const char* a_ptr(const Unit& u) const { return A + (size_t)u.pm * 256 * DM * 2 + u.z * 512 * 2; }
  __device__ const char* b_ptr(const Unit& u) const { return (u.z ? Bb : Ba) + (size_t)u.pn * 256 * 512 * 2; }
};
__device__ __forceinline__ void unpack8(const u32x4 w, float (&f)[8]) {
  f[0] = __uint_as_float(w.x << 16); f[1] = __uint_as_float(w.x & 0xffff0000u); f[2] = __uint_as_float(w.y << 16); f[3] = __uint_as_float(w.y & 0xffff0000u);
  f[4] = __uint_as_float(w.z << 16); f[5] = __uint_as_float(w.z & 0xffff0000u); f[6] = __uint_as_float(w.w << 16); f[7] = __uint_as_float(w.w & 0xffff0000u);
}
struct EpiBr {
  static constexpr bool PERM = true;
  const bf16_t* proj; bf16_t* O;
  __device__ __forceinline__ void operator()(const f32x4 (&acc)[2][2][4][2], const Unit& u, int wr, int wc, int fr, int fq) const {
    const int row0 = u.pm * 256 + wr * 64 + fr, col0 = u.pn * 256 + wc * 32 + 8 * fq;
    const int gcol = (u.z ? C_GB : C_GA) + col0;
#pragma unroll
    for (int ai = 0; ai < 2; ++ai)
#pragma unroll
      for (int m = 0; m < 4; ++m) {
        const size_t row = (size_t)(row0 + ai * 128 + m * 16);
        bf16_t* rowp = O + row * DM + col0;
        const bf16_t* gp = proj + row * PW + gcol;
#pragma unroll
        for (int bj = 0; bj < 2; ++bj) {
          float g[8]; unpack8(*(const u32x4*)(gp + bj * 128), g);
          f32x4 v0 = acc[ai][bj][m][0], v1 = acc[ai][bj][m][1];
          float r[8];
#pragma unroll
          for (int j = 0; j < 4; ++j) { r[j] = v0[j] * g[j]; r[4 + j] = v1[j] * g[4 + j]; }
          if (u.z) {
            float pv[8]; unpack8(*(const u32x4*)(rowp + bj * 128), pv);
#pragma unroll
            for (int j = 0; j < 8; ++j) r[j] += pv[j];
          }
          u32x4 w; w.x = pg8::cvt_pk_bf16(r[0], r[1]); w.y = pg8::cvt_pk_bf16(r[2], r[3]); w.z = pg8::cvt_pk_bf16(r[4], r[5]); w.w = pg8::cvt_pk_bf16(r[6], r[7]);
          *(u32x4*)(rowp + bj * 128) = w;
        }
      }
  }
};
__device__ void ph_br(const Params& p, PG8_LAS unsigned char* lds, int nblk, int bid) {
  SchedBr S; S.init(T_TOK / 256, DM / 256, nblk, bid); S.A = (const char*)p.oab; S.Ba = (const char*)p.wbra_t; S.Bb = (const char*)p.wbrb_t;
  EpiBr E{p.proj, p.merged};
  pg8::gemm_phase(lds, p.tid, DM, 512, 512, S, E);
}

struct SchedMix : pg8::TileOrder {
  static constexpr bool GATHER = false;
  const char* A; const char* B;
  __device__ bool next(int i, Unit& u) const { u.z = 0; return tile(i, u.pm, u.pn); }
  __device__ const char* a_ptr(const Unit& u) const { return A + (size_t)u.pm * 256 * DM * 2; }
  __device__ const char* b_ptr(const Unit& u) const { return B + (size_t)u.pn * 256 * DM * 2; }
};
struct EpiMix {
  static constexpr bool PERM = true;
  bf16_t* O;
  __device__ __forceinline__ void operator()(const f32x4 (&acc)[2][2][4][2], const Unit& u, int wr, int wc, int fr, int fq) const {
    const int row0 = u.pm * 256 + wr * 64 + fr, col0 = u.pn * 256 + wc * 32 + 8 * fq;
#pragma unroll
    for (int ai = 0; ai < 2; ++ai)
#pragma unroll
      for (int m = 0; m < 4; ++m) {
        bf16_t* rowp = O + (size_t)(row0 + ai * 128 + m * 16) * DM + col0;
#pragma unroll
        for (int bj = 0; bj < 2; ++bj) {
          const f32x4 v0 = acc[ai][bj][m][0], v1 = acc[ai][bj][m][1];
          u32x4 w; w.x = pg8::cvt_pk_bf16(v0[0], v0[1]); w.y = pg8::cvt_pk_bf16(v0[2], v0[3]); w.z = pg8::cvt_pk_bf16(v1[0], v1[1]); w.w = pg8::cvt_pk_bf16(v1[2], v1[3]);
          *(u32x4*)(rowp + bj * 128) = w;
        }
      }
  }
};
__device__ void ph_mix(const Params& p, PG8_LAS unsigned char* lds, int nblk, int bid) {
  SchedMix S; S.init(T_TOK / 256, DM / 256, nblk, bid); S.A = (const char*)p.merged; S.B = (const char*)p.wo_t;
  EpiMix E{p.mixer};
  pg8::gemm_phase(lds, p.tid, DM, DM, DM, S, E);
}

template <bool GATH>
struct SchedMoe {
  static constexpr bool GATHER = GATH;
  const PG8_LAS int* tb; int NT; int G, c; int nwg;
  const char* A; const char* B; size_t bexp;
  const int* elist;
  __device__ bool next(int i, Unit& u) const {
    const long L = (long)i * G + c; if (L >= nwg) return false;
    int wgid = (int)L; { const int q = nwg / 8, r = nwg % 8, xcd = wgid % 8, off = wgid / 8; wgid = (xcd < r ? xcd * (q + 1) : r * (q + 1) + (xcd - r) * q) + off; }
    int e = 0;
#pragma unroll 1
    for (int k = 1; k < NE; ++k) if (wgid >= tb[k]) e = k;
    const int q = wgid - tb[e]; const int tiles = tb[33 + e + 1] - tb[33 + e];
    u.pm = tb[33 + e] + q % tiles; u.pn = q / tiles; u.z = e; return true;
  }
  __device__ const char* a_ptr(const Unit& u) const { return GATH ? A : A + (size_t)u.pm * 256 * DM * 2; }
  __device__ const char* b_ptr(const Unit& u) const { return B + (size_t)u.z * bexp + (size_t)u.pn * 256 * DM * 2; }
  __device__ unsigned a_goff(const Unit& u, int tr, int C) const {
    const int i = (u.pm - tb[33 + u.z]) * 256 + tr;
    int tok = 0;
    if (i < tb[66 + u.z]) tok = elist[u.z * T_TOK + i] >> 2;
    return (unsigned)(tok * DM + C) * 2u;
  }
};
__device__ __forceinline__ void moe_table(const Params& p, PG8_LAS int* tb, int NT) {
  if (p.tid == 0) {
    int ub = 0, tbp = 0;
    for (int e = 0; e < NE; ++e) { const int c = p.cnt[e * 64]; tb[e] = ub; tb[33 + e] = tbp; tb[66 + e] = c; const int t = (c + 255) >> 8; ub += t * NT; tbp += t; }
    tb[NE] = ub; tb[33 + NE] = tbp;
  }
  __syncthreads();
}
struct EpiMoe1 {
  static constexpr bool PERM = true;
  const float* b_gu; bf16_t* act;
  __device__ __forceinline__ void operator()(f32x4 (&acc)[2][2][4][2], const Unit& u, int wr, int wc, int fr, int fq) const {
    const int row0 = u.pm * 256 + wr * 64 + fr, jc = u.pn * 128 + wc * 32 + 8 * fq;
    const float* bg = b_gu + (size_t)u.z * 2048 + jc;
#pragma unroll
    for (int bj = 0; bj < 2; ++bj)
#pragma unroll
      for (int n = 0; n < 2; ++n) {
        const f32x4 bv = *(const f32x4*)(bg + bj * 1024 + n * 4);
#pragma unroll
        for (int ai = 0; ai < 2; ++ai)
#pragma unroll
          for (int m = 0; m < 4; ++m) acc[ai][bj][m][n] += bv;
      }
#pragma unroll
    for (int ai = 0; ai < 2; ++ai)
#pragma unroll
      for (int m = 0; m < 4; ++m) {
        bf16_t* rowp = act + (size_t)(row0 + ai * 128 + m * 16) * DM + jc;
        float r[8];
#pragma unroll
        for (int n = 0; n < 2; ++n)
#pragma unroll
          for (int j = 0; j < 4; ++j) {
            float g = acc[ai][0][m][n][j], up = acc[ai][1][m][n][j];
            g = fminf(g, 7.f); up = fminf(fmaxf(up, -7.f), 7.f);
            r[n * 4 + j] = (up + 1.f) * g * sigmoidf_(1.702f * g);
          }
        u32x4 w; w.x = pk2(r[0], r[1]); w.y = pk2(r[2], r[3]); w.z = pk2(r[4], r[5]); w.w = pk2(r[6], r[7]);
        *(u32x4*)rowp = w;
      }
  }
};
__device__ void ph_moe1(const Params& p, PG8_LAS unsigned char* lds, int nblk, int bid) {
  PG8_LAS int* tb = (PG8_LAS int*)(lds + pg8::STAGE_BYTES);
  moe_table(p, tb, 8);
  SchedMoe<true> S; S.tb = tb; S.NT = 8; S.G = nblk; S.c = bid; S.nwg = tb[NE]; S.A = (const char*)p.h2; S.B = (const char*)p.wgu_t; S.bexp = (size_t)2048 * DM * 2; S.elist = p.elist;
  EpiMoe1 E{p.b_gu, p.act};
  pg8::gemm_phase(lds, p.tid, DM, DM, DM, S, E);
}
struct EpiMoe2 {
  static constexpr bool PERM = true;
  const float* b_down; const int* elist; const PG8_LAS int* tb; bf16_t* yslot;
  __device__ __forceinline__ void operator()(f32x4 (&acc)[2][2][4][2], const Unit& u, int wr, int wc, int fr, int fq) const {
    const int row0 = u.pm * 256 + wr * 64 + fr, col0 = u.pn * 256 + wc * 32 + 8 * fq;
    const float* bd = b_down + (size_t)u.z * 1024 + col0;
#pragma unroll
    for (int bj = 0; bj < 2; ++bj)
#pragma unroll
      for (int n = 0; n < 2; ++n) {
        const f32x4 bv = *(const f32x4*)(bd + bj * 128 + n * 4);
#pragma unroll
        for (int ai = 0; ai < 2; ++ai)
#pragma unroll
          for (int m = 0; m < 4; ++m) acc[ai][bj][m][n] += bv;
      }
#pragma unroll
    for (int ai = 0; ai < 2; ++ai)
#pragma unroll
      for (int m = 0; m < 4; ++m) {
        const int li = (u.pm - tb[33 + u.z]) * 256 + wr * 64 + fr + ai * 128 + m * 16;
        if (li < tb[66 + u.z]) {
          const int a = elist[u.z * T_TOK + li];
          bf16_t* rowp = yslot + (size_t)a * DM + col0;
#pragma unroll
          for (int bj = 0; bj < 2; ++bj) {
            const f32x4 v0 = acc[ai][bj][m][0], v1 = acc[ai][bj][m][1];
            u32x4 w; w.x = pk2(v0[0], v0[1]); w.y = pk2(v0[2], v0[3]); w.z = pk2(v1[0], v1[1]); w.w = pk2(v1[2], v1[3]);
            *(u32x4*)(rowp + bj * 128) = w;
          }
        }
      }
  }
};
__device__ void ph_moe2(const Params& p, PG8_LAS unsigned char* lds, int nblk, int bid) {
  PG8_LAS int* tb = (PG8_LAS int*)(lds + pg8::STAGE_BYTES);
  moe_table(p, tb, 4);
  SchedMoe<false> S; S.tb = tb; S.NT = 4; S.G = nblk; S.c = bid; S.nwg = tb[NE]; S.A = (const char*)p.act; S.B = (const char*)p.wd_t; S.bexp = (size_t)1024 * DM * 2; S.elist = p.elist;
  EpiMoe2 E{p.b_down, p.elist, tb, p.yslot};
  pg8::gemm_phase(lds, p.tid, DM, DM, DM, S, E);
}

typedef short bf16x8 __attribute__((ext_vector_type(8)));
typedef unsigned u32x2 __attribute__((ext_vector_type(2)));
#define LAS __attribute__((address_space(3)))
#define MFMA16(a, b, c) __builtin_amdgcn_mfma_f32_16x16x32_bf16((a), (b), (c), 0, 0, 0)
__device__ __forceinline__ bf16x8 pack8(float a0, float a1, float a2, float a3, float a4, float a5, float a6, float a7) {
  u32x4 w; w.x = pk2(a0, a1); w.y = pk2(a2, a3); w.z = pk2(a4, a5); w.w = pk2(a6, a7);
  return __builtin_bit_cast(bf16x8, w);
}
__device__ __forceinline__ bf16_t f2bf_hw(float a) { return (bf16_t)(pk2(a, 0.f) & 0xffffu); }

#define DN_ABYTES 57344
#define DN_UFLOATS 8192
#define F_WN 0
#define F_QD 16
#define F_QK 32
#define F_KT 40

#define DP_KH 0
#define DP_QT 17408
#define DP_KHT 34816
#define DP_VT 53248
#define DP_TU 71680
#define DP_TW 80896
#define DP_LF 90112
#define DP_GC 107520
#define DP_BETA 107776
#define DP_CW 108032
#define DP_TOTAL 114176

template <int KS>
__device__ __forceinline__ f32x4 prod16(const LAS bf16_t* A, int lda, int arow0, const LAS bf16_t* Bt, int ldb, int brow0, f32x4 acc, int lane) {
  const int r = lane & 15, q = lane >> 4;
#pragma unroll
  for (int ks = 0; ks < KS; ++ks) {
    const bf16x8 a = *(const LAS bf16x8*)(A + (arow0 + r) * lda + 32 * ks + 8 * q);
    const bf16x8 b = *(const LAS bf16x8*)(Bt + (brow0 + r) * ldb + 32 * ks + 8 * q);
    acc = MFMA16(a, b, acc);
  }
  return acc;
}
__device__ __forceinline__ void tile_store_rm(LAS bf16_t* X, int ld, int row0, int col0, const f32x4 v, int lane) {
  const int r = lane & 15, q = lane >> 4;
#pragma unroll
  for (int i = 0; i < 4; ++i) X[(row0 + 4 * q + i) * ld + col0 + r] = f2bf_hw(v[i]);
}
__device__ __forceinline__ void tile_store_tr(LAS bf16_t* Xt, int ld, int row0, int col0, const f32x4 v, int lane) {
  const int r = lane & 15, q = lane >> 4;
  u32x2 w; w.x = pk2(v[0], v[1]); w.y = pk2(v[2], v[3]);
  *(LAS u32x2*)(Xt + (col0 + r) * ld + row0 + 4 * q) = w;
}

__device__ void dn_prep_chunk(const Params& p, LAS unsigned char* lds, int ci, bool load_cw) {
  const int tid = p.tid, lane = tid & 63, w = tid >> 6, r16 = lane & 15, q4 = lane >> 4;
  const int bh = ci >> 6, n = ci & 63, b = bh >> 2, h = bh & 3;
  LAS bf16_t* Kh = (LAS bf16_t*)(lds + DP_KH); LAS bf16_t* Qt = (LAS bf16_t*)(lds + DP_QT);
  LAS bf16_t* KhT = (LAS bf16_t*)(lds + DP_KHT); LAS bf16_t* VT = (LAS bf16_t*)(lds + DP_VT);
  LAS bf16_t* Tu = (LAS bf16_t*)(lds + DP_TU); LAS bf16_t* Tw = (LAS bf16_t*)(lds + DP_TW); LAS float* Lf = (LAS float*)(lds + DP_LF);
  LAS float* gcb = (LAS float*)(lds + DP_GC); LAS float* betab = (LAS float*)(lds + DP_BETA); LAS float* cw = (LAS float*)(lds + DP_CW);
  unsigned char* gA = (unsigned char*)p.dnA + (size_t)ci * DN_ABYTES;
  float* gU = p.dnU + (size_t)ci * DN_UFLOATS;

  if (load_cw) {
    for (int i = tid; i < 4 * 384; i += 512) { const int tap = i / 384, cc = i % 384, part = cc >> 7, d = cc & 127; cw[i] = p.conv_w[tap * 1536 + part * 512 + h * 128 + d]; }
  }
  __syncthreads();
  const int c = tid >> 3, g = tid & 7;
  const int s = n * 64 + c;
  const size_t t = (size_t)b * SEQ + s;
  float qv[16], kv[16], vv[16];
#pragma unroll
  for (int j = 0; j < 16; ++j) { qv[j] = 0.f; kv[j] = 0.f; vv[j] = 0.f; }
#pragma unroll
  for (int tap = 0; tap < 4; ++tap) {
    const int ss = s - 3 + tap;
    if (ss >= 0) {
      const bf16_t* row = p.proj + (t - 3 + tap) * PW + h * 128 + 16 * g;
      float x[8];
#pragma unroll
      for (int part = 0; part < 3; ++part) {
#pragma unroll
        for (int hh = 0; hh < 2; ++hh) {
          unpack8(*(const u32x4*)(row + part * 512 + 8 * hh), x);
#pragma unroll
          for (int j = 0; j < 8; ++j) {
            const float wv = cw[tap * 384 + part * 128 + 16 * g + 8 * hh + j];
            if (part == 0) qv[8 * hh + j] += wv * x[j];
            if (part == 1) kv[8 * hh + j] += wv * x[j];
            if (part == 2) vv[8 * hh + j] += wv * x[j];
          }
        }
      }
    }
    asm volatile("" ::: "memory");
  }
  float sq = 0.f, sk = 0.f;
#pragma unroll
  for (int j = 0; j < 16; ++j) { qv[j] = siluf_(qv[j]); kv[j] = siluf_(kv[j]); vv[j] = siluf_(vv[j]); sq += qv[j] * qv[j]; sk += kv[j] * kv[j]; }
  sq += __shfl_xor(sq, 1, 64); sq += __shfl_xor(sq, 2, 64); sq += __shfl_xor(sq, 4, 64);
  sk += __shfl_xor(sk, 1, 64); sk += __shfl_xor(sk, 2, 64); sk += __shfl_xor(sk, 4, 64);
  const float rq = rsqrtf(sq + 1e-6f) * 0.08838834764831845f, rk = rsqrtf(sk + 1e-6f);
#pragma unroll
  for (int j = 0; j < 16; ++j) { qv[j] *= rq; kv[j] *= rk; }
  if (g == 0) {
    const float bb = p.ba[t * 8 + h], aa = p.ba[t * 8 + 4 + h];
    const float xx = aa + p.dt_bias[h];
    const float sp = xx > 20.f ? xx : log1pf(__expf(xx));
    betab[c] = sigmoidf_(bb);
    gcb[c] = -__expf(p.a_log[h]) * sp;
  }
  {
    u32x4 w0, w1;
    w0.x = pk2(kv[0], kv[1]); w0.y = pk2(kv[2], kv[3]); w0.z = pk2(kv[4], kv[5]); w0.w = pk2(kv[6], kv[7]);
    w1.x = pk2(kv[8], kv[9]); w1.y = pk2(kv[10], kv[11]); w1.z = pk2(kv[12], kv[13]); w1.w = pk2(kv[14], kv[15]);
    *(LAS u32x4*)(Kh + c * 136 + 16 * g) = w0; *(LAS u32x4*)(Kh + c * 136 + 16 * g + 8) = w1;
    w0.x = pk2(qv[0], qv[1]); w0.y = pk2(qv[2], qv[3]); w0.z = pk2(qv[4], qv[5]); w0.w = pk2(qv[6], qv[7]);
    w1.x = pk2(qv[8], qv[9]); w1.y = pk2(qv[10], qv[11]); w1.z = pk2(qv[12], qv[13]); w1.w = pk2(qv[14], qv[15]);
    *(LAS u32x4*)(Qt + c * 136 + 16 * g) = w0; *(LAS u32x4*)(Qt + c * 136 + 16 * g + 8) = w1;
#pragma unroll
    for (int j = 0; j < 16; ++j) { KhT[(16 * g + j) * 72 + c] = f2bf_hw(kv[j]); VT[(16 * g + j) * 72 + c] = f2bf_hw(vv[j]); }
  }
  __syncthreads();
  if (w == 0) {
    float v = gcb[lane];
#pragma unroll
    for (int o = 1; o < 64; o <<= 1) { const float u = __shfl_up(v, o, 64); if (lane >= o) v += u; }
    gcb[lane] = v;
  }
  __syncthreads();
  const float gc_c = gcb[c], gl = gcb[63];
  {
    const float eg = __expf(gc_c);
    unsigned char* fb = gA + (size_t)(F_QD + (c >> 4) * 4 + (g >> 1)) * 1024 + (g & 1) * 8;
#pragma unroll
    for (int qq = 0; qq < 4; ++qq) {
      u32x2 wv; wv.x = pk2(qv[4 * qq] * eg, qv[4 * qq + 1] * eg); wv.y = pk2(qv[4 * qq + 2] * eg, qv[4 * qq + 3] * eg);
      *(u32x2*)(fb + ((c & 15) + 16 * qq) * 16) = wv;
    }
  }
  const int rt = w >> 1, ct0 = 2 * (w & 1);
#pragma unroll
  for (int tt = 0; tt < 2; ++tt) {
    const int ct = ct0 + tt;
    f32x4 gacc = {0.f, 0.f, 0.f, 0.f};
    gacc = prod16<4>(Kh, 136, 16 * rt, Kh, 136, 16 * ct, gacc, lane);
    const int m = 16 * ct + r16; const float gc_m = gcb[m];
#pragma unroll
    for (int i = 0; i < 4; ++i) {
      const int cc = 16 * rt + 4 * q4 + i;
      Lf[cc * 68 + m] = (m < cc) ? betab[cc] * gacc[i] * __expf(gcb[cc] - gc_m) : 0.f;
    }
    f32x4 qacc = {0.f, 0.f, 0.f, 0.f};
    qacc = prod16<4>(Kh, 136, 16 * rt, Qt, 136, 16 * ct, qacc, lane);
    const int cq = 16 * ct + r16; const float gc_cq = gcb[cq];
    float o4[4];
#pragma unroll
    for (int i = 0; i < 4; ++i) { const int mm = 16 * rt + 4 * q4 + i; o4[i] = (mm <= cq) ? qacc[i] * __expf(gc_cq - gcb[mm]) : 0.f; }
    u32x2 wv; wv.x = pk2(o4[0], o4[1]); wv.y = pk2(o4[2], o4[3]);
    *(u32x2*)(gA + (size_t)(F_QK + ct * 2 + (rt >> 1)) * 1024 + (r16 + 16 * q4) * 16 + (rt & 1) * 8) = wv;
  }
  __syncthreads();
  if (w == 0) {
    float T[64];
    int lo = lane; asm volatile("" : "+v"(lo));
    unsigned lfb = DP_LF; asm volatile("" : "+v"(lfb));
    const LAS float* Lfo = (const LAS float*)(lds + lfb);
    const float bm = betab[lo], bem = bm * __expf(gcb[lo]);
#pragma unroll
    for (int i = 0; i < 64; ++i) {
      float a0 = (i == lo) ? 1.f : 0.f, a1 = 0.f, a2 = 0.f, a3 = 0.f;
#pragma unroll
      for (int k4 = 0; k4 < (i + 3) / 4; ++k4) {
        const f32x4 l = *(const LAS f32x4*)(Lfo + i * 68 + 4 * k4);
        if (4 * k4 + 0 < i) a0 -= l[0] * T[4 * k4 + 0];
        if (4 * k4 + 1 < i) a1 -= l[1] * T[4 * k4 + 1];
        if (4 * k4 + 2 < i) a2 -= l[2] * T[4 * k4 + 2];
        if (4 * k4 + 3 < i) a3 -= l[3] * T[4 * k4 + 3];
      }
      T[i] = (a0 + a1) + (a2 + a3);
      Tu[i * 72 + lo] = f2bf_hw(T[i] * bm);
      Tw[i * 72 + lo] = f2bf_hw(T[i] * bem);
      asm volatile("" ::: "memory");
    }
  }
  __syncthreads();
#pragma unroll
  for (int rr = 0; rr < 4; ++rr) {
    f32x4 u = {0.f, 0.f, 0.f, 0.f};
    u = prod16<2>(Tu, 72, 16 * rr, VT, 72, 16 * w, u, lane);
    *(f32x4*)(gU + ((w * 4 + rr) * 64 + lane) * 4) = u;
    f32x4 wt = {0.f, 0.f, 0.f, 0.f};
    wt = prod16<2>(KhT, 72, 16 * w, Tw, 72, 16 * rr, wt, lane);
    u32x2 wv; wv.x = pk2(-wt[0], -wt[1]); wv.y = pk2(-wt[2], -wt[3]);
    *(u32x2*)(gA + (size_t)(F_WN + rr * 4 + (w >> 1)) * 1024 + (r16 + 16 * q4) * 16 + (w & 1) * 8) = wv;
  }
#pragma unroll
  for (int it = 0; it < 4; ++it) {
    const int idx = tid + it * 512; const int d = idx >> 4, m4 = idx & 15;
    const u32x2 raw = *(const LAS u32x2*)(KhT + d * 72 + 4 * m4);
    const float k0 = __uint_as_float(raw.x << 16), k1 = __uint_as_float(raw.x & 0xffff0000u), k2 = __uint_as_float(raw.y << 16), k3 = __uint_as_float(raw.y & 0xffff0000u);
    const float e0 = __expf(gl - gcb[4 * m4]), e1 = __expf(gl - gcb[4 * m4 + 1]), e2 = __expf(gl - gcb[4 * m4 + 2]), e3 = __expf(gl - gcb[4 * m4 + 3]);
    u32x2 wv; wv.x = pk2(k0 * e0, k1 * e1); wv.y = pk2(k2 * e2, k3 * e3);
    *(u32x2*)(gA + (size_t)(F_KT + (d >> 4) * 2 + (m4 >> 3)) * 1024 + ((d & 15) + 16 * (m4 & 3)) * 16 + ((m4 >> 2) & 1) * 8) = wv;
  }
  if (tid == 0) p.dnG[ci] = __expf(gl);
}

#define DS_A0 0
#define DS_A1 57344
#define DS_TOTAL 114688
__device__ void dn_scan_blk(const Params& p, LAS unsigned char* lds, int item) {
  const int tid = p.tid, lane = tid & 63, w = __builtin_amdgcn_readfirstlane(tid >> 6), r16 = lane & 15, q4 = lane >> 4;
  const int bh = item >> 1, eh = item & 1, b = bh >> 2, h = bh & 3;
  const int et = eh * 4 + (w & 3);
  const bool comp = w < 4;
  const unsigned char* gA = (const unsigned char*)p.dnA + (size_t)bh * 64 * DN_ABYTES;
  const float* gU = p.dnU + (size_t)bh * 64 * DN_UFLOATS;
  const float* gG = p.dnG + bh * 64;
  auto issue_A = [&](int n, int buf) {
#pragma unroll
    for (int i = 0; i < 7; ++i) {
      const int f = w * 7 + i;
      __builtin_amdgcn_global_load_lds((const unsigned*)(gA + (size_t)n * DN_ABYTES + f * 1024 + lane * 16), (LAS unsigned*)(lds + (buf ? DS_A1 : DS_A0) + f * 1024), 16, 0, 0);
    }
  };
  __syncthreads();
  issue_A(0, 0);
  f32x4 Un[4];
#pragma unroll
  for (int rr = 0; rr < 4; ++rr) Un[rr] = *(const f32x4*)(gU + ((et * 4 + rr) * 64 + lane) * 4);
  f32x4 S[8];
#pragma unroll
  for (int dt = 0; dt < 8; ++dt) S[dt] = (f32x4){0.f, 0.f, 0.f, 0.f};
  asm volatile("s_waitcnt vmcnt(0)" ::: "memory");
  __syncthreads();
  bf16_t* obase = p.dn_out + ((size_t)b * SEQ) * p.dn_out_ld + h * 128 + 16 * et + r16;
  f32x4 Op[4];
#pragma unroll
  for (int rr = 0; rr < 4; ++rr) Op[rr] = (f32x4){0.f, 0.f, 0.f, 0.f};
#pragma unroll 1
  for (int n = 0; n < 64; ++n) {
    const LAS unsigned char* Ab = lds + ((n & 1) ? DS_A1 : DS_A0);
    if (n + 1 < 64) issue_A(n + 1, (n + 1) & 1);
    if (comp) {
      if (n > 0) {
#pragma unroll
        for (int rr = 0; rr < 4; ++rr)
#pragma unroll
          for (int i = 0; i < 4; ++i) obase[(size_t)((n - 1) * 64 + 16 * rr + 4 * q4 + i) * p.dn_out_ld] = f2bf_hw(Op[rr][i]);
      }
      f32x4 Vn[4];
#pragma unroll
      for (int rr = 0; rr < 4; ++rr) Vn[rr] = Un[rr];
      if (n + 1 < 64) {
#pragma unroll
        for (int rr = 0; rr < 4; ++rr) Un[rr] = *(const f32x4*)(gU + (size_t)(n + 1) * DN_UFLOATS + ((et * 4 + rr) * 64 + lane) * 4);
      }
      const float gdec = gG[n];
      bf16x8 Sb[4];
#pragma unroll
      for (int ks = 0; ks < 4; ++ks) Sb[ks] = pack8(S[2 * ks][0], S[2 * ks][1], S[2 * ks][2], S[2 * ks][3], S[2 * ks + 1][0], S[2 * ks + 1][1], S[2 * ks + 1][2], S[2 * ks + 1][3]);
      f32x4 O[4];
#pragma unroll
      for (int rr = 0; rr < 4; ++rr) {
        O[rr] = (f32x4){0.f, 0.f, 0.f, 0.f};
#pragma unroll
        for (int ks = 0; ks < 4; ++ks) {
          const bf16x8 aw = *(const LAS bf16x8*)(Ab + (F_WN + rr * 4 + ks) * 1024 + lane * 16);
          Vn[rr] = MFMA16(aw, Sb[ks], Vn[rr]);
          const bf16x8 aq = *(const LAS bf16x8*)(Ab + (F_QD + rr * 4 + ks) * 1024 + lane * 16);
          O[rr] = MFMA16(aq, Sb[ks], O[rr]);
        }
      }
      bf16x8 Vb[2];
#pragma unroll
      for (int ks = 0; ks < 2; ++ks) Vb[ks] = pack8(Vn[2 * ks][0], Vn[2 * ks][1], Vn[2 * ks][2], Vn[2 * ks][3], Vn[2 * ks + 1][0], Vn[2 * ks + 1][1], Vn[2 * ks + 1][2], Vn[2 * ks + 1][3]);
#pragma unroll
      for (int rr = 0; rr < 4; ++rr)
#pragma unroll
        for (int ks = 0; ks < 2; ++ks) {
          const bf16x8 a = *(const LAS bf16x8*)(Ab + (F_QK + rr * 2 + ks) * 1024 + lane * 16);
          O[rr] = MFMA16(a, Vb[ks], O[rr]);
        }
#pragma unroll
      for (int rr = 0; rr < 4; ++rr) Op[rr] = O[rr];
#pragma unroll
      for (int dt = 0; dt < 8; ++dt) {
        S[dt] *= gdec;
#pragma unroll
        for (int ks = 0; ks < 2; ++ks) {
          const bf16x8 a = *(const LAS bf16x8*)(Ab + (F_KT + dt * 2 + ks) * 1024 + lane * 16);
          S[dt] = MFMA16(a, Vb[ks], S[dt]);
        }
      }
    }
    asm volatile("s_waitcnt vmcnt(0)" ::: "memory");
    __syncthreads();
  }
  if (comp) {
#pragma unroll
    for (int rr = 0; rr < 4; ++rr)
#pragma unroll
      for (int i = 0; i < 4; ++i) obase[(size_t)(63 * 64 + 16 * rr + 4 * q4 + i) * p.dn_out_ld] = f2bf_hw(Op[rr][i]);
  }
}
__device__ void ph_dn_norm(const Params& p, int nblk, int bid) {
  const int wid = p.tid >> 6, lane = p.tid & 63;
  const f32x4 g0 = *(const f32x4*)(p.g_dn_out + (lane & 15) * 8), g1 = *(const f32x4*)(p.g_dn_out + (lane & 15) * 8 + 4);
  for (int t = bid * 8 + wid; t < T_TOK; t += nblk * 8) {
    bf16_t* op = p.oab + (size_t)t * DM + lane * 8;
    float o[8], z[8];
    unpack8(*(const u32x4*)op, o);
    unpack8(*(const u32x4*)(p.proj + (size_t)t * PW + C_Z + lane * 8), z);
    float ss = 0.f;
#pragma unroll
    for (int j = 0; j < 8; ++j) ss += o[j] * o[j];
    ss += __shfl_xor(ss, 1, 64); ss += __shfl_xor(ss, 2, 64); ss += __shfl_xor(ss, 4, 64); ss += __shfl_xor(ss, 8, 64);
    const float rstd = rsqrtf(ss * (1.f / 128.f) + 1e-6f);
    float y[8];
#pragma unroll
    for (int j = 0; j < 4; ++j) { y[j] = o[j] * rstd * g0[j] * siluf_(z[j]); y[4 + j] = o[4 + j] * rstd * g1[j] * siluf_(z[4 + j]); }
    u32x4 w; w.x = pk2(y[0], y[1]); w.y = pk2(y[2], y[3]); w.z = pk2(y[4], y[5]); w.w = pk2(y[6], y[7]);
    *(u32x4*)op = w;
  }
}
typedef float f32x16 __attribute__((ext_vector_type(16)));
#define MFMA32(a, b, c) __builtin_amdgcn_mfma_f32_32x32x16_bf16((a), (b), (c), 0, 0, 0)
#define MP_VL 0
#define MP_RED 65536
#define MP_TOTAL (65536 + 4096)

__device__ void moba_prep_block(const Params& p, LAS unsigned char* lds, int item) {
  const int tid = p.tid, lane = tid & 63, w = tid >> 6;
  const int bh = item >> 4, jb = item & 15, b = bh >> 2, h = bh & 3;
  LAS bf16_t* Vl = (LAS bf16_t*)(lds + MP_VL);
  LAS float* red = (LAS float*)(lds + MP_RED);
  __syncthreads();
#pragma unroll
  for (int it = 0; it < 8; ++it) {
    const int idx = tid + 512 * it, row = idx >> 4, ch = idx & 15;
    const u32x4 v = *(const u32x4*)(p.proj + ((size_t)b * SEQ + 256 * jb + row) * PW + C_MV + h * 128 + 8 * ch);
    *(LAS u32x4*)(Vl + row * 128 + 8 * ch) = v;
  }
  {
    const int r = tid >> 1, hh = tid & 1;
    const int pos = 256 * jb + r;
    const size_t t = (size_t)b * SEQ + pos;
    float cs[8], sn[8];
#pragma unroll
    for (int jj = 0; jj < 8; ++jj) {
      const float inv = exp2f(-(float)(8 * hh + jj) * (1.f / 16.f) * 18.931568569324174f);
      const float ang = (float)pos * inv;
      cs[jj] = cosf(ang); sn[jj] = sinf(ang);
    }
    float kacc[64];
#pragma unroll
    for (int which = 0; which < 2; ++which) {
      const bf16_t* src = p.proj + t * PW + (which ? C_MQ : C_MK) + h * 128 + 8 * hh;
      float x0[8], x1[8];
      unpack8(*(const u32x4*)(src), x0); unpack8(*(const u32x4*)(src + 16), x1);
      float y0[8], y1[8];
#pragma unroll
      for (int jj = 0; jj < 8; ++jj) { y0[jj] = x0[jj] * cs[jj] - x1[jj] * sn[jj]; y1[jj] = x1[jj] * cs[jj] + x0[jj] * sn[jj]; }
      u32x4 o[8];
      o[0].x = pk2(y0[0], y0[1]); o[0].y = pk2(y0[2], y0[3]); o[0].z = pk2(y0[4], y0[5]); o[0].w = pk2(y0[6], y0[7]);
      o[1].x = pk2(y1[0], y1[1]); o[1].y = pk2(y1[2], y1[3]); o[1].z = pk2(y1[4], y1[5]); o[1].w = pk2(y1[6], y1[7]);
#pragma unroll
      for (int ks = 2; ks < 8; ++ks) o[ks] = *(const u32x4*)(src + 16 * ks);
      if (which == 0) {
#pragma unroll
        for (int jj = 0; jj < 8; ++jj) { kacc[jj] = y0[jj]; kacc[8 + jj] = y1[jj]; }
#pragma unroll
        for (int ks = 2; ks < 8; ++ks) { float f[8]; unpack8(o[ks], f);
#pragma unroll
          for (int jj = 0; jj < 8; ++jj) kacc[8 * ks + jj] = f[jj]; }
        unsigned char* dst = (unsigned char*)p.Kp + ((size_t)(bh * 128 + 8 * jb + (r >> 5)) * 8192) + ((r & 31) + 32 * hh) * 16;
#pragma unroll
        for (int ks = 0; ks < 8; ++ks) *(u32x4*)(dst + ks * 1024) = o[ks];
      } else {
        bf16_t* dst = p.qb + ((size_t)bh * SEQ + pos) * 128 + 8 * hh;
#pragma unroll
        for (int ks = 0; ks < 8; ++ks) *(u32x4*)(dst + 16 * ks) = o[ks];
      }
    }
#pragma unroll
    for (int e = 0; e < 64; ++e) {
      float v = kacc[e];
      v += __shfl_xor(v, 2, 64); v += __shfl_xor(v, 4, 64); v += __shfl_xor(v, 8, 64); v += __shfl_xor(v, 16, 64); v += __shfl_xor(v, 32, 64);
      kacc[e] = v;
    }
    if (lane < 2) {
#pragma unroll
      for (int e = 0; e < 64; ++e) red[(w * 2 + lane) * 64 + e] = kacc[e];
    }
  }
  __syncthreads();
  if (tid < 128) {
    const int d = tid, hh = (d >> 3) & 1, ks = d >> 4, jj = d & 7;
    float a = 0.f;
#pragma unroll
    for (int ww = 0; ww < 8; ++ww) a += red[(ww * 2 + hh) * 64 + ks * 8 + jj];
    p.kmean[((size_t)bh * 16 + jb) * 128 + d] = a * (1.f / 256.f);
  }
#pragma unroll
  for (int it = 0; it < 8; ++it) {
    const int o = tid + 512 * it, ln = o & 63, frag = o >> 6, tl = frag >> 3, dt = (frag >> 1) & 3, s = frag & 1;
    const int r = ln & 31, hh = ln >> 5, d = 32 * dt + r;
    unsigned short e[8];
#pragma unroll
    for (int jj = 0; jj < 8; ++jj) { const int key = 32 * tl + 16 * s + 8 * (jj >> 2) + 4 * hh + (jj & 3); e[jj] = Vl[key * 128 + d]; }
    u32x4 wv; wv.x = e[0] | ((unsigned)e[1] << 16); wv.y = e[2] | ((unsigned)e[3] << 16); wv.z = e[4] | ((unsigned)e[5] << 16); wv.w = e[6] | ((unsigned)e[7] << 16);
    *(u32x4*)((unsigned char*)p.Vp + ((size_t)(bh * 128 + 8 * jb + tl) * 8192) + (dt * 2 + s) * 1024 + ln * 16) = wv;
  }
}
__device__ __forceinline__ int crow32(int reg, int hh) { return (reg & 3) + 8 * (reg >> 2) + 4 * hh; }
__device__ void moba_item(const Params& p, LAS float* km, LAS float* mrg, LAS float* ml, int bh, int ib, int sub, int par, int lane) {
  const int q = lane & 31, hh = lane >> 5;
  const int b = bh >> 2, h = bh & 3;
  const int s0 = 256 * ib + 32 * sub;
  const bf16_t* qrow = p.qb + ((size_t)bh * SEQ + s0 + q) * 128 + 8 * hh;
  bf16x8 Qf[8];
#pragma unroll
  for (int ks = 0; ks < 8; ++ks) Qf[ks] = *(const bf16x8*)(qrow + 16 * ks);
  LAS unsigned char* qlds = (LAS unsigned char*)km + 8192 + lane * 16;
#pragma unroll
  for (int ks = 0; ks < 8; ++ks) *(LAS bf16x8*)(qlds + ks * 1024) = Qf[ks];
  unsigned selmask = 0;
  if (ib > 0) {
    for (int idx = lane; idx < ib * 32; idx += 64) ((LAS f32x4*)km)[idx] = ((const f32x4*)(p.kmean + (size_t)bh * 16 * 128))[idx];
    float qf[64];
#pragma unroll
    for (int ks = 0; ks < 8; ++ks) { float f[8]; unpack8(__builtin_bit_cast(u32x4, Qf[ks]), f);
#pragma unroll
      for (int jj = 0; jj < 8; ++jj) qf[8 * ks + jj] = f[jj]; }
    float sc[16];
#pragma unroll
    for (int j = 0; j < 16; ++j) {
      sc[j] = -INFINITY;
      if (j < ib) {
        float a = 0.f;
#pragma unroll
        for (int ks = 0; ks < 8; ++ks) {
          const f32x4 k0 = *(const LAS f32x4*)(km + j * 128 + 16 * ks + 8 * hh), k1 = *(const LAS f32x4*)(km + j * 128 + 16 * ks + 8 * hh + 4);
          a += qf[8 * ks] * k0[0] + qf[8 * ks + 1] * k0[1] + qf[8 * ks + 2] * k0[2] + qf[8 * ks + 3] * k0[3];
          a += qf[8 * ks + 4] * k1[0] + qf[8 * ks + 5] * k1[1] + qf[8 * ks + 6] * k1[2] + qf[8 * ks + 7] * k1[3];
        }
        a += __shfl_xor(a, 32, 64);
        sc[j] = a;
      }
    }
#pragma unroll
    for (int r = 0; r < 3; ++r) {
      if (r < ib) {
        float best = -INFINITY; int bi = 0;
#pragma unroll
        for (int j = 0; j < 16; ++j) if (sc[j] > best) { best = sc[j]; bi = j; }
        selmask |= 1u << bi;
#pragma unroll
        for (int j = 0; j < 16; ++j) if (j == bi) sc[j] = -INFINITY;
      }
    }
  }
  unsigned rem = 0;
  for (int j = 0; j < ib; ++j) if (__ballot((selmask >> j) & 1u) != 0ull) rem |= 1u << j;
  rem = __builtin_amdgcn_readfirstlane(rem);
  const int own0 = 8 * ib, diag = 8 * ib + sub;
  const float cscale = 0.08838834764831845f * 1.4426950408889634f;
  float m = -1e30f, l = 0.f;
  f32x16 O[4];
#pragma unroll
  for (int dt = 0; dt < 4; ++dt)
#pragma unroll
    for (int r = 0; r < 16; ++r) O[dt][r] = 0.f;
  const unsigned char* kbase = (const unsigned char*)p.Kp + (size_t)bh * 128 * 8192 + lane * 16;
  const unsigned char* vbase = (const unsigned char*)p.Vp + (size_t)bh * 128 * 8192 + lane * 16;
  auto adv = [&](int& kt_, unsigned& rem_) {
    if (kt_ < 0) return;
    if (kt_ >= own0 ? (kt_ < diag) : ((kt_ & 7) != 7)) { kt_ = kt_ + 1; return; }
    if (rem_ == 0u) { kt_ = -1; return; }
    kt_ = 8 * (__builtin_ctz(rem_)); rem_ &= rem_ - 1u;
  };
  int kt = own0;
  if (par) adv(kt, rem);
  LAS unsigned char* kl = (LAS unsigned char*)km;
  auto issue_K = [&](int t) {
#pragma unroll
    for (int ks = 0; ks < 8; ++ks) __builtin_amdgcn_global_load_lds((const unsigned*)(kbase + (size_t)t * 8192 + ks * 1024), (LAS unsigned*)(kl + ks * 1024), 16, 0, 0);
  };
  asm volatile("s_waitcnt lgkmcnt(0)" ::: "memory");
  if (kt >= 0) issue_K(kt);
#pragma unroll 1
  while (kt >= 0) {
    int ktn = kt; unsigned remn = rem;
    adv(ktn, remn); adv(ktn, remn);
    asm volatile("s_waitcnt vmcnt(0)" ::: "memory");
    bf16x8 Kc[8], Vf[8];
#pragma unroll
    for (int ks = 0; ks < 8; ++ks) Kc[ks] = *(const LAS bf16x8*)(kl + lane * 16 + ks * 1024);
#pragma unroll
    for (int f = 0; f < 8; ++f) Vf[f] = *(const bf16x8*)(vbase + (size_t)kt * 8192 + f * 1024);
    asm volatile("s_waitcnt lgkmcnt(0)" ::: "memory");
    if (ktn >= 0) issue_K(ktn);
    f32x16 S;
#pragma unroll
    for (int r = 0; r < 16; ++r) S[r] = 0.f;
#pragma unroll
    for (int ks = 0; ks < 8; ++ks) S = MFMA32(Kc[ks], *(const LAS bf16x8*)(qlds + ks * 1024), S);
    const bool allowed = (kt >= own0) || ((selmask >> (kt >> 3)) & 1u);
    const float nb = allowed ? 0.f : -INFINITY;
    float sv[16]; float mx = -INFINITY;
#pragma unroll
    for (int r = 0; r < 16; ++r) sv[r] = __builtin_fmaf(S[r], cscale, nb);
    if (kt == diag) {
#pragma unroll
      for (int r = 0; r < 16; ++r) if (crow32(r, hh) > q) sv[r] = -INFINITY;
    }
#pragma unroll
    for (int r = 0; r < 16; ++r) mx = fmaxf(mx, sv[r]);
    mx = fmaxf(mx, __shfl_xor(mx, 32, 64));
    const float mn = fmaxf(m, mx);
    const float alpha = __builtin_amdgcn_exp2f(m - mn);
    float ps = 0.f;
#pragma unroll
    for (int r = 0; r < 16; ++r) { sv[r] = __builtin_amdgcn_exp2f(sv[r] - mn); ps += sv[r]; }
    l = l * alpha + ps; m = mn;
    if (__ballot(alpha != 1.f) != 0ull) {
#pragma unroll
      for (int dt = 0; dt < 4; ++dt)
#pragma unroll
        for (int r = 0; r < 16; ++r) O[dt][r] *= alpha;
    }
    const bf16x8 P0 = pack8(sv[0], sv[1], sv[2], sv[3], sv[4], sv[5], sv[6], sv[7]);
    const bf16x8 P1 = pack8(sv[8], sv[9], sv[10], sv[11], sv[12], sv[13], sv[14], sv[15]);
#pragma unroll
    for (int dt = 0; dt < 4; ++dt) { O[dt] = MFMA32(Vf[dt * 2], P0, O[dt]); O[dt] = MFMA32(Vf[dt * 2 + 1], P1, O[dt]); }
    kt = ktn; rem = remn;
  }
  asm volatile("s_waitcnt vmcnt(0) lgkmcnt(0)" ::: "memory");
  if (par) {
    ml[lane] = m; ml[64 + lane] = l;
#pragma unroll
    for (int dt = 0; dt < 4; ++dt)
#pragma unroll
      for (int r = 0; r < 16; ++r) mrg[(dt * 16 + r) * 64 + lane] = O[dt][r];
  }
  __syncthreads();
  if (par == 0) {
    const float m2 = ml[lane], l2 = ml[64 + lane];
    const float mm = fmaxf(m, m2);
    const float a1 = __builtin_amdgcn_exp2f(m - mm), a2 = __builtin_amdgcn_exp2f(m2 - mm);
    l = l * a1 + l2 * a2;
#pragma unroll
    for (int dt = 0; dt < 4; ++dt)
#pragma unroll
      for (int r = 0; r < 16; ++r) O[dt][r] = O[dt][r] * a1 + mrg[(dt * 16 + r) * 64 + lane] * a2;
  }
  if (par == 0) {
  l += __shfl_xor(l, 32, 64);
  const float inv = 1.f / l;
  bf16_t* orow = p.mb_out + ((size_t)b * SEQ + s0 + q) * p.mb_out_ld + p.mb_out_off + h * 128;
#pragma unroll
  for (int dt = 0; dt < 4; ++dt)
#pragma unroll
    for (int g4 = 0; g4 < 4; ++g4) {
      u32x2 wv; wv.x = pk2(O[dt][4 * g4] * inv, O[dt][4 * g4 + 1] * inv); wv.y = pk2(O[dt][4 * g4 + 2] * inv, O[dt][4 * g4 + 3] * inv);
      *(u32x2*)(orow + 32 * dt + 8 * g4 + 4 * hh) = wv;
    }
  }
  __syncthreads();
}
__device__ void moba_worker(const Params& p, LAS unsigned char* lds, int qi) {
  const int lane = p.tid & 63, w = __builtin_amdgcn_readfirstlane(p.tid >> 6);
  LAS float* km = (LAS float*)(lds + w * 16384);
  LAS float* mrg = (LAS float*)(lds + ((w & 3) + 4) * 16384);
  LAS float* ml = (LAS float*)(lds + 131072) + (w & 3) * 128;
  LAS int* slot = (LAS int*)(lds + 131072 + 2048);
  const int g = blockIdx.x & 7;
  for (;;) {
    __syncthreads();
    if (p.tid == 0) slot[0] = atomicAdd(p.wq + qi * 8 + g, 1);
    __syncthreads();
    const int idx = slot[0];
    if (idx >= 64) break;
    const int ib = 15 - (idx >> 2), bh = 2 * g + ((idx >> 1) & 1), quad = 1 - (idx & 1);
    moba_item(p, km, mrg, ml, bh, ib, 4 * quad + (w & 3), w >> 2, lane);
  }
}
__device__ void ph_mod(const Params& p, LAS unsigned char* lds, int nblk, int bid) {
  LAS float* sc = (LAS float*)lds;
  LAS float* part = (LAS float*)(lds + 16384);
  const int tid = p.tid;
  if (bid >= 192) return;
  for (int i = tid; i < 4096; i += 512) sc[i] = siluf_(p.c[i]);
  __syncthreads();
  for (int task = bid; task < 192; task += nblk) {
    const int jj = tid & 31, ks = tid >> 5, j = task * 32 + jj;
    float a0 = 0.f, a1 = 0.f, a2 = 0.f, a3 = 0.f;
#pragma unroll 8
    for (int kk = 0; kk < 64; ++kk) {
      const int k = ks * 64 + kk;
      const float w = p.w_ada[(size_t)k * 6144 + j];
      a0 += sc[k] * w; a1 += sc[1024 + k] * w; a2 += sc[2048 + k] * w; a3 += sc[3072 + k] * w;
    }
    *(LAS f32x4*)(part + (ks * 32 + jj) * 4) = (f32x4){a0, a1, a2, a3};
    __syncthreads();
    if (tid < 128) {
      const int j2 = tid & 31, bb = tid >> 5;
      float a = 0.f;
#pragma unroll
      for (int s = 0; s < 16; ++s) a += part[(s * 32 + j2) * 4 + bb];
      p.mod[bb * 6144 + task * 32 + j2] = a + p.b_ada[task * 32 + j2];
    }
    __syncthreads();
  }
}

#define WT_T0 1424
#define WT_T1 (WT_T0 + 16384)
#define WT_T2 (WT_T1 + 8192)
#define WT_T3 (WT_T2 + 128)
#define WT_T4 (WT_T3 + 128)
#define WT_T5 (WT_T4 + 256)
struct WtTile { const float* src; bf16_t* dst; int K, N, mode, k0, n0; };
__device__ __forceinline__ WtTile wt_desc(const Params& p, int t) {
  WtTile d;
  if (t < WT_T0) { const int kt = t / 89, nt = t % 89; d = {p.w_in, p.w_in_t, 1024, INW, 1, kt * 64, nt * 64}; }
  else if (t < WT_T1) { const int u = t - WT_T0, e = u >> 9, r = u & 511, kt = r >> 5, nt = r & 31; d = {p.w_gu + (size_t)e * 1024 * 2048, p.wgu_t + (size_t)e * 2048 * 1024, 1024, 2048, 2, kt * 64, nt * 64}; }
  else if (t < WT_T2) { const int u = t - WT_T1, e = u >> 8, r = u & 255, kt = r >> 4, nt = r & 15; d = {p.w_down + (size_t)e * 1024 * 1024, p.wd_t + (size_t)e * 1024 * 1024, 1024, 1024, 0, kt * 64, nt * 64}; }
  else if (t < WT_T3) { const int u = t - WT_T2, kt = u >> 4, nt = u & 15; d = {p.w_br_a, p.wbra_t, 512, 1024, 0, kt * 64, nt * 64}; }
  else if (t < WT_T4) { const int u = t - WT_T3, kt = u >> 4, nt = u & 15; d = {p.w_br_b, p.wbrb_t, 512, 1024, 0, kt * 64, nt * 64}; }
  else { const int u = t - WT_T4, kt = u >> 4, nt = u & 15; d = {p.w_o, p.wo_t, 1024, 1024, 0, kt * 64, nt * 64}; }
  return d;
}
__device__ __forceinline__ void wt_load(const WtTile& d, int tid, f32x4 (&v)[2]) {
#pragma unroll
  for (int it = 0; it < 2; ++it) {
    const int row = (tid >> 4) + 32 * it, n = d.n0 + (tid & 15) * 4;
    v[it] = (f32x4){0.f, 0.f, 0.f, 0.f};
    if (n < d.N) v[it] = __builtin_nontemporal_load((const f32x4*)(d.src + (size_t)(d.k0 + row) * d.N + n));
  }
}
__device__ void ph_wt(const Params& p, LAS unsigned char* lds, int nblk, int bid) {
  LAS float* tile = (LAS float*)(lds + 32768);
  const int tid = p.tid;
  int t = bid;
  if (t >= WT_T5) return;
  WtTile cur = wt_desc(p, t);
  f32x4 v[2]; wt_load(cur, tid, v);
  for (;;) {
    const int tn = t + nblk;
    WtTile nxt = cur; f32x4 vn[2];
    if (tn < WT_T5) { nxt = wt_desc(p, tn); wt_load(nxt, tid, vn); }
#pragma unroll
    for (int it = 0; it < 2; ++it) {
      const int row = (tid >> 4) + 32 * it, c4 = (tid & 15) * 4;
      tile[row * 65 + c4] = v[it][0]; tile[row * 65 + c4 + 1] = v[it][1]; tile[row * 65 + c4 + 2] = v[it][2]; tile[row * 65 + c4 + 3] = v[it][3];
    }
    __syncthreads();
    {
      const int nl = tid >> 3, kc = tid & 7, n = cur.n0 + nl;
      if (n < cur.N) {
        const int dd = map_col(n, cur.mode);
        if (dd >= 0) {
          float f[8];
#pragma unroll
          for (int j = 0; j < 8; ++j) f[j] = tile[(8 * kc + j) * 65 + nl];
          u32x4 w; w.x = pk2(f[0], f[1]); w.y = pk2(f[2], f[3]); w.z = pk2(f[4], f[5]); w.w = pk2(f[6], f[7]);
          *(u32x4*)(cur.dst + (size_t)dd * cur.K + cur.k0 + 8 * kc) = w;
        }
      }
    }
    __syncthreads();
    if (tn >= WT_T5) break;
    t = tn; cur = nxt; v[0] = vn[0]; v[1] = vn[1];
  }
}

__device__ void ph_h(const Params& p, LAS unsigned char* lds, int nblk, int bid) {
  const int wid = p.tid >> 6, lane = p.tid & 63;
  LAS float* wb = (LAS float*)lds;
  for (int i = p.tid; i < 2048; i += 512) {
    const int k = i >> 1, hf = i & 1;
    const f32x4 v = *(const f32x4*)(p.w_in + (size_t)k * INW + 2048 + 4 * hf);
    wb[(4 * hf + 0) * 1024 + k] = v[0]; wb[(4 * hf + 1) * 1024 + k] = v[1]; wb[(4 * hf + 2) * 1024 + k] = v[2]; wb[(4 * hf + 3) * 1024 + k] = v[3];
  }
  __syncthreads();
  for (int t = bid * 8 + wid; t < T_TOK; t += nblk * 8) {
    const int b = t / SEQ;
    const float* xr = p.x + (size_t)t * DM;
    f32x4 xv[4];
    float ss = 0.f;
#pragma unroll
    for (int i = 0; i < 4; ++i) {
      xv[i] = *(const f32x4*)(xr + i * 256 + lane * 4);
      ss += xv[i][0] * xv[i][0] + xv[i][1] * xv[i][1] + xv[i][2] * xv[i][2] + xv[i][3] * xv[i][3];
    }
    ss = wave_sum(ss);
    const float rstd = rsqrtf(ss * (1.f / DM) + 1e-6f);
    const float* shift = p.mod + b * 6144;
    const float* scale = p.mod + b * 6144 + 1024;
    float acc[8] = {0, 0, 0, 0, 0, 0, 0, 0};
#pragma unroll
    for (int i = 0; i < 4; ++i) {
      const int k = i * 256 + lane * 4;
      const f32x4 g = *(const f32x4*)(p.g_pre_mix + k), sc = *(const f32x4*)(scale + k), sh = *(const f32x4*)(shift + k);
      f32x4 hv;
#pragma unroll
      for (int j = 0; j < 4; ++j) hv[j] = xv[i][j] * rstd * g[j] * (1.f + sc[j]) + sh[j];
#pragma unroll
      for (int e = 0; e < 8; ++e) { const f32x4 w = *(const LAS f32x4*)(wb + e * 1024 + k); acc[e] += hv[0] * w[0] + hv[1] * w[1] + hv[2] * w[2] + hv[3] * w[3]; }
      u32x2 pk; pk.x = pk2(hv[0], hv[1]); pk.y = pk2(hv[2], hv[3]);
      *(u32x2*)(p.hbf + (size_t)t * DM + k) = pk;
    }
#pragma unroll
    for (int e = 0; e < 8; ++e) acc[e] = wave_sum(acc[e]);
    if (lane == 0) { *(f32x4*)(p.ba + (size_t)t * 8) = (f32x4){acc[0], acc[1], acc[2], acc[3]}; *(f32x4*)(p.ba + (size_t)t * 8 + 4) = (f32x4){acc[4], acc[5], acc[6], acc[7]}; }
  }
}

__device__ void ph_post_mix(const Params& p, LAS unsigned char* lds, int nblk, int bid, int rep) {
  const int wid = p.tid >> 6, lane = p.tid & 63;
  LAS bf16_t* wl = (LAS bf16_t*)lds;
  LAS float* sh = (LAS float*)(lds + 81920) + wid * 1024;
  LAS int* lcnt = (LAS int*)(lds + 114688);
  LAS int* lbase = lcnt + 32;
  LAS int* lent = (LAS int*)(lds + 115200) + wid * 256;
  int nloc = 0;
  if (p.tid < 32) lcnt[p.tid] = 0;
  for (int i = p.tid; i < 1024 * 8; i += 512) {
    const int k = i >> 3, c = i & 7;
    const f32x4 v = *(const f32x4*)(p.w_router + (size_t)k * 32 + c * 4);
    u32x2 w2; w2.x = pk2(v[0], v[1]); w2.y = pk2(v[2], v[3]);
    *(LAS u32x2*)(wl + k * 40 + c * 4) = w2;
  }
  __syncthreads();
  for (int t = bid * 8 + wid; t < T_TOK; t += nblk * 8) {
    const int b = t / SEQ;
    const float* md = p.mod + b * 6144;
    float mv[16];
    float ss = 0.f;
#pragma unroll
    for (int i = 0; i < 2; ++i) {
      float f[8]; unpack8(*(const u32x4*)(p.mixer + (size_t)t * DM + i * 512 + lane * 8), f);
#pragma unroll
      for (int j = 0; j < 8; ++j) { mv[i * 8 + j] = f[j]; ss += f[j] * f[j]; }
    }
    ss = wave_sum(ss);
    const float rstd = rsqrtf(ss * (1.f / DM) + 1e-6f);
    float x1[16];
    float s2 = 0.f;
#pragma unroll
    for (int i = 0; i < 2; ++i)
#pragma unroll
      for (int j4 = 0; j4 < 2; ++j4) {
        const int k = i * 512 + lane * 8 + j4 * 4;
        const f32x4 xv = *(const f32x4*)(p.x + (size_t)t * DM + k);
        const f32x4 gm = *(const f32x4*)(md + 2048 + k), gp = *(const f32x4*)(p.g_post_mix + k);
        f32x4 o;
#pragma unroll
        for (int j = 0; j < 4; ++j) { o[j] = xv[j] + gm[j] * (mv[i * 8 + j4 * 4 + j] * rstd * gp[j]); x1[i * 8 + j4 * 4 + j] = o[j]; s2 += o[j] * o[j]; }
        *(f32x4*)(p.out + (size_t)t * DM + k) = o;
      }
    s2 = wave_sum(s2);
    const float rstd2 = rsqrtf(s2 * (1.f / DM) + 1e-6f);
#pragma unroll
    for (int i = 0; i < 2; ++i) {
      float hv[8];
#pragma unroll
      for (int j = 0; j < 8; ++j) {
        const int k = i * 512 + lane * 8 + j;
        hv[j] = x1[i * 8 + j] * rstd2 * p.g_pre_ffn[k] * (1.f + md[4096 + k]) + md[3072 + k];
        sh[k] = hv[j];
      }
      u32x4 w; w.x = pk2(hv[0], hv[1]); w.y = pk2(hv[2], hv[3]); w.z = pk2(hv[4], hv[5]); w.w = pk2(hv[6], hv[7]);
      *(u32x4*)(p.h2 + (size_t)t * DM + i * 512 + lane * 8) = w;
    }
#ifdef PM_SKIP
    if (rep) continue;
#endif
    float acc[32];
#pragma unroll
    for (int e2 = 0; e2 < 32; ++e2) acc[e2] = 0.f;
#pragma unroll 4
    for (int i = 0; i < 16; ++i) {
      const float hk = sh[lane + 64 * i];
      const LAS u32x4* wr = (const LAS u32x4*)(wl + (lane + 64 * i) * 40);
#pragma unroll
      for (int c4 = 0; c4 < 4; ++c4) {
        float f[8]; unpack8(wr[c4], f);
#pragma unroll
        for (int j = 0; j < 8; ++j) acc[c4 * 8 + j] += hk * f[j];
      }
    }
    {
      const bool u5 = lane & 32, u4 = lane & 16, u3 = lane & 8, u2 = lane & 4, u1 = lane & 2;
      float a16[16], a8[8], a4[4], a2[2];
#pragma unroll
      for (int j = 0; j < 16; ++j) { const float snd = u5 ? acc[j] : acc[16 + j]; const float rcv = __shfl_xor(snd, 32, 64); a16[j] = (u5 ? acc[16 + j] : acc[j]) + rcv; }
#pragma unroll
      for (int j = 0; j < 8; ++j) { const float snd = u4 ? a16[j] : a16[8 + j]; const float rcv = __shfl_xor(snd, 16, 64); a8[j] = (u4 ? a16[8 + j] : a16[j]) + rcv; }
#pragma unroll
      for (int j = 0; j < 4; ++j) { const float snd = u3 ? a8[j] : a8[4 + j]; const float rcv = __shfl_xor(snd, 8, 64); a4[j] = (u3 ? a8[4 + j] : a8[j]) + rcv; }
#pragma unroll
      for (int j = 0; j < 2; ++j) { const float snd = u2 ? a4[j] : a4[2 + j]; const float rcv = __shfl_xor(snd, 4, 64); a2[j] = (u2 ? a4[2 + j] : a4[j]) + rcv; }
      const float snd = u1 ? a2[0] : a2[1]; const float rcv = __shfl_xor(snd, 2, 64);
      float a1 = (u1 ? a2[1] : a2[0]) + rcv;
      a1 += __shfl_xor(a1, 1, 64);
      acc[0] = a1;
    }
    const int e = lane >> 1;
    float lg = acc[0] + p.b_router[e];
    if (lane & 1) lg = -INFINITY;
    float tv[4]; int ti[4];
#pragma unroll
    for (int r = 0; r < 4; ++r) {
      const float m = wave_max(lg);
      const unsigned long long bal = __ballot(lg == m);
      const int idx = __ffsll((long long)bal) - 1;
      tv[r] = m; ti[r] = idx >> 1;
      if (lane == idx) lg = -INFINITY;
    }
    const float e1 = __expf(tv[1] - tv[0]), e2 = __expf(tv[2] - tv[0]), e3 = __expf(tv[3] - tv[0]);
    const float inv = 1.f / (1.f + e1 + e2 + e3);
    if (lane < 4) {
      const int ee = lane == 0 ? ti[0] : lane == 1 ? ti[1] : lane == 2 ? ti[2] : ti[3];
      const float ww = (lane == 0 ? 1.f : lane == 1 ? e1 : lane == 2 ? e2 : e3) * inv;
      p.aw[t * 4 + lane] = ww;
      const int rank = __hip_atomic_fetch_add(&lcnt[ee], 1, __ATOMIC_RELAXED, __HIP_MEMORY_SCOPE_WORKGROUP);
      lent[nloc * 4 + lane] = (ee << 16) | rank;
      lent[nloc * 4 + lane + 2048] = t * 4 + lane;
    }
    ++nloc;
  }
  __syncthreads();
  if (p.tid < 32) lbase[p.tid] = atomicAdd(&p.cnt[p.tid * 64 + 32 * rep], lcnt[p.tid]);
  __syncthreads();
  for (int i = lane; i < nloc * 4; i += 64) {
    const int er = lent[i], a = lent[i + 2048];
    p.elist[(er >> 16) * T_TOK + lbase[er >> 16] + (er & 0xffff)] = a;
  }
}

__device__ void ph_gather(const Params& p, LAS unsigned char* lds, int nblk, int bid) {
  const int wid = p.tid >> 6, lane = p.tid & 63;
  LAS int* tb = (LAS int*)lds;
  if (p.tid == 0) { int off = 0; for (int k = 0; k < NE; ++k) { const int c = p.cnt[k * 64]; tb[k] = off; tb[64 + k] = c; off += ((c + 255) >> 8) << 8; } tb[NE] = off; }
  __syncthreads();
  const int total = tb[NE];
  for (int r = bid * 8 + wid; r < total; r += nblk * 8) {
    int e = 0;
#pragma unroll 1
    for (int k = 1; k < NE; ++k) if (r >= tb[k]) e = k;
    const int i = r - tb[e];
    const int a = (i < tb[64 + e]) ? p.elist[e * T_TOK + i] : -1;
    if (lane == 0) p.rowmap[r] = a;
    u32x4 v0 = {0, 0, 0, 0}, v1 = v0;
    if (a >= 0) { const u32x4* src = (const u32x4*)(p.h2 + (size_t)(a >> 2) * DM); v0 = src[lane]; v1 = src[64 + lane]; }
    u32x4* dst = (u32x4*)(p.xs + (size_t)r * DM);
    dst[lane] = v0; dst[64 + lane] = v1;
  }
}

__device__ void ph_final(const Params& p, int nblk, int bid, int rep) {
  const int wid = p.tid >> 6, lane = p.tid & 63;
  for (int t0 = bid * 8 + wid; t0 < T_TOK; t0 += nblk * 16) {
    int tt[2] = {t0, t0 + nblk * 8};
    if (tt[1] >= T_TOK) tt[1] = t0;
    float mv[2][16]; float ss[2];
#pragma unroll
    for (int u = 0; u < 2; ++u) {
      const int t = tt[u];
      const f32x4 wv = *(const f32x4*)(p.aw + t * 4);
      ss[u] = 0.f;
#pragma unroll
      for (int i = 0; i < 2; ++i) {
        const bf16_t* y = p.yslot + (size_t)t * 4 * DM + i * 512 + lane * 8;
        float f0[8], f1[8], f2[8], f3[8];
        unpack8(*(const u32x4*)y, f0); unpack8(*(const u32x4*)(y + DM), f1); unpack8(*(const u32x4*)(y + 2 * DM), f2); unpack8(*(const u32x4*)(y + 3 * DM), f3);
#pragma unroll
        for (int j = 0; j < 8; ++j) { const float m = wv[0] * f0[j] + wv[1] * f1[j] + wv[2] * f2[j] + wv[3] * f3[j]; mv[u][i * 8 + j] = m; ss[u] += m * m; }
      }
    }
    f32x4 x1[2][4];
#pragma unroll
    for (int u = 0; u < 2; ++u)
#pragma unroll
      for (int i = 0; i < 2; ++i)
#pragma unroll
        for (int j4 = 0; j4 < 2; ++j4) x1[u][i * 2 + j4] = *(const f32x4*)(p.out + (size_t)tt[u] * DM + i * 512 + lane * 8 + j4 * 4);
    ss[0] = wave_sum(ss[0]); ss[1] = wave_sum(ss[1]);
#pragma unroll
    for (int u = 0; u < 2; ++u) {
      const int t = tt[u];
      if (u == 1 && t == t0) break;
      const float* md = p.mod + (t / SEQ) * 6144;
      const float rstd = rsqrtf(ss[u] * (1.f / DM) + 1e-6f);
#pragma unroll
      for (int i = 0; i < 2; ++i)
#pragma unroll
        for (int j4 = 0; j4 < 2; ++j4) {
          const int k = i * 512 + lane * 8 + j4 * 4;
          float* op = p.out + (size_t)t * DM + k;
          const f32x4 gf = *(const f32x4*)(md + 5120 + k), gp = *(const f32x4*)(p.g_post_ffn + k);
          f32x4 o;
#pragma unroll
          for (int j = 0; j < 4; ++j) o[j] = x1[u][i * 2 + j4][j] + gf[j] * (mv[u][i * 8 + j4 * 4 + j] * rstd * gp[j]);
          *(f32x4*)(rep ? (float*)p.hbf + (size_t)(t & 8191) * DM + k : op) = o;
        }
    }
  }
}

#define XCD_BAR_WORDS 3456
struct KArgs { const void* in[22]; float* out; char* ws; long long never; };
__host__ __device__ inline size_t al(size_t x) { return (x + 255) & ~(size_t)255; }
__host__ __device__ inline void fill_params(Params& p, const KArgs& k) {
  p.x = (const float*)k.in[0]; p.c = (const float*)k.in[1]; p.w_ada = (const float*)k.in[2]; p.b_ada = (const float*)k.in[3];
  p.g_pre_mix = (const float*)k.in[4]; p.g_post_mix = (const float*)k.in[5]; p.g_pre_ffn = (const float*)k.in[6];
  p.g_post_ffn = (const float*)k.in[7]; p.w_in = (const float*)k.in[8]; p.conv_w = (const float*)k.in[9];
  p.a_log = (const float*)k.in[10]; p.dt_bias = (const float*)k.in[11]; p.g_dn_out = (const float*)k.in[12];
  p.w_br_a = (const float*)k.in[13]; p.w_br_b = (const float*)k.in[14]; p.w_o = (const float*)k.in[15];
  p.w_router = (const float*)k.in[16]; p.b_router = (const float*)k.in[17]; p.w_gu = (const float*)k.in[18];
  p.b_gu = (const float*)k.in[19]; p.w_down = (const float*)k.in[20]; p.b_down = (const float*)k.in[21];
  p.out = k.out;
  char* w = k.ws;
  size_t o = 0;
#define take(bytes) (w + (o += al(bytes)) - al(bytes))
  p.mod = (float*)take(4 * 6144 * 4);
  p.cnt = (int*)take(16384);
  p.ba = (float*)take((size_t)T_TOK * 8 * 4);
  p.hbf = (bf16_t*)take((size_t)T_TOK * DM * 2);
  p.proj = (bf16_t*)take((size_t)T_TOK * PW * 2);
  p.w_in_t = (bf16_t*)take((size_t)PW * DM * 2);
  p.wgu_t = (bf16_t*)take((size_t)NE * 2048 * DM * 2);
  p.wd_t = (bf16_t*)take((size_t)NE * 1024 * DM * 2);
  p.wbra_t = (bf16_t*)take((size_t)1024 * 512 * 2);
  p.wbrb_t = (bf16_t*)take((size_t)1024 * 512 * 2);
  p.wo_t = (bf16_t*)take((size_t)1024 * 1024 * 2);
  p.qb = (bf16_t*)take((size_t)T_TOK * 512 * 2);
  p.kb = (bf16_t*)take((size_t)T_TOK * 512 * 2);
  p.kmean = (float*)take((size_t)16 * 16 * 128 * 4);
  p.oab = (bf16_t*)take((size_t)T_TOK * DM * 2);
  p.merged = (bf16_t*)take((size_t)T_TOK * DM * 2);
  p.mixer = (bf16_t*)take((size_t)T_TOK * DM * 2);
  p.h2 = (bf16_t*)take((size_t)T_TOK * DM * 2);
  p.elist = (int*)take((size_t)NE * T_TOK * 4);
  p.aw = (float*)take((size_t)T_TOK * 4 * 4);
  p.rowmap = (int*)take((size_t)73728 * 4);
  p.dnA = (unsigned char*)take((size_t)1024 * DN_ABYTES);
  p.dnU = (float*)take((size_t)1024 * DN_UFLOATS * 4);
  p.dnG = (float*)take(4096);
  p.oab2 = (bf16_t*)take((size_t)T_TOK * 512 * 2);
  p.dbg = (float*)take(256);
  p.bar = (unsigned*)take(XCD_BAR_WORDS * 4);
  p.dn_out = p.oab; p.dn_out_ld = DM;
  p.Kp = (bf16_t*)take((size_t)16 * 128 * 8192);
  p.Vp = (bf16_t*)take((size_t)16 * 128 * 8192);
  p.wq = p.cnt + 32 * 64;
  p.mb_out = p.oab; p.mb_out_ld = DM; p.mb_out_off = 512;
  p.xs = p.proj;
  char* big = take((size_t)73728 * DM * 2 + (size_t)65536 * DM * 2);
  p.act = (bf16_t*)big;
  p.yslot = (bf16_t*)(big + (size_t)73728 * DM * 2);
  {
    char* s = big; size_t so = 0;
#define t2(bytes) (s + (so += al(bytes)) - al(bytes))
    p.nq = (float*)t2((size_t)T_TOK * 512 * 4);
    p.nk = (float*)t2((size_t)T_TOK * 512 * 4);
    p.nv = (float*)t2((size_t)T_TOK * 512 * 4);
    p.no = (float*)t2((size_t)T_TOK * 512 * 4);
    p.ntmp = (float*)t2((size_t)T_TOK * DM * 4);
    p.nbeta = (float*)t2((size_t)T_TOK * 4 * 4);
    p.ng = (float*)t2((size_t)T_TOK * 4 * 4);
  }

#undef take
#undef t2
  p.never = (int)k.never;
}

#define XB_TMO      128
#define XB_XCNT(j)  (256  + 64 * (j))
#define XB_XSUB(j)  (1280 + 64 * (j))
#define XB_XGEN(j)  (2304 + 64 * (j))
#define XB_TOP      3328
#define XB_TOPGEN   3392
#define XB_SPIN_CAP (1u << 18)

__device__ __forceinline__ unsigned xb_ld(unsigned* p)              { return __hip_atomic_load(p, __ATOMIC_RELAXED, __HIP_MEMORY_SCOPE_AGENT); }
__device__ __forceinline__ unsigned xb_add(unsigned* p, unsigned v) { return __hip_atomic_fetch_add(p, v, __ATOMIC_RELAXED, __HIP_MEMORY_SCOPE_AGENT); }
__device__ __forceinline__ unsigned xb_xcc_id() { return (unsigned)__builtin_amdgcn_s_getreg((3 << 11) | 20) & 0xFu; }
#define XB_SPIN(cond, bar) do { unsigned _sp = 0; while (cond) { __builtin_amdgcn_s_sleep(1); \
    if ((++_sp & 255u) == 0u) { if (xb_ld(&(bar)[XB_TMO])) break; if (_sp > XB_SPIN_CAP) { atomicAdd(&(bar)[XB_TMO], 1u); break; } } } } while (0)

struct XcdBarrier {
    unsigned* bar; unsigned x;
    volatile LAS unsigned* st;
};

__device__ __forceinline__ XcdBarrier xcd_barrier_post(unsigned* bar, volatile LAS unsigned* st) {
    XcdBarrier b; b.bar = bar; b.x = xb_xcc_id(); b.st = st;
    if (threadIdx.x == 0) (void)xb_add(&bar[XB_XCNT(b.x)], 1u);
    return b;
}
__device__ __forceinline__ void xcd_barrier_complete(unsigned* bar, unsigned x, unsigned& nloc, unsigned& nx) {
    const unsigned G = gridDim.x * gridDim.y * gridDim.z;
    unsigned sum, cnt, mine, sp = 0u;
    for (;;) {
        sum = 0u; cnt = 0u; mine = 0u;
#pragma unroll
        for (unsigned j = 0; j < 16; ++j) { const unsigned c = xb_ld(&bar[XB_XCNT(j)]); sum += c; cnt += (c > 0u) ? 1u : 0u; mine = (j == x) ? c : mine; }
        if (sum == G) break;
        __builtin_amdgcn_s_sleep(1);
        if ((++sp & 255u) == 0u) { if (xb_ld(&bar[XB_TMO])) break; if (sp > XB_SPIN_CAP) { atomicAdd(&bar[XB_TMO], 1u); break; } }
    }
    nloc = mine > 0u ? mine : 1u; nx = cnt > 0u ? cnt : 1u;
}

__device__ __forceinline__ void xcd_barrier(const XcdBarrier& b, const int tid) {
    asm volatile("s_waitcnt vmcnt(0)" ::: "memory");
    __syncthreads();
    if (tid == 0) {
        unsigned* bar = b.bar;
        __builtin_amdgcn_s_waitcnt(0);
        unsigned nloc = b.st[0], nx = b.st[1];
        if (nloc == 0u) { xcd_barrier_complete(bar, b.x, nloc, nx); b.st[0] = nloc; b.st[1] = nx; }
        const unsigned old = xb_add(&bar[XB_XSUB(b.x)], 1u);
        const unsigned gen = old / nloc;
        if (old + 1u == (gen + 1u) * nloc) {
            __builtin_amdgcn_fence(__ATOMIC_RELEASE, "agent");
            asm volatile("s_waitcnt vmcnt(0)" ::: "memory");
            const unsigned og = xb_add(&bar[XB_TOP], 1u);
            const unsigned tg = og / nx;
            if (og + 1u == (tg + 1u) * nx) xb_add(&bar[XB_TOPGEN], 1u);
            else XB_SPIN(xb_ld(&bar[XB_TOPGEN]) == tg, bar);
            __builtin_amdgcn_fence(__ATOMIC_ACQUIRE, "agent");
            xb_add(&bar[XB_XGEN(b.x)], 1u);
            asm volatile("s_waitcnt vmcnt(0)" ::: "memory");
        } else {
            XB_SPIN(xb_ld(&bar[XB_XGEN(b.x)]) == gen, bar);
            __builtin_amdgcn_fence(__ATOMIC_ACQUIRE, "agent");
            asm volatile("s_waitcnt vmcnt(0)" ::: "memory");
        }
    }
    __syncthreads();
}


__device__ __forceinline__ void load_ka(KArgs& kk) {
#if defined(__HIP_DEVICE_COMPILE__)
  typedef __attribute__((address_space(1))) char* gptr_t;
  typedef const __attribute__((address_space(4))) gptr_t* kptr_t;
  kptr_t kp = (kptr_t)__builtin_amdgcn_kernarg_segment_ptr();
  asm volatile("" : "+s"(kp));
#pragma unroll
  for (int i = 0; i < 22; ++i) kk.in[i] = (const void*)kp[i];
  kk.out = (float*)kp[22];
  kk.ws = (char*)kp[23];
  kk.never = ((const __attribute__((address_space(4))) long long*)kp)[24];
#endif
}
__device__ __forceinline__ void grid_bar(const Params& p, LAS unsigned char* lds);
#define MEGA_LDS 148480
#define MEGA_LDS_ALLOC (MEGA_LDS + 16)
__device__ __forceinline__ void grid_bar(const Params& p, LAS unsigned char* lds) {
  XcdBarrier b; b.bar = p.bar; b.x = xb_xcc_id(); b.st = (volatile LAS unsigned*)(lds + MEGA_LDS);
  xcd_barrier(b, p.tid);
}
__global__ __launch_bounds__(512) void mega(KArgs ka) {
  extern __shared__ __attribute__((aligned(16))) unsigned char shm[];
  LAS unsigned char* lds = (LAS unsigned char*)shm;
  cg::grid_group grid = cg::this_grid();
  const int nblk = gridDim.x, bid = blockIdx.x;
  volatile LAS unsigned* xst = (volatile LAS unsigned*)(lds + MEGA_LDS);
  if (threadIdx.x == 0) { xst[0] = 0u; xst[1] = 0u; xst[2] = 0u; xst[3] = 0u; }
  __syncthreads();
  { Params p0; fill_params(p0, ka); (void)xcd_barrier_post(p0.bar, xst); }
  if (ka.never) grid.sync();
#ifndef REPMASK
#define REPMASK 0
#endif
#define LOADKA KArgs kk; load_ka(kk)
#ifndef PHMASK
#define PHMASK 0xffff
#endif
#define PHASE(k, body) if (((PHMASK) >> (k)) & 1) for (int rep_ = 0; rep_ < (((REPMASK) >> (k)) & 1) + 1; ++rep_) { \
    LOADKA; Params p; fill_params(p, kk); { int t_ = threadIdx.x; asm volatile("" : "+v"(t_)); p.tid = t_; } body; grid_bar(p, lds); }
#ifdef XBAR
  for (int xb_ = 0; xb_ < XBAR; ++xb_) { PHASE(15, {}) }
#endif
  PHASE(0, { ph_mod(p, lds, nblk, bid); ph_wt(p, lds, nblk, bid); })
  PHASE(1, { ph_h(p, lds, nblk, bid); })
  PHASE(2, { ph_proj(p, lds, nblk, bid); })
  PHASE(3, { bool first = true; for (int ci = bid; ci < 1024; ci += nblk) { dn_prep_chunk(p, lds, ci, first); first = false; }
             for (int item = bid; item < 256; item += nblk) moba_prep_block(p, lds, item); })
  PHASE(4, { if (bid < 32) dn_scan_blk(p, lds, bid); moba_worker(p, lds, rep_); })
  PHASE(5, { ph_dn_norm(p, nblk, bid); })
  PHASE(6, { ph_br(p, lds, nblk, bid); })
  PHASE(7, { ph_mix(p, lds, nblk, bid); })
  PHASE(8, { ph_post_mix(p, lds, nblk, bid, rep_); })
  PHASE(10, { ph_moe1(p, lds, nblk, bid); })
  PHASE(11, { ph_moe2(p, lds, nblk, bid); })
  PHASE(12, { ph_final(p, nblk, bid, rep_); })
}


extern "C" void kernel_launch(void* const* d_in, const int* in_sizes, int n_in, void* d_out, int out_size, void* d_ws,
                              size_t ws_size, hipStream_t stream) {
  KArgs ka{};
  for (int i = 0; i < 22; ++i) ka.in[i] = d_in[i];
  ka.out = (float*)d_out; ka.ws = (char*)d_ws; ka.never = 0;
  Params p{};
  fill_params(p, ka);
  static int grid_blocks = 0;
  if (!grid_blocks) {
    (void)hipFuncSetAttribute((const void*)mega, hipFuncAttributeMaxDynamicSharedMemorySize, MEGA_LDS_ALLOC);
    int dev = 0, cus = 0, per_cu = 0;
    (void)hipGetDevice(&dev);
    (void)hipDeviceGetAttribute(&cus, hipDeviceAttributeMultiprocessorCount, dev);
    (void)hipOccupancyMaxActiveBlocksPerMultiprocessor(&per_cu, mega, 512, MEGA_LDS_ALLOC);
    if (per_cu != 1) per_cu = 1;
    grid_blocks = cus * per_cu;
  }
  (void)hipMemsetAsync(p.cnt, 0, 16384, stream);
  (void)hipMemsetAsync(p.bar, 0, XCD_BAR_WORDS * 4, stream);
  void* args[] = {&ka};
  hipError_t e = hipLaunchCooperativeKernel((void*)mega, dim3(grid_blocks), dim3(512), args, MEGA_LDS_ALLOC, stream);
  if (e != hipSuccess) fprintf(stderr, "cooperative launch failed: %s (grid %d)\n", hipGetErrorString(e), grid_blocks);
}
```

```cpp
#include <hip/hip_runtime.h>
#include <hip/hip_cooperative_groups.h>
#include <cstdio>
namespace cg = cooperative_groups;
#include <stdint.h>

typedef unsigned short bf16_t;

#define T_TOK 16384
#define SEQ 4096
#define NB 4
#define DM 1024
#define INW 5640
#define PW 5632
#define C_QA 0
#define C_KA 512
#define C_VA 1024
#define C_Z 1536
#define C_MQ 2048
#define C_MK 2560
#define C_MV 3072
#define C_GA 3584
#define C_GB 4608
#define NE 32

__device__ __forceinline__ bf16_t f2bf(float f) {
  unsigned u = __float_as_uint(f);
  u += 0x7fffu + ((u >> 16) & 1u);
  return (bf16_t)(u >> 16);
}
__device__ __forceinline__ float bf2f(bf16_t h) { return __uint_as_float(((unsigned)h) << 16); }
__device__ __forceinline__ float sigmoidf_(float x) { return 1.f / (1.f + __expf(-x)); }
__device__ __forceinline__ float siluf_(float x) { return x / (1.f + __expf(-x)); }
__device__ __forceinline__ float wave_sum(float v) {
#pragma unroll
  for (int o = 32; o > 0; o >>= 1) v += __shfl_xor(v, o, 64);
  return v;
}
__device__ __forceinline__ float wave_max(float v) {
#pragma unroll
  for (int o = 32; o > 0; o >>= 1) v = fmaxf(v, __shfl_xor(v, o, 64));
  return v;
}

typedef __bf16 bf16x2_t __attribute__((ext_vector_type(2)));
typedef float f32x2_t __attribute__((ext_vector_type(2)));
__device__ __forceinline__ unsigned pk2(float a, float b) { f32x2_t v = {a, b}; bf16x2_t r = __builtin_convertvector(v, bf16x2_t); return __builtin_bit_cast(unsigned, r); }

struct Params {
  const float *x, *c, *w_ada, *b_ada, *g_pre_mix, *g_post_mix, *g_pre_ffn, *g_post_ffn, *w_in, *conv_w,
      *a_log, *dt_bias, *g_dn_out, *w_br_a, *w_br_b, *w_o, *w_router, *b_router, *w_gu, *b_gu, *w_down, *b_down;
  float* out;
  float* mod;
  int* cnt;
  float* ba;
  bf16_t* hbf;
  bf16_t* proj;
  bf16_t* w_in_t;
  bf16_t* wgu_t;
  bf16_t* wd_t;
  bf16_t* wbra_t;
  bf16_t* wbrb_t;
  bf16_t* wo_t;
  bf16_t* qb;
  bf16_t* kb;
  float* kmean;
  bf16_t* oab;
  bf16_t* merged;
  bf16_t* mixer;
  bf16_t* h2;
  int* elist;
  float* aw;
  bf16_t* act;
  bf16_t* xs;
  int* rowmap;
  bf16_t* yslot;
  unsigned char* dnA; float* dnU; float* dnG;
  bf16_t* dn_out; int dn_out_ld;
  bf16_t* oab2; float* dbg;
  unsigned* bar; int never; int tid;
  bf16_t* Kp; bf16_t* Vp; int* wq;
  bf16_t* mb_out; int mb_out_ld; int mb_out_off;
  float* nq; float* nk; float* nv;
  float* nbeta; float* ng;
  float* no;
  float* ntmp;
};

__device__ __forceinline__ int map_col(int n, int mode) {
  if (mode == 0) return n;
  if (mode == 1) return n < 2048 ? n : (n < 2056 ? -1 : n - 8);
  if (n < 1024) return (n >> 7) * 256 + (n & 127);
  int j = n - 1024;
  return (j >> 7) * 256 + 128 + (j & 127);
}
namespace pg8 {
#define PG8_LAS __attribute__((address_space(3)))
typedef short bf16x8 __attribute__((ext_vector_type(8)));
typedef float f32x4 __attribute__((ext_vector_type(4)));
typedef unsigned u32x4 __attribute__((ext_vector_type(4)));
constexpr int BM = 256, BK = 64, HALF = 128, HTB = HALF * BK * 2, STAGE_BYTES = 8 * HTB, NXCD = 8, WGM = 8;

__host__ __device__ __forceinline__ int lds_byte(int r, int c) { const int st = (r >> 4) * 2 + (c >> 5), rr = r & 15, cc = c & 31, ob = rr * 64 + cc * 2; return st * 1024 + (ob ^ (((ob >> 9) & 1) << 5)); }
__host__ __device__ __forceinline__ void stage_rc(int b, int& R, int& C) { const int st = b / 1024, sb = b % 1024, swz = sb ^ (((sb >> 9) & 1) << 5); R = (st >> 1) * 16 + swz / 64; C = (st & 1) * 32 + (swz % 64) / 2; }
__host__ __device__ __forceinline__ int perm32(int rho) { const int n = rho >> 4, i = rho & 15; return 8 * (i >> 2) + 4 * n + (i & 3); }

struct Unit { int pm, pn, z; };
__device__ __forceinline__ unsigned cvt_pk_bf16(float lo, float hi) { unsigned r; asm volatile("v_cvt_pk_bf16_f32 %0, %1, %2" : "=v"(r) : "v"(lo), "v"(hi)); return r; }

struct TileOrder {
    int nM, nN, nwg, G, c;
    __device__ void init(int nM_, int nN_, int G_, int c_) { nM = nM_; nN = nN_; nwg = nM * nN; G = G_; c = c_; }
    __device__ bool tile(int i, int& pm, int& pn) const {
        const long L = (long)i * G + c; if (L >= nwg) return false;
        int wgid = (int)L; { const int q = nwg / NXCD, r = nwg % NXCD, xcd = wgid % NXCD, off = wgid / NXCD; wgid = (xcd < r ? xcd * (q + 1) : r * (q + 1) + (xcd - r) * q) + off; }
        const int nig = WGM * nN, gid = wgid / nig, fm = gid * WGM, gsz = (nM - fm) < WGM ? (nM - fm) : WGM;
        pm = fm + ((wgid % nig) % gsz); pn = (wgid % nig) / gsz; return true;
    }
};

template <class Epi, class Sched>
__device__ __forceinline__ void gemm_phase(PG8_LAS unsigned char* lds, const int tid, const int lda, const int ldb, const int K, const Sched& S, const Epi& E) {
    const int wid = __builtin_amdgcn_readfirstlane(tid >> 6), lane = tid & 63, wr = wid >> 2, wc = wid & 3, fr = lane & 15, fq = lane >> 4;
    const int nt = K / BK;
    unsigned voffA[2], voffB[2];
#pragma unroll
    for (int i = 0; i < 2; ++i) { int R, C; stage_rc(tid * 16 + i * 8192, R, C); const int Rb = Epi::PERM ? ((R & ~31) + perm32(R & 31)) : R;
        voffA[i] = (unsigned)(R * lda + C) * 2u; voffB[i] = (unsigned)(Rb * ldb + C) * 2u; }
    const size_t kstep = (size_t)(BK * 2);
    const size_t hstepA = (size_t)HALF * lda * 2, hstepB = (size_t)HALF * ldb * 2;
    const unsigned ldsw = (unsigned)wid * 1024u;
    const int aoff = lds_byte(wr * 64 + fr, fq * 8), boff = lds_byte(wc * 32 + fr, fq * 8);
    unsigned gA[2][2] = {{0u, 0u}, {0u, 0u}}, gAn[2][2] = {{0u, 0u}, {0u, 0u}};
    int gR[2], gC[2];
#pragma unroll
    for (int i = 0; i < 2; ++i) stage_rc(tid * 16 + i * 8192, gR[i], gC[i]);
#define PG8_SA(b, h) (((b) * 2 + (h)) * HTB)
#define PG8_SB(b, h) ((4 + (b) * 2 + (h)) * HTB)
#define PG8_STAGE(bufoff, gbase, voff) do { _Pragma("unroll") for (int _i = 0; _i < 2; ++_i) \
        __builtin_amdgcn_global_load_lds((const unsigned*)((const char*)(gbase) + (voff)[_i]), (PG8_LAS unsigned*)(lds + (bufoff) + ldsw + _i * 8192), 16, 0, 0); } while (0)
#define PG8_STAGEA(bufoff, ptr, h, nx) do { if constexpr (Sched::GATHER) { const unsigned gs_[2] = {(nx) ? gAn[h][0] : gA[h][0], (nx) ? gAn[h][1] : gA[h][1]}; PG8_STAGE(bufoff, ptr, gs_); } \
        else { PG8_STAGE(bufoff, (ptr) + (h) * hstepA, voffA); } } while (0)
#define PG8_LDA(dst, b, h) do { _Pragma("unroll") for (int m = 0; m < 4; ++m) _Pragma("unroll") for (int k = 0; k < 2; ++k) dst[m][k] = *(const PG8_LAS bf16x8*)(lds + PG8_SA(b, h) + aoff + m * 2048 + k * 1024); } while (0)
#define PG8_LDB(dst, b, h) do { _Pragma("unroll") for (int n = 0; n < 2; ++n) _Pragma("unroll") for (int k = 0; k < 2; ++k) dst[n][k] = *(const PG8_LAS bf16x8*)(lds + PG8_SB(b, h) + boff + n * 2048 + k * 1024); } while (0)
#define PG8_MMA(ai, bj, At, Bt) do { __builtin_amdgcn_s_setprio(1); _Pragma("unroll") for (int m = 0; m < 4; ++m) _Pragma("unroll") for (int n = 0; n < 2; ++n) _Pragma("unroll") for (int k = 0; k < 2; ++k) \
        acc[ai][bj][m][n] = __builtin_amdgcn_mfma_f32_16x16x32_bf16(Bt[n][k], At[m][k], acc[ai][bj][m][n], 0, 0, 0); __builtin_amdgcn_s_setprio(0); } while (0)
#define PG8_WAIT_V(n) asm volatile("s_waitcnt vmcnt(" #n ")" ::: "memory")
#define PG8_WAIT_L(n) asm volatile("s_waitcnt lgkmcnt(" #n ")" ::: "memory")
#define PG8_BAR __builtin_amdgcn_s_barrier()
#define PG8_SCHED __builtin_amdgcn_sched_barrier(0)
    Unit cur, nxt; int ui = 0;
    if (!S.next(0, cur)) return;
    f32x4 acc[2][2][4][2];
#pragma unroll
    for (int a = 0; a < 2; ++a)
#pragma unroll
        for (int b = 0; b < 2; ++b)
#pragma unroll
            for (int m = 0; m < 4; ++m)
#pragma unroll
                for (int n = 0; n < 2; ++n) acc[a][b][m][n] = (f32x4){0.f, 0.f, 0.f, 0.f};
    bf16x8 At[4][2], B0[2][2], B1[2][2];
    const char* cA = S.a_ptr(cur); const char* cB = S.b_ptr(cur);
    if constexpr (Sched::GATHER) {
_Pragma("unroll") for (int h = 0; h < 2; ++h) _Pragma("unroll") for (int i = 0; i < 2; ++i) gA[h][i] = S.a_goff(cur, gR[i] + 128 * h, gC[i]); }
    PG8_STAGE(PG8_SB(0, 0), cB, voffB); PG8_STAGEA(PG8_SA(0, 0), cA, 0, false); PG8_STAGE(PG8_SB(0, 1), cB + hstepB, voffB); PG8_STAGEA(PG8_SA(0, 1), cA, 1, false);
    if (wr == 1) PG8_BAR;
    PG8_WAIT_V(4); PG8_BAR;
    PG8_STAGE(PG8_SB(1, 0), cB + kstep, voffB); PG8_STAGEA(PG8_SA(1, 0), cA + kstep, 0, false); PG8_STAGE(PG8_SB(1, 1), cB + hstepB + kstep, voffB);
    PG8_WAIT_V(6); PG8_BAR;
    for (;;) {
        const bool has_next = S.next(ui + 1, nxt);
        const char* nA = has_next ? S.a_ptr(nxt) : cA; const char* nB = has_next ? S.b_ptr(nxt) : cB;
        if constexpr (Sched::GATHER) {
_Pragma("unroll") for (int h = 0; h < 2; ++h) _Pragma("unroll") for (int i = 0; i < 2; ++i) gAn[h][i] = has_next ? S.a_goff(nxt, gR[i] + 128 * h, gC[i]) : gA[h][i]; }
        for (int t = 0; t < nt; t += 2) {
            const bool last = (t == nt - 2);
            const char* a1 = cA + (size_t)(t + 1) * kstep;
            const char* a2 = last ? nA : cA + (size_t)(t + 2) * kstep; const char* b2 = last ? nB : cB + (size_t)(t + 2) * kstep;
            const char* a3 = a2 + kstep; const char* b3 = b2 + kstep;
            PG8_LDB(B0, 0, 0); PG8_SCHED; PG8_LDA(At, 0, 0); PG8_STAGEA(PG8_SA(1, 1), a1, 1, false);
            PG8_WAIT_L(8); PG8_BAR; PG8_WAIT_L(0); PG8_MMA(0, 0, At, B0); PG8_BAR; PG8_SCHED;
            PG8_LDB(B1, 0, 1); PG8_STAGE(PG8_SB(0, 0), b2, voffB);
            PG8_BAR; PG8_WAIT_L(0); PG8_MMA(0, 1, At, B1); PG8_BAR;
            PG8_LDA(At, 0, 1); PG8_STAGEA(PG8_SA(0, 0), a2, 0, last);
            PG8_BAR; PG8_WAIT_L(0); PG8_MMA(1, 0, At, B0); PG8_BAR; PG8_SCHED;
            PG8_STAGE(PG8_SB(0, 1), b2 + hstepB, voffB);
            PG8_WAIT_V(6); PG8_BAR; PG8_MMA(1, 1, At, B1); PG8_BAR;
            PG8_LDB(B0, 1, 0); PG8_SCHED; PG8_LDA(At, 1, 0); PG8_STAGEA(PG8_SA(0, 1), a2, 1, last);
            PG8_WAIT_L(8); PG8_BAR; PG8_WAIT_L(0); PG8_MMA(0, 0, At, B0); PG8_BAR; PG8_SCHED;
            PG8_LDB(B1, 1, 1); PG8_STAGE(PG8_SB(1, 0), b3, voffB);
            PG8_BAR; PG8_WAIT_L(0); PG8_MMA(0, 1, At, B1); PG8_BAR;
            PG8_LDA(At, 1, 1); PG8_STAGEA(PG8_SA(1, 0), a3, 0, last);
            PG8_BAR; PG8_WAIT_L(0); PG8_MMA(1, 0, At, B0); PG8_BAR; PG8_SCHED;
            PG8_STAGE(PG8_SB(1, 1), b3 + hstepB, voffB);
            PG8_WAIT_V(6); PG8_BAR; PG8_MMA(1, 1, At, B1); PG8_BAR;
        }
        E(acc, cur, wr, wc, fr, fq);
        if (!has_next) break;
#pragma unroll
        for (int a = 0; a < 2; ++a)
#pragma unroll
            for (int b = 0; b < 2; ++b)
#pragma unroll
                for (int m = 0; m < 4; ++m)
#pragma unroll
                    for (int n = 0; n < 2; ++n) acc[a][b][m][n] = (f32x4){0.f, 0.f, 0.f, 0.f};
        cur = nxt; cA = nA; cB = nB; ++ui;
        if constexpr (Sched::GATHER) {
_Pragma("unroll") for (int h = 0; h < 2; ++h) _Pragma("unroll") for (int i = 0; i < 2; ++i) gA[h][i] = gAn[h][i]; }
    }
    PG8_WAIT_V(0);
    if (wr == 0) PG8_BAR;
    PG8_BAR;
#undef PG8_SA
#undef PG8_SB
#undef PG8_STAGE
#undef PG8_STAGEA
#undef PG8_LDA
#undef PG8_LDB
#undef PG8_MMA
#undef PG8_WAIT_V
#undef PG8_WAIT_L
#undef PG8_BAR
#undef PG8_SCHED
}
}
using pg8::f32x4; using pg8::u32x4; using pg8::Unit;

#define GEMM_LDS (pg8::STAGE_BYTES + 1024)

struct SchedProj : pg8::TileOrder {
  static constexpr bool GATHER = false;
  const char* A; const char* B;
  __device__ bool next(int i, Unit& u) const { u.z = 0; return tile(i, u.pm, u.pn); }
  __device__ const char* a_ptr(const Unit& u) const { return A + (size_t)u.pm * 256 * DM * 2; }
  __device__ const char* b_ptr(const Unit& u) const { return B + (size_t)u.pn * 256 * DM * 2; }
};
struct EpiProj {
  static constexpr bool PERM = true;
  bf16_t* O;
  __device__ __forceinline__ void operator()(const f32x4 (&acc)[2][2][4][2], const Unit& u, int wr, int wc, int fr, int fq) const {
    const int row0 = u.pm * 256 + wr * 64 + fr, col0 = u.pn * 256 + wc * 32 + 8 * fq;
    const bool gate = u.pn >= (C_GA / 256);
#pragma unroll
    for (int ai = 0; ai < 2; ++ai)
#pragma unroll
      for (int m = 0; m < 4; ++m) {
        bf16_t* rowp = O + (size_t)(row0 + ai * 128 + m * 16) * PW + col0;
#pragma unroll
        for (int bj = 0; bj < 2; ++bj) {
          f32x4 v0 = acc[ai][bj][m][0], v1 = acc[ai][bj][m][1];
          if (gate) {
#pragma unroll
            for (int j = 0; j < 4; ++j) { v0[j] = sigmoidf_(v0[j]); v1[j] = sigmoidf_(v1[j]); }
          }
          u32x4 w; w.x = pg8::cvt_pk_bf16(v0[0], v0[1]); w.y = pg8::cvt_pk_bf16(v0[2], v0[3]); w.z = pg8::cvt_pk_bf16(v1[0], v1[1]); w.w = pg8::cvt_pk_bf16(v1[2], v1[3]);
          *(u32x4*)(rowp + bj * 128) = w;
        }
      }
  }
};
__device__ void ph_proj(const Params& p, PG8_LAS unsigned char* lds, int nblk, int bid) {
  SchedProj S; S.init(T_TOK / 256, PW / 256, nblk, bid); S.A = (const char*)p.hbf; S.B = (const char*)p.w_in_t;
  EpiProj E{p.proj};
  pg8::gemm_phase(lds, p.tid, DM, DM, DM, S, E);
}

struct SchedBr : pg8::TileOrder {
  static constexpr bool GATHER = false;
  const char* A; const char* Ba; const char* Bb;
  __device__ bool next(int i, Unit& u) const { u.z = i & 1; return tile(i >> 1, u.pm, u.pn); }
  __device__ const char* a_ptr(const Unit& u) const { return A + (size_t)u.pm * 256 * DM * 2 + u.z * 512 * 2; }
  __device__ const char* b_ptr(const Unit& u) const { return (u.z ? Bb : Ba) + (size_t)u.pn * 256 * 512 * 2; }
};
__device__ __forceinline__ void unpack8(const u32x4 w, float (&f)[8]) {
  f[0] = __uint_as_float(w.x << 16); f[1] = __uint_as_float(w.x & 0xffff0000u); f[2] = __uint_as_float(w.y << 16); f[3] = __uint_as_float(w.y & 0xffff0000u);
  f[4] = __uint_as_float(w.z << 16); f[5] = __uint_as_float(w.z & 0xffff0000u); f[6] = __uint_as_float(w.w << 16); f[7] = __uint_as_float(w.w & 0xffff0000u);
}
struct EpiBr {
  static constexpr bool PERM = true;
  const bf16_t* proj; bf16_t* O;
  __device__ __forceinline__ void operator()(const f32x4 (&acc)[2][2][4][2], const Unit& u, int wr, int wc, int fr, int fq) const {
    const int row0 = u.pm * 256 + wr * 64 + fr, col0 = u.pn * 256 + wc * 32 + 8 * fq;
    const int gcol = (u.z ? C_GB : C_GA) + col0;
#pragma unroll
    for (int ai = 0; ai < 2; ++ai)
#pragma unroll
      for (int m = 0; m < 4; ++m) {
        const size_t row = (size_t)(row0 + ai * 128 + m * 16);
        bf16_t* rowp = O + row * DM + col0;
        const bf16_t* gp = proj + row * PW + gcol;
#pragma unroll
        for (int bj = 0; bj < 2; ++bj) {
          float g[8]; unpack8(*(const u32x4*)(gp + bj * 128), g);
          f32x4 v0 = acc[ai][bj][m][0], v1 = acc[ai][bj][m][1];
          float r[8];
#pragma unroll
          for (int j = 0; j < 4; ++j) { r[j] = v0[j] * g[j]; r[4 + j] = v1[j] * g[4 + j]; }
          if (u.z) {
            float pv[8]; unpack8(*(const u32x4*)(rowp + bj * 128), pv);
#pragma unroll
            for (int j = 0; j < 8; ++j) r[j] += pv[j];
          }
          u32x4 w; w.x = pg8::cvt_pk_bf16(r[0], r[1]); w.y = pg8::cvt_pk_bf16(r[2], r[3]); w.z = pg8::cvt_pk_bf16(r[4], r[5]); w.w = pg8::cvt_pk_bf16(r[6], r[7]);
          *(u32x4*)(rowp + bj * 128) = w;
        }
      }
  }
};
__device__ void ph_br(const Params& p, PG8_LAS unsigned char* lds, int nblk, int bid) {
  SchedBr S; S.init(T_TOK / 256, DM / 256, nblk, bid); S.A = (const char*)p.oab; S.Ba = (const char*)p.wbra_t; S.Bb = (const char*)p.wbrb_t;
  EpiBr E{p.proj, p.merged};
  pg8::gemm_phase(lds, p.tid, DM, 512, 512, S, E);
}

struct SchedMix : pg8::TileOrder {
  static constexpr bool GATHER = false;
  const char* A; const char* B;
  __device__ bool next(int i, Unit& u) const { u.z = 0; return tile(i, u.pm, u.pn); }
  __device__ const char* a_ptr(const Unit& u) const { return A + (size_t)u.pm * 256 * DM * 2; }
  __device__ const char* b_ptr(const Unit& u) const { return B + (size_t)u.pn * 256 * DM * 2; }
};
struct EpiMix {
  static constexpr bool PERM = true;
  bf16_t* O;
  __device__ __forceinline__ void operator()(const f32x4 (&acc)[2][2][4][2], const Unit& u, int wr, int wc, int fr, int fq) const {
    const int row0 = u.pm * 256 + wr * 64 + fr, col0 = u.pn * 256 + wc * 32 + 8 * fq;
#pragma unroll
    for (int ai = 0; ai < 2; ++ai)
#pragma unroll
      for (int m = 0; m < 4; ++m) {
        bf16_t* rowp = O + (size_t)(row0 + ai * 128 + m * 16) * DM + col0;
#pragma unroll
        for (int bj = 0; bj < 2; ++bj) {
          const f32x4 v0 = acc[ai][bj][m][0], v1 = acc[ai][bj][m][1];
          u32x4 w; w.x = pg8::cvt_pk_bf16(v0[0], v0[1]); w.y = pg8::cvt_pk_bf16(v0[2], v0[3]); w.z = pg8::cvt_pk_bf16(v1[0], v1[1]); w.w = pg8::cvt_pk_bf16(v1[2], v1[3]);
          *(u32x4*)(rowp + bj * 128) = w;
        }
      }
  }
};
__device__ void ph_mix(const Params& p, PG8_LAS unsigned char* lds, int nblk, int bid) {
  SchedMix S; S.init(T_TOK / 256, DM / 256, nblk, bid); S.A = (const char*)p.merged; S.B = (const char*)p.wo_t;
  EpiMix E{p.mixer};
  pg8::gemm_phase(lds, p.tid, DM, DM, DM, S, E);
}

template <bool GATH>
struct SchedMoe {
  static constexpr bool GATHER = GATH;
  const PG8_LAS int* tb; int NT; int G, c; int nwg;
  const char* A; const char* B; size_t bexp;
  const int* elist;
  __device__ bool next(int i, Unit& u) const {
    const long L = (long)i * G + c; if (L >= nwg) return false;
    int wgid = (int)L; { const int q = nwg / 8, r = nwg % 8, xcd = wgid % 8, off = wgid / 8; wgid = (xcd < r ? xcd * (q + 1) : r * (q + 1) + (xcd - r) * q) + off; }
    int e = 0;
#pragma unroll 1
    for (int k = 1; k < NE; ++k) if (wgid >= tb[k]) e = k;
    const int q = wgid - tb[e]; const int tiles = tb[33 + e + 1] - tb[33 + e];
    u.pm = tb[33 + e] + q % tiles; u.pn = q / tiles; u.z = e; return true;
  }
  __device__ const char* a_ptr(const Unit& u) const { return GATH ? A : A + (size_t)u.pm * 256 * DM * 2; }
  __device__ const char* b_ptr(const Unit& u) const { return B + (size_t)u.z * bexp + (size_t)u.pn * 256 * DM * 2; }
  __device__ unsigned a_goff(const Unit& u, int tr, int C) const {
    const int i = (u.pm - tb[33 + u.z]) * 256 + tr;
    int tok = 0;
    if (i < tb[66 + u.z]) tok = elist[u.z * T_TOK + i] >> 2;
    return (unsigned)(tok * DM + C) * 2u;
  }
};
__device__ __forceinline__ void moe_table(const Params& p, PG8_LAS int* tb, int NT) {
  if (p.tid == 0) {
    int ub = 0, tbp = 0;
    for (int e = 0; e < NE; ++e) { const int c = p.cnt[e * 64]; tb[e] = ub; tb[33 + e] = tbp; tb[66 + e] = c; const int t = (c + 255) >> 8; ub += t * NT; tbp += t; }
    tb[NE] = ub; tb[33 + NE] = tbp;
  }
  __syncthreads();
}
struct EpiMoe1 {
  static constexpr bool PERM = true;
  const float* b_gu; bf16_t* act;
  __device__ __forceinline__ void operator()(f32x4 (&acc)[2][2][4][2], const Unit& u, int wr, int wc, int fr, int fq) const {
    const int row0 = u.pm * 256 + wr * 64 + fr, jc = u.pn * 128 + wc * 32 + 8 * fq;
    const float* bg = b_gu + (size_t)u.z * 2048 + jc;
#pragma unroll
    for (int bj = 0; bj < 2; ++bj)
#pragma unroll
      for (int n = 0; n < 2; ++n) {
        const f32x4 bv = *(const f32x4*)(bg + bj * 1024 + n * 4);
#pragma unroll
        for (int ai = 0; ai < 2; ++ai)
#pragma unroll
          for (int m = 0; m < 4; ++m) acc[ai][bj][m][n] += bv;
      }
#pragma unroll
    for (int ai = 0; ai < 2; ++ai)
#pragma unroll
      for (int m = 0; m < 4; ++m) {
        bf16_t* rowp = act + (size_t)(row0 + ai * 128 + m * 16) * DM + jc;
        float r[8];
#pragma unroll
        for (int n = 0; n < 2; ++n)
#pragma unroll
          for (int j = 0; j < 4; ++j) {
            float g = acc[ai][0][m][n][j], up = acc[ai][1][m][n][j];
            g = fminf(g, 7.f); up = fminf(fmaxf(up, -7.f), 7.f);
            r[n * 4 + j] = (up + 1.f) * g * sigmoidf_(1.702f * g);
          }
        u32x4 w; w.x = pk2(r[0], r[1]); w.y = pk2(r[2], r[3]); w.z = pk2(r[4], r[5]); w.w = pk2(r[6], r[7]);
        *(u32x4*)rowp = w;
      }
  }
};
__device__ void ph_moe1(const Params& p, PG8_LAS unsigned char* lds, int nblk, int bid) {
  PG8_LAS int* tb = (PG8_LAS int*)(lds + pg8::STAGE_BYTES);
  moe_table(p, tb, 8);
  SchedMoe<true> S; S.tb = tb; S.NT = 8; S.G = nblk; S.c = bid; S.nwg = tb[NE]; S.A = (const char*)p.h2; S.B = (const char*)p.wgu_t; S.bexp = (size_t)2048 * DM * 2; S.elist = p.elist;
  EpiMoe1 E{p.b_gu, p.act};
  pg8::gemm_phase(lds, p.tid, DM, DM, DM, S, E);
}
struct EpiMoe2 {
  static constexpr bool PERM = true;
  const float* b_down; const int* elist; const PG8_LAS int* tb; bf16_t* yslot;
  __device__ __forceinline__ void operator()(f32x4 (&acc)[2][2][4][2], const Unit& u, int wr, int wc, int fr, int fq) const {
    const int row0 = u.pm * 256 + wr * 64 + fr, col0 = u.pn * 256 + wc * 32 + 8 * fq;
    const float* bd = b_down + (size_t)u.z * 1024 + col0;
#pragma unroll
    for (int bj = 0; bj < 2; ++bj)
#pragma unroll
      for (int n = 0; n < 2; ++n) {
        const f32x4 bv = *(const f32x4*)(bd + bj * 128 + n * 4);
#pragma unroll
        for (int ai = 0; ai < 2; ++ai)
#pragma unroll
          for (int m = 0; m < 4; ++m) acc[ai][bj][m][n] += bv;
      }
#pragma unroll
    for (int ai = 0; ai < 2; ++ai)
#pragma unroll
      for (int m = 0; m < 4; ++m) {
        const int li = (u.pm - tb[33 + u.z]) * 256 + wr * 64 + fr + ai * 128 + m * 16;
        if (li < tb[66 + u.z]) {
          const int a = elist[u.z * T_TOK + li];
          bf16_t* rowp = yslot + (size_t)a * DM + col0;
#pragma unroll
          for (int bj = 0; bj < 2; ++bj) {
            const f32x4 v0 = acc[ai][bj][m][0], v1 = acc[ai][bj][m][1];
            u32x4 w; w.x = pk2(v0[0], v0[1]); w.y = pk2(v0[2], v0[3]); w.z = pk2(v1[0], v1[1]); w.w = pk2(v1[2], v1[3]);
            *(u32x4*)(rowp + bj * 128) = w;
          }
        }
      }
  }
};
__device__ void ph_moe2(const Params& p, PG8_LAS unsigned char* lds, int nblk, int bid) {
  PG8_LAS int* tb = (PG8_LAS int*)(lds + pg8::STAGE_BYTES);
  moe_table(p, tb, 4);
  SchedMoe<false> S; S.tb = tb; S.NT = 4; S.G = nblk; S.c = bid; S.nwg = tb[NE]; S.A = (const char*)p.act; S.B = (const char*)p.wd_t; S.bexp = (size_t)1024 * DM * 2; S.elist = p.elist;
  EpiMoe2 E{p.b_down, p.elist, tb, p.yslot};
  pg8::gemm_phase(lds, p.tid, DM, DM, DM, S, E);
}

typedef short bf16x8 __attribute__((ext_vector_type(8)));
typedef unsigned u32x2 __attribute__((ext_vector_type(2)));
#define LAS __attribute__((address_space(3)))
#define MFMA16(a, b, c) __builtin_amdgcn_mfma_f32_16x16x32_bf16((a), (b), (c), 0, 0, 0)
__device__ __forceinline__ bf16x8 pack8(float a0, float a1, float a2, float a3, float a4, float a5, float a6, float a7) {
  u32x4 w; w.x = pk2(a0, a1); w.y = pk2(a2, a3); w.z = pk2(a4, a5); w.w = pk2(a6, a7);
  return __builtin_bit_cast(bf16x8, w);
}
__device__ __forceinline__ bf16_t f2bf_hw(float a) { return (bf16_t)(pk2(a, 0.f) & 0xffffu); }

#define DN_ABYTES 57344
#define DN_UFLOATS 8192
#define F_WN 0
#define F_QD 16
#define F_QK 32
#define F_KT 40

#define DP_KH 0
#define DP_QT 17408
#define DP_KHT 34816
#define DP_VT 53248
#define DP_TU 71680
#define DP_TW 80896
#define DP_LF 90112
#define DP_GC 107520
#define DP_BETA 107776
#define DP_CW 108032
#define DP_LB 114176
#define DP_TR 123392
#define DP_TT 132608
#define DP_MT 141824
#define DP_TOTAL 144128

template <int KS>
__device__ __forceinline__ f32x4 prod16(const LAS bf16_t* A, int lda, int arow0, const LAS bf16_t* Bt, int ldb, int brow0, f32x4 acc, int lane) {
  const int r = lane & 15, q = lane >> 4;
#pragma unroll
  for (int ks = 0; ks < KS; ++ks) {
    const bf16x8 a = *(const LAS bf16x8*)(A + (arow0 + r) * lda + 32 * ks + 8 * q);
    const bf16x8 b = *(const LAS bf16x8*)(Bt + (brow0 + r) * ldb + 32 * ks + 8 * q);
    acc = MFMA16(a, b, acc);
  }
  return acc;
}
__device__ __forceinline__ void tile_store_rm(LAS bf16_t* X, int ld, int row0, int col0, const f32x4 v, int lane) {
  const int r = lane & 15, q = lane >> 4;
#pragma unroll
  for (int i = 0; i < 4; ++i) X[(row0 + 4 * q + i) * ld + col0 + r] = f2bf_hw(v[i]);
}
__device__ __forceinline__ void tile_store_tr(LAS bf16_t* Xt, int ld, int row0, int col0, const f32x4 v, int lane) {
  const int r = lane & 15, q = lane >> 4;
  u32x2 w; w.x = pk2(v[0], v[1]); w.y = pk2(v[2], v[3]);
  *(LAS u32x2*)(Xt + (col0 + r) * ld + row0 + 4 * q) = w;
}

__device__ void dn_prep_chunk(const Params& p, LAS unsigned char* lds, int ci, bool load_cw) {
  const int tid = p.tid, lane = tid & 63, w = tid >> 6, r16 = lane & 15, q4 = lane >> 4;
  const int bh = ci >> 6, n = ci & 63, b = bh >> 2, h = bh & 3;
  LAS bf16_t* Kh = (LAS bf16_t*)(lds + DP_KH); LAS bf16_t* Qt = (LAS bf16_t*)(lds + DP_QT);
  LAS bf16_t* KhT = (LAS bf16_t*)(lds + DP_KHT); LAS bf16_t* VT = (LAS bf16_t*)(lds + DP_VT);
  LAS bf16_t* Tu = (LAS bf16_t*)(lds + DP_TU); LAS bf16_t* Tw = (LAS bf16_t*)(lds + DP_TW); LAS float* Lf = (LAS float*)(lds + DP_LF);
  LAS bf16_t* Lb = (LAS bf16_t*)(lds + DP_LB); LAS bf16_t* Tr = (LAS bf16_t*)(lds + DP_TR); LAS bf16_t* Tt = (LAS bf16_t*)(lds + DP_TT); LAS bf16_t* Mt = (LAS bf16_t*)(lds + DP_MT);
  LAS float* gcb = (LAS float*)(lds + DP_GC); LAS float* betab = (LAS float*)(lds + DP_BETA); LAS float* cw = (LAS float*)(lds + DP_CW);
  unsigned char* gA = (unsigned char*)p.dnA + (size_t)ci * DN_ABYTES;
  float* gU = p.dnU + (size_t)ci * DN_UFLOATS;

  if (load_cw) {
    for (int i = tid; i < 4 * 384; i += 512) { const int tap = i / 384, cc = i % 384, part = cc >> 7, d = cc & 127; cw[i] = p.conv_w[tap * 1536 + part * 512 + h * 128 + d]; }
  }
  __syncthreads();
  const int c = tid >> 3, g = tid & 7;
  const int s = n * 64 + c;
  const size_t t = (size_t)b * SEQ + s;
  float qv[16], kv[16], vv[16];
#pragma unroll
  for (int j = 0; j < 16; ++j) { qv[j] = 0.f; kv[j] = 0.f; vv[j] = 0.f; }
#pragma unroll
  for (int tap = 0; tap < 4; ++tap) {
    const int ss = s - 3 + tap;
    if (ss >= 0) {
      const bf16_t* row = p.proj + (t - 3 + tap) * PW + h * 128 + 16 * g;
      float x[8];
#pragma unroll
      for (int part = 0; part < 3; ++part) {
#pragma unroll
        for (int hh = 0; hh < 2; ++hh) {
          unpack8(*(const u32x4*)(row + part * 512 + 8 * hh), x);
#pragma unroll
          for (int j = 0; j < 8; ++j) {
            const float wv = cw[tap * 384 + part * 128 + 16 * g + 8 * hh + j];
            if (part == 0) qv[8 * hh + j] += wv * x[j];
            if (part == 1) kv[8 * hh + j] += wv * x[j];
            if (part == 2) vv[8 * hh + j] += wv * x[j];
          }
        }
      }
    }
    asm volatile("" ::: "memory");
  }
  float sq = 0.f, sk = 0.f;
#pragma unroll
  for (int j = 0; j < 16; ++j) { qv[j] = siluf_(qv[j]); kv[j] = siluf_(kv[j]); vv[j] = siluf_(vv[j]); sq += qv[j] * qv[j]; sk += kv[j] * kv[j]; }
  sq += __shfl_xor(sq, 1, 64); sq += __shfl_xor(sq, 2, 64); sq += __shfl_xor(sq, 4, 64);
  sk += __shfl_xor(sk, 1, 64); sk += __shfl_xor(sk, 2, 64); sk += __shfl_xor(sk, 4, 64);
  const float rq = rsqrtf(sq + 1e-6f) * 0.08838834764831845f, rk = rsqrtf(sk + 1e-6f);
#pragma unroll
  for (int j = 0; j < 16; ++j) { qv[j] *= rq; kv[j] *= rk; }
  if (g == 0) {
    const float bb = p.ba[t * 8 + h], aa = p.ba[t * 8 + 4 + h];
    const float xx = aa + p.dt_bias[h];
    const float sp = xx > 20.f ? xx : log1pf(__expf(xx));
    betab[c] = sigmoidf_(bb);
    gcb[c] = -__expf(p.a_log[h]) * sp;
  }
  {
    u32x4 w0, w1;
    w0.x = pk2(kv[0], kv[1]); w0.y = pk2(kv[2], kv[3]); w0.z = pk2(kv[4], kv[5]); w0.w = pk2(kv[6], kv[7]);
    w1.x = pk2(kv[8], kv[9]); w1.y = pk2(kv[10], kv[11]); w1.z = pk2(kv[12], kv[13]); w1.w = pk2(kv[14], kv[15]);
    *(LAS u32x4*)(Kh + c * 136 + 16 * g) = w0; *(LAS u32x4*)(Kh + c * 136 + 16 * g + 8) = w1;
    w0.x = pk2(qv[0], qv[1]); w0.y = pk2(qv[2], qv[3]); w0.z = pk2(qv[4], qv[5]); w0.w = pk2(qv[6], qv[7]);
    w1.x = pk2(qv[8], qv[9]); w1.y = pk2(qv[10], qv[11]); w1.z = pk2(qv[12], qv[13]); w1.w = pk2(qv[14], qv[15]);
    *(LAS u32x4*)(Qt + c * 136 + 16 * g) = w0; *(LAS u32x4*)(Qt + c * 136 + 16 * g + 8) = w1;
#pragma unroll
    for (int j = 0; j < 16; ++j) { KhT[(16 * g + j) * 72 + c] = f2bf_hw(kv[j]); VT[(16 * g + j) * 72 + c] = f2bf_hw(vv[j]); }
  }
  __syncthreads();
  if (w == 0) {
    float v = gcb[lane];
#pragma unroll
    for (int o = 1; o < 64; o <<= 1) { const float u = __shfl_up(v, o, 64); if (lane >= o) v += u; }
    gcb[lane] = v;
  }
  __syncthreads();
  const float gc_c = gcb[c], gl = gcb[63];
  {
    const float eg = __expf(gc_c);
    unsigned char* fb = gA + (size_t)(F_QD + (c >> 4) * 4 + (g >> 1)) * 1024 + (g & 1) * 8;
#pragma unroll
    for (int qq = 0; qq < 4; ++qq) {
      u32x2 wv; wv.x = pk2(qv[4 * qq] * eg, qv[4 * qq + 1] * eg); wv.y = pk2(qv[4 * qq + 2] * eg, qv[4 * qq + 3] * eg);
      *(u32x2*)(fb + ((c & 15) + 16 * qq) * 16) = wv;
    }
  }
  const int rt = w >> 1, ct0 = 2 * (w & 1);
#pragma unroll
  for (int tt = 0; tt < 2; ++tt) {
    const int ct = ct0 + tt;
    f32x4 gacc = {0.f, 0.f, 0.f, 0.f};
    gacc = prod16<4>(Kh, 136, 16 * rt, Kh, 136, 16 * ct, gacc, lane);
    const int m = 16 * ct + r16; const float gc_m = gcb[m];
    f32x4 lv;
#pragma unroll
    for (int i = 0; i < 4; ++i) {
      const int cc = 16 * rt + 4 * q4 + i;
      lv[i] = (m < cc) ? betab[cc] * gacc[i] * __expf(gcb[cc] - gc_m) : 0.f;
      Lf[cc * 68 + m] = lv[i];
    }
    tile_store_rm(Lb, 72, 16 * rt, 16 * ct, lv, lane);
    f32x4 qacc = {0.f, 0.f, 0.f, 0.f};
    qacc = prod16<4>(Kh, 136, 16 * rt, Qt, 136, 16 * ct, qacc, lane);
    const int cq = 16 * ct + r16; const float gc_cq = gcb[cq];
    float o4[4];
#pragma unroll
    for (int i = 0; i < 4; ++i) { const int mm = 16 * rt + 4 * q4 + i; o4[i] = (mm <= cq) ? qacc[i] * __expf(gc_cq - gcb[mm]) : 0.f; }
    u32x2 wv; wv.x = pk2(o4[0], o4[1]); wv.y = pk2(o4[2], o4[3]);
    *(u32x2*)(gA + (size_t)(F_QK + ct * 2 + (rt >> 1)) * 1024 + (r16 + 16 * q4) * 16 + (rt & 1) * 8) = wv;
  }
  __syncthreads();
  for (int i = tid; i < 2 * 64 * 72 / 8; i += 512) ((LAS u32x4*)Tr)[i] = (u32x4){0u, 0u, 0u, 0u};
  __syncthreads();
  if (w == 0) {
    int lo = lane; asm volatile("" : "+v"(lo));
    const int g = lo >> 4, j = lo & 15;
    unsigned lfb = DP_LF + (16 * g * 68 + 16 * g) * 4; asm volatile("" : "+v"(lfb));
    const LAS float* Lg = (const LAS float*)(lds + lfb);
    float t[16];
#pragma unroll
    for (int r = 0; r < 16; ++r) {
      float a0 = (r == j) ? 1.f : 0.f, a1 = 0.f;
#pragma unroll
      for (int k4 = 0; k4 < (r + 3) / 4; ++k4) {
        const f32x4 l = *(const LAS f32x4*)(Lg + r * 68 + 4 * k4);
        if (4 * k4 + 0 < r) a0 -= l[0] * t[4 * k4 + 0];
        if (4 * k4 + 1 < r) a1 -= l[1] * t[4 * k4 + 1];
        if (4 * k4 + 2 < r) a0 -= l[2] * t[4 * k4 + 2];
        if (4 * k4 + 3 < r) a1 -= l[3] * t[4 * k4 + 3];
      }
      t[r] = a0 + a1;
      Tr[(16 * g + r) * 72 + 16 * g + j] = f2bf_hw(t[r]);
    }
    u32x4 w0, w1;
    w0.x = pk2(t[0], t[1]); w0.y = pk2(t[2], t[3]); w0.z = pk2(t[4], t[5]); w0.w = pk2(t[6], t[7]);
    w1.x = pk2(t[8], t[9]); w1.y = pk2(t[10], t[11]); w1.z = pk2(t[12], t[13]); w1.w = pk2(t[14], t[15]);
    *(LAS u32x4*)(Tt + (16 * g + j) * 72 + 16 * g) = w0; *(LAS u32x4*)(Tt + (16 * g + j) * 72 + 16 * g + 8) = w1;
  }
  __syncthreads();
#pragma unroll 1
  for (int d = 1; d <= 3; ++d) {
    const bool act = w < 4 - d;
    const int I = w + d, J = w;
    LAS bf16_t* Mw = Mt + w * 16 * 24;
    if (act) {
      f32x4 macc = {0.f, 0.f, 0.f, 0.f};
      macc = prod16<2>(Lb, 72, 16 * I, Tt, 72, 16 * J, macc, lane);
      tile_store_tr(Mw, 24, 0, 0, macc, lane);
    }
    __syncthreads();
    if (act) {
      bf16x8 a = {0, 0, 0, 0, 0, 0, 0, 0}, bb = {0, 0, 0, 0, 0, 0, 0, 0};
      if (q4 < 2) { a = *(const LAS bf16x8*)(Tr + (16 * I + r16) * 72 + 16 * I + 8 * q4); bb = *(const LAS bf16x8*)(Mw + r16 * 24 + 8 * q4); }
      f32x4 tacc = {0.f, 0.f, 0.f, 0.f};
      tacc = MFMA16(a, bb, tacc);
#pragma unroll
      for (int i = 0; i < 4; ++i) tacc[i] = -tacc[i];
      tile_store_rm(Tr, 72, 16 * I, 16 * J, tacc, lane);
      tile_store_tr(Tt, 72, 16 * I, 16 * J, tacc, lane);
    }
    __syncthreads();
  }
  {
    const int cc = tid >> 3, m0 = (tid & 7) * 8;
    float tv[8]; unpack8(*(const LAS u32x4*)(Tr + cc * 72 + m0), tv);
    float tu[8], tw[8];
#pragma unroll
    for (int jj = 0; jj < 8; ++jj) { const float bm = betab[m0 + jj]; tu[jj] = tv[jj] * bm; tw[jj] = tu[jj] * __expf(gcb[m0 + jj]); }
    u32x4 wu, ww;
    wu.x = pk2(tu[0], tu[1]); wu.y = pk2(tu[2], tu[3]); wu.z = pk2(tu[4], tu[5]); wu.w = pk2(tu[6], tu[7]);
    ww.x = pk2(tw[0], tw[1]); ww.y = pk2(tw[2], tw[3]); ww.z = pk2(tw[4], tw[5]); ww.w = pk2(tw[6], tw[7]);
    *(LAS u32x4*)(Tu + cc * 72 + m0) = wu; *(LAS u32x4*)(Tw + cc * 72 + m0) = ww;
  }
  __syncthreads();
#pragma unroll
  for (int rr = 0; rr < 4; ++rr) {
    f32x4 u = {0.f, 0.f, 0.f, 0.f};
    u = prod16<2>(Tu, 72, 16 * rr, VT, 72, 16 * w, u, lane);
    *(f32x4*)(gU + ((w * 4 + rr) * 64 + lane) * 4) = u;
    f32x4 wt = {0.f, 0.f, 0.f, 0.f};
    wt = prod16<2>(KhT, 72, 16 * w, Tw, 72, 16 * rr, wt, lane);
    u32x2 wv; wv.x = pk2(-wt[0], -wt[1]); wv.y = pk2(-wt[2], -wt[3]);
    *(u32x2*)(gA + (size_t)(F_WN + rr * 4 + (w >> 1)) * 1024 + (r16 + 16 * q4) * 16 + (w & 1) * 8) = wv;
  }
#pragma unroll
  for (int it = 0; it < 4; ++it) {
    const int idx = tid + it * 512; const int d = idx >> 4, m4 = idx & 15;
    const u32x2 raw = *(const LAS u32x2*)(KhT + d * 72 + 4 * m4);
    const float k0 = __uint_as_float(raw.x << 16), k1 = __uint_as_float(raw.x & 0xffff0000u), k2 = __uint_as_float(raw.y << 16), k3 = __uint_as_float(raw.y & 0xffff0000u);
    const float e0 = __expf(gl - gcb[4 * m4]), e1 = __expf(gl - gcb[4 * m4 + 1]), e2 = __expf(gl - gcb[4 * m4 + 2]), e3 = __expf(gl - gcb[4 * m4 + 3]);
    u32x2 wv; wv.x = pk2(k0 * e0, k1 * e1); wv.y = pk2(k2 * e2, k3 * e3);
    *(u32x2*)(gA + (size_t)(F_KT + (d >> 4) * 2 + (m4 >> 3)) * 1024 + ((d & 15) + 16 * (m4 & 3)) * 16 + ((m4 >> 2) & 1) * 8) = wv;
  }
  if (tid == 0) p.dnG[ci] = __expf(gl);
}

#define DS_A0 0
#define DS_A1 57344
#define DS_TOTAL 114688
__device__ void dn_scan_blk(const Params& p, LAS unsigned char* lds, int item) {
  const int tid = p.tid, lane = tid & 63, w = __builtin_amdgcn_readfirstlane(tid >> 6), r16 = lane & 15, q4 = lane >> 4;
  const int bh = item >> 1, eh = item & 1, b = bh >> 2, h = bh & 3;
  const int et = eh * 4 + (w & 3);
  const bool comp = w < 4;
  const unsigned char* gA = (const unsigned char*)p.dnA + (size_t)bh * 64 * DN_ABYTES;
  const float* gU = p.dnU + (size_t)bh * 64 * DN_UFLOATS;
  const float* gG = p.dnG + bh * 64;
  auto issue_A = [&](int n, int buf) {
#pragma unroll
    for (int i = 0; i < 7; ++i) {
      const int f = w * 7 + i;
      __builtin_amdgcn_global_load_lds((const unsigned*)(gA + (size_t)n * DN_ABYTES + f * 1024 + lane * 16), (LAS unsigned*)(lds + (buf ? DS_A1 : DS_A0) + f * 1024), 16, 0, 0);
    }
  };
  __syncthreads();
  issue_A(0, 0);
  f32x4 Un[4];
#pragma unroll
  for (int rr = 0; rr < 4; ++rr) Un[rr] = *(const f32x4*)(gU + ((et * 4 + rr) * 64 + lane) * 4);
  f32x4 S[8];
#pragma unroll
  for (int dt = 0; dt < 8; ++dt) S[dt] = (f32x4){0.f, 0.f, 0.f, 0.f};
  asm volatile("s_waitcnt vmcnt(0)" ::: "memory");
  __syncthreads();
  bf16_t* obase = p.dn_out + ((size_t)b * SEQ) * p.dn_out_ld + h * 128 + 16 * et + r16;
  f32x4 Op[4];
#pragma unroll
  for (int rr = 0; rr < 4; ++rr) Op[rr] = (f32x4){0.f, 0.f, 0.f, 0.f};
#pragma unroll 1
  for (int n = 0; n < 64; ++n) {
    const LAS unsigned char* Ab = lds + ((n & 1) ? DS_A1 : DS_A0);
    if (n + 1 < 64) issue_A(n + 1, (n + 1) & 1);
    if (comp) {
      if (n > 0) {
#pragma unroll
        for (int rr = 0; rr < 4; ++rr)
#pragma unroll
          for (int i = 0; i < 4; ++i) obase[(size_t)((n - 1) * 64 + 16 * rr + 4 * q4 + i) * p.dn_out_ld] = f2bf_hw(Op[rr][i]);
      }
      f32x4 Vn[4];
#pragma unroll
      for (int rr = 0; rr < 4; ++rr) Vn[rr] = Un[rr];
      if (n + 1 < 64) {
#pragma unroll
        for (int rr = 0; rr < 4; ++rr) Un[rr] = *(const f32x4*)(gU + (size_t)(n + 1) * DN_UFLOATS + ((et * 4 + rr) * 64 + lane) * 4);
      }
      const float gdec = gG[n];
      bf16x8 Sb[4];
#pragma unroll
      for (int ks = 0; ks < 4; ++ks) Sb[ks] = pack8(S[2 * ks][0], S[2 * ks][1], S[2 * ks][2], S[2 * ks][3], S[2 * ks + 1][0], S[2 * ks + 1][1], S[2 * ks + 1][2], S[2 * ks + 1][3]);
      f32x4 O[4];
#pragma unroll
      for (int rr = 0; rr < 4; ++rr) {
        O[rr] = (f32x4){0.f, 0.f, 0.f, 0.f};
#pragma unroll
        for (int ks = 0; ks < 4; ++ks) {
          const bf16x8 aw = *(const LAS bf16x8*)(Ab + (F_WN + rr * 4 + ks) * 1024 + lane * 16);
          Vn[rr] = MFMA16(aw, Sb[ks], Vn[rr]);
          const bf16x8 aq = *(const LAS bf16x8*)(Ab + (F_QD + rr * 4 + ks) * 1024 + lane * 16);
          O[rr] = MFMA16(aq, Sb[ks], O[rr]);
        }
      }
      bf16x8 Vb[2];
#pragma unroll
      for (int ks = 0; ks < 2; ++ks) Vb[ks] = pack8(Vn[2 * ks][0], Vn[2 * ks][1], Vn[2 * ks][2], Vn[2 * ks][3], Vn[2 * ks + 1][0], Vn[2 * ks + 1][1], Vn[2 * ks + 1][2], Vn[2 * ks + 1][3]);
#pragma unroll
      for (int rr = 0; rr < 4; ++rr)
#pragma unroll
        for (int ks = 0; ks < 2; ++ks) {
          const bf16x8 a = *(const LAS bf16x8*)(Ab + (F_QK + rr * 2 + ks) * 1024 + lane * 16);
          O[rr] = MFMA16(a, Vb[ks], O[rr]);
        }
#pragma unroll
      for (int rr = 0; rr < 4; ++rr) Op[rr] = O[rr];
#pragma unroll
      for (int dt = 0; dt < 8; ++dt) {
        S[dt] *= gdec;
#pragma unroll
        for (int ks = 0; ks < 2; ++ks) {
          const bf16x8 a = *(const LAS bf16x8*)(Ab + (F_KT + dt * 2 + ks) * 1024 + lane * 16);
          S[dt] = MFMA16(a, Vb[ks], S[dt]);
        }
      }
    }
    asm volatile("s_waitcnt vmcnt(0)" ::: "memory");
    __syncthreads();
  }
  if (comp) {
#pragma unroll
    for (int rr = 0; rr < 4; ++rr)
#pragma unroll
      for (int i = 0; i < 4; ++i) obase[(size_t)(63 * 64 + 16 * rr + 4 * q4 + i) * p.dn_out_ld] = f2bf_hw(Op[rr][i]);
  }
}
__device__ void ph_dn_norm(const Params& p, int nblk, int bid) {
  const int wid = p.tid >> 6, lane = p.tid & 63;
  const f32x4 g0 = *(const f32x4*)(p.g_dn_out + (lane & 15) * 8), g1 = *(const f32x4*)(p.g_dn_out + (lane & 15) * 8 + 4);
  for (int t = bid * 8 + wid; t < T_TOK; t += nblk * 8) {
    bf16_t* op = p.oab + (size_t)t * DM + lane * 8;
    float o[8], z[8];
    unpack8(*(const u32x4*)op, o);
    unpack8(*(const u32x4*)(p.proj + (size_t)t * PW + C_Z + lane * 8), z);
    float ss = 0.f;
#pragma unroll
    for (int j = 0; j < 8; ++j) ss += o[j] * o[j];
    ss += __shfl_xor(ss, 1, 64); ss += __shfl_xor(ss, 2, 64); ss += __shfl_xor(ss, 4, 64); ss += __shfl_xor(ss, 8, 64);
    const float rstd = rsqrtf(ss * (1.f / 128.f) + 1e-6f);
    float y[8];
#pragma unroll
    for (int j = 0; j < 4; ++j) { y[j] = o[j] * rstd * g0[j] * siluf_(z[j]); y[4 + j] = o[4 + j] * rstd * g1[j] * siluf_(z[4 + j]); }
    u32x4 w; w.x = pk2(y[0], y[1]); w.y = pk2(y[2], y[3]); w.z = pk2(y[4], y[5]); w.w = pk2(y[6], y[7]);
    *(u32x4*)op = w;
  }
}
typedef float f32x16 __attribute__((ext_vector_type(16)));
#define MFMA32(a, b, c) __builtin_amdgcn_mfma_f32_32x32x16_bf16((a), (b), (c), 0, 0, 0)
#define MP_VL 0
#define MP_RED 65536
#define MP_TOTAL (65536 + 4096)

__device__ void moba_prep_block(const Params& p, LAS unsigned char* lds, int item) {
  const int tid = p.tid, lane = tid & 63, w = tid >> 6;
  const int bh = item >> 4, jb = item & 15, b = bh >> 2, h = bh & 3;
  LAS bf16_t* Vl = (LAS bf16_t*)(lds + MP_VL);
  LAS float* red = (LAS float*)(lds + MP_RED);
  __syncthreads();
#pragma unroll
  for (int it = 0; it < 8; ++it) {
    const int idx = tid + 512 * it, row = idx >> 4, ch = idx & 15;
    const u32x4 v = *(const u32x4*)(p.proj + ((size_t)b * SEQ + 256 * jb + row) * PW + C_MV + h * 128 + 8 * ch);
    *(LAS u32x4*)(Vl + row * 128 + 8 * ch) = v;
  }
  {
    const int r = tid >> 1, hh = tid & 1;
    const int pos = 256 * jb + r;
    const size_t t = (size_t)b * SEQ + pos;
    float cs[8], sn[8];
#pragma unroll
    for (int jj = 0; jj < 8; ++jj) {
      const float inv = exp2f(-(float)(8 * hh + jj) * (1.f / 16.f) * 18.931568569324174f);
      const float ang = (float)pos * inv;
      cs[jj] = cosf(ang); sn[jj] = sinf(ang);
    }
    float kacc[64];
#pragma unroll
    for (int which = 0; which < 2; ++which) {
      const bf16_t* src = p.proj + t * PW + (which ? C_MQ : C_MK) + h * 128 + 8 * hh;
      float x0[8], x1[8];
      unpack8(*(const u32x4*)(src), x0); unpack8(*(const u32x4*)(src + 16), x1);
      float y0[8], y1[8];
#pragma unroll
      for (int jj = 0; jj < 8; ++jj) { y0[jj] = x0[jj] * cs[jj] - x1[jj] * sn[jj]; y1[jj] = x1[jj] * cs[jj] + x0[jj] * sn[jj]; }
      u32x4 o[8];
      o[0].x = pk2(y0[0], y0[1]); o[0].y = pk2(y0[2], y0[3]); o[0].z = pk2(y0[4], y0[5]); o[0].w = pk2(y0[6], y0[7]);
      o[1].x = pk2(y1[0], y1[1]); o[1].y = pk2(y1[2], y1[3]); o[1].z = pk2(y1[4], y1[5]); o[1].w = pk2(y1[6], y1[7]);
#pragma unroll
      for (int ks = 2; ks < 8; ++ks) o[ks] = *(const u32x4*)(src + 16 * ks);
      if (which == 0) {
#pragma unroll
        for (int jj = 0; jj < 8; ++jj) { kacc[jj] = y0[jj]; kacc[8 + jj] = y1[jj]; }
#pragma unroll
        for (int ks = 2; ks < 8; ++ks) { float f[8]; unpack8(o[ks], f);
#pragma unroll
          for (int jj = 0; jj < 8; ++jj) kacc[8 * ks + jj] = f[jj]; }
        unsigned char* dst = (unsigned char*)p.Kp + ((size_t)(bh * 128 + 8 * jb + (r >> 5)) * 8192) + ((r & 31) + 32 * hh) * 16;
#pragma unroll
        for (int ks = 0; ks < 8; ++ks) *(u32x4*)(dst + ks * 1024) = o[ks];
      } else {
        bf16_t* dst = p.qb + ((size_t)bh * SEQ + pos) * 128 + 8 * hh;
#pragma unroll
        for (int ks = 0; ks < 8; ++ks) *(u32x4*)(dst + 16 * ks) = o[ks];
      }
    }
#pragma unroll
    for (int e = 0; e < 64; ++e) {
      float v = kacc[e];
      v += __shfl_xor(v, 2, 64); v += __shfl_xor(v, 4, 64); v += __shfl_xor(v, 8, 64); v += __shfl_xor(v, 16, 64); v += __shfl_xor(v, 32, 64);
      kacc[e] = v;
    }
    if (lane < 2) {
#pragma unroll
      for (int e = 0; e < 64; ++e) red[(w * 2 + lane) * 64 + e] = kacc[e];
    }
  }
  __syncthreads();
  if (tid < 128) {
    const int d = tid, hh = (d >> 3) & 1, ks = d >> 4, jj = d & 7;
    float a = 0.f;
#pragma unroll
    for (int ww = 0; ww < 8; ++ww) a += red[(ww * 2 + hh) * 64 + ks * 8 + jj];
    p.kmean[((size_t)bh * 16 + jb) * 128 + d] = a * (1.f / 256.f);
  }
#pragma unroll
  for (int it = 0; it < 8; ++it) {
    const int o = tid + 512 * it, ln = o & 63, frag = o >> 6, tl = frag >> 3, dt = (frag >> 1) & 3, s = frag & 1;
    const int r = ln & 31, hh = ln >> 5, d = 32 * dt + r;
    unsigned short e[8];
#pragma unroll
    for (int jj = 0; jj < 8; ++jj) { const int key = 32 * tl + 16 * s + 8 * (jj >> 2) + 4 * hh + (jj & 3); e[jj] = Vl[key * 128 + d]; }
    u32x4 wv; wv.x = e[0] | ((unsigned)e[1] << 16); wv.y = e[2] | ((unsigned)e[3] << 16); wv.z = e[4] | ((unsigned)e[5] << 16); wv.w = e[6] | ((unsigned)e[7] << 16);
    *(u32x4*)((unsigned char*)p.Vp + ((size_t)(bh * 128 + 8 * jb + tl) * 8192) + (dt * 2 + s) * 1024 + ln * 16) = wv;
  }
}
__device__ __forceinline__ int crow32(int reg, int hh) { return (reg & 3) + 8 * (reg >> 2) + 4 * hh; }
__device__ void moba_item(const Params& p, LAS float* km, LAS float* mrg, LAS float* ml, int bh, int ib, int sub, int par, int lane) {
  const int q = lane & 31, hh = lane >> 5;
  const int b = bh >> 2, h = bh & 3;
  const int s0 = 256 * ib + 32 * sub;
  const bf16_t* qrow = p.qb + ((size_t)bh * SEQ + s0 + q) * 128 + 8 * hh;
  bf16x8 Qf[8];
#pragma unroll
  for (int ks = 0; ks < 8; ++ks) Qf[ks] = *(const bf16x8*)(qrow + 16 * ks);
  LAS unsigned char* qlds = (LAS unsigned char*)km + 8192 + lane * 16;
#pragma unroll
  for (int ks = 0; ks < 8; ++ks) *(LAS bf16x8*)(qlds + ks * 1024) = Qf[ks];
  unsigned selmask = 0;
  if (ib > 0) {
    for (int idx = lane; idx < ib * 32; idx += 64) ((LAS f32x4*)km)[idx] = ((const f32x4*)(p.kmean + (size_t)bh * 16 * 128))[idx];
    float qf[64];
#pragma unroll
    for (int ks = 0; ks < 8; ++ks) { float f[8]; unpack8(__builtin_bit_cast(u32x4, Qf[ks]), f);
#pragma unroll
      for (int jj = 0; jj < 8; ++jj) qf[8 * ks + jj] = f[jj]; }
    float sc[16];
#pragma unroll
    for (int j = 0; j < 16; ++j) {
      sc[j] = -INFINITY;
      if (j < ib) {
        float a = 0.f;
#pragma unroll
        for (int ks = 0; ks < 8; ++ks) {
          const f32x4 k0 = *(const LAS f32x4*)(km + j * 128 + 16 * ks + 8 * hh), k1 = *(const LAS f32x4*)(km + j * 128 + 16 * ks + 8 * hh + 4);
          a += qf[8 * ks] * k0[0] + qf[8 * ks + 1] * k0[1] + qf[8 * ks + 2] * k0[2] + qf[8 * ks + 3] * k0[3];
          a += qf[8 * ks + 4] * k1[0] + qf[8 * ks + 5] * k1[1] + qf[8 * ks + 6] * k1[2] + qf[8 * ks + 7] * k1[3];
        }
        a += __shfl_xor(a, 32, 64);
        sc[j] = a;
      }
    }
#pragma unroll
    for (int r = 0; r < 3; ++r) {
      if (r < ib) {
        float best = -INFINITY; int bi = 0;
#pragma unroll
        for (int j = 0; j < 16; ++j) if (sc[j] > best) { best = sc[j]; bi = j; }
        selmask |= 1u << bi;
#pragma unroll
        for (int j = 0; j < 16; ++j) if (j == bi) sc[j] = -INFINITY;
      }
    }
  }
  unsigned rem = 0;
  for (int j = 0; j < ib; ++j) if (__ballot((selmask >> j) & 1u) != 0ull) rem |= 1u << j;
  rem = __builtin_amdgcn_readfirstlane(rem);
  const int own0 = 8 * ib, diag = 8 * ib + sub;
  const float cscale = 0.08838834764831845f * 1.4426950408889634f;
  float m = -1e30f, l = 0.f;
  f32x16 O[4];
#pragma unroll
  for (int dt = 0; dt < 4; ++dt)
#pragma unroll
    for (int r = 0; r < 16; ++r) O[dt][r] = 0.f;
  const unsigned char* kbase = (const unsigned char*)p.Kp + (size_t)bh * 128 * 8192 + lane * 16;
  const unsigned char* vbase = (const unsigned char*)p.Vp + (size_t)bh * 128 * 8192 + lane * 16;
  auto adv = [&](int& kt_, unsigned& rem_) {
    if (kt_ < 0) return;
    if (kt_ >= own0 ? (kt_ < diag) : ((kt_ & 7) != 7)) { kt_ = kt_ + 1; return; }
    if (rem_ == 0u) { kt_ = -1; return; }
    kt_ = 8 * (__builtin_ctz(rem_)); rem_ &= rem_ - 1u;
  };
  int kt = own0;
  if (par) adv(kt, rem);
  LAS unsigned char* kl = (LAS unsigned char*)km;
  auto issue_K = [&](int t) {
#pragma unroll
    for (int ks = 0; ks < 8; ++ks) __builtin_amdgcn_global_load_lds((const unsigned*)(kbase + (size_t)t * 8192 + ks * 1024), (LAS unsigned*)(kl + ks * 1024), 16, 0, 0);
  };
  asm volatile("s_waitcnt lgkmcnt(0)" ::: "memory");
  if (kt >= 0) issue_K(kt);
#pragma unroll 1
  while (kt >= 0) {
    int ktn = kt; unsigned remn = rem;
    adv(ktn, remn); adv(ktn, remn);
    asm volatile("s_waitcnt vmcnt(0)" ::: "memory");
    bf16x8 Kc[8], Vf[8];
#pragma unroll
    for (int ks = 0; ks < 8; ++ks) Kc[ks] = *(const LAS bf16x8*)(kl + lane * 16 + ks * 1024);
#pragma unroll
    for (int f = 0; f < 8; ++f) Vf[f] = *(const bf16x8*)(vbase + (size_t)kt * 8192 + f * 1024);
    asm volatile("s_waitcnt lgkmcnt(0)" ::: "memory");
    if (ktn >= 0) issue_K(ktn);
    f32x16 S;
#pragma unroll
    for (int r = 0; r < 16; ++r) S[r] = 0.f;
#pragma unroll
    for (int ks = 0; ks < 8; ++ks) S = MFMA32(Kc[ks], *(const LAS bf16x8*)(qlds + ks * 1024), S);
    const bool allowed = (kt >= own0) || ((selmask >> (kt >> 3)) & 1u);
    const float nb = allowed ? 0.f : -INFINITY;
    float sv[16]; float mx = -INFINITY;
#pragma unroll
    for (int r = 0; r < 16; ++r) sv[r] = __builtin_fmaf(S[r], cscale, nb);
    if (kt == diag) {
#pragma unroll
      for (int r = 0; r < 16; ++r) if (crow32(r, hh) > q) sv[r] = -INFINITY;
    }
#pragma unroll
    for (int r = 0; r < 16; ++r) mx = fmaxf(mx, sv[r]);
    mx = fmaxf(mx, __shfl_xor(mx, 32, 64));
    const float mn = fmaxf(m, mx);
    const float alpha = __builtin_amdgcn_exp2f(m - mn);
    float ps = 0.f;
#pragma unroll
    for (int r = 0; r < 16; ++r) { sv[r] = __builtin_amdgcn_exp2f(sv[r] - mn); ps += sv[r]; }
    l = l * alpha + ps; m = mn;
    if (__ballot(alpha != 1.f) != 0ull) {
#pragma unroll
      for (int dt = 0; dt < 4; ++dt)
#pragma unroll
        for (int r = 0; r < 16; ++r) O[dt][r] *= alpha;
    }
    const bf16x8 P0 = pack8(sv[0], sv[1], sv[2], sv[3], sv[4], sv[5], sv[6], sv[7]);
    const bf16x8 P1 = pack8(sv[8], sv[9], sv[10], sv[11], sv[12], sv[13], sv[14], sv[15]);
#pragma unroll
    for (int dt = 0; dt < 4; ++dt) { O[dt] = MFMA32(Vf[dt * 2], P0, O[dt]); O[dt] = MFMA32(Vf[dt * 2 + 1], P1, O[dt]); }
    kt = ktn; rem = remn;
  }
  asm volatile("s_waitcnt vmcnt(0) lgkmcnt(0)" ::: "memory");
  if (par) {
    ml[lane] = m; ml[64 + lane] = l;
#pragma unroll
    for (int dt = 0; dt < 4; ++dt)
#pragma unroll
      for (int r = 0; r < 16; ++r) mrg[(dt * 16 + r) * 64 + lane] = O[dt][r];
  }
  __syncthreads();
  if (par == 0) {
    const float m2 = ml[lane], l2 = ml[64 + lane];
    const float mm = fmaxf(m, m2);
    const float a1 = __builtin_amdgcn_exp2f(m - mm), a2 = __builtin_amdgcn_exp2f(m2 - mm);
    l = l * a1 + l2 * a2;
#pragma unroll
    for (int dt = 0; dt < 4; ++dt)
#pragma unroll
      for (int r = 0; r < 16; ++r) O[dt][r] = O[dt][r] * a1 + mrg[(dt * 16 + r) * 64 + lane] * a2;
  }
  if (par == 0) {
  l += __shfl_xor(l, 32, 64);
  const float inv = 1.f / l;
  bf16_t* orow = p.mb_out + ((size_t)b * SEQ + s0 + q) * p.mb_out_ld + p.mb_out_off + h * 128;
#pragma unroll
  for (int dt = 0; dt < 4; ++dt)
#pragma unroll
    for (int g4 = 0; g4 < 4; ++g4) {
      u32x2 wv; wv.x = pk2(O[dt][4 * g4] * inv, O[dt][4 * g4 + 1] * inv); wv.y = pk2(O[dt][4 * g4 + 2] * inv, O[dt][4 * g4 + 3] * inv);
      *(u32x2*)(orow + 32 * dt + 8 * g4 + 4 * hh) = wv;
    }
  }
  __syncthreads();
}
__device__ void moba_worker(const Params& p, LAS unsigned char* lds, int qi) {
  const int lane = p.tid & 63, w = __builtin_amdgcn_readfirstlane(p.tid >> 6);
  LAS float* km = (LAS float*)(lds + w * 16384);
  LAS float* mrg = (LAS float*)(lds + ((w & 3) + 4) * 16384);
  LAS float* ml = (LAS float*)(lds + 131072) + (w & 3) * 128;
  LAS int* slot = (LAS int*)(lds + 131072 + 2048);
  const int g = blockIdx.x & 7;
  for (;;) {
    __syncthreads();
    if (p.tid == 0) slot[0] = atomicAdd(p.wq + qi * 8 + g, 1);
    __syncthreads();
    const int idx = slot[0];
    if (idx >= 64) break;
    const int ib = 15 - (idx >> 2), bh = 2 * g + ((idx >> 1) & 1), quad = 1 - (idx & 1);
    moba_item(p, km, mrg, ml, bh, ib, 4 * quad + (w & 3), w >> 2, lane);
  }
}
__device__ void ph_mod(const Params& p, LAS unsigned char* lds, int nblk, int bid) {
  LAS float* sc = (LAS float*)lds;
  LAS float* part = (LAS float*)(lds + 16384);
  const int tid = p.tid;
  if (bid >= 192) return;
  for (int i = tid; i < 4096; i += 512) sc[i] = siluf_(p.c[i]);
  __syncthreads();
  for (int task = bid; task < 192; task += nblk) {
    const int jj = tid & 31, ks = tid >> 5, j = task * 32 + jj;
    float a0 = 0.f, a1 = 0.f, a2 = 0.f, a3 = 0.f;
#pragma unroll 8
    for (int kk = 0; kk < 64; ++kk) {
      const int k = ks * 64 + kk;
      const float w = p.w_ada[(size_t)k * 6144 + j];
      a0 += sc[k] * w; a1 += sc[1024 + k] * w; a2 += sc[2048 + k] * w; a3 += sc[3072 + k] * w;
    }
    *(LAS f32x4*)(part + (ks * 32 + jj) * 4) = (f32x4){a0, a1, a2, a3};
    __syncthreads();
    if (tid < 128) {
      const int j2 = tid & 31, bb = tid >> 5;
      float a = 0.f;
#pragma unroll
      for (int s = 0; s < 16; ++s) a += part[(s * 32 + j2) * 4 + bb];
      p.mod[bb * 6144 + task * 32 + j2] = a + p.b_ada[task * 32 + j2];
    }
    __syncthreads();
  }
}

#define WT_T0 1424
#define WT_T1 (WT_T0 + 16384)
#define WT_T2 (WT_T1 + 8192)
#define WT_T3 (WT_T2 + 128)
#define WT_T4 (WT_T3 + 128)
#define WT_T5 (WT_T4 + 256)
struct WtTile { const float* src; bf16_t* dst; int K, N, mode, k0, n0; };
__device__ __forceinline__ WtTile wt_desc(const Params& p, int t) {
  WtTile d;
  if (t < WT_T0) { const int kt = t / 89, nt = t % 89; d = {p.w_in, p.w_in_t, 1024, INW, 1, kt * 64, nt * 64}; }
  else if (t < WT_T1) { const int u = t - WT_T0, e = u >> 9, r = u & 511, kt = r >> 5, nt = r & 31; d = {p.w_gu + (size_t)e * 1024 * 2048, p.wgu_t + (size_t)e * 2048 * 1024, 1024, 2048, 2, kt * 64, nt * 64}; }
  else if (t < WT_T2) { const int u = t - WT_T1, e = u >> 8, r = u & 255, kt = r >> 4, nt = r & 15; d = {p.w_down + (size_t)e * 1024 * 1024, p.wd_t + (size_t)e * 1024 * 1024, 1024, 1024, 0, kt * 64, nt * 64}; }
  else if (t < WT_T3) { const int u = t - WT_T2, kt = u >> 4, nt = u & 15; d = {p.w_br_a, p.wbra_t, 512, 1024, 0, kt * 64, nt * 64}; }
  else if (t < WT_T4) { const int u = t - WT_T3, kt = u >> 4, nt = u & 15; d = {p.w_br_b, p.wbrb_t, 512, 1024, 0, kt * 64, nt * 64}; }
  else { const int u = t - WT_T4, kt = u >> 4, nt = u & 15; d = {p.w_o, p.wo_t, 1024, 1024, 0, kt * 64, nt * 64}; }
  return d;
}
__device__ __forceinline__ void wt_load(const WtTile& d, int tid, f32x4 (&v)[2]) {
#pragma unroll
  for (int it = 0; it < 2; ++it) {
    const int row = (tid >> 4) + 32 * it, n = d.n0 + (tid & 15) * 4;
    v[it] = (f32x4){0.f, 0.f, 0.f, 0.f};
    if (n < d.N) v[it] = __builtin_nontemporal_load((const f32x4*)(d.src + (size_t)(d.k0 + row) * d.N + n));
  }
}
__device__ void ph_wt(const Params& p, LAS unsigned char* lds, int nblk, int bid) {
  LAS float* tile = (LAS float*)(lds + 32768);
  const int tid = p.tid;
  int t = bid;
  if (t >= WT_T5) return;
  WtTile cur = wt_desc(p, t);
  f32x4 v[2]; wt_load(cur, tid, v);
  for (;;) {
    const int tn = t + nblk;
    WtTile nxt = cur; f32x4 vn[2];
    if (tn < WT_T5) { nxt = wt_desc(p, tn); wt_load(nxt, tid, vn); }
#pragma unroll
    for (int it = 0; it < 2; ++it) {
      const int row = (tid >> 4) + 32 * it, c4 = (tid & 15) * 4;
      tile[row * 65 + c4] = v[it][0]; tile[row * 65 + c4 + 1] = v[it][1]; tile[row * 65 + c4 + 2] = v[it][2]; tile[row * 65 + c4 + 3] = v[it][3];
    }
    __syncthreads();
    {
      const int nl = tid >> 3, kc = tid & 7, n = cur.n0 + nl;
      if (n < cur.N) {
        const int dd = map_col(n, cur.mode);
        if (dd >= 0) {
          float f[8];
#pragma unroll
          for (int j = 0; j < 8; ++j) f[j] = tile[(8 * kc + j) * 65 + nl];
          u32x4 w; w.x = pk2(f[0], f[1]); w.y = pk2(f[2], f[3]); w.z = pk2(f[4], f[5]); w.w = pk2(f[6], f[7]);
          *(u32x4*)(cur.dst + (size_t)dd * cur.K + cur.k0 + 8 * kc) = w;
        }
      }
    }
    __syncthreads();
    if (tn >= WT_T5) break;
    t = tn; cur = nxt; v[0] = vn[0]; v[1] = vn[1];
  }
}

__device__ void ph_h(const Params& p, LAS unsigned char* lds, int nblk, int bid) {
  const int wid = p.tid >> 6, lane = p.tid & 63;
  LAS float* wb = (LAS float*)lds;
  for (int i = p.tid; i < 2048; i += 512) {
    const int k = i >> 1, hf = i & 1;
    const f32x4 v = *(const f32x4*)(p.w_in + (size_t)k * INW + 2048 + 4 * hf);
    wb[(4 * hf + 0) * 1024 + k] = v[0]; wb[(4 * hf + 1) * 1024 + k] = v[1]; wb[(4 * hf + 2) * 1024 + k] = v[2]; wb[(4 * hf + 3) * 1024 + k] = v[3];
  }
  __syncthreads();
  for (int t = bid * 8 + wid; t < T_TOK; t += nblk * 8) {
    const int b = t / SEQ;
    const float* xr = p.x + (size_t)t * DM;
    f32x4 xv[4];
    float ss = 0.f;
#pragma unroll
    for (int i = 0; i < 4; ++i) {
      xv[i] = *(const f32x4*)(xr + i * 256 + lane * 4);
      ss += xv[i][0] * xv[i][0] + xv[i][1] * xv[i][1] + xv[i][2] * xv[i][2] + xv[i][3] * xv[i][3];
    }
    ss = wave_sum(ss);
    const float rstd = rsqrtf(ss * (1.f / DM) + 1e-6f);
    const float* shift = p.mod + b * 6144;
    const float* scale = p.mod + b * 6144 + 1024;
    float acc[8] = {0, 0, 0, 0, 0, 0, 0, 0};
#pragma unroll
    for (int i = 0; i < 4; ++i) {
      const int k = i * 256 + lane * 4;
      const f32x4 g = *(const f32x4*)(p.g_pre_mix + k), sc = *(const f32x4*)(scale + k), sh = *(const f32x4*)(shift + k);
      f32x4 hv;
#pragma unroll
      for (int j = 0; j < 4; ++j) hv[j] = xv[i][j] * rstd * g[j] * (1.f + sc[j]) + sh[j];
#pragma unroll
      for (int e = 0; e < 8; ++e) { const f32x4 w = *(const LAS f32x4*)(wb + e * 1024 + k); acc[e] += hv[0] * w[0] + hv[1] * w[1] + hv[2] * w[2] + hv[3] * w[3]; }
      u32x2 pk; pk.x = pk2(hv[0], hv[1]); pk.y = pk2(hv[2], hv[3]);
      *(u32x2*)(p.hbf + (size_t)t * DM + k) = pk;
    }
#pragma unroll
    for (int e = 0; e < 8; ++e) acc[e] = wave_sum(acc[e]);
    if (lane == 0) { *(f32x4*)(p.ba + (size_t)t * 8) = (f32x4){acc[0], acc[1], acc[2], acc[3]}; *(f32x4*)(p.ba + (size_t)t * 8 + 4) = (f32x4){acc[4], acc[5], acc[6], acc[7]}; }
  }
}

__device__ void ph_post_mix(const Params& p, LAS unsigned char* lds, int nblk, int bid, int rep) {
  const int wid = p.tid >> 6, lane = p.tid & 63;
  LAS bf16_t* wl = (LAS bf16_t*)lds;
  LAS float* sh = (LAS float*)(lds + 81920) + wid * 1024;
  LAS int* lcnt = (LAS int*)(lds + 114688);
  LAS int* lbase = lcnt + 32;
  LAS int* lent = (LAS int*)(lds + 115200) + wid * 256;
  int nloc = 0;
  if (p.tid < 32) lcnt[p.tid] = 0;
  for (int i = p.tid; i < 1024 * 8; i += 512) {
    const int k = i >> 3, c = i & 7;
    const f32x4 v = *(const f32x4*)(p.w_router + (size_t)k * 32 + c * 4);
    u32x2 w2; w2.x = pk2(v[0], v[1]); w2.y = pk2(v[2], v[3]);
    *(LAS u32x2*)(wl + k * 40 + c * 4) = w2;
  }
  __syncthreads();
  for (int t = bid * 8 + wid; t < T_TOK; t += nblk * 8) {
    const int b = t / SEQ;
    const float* md = p.mod + b * 6144;
    float mv[16];
    float ss = 0.f;
#pragma unroll
    for (int i = 0; i < 2; ++i) {
      float f[8]; unpack8(*(const u32x4*)(p.mixer + (size_t)t * DM + i * 512 + lane * 8), f);
#pragma unroll
      for (int j = 0; j < 8; ++j) { mv[i * 8 + j] = f[j]; ss += f[j] * f[j]; }
    }
    ss = wave_sum(ss);
    const float rstd = rsqrtf(ss * (1.f / DM) + 1e-6f);
    float x1[16];
    float s2 = 0.f;
#pragma unroll
    for (int i = 0; i < 2; ++i)
#pragma unroll
      for (int j4 = 0; j4 < 2; ++j4) {
        const int k = i * 512 + lane * 8 + j4 * 4;
        const f32x4 xv = *(const f32x4*)(p.x + (size_t)t * DM + k);
        const f32x4 gm = *(const f32x4*)(md + 2048 + k), gp = *(const f32x4*)(p.g_post_mix + k);
        f32x4 o;
#pragma unroll
        for (int j = 0; j < 4; ++j) { o[j] = xv[j] + gm[j] * (mv[i * 8 + j4 * 4 + j] * rstd * gp[j]); x1[i * 8 + j4 * 4 + j] = o[j]; s2 += o[j] * o[j]; }
        *(f32x4*)(p.out + (size_t)t * DM + k) = o;
      }
    s2 = wave_sum(s2);
    const float rstd2 = rsqrtf(s2 * (1.f / DM) + 1e-6f);
#pragma unroll
    for (int i = 0; i < 2; ++i) {
      float hv[8];
#pragma unroll
      for (int j = 0; j < 8; ++j) {
        const int k = i * 512 + lane * 8 + j;
        hv[j] = x1[i * 8 + j] * rstd2 * p.g_pre_ffn[k] * (1.f + md[4096 + k]) + md[3072 + k];
        sh[k] = hv[j];
      }
      u32x4 w; w.x = pk2(hv[0], hv[1]); w.y = pk2(hv[2], hv[3]); w.z = pk2(hv[4], hv[5]); w.w = pk2(hv[6], hv[7]);
      *(u32x4*)(p.h2 + (size_t)t * DM + i * 512 + lane * 8) = w;
    }
#ifdef PM_SKIP
    if (rep) continue;
#endif
    float acc[32];
#pragma unroll
    for (int e2 = 0; e2 < 32; ++e2) acc[e2] = 0.f;
#pragma unroll 4
    for (int i = 0; i < 16; ++i) {
      const float hk = sh[lane + 64 * i];
      const LAS u32x4* wr = (const LAS u32x4*)(wl + (lane + 64 * i) * 40);
#pragma unroll
      for (int c4 = 0; c4 < 4; ++c4) {
        float f[8]; unpack8(wr[c4], f);
#pragma unroll
        for (int j = 0; j < 8; ++j) acc[c4 * 8 + j] += hk * f[j];
      }
    }
    {
      const bool u5 = lane & 32, u4 = lane & 16, u3 = lane & 8, u2 = lane & 4, u1 = lane & 2;
      float a16[16], a8[8], a4[4], a2[2];
#pragma unroll
      for (int j = 0; j < 16; ++j) { const float snd = u5 ? acc[j] : acc[16 + j]; const float rcv = __shfl_xor(snd, 32, 64); a16[j] = (u5 ? acc[16 + j] : acc[j]) + rcv; }
#pragma unroll
      for (int j = 0; j < 8; ++j) { const float snd = u4 ? a16[j] : a16[8 + j]; const float rcv = __shfl_xor(snd, 16, 64); a8[j] = (u4 ? a16[8 + j] : a16[j]) + rcv; }
#pragma unroll
      for (int j = 0; j < 4; ++j) { const float snd = u3 ? a8[j] : a8[4 + j]; const float rcv = __shfl_xor(snd, 8, 64); a4[j] = (u3 ? a8[4 + j] : a8[j]) + rcv; }
#pragma unroll
      for (int j = 0; j < 2; ++j) { const float snd = u2 ? a4[j] : a4[2 + j]; const float rcv = __shfl_xor(snd, 4, 64); a2[j] = (u2 ? a4[2 + j] : a4[j]) + rcv; }
      const float snd = u1 ? a2[0] : a2[1]; const float rcv = __shfl_xor(snd, 2, 64);
      float a1 = (u1 ? a2[1] : a2[0]) + rcv;
      a1 += __shfl_xor(a1, 1, 64);
      acc[0] = a1;
    }
    const int e = lane >> 1;
    float lg = acc[0] + p.b_router[e];
    if (lane & 1) lg = -INFINITY;
    float tv[4]; int ti[4];
#pragma unroll
    for (int r = 0; r < 4; ++r) {
      const float m = wave_max(lg);
      const unsigned long long bal = __ballot(lg == m);
      const int idx = __ffsll((long long)bal) - 1;
      tv[r] = m; ti[r] = idx >> 1;
      if (lane == idx) lg = -INFINITY;
    }
    const float e1 = __expf(tv[1] - tv[0]), e2 = __expf(tv[2] - tv[0]), e3 = __expf(tv[3] - tv[0]);
    const float inv = 1.f / (1.f + e1 + e2 + e3);
    if (lane < 4) {
      const int ee = lane == 0 ? ti[0] : lane == 1 ? ti[1] : lane == 2 ? ti[2] : ti[3];
      const float ww = (lane == 0 ? 1.f : lane == 1 ? e1 : lane == 2 ? e2 : e3) * inv;
      p.aw[t * 4 + lane] = ww;
      const int rank = __hip_atomic_fetch_add(&lcnt[ee], 1, __ATOMIC_RELAXED, __HIP_MEMORY_SCOPE_WORKGROUP);
      lent[nloc * 4 + lane] = (ee << 16) | rank;
      lent[nloc * 4 + lane + 2048] = t * 4 + lane;
    }
    ++nloc;
  }
  __syncthreads();
  if (p.tid < 32) lbase[p.tid] = atomicAdd(&p.cnt[p.tid * 64 + 32 * rep], lcnt[p.tid]);
  __syncthreads();
  for (int i = lane; i < nloc * 4; i += 64) {
    const int er = lent[i], a = lent[i + 2048];
    p.elist[(er >> 16) * T_TOK + lbase[er >> 16] + (er & 0xffff)] = a;
  }
}

__device__ void ph_gather(const Params& p, LAS unsigned char* lds, int nblk, int bid) {
  const int wid = p.tid >> 6, lane = p.tid & 63;
  LAS int* tb = (LAS int*)lds;
  if (p.tid == 0) { int off = 0; for (int k = 0; k < NE; ++k) { const int c = p.cnt[k * 64]; tb[k] = off; tb[64 + k] = c; off += ((c + 255) >> 8) << 8; } tb[NE] = off; }
  __syncthreads();
  const int total = tb[NE];
  for (int r = bid * 8 + wid; r < total; r += nblk * 8) {
    int e = 0;
#pragma unroll 1
    for (int k = 1; k < NE; ++k) if (r >= tb[k]) e = k;
    const int i = r - tb[e];
    const int a = (i < tb[64 + e]) ? p.elist[e * T_TOK + i] : -1;
    if (lane == 0) p.rowmap[r] = a;
    u32x4 v0 = {0, 0, 0, 0}, v1 = v0;
    if (a >= 0) { const u32x4* src = (const u32x4*)(p.h2 + (size_t)(a >> 2) * DM); v0 = src[lane]; v1 = src[64 + lane]; }
    u32x4* dst = (u32x4*)(p.xs + (size_t)r * DM);
    dst[lane] = v0; dst[64 + lane] = v1;
  }
}

__device__ void ph_final(const Params& p, int nblk, int bid, int rep) {
  const int wid = p.tid >> 6, lane = p.tid & 63;
  for (int t0 = bid * 8 + wid; t0 < T_TOK; t0 += nblk * 16) {
    int tt[2] = {t0, t0 + nblk * 8};
    if (tt[1] >= T_TOK) tt[1] = t0;
    float mv[2][16]; float ss[2];
#pragma unroll
    for (int u = 0; u < 2; ++u) {
      const int t = tt[u];
      const f32x4 wv = *(const f32x4*)(p.aw + t * 4);
      ss[u] = 0.f;
#pragma unroll
      for (int i = 0; i < 2; ++i) {
        const bf16_t* y = p.yslot + (size_t)t * 4 * DM + i * 512 + lane * 8;
        float f0[8], f1[8], f2[8], f3[8];
        unpack8(*(const u32x4*)y, f0); unpack8(*(const u32x4*)(y + DM), f1); unpack8(*(const u32x4*)(y + 2 * DM), f2); unpack8(*(const u32x4*)(y + 3 * DM), f3);
#pragma unroll
        for (int j = 0; j < 8; ++j) { const float m = wv[0] * f0[j] + wv[1] * f1[j] + wv[2] * f2[j] + wv[3] * f3[j]; mv[u][i * 8 + j] = m; ss[u] += m * m; }
      }
    }
    f32x4 x1[2][4];
#pragma unroll
    for (int u = 0; u < 2; ++u)
#pragma unroll
      for (int i = 0; i < 2; ++i)
#pragma unroll
        for (int j4 = 0; j4 < 2; ++j4) x1[u][i * 2 + j4] = *(const f32x4*)(p.out + (size_t)tt[u] * DM + i * 512 + lane * 8 + j4 * 4);
    ss[0] = wave_sum(ss[0]); ss[1] = wave_sum(ss[1]);
#pragma unroll
    for (int u = 0; u < 2; ++u) {
      const int t = tt[u];
      if (u == 1 && t == t0) break;
      const float* md = p.mod + (t / SEQ) * 6144;
      const float rstd = rsqrtf(ss[u] * (1.f / DM) + 1e-6f);
#pragma unroll
      for (int i = 0; i < 2; ++i)
#pragma unroll
        for (int j4 = 0; j4 < 2; ++j4) {
          const int k = i * 512 + lane * 8 + j4 * 4;
          float* op = p.out + (size_t)t * DM + k;
          const f32x4 gf = *(const f32x4*)(md + 5120 + k), gp = *(const f32x4*)(p.g_post_ffn + k);
          f32x4 o;
#pragma unroll
          for (int j = 0; j < 4; ++j) o[j] = x1[u][i * 2 + j4][j] + gf[j] * (mv[u][i * 8 + j4 * 4 + j] * rstd * gp[j]);
          *(f32x4*)(rep ? (float*)p.hbf + (size_t)(t & 8191) * DM + k : op) = o;
        }
    }
  }
}

#define XCD_BAR_WORDS 3456
struct KArgs { const void* in[22]; float* out; char* ws; long long never; };
__host__ __device__ inline size_t al(size_t x) { return (x + 255) & ~(size_t)255; }
__host__ __device__ inline void fill_params(Params& p, const KArgs& k) {
  p.x = (const float*)k.in[0]; p.c = (const float*)k.in[1]; p.w_ada = (const float*)k.in[2]; p.b_ada = (const float*)k.in[3];
  p.g_pre_mix = (const float*)k.in[4]; p.g_post_mix = (const float*)k.in[5]; p.g_pre_ffn = (const float*)k.in[6];
  p.g_post_ffn = (const float*)k.in[7]; p.w_in = (const float*)k.in[8]; p.conv_w = (const float*)k.in[9];
  p.a_log = (const float*)k.in[10]; p.dt_bias = (const float*)k.in[11]; p.g_dn_out = (const float*)k.in[12];
  p.w_br_a = (const float*)k.in[13]; p.w_br_b = (const float*)k.in[14]; p.w_o = (const float*)k.in[15];
  p.w_router = (const float*)k.in[16]; p.b_router = (const float*)k.in[17]; p.w_gu = (const float*)k.in[18];
  p.b_gu = (const float*)k.in[19]; p.w_down = (const float*)k.in[20]; p.b_down = (const float*)k.in[21];
  p.out = k.out;
  char* w = k.ws;
  size_t o = 0;
#define take(bytes) (w + (o += al(bytes)) - al(bytes))
  p.mod = (float*)take(4 * 6144 * 4);
  p.cnt = (int*)take(16384);
  p.ba = (float*)take((size_t)T_TOK * 8 * 4);
  p.hbf = (bf16_t*)take((size_t)T_TOK * DM * 2);
  p.proj = (bf16_t*)take((size_t)T_TOK * PW * 2);
  p.w_in_t = (bf16_t*)take((size_t)PW * DM * 2);
  p.wgu_t = (bf16_t*)take((size_t)NE * 2048 * DM * 2);
  p.wd_t = (bf16_t*)take((size_t)NE * 1024 * DM * 2);
  p.wbra_t = (bf16_t*)take((size_t)1024 * 512 * 2);
  p.wbrb_t = (bf16_t*)take((size_t)1024 * 512 * 2);
  p.wo_t = (bf16_t*)take((size_t)1024 * 1024 * 2);
  p.qb = (bf16_t*)take((size_t)T_TOK * 512 * 2);
  p.kb = (bf16_t*)take((size_t)T_TOK * 512 * 2);
  p.kmean = (float*)take((size_t)16 * 16 * 128 * 4);
  p.oab = (bf16_t*)take((size_t)T_TOK * DM * 2);
  p.merged = (bf16_t*)take((size_t)T_TOK * DM * 2);
  p.mixer = (bf16_t*)take((size_t)T_TOK * DM * 2);
  p.h2 = (bf16_t*)take((size_t)T_TOK * DM * 2);
  p.elist = (int*)take((size_t)NE * T_TOK * 4);
  p.aw = (float*)take((size_t)T_TOK * 4 * 4);
  p.rowmap = (int*)take((size_t)73728 * 4);
  p.dnA = (unsigned char*)take((size_t)1024 * DN_ABYTES);
  p.dnU = (float*)take((size_t)1024 * DN_UFLOATS * 4);
  p.dnG = (float*)take(4096);
  p.oab2 = (bf16_t*)take((size_t)T_TOK * 512 * 2);
  p.dbg = (float*)take(256);
  p.bar = (unsigned*)take(XCD_BAR_WORDS * 4);
  p.dn_out = p.oab; p.dn_out_ld = DM;
  p.Kp = (bf16_t*)take((size_t)16 * 128 * 8192);
  p.Vp = (bf16_t*)take((size_t)16 * 128 * 8192);
  p.wq = p.cnt + 32 * 64;
  p.mb_out = p.oab; p.mb_out_ld = DM; p.mb_out_off = 512;
  p.xs = p.proj;
  char* big = take((size_t)73728 * DM * 2 + (size_t)65536 * DM * 2);
  p.act = (bf16_t*)big;
  p.yslot = (bf16_t*)(big + (size_t)73728 * DM * 2);
  {
    char* s = big; size_t so = 0;
#define t2(bytes) (s + (so += al(bytes)) - al(bytes))
    p.nq = (float*)t2((size_t)T_TOK * 512 * 4);
    p.nk = (float*)t2((size_t)T_TOK * 512 * 4);
    p.nv = (float*)t2((size_t)T_TOK * 512 * 4);
    p.no = (float*)t2((size_t)T_TOK * 512 * 4);
    p.ntmp = (float*)t2((size_t)T_TOK * DM * 4);
    p.nbeta = (float*)t2((size_t)T_TOK * 4 * 4);
    p.ng = (float*)t2((size_t)T_TOK * 4 * 4);
  }

#undef take
#undef t2
  p.never = (int)k.never;
}

#define XB_TMO      128
#define XB_XCNT(j)  (256  + 64 * (j))
#define XB_XSUB(j)  (1280 + 64 * (j))
#define XB_XGEN(j)  (2304 + 64 * (j))
#define XB_TOP      3328
#define XB_TOPGEN   3392
#define XB_SPIN_CAP (1u << 18)

__device__ __forceinline__ unsigned xb_ld(unsigned* p)              { return __hip_atomic_load(p, __ATOMIC_RELAXED, __HIP_MEMORY_SCOPE_AGENT); }
__device__ __forceinline__ unsigned xb_add(unsigned* p, unsigned v) { return __hip_atomic_fetch_add(p, v, __ATOMIC_RELAXED, __HIP_MEMORY_SCOPE_AGENT); }
__device__ __forceinline__ unsigned xb_xcc_id() { return (unsigned)__builtin_amdgcn_s_getreg((3 << 11) | 20) & 0xFu; }
#define XB_SPIN(cond, bar) do { unsigned _sp = 0; while (cond) { __builtin_amdgcn_s_sleep(1); \
    if ((++_sp & 255u) == 0u) { if (xb_ld(&(bar)[XB_TMO])) break; if (_sp > XB_SPIN_CAP) { atomicAdd(&(bar)[XB_TMO], 1u); break; } } } } while (0)

struct XcdBarrier {
    unsigned* bar; unsigned x;
    volatile LAS unsigned* st;
};

__device__ __forceinline__ XcdBarrier xcd_barrier_post(unsigned* bar, volatile LAS unsigned* st) {
    XcdBarrier b; b.bar = bar; b.x = xb_xcc_id(); b.st = st;
    if (threadIdx.x == 0) (void)xb_add(&bar[XB_XCNT(b.x)], 1u);
    return b;
}
__device__ __forceinline__ void xcd_barrier_complete(unsigned* bar, unsigned x, unsigned& nloc, unsigned& nx) {
    const unsigned G = gridDim.x * gridDim.y * gridDim.z;
    unsigned sum, cnt, mine, sp = 0u;
    for (;;) {
        sum = 0u; cnt = 0u; mine = 0u;
#pragma unroll
        for (unsigned j = 0; j < 16; ++j) { const unsigned c = xb_ld(&bar[XB_XCNT(j)]); sum += c; cnt += (c > 0u) ? 1u : 0u; mine = (j == x) ? c : mine; }
        if (sum == G) break;
        __builtin_amdgcn_s_sleep(1);
        if ((++sp & 255u) == 0u) { if (xb_ld(&bar[XB_TMO])) break; if (sp > XB_SPIN_CAP) { atomicAdd(&bar[XB_TMO], 1u); break; } }
    }
    nloc = mine > 0u ? mine : 1u; nx = cnt > 0u ? cnt : 1u;
}

__device__ __forceinline__ void xcd_barrier(const XcdBarrier& b, const int tid) {
    asm volatile("s_waitcnt vmcnt(0)" ::: "memory");
    __syncthreads();
    if (tid == 0) {
        unsigned* bar = b.bar;
        __builtin_amdgcn_s_waitcnt(0);
        unsigned nloc = b.st[0], nx = b.st[1];
        if (nloc == 0u) { xcd_barrier_complete(bar, b.x, nloc, nx); b.st[0] = nloc; b.st[1] = nx; }
        const unsigned old = xb_add(&bar[XB_XSUB(b.x)], 1u);
        const unsigned gen = old / nloc;
        if (old + 1u == (gen + 1u) * nloc) {
            __builtin_amdgcn_fence(__ATOMIC_RELEASE, "agent");
            asm volatile("s_waitcnt vmcnt(0)" ::: "memory");
            const unsigned og = xb_add(&bar[XB_TOP], 1u);
            const unsigned tg = og / nx;
            if (og + 1u == (tg + 1u) * nx) xb_add(&bar[XB_TOPGEN], 1u);
            else XB_SPIN(xb_ld(&bar[XB_TOPGEN]) == tg, bar);
            __builtin_amdgcn_fence(__ATOMIC_ACQUIRE, "agent");
            xb_add(&bar[XB_XGEN(b.x)], 1u);
            asm volatile("s_waitcnt vmcnt(0)" ::: "memory");
        } else {
            XB_SPIN(xb_ld(&bar[XB_XGEN(b.x)]) == gen, bar);
            __builtin_amdgcn_fence(__ATOMIC_ACQUIRE, "agent");
            asm volatile("s_waitcnt vmcnt(0)" ::: "memory");
        }
    }
    __syncthreads();
}


__device__ __forceinline__ void load_ka(KArgs& kk) {
#if defined(__HIP_DEVICE_COMPILE__)
  typedef __attribute__((address_space(1))) char* gptr_t;
  typedef const __attribute__((address_space(4))) gptr_t* kptr_t;
  kptr_t kp = (kptr_t)__builtin_amdgcn_kernarg_segment_ptr();
  asm volatile("" : "+s"(kp));
#pragma unroll
  for (int i = 0; i < 22; ++i) kk.in[i] = (const void*)kp[i];
  kk.out = (float*)kp[22];
  kk.ws = (char*)kp[23];
  kk.never = ((const __attribute__((address_space(4))) long long*)kp)[24];
#endif
}
__device__ __forceinline__ void grid_bar(const Params& p, LAS unsigned char* lds);
#define MEGA_LDS 148480
#define MEGA_LDS_ALLOC (MEGA_LDS + 16)
__device__ __forceinline__ void grid_bar(const Params& p, LAS unsigned char* lds) {
  XcdBarrier b; b.bar = p.bar; b.x = xb_xcc_id(); b.st = (volatile LAS unsigned*)(lds + MEGA_LDS);
  xcd_barrier(b, p.tid);
}
__global__ __launch_bounds__(512) void mega(KArgs ka) {
  extern __shared__ __attribute__((aligned(16))) unsigned char shm[];
  LAS unsigned char* lds = (LAS unsigned char*)shm;
  cg::grid_group grid = cg::this_grid();
  const int nblk = gridDim.x, bid = blockIdx.x;
  volatile LAS unsigned* xst = (volatile LAS unsigned*)(lds + MEGA_LDS);
  if (threadIdx.x == 0) { xst[0] = 0u; xst[1] = 0u; xst[2] = 0u; xst[3] = 0u; }
  __syncthreads();
  { Params p0; fill_params(p0, ka); (void)xcd_barrier_post(p0.bar, xst); }
  if (ka.never) grid.sync();
#ifndef REPMASK
#define REPMASK 0
#endif
#define LOADKA KArgs kk; load_ka(kk)
#ifndef PHMASK
#define PHMASK 0xffff
#endif
#define PHASE(k, body) if (((PHMASK) >> (k)) & 1) for (int rep_ = 0; rep_ < (((REPMASK) >> (k)) & 1) + 1; ++rep_) { \
    LOADKA; Params p; fill_params(p, kk); { int t_ = threadIdx.x; asm volatile("" : "+v"(t_)); p.tid = t_; } body; grid_bar(p, lds); }
#ifdef XBAR
  for (int xb_ = 0; xb_ < XBAR; ++xb_) { PHASE(15, {}) }
#endif
  PHASE(0, { ph_mod(p, lds, nblk, bid); ph_wt(p, lds, nblk, bid); })
  PHASE(1, { ph_h(p, lds, nblk, bid); })
  PHASE(2, { ph_proj(p, lds, nblk, bid); })
  PHASE(3, { bool first = true; for (int ci = bid; ci < 1024; ci += nblk) { dn_prep_chunk(p, lds, ci, first); first = false; }
             for (int item = bid; item < 256; item += nblk) moba_prep_block(p, lds, item); })
  PHASE(4, { if (bid < 32) dn_scan_blk(p, lds, bid); moba_worker(p, lds, rep_); })
  PHASE(5, { ph_dn_norm(p, nblk, bid); })
  PHASE(6, { ph_br(p, lds, nblk, bid); })
  PHASE(7, { ph_mix(p, lds, nblk, bid); })
  PHASE(8, { ph_post_mix(p, lds, nblk, bid, rep_); })
  PHASE(10, { ph_moe1(p, lds, nblk, bid); })
  PHASE(11, { ph_moe2(p, lds, nblk, bid); })
  PHASE(12, { ph_final(p, nblk, bid, rep_); })
}


extern "C" void kernel_launch(void* const* d_in, const int* in_sizes, int n_in, void* d_out, int out_size, void* d_ws,
                              size_t ws_size, hipStream_t stream) {
  KArgs ka{};
  for (int i = 0; i < 22; ++i) ka.in[i] = d_in[i];
  ka.out = (float*)d_out; ka.ws = (char*)d_ws; ka.never = 0;
  Params p{};
  fill_params(p, ka);
  static int grid_blocks = 0;
  if (!grid_blocks) {
    (void)hipFuncSetAttribute((const void*)mega, hipFuncAttributeMaxDynamicSharedMemorySize, MEGA_LDS_ALLOC);
    int dev = 0, cus = 0, per_cu = 0;
    (void)hipGetDevice(&dev);
    (void)hipDeviceGetAttribute(&cus, hipDeviceAttributeMultiprocessorCount, dev);
    (void)hipOccupancyMaxActiveBlocksPerMultiprocessor(&per_cu, mega, 512, MEGA_LDS_ALLOC);
    if (per_cu != 1) per_cu = 1;
    grid_blocks = cus * per_cu;
  }
  (void)hipMemsetAsync(p.cnt, 0, 16384, stream);
  (void)hipMemsetAsync(p.bar, 0, XCD_BAR_WORDS * 4, stream);
  void* args[] = {&ka};
  hipError_t e = hipLaunchCooperativeKernel((void*)mega, dim3(grid_blocks), dim3(512), args, MEGA_LDS_ALLOC, stream);
  if (e != hipSuccess) fprintf(stderr, "cooperative launch failed: %s (grid %d)\n", hipGetErrorString(e), grid_blocks);
}
```

```cpp
#include <hip/hip_runtime.h>
#include <hip/hip_cooperative_groups.h>
#include <cstdio>
namespace cg = cooperative_groups;
#include <stdint.h>

typedef unsigned short bf16_t;
#ifndef MB_ABL
#define MB_ABL 0
#endif

#define T_TOK 16384
#define SEQ 4096
#define NB 4
#define DM 1024
#define INW 5640
#define PW 5632
#define C_QA 0
#define C_KA 512
#define C_VA 1024
#define C_Z 1536
#define C_MQ 2048
#define C_MK 2560
#define C_MV 3072
#define C_GA 3584
#define C_GB 4608
#define NE 32

__device__ __forceinline__ bf16_t f2bf(float f) {
  unsigned u = __float_as_uint(f);
  u += 0x7fffu + ((u >> 16) & 1u);
  return (bf16_t)(u >> 16);
}
__device__ __forceinline__ float bf2f(bf16_t h) { return __uint_as_float(((unsigned)h) << 16); }
__device__ __forceinline__ float sigmoidf_(float x) { return 1.f / (1.f + __expf(-x)); }
__device__ __forceinline__ float siluf_(float x) { return x / (1.f + __expf(-x)); }
__device__ __forceinline__ float wave_sum(float v) {
#pragma unroll
  for (int o = 32; o > 0; o >>= 1) v += __shfl_xor(v, o, 64);
  return v;
}
__device__ __forceinline__ float wave_max(float v) {
#pragma unroll
  for (int o = 32; o > 0; o >>= 1) v = fmaxf(v, __shfl_xor(v, o, 64));
  return v;
}

typedef __bf16 bf16x2_t __attribute__((ext_vector_type(2)));
typedef float f32x2_t __attribute__((ext_vector_type(2)));
__device__ __forceinline__ unsigned pk2(float a, float b) { f32x2_t v = {a, b}; bf16x2_t r = __builtin_convertvector(v, bf16x2_t); return __builtin_bit_cast(unsigned, r); }

struct Params {
  const float *x, *c, *w_ada, *b_ada, *g_pre_mix, *g_post_mix, *g_pre_ffn, *g_post_ffn, *w_in, *conv_w,
      *a_log, *dt_bias, *g_dn_out, *w_br_a, *w_br_b, *w_o, *w_router, *b_router, *w_gu, *b_gu, *w_down, *b_down;
  float* out;
  float* mod;
  int* cnt;
  float* ba;
  bf16_t* hbf;
  bf16_t* proj;
  bf16_t* w_in_t;
  bf16_t* wgu_t;
  bf16_t* wd_t;
  bf16_t* wbra_t;
  bf16_t* wbrb_t;
  bf16_t* wo_t;
  bf16_t* qb;
  bf16_t* kb;
  float* kmean;
  bf16_t* oab;
  bf16_t* merged;
  bf16_t* mixer;
  bf16_t* h2;
  int* elist;
  float* aw;
  bf16_t* act;
  bf16_t* xs;
  int* rowmap;
  bf16_t* yslot;
  unsigned char* dnA; float* dnU; float* dnG;
  bf16_t* dn_out; int dn_out_ld;
  bf16_t* oab2; float* dbg;
  unsigned* bar; int never; int tid;
  bf16_t* Kp; bf16_t* Vp; int* wq;
  bf16_t* mb_out; int mb_out_ld; int mb_out_off;
  float* nq; float* nk; float* nv;
  float* nbeta; float* ng;
  float* no;
  float* ntmp;
};

__device__ __forceinline__ int map_col(int n, int mode) {
  if (mode == 0) return n;
  if (mode == 1) return n < 2048 ? n : (n < 2056 ? -1 : n - 8);
  if (n < 1024) return (n >> 7) * 256 + (n & 127);
  int j = n - 1024;
  return (j >> 7) * 256 + 128 + (j & 127);
}
namespace pg8 {
#define PG8_LAS __attribute__((address_space(3)))
typedef short bf16x8 __attribute__((ext_vector_type(8)));
typedef float f32x4 __attribute__((ext_vector_type(4)));
typedef unsigned u32x4 __attribute__((ext_vector_type(4)));
constexpr int BM = 256, BK = 64, HALF = 128, HTB = HALF * BK * 2, STAGE_BYTES = 8 * HTB, NXCD = 8, WGM = 8;

__host__ __device__ __forceinline__ int lds_byte(int r, int c) { const int st = (r >> 4) * 2 + (c >> 5), rr = r & 15, cc = c & 31, ob = rr * 64 + cc * 2; return st * 1024 + (ob ^ (((ob >> 9) & 1) << 5)); }
__host__ __device__ __forceinline__ void stage_rc(int b, int& R, int& C) { const int st = b / 1024, sb = b % 1024, swz = sb ^ (((sb >> 9) & 1) << 5); R = (st >> 1) * 16 + swz / 64; C = (st & 1) * 32 + (swz % 64) / 2; }
__host__ __device__ __forceinline__ int perm32(int rho) { const int n = rho >> 4, i = rho & 15; return 8 * (i >> 2) + 4 * n + (i & 3); }

struct Unit { int pm, pn, z; };
__device__ __forceinline__ unsigned cvt_pk_bf16(float lo, float hi) { unsigned r; asm volatile("v_cvt_pk_bf16_f32 %0, %1, %2" : "=v"(r) : "v"(lo), "v"(hi)); return r; }

struct TileOrder {
    int nM, nN, nwg, G, c;
    __device__ void init(int nM_, int nN_, int G_, int c_) { nM = nM_; nN = nN_; nwg = nM * nN; G = G_; c = c_; }
    __device__ bool tile(int i, int& pm, int& pn) const {
        const long L = (long)i * G + c; if (L >= nwg) return false;
        int wgid = (int)L; { const int q = nwg / NXCD, r = nwg % NXCD, xcd = wgid % NXCD, off = wgid / NXCD; wgid = (xcd < r ? xcd * (q + 1) : r * (q + 1) + (xcd - r) * q) + off; }
        const int nig = WGM * nN, gid = wgid / nig, fm = gid * WGM, gsz = (nM - fm) < WGM ? (nM - fm) : WGM;
        pm = fm + ((wgid % nig) % gsz); pn = (wgid % nig) / gsz; return true;
    }
};

template <class Epi, class Sched>
__device__ __forceinline__ void gemm_phase(PG8_LAS unsigned char* lds, const int tid, const int lda, const int ldb, const int K, const Sched& S, const Epi& E) {
    const int wid = __builtin_amdgcn_readfirstlane(tid >> 6), lane = tid & 63, wr = wid >> 2, wc = wid & 3, fr = lane & 15, fq = lane >> 4;
    const int nt = K / BK;
    unsigned voffA[2], voffB[2];
#pragma unroll
    for (int i = 0; i < 2; ++i) { int R, C; stage_rc(tid * 16 + i * 8192, R, C); const int Rb = Epi::PERM ? ((R & ~31) + perm32(R & 31)) : R;
        voffA[i] = (unsigned)(R * lda + C) * 2u; voffB[i] = (unsigned)(Rb * ldb + C) * 2u; }
    const size_t kstep = (size_t)(BK * 2);
    const size_t hstepA = (size_t)HALF * lda * 2, hstepB = (size_t)HALF * ldb * 2;
    const unsigned ldsw = (unsigned)wid * 1024u;
    const int aoff = lds_byte(wr * 64 + fr, fq * 8), boff = lds_byte(wc * 32 + fr, fq * 8);
    unsigned gA[2][2] = {{0u, 0u}, {0u, 0u}}, gAn[2][2] = {{0u, 0u}, {0u, 0u}};
    int gR[2], gC[2];
#pragma unroll
    for (int i = 0; i < 2; ++i) stage_rc(tid * 16 + i * 8192, gR[i], gC[i]);
#define PG8_SA(b, h) (((b) * 2 + (h)) * HTB)
#define PG8_SB(b, h) ((4 + (b) * 2 + (h)) * HTB)
#define PG8_STAGE(bufoff, gbase, voff) do { _Pragma("unroll") for (int _i = 0; _i < 2; ++_i) \
        __builtin_amdgcn_global_load_lds((const unsigned*)((const char*)(gbase) + (voff)[_i]), (PG8_LAS unsigned*)(lds + (bufoff) + ldsw + _i * 8192), 16, 0, 0); } while (0)
#define PG8_STAGEA(bufoff, ptr, h, nx) do { if constexpr (Sched::GATHER) { const unsigned gs_[2] = {(nx) ? gAn[h][0] : gA[h][0], (nx) ? gAn[h][1] : gA[h][1]}; PG8_STAGE(bufoff, ptr, gs_); } \
        else { PG8_STAGE(bufoff, (ptr) + (h) * hstepA, voffA); } } while (0)
#define PG8_LDA(dst, b, h) do { _Pragma("unroll") for (int m = 0; m < 4; ++m) _Pragma("unroll") for (int k = 0; k < 2; ++k) dst[m][k] = *(const PG8_LAS bf16x8*)(lds + PG8_SA(b, h) + aoff + m * 2048 + k * 1024); } while (0)
#define PG8_LDB(dst, b, h) do { _Pragma("unroll") for (int n = 0; n < 2; ++n) _Pragma("unroll") for (int k = 0; k < 2; ++k) dst[n][k] = *(const PG8_LAS bf16x8*)(lds + PG8_SB(b, h) + boff + n * 2048 + k * 1024); } while (0)
#define PG8_MMA(ai, bj, At, Bt) do { __builtin_amdgcn_s_setprio(1); _Pragma("unroll") for (int m = 0; m < 4; ++m) _Pragma("unroll") for (int n = 0; n < 2; ++n) _Pragma("unroll") for (int k = 0; k < 2; ++k) \
        acc[ai][bj][m][n] = __builtin_amdgcn_mfma_f32_16x16x32_bf16(Bt[n][k], At[m][k], acc[ai][bj][m][n], 0, 0, 0); __builtin_amdgcn_s_setprio(0); } while (0)
#define PG8_WAIT_V(n) asm volatile("s_waitcnt vmcnt(" #n ")" ::: "memory")
#define PG8_WAIT_L(n) asm volatile("s_waitcnt lgkmcnt(" #n ")" ::: "memory")
#define PG8_BAR __builtin_amdgcn_s_barrier()
#define PG8_SCHED __builtin_amdgcn_sched_barrier(0)
    Unit cur, nxt; int ui = 0;
    if (!S.next(0, cur)) return;
    f32x4 acc[2][2][4][2];
#pragma unroll
    for (int a = 0; a < 2; ++a)
#pragma unroll
        for (int b = 0; b < 2; ++b)
#pragma unroll
            for (int m = 0; m < 4; ++m)
#pragma unroll
                for (int n = 0; n < 2; ++n) acc[a][b][m][n] = (f32x4){0.f, 0.f, 0.f, 0.f};
    bf16x8 At[4][2], B0[2][2], B1[2][2];
    const char* cA = S.a_ptr(cur); const char* cB = S.b_ptr(cur);
    if constexpr (Sched::GATHER) {
_Pragma("unroll") for (int h = 0; h < 2; ++h) _Pragma("unroll") for (int i = 0; i < 2; ++i) gA[h][i] = S.a_goff(cur, gR[i] + 128 * h, gC[i]); }
    PG8_STAGE(PG8_SB(0, 0), cB, voffB); PG8_STAGEA(PG8_SA(0, 0), cA, 0, false); PG8_STAGE(PG8_SB(0, 1), cB + hstepB, voffB); PG8_STAGEA(PG8_SA(0, 1), cA, 1, false);
    if (wr == 1) PG8_BAR;
    PG8_WAIT_V(4); PG8_BAR;
    PG8_STAGE(PG8_SB(1, 0), cB + kstep, voffB); PG8_STAGEA(PG8_SA(1, 0), cA + kstep, 0, false); PG8_STAGE(PG8_SB(1, 1), cB + hstepB + kstep, voffB);
    PG8_WAIT_V(6); PG8_BAR;
    for (;;) {
        const bool has_next = S.next(ui + 1, nxt);
        const char* nA = has_next ? S.a_ptr(nxt) : cA; const char* nB = has_next ? S.b_ptr(nxt) : cB;
        if constexpr (Sched::GATHER) {
_Pragma("unroll") for (int h = 0; h < 2; ++h) _Pragma("unroll") for (int i = 0; i < 2; ++i) gAn[h][i] = has_next ? S.a_goff(nxt, gR[i] + 128 * h, gC[i]) : gA[h][i]; }
        for (int t = 0; t < nt; t += 2) {
            const bool last = (t == nt - 2);
            const char* a1 = cA + (size_t)(t + 1) * kstep;
            const char* a2 = last ? nA : cA + (size_t)(t + 2) * kstep; const char* b2 = last ? nB : cB + (size_t)(t + 2) * kstep;
            const char* a3 = a2 + kstep; const char* b3 = b2 + kstep;
            PG8_LDB(B0, 0, 0); PG8_SCHED; PG8_LDA(At, 0, 0); PG8_STAGEA(PG8_SA(1, 1), a1, 1, false);
            PG8_WAIT_L(8); PG8_BAR; PG8_WAIT_L(0); PG8_MMA(0, 0, At, B0); PG8_BAR; PG8_SCHED;
            PG8_LDB(B1, 0, 1); PG8_STAGE(PG8_SB(0, 0), b2, voffB);
            PG8_BAR; PG8_WAIT_L(0); PG8_MMA(0, 1, At, B1); PG8_BAR;
            PG8_LDA(At, 0, 1); PG8_STAGEA(PG8_SA(0, 0), a2, 0, last);
            PG8_BAR; PG8_WAIT_L(0); PG8_MMA(1, 0, At, B0); PG8_BAR; PG8_SCHED;
            PG8_STAGE(PG8_SB(0, 1), b2 + hstepB, voffB);
            PG8_WAIT_V(6); PG8_BAR; PG8_MMA(1, 1, At, B1); PG8_BAR;
            PG8_LDB(B0, 1, 0); PG8_SCHED; PG8_LDA(At, 1, 0); PG8_STAGEA(PG8_SA(0, 1), a2, 1, last);
            PG8_WAIT_L(8); PG8_BAR; PG8_WAIT_L(0); PG8_MMA(0, 0, At, B0); PG8_BAR; PG8_SCHED;
            PG8_LDB(B1, 1, 1); PG8_STAGE(PG8_SB(1, 0), b3, voffB);
            PG8_BAR; PG8_WAIT_L(0); PG8_MMA(0, 1, At, B1); PG8_BAR;
            PG8_LDA(At, 1, 1); PG8_STAGEA(PG8_SA(1, 0), a3, 0, last);
            PG8_BAR; PG8_WAIT_L(0); PG8_MMA(1, 0, At, B0); PG8_BAR; PG8_SCHED;
            PG8_STAGE(PG8_SB(1, 1), b3 + hstepB, voffB);
            PG8_WAIT_V(6); PG8_BAR; PG8_MMA(1, 1, At, B1); PG8_BAR;
        }
        E(acc, cur, wr, wc, fr, fq);
        if (!has_next) break;
#pragma unroll
        for (int a = 0; a < 2; ++a)
#pragma unroll
            for (int b = 0; b < 2; ++b)
#pragma unroll
                for (int m = 0; m < 4; ++m)
#pragma unroll
                    for (int n = 0; n < 2; ++n) acc[a][b][m][n] = (f32x4){0.f, 0.f, 0.f, 0.f};
        cur = nxt; cA = nA; cB = nB; ++ui;
        if constexpr (Sched::GATHER) {
_Pragma("unroll") for (int h = 0; h < 2; ++h) _Pragma("unroll") for (int i = 0; i < 2; ++i) gA[h][i] = gAn[h][i]; }
    }
    PG8_WAIT_V(0);
    if (wr == 0) PG8_BAR;
    PG8_BAR;
#undef PG8_SA
#undef PG8_SB
#undef PG8_STAGE
#undef PG8_STAGEA
#undef PG8_LDA
#undef PG8_LDB
#undef PG8_MMA
#undef PG8_WAIT_V
#undef PG8_WAIT_L
#undef PG8_BAR
#undef PG8_SCHED
}
}
using pg8::f32x4; using pg8::u32x4; using pg8::Unit;

#define GEMM_LDS (pg8::STAGE_BYTES + 1024)

struct SchedProj : pg8::TileOrder {
  static constexpr bool GATHER = false;
  const char* A; const char* B;
  __device__ bool next(int i, Unit& u) const { u.z = 0; return tile(i, u.pm, u.pn); }
  __device__ const char* a_ptr(const Unit& u) const { return A + (size_t)u.pm * 256 * DM * 2; }
  __device__ const char* b_ptr(const Unit& u) const { return B + (size_t)u.pn * 256 * DM * 2; }
};
struct EpiProj {
  static constexpr bool PERM = true;
  bf16_t* O;
  __device__ __forceinline__ void operator()(const f32x4 (&acc)[2][2][4][2], const Unit& u, int wr, int wc, int fr, int fq) const {
    const int row0 = u.pm * 256 + wr * 64 + fr, col0 = u.pn * 256 + wc * 32 + 8 * fq;
    const bool gate = u.pn >= (C_GA / 256);
#pragma unroll
    for (int ai = 0; ai < 2; ++ai)
#pragma unroll
      for (int m = 0; m < 4; ++m) {
        bf16_t* rowp = O + (size_t)(row0 + ai * 128 + m * 16) * PW + col0;
#pragma unroll
        for (int bj = 0; bj < 2; ++bj) {
          f32x4 v0 = acc[ai][bj][m][0], v1 = acc[ai][bj][m][1];
          if (gate) {
#pragma unroll
            for (int j = 0; j < 4; ++j) { v0[j] = sigmoidf_(v0[j]); v1[j] = sigmoidf_(v1[j]); }
          }
          u32x4 w; w.x = pg8::cvt_pk_bf16(v0[0], v0[1]); w.y = pg8::cvt_pk_bf16(v0[2], v0[3]); w.z = pg8::cvt_pk_bf16(v1[0], v1[1]); w.w = pg8::cvt_pk_bf16(v1[2], v1[3]);
          *(u32x4*)(rowp + bj * 128) = w;
        }
      }
  }
};
__device__ void ph_proj(const Params& p, PG8_LAS unsigned char* lds, int nblk, int bid) {
  SchedProj S; S.init(T_TOK / 256, PW / 256, nblk, bid); S.A = (const char*)p.hbf; S.B = (const char*)p.w_in_t;
  EpiProj E{p.proj};
  pg8::gemm_phase(lds, p.tid, DM, DM, DM, S, E);
}

struct SchedBr : pg8::TileOrder {
  static constexpr bool GATHER = false;
  const char* A; const char* Ba; const char* Bb;
  __device__ bool next(int i, Unit& u) const { u.z = i & 1; return tile(i >> 1, u.pm, u.pn); }
  __device__ const char* a_ptr(const Unit& u) const { return A + (size_t)u.pm * 256 * DM * 2 + u.z * 512 * 2; }
  __device__ const char* b_ptr(const Unit& u) const { return (u.z ? Bb : Ba) + (size_t)u.pn * 256 * 512 * 2; }
};
__device__ __forceinline__ void unpack8(const u32x4 w, float (&f)[8]) {
  f[0] = __uint_as_float(w.x << 16); f[1] = __uint_as_float(w.x & 0xffff0000u); f[2] = __uint_as_float(w.y << 16); f[3] = __uint_as_float(w.y & 0xffff0000u);
  f[4] = __uint_as_float(w.z << 16); f[5] = __uint_as_float(w.z & 0xffff0000u); f[6] = __uint_as_float(w.w << 16); f[7] = __uint_as_float(w.w & 0xffff0000u);
}
struct EpiBr {
  static constexpr bool PERM = true;
  const bf16_t* proj; bf16_t* O;
  __device__ __forceinline__ void operator()(const f32x4 (&acc)[2][2][4][2], const Unit& u, int wr, int wc, int fr, int fq) const {
    const int row0 = u.pm * 256 + wr * 64 + fr, col0 = u.pn * 256 + wc * 32 + 8 * fq;
    const int gcol = (u.z ? C_GB : C_GA) + col0;
#pragma unroll
    for (int ai = 0; ai < 2; ++ai)
#pragma unroll
      for (int m = 0; m < 4; ++m) {
        const size_t row = (size_t)(row0 + ai * 128 + m * 16);
        bf16_t* rowp = O + row * DM + col0;
        const bf16_t* gp = proj + row * PW + gcol;
#pragma unroll
        for (int bj = 0; bj < 2; ++bj) {
          float g[8]; unpack8(*(const u32x4*)(gp + bj * 128), g);
          f32x4 v0 = acc[ai][bj][m][0], v1 = acc[ai][bj][m][1];
          float r[8];
#pragma unroll
          for (int j = 0; j < 4; ++j) { r[j] = v0[j] * g[j]; r[4 + j] = v1[j] * g[4 + j]; }
          if (u.z) {
            float pv[8]; unpack8(*(const u32x4*)(rowp + bj * 128), pv);
#pragma unroll
            for (int j = 0; j < 8; ++j) r[j] += pv[j];
          }
          u32x4 w; w.x = pg8::cvt_pk_bf16(r[0], r[1]); w.y = pg8::cvt_pk_bf16(r[2], r[3]); w.z = pg8::cvt_pk_bf16(r[4], r[5]); w.w = pg8::cvt_pk_bf16(r[6], r[7]);
          *(u32x4*)(rowp + bj * 128) = w;
        }
      }
  }
};
__device__ void ph_br(const Params& p, PG8_LAS unsigned char* lds, int nblk, int bid) {
  SchedBr S; S.init(T_TOK / 256, DM / 256, nblk, bid); S.A = (const char*)p.oab; S.Ba = (const char*)p.wbra_t; S.Bb = (const char*)p.wbrb_t;
  EpiBr E{p.proj, p.merged};
  pg8::gemm_phase(lds, p.tid, DM, 512, 512, S, E);
}

struct SchedMix : pg8::TileOrder {
  static constexpr bool GATHER = false;
  const char* A; const char* B;
  __device__ bool next(int i, Unit& u) const { u.z = 0; return tile(i, u.pm, u.pn); }
  __device__ const char* a_ptr(const Unit& u) const { return A + (size_t)u.pm * 256 * DM * 2; }
  __device__ const char* b_ptr(const Unit& u) const { return B + (size_t)u.pn * 256 * DM * 2; }
};
struct EpiMix {
  static constexpr bool PERM = true;
  bf16_t* O;
  __device__ __forceinline__ void operator()(const f32x4 (&acc)[2][2][4][2], const Unit& u, int wr, int wc, int fr, int fq) const {
    const int row0 = u.pm * 256 + wr * 64 + fr, col0 = u.pn * 256 + wc * 32 + 8 * fq;
#pragma unroll
    for (int ai = 0; ai < 2; ++ai)
#pragma unroll
      for (int m = 0; m < 4; ++m) {
        bf16_t* rowp = O + (size_t)(row0 + ai * 128 + m * 16) * DM + col0;
#pragma unroll
        for (int bj = 0; bj < 2; ++bj) {
          const f32x4 v0 = acc[ai][bj][m][0], v1 = acc[ai][bj][m][1];
          u32x4 w; w.x = pg8::cvt_pk_bf16(v0[0], v0[1]); w.y = pg8::cvt_pk_bf16(v0[2], v0[3]); w.z = pg8::cvt_pk_bf16(v1[0], v1[1]); w.w = pg8::cvt_pk_bf16(v1[2], v1[3]);
          *(u32x4*)(rowp + bj * 128) = w;
        }
      }
  }
};
__device__ void ph_mix(const Params& p, PG8_LAS unsigned char* lds, int nblk, int bid) {
  SchedMix S; S.init(T_TOK / 256, DM / 256, nblk, bid); S.A = (const char*)p.merged; S.B = (const char*)p.wo_t;
  EpiMix E{p.mixer};
  pg8::gemm_phase(lds, p.tid, DM, DM, DM, S, E);
}

template <bool GATH>
struct SchedMoe {
  static constexpr bool GATHER = GATH;
  const PG8_LAS int* tb; int NT; int G, c; int nwg;
  const char* A; const char* B; size_t bexp;
  const int* elist;
  __device__ bool next(int i, Unit& u) const {
    const long L = (long)i * G + c; if (L >= nwg) return false;
    int wgid = (int)L; { const int q = nwg / 8, r = nwg % 8, xcd = wgid % 8, off = wgid / 8; wgid = (xcd < r ? xcd * (q + 1) : r * (q + 1) + (xcd - r) * q) + off; }
    int e = 0;
#pragma unroll 1
    for (int k = 1; k < NE; ++k) if (wgid >= tb[k]) e = k;
    const int q = wgid - tb[e]; const int tiles = tb[33 + e + 1] - tb[33 + e];
    u.pm = tb[33 + e] + q % tiles; u.pn = q / tiles; u.z = e; return true;
  }
  __device__ const char* a_ptr(const Unit& u) const { return GATH ? A : A + (size_t)u.pm * 256 * DM * 2; }
  __device__ const char* b_ptr(const Unit& u) const { return B + (size_t)u.z * bexp + (size_t)u.pn * 256 * DM * 2; }
  __device__ unsigned a_goff(const Unit& u, int tr, int C) const {
    const int i = (u.pm - tb[33 + u.z]) * 256 + tr;
    int tok = 0;
    if (i < tb[66 + u.z]) tok = elist[u.z * T_TOK + i] >> 2;
    return (unsigned)(tok * DM + C) * 2u;
  }
};
__device__ __forceinline__ void moe_table(const Params& p, PG8_LAS int* tb, int NT) {
  if (p.tid == 0) {
    int ub = 0, tbp = 0;
    for (int e = 0; e < NE; ++e) { const int c = p.cnt[e * 64]; tb[e] = ub; tb[33 + e] = tbp; tb[66 + e] = c; const int t = (c + 255) >> 8; ub += t * NT; tbp += t; }
    tb[NE] = ub; tb[33 + NE] = tbp;
  }
  __syncthreads();
}
struct EpiMoe1 {
  static constexpr bool PERM = true;
  const float* b_gu; bf16_t* act;
  __device__ __forceinline__ void operator()(f32x4 (&acc)[2][2][4][2], const Unit& u, int wr, int wc, int fr, int fq) const {
    const int row0 = u.pm * 256 + wr * 64 + fr, jc = u.pn * 128 + wc * 32 + 8 * fq;
    const float* bg = b_gu + (size_t)u.z * 2048 + jc;
#pragma unroll
    for (int bj = 0; bj < 2; ++bj)
#pragma unroll
      for (int n = 0; n < 2; ++n) {
        const f32x4 bv = *(const f32x4*)(bg + bj * 1024 + n * 4);
#pragma unroll
        for (int ai = 0; ai < 2; ++ai)
#pragma unroll
          for (int m = 0; m < 4; ++m) acc[ai][bj][m][n] += bv;
      }
#pragma unroll
    for (int ai = 0; ai < 2; ++ai)
#pragma unroll
      for (int m = 0; m < 4; ++m) {
        bf16_t* rowp = act + (size_t)(row0 + ai * 128 + m * 16) * DM + jc;
        float r[8];
#pragma unroll
        for (int n = 0; n < 2; ++n)
#pragma unroll
          for (int j = 0; j < 4; ++j) {
            float g = acc[ai][0][m][n][j], up = acc[ai][1][m][n][j];
            g = fminf(g, 7.f); up = fminf(fmaxf(up, -7.f), 7.f);
            r[n * 4 + j] = (up + 1.f) * g * sigmoidf_(1.702f * g);
          }
        u32x4 w; w.x = pk2(r[0], r[1]); w.y = pk2(r[2], r[3]); w.z = pk2(r[4], r[5]); w.w = pk2(r[6], r[7]);
        *(u32x4*)rowp = w;
      }
  }
};
__device__ void ph_moe1(const Params& p, PG8_LAS unsigned char* lds, int nblk, int bid) {
  PG8_LAS int* tb = (PG8_LAS int*)(lds + pg8::STAGE_BYTES);
  moe_table(p, tb, 8);
  SchedMoe<true> S; S.tb = tb; S.NT = 8; S.G = nblk; S.c = bid; S.nwg = tb[NE]; S.A = (const char*)p.h2; S.B = (const char*)p.wgu_t; S.bexp = (size_t)2048 * DM * 2; S.elist = p.elist;
  EpiMoe1 E{p.b_gu, p.act};
  pg8::gemm_phase(lds, p.tid, DM, DM, DM, S, E);
}
struct EpiMoe2 {
  static constexpr bool PERM = true;
  const float* b_down; const int* elist; const PG8_LAS int* tb; bf16_t* yslot;
  __device__ __forceinline__ void operator()(f32x4 (&acc)[2][2][4][2], const Unit& u, int wr, int wc, int fr, int fq) const {
    const int row0 = u.pm * 256 + wr * 64 + fr, col0 = u.pn * 256 + wc * 32 + 8 * fq;
    const float* bd = b_down + (size_t)u.z * 1024 + col0;
#pragma unroll
    for (int bj = 0; bj < 2; ++bj)
#pragma unroll
      for (int n = 0; n < 2; ++n) {
        const f32x4 bv = *(const f32x4*)(bd + bj * 128 + n * 4);
#pragma unroll
        for (int ai = 0; ai < 2; ++ai)
#pragma unroll
          for (int m = 0; m < 4; ++m) acc[ai][bj][m][n] += bv;
      }
#pragma unroll
    for (int ai = 0; ai < 2; ++ai)
#pragma unroll
      for (int m = 0; m < 4; ++m) {
        const int li = (u.pm - tb[33 + u.z]) * 256 + wr * 64 + fr + ai * 128 + m * 16;
        if (li < tb[66 + u.z]) {
          const int a = elist[u.z * T_TOK + li];
          bf16_t* rowp = yslot + (size_t)a * DM + col0;
#pragma unroll
          for (int bj = 0; bj < 2; ++bj) {
            const f32x4 v0 = acc[ai][bj][m][0], v1 = acc[ai][bj][m][1];
            u32x4 w; w.x = pk2(v0[0], v0[1]); w.y = pk2(v0[2], v0[3]); w.z = pk2(v1[0], v1[1]); w.w = pk2(v1[2], v1[3]);
            *(u32x4*)(rowp + bj * 128) = w;
          }
        }
      }
  }
};
__device__ void ph_moe2(const Params& p, PG8_LAS unsigned char* lds, int nblk, int bid) {
  PG8_LAS int* tb = (PG8_LAS int*)(lds + pg8::STAGE_BYTES);
  moe_table(p, tb, 4);
  SchedMoe<false> S; S.tb = tb; S.NT = 4; S.G = nblk; S.c = bid; S.nwg = tb[NE]; S.A = (const char*)p.act; S.B = (const char*)p.wd_t; S.bexp = (size_t)1024 * DM * 2; S.elist = p.elist;
  EpiMoe2 E{p.b_down, p.elist, tb, p.yslot};
  pg8::gemm_phase(lds, p.tid, DM, DM, DM, S, E);
}

typedef short bf16x8 __attribute__((ext_vector_type(8)));
typedef unsigned u32x2 __attribute__((ext_vector_type(2)));
#define LAS __attribute__((address_space(3)))
#define MFMA16(a, b, c) __builtin_amdgcn_mfma_f32_16x16x32_bf16((a), (b), (c), 0, 0, 0)
__device__ __forceinline__ bf16x8 pack8(float a0, float a1, float a2, float a3, float a4, float a5, float a6, float a7) {
  u32x4 w; w.x = pk2(a0, a1); w.y = pk2(a2, a3); w.z = pk2(a4, a5); w.w = pk2(a6, a7);
  return __builtin_bit_cast(bf16x8, w);
}
__device__ __forceinline__ bf16_t f2bf_hw(float a) { return (bf16_t)(pk2(a, 0.f) & 0xffffu); }

#define DN_ABYTES 57344
#define DN_UFLOATS 8192
#define F_WN 0
#define F_QD 16
#define F_QK 32
#define F_KT 40

#define DP_KH 0
#define DP_QT 17408
#define DP_KHT 34816
#define DP_VT 53248
#define DP_TU 71680
#define DP_TW 80896
#define DP_LF 90112
#define DP_GC 107520
#define DP_BETA 107776
#define DP_CW 108032
#define DP_LB 114176
#define DP_TR 123392
#define DP_TT 132608
#define DP_MT 141824
#define DP_TOTAL 144128

template <int KS>
__device__ __forceinline__ f32x4 prod16(const LAS bf16_t* A, int lda, int arow0, const LAS bf16_t* Bt, int ldb, int brow0, f32x4 acc, int lane) {
  const int r = lane & 15, q = lane >> 4;
#pragma unroll
  for (int ks = 0; ks < KS; ++ks) {
    const bf16x8 a = *(const LAS bf16x8*)(A + (arow0 + r) * lda + 32 * ks + 8 * q);
    const bf16x8 b = *(const LAS bf16x8*)(Bt + (brow0 + r) * ldb + 32 * ks + 8 * q);
    acc = MFMA16(a, b, acc);
  }
  return acc;
}
__device__ __forceinline__ void tile_store_rm(LAS bf16_t* X, int ld, int row0, int col0, const f32x4 v, int lane) {
  const int r = lane & 15, q = lane >> 4;
#pragma unroll
  for (int i = 0; i < 4; ++i) X[(row0 + 4 * q + i) * ld + col0 + r] = f2bf_hw(v[i]);
}
__device__ __forceinline__ void tile_store_tr(LAS bf16_t* Xt, int ld, int row0, int col0, const f32x4 v, int lane) {
  const int r = lane & 15, q = lane >> 4;
  u32x2 w; w.x = pk2(v[0], v[1]); w.y = pk2(v[2], v[3]);
  *(LAS u32x2*)(Xt + (col0 + r) * ld + row0 + 4 * q) = w;
}

__device__ void dn_prep_chunk(const Params& p, LAS unsigned char* lds, int ci, bool load_cw) {
  const int tid = p.tid, lane = tid & 63, w = tid >> 6, r16 = lane & 15, q4 = lane >> 4;
  const int bh = ci >> 6, n = ci & 63, b = bh >> 2, h = bh & 3;
  LAS bf16_t* Kh = (LAS bf16_t*)(lds + DP_KH); LAS bf16_t* Qt = (LAS bf16_t*)(lds + DP_QT);
  LAS bf16_t* KhT = (LAS bf16_t*)(lds + DP_KHT); LAS bf16_t* VT = (LAS bf16_t*)(lds + DP_VT);
  LAS bf16_t* Tu = (LAS bf16_t*)(lds + DP_TU); LAS bf16_t* Tw = (LAS bf16_t*)(lds + DP_TW); LAS float* Lf = (LAS float*)(lds + DP_LF);
  LAS bf16_t* Lb = (LAS bf16_t*)(lds + DP_LB); LAS bf16_t* Tr = (LAS bf16_t*)(lds + DP_TR); LAS bf16_t* Tt = (LAS bf16_t*)(lds + DP_TT); LAS bf16_t* Mt = (LAS bf16_t*)(lds + DP_MT);
  LAS float* gcb = (LAS float*)(lds + DP_GC); LAS float* betab = (LAS float*)(lds + DP_BETA); LAS float* cw = (LAS float*)(lds + DP_CW);
  unsigned char* gA = (unsigned char*)p.dnA + (size_t)ci * DN_ABYTES;
  float* gU = p.dnU + (size_t)ci * DN_UFLOATS;

  if (load_cw) {
    for (int i = tid; i < 4 * 384; i += 512) { const int tap = i / 384, cc = i % 384, part = cc >> 7, d = cc & 127; cw[i] = p.conv_w[tap * 1536 + part * 512 + h * 128 + d]; }
  }
  __syncthreads();
  const int c = tid >> 3, g = tid & 7;
  const int s = n * 64 + c;
  const size_t t = (size_t)b * SEQ + s;
  float qv[16], kv[16], vv[16];
#pragma unroll
  for (int j = 0; j < 16; ++j) { qv[j] = 0.f; kv[j] = 0.f; vv[j] = 0.f; }
#pragma unroll
  for (int tap = 0; tap < 4; ++tap) {
    const int ss = s - 3 + tap;
    if (ss >= 0) {
      const bf16_t* row = p.proj + (t - 3 + tap) * PW + h * 128 + 16 * g;
      float x[8];
#pragma unroll
      for (int part = 0; part < 3; ++part) {
#pragma unroll
        for (int hh = 0; hh < 2; ++hh) {
          unpack8(*(const u32x4*)(row + part * 512 + 8 * hh), x);
#pragma unroll
          for (int j = 0; j < 8; ++j) {
            const float wv = cw[tap * 384 + part * 128 + 16 * g + 8 * hh + j];
            if (part == 0) qv[8 * hh + j] += wv * x[j];
            if (part == 1) kv[8 * hh + j] += wv * x[j];
            if (part == 2) vv[8 * hh + j] += wv * x[j];
          }
        }
      }
    }
    asm volatile("" ::: "memory");
  }
  float sq = 0.f, sk = 0.f;
#pragma unroll
  for (int j = 0; j < 16; ++j) { qv[j] = siluf_(qv[j]); kv[j] = siluf_(kv[j]); vv[j] = siluf_(vv[j]); sq += qv[j] * qv[j]; sk += kv[j] * kv[j]; }
  sq += __shfl_xor(sq, 1, 64); sq += __shfl_xor(sq, 2, 64); sq += __shfl_xor(sq, 4, 64);
  sk += __shfl_xor(sk, 1, 64); sk += __shfl_xor(sk, 2, 64); sk += __shfl_xor(sk, 4, 64);
  const float rq = rsqrtf(sq + 1e-6f) * 0.08838834764831845f, rk = rsqrtf(sk + 1e-6f);
#pragma unroll
  for (int j = 0; j < 16; ++j) { qv[j] *= rq; kv[j] *= rk; }
  if (g == 0) {
    const float bb = p.ba[t * 8 + h], aa = p.ba[t * 8 + 4 + h];
    const float xx = aa + p.dt_bias[h];
    const float sp = xx > 20.f ? xx : log1pf(__expf(xx));
    betab[c] = sigmoidf_(bb);
    gcb[c] = -__expf(p.a_log[h]) * sp;
  }
  {
    u32x4 w0, w1;
    w0.x = pk2(kv[0], kv[1]); w0.y = pk2(kv[2], kv[3]); w0.z = pk2(kv[4], kv[5]); w0.w = pk2(kv[6], kv[7]);
    w1.x = pk2(kv[8], kv[9]); w1.y = pk2(kv[10], kv[11]); w1.z = pk2(kv[12], kv[13]); w1.w = pk2(kv[14], kv[15]);
    *(LAS u32x4*)(Kh + c * 136 + 16 * g) = w0; *(LAS u32x4*)(Kh + c * 136 + 16 * g + 8) = w1;
    w0.x = pk2(qv[0], qv[1]); w0.y = pk2(qv[2], qv[3]); w0.z = pk2(qv[4], qv[5]); w0.w = pk2(qv[6], qv[7]);
    w1.x = pk2(qv[8], qv[9]); w1.y = pk2(qv[10], qv[11]); w1.z = pk2(qv[12], qv[13]); w1.w = pk2(qv[14], qv[15]);
    *(LAS u32x4*)(Qt + c * 136 + 16 * g) = w0; *(LAS u32x4*)(Qt + c * 136 + 16 * g + 8) = w1;
#pragma unroll
    for (int j = 0; j < 16; ++j) { KhT[(16 * g + j) * 72 + c] = f2bf_hw(kv[j]); VT[(16 * g + j) * 72 + c] = f2bf_hw(vv[j]); }
  }
  __syncthreads();
  if (w == 0) {
    float v = gcb[lane];
#pragma unroll
    for (int o = 1; o < 64; o <<= 1) { const float u = __shfl_up(v, o, 64); if (lane >= o) v += u; }
    gcb[lane] = v;
  }
  __syncthreads();
  const float gc_c = gcb[c], gl = gcb[63];
  {
    const float eg = __expf(gc_c);
    unsigned char* fb = gA + (size_t)(F_QD + (c >> 4) * 4 + (g >> 1)) * 1024 + (g & 1) * 8;
#pragma unroll
    for (int qq = 0; qq < 4; ++qq) {
      u32x2 wv; wv.x = pk2(qv[4 * qq] * eg, qv[4 * qq + 1] * eg); wv.y = pk2(qv[4 * qq + 2] * eg, qv[4 * qq + 3] * eg);
      *(u32x2*)(fb + ((c & 15) + 16 * qq) * 16) = wv;
    }
  }
  const int rt = w >> 1, ct0 = 2 * (w & 1);
#pragma unroll
  for (int tt = 0; tt < 2; ++tt) {
    const int ct = ct0 + tt;
    f32x4 gacc = {0.f, 0.f, 0.f, 0.f};
    gacc = prod16<4>(Kh, 136, 16 * rt, Kh, 136, 16 * ct, gacc, lane);
    const int m = 16 * ct + r16; const float gc_m = gcb[m];
    f32x4 lv;
#pragma unroll
    for (int i = 0; i < 4; ++i) {
      const int cc = 16 * rt + 4 * q4 + i;
      lv[i] = (m < cc) ? betab[cc] * gacc[i] * __expf(gcb[cc] - gc_m) : 0.f;
      Lf[cc * 68 + m] = lv[i];
    }
    tile_store_rm(Lb, 72, 16 * rt, 16 * ct, lv, lane);
    f32x4 qacc = {0.f, 0.f, 0.f, 0.f};
    qacc = prod16<4>(Kh, 136, 16 * rt, Qt, 136, 16 * ct, qacc, lane);
    const int cq = 16 * ct + r16; const float gc_cq = gcb[cq];
    float o4[4];
#pragma unroll
    for (int i = 0; i < 4; ++i) { const int mm = 16 * rt + 4 * q4 + i; o4[i] = (mm <= cq) ? qacc[i] * __expf(gc_cq - gcb[mm]) : 0.f; }
    u32x2 wv; wv.x = pk2(o4[0], o4[1]); wv.y = pk2(o4[2], o4[3]);
    *(u32x2*)(gA + (size_t)(F_QK + ct * 2 + (rt >> 1)) * 1024 + (r16 + 16 * q4) * 16 + (rt & 1) * 8) = wv;
  }
  __syncthreads();
  for (int i = tid; i < 2 * 64 * 72 / 8; i += 512) ((LAS u32x4*)Tr)[i] = (u32x4){0u, 0u, 0u, 0u};
  __syncthreads();
  if (w == 0) {
    int lo = lane; asm volatile("" : "+v"(lo));
    const int g = lo >> 4, j = lo & 15;
    unsigned lfb = DP_LF + (16 * g * 68 + 16 * g) * 4; asm volatile("" : "+v"(lfb));
    const LAS float* Lg = (const LAS float*)(lds + lfb);
    float t[16];
#pragma unroll
    for (int r = 0; r < 16; ++r) {
      float a0 = (r == j) ? 1.f : 0.f, a1 = 0.f;
#pragma unroll
      for (int k4 = 0; k4 < (r + 3) / 4; ++k4) {
        const f32x4 l = *(const LAS f32x4*)(Lg + r * 68 + 4 * k4);
        if (4 * k4 + 0 < r) a0 -= l[0] * t[4 * k4 + 0];
        if (4 * k4 + 1 < r) a1 -= l[1] * t[4 * k4 + 1];
        if (4 * k4 + 2 < r) a0 -= l[2] * t[4 * k4 + 2];
        if (4 * k4 + 3 < r) a1 -= l[3] * t[4 * k4 + 3];
      }
      t[r] = a0 + a1;
      Tr[(16 * g + r) * 72 + 16 * g + j] = f2bf_hw(t[r]);
    }
    u32x4 w0, w1;
    w0.x = pk2(t[0], t[1]); w0.y = pk2(t[2], t[3]); w0.z = pk2(t[4], t[5]); w0.w = pk2(t[6], t[7]);
    w1.x = pk2(t[8], t[9]); w1.y = pk2(t[10], t[11]); w1.z = pk2(t[12], t[13]); w1.w = pk2(t[14], t[15]);
    *(LAS u32x4*)(Tt + (16 * g + j) * 72 + 16 * g) = w0; *(LAS u32x4*)(Tt + (16 * g + j) * 72 + 16 * g + 8) = w1;
  }
  __syncthreads();
#pragma unroll 1
  for (int d = 1; d <= 3; ++d) {
    const bool act = w < 4 - d;
    const int I = w + d, J = w;
    LAS bf16_t* Mw = Mt + w * 16 * 24;
    if (act) {
      f32x4 macc = {0.f, 0.f, 0.f, 0.f};
      macc = prod16<2>(Lb, 72, 16 * I, Tt, 72, 16 * J, macc, lane);
      tile_store_tr(Mw, 24, 0, 0, macc, lane);
    }
    __syncthreads();
    if (act) {
      bf16x8 a = {0, 0, 0, 0, 0, 0, 0, 0}, bb = {0, 0, 0, 0, 0, 0, 0, 0};
      if (q4 < 2) { a = *(const LAS bf16x8*)(Tr + (16 * I + r16) * 72 + 16 * I + 8 * q4); bb = *(const LAS bf16x8*)(Mw + r16 * 24 + 8 * q4); }
      f32x4 tacc = {0.f, 0.f, 0.f, 0.f};
      tacc = MFMA16(a, bb, tacc);
#pragma unroll
      for (int i = 0; i < 4; ++i) tacc[i] = -tacc[i];
      tile_store_rm(Tr, 72, 16 * I, 16 * J, tacc, lane);
      tile_store_tr(Tt, 72, 16 * I, 16 * J, tacc, lane);
    }
    __syncthreads();
  }
  {
    const int cc = tid >> 3, m0 = (tid & 7) * 8;
    float tv[8]; unpack8(*(const LAS u32x4*)(Tr + cc * 72 + m0), tv);
    float tu[8], tw[8];
#pragma unroll
    for (int jj = 0; jj < 8; ++jj) { const float bm = betab[m0 + jj]; tu[jj] = tv[jj] * bm; tw[jj] = tu[jj] * __expf(gcb[m0 + jj]); }
    u32x4 wu, ww;
    wu.x = pk2(tu[0], tu[1]); wu.y = pk2(tu[2], tu[3]); wu.z = pk2(tu[4], tu[5]); wu.w = pk2(tu[6], tu[7]);
    ww.x = pk2(tw[0], tw[1]); ww.y = pk2(tw[2], tw[3]); ww.z = pk2(tw[4], tw[5]); ww.w = pk2(tw[6], tw[7]);
    *(LAS u32x4*)(Tu + cc * 72 + m0) = wu; *(LAS u32x4*)(Tw + cc * 72 + m0) = ww;
  }
  __syncthreads();
#pragma unroll
  for (int rr = 0; rr < 4; ++rr) {
    f32x4 u = {0.f, 0.f, 0.f, 0.f};
    u = prod16<2>(Tu, 72, 16 * rr, VT, 72, 16 * w, u, lane);
    *(f32x4*)(gU + ((w * 4 + rr) * 64 + lane) * 4) = u;
    f32x4 wt = {0.f, 0.f, 0.f, 0.f};
    wt = prod16<2>(KhT, 72, 16 * w, Tw, 72, 16 * rr, wt, lane);
    u32x2 wv; wv.x = pk2(-wt[0], -wt[1]); wv.y = pk2(-wt[2], -wt[3]);
    *(u32x2*)(gA + (size_t)(F_WN + rr * 4 + (w >> 1)) * 1024 + (r16 + 16 * q4) * 16 + (w & 1) * 8) = wv;
  }
#pragma unroll
  for (int it = 0; it < 4; ++it) {
    const int idx = tid + it * 512; const int d = idx >> 4, m4 = idx & 15;
    const u32x2 raw = *(const LAS u32x2*)(KhT + d * 72 + 4 * m4);
    const float k0 = __uint_as_float(raw.x << 16), k1 = __uint_as_float(raw.x & 0xffff0000u), k2 = __uint_as_float(raw.y << 16), k3 = __uint_as_float(raw.y & 0xffff0000u);
    const float e0 = __expf(gl - gcb[4 * m4]), e1 = __expf(gl - gcb[4 * m4 + 1]), e2 = __expf(gl - gcb[4 * m4 + 2]), e3 = __expf(gl - gcb[4 * m4 + 3]);
    u32x2 wv; wv.x = pk2(k0 * e0, k1 * e1); wv.y = pk2(k2 * e2, k3 * e3);
    *(u32x2*)(gA + (size_t)(F_KT + (d >> 4) * 2 + (m4 >> 3)) * 1024 + ((d & 15) + 16 * (m4 & 3)) * 16 + ((m4 >> 2) & 1) * 8) = wv;
  }
  if (tid == 0) p.dnG[ci] = __expf(gl);
}

#define DS_A0 0
#define DS_A1 57344
#define DS_TOTAL 114688
__device__ void dn_scan_blk(const Params& p, LAS unsigned char* lds, int item) {
  const int tid = p.tid, lane = tid & 63, w = __builtin_amdgcn_readfirstlane(tid >> 6), r16 = lane & 15, q4 = lane >> 4;
  const int bh = item >> 1, eh = item & 1, b = bh >> 2, h = bh & 3;
  const int et = eh * 4 + (w & 3);
  const bool comp = w < 4;
  const unsigned char* gA = (const unsigned char*)p.dnA + (size_t)bh * 64 * DN_ABYTES;
  const float* gU = p.dnU + (size_t)bh * 64 * DN_UFLOATS;
  const float* gG = p.dnG + bh * 64;
  auto issue_A = [&](int n, int buf) {
#pragma unroll
    for (int i = 0; i < 7; ++i) {
      const int f = w * 7 + i;
      __builtin_amdgcn_global_load_lds((const unsigned*)(gA + (size_t)n * DN_ABYTES + f * 1024 + lane * 16), (LAS unsigned*)(lds + (buf ? DS_A1 : DS_A0) + f * 1024), 16, 0, 0);
    }
  };
  __syncthreads();
  issue_A(0, 0);
  f32x4 Un[4];
#pragma unroll
  for (int rr = 0; rr < 4; ++rr) Un[rr] = *(const f32x4*)(gU + ((et * 4 + rr) * 64 + lane) * 4);
  f32x4 S[8];
#pragma unroll
  for (int dt = 0; dt < 8; ++dt) S[dt] = (f32x4){0.f, 0.f, 0.f, 0.f};
  asm volatile("s_waitcnt vmcnt(0)" ::: "memory");
  __syncthreads();
  bf16_t* obase = p.dn_out + ((size_t)b * SEQ) * p.dn_out_ld + h * 128 + 16 * et + r16;
  f32x4 Op[4];
#pragma unroll
  for (int rr = 0; rr < 4; ++rr) Op[rr] = (f32x4){0.f, 0.f, 0.f, 0.f};
  float gnext = gG[0];
#pragma unroll 1
  for (int n = 0; n < 64; ++n) {
    const LAS unsigned char* Ab = lds + ((n & 1) ? DS_A1 : DS_A0);
    if (n + 1 < 64) issue_A(n + 1, (n + 1) & 1);
    if (comp) {
      if (n > 0) {
#pragma unroll
        for (int rr = 0; rr < 4; ++rr)
#pragma unroll
          for (int i = 0; i < 4; ++i) obase[(size_t)((n - 1) * 64 + 16 * rr + 4 * q4 + i) * p.dn_out_ld] = f2bf_hw(Op[rr][i]);
      }
      f32x4 Vn[4];
#pragma unroll
      for (int rr = 0; rr < 4; ++rr) Vn[rr] = Un[rr];
      if (n + 1 < 64) {
#pragma unroll
        for (int rr = 0; rr < 4; ++rr) Un[rr] = *(const f32x4*)(gU + (size_t)(n + 1) * DN_UFLOATS + ((et * 4 + rr) * 64 + lane) * 4);
      }
      const float gdec = gnext;
      if (n + 1 < 64) gnext = gG[n + 1];
      bf16x8 Sb[4];
#pragma unroll
      for (int ks = 0; ks < 4; ++ks) Sb[ks] = pack8(S[2 * ks][0], S[2 * ks][1], S[2 * ks][2], S[2 * ks][3], S[2 * ks + 1][0], S[2 * ks + 1][1], S[2 * ks + 1][2], S[2 * ks + 1][3]);
#pragma unroll
      for (int dt = 0; dt < 8; ++dt) S[dt] *= gdec;
#define LDF(idx) (*(const LAS bf16x8*)(Ab + (idx) * 1024 + lane * 16))
#define SBAR __builtin_amdgcn_sched_barrier(0)
      bf16x8 fa[8], fb[8];
      f32x4 O[4];
#pragma unroll
      for (int rr = 0; rr < 4; ++rr) O[rr] = (f32x4){0.f, 0.f, 0.f, 0.f};
#pragma unroll
      for (int i = 0; i < 4; ++i) { fa[i] = LDF(F_WN + i); fa[4 + i] = LDF(F_QD + i); }
      SBAR;
#pragma unroll
      for (int i = 0; i < 4; ++i) { fb[i] = LDF(F_WN + 4 + i); fb[4 + i] = LDF(F_QD + 4 + i); }
      SBAR;
#pragma unroll
      for (int ks = 0; ks < 4; ++ks) { Vn[0] = MFMA16(fa[ks], Sb[ks], Vn[0]); O[0] = MFMA16(fa[4 + ks], Sb[ks], O[0]); }
      SBAR;
#pragma unroll
      for (int i = 0; i < 4; ++i) { fa[i] = LDF(F_WN + 8 + i); fa[4 + i] = LDF(F_QD + 8 + i); }
      SBAR;
#pragma unroll
      for (int ks = 0; ks < 4; ++ks) { Vn[1] = MFMA16(fb[ks], Sb[ks], Vn[1]); O[1] = MFMA16(fb[4 + ks], Sb[ks], O[1]); }
      SBAR;
#pragma unroll
      for (int i = 0; i < 4; ++i) { fb[i] = LDF(F_WN + 12 + i); fb[4 + i] = LDF(F_QD + 12 + i); }
      SBAR;
#pragma unroll
      for (int ks = 0; ks < 4; ++ks) { Vn[2] = MFMA16(fa[ks], Sb[ks], Vn[2]); O[2] = MFMA16(fa[4 + ks], Sb[ks], O[2]); }
      SBAR;
#pragma unroll
      for (int i = 0; i < 8; ++i) fa[i] = LDF(F_QK + i);
      SBAR;
#pragma unroll
      for (int ks = 0; ks < 4; ++ks) { Vn[3] = MFMA16(fb[ks], Sb[ks], Vn[3]); O[3] = MFMA16(fb[4 + ks], Sb[ks], O[3]); }
      SBAR;
#pragma unroll
      for (int i = 0; i < 8; ++i) fb[i] = LDF(F_KT + i);
      SBAR;
      bf16x8 Vb[2];
#pragma unroll
      for (int ks = 0; ks < 2; ++ks) Vb[ks] = pack8(Vn[2 * ks][0], Vn[2 * ks][1], Vn[2 * ks][2], Vn[2 * ks][3], Vn[2 * ks + 1][0], Vn[2 * ks + 1][1], Vn[2 * ks + 1][2], Vn[2 * ks + 1][3]);
#pragma unroll
      for (int ks = 0; ks < 2; ++ks)
#pragma unroll
        for (int rr = 0; rr < 4; ++rr) O[rr] = MFMA16(fa[rr * 2 + ks], Vb[ks], O[rr]);
      SBAR;
#pragma unroll
      for (int i = 0; i < 8; ++i) fa[i] = LDF(F_KT + 8 + i);
      SBAR;
#pragma unroll
      for (int ks = 0; ks < 2; ++ks)
#pragma unroll
        for (int dt = 0; dt < 4; ++dt) S[dt] = MFMA16(fb[dt * 2 + ks], Vb[ks], S[dt]);
      SBAR;
#pragma unroll
      for (int ks = 0; ks < 2; ++ks)
#pragma unroll
        for (int dt = 0; dt < 4; ++dt) S[4 + dt] = MFMA16(fa[dt * 2 + ks], Vb[ks], S[4 + dt]);
#pragma unroll
      for (int rr = 0; rr < 4; ++rr) Op[rr] = O[rr];
#undef LDF
#undef SBAR
    }
    asm volatile("s_waitcnt vmcnt(0)" ::: "memory");
    __syncthreads();
  }
  if (comp) {
#pragma unroll
    for (int rr = 0; rr < 4; ++rr)
#pragma unroll
      for (int i = 0; i < 4; ++i) obase[(size_t)(63 * 64 + 16 * rr + 4 * q4 + i) * p.dn_out_ld] = f2bf_hw(Op[rr][i]);
  }
}
__device__ void ph_dn_norm(const Params& p, int nblk, int bid) {
  const int wid = p.tid >> 6, lane = p.tid & 63;
  const f32x4 g0 = *(const f32x4*)(p.g_dn_out + (lane & 15) * 8), g1 = *(const f32x4*)(p.g_dn_out + (lane & 15) * 8 + 4);
  for (int t = bid * 8 + wid; t < T_TOK; t += nblk * 8) {
    bf16_t* op = p.oab + (size_t)t * DM + lane * 8;
    float o[8], z[8];
    unpack8(*(const u32x4*)op, o);
    unpack8(*(const u32x4*)(p.proj + (size_t)t * PW + C_Z + lane * 8), z);
    float ss = 0.f;
#pragma unroll
    for (int j = 0; j < 8; ++j) ss += o[j] * o[j];
    ss += __shfl_xor(ss, 1, 64); ss += __shfl_xor(ss, 2, 64); ss += __shfl_xor(ss, 4, 64); ss += __shfl_xor(ss, 8, 64);
    const float rstd = rsqrtf(ss * (1.f / 128.f) + 1e-6f);
    float y[8];
#pragma unroll
    for (int j = 0; j < 4; ++j) { y[j] = o[j] * rstd * g0[j] * siluf_(z[j]); y[4 + j] = o[4 + j] * rstd * g1[j] * siluf_(z[4 + j]); }
    u32x4 w; w.x = pk2(y[0], y[1]); w.y = pk2(y[2], y[3]); w.z = pk2(y[4], y[5]); w.w = pk2(y[6], y[7]);
    *(u32x4*)op = w;
  }
}
typedef float f32x16 __attribute__((ext_vector_type(16)));
#define MFMA32(a, b, c) __builtin_amdgcn_mfma_f32_32x32x16_bf16((a), (b), (c), 0, 0, 0)
#define MP_VL 0
#define MP_RED 65536
#define MP_TOTAL (65536 + 4096)

__device__ void moba_prep_block(const Params& p, LAS unsigned char* lds, int item) {
  const int tid = p.tid, lane = tid & 63, w = tid >> 6;
  const int bh = item >> 4, jb = item & 15, b = bh >> 2, h = bh & 3;
  LAS bf16_t* Vl = (LAS bf16_t*)(lds + MP_VL);
  LAS float* red = (LAS float*)(lds + MP_RED);
  __syncthreads();
#pragma unroll
  for (int it = 0; it < 8; ++it) {
    const int idx = tid + 512 * it, row = idx >> 4, ch = idx & 15;
    const u32x4 v = *(const u32x4*)(p.proj + ((size_t)b * SEQ + 256 * jb + row) * PW + C_MV + h * 128 + 8 * ch);
    *(LAS u32x4*)(Vl + row * 128 + 8 * ch) = v;
  }
  {
    const int r = tid >> 1, hh = tid & 1;
    const int pos = 256 * jb + r;
    const size_t t = (size_t)b * SEQ + pos;
    float cs[8], sn[8];
#pragma unroll
    for (int jj = 0; jj < 8; ++jj) {
      const float inv = exp2f(-(float)(8 * hh + jj) * (1.f / 16.f) * 18.931568569324174f);
      const float ang = (float)pos * inv;
      cs[jj] = cosf(ang); sn[jj] = sinf(ang);
    }
    float kacc[64];
#pragma unroll
    for (int which = 0; which < 2; ++which) {
      const bf16_t* src = p.proj + t * PW + (which ? C_MQ : C_MK) + h * 128 + 8 * hh;
      float x0[8], x1[8];
      unpack8(*(const u32x4*)(src), x0); unpack8(*(const u32x4*)(src + 16), x1);
      float y0[8], y1[8];
#pragma unroll
      for (int jj = 0; jj < 8; ++jj) { y0[jj] = x0[jj] * cs[jj] - x1[jj] * sn[jj]; y1[jj] = x1[jj] * cs[jj] + x0[jj] * sn[jj]; }
      u32x4 o[8];
      o[0].x = pk2(y0[0], y0[1]); o[0].y = pk2(y0[2], y0[3]); o[0].z = pk2(y0[4], y0[5]); o[0].w = pk2(y0[6], y0[7]);
      o[1].x = pk2(y1[0], y1[1]); o[1].y = pk2(y1[2], y1[3]); o[1].z = pk2(y1[4], y1[5]); o[1].w = pk2(y1[6], y1[7]);
#pragma unroll
      for (int ks = 2; ks < 8; ++ks) o[ks] = *(const u32x4*)(src + 16 * ks);
      if (which == 0) {
#pragma unroll
        for (int jj = 0; jj < 8; ++jj) { kacc[jj] = y0[jj]; kacc[8 + jj] = y1[jj]; }
#pragma unroll
        for (int ks = 2; ks < 8; ++ks) { float f[8]; unpack8(o[ks], f);
#pragma unroll
          for (int jj = 0; jj < 8; ++jj) kacc[8 * ks + jj] = f[jj]; }
        unsigned char* dst = (unsigned char*)p.Kp + ((size_t)(bh * 128 + 8 * jb + (r >> 5)) * 8192) + ((r & 31) + 32 * hh) * 16;
#pragma unroll
        for (int ks = 0; ks < 8; ++ks) *(u32x4*)(dst + ks * 1024) = o[ks];
      } else {
        bf16_t* dst = p.qb + ((size_t)bh * SEQ + pos) * 128 + 8 * hh;
#pragma unroll
        for (int ks = 0; ks < 8; ++ks) *(u32x4*)(dst + 16 * ks) = o[ks];
      }
    }
#pragma unroll
    for (int e = 0; e < 64; ++e) {
      float v = kacc[e];
      v += __shfl_xor(v, 2, 64); v += __shfl_xor(v, 4, 64); v += __shfl_xor(v, 8, 64); v += __shfl_xor(v, 16, 64); v += __shfl_xor(v, 32, 64);
      kacc[e] = v;
    }
    if (lane < 2) {
#pragma unroll
      for (int e = 0; e < 64; ++e) red[(w * 2 + lane) * 64 + e] = kacc[e];
    }
  }
  __syncthreads();
  if (tid < 128) {
    const int d = tid, hh = (d >> 3) & 1, ks = d >> 4, jj = d & 7;
    float a = 0.f;
#pragma unroll
    for (int ww = 0; ww < 8; ++ww) a += red[(ww * 2 + hh) * 64 + ks * 8 + jj];
    p.kmean[((size_t)bh * 16 + jb) * 128 + d] = a * (1.f / 256.f);
  }
#pragma unroll
  for (int it = 0; it < 8; ++it) {
    const int o = tid + 512 * it, ln = o & 63, frag = o >> 6, tl = frag >> 3, dt = (frag >> 1) & 3, s = frag & 1;
    const int r = ln & 31, hh = ln >> 5, d = 32 * dt + r;
    unsigned short e[8];
#pragma unroll
    for (int jj = 0; jj < 8; ++jj) { const int key = 32 * tl + 16 * s + 8 * (jj >> 2) + 4 * hh + (jj & 3); e[jj] = Vl[key * 128 + d]; }
    u32x4 wv; wv.x = e[0] | ((unsigned)e[1] << 16); wv.y = e[2] | ((unsigned)e[3] << 16); wv.z = e[4] | ((unsigned)e[5] << 16); wv.w = e[6] | ((unsigned)e[7] << 16);
    *(u32x4*)((unsigned char*)p.Vp + ((size_t)(bh * 128 + 8 * jb + tl) * 8192) + (dt * 2 + s) * 1024 + ln * 16) = wv;
  }
}
__device__ __forceinline__ int crow32(int reg, int hh) { return (reg & 3) + 8 * (reg >> 2) + 4 * hh; }
__device__ void moba_item(const Params& p, LAS float* km, LAS float* mrg, LAS float* ml, int bh, int ib, int sub, int par, int lane, int rep) {
  const int q = lane & 31, hh = lane >> 5;
  const int b = bh >> 2, h = bh & 3;
  const int s0 = 256 * ib + 32 * sub;
  const bf16_t* qrow = p.qb + ((size_t)bh * SEQ + s0 + q) * 128 + 8 * hh;
  bf16x8 Qf[8];
#pragma unroll
  for (int ks = 0; ks < 8; ++ks) Qf[ks] = *(const bf16x8*)(qrow + 16 * ks);
  LAS unsigned char* qlds = (LAS unsigned char*)km + 8192 + lane * 16;
#pragma unroll
  for (int ks = 0; ks < 8; ++ks) *(LAS bf16x8*)(qlds + ks * 1024) = Qf[ks];
  unsigned selmask = 0;
  if (ib > 0) {
    for (int idx = lane; idx < ib * 32; idx += 64) ((LAS f32x4*)km)[idx] = ((const f32x4*)(p.kmean + (size_t)bh * 16 * 128))[idx];
    float qf[64];
#pragma unroll
    for (int ks = 0; ks < 8; ++ks) { float f[8]; unpack8(__builtin_bit_cast(u32x4, Qf[ks]), f);
#pragma unroll
      for (int jj = 0; jj < 8; ++jj) qf[8 * ks + jj] = f[jj]; }
    float sc[16];
#pragma unroll
    for (int j = 0; j < 16; ++j) {
      sc[j] = -INFINITY;
      if (j < ib) {
        float a = 0.f;
#pragma unroll
        for (int ks = 0; ks < 8; ++ks) {
          const f32x4 k0 = *(const LAS f32x4*)(km + j * 128 + 16 * ks + 8 * hh), k1 = *(const LAS f32x4*)(km + j * 128 + 16 * ks + 8 * hh + 4);
          a += qf[8 * ks] * k0[0] + qf[8 * ks + 1] * k0[1] + qf[8 * ks + 2] * k0[2] + qf[8 * ks + 3] * k0[3];
          a += qf[8 * ks + 4] * k1[0] + qf[8 * ks + 5] * k1[1] + qf[8 * ks + 6] * k1[2] + qf[8 * ks + 7] * k1[3];
        }
        a += __shfl_xor(a, 32, 64);
        sc[j] = a;
      }
    }
#pragma unroll
    for (int r = 0; r < 3; ++r) {
      if (r < ib) {
        float best = -INFINITY; int bi = 0;
#pragma unroll
        for (int j = 0; j < 16; ++j) if (sc[j] > best) { best = sc[j]; bi = j; }
        selmask |= 1u << bi;
#pragma unroll
        for (int j = 0; j < 16; ++j) if (j == bi) sc[j] = -INFINITY;
      }
    }
  }
  unsigned rem = 0;
  for (int j = 0; j < ib; ++j) if (__ballot((selmask >> j) & 1u) != 0ull) rem |= 1u << j;
  rem = __builtin_amdgcn_readfirstlane(rem);
  const int own0 = 8 * ib, diag = 8 * ib + sub;
  const float cscale = 0.08838834764831845f * 1.4426950408889634f;
  float m = -1e30f, l = 0.f;
  f32x16 O[4];
#pragma unroll
  for (int dt = 0; dt < 4; ++dt)
#pragma unroll
    for (int r = 0; r < 16; ++r) O[dt][r] = 0.f;
  const unsigned char* kbase = (const unsigned char*)p.Kp + (size_t)bh * 128 * 8192 + lane * 16;
  const unsigned char* vbase = (const unsigned char*)p.Vp + (size_t)bh * 128 * 8192 + lane * 16;
  auto adv = [&](int& kt_, unsigned& rem_) {
    if (kt_ < 0) return;
    if (kt_ >= own0 ? (kt_ < diag) : ((kt_ & 7) != 7)) { kt_ = kt_ + 1; return; }
    if (rem_ == 0u) { kt_ = -1; return; }
    kt_ = 8 * (__builtin_ctz(rem_)); rem_ &= rem_ - 1u;
  };
  int kt = own0;
  if (par) adv(kt, rem);
  auto load_k = [&](int t, bf16x8 (&K_)[8]) {
#pragma unroll
    for (int ks = 0; ks < 8; ++ks) K_[ks] = *(const bf16x8*)(kbase + (size_t)t * 8192 + ks * 1024);
  };
  auto tile_step = [&](bf16x8 (&Kc)[8], bf16x8 (&Kn)[8]) -> bool {
    int ktn = kt; unsigned remn = rem;
    adv(ktn, remn); adv(ktn, remn);
    bf16x8 Vf[8];
#pragma unroll
    for (int f = 0; f < 8; ++f) Vf[f] = *(const bf16x8*)(vbase + (size_t)kt * 8192 + f * 1024);
    if (ktn >= 0) load_k(ktn, Kn);
    f32x16 S;
#pragma unroll
    for (int r = 0; r < 16; ++r) S[r] = 0.f;
#pragma unroll
    for (int ks = 0; ks < 8; ++ks) S = MFMA32(Kc[ks], *(const LAS bf16x8*)(qlds + ks * 1024), S);
    const bool allowed = (kt >= own0) || ((selmask >> (kt >> 3)) & 1u);
    const float nb = allowed ? 0.f : -INFINITY;
    float sv[16]; float mx = -INFINITY;
#pragma unroll
    for (int r = 0; r < 16; ++r) sv[r] = __builtin_fmaf(S[r], cscale, nb);
    if (kt == diag) {
#pragma unroll
      for (int r = 0; r < 16; ++r) if (crow32(r, hh) > q) sv[r] = -INFINITY;
    }
#pragma unroll
    for (int r = 0; r < 16; ++r) mx = fmaxf(mx, sv[r]);
    mx = fmaxf(mx, __shfl_xor(mx, 32, 64));
    const bool grow = mx > m + 8.f;
    const float mn = (__ballot(grow) != 0ull) ? fmaxf(m, mx) : m;
    const float alpha = __builtin_amdgcn_exp2f(m - mn);
    float ps = 0.f;
#pragma unroll
    for (int r = 0; r < 16; ++r) { sv[r] = __builtin_amdgcn_exp2f(sv[r] - mn); ps += sv[r]; }
    l = l * alpha + ps; m = mn;
    if (__ballot(alpha != 1.f) != 0ull) {
#pragma unroll
      for (int dt = 0; dt < 4; ++dt)
#pragma unroll
        for (int r = 0; r < 16; ++r) O[dt][r] *= alpha;
    }
    const bf16x8 P0 = pack8(sv[0], sv[1], sv[2], sv[3], sv[4], sv[5], sv[6], sv[7]);
    const bf16x8 P1 = pack8(sv[8], sv[9], sv[10], sv[11], sv[12], sv[13], sv[14], sv[15]);
#pragma unroll
    for (int dt = 0; dt < 4; ++dt) { O[dt] = MFMA32(Vf[dt * 2], P0, O[dt]); O[dt] = MFMA32(Vf[dt * 2 + 1], P1, O[dt]); }
    kt = ktn; rem = remn;
    return kt >= 0;
  };
  if (kt >= 0) {
    bf16x8 KA[8], KB[8];
    load_k(kt, KA);
#pragma unroll 1
    for (;;) {
      if (!tile_step(KA, KB)) break;
      if (!tile_step(KB, KA)) break;
    }
  }
  asm volatile("s_waitcnt vmcnt(0) lgkmcnt(0)" ::: "memory");
  if (par) {
    ml[lane] = m; ml[64 + lane] = l;
#pragma unroll
    for (int dt = 0; dt < 4; ++dt)
#pragma unroll
      for (int r = 0; r < 16; ++r) mrg[(dt * 16 + r) * 64 + lane] = O[dt][r];
  }
  __syncthreads();
  if (par == 0) {
    const float m2 = ml[lane], l2 = ml[64 + lane];
    const float mm = fmaxf(m, m2);
    const float a1 = __builtin_amdgcn_exp2f(m - mm), a2 = __builtin_amdgcn_exp2f(m2 - mm);
    l = l * a1 + l2 * a2;
#pragma unroll
    for (int dt = 0; dt < 4; ++dt)
#pragma unroll
      for (int r = 0; r < 16; ++r) O[dt][r] = O[dt][r] * a1 + mrg[(dt * 16 + r) * 64 + lane] * a2;
  }
  if (par == 0) {
  l += __shfl_xor(l, 32, 64);
  const float inv = 1.f / l;
  bf16_t* orow = rep ? p.oab2 + ((size_t)b * SEQ + s0 + q) * 512 + h * 128 : p.mb_out + ((size_t)b * SEQ + s0 + q) * p.mb_out_ld + p.mb_out_off + h * 128;
#pragma unroll
  for (int dt = 0; dt < 4; ++dt)
#pragma unroll
    for (int g4 = 0; g4 < 4; ++g4) {
      u32x2 wv; wv.x = pk2(O[dt][4 * g4] * inv, O[dt][4 * g4 + 1] * inv); wv.y = pk2(O[dt][4 * g4 + 2] * inv, O[dt][4 * g4 + 3] * inv);
      *(u32x2*)(orow + 32 * dt + 8 * g4 + 4 * hh) = wv;
    }
  }
  __syncthreads();
}
__device__ void moba_worker(const Params& p, LAS unsigned char* lds, int qi) {
  const int lane = p.tid & 63, w = __builtin_amdgcn_readfirstlane(p.tid >> 6);
  LAS float* km = (LAS float*)(lds + w * 16384);
  LAS float* mrg = (LAS float*)(lds + ((w & 3) + 4) * 16384);
  LAS float* ml = (LAS float*)(lds + 131072) + (w & 3) * 128;
  LAS int* slot = (LAS int*)(lds + 131072 + 2048);
  const int g = (int)((unsigned)__builtin_amdgcn_s_getreg((3 << 11) | 20) & 7u);
  for (;;) {
    __syncthreads();
    if (p.tid == 0) slot[0] = atomicAdd(p.wq + qi * 8 + g, 1);
    __syncthreads();
    const int idx = slot[0];
    if (idx >= 64) break;
    const int bh = 2 * g + (idx >> 5), ib = 15 - ((idx >> 1) & 15), quad = 1 - (idx & 1);
    moba_item(p, km, mrg, ml, bh, ib, 4 * quad + (w & 3), w >> 2, lane, qi);
  }
}
__device__ void ph_mod(const Params& p, LAS unsigned char* lds, int nblk, int bid) {
  LAS float* sc = (LAS float*)lds;
  LAS float* part = (LAS float*)(lds + 16384);
  const int tid = p.tid;
  if (bid >= 192) return;
  for (int i = tid; i < 4096; i += 512) sc[i] = siluf_(p.c[i]);
  __syncthreads();
  for (int task = bid; task < 192; task += nblk) {
    const int jj = tid & 31, ks = tid >> 5, j = task * 32 + jj;
    float a0 = 0.f, a1 = 0.f, a2 = 0.f, a3 = 0.f;
#pragma unroll 8
    for (int kk = 0; kk < 64; ++kk) {
      const int k = ks * 64 + kk;
      const float w = p.w_ada[(size_t)k * 6144 + j];
      a0 += sc[k] * w; a1 += sc[1024 + k] * w; a2 += sc[2048 + k] * w; a3 += sc[3072 + k] * w;
    }
    *(LAS f32x4*)(part + (ks * 32 + jj) * 4) = (f32x4){a0, a1, a2, a3};
    __syncthreads();
    if (tid < 128) {
      const int j2 = tid & 31, bb = tid >> 5;
      float a = 0.f;
#pragma unroll
      for (int s = 0; s < 16; ++s) a += part[(s * 32 + j2) * 4 + bb];
      p.mod[bb * 6144 + task * 32 + j2] = a + p.b_ada[task * 32 + j2];
    }
    __syncthreads();
  }
}

#define WT_T0 1424
#define WT_T1 (WT_T0 + 16384)
#define WT_T2 (WT_T1 + 8192)
#define WT_T3 (WT_T2 + 128)
#define WT_T4 (WT_T3 + 128)
#define WT_T5 (WT_T4 + 256)
struct WtTile { const float* src; bf16_t* dst; int K, N, mode, k0, n0; };
__device__ __forceinline__ WtTile wt_desc(const Params& p, int t) {
  WtTile d;
  if (t < WT_T0) { const int kt = t / 89, nt = t % 89; d = {p.w_in, p.w_in_t, 1024, INW, 1, kt * 64, nt * 64}; }
  else if (t < WT_T1) { const int u = t - WT_T0, e = u >> 9, r = u & 511, kt = r >> 5, nt = r & 31; d = {p.w_gu + (size_t)e * 1024 * 2048, p.wgu_t + (size_t)e * 2048 * 1024, 1024, 2048, 2, kt * 64, nt * 64}; }
  else if (t < WT_T2) { const int u = t - WT_T1, e = u >> 8, r = u & 255, kt = r >> 4, nt = r & 15; d = {p.w_down + (size_t)e * 1024 * 1024, p.wd_t + (size_t)e * 1024 * 1024, 1024, 1024, 0, kt * 64, nt * 64}; }
  else if (t < WT_T3) { const int u = t - WT_T2, kt = u >> 4, nt = u & 15; d = {p.w_br_a, p.wbra_t, 512, 1024, 0, kt * 64, nt * 64}; }
  else if (t < WT_T4) { const int u = t - WT_T3, kt = u >> 4, nt = u & 15; d = {p.w_br_b, p.wbrb_t, 512, 1024, 0, kt * 64, nt * 64}; }
  else { const int u = t - WT_T4, kt = u >> 4, nt = u & 15; d = {p.w_o, p.wo_t, 1024, 1024, 0, kt * 64, nt * 64}; }
  return d;
}
__device__ __forceinline__ void wt_load(const WtTile& d, int tid, f32x4 (&v)[2]) {
#pragma unroll
  for (int it = 0; it < 2; ++it) {
    const int row = (tid >> 4) + 32 * it, n = d.n0 + (tid & 15) * 4;
    v[it] = (f32x4){0.f, 0.f, 0.f, 0.f};
    if (n < d.N) v[it] = __builtin_nontemporal_load((const f32x4*)(d.src + (size_t)(d.k0 + row) * d.N + n));
  }
}
__device__ void ph_wt(const Params& p, LAS unsigned char* lds, int nblk, int bid) {
  LAS float* tile = (LAS float*)(lds + 32768);
  const int tid = p.tid;
  int t = bid;
  if (t >= WT_T5) return;
  WtTile cur = wt_desc(p, t);
  f32x4 v[2]; wt_load(cur, tid, v);
  for (;;) {
    const int tn = t + nblk;
    WtTile nxt = cur; f32x4 vn[2];
    if (tn < WT_T5) { nxt = wt_desc(p, tn); wt_load(nxt, tid, vn); }
#pragma unroll
    for (int it = 0; it < 2; ++it) {
      const int row = (tid >> 4) + 32 * it, c4 = (tid & 15) * 4;
      tile[row * 65 + c4] = v[it][0]; tile[row * 65 + c4 + 1] = v[it][1]; tile[row * 65 + c4 + 2] = v[it][2]; tile[row * 65 + c4 + 3] = v[it][3];
    }
    __syncthreads();
    {
      const int nl = tid >> 3, kc = tid & 7, n = cur.n0 + nl;
      if (n < cur.N) {
        const int dd = map_col(n, cur.mode);
        if (dd >= 0) {
          float f[8];
#pragma unroll
          for (int j = 0; j < 8; ++j) f[j] = tile[(8 * kc + j) * 65 + nl];
          u32x4 w; w.x = pk2(f[0], f[1]); w.y = pk2(f[2], f[3]); w.z = pk2(f[4], f[5]); w.w = pk2(f[6], f[7]);
          *(u32x4*)(cur.dst + (size_t)dd * cur.K + cur.k0 + 8 * kc) = w;
        }
      }
    }
    __syncthreads();
    if (tn >= WT_T5) break;
    t = tn; cur = nxt; v[0] = vn[0]; v[1] = vn[1];
  }
}

__device__ void ph_h(const Params& p, LAS unsigned char* lds, int nblk, int bid) {
  const int wid = p.tid >> 6, lane = p.tid & 63;
  LAS float* wb = (LAS float*)lds;
  for (int i = p.tid; i < 2048; i += 512) {
    const int k = i >> 1, hf = i & 1;
    const f32x4 v = *(const f32x4*)(p.w_in + (size_t)k * INW + 2048 + 4 * hf);
    wb[(4 * hf + 0) * 1024 + k] = v[0]; wb[(4 * hf + 1) * 1024 + k] = v[1]; wb[(4 * hf + 2) * 1024 + k] = v[2]; wb[(4 * hf + 3) * 1024 + k] = v[3];
  }
  __syncthreads();
  for (int t = bid * 8 + wid; t < T_TOK; t += nblk * 8) {
    const int b = t / SEQ;
    const float* xr = p.x + (size_t)t * DM;
    f32x4 xv[4];
    float ss = 0.f;
#pragma unroll
    for (int i = 0; i < 4; ++i) {
      xv[i] = *(const f32x4*)(xr + i * 256 + lane * 4);
      ss += xv[i][0] * xv[i][0] + xv[i][1] * xv[i][1] + xv[i][2] * xv[i][2] + xv[i][3] * xv[i][3];
    }
    ss = wave_sum(ss);
    const float rstd = rsqrtf(ss * (1.f / DM) + 1e-6f);
    const float* shift = p.mod + b * 6144;
    const float* scale = p.mod + b * 6144 + 1024;
    float acc[8] = {0, 0, 0, 0, 0, 0, 0, 0};
#pragma unroll
    for (int i = 0; i < 4; ++i) {
      const int k = i * 256 + lane * 4;
      const f32x4 g = *(const f32x4*)(p.g_pre_mix + k), sc = *(const f32x4*)(scale + k), sh = *(const f32x4*)(shift + k);
      f32x4 hv;
#pragma unroll
      for (int j = 0; j < 4; ++j) hv[j] = xv[i][j] * rstd * g[j] * (1.f + sc[j]) + sh[j];
#pragma unroll
      for (int e = 0; e < 8; ++e) { const f32x4 w = *(const LAS f32x4*)(wb + e * 1024 + k); acc[e] += hv[0] * w[0] + hv[1] * w[1] + hv[2] * w[2] + hv[3] * w[3]; }
      u32x2 pk; pk.x = pk2(hv[0], hv[1]); pk.y = pk2(hv[2], hv[3]);
      *(u32x2*)(p.hbf + (size_t)t * DM + k) = pk;
    }
#pragma unroll
    for (int e = 0; e < 8; ++e) acc[e] = wave_sum(acc[e]);
    if (lane == 0) { *(f32x4*)(p.ba + (size_t)t * 8) = (f32x4){acc[0], acc[1], acc[2], acc[3]}; *(f32x4*)(p.ba + (size_t)t * 8 + 4) = (f32x4){acc[4], acc[5], acc[6], acc[7]}; }
  }
}

__device__ void ph_post_mix(const Params& p, LAS unsigned char* lds, int nblk, int bid, int rep) {
  const int wid = p.tid >> 6, lane = p.tid & 63;
  LAS bf16_t* wl = (LAS bf16_t*)lds;
  LAS float* sh = (LAS float*)(lds + 81920) + wid * 1024;
  LAS int* lcnt = (LAS int*)(lds + 114688);
  LAS int* lbase = lcnt + 32;
  LAS int* lent = (LAS int*)(lds + 115200) + wid * 256;
  int nloc = 0;
  if (p.tid < 32) lcnt[p.tid] = 0;
  for (int i = p.tid; i < 1024 * 8; i += 512) {
    const int k = i >> 3, c = i & 7;
    const f32x4 v = *(const f32x4*)(p.w_router + (size_t)k * 32 + c * 4);
    u32x2 w2; w2.x = pk2(v[0], v[1]); w2.y = pk2(v[2], v[3]);
    *(LAS u32x2*)(wl + k * 40 + c * 4) = w2;
  }
  __syncthreads();
  for (int t = bid * 8 + wid; t < T_TOK; t += nblk * 8) {
    const int b = t / SEQ;
    const float* md = p.mod + b * 6144;
    float mv[16];
    float ss = 0.f;
#pragma unroll
    for (int i = 0; i < 2; ++i) {
      float f[8]; unpack8(*(const u32x4*)(p.mixer + (size_t)t * DM + i * 512 + lane * 8), f);
#pragma unroll
      for (int j = 0; j < 8; ++j) { mv[i * 8 + j] = f[j]; ss += f[j] * f[j]; }
    }
    ss = wave_sum(ss);
    const float rstd = rsqrtf(ss * (1.f / DM) + 1e-6f);
    float x1[16];
    float s2 = 0.f;
#pragma unroll
    for (int i = 0; i < 2; ++i)
#pragma unroll
      for (int j4 = 0; j4 < 2; ++j4) {
        const int k = i * 512 + lane * 8 + j4 * 4;
        const f32x4 xv = *(const f32x4*)(p.x + (size_t)t * DM + k);
        const f32x4 gm = *(const f32x4*)(md + 2048 + k), gp = *(const f32x4*)(p.g_post_mix + k);
        f32x4 o;
#pragma unroll
        for (int j = 0; j < 4; ++j) { o[j] = xv[j] + gm[j] * (mv[i * 8 + j4 * 4 + j] * rstd * gp[j]); x1[i * 8 + j4 * 4 + j] = o[j]; s2 += o[j] * o[j]; }
        *(f32x4*)(p.out + (size_t)t * DM + k) = o;
      }
    s2 = wave_sum(s2);
    const float rstd2 = rsqrtf(s2 * (1.f / DM) + 1e-6f);
#pragma unroll
    for (int i = 0; i < 2; ++i) {
      float hv[8];
#pragma unroll
      for (int j = 0; j < 8; ++j) {
        const int k = i * 512 + lane * 8 + j;
        hv[j] = x1[i * 8 + j] * rstd2 * p.g_pre_ffn[k] * (1.f + md[4096 + k]) + md[3072 + k];
        sh[k] = hv[j];
      }
      u32x4 w; w.x = pk2(hv[0], hv[1]); w.y = pk2(hv[2], hv[3]); w.z = pk2(hv[4], hv[5]); w.w = pk2(hv[6], hv[7]);
      *(u32x4*)(p.h2 + (size_t)t * DM + i * 512 + lane * 8) = w;
    }
#ifdef PM_SKIP
    if (rep) continue;
#endif
    float acc[32];
#pragma unroll
    for (int e2 = 0; e2 < 32; ++e2) acc[e2] = 0.f;
#pragma unroll 4
    for (int i = 0; i < 16; ++i) {
      const float hk = sh[lane + 64 * i];
      const LAS u32x4* wr = (const LAS u32x4*)(wl + (lane + 64 * i) * 40);
#pragma unroll
      for (int c4 = 0; c4 < 4; ++c4) {
        float f[8]; unpack8(wr[c4], f);
#pragma unroll
        for (int j = 0; j < 8; ++j) acc[c4 * 8 + j] += hk * f[j];
      }
    }
    {
      const bool u5 = lane & 32, u4 = lane & 16, u3 = lane & 8, u2 = lane & 4, u1 = lane & 2;
      float a16[16], a8[8], a4[4], a2[2];
#pragma unroll
      for (int j = 0; j < 16; ++j) { const float snd = u5 ? acc[j] : acc[16 + j]; const float rcv = __shfl_xor(snd, 32, 64); a16[j] = (u5 ? acc[16 + j] : acc[j]) + rcv; }
#pragma unroll
      for (int j = 0; j < 8; ++j) { const float snd = u4 ? a16[j] : a16[8 + j]; const float rcv = __shfl_xor(snd, 16, 64); a8[j] = (u4 ? a16[8 + j] : a16[j]) + rcv; }
#pragma unroll
      for (int j = 0; j < 4; ++j) { const float snd = u3 ? a8[j] : a8[4 + j]; const float rcv = __shfl_xor(snd, 8, 64); a4[j] = (u3 ? a8[4 + j] : a8[j]) + rcv; }
#pragma unroll
      for (int j = 0; j < 2; ++j) { const float snd = u2 ? a4[j] : a4[2 + j]; const float rcv = __shfl_xor(snd, 4, 64); a2[j] = (u2 ? a4[2 + j] : a4[j]) + rcv; }
      const float snd = u1 ? a2[0] : a2[1]; const float rcv = __shfl_xor(snd, 2, 64);
      float a1 = (u1 ? a2[1] : a2[0]) + rcv;
      a1 += __shfl_xor(a1, 1, 64);
      acc[0] = a1;
    }
    const int e = lane >> 1;
    float lg = acc[0] + p.b_router[e];
    if (lane & 1) lg = -INFINITY;
    float tv[4]; int ti[4];
#pragma unroll
    for (int r = 0; r < 4; ++r) {
      const float m = wave_max(lg);
      const unsigned long long bal = __ballot(lg == m);
      const int idx = __ffsll((long long)bal) - 1;
      tv[r] = m; ti[r] = idx >> 1;
      if (lane == idx) lg = -INFINITY;
    }
    const float e1 = __expf(tv[1] - tv[0]), e2 = __expf(tv[2] - tv[0]), e3 = __expf(tv[3] - tv[0]);
    const float inv = 1.f / (1.f + e1 + e2 + e3);
    if (lane < 4) {
      const int ee = lane == 0 ? ti[0] : lane == 1 ? ti[1] : lane == 2 ? ti[2] : ti[3];
      const float ww = (lane == 0 ? 1.f : lane == 1 ? e1 : lane == 2 ? e2 : e3) * inv;
      p.aw[t * 4 + lane] = ww;
      const int rank = __hip_atomic_fetch_add(&lcnt[ee], 1, __ATOMIC_RELAXED, __HIP_MEMORY_SCOPE_WORKGROUP);
      lent[nloc * 4 + lane] = (ee << 16) | rank;
      lent[nloc * 4 + lane + 2048] = t * 4 + lane;
    }
    ++nloc;
  }
  __syncthreads();
  if (p.tid < 32) lbase[p.tid] = atomicAdd(&p.cnt[p.tid * 64 + 32 * rep], lcnt[p.tid]);
  __syncthreads();
  for (int i = lane; i < nloc * 4; i += 64) {
    const int er = lent[i], a = lent[i + 2048];
    p.elist[(er >> 16) * T_TOK + lbase[er >> 16] + (er & 0xffff)] = a;
  }
}

__device__ void ph_gather(const Params& p, LAS unsigned char* lds, int nblk, int bid) {
  const int wid = p.tid >> 6, lane = p.tid & 63;
  LAS int* tb = (LAS int*)lds;
  if (p.tid == 0) { int off = 0; for (int k = 0; k < NE; ++k) { const int c = p.cnt[k * 64]; tb[k] = off; tb[64 + k] = c; off += ((c + 255) >> 8) << 8; } tb[NE] = off; }
  __syncthreads();
  const int total = tb[NE];
  for (int r = bid * 8 + wid; r < total; r += nblk * 8) {
    int e = 0;
#pragma unroll 1
    for (int k = 1; k < NE; ++k) if (r >= tb[k]) e = k;
    const int i = r - tb[e];
    const int a = (i < tb[64 + e]) ? p.elist[e * T_TOK + i] : -1;
    if (lane == 0) p.rowmap[r] = a;
    u32x4 v0 = {0, 0, 0, 0}, v1 = v0;
    if (a >= 0) { const u32x4* src = (const u32x4*)(p.h2 + (size_t)(a >> 2) * DM); v0 = src[lane]; v1 = src[64 + lane]; }
    u32x4* dst = (u32x4*)(p.xs + (size_t)r * DM);
    dst[lane] = v0; dst[64 + lane] = v1;
  }
}

__device__ void ph_final(const Params& p, int nblk, int bid, int rep) {
  const int wid = p.tid >> 6, lane = p.tid & 63;
  for (int t0 = bid * 8 + wid; t0 < T_TOK; t0 += nblk * 16) {
    int tt[2] = {t0, t0 + nblk * 8};
    if (tt[1] >= T_TOK) tt[1] = t0;
    float mv[2][16]; float ss[2];
#pragma unroll
    for (int u = 0; u < 2; ++u) {
      const int t = tt[u];
      const f32x4 wv = *(const f32x4*)(p.aw + t * 4);
      ss[u] = 0.f;
#pragma unroll
      for (int i = 0; i < 2; ++i) {
        const bf16_t* y = p.yslot + (size_t)t * 4 * DM + i * 512 + lane * 8;
        float f0[8], f1[8], f2[8], f3[8];
        unpack8(*(const u32x4*)y, f0); unpack8(*(const u32x4*)(y + DM), f1); unpack8(*(const u32x4*)(y + 2 * DM), f2); unpack8(*(const u32x4*)(y + 3 * DM), f3);
#pragma unroll
        for (int j = 0; j < 8; ++j) { const float m = wv[0] * f0[j] + wv[1] * f1[j] + wv[2] * f2[j] + wv[3] * f3[j]; mv[u][i * 8 + j] = m; ss[u] += m * m; }
      }
    }
    f32x4 x1[2][4];
#pragma unroll
    for (int u = 0; u < 2; ++u)
#pragma unroll
      for (int i = 0; i < 2; ++i)
#pragma unroll
        for (int j4 = 0; j4 < 2; ++j4) x1[u][i * 2 + j4] = *(const f32x4*)(p.out + (size_t)tt[u] * DM + i * 512 + lane * 8 + j4 * 4);
    ss[0] = wave_sum(ss[0]); ss[1] = wave_sum(ss[1]);
#pragma unroll
    for (int u = 0; u < 2; ++u) {
      const int t = tt[u];
      if (u == 1 && t == t0) break;
      const float* md = p.mod + (t / SEQ) * 6144;
      const float rstd = rsqrtf(ss[u] * (1.f / DM) + 1e-6f);
#pragma unroll
      for (int i = 0; i < 2; ++i)
#pragma unroll
        for (int j4 = 0; j4 < 2; ++j4) {
          const int k = i * 512 + lane * 8 + j4 * 4;
          float* op = p.out + (size_t)t * DM + k;
          const f32x4 gf = *(const f32x4*)(md + 5120 + k), gp = *(const f32x4*)(p.g_post_ffn + k);
          f32x4 o;
#pragma unroll
          for (int j = 0; j < 4; ++j) o[j] = x1[u][i * 2 + j4][j] + gf[j] * (mv[u][i * 8 + j4 * 4 + j] * rstd * gp[j]);
          *(f32x4*)(rep ? (float*)p.hbf + (size_t)(t & 8191) * DM + k : op) = o;
        }
    }
  }
}

#define XCD_BAR_WORDS 3456
struct KArgs { const void* in[22]; float* out; char* ws; long long never; };
__host__ __device__ inline size_t al(size_t x) { return (x + 255) & ~(size_t)255; }
__host__ __device__ inline void fill_params(Params& p, const KArgs& k) {
  p.x = (const float*)k.in[0]; p.c = (const float*)k.in[1]; p.w_ada = (const float*)k.in[2]; p.b_ada = (const float*)k.in[3];
  p.g_pre_mix = (const float*)k.in[4]; p.g_post_mix = (const float*)k.in[5]; p.g_pre_ffn = (const float*)k.in[6];
  p.g_post_ffn = (const float*)k.in[7]; p.w_in = (const float*)k.in[8]; p.conv_w = (const float*)k.in[9];
  p.a_log = (const float*)k.in[10]; p.dt_bias = (const float*)k.in[11]; p.g_dn_out = (const float*)k.in[12];
  p.w_br_a = (const float*)k.in[13]; p.w_br_b = (const float*)k.in[14]; p.w_o = (const float*)k.in[15];
  p.w_router = (const float*)k.in[16]; p.b_router = (const float*)k.in[17]; p.w_gu = (const float*)k.in[18];
  p.b_gu = (const float*)k.in[19]; p.w_down = (const float*)k.in[20]; p.b_down = (const float*)k.in[21];
  p.out = k.out;
  char* w = k.ws;
  size_t o = 0;
#define take(bytes) (w + (o += al(bytes)) - al(bytes))
  p.mod = (float*)take(4 * 6144 * 4);
  p.cnt = (int*)take(16384);
  p.ba = (float*)take((size_t)T_TOK * 8 * 4);
  p.hbf = (bf16_t*)take((size_t)T_TOK * DM * 2);
  p.proj = (bf16_t*)take((size_t)T_TOK * PW * 2);
  p.w_in_t = (bf16_t*)take((size_t)PW * DM * 2);
  p.wgu_t = (bf16_t*)take((size_t)NE * 2048 * DM * 2);
  p.wd_t = (bf16_t*)take((size_t)NE * 1024 * DM * 2);
  p.wbra_t = (bf16_t*)take((size_t)1024 * 512 * 2);
  p.wbrb_t = (bf16_t*)take((size_t)1024 * 512 * 2);
  p.wo_t = (bf16_t*)take((size_t)1024 * 1024 * 2);
  p.qb = (bf16_t*)take((size_t)T_TOK * 512 * 2);
  p.kb = (bf16_t*)take((size_t)T_TOK * 512 * 2);
  p.kmean = (float*)take((size_t)16 * 16 * 128 * 4);
  p.oab = (bf16_t*)take((size_t)T_TOK * DM * 2);
  p.merged = (bf16_t*)take((size_t)T_TOK * DM * 2);
  p.mixer = (bf16_t*)take((size_t)T_TOK * DM * 2);
  p.h2 = (bf16_t*)take((size_t)T_TOK * DM * 2);
  p.elist = (int*)take((size_t)NE * T_TOK * 4);
  p.aw = (float*)take((size_t)T_TOK * 4 * 4);
  p.rowmap = (int*)take((size_t)73728 * 4);
  p.dnA = (unsigned char*)take((size_t)1024 * DN_ABYTES);
  p.dnU = (float*)take((size_t)1024 * DN_UFLOATS * 4);
  p.dnG = (float*)take(4096);
  p.oab2 = (bf16_t*)take((size_t)T_TOK * 512 * 2);
  p.dbg = (float*)take(256);
  p.bar = (unsigned*)take(XCD_BAR_WORDS * 4);
  p.dn_out = p.oab; p.dn_out_ld = DM;
  p.Kp = (bf16_t*)take((size_t)16 * 128 * 8192);
  p.Vp = (bf16_t*)take((size_t)16 * 128 * 8192);
  p.wq = p.cnt + 32 * 64;
  p.mb_out = p.oab; p.mb_out_ld = DM; p.mb_out_off = 512;
  p.xs = p.proj;
  char* big = take((size_t)73728 * DM * 2 + (size_t)65536 * DM * 2);
  p.act = (bf16_t*)big;
  p.yslot = (bf16_t*)(big + (size_t)73728 * DM * 2);
  {
    char* s = big; size_t so = 0;
#define t2(bytes) (s + (so += al(bytes)) - al(bytes))
    p.nq = (float*)t2((size_t)T_TOK * 512 * 4);
    p.nk = (float*)t2((size_t)T_TOK * 512 * 4);
    p.nv = (float*)t2((size_t)T_TOK * 512 * 4);
    p.no = (float*)t2((size_t)T_TOK * 512 * 4);
    p.ntmp = (float*)t2((size_t)T_TOK * DM * 4);
    p.nbeta = (float*)t2((size_t)T_TOK * 4 * 4);
    p.ng = (float*)t2((size_t)T_TOK * 4 * 4);
  }

#undef take
#undef t2
  p.never = (int)k.never;
}

#define XB_TMO      128
#define XB_XCNT(j)  (256  + 64 * (j))
#define XB_XSUB(j)  (1280 + 64 * (j))
#define XB_XGEN(j)  (2304 + 64 * (j))
#define XB_TOP      3328
#define XB_TOPGEN   3392
#define XB_SPIN_CAP (1u << 18)

__device__ __forceinline__ unsigned xb_ld(unsigned* p)              { return __hip_atomic_load(p, __ATOMIC_RELAXED, __HIP_MEMORY_SCOPE_AGENT); }
__device__ __forceinline__ unsigned xb_add(unsigned* p, unsigned v) { return __hip_atomic_fetch_add(p, v, __ATOMIC_RELAXED, __HIP_MEMORY_SCOPE_AGENT); }
__device__ __forceinline__ unsigned xb_xcc_id() { return (unsigned)__builtin_amdgcn_s_getreg((3 << 11) | 20) & 0xFu; }
#define XB_SPIN(cond, bar) do { unsigned _sp = 0; while (cond) { __builtin_amdgcn_s_sleep(1); \
    if ((++_sp & 255u) == 0u) { if (xb_ld(&(bar)[XB_TMO])) break; if (_sp > XB_SPIN_CAP) { atomicAdd(&(bar)[XB_TMO], 1u); break; } } } } while (0)

struct XcdBarrier {
    unsigned* bar; unsigned x;
    volatile LAS unsigned* st;
};

__device__ __forceinline__ XcdBarrier xcd_barrier_post(unsigned* bar, volatile LAS unsigned* st) {
    XcdBarrier b; b.bar = bar; b.x = xb_xcc_id(); b.st = st;
    if (threadIdx.x == 0) (void)xb_add(&bar[XB_XCNT(b.x)], 1u);
    return b;
}
__device__ __forceinline__ void xcd_barrier_complete(unsigned* bar, unsigned x, unsigned& nloc, unsigned& nx) {
    const unsigned G = gridDim.x * gridDim.y * gridDim.z;
    unsigned sum, cnt, mine, sp = 0u;
    for (;;) {
        sum = 0u; cnt = 0u; mine = 0u;
#pragma unroll
        for (unsigned j = 0; j < 16; ++j) { const unsigned c = xb_ld(&bar[XB_XCNT(j)]); sum += c; cnt += (c > 0u) ? 1u : 0u; mine = (j == x) ? c : mine; }
        if (sum == G) break;
        __builtin_amdgcn_s_sleep(1);
        if ((++sp & 255u) == 0u) { if (xb_ld(&bar[XB_TMO])) break; if (sp > XB_SPIN_CAP) { atomicAdd(&bar[XB_TMO], 1u); break; } }
    }
    nloc = mine > 0u ? mine : 1u; nx = cnt > 0u ? cnt : 1u;
}

__device__ __forceinline__ void xcd_barrier(const XcdBarrier& b, const int tid) {
    asm volatile("s_waitcnt vmcnt(0)" ::: "memory");
    __syncthreads();
    if (tid == 0) {
        unsigned* bar = b.bar;
        __builtin_amdgcn_s_waitcnt(0);
        unsigned nloc = b.st[0], nx = b.st[1];
        if (nloc == 0u) { xcd_barrier_complete(bar, b.x, nloc, nx); b.st[0] = nloc; b.st[1] = nx; }
        const unsigned old = xb_add(&bar[XB_XSUB(b.x)], 1u);
        const unsigned gen = old / nloc;
        if (old + 1u == (gen + 1u) * nloc) {
            __builtin_amdgcn_fence(__ATOMIC_RELEASE, "agent");
            asm volatile("s_waitcnt vmcnt(0)" ::: "memory");
            const unsigned og = xb_add(&bar[XB_TOP], 1u);
            const unsigned tg = og / nx;
            if (og + 1u == (tg + 1u) * nx) xb_add(&bar[XB_TOPGEN], 1u);
            else XB_SPIN(xb_ld(&bar[XB_TOPGEN]) == tg, bar);
            __builtin_amdgcn_fence(__ATOMIC_ACQUIRE, "agent");
            xb_add(&bar[XB_XGEN(b.x)], 1u);
            asm volatile("s_waitcnt vmcnt(0)" ::: "memory");
        } else {
            XB_SPIN(xb_ld(&bar[XB_XGEN(b.x)]) == gen, bar);
            __builtin_amdgcn_fence(__ATOMIC_ACQUIRE, "agent");
            asm volatile("s_waitcnt vmcnt(0)" ::: "memory");
        }
    }
    __syncthreads();
}


__device__ __forceinline__ void load_ka(KArgs& kk) {
#if defined(__HIP_DEVICE_COMPILE__)
  typedef __attribute__((address_space(1))) char* gptr_t;
  typedef const __attribute__((address_space(4))) gptr_t* kptr_t;
  kptr_t kp = (kptr_t)__builtin_amdgcn_kernarg_segment_ptr();
  asm volatile("" : "+s"(kp));
#pragma unroll
  for (int i = 0; i < 22; ++i) kk.in[i] = (const void*)kp[i];
  kk.out = (float*)kp[22];
  kk.ws = (char*)kp[23];
  kk.never = ((const __attribute__((address_space(4))) long long*)kp)[24];
#endif
}
__device__ __forceinline__ void grid_bar(const Params& p, LAS unsigned char* lds);
#define MEGA_LDS 148480
#define MEGA_LDS_ALLOC (MEGA_LDS + 16)
__device__ __forceinline__ void grid_bar(const Params& p, LAS unsigned char* lds) {
  XcdBarrier b; b.bar = p.bar; b.x = xb_xcc_id(); b.st = (volatile LAS unsigned*)(lds + MEGA_LDS);
  xcd_barrier(b, p.tid);
}
__global__ __launch_bounds__(512) void mega(KArgs ka) {
  extern __shared__ __attribute__((aligned(16))) unsigned char shm[];
  LAS unsigned char* lds = (LAS unsigned char*)shm;
  cg::grid_group grid = cg::this_grid();
  const int nblk = gridDim.x, bid = blockIdx.x;
  const int wv_ = __builtin_amdgcn_readfirstlane(threadIdx.x >> 6);
  volatile LAS unsigned* xst = (volatile LAS unsigned*)(lds + MEGA_LDS);
  if (threadIdx.x == 0) { xst[0] = 0u; xst[1] = 0u; xst[2] = 0u; xst[3] = 0u; }
  __syncthreads();
  { Params p0; fill_params(p0, ka); (void)xcd_barrier_post(p0.bar, xst); }
  if (ka.never) grid.sync();
#ifndef REPMASK
#define REPMASK 0
#endif
#define LOADKA KArgs kk; load_ka(kk)
#ifndef PHMASK
#define PHMASK 0xffff
#endif
#define PHASE(k, body) if (((PHMASK) >> (k)) & 1) for (int rep_ = 0; rep_ < (((REPMASK) >> (k)) & 1) + 1; ++rep_) { \
    LOADKA; Params p; fill_params(p, kk); { int t_; asm volatile("v_mbcnt_lo_u32_b32 %0, -1, 0\n\tv_mbcnt_hi_u32_b32 %0, -1, %0" : "=v"(t_)); p.tid = (wv_ << 6) | t_; } body; grid_bar(p, lds); }
#ifdef XBAR
  for (int xb_ = 0; xb_ < XBAR; ++xb_) { PHASE(15, {}) }
#endif
  PHASE(0, { ph_mod(p, lds, nblk, bid); ph_wt(p, lds, nblk, bid); })
  PHASE(1, { ph_h(p, lds, nblk, bid); })
  PHASE(2, { ph_proj(p, lds, nblk, bid); })
  PHASE(3, { bool first = true; for (int ci = bid; ci < 1024; ci += nblk) { dn_prep_chunk(p, lds, ci, first); first = false; }
             for (int item = bid; item < 256; item += nblk) moba_prep_block(p, lds, item); })
  PHASE(4, { if (bid < 32) dn_scan_blk(p, lds, bid); moba_worker(p, lds, rep_); })
  PHASE(5, { ph_dn_norm(p, nblk, bid); })
  PHASE(6, { ph_br(p, lds, nblk, bid); })
  PHASE(7, { ph_mix(p, lds, nblk, bid); })
  PHASE(8, { ph_post_mix(p, lds, nblk, bid, rep_); })
  PHASE(10, { ph_moe1(p, lds, nblk, bid); })
  PHASE(11, { ph_moe2(p, lds, nblk, bid); })
  PHASE(12, { ph_final(p, nblk, bid, rep_); })
}


extern "C" void kernel_launch(void* const* d_in, const int* in_sizes, int n_in, void* d_out, int out_size, void* d_ws,
                              size_t ws_size, hipStream_t stream) {
  KArgs ka{};
  for (int i = 0; i < 22; ++i) ka.in[i] = d_in[i];
  ka.out = (float*)d_out; ka.ws = (char*)d_ws; ka.never = 0;
  Params p{};
  fill_params(p, ka);
  static int grid_blocks = 0;
  if (!grid_blocks) {
    (void)hipFuncSetAttribute((const void*)mega, hipFuncAttributeMaxDynamicSharedMemorySize, MEGA_LDS_ALLOC);
    int dev = 0, cus = 0, per_cu = 0;
    (void)hipGetDevice(&dev);
    (void)hipDeviceGetAttribute(&cus, hipDeviceAttributeMultiprocessorCount, dev);
    (void)hipOccupancyMaxActiveBlocksPerMultiprocessor(&per_cu, mega, 512, MEGA_LDS_ALLOC);
    if (per_cu != 1) per_cu = 1;
    grid_blocks = cus * per_cu;
  }
  (void)hipMemsetAsync(p.cnt, 0, 16384, stream);
  (void)hipMemsetAsync(p.bar, 0, XCD_BAR_WORDS * 4, stream);
  void* args[] = {&ka};
  hipError_t e = hipLaunchCooperativeKernel((void*)mega, dim3(grid_blocks), dim3(512), args, MEGA_LDS_ALLOC, stream);
  if (e != hipSuccess) fprintf(stderr, "cooperative launch failed: %s (grid %d)\n", hipGetErrorString(e), grid_blocks);
}
```

```cpp
#include <hip/hip_runtime.h>
#include <hip/hip_cooperative_groups.h>
#include <cstdio>
namespace cg = cooperative_groups;
#include <stdint.h>

typedef unsigned short bf16_t;
#ifndef MB_ABL
#define MB_ABL 0
#endif

#define T_TOK 16384
#define SEQ 4096
#define NB 4
#define DM 1024
#define INW 5640
#define PW 5632
#define C_QA 0
#define C_KA 512
#define C_VA 1024
#define C_Z 1536
#define C_MQ 2048
#define C_MK 2560
#define C_MV 3072
#define C_GA 3584
#define C_GB 4608
#define NE 32

__device__ __forceinline__ bf16_t f2bf(float f) {
  unsigned u = __float_as_uint(f);
  u += 0x7fffu + ((u >> 16) & 1u);
  return (bf16_t)(u >> 16);
}
__device__ __forceinline__ float bf2f(bf16_t h) { return __uint_as_float(((unsigned)h) << 16); }
__device__ __forceinline__ float sigmoidf_(float x) { return 1.f / (1.f + __expf(-x)); }
__device__ __forceinline__ float siluf_(float x) { return x / (1.f + __expf(-x)); }
__device__ __forceinline__ float wave_sum(float v) {
#pragma unroll
  for (int o = 32; o > 0; o >>= 1) v += __shfl_xor(v, o, 64);
  return v;
}
__device__ __forceinline__ float wave_max(float v) {
#pragma unroll
  for (int o = 32; o > 0; o >>= 1) v = fmaxf(v, __shfl_xor(v, o, 64));
  return v;
}

typedef __bf16 bf16x2_t __attribute__((ext_vector_type(2)));
typedef float f32x2_t __attribute__((ext_vector_type(2)));
__device__ __forceinline__ unsigned pk2(float a, float b) { f32x2_t v = {a, b}; bf16x2_t r = __builtin_convertvector(v, bf16x2_t); return __builtin_bit_cast(unsigned, r); }

struct Params {
  const float *x, *c, *w_ada, *b_ada, *g_pre_mix, *g_post_mix, *g_pre_ffn, *g_post_ffn, *w_in, *conv_w,
      *a_log, *dt_bias, *g_dn_out, *w_br_a, *w_br_b, *w_o, *w_router, *b_router, *w_gu, *b_gu, *w_down, *b_down;
  float* out;
  float* mod;
  int* cnt;
  float* ba;
  bf16_t* hbf;
  bf16_t* proj;
  bf16_t* w_in_t;
  bf16_t* wgu_t;
  bf16_t* wd_t;
  bf16_t* wbra_t;
  bf16_t* wbrb_t;
  bf16_t* wo_t;
  bf16_t* qb;
  bf16_t* kb;
  float* kmean;
  bf16_t* oab;
  bf16_t* merged;
  bf16_t* mixer;
  bf16_t* h2;
  int* elist;
  float* aw;
  bf16_t* act;
  bf16_t* xs;
  int* rowmap;
  bf16_t* yslot;
  unsigned char* dnA; float* dnU; float* dnG;
  bf16_t* dn_out; int dn_out_ld;
  bf16_t* oab2; float* dbg;
  unsigned* bar; int never; int tid;
  bf16_t* Kp; bf16_t* Vp; int* wq;
  bf16_t* mb_out; int mb_out_ld; int mb_out_off;
  float* nq; float* nk; float* nv;
  float* nbeta; float* ng;
  float* no;
  float* ntmp;
};

__device__ __forceinline__ int map_col(int n, int mode) {
  if (mode == 0) return n;
  if (mode == 1) return n < 2048 ? n : (n < 2056 ? -1 : n - 8);
  if (n < 1024) return (n >> 7) * 256 + (n & 127);
  int j = n - 1024;
  return (j >> 7) * 256 + 128 + (j & 127);
}
namespace pg8 {
#define PG8_LAS __attribute__((address_space(3)))
typedef short bf16x8 __attribute__((ext_vector_type(8)));
typedef float f32x4 __attribute__((ext_vector_type(4)));
typedef unsigned u32x4 __attribute__((ext_vector_type(4)));
constexpr int BM = 256, BK = 64, HALF = 128, HTB = HALF * BK * 2, STAGE_BYTES = 8 * HTB, NXCD = 8, WGM = 8;

__host__ __device__ __forceinline__ int lds_byte(int r, int c) { const int st = (r >> 4) * 2 + (c >> 5), rr = r & 15, cc = c & 31, ob = rr * 64 + cc * 2; return st * 1024 + (ob ^ (((ob >> 9) & 1) << 5)); }
__host__ __device__ __forceinline__ void stage_rc(int b, int& R, int& C) { const int st = b / 1024, sb = b % 1024, swz = sb ^ (((sb >> 9) & 1) << 5); R = (st >> 1) * 16 + swz / 64; C = (st & 1) * 32 + (swz % 64) / 2; }
__host__ __device__ __forceinline__ int perm32(int rho) { const int n = rho >> 4, i = rho & 15; return 8 * (i >> 2) + 4 * n + (i & 3); }

struct Unit { int pm, pn, z; };
__device__ __forceinline__ unsigned cvt_pk_bf16(float lo, float hi) { unsigned r; asm volatile("v_cvt_pk_bf16_f32 %0, %1, %2" : "=v"(r) : "v"(lo), "v"(hi)); return r; }

struct TileOrder {
    int nM, nN, nwg, G, c;
    __device__ void init(int nM_, int nN_, int G_, int c_) { nM = nM_; nN = nN_; nwg = nM * nN; G = G_; c = c_; }
    __device__ bool tile(int i, int& pm, int& pn) const {
        const long L = (long)i * G + c; if (L >= nwg) return false;
        int wgid = (int)L; { const int q = nwg / NXCD, r = nwg % NXCD, xcd = wgid % NXCD, off = wgid / NXCD; wgid = (xcd < r ? xcd * (q + 1) : r * (q + 1) + (xcd - r) * q) + off; }
        const int nig = WGM * nN, gid = wgid / nig, fm = gid * WGM, gsz = (nM - fm) < WGM ? (nM - fm) : WGM;
        pm = fm + ((wgid % nig) % gsz); pn = (wgid % nig) / gsz; return true;
    }
};

template <class Epi, class Sched>
__device__ __forceinline__ void gemm_phase(PG8_LAS unsigned char* lds, const int tid, const int lda, const int ldb, const int K, const Sched& S, const Epi& E) {
    const int wid = __builtin_amdgcn_readfirstlane(tid >> 6), lane = tid & 63, wr = wid >> 2, wc = wid & 3, fr = lane & 15, fq = lane >> 4;
    const int nt = K / BK;
    unsigned voffA[2], voffB[2];
#pragma unroll
    for (int i = 0; i < 2; ++i) { int R, C; stage_rc(tid * 16 + i * 8192, R, C); const int Rb = Epi::PERM ? ((R & ~31) + perm32(R & 31)) : R;
        voffA[i] = (unsigned)(R * lda + C) * 2u; voffB[i] = (unsigned)(Rb * ldb + C) * 2u; }
    const size_t kstep = (size_t)(BK * 2);
    const size_t hstepA = (size_t)HALF * lda * 2, hstepB = (size_t)HALF * ldb * 2;
    const unsigned ldsw = (unsigned)wid * 1024u;
    const int aoff = lds_byte(wr * 64 + fr, fq * 8), boff = lds_byte(wc * 32 + fr, fq * 8);
    unsigned gA[2][2] = {{0u, 0u}, {0u, 0u}}, gAn[2][2] = {{0u, 0u}, {0u, 0u}};
    int gR[2], gC[2];
#pragma unroll
    for (int i = 0; i < 2; ++i) stage_rc(tid * 16 + i * 8192, gR[i], gC[i]);
#define PG8_SA(b, h) (((b) * 2 + (h)) * HTB)
#define PG8_SB(b, h) ((4 + (b) * 2 + (h)) * HTB)
#define PG8_STAGE(bufoff, gbase, voff) do { _Pragma("unroll") for (int _i = 0; _i < 2; ++_i) \
        __builtin_amdgcn_global_load_lds((const unsigned*)((const char*)(gbase) + (voff)[_i]), (PG8_LAS unsigned*)(lds + (bufoff) + ldsw + _i * 8192), 16, 0, 0); } while (0)
#define PG8_STAGEA(bufoff, ptr, h, nx) do { if constexpr (Sched::GATHER) { const unsigned gs_[2] = {(nx) ? gAn[h][0] : gA[h][0], (nx) ? gAn[h][1] : gA[h][1]}; PG8_STAGE(bufoff, ptr, gs_); } \
        else { PG8_STAGE(bufoff, (ptr) + (h) * hstepA, voffA); } } while (0)
#define PG8_LDA(dst, b, h) do { _Pragma("unroll") for (int m = 0; m < 4; ++m) _Pragma("unroll") for (int k = 0; k < 2; ++k) dst[m][k] = *(const PG8_LAS bf16x8*)(lds + PG8_SA(b, h) + aoff + m * 2048 + k * 1024); } while (0)
#define PG8_LDB(dst, b, h) do { _Pragma("unroll") for (int n = 0; n < 2; ++n) _Pragma("unroll") for (int k = 0; k < 2; ++k) dst[n][k] = *(const PG8_LAS bf16x8*)(lds + PG8_SB(b, h) + boff + n * 2048 + k * 1024); } while (0)
#define PG8_MMA(ai, bj, At, Bt) do { __builtin_amdgcn_s_setprio(1); _Pragma("unroll") for (int m = 0; m < 4; ++m) _Pragma("unroll") for (int n = 0; n < 2; ++n) _Pragma("unroll") for (int k = 0; k < 2; ++k) \
        acc[ai][bj][m][n] = __builtin_amdgcn_mfma_f32_16x16x32_bf16(Bt[n][k], At[m][k], acc[ai][bj][m][n], 0, 0, 0); __builtin_amdgcn_s_setprio(0); } while (0)
#define PG8_WAIT_V(n) asm volatile("s_waitcnt vmcnt(" #n ")" ::: "memory")
#define PG8_WAIT_L(n) asm volatile("s_waitcnt lgkmcnt(" #n ")" ::: "memory")
#define PG8_BAR __builtin_amdgcn_s_barrier()
#define PG8_SCHED __builtin_amdgcn_sched_barrier(0)
    Unit cur, nxt; int ui = 0;
    if (!S.next(0, cur)) return;
    f32x4 acc[2][2][4][2];
#pragma unroll
    for (int a = 0; a < 2; ++a)
#pragma unroll
        for (int b = 0; b < 2; ++b)
#pragma unroll
            for (int m = 0; m < 4; ++m)
#pragma unroll
                for (int n = 0; n < 2; ++n) acc[a][b][m][n] = (f32x4){0.f, 0.f, 0.f, 0.f};
    bf16x8 At[4][2], B0[2][2], B1[2][2];
    const char* cA = S.a_ptr(cur); const char* cB = S.b_ptr(cur);
    if constexpr (Sched::GATHER) {
_Pragma("unroll") for (int h = 0; h < 2; ++h) _Pragma("unroll") for (int i = 0; i < 2; ++i) gA[h][i] = S.a_goff(cur, gR[i] + 128 * h, gC[i]); }
    PG8_STAGE(PG8_SB(0, 0), cB, voffB); PG8_STAGEA(PG8_SA(0, 0), cA, 0, false); PG8_STAGE(PG8_SB(0, 1), cB + hstepB, voffB); PG8_STAGEA(PG8_SA(0, 1), cA, 1, false);
    if (wr == 1) PG8_BAR;
    PG8_WAIT_V(4); PG8_BAR;
    PG8_STAGE(PG8_SB(1, 0), cB + kstep, voffB); PG8_STAGEA(PG8_SA(1, 0), cA + kstep, 0, false); PG8_STAGE(PG8_SB(1, 1), cB + hstepB + kstep, voffB);
    PG8_WAIT_V(6); PG8_BAR;
    for (;;) {
        const bool has_next = S.next(ui + 1, nxt);
        const char* nA = has_next ? S.a_ptr(nxt) : cA; const char* nB = has_next ? S.b_ptr(nxt) : cB;
        if constexpr (Sched::GATHER) {
_Pragma("unroll") for (int h = 0; h < 2; ++h) _Pragma("unroll") for (int i = 0; i < 2; ++i) gAn[h][i] = has_next ? S.a_goff(nxt, gR[i] + 128 * h, gC[i]) : gA[h][i]; }
        for (int t = 0; t < nt; t += 2) {
            const bool last = (t == nt - 2);
            const char* a1 = cA + (size_t)(t + 1) * kstep;
            const char* a2 = last ? nA : cA + (size_t)(t + 2) * kstep; const char* b2 = last ? nB : cB + (size_t)(t + 2) * kstep;
            const char* a3 = a2 + kstep; const char* b3 = b2 + kstep;
            PG8_LDB(B0, 0, 0); PG8_SCHED; PG8_LDA(At, 0, 0); PG8_STAGEA(PG8_SA(1, 1), a1, 1, false);
            PG8_WAIT_L(8); PG8_BAR; PG8_WAIT_L(0); PG8_MMA(0, 0, At, B0); PG8_BAR; PG8_SCHED;
            PG8_LDB(B1, 0, 1); PG8_STAGE(PG8_SB(0, 0), b2, voffB);
            PG8_BAR; PG8_WAIT_L(0); PG8_MMA(0, 1, At, B1); PG8_BAR;
            PG8_LDA(At, 0, 1); PG8_STAGEA(PG8_SA(0, 0), a2, 0, last);
            PG8_BAR; PG8_WAIT_L(0); PG8_MMA(1, 0, At, B0); PG8_BAR; PG8_SCHED;
            PG8_STAGE(PG8_SB(0, 1), b2 + hstepB, voffB);
            PG8_WAIT_V(6); PG8_BAR; PG8_MMA(1, 1, At, B1); PG8_BAR;
            PG8_LDB(B0, 1, 0); PG8_SCHED; PG8_LDA(At, 1, 0); PG8_STAGEA(PG8_SA(0, 1), a2, 1, last);
            PG8_WAIT_L(8); PG8_BAR; PG8_WAIT_L(0); PG8_MMA(0, 0, At, B0); PG8_BAR; PG8_SCHED;
            PG8_LDB(B1, 1, 1); PG8_STAGE(PG8_SB(1, 0), b3, voffB);
            PG8_BAR; PG8_WAIT_L(0); PG8_MMA(0, 1, At, B1); PG8_BAR;
            PG8_LDA(At, 1, 1); PG8_STAGEA(PG8_SA(1, 0), a3, 0, last);
            PG8_BAR; PG8_WAIT_L(0); PG8_MMA(1, 0, At, B0); PG8_BAR; PG8_SCHED;
            PG8_STAGE(PG8_SB(1, 1), b3 + hstepB, voffB);
            PG8_WAIT_V(6); PG8_BAR; PG8_MMA(1, 1, At, B1); PG8_BAR;
        }
        E(acc, cur, wr, wc, fr, fq);
        if (!has_next) break;
#pragma unroll
        for (int a = 0; a < 2; ++a)
#pragma unroll
            for (int b = 0; b < 2; ++b)
#pragma unroll
                for (int m = 0; m < 4; ++m)
#pragma unroll
                    for (int n = 0; n < 2; ++n) acc[a][b][m][n] = (f32x4){0.f, 0.f, 0.f, 0.f};
        cur = nxt; cA = nA; cB = nB; ++ui;
        if constexpr (Sched::GATHER) {
_Pragma("unroll") for (int h = 0; h < 2; ++h) _Pragma("unroll") for (int i = 0; i < 2; ++i) gA[h][i] = gAn[h][i]; }
    }
    PG8_WAIT_V(0);
    if (wr == 0) PG8_BAR;
    PG8_BAR;
#undef PG8_SA
#undef PG8_SB
#undef PG8_STAGE
#undef PG8_STAGEA
#undef PG8_LDA
#undef PG8_LDB
#undef PG8_MMA
#undef PG8_WAIT_V
#undef PG8_WAIT_L
#undef PG8_BAR
#undef PG8_SCHED
}
}
using pg8::f32x4; using pg8::u32x4; using pg8::Unit;

#define GEMM_LDS (pg8::STAGE_BYTES + 1024)

struct SchedProj : pg8::TileOrder {
  static constexpr bool GATHER = false;
  const char* A; const char* B;
  __device__ bool next(int i, Unit& u) const { u.z = 0; return tile(i, u.pm, u.pn); }
  __device__ const char* a_ptr(const Unit& u) const { return A + (size_t)u.pm * 256 * DM * 2; }
  __device__ const char* b_ptr(const Unit& u) const { return B + (size_t)u.pn * 256 * DM * 2; }
};
struct EpiProj {
  static constexpr bool PERM = true;
  bf16_t* O;
  __device__ __forceinline__ void operator()(const f32x4 (&acc)[2][2][4][2], const Unit& u, int wr, int wc, int fr, int fq) const {
    const int row0 = u.pm * 256 + wr * 64 + fr, col0 = u.pn * 256 + wc * 32 + 8 * fq;
    const bool gate = u.pn >= (C_GA / 256);
#pragma unroll
    for (int ai = 0; ai < 2; ++ai)
#pragma unroll
      for (int m = 0; m < 4; ++m) {
        bf16_t* rowp = O + (size_t)(row0 + ai * 128 + m * 16) * PW + col0;
#pragma unroll
        for (int bj = 0; bj < 2; ++bj) {
          f32x4 v0 = acc[ai][bj][m][0], v1 = acc[ai][bj][m][1];
          if (gate) {
#pragma unroll
            for (int j = 0; j < 4; ++j) { v0[j] = sigmoidf_(v0[j]); v1[j] = sigmoidf_(v1[j]); }
          }
          u32x4 w; w.x = pg8::cvt_pk_bf16(v0[0], v0[1]); w.y = pg8::cvt_pk_bf16(v0[2], v0[3]); w.z = pg8::cvt_pk_bf16(v1[0], v1[1]); w.w = pg8::cvt_pk_bf16(v1[2], v1[3]);
          *(u32x4*)(rowp + bj * 128) = w;
        }
      }
  }
};
__device__ void ph_proj(const Params& p, PG8_LAS unsigned char* lds, int nblk, int bid) {
  SchedProj S; S.init(T_TOK / 256, PW / 256, nblk, bid); S.A = (const char*)p.hbf; S.B = (const char*)p.w_in_t;
  EpiProj E{p.proj};
  pg8::gemm_phase(lds, p.tid, DM, DM, DM, S, E);
}

struct SchedBr : pg8::TileOrder {
  static constexpr bool GATHER = false;
  const char* A; const char* Ba; const char* Bb;
  __device__ bool next(int i, Unit& u) const { u.z = i & 1; return tile(i >> 1, u.pm, u.pn); }
  __device__ const char* a_ptr(const Unit& u) const { return A + (size_t)u.pm * 256 * DM * 2 + u.z * 512 * 2; }
  __device__ const char* b_ptr(const Unit& u) const { return (u.z ? Bb : Ba) + (size_t)u.pn * 256 * 512 * 2; }
};
__device__ __forceinline__ void unpack8(const u32x4 w, float (&f)[8]) {
  f[0] = __uint_as_float(w.x << 16); f[1] = __uint_as_float(w.x & 0xffff0000u); f[2] = __uint_as_float(w.y << 16); f[3] = __uint_as_float(w.y & 0xffff0000u);
  f[4] = __uint_as_float(w.z << 16); f[5] = __uint_as_float(w.z & 0xffff0000u); f[6] = __uint_as_float(w.w << 16); f[7] = __uint_as_float(w.w & 0xffff0000u);
}
struct EpiBr {
  static constexpr bool PERM = true;
  const bf16_t* proj; bf16_t* O;
  __device__ __forceinline__ void operator()(const f32x4 (&acc)[2][2][4][2], const Unit& u, int wr, int wc, int fr, int fq) const {
    const int row0 = u.pm * 256 + wr * 64 + fr, col0 = u.pn * 256 + wc * 32 + 8 * fq;
    const int gcol = (u.z ? C_GB : C_GA) + col0;
#pragma unroll
    for (int ai = 0; ai < 2; ++ai)
#pragma unroll
      for (int m = 0; m < 4; ++m) {
        const size_t row = (size_t)(row0 + ai * 128 + m * 16);
        bf16_t* rowp = O + row * DM + col0;
        const bf16_t* gp = proj + row * PW + gcol;
#pragma unroll
        for (int bj = 0; bj < 2; ++bj) {
          float g[8]; unpack8(*(const u32x4*)(gp + bj * 128), g);
          f32x4 v0 = acc[ai][bj][m][0], v1 = acc[ai][bj][m][1];
          float r[8];
#pragma unroll
          for (int j = 0; j < 4; ++j) { r[j] = v0[j] * g[j]; r[4 + j] = v1[j] * g[4 + j]; }
          if (u.z) {
            float pv[8]; unpack8(*(const u32x4*)(rowp + bj * 128), pv);
#pragma unroll
            for (int j = 0; j < 8; ++j) r[j] += pv[j];
          }
          u32x4 w; w.x = pg8::cvt_pk_bf16(r[0], r[1]); w.y = pg8::cvt_pk_bf16(r[2], r[3]); w.z = pg8::cvt_pk_bf16(r[4], r[5]); w.w = pg8::cvt_pk_bf16(r[6], r[7]);
          *(u32x4*)(rowp + bj * 128) = w;
        }
      }
  }
};
__device__ void ph_br(const Params& p, PG8_LAS unsigned char* lds, int nblk, int bid) {
  SchedBr S; S.init(T_TOK / 256, DM / 256, nblk, bid); S.A = (const char*)p.oab; S.Ba = (const char*)p.wbra_t; S.Bb = (const char*)p.wbrb_t;
  EpiBr E{p.proj, p.merged};
  pg8::gemm_phase(lds, p.tid, DM, 512, 512, S, E);
}

struct SchedMix : pg8::TileOrder {
  static constexpr bool GATHER = false;
  const char* A; const char* B;
  __device__ bool next(int i, Unit& u) const { u.z = 0; return tile(i, u.pm, u.pn); }
  __device__ const char* a_ptr(const Unit& u) const { return A + (size_t)u.pm * 256 * DM * 2; }
  __device__ const char* b_ptr(const Unit& u) const { return B + (size_t)u.pn * 256 * DM * 2; }
};
struct EpiMix {
  static constexpr bool PERM = true;
  bf16_t* O;
  __device__ __forceinline__ void operator()(const f32x4 (&acc)[2][2][4][2], const Unit& u, int wr, int wc, int fr, int fq) const {
    const int row0 = u.pm * 256 + wr * 64 + fr, col0 = u.pn * 256 + wc * 32 + 8 * fq;
#pragma unroll
    for (int ai = 0; ai < 2; ++ai)
#pragma unroll
      for (int m = 0; m < 4; ++m) {
        bf16_t* rowp = O + (size_t)(row0 + ai * 128 + m * 16) * DM + col0;
#pragma unroll
        for (int bj = 0; bj < 2; ++bj) {
          const f32x4 v0 = acc[ai][bj][m][0], v1 = acc[ai][bj][m][1];
          u32x4 w; w.x = pg8::cvt_pk_bf16(v0[0], v0[1]); w.y = pg8::cvt_pk_bf16(v0[2], v0[3]); w.z = pg8::cvt_pk_bf16(v1[0], v1[1]); w.w = pg8::cvt_pk_bf16(v1[2], v1[3]);
          *(u32x4*)(rowp + bj * 128) = w;
        }
      }
  }
};
__device__ void ph_mix(const Params& p, PG8_LAS unsigned char* lds, int nblk, int bid) {
  SchedMix S; S.init(T_TOK / 256, DM / 256, nblk, bid); S.A = (const char*)p.merged; S.B = (const char*)p.wo_t;
  EpiMix E{p.mixer};
  pg8::gemm_phase(lds, p.tid, DM, DM, DM, S, E);
}

template <bool GATH>
struct SchedMoe {
  static constexpr bool GATHER = GATH;
  const PG8_LAS int* tb; int NT; int G, c; int nwg;
  const char* A; const char* B; size_t bexp;
  const int* elist;
  __device__ bool next(int i, Unit& u) const {
    const long L = (long)i * G + c; if (L >= nwg) return false;
    int wgid = (int)L; { const int q = nwg / 8, r = nwg % 8, xcd = wgid % 8, off = wgid / 8; wgid = (xcd < r ? xcd * (q + 1) : r * (q + 1) + (xcd - r) * q) + off; }
    int e = 0;
#pragma unroll 1
    for (int k = 1; k < NE; ++k) if (wgid >= tb[k]) e = k;
    const int q = wgid - tb[e]; const int tiles = tb[33 + e + 1] - tb[33 + e];
    u.pm = tb[33 + e] + q % tiles; u.pn = q / tiles; u.z = e; return true;
  }
  __device__ const char* a_ptr(const Unit& u) const { return GATH ? A : A + (size_t)u.pm * 256 * DM * 2; }
  __device__ const char* b_ptr(const Unit& u) const { return B + (size_t)u.z * bexp + (size_t)u.pn * 256 * DM * 2; }
  __device__ unsigned a_goff(const Unit& u, int tr, int C) const {
    const int i = (u.pm - tb[33 + u.z]) * 256 + tr;
    int tok = 0;
    if (i < tb[66 + u.z]) tok = elist[u.z * T_TOK + i] >> 2;
    return (unsigned)(tok * DM + C) * 2u;
  }
};
__device__ __forceinline__ void moe_table(const Params& p, PG8_LAS int* tb, int NT) {
  if (p.tid == 0) {
    int ub = 0, tbp = 0;
    for (int e = 0; e < NE; ++e) { const int c = p.cnt[e * 64]; tb[e] = ub; tb[33 + e] = tbp; tb[66 + e] = c; const int t = (c + 255) >> 8; ub += t * NT; tbp += t; }
    tb[NE] = ub; tb[33 + NE] = tbp;
  }
  __syncthreads();
}
struct EpiMoe1 {
  static constexpr bool PERM = true;
  const float* b_gu; bf16_t* act;
  __device__ __forceinline__ void operator()(f32x4 (&acc)[2][2][4][2], const Unit& u, int wr, int wc, int fr, int fq) const {
    const int row0 = u.pm * 256 + wr * 64 + fr, jc = u.pn * 128 + wc * 32 + 8 * fq;
    const float* bg = b_gu + (size_t)u.z * 2048 + jc;
#pragma unroll
    for (int bj = 0; bj < 2; ++bj)
#pragma unroll
      for (int n = 0; n < 2; ++n) {
        const f32x4 bv = *(const f32x4*)(bg + bj * 1024 + n * 4);
#pragma unroll
        for (int ai = 0; ai < 2; ++ai)
#pragma unroll
          for (int m = 0; m < 4; ++m) acc[ai][bj][m][n] += bv;
      }
#pragma unroll
    for (int ai = 0; ai < 2; ++ai)
#pragma unroll
      for (int m = 0; m < 4; ++m) {
        bf16_t* rowp = act + (size_t)(row0 + ai * 128 + m * 16) * DM + jc;
        float r[8];
#pragma unroll
        for (int n = 0; n < 2; ++n)
#pragma unroll
          for (int j = 0; j < 4; ++j) {
            float g = acc[ai][0][m][n][j], up = acc[ai][1][m][n][j];
            g = fminf(g, 7.f); up = fminf(fmaxf(up, -7.f), 7.f);
            r[n * 4 + j] = (up + 1.f) * g * sigmoidf_(1.702f * g);
          }
        u32x4 w; w.x = pk2(r[0], r[1]); w.y = pk2(r[2], r[3]); w.z = pk2(r[4], r[5]); w.w = pk2(r[6], r[7]);
        *(u32x4*)rowp = w;
      }
  }
};
__device__ void ph_moe1(const Params& p, PG8_LAS unsigned char* lds, int nblk, int bid) {
  PG8_LAS int* tb = (PG8_LAS int*)(lds + pg8::STAGE_BYTES);
  moe_table(p, tb, 8);
  SchedMoe<true> S; S.tb = tb; S.NT = 8; S.G = nblk; S.c = bid; S.nwg = tb[NE]; S.A = (const char*)p.h2; S.B = (const char*)p.wgu_t; S.bexp = (size_t)2048 * DM * 2; S.elist = p.elist;
  EpiMoe1 E{p.b_gu, p.act};
  pg8::gemm_phase(lds, p.tid, DM, DM, DM, S, E);
}
struct EpiMoe2 {
  static constexpr bool PERM = true;
  const float* b_down; const int* elist; const PG8_LAS int* tb; bf16_t* yslot;
  __device__ __forceinline__ void operator()(f32x4 (&acc)[2][2][4][2], const Unit& u, int wr, int wc, int fr, int fq) const {
    const int row0 = u.pm * 256 + wr * 64 + fr, col0 = u.pn * 256 + wc * 32 + 8 * fq;
    const float* bd = b_down + (size_t)u.z * 1024 + col0;
#pragma unroll
    for (int bj = 0; bj < 2; ++bj)
#pragma unroll
      for (int n = 0; n < 2; ++n) {
        const f32x4 bv = *(const f32x4*)(bd + bj * 128 + n * 4);
#pragma unroll
        for (int ai = 0; ai < 2; ++ai)
#pragma unroll
          for (int m = 0; m < 4; ++m) acc[ai][bj][m][n] += bv;
      }
#pragma unroll
    for (int ai = 0; ai < 2; ++ai)
#pragma unroll
      for (int m = 0; m < 4; ++m) {
        const int li = (u.pm - tb[33 + u.z]) * 256 + wr * 64 + fr + ai * 128 + m * 16;
        if (li < tb[66 + u.z]) {
          const int a = elist[u.z * T_TOK + li];
          bf16_t* rowp = yslot + (size_t)a * DM + col0;
#pragma unroll
          for (int bj = 0; bj < 2; ++bj) {
            const f32x4 v0 = acc[ai][bj][m][0], v1 = acc[ai][bj][m][1];
            u32x4 w; w.x = pk2(v0[0], v0[1]); w.y = pk2(v0[2], v0[3]); w.z = pk2(v1[0], v1[1]); w.w = pk2(v1[2], v1[3]);
            *(u32x4*)(rowp + bj * 128) = w;
          }
        }
      }
  }
};
__device__ void ph_moe2(const Params& p, PG8_LAS unsigned char* lds, int nblk, int bid) {
  PG8_LAS int* tb = (PG8_LAS int*)(lds + pg8::STAGE_BYTES);
  moe_table(p, tb, 4);
  SchedMoe<false> S; S.tb = tb; S.NT = 4; S.G = nblk; S.c = bid; S.nwg = tb[NE]; S.A = (const char*)p.act; S.B = (const char*)p.wd_t; S.bexp = (size_t)1024 * DM * 2; S.elist = p.elist;
  EpiMoe2 E{p.b_down, p.elist, tb, p.yslot};
  pg8::gemm_phase(lds, p.tid, DM, DM, DM, S, E);
}

typedef short bf16x8 __attribute__((ext_vector_type(8)));
typedef unsigned u32x2 __attribute__((ext_vector_type(2)));
#define LAS __attribute__((address_space(3)))
#define MFMA16(a, b, c) __builtin_amdgcn_mfma_f32_16x16x32_bf16((a), (b), (c), 0, 0, 0)
__device__ __forceinline__ bf16x8 pack8(float a0, float a1, float a2, float a3, float a4, float a5, float a6, float a7) {
  u32x4 w; w.x = pk2(a0, a1); w.y = pk2(a2, a3); w.z = pk2(a4, a5); w.w = pk2(a6, a7);
  return __builtin_bit_cast(bf16x8, w);
}
__device__ __forceinline__ bf16_t f2bf_hw(float a) { return (bf16_t)(pk2(a, 0.f) & 0xffffu); }

#define DN_ABYTES 57344
#define DN_UFLOATS 8192
#define F_WN 0
#define F_QD 16
#define F_QK 32
#define F_KT 40

#define DP_KH 0
#define DP_QT 17408
#define DP_KHT 34816
#define DP_VT 53248
#define DP_TU 71680
#define DP_TW 80896
#define DP_LF 90112
#define DP_GC 107520
#define DP_BETA 107776
#define DP_CW 108032
#define DP_LB 114176
#define DP_TR 123392
#define DP_TT 132608
#define DP_MT 141824
#define DP_TOTAL 144128

template <int KS>
__device__ __forceinline__ f32x4 prod16(const LAS bf16_t* A, int lda, int arow0, const LAS bf16_t* Bt, int ldb, int brow0, f32x4 acc, int lane) {
  const int r = lane & 15, q = lane >> 4;
#pragma unroll
  for (int ks = 0; ks < KS; ++ks) {
    const bf16x8 a = *(const LAS bf16x8*)(A + (arow0 + r) * lda + 32 * ks + 8 * q);
    const bf16x8 b = *(const LAS bf16x8*)(Bt + (brow0 + r) * ldb + 32 * ks + 8 * q);
    acc = MFMA16(a, b, acc);
  }
  return acc;
}
__device__ __forceinline__ void tile_store_rm(LAS bf16_t* X, int ld, int row0, int col0, const f32x4 v, int lane) {
  const int r = lane & 15, q = lane >> 4;
#pragma unroll
  for (int i = 0; i < 4; ++i) X[(row0 + 4 * q + i) * ld + col0 + r] = f2bf_hw(v[i]);
}
__device__ __forceinline__ void tile_store_tr(LAS bf16_t* Xt, int ld, int row0, int col0, const f32x4 v, int lane) {
  const int r = lane & 15, q = lane >> 4;
  u32x2 w; w.x = pk2(v[0], v[1]); w.y = pk2(v[2], v[3]);
  *(LAS u32x2*)(Xt + (col0 + r) * ld + row0 + 4 * q) = w;
}

__device__ void dn_prep_chunk(const Params& p, LAS unsigned char* lds, int ci, bool load_cw) {
  const int tid = p.tid, lane = tid & 63, w = tid >> 6, r16 = lane & 15, q4 = lane >> 4;
  const int bh = ci >> 6, n = ci & 63, b = bh >> 2, h = bh & 3;
  LAS bf16_t* Kh = (LAS bf16_t*)(lds + DP_KH); LAS bf16_t* Qt = (LAS bf16_t*)(lds + DP_QT);
  LAS bf16_t* KhT = (LAS bf16_t*)(lds + DP_KHT); LAS bf16_t* VT = (LAS bf16_t*)(lds + DP_VT);
  LAS bf16_t* Tu = (LAS bf16_t*)(lds + DP_TU); LAS bf16_t* Tw = (LAS bf16_t*)(lds + DP_TW); LAS float* Lf = (LAS float*)(lds + DP_LF);
  LAS bf16_t* Lb = (LAS bf16_t*)(lds + DP_LB); LAS bf16_t* Tr = (LAS bf16_t*)(lds + DP_TR); LAS bf16_t* Tt = (LAS bf16_t*)(lds + DP_TT); LAS bf16_t* Mt = (LAS bf16_t*)(lds + DP_MT);
  LAS float* gcb = (LAS float*)(lds + DP_GC); LAS float* betab = (LAS float*)(lds + DP_BETA); LAS float* cw = (LAS float*)(lds + DP_CW);
  unsigned char* gA = (unsigned char*)p.dnA + (size_t)ci * DN_ABYTES;
  float* gU = p.dnU + (size_t)ci * DN_UFLOATS;

  if (load_cw) {
    for (int i = tid; i < 4 * 384; i += 512) { const int tap = i / 384, cc = i % 384, part = cc >> 7, d = cc & 127; cw[i] = p.conv_w[tap * 1536 + part * 512 + h * 128 + d]; }
  }
  __syncthreads();
  const int c = tid >> 3, g = tid & 7;
  const int s = n * 64 + c;
  const size_t t = (size_t)b * SEQ + s;
  float qv[16], kv[16], vv[16];
#pragma unroll
  for (int j = 0; j < 16; ++j) { qv[j] = 0.f; kv[j] = 0.f; vv[j] = 0.f; }
#pragma unroll
  for (int tap = 0; tap < 4; ++tap) {
    const int ss = s - 3 + tap;
    if (ss >= 0) {
      const bf16_t* row = p.proj + (t - 3 + tap) * PW + h * 128 + 16 * g;
      float x[8];
#pragma unroll
      for (int part = 0; part < 3; ++part) {
#pragma unroll
        for (int hh = 0; hh < 2; ++hh) {
          unpack8(*(const u32x4*)(row + part * 512 + 8 * hh), x);
#pragma unroll
          for (int j = 0; j < 8; ++j) {
            const float wv = cw[tap * 384 + part * 128 + 16 * g + 8 * hh + j];
            if (part == 0) qv[8 * hh + j] += wv * x[j];
            if (part == 1) kv[8 * hh + j] += wv * x[j];
            if (part == 2) vv[8 * hh + j] += wv * x[j];
          }
        }
      }
    }
    asm volatile("" ::: "memory");
  }
  float sq = 0.f, sk = 0.f;
#pragma unroll
  for (int j = 0; j < 16; ++j) { qv[j] = siluf_(qv[j]); kv[j] = siluf_(kv[j]); vv[j] = siluf_(vv[j]); sq += qv[j] * qv[j]; sk += kv[j] * kv[j]; }
  sq += __shfl_xor(sq, 1, 64); sq += __shfl_xor(sq, 2, 64); sq += __shfl_xor(sq, 4, 64);
  sk += __shfl_xor(sk, 1, 64); sk += __shfl_xor(sk, 2, 64); sk += __shfl_xor(sk, 4, 64);
  const float rq = rsqrtf(sq + 1e-6f) * 0.08838834764831845f, rk = rsqrtf(sk + 1e-6f);
#pragma unroll
  for (int j = 0; j < 16; ++j) { qv[j] *= rq; kv[j] *= rk; }
  if (g == 0) {
    const float bb = p.ba[t * 8 + h], aa = p.ba[t * 8 + 4 + h];
    const float xx = aa + p.dt_bias[h];
    const float sp = xx > 20.f ? xx : log1pf(__expf(xx));
    betab[c] = sigmoidf_(bb);
    gcb[c] = -__expf(p.a_log[h]) * sp;
  }
  {
    u32x4 w0, w1;
    w0.x = pk2(kv[0], kv[1]); w0.y = pk2(kv[2], kv[3]); w0.z = pk2(kv[4], kv[5]); w0.w = pk2(kv[6], kv[7]);
    w1.x = pk2(kv[8], kv[9]); w1.y = pk2(kv[10], kv[11]); w1.z = pk2(kv[12], kv[13]); w1.w = pk2(kv[14], kv[15]);
    *(LAS u32x4*)(Kh + c * 136 + 16 * g) = w0; *(LAS u32x4*)(Kh + c * 136 + 16 * g + 8) = w1;
    w0.x = pk2(qv[0], qv[1]); w0.y = pk2(qv[2], qv[3]); w0.z = pk2(qv[4], qv[5]); w0.w = pk2(qv[6], qv[7]);
    w1.x = pk2(qv[8], qv[9]); w1.y = pk2(qv[10], qv[11]); w1.z = pk2(qv[12], qv[13]); w1.w = pk2(qv[14], qv[15]);
    *(LAS u32x4*)(Qt + c * 136 + 16 * g) = w0; *(LAS u32x4*)(Qt + c * 136 + 16 * g + 8) = w1;
#pragma unroll
    for (int j = 0; j < 16; ++j) { KhT[(16 * g + j) * 72 + c] = f2bf_hw(kv[j]); VT[(16 * g + j) * 72 + c] = f2bf_hw(vv[j]); }
  }
  __syncthreads();
  if (w == 0) {
    float v = gcb[lane];
#pragma unroll
    for (int o = 1; o < 64; o <<= 1) { const float u = __shfl_up(v, o, 64); if (lane >= o) v += u; }
    gcb[lane] = v;
  }
  __syncthreads();
  const float gc_c = gcb[c], gl = gcb[63];
  {
    const float eg = __expf(gc_c);
    unsigned char* fb = gA + (size_t)(F_QD + (c >> 4) * 4 + (g >> 1)) * 1024 + (g & 1) * 8;
#pragma unroll
    for (int qq = 0; qq < 4; ++qq) {
      u32x2 wv; wv.x = pk2(qv[4 * qq] * eg, qv[4 * qq + 1] * eg); wv.y = pk2(qv[4 * qq + 2] * eg, qv[4 * qq + 3] * eg);
      *(u32x2*)(fb + ((c & 15) + 16 * qq) * 16) = wv;
    }
  }
  const int rt = w >> 1, ct0 = 2 * (w & 1);
#pragma unroll
  for (int tt = 0; tt < 2; ++tt) {
    const int ct = ct0 + tt;
    f32x4 gacc = {0.f, 0.f, 0.f, 0.f};
    gacc = prod16<4>(Kh, 136, 16 * rt, Kh, 136, 16 * ct, gacc, lane);
    const int m = 16 * ct + r16; const float gc_m = gcb[m];
    f32x4 lv;
#pragma unroll
    for (int i = 0; i < 4; ++i) {
      const int cc = 16 * rt + 4 * q4 + i;
      lv[i] = (m < cc) ? betab[cc] * gacc[i] * __expf(gcb[cc] - gc_m) : 0.f;
      Lf[cc * 68 + m] = lv[i];
    }
    tile_store_rm(Lb, 72, 16 * rt, 16 * ct, lv, lane);
    f32x4 qacc = {0.f, 0.f, 0.f, 0.f};
    qacc = prod16<4>(Kh, 136, 16 * rt, Qt, 136, 16 * ct, qacc, lane);
    const int cq = 16 * ct + r16; const float gc_cq = gcb[cq];
    float o4[4];
#pragma unroll
    for (int i = 0; i < 4; ++i) { const int mm = 16 * rt + 4 * q4 + i; o4[i] = (mm <= cq) ? qacc[i] * __expf(gc_cq - gcb[mm]) : 0.f; }
    u32x2 wv; wv.x = pk2(o4[0], o4[1]); wv.y = pk2(o4[2], o4[3]);
    *(u32x2*)(gA + (size_t)(F_QK + ct * 2 + (rt >> 1)) * 1024 + (r16 + 16 * q4) * 16 + (rt & 1) * 8) = wv;
  }
  __syncthreads();
  for (int i = tid; i < 2 * 64 * 72 / 8; i += 512) ((LAS u32x4*)Tr)[i] = (u32x4){0u, 0u, 0u, 0u};
  __syncthreads();
  if (w == 0) {
    int lo = lane; asm volatile("" : "+v"(lo));
    const int g = lo >> 4, j = lo & 15;
    unsigned lfb = DP_LF + (16 * g * 68 + 16 * g) * 4; asm volatile("" : "+v"(lfb));
    const LAS float* Lg = (const LAS float*)(lds + lfb);
    float t[16];
#pragma unroll
    for (int r = 0; r < 16; ++r) {
      float a0 = (r == j) ? 1.f : 0.f, a1 = 0.f;
#pragma unroll
      for (int k4 = 0; k4 < (r + 3) / 4; ++k4) {
        const f32x4 l = *(const LAS f32x4*)(Lg + r * 68 + 4 * k4);
        if (4 * k4 + 0 < r) a0 -= l[0] * t[4 * k4 + 0];
        if (4 * k4 + 1 < r) a1 -= l[1] * t[4 * k4 + 1];
        if (4 * k4 + 2 < r) a0 -= l[2] * t[4 * k4 + 2];
        if (4 * k4 + 3 < r) a1 -= l[3] * t[4 * k4 + 3];
      }
      t[r] = a0 + a1;
      Tr[(16 * g + r) * 72 + 16 * g + j] = f2bf_hw(t[r]);
    }
    u32x4 w0, w1;
    w0.x = pk2(t[0], t[1]); w0.y = pk2(t[2], t[3]); w0.z = pk2(t[4], t[5]); w0.w = pk2(t[6], t[7]);
    w1.x = pk2(t[8], t[9]); w1.y = pk2(t[10], t[11]); w1.z = pk2(t[12], t[13]); w1.w = pk2(t[14], t[15]);
    *(LAS u32x4*)(Tt + (16 * g + j) * 72 + 16 * g) = w0; *(LAS u32x4*)(Tt + (16 * g + j) * 72 + 16 * g + 8) = w1;
  }
  __syncthreads();
#pragma unroll 1
  for (int d = 1; d <= 3; ++d) {
    const bool act = w < 4 - d;
    const int I = w + d, J = w;
    LAS bf16_t* Mw = Mt + w * 16 * 24;
    if (act) {
      f32x4 macc = {0.f, 0.f, 0.f, 0.f};
      macc = prod16<2>(Lb, 72, 16 * I, Tt, 72, 16 * J, macc, lane);
      tile_store_tr(Mw, 24, 0, 0, macc, lane);
    }
    __syncthreads();
    if (act) {
      bf16x8 a = {0, 0, 0, 0, 0, 0, 0, 0}, bb = {0, 0, 0, 0, 0, 0, 0, 0};
      if (q4 < 2) { a = *(const LAS bf16x8*)(Tr + (16 * I + r16) * 72 + 16 * I + 8 * q4); bb = *(const LAS bf16x8*)(Mw + r16 * 24 + 8 * q4); }
      f32x4 tacc = {0.f, 0.f, 0.f, 0.f};
      tacc = MFMA16(a, bb, tacc);
#pragma unroll
      for (int i = 0; i < 4; ++i) tacc[i] = -tacc[i];
      tile_store_rm(Tr, 72, 16 * I, 16 * J, tacc, lane);
      tile_store_tr(Tt, 72, 16 * I, 16 * J, tacc, lane);
    }
    __syncthreads();
  }
  {
    const int cc = tid >> 3, m0 = (tid & 7) * 8;
    float tv[8]; unpack8(*(const LAS u32x4*)(Tr + cc * 72 + m0), tv);
    float tu[8], tw[8];
#pragma unroll
    for (int jj = 0; jj < 8; ++jj) { const float bm = betab[m0 + jj]; tu[jj] = tv[jj] * bm; tw[jj] = tu[jj] * __expf(gcb[m0 + jj]); }
    u32x4 wu, ww;
    wu.x = pk2(tu[0], tu[1]); wu.y = pk2(tu[2], tu[3]); wu.z = pk2(tu[4], tu[5]); wu.w = pk2(tu[6], tu[7]);
    ww.x = pk2(tw[0], tw[1]); ww.y = pk2(tw[2], tw[3]); ww.z = pk2(tw[4], tw[5]); ww.w = pk2(tw[6], tw[7]);
    *(LAS u32x4*)(Tu + cc * 72 + m0) = wu; *(LAS u32x4*)(Tw + cc * 72 + m0) = ww;
  }
  __syncthreads();
#pragma unroll
  for (int rr = 0; rr < 4; ++rr) {
    f32x4 u = {0.f, 0.f, 0.f, 0.f};
    u = prod16<2>(Tu, 72, 16 * rr, VT, 72, 16 * w, u, lane);
    *(f32x4*)(gU + ((w * 4 + rr) * 64 + lane) * 4) = u;
    f32x4 wt = {0.f, 0.f, 0.f, 0.f};
    wt = prod16<2>(KhT, 72, 16 * w, Tw, 72, 16 * rr, wt, lane);
    u32x2 wv; wv.x = pk2(-wt[0], -wt[1]); wv.y = pk2(-wt[2], -wt[3]);
    *(u32x2*)(gA + (size_t)(F_WN + rr * 4 + (w >> 1)) * 1024 + (r16 + 16 * q4) * 16 + (w & 1) * 8) = wv;
  }
#pragma unroll
  for (int it = 0; it < 4; ++it) {
    const int idx = tid + it * 512; const int d = idx >> 4, m4 = idx & 15;
    const u32x2 raw = *(const LAS u32x2*)(KhT + d * 72 + 4 * m4);
    const float k0 = __uint_as_float(raw.x << 16), k1 = __uint_as_float(raw.x & 0xffff0000u), k2 = __uint_as_float(raw.y << 16), k3 = __uint_as_float(raw.y & 0xffff0000u);
    const float e0 = __expf(gl - gcb[4 * m4]), e1 = __expf(gl - gcb[4 * m4 + 1]), e2 = __expf(gl - gcb[4 * m4 + 2]), e3 = __expf(gl - gcb[4 * m4 + 3]);
    u32x2 wv; wv.x = pk2(k0 * e0, k1 * e1); wv.y = pk2(k2 * e2, k3 * e3);
    *(u32x2*)(gA + (size_t)(F_KT + (d >> 4) * 2 + (m4 >> 3)) * 1024 + ((d & 15) + 16 * (m4 & 3)) * 16 + ((m4 >> 2) & 1) * 8) = wv;
  }
  if (tid == 0) p.dnG[ci] = __expf(gl);
}

#define DS_A0 0
#define DS_A1 57344
#define DS_TOTAL 114688
__device__ void dn_scan_blk(const Params& p, LAS unsigned char* lds, int item) {
  const int tid = p.tid, lane = tid & 63, w = __builtin_amdgcn_readfirstlane(tid >> 6), r16 = lane & 15, q4 = lane >> 4;
  const int bh = item >> 1, eh = item & 1, b = bh >> 2, h = bh & 3;
  const int et = eh * 4 + (w & 3);
  const bool comp = w < 4;
  const unsigned char* gA = (const unsigned char*)p.dnA + (size_t)bh * 64 * DN_ABYTES;
  const float* gU = p.dnU + (size_t)bh * 64 * DN_UFLOATS;
  const float* gG = p.dnG + bh * 64;
  auto issue_A = [&](int n, int buf) {
#pragma unroll
    for (int i = 0; i < 7; ++i) {
      const int f = w * 7 + i;
      __builtin_amdgcn_global_load_lds((const unsigned*)(gA + (size_t)n * DN_ABYTES + f * 1024 + lane * 16), (LAS unsigned*)(lds + (buf ? DS_A1 : DS_A0) + f * 1024), 16, 0, 0);
    }
  };
  __syncthreads();
  issue_A(0, 0);
  f32x4 Un[4];
#pragma unroll
  for (int rr = 0; rr < 4; ++rr) Un[rr] = *(const f32x4*)(gU + ((et * 4 + rr) * 64 + lane) * 4);
  f32x4 S[8];
#pragma unroll
  for (int dt = 0; dt < 8; ++dt) S[dt] = (f32x4){0.f, 0.f, 0.f, 0.f};
  asm volatile("s_waitcnt vmcnt(0)" ::: "memory");
  __syncthreads();
  bf16_t* obase = p.dn_out + ((size_t)b * SEQ) * p.dn_out_ld + h * 128 + 16 * et + r16;
  f32x4 Op[4];
#pragma unroll
  for (int rr = 0; rr < 4; ++rr) Op[rr] = (f32x4){0.f, 0.f, 0.f, 0.f};
  float gnext = gG[0];
#pragma unroll 1
  for (int n = 0; n < 64; ++n) {
    const LAS unsigned char* Ab = lds + ((n & 1) ? DS_A1 : DS_A0);
    if (n + 1 < 64) issue_A(n + 1, (n + 1) & 1);
    if (comp) {
      if (n > 0) {
#pragma unroll
        for (int rr = 0; rr < 4; ++rr)
#pragma unroll
          for (int i = 0; i < 4; ++i) obase[(size_t)((n - 1) * 64 + 16 * rr + 4 * q4 + i) * p.dn_out_ld] = f2bf_hw(Op[rr][i]);
      }
      f32x4 Vn[4];
#pragma unroll
      for (int rr = 0; rr < 4; ++rr) Vn[rr] = Un[rr];
      if (n + 1 < 64) {
#pragma unroll
        for (int rr = 0; rr < 4; ++rr) Un[rr] = *(const f32x4*)(gU + (size_t)(n + 1) * DN_UFLOATS + ((et * 4 + rr) * 64 + lane) * 4);
      }
      const float gdec = gnext;
      if (n + 1 < 64) gnext = gG[n + 1];
      bf16x8 Sb[4];
#pragma unroll
      for (int ks = 0; ks < 4; ++ks) Sb[ks] = pack8(S[2 * ks][0], S[2 * ks][1], S[2 * ks][2], S[2 * ks][3], S[2 * ks + 1][0], S[2 * ks + 1][1], S[2 * ks + 1][2], S[2 * ks + 1][3]);
#pragma unroll
      for (int dt = 0; dt < 8; ++dt) S[dt] *= gdec;
#define LDF(idx) (*(const LAS bf16x8*)(Ab + (idx) * 1024 + lane * 16))
#define SBAR __builtin_amdgcn_sched_barrier(0)
      bf16x8 fa[8], fb[8];
      f32x4 O[4];
#pragma unroll
      for (int rr = 0; rr < 4; ++rr) O[rr] = (f32x4){0.f, 0.f, 0.f, 0.f};
#pragma unroll
      for (int i = 0; i < 4; ++i) { fa[i] = LDF(F_WN + i); fa[4 + i] = LDF(F_QD + i); }
      SBAR;
#pragma unroll
      for (int i = 0; i < 4; ++i) { fb[i] = LDF(F_WN + 4 + i); fb[4 + i] = LDF(F_QD + 4 + i); }
      SBAR;
#pragma unroll
      for (int ks = 0; ks < 4; ++ks) { Vn[0] = MFMA16(fa[ks], Sb[ks], Vn[0]); O[0] = MFMA16(fa[4 + ks], Sb[ks], O[0]); }
      SBAR;
#pragma unroll
      for (int i = 0; i < 4; ++i) { fa[i] = LDF(F_WN + 8 + i); fa[4 + i] = LDF(F_QD + 8 + i); }
      SBAR;
#pragma unroll
      for (int ks = 0; ks < 4; ++ks) { Vn[1] = MFMA16(fb[ks], Sb[ks], Vn[1]); O[1] = MFMA16(fb[4 + ks], Sb[ks], O[1]); }
      SBAR;
#pragma unroll
      for (int i = 0; i < 4; ++i) { fb[i] = LDF(F_WN + 12 + i); fb[4 + i] = LDF(F_QD + 12 + i); }
      SBAR;
#pragma unroll
      for (int ks = 0; ks < 4; ++ks) { Vn[2] = MFMA16(fa[ks], Sb[ks], Vn[2]); O[2] = MFMA16(fa[4 + ks], Sb[ks], O[2]); }
      SBAR;
#pragma unroll
      for (int i = 0; i < 8; ++i) fa[i] = LDF(F_QK + i);
      SBAR;
#pragma unroll
      for (int ks = 0; ks < 4; ++ks) { Vn[3] = MFMA16(fb[ks], Sb[ks], Vn[3]); O[3] = MFMA16(fb[4 + ks], Sb[ks], O[3]); }
      SBAR;
#pragma unroll
      for (int i = 0; i < 8; ++i) fb[i] = LDF(F_KT + i);
      SBAR;
      bf16x8 Vb[2];
#pragma unroll
      for (int ks = 0; ks < 2; ++ks) Vb[ks] = pack8(Vn[2 * ks][0], Vn[2 * ks][1], Vn[2 * ks][2], Vn[2 * ks][3], Vn[2 * ks + 1][0], Vn[2 * ks + 1][1], Vn[2 * ks + 1][2], Vn[2 * ks + 1][3]);
#pragma unroll
      for (int ks = 0; ks < 2; ++ks)
#pragma unroll
        for (int rr = 0; rr < 4; ++rr) O[rr] = MFMA16(fa[rr * 2 + ks], Vb[ks], O[rr]);
      SBAR;
#pragma unroll
      for (int i = 0; i < 8; ++i) fa[i] = LDF(F_KT + 8 + i);
      SBAR;
#pragma unroll
      for (int ks = 0; ks < 2; ++ks)
#pragma unroll
        for (int dt = 0; dt < 4; ++dt) S[dt] = MFMA16(fb[dt * 2 + ks], Vb[ks], S[dt]);
      SBAR;
#pragma unroll
      for (int ks = 0; ks < 2; ++ks)
#pragma unroll
        for (int dt = 0; dt < 4; ++dt) S[4 + dt] = MFMA16(fa[dt * 2 + ks], Vb[ks], S[4 + dt]);
#pragma unroll
      for (int rr = 0; rr < 4; ++rr) Op[rr] = O[rr];
#undef LDF
#undef SBAR
    }
    asm volatile("s_waitcnt vmcnt(0)" ::: "memory");
    __syncthreads();
  }
  if (comp) {
#pragma unroll
    for (int rr = 0; rr < 4; ++rr)
#pragma unroll
      for (int i = 0; i < 4; ++i) obase[(size_t)(63 * 64 + 16 * rr + 4 * q4 + i) * p.dn_out_ld] = f2bf_hw(Op[rr][i]);
  }
}
__device__ void ph_dn_norm(const Params& p, int nblk, int bid) {
  const int wid = p.tid >> 6, lane = p.tid & 63;
  const f32x4 g0 = *(const f32x4*)(p.g_dn_out + (lane & 15) * 8), g1 = *(const f32x4*)(p.g_dn_out + (lane & 15) * 8 + 4);
  for (int t = bid * 8 + wid; t < T_TOK; t += nblk * 8) {
    bf16_t* op = p.oab + (size_t)t * DM + lane * 8;
    float o[8], z[8];
    unpack8(*(const u32x4*)op, o);
    unpack8(*(const u32x4*)(p.proj + (size_t)t * PW + C_Z + lane * 8), z);
    float ss = 0.f;
#pragma unroll
    for (int j = 0; j < 8; ++j) ss += o[j] * o[j];
    ss += __shfl_xor(ss, 1, 64); ss += __shfl_xor(ss, 2, 64); ss += __shfl_xor(ss, 4, 64); ss += __shfl_xor(ss, 8, 64);
    const float rstd = rsqrtf(ss * (1.f / 128.f) + 1e-6f);
    float y[8];
#pragma unroll
    for (int j = 0; j < 4; ++j) { y[j] = o[j] * rstd * g0[j] * siluf_(z[j]); y[4 + j] = o[4 + j] * rstd * g1[j] * siluf_(z[4 + j]); }
    u32x4 w; w.x = pk2(y[0], y[1]); w.y = pk2(y[2], y[3]); w.z = pk2(y[4], y[5]); w.w = pk2(y[6], y[7]);
    *(u32x4*)op = w;
  }
}
typedef float f32x16 __attribute__((ext_vector_type(16)));
#define MFMA32(a, b, c) __builtin_amdgcn_mfma_f32_32x32x16_bf16((a), (b), (c), 0, 0, 0)
#define MP_VL 0
#define MP_RED 65536
#define MP_TOTAL (65536 + 4096)

__device__ void moba_prep_block(const Params& p, LAS unsigned char* lds, int item) {
  const int tid = p.tid, lane = tid & 63, w = tid >> 6;
  const int bh = item >> 4, jb = item & 15, b = bh >> 2, h = bh & 3;
  LAS bf16_t* Vl = (LAS bf16_t*)(lds + MP_VL);
  LAS float* red = (LAS float*)(lds + MP_RED);
  __syncthreads();
#pragma unroll
  for (int it = 0; it < 8; ++it) {
    const int idx = tid + 512 * it, row = idx >> 4, ch = idx & 15;
    const u32x4 v = *(const u32x4*)(p.proj + ((size_t)b * SEQ + 256 * jb + row) * PW + C_MV + h * 128 + 8 * ch);
    *(LAS u32x4*)(Vl + row * 128 + 8 * ch) = v;
  }
  {
    const int r = tid >> 1, hh = tid & 1;
    const int pos = 256 * jb + r;
    const size_t t = (size_t)b * SEQ + pos;
    float cs[8], sn[8];
#pragma unroll
    for (int jj = 0; jj < 8; ++jj) {
      const float inv = exp2f(-(float)(8 * hh + jj) * (1.f / 16.f) * 18.931568569324174f);
      const float ang = (float)pos * inv;
      cs[jj] = cosf(ang); sn[jj] = sinf(ang);
    }
    float kacc[64];
#pragma unroll
    for (int which = 0; which < 2; ++which) {
      const bf16_t* src = p.proj + t * PW + (which ? C_MQ : C_MK) + h * 128 + 8 * hh;
      float x0[8], x1[8];
      unpack8(*(const u32x4*)(src), x0); unpack8(*(const u32x4*)(src + 16), x1);
      float y0[8], y1[8];
#pragma unroll
      for (int jj = 0; jj < 8; ++jj) { y0[jj] = x0[jj] * cs[jj] - x1[jj] * sn[jj]; y1[jj] = x1[jj] * cs[jj] + x0[jj] * sn[jj]; }
      u32x4 o[8];
      o[0].x = pk2(y0[0], y0[1]); o[0].y = pk2(y0[2], y0[3]); o[0].z = pk2(y0[4], y0[5]); o[0].w = pk2(y0[6], y0[7]);
      o[1].x = pk2(y1[0], y1[1]); o[1].y = pk2(y1[2], y1[3]); o[1].z = pk2(y1[4], y1[5]); o[1].w = pk2(y1[6], y1[7]);
#pragma unroll
      for (int ks = 2; ks < 8; ++ks) o[ks] = *(const u32x4*)(src + 16 * ks);
      if (which == 0) {
#pragma unroll
        for (int jj = 0; jj < 8; ++jj) { kacc[jj] = y0[jj]; kacc[8 + jj] = y1[jj]; }
#pragma unroll
        for (int ks = 2; ks < 8; ++ks) { float f[8]; unpack8(o[ks], f);
#pragma unroll
          for (int jj = 0; jj < 8; ++jj) kacc[8 * ks + jj] = f[jj]; }
        unsigned char* dst = (unsigned char*)p.Kp + ((size_t)(bh * 128 + 8 * jb + (r >> 5)) * 8192) + ((r & 31) + 32 * hh) * 16;
#pragma unroll
        for (int ks = 0; ks < 8; ++ks) *(u32x4*)(dst + ks * 1024) = o[ks];
      } else {
        bf16_t* dst = p.qb + ((size_t)bh * SEQ + pos) * 128 + 8 * hh;
#pragma unroll
        for (int ks = 0; ks < 8; ++ks) *(u32x4*)(dst + 16 * ks) = o[ks];
      }
    }
#pragma unroll
    for (int e = 0; e < 64; ++e) {
      float v = kacc[e];
      v += __shfl_xor(v, 2, 64); v += __shfl_xor(v, 4, 64); v += __shfl_xor(v, 8, 64); v += __shfl_xor(v, 16, 64); v += __shfl_xor(v, 32, 64);
      kacc[e] = v;
    }
    if (lane < 2) {
#pragma unroll
      for (int e = 0; e < 64; ++e) red[(w * 2 + lane) * 64 + e] = kacc[e];
    }
  }
  __syncthreads();
  if (tid < 128) {
    const int d = tid, hh = (d >> 3) & 1, ks = d >> 4, jj = d & 7;
    float a = 0.f;
#pragma unroll
    for (int ww = 0; ww < 8; ++ww) a += red[(ww * 2 + hh) * 64 + ks * 8 + jj];
    p.kmean[((size_t)bh * 16 + jb) * 128 + d] = a * (1.f / 256.f);
  }
#pragma unroll
  for (int it = 0; it < 8; ++it) {
    const int o = tid + 512 * it, ln = o & 63, frag = o >> 6, tl = frag >> 3, dt = (frag >> 1) & 3, s = frag & 1;
    const int r = ln & 31, hh = ln >> 5, d = 32 * dt + r;
    unsigned short e[8];
#pragma unroll
    for (int jj = 0; jj < 8; ++jj) { const int key = 32 * tl + 16 * s + 8 * (jj >> 2) + 4 * hh + (jj & 3); e[jj] = Vl[key * 128 + d]; }
    u32x4 wv; wv.x = e[0] | ((unsigned)e[1] << 16); wv.y = e[2] | ((unsigned)e[3] << 16); wv.z = e[4] | ((unsigned)e[5] << 16); wv.w = e[6] | ((unsigned)e[7] << 16);
    *(u32x4*)((unsigned char*)p.Vp + ((size_t)(bh * 128 + 8 * jb + tl) * 8192) + (dt * 2 + s) * 1024 + ln * 16) = wv;
  }
}
__device__ __forceinline__ int crow32(int reg, int hh) { return (reg & 3) + 8 * (reg >> 2) + 4 * hh; }
__device__ void moba_item(const Params& p, LAS float* km, LAS float* mrg, LAS float* ml, int bh, int ib, int sub, int par, int lane, int rep) {
  const int q = lane & 31, hh = lane >> 5;
  const int b = bh >> 2, h = bh & 3;
  const int s0 = 256 * ib + 32 * sub;
  const bf16_t* qrow = p.qb + ((size_t)bh * SEQ + s0 + q) * 128 + 8 * hh;
  bf16x8 Qf[8];
#pragma unroll
  for (int ks = 0; ks < 8; ++ks) Qf[ks] = *(const bf16x8*)(qrow + 16 * ks);
  LAS unsigned char* qlds = (LAS unsigned char*)km + 8192 + lane * 16;
#pragma unroll
  for (int ks = 0; ks < 8; ++ks) *(LAS bf16x8*)(qlds + ks * 1024) = Qf[ks];
  unsigned selmask = 0;
  if (ib > 0) {
    for (int idx = lane; idx < ib * 32; idx += 64) ((LAS f32x4*)km)[idx] = ((const f32x4*)(p.kmean + (size_t)bh * 16 * 128))[idx];
    float qf[64];
#pragma unroll
    for (int ks = 0; ks < 8; ++ks) { float f[8]; unpack8(__builtin_bit_cast(u32x4, Qf[ks]), f);
#pragma unroll
      for (int jj = 0; jj < 8; ++jj) qf[8 * ks + jj] = f[jj]; }
    float sc[16];
#pragma unroll
    for (int j = 0; j < 16; ++j) {
      sc[j] = -INFINITY;
      if (j < ib) {
        float a = 0.f;
#pragma unroll
        for (int ks = 0; ks < 8; ++ks) {
          const f32x4 k0 = *(const LAS f32x4*)(km + j * 128 + 16 * ks + 8 * hh), k1 = *(const LAS f32x4*)(km + j * 128 + 16 * ks + 8 * hh + 4);
          a += qf[8 * ks] * k0[0] + qf[8 * ks + 1] * k0[1] + qf[8 * ks + 2] * k0[2] + qf[8 * ks + 3] * k0[3];
          a += qf[8 * ks + 4] * k1[0] + qf[8 * ks + 5] * k1[1] + qf[8 * ks + 6] * k1[2] + qf[8 * ks + 7] * k1[3];
        }
        a += __shfl_xor(a, 32, 64);
        sc[j] = a;
      }
    }
#pragma unroll
    for (int r = 0; r < 3; ++r) {
      if (r < ib) {
        float best = -INFINITY; int bi = 0;
#pragma unroll
        for (int j = 0; j < 16; ++j) if (sc[j] > best) { best = sc[j]; bi = j; }
        selmask |= 1u << bi;
#pragma unroll
        for (int j = 0; j < 16; ++j) if (j == bi) sc[j] = -INFINITY;
      }
    }
  }
  unsigned rem = 0;
  for (int j = 0; j < ib; ++j) if (__ballot((selmask >> j) & 1u) != 0ull) rem |= 1u << j;
  rem = __builtin_amdgcn_readfirstlane(rem);
  const int own0 = 8 * ib, diag = 8 * ib + sub;
  const float cscale = 0.08838834764831845f * 1.4426950408889634f;
  float m = -1e30f, l = 0.f;
  f32x16 O[4];
#pragma unroll
  for (int dt = 0; dt < 4; ++dt)
#pragma unroll
    for (int r = 0; r < 16; ++r) O[dt][r] = 0.f;
  const unsigned char* kbase = (const unsigned char*)p.Kp + (size_t)bh * 128 * 8192 + lane * 16;
  const unsigned char* vbase = (const unsigned char*)p.Vp + (size_t)bh * 128 * 8192 + lane * 16;
  auto adv = [&](int& kt_, unsigned& rem_) {
    if (kt_ < 0) return;
    if (kt_ >= own0 ? (kt_ < diag) : ((kt_ & 7) != 7)) { kt_ = kt_ + 1; return; }
    if (rem_ == 0u) { kt_ = -1; return; }
    kt_ = 8 * (__builtin_ctz(rem_)); rem_ &= rem_ - 1u;
  };
  int kt = own0;
  if (par) adv(kt, rem);
  auto load_k = [&](int t, bf16x8 (&K_)[8]) {
#pragma unroll
    for (int ks = 0; ks < 8; ++ks) K_[ks] = *(const bf16x8*)(kbase + (size_t)t * 8192 + ks * 1024);
  };
  auto tile_step = [&](bf16x8 (&Kc)[8], bf16x8 (&Kn)[8]) -> bool {
    int ktn = kt; unsigned remn = rem;
    adv(ktn, remn); adv(ktn, remn);
    bf16x8 Vf[8];
#pragma unroll
    for (int f = 0; f < 8; ++f) Vf[f] = *(const bf16x8*)(vbase + (size_t)kt * 8192 + f * 1024);
    if (ktn >= 0) load_k(ktn, Kn);
    f32x16 S;
#pragma unroll
    for (int r = 0; r < 16; ++r) S[r] = 0.f;
#pragma unroll
    for (int ks = 0; ks < 8; ++ks) S = MFMA32(Kc[ks], *(const LAS bf16x8*)(qlds + ks * 1024), S);
    const bool allowed = (kt >= own0) || ((selmask >> (kt >> 3)) & 1u);
    const float nb = allowed ? 0.f : -INFINITY;
    float sv[16]; float mx = -INFINITY;
#pragma unroll
    for (int r = 0; r < 16; ++r) sv[r] = __builtin_fmaf(S[r], cscale, nb);
    if (kt == diag) {
#pragma unroll
      for (int r = 0; r < 16; ++r) if (crow32(r, hh) > q) sv[r] = -INFINITY;
    }
#pragma unroll
    for (int r = 0; r < 16; ++r) mx = fmaxf(mx, sv[r]);
    mx = fmaxf(mx, __shfl_xor(mx, 32, 64));
    const bool grow = mx > m + 8.f;
    const float mn = (__ballot(grow) != 0ull) ? fmaxf(m, mx) : m;
    const float alpha = __builtin_amdgcn_exp2f(m - mn);
    float ps = 0.f;
#pragma unroll
    for (int r = 0; r < 16; ++r) { sv[r] = __builtin_amdgcn_exp2f(sv[r] - mn); ps += sv[r]; }
    l = l * alpha + ps; m = mn;
    if (__ballot(alpha != 1.f) != 0ull) {
#pragma unroll
      for (int dt = 0; dt < 4; ++dt)
#pragma unroll
        for (int r = 0; r < 16; ++r) O[dt][r] *= alpha;
    }
    const bf16x8 P0 = pack8(sv[0], sv[1], sv[2], sv[3], sv[4], sv[5], sv[6], sv[7]);
    const bf16x8 P1 = pack8(sv[8], sv[9], sv[10], sv[11], sv[12], sv[13], sv[14], sv[15]);
#pragma unroll
    for (int dt = 0; dt < 4; ++dt) { O[dt] = MFMA32(Vf[dt * 2], P0, O[dt]); O[dt] = MFMA32(Vf[dt * 2 + 1], P1, O[dt]); }
    kt = ktn; rem = remn;
    return kt >= 0;
  };
  if (kt >= 0) {
    bf16x8 KA[8], KB[8];
    load_k(kt, KA);
#pragma unroll 1
    for (;;) {
      if (!tile_step(KA, KB)) break;
      asm volatile("" ::: "memory");
      if (!tile_step(KB, KA)) break;
      asm volatile("" ::: "memory");
    }
  }
  asm volatile("s_waitcnt vmcnt(0) lgkmcnt(0)" ::: "memory");
  if (par) {
    ml[lane] = m; ml[64 + lane] = l;
#pragma unroll
    for (int dt = 0; dt < 4; ++dt)
#pragma unroll
      for (int r = 0; r < 16; ++r) mrg[(dt * 16 + r) * 64 + lane] = O[dt][r];
  }
  __syncthreads();
  if (par == 0) {
    const float m2 = ml[lane], l2 = ml[64 + lane];
    const float mm = fmaxf(m, m2);
    const float a1 = __builtin_amdgcn_exp2f(m - mm), a2 = __builtin_amdgcn_exp2f(m2 - mm);
    l = l * a1 + l2 * a2;
#pragma unroll
    for (int dt = 0; dt < 4; ++dt)
#pragma unroll
      for (int r = 0; r < 16; ++r) O[dt][r] = O[dt][r] * a1 + mrg[(dt * 16 + r) * 64 + lane] * a2;
  }
  if (par == 0) {
  l += __shfl_xor(l, 32, 64);
  const float inv = 1.f / l;
  bf16_t* orow = rep ? p.oab2 + ((size_t)b * SEQ + s0 + q) * 512 + h * 128 : p.mb_out + ((size_t)b * SEQ + s0 + q) * p.mb_out_ld + p.mb_out_off + h * 128;
#pragma unroll
  for (int dt = 0; dt < 4; ++dt)
#pragma unroll
    for (int g4 = 0; g4 < 4; ++g4) {
      u32x2 wv; wv.x = pk2(O[dt][4 * g4] * inv, O[dt][4 * g4 + 1] * inv); wv.y = pk2(O[dt][4 * g4 + 2] * inv, O[dt][4 * g4 + 3] * inv);
      *(u32x2*)(orow + 32 * dt + 8 * g4 + 4 * hh) = wv;
    }
  }
  __syncthreads();
}
__device__ void moba_worker(const Params& p, LAS unsigned char* lds, int qi) {
  const int lane = p.tid & 63, w = __builtin_amdgcn_readfirstlane(p.tid >> 6);
  LAS float* km = (LAS float*)(lds + w * 16384);
  LAS float* mrg = (LAS float*)(lds + ((w & 3) + 4) * 16384);
  LAS float* ml = (LAS float*)(lds + 131072) + (w & 3) * 128;
  LAS int* slot = (LAS int*)(lds + 131072 + 2048);
  const int g0 = (int)((unsigned)__builtin_amdgcn_s_getreg((3 << 11) | 20) & 7u);
  for (int gi = 0; gi < 8; ++gi) {
    const int g = (g0 + gi) & 7;
    for (;;) {
      __syncthreads();
      if (p.tid == 0) slot[0] = atomicAdd(p.wq + qi * 8 + g, 1);
      __syncthreads();
      const int idx = slot[0];
      if (idx >= 64) break;
      const int bh = 2 * g + (idx >> 5), ib = 15 - ((idx >> 1) & 15), quad = 1 - (idx & 1);
      moba_item(p, km, mrg, ml, bh, ib, 4 * quad + (w & 3), w >> 2, lane, qi);
    }
  }
}
__device__ void ph_mod(const Params& p, LAS unsigned char* lds, int nblk, int bid) {
  LAS float* sc = (LAS float*)lds;
  LAS float* part = (LAS float*)(lds + 16384);
  const int tid = p.tid;
  if (bid >= 192) return;
  for (int i = tid; i < 4096; i += 512) sc[i] = siluf_(p.c[i]);
  __syncthreads();
  for (int task = bid; task < 192; task += nblk) {
    const int jj = tid & 31, ks = tid >> 5, j = task * 32 + jj;
    float a0 = 0.f, a1 = 0.f, a2 = 0.f, a3 = 0.f;
#pragma unroll 8
    for (int kk = 0; kk < 64; ++kk) {
      const int k = ks * 64 + kk;
      const float w = p.w_ada[(size_t)k * 6144 + j];
      a0 += sc[k] * w; a1 += sc[1024 + k] * w; a2 += sc[2048 + k] * w; a3 += sc[3072 + k] * w;
    }
    *(LAS f32x4*)(part + (ks * 32 + jj) * 4) = (f32x4){a0, a1, a2, a3};
    __syncthreads();
    if (tid < 128) {
      const int j2 = tid & 31, bb = tid >> 5;
      float a = 0.f;
#pragma unroll
      for (int s = 0; s < 16; ++s) a += part[(s * 32 + j2) * 4 + bb];
      p.mod[bb * 6144 + task * 32 + j2] = a + p.b_ada[task * 32 + j2];
    }
    __syncthreads();
  }
}

#define WT_T0 1424
#define WT_T1 (WT_T0 + 16384)
#define WT_T2 (WT_T1 + 8192)
#define WT_T3 (WT_T2 + 128)
#define WT_T4 (WT_T3 + 128)
#define WT_T5 (WT_T4 + 256)
struct WtTile { const float* src; bf16_t* dst; int K, N, mode, k0, n0; };
__device__ __forceinline__ WtTile wt_desc(const Params& p, int t) {
  WtTile d;
  if (t < WT_T0) { const int kt = t / 89, nt = t % 89; d = {p.w_in, p.w_in_t, 1024, INW, 1, kt * 64, nt * 64}; }
  else if (t < WT_T1) { const int u = t - WT_T0, e = u >> 9, r = u & 511, kt = r >> 5, nt = r & 31; d = {p.w_gu + (size_t)e * 1024 * 2048, p.wgu_t + (size_t)e * 2048 * 1024, 1024, 2048, 2, kt * 64, nt * 64}; }
  else if (t < WT_T2) { const int u = t - WT_T1, e = u >> 8, r = u & 255, kt = r >> 4, nt = r & 15; d = {p.w_down + (size_t)e * 1024 * 1024, p.wd_t + (size_t)e * 1024 * 1024, 1024, 1024, 0, kt * 64, nt * 64}; }
  else if (t < WT_T3) { const int u = t - WT_T2, kt = u >> 4, nt = u & 15; d = {p.w_br_a, p.wbra_t, 512, 1024, 0, kt * 64, nt * 64}; }
  else if (t < WT_T4) { const int u = t - WT_T3, kt = u >> 4, nt = u & 15; d = {p.w_br_b, p.wbrb_t, 512, 1024, 0, kt * 64, nt * 64}; }
  else { const int u = t - WT_T4, kt = u >> 4, nt = u & 15; d = {p.w_o, p.wo_t, 1024, 1024, 0, kt * 64, nt * 64}; }
  return d;
}
__device__ __forceinline__ void wt_load(const WtTile& d, int tid, f32x4 (&v)[2]) {
#pragma unroll
  for (int it = 0; it < 2; ++it) {
    const int row = (tid >> 4) + 32 * it, n = d.n0 + (tid & 15) * 4;
    v[it] = (f32x4){0.f, 0.f, 0.f, 0.f};
    if (n < d.N) v[it] = __builtin_nontemporal_load((const f32x4*)(d.src + (size_t)(d.k0 + row) * d.N + n));
  }
}
__device__ void ph_wt(const Params& p, LAS unsigned char* lds, int nblk, int bid) {
  LAS float* tile = (LAS float*)(lds + 32768);
  const int tid = p.tid;
  int t = bid;
  if (t >= WT_T5) return;
  WtTile cur = wt_desc(p, t);
  f32x4 v[2]; wt_load(cur, tid, v);
  WtTile nxt = cur; f32x4 vn[2] = {v[0], v[1]};
  if (t + nblk < WT_T5) { nxt = wt_desc(p, t + nblk); wt_load(nxt, tid, vn); }
  for (;;) {
    const int tnn = t + 2 * nblk;
    WtTile nn = nxt; f32x4 vnn[2] = {vn[0], vn[1]};
    if (tnn < WT_T5) { nn = wt_desc(p, tnn); wt_load(nn, tid, vnn); }
#pragma unroll
    for (int it = 0; it < 2; ++it) {
      const int row = (tid >> 4) + 32 * it, c4 = (tid & 15) * 4;
      tile[row * 65 + c4] = v[it][0]; tile[row * 65 + c4 + 1] = v[it][1]; tile[row * 65 + c4 + 2] = v[it][2]; tile[row * 65 + c4 + 3] = v[it][3];
    }
    __syncthreads();
    {
      const int nl = tid >> 3, kc = tid & 7, n = cur.n0 + nl;
      if (n < cur.N) {
        const int dd = map_col(n, cur.mode);
        if (dd >= 0) {
          float f[8];
#pragma unroll
          for (int j = 0; j < 8; ++j) f[j] = tile[(8 * kc + j) * 65 + nl];
          u32x4 w; w.x = pk2(f[0], f[1]); w.y = pk2(f[2], f[3]); w.z = pk2(f[4], f[5]); w.w = pk2(f[6], f[7]);
          *(u32x4*)(cur.dst + (size_t)dd * cur.K + cur.k0 + 8 * kc) = w;
        }
      }
    }
    __syncthreads();
    if (t + nblk >= WT_T5) break;
    t += nblk; cur = nxt; v[0] = vn[0]; v[1] = vn[1]; nxt = nn; vn[0] = vnn[0]; vn[1] = vnn[1];
  }
}

__device__ void ph_h(const Params& p, LAS unsigned char* lds, int nblk, int bid) {
  const int wid = p.tid >> 6, lane = p.tid & 63;
  LAS float* wb = (LAS float*)lds;
  for (int i = p.tid; i < 2048; i += 512) {
    const int k = i >> 1, hf = i & 1;
    const f32x4 v = *(const f32x4*)(p.w_in + (size_t)k * INW + 2048 + 4 * hf);
    wb[(4 * hf + 0) * 1024 + k] = v[0]; wb[(4 * hf + 1) * 1024 + k] = v[1]; wb[(4 * hf + 2) * 1024 + k] = v[2]; wb[(4 * hf + 3) * 1024 + k] = v[3];
  }
  __syncthreads();
  for (int t = bid * 8 + wid; t < T_TOK; t += nblk * 8) {
    const int b = t / SEQ;
    const float* xr = p.x + (size_t)t * DM;
    f32x4 xv[4];
    float ss = 0.f;
#pragma unroll
    for (int i = 0; i < 4; ++i) {
      xv[i] = *(const f32x4*)(xr + i * 256 + lane * 4);
      ss += xv[i][0] * xv[i][0] + xv[i][1] * xv[i][1] + xv[i][2] * xv[i][2] + xv[i][3] * xv[i][3];
    }
    ss = wave_sum(ss);
    const float rstd = rsqrtf(ss * (1.f / DM) + 1e-6f);
    const float* shift = p.mod + b * 6144;
    const float* scale = p.mod + b * 6144 + 1024;
    float acc[8] = {0, 0, 0, 0, 0, 0, 0, 0};
#pragma unroll
    for (int i = 0; i < 4; ++i) {
      const int k = i * 256 + lane * 4;
      const f32x4 g = *(const f32x4*)(p.g_pre_mix + k), sc = *(const f32x4*)(scale + k), sh = *(const f32x4*)(shift + k);
      f32x4 hv;
#pragma unroll
      for (int j = 0; j < 4; ++j) hv[j] = xv[i][j] * rstd * g[j] * (1.f + sc[j]) + sh[j];
#pragma unroll
      for (int e = 0; e < 8; ++e) { const f32x4 w = *(const LAS f32x4*)(wb + e * 1024 + k); acc[e] += hv[0] * w[0] + hv[1] * w[1] + hv[2] * w[2] + hv[3] * w[3]; }
      u32x2 pk; pk.x = pk2(hv[0], hv[1]); pk.y = pk2(hv[2], hv[3]);
      *(u32x2*)(p.hbf + (size_t)t * DM + k) = pk;
    }
#pragma unroll
    for (int e = 0; e < 8; ++e) acc[e] = wave_sum(acc[e]);
    if (lane == 0) { *(f32x4*)(p.ba + (size_t)t * 8) = (f32x4){acc[0], acc[1], acc[2], acc[3]}; *(f32x4*)(p.ba + (size_t)t * 8 + 4) = (f32x4){acc[4], acc[5], acc[6], acc[7]}; }
  }
}

__device__ void ph_post_mix(const Params& p, LAS unsigned char* lds, int nblk, int bid, int rep) {
  const int wid = p.tid >> 6, lane = p.tid & 63;
  LAS bf16_t* wl = (LAS bf16_t*)lds;
  LAS float* sh = (LAS float*)(lds + 81920) + wid * 1024;
  LAS int* lcnt = (LAS int*)(lds + 114688);
  LAS int* lbase = lcnt + 32;
  LAS int* lent = (LAS int*)(lds + 115200) + wid * 256;
  int nloc = 0;
  if (p.tid < 32) lcnt[p.tid] = 0;
  for (int i = p.tid; i < 1024 * 8; i += 512) {
    const int k = i >> 3, c = i & 7;
    const f32x4 v = *(const f32x4*)(p.w_router + (size_t)k * 32 + c * 4);
    u32x2 w2; w2.x = pk2(v[0], v[1]); w2.y = pk2(v[2], v[3]);
    *(LAS u32x2*)(wl + k * 40 + c * 4) = w2;
  }
  __syncthreads();
  u32x4 mxn[2]; f32x4 xn[4];
  {
    const int t0 = bid * 8 + wid;
    if (t0 < T_TOK) {
#pragma unroll
      for (int i = 0; i < 2; ++i) mxn[i] = *(const u32x4*)(p.mixer + (size_t)t0 * DM + i * 512 + lane * 8);
#pragma unroll
      for (int i = 0; i < 4; ++i) xn[i] = *(const f32x4*)(p.x + (size_t)t0 * DM + (i >> 1) * 512 + lane * 8 + (i & 1) * 4);
    }
  }
  for (int t = bid * 8 + wid; t < T_TOK; t += nblk * 8) {
    const int b = t / SEQ;
    const float* md = p.mod + b * 6144;
    u32x4 mxc[2] = {mxn[0], mxn[1]}; f32x4 xc[4] = {xn[0], xn[1], xn[2], xn[3]};
    {
      const int tn = t + nblk * 8;
      if (tn < T_TOK) {
#pragma unroll
        for (int i = 0; i < 2; ++i) mxn[i] = *(const u32x4*)(p.mixer + (size_t)tn * DM + i * 512 + lane * 8);
#pragma unroll
        for (int i = 0; i < 4; ++i) xn[i] = *(const f32x4*)(p.x + (size_t)tn * DM + (i >> 1) * 512 + lane * 8 + (i & 1) * 4);
      }
    }
    float mv[16];
    float ss = 0.f;
#pragma unroll
    for (int i = 0; i < 2; ++i) {
      float f[8]; unpack8(mxc[i], f);
#pragma unroll
      for (int j = 0; j < 8; ++j) { mv[i * 8 + j] = f[j]; ss += f[j] * f[j]; }
    }
    ss = wave_sum(ss);
    const float rstd = rsqrtf(ss * (1.f / DM) + 1e-6f);
    float x1[16];
    float s2 = 0.f;
#pragma unroll
    for (int i = 0; i < 2; ++i)
#pragma unroll
      for (int j4 = 0; j4 < 2; ++j4) {
        const int k = i * 512 + lane * 8 + j4 * 4;
        const f32x4 xv = xc[i * 2 + j4];
        const f32x4 gm = *(const f32x4*)(md + 2048 + k), gp = *(const f32x4*)(p.g_post_mix + k);
        f32x4 o;
#pragma unroll
        for (int j = 0; j < 4; ++j) { o[j] = xv[j] + gm[j] * (mv[i * 8 + j4 * 4 + j] * rstd * gp[j]); x1[i * 8 + j4 * 4 + j] = o[j]; s2 += o[j] * o[j]; }
        *(f32x4*)(p.out + (size_t)t * DM + k) = o;
      }
    s2 = wave_sum(s2);
    const float rstd2 = rsqrtf(s2 * (1.f / DM) + 1e-6f);
#pragma unroll
    for (int i = 0; i < 2; ++i) {
      float hv[8];
#pragma unroll
      for (int j = 0; j < 8; ++j) {
        const int k = i * 512 + lane * 8 + j;
        hv[j] = x1[i * 8 + j] * rstd2 * p.g_pre_ffn[k] * (1.f + md[4096 + k]) + md[3072 + k];
        sh[k] = hv[j];
      }
      u32x4 w; w.x = pk2(hv[0], hv[1]); w.y = pk2(hv[2], hv[3]); w.z = pk2(hv[4], hv[5]); w.w = pk2(hv[6], hv[7]);
      *(u32x4*)(p.h2 + (size_t)t * DM + i * 512 + lane * 8) = w;
    }
#ifdef PM_SKIP
    if (rep) continue;
#endif
    float acc[32];
#pragma unroll
    for (int e2 = 0; e2 < 32; ++e2) acc[e2] = 0.f;
#pragma unroll 4
    for (int i = 0; i < 16; ++i) {
      const float hk = sh[lane + 64 * i];
      const LAS u32x4* wr = (const LAS u32x4*)(wl + (lane + 64 * i) * 40);
#pragma unroll
      for (int c4 = 0; c4 < 4; ++c4) {
        float f[8]; unpack8(wr[c4], f);
#pragma unroll
        for (int j = 0; j < 8; ++j) acc[c4 * 8 + j] += hk * f[j];
      }
    }
    {
      const bool u5 = lane & 32, u4 = lane & 16, u3 = lane & 8, u2 = lane & 4, u1 = lane & 2;
      float a16[16], a8[8], a4[4], a2[2];
#pragma unroll
      for (int j = 0; j < 16; ++j) { const float snd = u5 ? acc[j] : acc[16 + j]; const float rcv = __shfl_xor(snd, 32, 64); a16[j] = (u5 ? acc[16 + j] : acc[j]) + rcv; }
#pragma unroll
      for (int j = 0; j < 8; ++j) { const float snd = u4 ? a16[j] : a16[8 + j]; const float rcv = __shfl_xor(snd, 16, 64); a8[j] = (u4 ? a16[8 + j] : a16[j]) + rcv; }
#pragma unroll
      for (int j = 0; j < 4; ++j) { const float snd = u3 ? a8[j] : a8[4 + j]; const float rcv = __shfl_xor(snd, 8, 64); a4[j] = (u3 ? a8[4 + j] : a8[j]) + rcv; }
#pragma unroll
      for (int j = 0; j < 2; ++j) { const float snd = u2 ? a4[j] : a4[2 + j]; const float rcv = __shfl_xor(snd, 4, 64); a2[j] = (u2 ? a4[2 + j] : a4[j]) + rcv; }
      const float snd = u1 ? a2[0] : a2[1]; const float rcv = __shfl_xor(snd, 2, 64);
      float a1 = (u1 ? a2[1] : a2[0]) + rcv;
      a1 += __shfl_xor(a1, 1, 64);
      acc[0] = a1;
    }
    const int e = lane >> 1;
    float lg = acc[0] + p.b_router[e];
    if (lane & 1) lg = -INFINITY;
    float tv[4]; int ti[4];
#pragma unroll
    for (int r = 0; r < 4; ++r) {
      const float m = wave_max(lg);
      const unsigned long long bal = __ballot(lg == m);
      const int idx = __ffsll((long long)bal) - 1;
      tv[r] = m; ti[r] = idx >> 1;
      if (lane == idx) lg = -INFINITY;
    }
    const float e1 = __expf(tv[1] - tv[0]), e2 = __expf(tv[2] - tv[0]), e3 = __expf(tv[3] - tv[0]);
    const float inv = 1.f / (1.f + e1 + e2 + e3);
    if (lane < 4) {
      const int ee = lane == 0 ? ti[0] : lane == 1 ? ti[1] : lane == 2 ? ti[2] : ti[3];
      const float ww = (lane == 0 ? 1.f : lane == 1 ? e1 : lane == 2 ? e2 : e3) * inv;
      p.aw[t * 4 + lane] = ww;
      const int rank = __hip_atomic_fetch_add(&lcnt[ee], 1, __ATOMIC_RELAXED, __HIP_MEMORY_SCOPE_WORKGROUP);
      lent[nloc * 4 + lane] = (ee << 16) | rank;
      lent[nloc * 4 + lane + 2048] = t * 4 + lane;
    }
    ++nloc;
  }
  __syncthreads();
  if (p.tid < 32) lbase[p.tid] = atomicAdd(&p.cnt[p.tid * 64 + 32 * rep], lcnt[p.tid]);
  __syncthreads();
  for (int i = lane; i < nloc * 4; i += 64) {
    const int er = lent[i], a = lent[i + 2048];
    p.elist[(er >> 16) * T_TOK + lbase[er >> 16] + (er & 0xffff)] = a;
  }
}

__device__ void ph_gather(const Params& p, LAS unsigned char* lds, int nblk, int bid) {
  const int wid = p.tid >> 6, lane = p.tid & 63;
  LAS int* tb = (LAS int*)lds;
  if (p.tid == 0) { int off = 0; for (int k = 0; k < NE; ++k) { const int c = p.cnt[k * 64]; tb[k] = off; tb[64 + k] = c; off += ((c + 255) >> 8) << 8; } tb[NE] = off; }
  __syncthreads();
  const int total = tb[NE];
  for (int r = bid * 8 + wid; r < total; r += nblk * 8) {
    int e = 0;
#pragma unroll 1
    for (int k = 1; k < NE; ++k) if (r >= tb[k]) e = k;
    const int i = r - tb[e];
    const int a = (i < tb[64 + e]) ? p.elist[e * T_TOK + i] : -1;
    if (lane == 0) p.rowmap[r] = a;
    u32x4 v0 = {0, 0, 0, 0}, v1 = v0;
    if (a >= 0) { const u32x4* src = (const u32x4*)(p.h2 + (size_t)(a >> 2) * DM); v0 = src[lane]; v1 = src[64 + lane]; }
    u32x4* dst = (u32x4*)(p.xs + (size_t)r * DM);
    dst[lane] = v0; dst[64 + lane] = v1;
  }
}

__device__ void ph_final(const Params& p, int nblk, int bid, int rep) {
  const int wid = p.tid >> 6, lane = p.tid & 63;
  for (int t0 = bid * 8 + wid; t0 < T_TOK; t0 += nblk * 16) {
    int tt[2] = {t0, t0 + nblk * 8};
    if (tt[1] >= T_TOK) tt[1] = t0;
    float mv[2][16]; float ss[2];
#pragma unroll
    for (int u = 0; u < 2; ++u) {
      const int t = tt[u];
      const f32x4 wv = *(const f32x4*)(p.aw + t * 4);
      ss[u] = 0.f;
#pragma unroll
      for (int i = 0; i < 2; ++i) {
        const bf16_t* y = p.yslot + (size_t)t * 4 * DM + i * 512 + lane * 8;
        float f0[8], f1[8], f2[8], f3[8];
        unpack8(*(const u32x4*)y, f0); unpack8(*(const u32x4*)(y + DM), f1); unpack8(*(const u32x4*)(y + 2 * DM), f2); unpack8(*(const u32x4*)(y + 3 * DM), f3);
#pragma unroll
        for (int j = 0; j < 8; ++j) { const float m = wv[0] * f0[j] + wv[1] * f1[j] + wv[2] * f2[j] + wv[3] * f3[j]; mv[u][i * 8 + j] = m; ss[u] += m * m; }
      }
    }
    f32x4 x1[2][4];
#pragma unroll
    for (int u = 0; u < 2; ++u)
#pragma unroll
      for (int i = 0; i < 2; ++i)
#pragma unroll
        for (int j4 = 0; j4 < 2; ++j4) x1[u][i * 2 + j4] = *(const f32x4*)(p.out + (size_t)tt[u] * DM + i * 512 + lane * 8 + j4 * 4);
    ss[0] = wave_sum(ss[0]); ss[1] = wave_sum(ss[1]);
#pragma unroll
    for (int u = 0; u < 2; ++u) {
      const int t = tt[u];
      if (u == 1 && t == t0) break;
      const float* md = p.mod + (t / SEQ) * 6144;
      const float rstd = rsqrtf(ss[u] * (1.f / DM) + 1e-6f);
#pragma unroll
      for (int i = 0; i < 2; ++i)
#pragma unroll
        for (int j4 = 0; j4 < 2; ++j4) {
          const int k = i * 512 + lane * 8 + j4 * 4;
          float* op = p.out + (size_t)t * DM + k;
          const f32x4 gf = *(const f32x4*)(md + 5120 + k), gp = *(const f32x4*)(p.g_post_ffn + k);
          f32x4 o;
#pragma unroll
          for (int j = 0; j < 4; ++j) o[j] = x1[u][i * 2 + j4][j] + gf[j] * (mv[u][i * 8 + j4 * 4 + j] * rstd * gp[j]);
          *(f32x4*)(rep ? (float*)p.hbf + (size_t)(t & 8191) * DM + k : op) = o;
        }
    }
  }
}

#define XCD_BAR_WORDS 3456
struct KArgs { const void* in[22]; float* out; char* ws; long long never; };
__host__ __device__ inline size_t al(size_t x) { return (x + 255) & ~(size_t)255; }
__host__ __device__ inline void fill_params(Params& p, const KArgs& k) {
  p.x = (const float*)k.in[0]; p.c = (const float*)k.in[1]; p.w_ada = (const float*)k.in[2]; p.b_ada = (const float*)k.in[3];
  p.g_pre_mix = (const float*)k.in[4]; p.g_post_mix = (const float*)k.in[5]; p.g_pre_ffn = (const float*)k.in[6];
  p.g_post_ffn = (const float*)k.in[7]; p.w_in = (const float*)k.in[8]; p.conv_w = (const float*)k.in[9];
  p.a_log = (const float*)k.in[10]; p.dt_bias = (const float*)k.in[11]; p.g_dn_out = (const float*)k.in[12];
  p.w_br_a = (const float*)k.in[13]; p.w_br_b = (const float*)k.in[14]; p.w_o = (const float*)k.in[15];
  p.w_router = (const float*)k.in[16]; p.b_router = (const float*)k.in[17]; p.w_gu = (const float*)k.in[18];
  p.b_gu = (const float*)k.in[19]; p.w_down = (const float*)k.in[20]; p.b_down = (const float*)k.in[21];
  p.out = k.out;
  char* w = k.ws;
  size_t o = 0;
#define take(bytes) (w + (o += al(bytes)) - al(bytes))
  p.mod = (float*)take(4 * 6144 * 4);
  p.cnt = (int*)take(16384);
  p.ba = (float*)take((size_t)T_TOK * 8 * 4);
  p.hbf = (bf16_t*)take((size_t)T_TOK * DM * 2);
  p.proj = (bf16_t*)take((size_t)T_TOK * PW * 2);
  p.w_in_t = (bf16_t*)take((size_t)PW * DM * 2);
  p.wgu_t = (bf16_t*)take((size_t)NE * 2048 * DM * 2);
  p.wd_t = (bf16_t*)take((size_t)NE * 1024 * DM * 2);
  p.wbra_t = (bf16_t*)take((size_t)1024 * 512 * 2);
  p.wbrb_t = (bf16_t*)take((size_t)1024 * 512 * 2);
  p.wo_t = (bf16_t*)take((size_t)1024 * 1024 * 2);
  p.qb = (bf16_t*)take((size_t)T_TOK * 512 * 2);
  p.kb = (bf16_t*)take((size_t)T_TOK * 512 * 2);
  p.kmean = (float*)take((size_t)16 * 16 * 128 * 4);
  p.oab = (bf16_t*)take((size_t)T_TOK * DM * 2);
  p.merged = (bf16_t*)take((size_t)T_TOK * DM * 2);
  p.mixer = (bf16_t*)take((size_t)T_TOK * DM * 2);
  p.h2 = (bf16_t*)take((size_t)T_TOK * DM * 2);
  p.elist = (int*)take((size_t)NE * T_TOK * 4);
  p.aw = (float*)take((size_t)T_TOK * 4 * 4);
  p.rowmap = (int*)take((size_t)73728 * 4);
  p.dnA = (unsigned char*)take((size_t)1024 * DN_ABYTES);
  p.dnU = (float*)take((size_t)1024 * DN_UFLOATS * 4);
  p.dnG = (float*)take(4096);
  p.oab2 = (bf16_t*)take((size_t)T_TOK * 512 * 2);
  p.dbg = (float*)take(256);
  p.bar = (unsigned*)take(XCD_BAR_WORDS * 4);
  p.dn_out = p.oab; p.dn_out_ld = DM;
  p.Kp = (bf16_t*)take((size_t)16 * 128 * 8192);
  p.Vp = (bf16_t*)take((size_t)16 * 128 * 8192);
  p.wq = p.cnt + 32 * 64;
  p.mb_out = p.oab; p.mb_out_ld = DM; p.mb_out_off = 512;
  p.xs = p.proj;
  char* big = take((size_t)73728 * DM * 2 + (size_t)65536 * DM * 2);
  p.act = (bf16_t*)big;
  p.yslot = (bf16_t*)(big + (size_t)73728 * DM * 2);
  {
    char* s = big; size_t so = 0;
#define t2(bytes) (s + (so += al(bytes)) - al(bytes))
    p.nq = (float*)t2((size_t)T_TOK * 512 * 4);
    p.nk = (float*)t2((size_t)T_TOK * 512 * 4);
    p.nv = (float*)t2((size_t)T_TOK * 512 * 4);
    p.no = (float*)t2((size_t)T_TOK * 512 * 4);
    p.ntmp = (float*)t2((size_t)T_TOK * DM * 4);
    p.nbeta = (float*)t2((size_t)T_TOK * 4 * 4);
    p.ng = (float*)t2((size_t)T_TOK * 4 * 4);
  }

#undef take
#undef t2
  p.never = (int)k.never;
}

#define XB_TMO      128
#define XB_XCNT(j)  (256  + 64 * (j))
#define XB_XSUB(j)  (1280 + 64 * (j))
#define XB_XGEN(j)  (2304 + 64 * (j))
#define XB_TOP      3328
#define XB_TOPGEN   3392
#define XB_SPIN_CAP (1u << 18)

__device__ __forceinline__ unsigned xb_ld(unsigned* p)              { return __hip_atomic_load(p, __ATOMIC_RELAXED, __HIP_MEMORY_SCOPE_AGENT); }
__device__ __forceinline__ unsigned xb_add(unsigned* p, unsigned v) { return __hip_atomic_fetch_add(p, v, __ATOMIC_RELAXED, __HIP_MEMORY_SCOPE_AGENT); }
__device__ __forceinline__ unsigned xb_xcc_id() { return (unsigned)__builtin_amdgcn_s_getreg((3 << 11) | 20) & 0xFu; }
#define XB_SPIN(cond, bar) do { unsigned _sp = 0; while (cond) { __builtin_amdgcn_s_sleep(1); \
    if ((++_sp & 255u) == 0u) { if (xb_ld(&(bar)[XB_TMO])) break; if (_sp > XB_SPIN_CAP) { atomicAdd(&(bar)[XB_TMO], 1u); break; } } } } while (0)

struct XcdBarrier {
    unsigned* bar; unsigned x;
    volatile LAS unsigned* st;
};

__device__ __forceinline__ XcdBarrier xcd_barrier_post(unsigned* bar, volatile LAS unsigned* st) {
    XcdBarrier b; b.bar = bar; b.x = xb_xcc_id(); b.st = st;
    if (threadIdx.x == 0) (void)xb_add(&bar[XB_XCNT(b.x)], 1u);
    return b;
}
__device__ __forceinline__ void xcd_barrier_complete(unsigned* bar, unsigned x, unsigned& nloc, unsigned& nx) {
    const unsigned G = gridDim.x * gridDim.y * gridDim.z;
    unsigned sum, cnt, mine, sp = 0u;
    for (;;) {
        sum = 0u; cnt = 0u; mine = 0u;
#pragma unroll
        for (unsigned j = 0; j < 16; ++j) { const unsigned c = xb_ld(&bar[XB_XCNT(j)]); sum += c; cnt += (c > 0u) ? 1u : 0u; mine = (j == x) ? c : mine; }
        if (sum == G) break;
        __builtin_amdgcn_s_sleep(1);
        if ((++sp & 255u) == 0u) { if (xb_ld(&bar[XB_TMO])) break; if (sp > XB_SPIN_CAP) { atomicAdd(&bar[XB_TMO], 1u); break; } }
    }
    nloc = mine > 0u ? mine : 1u; nx = cnt > 0u ? cnt : 1u;
}

__device__ __forceinline__ void xcd_barrier(const XcdBarrier& b, const int tid) {
    asm volatile("s_waitcnt vmcnt(0)" ::: "memory");
    __syncthreads();
    if (tid == 0) {
        unsigned* bar = b.bar;
        __builtin_amdgcn_s_waitcnt(0);
        unsigned nloc = b.st[0], nx = b.st[1];
        if (nloc == 0u) { xcd_barrier_complete(bar, b.x, nloc, nx); b.st[0] = nloc; b.st[1] = nx; }
        const unsigned old = xb_add(&bar[XB_XSUB(b.x)], 1u);
        const unsigned gen = old / nloc;
        if (old + 1u == (gen + 1u) * nloc) {
            __builtin_amdgcn_fence(__ATOMIC_RELEASE, "agent");
            asm volatile("s_waitcnt vmcnt(0)" ::: "memory");
            const unsigned og = xb_add(&bar[XB_TOP], 1u);
            const unsigned tg = og / nx;
            if (og + 1u == (tg + 1u) * nx) xb_add(&bar[XB_TOPGEN], 1u);
            else XB_SPIN(xb_ld(&bar[XB_TOPGEN]) == tg, bar);
            __builtin_amdgcn_fence(__ATOMIC_ACQUIRE, "agent");
            xb_add(&bar[XB_XGEN(b.x)], 1u);
            asm volatile("s_waitcnt vmcnt(0)" ::: "memory");
        } else {
            XB_SPIN(xb_ld(&bar[XB_XGEN(b.x)]) == gen, bar);
            __builtin_amdgcn_fence(__ATOMIC_ACQUIRE, "agent");
            asm volatile("s_waitcnt vmcnt(0)" ::: "memory");
        }
    }
    __syncthreads();
}


__device__ __forceinline__ void load_ka(KArgs& kk) {
#if defined(__HIP_DEVICE_COMPILE__)
  typedef __attribute__((address_space(1))) char* gptr_t;
  typedef const __attribute__((address_space(4))) gptr_t* kptr_t;
  kptr_t kp = (kptr_t)__builtin_amdgcn_kernarg_segment_ptr();
  asm volatile("" : "+s"(kp));
#pragma unroll
  for (int i = 0; i < 22; ++i) kk.in[i] = (const void*)kp[i];
  kk.out = (float*)kp[22];
  kk.ws = (char*)kp[23];
  kk.never = ((const __attribute__((address_space(4))) long long*)kp)[24];
#endif
}
__device__ __forceinline__ void grid_bar(const Params& p, LAS unsigned char* lds);
#define MEGA_LDS 148480
#define MEGA_LDS_ALLOC (MEGA_LDS + 16)
__device__ __forceinline__ void grid_bar(const Params& p, LAS unsigned char* lds) {
  XcdBarrier b; b.bar = p.bar; b.x = xb_xcc_id(); b.st = (volatile LAS unsigned*)(lds + MEGA_LDS);
  xcd_barrier(b, p.tid);
}
__global__ __launch_bounds__(512) void mega(KArgs ka) {
  extern __shared__ __attribute__((aligned(16))) unsigned char shm[];
  LAS unsigned char* lds = (LAS unsigned char*)shm;
  cg::grid_group grid = cg::this_grid();
  const int nblk = gridDim.x, bid = blockIdx.x;
  const int wv_ = __builtin_amdgcn_readfirstlane(threadIdx.x >> 6);
  volatile LAS unsigned* xst = (volatile LAS unsigned*)(lds + MEGA_LDS);
  if (threadIdx.x == 0) { xst[0] = 0u; xst[1] = 0u; xst[2] = 0u; xst[3] = 0u; }
  __syncthreads();
  { Params p0; fill_params(p0, ka); (void)xcd_barrier_post(p0.bar, xst); }
  if (ka.never) grid.sync();
#ifndef REPMASK
#define REPMASK 0
#endif
#define LOADKA KArgs kk; load_ka(kk)
#ifndef PHMASK
#define PHMASK 0xffff
#endif
#define PHASE(k, body) if (((PHMASK) >> (k)) & 1) for (int rep_ = 0; rep_ < (((REPMASK) >> (k)) & 1) + 1; ++rep_) { \
    LOADKA; Params p; fill_params(p, kk); { int t_; asm volatile("v_mbcnt_lo_u32_b32 %0, -1, 0\n\tv_mbcnt_hi_u32_b32 %0, -1, %0" : "=v"(t_)); p.tid = (wv_ << 6) | t_; } body; grid_bar(p, lds); }
#ifdef XBAR
  for (int xb_ = 0; xb_ < XBAR; ++xb_) { PHASE(15, {}) }
#endif
  PHASE(0, { ph_mod(p, lds, nblk, bid); ph_wt(p, lds, nblk, bid); })
  PHASE(1, { ph_h(p, lds, nblk, bid); })
  PHASE(2, { ph_proj(p, lds, nblk, bid); })
  PHASE(3, { bool first = true; for (int ci = bid; ci < 1024; ci += nblk) { dn_prep_chunk(p, lds, ci, first); first = false; }
             for (int item = bid; item < 256; item += nblk) moba_prep_block(p, lds, item); })
  PHASE(4, { if (bid < 32) dn_scan_blk(p, lds, bid); moba_worker(p, lds, rep_); })
  PHASE(5, { ph_dn_norm(p, nblk, bid); })
  PHASE(6, { ph_br(p, lds, nblk, bid); })
  PHASE(7, { ph_mix(p, lds, nblk, bid); })
  PHASE(8, { ph_post_mix(p, lds, nblk, bid, rep_); })
  PHASE(10, { ph_moe1(p, lds, nblk, bid); })
  PHASE(11, { ph_moe2(p, lds, nblk, bid); })
  PHASE(12, { ph_final(p, nblk, bid, rep_); })
}


extern "C" void kernel_launch(void* const* d_in, const int* in_sizes, int n_in, void* d_out, int out_size, void* d_ws,
                              size_t ws_size, hipStream_t stream) {
  KArgs ka{};
  for (int i = 0; i < 22; ++i) ka.in[i] = d_in[i];
  ka.out = (float*)d_out; ka.ws = (char*)d_ws; ka.never = 0;
  Params p{};
  fill_params(p, ka);
  static int grid_blocks = 0;
  if (!grid_blocks) {
    (void)hipFuncSetAttribute((const void*)mega, hipFuncAttributeMaxDynamicSharedMemorySize, MEGA_LDS_ALLOC);
    int dev = 0, cus = 0, per_cu = 0;
    (void)hipGetDevice(&dev);
    (void)hipDeviceGetAttribute(&cus, hipDeviceAttributeMultiprocessorCount, dev);
    (void)hipOccupancyMaxActiveBlocksPerMultiprocessor(&per_cu, mega, 512, MEGA_LDS_ALLOC);
    if (per_cu != 1) per_cu = 1;
    grid_blocks = cus * per_cu;
  }
  (void)hipMemsetAsync(p.cnt, 0, 16384, stream);
  (void)hipMemsetAsync(p.bar, 0, XCD_BAR_WORDS * 4, stream);
  void* args[] = {&ka};
  hipError_t e = hipLaunchCooperativeKernel((void*)mega, dim3(grid_blocks), dim3(512), args, MEGA_LDS_ALLOC, stream);
  if (e != hipSuccess) fprintf(stderr, "cooperative launch failed: %s (grid %d)\n", hipGetErrorString(e), grid_blocks);
}
```

```cpp
#include <hip/hip_runtime.h>
#include <hip/hip_cooperative_groups.h>
#include <cstdio>
namespace cg = cooperative_groups;
#include <stdint.h>

typedef unsigned short bf16_t;
#ifndef MB_ABL
#define MB_ABL 0
#endif

#define T_TOK 16384
#define SEQ 4096
#define NB 4
#define DM 1024
#define INW 5640
#define PW 5632
#define C_QA 0
#define C_KA 512
#define C_VA 1024
#define C_Z 1536
#define C_MQ 2048
#define C_MK 2560
#define C_MV 3072
#define C_GA 3584
#define C_GB 4608
#define NE 32

__device__ __forceinline__ bf16_t f2bf(float f) {
  unsigned u = __float_as_uint(f);
  u += 0x7fffu + ((u >> 16) & 1u);
  return (bf16_t)(u >> 16);
}
__device__ __forceinline__ float bf2f(bf16_t h) { return __uint_as_float(((unsigned)h) << 16); }
__device__ __forceinline__ float sigmoidf_(float x) { return 1.f / (1.f + __expf(-x)); }
__device__ __forceinline__ float siluf_(float x) { return x / (1.f + __expf(-x)); }
__device__ __forceinline__ float wave_sum(float v) {
#pragma unroll
  for (int o = 32; o > 0; o >>= 1) v += __shfl_xor(v, o, 64);
  return v;
}
__device__ __forceinline__ float wave_max(float v) {
#pragma unroll
  for (int o = 32; o > 0; o >>= 1) v = fmaxf(v, __shfl_xor(v, o, 64));
  return v;
}

typedef unsigned u32x2 __attribute__((ext_vector_type(2)));
typedef __bf16 bf16x2_t __attribute__((ext_vector_type(2)));
typedef float f32x2_t __attribute__((ext_vector_type(2)));
__device__ __forceinline__ unsigned pk2(float a, float b) { f32x2_t v = {a, b}; bf16x2_t r = __builtin_convertvector(v, bf16x2_t); return __builtin_bit_cast(unsigned, r); }

__device__ __forceinline__ unsigned pk4_fp8(float a, float b, float c, float d) {
  int w = 0;
  w = __builtin_amdgcn_cvt_pk_fp8_f32(a, b, w, false);
  w = __builtin_amdgcn_cvt_pk_fp8_f32(c, d, w, true);
  return (unsigned)w;
}

struct Params {
  const float *x, *c, *w_ada, *b_ada, *g_pre_mix, *g_post_mix, *g_pre_ffn, *g_post_ffn, *w_in, *conv_w,
      *a_log, *dt_bias, *g_dn_out, *w_br_a, *w_br_b, *w_o, *w_router, *b_router, *w_gu, *b_gu, *w_down, *b_down;
  float* out;
  float* mod;
  int* cnt;
  float* ba;
  bf16_t* hbf;
  bf16_t* proj;
  bf16_t* w_in_t;
  unsigned char* wgu8;
  unsigned char* wd8;
  unsigned char* h2q;
  unsigned char* act8;
  bf16_t* wbra_t;
  bf16_t* wbrb_t;
  bf16_t* wo_t;
  bf16_t* qb;
  bf16_t* kb;
  float* kmean;
  bf16_t* oab;
  bf16_t* merged;
  bf16_t* mixer;
  bf16_t* h2;
  int* elist;
  float* aw;
  bf16_t* act;
  bf16_t* xs;
  int* rowmap;
  bf16_t* yslot;
  unsigned char* dnA; float* dnU; float* dnG;
  bf16_t* dn_out; int dn_out_ld;
  bf16_t* oab2; float* dbg;
  unsigned* bar; int never; int tid;
  bf16_t* Kp; bf16_t* Vp; int* wq;
  bf16_t* mb_out; int mb_out_ld; int mb_out_off;
  float* nq; float* nk; float* nv;
  float* nbeta; float* ng;
  float* no;
  float* ntmp;
};

__device__ __forceinline__ int map_col(int n, int mode) {
  if (mode == 0) return n;
  if (mode == 1) return n < 2048 ? n : (n < 2056 ? -1 : n - 8);
  if (n < 1024) return (n >> 7) * 256 + (n & 127);
  int j = n - 1024;
  return (j >> 7) * 256 + 128 + (j & 127);
}
namespace pg8 {
#define PG8_LAS __attribute__((address_space(3)))
typedef short bf16x8 __attribute__((ext_vector_type(8)));
typedef float f32x4 __attribute__((ext_vector_type(4)));
typedef unsigned u32x4 __attribute__((ext_vector_type(4)));
constexpr int BM = 256, BK = 64, HALF = 128, HTB = HALF * BK * 2, STAGE_BYTES = 8 * HTB, NXCD = 8, WGM = 8;

__host__ __device__ __forceinline__ int lds_byte(int r, int c) { const int st = (r >> 4) * 2 + (c >> 5), rr = r & 15, cc = c & 31, ob = rr * 64 + cc * 2; return st * 1024 + (ob ^ (((ob >> 9) & 1) << 5)); }
__host__ __device__ __forceinline__ void stage_rc(int b, int& R, int& C) { const int st = b / 1024, sb = b % 1024, swz = sb ^ (((sb >> 9) & 1) << 5); R = (st >> 1) * 16 + swz / 64; C = (st & 1) * 32 + (swz % 64) / 2; }
__host__ __device__ __forceinline__ int perm32(int rho) { const int n = rho >> 4, i = rho & 15; return 8 * (i >> 2) + 4 * n + (i & 3); }

struct Unit { int pm, pn, z; };
__device__ __forceinline__ unsigned cvt_pk_bf16(float lo, float hi) { unsigned r; asm volatile("v_cvt_pk_bf16_f32 %0, %1, %2" : "=v"(r) : "v"(lo), "v"(hi)); return r; }

typedef int i32x8 __attribute__((ext_vector_type(8)));
typedef int i32x4 __attribute__((ext_vector_type(4)));
__device__ __forceinline__ i32x8 cat8(const bf16x8 lo, const bf16x8 hi) { const i32x4 a = __builtin_bit_cast(i32x4, lo), b = __builtin_bit_cast(i32x4, hi); return __builtin_shufflevector(a, b, 0, 1, 2, 3, 4, 5, 6, 7); }
struct TileOrder {
    int nM, nN, nwg, G, c;
    __device__ void init(int nM_, int nN_, int G_, int c_) { nM = nM_; nN = nN_; nwg = nM * nN; G = G_; c = c_; }
    __device__ bool tile(int i, int& pm, int& pn) const {
        const long L = (long)i * G + c; if (L >= nwg) return false;
        int wgid = (int)L; { const int q = nwg / NXCD, r = nwg % NXCD, xcd = wgid % NXCD, off = wgid / NXCD; wgid = (xcd < r ? xcd * (q + 1) : r * (q + 1) + (xcd - r) * q) + off; }
        const int nig = WGM * nN, gid = wgid / nig, fm = gid * WGM, gsz = (nM - fm) < WGM ? (nM - fm) : WGM;
        pm = fm + ((wgid % nig) % gsz); pn = (wgid % nig) / gsz; return true;
    }
};

template <class Epi, class Sched, bool FP8 = false>
__device__ __forceinline__ void gemm_phase(PG8_LAS unsigned char* lds, const int tid, const int lda, const int ldb, const int K, const Sched& S, const Epi& E) {
    const int wid = __builtin_amdgcn_readfirstlane(tid >> 6), lane = tid & 63, wr = wid >> 2, wc = wid & 3, fr = lane & 15, fq = lane >> 4;
    const int nt = K / BK;
    unsigned voffA[2], voffB[2];
#pragma unroll
    for (int i = 0; i < 2; ++i) { int R, C; stage_rc(tid * 16 + i * 8192, R, C); const int Rb = Epi::PERM ? ((R & ~31) + perm32(R & 31)) : R;
        voffA[i] = (unsigned)(R * lda + C) * 2u; voffB[i] = (unsigned)(Rb * ldb + C) * 2u; }
    const size_t kstep = (size_t)(BK * 2);
    const size_t hstepA = (size_t)HALF * lda * 2, hstepB = (size_t)HALF * ldb * 2;
    const unsigned ldsw = (unsigned)wid * 1024u;
    const int aoff = FP8 ? lds_byte(wr * 64 + fr, fq * 16) : lds_byte(wr * 64 + fr, fq * 8), boff = FP8 ? lds_byte(wc * 32 + fr, fq * 16) : lds_byte(wc * 32 + fr, fq * 8);
    constexpr int KOFF1 = FP8 ? 16 : 1024;
    unsigned gA[2][2] = {{0u, 0u}, {0u, 0u}}, gAn[2][2] = {{0u, 0u}, {0u, 0u}};
#define PG8_GOFFS(dst, unit) do { int t_ = tid; asm volatile("" : "+v"(t_)); _Pragma("unroll") for (int i_ = 0; i_ < 2; ++i_) { int gR_, gC_; stage_rc(t_ * 16 + i_ * 8192, gR_, gC_); \
        _Pragma("unroll") for (int h_ = 0; h_ < 2; ++h_) dst[h_][i_] = S.a_goff(unit, gR_ + 128 * h_, gC_); } } while (0)
#define PG8_SA(b, h) (((b) * 2 + (h)) * HTB)
#define PG8_SB(b, h) ((4 + (b) * 2 + (h)) * HTB)
#define PG8_STAGE(bufoff, gbase, voff) do { _Pragma("unroll") for (int _i = 0; _i < 2; ++_i) \
        __builtin_amdgcn_global_load_lds((const unsigned*)((const char*)(gbase) + (voff)[_i]), (PG8_LAS unsigned*)(lds + (bufoff) + ldsw + _i * 8192), 16, 0, 0); } while (0)
#define PG8_STAGEA(bufoff, ptr, h, nx) do { if constexpr (Sched::GATHER) { const unsigned gs_[2] = {(nx) ? gAn[h][0] : gA[h][0], (nx) ? gAn[h][1] : gA[h][1]}; PG8_STAGE(bufoff, ptr, gs_); } \
        else { PG8_STAGE(bufoff, (ptr) + (h) * hstepA, voffA); } } while (0)
#define PG8_LDA(dst, b, h) do { if constexpr (FP8) { _Pragma("unroll") for (int m = 0; m < 4; ++m) dst##8[m] = cat8(*(const PG8_LAS bf16x8*)(lds + PG8_SA(b, h) + aoff + m * 2048), *(const PG8_LAS bf16x8*)(lds + PG8_SA(b, h) + aoff + KOFF1 + m * 2048)); } \
        else { _Pragma("unroll") for (int m = 0; m < 4; ++m) _Pragma("unroll") for (int k = 0; k < 2; ++k) dst[m][k] = *(const PG8_LAS bf16x8*)(lds + PG8_SA(b, h) + aoff + k * KOFF1 + m * 2048); } } while (0)
#define PG8_LDB(dst, b, h) do { if constexpr (FP8) { _Pragma("unroll") for (int n = 0; n < 2; ++n) dst##8[n] = cat8(*(const PG8_LAS bf16x8*)(lds + PG8_SB(b, h) + boff + n * 2048), *(const PG8_LAS bf16x8*)(lds + PG8_SB(b, h) + boff + KOFF1 + n * 2048)); } \
        else { _Pragma("unroll") for (int n = 0; n < 2; ++n) _Pragma("unroll") for (int k = 0; k < 2; ++k) dst[n][k] = *(const PG8_LAS bf16x8*)(lds + PG8_SB(b, h) + boff + k * KOFF1 + n * 2048); } } while (0)
#define PG8_MMA(ai, bj, At, Bt) do { __builtin_amdgcn_s_setprio(1); if constexpr (FP8) { _Pragma("unroll") for (int m = 0; m < 4; ++m) _Pragma("unroll") for (int n = 0; n < 2; ++n) \
        asm volatile("v_mfma_scale_f32_16x16x128_f8f6f4 %0, %1, %2, %0, %3, %4 op_sel_hi:[0,0,0]" : "+v"(acc[ai][bj][m][n]) : "v"(Bt##8[n]), "v"(At##8[m]), "v"(sclB), "v"(sclA)); } \
        else { _Pragma("unroll") for (int m = 0; m < 4; ++m) _Pragma("unroll") for (int n = 0; n < 2; ++n) _Pragma("unroll") for (int k = 0; k < 2; ++k) \
        acc[ai][bj][m][n] = __builtin_amdgcn_mfma_f32_16x16x32_bf16(Bt[n][k], At[m][k], acc[ai][bj][m][n], 0, 0, 0); } __builtin_amdgcn_s_setprio(0); } while (0)
#define PG8_WAIT_V(n) asm volatile("s_waitcnt vmcnt(" #n ")" ::: "memory")
#define PG8_WAIT_L(n) asm volatile("s_waitcnt lgkmcnt(" #n ")" ::: "memory")
#define PG8_BAR __builtin_amdgcn_s_barrier()
#define PG8_SCHED __builtin_amdgcn_sched_barrier(0)
    Unit cur, nxt; int ui = 0;
    if (!S.next(0, cur)) return;
    f32x4 acc[2][2][4][2];
#pragma unroll
    for (int a = 0; a < 2; ++a)
#pragma unroll
        for (int b = 0; b < 2; ++b)
#pragma unroll
            for (int m = 0; m < 4; ++m)
#pragma unroll
                for (int n = 0; n < 2; ++n) acc[a][b][m][n] = (f32x4){0.f, 0.f, 0.f, 0.f};
    bf16x8 At[4][2], B0[2][2], B1[2][2];
    i32x8 At8[4], B08[2], B18[2];
    int sclA = 0x7f7f7f7f, sclB = 0x79797979;
    const char* cA = S.a_ptr(cur); const char* cB = S.b_ptr(cur);
    if constexpr (Sched::GATHER) { PG8_GOFFS(gA, cur); }
    PG8_STAGE(PG8_SB(0, 0), cB, voffB); PG8_STAGEA(PG8_SA(0, 0), cA, 0, false); PG8_STAGE(PG8_SB(0, 1), cB + hstepB, voffB); PG8_STAGEA(PG8_SA(0, 1), cA, 1, false);
    if (wr == 1) PG8_BAR;
    PG8_WAIT_V(4); PG8_BAR;
    PG8_STAGE(PG8_SB(1, 0), cB + kstep, voffB); PG8_STAGEA(PG8_SA(1, 0), cA + kstep, 0, false); PG8_STAGE(PG8_SB(1, 1), cB + hstepB + kstep, voffB);
    PG8_WAIT_V(6); PG8_BAR;
    for (;;) {
        const bool has_next = S.next(ui + 1, nxt);
        const char* nA = has_next ? S.a_ptr(nxt) : cA; const char* nB = has_next ? S.b_ptr(nxt) : cB;
        if constexpr (Sched::GATHER) { if (has_next) { PG8_GOFFS(gAn, nxt); } else {
_Pragma("unroll") for (int h = 0; h < 2; ++h) _Pragma("unroll") for (int i = 0; i < 2; ++i) gAn[h][i] = gA[h][i]; } }
_Pragma("unroll 1")
        for (int t = 0; t < nt; t += 2) {
            const bool last = (t == nt - 2);
            const char* a1 = cA + (size_t)(t + 1) * kstep;
            const char* a2 = last ? nA : cA + (size_t)(t + 2) * kstep; const char* b2 = last ? nB : cB + (size_t)(t + 2) * kstep;
            const char* a3 = a2 + kstep; const char* b3 = b2 + kstep;
            PG8_LDB(B0, 0, 0); PG8_SCHED; PG8_LDA(At, 0, 0); PG8_STAGEA(PG8_SA(1, 1), a1, 1, false);
            PG8_WAIT_L(8); PG8_BAR; PG8_WAIT_L(0); PG8_MMA(0, 0, At, B0); PG8_BAR; PG8_SCHED;
            PG8_LDB(B1, 0, 1); PG8_STAGE(PG8_SB(0, 0), b2, voffB);
            PG8_BAR; PG8_WAIT_L(0); PG8_MMA(0, 1, At, B1); PG8_BAR;
            PG8_LDA(At, 0, 1); PG8_STAGEA(PG8_SA(0, 0), a2, 0, last);
            PG8_BAR; PG8_WAIT_L(0); PG8_MMA(1, 0, At, B0); PG8_BAR; PG8_SCHED;
            PG8_STAGE(PG8_SB(0, 1), b2 + hstepB, voffB);
            PG8_WAIT_V(6); PG8_BAR; PG8_MMA(1, 1, At, B1); PG8_BAR;
            PG8_LDB(B0, 1, 0); PG8_SCHED; PG8_LDA(At, 1, 0); PG8_STAGEA(PG8_SA(0, 1), a2, 1, last);
            PG8_WAIT_L(8); PG8_BAR; PG8_WAIT_L(0); PG8_MMA(0, 0, At, B0); PG8_BAR; PG8_SCHED;
            PG8_LDB(B1, 1, 1); PG8_STAGE(PG8_SB(1, 0), b3, voffB);
            PG8_BAR; PG8_WAIT_L(0); PG8_MMA(0, 1, At, B1); PG8_BAR;
            PG8_LDA(At, 1, 1); PG8_STAGEA(PG8_SA(1, 0), a3, 0, last);
            PG8_BAR; PG8_WAIT_L(0); PG8_MMA(1, 0, At, B0); PG8_BAR; PG8_SCHED;
            PG8_STAGE(PG8_SB(1, 1), b3 + hstepB, voffB);
            PG8_WAIT_V(6); PG8_BAR; PG8_MMA(1, 1, At, B1); PG8_BAR;
        }
        { if constexpr (FP8) asm volatile("s_nop 15\n\ts_nop 3" ::: "memory");
          int t_ = tid; asm volatile("" : "+v"(t_));
          E(acc, cur, wr, wc, t_ & 15, (t_ & 63) >> 4); }
        if (!has_next) break;
#pragma unroll
        for (int a = 0; a < 2; ++a)
#pragma unroll
            for (int b = 0; b < 2; ++b)
#pragma unroll
                for (int m = 0; m < 4; ++m)
#pragma unroll
                    for (int n = 0; n < 2; ++n) acc[a][b][m][n] = (f32x4){0.f, 0.f, 0.f, 0.f};
        cur = nxt; cA = nA; cB = nB; ++ui;
        if constexpr (Sched::GATHER) {
_Pragma("unroll") for (int h = 0; h < 2; ++h) _Pragma("unroll") for (int i = 0; i < 2; ++i) gA[h][i] = gAn[h][i]; }
    }
    PG8_WAIT_V(0);
    if (wr == 0) PG8_BAR;
    PG8_BAR;
#undef PG8_SA
#undef PG8_SB
#undef PG8_STAGE
#undef PG8_STAGEA
#undef PG8_GOFFS
#undef PG8_LDA
#undef PG8_LDB
#undef PG8_MMA
#undef PG8_WAIT_V
#undef PG8_WAIT_L
#undef PG8_BAR
#undef PG8_SCHED
}
}
using pg8::f32x4; using pg8::u32x4; using pg8::Unit;

#define GEMM_LDS (pg8::STAGE_BYTES + 1024)

struct SchedProj : pg8::TileOrder {
  static constexpr bool GATHER = false;
  const char* A; const char* B;
  __device__ bool next(int i, Unit& u) const { u.z = 0; return tile(i, u.pm, u.pn); }
  __device__ const char* a_ptr(const Unit& u) const { return A + (size_t)u.pm * 256 * DM * 2; }
  __device__ const char* b_ptr(const Unit& u) const { return B + (size_t)u.pn * 256 * DM * 2; }
};
struct EpiProj {
  static constexpr bool PERM = true;
  bf16_t* O;
  __device__ __forceinline__ void operator()(const f32x4 (&acc)[2][2][4][2], const Unit& u, int wr, int wc, int fr, int fq) const {
    const int row0 = u.pm * 256 + wr * 64 + fr, col0 = u.pn * 256 + wc * 32 + 8 * fq;
    const bool gate = u.pn >= (C_GA / 256);
#pragma unroll
    for (int ai = 0; ai < 2; ++ai)
#pragma unroll
      for (int m = 0; m < 4; ++m) {
        bf16_t* rowp = O + (size_t)(row0 + ai * 128 + m * 16) * PW + col0;
#pragma unroll
        for (int bj = 0; bj < 2; ++bj) {
          f32x4 v0 = acc[ai][bj][m][0], v1 = acc[ai][bj][m][1];
          if (gate) {
#pragma unroll
            for (int j = 0; j < 4; ++j) { v0[j] = sigmoidf_(v0[j]); v1[j] = sigmoidf_(v1[j]); }
          }
          u32x4 w; w.x = pg8::cvt_pk_bf16(v0[0], v0[1]); w.y = pg8::cvt_pk_bf16(v0[2], v0[3]); w.z = pg8::cvt_pk_bf16(v1[0], v1[1]); w.w = pg8::cvt_pk_bf16(v1[2], v1[3]);
          *(u32x4*)(rowp + bj * 128) = w;
        }
      }
  }
};
__device__ void ph_proj(const Params& p, PG8_LAS unsigned char* lds, int nblk, int bid) {
  SchedProj S; S.init(T_TOK / 256, PW / 256, nblk, bid); S.A = (const char*)p.hbf; S.B = (const char*)p.w_in_t;
  EpiProj E{p.proj};
  pg8::gemm_phase(lds, p.tid, DM, DM, DM, S, E);
}

struct SchedBr : pg8::TileOrder {
  static constexpr bool GATHER = false;
  const char* A; const char* Ba; const char* Bb;
  __device__ bool next(int i, Unit& u) const { u.z = i & 1; return tile(i >> 1, u.pm, u.pn); }
  __device__ const char* a_ptr(const Unit& u) const { return A + (size_t)u.pm * 256 * DM * 2 + u.z * 512 * 2; }
  __device__ const char* b_ptr(const Unit& u) const { return (u.z ? Bb : Ba) + (size_t)u.pn * 256 * 512 * 2; }
};
__device__ __forceinline__ void unpack8(const u32x4 w, float (&f)[8]) {
  f[0] = __uint_as_float(w.x << 16); f[1] = __uint_as_float(w.x & 0xffff0000u); f[2] = __uint_as_float(w.y << 16); f[3] = __uint_as_float(w.y & 0xffff0000u);
  f[4] = __uint_as_float(w.z << 16); f[5] = __uint_as_float(w.z & 0xffff0000u); f[6] = __uint_as_float(w.w << 16); f[7] = __uint_as_float(w.w & 0xffff0000u);
}
struct EpiBr {
  static constexpr bool PERM = true;
  const bf16_t* proj; bf16_t* O;
  __device__ __forceinline__ void operator()(const f32x4 (&acc)[2][2][4][2], const Unit& u, int wr, int wc, int fr, int fq) const {
    const int row0 = u.pm * 256 + wr * 64 + fr, col0 = u.pn * 256 + wc * 32 + 8 * fq;
    const int gcol = (u.z ? C_GB : C_GA) + col0;
#pragma unroll
    for (int ai = 0; ai < 2; ++ai)
#pragma unroll
      for (int m = 0; m < 4; ++m) {
        const size_t row = (size_t)(row0 + ai * 128 + m * 16);
        bf16_t* rowp = O + row * DM + col0;
        const bf16_t* gp = proj + row * PW + gcol;
#pragma unroll
        for (int bj = 0; bj < 2; ++bj) {
          float g[8]; unpack8(*(const u32x4*)(gp + bj * 128), g);
          f32x4 v0 = acc[ai][bj][m][0], v1 = acc[ai][bj][m][1];
          float r[8];
#pragma unroll
          for (int j = 0; j < 4; ++j) { r[j] = v0[j] * g[j]; r[4 + j] = v1[j] * g[4 + j]; }
          if (u.z) {
            float pv[8]; unpack8(*(const u32x4*)(rowp + bj * 128), pv);
#pragma unroll
            for (int j = 0; j < 8; ++j) r[j] += pv[j];
          }
          u32x4 w; w.x = pg8::cvt_pk_bf16(r[0], r[1]); w.y = pg8::cvt_pk_bf16(r[2], r[3]); w.z = pg8::cvt_pk_bf16(r[4], r[5]); w.w = pg8::cvt_pk_bf16(r[6], r[7]);
          *(u32x4*)(rowp + bj * 128) = w;
        }
      }
  }
};
__device__ void ph_br(const Params& p, PG8_LAS unsigned char* lds, int nblk, int bid) {
  SchedBr S; S.init(T_TOK / 256, DM / 256, nblk, bid); S.A = (const char*)p.oab; S.Ba = (const char*)p.wbra_t; S.Bb = (const char*)p.wbrb_t;
  EpiBr E{p.proj, p.merged};
  pg8::gemm_phase(lds, p.tid, DM, 512, 512, S, E);
}

struct SchedMix : pg8::TileOrder {
  static constexpr bool GATHER = false;
  const char* A; const char* B;
  __device__ bool next(int i, Unit& u) const { u.z = 0; return tile(i, u.pm, u.pn); }
  __device__ const char* a_ptr(const Unit& u) const { return A + (size_t)u.pm * 256 * DM * 2; }
  __device__ const char* b_ptr(const Unit& u) const { return B + (size_t)u.pn * 256 * DM * 2; }
};
struct EpiMix {
  static constexpr bool PERM = true;
  bf16_t* O;
  __device__ __forceinline__ void operator()(const f32x4 (&acc)[2][2][4][2], const Unit& u, int wr, int wc, int fr, int fq) const {
    const int row0 = u.pm * 256 + wr * 64 + fr, col0 = u.pn * 256 + wc * 32 + 8 * fq;
#pragma unroll
    for (int ai = 0; ai < 2; ++ai)
#pragma unroll
      for (int m = 0; m < 4; ++m) {
        bf16_t* rowp = O + (size_t)(row0 + ai * 128 + m * 16) * DM + col0;
#pragma unroll
        for (int bj = 0; bj < 2; ++bj) {
          const f32x4 v0 = acc[ai][bj][m][0], v1 = acc[ai][bj][m][1];
          u32x4 w; w.x = pg8::cvt_pk_bf16(v0[0], v0[1]); w.y = pg8::cvt_pk_bf16(v0[2], v0[3]); w.z = pg8::cvt_pk_bf16(v1[0], v1[1]); w.w = pg8::cvt_pk_bf16(v1[2], v1[3]);
          *(u32x4*)(rowp + bj * 128) = w;
        }
      }
  }
};
__device__ void ph_mix(const Params& p, PG8_LAS unsigned char* lds, int nblk, int bid) {
  SchedMix S; S.init(T_TOK / 256, DM / 256, nblk, bid); S.A = (const char*)p.merged; S.B = (const char*)p.wo_t;
  EpiMix E{p.mixer};
  pg8::gemm_phase(lds, p.tid, DM, DM, DM, S, E);
}

template <bool GATH>
struct SchedMoe {
  static constexpr bool GATHER = GATH;
  const PG8_LAS int* tb; int NT; int G, c; int nwg;
  const char* A; const char* B; size_t bexp;
  const int* elist; int rowb;
  __device__ bool next(int i, Unit& u) const {
    const long L = (long)i * G + c; if (L >= nwg) return false;
    int wgid = (int)L; { const int q = nwg / 8, r = nwg % 8, xcd = wgid % 8, off = wgid / 8; wgid = (xcd < r ? xcd * (q + 1) : r * (q + 1) + (xcd - r) * q) + off; }
    int e = 0;
#pragma unroll 1
    for (int k = 1; k < NE; ++k) if (wgid >= tb[k]) e = k;
    const int q = wgid - tb[e]; const int tiles = tb[33 + e + 1] - tb[33 + e];
    u.pm = tb[33 + e] + q % tiles; u.pn = q / tiles; u.z = e; return true;
  }
  __device__ const char* a_ptr(const Unit& u) const { return GATH ? A : A + (size_t)u.pm * 256 * rowb; }
  __device__ const char* b_ptr(const Unit& u) const { return B + (size_t)u.z * bexp + (size_t)u.pn * 256 * rowb; }
  __device__ unsigned a_goff(const Unit& u, int tr, int C) const {
    const int i = (u.pm - tb[33 + u.z]) * 256 + tr;
    int tok = 0;
    if (i < tb[66 + u.z]) tok = elist[u.z * T_TOK + i] >> 2;
    return (unsigned)(tok * rowb + C * 2);
  }
};
__device__ __forceinline__ void moe_table(const Params& p, PG8_LAS int* tb, int NT) {
  if (p.tid == 0) {
    int ub = 0, tbp = 0;
    for (int e = 0; e < NE; ++e) { const int c = p.cnt[e * 64]; tb[e] = ub; tb[33 + e] = tbp; tb[66 + e] = c; const int t = (c + 255) >> 8; ub += t * NT; tbp += t; }
    tb[NE] = ub; tb[33 + NE] = tbp;
  }
  __syncthreads();
}
struct EpiMoe1 {
  static constexpr bool PERM = true;
  const float* b_gu; unsigned char* act;
  __device__ __forceinline__ void operator()(f32x4 (&acc)[2][2][4][2], const Unit& u, int wr, int wc, int fr, int fq) const {
    const int row0 = u.pm * 256 + wr * 64 + fr, jc = u.pn * 128 + wc * 32 + 8 * fq;
    const float* bg = b_gu + (size_t)u.z * 2048 + jc;
#pragma unroll
    for (int bj = 0; bj < 2; ++bj)
#pragma unroll
      for (int n = 0; n < 2; ++n) {
        const f32x4 bv = *(const f32x4*)(bg + bj * 1024 + n * 4);
#pragma unroll
        for (int ai = 0; ai < 2; ++ai)
#pragma unroll
          for (int m = 0; m < 4; ++m) acc[ai][bj][m][n] += bv;
      }
#pragma unroll
    for (int ai = 0; ai < 2; ++ai)
#pragma unroll
      for (int m = 0; m < 4; ++m) {
        unsigned char* rowp = act + (size_t)(row0 + ai * 128 + m * 16) * DM + jc;
        float r[8];
#pragma unroll
        for (int n = 0; n < 2; ++n)
#pragma unroll
          for (int j = 0; j < 4; ++j) {
            float g = acc[ai][0][m][n][j], up = acc[ai][1][m][n][j];
            g = fminf(g, 7.f); up = fminf(fmaxf(up, -7.f), 7.f);
            r[n * 4 + j] = (up + 1.f) * g * sigmoidf_(1.702f * g);
          }
        u32x2 w; w.x = pk4_fp8(r[0], r[1], r[2], r[3]); w.y = pk4_fp8(r[4], r[5], r[6], r[7]);
        *(u32x2*)rowp = w;
      }
  }
};
__device__ void ph_moe1(const Params& p, PG8_LAS unsigned char* lds, int nblk, int bid) {
  PG8_LAS int* tb = (PG8_LAS int*)(lds + pg8::STAGE_BYTES);
  moe_table(p, tb, 8);
  SchedMoe<true> S; S.tb = tb; S.NT = 8; S.G = nblk; S.c = bid; S.nwg = tb[NE]; S.A = (const char*)p.h2q; S.B = (const char*)p.wgu8; S.bexp = (size_t)2048 * DM; S.elist = p.elist; S.rowb = DM;
  EpiMoe1 E{p.b_gu, p.act8};
  pg8::gemm_phase<EpiMoe1, SchedMoe<true>, true>(lds, p.tid, DM / 2, DM / 2, DM / 2, S, E);
}
struct EpiMoe2 {
  static constexpr bool PERM = true;
  const float* b_down; const int* elist; const PG8_LAS int* tb; bf16_t* yslot;
  __device__ __forceinline__ void operator()(f32x4 (&acc)[2][2][4][2], const Unit& u, int wr, int wc, int fr, int fq) const {
    const int row0 = u.pm * 256 + wr * 64 + fr, col0 = u.pn * 256 + wc * 32 + 8 * fq;
    const float* bd = b_down + (size_t)u.z * 1024 + col0;
#pragma unroll
    for (int bj = 0; bj < 2; ++bj)
#pragma unroll
      for (int n = 0; n < 2; ++n) {
        const f32x4 bv = *(const f32x4*)(bd + bj * 128 + n * 4);
#pragma unroll
        for (int ai = 0; ai < 2; ++ai)
#pragma unroll
          for (int m = 0; m < 4; ++m) acc[ai][bj][m][n] += bv;
      }
#pragma unroll
    for (int ai = 0; ai < 2; ++ai)
#pragma unroll
      for (int m = 0; m < 4; ++m) {
        const int li = (u.pm - tb[33 + u.z]) * 256 + wr * 64 + fr + ai * 128 + m * 16;
        if (li < tb[66 + u.z]) {
          const int a = elist[u.z * T_TOK + li];
          bf16_t* rowp = yslot + (size_t)a * DM + col0;
#pragma unroll
          for (int bj = 0; bj < 2; ++bj) {
            const f32x4 v0 = acc[ai][bj][m][0], v1 = acc[ai][bj][m][1];
            u32x4 w; w.x = pk2(v0[0], v0[1]); w.y = pk2(v0[2], v0[3]); w.z = pk2(v1[0], v1[1]); w.w = pk2(v1[2], v1[3]);
            *(u32x4*)(rowp + bj * 128) = w;
          }
        }
      }
  }
};
__device__ void ph_moe2(const Params& p, PG8_LAS unsigned char* lds, int nblk, int bid) {
  PG8_LAS int* tb = (PG8_LAS int*)(lds + pg8::STAGE_BYTES);
  moe_table(p, tb, 4);
  SchedMoe<false> S; S.tb = tb; S.NT = 4; S.G = nblk; S.c = bid; S.nwg = tb[NE]; S.A = (const char*)p.act8; S.B = (const char*)p.wd8; S.bexp = (size_t)1024 * DM; S.elist = p.elist; S.rowb = DM;
  EpiMoe2 E{p.b_down, p.elist, tb, p.yslot};
  pg8::gemm_phase<EpiMoe2, SchedMoe<false>, true>(lds, p.tid, DM / 2, DM / 2, DM / 2, S, E);
}

typedef short bf16x8 __attribute__((ext_vector_type(8)));
#define LAS __attribute__((address_space(3)))
#define MFMA16(a, b, c) __builtin_amdgcn_mfma_f32_16x16x32_bf16((a), (b), (c), 0, 0, 0)
__device__ __forceinline__ bf16x8 pack8(float a0, float a1, float a2, float a3, float a4, float a5, float a6, float a7) {
  u32x4 w; w.x = pk2(a0, a1); w.y = pk2(a2, a3); w.z = pk2(a4, a5); w.w = pk2(a6, a7);
  return __builtin_bit_cast(bf16x8, w);
}
__device__ __forceinline__ bf16_t f2bf_hw(float a) { return (bf16_t)(pk2(a, 0.f) & 0xffffu); }

#define DN_ABYTES 57344
#define DN_UFLOATS 8192
#define F_WN 0
#define F_QD 16
#define F_QK 32
#define F_KT 40

#define DP_KH 0
#define DP_QT 17408
#define DP_KHT 34816
#define DP_VT 53248
#define DP_TU 71680
#define DP_TW 80896
#define DP_LF 90112
#define DP_GC 107520
#define DP_BETA 107776
#define DP_CW 108032
#define DP_LB 114176
#define DP_TR 123392
#define DP_TT 132608
#define DP_MT 141824
#define DP_TOTAL 144128

template <int KS>
__device__ __forceinline__ f32x4 prod16(const LAS bf16_t* A, int lda, int arow0, const LAS bf16_t* Bt, int ldb, int brow0, f32x4 acc, int lane) {
  const int r = lane & 15, q = lane >> 4;
#pragma unroll
  for (int ks = 0; ks < KS; ++ks) {
    const bf16x8 a = *(const LAS bf16x8*)(A + (arow0 + r) * lda + 32 * ks + 8 * q);
    const bf16x8 b = *(const LAS bf16x8*)(Bt + (brow0 + r) * ldb + 32 * ks + 8 * q);
    acc = MFMA16(a, b, acc);
  }
  return acc;
}
__device__ __forceinline__ void tile_store_rm(LAS bf16_t* X, int ld, int row0, int col0, const f32x4 v, int lane) {
  const int r = lane & 15, q = lane >> 4;
#pragma unroll
  for (int i = 0; i < 4; ++i) X[(row0 + 4 * q + i) * ld + col0 + r] = f2bf_hw(v[i]);
}
__device__ __forceinline__ void tile_store_tr(LAS bf16_t* Xt, int ld, int row0, int col0, const f32x4 v, int lane) {
  const int r = lane & 15, q = lane >> 4;
  u32x2 w; w.x = pk2(v[0], v[1]); w.y = pk2(v[2], v[3]);
  *(LAS u32x2*)(Xt + (col0 + r) * ld + row0 + 4 * q) = w;
}

__device__ void dn_prep_chunk(const Params& p, LAS unsigned char* lds, int ci, bool load_cw) {
  const int tid = p.tid, lane = tid & 63, w = tid >> 6, r16 = lane & 15, q4 = lane >> 4;
  const int bh = ci >> 6, n = ci & 63, b = bh >> 2, h = bh & 3;
  LAS bf16_t* Kh = (LAS bf16_t*)(lds + DP_KH); LAS bf16_t* Qt = (LAS bf16_t*)(lds + DP_QT);
  LAS bf16_t* KhT = (LAS bf16_t*)(lds + DP_KHT); LAS bf16_t* VT = (LAS bf16_t*)(lds + DP_VT);
  LAS bf16_t* Tu = (LAS bf16_t*)(lds + DP_TU); LAS bf16_t* Tw = (LAS bf16_t*)(lds + DP_TW); LAS float* Lf = (LAS float*)(lds + DP_LF);
  LAS bf16_t* Lb = (LAS bf16_t*)(lds + DP_LB); LAS bf16_t* Tr = (LAS bf16_t*)(lds + DP_TR); LAS bf16_t* Tt = (LAS bf16_t*)(lds + DP_TT); LAS bf16_t* Mt = (LAS bf16_t*)(lds + DP_MT);
  LAS float* gcb = (LAS float*)(lds + DP_GC); LAS float* betab = (LAS float*)(lds + DP_BETA); LAS float* cw = (LAS float*)(lds + DP_CW);
  unsigned char* gA = (unsigned char*)p.dnA + (size_t)ci * DN_ABYTES;
  float* gU = p.dnU + (size_t)ci * DN_UFLOATS;

  if (load_cw) {
    for (int i = tid; i < 4 * 384; i += 512) { const int tap = i / 384, cc = i % 384, part = cc >> 7, d = cc & 127; cw[i] = p.conv_w[tap * 1536 + part * 512 + h * 128 + d]; }
  }
  __syncthreads();
  const int c = tid >> 3, g = tid & 7;
  const int s = n * 64 + c;
  const size_t t = (size_t)b * SEQ + s;
  float qv[16], kv[16], vv[16];
#pragma unroll
  for (int j = 0; j < 16; ++j) { qv[j] = 0.f; kv[j] = 0.f; vv[j] = 0.f; }
#pragma unroll
  for (int tap = 0; tap < 4; ++tap) {
    const int ss = s - 3 + tap;
    if (ss >= 0) {
      const bf16_t* row = p.proj + (t - 3 + tap) * PW + h * 128 + 16 * g;
      float x[8];
#pragma unroll
      for (int part = 0; part < 3; ++part) {
#pragma unroll
        for (int hh = 0; hh < 2; ++hh) {
          unpack8(*(const u32x4*)(row + part * 512 + 8 * hh), x);
#pragma unroll
          for (int j = 0; j < 8; ++j) {
            const float wv = cw[tap * 384 + part * 128 + 16 * g + 8 * hh + j];
            if (part == 0) qv[8 * hh + j] += wv * x[j];
            if (part == 1) kv[8 * hh + j] += wv * x[j];
            if (part == 2) vv[8 * hh + j] += wv * x[j];
          }
        }
      }
    }
    asm volatile("" ::: "memory");
  }
  float sq = 0.f, sk = 0.f;
#pragma unroll
  for (int j = 0; j < 16; ++j) { qv[j] = siluf_(qv[j]); kv[j] = siluf_(kv[j]); vv[j] = siluf_(vv[j]); sq += qv[j] * qv[j]; sk += kv[j] * kv[j]; }
  sq += __shfl_xor(sq, 1, 64); sq += __shfl_xor(sq, 2, 64); sq += __shfl_xor(sq, 4, 64);
  sk += __shfl_xor(sk, 1, 64); sk += __shfl_xor(sk, 2, 64); sk += __shfl_xor(sk, 4, 64);
  const float rq = rsqrtf(sq + 1e-6f) * 0.08838834764831845f, rk = rsqrtf(sk + 1e-6f);
#pragma unroll
  for (int j = 0; j < 16; ++j) { qv[j] *= rq; kv[j] *= rk; }
  if (g == 0) {
    const float bb = p.ba[t * 8 + h], aa = p.ba[t * 8 + 4 + h];
    const float xx = aa + p.dt_bias[h];
    const float sp = xx > 20.f ? xx : log1pf(__expf(xx));
    betab[c] = sigmoidf_(bb);
    gcb[c] = -__expf(p.a_log[h]) * sp;
  }
  {
    u32x4 w0, w1;
    w0.x = pk2(kv[0], kv[1]); w0.y = pk2(kv[2], kv[3]); w0.z = pk2(kv[4], kv[5]); w0.w = pk2(kv[6], kv[7]);
    w1.x = pk2(kv[8], kv[9]); w1.y = pk2(kv[10], kv[11]); w1.z = pk2(kv[12], kv[13]); w1.w = pk2(kv[14], kv[15]);
    *(LAS u32x4*)(Kh + c * 136 + 16 * g) = w0; *(LAS u32x4*)(Kh + c * 136 + 16 * g + 8) = w1;
    w0.x = pk2(qv[0], qv[1]); w0.y = pk2(qv[2], qv[3]); w0.z = pk2(qv[4], qv[5]); w0.w = pk2(qv[6], qv[7]);
    w1.x = pk2(qv[8], qv[9]); w1.y = pk2(qv[10], qv[11]); w1.z = pk2(qv[12], qv[13]); w1.w = pk2(qv[14], qv[15]);
    *(LAS u32x4*)(Qt + c * 136 + 16 * g) = w0; *(LAS u32x4*)(Qt + c * 136 + 16 * g + 8) = w1;
#pragma unroll
    for (int j = 0; j < 16; ++j) { KhT[(16 * g + j) * 72 + c] = f2bf_hw(kv[j]); VT[(16 * g + j) * 72 + c] = f2bf_hw(vv[j]); }
  }
  __syncthreads();
  if (w == 0) {
    float v = gcb[lane];
#pragma unroll
    for (int o = 1; o < 64; o <<= 1) { const float u = __shfl_up(v, o, 64); if (lane >= o) v += u; }
    gcb[lane] = v;
  }
  __syncthreads();
  const float gc_c = gcb[c], gl = gcb[63];
  {
    const float eg = __expf(gc_c);
    unsigned char* fb = gA + (size_t)(F_QD + (c >> 4) * 4 + (g >> 1)) * 1024 + (g & 1) * 8;
#pragma unroll
    for (int qq = 0; qq < 4; ++qq) {
      u32x2 wv; wv.x = pk2(qv[4 * qq] * eg, qv[4 * qq + 1] * eg); wv.y = pk2(qv[4 * qq + 2] * eg, qv[4 * qq + 3] * eg);
      *(u32x2*)(fb + ((c & 15) + 16 * qq) * 16) = wv;
    }
  }
  const int rt = w >> 1, ct0 = 2 * (w & 1);
#pragma unroll
  for (int tt = 0; tt < 2; ++tt) {
    const int ct = ct0 + tt;
    f32x4 gacc = {0.f, 0.f, 0.f, 0.f};
    gacc = prod16<4>(Kh, 136, 16 * rt, Kh, 136, 16 * ct, gacc, lane);
    const int m = 16 * ct + r16; const float gc_m = gcb[m];
    f32x4 lv;
#pragma unroll
    for (int i = 0; i < 4; ++i) {
      const int cc = 16 * rt + 4 * q4 + i;
      lv[i] = (m < cc) ? betab[cc] * gacc[i] * __expf(gcb[cc] - gc_m) : 0.f;
      Lf[cc * 68 + m] = lv[i];
    }
    tile_store_rm(Lb, 72, 16 * rt, 16 * ct, lv, lane);
    f32x4 qacc = {0.f, 0.f, 0.f, 0.f};
    qacc = prod16<4>(Kh, 136, 16 * rt, Qt, 136, 16 * ct, qacc, lane);
    const int cq = 16 * ct + r16; const float gc_cq = gcb[cq];
    float o4[4];
#pragma unroll
    for (int i = 0; i < 4; ++i) { const int mm = 16 * rt + 4 * q4 + i; o4[i] = (mm <= cq) ? qacc[i] * __expf(gc_cq - gcb[mm]) : 0.f; }
    u32x2 wv; wv.x = pk2(o4[0], o4[1]); wv.y = pk2(o4[2], o4[3]);
    *(u32x2*)(gA + (size_t)(F_QK + ct * 2 + (rt >> 1)) * 1024 + (r16 + 16 * q4) * 16 + (rt & 1) * 8) = wv;
  }
  __syncthreads();
  for (int i = tid; i < 2 * 64 * 72 / 8; i += 512) ((LAS u32x4*)Tr)[i] = (u32x4){0u, 0u, 0u, 0u};
  __syncthreads();
  if (w == 0) {
    int lo = lane; asm volatile("" : "+v"(lo));
    const int g = lo >> 4, j = lo & 15;
    unsigned lfb = DP_LF + (16 * g * 68 + 16 * g) * 4; asm volatile("" : "+v"(lfb));
    const LAS float* Lg = (const LAS float*)(lds + lfb);
    float t[16];
#pragma unroll
    for (int r = 0; r < 16; ++r) {
      float a0 = (r == j) ? 1.f : 0.f, a1 = 0.f;
#pragma unroll
      for (int k4 = 0; k4 < (r + 3) / 4; ++k4) {
        const f32x4 l = *(const LAS f32x4*)(Lg + r * 68 + 4 * k4);
        if (4 * k4 + 0 < r) a0 -= l[0] * t[4 * k4 + 0];
        if (4 * k4 + 1 < r) a1 -= l[1] * t[4 * k4 + 1];
        if (4 * k4 + 2 < r) a0 -= l[2] * t[4 * k4 + 2];
        if (4 * k4 + 3 < r) a1 -= l[3] * t[4 * k4 + 3];
      }
      t[r] = a0 + a1;
      Tr[(16 * g + r) * 72 + 16 * g + j] = f2bf_hw(t[r]);
    }
    u32x4 w0, w1;
    w0.x = pk2(t[0], t[1]); w0.y = pk2(t[2], t[3]); w0.z = pk2(t[4], t[5]); w0.w = pk2(t[6], t[7]);
    w1.x = pk2(t[8], t[9]); w1.y = pk2(t[10], t[11]); w1.z = pk2(t[12], t[13]); w1.w = pk2(t[14], t[15]);
    *(LAS u32x4*)(Tt + (16 * g + j) * 72 + 16 * g) = w0; *(LAS u32x4*)(Tt + (16 * g + j) * 72 + 16 * g + 8) = w1;
  }
  __syncthreads();
#pragma unroll 1
  for (int d = 1; d <= 3; ++d) {
    const bool act = w < 4 - d;
    const int I = w + d, J = w;
    LAS bf16_t* Mw = Mt + w * 16 * 24;
    if (act) {
      f32x4 macc = {0.f, 0.f, 0.f, 0.f};
      macc = prod16<2>(Lb, 72, 16 * I, Tt, 72, 16 * J, macc, lane);
      tile_store_tr(Mw, 24, 0, 0, macc, lane);
    }
    __syncthreads();
    if (act) {
      bf16x8 a = {0, 0, 0, 0, 0, 0, 0, 0}, bb = {0, 0, 0, 0, 0, 0, 0, 0};
      if (q4 < 2) { a = *(const LAS bf16x8*)(Tr + (16 * I + r16) * 72 + 16 * I + 8 * q4); bb = *(const LAS bf16x8*)(Mw + r16 * 24 + 8 * q4); }
      f32x4 tacc = {0.f, 0.f, 0.f, 0.f};
      tacc = MFMA16(a, bb, tacc);
#pragma unroll
      for (int i = 0; i < 4; ++i) tacc[i] = -tacc[i];
      tile_store_rm(Tr, 72, 16 * I, 16 * J, tacc, lane);
      tile_store_tr(Tt, 72, 16 * I, 16 * J, tacc, lane);
    }
    __syncthreads();
  }
  {
    const int cc = tid >> 3, m0 = (tid & 7) * 8;
    float tv[8]; unpack8(*(const LAS u32x4*)(Tr + cc * 72 + m0), tv);
    float tu[8], tw[8];
#pragma unroll
    for (int jj = 0; jj < 8; ++jj) { const float bm = betab[m0 + jj]; tu[jj] = tv[jj] * bm; tw[jj] = tu[jj] * __expf(gcb[m0 + jj]); }
    u32x4 wu, ww;
    wu.x = pk2(tu[0], tu[1]); wu.y = pk2(tu[2], tu[3]); wu.z = pk2(tu[4], tu[5]); wu.w = pk2(tu[6], tu[7]);
    ww.x = pk2(tw[0], tw[1]); ww.y = pk2(tw[2], tw[3]); ww.z = pk2(tw[4], tw[5]); ww.w = pk2(tw[6], tw[7]);
    *(LAS u32x4*)(Tu + cc * 72 + m0) = wu; *(LAS u32x4*)(Tw + cc * 72 + m0) = ww;
  }
  __syncthreads();
#pragma unroll
  for (int rr = 0; rr < 4; ++rr) {
    f32x4 u = {0.f, 0.f, 0.f, 0.f};
    u = prod16<2>(Tu, 72, 16 * rr, VT, 72, 16 * w, u, lane);
    *(f32x4*)(gU + ((w * 4 + rr) * 64 + lane) * 4) = u;
    f32x4 wt = {0.f, 0.f, 0.f, 0.f};
    wt = prod16<2>(KhT, 72, 16 * w, Tw, 72, 16 * rr, wt, lane);
    u32x2 wv; wv.x = pk2(-wt[0], -wt[1]); wv.y = pk2(-wt[2], -wt[3]);
    *(u32x2*)(gA + (size_t)(F_WN + rr * 4 + (w >> 1)) * 1024 + (r16 + 16 * q4) * 16 + (w & 1) * 8) = wv;
  }
#pragma unroll
  for (int it = 0; it < 4; ++it) {
    const int idx = tid + it * 512; const int d = idx >> 4, m4 = idx & 15;
    const u32x2 raw = *(const LAS u32x2*)(KhT + d * 72 + 4 * m4);
    const float k0 = __uint_as_float(raw.x << 16), k1 = __uint_as_float(raw.x & 0xffff0000u), k2 = __uint_as_float(raw.y << 16), k3 = __uint_as_float(raw.y & 0xffff0000u);
    const float e0 = __expf(gl - gcb[4 * m4]), e1 = __expf(gl - gcb[4 * m4 + 1]), e2 = __expf(gl - gcb[4 * m4 + 2]), e3 = __expf(gl - gcb[4 * m4 + 3]);
    u32x2 wv; wv.x = pk2(k0 * e0, k1 * e1); wv.y = pk2(k2 * e2, k3 * e3);
    *(u32x2*)(gA + (size_t)(F_KT + (d >> 4) * 2 + (m4 >> 3)) * 1024 + ((d & 15) + 16 * (m4 & 3)) * 16 + ((m4 >> 2) & 1) * 8) = wv;
  }
  if (tid == 0) p.dnG[ci] = __expf(gl);
}

#define DS_A0 0
#define DS_A1 57344
#define DS_TOTAL 114688
__device__ void dn_scan_blk(const Params& p, LAS unsigned char* lds, int item) {
  const int tid = p.tid, lane = tid & 63, w = __builtin_amdgcn_readfirstlane(tid >> 6), r16 = lane & 15, q4 = lane >> 4;
  const int bh = item >> 1, eh = item & 1, b = bh >> 2, h = bh & 3;
  const int et = eh * 4 + (w & 3);
  const bool comp = w < 4;
  const unsigned char* gA = (const unsigned char*)p.dnA + (size_t)bh * 64 * DN_ABYTES;
  const float* gU = p.dnU + (size_t)bh * 64 * DN_UFLOATS;
  const float* gG = p.dnG + bh * 64;
  auto issue_A = [&](int n, int buf) {
#pragma unroll
    for (int i = 0; i < 7; ++i) {
      const int f = w * 7 + i;
      __builtin_amdgcn_global_load_lds((const unsigned*)(gA + (size_t)n * DN_ABYTES + f * 1024 + lane * 16), (LAS unsigned*)(lds + (buf ? DS_A1 : DS_A0) + f * 1024), 16, 0, 0);
    }
  };
  __syncthreads();
  issue_A(0, 0);
  f32x4 Un[4];
#pragma unroll
  for (int rr = 0; rr < 4; ++rr) Un[rr] = *(const f32x4*)(gU + ((et * 4 + rr) * 64 + lane) * 4);
  f32x4 S[8];
#pragma unroll
  for (int dt = 0; dt < 8; ++dt) S[dt] = (f32x4){0.f, 0.f, 0.f, 0.f};
  asm volatile("s_waitcnt vmcnt(0)" ::: "memory");
  __syncthreads();
  bf16_t* obase = p.dn_out + ((size_t)b * SEQ) * p.dn_out_ld + h * 128 + 16 * et + r16;
  f32x4 Op[4];
#pragma unroll
  for (int rr = 0; rr < 4; ++rr) Op[rr] = (f32x4){0.f, 0.f, 0.f, 0.f};
  float gnext = gG[0];
#pragma unroll 1
  for (int n = 0; n < 64; ++n) {
    const LAS unsigned char* Ab = lds + ((n & 1) ? DS_A1 : DS_A0);
    if (n + 1 < 64) issue_A(n + 1, (n + 1) & 1);
    if (comp) {
      if (n > 0) {
#pragma unroll
        for (int rr = 0; rr < 4; ++rr)
#pragma unroll
          for (int i = 0; i < 4; ++i) obase[(size_t)((n - 1) * 64 + 16 * rr + 4 * q4 + i) * p.dn_out_ld] = f2bf_hw(Op[rr][i]);
      }
      f32x4 Vn[4];
#pragma unroll
      for (int rr = 0; rr < 4; ++rr) Vn[rr] = Un[rr];
      if (n + 1 < 64) {
#pragma unroll
        for (int rr = 0; rr < 4; ++rr) Un[rr] = *(const f32x4*)(gU + (size_t)(n + 1) * DN_UFLOATS + ((et * 4 + rr) * 64 + lane) * 4);
      }
      const float gdec = gnext;
      if (n + 1 < 64) gnext = gG[n + 1];
      bf16x8 Sb[4];
#pragma unroll
      for (int ks = 0; ks < 4; ++ks) Sb[ks] = pack8(S[2 * ks][0], S[2 * ks][1], S[2 * ks][2], S[2 * ks][3], S[2 * ks + 1][0], S[2 * ks + 1][1], S[2 * ks + 1][2], S[2 * ks + 1][3]);
#pragma unroll
      for (int dt = 0; dt < 8; ++dt) S[dt] *= gdec;
#define LDF(idx) (*(const LAS bf16x8*)(Ab + (idx) * 1024 + lane * 16))
#define SBAR __builtin_amdgcn_sched_barrier(0)
      bf16x8 fa[8], fb[8];
      f32x4 O[4];
#pragma unroll
      for (int rr = 0; rr < 4; ++rr) O[rr] = (f32x4){0.f, 0.f, 0.f, 0.f};
#pragma unroll
      for (int i = 0; i < 4; ++i) { fa[i] = LDF(F_WN + i); fa[4 + i] = LDF(F_QD + i); }
      SBAR;
#pragma unroll
      for (int i = 0; i < 4; ++i) { fb[i] = LDF(F_WN + 4 + i); fb[4 + i] = LDF(F_QD + 4 + i); }
      SBAR;
#pragma unroll
      for (int ks = 0; ks < 4; ++ks) { Vn[0] = MFMA16(fa[ks], Sb[ks], Vn[0]); O[0] = MFMA16(fa[4 + ks], Sb[ks], O[0]); }
      SBAR;
#pragma unroll
      for (int i = 0; i < 4; ++i) { fa[i] = LDF(F_WN + 8 + i); fa[4 + i] = LDF(F_QD + 8 + i); }
      SBAR;
#pragma unroll
      for (int ks = 0; ks < 4; ++ks) { Vn[1] = MFMA16(fb[ks], Sb[ks], Vn[1]); O[1] = MFMA16(fb[4 + ks], Sb[ks], O[1]); }
      SBAR;
#pragma unroll
      for (int i = 0; i < 4; ++i) { fb[i] = LDF(F_WN + 12 + i); fb[4 + i] = LDF(F_QD + 12 + i); }
      SBAR;
#pragma unroll
      for (int ks = 0; ks < 4; ++ks) { Vn[2] = MFMA16(fa[ks], Sb[ks], Vn[2]); O[2] = MFMA16(fa[4 + ks], Sb[ks], O[2]); }
      SBAR;
#pragma unroll
      for (int i = 0; i < 8; ++i) fa[i] = LDF(F_QK + i);
      SBAR;
#pragma unroll
      for (int ks = 0; ks < 4; ++ks) { Vn[3] = MFMA16(fb[ks], Sb[ks], Vn[3]); O[3] = MFMA16(fb[4 + ks], Sb[ks], O[3]); }
      SBAR;
#pragma unroll
      for (int i = 0; i < 8; ++i) fb[i] = LDF(F_KT + i);
      SBAR;
      bf16x8 Vb[2];
#pragma unroll
      for (int ks = 0; ks < 2; ++ks) Vb[ks] = pack8(Vn[2 * ks][0], Vn[2 * ks][1], Vn[2 * ks][2], Vn[2 * ks][3], Vn[2 * ks + 1][0], Vn[2 * ks + 1][1], Vn[2 * ks + 1][2], Vn[2 * ks + 1][3]);
#pragma unroll
      for (int ks = 0; ks < 2; ++ks)
#pragma unroll
        for (int rr = 0; rr < 4; ++rr) O[rr] = MFMA16(fa[rr * 2 + ks], Vb[ks], O[rr]);
      SBAR;
#pragma unroll
      for (int i = 0; i < 8; ++i) fa[i] = LDF(F_KT + 8 + i);
      SBAR;
#pragma unroll
      for (int ks = 0; ks < 2; ++ks)
#pragma unroll
        for (int dt = 0; dt < 4; ++dt) S[dt] = MFMA16(fb[dt * 2 + ks], Vb[ks], S[dt]);
      SBAR;
#pragma unroll
      for (int ks = 0; ks < 2; ++ks)
#pragma unroll
        for (int dt = 0; dt < 4; ++dt) S[4 + dt] = MFMA16(fa[dt * 2 + ks], Vb[ks], S[4 + dt]);
#pragma unroll
      for (int rr = 0; rr < 4; ++rr) Op[rr] = O[rr];
#undef LDF
#undef SBAR
    }
    asm volatile("s_waitcnt vmcnt(0)" ::: "memory");
    __syncthreads();
  }
  if (comp) {
#pragma unroll
    for (int rr = 0; rr < 4; ++rr)
#pragma unroll
      for (int i = 0; i < 4; ++i) obase[(size_t)(63 * 64 + 16 * rr + 4 * q4 + i) * p.dn_out_ld] = f2bf_hw(Op[rr][i]);
  }
}
__device__ void ph_dn_norm(const Params& p, int nblk, int bid) {
  const int wid = p.tid >> 6, lane = p.tid & 63;
  const f32x4 g0 = *(const f32x4*)(p.g_dn_out + (lane & 15) * 8), g1 = *(const f32x4*)(p.g_dn_out + (lane & 15) * 8 + 4);
  for (int t = bid * 8 + wid; t < T_TOK; t += nblk * 8) {
    bf16_t* op = p.oab + (size_t)t * DM + lane * 8;
    float o[8], z[8];
    unpack8(*(const u32x4*)op, o);
    unpack8(*(const u32x4*)(p.proj + (size_t)t * PW + C_Z + lane * 8), z);
    float ss = 0.f;
#pragma unroll
    for (int j = 0; j < 8; ++j) ss += o[j] * o[j];
    ss += __shfl_xor(ss, 1, 64); ss += __shfl_xor(ss, 2, 64); ss += __shfl_xor(ss, 4, 64); ss += __shfl_xor(ss, 8, 64);
    const float rstd = rsqrtf(ss * (1.f / 128.f) + 1e-6f);
    float y[8];
#pragma unroll
    for (int j = 0; j < 4; ++j) { y[j] = o[j] * rstd * g0[j] * siluf_(z[j]); y[4 + j] = o[4 + j] * rstd * g1[j] * siluf_(z[4 + j]); }
    u32x4 w; w.x = pk2(y[0], y[1]); w.y = pk2(y[2], y[3]); w.z = pk2(y[4], y[5]); w.w = pk2(y[6], y[7]);
    *(u32x4*)op = w;
  }
}
typedef float f32x16 __attribute__((ext_vector_type(16)));
#define MFMA32(a, b, c) __builtin_amdgcn_mfma_f32_32x32x16_bf16((a), (b), (c), 0, 0, 0)
#define MP_VL 0
#define MP_RED 65536
#define MP_TOTAL (65536 + 4096)

__device__ void moba_prep_block(const Params& p, LAS unsigned char* lds, int item) {
  const int tid = p.tid, lane = tid & 63, w = tid >> 6;
  const int bh = item >> 4, jb = item & 15, b = bh >> 2, h = bh & 3;
  LAS bf16_t* Vl = (LAS bf16_t*)(lds + MP_VL);
  LAS float* red = (LAS float*)(lds + MP_RED);
  __syncthreads();
#pragma unroll
  for (int it = 0; it < 8; ++it) {
    const int idx = tid + 512 * it, row = idx >> 4, ch = idx & 15;
    const u32x4 v = *(const u32x4*)(p.proj + ((size_t)b * SEQ + 256 * jb + row) * PW + C_MV + h * 128 + 8 * ch);
    *(LAS u32x4*)(Vl + row * 128 + 8 * ch) = v;
  }
  {
    const int r = tid >> 1, hh = tid & 1;
    const int pos = 256 * jb + r;
    const size_t t = (size_t)b * SEQ + pos;
    float cs[8], sn[8];
#pragma unroll
    for (int jj = 0; jj < 8; ++jj) {
      const float inv = exp2f(-(float)(8 * hh + jj) * (1.f / 16.f) * 18.931568569324174f);
      const float ang = (float)pos * inv;
      cs[jj] = cosf(ang); sn[jj] = sinf(ang);
    }
    float kacc[64];
#pragma unroll
    for (int which = 0; which < 2; ++which) {
      const bf16_t* src = p.proj + t * PW + (which ? C_MQ : C_MK) + h * 128 + 8 * hh;
      float x0[8], x1[8];
      unpack8(*(const u32x4*)(src), x0); unpack8(*(const u32x4*)(src + 16), x1);
      float y0[8], y1[8];
#pragma unroll
      for (int jj = 0; jj < 8; ++jj) { y0[jj] = x0[jj] * cs[jj] - x1[jj] * sn[jj]; y1[jj] = x1[jj] * cs[jj] + x0[jj] * sn[jj]; }
      u32x4 o[8];
      o[0].x = pk2(y0[0], y0[1]); o[0].y = pk2(y0[2], y0[3]); o[0].z = pk2(y0[4], y0[5]); o[0].w = pk2(y0[6], y0[7]);
      o[1].x = pk2(y1[0], y1[1]); o[1].y = pk2(y1[2], y1[3]); o[1].z = pk2(y1[4], y1[5]); o[1].w = pk2(y1[6], y1[7]);
#pragma unroll
      for (int ks = 2; ks < 8; ++ks) o[ks] = *(const u32x4*)(src + 16 * ks);
      if (which == 0) {
#pragma unroll
        for (int jj = 0; jj < 8; ++jj) { kacc[jj] = y0[jj]; kacc[8 + jj] = y1[jj]; }
#pragma unroll
        for (int ks = 2; ks < 8; ++ks) { float f[8]; unpack8(o[ks], f);
#pragma unroll
          for (int jj = 0; jj < 8; ++jj) kacc[8 * ks + jj] = f[jj]; }
        unsigned char* dst = (unsigned char*)p.Kp + ((size_t)(bh * 128 + 8 * jb + (r >> 5)) * 8192) + ((r & 31) + 32 * hh) * 16;
#pragma unroll
        for (int ks = 0; ks < 8; ++ks) *(u32x4*)(dst + ks * 1024) = o[ks];
      } else {
        bf16_t* dst = p.qb + ((size_t)bh * SEQ + pos) * 128 + 8 * hh;
#pragma unroll
        for (int ks = 0; ks < 8; ++ks) *(u32x4*)(dst + 16 * ks) = o[ks];
      }
    }
#pragma unroll
    for (int e = 0; e < 64; ++e) {
      float v = kacc[e];
      v += __shfl_xor(v, 2, 64); v += __shfl_xor(v, 4, 64); v += __shfl_xor(v, 8, 64); v += __shfl_xor(v, 16, 64); v += __shfl_xor(v, 32, 64);
      kacc[e] = v;
    }
    if (lane < 2) {
#pragma unroll
      for (int e = 0; e < 64; ++e) red[(w * 2 + lane) * 64 + e] = kacc[e];
    }
  }
  __syncthreads();
  if (tid < 128) {
    const int d = tid, hh = (d >> 3) & 1, ks = d >> 4, jj = d & 7;
    float a = 0.f;
#pragma unroll
    for (int ww = 0; ww < 8; ++ww) a += red[(ww * 2 + hh) * 64 + ks * 8 + jj];
    p.kmean[((size_t)bh * 16 + jb) * 128 + d] = a * (1.f / 256.f);
  }
#pragma unroll
  for (int it = 0; it < 8; ++it) {
    const int o = tid + 512 * it, ln = o & 63, frag = o >> 6, tl = frag >> 3, dt = (frag >> 1) & 3, s = frag & 1;
    const int r = ln & 31, hh = ln >> 5, d = 32 * dt + r;
    unsigned short e[8];
#pragma unroll
    for (int jj = 0; jj < 8; ++jj) { const int key = 32 * tl + 16 * s + 8 * (jj >> 2) + 4 * hh + (jj & 3); e[jj] = Vl[key * 128 + d]; }
    u32x4 wv; wv.x = e[0] | ((unsigned)e[1] << 16); wv.y = e[2] | ((unsigned)e[3] << 16); wv.z = e[4] | ((unsigned)e[5] << 16); wv.w = e[6] | ((unsigned)e[7] << 16);
    *(u32x4*)((unsigned char*)p.Vp + ((size_t)(bh * 128 + 8 * jb + tl) * 8192) + (dt * 2 + s) * 1024 + ln * 16) = wv;
  }
}
__device__ __forceinline__ int crow32(int reg, int hh) { return (reg & 3) + 8 * (reg >> 2) + 4 * hh; }
__device__ void moba_item(const Params& p, LAS float* km, LAS float* mrg, LAS float* ml, int bh, int ib, int sub, int par, int lane, int rep) {
  const int q = lane & 31, hh = lane >> 5;
  const int b = bh >> 2, h = bh & 3;
  const int s0 = 256 * ib + 32 * sub;
  const bf16_t* qrow = p.qb + ((size_t)bh * SEQ + s0 + q) * 128 + 8 * hh;
  bf16x8 Qf[8];
#pragma unroll
  for (int ks = 0; ks < 8; ++ks) Qf[ks] = *(const bf16x8*)(qrow + 16 * ks);
  LAS unsigned char* qlds = (LAS unsigned char*)km + 8192 + lane * 16;
#pragma unroll
  for (int ks = 0; ks < 8; ++ks) *(LAS bf16x8*)(qlds + ks * 1024) = Qf[ks];
  unsigned selmask = 0;
  if (ib > 0) {
    for (int idx = lane; idx < ib * 32; idx += 64) ((LAS f32x4*)km)[idx] = ((const f32x4*)(p.kmean + (size_t)bh * 16 * 128))[idx];
    float qf[64];
#pragma unroll
    for (int ks = 0; ks < 8; ++ks) { float f[8]; unpack8(__builtin_bit_cast(u32x4, Qf[ks]), f);
#pragma unroll
      for (int jj = 0; jj < 8; ++jj) qf[8 * ks + jj] = f[jj]; }
    float sc[16];
#pragma unroll
    for (int j = 0; j < 16; ++j) {
      sc[j] = -INFINITY;
      if (j < ib) {
        float a = 0.f;
#pragma unroll
        for (int ks = 0; ks < 8; ++ks) {
          const f32x4 k0 = *(const LAS f32x4*)(km + j * 128 + 16 * ks + 8 * hh), k1 = *(const LAS f32x4*)(km + j * 128 + 16 * ks + 8 * hh + 4);
          a += qf[8 * ks] * k0[0] + qf[8 * ks + 1] * k0[1] + qf[8 * ks + 2] * k0[2] + qf[8 * ks + 3] * k0[3];
          a += qf[8 * ks + 4] * k1[0] + qf[8 * ks + 5] * k1[1] + qf[8 * ks + 6] * k1[2] + qf[8 * ks + 7] * k1[3];
        }
        a += __shfl_xor(a, 32, 64);
        sc[j] = a;
      }
    }
#pragma unroll
    for (int r = 0; r < 3; ++r) {
      if (r < ib) {
        float best = -INFINITY; int bi = 0;
#pragma unroll
        for (int j = 0; j < 16; ++j) if (sc[j] > best) { best = sc[j]; bi = j; }
        selmask |= 1u << bi;
#pragma unroll
        for (int j = 0; j < 16; ++j) if (j == bi) sc[j] = -INFINITY;
      }
    }
  }
  unsigned rem = 0;
  for (int j = 0; j < ib; ++j) if (__ballot((selmask >> j) & 1u) != 0ull) rem |= 1u << j;
  rem = __builtin_amdgcn_readfirstlane(rem);
  const int own0 = 8 * ib, diag = 8 * ib + sub;
  const float cscale = 0.08838834764831845f * 1.4426950408889634f;
  float m = -1e30f, l = 0.f;
  f32x16 O[4];
#pragma unroll
  for (int dt = 0; dt < 4; ++dt)
#pragma unroll
    for (int r = 0; r < 16; ++r) O[dt][r] = 0.f;
  const unsigned char* kbase = (const unsigned char*)p.Kp + (size_t)bh * 128 * 8192 + lane * 16;
  const unsigned char* vbase = (const unsigned char*)p.Vp + (size_t)bh * 128 * 8192 + lane * 16;
  auto adv = [&](int& kt_, unsigned& rem_) {
    if (kt_ < 0) return;
    if (kt_ >= own0 ? (kt_ < diag) : ((kt_ & 7) != 7)) { kt_ = kt_ + 1; return; }
    if (rem_ == 0u) { kt_ = -1; return; }
    kt_ = 8 * (__builtin_ctz(rem_)); rem_ &= rem_ - 1u;
  };
  int kt = own0;
  if (par) adv(kt, rem);
  auto load_k = [&](int t, bf16x8 (&K_)[8]) {
#pragma unroll
    for (int ks = 0; ks < 8; ++ks) K_[ks] = *(const bf16x8*)(kbase + (size_t)t * 8192 + ks * 1024);
  };
  auto tile_step = [&](bf16x8 (&Kc)[8], bf16x8 (&Kn)[8]) -> bool {
    int ktn = kt; unsigned remn = rem;
    adv(ktn, remn); adv(ktn, remn);
    bf16x8 Vf[8];
#pragma unroll
    for (int f = 0; f < 8; ++f) Vf[f] = *(const bf16x8*)(vbase + (size_t)kt * 8192 + f * 1024);
    if (ktn >= 0) load_k(ktn, Kn);
    f32x16 S;
#pragma unroll
    for (int r = 0; r < 16; ++r) S[r] = 0.f;
#pragma unroll
    for (int ks = 0; ks < 8; ++ks) S = MFMA32(Kc[ks], *(const LAS bf16x8*)(qlds + ks * 1024), S);
    const bool allowed = (kt >= own0) || ((selmask >> (kt >> 3)) & 1u);
    const float nb = allowed ? 0.f : -INFINITY;
    float sv[16]; float mx = -INFINITY;
#pragma unroll
    for (int r = 0; r < 16; ++r) sv[r] = __builtin_fmaf(S[r], cscale, nb);
    if (kt == diag) {
#pragma unroll
      for (int r = 0; r < 16; ++r) if (crow32(r, hh) > q) sv[r] = -INFINITY;
    }
#pragma unroll
    for (int r = 0; r < 16; ++r) mx = fmaxf(mx, sv[r]);
    mx = fmaxf(mx, __shfl_xor(mx, 32, 64));
    const bool grow = mx > m + 8.f;
    const float mn = (__ballot(grow) != 0ull) ? fmaxf(m, mx) : m;
    const float alpha = __builtin_amdgcn_exp2f(m - mn);
    float ps = 0.f;
#pragma unroll
    for (int r = 0; r < 16; ++r) { sv[r] = __builtin_amdgcn_exp2f(sv[r] - mn); ps += sv[r]; }
    l = l * alpha + ps; m = mn;
    if (__ballot(alpha != 1.f) != 0ull) {
#pragma unroll
      for (int dt = 0; dt < 4; ++dt)
#pragma unroll
        for (int r = 0; r < 16; ++r) O[dt][r] *= alpha;
    }
    const bf16x8 P0 = pack8(sv[0], sv[1], sv[2], sv[3], sv[4], sv[5], sv[6], sv[7]);
    const bf16x8 P1 = pack8(sv[8], sv[9], sv[10], sv[11], sv[12], sv[13], sv[14], sv[15]);
#pragma unroll
    for (int dt = 0; dt < 4; ++dt) { O[dt] = MFMA32(Vf[dt * 2], P0, O[dt]); O[dt] = MFMA32(Vf[dt * 2 + 1], P1, O[dt]); }
    kt = ktn; rem = remn;
    return kt >= 0;
  };
  if (kt >= 0) {
    bf16x8 KA[8], KB[8];
    load_k(kt, KA);
#pragma unroll 1
    for (;;) {
      if (!tile_step(KA, KB)) break;
      asm volatile("" ::: "memory");
      if (!tile_step(KB, KA)) break;
      asm volatile("" ::: "memory");
    }
  }
  asm volatile("s_waitcnt vmcnt(0) lgkmcnt(0)" ::: "memory");
  if (par) {
    ml[lane] = m; ml[64 + lane] = l;
#pragma unroll
    for (int dt = 0; dt < 4; ++dt)
#pragma unroll
      for (int r = 0; r < 16; ++r) mrg[(dt * 16 + r) * 64 + lane] = O[dt][r];
  }
  __syncthreads();
  if (par == 0) {
    const float m2 = ml[lane], l2 = ml[64 + lane];
    const float mm = fmaxf(m, m2);
    const float a1 = __builtin_amdgcn_exp2f(m - mm), a2 = __builtin_amdgcn_exp2f(m2 - mm);
    l = l * a1 + l2 * a2;
#pragma unroll
    for (int dt = 0; dt < 4; ++dt)
#pragma unroll
      for (int r = 0; r < 16; ++r) O[dt][r] = O[dt][r] * a1 + mrg[(dt * 16 + r) * 64 + lane] * a2;
  }
  if (par == 0) {
  l += __shfl_xor(l, 32, 64);
  const float inv = 1.f / l;
  bf16_t* orow = rep ? p.oab2 + ((size_t)b * SEQ + s0 + q) * 512 + h * 128 : p.mb_out + ((size_t)b * SEQ + s0 + q) * p.mb_out_ld + p.mb_out_off + h * 128;
#pragma unroll
  for (int dt = 0; dt < 4; ++dt)
#pragma unroll
    for (int g4 = 0; g4 < 4; ++g4) {
      u32x2 wv; wv.x = pk2(O[dt][4 * g4] * inv, O[dt][4 * g4 + 1] * inv); wv.y = pk2(O[dt][4 * g4 + 2] * inv, O[dt][4 * g4 + 3] * inv);
      *(u32x2*)(orow + 32 * dt + 8 * g4 + 4 * hh) = wv;
    }
  }
  __syncthreads();
}
__device__ void moba_worker(const Params& p, LAS unsigned char* lds, int qi) {
  const int lane = p.tid & 63, w = __builtin_amdgcn_readfirstlane(p.tid >> 6);
  LAS float* km = (LAS float*)(lds + w * 16384);
  LAS float* mrg = (LAS float*)(lds + ((w & 3) + 4) * 16384);
  LAS float* ml = (LAS float*)(lds + 131072) + (w & 3) * 128;
  LAS int* slot = (LAS int*)(lds + 131072 + 2048);
  const int g0 = (int)((unsigned)__builtin_amdgcn_s_getreg((3 << 11) | 20) & 7u);
  for (int gi = 0; gi < 8; ++gi) {
    const int g = (g0 + gi) & 7;
    for (;;) {
      __syncthreads();
      if (p.tid == 0) slot[0] = atomicAdd(p.wq + qi * 8 + g, 1);
      __syncthreads();
      const int idx = slot[0];
      if (idx >= 64) break;
      const int bh = 2 * g + (idx >> 5), ib = 15 - ((idx >> 1) & 15), quad = 1 - (idx & 1);
      moba_item(p, km, mrg, ml, bh, ib, 4 * quad + (w & 3), w >> 2, lane, qi);
    }
  }
}
__device__ void ph_mod(const Params& p, LAS unsigned char* lds, int nblk, int bid) {
  LAS float* sc = (LAS float*)lds;
  LAS float* part = (LAS float*)(lds + 16384);
  const int tid = p.tid;
  if (bid >= 192) return;
  for (int i = tid; i < 4096; i += 512) sc[i] = siluf_(p.c[i]);
  __syncthreads();
  for (int task = bid; task < 192; task += nblk) {
    const int jj = tid & 31, ks = tid >> 5, j = task * 32 + jj;
    float a0 = 0.f, a1 = 0.f, a2 = 0.f, a3 = 0.f;
#pragma unroll 8
    for (int kk = 0; kk < 64; ++kk) {
      const int k = ks * 64 + kk;
      const float w = p.w_ada[(size_t)k * 6144 + j];
      a0 += sc[k] * w; a1 += sc[1024 + k] * w; a2 += sc[2048 + k] * w; a3 += sc[3072 + k] * w;
    }
    *(LAS f32x4*)(part + (ks * 32 + jj) * 4) = (f32x4){a0, a1, a2, a3};
    __syncthreads();
    if (tid < 128) {
      const int j2 = tid & 31, bb = tid >> 5;
      float a = 0.f;
#pragma unroll
      for (int s = 0; s < 16; ++s) a += part[(s * 32 + j2) * 4 + bb];
      p.mod[bb * 6144 + task * 32 + j2] = a + p.b_ada[task * 32 + j2];
    }
    __syncthreads();
  }
}

#define WT_T0 1424
#define WT_T1 (WT_T0 + 16384)
#define WT_T2 (WT_T1 + 8192)
#define WT_T3 (WT_T2 + 128)
#define WT_T4 (WT_T3 + 128)
#define WT_T5 (WT_T4 + 256)
struct WtTile { const float* src; bf16_t* dst; int K, N, mode, k0, n0; unsigned char* dst8; };
__device__ __forceinline__ WtTile wt_desc(const Params& p, int t) {
  WtTile d;
  if (t < WT_T0) { const int kt = t / 89, nt = t % 89; d = {p.w_in, p.w_in_t, 1024, INW, 1, kt * 64, nt * 64, nullptr}; }
  else if (t < WT_T1) { const int u = t - WT_T0, e = u >> 9, r = u & 511, kt = r >> 5, nt = r & 31; d = {p.w_gu + (size_t)e * 1024 * 2048, nullptr, 1024, 2048, 2, kt * 64, nt * 64, p.wgu8 + (size_t)e * 2048 * 1024}; }
  else if (t < WT_T2) { const int u = t - WT_T1, e = u >> 8, r = u & 255, kt = r >> 4, nt = r & 15; d = {p.w_down + (size_t)e * 1024 * 1024, nullptr, 1024, 1024, 0, kt * 64, nt * 64, p.wd8 + (size_t)e * 1024 * 1024}; }
  else if (t < WT_T3) { const int u = t - WT_T2, kt = u >> 4, nt = u & 15; d = {p.w_br_a, p.wbra_t, 512, 1024, 0, kt * 64, nt * 64, nullptr}; }
  else if (t < WT_T4) { const int u = t - WT_T3, kt = u >> 4, nt = u & 15; d = {p.w_br_b, p.wbrb_t, 512, 1024, 0, kt * 64, nt * 64, nullptr}; }
  else { const int u = t - WT_T4, kt = u >> 4, nt = u & 15; d = {p.w_o, p.wo_t, 1024, 1024, 0, kt * 64, nt * 64, nullptr}; }
  return d;
}
__device__ __forceinline__ void wt_load(const WtTile& d, int tid, f32x4 (&v)[2]) {
#pragma unroll
  for (int it = 0; it < 2; ++it) {
    const int row = (tid >> 4) + 32 * it, n = d.n0 + (tid & 15) * 4;
    v[it] = (f32x4){0.f, 0.f, 0.f, 0.f};
    if (n < d.N) v[it] = __builtin_nontemporal_load((const f32x4*)(d.src + (size_t)(d.k0 + row) * d.N + n));
  }
}
__device__ void ph_wt(const Params& p, LAS unsigned char* lds, int nblk, int bid) {
  LAS float* tile = (LAS float*)(lds + 32768);
  const int tid = p.tid;
  int t = bid;
  if (t >= WT_T5) return;
  WtTile cur = wt_desc(p, t);
  f32x4 v[2]; wt_load(cur, tid, v);
  WtTile nxt = cur; f32x4 vn[2] = {v[0], v[1]};
  if (t + nblk < WT_T5) { nxt = wt_desc(p, t + nblk); wt_load(nxt, tid, vn); }
  for (;;) {
    const int tnn = t + 2 * nblk;
    WtTile nn = nxt; f32x4 vnn[2] = {vn[0], vn[1]};
    if (tnn < WT_T5) { nn = wt_desc(p, tnn); wt_load(nn, tid, vnn); }
#pragma unroll
    for (int it = 0; it < 2; ++it) {
      const int row = (tid >> 4) + 32 * it, c4 = (tid & 15) * 4;
      tile[row * 65 + c4] = v[it][0]; tile[row * 65 + c4 + 1] = v[it][1]; tile[row * 65 + c4 + 2] = v[it][2]; tile[row * 65 + c4 + 3] = v[it][3];
    }
    __syncthreads();
    {
      const int nl = tid >> 3, kc = tid & 7, n = cur.n0 + nl;
      if (n < cur.N) {
        const int dd = map_col(n, cur.mode);
        if (dd >= 0) {
          float f[8];
#pragma unroll
          for (int j = 0; j < 8; ++j) f[j] = tile[(8 * kc + j) * 65 + nl];
          if (cur.dst8) {
            u32x2 w; w.x = pk4_fp8(f[0] * 64.f, f[1] * 64.f, f[2] * 64.f, f[3] * 64.f); w.y = pk4_fp8(f[4] * 64.f, f[5] * 64.f, f[6] * 64.f, f[7] * 64.f);
            *(u32x2*)(cur.dst8 + (size_t)dd * cur.K + cur.k0 + 8 * kc) = w;
          } else {
            u32x4 w; w.x = pk2(f[0], f[1]); w.y = pk2(f[2], f[3]); w.z = pk2(f[4], f[5]); w.w = pk2(f[6], f[7]);
            *(u32x4*)(cur.dst + (size_t)dd * cur.K + cur.k0 + 8 * kc) = w;
          }
        }
      }
    }
    __syncthreads();
    if (t + nblk >= WT_T5) break;
    t += nblk; cur = nxt; v[0] = vn[0]; v[1] = vn[1]; nxt = nn; vn[0] = vnn[0]; vn[1] = vnn[1];
  }
}

__device__ void ph_h(const Params& p, LAS unsigned char* lds, int nblk, int bid) {
  const int wid = p.tid >> 6, lane = p.tid & 63;
  LAS float* wb = (LAS float*)lds;
  for (int i = p.tid; i < 2048; i += 512) {
    const int k = i >> 1, hf = i & 1;
    const f32x4 v = *(const f32x4*)(p.w_in + (size_t)k * INW + 2048 + 4 * hf);
    wb[(4 * hf + 0) * 1024 + k] = v[0]; wb[(4 * hf + 1) * 1024 + k] = v[1]; wb[(4 * hf + 2) * 1024 + k] = v[2]; wb[(4 * hf + 3) * 1024 + k] = v[3];
  }
  __syncthreads();
  for (int t = bid * 8 + wid; t < T_TOK; t += nblk * 8) {
    const int b = t / SEQ;
    const float* xr = p.x + (size_t)t * DM;
    f32x4 xv[4];
    float ss = 0.f;
#pragma unroll
    for (int i = 0; i < 4; ++i) {
      xv[i] = *(const f32x4*)(xr + i * 256 + lane * 4);
      ss += xv[i][0] * xv[i][0] + xv[i][1] * xv[i][1] + xv[i][2] * xv[i][2] + xv[i][3] * xv[i][3];
    }
    ss = wave_sum(ss);
    const float rstd = rsqrtf(ss * (1.f / DM) + 1e-6f);
    const float* shift = p.mod + b * 6144;
    const float* scale = p.mod + b * 6144 + 1024;
    float acc[8] = {0, 0, 0, 0, 0, 0, 0, 0};
#pragma unroll
    for (int i = 0; i < 4; ++i) {
      const int k = i * 256 + lane * 4;
      const f32x4 g = *(const f32x4*)(p.g_pre_mix + k), sc = *(const f32x4*)(scale + k), sh = *(const f32x4*)(shift + k);
      f32x4 hv;
#pragma unroll
      for (int j = 0; j < 4; ++j) hv[j] = xv[i][j] * rstd * g[j] * (1.f + sc[j]) + sh[j];
#pragma unroll
      for (int e = 0; e < 8; ++e) { const f32x4 w = *(const LAS f32x4*)(wb + e * 1024 + k); acc[e] += hv[0] * w[0] + hv[1] * w[1] + hv[2] * w[2] + hv[3] * w[3]; }
      u32x2 pk; pk.x = pk2(hv[0], hv[1]); pk.y = pk2(hv[2], hv[3]);
      *(u32x2*)(p.hbf + (size_t)t * DM + k) = pk;
    }
#pragma unroll
    for (int e = 0; e < 8; ++e) acc[e] = wave_sum(acc[e]);
    if (lane == 0) { *(f32x4*)(p.ba + (size_t)t * 8) = (f32x4){acc[0], acc[1], acc[2], acc[3]}; *(f32x4*)(p.ba + (size_t)t * 8 + 4) = (f32x4){acc[4], acc[5], acc[6], acc[7]}; }
  }
}

__device__ void ph_post_mix(const Params& p, LAS unsigned char* lds, int nblk, int bid, int rep) {
  const int wid = p.tid >> 6, lane = p.tid & 63;
  LAS bf16_t* wl = (LAS bf16_t*)lds;
  LAS float* sh = (LAS float*)(lds + 81920) + wid * 1024;
  LAS int* lcnt = (LAS int*)(lds + 114688);
  LAS int* lbase = lcnt + 32;
  LAS int* lent = (LAS int*)(lds + 115200) + wid * 256;
  int nloc = 0;
  if (p.tid < 32) lcnt[p.tid] = 0;
  for (int i = p.tid; i < 1024 * 8; i += 512) {
    const int k = i >> 3, c = i & 7;
    const f32x4 v = *(const f32x4*)(p.w_router + (size_t)k * 32 + c * 4);
    u32x2 w2; w2.x = pk2(v[0], v[1]); w2.y = pk2(v[2], v[3]);
    *(LAS u32x2*)(wl + k * 40 + c * 4) = w2;
  }
  __syncthreads();
  u32x4 mxn[2]; f32x4 xn[4];
  {
    const int t0 = bid * 8 + wid;
    if (t0 < T_TOK) {
#pragma unroll
      for (int i = 0; i < 2; ++i) mxn[i] = *(const u32x4*)(p.mixer + (size_t)t0 * DM + i * 512 + lane * 8);
#pragma unroll
      for (int i = 0; i < 4; ++i) xn[i] = *(const f32x4*)(p.x + (size_t)t0 * DM + (i >> 1) * 512 + lane * 8 + (i & 1) * 4);
    }
  }
  for (int t = bid * 8 + wid; t < T_TOK; t += nblk * 8) {
    const int b = t / SEQ;
    const float* md = p.mod + b * 6144;
    u32x4 mxc[2] = {mxn[0], mxn[1]}; f32x4 xc[4] = {xn[0], xn[1], xn[2], xn[3]};
    {
      const int tn = t + nblk * 8;
      if (tn < T_TOK) {
#pragma unroll
        for (int i = 0; i < 2; ++i) mxn[i] = *(const u32x4*)(p.mixer + (size_t)tn * DM + i * 512 + lane * 8);
#pragma unroll
        for (int i = 0; i < 4; ++i) xn[i] = *(const f32x4*)(p.x + (size_t)tn * DM + (i >> 1) * 512 + lane * 8 + (i & 1) * 4);
      }
    }
    float mv[16];
    float ss = 0.f;
#pragma unroll
    for (int i = 0; i < 2; ++i) {
      float f[8]; unpack8(mxc[i], f);
#pragma unroll
      for (int j = 0; j < 8; ++j) { mv[i * 8 + j] = f[j]; ss += f[j] * f[j]; }
    }
    ss = wave_sum(ss);
    const float rstd = rsqrtf(ss * (1.f / DM) + 1e-6f);
    float x1[16];
    float s2 = 0.f;
#pragma unroll
    for (int i = 0; i < 2; ++i)
#pragma unroll
      for (int j4 = 0; j4 < 2; ++j4) {
        const int k = i * 512 + lane * 8 + j4 * 4;
        const f32x4 xv = xc[i * 2 + j4];
        const f32x4 gm = *(const f32x4*)(md + 2048 + k), gp = *(const f32x4*)(p.g_post_mix + k);
        f32x4 o;
#pragma unroll
        for (int j = 0; j < 4; ++j) { o[j] = xv[j] + gm[j] * (mv[i * 8 + j4 * 4 + j] * rstd * gp[j]); x1[i * 8 + j4 * 4 + j] = o[j]; s2 += o[j] * o[j]; }
        *(f32x4*)(p.out + (size_t)t * DM + k) = o;
      }
    s2 = wave_sum(s2);
    const float rstd2 = rsqrtf(s2 * (1.f / DM) + 1e-6f);
#pragma unroll
    for (int i = 0; i < 2; ++i) {
      float hv[8];
#pragma unroll
      for (int j = 0; j < 8; ++j) {
        const int k = i * 512 + lane * 8 + j;
        hv[j] = x1[i * 8 + j] * rstd2 * p.g_pre_ffn[k] * (1.f + md[4096 + k]) + md[3072 + k];
        sh[k] = hv[j];
      }
      u32x2 w; w.x = pk4_fp8(hv[0], hv[1], hv[2], hv[3]); w.y = pk4_fp8(hv[4], hv[5], hv[6], hv[7]);
      *(u32x2*)(p.h2q + (size_t)t * DM + i * 512 + lane * 8) = w;
    }
#ifdef PM_SKIP
    if (rep) continue;
#endif
    float acc[32];
#pragma unroll
    for (int e2 = 0; e2 < 32; ++e2) acc[e2] = 0.f;
#pragma unroll 4
    for (int i = 0; i < 16; ++i) {
      const float hk = sh[lane + 64 * i];
      const LAS u32x4* wr = (const LAS u32x4*)(wl + (lane + 64 * i) * 40);
#pragma unroll
      for (int c4 = 0; c4 < 4; ++c4) {
        float f[8]; unpack8(wr[c4], f);
#pragma unroll
        for (int j = 0; j < 8; ++j) acc[c4 * 8 + j] += hk * f[j];
      }
    }
    {
      const bool u5 = lane & 32, u4 = lane & 16, u3 = lane & 8, u2 = lane & 4, u1 = lane & 2;
      float a16[16], a8[8], a4[4], a2[2];
#pragma unroll
      for (int j = 0; j < 16; ++j) { const float snd = u5 ? acc[j] : acc[16 + j]; const float rcv = __shfl_xor(snd, 32, 64); a16[j] = (u5 ? acc[16 + j] : acc[j]) + rcv; }
#pragma unroll
      for (int j = 0; j < 8; ++j) { const float snd = u4 ? a16[j] : a16[8 + j]; const float rcv = __shfl_xor(snd, 16, 64); a8[j] = (u4 ? a16[8 + j] : a16[j]) + rcv; }
#pragma unroll
      for (int j = 0; j < 4; ++j) { const float snd = u3 ? a8[j] : a8[4 + j]; const float rcv = __shfl_xor(snd, 8, 64); a4[j] = (u3 ? a8[4 + j] : a8[j]) + rcv; }
#pragma unroll
      for (int j = 0; j < 2; ++j) { const float snd = u2 ? a4[j] : a4[2 + j]; const float rcv = __shfl_xor(snd, 4, 64); a2[j] = (u2 ? a4[2 + j] : a4[j]) + rcv; }
      const float snd = u1 ? a2[0] : a2[1]; const float rcv = __shfl_xor(snd, 2, 64);
      float a1 = (u1 ? a2[1] : a2[0]) + rcv;
      a1 += __shfl_xor(a1, 1, 64);
      acc[0] = a1;
    }
    const int e = lane >> 1;
    float lg = acc[0] + p.b_router[e];
    if (lane & 1) lg = -INFINITY;
    float tv[4]; int ti[4];
#pragma unroll
    for (int r = 0; r < 4; ++r) {
      const float m = wave_max(lg);
      const unsigned long long bal = __ballot(lg == m);
      const int idx = __ffsll((long long)bal) - 1;
      tv[r] = m; ti[r] = idx >> 1;
      if (lane == idx) lg = -INFINITY;
    }
    const float e1 = __expf(tv[1] - tv[0]), e2 = __expf(tv[2] - tv[0]), e3 = __expf(tv[3] - tv[0]);
    const float inv = 1.f / (1.f + e1 + e2 + e3);
    if (lane < 4) {
      const int ee = lane == 0 ? ti[0] : lane == 1 ? ti[1] : lane == 2 ? ti[2] : ti[3];
      const float ww = (lane == 0 ? 1.f : lane == 1 ? e1 : lane == 2 ? e2 : e3) * inv;
      p.aw[t * 4 + lane] = ww;
      const int rank = __hip_atomic_fetch_add(&lcnt[ee], 1, __ATOMIC_RELAXED, __HIP_MEMORY_SCOPE_WORKGROUP);
      lent[nloc * 4 + lane] = (ee << 16) | rank;
      lent[nloc * 4 + lane + 2048] = t * 4 + lane;
    }
    ++nloc;
  }
  __syncthreads();
  if (p.tid < 32) lbase[p.tid] = atomicAdd(&p.cnt[p.tid * 64 + 32 * rep], lcnt[p.tid]);
  __syncthreads();
  for (int i = lane; i < nloc * 4; i += 64) {
    const int er = lent[i], a = lent[i + 2048];
    p.elist[(er >> 16) * T_TOK + lbase[er >> 16] + (er & 0xffff)] = a;
  }
}

__device__ void ph_gather(const Params& p, LAS unsigned char* lds, int nblk, int bid) {
  const int wid = p.tid >> 6, lane = p.tid & 63;
  LAS int* tb = (LAS int*)lds;
  if (p.tid == 0) { int off = 0; for (int k = 0; k < NE; ++k) { const int c = p.cnt[k * 64]; tb[k] = off; tb[64 + k] = c; off += ((c + 255) >> 8) << 8; } tb[NE] = off; }
  __syncthreads();
  const int total = tb[NE];
  for (int r = bid * 8 + wid; r < total; r += nblk * 8) {
    int e = 0;
#pragma unroll 1
    for (int k = 1; k < NE; ++k) if (r >= tb[k]) e = k;
    const int i = r - tb[e];
    const int a = (i < tb[64 + e]) ? p.elist[e * T_TOK + i] : -1;
    if (lane == 0) p.rowmap[r] = a;
    u32x4 v0 = {0, 0, 0, 0}, v1 = v0;
    if (a >= 0) { const u32x4* src = (const u32x4*)(p.h2 + (size_t)(a >> 2) * DM); v0 = src[lane]; v1 = src[64 + lane]; }
    u32x4* dst = (u32x4*)(p.xs + (size_t)r * DM);
    dst[lane] = v0; dst[64 + lane] = v1;
  }
}

__device__ void ph_final(const Params& p, int nblk, int bid, int rep) {
  const int wid = p.tid >> 6, lane = p.tid & 63;
  for (int t0 = bid * 8 + wid; t0 < T_TOK; t0 += nblk * 16) {
    int tt[2] = {t0, t0 + nblk * 8};
    if (tt[1] >= T_TOK) tt[1] = t0;
    float mv[2][16]; float ss[2];
#pragma unroll
    for (int u = 0; u < 2; ++u) {
      const int t = tt[u];
      const f32x4 wv = *(const f32x4*)(p.aw + t * 4);
      ss[u] = 0.f;
#pragma unroll
      for (int i = 0; i < 2; ++i) {
        const bf16_t* y = p.yslot + (size_t)t * 4 * DM + i * 512 + lane * 8;
        float f0[8], f1[8], f2[8], f3[8];
        unpack8(*(const u32x4*)y, f0); unpack8(*(const u32x4*)(y + DM), f1); unpack8(*(const u32x4*)(y + 2 * DM), f2); unpack8(*(const u32x4*)(y + 3 * DM), f3);
#pragma unroll
        for (int j = 0; j < 8; ++j) { const float m = wv[0] * f0[j] + wv[1] * f1[j] + wv[2] * f2[j] + wv[3] * f3[j]; mv[u][i * 8 + j] = m; ss[u] += m * m; }
      }
    }
    f32x4 x1[2][4];
#pragma unroll
    for (int u = 0; u < 2; ++u)
#pragma unroll
      for (int i = 0; i < 2; ++i)
#pragma unroll
        for (int j4 = 0; j4 < 2; ++j4) x1[u][i * 2 + j4] = *(const f32x4*)(p.out + (size_t)tt[u] * DM + i * 512 + lane * 8 + j4 * 4);
    ss[0] = wave_sum(ss[0]); ss[1] = wave_sum(ss[1]);
#pragma unroll
    for (int u = 0; u < 2; ++u) {
      const int t = tt[u];
      if (u == 1 && t == t0) break;
      const float* md = p.mod + (t / SEQ) * 6144;
      const float rstd = rsqrtf(ss[u] * (1.f / DM) + 1e-6f);
#pragma unroll
      for (int i = 0; i < 2; ++i)
#pragma unroll
        for (int j4 = 0; j4 < 2; ++j4) {
          const int k = i * 512 + lane * 8 + j4 * 4;
          float* op = p.out + (size_t)t * DM + k;
          const f32x4 gf = *(const f32x4*)(md + 5120 + k), gp = *(const f32x4*)(p.g_post_ffn + k);
          f32x4 o;
#pragma unroll
          for (int j = 0; j < 4; ++j) o[j] = x1[u][i * 2 + j4][j] + gf[j] * (mv[u][i * 8 + j4 * 4 + j] * rstd * gp[j]);
          *(f32x4*)(rep ? (float*)p.hbf + (size_t)(t & 8191) * DM + k : op) = o;
        }
    }
  }
}

#define XCD_BAR_WORDS 3456
struct KArgs { const void* in[22]; float* out; char* ws; long long never; };
__host__ __device__ inline size_t al(size_t x) { return (x + 255) & ~(size_t)255; }
__host__ __device__ inline void fill_params(Params& p, const KArgs& k) {
  p.x = (const float*)k.in[0]; p.c = (const float*)k.in[1]; p.w_ada = (const float*)k.in[2]; p.b_ada = (const float*)k.in[3];
  p.g_pre_mix = (const float*)k.in[4]; p.g_post_mix = (const float*)k.in[5]; p.g_pre_ffn = (const float*)k.in[6];
  p.g_post_ffn = (const float*)k.in[7]; p.w_in = (const float*)k.in[8]; p.conv_w = (const float*)k.in[9];
  p.a_log = (const float*)k.in[10]; p.dt_bias = (const float*)k.in[11]; p.g_dn_out = (const float*)k.in[12];
  p.w_br_a = (const float*)k.in[13]; p.w_br_b = (const float*)k.in[14]; p.w_o = (const float*)k.in[15];
  p.w_router = (const float*)k.in[16]; p.b_router = (const float*)k.in[17]; p.w_gu = (const float*)k.in[18];
  p.b_gu = (const float*)k.in[19]; p.w_down = (const float*)k.in[20]; p.b_down = (const float*)k.in[21];
  p.out = k.out;
  char* w = k.ws;
  size_t o = 0;
#define take(bytes) (w + (o += al(bytes)) - al(bytes))
  p.mod = (float*)take(4 * 6144 * 4);
  p.cnt = (int*)take(16384);
  p.ba = (float*)take((size_t)T_TOK * 8 * 4);
  p.hbf = (bf16_t*)take((size_t)T_TOK * DM * 2);
  p.proj = (bf16_t*)take((size_t)T_TOK * PW * 2);
  p.w_in_t = (bf16_t*)take((size_t)PW * DM * 2);
  p.wgu8 = (unsigned char*)take((size_t)NE * 2048 * DM);
  p.wd8 = (unsigned char*)take((size_t)NE * 1024 * DM);
  p.h2q = (unsigned char*)take((size_t)T_TOK * DM);
  p.act8 = (unsigned char*)take((size_t)73728 * DM);
  p.wbra_t = (bf16_t*)take((size_t)1024 * 512 * 2);
  p.wbrb_t = (bf16_t*)take((size_t)1024 * 512 * 2);
  p.wo_t = (bf16_t*)take((size_t)1024 * 1024 * 2);
  p.qb = (bf16_t*)take((size_t)T_TOK * 512 * 2);
  p.kb = (bf16_t*)take((size_t)T_TOK * 512 * 2);
  p.kmean = (float*)take((size_t)16 * 16 * 128 * 4);
  p.oab = (bf16_t*)take((size_t)T_TOK * DM * 2);
  p.merged = (bf16_t*)take((size_t)T_TOK * DM * 2);
  p.mixer = (bf16_t*)take((size_t)T_TOK * DM * 2);
  p.h2 = (bf16_t*)take((size_t)T_TOK * DM * 2);
  p.elist = (int*)take((size_t)NE * T_TOK * 4);
  p.aw = (float*)take((size_t)T_TOK * 4 * 4);
  p.rowmap = (int*)take((size_t)73728 * 4);
  p.dnA = (unsigned char*)take((size_t)1024 * DN_ABYTES);
  p.dnU = (float*)take((size_t)1024 * DN_UFLOATS * 4);
  p.dnG = (float*)take(4096);
  p.oab2 = (bf16_t*)take((size_t)T_TOK * 512 * 2);
  p.dbg = (float*)take(256);
  p.bar = (unsigned*)take(XCD_BAR_WORDS * 4);
  p.dn_out = p.oab; p.dn_out_ld = DM;
  p.Kp = (bf16_t*)take((size_t)16 * 128 * 8192);
  p.Vp = (bf16_t*)take((size_t)16 * 128 * 8192);
  p.wq = p.cnt + 32 * 64;
  p.mb_out = p.oab; p.mb_out_ld = DM; p.mb_out_off = 512;
  p.xs = p.proj;
  char* big = take((size_t)73728 * DM * 2 + (size_t)65536 * DM * 2);
  p.act = (bf16_t*)big;
  p.yslot = (bf16_t*)(big + (size_t)73728 * DM * 2);
  {
    char* s = big; size_t so = 0;
#define t2(bytes) (s + (so += al(bytes)) - al(bytes))
    p.nq = (float*)t2((size_t)T_TOK * 512 * 4);
    p.nk = (float*)t2((size_t)T_TOK * 512 * 4);
    p.nv = (float*)t2((size_t)T_TOK * 512 * 4);
    p.no = (float*)t2((size_t)T_TOK * 512 * 4);
    p.ntmp = (float*)t2((size_t)T_TOK * DM * 4);
    p.nbeta = (float*)t2((size_t)T_TOK * 4 * 4);
    p.ng = (float*)t2((size_t)T_TOK * 4 * 4);
  }

#undef take
#undef t2
  p.never = (int)k.never;
}

#define XB_TMO      128
#define XB_XCNT(j)  (256  + 64 * (j))
#define XB_XSUB(j)  (1280 + 64 * (j))
#define XB_XGEN(j)  (2304 + 64 * (j))
#define XB_TOP      3328
#define XB_TOPGEN   3392
#define XB_SPIN_CAP (1u << 18)

__device__ __forceinline__ unsigned xb_ld(unsigned* p)              { return __hip_atomic_load(p, __ATOMIC_RELAXED, __HIP_MEMORY_SCOPE_AGENT); }
__device__ __forceinline__ unsigned xb_add(unsigned* p, unsigned v) { return __hip_atomic_fetch_add(p, v, __ATOMIC_RELAXED, __HIP_MEMORY_SCOPE_AGENT); }
__device__ __forceinline__ unsigned xb_xcc_id() { return (unsigned)__builtin_amdgcn_s_getreg((3 << 11) | 20) & 0xFu; }
#define XB_SPIN(cond, bar) do { unsigned _sp = 0; while (cond) { __builtin_amdgcn_s_sleep(1); \
    if ((++_sp & 255u) == 0u) { if (xb_ld(&(bar)[XB_TMO])) break; if (_sp > XB_SPIN_CAP) { atomicAdd(&(bar)[XB_TMO], 1u); break; } } } } while (0)

struct XcdBarrier {
    unsigned* bar; unsigned x;
    volatile LAS unsigned* st;
};

__device__ __forceinline__ XcdBarrier xcd_barrier_post(unsigned* bar, volatile LAS unsigned* st) {
    XcdBarrier b; b.bar = bar; b.x = xb_xcc_id(); b.st = st;
    if (threadIdx.x == 0) (void)xb_add(&bar[XB_XCNT(b.x)], 1u);
    return b;
}
__device__ __forceinline__ void xcd_barrier_complete(unsigned* bar, unsigned x, unsigned& nloc, unsigned& nx) {
    const unsigned G = gridDim.x * gridDim.y * gridDim.z;
    unsigned sum, cnt, mine, sp = 0u;
    for (;;) {
        sum = 0u; cnt = 0u; mine = 0u;
#pragma unroll
        for (unsigned j = 0; j < 16; ++j) { const unsigned c = xb_ld(&bar[XB_XCNT(j)]); sum += c; cnt += (c > 0u) ? 1u : 0u; mine = (j == x) ? c : mine; }
        if (sum == G) break;
        __builtin_amdgcn_s_sleep(1);
        if ((++sp & 255u) == 0u) { if (xb_ld(&bar[XB_TMO])) break; if (sp > XB_SPIN_CAP) { atomicAdd(&bar[XB_TMO], 1u); break; } }
    }
    nloc = mine > 0u ? mine : 1u; nx = cnt > 0u ? cnt : 1u;
}

__device__ __forceinline__ void xcd_barrier(const XcdBarrier& b, const int tid) {
    asm volatile("s_waitcnt vmcnt(0)" ::: "memory");
    __syncthreads();
    if (tid == 0) {
        unsigned* bar = b.bar;
        __builtin_amdgcn_s_waitcnt(0);
        unsigned nloc = b.st[0], nx = b.st[1];
        if (nloc == 0u) { xcd_barrier_complete(bar, b.x, nloc, nx); b.st[0] = nloc; b.st[1] = nx; }
        const unsigned old = xb_add(&bar[XB_XSUB(b.x)], 1u);
        const unsigned gen = old / nloc;
        if (old + 1u == (gen + 1u) * nloc) {
            __builtin_amdgcn_fence(__ATOMIC_RELEASE, "agent");
            asm volatile("s_waitcnt vmcnt(0)" ::: "memory");
            const unsigned og = xb_add(&bar[XB_TOP], 1u);
            const unsigned tg = og / nx;
            if (og + 1u == (tg + 1u) * nx) xb_add(&bar[XB_TOPGEN], 1u);
            else XB_SPIN(xb_ld(&bar[XB_TOPGEN]) == tg, bar);
            __builtin_amdgcn_fence(__ATOMIC_ACQUIRE, "agent");
            xb_add(&bar[XB_XGEN(b.x)], 1u);
            asm volatile("s_waitcnt vmcnt(0)" ::: "memory");
        } else {
            XB_SPIN(xb_ld(&bar[XB_XGEN(b.x)]) == gen, bar);
            __builtin_amdgcn_fence(__ATOMIC_ACQUIRE, "agent");
            asm volatile("s_waitcnt vmcnt(0)" ::: "memory");
        }
    }
    __syncthreads();
}


__device__ __forceinline__ void load_ka(KArgs& kk) {
#if defined(__HIP_DEVICE_COMPILE__)
  typedef __attribute__((address_space(1))) char* gptr_t;
  typedef const __attribute__((address_space(4))) gptr_t* kptr_t;
  kptr_t kp = (kptr_t)__builtin_amdgcn_kernarg_segment_ptr();
  asm volatile("" : "+s"(kp));
#pragma unroll
  for (int i = 0; i < 22; ++i) kk.in[i] = (const void*)kp[i];
  kk.out = (float*)kp[22];
  kk.ws = (char*)kp[23];
  kk.never = ((const __attribute__((address_space(4))) long long*)kp)[24];
#endif
}
__device__ __forceinline__ void grid_bar(const Params& p, LAS unsigned char* lds);
#define MEGA_LDS 148480
#define MEGA_LDS_ALLOC (MEGA_LDS + 16)
__device__ __forceinline__ void grid_bar(const Params& p, LAS unsigned char* lds) {
  XcdBarrier b; b.bar = p.bar; b.x = xb_xcc_id(); b.st = (volatile LAS unsigned*)(lds + MEGA_LDS);
  xcd_barrier(b, p.tid);
}
__global__ __launch_bounds__(512) void mega(KArgs ka) {
  extern __shared__ __attribute__((aligned(16))) unsigned char shm[];
  LAS unsigned char* lds = (LAS unsigned char*)shm;
  cg::grid_group grid = cg::this_grid();
  const int nblk = gridDim.x, bid = blockIdx.x;
  const int wv_ = __builtin_amdgcn_readfirstlane(threadIdx.x >> 6);
  volatile LAS unsigned* xst = (volatile LAS unsigned*)(lds + MEGA_LDS);
  if (threadIdx.x == 0) { xst[0] = 0u; xst[1] = 0u; xst[2] = 0u; xst[3] = 0u; }
  __syncthreads();
  { Params p0; fill_params(p0, ka); (void)xcd_barrier_post(p0.bar, xst); }
  if (ka.never) grid.sync();
#ifndef REPMASK
#define REPMASK 0
#endif
#define LOADKA KArgs kk; load_ka(kk)
#ifndef PHMASK
#define PHMASK 0xffff
#endif
#define PHASE(k, body) if (((PHMASK) >> (k)) & 1) for (int rep_ = 0; rep_ < (((REPMASK) >> (k)) & 1) + 1; ++rep_) { \
    LOADKA; Params p; fill_params(p, kk); { int t_; asm volatile("v_mbcnt_lo_u32_b32 %0, -1, 0\n\tv_mbcnt_hi_u32_b32 %0, -1, %0" : "=v"(t_)); p.tid = (wv_ << 6) | t_; } body; grid_bar(p, lds); }
#ifdef XBAR
  for (int xb_ = 0; xb_ < XBAR; ++xb_) { PHASE(15, {}) }
#endif
  PHASE(0, { ph_mod(p, lds, nblk, bid); ph_wt(p, lds, nblk, bid); })
  PHASE(1, { ph_h(p, lds, nblk, bid); })
  PHASE(2, { ph_proj(p, lds, nblk, bid); })
  PHASE(3, { bool first = true; for (int ci = bid; ci < 1024; ci += nblk) { dn_prep_chunk(p, lds, ci, first); first = false; }
             for (int item = bid; item < 256; item += nblk) moba_prep_block(p, lds, item); })
  PHASE(4, { if (bid < 32) dn_scan_blk(p, lds, bid); moba_worker(p, lds, rep_); })
  PHASE(5, { ph_dn_norm(p, nblk, bid); })
  PHASE(6, { ph_br(p, lds, nblk, bid); })
  PHASE(7, { ph_mix(p, lds, nblk, bid); })
  PHASE(8, { ph_post_mix(p, lds, nblk, bid, rep_); })
  PHASE(10, { ph_moe1(p, lds, nblk, bid); })
  PHASE(11, { ph_moe2(p, lds, nblk, bid); })
  PHASE(12, { ph_final(p, nblk, bid, rep_); })
}


extern "C" void kernel_launch(void* const* d_in, const int* in_sizes, int n_in, void* d_out, int out_size, void* d_ws,
                              size_t ws_size, hipStream_t stream) {
  KArgs ka{};
  for (int i = 0; i < 22; ++i) ka.in[i] = d_in[i];
  ka.out = (float*)d_out; ka.ws = (char*)d_ws; ka.never = 0;
  Params p{};
  fill_params(p, ka);
  static int grid_blocks = 0;
  if (!grid_blocks) {
    (void)hipFuncSetAttribute((const void*)mega, hipFuncAttributeMaxDynamicSharedMemorySize, MEGA_LDS_ALLOC);
    int dev = 0, cus = 0, per_cu = 0;
    (void)hipGetDevice(&dev);
    (void)hipDeviceGetAttribute(&cus, hipDeviceAttributeMultiprocessorCount, dev);
    (void)hipOccupancyMaxActiveBlocksPerMultiprocessor(&per_cu, mega, 512, MEGA_LDS_ALLOC);
    if (per_cu != 1) per_cu = 1;
    grid_blocks = cus * per_cu;
  }
  (void)hipMemsetAsync(p.cnt, 0, 16384, stream);
  (void)hipMemsetAsync(p.bar, 0, XCD_BAR_WORDS * 4, stream);
  void* args[] = {&ka};
  hipError_t e = hipLaunchCooperativeKernel((void*)mega, dim3(grid_blocks), dim3(512), args, MEGA_LDS_ALLOC, stream);
  if (e != hipSuccess) fprintf(stderr, "cooperative launch failed: %s (grid %d)\n", hipGetErrorString(e), grid_blocks);
}
```

```cpp
#include <hip/hip_runtime.h>
#include <hip/hip_cooperative_groups.h>
#include <cstdio>
namespace cg = cooperative_groups;
#include <stdint.h>

typedef unsigned short bf16_t;
#ifndef MB_ABL
#define MB_ABL 0
#endif

#define T_TOK 16384
#define SEQ 4096
#define NB 4
#define DM 1024
#define INW 5640
#define PW 5632
#define C_QA 0
#define C_KA 512
#define C_VA 1024
#define C_Z 1536
#define C_MQ 2048
#define C_MK 2560
#define C_MV 3072
#define C_GA 3584
#define C_GB 4608
#define NE 32

__device__ __forceinline__ bf16_t f2bf(float f) {
  unsigned u = __float_as_uint(f);
  u += 0x7fffu + ((u >> 16) & 1u);
  return (bf16_t)(u >> 16);
}
__device__ __forceinline__ float bf2f(bf16_t h) { return __uint_as_float(((unsigned)h) << 16); }
__device__ __forceinline__ float sigmoidf_(float x) { return __builtin_amdgcn_rcpf(1.f + __builtin_amdgcn_exp2f(-1.4426950408889634f * x)); }
__device__ __forceinline__ float siluf_(float x) { return x * sigmoidf_(x); }
__device__ __forceinline__ float wave_sum(float v) {
#pragma unroll
  for (int o = 32; o > 0; o >>= 1) v += __shfl_xor(v, o, 64);
  return v;
}
__device__ __forceinline__ float wave_max(float v) {
#pragma unroll
  for (int o = 32; o > 0; o >>= 1) v = fmaxf(v, __shfl_xor(v, o, 64));
  return v;
}

typedef unsigned u32x2 __attribute__((ext_vector_type(2)));
typedef __bf16 bf16x2_t __attribute__((ext_vector_type(2)));
typedef float f32x2_t __attribute__((ext_vector_type(2)));
__device__ __forceinline__ unsigned pk2(float a, float b) { f32x2_t v = {a, b}; bf16x2_t r = __builtin_convertvector(v, bf16x2_t); return __builtin_bit_cast(unsigned, r); }

__device__ __forceinline__ unsigned pk4_fp8(float a, float b, float c, float d) {
  int w = 0;
  w = __builtin_amdgcn_cvt_pk_fp8_f32(a, b, w, false);
  w = __builtin_amdgcn_cvt_pk_fp8_f32(c, d, w, true);
  return (unsigned)w;
}

struct Params {
  const float *x, *c, *w_ada, *b_ada, *g_pre_mix, *g_post_mix, *g_pre_ffn, *g_post_ffn, *w_in, *conv_w,
      *a_log, *dt_bias, *g_dn_out, *w_br_a, *w_br_b, *w_o, *w_router, *b_router, *w_gu, *b_gu, *w_down, *b_down;
  float* out;
  float* mod;
  int* cnt;
  float* ba;
  bf16_t* hbf;
  bf16_t* proj;
  bf16_t* w_in_t;
  unsigned char* wgu8;
  unsigned char* wd8;
  unsigned char* h2q;
  unsigned char* act8;
  bf16_t* wbra_t;
  bf16_t* wbrb_t;
  bf16_t* wo_t;
  bf16_t* qb;
  bf16_t* kb;
  float* kmean;
  bf16_t* oab;
  bf16_t* merged;
  bf16_t* mixer;
  bf16_t* h2;
  int* elist;
  float* aw;
  bf16_t* act;
  bf16_t* xs;
  int* rowmap;
  bf16_t* yslot;
  unsigned char* dnA; float* dnU; float* dnG;
  bf16_t* dn_out; int dn_out_ld;
  bf16_t* oab2; float* dbg;
  unsigned* bar; int never; int tid;
  bf16_t* Kp; bf16_t* Vp; int* wq;
  bf16_t* mb_out; int mb_out_ld; int mb_out_off;
  float* nq; float* nk; float* nv;
  float* nbeta; float* ng;
  float* no;
  float* ntmp;
};

__device__ __forceinline__ int map_col(int n, int mode) {
  if (mode == 0) return n;
  if (mode == 1) return n < 2048 ? n : (n < 2056 ? -1 : n - 8);
  if (n < 1024) return (n >> 7) * 256 + (n & 127);
  int j = n - 1024;
  return (j >> 7) * 256 + 128 + (j & 127);
}
namespace pg8 {
#define PG8_LAS __attribute__((address_space(3)))
typedef short bf16x8 __attribute__((ext_vector_type(8)));
typedef float f32x4 __attribute__((ext_vector_type(4)));
typedef unsigned u32x4 __attribute__((ext_vector_type(4)));
constexpr int BM = 256, BK = 64, HALF = 128, HTB = HALF * BK * 2, STAGE_BYTES = 8 * HTB, NXCD = 8, WGM = 8;

__host__ __device__ __forceinline__ int lds_byte(int r, int c) { const int st = (r >> 4) * 2 + (c >> 5), rr = r & 15, cc = c & 31, ob = rr * 64 + cc * 2; return st * 1024 + (ob ^ (((ob >> 9) & 1) << 5)); }
__host__ __device__ __forceinline__ void stage_rc(int b, int& R, int& C) { const int st = b / 1024, sb = b % 1024, swz = sb ^ (((sb >> 9) & 1) << 5); R = (st >> 1) * 16 + swz / 64; C = (st & 1) * 32 + (swz % 64) / 2; }
__host__ __device__ __forceinline__ int perm32(int rho) { const int n = rho >> 4, i = rho & 15; return 8 * (i >> 2) + 4 * n + (i & 3); }

struct Unit { int pm, pn, z; };
__device__ __forceinline__ unsigned cvt_pk_bf16(float lo, float hi) { unsigned r; asm volatile("v_cvt_pk_bf16_f32 %0, %1, %2" : "=v"(r) : "v"(lo), "v"(hi)); return r; }

typedef int i32x8 __attribute__((ext_vector_type(8)));
typedef int i32x4 __attribute__((ext_vector_type(4)));
__device__ __forceinline__ i32x8 cat8(const bf16x8 lo, const bf16x8 hi) { const i32x4 a = __builtin_bit_cast(i32x4, lo), b = __builtin_bit_cast(i32x4, hi); return __builtin_shufflevector(a, b, 0, 1, 2, 3, 4, 5, 6, 7); }
struct TileOrder {
    int nM, nN, nwg, G, c;
    __device__ void init(int nM_, int nN_, int G_, int c_) { nM = nM_; nN = nN_; nwg = nM * nN; G = G_; c = c_; }
    __device__ bool tile(int i, int& pm, int& pn) const {
        const long L = (long)i * G + c; if (L >= nwg) return false;
        int wgid = (int)L; { const int q = nwg / NXCD, r = nwg % NXCD, xcd = wgid % NXCD, off = wgid / NXCD; wgid = (xcd < r ? xcd * (q + 1) : r * (q + 1) + (xcd - r) * q) + off; }
        const int nig = WGM * nN, gid = wgid / nig, fm = gid * WGM, gsz = (nM - fm) < WGM ? (nM - fm) : WGM;
        pm = fm + ((wgid % nig) % gsz); pn = (wgid % nig) / gsz; return true;
    }
};

template <class Epi, class Sched, bool FP8 = false>
__device__ __forceinline__ void gemm_phase(PG8_LAS unsigned char* lds, const int tid, const int lda, const int ldb, const int K, const Sched& S, const Epi& E) {
    const int wid = __builtin_amdgcn_readfirstlane(tid >> 6), lane = tid & 63, wr = wid >> 2, wc = wid & 3, fr = lane & 15, fq = lane >> 4;
    const int nt = K / BK;
    unsigned voffA[2], voffB[2];
#pragma unroll
    for (int i = 0; i < 2; ++i) { int R, C; stage_rc(tid * 16 + i * 8192, R, C); const int Rb = Epi::PERM ? ((R & ~31) + perm32(R & 31)) : R;
        voffA[i] = (unsigned)(R * lda + C) * 2u; voffB[i] = (unsigned)(Rb * ldb + C) * 2u; }
    const size_t kstep = (size_t)(BK * 2);
    const size_t hstepA = (size_t)HALF * lda * 2, hstepB = (size_t)HALF * ldb * 2;
    const unsigned ldsw = (unsigned)wid * 1024u;
    const int aoff = FP8 ? lds_byte(wr * 64 + fr, fq * 16) : lds_byte(wr * 64 + fr, fq * 8), boff = FP8 ? lds_byte(wc * 32 + fr, fq * 16) : lds_byte(wc * 32 + fr, fq * 8);
    constexpr int KOFF1 = FP8 ? 16 : 1024;
    unsigned gA[2][2] = {{0u, 0u}, {0u, 0u}}, gAn[2][2] = {{0u, 0u}, {0u, 0u}};
#define PG8_GOFFS(dst, unit) do { int t_ = tid; asm volatile("" : "+v"(t_)); _Pragma("unroll") for (int i_ = 0; i_ < 2; ++i_) { int gR_, gC_; stage_rc(t_ * 16 + i_ * 8192, gR_, gC_); \
        _Pragma("unroll") for (int h_ = 0; h_ < 2; ++h_) dst[h_][i_] = S.a_goff(unit, gR_ + 128 * h_, gC_); } } while (0)
#define PG8_SA(b, h) (((b) * 2 + (h)) * HTB)
#define PG8_SB(b, h) ((4 + (b) * 2 + (h)) * HTB)
#define PG8_STAGE(bufoff, gbase, voff) do { _Pragma("unroll") for (int _i = 0; _i < 2; ++_i) \
        __builtin_amdgcn_global_load_lds((const unsigned*)((const char*)(gbase) + (voff)[_i]), (PG8_LAS unsigned*)(lds + (bufoff) + ldsw + _i * 8192), 16, 0, 0); } while (0)
#define PG8_STAGEA(bufoff, ptr, h, nx) do { if constexpr (Sched::GATHER) { const unsigned gs_[2] = {(nx) ? gAn[h][0] : gA[h][0], (nx) ? gAn[h][1] : gA[h][1]}; PG8_STAGE(bufoff, ptr, gs_); } \
        else { PG8_STAGE(bufoff, (ptr) + (h) * hstepA, voffA); } } while (0)
#define PG8_LDA(dst, b, h) do { if constexpr (FP8) { _Pragma("unroll") for (int m = 0; m < 4; ++m) dst##8[m] = cat8(*(const PG8_LAS bf16x8*)(lds + PG8_SA(b, h) + aoff + m * 2048), *(const PG8_LAS bf16x8*)(lds + PG8_SA(b, h) + aoff + KOFF1 + m * 2048)); } \
        else { _Pragma("unroll") for (int m = 0; m < 4; ++m) _Pragma("unroll") for (int k = 0; k < 2; ++k) dst[m][k] = *(const PG8_LAS bf16x8*)(lds + PG8_SA(b, h) + aoff + k * KOFF1 + m * 2048); } } while (0)
#define PG8_LDB(dst, b, h) do { if constexpr (FP8) { _Pragma("unroll") for (int n = 0; n < 2; ++n) dst##8[n] = cat8(*(const PG8_LAS bf16x8*)(lds + PG8_SB(b, h) + boff + n * 2048), *(const PG8_LAS bf16x8*)(lds + PG8_SB(b, h) + boff + KOFF1 + n * 2048)); } \
        else { _Pragma("unroll") for (int n = 0; n < 2; ++n) _Pragma("unroll") for (int k = 0; k < 2; ++k) dst[n][k] = *(const PG8_LAS bf16x8*)(lds + PG8_SB(b, h) + boff + k * KOFF1 + n * 2048); } } while (0)
#define PG8_MMA(ai, bj, At, Bt) do { __builtin_amdgcn_s_setprio(1); if constexpr (FP8) { _Pragma("unroll") for (int m = 0; m < 4; ++m) _Pragma("unroll") for (int n = 0; n < 2; ++n) \
        asm volatile("v_mfma_scale_f32_16x16x128_f8f6f4 %0, %1, %2, %0, %3, %4 op_sel_hi:[0,0,0]" : "+v"(acc[ai][bj][m][n]) : "v"(Bt##8[n]), "v"(At##8[m]), "v"(sclB), "v"(sclA)); } \
        else { _Pragma("unroll") for (int m = 0; m < 4; ++m) _Pragma("unroll") for (int n = 0; n < 2; ++n) _Pragma("unroll") for (int k = 0; k < 2; ++k) \
        acc[ai][bj][m][n] = __builtin_amdgcn_mfma_f32_16x16x32_bf16(Bt[n][k], At[m][k], acc[ai][bj][m][n], 0, 0, 0); } __builtin_amdgcn_s_setprio(0); } while (0)
#define PG8_WAIT_V(n) asm volatile("s_waitcnt vmcnt(" #n ")" ::: "memory")
#define PG8_WAIT_L(n) asm volatile("s_waitcnt lgkmcnt(" #n ")" ::: "memory")
#define PG8_BAR __builtin_amdgcn_s_barrier()
#define PG8_SCHED __builtin_amdgcn_sched_barrier(0)
    Unit cur, nxt; int ui = 0;
    if (!S.next(0, cur)) return;
    f32x4 acc[2][2][4][2];
#pragma unroll
    for (int a = 0; a < 2; ++a)
#pragma unroll
        for (int b = 0; b < 2; ++b)
#pragma unroll
            for (int m = 0; m < 4; ++m)
#pragma unroll
                for (int n = 0; n < 2; ++n) acc[a][b][m][n] = (f32x4){0.f, 0.f, 0.f, 0.f};
    bf16x8 At[4][2], B0[2][2], B1[2][2];
    i32x8 At8[4], B08[2], B18[2];
    int sclA = 0x7f7f7f7f, sclB = 0x79797979;
    const char* cA = S.a_ptr(cur); const char* cB = S.b_ptr(cur);
    if constexpr (Sched::GATHER) { PG8_GOFFS(gA, cur); }
    PG8_STAGE(PG8_SB(0, 0), cB, voffB); PG8_STAGEA(PG8_SA(0, 0), cA, 0, false); PG8_STAGE(PG8_SB(0, 1), cB + hstepB, voffB); PG8_STAGEA(PG8_SA(0, 1), cA, 1, false);
    if (wr == 1) PG8_BAR;
    PG8_WAIT_V(4); PG8_BAR;
    PG8_STAGE(PG8_SB(1, 0), cB + kstep, voffB); PG8_STAGEA(PG8_SA(1, 0), cA + kstep, 0, false); PG8_STAGE(PG8_SB(1, 1), cB + hstepB + kstep, voffB);
    PG8_WAIT_V(6); PG8_BAR;
    for (;;) {
        const bool has_next = S.next(ui + 1, nxt);
        const char* nA = has_next ? S.a_ptr(nxt) : cA; const char* nB = has_next ? S.b_ptr(nxt) : cB;
        if constexpr (Sched::GATHER) { if (has_next) { PG8_GOFFS(gAn, nxt); } else {
_Pragma("unroll") for (int h = 0; h < 2; ++h) _Pragma("unroll") for (int i = 0; i < 2; ++i) gAn[h][i] = gA[h][i]; } }
_Pragma("unroll 1")
        for (int t = 0; t < nt; t += 2) {
            const bool last = (t == nt - 2);
            const char* a1 = cA + (size_t)(t + 1) * kstep;
            const char* a2 = last ? nA : cA + (size_t)(t + 2) * kstep; const char* b2 = last ? nB : cB + (size_t)(t + 2) * kstep;
            const char* a3 = a2 + kstep; const char* b3 = b2 + kstep;
            PG8_LDB(B0, 0, 0); PG8_SCHED; PG8_LDA(At, 0, 0); PG8_STAGEA(PG8_SA(1, 1), a1, 1, false);
            PG8_WAIT_L(8); PG8_BAR; PG8_WAIT_L(0); PG8_MMA(0, 0, At, B0); PG8_BAR; PG8_SCHED;
            PG8_LDB(B1, 0, 1); PG8_STAGE(PG8_SB(0, 0), b2, voffB);
            PG8_BAR; PG8_WAIT_L(0); PG8_MMA(0, 1, At, B1); PG8_BAR;
            PG8_LDA(At, 0, 1); PG8_STAGEA(PG8_SA(0, 0), a2, 0, last);
            PG8_BAR; PG8_WAIT_L(0); PG8_MMA(1, 0, At, B0); PG8_BAR; PG8_SCHED;
            PG8_STAGE(PG8_SB(0, 1), b2 + hstepB, voffB);
            PG8_WAIT_V(6); PG8_BAR; PG8_MMA(1, 1, At, B1); PG8_BAR;
            PG8_LDB(B0, 1, 0); PG8_SCHED; PG8_LDA(At, 1, 0); PG8_STAGEA(PG8_SA(0, 1), a2, 1, last);
            PG8_WAIT_L(8); PG8_BAR; PG8_WAIT_L(0); PG8_MMA(0, 0, At, B0); PG8_BAR; PG8_SCHED;
            PG8_LDB(B1, 1, 1); PG8_STAGE(PG8_SB(1, 0), b3, voffB);
            PG8_BAR; PG8_WAIT_L(0); PG8_MMA(0, 1, At, B1); PG8_BAR;
            PG8_LDA(At, 1, 1); PG8_STAGEA(PG8_SA(1, 0), a3, 0, last);
            PG8_BAR; PG8_WAIT_L(0); PG8_MMA(1, 0, At, B0); PG8_BAR; PG8_SCHED;
            PG8_STAGE(PG8_SB(1, 1), b3 + hstepB, voffB);
            PG8_WAIT_V(6); PG8_BAR; PG8_MMA(1, 1, At, B1); PG8_BAR;
        }
        { if constexpr (FP8) asm volatile("s_nop 15\n\ts_nop 3" ::: "memory");
          int t_ = tid; asm volatile("" : "+v"(t_));
          E(acc, cur, wr, wc, t_ & 15, (t_ & 63) >> 4); }
        if (!has_next) break;
#pragma unroll
        for (int a = 0; a < 2; ++a)
#pragma unroll
            for (int b = 0; b < 2; ++b)
#pragma unroll
                for (int m = 0; m < 4; ++m)
#pragma unroll
                    for (int n = 0; n < 2; ++n) acc[a][b][m][n] = (f32x4){0.f, 0.f, 0.f, 0.f};
        cur = nxt; cA = nA; cB = nB; ++ui;
        if constexpr (Sched::GATHER) {
_Pragma("unroll") for (int h = 0; h < 2; ++h) _Pragma("unroll") for (int i = 0; i < 2; ++i) gA[h][i] = gAn[h][i]; }
    }
    PG8_WAIT_V(0);
    if (wr == 0) PG8_BAR;
    PG8_BAR;
#undef PG8_SA
#undef PG8_SB
#undef PG8_STAGE
#undef PG8_STAGEA
#undef PG8_GOFFS
#undef PG8_LDA
#undef PG8_LDB
#undef PG8_MMA
#undef PG8_WAIT_V
#undef PG8_WAIT_L
#undef PG8_BAR
#undef PG8_SCHED
}
}
using pg8::f32x4; using pg8::u32x4; using pg8::Unit;

#define GEMM_LDS (pg8::STAGE_BYTES + 1024)

struct SchedProj : pg8::TileOrder {
  static constexpr bool GATHER = false;
  const char* A; const char* B;
  __device__ bool next(int i, Unit& u) const { u.z = 0; return tile(i, u.pm, u.pn); }
  __device__ const char* a_ptr(const Unit& u) const { return A + (size_t)u.pm * 256 * DM * 2; }
  __device__ const char* b_ptr(const Unit& u) const { return B + (size_t)u.pn * 256 * DM * 2; }
};
struct EpiProj {
  static constexpr bool PERM = true;
  bf16_t* O;
  __device__ __forceinline__ void operator()(const f32x4 (&acc)[2][2][4][2], const Unit& u, int wr, int wc, int fr, int fq) const {
    const int row0 = u.pm * 256 + wr * 64 + fr, col0 = u.pn * 256 + wc * 32 + 8 * fq;
    const bool gate = u.pn >= (C_GA / 256);
#pragma unroll
    for (int ai = 0; ai < 2; ++ai)
#pragma unroll
      for (int m = 0; m < 4; ++m) {
        bf16_t* rowp = O + (size_t)(row0 + ai * 128 + m * 16) * PW + col0;
#pragma unroll
        for (int bj = 0; bj < 2; ++bj) {
          f32x4 v0 = acc[ai][bj][m][0], v1 = acc[ai][bj][m][1];
          if (gate) {
#pragma unroll
            for (int j = 0; j < 4; ++j) { v0[j] = sigmoidf_(v0[j]); v1[j] = sigmoidf_(v1[j]); }
          }
          u32x4 w; w.x = pg8::cvt_pk_bf16(v0[0], v0[1]); w.y = pg8::cvt_pk_bf16(v0[2], v0[3]); w.z = pg8::cvt_pk_bf16(v1[0], v1[1]); w.w = pg8::cvt_pk_bf16(v1[2], v1[3]);
          *(u32x4*)(rowp + bj * 128) = w;
        }
      }
  }
};
__device__ void ph_proj(const Params& p, PG8_LAS unsigned char* lds, int nblk, int bid) {
  SchedProj S; S.init(T_TOK / 256, PW / 256, nblk, bid); S.A = (const char*)p.hbf; S.B = (const char*)p.w_in_t;
  EpiProj E{p.proj};
  pg8::gemm_phase(lds, p.tid, DM, DM, DM, S, E);
}

struct SchedBr : pg8::TileOrder {
  static constexpr bool GATHER = false;
  const char* A; const char* Ba; const char* Bb;
  __device__ bool next(int i, Unit& u) const { u.z = i & 1; return tile(i >> 1, u.pm, u.pn); }
  __device__ const char* a_ptr(const Unit& u) const { return A + (size_t)u.pm * 256 * DM * 2 + u.z * 512 * 2; }
  __device__ const char* b_ptr(const Unit& u) const { return (u.z ? Bb : Ba) + (size_t)u.pn * 256 * 512 * 2; }
};
__device__ __forceinline__ void unpack8(const u32x4 w, float (&f)[8]) {
  f[0] = __uint_as_float(w.x << 16); f[1] = __uint_as_float(w.x & 0xffff0000u); f[2] = __uint_as_float(w.y << 16); f[3] = __uint_as_float(w.y & 0xffff0000u);
  f[4] = __uint_as_float(w.z << 16); f[5] = __uint_as_float(w.z & 0xffff0000u); f[6] = __uint_as_float(w.w << 16); f[7] = __uint_as_float(w.w & 0xffff0000u);
}
struct EpiBr {
  static constexpr bool PERM = true;
  const bf16_t* proj; bf16_t* O;
  __device__ __forceinline__ void operator()(const f32x4 (&acc)[2][2][4][2], const Unit& u, int wr, int wc, int fr, int fq) const {
    const int row0 = u.pm * 256 + wr * 64 + fr, col0 = u.pn * 256 + wc * 32 + 8 * fq;
    const int gcol = (u.z ? C_GB : C_GA) + col0;
#pragma unroll
    for (int ai = 0; ai < 2; ++ai)
#pragma unroll
      for (int m = 0; m < 4; ++m) {
        const size_t row = (size_t)(row0 + ai * 128 + m * 16);
        bf16_t* rowp = O + row * DM + col0;
        const bf16_t* gp = proj + row * PW + gcol;
#pragma unroll
        for (int bj = 0; bj < 2; ++bj) {
          float g[8]; unpack8(*(const u32x4*)(gp + bj * 128), g);
          f32x4 v0 = acc[ai][bj][m][0], v1 = acc[ai][bj][m][1];
          float r[8];
#pragma unroll
          for (int j = 0; j < 4; ++j) { r[j] = v0[j] * g[j]; r[4 + j] = v1[j] * g[4 + j]; }
          if (u.z) {
            float pv[8]; unpack8(*(const u32x4*)(rowp + bj * 128), pv);
#pragma unroll
            for (int j = 0; j < 8; ++j) r[j] += pv[j];
          }
          u32x4 w; w.x = pg8::cvt_pk_bf16(r[0], r[1]); w.y = pg8::cvt_pk_bf16(r[2], r[3]); w.z = pg8::cvt_pk_bf16(r[4], r[5]); w.w = pg8::cvt_pk_bf16(r[6], r[7]);
          *(u32x4*)(rowp + bj * 128) = w;
        }
      }
  }
};
__device__ void ph_br(const Params& p, PG8_LAS unsigned char* lds, int nblk, int bid) {
  SchedBr S; S.init(T_TOK / 256, DM / 256, nblk, bid); S.A = (const char*)p.oab; S.Ba = (const char*)p.wbra_t; S.Bb = (const char*)p.wbrb_t;
  EpiBr E{p.proj, p.merged};
  pg8::gemm_phase(lds, p.tid, DM, 512, 512, S, E);
}

struct SchedMix : pg8::TileOrder {
  static constexpr bool GATHER = false;
  const char* A; const char* B;
  __device__ bool next(int i, Unit& u) const { u.z = 0; return tile(i, u.pm, u.pn); }
  __device__ const char* a_ptr(const Unit& u) const { return A + (size_t)u.pm * 256 * DM * 2; }
  __device__ const char* b_ptr(const Unit& u) const { return B + (size_t)u.pn * 256 * DM * 2; }
};
struct EpiMix {
  static constexpr bool PERM = true;
  bf16_t* O;
  __device__ __forceinline__ void operator()(const f32x4 (&acc)[2][2][4][2], const Unit& u, int wr, int wc, int fr, int fq) const {
    const int row0 = u.pm * 256 + wr * 64 + fr, col0 = u.pn * 256 + wc * 32 + 8 * fq;
#pragma unroll
    for (int ai = 0; ai < 2; ++ai)
#pragma unroll
      for (int m = 0; m < 4; ++m) {
        bf16_t* rowp = O + (size_t)(row0 + ai * 128 + m * 16) * DM + col0;
#pragma unroll
        for (int bj = 0; bj < 2; ++bj) {
          const f32x4 v0 = acc[ai][bj][m][0], v1 = acc[ai][bj][m][1];
          u32x4 w; w.x = pg8::cvt_pk_bf16(v0[0], v0[1]); w.y = pg8::cvt_pk_bf16(v0[2], v0[3]); w.z = pg8::cvt_pk_bf16(v1[0], v1[1]); w.w = pg8::cvt_pk_bf16(v1[2], v1[3]);
          *(u32x4*)(rowp + bj * 128) = w;
        }
      }
  }
};
__device__ void ph_mix(const Params& p, PG8_LAS unsigned char* lds, int nblk, int bid) {
  SchedMix S; S.init(T_TOK / 256, DM / 256, nblk, bid); S.A = (const char*)p.merged; S.B = (const char*)p.wo_t;
  EpiMix E{p.mixer};
  pg8::gemm_phase(lds, p.tid, DM, DM, DM, S, E);
}

template <bool GATH>
struct SchedMoe {
  static constexpr bool GATHER = GATH;
  const PG8_LAS int* tb; int NT; int G, c; int nwg;
  const char* A; const char* B; size_t bexp;
  const int* elist; int rowb;
  __device__ bool next(int i, Unit& u) const {
    const long L = (long)i * G + c; if (L >= nwg) return false;
    int wgid = (int)L; { const int q = nwg / 8, r = nwg % 8, xcd = wgid % 8, off = wgid / 8; wgid = (xcd < r ? xcd * (q + 1) : r * (q + 1) + (xcd - r) * q) + off; }
    int e = 0;
#pragma unroll 1
    for (int k = 1; k < NE; ++k) if (wgid >= tb[k]) e = k;
    const int q = wgid - tb[e]; const int tiles = tb[33 + e + 1] - tb[33 + e];
    u.pm = tb[33 + e] + q % tiles; u.pn = q / tiles; u.z = e; return true;
  }
  __device__ const char* a_ptr(const Unit& u) const { return GATH ? A : A + (size_t)u.pm * 256 * rowb; }
  __device__ const char* b_ptr(const Unit& u) const { return B + (size_t)u.z * bexp + (size_t)u.pn * 256 * rowb; }
  __device__ unsigned a_goff(const Unit& u, int tr, int C) const {
    const int i = (u.pm - tb[33 + u.z]) * 256 + tr;
    int tok = 0;
    if (i < tb[66 + u.z]) tok = elist[u.z * T_TOK + i] >> 2;
    return (unsigned)(tok * rowb + C * 2);
  }
};
__device__ __forceinline__ void moe_table(const Params& p, PG8_LAS int* tb, int NT) {
  if (p.tid == 0) {
    int ub = 0, tbp = 0;
    for (int e = 0; e < NE; ++e) { const int c = p.cnt[e * 64]; tb[e] = ub; tb[33 + e] = tbp; tb[66 + e] = c; const int t = (c + 255) >> 8; ub += t * NT; tbp += t; }
    tb[NE] = ub; tb[33 + NE] = tbp;
  }
  __syncthreads();
}
struct EpiMoe1 {
  static constexpr bool PERM = true;
  const float* b_gu; unsigned char* act;
  __device__ __forceinline__ void operator()(f32x4 (&acc)[2][2][4][2], const Unit& u, int wr, int wc, int fr, int fq) const {
    const int row0 = u.pm * 256 + wr * 64 + fr, jc = u.pn * 128 + wc * 32 + 8 * fq;
    const float* bg = b_gu + (size_t)u.z * 2048 + jc;
#pragma unroll
    for (int bj = 0; bj < 2; ++bj)
#pragma unroll
      for (int n = 0; n < 2; ++n) {
        const f32x4 bv = *(const f32x4*)(bg + bj * 1024 + n * 4);
#pragma unroll
        for (int ai = 0; ai < 2; ++ai)
#pragma unroll
          for (int m = 0; m < 4; ++m) acc[ai][bj][m][n] += bv;
      }
#pragma unroll
    for (int ai = 0; ai < 2; ++ai)
#pragma unroll
      for (int m = 0; m < 4; ++m) {
        unsigned char* rowp = act + (size_t)(row0 + ai * 128 + m * 16) * DM + jc;
        float r[8];
#pragma unroll
        for (int n = 0; n < 2; ++n)
#pragma unroll
          for (int j = 0; j < 4; ++j) {
            float g = acc[ai][0][m][n][j], up = acc[ai][1][m][n][j];
            g = fminf(g, 7.f); up = fminf(fmaxf(up, -7.f), 7.f);
            r[n * 4 + j] = (up + 1.f) * g * sigmoidf_(1.702f * g);
          }
        u32x2 w; w.x = pk4_fp8(r[0], r[1], r[2], r[3]); w.y = pk4_fp8(r[4], r[5], r[6], r[7]);
        *(u32x2*)rowp = w;
      }
  }
};
__device__ void ph_moe1(const Params& p, PG8_LAS unsigned char* lds, int nblk, int bid) {
  PG8_LAS int* tb = (PG8_LAS int*)(lds + pg8::STAGE_BYTES);
  moe_table(p, tb, 8);
  SchedMoe<true> S; S.tb = tb; S.NT = 8; S.G = nblk; S.c = bid; S.nwg = tb[NE]; S.A = (const char*)p.h2q; S.B = (const char*)p.wgu8; S.bexp = (size_t)2048 * DM; S.elist = p.elist; S.rowb = DM;
  EpiMoe1 E{p.b_gu, p.act8};
  pg8::gemm_phase<EpiMoe1, SchedMoe<true>, true>(lds, p.tid, DM / 2, DM / 2, DM / 2, S, E);
}
struct EpiMoe2 {
  static constexpr bool PERM = true;
  const float* b_down; const int* elist; const PG8_LAS int* tb; bf16_t* yslot;
  __device__ __forceinline__ void operator()(f32x4 (&acc)[2][2][4][2], const Unit& u, int wr, int wc, int fr, int fq) const {
    const int row0 = u.pm * 256 + wr * 64 + fr, col0 = u.pn * 256 + wc * 32 + 8 * fq;
    const float* bd = b_down + (size_t)u.z * 1024 + col0;
#pragma unroll
    for (int bj = 0; bj < 2; ++bj)
#pragma unroll
      for (int n = 0; n < 2; ++n) {
        const f32x4 bv = *(const f32x4*)(bd + bj * 128 + n * 4);
#pragma unroll
        for (int ai = 0; ai < 2; ++ai)
#pragma unroll
          for (int m = 0; m < 4; ++m) acc[ai][bj][m][n] += bv;
      }
#pragma unroll
    for (int ai = 0; ai < 2; ++ai)
#pragma unroll
      for (int m = 0; m < 4; ++m) {
        const int li = (u.pm - tb[33 + u.z]) * 256 + wr * 64 + fr + ai * 128 + m * 16;
        if (li < tb[66 + u.z]) {
          const int a = elist[u.z * T_TOK + li];
          bf16_t* rowp = yslot + (size_t)a * DM + col0;
#pragma unroll
          for (int bj = 0; bj < 2; ++bj) {
            const f32x4 v0 = acc[ai][bj][m][0], v1 = acc[ai][bj][m][1];
            u32x4 w; w.x = pk2(v0[0], v0[1]); w.y = pk2(v0[2], v0[3]); w.z = pk2(v1[0], v1[1]); w.w = pk2(v1[2], v1[3]);
            *(u32x4*)(rowp + bj * 128) = w;
          }
        }
      }
  }
};
__device__ void ph_moe2(const Params& p, PG8_LAS unsigned char* lds, int nblk, int bid) {
  PG8_LAS int* tb = (PG8_LAS int*)(lds + pg8::STAGE_BYTES);
  moe_table(p, tb, 4);
  SchedMoe<false> S; S.tb = tb; S.NT = 4; S.G = nblk; S.c = bid; S.nwg = tb[NE]; S.A = (const char*)p.act8; S.B = (const char*)p.wd8; S.bexp = (size_t)1024 * DM; S.elist = p.elist; S.rowb = DM;
  EpiMoe2 E{p.b_down, p.elist, tb, p.yslot};
  pg8::gemm_phase<EpiMoe2, SchedMoe<false>, true>(lds, p.tid, DM / 2, DM / 2, DM / 2, S, E);
}

typedef short bf16x8 __attribute__((ext_vector_type(8)));
#define LAS __attribute__((address_space(3)))
#define MFMA16(a, b, c) __builtin_amdgcn_mfma_f32_16x16x32_bf16((a), (b), (c), 0, 0, 0)
__device__ __forceinline__ bf16x8 pack8(float a0, float a1, float a2, float a3, float a4, float a5, float a6, float a7) {
  u32x4 w; w.x = pk2(a0, a1); w.y = pk2(a2, a3); w.z = pk2(a4, a5); w.w = pk2(a6, a7);
  return __builtin_bit_cast(bf16x8, w);
}
__device__ __forceinline__ bf16_t f2bf_hw(float a) { return (bf16_t)(pk2(a, 0.f) & 0xffffu); }

#define DN_ABYTES 57344
#define DN_UFLOATS 8192
#define F_WN 0
#define F_QD 16
#define F_QK 32
#define F_KT 40

#define DP_KH 0
#define DP_QT 17408
#define DP_KHT 34816
#define DP_VT 53248
#define DP_TU 71680
#define DP_TW 80896
#define DP_LF 90112
#define DP_GC 107520
#define DP_BETA 107776
#define DP_CW 108032
#define DP_LB 114176
#define DP_TR 123392
#define DP_TT 132608
#define DP_MT 141824
#define DP_TOTAL 144128

template <int KS>
__device__ __forceinline__ f32x4 prod16(const LAS bf16_t* A, int lda, int arow0, const LAS bf16_t* Bt, int ldb, int brow0, f32x4 acc, int lane) {
  const int r = lane & 15, q = lane >> 4;
#pragma unroll
  for (int ks = 0; ks < KS; ++ks) {
    const bf16x8 a = *(const LAS bf16x8*)(A + (arow0 + r) * lda + 32 * ks + 8 * q);
    const bf16x8 b = *(const LAS bf16x8*)(Bt + (brow0 + r) * ldb + 32 * ks + 8 * q);
    acc = MFMA16(a, b, acc);
  }
  return acc;
}
__device__ __forceinline__ void tile_store_rm(LAS bf16_t* X, int ld, int row0, int col0, const f32x4 v, int lane) {
  const int r = lane & 15, q = lane >> 4;
#pragma unroll
  for (int i = 0; i < 4; ++i) X[(row0 + 4 * q + i) * ld + col0 + r] = f2bf_hw(v[i]);
}
__device__ __forceinline__ void tile_store_tr(LAS bf16_t* Xt, int ld, int row0, int col0, const f32x4 v, int lane) {
  const int r = lane & 15, q = lane >> 4;
  u32x2 w; w.x = pk2(v[0], v[1]); w.y = pk2(v[2], v[3]);
  *(LAS u32x2*)(Xt + (col0 + r) * ld + row0 + 4 * q) = w;
}

__device__ void dn_prep_chunk(const Params& p, LAS unsigned char* lds, int ci, bool load_cw) {
  const int tid = p.tid, lane = tid & 63, w = tid >> 6, r16 = lane & 15, q4 = lane >> 4;
  const int bh = ci >> 6, n = ci & 63, b = bh >> 2, h = bh & 3;
  LAS bf16_t* Kh = (LAS bf16_t*)(lds + DP_KH); LAS bf16_t* Qt = (LAS bf16_t*)(lds + DP_QT);
  LAS bf16_t* KhT = (LAS bf16_t*)(lds + DP_KHT); LAS bf16_t* VT = (LAS bf16_t*)(lds + DP_VT);
  LAS bf16_t* Tu = (LAS bf16_t*)(lds + DP_TU); LAS bf16_t* Tw = (LAS bf16_t*)(lds + DP_TW); LAS float* Lf = (LAS float*)(lds + DP_LF);
  LAS bf16_t* Lb = (LAS bf16_t*)(lds + DP_LB); LAS bf16_t* Tr = (LAS bf16_t*)(lds + DP_TR); LAS bf16_t* Tt = (LAS bf16_t*)(lds + DP_TT); LAS bf16_t* Mt = (LAS bf16_t*)(lds + DP_MT);
  LAS float* gcb = (LAS float*)(lds + DP_GC); LAS float* betab = (LAS float*)(lds + DP_BETA); LAS float* cw = (LAS float*)(lds + DP_CW);
  unsigned char* gA = (unsigned char*)p.dnA + (size_t)ci * DN_ABYTES;
  float* gU = p.dnU + (size_t)ci * DN_UFLOATS;

  if (load_cw) {
    for (int i = tid; i < 4 * 384; i += 512) { const int tap = i / 384, cc = i % 384, part = cc >> 7, d = cc & 127; cw[i] = p.conv_w[tap * 1536 + part * 512 + h * 128 + d]; }
  }
  __syncthreads();
  const int c = tid >> 3, g = tid & 7;
  const int s = n * 64 + c;
  const size_t t = (size_t)b * SEQ + s;
  float qv[16], kv[16], vv[16];
#pragma unroll
  for (int j = 0; j < 16; ++j) { qv[j] = 0.f; kv[j] = 0.f; vv[j] = 0.f; }
#pragma unroll
  for (int tap = 0; tap < 4; ++tap) {
    const int ss = s - 3 + tap;
    if (ss >= 0) {
      const bf16_t* row = p.proj + (t - 3 + tap) * PW + h * 128 + 16 * g;
      float x[8];
#pragma unroll
      for (int part = 0; part < 3; ++part) {
#pragma unroll
        for (int hh = 0; hh < 2; ++hh) {
          unpack8(*(const u32x4*)(row + part * 512 + 8 * hh), x);
#pragma unroll
          for (int j = 0; j < 8; ++j) {
            const float wv = cw[tap * 384 + part * 128 + 16 * g + 8 * hh + j];
            if (part == 0) qv[8 * hh + j] += wv * x[j];
            if (part == 1) kv[8 * hh + j] += wv * x[j];
            if (part == 2) vv[8 * hh + j] += wv * x[j];
          }
        }
      }
    }
    asm volatile("" ::: "memory");
  }
  float sq = 0.f, sk = 0.f;
#pragma unroll
  for (int j = 0; j < 16; ++j) { qv[j] = siluf_(qv[j]); kv[j] = siluf_(kv[j]); vv[j] = siluf_(vv[j]); sq += qv[j] * qv[j]; sk += kv[j] * kv[j]; }
  sq += __shfl_xor(sq, 1, 64); sq += __shfl_xor(sq, 2, 64); sq += __shfl_xor(sq, 4, 64);
  sk += __shfl_xor(sk, 1, 64); sk += __shfl_xor(sk, 2, 64); sk += __shfl_xor(sk, 4, 64);
  const float rq = rsqrtf(sq + 1e-6f) * 0.08838834764831845f, rk = rsqrtf(sk + 1e-6f);
#pragma unroll
  for (int j = 0; j < 16; ++j) { qv[j] *= rq; kv[j] *= rk; }
  if (g == 0) {
    const float bb = p.ba[t * 8 + h], aa = p.ba[t * 8 + 4 + h];
    const float xx = aa + p.dt_bias[h];
    const float sp = xx > 20.f ? xx : log1pf(__expf(xx));
    betab[c] = sigmoidf_(bb);
    gcb[c] = -__expf(p.a_log[h]) * sp;
  }
  {
    u32x4 w0, w1;
    w0.x = pk2(kv[0], kv[1]); w0.y = pk2(kv[2], kv[3]); w0.z = pk2(kv[4], kv[5]); w0.w = pk2(kv[6], kv[7]);
    w1.x = pk2(kv[8], kv[9]); w1.y = pk2(kv[10], kv[11]); w1.z = pk2(kv[12], kv[13]); w1.w = pk2(kv[14], kv[15]);
    *(LAS u32x4*)(Kh + c * 136 + 16 * g) = w0; *(LAS u32x4*)(Kh + c * 136 + 16 * g + 8) = w1;
    w0.x = pk2(qv[0], qv[1]); w0.y = pk2(qv[2], qv[3]); w0.z = pk2(qv[4], qv[5]); w0.w = pk2(qv[6], qv[7]);
    w1.x = pk2(qv[8], qv[9]); w1.y = pk2(qv[10], qv[11]); w1.z = pk2(qv[12], qv[13]); w1.w = pk2(qv[14], qv[15]);
    *(LAS u32x4*)(Qt + c * 136 + 16 * g) = w0; *(LAS u32x4*)(Qt + c * 136 + 16 * g + 8) = w1;
#pragma unroll
    for (int j = 0; j < 16; ++j) { KhT[(16 * g + j) * 72 + c] = f2bf_hw(kv[j]); VT[(16 * g + j) * 72 + c] = f2bf_hw(vv[j]); }
  }
  __syncthreads();
  if (w == 0) {
    float v = gcb[lane];
#pragma unroll
    for (int o = 1; o < 64; o <<= 1) { const float u = __shfl_up(v, o, 64); if (lane >= o) v += u; }
    gcb[lane] = v;
  }
  __syncthreads();
  const float gc_c = gcb[c], gl = gcb[63];
  {
    const float eg = __expf(gc_c);
    unsigned char* fb = gA + (size_t)(F_QD + (c >> 4) * 4 + (g >> 1)) * 1024 + (g & 1) * 8;
#pragma unroll
    for (int qq = 0; qq < 4; ++qq) {
      u32x2 wv; wv.x = pk2(qv[4 * qq] * eg, qv[4 * qq + 1] * eg); wv.y = pk2(qv[4 * qq + 2] * eg, qv[4 * qq + 3] * eg);
      *(u32x2*)(fb + ((c & 15) + 16 * qq) * 16) = wv;
    }
  }
  const int rt = w >> 1, ct0 = 2 * (w & 1);
#pragma unroll
  for (int tt = 0; tt < 2; ++tt) {
    const int ct = ct0 + tt;
    f32x4 gacc = {0.f, 0.f, 0.f, 0.f};
    gacc = prod16<4>(Kh, 136, 16 * rt, Kh, 136, 16 * ct, gacc, lane);
    const int m = 16 * ct + r16; const float gc_m = gcb[m];
    f32x4 lv;
#pragma unroll
    for (int i = 0; i < 4; ++i) {
      const int cc = 16 * rt + 4 * q4 + i;
      lv[i] = (m < cc) ? betab[cc] * gacc[i] * __expf(gcb[cc] - gc_m) : 0.f;
      Lf[cc * 68 + m] = lv[i];
    }
    tile_store_rm(Lb, 72, 16 * rt, 16 * ct, lv, lane);
    f32x4 qacc = {0.f, 0.f, 0.f, 0.f};
    qacc = prod16<4>(Kh, 136, 16 * rt, Qt, 136, 16 * ct, qacc, lane);
    const int cq = 16 * ct + r16; const float gc_cq = gcb[cq];
    float o4[4];
#pragma unroll
    for (int i = 0; i < 4; ++i) { const int mm = 16 * rt + 4 * q4 + i; o4[i] = (mm <= cq) ? qacc[i] * __expf(gc_cq - gcb[mm]) : 0.f; }
    u32x2 wv; wv.x = pk2(o4[0], o4[1]); wv.y = pk2(o4[2], o4[3]);
    *(u32x2*)(gA + (size_t)(F_QK + ct * 2 + (rt >> 1)) * 1024 + (r16 + 16 * q4) * 16 + (rt & 1) * 8) = wv;
  }
  __syncthreads();
  for (int i = tid; i < 2 * 64 * 72 / 8; i += 512) ((LAS u32x4*)Tr)[i] = (u32x4){0u, 0u, 0u, 0u};
  __syncthreads();
  if (w == 0) {
    int lo = lane; asm volatile("" : "+v"(lo));
    const int g = lo >> 4, j = lo & 15;
    unsigned lfb = DP_LF + (16 * g * 68 + 16 * g) * 4; asm volatile("" : "+v"(lfb));
    const LAS float* Lg = (const LAS float*)(lds + lfb);
    float t[16];
#pragma unroll
    for (int r = 0; r < 16; ++r) {
      float a0 = (r == j) ? 1.f : 0.f, a1 = 0.f;
#pragma unroll
      for (int k4 = 0; k4 < (r + 3) / 4; ++k4) {
        const f32x4 l = *(const LAS f32x4*)(Lg + r * 68 + 4 * k4);
        if (4 * k4 + 0 < r) a0 -= l[0] * t[4 * k4 + 0];
        if (4 * k4 + 1 < r) a1 -= l[1] * t[4 * k4 + 1];
        if (4 * k4 + 2 < r) a0 -= l[2] * t[4 * k4 + 2];
        if (4 * k4 + 3 < r) a1 -= l[3] * t[4 * k4 + 3];
      }
      t[r] = a0 + a1;
      Tr[(16 * g + r) * 72 + 16 * g + j] = f2bf_hw(t[r]);
    }
    u32x4 w0, w1;
    w0.x = pk2(t[0], t[1]); w0.y = pk2(t[2], t[3]); w0.z = pk2(t[4], t[5]); w0.w = pk2(t[6], t[7]);
    w1.x = pk2(t[8], t[9]); w1.y = pk2(t[10], t[11]); w1.z = pk2(t[12], t[13]); w1.w = pk2(t[14], t[15]);
    *(LAS u32x4*)(Tt + (16 * g + j) * 72 + 16 * g) = w0; *(LAS u32x4*)(Tt + (16 * g + j) * 72 + 16 * g + 8) = w1;
  }
  __syncthreads();
#pragma unroll 1
  for (int d = 1; d <= 3; ++d) {
    const bool act = w < 4 - d;
    const int I = w + d, J = w;
    LAS bf16_t* Mw = Mt + w * 16 * 24;
    if (act) {
      f32x4 macc = {0.f, 0.f, 0.f, 0.f};
      macc = prod16<2>(Lb, 72, 16 * I, Tt, 72, 16 * J, macc, lane);
      tile_store_tr(Mw, 24, 0, 0, macc, lane);
    }
    __syncthreads();
    if (act) {
      bf16x8 a = {0, 0, 0, 0, 0, 0, 0, 0}, bb = {0, 0, 0, 0, 0, 0, 0, 0};
      if (q4 < 2) { a = *(const LAS bf16x8*)(Tr + (16 * I + r16) * 72 + 16 * I + 8 * q4); bb = *(const LAS bf16x8*)(Mw + r16 * 24 + 8 * q4); }
      f32x4 tacc = {0.f, 0.f, 0.f, 0.f};
      tacc = MFMA16(a, bb, tacc);
#pragma unroll
      for (int i = 0; i < 4; ++i) tacc[i] = -tacc[i];
      tile_store_rm(Tr, 72, 16 * I, 16 * J, tacc, lane);
      tile_store_tr(Tt, 72, 16 * I, 16 * J, tacc, lane);
    }
    __syncthreads();
  }
  {
    const int cc = tid >> 3, m0 = (tid & 7) * 8;
    float tv[8]; unpack8(*(const LAS u32x4*)(Tr + cc * 72 + m0), tv);
    float tu[8], tw[8];
#pragma unroll
    for (int jj = 0; jj < 8; ++jj) { const float bm = betab[m0 + jj]; tu[jj] = tv[jj] * bm; tw[jj] = tu[jj] * __expf(gcb[m0 + jj]); }
    u32x4 wu, ww;
    wu.x = pk2(tu[0], tu[1]); wu.y = pk2(tu[2], tu[3]); wu.z = pk2(tu[4], tu[5]); wu.w = pk2(tu[6], tu[7]);
    ww.x = pk2(tw[0], tw[1]); ww.y = pk2(tw[2], tw[3]); ww.z = pk2(tw[4], tw[5]); ww.w = pk2(tw[6], tw[7]);
    *(LAS u32x4*)(Tu + cc * 72 + m0) = wu; *(LAS u32x4*)(Tw + cc * 72 + m0) = ww;
  }
  __syncthreads();
#pragma unroll
  for (int rr = 0; rr < 4; ++rr) {
    f32x4 u = {0.f, 0.f, 0.f, 0.f};
    u = prod16<2>(Tu, 72, 16 * rr, VT, 72, 16 * w, u, lane);
    *(f32x4*)(gU + ((w * 4 + rr) * 64 + lane) * 4) = u;
    f32x4 wt = {0.f, 0.f, 0.f, 0.f};
    wt = prod16<2>(KhT, 72, 16 * w, Tw, 72, 16 * rr, wt, lane);
    u32x2 wv; wv.x = pk2(-wt[0], -wt[1]); wv.y = pk2(-wt[2], -wt[3]);
    *(u32x2*)(gA + (size_t)(F_WN + rr * 4 + (w >> 1)) * 1024 + (r16 + 16 * q4) * 16 + (w & 1) * 8) = wv;
  }
#pragma unroll
  for (int it = 0; it < 4; ++it) {
    const int idx = tid + it * 512; const int d = idx >> 4, m4 = idx & 15;
    const u32x2 raw = *(const LAS u32x2*)(KhT + d * 72 + 4 * m4);
    const float k0 = __uint_as_float(raw.x << 16), k1 = __uint_as_float(raw.x & 0xffff0000u), k2 = __uint_as_float(raw.y << 16), k3 = __uint_as_float(raw.y & 0xffff0000u);
    const float e0 = __expf(gl - gcb[4 * m4]), e1 = __expf(gl - gcb[4 * m4 + 1]), e2 = __expf(gl - gcb[4 * m4 + 2]), e3 = __expf(gl - gcb[4 * m4 + 3]);
    u32x2 wv; wv.x = pk2(k0 * e0, k1 * e1); wv.y = pk2(k2 * e2, k3 * e3);
    *(u32x2*)(gA + (size_t)(F_KT + (d >> 4) * 2 + (m4 >> 3)) * 1024 + ((d & 15) + 16 * (m4 & 3)) * 16 + ((m4 >> 2) & 1) * 8) = wv;
  }
  if (tid == 0) p.dnG[ci] = __expf(gl);
}

#define DS_A0 0
#define DS_A1 57344
#define DS_TOTAL 114688
__device__ void dn_scan_blk(const Params& p, LAS unsigned char* lds, int item) {
  const int tid = p.tid, lane = tid & 63, w = __builtin_amdgcn_readfirstlane(tid >> 6), r16 = lane & 15, q4 = lane >> 4;
  const int bh = item >> 1, eh = item & 1, b = bh >> 2, h = bh & 3;
  const int et = eh * 4 + (w & 3);
  const bool comp = w < 4;
  const unsigned char* gA = (const unsigned char*)p.dnA + (size_t)bh * 64 * DN_ABYTES;
  const float* gU = p.dnU + (size_t)bh * 64 * DN_UFLOATS;
  const float* gG = p.dnG + bh * 64;
  auto issue_A = [&](int n, int buf) {
#pragma unroll
    for (int i = 0; i < 7; ++i) {
      const int f = w * 7 + i;
      __builtin_amdgcn_global_load_lds((const unsigned*)(gA + (size_t)n * DN_ABYTES + f * 1024 + lane * 16), (LAS unsigned*)(lds + (buf ? DS_A1 : DS_A0) + f * 1024), 16, 0, 0);
    }
  };
  __syncthreads();
  issue_A(0, 0);
  f32x4 Un[4];
#pragma unroll
  for (int rr = 0; rr < 4; ++rr) Un[rr] = *(const f32x4*)(gU + ((et * 4 + rr) * 64 + lane) * 4);
  f32x4 S[8];
#pragma unroll
  for (int dt = 0; dt < 8; ++dt) S[dt] = (f32x4){0.f, 0.f, 0.f, 0.f};
  asm volatile("s_waitcnt vmcnt(0)" ::: "memory");
  __syncthreads();
  bf16_t* obase = p.dn_out + ((size_t)b * SEQ) * p.dn_out_ld + h * 128 + 16 * et + r16;
  f32x4 Op[4];
#pragma unroll
  for (int rr = 0; rr < 4; ++rr) Op[rr] = (f32x4){0.f, 0.f, 0.f, 0.f};
  float gnext = gG[0];
#pragma unroll 1
  for (int n = 0; n < 64; ++n) {
    const LAS unsigned char* Ab = lds + ((n & 1) ? DS_A1 : DS_A0);
    if (n + 1 < 64) issue_A(n + 1, (n + 1) & 1);
    if (comp) {
      if (n > 0) {
#pragma unroll
        for (int rr = 0; rr < 4; ++rr)
#pragma unroll
          for (int i = 0; i < 4; ++i) obase[(size_t)((n - 1) * 64 + 16 * rr + 4 * q4 + i) * p.dn_out_ld] = f2bf_hw(Op[rr][i]);
      }
      f32x4 Vn[4];
#pragma unroll
      for (int rr = 0; rr < 4; ++rr) Vn[rr] = Un[rr];
      if (n + 1 < 64) {
#pragma unroll
        for (int rr = 0; rr < 4; ++rr) Un[rr] = *(const f32x4*)(gU + (size_t)(n + 1) * DN_UFLOATS + ((et * 4 + rr) * 64 + lane) * 4);
      }
      const float gdec = gnext;
      if (n + 1 < 64) gnext = gG[n + 1];
      bf16x8 Sb[4];
#pragma unroll
      for (int ks = 0; ks < 4; ++ks) Sb[ks] = pack8(S[2 * ks][0], S[2 * ks][1], S[2 * ks][2], S[2 * ks][3], S[2 * ks + 1][0], S[2 * ks + 1][1], S[2 * ks + 1][2], S[2 * ks + 1][3]);
#pragma unroll
      for (int dt = 0; dt < 8; ++dt) S[dt] *= gdec;
#define LDF(idx) (*(const LAS bf16x8*)(Ab + (idx) * 1024 + lane * 16))
#define SBAR __builtin_amdgcn_sched_barrier(0)
      bf16x8 fa[8], fb[8];
      f32x4 O[4];
#pragma unroll
      for (int rr = 0; rr < 4; ++rr) O[rr] = (f32x4){0.f, 0.f, 0.f, 0.f};
#pragma unroll
      for (int i = 0; i < 4; ++i) { fa[i] = LDF(F_WN + i); fa[4 + i] = LDF(F_QD + i); }
      SBAR;
#pragma unroll
      for (int i = 0; i < 4; ++i) { fb[i] = LDF(F_WN + 4 + i); fb[4 + i] = LDF(F_QD + 4 + i); }
      SBAR;
#pragma unroll
      for (int ks = 0; ks < 4; ++ks) { Vn[0] = MFMA16(fa[ks], Sb[ks], Vn[0]); O[0] = MFMA16(fa[4 + ks], Sb[ks], O[0]); }
      SBAR;
#pragma unroll
      for (int i = 0; i < 4; ++i) { fa[i] = LDF(F_WN + 8 + i); fa[4 + i] = LDF(F_QD + 8 + i); }
      SBAR;
#pragma unroll
      for (int ks = 0; ks < 4; ++ks) { Vn[1] = MFMA16(fb[ks], Sb[ks], Vn[1]); O[1] = MFMA16(fb[4 + ks], Sb[ks], O[1]); }
      SBAR;
#pragma unroll
      for (int i = 0; i < 4; ++i) { fb[i] = LDF(F_WN + 12 + i); fb[4 + i] = LDF(F_QD + 12 + i); }
      SBAR;
#pragma unroll
      for (int ks = 0; ks < 4; ++ks) { Vn[2] = MFMA16(fa[ks], Sb[ks], Vn[2]); O[2] = MFMA16(fa[4 + ks], Sb[ks], O[2]); }
      SBAR;
#pragma unroll
      for (int i = 0; i < 8; ++i) fa[i] = LDF(F_QK + i);
      SBAR;
#pragma unroll
      for (int ks = 0; ks < 4; ++ks) { Vn[3] = MFMA16(fb[ks], Sb[ks], Vn[3]); O[3] = MFMA16(fb[4 + ks], Sb[ks], O[3]); }
      SBAR;
#pragma unroll
      for (int i = 0; i < 8; ++i) fb[i] = LDF(F_KT + i);
      SBAR;
      bf16x8 Vb[2];
#pragma unroll
      for (int ks = 0; ks < 2; ++ks) Vb[ks] = pack8(Vn[2 * ks][0], Vn[2 * ks][1], Vn[2 * ks][2], Vn[2 * ks][3], Vn[2 * ks + 1][0], Vn[2 * ks + 1][1], Vn[2 * ks + 1][2], Vn[2 * ks + 1][3]);
#pragma unroll
      for (int ks = 0; ks < 2; ++ks)
#pragma unroll
        for (int rr = 0; rr < 4; ++rr) O[rr] = MFMA16(fa[rr * 2 + ks], Vb[ks], O[rr]);
      SBAR;
#pragma unroll
      for (int i = 0; i < 8; ++i) fa[i] = LDF(F_KT + 8 + i);
      SBAR;
#pragma unroll
      for (int ks = 0; ks < 2; ++ks)
#pragma unroll
        for (int dt = 0; dt < 4; ++dt) S[dt] = MFMA16(fb[dt * 2 + ks], Vb[ks], S[dt]);
      SBAR;
#pragma unroll
      for (int ks = 0; ks < 2; ++ks)
#pragma unroll
        for (int dt = 0; dt < 4; ++dt) S[4 + dt] = MFMA16(fa[dt * 2 + ks], Vb[ks], S[4 + dt]);
#pragma unroll
      for (int rr = 0; rr < 4; ++rr) Op[rr] = O[rr];
#undef LDF
#undef SBAR
    }
    asm volatile("s_waitcnt vmcnt(0)" ::: "memory");
    __syncthreads();
  }
  if (comp) {
#pragma unroll
    for (int rr = 0; rr < 4; ++rr)
#pragma unroll
      for (int i = 0; i < 4; ++i) obase[(size_t)(63 * 64 + 16 * rr + 4 * q4 + i) * p.dn_out_ld] = f2bf_hw(Op[rr][i]);
  }
}
__device__ void ph_dn_norm(const Params& p, int nblk, int bid) {
  const int wid = p.tid >> 6, lane = p.tid & 63;
  const f32x4 g0 = *(const f32x4*)(p.g_dn_out + (lane & 15) * 8), g1 = *(const f32x4*)(p.g_dn_out + (lane & 15) * 8 + 4);
  for (int t = bid * 8 + wid; t < T_TOK; t += nblk * 8) {
    bf16_t* op = p.oab + (size_t)t * DM + lane * 8;
    float o[8], z[8];
    unpack8(*(const u32x4*)op, o);
    unpack8(*(const u32x4*)(p.proj + (size_t)t * PW + C_Z + lane * 8), z);
    float ss = 0.f;
#pragma unroll
    for (int j = 0; j < 8; ++j) ss += o[j] * o[j];
    ss += __shfl_xor(ss, 1, 64); ss += __shfl_xor(ss, 2, 64); ss += __shfl_xor(ss, 4, 64); ss += __shfl_xor(ss, 8, 64);
    const float rstd = rsqrtf(ss * (1.f / 128.f) + 1e-6f);
    float y[8];
#pragma unroll
    for (int j = 0; j < 4; ++j) { y[j] = o[j] * rstd * g0[j] * siluf_(z[j]); y[4 + j] = o[4 + j] * rstd * g1[j] * siluf_(z[4 + j]); }
    u32x4 w; w.x = pk2(y[0], y[1]); w.y = pk2(y[2], y[3]); w.z = pk2(y[4], y[5]); w.w = pk2(y[6], y[7]);
    *(u32x4*)op = w;
  }
}
typedef float f32x16 __attribute__((ext_vector_type(16)));
#define MFMA32(a, b, c) __builtin_amdgcn_mfma_f32_32x32x16_bf16((a), (b), (c), 0, 0, 0)
#define MP_VL 0
#define MP_RED 65536
#define MP_TOTAL (65536 + 4096)

__device__ void moba_prep_block(const Params& p, LAS unsigned char* lds, int item) {
  const int tid = p.tid, lane = tid & 63, w = tid >> 6;
  const int bh = item >> 4, jb = item & 15, b = bh >> 2, h = bh & 3;
  LAS bf16_t* Vl = (LAS bf16_t*)(lds + MP_VL);
  LAS float* red = (LAS float*)(lds + MP_RED);
  __syncthreads();
#pragma unroll
  for (int it = 0; it < 8; ++it) {
    const int idx = tid + 512 * it, row = idx >> 4, ch = idx & 15;
    const u32x4 v = *(const u32x4*)(p.proj + ((size_t)b * SEQ + 256 * jb + row) * PW + C_MV + h * 128 + 8 * ch);
    *(LAS u32x4*)(Vl + row * 128 + 8 * ch) = v;
  }
  {
    const int r = tid >> 1, hh = tid & 1;
    const int pos = 256 * jb + r;
    const size_t t = (size_t)b * SEQ + pos;
    float cs[8], sn[8];
#pragma unroll
    for (int jj = 0; jj < 8; ++jj) {
      const float inv = exp2f(-(float)(8 * hh + jj) * (1.f / 16.f) * 18.931568569324174f);
      const float ang = (float)pos * inv;
      cs[jj] = cosf(ang); sn[jj] = sinf(ang);
    }
    float kacc[64];
#pragma unroll
    for (int which = 0; which < 2; ++which) {
      const bf16_t* src = p.proj + t * PW + (which ? C_MQ : C_MK) + h * 128 + 8 * hh;
      float x0[8], x1[8];
      unpack8(*(const u32x4*)(src), x0); unpack8(*(const u32x4*)(src + 16), x1);
      float y0[8], y1[8];
#pragma unroll
      for (int jj = 0; jj < 8; ++jj) { y0[jj] = x0[jj] * cs[jj] - x1[jj] * sn[jj]; y1[jj] = x1[jj] * cs[jj] + x0[jj] * sn[jj]; }
      u32x4 o[8];
      o[0].x = pk2(y0[0], y0[1]); o[0].y = pk2(y0[2], y0[3]); o[0].z = pk2(y0[4], y0[5]); o[0].w = pk2(y0[6], y0[7]);
      o[1].x = pk2(y1[0], y1[1]); o[1].y = pk2(y1[2], y1[3]); o[1].z = pk2(y1[4], y1[5]); o[1].w = pk2(y1[6], y1[7]);
#pragma unroll
      for (int ks = 2; ks < 8; ++ks) o[ks] = *(const u32x4*)(src + 16 * ks);
      if (which == 0) {
#pragma unroll
        for (int jj = 0; jj < 8; ++jj) { kacc[jj] = y0[jj]; kacc[8 + jj] = y1[jj]; }
#pragma unroll
        for (int ks = 2; ks < 8; ++ks) { float f[8]; unpack8(o[ks], f);
#pragma unroll
          for (int jj = 0; jj < 8; ++jj) kacc[8 * ks + jj] = f[jj]; }
        unsigned char* dst = (unsigned char*)p.Kp + ((size_t)(bh * 128 + 8 * jb + (r >> 5)) * 8192) + ((r & 31) + 32 * hh) * 16;
#pragma unroll
        for (int ks = 0; ks < 8; ++ks) *(u32x4*)(dst + ks * 1024) = o[ks];
      } else {
        bf16_t* dst = p.qb + ((size_t)bh * SEQ + pos) * 128 + 8 * hh;
#pragma unroll
        for (int ks = 0; ks < 8; ++ks) *(u32x4*)(dst + 16 * ks) = o[ks];
      }
    }
#pragma unroll
    for (int e = 0; e < 64; ++e) {
      float v = kacc[e];
      v += __shfl_xor(v, 2, 64); v += __shfl_xor(v, 4, 64); v += __shfl_xor(v, 8, 64); v += __shfl_xor(v, 16, 64); v += __shfl_xor(v, 32, 64);
      kacc[e] = v;
    }
    if (lane < 2) {
#pragma unroll
      for (int e = 0; e < 64; ++e) red[(w * 2 + lane) * 64 + e] = kacc[e];
    }
  }
  __syncthreads();
  if (tid < 128) {
    const int d = tid, hh = (d >> 3) & 1, ks = d >> 4, jj = d & 7;
    float a = 0.f;
#pragma unroll
    for (int ww = 0; ww < 8; ++ww) a += red[(ww * 2 + hh) * 64 + ks * 8 + jj];
    p.kmean[((size_t)bh * 16 + jb) * 128 + d] = a * (1.f / 256.f);
  }
#pragma unroll
  for (int it = 0; it < 8; ++it) {
    const int o = tid + 512 * it, ln = o & 63, frag = o >> 6, tl = frag >> 3, dt = (frag >> 1) & 3, s = frag & 1;
    const int r = ln & 31, hh = ln >> 5, d = 32 * dt + r;
    unsigned short e[8];
#pragma unroll
    for (int jj = 0; jj < 8; ++jj) { const int key = 32 * tl + 16 * s + 8 * (jj >> 2) + 4 * hh + (jj & 3); e[jj] = Vl[key * 128 + d]; }
    u32x4 wv; wv.x = e[0] | ((unsigned)e[1] << 16); wv.y = e[2] | ((unsigned)e[3] << 16); wv.z = e[4] | ((unsigned)e[5] << 16); wv.w = e[6] | ((unsigned)e[7] << 16);
    *(u32x4*)((unsigned char*)p.Vp + ((size_t)(bh * 128 + 8 * jb + tl) * 8192) + (dt * 2 + s) * 1024 + ln * 16) = wv;
  }
}
__device__ __forceinline__ int crow32(int reg, int hh) { return (reg & 3) + 8 * (reg >> 2) + 4 * hh; }
__device__ void moba_item(const Params& p, LAS float* km, LAS float* mrg, LAS float* ml, int bh, int ib, int sub, int par, int lane, int rep) {
  const int q = lane & 31, hh = lane >> 5;
  const int b = bh >> 2, h = bh & 3;
  const int s0 = 256 * ib + 32 * sub;
  const bf16_t* qrow = p.qb + ((size_t)bh * SEQ + s0 + q) * 128 + 8 * hh;
  bf16x8 Qf[8];
#pragma unroll
  for (int ks = 0; ks < 8; ++ks) Qf[ks] = *(const bf16x8*)(qrow + 16 * ks);
  LAS unsigned char* qlds = (LAS unsigned char*)km + 8192 + lane * 16;
#pragma unroll
  for (int ks = 0; ks < 8; ++ks) *(LAS bf16x8*)(qlds + ks * 1024) = Qf[ks];
  unsigned selmask = 0;
  if (ib > 0) {
    for (int idx = lane; idx < ib * 32; idx += 64) ((LAS f32x4*)km)[idx] = ((const f32x4*)(p.kmean + (size_t)bh * 16 * 128))[idx];
    float qf[64];
#pragma unroll
    for (int ks = 0; ks < 8; ++ks) { float f[8]; unpack8(__builtin_bit_cast(u32x4, Qf[ks]), f);
#pragma unroll
      for (int jj = 0; jj < 8; ++jj) qf[8 * ks + jj] = f[jj]; }
    float sc[16];
#pragma unroll
    for (int j = 0; j < 16; ++j) {
      sc[j] = -INFINITY;
      if (j < ib) {
        float a = 0.f;
#pragma unroll
        for (int ks = 0; ks < 8; ++ks) {
          const f32x4 k0 = *(const LAS f32x4*)(km + j * 128 + 16 * ks + 8 * hh), k1 = *(const LAS f32x4*)(km + j * 128 + 16 * ks + 8 * hh + 4);
          a += qf[8 * ks] * k0[0] + qf[8 * ks + 1] * k0[1] + qf[8 * ks + 2] * k0[2] + qf[8 * ks + 3] * k0[3];
          a += qf[8 * ks + 4] * k1[0] + qf[8 * ks + 5] * k1[1] + qf[8 * ks + 6] * k1[2] + qf[8 * ks + 7] * k1[3];
        }
        a += __shfl_xor(a, 32, 64);
        sc[j] = a;
      }
    }
#pragma unroll
    for (int r = 0; r < 3; ++r) {
      if (r < ib) {
        float best = -INFINITY; int bi = 0;
#pragma unroll
        for (int j = 0; j < 16; ++j) if (sc[j] > best) { best = sc[j]; bi = j; }
        selmask |= 1u << bi;
#pragma unroll
        for (int j = 0; j < 16; ++j) if (j == bi) sc[j] = -INFINITY;
      }
    }
  }
  unsigned rem = 0;
  for (int j = 0; j < ib; ++j) if (__ballot((selmask >> j) & 1u) != 0ull) rem |= 1u << j;
  rem = __builtin_amdgcn_readfirstlane(rem);
  const int own0 = 8 * ib, diag = 8 * ib + sub;
  const float cscale = 0.08838834764831845f * 1.4426950408889634f;
  float m = -1e30f, l = 0.f;
  f32x16 O[4];
#pragma unroll
  for (int dt = 0; dt < 4; ++dt)
#pragma unroll
    for (int r = 0; r < 16; ++r) O[dt][r] = 0.f;
  const unsigned char* kbase = (const unsigned char*)p.Kp + (size_t)bh * 128 * 8192 + lane * 16;
  const unsigned char* vbase = (const unsigned char*)p.Vp + (size_t)bh * 128 * 8192 + lane * 16;
  auto adv = [&](int& kt_, unsigned& rem_) {
    if (kt_ < 0) return;
    if (kt_ >= own0 ? (kt_ < diag) : ((kt_ & 7) != 7)) { kt_ = kt_ + 1; return; }
    if (rem_ == 0u) { kt_ = -1; return; }
    kt_ = 8 * (__builtin_ctz(rem_)); rem_ &= rem_ - 1u;
  };
  int kt = own0;
  if (par) adv(kt, rem);
  auto load_k = [&](int t, bf16x8 (&K_)[8]) {
#pragma unroll
    for (int ks = 0; ks < 8; ++ks) K_[ks] = *(const bf16x8*)(kbase + (size_t)t * 8192 + ks * 1024);
  };
  auto tile_step = [&](bf16x8 (&Kc)[8], bf16x8 (&Kn)[8]) -> bool {
    int ktn = kt; unsigned remn = rem;
    adv(ktn, remn); adv(ktn, remn);
    bf16x8 Vf[8];
#pragma unroll
    for (int f = 0; f < 8; ++f) Vf[f] = *(const bf16x8*)(vbase + (size_t)kt * 8192 + f * 1024);
    if (ktn >= 0) load_k(ktn, Kn);
    f32x16 S;
#pragma unroll
    for (int r = 0; r < 16; ++r) S[r] = 0.f;
#pragma unroll
    for (int ks = 0; ks < 8; ++ks) S = MFMA32(Kc[ks], *(const LAS bf16x8*)(qlds + ks * 1024), S);
    const bool allowed = (kt >= own0) || ((selmask >> (kt >> 3)) & 1u);
    const float nb = allowed ? 0.f : -INFINITY;
    float sv[16]; float mx = -INFINITY;
#pragma unroll
    for (int r = 0; r < 16; ++r) sv[r] = __builtin_fmaf(S[r], cscale, nb);
    if (kt == diag) {
#pragma unroll
      for (int r = 0; r < 16; ++r) if (crow32(r, hh) > q) sv[r] = -INFINITY;
    }
#pragma unroll
    for (int r = 0; r < 16; ++r) mx = fmaxf(mx, sv[r]);
    mx = fmaxf(mx, __shfl_xor(mx, 32, 64));
    const bool grow = mx > m + 8.f;
    const float mn = (__ballot(grow) != 0ull) ? fmaxf(m, mx) : m;
    const float alpha = __builtin_amdgcn_exp2f(m - mn);
    float ps = 0.f;
#pragma unroll
    for (int r = 0; r < 16; ++r) { sv[r] = __builtin_amdgcn_exp2f(sv[r] - mn); ps += sv[r]; }
    l = l * alpha + ps; m = mn;
    if (__ballot(alpha != 1.f) != 0ull) {
#pragma unroll
      for (int dt = 0; dt < 4; ++dt)
#pragma unroll
        for (int r = 0; r < 16; ++r) O[dt][r] *= alpha;
    }
    const bf16x8 P0 = pack8(sv[0], sv[1], sv[2], sv[3], sv[4], sv[5], sv[6], sv[7]);
    const bf16x8 P1 = pack8(sv[8], sv[9], sv[10], sv[11], sv[12], sv[13], sv[14], sv[15]);
#pragma unroll
    for (int dt = 0; dt < 4; ++dt) { O[dt] = MFMA32(Vf[dt * 2], P0, O[dt]); O[dt] = MFMA32(Vf[dt * 2 + 1], P1, O[dt]); }
    kt = ktn; rem = remn;
    return kt >= 0;
  };
  if (kt >= 0) {
    bf16x8 KA[8], KB[8];
    load_k(kt, KA);
#pragma unroll 1
    for (;;) {
      if (!tile_step(KA, KB)) break;
      asm volatile("" ::: "memory");
      if (!tile_step(KB, KA)) break;
      asm volatile("" ::: "memory");
    }
  }
  asm volatile("s_waitcnt vmcnt(0) lgkmcnt(0)" ::: "memory");
  if (par) {
    ml[lane] = m; ml[64 + lane] = l;
#pragma unroll
    for (int dt = 0; dt < 4; ++dt)
#pragma unroll
      for (int r = 0; r < 16; ++r) mrg[(dt * 16 + r) * 64 + lane] = O[dt][r];
  }
  __syncthreads();
  if (par == 0) {
    const float m2 = ml[lane], l2 = ml[64 + lane];
    const float mm = fmaxf(m, m2);
    const float a1 = __builtin_amdgcn_exp2f(m - mm), a2 = __builtin_amdgcn_exp2f(m2 - mm);
    l = l * a1 + l2 * a2;
#pragma unroll
    for (int dt = 0; dt < 4; ++dt)
#pragma unroll
      for (int r = 0; r < 16; ++r) O[dt][r] = O[dt][r] * a1 + mrg[(dt * 16 + r) * 64 + lane] * a2;
  }
  if (par == 0) {
  l += __shfl_xor(l, 32, 64);
  const float inv = 1.f / l;
  bf16_t* orow = rep ? p.oab2 + ((size_t)b * SEQ + s0 + q) * 512 + h * 128 : p.mb_out + ((size_t)b * SEQ + s0 + q) * p.mb_out_ld + p.mb_out_off + h * 128;
#pragma unroll
  for (int dt = 0; dt < 4; ++dt)
#pragma unroll
    for (int g4 = 0; g4 < 4; ++g4) {
      u32x2 wv; wv.x = pk2(O[dt][4 * g4] * inv, O[dt][4 * g4 + 1] * inv); wv.y = pk2(O[dt][4 * g4 + 2] * inv, O[dt][4 * g4 + 3] * inv);
      *(u32x2*)(orow + 32 * dt + 8 * g4 + 4 * hh) = wv;
    }
  }
  __syncthreads();
}
__device__ void moba_worker(const Params& p, LAS unsigned char* lds, int qi) {
  const int lane = p.tid & 63, w = __builtin_amdgcn_readfirstlane(p.tid >> 6);
  LAS float* km = (LAS float*)(lds + w * 16384);
  LAS float* mrg = (LAS float*)(lds + ((w & 3) + 4) * 16384);
  LAS float* ml = (LAS float*)(lds + 131072) + (w & 3) * 128;
  LAS int* slot = (LAS int*)(lds + 131072 + 2048);
  const int g0 = (int)((unsigned)__builtin_amdgcn_s_getreg((3 << 11) | 20) & 7u);
  for (int gi = 0; gi < 8; ++gi) {
    const int g = (g0 + gi) & 7;
    for (;;) {
      __syncthreads();
      if (p.tid == 0) slot[0] = atomicAdd(p.wq + qi * 8 + g, 1);
      __syncthreads();
      const int idx = slot[0];
      if (idx >= 64) break;
      const int bh = 2 * g + (idx >> 5), ib = 15 - ((idx >> 1) & 15), quad = 1 - (idx & 1);
      moba_item(p, km, mrg, ml, bh, ib, 4 * quad + (w & 3), w >> 2, lane, qi);
    }
  }
}
__device__ void ph_mod(const Params& p, LAS unsigned char* lds, int nblk, int bid) {
  LAS float* sc = (LAS float*)lds;
  LAS float* part = (LAS float*)(lds + 16384);
  const int tid = p.tid;
  if (bid >= 192) return;
  for (int i = tid; i < 4096; i += 512) sc[i] = siluf_(p.c[i]);
  __syncthreads();
  for (int task = bid; task < 192; task += nblk) {
    const int jj = tid & 31, ks = tid >> 5, j = task * 32 + jj;
    float a0 = 0.f, a1 = 0.f, a2 = 0.f, a3 = 0.f;
#pragma unroll 8
    for (int kk = 0; kk < 64; ++kk) {
      const int k = ks * 64 + kk;
      const float w = p.w_ada[(size_t)k * 6144 + j];
      a0 += sc[k] * w; a1 += sc[1024 + k] * w; a2 += sc[2048 + k] * w; a3 += sc[3072 + k] * w;
    }
    *(LAS f32x4*)(part + (ks * 32 + jj) * 4) = (f32x4){a0, a1, a2, a3};
    __syncthreads();
    if (tid < 128) {
      const int j2 = tid & 31, bb = tid >> 5;
      float a = 0.f;
#pragma unroll
      for (int s = 0; s < 16; ++s) a += part[(s * 32 + j2) * 4 + bb];
      p.mod[bb * 6144 + task * 32 + j2] = a + p.b_ada[task * 32 + j2];
    }
    __syncthreads();
  }
}

#define WT_T0 1424
#define WT_T1 (WT_T0 + 16384)
#define WT_T2 (WT_T1 + 8192)
#define WT_T3 (WT_T2 + 128)
#define WT_T4 (WT_T3 + 128)
#define WT_T5 (WT_T4 + 256)
struct WtTile { const float* src; bf16_t* dst; int K, N, mode, k0, n0; unsigned char* dst8; };
__device__ __forceinline__ WtTile wt_desc(const Params& p, int t) {
  WtTile d;
  if (t < WT_T0) { const int kt = t / 89, nt = t % 89; d = {p.w_in, p.w_in_t, 1024, INW, 1, kt * 64, nt * 64, nullptr}; }
  else if (t < WT_T1) { const int u = t - WT_T0, e = u >> 9, r = u & 511, kt = r >> 5, nt = r & 31; d = {p.w_gu + (size_t)e * 1024 * 2048, nullptr, 1024, 2048, 2, kt * 64, nt * 64, p.wgu8 + (size_t)e * 2048 * 1024}; }
  else if (t < WT_T2) { const int u = t - WT_T1, e = u >> 8, r = u & 255, kt = r >> 4, nt = r & 15; d = {p.w_down + (size_t)e * 1024 * 1024, nullptr, 1024, 1024, 0, kt * 64, nt * 64, p.wd8 + (size_t)e * 1024 * 1024}; }
  else if (t < WT_T3) { const int u = t - WT_T2, kt = u >> 4, nt = u & 15; d = {p.w_br_a, p.wbra_t, 512, 1024, 0, kt * 64, nt * 64, nullptr}; }
  else if (t < WT_T4) { const int u = t - WT_T3, kt = u >> 4, nt = u & 15; d = {p.w_br_b, p.wbrb_t, 512, 1024, 0, kt * 64, nt * 64, nullptr}; }
  else { const int u = t - WT_T4, kt = u >> 4, nt = u & 15; d = {p.w_o, p.wo_t, 1024, 1024, 0, kt * 64, nt * 64, nullptr}; }
  return d;
}
__device__ __forceinline__ void wt_load(const WtTile& d, int tid, f32x4 (&v)[2]) {
#pragma unroll
  for (int it = 0; it < 2; ++it) {
    const int row = (tid >> 4) + 32 * it, n = d.n0 + (tid & 15) * 4;
    v[it] = (f32x4){0.f, 0.f, 0.f, 0.f};
    if (n < d.N) v[it] = __builtin_nontemporal_load((const f32x4*)(d.src + (size_t)(d.k0 + row) * d.N + n));
  }
}
__device__ void ph_wt(const Params& p, LAS unsigned char* lds, int nblk, int bid) {
  LAS float* tile = (LAS float*)(lds + 32768);
  const int tid = p.tid;
  int t = bid;
  if (t >= WT_T5) return;
  WtTile cur = wt_desc(p, t);
  f32x4 v[2]; wt_load(cur, tid, v);
  WtTile nxt = cur; f32x4 vn[2] = {v[0], v[1]};
  if (t + nblk < WT_T5) { nxt = wt_desc(p, t + nblk); wt_load(nxt, tid, vn); }
  for (;;) {
    const int tnn = t + 2 * nblk;
    WtTile nn = nxt; f32x4 vnn[2] = {vn[0], vn[1]};
    if (tnn < WT_T5) { nn = wt_desc(p, tnn); wt_load(nn, tid, vnn); }
#pragma unroll
    for (int it = 0; it < 2; ++it) {
      const int row = (tid >> 4) + 32 * it, c4 = (tid & 15) * 4;
      tile[row * 65 + c4] = v[it][0]; tile[row * 65 + c4 + 1] = v[it][1]; tile[row * 65 + c4 + 2] = v[it][2]; tile[row * 65 + c4 + 3] = v[it][3];
    }
    __syncthreads();
    {
      const int nl = tid >> 3, kc = tid & 7, n = cur.n0 + nl;
      if (n < cur.N) {
        const int dd = map_col(n, cur.mode);
        if (dd >= 0) {
          float f[8];
#pragma unroll
          for (int j = 0; j < 8; ++j) f[j] = tile[(8 * kc + j) * 65 + nl];
          if (cur.dst8) {
            u32x2 w; w.x = pk4_fp8(f[0] * 64.f, f[1] * 64.f, f[2] * 64.f, f[3] * 64.f); w.y = pk4_fp8(f[4] * 64.f, f[5] * 64.f, f[6] * 64.f, f[7] * 64.f);
            *(u32x2*)(cur.dst8 + (size_t)dd * cur.K + cur.k0 + 8 * kc) = w;
          } else {
            u32x4 w; w.x = pk2(f[0], f[1]); w.y = pk2(f[2], f[3]); w.z = pk2(f[4], f[5]); w.w = pk2(f[6], f[7]);
            *(u32x4*)(cur.dst + (size_t)dd * cur.K + cur.k0 + 8 * kc) = w;
          }
        }
      }
    }
    __syncthreads();
    if (t + nblk >= WT_T5) break;
    t += nblk; cur = nxt; v[0] = vn[0]; v[1] = vn[1]; nxt = nn; vn[0] = vnn[0]; vn[1] = vnn[1];
  }
}

__device__ void ph_h(const Params& p, LAS unsigned char* lds, int nblk, int bid) {
  const int wid = p.tid >> 6, lane = p.tid & 63;
  LAS float* wb = (LAS float*)lds;
  for (int i = p.tid; i < 2048; i += 512) {
    const int k = i >> 1, hf = i & 1;
    const f32x4 v = *(const f32x4*)(p.w_in + (size_t)k * INW + 2048 + 4 * hf);
    wb[(4 * hf + 0) * 1024 + k] = v[0]; wb[(4 * hf + 1) * 1024 + k] = v[1]; wb[(4 * hf + 2) * 1024 + k] = v[2]; wb[(4 * hf + 3) * 1024 + k] = v[3];
  }
  __syncthreads();
  for (int t = bid * 8 + wid; t < T_TOK; t += nblk * 8) {
    const int b = t / SEQ;
    const float* xr = p.x + (size_t)t * DM;
    f32x4 xv[4];
    float ss = 0.f;
#pragma unroll
    for (int i = 0; i < 4; ++i) {
      xv[i] = *(const f32x4*)(xr + i * 256 + lane * 4);
      ss += xv[i][0] * xv[i][0] + xv[i][1] * xv[i][1] + xv[i][2] * xv[i][2] + xv[i][3] * xv[i][3];
    }
    ss = wave_sum(ss);
    const float rstd = rsqrtf(ss * (1.f / DM) + 1e-6f);
    const float* shift = p.mod + b * 6144;
    const float* scale = p.mod + b * 6144 + 1024;
    float acc[8] = {0, 0, 0, 0, 0, 0, 0, 0};
#pragma unroll
    for (int i = 0; i < 4; ++i) {
      const int k = i * 256 + lane * 4;
      const f32x4 g = *(const f32x4*)(p.g_pre_mix + k), sc = *(const f32x4*)(scale + k), sh = *(const f32x4*)(shift + k);
      f32x4 hv;
#pragma unroll
      for (int j = 0; j < 4; ++j) hv[j] = xv[i][j] * rstd * g[j] * (1.f + sc[j]) + sh[j];
#pragma unroll
      for (int e = 0; e < 8; ++e) { const f32x4 w = *(const LAS f32x4*)(wb + e * 1024 + k); acc[e] += hv[0] * w[0] + hv[1] * w[1] + hv[2] * w[2] + hv[3] * w[3]; }
      u32x2 pk; pk.x = pk2(hv[0], hv[1]); pk.y = pk2(hv[2], hv[3]);
      *(u32x2*)(p.hbf + (size_t)t * DM + k) = pk;
    }
#pragma unroll
    for (int e = 0; e < 8; ++e) acc[e] = wave_sum(acc[e]);
    if (lane == 0) { *(f32x4*)(p.ba + (size_t)t * 8) = (f32x4){acc[0], acc[1], acc[2], acc[3]}; *(f32x4*)(p.ba + (size_t)t * 8 + 4) = (f32x4){acc[4], acc[5], acc[6], acc[7]}; }
  }
}

__device__ void ph_post_mix(const Params& p, LAS unsigned char* lds, int nblk, int bid, int rep) {
  const int wid = p.tid >> 6, lane = p.tid & 63;
  LAS bf16_t* wl = (LAS bf16_t*)lds;
  LAS float* sh = (LAS float*)(lds + 81920) + wid * 1024;
  LAS int* lcnt = (LAS int*)(lds + 114688);
  LAS int* lbase = lcnt + 32;
  LAS int* lent = (LAS int*)(lds + 115200) + wid * 256;
  int nloc = 0;
  if (p.tid < 32) lcnt[p.tid] = 0;
  for (int i = p.tid; i < 1024 * 8; i += 512) {
    const int k = i >> 3, c = i & 7;
    const f32x4 v = *(const f32x4*)(p.w_router + (size_t)k * 32 + c * 4);
    u32x2 w2; w2.x = pk2(v[0], v[1]); w2.y = pk2(v[2], v[3]);
    *(LAS u32x2*)(wl + k * 40 + c * 4) = w2;
  }
  __syncthreads();
  u32x4 mxn[2]; f32x4 xn[4];
  {
    const int t0 = bid * 8 + wid;
    if (t0 < T_TOK) {
#pragma unroll
      for (int i = 0; i < 2; ++i) mxn[i] = *(const u32x4*)(p.mixer + (size_t)t0 * DM + i * 512 + lane * 8);
#pragma unroll
      for (int i = 0; i < 4; ++i) xn[i] = *(const f32x4*)(p.x + (size_t)t0 * DM + (i >> 1) * 512 + lane * 8 + (i & 1) * 4);
    }
  }
  for (int t = bid * 8 + wid; t < T_TOK; t += nblk * 8) {
    const int b = t / SEQ;
    const float* md = p.mod + b * 6144;
    u32x4 mxc[2] = {mxn[0], mxn[1]}; f32x4 xc[4] = {xn[0], xn[1], xn[2], xn[3]};
    {
      const int tn = t + nblk * 8;
      if (tn < T_TOK) {
#pragma unroll
        for (int i = 0; i < 2; ++i) mxn[i] = *(const u32x4*)(p.mixer + (size_t)tn * DM + i * 512 + lane * 8);
#pragma unroll
        for (int i = 0; i < 4; ++i) xn[i] = *(const f32x4*)(p.x + (size_t)tn * DM + (i >> 1) * 512 + lane * 8 + (i & 1) * 4);
      }
    }
    float mv[16];
    float ss = 0.f;
#pragma unroll
    for (int i = 0; i < 2; ++i) {
      float f[8]; unpack8(mxc[i], f);
#pragma unroll
      for (int j = 0; j < 8; ++j) { mv[i * 8 + j] = f[j]; ss += f[j] * f[j]; }
    }
    ss = wave_sum(ss);
    const float rstd = rsqrtf(ss * (1.f / DM) + 1e-6f);
    float x1[16];
    float s2 = 0.f;
#pragma unroll
    for (int i = 0; i < 2; ++i)
#pragma unroll
      for (int j4 = 0; j4 < 2; ++j4) {
        const int k = i * 512 + lane * 8 + j4 * 4;
        const f32x4 xv = xc[i * 2 + j4];
        const f32x4 gm = *(const f32x4*)(md + 2048 + k), gp = *(const f32x4*)(p.g_post_mix + k);
        f32x4 o;
#pragma unroll
        for (int j = 0; j < 4; ++j) { o[j] = xv[j] + gm[j] * (mv[i * 8 + j4 * 4 + j] * rstd * gp[j]); x1[i * 8 + j4 * 4 + j] = o[j]; s2 += o[j] * o[j]; }
        *(f32x4*)(p.out + (size_t)t * DM + k) = o;
      }
    s2 = wave_sum(s2);
    const float rstd2 = rsqrtf(s2 * (1.f / DM) + 1e-6f);
#pragma unroll
    for (int i = 0; i < 2; ++i) {
      float hv[8];
#pragma unroll
      for (int j = 0; j < 8; ++j) {
        const int k = i * 512 + lane * 8 + j;
        hv[j] = x1[i * 8 + j] * rstd2 * p.g_pre_ffn[k] * (1.f + md[4096 + k]) + md[3072 + k];
        sh[k] = hv[j];
      }
      u32x2 w; w.x = pk4_fp8(hv[0], hv[1], hv[2], hv[3]); w.y = pk4_fp8(hv[4], hv[5], hv[6], hv[7]);
      *(u32x2*)(p.h2q + (size_t)t * DM + i * 512 + lane * 8) = w;
    }
#ifdef PM_SKIP
    if (rep) continue;
#endif
    float acc[32];
#pragma unroll
    for (int e2 = 0; e2 < 32; ++e2) acc[e2] = 0.f;
#pragma unroll 4
    for (int i = 0; i < 16; ++i) {
      const float hk = sh[lane + 64 * i];
      const LAS u32x4* wr = (const LAS u32x4*)(wl + (lane + 64 * i) * 40);
#pragma unroll
      for (int c4 = 0; c4 < 4; ++c4) {
        float f[8]; unpack8(wr[c4], f);
#pragma unroll
        for (int j = 0; j < 8; ++j) acc[c4 * 8 + j] += hk * f[j];
      }
    }
    {
      const bool u5 = lane & 32, u4 = lane & 16, u3 = lane & 8, u2 = lane & 4, u1 = lane & 2;
      float a16[16], a8[8], a4[4], a2[2];
#pragma unroll
      for (int j = 0; j < 16; ++j) { const float snd = u5 ? acc[j] : acc[16 + j]; const float rcv = __shfl_xor(snd, 32, 64); a16[j] = (u5 ? acc[16 + j] : acc[j]) + rcv; }
#pragma unroll
      for (int j = 0; j < 8; ++j) { const float snd = u4 ? a16[j] : a16[8 + j]; const float rcv = __shfl_xor(snd, 16, 64); a8[j] = (u4 ? a16[8 + j] : a16[j]) + rcv; }
#pragma unroll
      for (int j = 0; j < 4; ++j) { const float snd = u3 ? a8[j] : a8[4 + j]; const float rcv = __shfl_xor(snd, 8, 64); a4[j] = (u3 ? a8[4 + j] : a8[j]) + rcv; }
#pragma unroll
      for (int j = 0; j < 2; ++j) { const float snd = u2 ? a4[j] : a4[2 + j]; const float rcv = __shfl_xor(snd, 4, 64); a2[j] = (u2 ? a4[2 + j] : a4[j]) + rcv; }
      const float snd = u1 ? a2[0] : a2[1]; const float rcv = __shfl_xor(snd, 2, 64);
      float a1 = (u1 ? a2[1] : a2[0]) + rcv;
      a1 += __shfl_xor(a1, 1, 64);
      acc[0] = a1;
    }
    const int e = lane >> 1;
    float lg = acc[0] + p.b_router[e];
    if (lane & 1) lg = -INFINITY;
    float tv[4]; int ti[4];
#pragma unroll
    for (int r = 0; r < 4; ++r) {
      const float m = wave_max(lg);
      const unsigned long long bal = __ballot(lg == m);
      const int idx = __ffsll((long long)bal) - 1;
      tv[r] = m; ti[r] = idx >> 1;
      if (lane == idx) lg = -INFINITY;
    }
    const float e1 = __expf(tv[1] - tv[0]), e2 = __expf(tv[2] - tv[0]), e3 = __expf(tv[3] - tv[0]);
    const float inv = 1.f / (1.f + e1 + e2 + e3);
    if (lane < 4) {
      const int ee = lane == 0 ? ti[0] : lane == 1 ? ti[1] : lane == 2 ? ti[2] : ti[3];
      const float ww = (lane == 0 ? 1.f : lane == 1 ? e1 : lane == 2 ? e2 : e3) * inv;
      p.aw[t * 4 + lane] = ww;
      const int rank = __hip_atomic_fetch_add(&lcnt[ee], 1, __ATOMIC_RELAXED, __HIP_MEMORY_SCOPE_WORKGROUP);
      lent[nloc * 4 + lane] = (ee << 16) | rank;
      lent[nloc * 4 + lane + 2048] = t * 4 + lane;
    }
    ++nloc;
  }
  __syncthreads();
  if (p.tid < 32) lbase[p.tid] = atomicAdd(&p.cnt[p.tid * 64 + 32 * rep], lcnt[p.tid]);
  __syncthreads();
  for (int i = lane; i < nloc * 4; i += 64) {
    const int er = lent[i], a = lent[i + 2048];
    p.elist[(er >> 16) * T_TOK + lbase[er >> 16] + (er & 0xffff)] = a;
  }
}

__device__ void ph_gather(const Params& p, LAS unsigned char* lds, int nblk, int bid) {
  const int wid = p.tid >> 6, lane = p.tid & 63;
  LAS int* tb = (LAS int*)lds;
  if (p.tid == 0) { int off = 0; for (int k = 0; k < NE; ++k) { const int c = p.cnt[k * 64]; tb[k] = off; tb[64 + k] = c; off += ((c + 255) >> 8) << 8; } tb[NE] = off; }
  __syncthreads();
  const int total = tb[NE];
  for (int r = bid * 8 + wid; r < total; r += nblk * 8) {
    int e = 0;
#pragma unroll 1
    for (int k = 1; k < NE; ++k) if (r >= tb[k]) e = k;
    const int i = r - tb[e];
    const int a = (i < tb[64 + e]) ? p.elist[e * T_TOK + i] : -1;
    if (lane == 0) p.rowmap[r] = a;
    u32x4 v0 = {0, 0, 0, 0}, v1 = v0;
    if (a >= 0) { const u32x4* src = (const u32x4*)(p.h2 + (size_t)(a >> 2) * DM); v0 = src[lane]; v1 = src[64 + lane]; }
    u32x4* dst = (u32x4*)(p.xs + (size_t)r * DM);
    dst[lane] = v0; dst[64 + lane] = v1;
  }
}

__device__ void ph_final(const Params& p, int nblk, int bid, int rep) {
  const int wid = p.tid >> 6, lane = p.tid & 63;
  for (int t0 = bid * 8 + wid; t0 < T_TOK; t0 += nblk * 16) {
    int tt[2] = {t0, t0 + nblk * 8};
    if (tt[1] >= T_TOK) tt[1] = t0;
    float mv[2][16]; float ss[2];
#pragma unroll
    for (int u = 0; u < 2; ++u) {
      const int t = tt[u];
      const f32x4 wv = *(const f32x4*)(p.aw + t * 4);
      ss[u] = 0.f;
#pragma unroll
      for (int i = 0; i < 2; ++i) {
        const bf16_t* y = p.yslot + (size_t)t * 4 * DM + i * 512 + lane * 8;
        float f0[8], f1[8], f2[8], f3[8];
        unpack8(*(const u32x4*)y, f0); unpack8(*(const u32x4*)(y + DM), f1); unpack8(*(const u32x4*)(y + 2 * DM), f2); unpack8(*(const u32x4*)(y + 3 * DM), f3);
#pragma unroll
        for (int j = 0; j < 8; ++j) { const float m = wv[0] * f0[j] + wv[1] * f1[j] + wv[2] * f2[j] + wv[3] * f3[j]; mv[u][i * 8 + j] = m; ss[u] += m * m; }
      }
    }
    f32x4 x1[2][4];
#pragma unroll
    for (int u = 0; u < 2; ++u)
#pragma unroll
      for (int i = 0; i < 2; ++i)
#pragma unroll
        for (int j4 = 0; j4 < 2; ++j4) x1[u][i * 2 + j4] = *(const f32x4*)(p.out + (size_t)tt[u] * DM + i * 512 + lane * 8 + j4 * 4);
    ss[0] = wave_sum(ss[0]); ss[1] = wave_sum(ss[1]);
#pragma unroll
    for (int u = 0; u < 2; ++u) {
      const int t = tt[u];
      if (u == 1 && t == t0) break;
      const float* md = p.mod + (t / SEQ) * 6144;
      const float rstd = rsqrtf(ss[u] * (1.f / DM) + 1e-6f);
#pragma unroll
      for (int i = 0; i < 2; ++i)
#pragma unroll
        for (int j4 = 0; j4 < 2; ++j4) {
          const int k = i * 512 + lane * 8 + j4 * 4;
          float* op = p.out + (size_t)t * DM + k;
          const f32x4 gf = *(const f32x4*)(md + 5120 + k), gp = *(const f32x4*)(p.g_post_ffn + k);
          f32x4 o;
#pragma unroll
          for (int j = 0; j < 4; ++j) o[j] = x1[u][i * 2 + j4][j] + gf[j] * (mv[u][i * 8 + j4 * 4 + j] * rstd * gp[j]);
          *(f32x4*)(rep ? (float*)p.hbf + (size_t)(t & 8191) * DM + k : op) = o;
        }
    }
  }
}

#define XCD_BAR_WORDS 3456
struct KArgs { const void* in[22]; float* out; char* ws; long long never; };
__host__ __device__ inline size_t al(size_t x) { return (x + 255) & ~(size_t)255; }
__host__ __device__ inline void fill_params(Params& p, const KArgs& k) {
  p.x = (const float*)k.in[0]; p.c = (const float*)k.in[1]; p.w_ada = (const float*)k.in[2]; p.b_ada = (const float*)k.in[3];
  p.g_pre_mix = (const float*)k.in[4]; p.g_post_mix = (const float*)k.in[5]; p.g_pre_ffn = (const float*)k.in[6];
  p.g_post_ffn = (const float*)k.in[7]; p.w_in = (const float*)k.in[8]; p.conv_w = (const float*)k.in[9];
  p.a_log = (const float*)k.in[10]; p.dt_bias = (const float*)k.in[11]; p.g_dn_out = (const float*)k.in[12];
  p.w_br_a = (const float*)k.in[13]; p.w_br_b = (const float*)k.in[14]; p.w_o = (const float*)k.in[15];
  p.w_router = (const float*)k.in[16]; p.b_router = (const float*)k.in[17]; p.w_gu = (const float*)k.in[18];
  p.b_gu = (const float*)k.in[19]; p.w_down = (const float*)k.in[20]; p.b_down = (const float*)k.in[21];
  p.out = k.out;
  char* w = k.ws;
  size_t o = 0;
#define take(bytes) (w + (o += al(bytes)) - al(bytes))
  p.mod = (float*)take(4 * 6144 * 4);
  p.cnt = (int*)take(16384);
  p.ba = (float*)take((size_t)T_TOK * 8 * 4);
  p.hbf = (bf16_t*)take((size_t)T_TOK * DM * 2);
  p.proj = (bf16_t*)take((size_t)T_TOK * PW * 2);
  p.w_in_t = (bf16_t*)take((size_t)PW * DM * 2);
  p.wgu8 = (unsigned char*)take((size_t)NE * 2048 * DM);
  p.wd8 = (unsigned char*)take((size_t)NE * 1024 * DM);
  p.h2q = (unsigned char*)take((size_t)T_TOK * DM);
  p.act8 = (unsigned char*)take((size_t)73728 * DM);
  p.wbra_t = (bf16_t*)take((size_t)1024 * 512 * 2);
  p.wbrb_t = (bf16_t*)take((size_t)1024 * 512 * 2);
  p.wo_t = (bf16_t*)take((size_t)1024 * 1024 * 2);
  p.qb = (bf16_t*)take((size_t)T_TOK * 512 * 2);
  p.kb = (bf16_t*)take((size_t)T_TOK * 512 * 2);
  p.kmean = (float*)take((size_t)16 * 16 * 128 * 4);
  p.oab = (bf16_t*)take((size_t)T_TOK * DM * 2);
  p.merged = (bf16_t*)take((size_t)T_TOK * DM * 2);
  p.mixer = (bf16_t*)take((size_t)T_TOK * DM * 2);
  p.h2 = (bf16_t*)take((size_t)T_TOK * DM * 2);
  p.elist = (int*)take((size_t)NE * T_TOK * 4);
  p.aw = (float*)take((size_t)T_TOK * 4 * 4);
  p.rowmap = (int*)take((size_t)73728 * 4);
  p.dnA = (unsigned char*)take((size_t)1024 * DN_ABYTES);
  p.dnU = (float*)take((size_t)1024 * DN_UFLOATS * 4);
  p.dnG = (float*)take(4096);
  p.oab2 = (bf16_t*)take((size_t)T_TOK * 512 * 2);
  p.dbg = (float*)take(256);
  p.bar = (unsigned*)take(XCD_BAR_WORDS * 4);
  p.dn_out = p.oab; p.dn_out_ld = DM;
  p.Kp = (bf16_t*)take((size_t)16 * 128 * 8192);
  p.Vp = (bf16_t*)take((size_t)16 * 128 * 8192);
  p.wq = p.cnt + 32 * 64;
  p.mb_out = p.oab; p.mb_out_ld = DM; p.mb_out_off = 512;
  p.xs = p.proj;
  char* big = take((size_t)73728 * DM * 2 + (size_t)65536 * DM * 2);
  p.act = (bf16_t*)big;
  p.yslot = (bf16_t*)(big + (size_t)73728 * DM * 2);
  {
    char* s = big; size_t so = 0;
#define t2(bytes) (s + (so += al(bytes)) - al(bytes))
    p.nq = (float*)t2((size_t)T_TOK * 512 * 4);
    p.nk = (float*)t2((size_t)T_TOK * 512 * 4);
    p.nv = (float*)t2((size_t)T_TOK * 512 * 4);
    p.no = (float*)t2((size_t)T_TOK * 512 * 4);
    p.ntmp = (float*)t2((size_t)T_TOK * DM * 4);
    p.nbeta = (float*)t2((size_t)T_TOK * 4 * 4);
    p.ng = (float*)t2((size_t)T_TOK * 4 * 4);
  }

#undef take
#undef t2
  p.never = (int)k.never;
}

#define XB_TMO      128
#define XB_XCNT(j)  (256  + 64 * (j))
#define XB_XSUB(j)  (1280 + 64 * (j))
#define XB_XGEN(j)  (2304 + 64 * (j))
#define XB_TOP      3328
#define XB_TOPGEN   3392
#define XB_SPIN_CAP (1u << 18)

__device__ __forceinline__ unsigned xb_ld(unsigned* p)              { return __hip_atomic_load(p, __ATOMIC_RELAXED, __HIP_MEMORY_SCOPE_AGENT); }
__device__ __forceinline__ unsigned xb_add(unsigned* p, unsigned v) { return __hip_atomic_fetch_add(p, v, __ATOMIC_RELAXED, __HIP_MEMORY_SCOPE_AGENT); }
__device__ __forceinline__ unsigned xb_xcc_id() { return (unsigned)__builtin_amdgcn_s_getreg((3 << 11) | 20) & 0xFu; }
#define XB_SPIN(cond, bar) do { unsigned _sp = 0; while (cond) { __builtin_amdgcn_s_sleep(1); \
    if ((++_sp & 255u) == 0u) { if (xb_ld(&(bar)[XB_TMO])) break; if (_sp > XB_SPIN_CAP) { atomicAdd(&(bar)[XB_TMO], 1u); break; } } } } while (0)

struct XcdBarrier {
    unsigned* bar; unsigned x;
    volatile LAS unsigned* st;
};

__device__ __forceinline__ XcdBarrier xcd_barrier_post(unsigned* bar, volatile LAS unsigned* st) {
    XcdBarrier b; b.bar = bar; b.x = xb_xcc_id(); b.st = st;
    if (threadIdx.x == 0) (void)xb_add(&bar[XB_XCNT(b.x)], 1u);
    return b;
}
__device__ __forceinline__ void xcd_barrier_complete(unsigned* bar, unsigned x, unsigned& nloc, unsigned& nx) {
    const unsigned G = gridDim.x * gridDim.y * gridDim.z;
    unsigned sum, cnt, mine, sp = 0u;
    for (;;) {
        sum = 0u; cnt = 0u; mine = 0u;
#pragma unroll
        for (unsigned j = 0; j < 16; ++j) { const unsigned c = xb_ld(&bar[XB_XCNT(j)]); sum += c; cnt += (c > 0u) ? 1u : 0u; mine = (j == x) ? c : mine; }
        if (sum == G) break;
        __builtin_amdgcn_s_sleep(1);
        if ((++sp & 255u) == 0u) { if (xb_ld(&bar[XB_TMO])) break; if (sp > XB_SPIN_CAP) { atomicAdd(&bar[XB_TMO], 1u); break; } }
    }
    nloc = mine > 0u ? mine : 1u; nx = cnt > 0u ? cnt : 1u;
}

__device__ __forceinline__ void xcd_barrier(const XcdBarrier& b, const int tid) {
    asm volatile("s_waitcnt vmcnt(0)" ::: "memory");
    __syncthreads();
    if (tid == 0) {
        unsigned* bar = b.bar;
        __builtin_amdgcn_s_waitcnt(0);
        unsigned nloc = b.st[0], nx = b.st[1];
        if (nloc == 0u) { xcd_barrier_complete(bar, b.x, nloc, nx); b.st[0] = nloc; b.st[1] = nx; }
        const unsigned old = xb_add(&bar[XB_XSUB(b.x)], 1u);
        const unsigned gen = old / nloc;
        if (old + 1u == (gen + 1u) * nloc) {
            __builtin_amdgcn_fence(__ATOMIC_RELEASE, "agent");
            asm volatile("s_waitcnt vmcnt(0)" ::: "memory");
            const unsigned og = xb_add(&bar[XB_TOP], 1u);
            const unsigned tg = og / nx;
            if (og + 1u == (tg + 1u) * nx) xb_add(&bar[XB_TOPGEN], 1u);
            else XB_SPIN(xb_ld(&bar[XB_TOPGEN]) == tg, bar);
            __builtin_amdgcn_fence(__ATOMIC_ACQUIRE, "agent");
            xb_add(&bar[XB_XGEN(b.x)], 1u);
            asm volatile("s_waitcnt vmcnt(0)" ::: "memory");
        } else {
            XB_SPIN(xb_ld(&bar[XB_XGEN(b.x)]) == gen, bar);
            __builtin_amdgcn_fence(__ATOMIC_ACQUIRE, "agent");
            asm volatile("s_waitcnt vmcnt(0)" ::: "memory");
        }
    }
    __syncthreads();
}


__device__ __forceinline__ void load_ka(KArgs& kk) {
#if defined(__HIP_DEVICE_COMPILE__)
  typedef __attribute__((address_space(1))) char* gptr_t;
  typedef const __attribute__((address_space(4))) gptr_t* kptr_t;
  kptr_t kp = (kptr_t)__builtin_amdgcn_kernarg_segment_ptr();
  asm volatile("" : "+s"(kp));
#pragma unroll
  for (int i = 0; i < 22; ++i) kk.in[i] = (const void*)kp[i];
  kk.out = (float*)kp[22];
  kk.ws = (char*)kp[23];
  kk.never = ((const __attribute__((address_space(4))) long long*)kp)[24];
#endif
}
__device__ __forceinline__ void grid_bar(const Params& p, LAS unsigned char* lds);
#define MEGA_LDS 148480
#define MEGA_LDS_ALLOC (MEGA_LDS + 16)
__device__ __forceinline__ void grid_bar(const Params& p, LAS unsigned char* lds) {
  XcdBarrier b; b.bar = p.bar; b.x = xb_xcc_id(); b.st = (volatile LAS unsigned*)(lds + MEGA_LDS);
  xcd_barrier(b, p.tid);
}
__global__ __launch_bounds__(512) void mega(KArgs ka) {
  extern __shared__ __attribute__((aligned(16))) unsigned char shm[];
  LAS unsigned char* lds = (LAS unsigned char*)shm;
  cg::grid_group grid = cg::this_grid();
  const int nblk = gridDim.x, bid = blockIdx.x;
  const int wv_ = __builtin_amdgcn_readfirstlane(threadIdx.x >> 6);
  volatile LAS unsigned* xst = (volatile LAS unsigned*)(lds + MEGA_LDS);
  if (threadIdx.x == 0) { xst[0] = 0u; xst[1] = 0u; xst[2] = 0u; xst[3] = 0u; }
  __syncthreads();
  { Params p0; fill_params(p0, ka); (void)xcd_barrier_post(p0.bar, xst); }
  if (ka.never) grid.sync();
#ifndef REPMASK
#define REPMASK 0
#endif
#define LOADKA KArgs kk; load_ka(kk)
#ifndef PHMASK
#define PHMASK 0xffff
#endif
#define PHASE(k, body) if (((PHMASK) >> (k)) & 1) for (int rep_ = 0; rep_ < (((REPMASK) >> (k)) & 1) + 1; ++rep_) { \
    LOADKA; Params p; fill_params(p, kk); { int t_; asm volatile("v_mbcnt_lo_u32_b32 %0, -1, 0\n\tv_mbcnt_hi_u32_b32 %0, -1, %0" : "=v"(t_)); p.tid = (wv_ << 6) | t_; } body; grid_bar(p, lds); }
#ifdef XBAR
  for (int xb_ = 0; xb_ < XBAR; ++xb_) { PHASE(15, {}) }
#endif
  PHASE(0, { ph_mod(p, lds, nblk, bid); ph_wt(p, lds, nblk, bid); })
  PHASE(1, { ph_h(p, lds, nblk, bid); })
  PHASE(2, { ph_proj(p, lds, nblk, bid); })
  PHASE(3, { bool first = true; for (int ci = bid; ci < 1024; ci += nblk) { dn_prep_chunk(p, lds, ci, first); first = false; }
             for (int item = bid; item < 256; item += nblk) moba_prep_block(p, lds, item); })
  PHASE(4, { if (bid < 32) dn_scan_blk(p, lds, bid); moba_worker(p, lds, rep_); })
  PHASE(5, { ph_dn_norm(p, nblk, bid); })
  PHASE(6, { ph_br(p, lds, nblk, bid); })
  PHASE(7, { ph_mix(p, lds, nblk, bid); })
  PHASE(8, { ph_post_mix(p, lds, nblk, bid, rep_); })
  PHASE(10, { ph_moe1(p, lds, nblk, bid); })
  PHASE(11, { ph_moe2(p, lds, nblk, bid); })
  PHASE(12, { ph_final(p, nblk, bid, rep_); })
}


extern "C" void kernel_launch(void* const* d_in, const int* in_sizes, int n_in, void* d_out, int out_size, void* d_ws,
                              size_t ws_size, hipStream_t stream) {
  KArgs ka{};
  for (int i = 0; i < 22; ++i) ka.in[i] = d_in[i];
  ka.out = (float*)d_out; ka.ws = (char*)d_ws; ka.never = 0;
  Params p{};
  fill_params(p, ka);
  static int grid_blocks = 0;
  if (!grid_blocks) {
    (void)hipFuncSetAttribute((const void*)mega, hipFuncAttributeMaxDynamicSharedMemorySize, MEGA_LDS_ALLOC);
    int dev = 0, cus = 0, per_cu = 0;
    (void)hipGetDevice(&dev);
    (void)hipDeviceGetAttribute(&cus, hipDeviceAttributeMultiprocessorCount, dev);
    (void)hipOccupancyMaxActiveBlocksPerMultiprocessor(&per_cu, mega, 512, MEGA_LDS_ALLOC);
    if (per_cu != 1) per_cu = 1;
    grid_blocks = cus * per_cu;
  }
  (void)hipMemsetAsync(p.cnt, 0, 16384, stream);
  (void)hipMemsetAsync(p.bar, 0, XCD_BAR_WORDS * 4, stream);
  void* args[] = {&ka};
  hipError_t e = hipLaunchCooperativeKernel((void*)mega, dim3(grid_blocks), dim3(512), args, MEGA_LDS_ALLOC, stream);
  if (e != hipSuccess) fprintf(stderr, "cooperative launch failed: %s (grid %d)\n", hipGetErrorString(e), grid_blocks);
}
```

```cpp
#include <hip/hip_runtime.h>
#include <hip/hip_cooperative_groups.h>
#include <cstdio>
namespace cg = cooperative_groups;
#include <stdint.h>

typedef unsigned short bf16_t;
#ifndef MB_ABL
#define MB_ABL 0
#endif

#define T_TOK 16384
#define SEQ 4096
#define NB 4
#define DM 1024
#define INW 5640
#define PW 5632
#define C_QA 0
#define C_KA 512
#define C_VA 1024
#define C_Z 1536
#define C_MQ 2048
#define C_MK 2560
#define C_MV 3072
#define C_GA 3584
#define C_GB 4608
#define NE 32

__device__ __forceinline__ bf16_t f2bf(float f) {
  unsigned u = __float_as_uint(f);
  u += 0x7fffu + ((u >> 16) & 1u);
  return (bf16_t)(u >> 16);
}
__device__ __forceinline__ float bf2f(bf16_t h) { return __uint_as_float(((unsigned)h) << 16); }
__device__ __forceinline__ float sigmoidf_(float x) { return __builtin_amdgcn_rcpf(1.f + __builtin_amdgcn_exp2f(-1.4426950408889634f * x)); }
__device__ __forceinline__ float siluf_(float x) { return x * sigmoidf_(x); }
__device__ __forceinline__ float wave_sum(float v) {
#pragma unroll
  for (int o = 32; o > 0; o >>= 1) v += __shfl_xor(v, o, 64);
  return v;
}
__device__ __forceinline__ float wave_max(float v) {
#pragma unroll
  for (int o = 32; o > 0; o >>= 1) v = fmaxf(v, __shfl_xor(v, o, 64));
  return v;
}

typedef unsigned u32x2 __attribute__((ext_vector_type(2)));
typedef __bf16 bf16x2_t __attribute__((ext_vector_type(2)));
typedef float f32x2_t __attribute__((ext_vector_type(2)));
__device__ __forceinline__ unsigned pk2(float a, float b) { f32x2_t v = {a, b}; bf16x2_t r = __builtin_convertvector(v, bf16x2_t); return __builtin_bit_cast(unsigned, r); }

__device__ __forceinline__ unsigned pk4_fp8(float a, float b, float c, float d) {
  int w = 0;
  w = __builtin_amdgcn_cvt_pk_fp8_f32(a, b, w, false);
  w = __builtin_amdgcn_cvt_pk_fp8_f32(c, d, w, true);
  return (unsigned)w;
}

struct Params {
  const float *x, *c, *w_ada, *b_ada, *g_pre_mix, *g_post_mix, *g_pre_ffn, *g_post_ffn, *w_in, *conv_w,
      *a_log, *dt_bias, *g_dn_out, *w_br_a, *w_br_b, *w_o, *w_router, *b_router, *w_gu, *b_gu, *w_down, *b_down;
  float* out;
  float* mod;
  int* cnt;
  float* ba;
  bf16_t* hbf;
  bf16_t* proj;
  bf16_t* w_in_t;
  unsigned char* wgu8;
  unsigned char* wd8;
  unsigned char* h2q;
  unsigned char* act8;
  bf16_t* wbra_t;
  bf16_t* wbrb_t;
  bf16_t* wo_t;
  bf16_t* qb;
  bf16_t* kb;
  float* kmean;
  bf16_t* oab;
  bf16_t* merged;
  bf16_t* mixer;
  bf16_t* h2;
  int* elist;
  float* aw;
  bf16_t* act;
  bf16_t* xs;
  int* rowmap;
  bf16_t* yslot;
  unsigned char* dnA; float* dnU; float* dnG;
  bf16_t* dn_out; int dn_out_ld;
  bf16_t* oab2; float* dbg;
  unsigned* bar; int never; int tid;
  bf16_t* Kp; bf16_t* Vp; int* wq;
  bf16_t* mb_out; int mb_out_ld; int mb_out_off;
  float* nq; float* nk; float* nv;
  float* nbeta; float* ng;
  float* no;
  float* ntmp;
};

__device__ __forceinline__ int map_col(int n, int mode) {
  if (mode == 0) return n;
  if (mode == 1) return n < 2048 ? n : (n < 2056 ? -1 : n - 8);
  if (n < 1024) return (n >> 7) * 256 + (n & 127);
  int j = n - 1024;
  return (j >> 7) * 256 + 128 + (j & 127);
}
namespace pg8 {
#define PG8_LAS __attribute__((address_space(3)))
typedef short bf16x8 __attribute__((ext_vector_type(8)));
typedef float f32x4 __attribute__((ext_vector_type(4)));
typedef unsigned u32x4 __attribute__((ext_vector_type(4)));
constexpr int BM = 256, BK = 64, HALF = 128, HTB = HALF * BK * 2, STAGE_BYTES = 8 * HTB, NXCD = 8, WGM = 8;

__host__ __device__ __forceinline__ int lds_byte(int r, int c) { const int st = (r >> 4) * 2 + (c >> 5), rr = r & 15, cc = c & 31, ob = rr * 64 + cc * 2; return st * 1024 + (ob ^ (((ob >> 9) & 1) << 5)); }
__host__ __device__ __forceinline__ void stage_rc(int b, int& R, int& C) { const int st = b / 1024, sb = b % 1024, swz = sb ^ (((sb >> 9) & 1) << 5); R = (st >> 1) * 16 + swz / 64; C = (st & 1) * 32 + (swz % 64) / 2; }
__host__ __device__ __forceinline__ int perm32(int rho) { const int n = rho >> 4, i = rho & 15; return 8 * (i >> 2) + 4 * n + (i & 3); }

struct Unit { int pm, pn, z; };
__device__ __forceinline__ unsigned cvt_pk_bf16(float lo, float hi) { unsigned r; asm volatile("v_cvt_pk_bf16_f32 %0, %1, %2" : "=v"(r) : "v"(lo), "v"(hi)); return r; }

typedef int i32x8 __attribute__((ext_vector_type(8)));
typedef int i32x4 __attribute__((ext_vector_type(4)));
__device__ __forceinline__ i32x8 cat8(const bf16x8 lo, const bf16x8 hi) { const i32x4 a = __builtin_bit_cast(i32x4, lo), b = __builtin_bit_cast(i32x4, hi); return __builtin_shufflevector(a, b, 0, 1, 2, 3, 4, 5, 6, 7); }
struct TileOrder {
    int nM, nN, nwg, G, c;
    __device__ void init(int nM_, int nN_, int G_, int c_) { nM = nM_; nN = nN_; nwg = nM * nN; G = G_; c = c_; }
    __device__ bool tile(int i, int& pm, int& pn) const {
        const long L = (long)i * G + c; if (L >= nwg) return false;
        int wgid = (int)L; { const int q = nwg / NXCD, r = nwg % NXCD, xcd = wgid % NXCD, off = wgid / NXCD; wgid = (xcd < r ? xcd * (q + 1) : r * (q + 1) + (xcd - r) * q) + off; }
        const int nig = WGM * nN, gid = wgid / nig, fm = gid * WGM, gsz = (nM - fm) < WGM ? (nM - fm) : WGM;
        pm = fm + ((wgid % nig) % gsz); pn = (wgid % nig) / gsz; return true;
    }
};

template <class Epi, class Sched, bool FP8 = false>
__device__ __forceinline__ void gemm_phase(PG8_LAS unsigned char* lds, const int tid, const int lda, const int ldb, const int K, const Sched& S, const Epi& E) {
    const int wid = __builtin_amdgcn_readfirstlane(tid >> 6), lane = tid & 63, wr = wid >> 2, wc = wid & 3, fr = lane & 15, fq = lane >> 4;
    const int nt = K / BK;
    unsigned voffA[2], voffB[2];
#pragma unroll
    for (int i = 0; i < 2; ++i) { int R, C; stage_rc(tid * 16 + i * 8192, R, C); const int Rb = Epi::PERM ? ((R & ~31) + perm32(R & 31)) : R;
        voffA[i] = (unsigned)(R * lda + C) * 2u; voffB[i] = (unsigned)(Rb * ldb + C) * 2u; }
    const size_t kstep = (size_t)(BK * 2);
    const size_t hstepA = (size_t)HALF * lda * 2, hstepB = (size_t)HALF * ldb * 2;
    const unsigned ldsw = (unsigned)wid * 1024u;
    const int aoff = lds_byte(wr * 64 + fr, fq * 8), boff = lds_byte(wc * 32 + fr, fq * 8);
    constexpr int KOFF1 = 1024;
    unsigned gA[2][2] = {{0u, 0u}, {0u, 0u}}, gAn[2][2] = {{0u, 0u}, {0u, 0u}};
#define PG8_GOFFS(dst, unit) do { int t_ = tid; asm volatile("" : "+v"(t_)); _Pragma("unroll") for (int i_ = 0; i_ < 2; ++i_) { int gR_, gC_; stage_rc(t_ * 16 + i_ * 8192, gR_, gC_); \
        _Pragma("unroll") for (int h_ = 0; h_ < 2; ++h_) dst[h_][i_] = S.a_goff(unit, gR_ + 128 * h_, gC_); } } while (0)
#define PG8_SA(b, h) (((b) * 2 + (h)) * HTB)
#define PG8_SB(b, h) ((4 + (b) * 2 + (h)) * HTB)
#define PG8_STAGE(bufoff, gbase, voff) do { _Pragma("unroll") for (int _i = 0; _i < 2; ++_i) \
        __builtin_amdgcn_global_load_lds((const unsigned*)((const char*)(gbase) + (voff)[_i]), (PG8_LAS unsigned*)(lds + (bufoff) + ldsw + _i * 8192), 16, 0, 0); } while (0)
#define PG8_STAGEA(bufoff, ptr, h, nx) do { if constexpr (Sched::GATHER) { const unsigned gs_[2] = {(nx) ? gAn[h][0] : gA[h][0], (nx) ? gAn[h][1] : gA[h][1]}; PG8_STAGE(bufoff, ptr, gs_); } \
        else { PG8_STAGE(bufoff, (ptr) + (h) * hstepA, voffA); } } while (0)
#define PG8_LDA(dst, b, h) do { if constexpr (FP8) { _Pragma("unroll") for (int m = 0; m < 4; ++m) dst##8[m] = cat8(*(const PG8_LAS bf16x8*)(lds + PG8_SA(b, h) + aoff + m * 2048), *(const PG8_LAS bf16x8*)(lds + PG8_SA(b, h) + aoff + KOFF1 + m * 2048)); } \
        else { _Pragma("unroll") for (int m = 0; m < 4; ++m) _Pragma("unroll") for (int k = 0; k < 2; ++k) dst[m][k] = *(const PG8_LAS bf16x8*)(lds + PG8_SA(b, h) + aoff + k * KOFF1 + m * 2048); } } while (0)
#define PG8_LDB(dst, b, h) do { if constexpr (FP8) { _Pragma("unroll") for (int n = 0; n < 2; ++n) dst##8[n] = cat8(*(const PG8_LAS bf16x8*)(lds + PG8_SB(b, h) + boff + n * 2048), *(const PG8_LAS bf16x8*)(lds + PG8_SB(b, h) + boff + KOFF1 + n * 2048)); } \
        else { _Pragma("unroll") for (int n = 0; n < 2; ++n) _Pragma("unroll") for (int k = 0; k < 2; ++k) dst[n][k] = *(const PG8_LAS bf16x8*)(lds + PG8_SB(b, h) + boff + k * KOFF1 + n * 2048); } } while (0)
#define PG8_MMA(ai, bj, At, Bt) do { __builtin_amdgcn_s_setprio(1); if constexpr (FP8) { _Pragma("unroll") for (int m = 0; m < 4; ++m) _Pragma("unroll") for (int n = 0; n < 2; ++n) \
        asm volatile("v_mfma_scale_f32_16x16x128_f8f6f4 %0, %1, %2, %0, %3, %4 op_sel_hi:[0,0,0]" : "+v"(acc[ai][bj][m][n]) : "v"(Bt##8[n]), "v"(At##8[m]), "v"(sclB), "v"(sclA)); } \
        else { _Pragma("unroll") for (int m = 0; m < 4; ++m) _Pragma("unroll") for (int n = 0; n < 2; ++n) _Pragma("unroll") for (int k = 0; k < 2; ++k) \
        acc[ai][bj][m][n] = __builtin_amdgcn_mfma_f32_16x16x32_bf16(Bt[n][k], At[m][k], acc[ai][bj][m][n], 0, 0, 0); } __builtin_amdgcn_s_setprio(0); } while (0)
#define PG8_WAIT_V(n) asm volatile("s_waitcnt vmcnt(" #n ")" ::: "memory")
#define PG8_WAIT_L(n) asm volatile("s_waitcnt lgkmcnt(" #n ")" ::: "memory")
#define PG8_BAR __builtin_amdgcn_s_barrier()
#define PG8_SCHED __builtin_amdgcn_sched_barrier(0)
    Unit cur, nxt; int ui = 0;
    if (!S.next(0, cur)) return;
    f32x4 acc[2][2][4][2];
#pragma unroll
    for (int a = 0; a < 2; ++a)
#pragma unroll
        for (int b = 0; b < 2; ++b)
#pragma unroll
            for (int m = 0; m < 4; ++m)
#pragma unroll
                for (int n = 0; n < 2; ++n) acc[a][b][m][n] = (f32x4){0.f, 0.f, 0.f, 0.f};
    bf16x8 At[4][2], B0[2][2], B1[2][2];
    i32x8 At8[4], B08[2], B18[2];
    int sclA = 0x7f7f7f7f, sclB = 0x79797979;
    const char* cA = S.a_ptr(cur); const char* cB = S.b_ptr(cur);
    if constexpr (Sched::GATHER) { PG8_GOFFS(gA, cur); }
    PG8_STAGE(PG8_SB(0, 0), cB, voffB); PG8_STAGEA(PG8_SA(0, 0), cA, 0, false); PG8_STAGE(PG8_SB(0, 1), cB + hstepB, voffB); PG8_STAGEA(PG8_SA(0, 1), cA, 1, false);
    if (wr == 1) PG8_BAR;
    PG8_WAIT_V(4); PG8_BAR;
    PG8_STAGE(PG8_SB(1, 0), cB + kstep, voffB); PG8_STAGEA(PG8_SA(1, 0), cA + kstep, 0, false); PG8_STAGE(PG8_SB(1, 1), cB + hstepB + kstep, voffB);
    PG8_WAIT_V(6); PG8_BAR;
    for (;;) {
        const bool has_next = S.next(ui + 1, nxt);
        const char* nA = has_next ? S.a_ptr(nxt) : cA; const char* nB = has_next ? S.b_ptr(nxt) : cB;
        if constexpr (Sched::GATHER) { if (has_next) { PG8_GOFFS(gAn, nxt); } else {
_Pragma("unroll") for (int h = 0; h < 2; ++h) _Pragma("unroll") for (int i = 0; i < 2; ++i) gAn[h][i] = gA[h][i]; } }
_Pragma("unroll 1")
        for (int t = 0; t < nt; t += 2) {
            const bool last = (t == nt - 2);
            const char* a1 = cA + (size_t)(t + 1) * kstep;
            const char* a2 = last ? nA : cA + (size_t)(t + 2) * kstep; const char* b2 = last ? nB : cB + (size_t)(t + 2) * kstep;
            const char* a3 = a2 + kstep; const char* b3 = b2 + kstep;
            PG8_LDB(B0, 0, 0); PG8_SCHED; PG8_LDA(At, 0, 0); PG8_STAGEA(PG8_SA(1, 1), a1, 1, false);
            PG8_WAIT_L(8); PG8_BAR; PG8_WAIT_L(0); PG8_MMA(0, 0, At, B0); PG8_BAR; PG8_SCHED;
            PG8_LDB(B1, 0, 1); PG8_STAGE(PG8_SB(0, 0), b2, voffB);
            PG8_BAR; PG8_WAIT_L(0); PG8_MMA(0, 1, At, B1); PG8_BAR;
            PG8_LDA(At, 0, 1); PG8_STAGEA(PG8_SA(0, 0), a2, 0, last);
            PG8_BAR; PG8_WAIT_L(0); PG8_MMA(1, 0, At, B0); PG8_BAR; PG8_SCHED;
            PG8_STAGE(PG8_SB(0, 1), b2 + hstepB, voffB);
            PG8_WAIT_V(6); PG8_BAR; PG8_MMA(1, 1, At, B1); PG8_BAR;
            PG8_LDB(B0, 1, 0); PG8_SCHED; PG8_LDA(At, 1, 0); PG8_STAGEA(PG8_SA(0, 1), a2, 1, last);
            PG8_WAIT_L(8); PG8_BAR; PG8_WAIT_L(0); PG8_MMA(0, 0, At, B0); PG8_BAR; PG8_SCHED;
            PG8_LDB(B1, 1, 1); PG8_STAGE(PG8_SB(1, 0), b3, voffB);
            PG8_BAR; PG8_WAIT_L(0); PG8_MMA(0, 1, At, B1); PG8_BAR;
            PG8_LDA(At, 1, 1); PG8_STAGEA(PG8_SA(1, 0), a3, 0, last);
            PG8_BAR; PG8_WAIT_L(0); PG8_MMA(1, 0, At, B0); PG8_BAR; PG8_SCHED;
            PG8_STAGE(PG8_SB(1, 1), b3 + hstepB, voffB);
            PG8_WAIT_V(6); PG8_BAR; PG8_MMA(1, 1, At, B1); PG8_BAR;
        }
        { if constexpr (FP8) asm volatile("s_nop 15\n\ts_nop 3" ::: "memory");
          int t_ = tid; asm volatile("" : "+v"(t_));
          E(acc, cur, wr, wc, t_ & 15, (t_ & 63) >> 4); }
        if (!has_next) break;
#pragma unroll
        for (int a = 0; a < 2; ++a)
#pragma unroll
            for (int b = 0; b < 2; ++b)
#pragma unroll
                for (int m = 0; m < 4; ++m)
#pragma unroll
                    for (int n = 0; n < 2; ++n) acc[a][b][m][n] = (f32x4){0.f, 0.f, 0.f, 0.f};
        cur = nxt; cA = nA; cB = nB; ++ui;
        if constexpr (Sched::GATHER) {
_Pragma("unroll") for (int h = 0; h < 2; ++h) _Pragma("unroll") for (int i = 0; i < 2; ++i) gA[h][i] = gAn[h][i]; }
    }
    PG8_WAIT_V(0);
    if (wr == 0) PG8_BAR;
    PG8_BAR;
#undef PG8_SA
#undef PG8_SB
#undef PG8_STAGE
#undef PG8_STAGEA
#undef PG8_GOFFS
#undef PG8_LDA
#undef PG8_LDB
#undef PG8_MMA
#undef PG8_WAIT_V
#undef PG8_WAIT_L
#undef PG8_BAR
#undef PG8_SCHED
}
}
using pg8::f32x4; using pg8::u32x4; using pg8::Unit;

#define GEMM_LDS (pg8::STAGE_BYTES + 1024)

struct SchedProj : pg8::TileOrder {
  static constexpr bool GATHER = false;
  const char* A; const char* B;
  __device__ bool next(int i, Unit& u) const { u.z = 0; return tile(i, u.pm, u.pn); }
  __device__ const char* a_ptr(const Unit& u) const { return A + (size_t)u.pm * 256 * DM * 2; }
  __device__ const char* b_ptr(const Unit& u) const { return B + (size_t)u.pn * 256 * DM * 2; }
};
struct EpiProj {
  static constexpr bool PERM = true;
  bf16_t* O;
  __device__ __forceinline__ void operator()(const f32x4 (&acc)[2][2][4][2], const Unit& u, int wr, int wc, int fr, int fq) const {
    const int row0 = u.pm * 256 + wr * 64 + fr, col0 = u.pn * 256 + wc * 32 + 8 * fq;
    const bool gate = u.pn >= (C_GA / 256);
#pragma unroll
    for (int ai = 0; ai < 2; ++ai)
#pragma unroll
      for (int m = 0; m < 4; ++m) {
        bf16_t* rowp = O + (size_t)(row0 + ai * 128 + m * 16) * PW + col0;
#pragma unroll
        for (int bj = 0; bj < 2; ++bj) {
          f32x4 v0 = acc[ai][bj][m][0], v1 = acc[ai][bj][m][1];
          if (gate) {
#pragma unroll
            for (int j = 0; j < 4; ++j) { v0[j] = sigmoidf_(v0[j]); v1[j] = sigmoidf_(v1[j]); }
          }
          u32x4 w; w.x = pg8::cvt_pk_bf16(v0[0], v0[1]); w.y = pg8::cvt_pk_bf16(v0[2], v0[3]); w.z = pg8::cvt_pk_bf16(v1[0], v1[1]); w.w = pg8::cvt_pk_bf16(v1[2], v1[3]);
          *(u32x4*)(rowp + bj * 128) = w;
        }
      }
  }
};
__device__ void ph_proj(const Params& p, PG8_LAS unsigned char* lds, int nblk, int bid) {
  SchedProj S; S.init(T_TOK / 256, PW / 256, nblk, bid); S.A = (const char*)p.hbf; S.B = (const char*)p.w_in_t;
  EpiProj E{p.proj};
  pg8::gemm_phase(lds, p.tid, DM, DM, DM, S, E);
}

struct SchedBr : pg8::TileOrder {
  static constexpr bool GATHER = false;
  const char* A; const char* Ba; const char* Bb;
  __device__ bool next(int i, Unit& u) const { u.z = i & 1; return tile(i >> 1, u.pm, u.pn); }
  __device__ const char* a_ptr(const Unit& u) const { return A + (size_t)u.pm * 256 * DM * 2 + u.z * 512 * 2; }
  __device__ const char* b_ptr(const Unit& u) const { return (u.z ? Bb : Ba) + (size_t)u.pn * 256 * 512 * 2; }
};
__device__ __forceinline__ void unpack8(const u32x4 w, float (&f)[8]) {
  f[0] = __uint_as_float(w.x << 16); f[1] = __uint_as_float(w.x & 0xffff0000u); f[2] = __uint_as_float(w.y << 16); f[3] = __uint_as_float(w.y & 0xffff0000u);
  f[4] = __uint_as_float(w.z << 16); f[5] = __uint_as_float(w.z & 0xffff0000u); f[6] = __uint_as_float(w.w << 16); f[7] = __uint_as_float(w.w & 0xffff0000u);
}
struct EpiBr {
  static constexpr bool PERM = true;
  const bf16_t* proj; bf16_t* O;
  __device__ __forceinline__ void operator()(const f32x4 (&acc)[2][2][4][2], const Unit& u, int wr, int wc, int fr, int fq) const {
    const int row0 = u.pm * 256 + wr * 64 + fr, col0 = u.pn * 256 + wc * 32 + 8 * fq;
    const int gcol = (u.z ? C_GB : C_GA) + col0;
#pragma unroll
    for (int ai = 0; ai < 2; ++ai)
#pragma unroll
      for (int m = 0; m < 4; ++m) {
        const size_t row = (size_t)(row0 + ai * 128 + m * 16);
        bf16_t* rowp = O + row * DM + col0;
        const bf16_t* gp = proj + row * PW + gcol;
#pragma unroll
        for (int bj = 0; bj < 2; ++bj) {
          float g[8]; unpack8(*(const u32x4*)(gp + bj * 128), g);
          f32x4 v0 = acc[ai][bj][m][0], v1 = acc[ai][bj][m][1];
          float r[8];
#pragma unroll
          for (int j = 0; j < 4; ++j) { r[j] = v0[j] * g[j]; r[4 + j] = v1[j] * g[4 + j]; }
          if (u.z) {
            float pv[8]; unpack8(*(const u32x4*)(rowp + bj * 128), pv);
#pragma unroll
            for (int j = 0; j < 8; ++j) r[j] += pv[j];
          }
          u32x4 w; w.x = pg8::cvt_pk_bf16(r[0], r[1]); w.y = pg8::cvt_pk_bf16(r[2], r[3]); w.z = pg8::cvt_pk_bf16(r[4], r[5]); w.w = pg8::cvt_pk_bf16(r[6], r[7]);
          *(u32x4*)(rowp + bj * 128) = w;
        }
      }
  }
};
__device__ void ph_br(const Params& p, PG8_LAS unsigned char* lds, int nblk, int bid) {
  SchedBr S; S.init(T_TOK / 256, DM / 256, nblk, bid); S.A = (const char*)p.oab; S.Ba = (const char*)p.wbra_t; S.Bb = (const char*)p.wbrb_t;
  EpiBr E{p.proj, p.merged};
  pg8::gemm_phase(lds, p.tid, DM, 512, 512, S, E);
}

struct SchedMix : pg8::TileOrder {
  static constexpr bool GATHER = false;
  const char* A; const char* B;
  __device__ bool next(int i, Unit& u) const { u.z = 0; return tile(i, u.pm, u.pn); }
  __device__ const char* a_ptr(const Unit& u) const { return A + (size_t)u.pm * 256 * DM * 2; }
  __device__ const char* b_ptr(const Unit& u) const { return B + (size_t)u.pn * 256 * DM * 2; }
};
struct EpiMix {
  static constexpr bool PERM = true;
  bf16_t* O;
  __device__ __forceinline__ void operator()(const f32x4 (&acc)[2][2][4][2], const Unit& u, int wr, int wc, int fr, int fq) const {
    const int row0 = u.pm * 256 + wr * 64 + fr, col0 = u.pn * 256 + wc * 32 + 8 * fq;
#pragma unroll
    for (int ai = 0; ai < 2; ++ai)
#pragma unroll
      for (int m = 0; m < 4; ++m) {
        bf16_t* rowp = O + (size_t)(row0 + ai * 128 + m * 16) * DM + col0;
#pragma unroll
        for (int bj = 0; bj < 2; ++bj) {
          const f32x4 v0 = acc[ai][bj][m][0], v1 = acc[ai][bj][m][1];
          u32x4 w; w.x = pg8::cvt_pk_bf16(v0[0], v0[1]); w.y = pg8::cvt_pk_bf16(v0[2], v0[3]); w.z = pg8::cvt_pk_bf16(v1[0], v1[1]); w.w = pg8::cvt_pk_bf16(v1[2], v1[3]);
          *(u32x4*)(rowp + bj * 128) = w;
        }
      }
  }
};
__device__ void ph_mix(const Params& p, PG8_LAS unsigned char* lds, int nblk, int bid) {
  SchedMix S; S.init(T_TOK / 256, DM / 256, nblk, bid); S.A = (const char*)p.merged; S.B = (const char*)p.wo_t;
  EpiMix E{p.mixer};
  pg8::gemm_phase(lds, p.tid, DM, DM, DM, S, E);
}

template <bool GATH>
struct SchedMoe {
  static constexpr bool GATHER = GATH;
  const PG8_LAS int* tb; int NT; int G, c; int nwg;
  const char* A; const char* B; size_t bexp;
  const int* elist; int rowb;
  __device__ bool next(int i, Unit& u) const {
    const long L = (long)i * G + c; if (L >= nwg) return false;
    int wgid = (int)L; { const int q = nwg / 8, r = nwg % 8, xcd = wgid % 8, off = wgid / 8; wgid = (xcd < r ? xcd * (q + 1) : r * (q + 1) + (xcd - r) * q) + off; }
    int e = 0;
#pragma unroll 1
    for (int k = 1; k < NE; ++k) if (wgid >= tb[k]) e = k;
    const int q = wgid - tb[e]; const int tiles = tb[33 + e + 1] - tb[33 + e];
    u.pm = tb[33 + e] + q % tiles; u.pn = q / tiles; u.z = e; return true;
  }
  __device__ const char* a_ptr(const Unit& u) const { return GATH ? A : A + (size_t)u.pm * 256 * rowb; }
  __device__ const char* b_ptr(const Unit& u) const { return B + (size_t)u.z * bexp + (size_t)u.pn * 256 * rowb; }
  __device__ unsigned a_goff(const Unit& u, int tr, int C) const {
    const int i = (u.pm - tb[33 + u.z]) * 256 + tr;
    int tok = 0;
    if (i < tb[66 + u.z]) tok = elist[u.z * T_TOK + i] >> 2;
    return (unsigned)(tok * rowb + C * 2);
  }
};
__device__ __forceinline__ void moe_table(const Params& p, PG8_LAS int* tb, int NT) {
  if (p.tid == 0) {
    int ub = 0, tbp = 0;
    for (int e = 0; e < NE; ++e) { const int c = p.cnt[e * 64]; tb[e] = ub; tb[33 + e] = tbp; tb[66 + e] = c; const int t = (c + 255) >> 8; ub += t * NT; tbp += t; }
    tb[NE] = ub; tb[33 + NE] = tbp;
  }
  __syncthreads();
}
struct EpiMoe1 {
  static constexpr bool PERM = true;
  const float* b_gu; unsigned char* act;
  __device__ __forceinline__ void operator()(f32x4 (&acc)[2][2][4][2], const Unit& u, int wr, int wc, int fr, int fq) const {
    const int row0 = u.pm * 256 + wr * 64 + fr, jc = u.pn * 128 + wc * 32 + 8 * fq;
    const float* bg = b_gu + (size_t)u.z * 2048 + jc;
#pragma unroll
    for (int bj = 0; bj < 2; ++bj)
#pragma unroll
      for (int n = 0; n < 2; ++n) {
        const f32x4 bv = *(const f32x4*)(bg + bj * 1024 + n * 4);
#pragma unroll
        for (int ai = 0; ai < 2; ++ai)
#pragma unroll
          for (int m = 0; m < 4; ++m) acc[ai][bj][m][n] += bv;
      }
#pragma unroll
    for (int ai = 0; ai < 2; ++ai)
#pragma unroll
      for (int m = 0; m < 4; ++m) {
        unsigned char* rowp = act + (size_t)(row0 + ai * 128 + m * 16) * DM + jc;
        float r[8];
#pragma unroll
        for (int n = 0; n < 2; ++n)
#pragma unroll
          for (int j = 0; j < 4; ++j) {
            float g = acc[ai][0][m][n][j], up = acc[ai][1][m][n][j];
            g = fminf(g, 7.f); up = fminf(fmaxf(up, -7.f), 7.f);
            r[n * 4 + j] = (up + 1.f) * g * sigmoidf_(1.702f * g);
          }
        u32x2 w; w.x = pk4_fp8(r[0], r[1], r[2], r[3]); w.y = pk4_fp8(r[4], r[5], r[6], r[7]);
        *(u32x2*)rowp = w;
      }
  }
};
__device__ void ph_moe1(const Params& p, PG8_LAS unsigned char* lds, int nblk, int bid) {
  PG8_LAS int* tb = (PG8_LAS int*)(lds + pg8::STAGE_BYTES);
  moe_table(p, tb, 8);
  SchedMoe<true> S; S.tb = tb; S.NT = 8; S.G = nblk; S.c = bid; S.nwg = tb[NE]; S.A = (const char*)p.h2q; S.B = (const char*)p.wgu8; S.bexp = (size_t)2048 * DM; S.elist = p.elist; S.rowb = DM;
  EpiMoe1 E{p.b_gu, p.act8};
  pg8::gemm_phase<EpiMoe1, SchedMoe<true>, true>(lds, p.tid, DM / 2, DM / 2, DM / 2, S, E);
}
struct EpiMoe2 {
  static constexpr bool PERM = true;
  const float* b_down; const int* elist; const PG8_LAS int* tb; bf16_t* yslot;
  __device__ __forceinline__ void operator()(f32x4 (&acc)[2][2][4][2], const Unit& u, int wr, int wc, int fr, int fq) const {
    const int row0 = u.pm * 256 + wr * 64 + fr, col0 = u.pn * 256 + wc * 32 + 8 * fq;
    const float* bd = b_down + (size_t)u.z * 1024 + col0;
#pragma unroll
    for (int bj = 0; bj < 2; ++bj)
#pragma unroll
      for (int n = 0; n < 2; ++n) {
        const f32x4 bv = *(const f32x4*)(bd + bj * 128 + n * 4);
#pragma unroll
        for (int ai = 0; ai < 2; ++ai)
#pragma unroll
          for (int m = 0; m < 4; ++m) acc[ai][bj][m][n] += bv;
      }
    const int li0 = (u.pm - tb[33 + u.z]) * 256 + wr * 64 + fr, cnt = tb[66 + u.z];
    int av[2][4];
#pragma unroll
    for (int ai = 0; ai < 2; ++ai)
#pragma unroll
      for (int m = 0; m < 4; ++m) { const int li = li0 + ai * 128 + m * 16; av[ai][m] = elist[u.z * T_TOK + (li < cnt ? li : 0)]; if (li >= cnt) av[ai][m] = -1; }
#pragma unroll
    for (int ai = 0; ai < 2; ++ai)
#pragma unroll
      for (int m = 0; m < 4; ++m) {
        const int a = av[ai][m];
        if (a >= 0) {
          bf16_t* rowp = yslot + (size_t)a * DM + col0;
#pragma unroll
          for (int bj = 0; bj < 2; ++bj) {
            const f32x4 v0 = acc[ai][bj][m][0], v1 = acc[ai][bj][m][1];
            u32x4 w; w.x = pk2(v0[0], v0[1]); w.y = pk2(v0[2], v0[3]); w.z = pk2(v1[0], v1[1]); w.w = pk2(v1[2], v1[3]);
            *(u32x4*)(rowp + bj * 128) = w;
          }
        }
      }
  }
};
__device__ void ph_moe2(const Params& p, PG8_LAS unsigned char* lds, int nblk, int bid) {
  PG8_LAS int* tb = (PG8_LAS int*)(lds + pg8::STAGE_BYTES);
  moe_table(p, tb, 4);
  SchedMoe<false> S; S.tb = tb; S.NT = 4; S.G = nblk; S.c = bid; S.nwg = tb[NE]; S.A = (const char*)p.act8; S.B = (const char*)p.wd8; S.bexp = (size_t)1024 * DM; S.elist = p.elist; S.rowb = DM;
  EpiMoe2 E{p.b_down, p.elist, tb, p.yslot};
  pg8::gemm_phase<EpiMoe2, SchedMoe<false>, true>(lds, p.tid, DM / 2, DM / 2, DM / 2, S, E);
}

typedef short bf16x8 __attribute__((ext_vector_type(8)));
#define LAS __attribute__((address_space(3)))
#define MFMA16(a, b, c) __builtin_amdgcn_mfma_f32_16x16x32_bf16((a), (b), (c), 0, 0, 0)
__device__ __forceinline__ bf16x8 pack8(float a0, float a1, float a2, float a3, float a4, float a5, float a6, float a7) {
  u32x4 w; w.x = pk2(a0, a1); w.y = pk2(a2, a3); w.z = pk2(a4, a5); w.w = pk2(a6, a7);
  return __builtin_bit_cast(bf16x8, w);
}
__device__ __forceinline__ bf16_t f2bf_hw(float a) { return (bf16_t)(pk2(a, 0.f) & 0xffffu); }

#define DN_ABYTES 57344
#define DN_UFLOATS 8192
#define F_WN 0
#define F_QD 16
#define F_QK 32
#define F_KT 40

#define DP_KH 0
#define DP_QT 17408
#define DP_KHT 34816
#define DP_VT 53248
#define DP_TU 71680
#define DP_TW 80896
#define DP_LF 90112
#define DP_GC 107520
#define DP_BETA 107776
#define DP_CW 108032
#define DP_LB 114176
#define DP_TR 123392
#define DP_TT 132608
#define DP_MT 141824
#define DP_TOTAL 144128

template <int KS>
__device__ __forceinline__ f32x4 prod16(const LAS bf16_t* A, int lda, int arow0, const LAS bf16_t* Bt, int ldb, int brow0, f32x4 acc, int lane) {
  const int r = lane & 15, q = lane >> 4;
#pragma unroll
  for (int ks = 0; ks < KS; ++ks) {
    const bf16x8 a = *(const LAS bf16x8*)(A + (arow0 + r) * lda + 32 * ks + 8 * q);
    const bf16x8 b = *(const LAS bf16x8*)(Bt + (brow0 + r) * ldb + 32 * ks + 8 * q);
    acc = MFMA16(a, b, acc);
  }
  return acc;
}
__device__ __forceinline__ void tile_store_rm(LAS bf16_t* X, int ld, int row0, int col0, const f32x4 v, int lane) {
  const int r = lane & 15, q = lane >> 4;
#pragma unroll
  for (int i = 0; i < 4; ++i) X[(row0 + 4 * q + i) * ld + col0 + r] = f2bf_hw(v[i]);
}
__device__ __forceinline__ void tile_store_tr(LAS bf16_t* Xt, int ld, int row0, int col0, const f32x4 v, int lane) {
  const int r = lane & 15, q = lane >> 4;
  u32x2 w; w.x = pk2(v[0], v[1]); w.y = pk2(v[2], v[3]);
  *(LAS u32x2*)(Xt + (col0 + r) * ld + row0 + 4 * q) = w;
}

__device__ void dn_prep_chunk(const Params& p, LAS unsigned char* lds, int ci, bool load_cw) {
  const int tid = p.tid, lane = tid & 63, w = tid >> 6, r16 = lane & 15, q4 = lane >> 4;
  const int bh = ci >> 6, n = ci & 63, b = bh >> 2, h = bh & 3;
  LAS bf16_t* Kh = (LAS bf16_t*)(lds + DP_KH); LAS bf16_t* Qt = (LAS bf16_t*)(lds + DP_QT);
  LAS bf16_t* KhT = (LAS bf16_t*)(lds + DP_KHT); LAS bf16_t* VT = (LAS bf16_t*)(lds + DP_VT);
  LAS bf16_t* Tu = (LAS bf16_t*)(lds + DP_TU); LAS bf16_t* Tw = (LAS bf16_t*)(lds + DP_TW); LAS float* Lf = (LAS float*)(lds + DP_LF);
  LAS bf16_t* Lb = (LAS bf16_t*)(lds + DP_LB); LAS bf16_t* Tr = (LAS bf16_t*)(lds + DP_TR); LAS bf16_t* Tt = (LAS bf16_t*)(lds + DP_TT); LAS bf16_t* Mt = (LAS bf16_t*)(lds + DP_MT);
  LAS float* gcb = (LAS float*)(lds + DP_GC); LAS float* betab = (LAS float*)(lds + DP_BETA); LAS float* cw = (LAS float*)(lds + DP_CW);
  unsigned char* gA = (unsigned char*)p.dnA + (size_t)ci * DN_ABYTES;
  float* gU = p.dnU + (size_t)ci * DN_UFLOATS;

  if (load_cw) {
    for (int i = tid; i < 4 * 384; i += 512) { const int tap = i / 384, cc = i % 384, part = cc >> 7, d = cc & 127; cw[i] = p.conv_w[tap * 1536 + part * 512 + h * 128 + d]; }
  }
  __syncthreads();
  const int c = tid >> 3, g = tid & 7;
  const int s = n * 64 + c;
  const size_t t = (size_t)b * SEQ + s;
  float qv[16], kv[16], vv[16];
#pragma unroll
  for (int j = 0; j < 16; ++j) { qv[j] = 0.f; kv[j] = 0.f; vv[j] = 0.f; }
#pragma unroll
  for (int tap = 0; tap < 4; ++tap) {
    const int ss = s - 3 + tap;
    if (ss >= 0) {
      const bf16_t* row = p.proj + (t - 3 + tap) * PW + h * 128 + 16 * g;
      float x[8];
#pragma unroll
      for (int part = 0; part < 3; ++part) {
#pragma unroll
        for (int hh = 0; hh < 2; ++hh) {
          unpack8(*(const u32x4*)(row + part * 512 + 8 * hh), x);
#pragma unroll
          for (int j = 0; j < 8; ++j) {
            const float wv = cw[tap * 384 + part * 128 + 16 * g + 8 * hh + j];
            if (part == 0) qv[8 * hh + j] += wv * x[j];
            if (part == 1) kv[8 * hh + j] += wv * x[j];
            if (part == 2) vv[8 * hh + j] += wv * x[j];
          }
        }
      }
    }
    asm volatile("" ::: "memory");
  }
  float sq = 0.f, sk = 0.f;
#pragma unroll
  for (int j = 0; j < 16; ++j) { qv[j] = siluf_(qv[j]); kv[j] = siluf_(kv[j]); vv[j] = siluf_(vv[j]); sq += qv[j] * qv[j]; sk += kv[j] * kv[j]; }
  sq += __shfl_xor(sq, 1, 64); sq += __shfl_xor(sq, 2, 64); sq += __shfl_xor(sq, 4, 64);
  sk += __shfl_xor(sk, 1, 64); sk += __shfl_xor(sk, 2, 64); sk += __shfl_xor(sk, 4, 64);
  const float rq = rsqrtf(sq + 1e-6f) * 0.08838834764831845f, rk = rsqrtf(sk + 1e-6f);
#pragma unroll
  for (int j = 0; j < 16; ++j) { qv[j] *= rq; kv[j] *= rk; }
  if (g == 0) {
    const float bb = p.ba[t * 8 + h], aa = p.ba[t * 8 + 4 + h];
    const float xx = aa + p.dt_bias[h];
    const float sp = xx > 20.f ? xx : log1pf(__expf(xx));
    betab[c] = sigmoidf_(bb);
    gcb[c] = -__expf(p.a_log[h]) * sp;
  }
  {
    u32x4 w0, w1;
    w0.x = pk2(kv[0], kv[1]); w0.y = pk2(kv[2], kv[3]); w0.z = pk2(kv[4], kv[5]); w0.w = pk2(kv[6], kv[7]);
    w1.x = pk2(kv[8], kv[9]); w1.y = pk2(kv[10], kv[11]); w1.z = pk2(kv[12], kv[13]); w1.w = pk2(kv[14], kv[15]);
    *(LAS u32x4*)(Kh + c * 136 + 16 * g) = w0; *(LAS u32x4*)(Kh + c * 136 + 16 * g + 8) = w1;
    w0.x = pk2(qv[0], qv[1]); w0.y = pk2(qv[2], qv[3]); w0.z = pk2(qv[4], qv[5]); w0.w = pk2(qv[6], qv[7]);
    w1.x = pk2(qv[8], qv[9]); w1.y = pk2(qv[10], qv[11]); w1.z = pk2(qv[12], qv[13]); w1.w = pk2(qv[14], qv[15]);
    *(LAS u32x4*)(Qt + c * 136 + 16 * g) = w0; *(LAS u32x4*)(Qt + c * 136 + 16 * g + 8) = w1;
#pragma unroll
    for (int j = 0; j < 16; ++j) { KhT[(16 * g + j) * 72 + c] = f2bf_hw(kv[j]); VT[(16 * g + j) * 72 + c] = f2bf_hw(vv[j]); }
  }
  __syncthreads();
  if (w == 0) {
    float v = gcb[lane];
#pragma unroll
    for (int o = 1; o < 64; o <<= 1) { const float u = __shfl_up(v, o, 64); if (lane >= o) v += u; }
    gcb[lane] = v;
  }
  __syncthreads();
  const float gc_c = gcb[c], gl = gcb[63];
  {
    const float eg = __expf(gc_c);
    unsigned char* fb = gA + (size_t)(F_QD + (c >> 4) * 4 + (g >> 1)) * 1024 + (g & 1) * 8;
#pragma unroll
    for (int qq = 0; qq < 4; ++qq) {
      u32x2 wv; wv.x = pk2(qv[4 * qq] * eg, qv[4 * qq + 1] * eg); wv.y = pk2(qv[4 * qq + 2] * eg, qv[4 * qq + 3] * eg);
      *(u32x2*)(fb + ((c & 15) + 16 * qq) * 16) = wv;
    }
  }
  const int rt = w >> 1, ct0 = 2 * (w & 1);
#pragma unroll
  for (int tt = 0; tt < 2; ++tt) {
    const int ct = ct0 + tt;
    f32x4 gacc = {0.f, 0.f, 0.f, 0.f};
    gacc = prod16<4>(Kh, 136, 16 * rt, Kh, 136, 16 * ct, gacc, lane);
    const int m = 16 * ct + r16; const float gc_m = gcb[m];
    f32x4 lv;
#pragma unroll
    for (int i = 0; i < 4; ++i) {
      const int cc = 16 * rt + 4 * q4 + i;
      lv[i] = (m < cc) ? betab[cc] * gacc[i] * __expf(gcb[cc] - gc_m) : 0.f;
      Lf[cc * 68 + m] = lv[i];
    }
    tile_store_rm(Lb, 72, 16 * rt, 16 * ct, lv, lane);
    f32x4 qacc = {0.f, 0.f, 0.f, 0.f};
    qacc = prod16<4>(Kh, 136, 16 * rt, Qt, 136, 16 * ct, qacc, lane);
    const int cq = 16 * ct + r16; const float gc_cq = gcb[cq];
    float o4[4];
#pragma unroll
    for (int i = 0; i < 4; ++i) { const int mm = 16 * rt + 4 * q4 + i; o4[i] = (mm <= cq) ? qacc[i] * __expf(gc_cq - gcb[mm]) : 0.f; }
    u32x2 wv; wv.x = pk2(o4[0], o4[1]); wv.y = pk2(o4[2], o4[3]);
    *(u32x2*)(gA + (size_t)(F_QK + ct * 2 + (rt >> 1)) * 1024 + (r16 + 16 * q4) * 16 + (rt & 1) * 8) = wv;
  }
  __syncthreads();
  for (int i = tid; i < 2 * 64 * 72 / 8; i += 512) ((LAS u32x4*)Tr)[i] = (u32x4){0u, 0u, 0u, 0u};
  __syncthreads();
  if (w == 0) {
    int lo = lane; asm volatile("" : "+v"(lo));
    const int g = lo >> 4, j = lo & 15;
    unsigned lfb = DP_LF + (16 * g * 68 + 16 * g) * 4; asm volatile("" : "+v"(lfb));
    const LAS float* Lg = (const LAS float*)(lds + lfb);
    float t[16];
#pragma unroll
    for (int r = 0; r < 16; ++r) {
      float a0 = (r == j) ? 1.f : 0.f, a1 = 0.f;
#pragma unroll
      for (int k4 = 0; k4 < (r + 3) / 4; ++k4) {
        const f32x4 l = *(const LAS f32x4*)(Lg + r * 68 + 4 * k4);
        if (4 * k4 + 0 < r) a0 -= l[0] * t[4 * k4 + 0];
        if (4 * k4 + 1 < r) a1 -= l[1] * t[4 * k4 + 1];
        if (4 * k4 + 2 < r) a0 -= l[2] * t[4 * k4 + 2];
        if (4 * k4 + 3 < r) a1 -= l[3] * t[4 * k4 + 3];
      }
      t[r] = a0 + a1;
      Tr[(16 * g + r) * 72 + 16 * g + j] = f2bf_hw(t[r]);
    }
    u32x4 w0, w1;
    w0.x = pk2(t[0], t[1]); w0.y = pk2(t[2], t[3]); w0.z = pk2(t[4], t[5]); w0.w = pk2(t[6], t[7]);
    w1.x = pk2(t[8], t[9]); w1.y = pk2(t[10], t[11]); w1.z = pk2(t[12], t[13]); w1.w = pk2(t[14], t[15]);
    *(LAS u32x4*)(Tt + (16 * g + j) * 72 + 16 * g) = w0; *(LAS u32x4*)(Tt + (16 * g + j) * 72 + 16 * g + 8) = w1;
  }
  __syncthreads();
#pragma unroll 1
  for (int d = 1; d <= 3; ++d) {
    const bool act = w < 4 - d;
    const int I = w + d, J = w;
    LAS bf16_t* Mw = Mt + w * 16 * 24;
    if (act) {
      f32x4 macc = {0.f, 0.f, 0.f, 0.f};
      macc = prod16<2>(Lb, 72, 16 * I, Tt, 72, 16 * J, macc, lane);
      tile_store_tr(Mw, 24, 0, 0, macc, lane);
    }
    __syncthreads();
    if (act) {
      bf16x8 a = {0, 0, 0, 0, 0, 0, 0, 0}, bb = {0, 0, 0, 0, 0, 0, 0, 0};
      if (q4 < 2) { a = *(const LAS bf16x8*)(Tr + (16 * I + r16) * 72 + 16 * I + 8 * q4); bb = *(const LAS bf16x8*)(Mw + r16 * 24 + 8 * q4); }
      f32x4 tacc = {0.f, 0.f, 0.f, 0.f};
      tacc = MFMA16(a, bb, tacc);
#pragma unroll
      for (int i = 0; i < 4; ++i) tacc[i] = -tacc[i];
      tile_store_rm(Tr, 72, 16 * I, 16 * J, tacc, lane);
      tile_store_tr(Tt, 72, 16 * I, 16 * J, tacc, lane);
    }
    __syncthreads();
  }
  {
    const int cc = tid >> 3, m0 = (tid & 7) * 8;
    float tv[8]; unpack8(*(const LAS u32x4*)(Tr + cc * 72 + m0), tv);
    float tu[8], tw[8];
#pragma unroll
    for (int jj = 0; jj < 8; ++jj) { const float bm = betab[m0 + jj]; tu[jj] = tv[jj] * bm; tw[jj] = tu[jj] * __expf(gcb[m0 + jj]); }
    u32x4 wu, ww;
    wu.x = pk2(tu[0], tu[1]); wu.y = pk2(tu[2], tu[3]); wu.z = pk2(tu[4], tu[5]); wu.w = pk2(tu[6], tu[7]);
    ww.x = pk2(tw[0], tw[1]); ww.y = pk2(tw[2], tw[3]); ww.z = pk2(tw[4], tw[5]); ww.w = pk2(tw[6], tw[7]);
    *(LAS u32x4*)(Tu + cc * 72 + m0) = wu; *(LAS u32x4*)(Tw + cc * 72 + m0) = ww;
  }
  __syncthreads();
#pragma unroll
  for (int rr = 0; rr < 4; ++rr) {
    f32x4 u = {0.f, 0.f, 0.f, 0.f};
    u = prod16<2>(Tu, 72, 16 * rr, VT, 72, 16 * w, u, lane);
    *(f32x4*)(gU + ((w * 4 + rr) * 64 + lane) * 4) = u;
    f32x4 wt = {0.f, 0.f, 0.f, 0.f};
    wt = prod16<2>(KhT, 72, 16 * w, Tw, 72, 16 * rr, wt, lane);
    u32x2 wv; wv.x = pk2(-wt[0], -wt[1]); wv.y = pk2(-wt[2], -wt[3]);
    *(u32x2*)(gA + (size_t)(F_WN + rr * 4 + (w >> 1)) * 1024 + (r16 + 16 * q4) * 16 + (w & 1) * 8) = wv;
  }
#pragma unroll
  for (int it = 0; it < 4; ++it) {
    const int idx = tid + it * 512; const int d = idx >> 4, m4 = idx & 15;
    const u32x2 raw = *(const LAS u32x2*)(KhT + d * 72 + 4 * m4);
    const float k0 = __uint_as_float(raw.x << 16), k1 = __uint_as_float(raw.x & 0xffff0000u), k2 = __uint_as_float(raw.y << 16), k3 = __uint_as_float(raw.y & 0xffff0000u);
    const float e0 = __expf(gl - gcb[4 * m4]), e1 = __expf(gl - gcb[4 * m4 + 1]), e2 = __expf(gl - gcb[4 * m4 + 2]), e3 = __expf(gl - gcb[4 * m4 + 3]);
    u32x2 wv; wv.x = pk2(k0 * e0, k1 * e1); wv.y = pk2(k2 * e2, k3 * e3);
    *(u32x2*)(gA + (size_t)(F_KT + (d >> 4) * 2 + (m4 >> 3)) * 1024 + ((d & 15) + 16 * (m4 & 3)) * 16 + ((m4 >> 2) & 1) * 8) = wv;
  }
  if (tid == 0) p.dnG[ci] = __expf(gl);
}

#define DS_A0 0
#define DS_A1 57344
#define DS_TOTAL 114688
__device__ void dn_scan_blk(const Params& p, LAS unsigned char* lds, int item) {
  const int tid = p.tid, lane = tid & 63, w = __builtin_amdgcn_readfirstlane(tid >> 6), r16 = lane & 15, q4 = lane >> 4;
  const int bh = item >> 1, eh = item & 1, b = bh >> 2, h = bh & 3;
  const int et = eh * 4 + (w & 3);
  const bool comp = w < 4;
  const unsigned char* gA = (const unsigned char*)p.dnA + (size_t)bh * 64 * DN_ABYTES;
  const float* gU = p.dnU + (size_t)bh * 64 * DN_UFLOATS;
  const float* gG = p.dnG + bh * 64;
  auto issue_A = [&](int n, int buf) {
#pragma unroll
    for (int i = 0; i < 7; ++i) {
      const int f = w * 7 + i;
      __builtin_amdgcn_global_load_lds((const unsigned*)(gA + (size_t)n * DN_ABYTES + f * 1024 + lane * 16), (LAS unsigned*)(lds + (buf ? DS_A1 : DS_A0) + f * 1024), 16, 0, 0);
    }
  };
  __syncthreads();
  issue_A(0, 0);
  f32x4 Un[4];
#pragma unroll
  for (int rr = 0; rr < 4; ++rr) Un[rr] = *(const f32x4*)(gU + ((et * 4 + rr) * 64 + lane) * 4);
  f32x4 S[8];
#pragma unroll
  for (int dt = 0; dt < 8; ++dt) S[dt] = (f32x4){0.f, 0.f, 0.f, 0.f};
  asm volatile("s_waitcnt vmcnt(0)" ::: "memory");
  __syncthreads();
  bf16_t* obase = p.dn_out + ((size_t)b * SEQ) * p.dn_out_ld + h * 128 + 16 * et + r16;
  f32x4 Op[4];
#pragma unroll
  for (int rr = 0; rr < 4; ++rr) Op[rr] = (f32x4){0.f, 0.f, 0.f, 0.f};
  float gnext = gG[0];
#pragma unroll 1
  for (int n = 0; n < 64; ++n) {
    const LAS unsigned char* Ab = lds + ((n & 1) ? DS_A1 : DS_A0);
    if (n + 1 < 64) issue_A(n + 1, (n + 1) & 1);
    if (comp) {
      if (n > 0) {
#pragma unroll
        for (int rr = 0; rr < 4; ++rr)
#pragma unroll
          for (int i = 0; i < 4; ++i) obase[(size_t)((n - 1) * 64 + 16 * rr + 4 * q4 + i) * p.dn_out_ld] = f2bf_hw(Op[rr][i]);
      }
      f32x4 Vn[4];
#pragma unroll
      for (int rr = 0; rr < 4; ++rr) Vn[rr] = Un[rr];
      if (n + 1 < 64) {
#pragma unroll
        for (int rr = 0; rr < 4; ++rr) Un[rr] = *(const f32x4*)(gU + (size_t)(n + 1) * DN_UFLOATS + ((et * 4 + rr) * 64 + lane) * 4);
      }
      const float gdec = gnext;
      if (n + 1 < 64) gnext = gG[n + 1];
      bf16x8 Sb[4];
#pragma unroll
      for (int ks = 0; ks < 4; ++ks) Sb[ks] = pack8(S[2 * ks][0], S[2 * ks][1], S[2 * ks][2], S[2 * ks][3], S[2 * ks + 1][0], S[2 * ks + 1][1], S[2 * ks + 1][2], S[2 * ks + 1][3]);
#pragma unroll
      for (int dt = 0; dt < 8; ++dt) S[dt] *= gdec;
#define LDF(idx) (*(const LAS bf16x8*)(Ab + (idx) * 1024 + lane * 16))
#define SBAR __builtin_amdgcn_sched_barrier(0)
      bf16x8 fa[8], fb[8];
      f32x4 O[4];
#pragma unroll
      for (int rr = 0; rr < 4; ++rr) O[rr] = (f32x4){0.f, 0.f, 0.f, 0.f};
#pragma unroll
      for (int i = 0; i < 4; ++i) { fa[i] = LDF(F_WN + i); fa[4 + i] = LDF(F_QD + i); }
      SBAR;
#pragma unroll
      for (int i = 0; i < 4; ++i) { fb[i] = LDF(F_WN + 4 + i); fb[4 + i] = LDF(F_QD + 4 + i); }
      SBAR;
#pragma unroll
      for (int ks = 0; ks < 4; ++ks) { Vn[0] = MFMA16(fa[ks], Sb[ks], Vn[0]); O[0] = MFMA16(fa[4 + ks], Sb[ks], O[0]); }
      SBAR;
#pragma unroll
      for (int i = 0; i < 4; ++i) { fa[i] = LDF(F_WN + 8 + i); fa[4 + i] = LDF(F_QD + 8 + i); }
      SBAR;
#pragma unroll
      for (int ks = 0; ks < 4; ++ks) { Vn[1] = MFMA16(fb[ks], Sb[ks], Vn[1]); O[1] = MFMA16(fb[4 + ks], Sb[ks], O[1]); }
      SBAR;
#pragma unroll
      for (int i = 0; i < 4; ++i) { fb[i] = LDF(F_WN + 12 + i); fb[4 + i] = LDF(F_QD + 12 + i); }
      SBAR;
#pragma unroll
      for (int ks = 0; ks < 4; ++ks) { Vn[2] = MFMA16(fa[ks], Sb[ks], Vn[2]); O[2] = MFMA16(fa[4 + ks], Sb[ks], O[2]); }
      SBAR;
#pragma unroll
      for (int i = 0; i < 8; ++i) fa[i] = LDF(F_QK + i);
      SBAR;
#pragma unroll
      for (int ks = 0; ks < 4; ++ks) { Vn[3] = MFMA16(fb[ks], Sb[ks], Vn[3]); O[3] = MFMA16(fb[4 + ks], Sb[ks], O[3]); }
      SBAR;
#pragma unroll
      for (int i = 0; i < 8; ++i) fb[i] = LDF(F_KT + i);
      SBAR;
      bf16x8 Vb[2];
#pragma unroll
      for (int ks = 0; ks < 2; ++ks) Vb[ks] = pack8(Vn[2 * ks][0], Vn[2 * ks][1], Vn[2 * ks][2], Vn[2 * ks][3], Vn[2 * ks + 1][0], Vn[2 * ks + 1][1], Vn[2 * ks + 1][2], Vn[2 * ks + 1][3]);
#pragma unroll
      for (int ks = 0; ks < 2; ++ks)
#pragma unroll
        for (int rr = 0; rr < 4; ++rr) O[rr] = MFMA16(fa[rr * 2 + ks], Vb[ks], O[rr]);
      SBAR;
#pragma unroll
      for (int i = 0; i < 8; ++i) fa[i] = LDF(F_KT + 8 + i);
      SBAR;
#pragma unroll
      for (int ks = 0; ks < 2; ++ks)
#pragma unroll
        for (int dt = 0; dt < 4; ++dt) S[dt] = MFMA16(fb[dt * 2 + ks], Vb[ks], S[dt]);
      SBAR;
#pragma unroll
      for (int ks = 0; ks < 2; ++ks)
#pragma unroll
        for (int dt = 0; dt < 4; ++dt) S[4 + dt] = MFMA16(fa[dt * 2 + ks], Vb[ks], S[4 + dt]);
#pragma unroll
      for (int rr = 0; rr < 4; ++rr) Op[rr] = O[rr];
#undef LDF
#undef SBAR
    }
    asm volatile("s_waitcnt vmcnt(0)" ::: "memory");
    __syncthreads();
  }
  if (comp) {
#pragma unroll
    for (int rr = 0; rr < 4; ++rr)
#pragma unroll
      for (int i = 0; i < 4; ++i) obase[(size_t)(63 * 64 + 16 * rr + 4 * q4 + i) * p.dn_out_ld] = f2bf_hw(Op[rr][i]);
  }
}
__device__ void ph_dn_norm(const Params& p, int nblk, int bid) {
  const int wid = p.tid >> 6, lane = p.tid & 63;
  const f32x4 g0 = *(const f32x4*)(p.g_dn_out + (lane & 15) * 8), g1 = *(const f32x4*)(p.g_dn_out + (lane & 15) * 8 + 4);
  for (int t = bid * 8 + wid; t < T_TOK; t += nblk * 8) {
    bf16_t* op = p.oab + (size_t)t * DM + lane * 8;
    float o[8], z[8];
    unpack8(*(const u32x4*)op, o);
    unpack8(*(const u32x4*)(p.proj + (size_t)t * PW + C_Z + lane * 8), z);
    float ss = 0.f;
#pragma unroll
    for (int j = 0; j < 8; ++j) ss += o[j] * o[j];
    ss += __shfl_xor(ss, 1, 64); ss += __shfl_xor(ss, 2, 64); ss += __shfl_xor(ss, 4, 64); ss += __shfl_xor(ss, 8, 64);
    const float rstd = rsqrtf(ss * (1.f / 128.f) + 1e-6f);
    float y[8];
#pragma unroll
    for (int j = 0; j < 4; ++j) { y[j] = o[j] * rstd * g0[j] * siluf_(z[j]); y[4 + j] = o[4 + j] * rstd * g1[j] * siluf_(z[4 + j]); }
    u32x4 w; w.x = pk2(y[0], y[1]); w.y = pk2(y[2], y[3]); w.z = pk2(y[4], y[5]); w.w = pk2(y[6], y[7]);
    *(u32x4*)op = w;
  }
}
typedef float f32x16 __attribute__((ext_vector_type(16)));
#define MFMA32(a, b, c) __builtin_amdgcn_mfma_f32_32x32x16_bf16((a), (b), (c), 0, 0, 0)
#define MP_VL 0
#define MP_RED 65536
#define MP_TOTAL (65536 + 4096)

__device__ void moba_prep_block(const Params& p, LAS unsigned char* lds, int item) {
  const int tid = p.tid, lane = tid & 63, w = tid >> 6;
  const int bh = item >> 4, jb = item & 15, b = bh >> 2, h = bh & 3;
  LAS bf16_t* Vl = (LAS bf16_t*)(lds + MP_VL);
  LAS float* red = (LAS float*)(lds + MP_RED);
  __syncthreads();
#pragma unroll
  for (int it = 0; it < 8; ++it) {
    const int idx = tid + 512 * it, row = idx >> 4, ch = idx & 15;
    const u32x4 v = *(const u32x4*)(p.proj + ((size_t)b * SEQ + 256 * jb + row) * PW + C_MV + h * 128 + 8 * ch);
    *(LAS u32x4*)(Vl + row * 128 + 8 * ch) = v;
  }
  {
    const int r = tid >> 1, hh = tid & 1;
    const int pos = 256 * jb + r;
    const size_t t = (size_t)b * SEQ + pos;
    float cs[8], sn[8];
#pragma unroll
    for (int jj = 0; jj < 8; ++jj) {
      const float inv = exp2f(-(float)(8 * hh + jj) * (1.f / 16.f) * 18.931568569324174f);
      const float ang = (float)pos * inv;
      cs[jj] = cosf(ang); sn[jj] = sinf(ang);
    }
    float kacc[64];
#pragma unroll
    for (int which = 0; which < 2; ++which) {
      const bf16_t* src = p.proj + t * PW + (which ? C_MQ : C_MK) + h * 128 + 8 * hh;
      float x0[8], x1[8];
      unpack8(*(const u32x4*)(src), x0); unpack8(*(const u32x4*)(src + 16), x1);
      float y0[8], y1[8];
#pragma unroll
      for (int jj = 0; jj < 8; ++jj) { y0[jj] = x0[jj] * cs[jj] - x1[jj] * sn[jj]; y1[jj] = x1[jj] * cs[jj] + x0[jj] * sn[jj]; }
      u32x4 o[8];
      o[0].x = pk2(y0[0], y0[1]); o[0].y = pk2(y0[2], y0[3]); o[0].z = pk2(y0[4], y0[5]); o[0].w = pk2(y0[6], y0[7]);
      o[1].x = pk2(y1[0], y1[1]); o[1].y = pk2(y1[2], y1[3]); o[1].z = pk2(y1[4], y1[5]); o[1].w = pk2(y1[6], y1[7]);
#pragma unroll
      for (int ks = 2; ks < 8; ++ks) o[ks] = *(const u32x4*)(src + 16 * ks);
      if (which == 0) {
#pragma unroll
        for (int jj = 0; jj < 8; ++jj) { kacc[jj] = y0[jj]; kacc[8 + jj] = y1[jj]; }
#pragma unroll
        for (int ks = 2; ks < 8; ++ks) { float f[8]; unpack8(o[ks], f);
#pragma unroll
          for (int jj = 0; jj < 8; ++jj) kacc[8 * ks + jj] = f[jj]; }
        unsigned char* dst = (unsigned char*)p.Kp + ((size_t)(bh * 128 + 8 * jb + (r >> 5)) * 8192) + ((r & 31) + 32 * hh) * 16;
#pragma unroll
        for (int ks = 0; ks < 8; ++ks) *(u32x4*)(dst + ks * 1024) = o[ks];
      } else {
        bf16_t* dst = p.qb + ((size_t)bh * SEQ + pos) * 128 + 8 * hh;
#pragma unroll
        for (int ks = 0; ks < 8; ++ks) *(u32x4*)(dst + 16 * ks) = o[ks];
      }
    }
#pragma unroll
    for (int e = 0; e < 64; ++e) {
      float v = kacc[e];
      v += __shfl_xor(v, 2, 64); v += __shfl_xor(v, 4, 64); v += __shfl_xor(v, 8, 64); v += __shfl_xor(v, 16, 64); v += __shfl_xor(v, 32, 64);
      kacc[e] = v;
    }
    if (lane < 2) {
#pragma unroll
      for (int e = 0; e < 64; ++e) red[(w * 2 + lane) * 64 + e] = kacc[e];
    }
  }
  __syncthreads();
  if (tid < 128) {
    const int d = tid, hh = (d >> 3) & 1, ks = d >> 4, jj = d & 7;
    float a = 0.f;
#pragma unroll
    for (int ww = 0; ww < 8; ++ww) a += red[(ww * 2 + hh) * 64 + ks * 8 + jj];
    p.kmean[((size_t)bh * 16 + jb) * 128 + d] = a * (1.f / 256.f);
  }
#pragma unroll
  for (int it = 0; it < 8; ++it) {
    const int o = tid + 512 * it, ln = o & 63, frag = o >> 6, tl = frag >> 3, dt = (frag >> 1) & 3, s = frag & 1;
    const int r = ln & 31, hh = ln >> 5, d = 32 * dt + r;
    unsigned short e[8];
#pragma unroll
    for (int jj = 0; jj < 8; ++jj) { const int key = 32 * tl + 16 * s + 8 * (jj >> 2) + 4 * hh + (jj & 3); e[jj] = Vl[key * 128 + d]; }
    u32x4 wv; wv.x = e[0] | ((unsigned)e[1] << 16); wv.y = e[2] | ((unsigned)e[3] << 16); wv.z = e[4] | ((unsigned)e[5] << 16); wv.w = e[6] | ((unsigned)e[7] << 16);
    *(u32x4*)((unsigned char*)p.Vp + ((size_t)(bh * 128 + 8 * jb + tl) * 8192) + (dt * 2 + s) * 1024 + ln * 16) = wv;
  }
}
__device__ __forceinline__ int crow32(int reg, int hh) { return (reg & 3) + 8 * (reg >> 2) + 4 * hh; }
__device__ void moba_item(const Params& p, LAS float* km, LAS float* mrg, LAS float* ml, int bh, int ib, int sub, int par, int lane, int rep) {
  const int q = lane & 31, hh = lane >> 5;
  const int b = bh >> 2, h = bh & 3;
  const int s0 = 256 * ib + 32 * sub;
  const bf16_t* qrow = p.qb + ((size_t)bh * SEQ + s0 + q) * 128 + 8 * hh;
  bf16x8 Qf[8];
#pragma unroll
  for (int ks = 0; ks < 8; ++ks) Qf[ks] = *(const bf16x8*)(qrow + 16 * ks);
  LAS unsigned char* qlds = (LAS unsigned char*)km + 8192 + lane * 16;
#pragma unroll
  for (int ks = 0; ks < 8; ++ks) *(LAS bf16x8*)(qlds + ks * 1024) = Qf[ks];
  unsigned selmask = 0;
  if (ib > 0) {
    for (int idx = lane; idx < ib * 32; idx += 64) ((LAS f32x4*)km)[idx] = ((const f32x4*)(p.kmean + (size_t)bh * 16 * 128))[idx];
    float qf[64];
#pragma unroll
    for (int ks = 0; ks < 8; ++ks) { float f[8]; unpack8(__builtin_bit_cast(u32x4, Qf[ks]), f);
#pragma unroll
      for (int jj = 0; jj < 8; ++jj) qf[8 * ks + jj] = f[jj]; }
    float sc[16];
#pragma unroll
    for (int j = 0; j < 16; ++j) {
      sc[j] = -INFINITY;
      if (j < ib) {
        float a = 0.f;
#pragma unroll
        for (int ks = 0; ks < 8; ++ks) {
          const f32x4 k0 = *(const LAS f32x4*)(km + j * 128 + 16 * ks + 8 * hh), k1 = *(const LAS f32x4*)(km + j * 128 + 16 * ks + 8 * hh + 4);
          a += qf[8 * ks] * k0[0] + qf[8 * ks + 1] * k0[1] + qf[8 * ks + 2] * k0[2] + qf[8 * ks + 3] * k0[3];
          a += qf[8 * ks + 4] * k1[0] + qf[8 * ks + 5] * k1[1] + qf[8 * ks + 6] * k1[2] + qf[8 * ks + 7] * k1[3];
        }
        a += __shfl_xor(a, 32, 64);
        sc[j] = a;
      }
    }
#pragma unroll
    for (int r = 0; r < 3; ++r) {
      if (r < ib) {
        float best = -INFINITY; int bi = 0;
#pragma unroll
        for (int j = 0; j < 16; ++j) if (sc[j] > best) { best = sc[j]; bi = j; }
        selmask |= 1u << bi;
#pragma unroll
        for (int j = 0; j < 16; ++j) if (j == bi) sc[j] = -INFINITY;
      }
    }
  }
  unsigned rem = 0;
  for (int j = 0; j < ib; ++j) if (__ballot((selmask >> j) & 1u) != 0ull) rem |= 1u << j;
  rem = __builtin_amdgcn_readfirstlane(rem);
  const int own0 = 8 * ib, diag = 8 * ib + sub;
  const float cscale = 0.08838834764831845f * 1.4426950408889634f;
  float m = -1e30f, l = 0.f;
  f32x16 O[4];
#pragma unroll
  for (int dt = 0; dt < 4; ++dt)
#pragma unroll
    for (int r = 0; r < 16; ++r) O[dt][r] = 0.f;
  const unsigned char* kbase = (const unsigned char*)p.Kp + (size_t)bh * 128 * 8192 + lane * 16;
  const unsigned char* vbase = (const unsigned char*)p.Vp + (size_t)bh * 128 * 8192 + lane * 16;
  auto adv = [&](int& kt_, unsigned& rem_) {
    if (kt_ < 0) return;
    if (kt_ >= own0 ? (kt_ < diag) : ((kt_ & 7) != 7)) { kt_ = kt_ + 1; return; }
    if (rem_ == 0u) { kt_ = -1; return; }
    kt_ = 8 * (__builtin_ctz(rem_)); rem_ &= rem_ - 1u;
  };
  int kt = own0;
  if (par) adv(kt, rem);
  auto load_k = [&](int t, bf16x8 (&K_)[8]) {
#pragma unroll
    for (int ks = 0; ks < 8; ++ks) K_[ks] = *(const bf16x8*)(kbase + (size_t)t * 8192 + ks * 1024);
  };
  auto tile_step = [&](bf16x8 (&Kc)[8], bf16x8 (&Kn)[8]) -> bool {
    int ktn = kt; unsigned remn = rem;
    adv(ktn, remn); adv(ktn, remn);
    bf16x8 Vf[8];
#pragma unroll
    for (int f = 0; f < 8; ++f) Vf[f] = *(const bf16x8*)(vbase + (size_t)kt * 8192 + f * 1024);
    if (ktn >= 0) load_k(ktn, Kn);
    f32x16 S;
#pragma unroll
    for (int r = 0; r < 16; ++r) S[r] = 0.f;
#pragma unroll
    for (int ks = 0; ks < 8; ++ks) S = MFMA32(Kc[ks], *(const LAS bf16x8*)(qlds + ks * 1024), S);
    const bool allowed = (kt >= own0) || ((selmask >> (kt >> 3)) & 1u);
    const float nb = allowed ? 0.f : -INFINITY;
    float sv[16]; float mx = -INFINITY;
#pragma unroll
    for (int r = 0; r < 16; ++r) sv[r] = __builtin_fmaf(S[r], cscale, nb);
    if (kt == diag) {
#pragma unroll
      for (int r = 0; r < 16; ++r) if (crow32(r, hh) > q) sv[r] = -INFINITY;
    }
#pragma unroll
    for (int r = 0; r < 16; ++r) mx = fmaxf(mx, sv[r]);
    mx = fmaxf(mx, __shfl_xor(mx, 32, 64));
    const bool grow = mx > m + 8.f;
    const float mn = (__ballot(grow) != 0ull) ? fmaxf(m, mx) : m;
    const float alpha = __builtin_amdgcn_exp2f(m - mn);
    float ps = 0.f;
#pragma unroll
    for (int r = 0; r < 16; ++r) { sv[r] = __builtin_amdgcn_exp2f(sv[r] - mn); ps += sv[r]; }
    l = l * alpha + ps; m = mn;
    if (__ballot(alpha != 1.f) != 0ull) {
#pragma unroll
      for (int dt = 0; dt < 4; ++dt)
#pragma unroll
        for (int r = 0; r < 16; ++r) O[dt][r] *= alpha;
    }
    const bf16x8 P0 = pack8(sv[0], sv[1], sv[2], sv[3], sv[4], sv[5], sv[6], sv[7]);
    const bf16x8 P1 = pack8(sv[8], sv[9], sv[10], sv[11], sv[12], sv[13], sv[14], sv[15]);
#pragma unroll
    for (int dt = 0; dt < 4; ++dt) { O[dt] = MFMA32(Vf[dt * 2], P0, O[dt]); O[dt] = MFMA32(Vf[dt * 2 + 1], P1, O[dt]); }
    kt = ktn; rem = remn;
    return kt >= 0;
  };
  if (kt >= 0) {
    bf16x8 KA[8], KB[8];
    load_k(kt, KA);
#pragma unroll 1
    for (;;) {
      if (!tile_step(KA, KB)) break;
      asm volatile("" ::: "memory");
      if (!tile_step(KB, KA)) break;
      asm volatile("" ::: "memory");
    }
  }
  asm volatile("s_waitcnt vmcnt(0) lgkmcnt(0)" ::: "memory");
  if (par) {
    ml[lane] = m; ml[64 + lane] = l;
#pragma unroll
    for (int dt = 0; dt < 4; ++dt)
#pragma unroll
      for (int r = 0; r < 16; ++r) mrg[(dt * 16 + r) * 64 + lane] = O[dt][r];
  }
  __syncthreads();
  if (par == 0) {
    const float m2 = ml[lane], l2 = ml[64 + lane];
    const float mm = fmaxf(m, m2);
    const float a1 = __builtin_amdgcn_exp2f(m - mm), a2 = __builtin_amdgcn_exp2f(m2 - mm);
    l = l * a1 + l2 * a2;
#pragma unroll
    for (int dt = 0; dt < 4; ++dt)
#pragma unroll
      for (int r = 0; r < 16; ++r) O[dt][r] = O[dt][r] * a1 + mrg[(dt * 16 + r) * 64 + lane] * a2;
  }
  if (par == 0) {
  l += __shfl_xor(l, 32, 64);
  const float inv = 1.f / l;
  bf16_t* orow = rep ? p.oab2 + ((size_t)b * SEQ + s0 + q) * 512 + h * 128 : p.mb_out + ((size_t)b * SEQ + s0 + q) * p.mb_out_ld + p.mb_out_off + h * 128;
#pragma unroll
  for (int dt = 0; dt < 4; ++dt)
#pragma unroll
    for (int g4 = 0; g4 < 4; ++g4) {
      u32x2 wv; wv.x = pk2(O[dt][4 * g4] * inv, O[dt][4 * g4 + 1] * inv); wv.y = pk2(O[dt][4 * g4 + 2] * inv, O[dt][4 * g4 + 3] * inv);
      *(u32x2*)(orow + 32 * dt + 8 * g4 + 4 * hh) = wv;
    }
  }
  __syncthreads();
}
__device__ void moba_worker(const Params& p, LAS unsigned char* lds, int qi) {
  const int lane = p.tid & 63, w = __builtin_amdgcn_readfirstlane(p.tid >> 6);
  LAS float* km = (LAS float*)(lds + w * 16384);
  LAS float* mrg = (LAS float*)(lds + ((w & 3) + 4) * 16384);
  LAS float* ml = (LAS float*)(lds + 131072) + (w & 3) * 128;
  LAS int* slot = (LAS int*)(lds + 131072 + 2048);
  const int g0 = (int)((unsigned)__builtin_amdgcn_s_getreg((3 << 11) | 20) & 7u);
  for (int gi = 0; gi < 8; ++gi) {
    const int g = (g0 + gi) & 7;
    for (;;) {
      __syncthreads();
      if (p.tid == 0) slot[0] = atomicAdd(p.wq + qi * 8 + g, 1);
      __syncthreads();
      const int idx = slot[0];
      if (idx >= 64) break;
      const int bh = 2 * g + (idx >> 5), ib = 15 - ((idx >> 1) & 15), quad = 1 - (idx & 1);
      moba_item(p, km, mrg, ml, bh, ib, 4 * quad + (w & 3), w >> 2, lane, qi);
    }
  }
}
__device__ void ph_mod(const Params& p, LAS unsigned char* lds, int nblk, int bid) {
  LAS float* sc = (LAS float*)lds;
  LAS float* part = (LAS float*)(lds + 16384);
  const int tid = p.tid;
  if (bid >= 192) return;
  for (int i = tid; i < 4096; i += 512) sc[i] = siluf_(p.c[i]);
  __syncthreads();
  for (int task = bid; task < 192; task += nblk) {
    const int jj = tid & 31, ks = tid >> 5, j = task * 32 + jj;
    float a0 = 0.f, a1 = 0.f, a2 = 0.f, a3 = 0.f;
#pragma unroll 8
    for (int kk = 0; kk < 64; ++kk) {
      const int k = ks * 64 + kk;
      const float w = p.w_ada[(size_t)k * 6144 + j];
      a0 += sc[k] * w; a1 += sc[1024 + k] * w; a2 += sc[2048 + k] * w; a3 += sc[3072 + k] * w;
    }
    *(LAS f32x4*)(part + (ks * 32 + jj) * 4) = (f32x4){a0, a1, a2, a3};
    __syncthreads();
    if (tid < 128) {
      const int j2 = tid & 31, bb = tid >> 5;
      float a = 0.f;
#pragma unroll
      for (int s = 0; s < 16; ++s) a += part[(s * 32 + j2) * 4 + bb];
      p.mod[bb * 6144 + task * 32 + j2] = a + p.b_ada[task * 32 + j2];
    }
    __syncthreads();
  }
}

#define WT_T0 1424
#define WT_T1 (WT_T0 + 16384)
#define WT_T2 (WT_T1 + 8192)
#define WT_T3 (WT_T2 + 128)
#define WT_T4 (WT_T3 + 128)
#define WT_T5 (WT_T4 + 256)
struct WtTile { const float* src; bf16_t* dst; int K, N, mode, k0, n0; unsigned char* dst8; };
__device__ __forceinline__ WtTile wt_desc(const Params& p, int t) {
  WtTile d;
  if (t < WT_T0) { const int kt = t / 89, nt = t % 89; d = {p.w_in, p.w_in_t, 1024, INW, 1, kt * 64, nt * 64, nullptr}; }
  else if (t < WT_T1) { const int u = t - WT_T0, e = u >> 9, r = u & 511, kt = r >> 5, nt = r & 31; d = {p.w_gu + (size_t)e * 1024 * 2048, nullptr, 1024, 2048, 2, kt * 64, nt * 64, p.wgu8 + (size_t)e * 2048 * 1024}; }
  else if (t < WT_T2) { const int u = t - WT_T1, e = u >> 8, r = u & 255, kt = r >> 4, nt = r & 15; d = {p.w_down + (size_t)e * 1024 * 1024, nullptr, 1024, 1024, 0, kt * 64, nt * 64, p.wd8 + (size_t)e * 1024 * 1024}; }
  else if (t < WT_T3) { const int u = t - WT_T2, kt = u >> 4, nt = u & 15; d = {p.w_br_a, p.wbra_t, 512, 1024, 0, kt * 64, nt * 64, nullptr}; }
  else if (t < WT_T4) { const int u = t - WT_T3, kt = u >> 4, nt = u & 15; d = {p.w_br_b, p.wbrb_t, 512, 1024, 0, kt * 64, nt * 64, nullptr}; }
  else { const int u = t - WT_T4, kt = u >> 4, nt = u & 15; d = {p.w_o, p.wo_t, 1024, 1024, 0, kt * 64, nt * 64, nullptr}; }
  return d;
}
__device__ __forceinline__ void wt_load(const WtTile& d, int tid, f32x4 (&v)[2]) {
#pragma unroll
  for (int it = 0; it < 2; ++it) {
    const int row = (tid >> 4) + 32 * it, n = d.n0 + (tid & 15) * 4;
    v[it] = (f32x4){0.f, 0.f, 0.f, 0.f};
    if (n < d.N) v[it] = __builtin_nontemporal_load((const f32x4*)(d.src + (size_t)(d.k0 + row) * d.N + n));
  }
}
__device__ void ph_wt(const Params& p, LAS unsigned char* lds, int nblk, int bid) {
  LAS float* tile = (LAS float*)(lds + 32768);
  const int tid = p.tid;
  int t = bid;
  if (t >= WT_T5) return;
  WtTile cur = wt_desc(p, t);
  f32x4 v[2]; wt_load(cur, tid, v);
  WtTile nxt = cur; f32x4 vn[2] = {v[0], v[1]};
  if (t + nblk < WT_T5) { nxt = wt_desc(p, t + nblk); wt_load(nxt, tid, vn); }
  for (;;) {
    const int tnn = t + 2 * nblk;
    WtTile nn = nxt; f32x4 vnn[2] = {vn[0], vn[1]};
    if (tnn < WT_T5) { nn = wt_desc(p, tnn); wt_load(nn, tid, vnn); }
#pragma unroll
    for (int it = 0; it < 2; ++it) {
      const int row = (tid >> 4) + 32 * it, c4 = (tid & 15) * 4;
      tile[row * 65 + c4] = v[it][0]; tile[row * 65 + c4 + 1] = v[it][1]; tile[row * 65 + c4 + 2] = v[it][2]; tile[row * 65 + c4 + 3] = v[it][3];
    }
    __syncthreads();
    {
      const int nl = tid >> 3, kc = tid & 7, n = cur.n0 + nl;
      if (n < cur.N) {
        const int dd = map_col(n, cur.mode);
        if (dd >= 0) {
          float f[8];
#pragma unroll
          for (int j = 0; j < 8; ++j) f[j] = tile[(8 * kc + j) * 65 + nl];
          if (cur.dst8) {
            u32x2 w; w.x = pk4_fp8(f[0] * 64.f, f[1] * 64.f, f[2] * 64.f, f[3] * 64.f); w.y = pk4_fp8(f[4] * 64.f, f[5] * 64.f, f[6] * 64.f, f[7] * 64.f);
            *(u32x2*)(cur.dst8 + (size_t)dd * cur.K + cur.k0 + 8 * kc) = w;
          } else {
            u32x4 w; w.x = pk2(f[0], f[1]); w.y = pk2(f[2], f[3]); w.z = pk2(f[4], f[5]); w.w = pk2(f[6], f[7]);
            *(u32x4*)(cur.dst + (size_t)dd * cur.K + cur.k0 + 8 * kc) = w;
          }
        }
      }
    }
    __syncthreads();
    if (t + nblk >= WT_T5) break;
    t += nblk; cur = nxt; v[0] = vn[0]; v[1] = vn[1]; nxt = nn; vn[0] = vnn[0]; vn[1] = vnn[1];
  }
}

__device__ void ph_h(const Params& p, LAS unsigned char* lds, int nblk, int bid) {
  const int wid = p.tid >> 6, lane = p.tid & 63;
  LAS float* wb = (LAS float*)lds;
  for (int i = p.tid; i < 2048; i += 512) {
    const int k = i >> 1, hf = i & 1;
    const f32x4 v = *(const f32x4*)(p.w_in + (size_t)k * INW + 2048 + 4 * hf);
    wb[(4 * hf + 0) * 1024 + k] = v[0]; wb[(4 * hf + 1) * 1024 + k] = v[1]; wb[(4 * hf + 2) * 1024 + k] = v[2]; wb[(4 * hf + 3) * 1024 + k] = v[3];
  }
  __syncthreads();
  for (int t = bid * 8 + wid; t < T_TOK; t += nblk * 8) {
    const int b = t / SEQ;
    const float* xr = p.x + (size_t)t * DM;
    f32x4 xv[4];
    float ss = 0.f;
#pragma unroll
    for (int i = 0; i < 4; ++i) {
      xv[i] = *(const f32x4*)(xr + i * 256 + lane * 4);
      ss += xv[i][0] * xv[i][0] + xv[i][1] * xv[i][1] + xv[i][2] * xv[i][2] + xv[i][3] * xv[i][3];
    }
    ss = wave_sum(ss);
    const float rstd = rsqrtf(ss * (1.f / DM) + 1e-6f);
    const float* shift = p.mod + b * 6144;
    const float* scale = p.mod + b * 6144 + 1024;
    float acc[8] = {0, 0, 0, 0, 0, 0, 0, 0};
#pragma unroll
    for (int i = 0; i < 4; ++i) {
      const int k = i * 256 + lane * 4;
      const f32x4 g = *(const f32x4*)(p.g_pre_mix + k), sc = *(const f32x4*)(scale + k), sh = *(const f32x4*)(shift + k);
      f32x4 hv;
#pragma unroll
      for (int j = 0; j < 4; ++j) hv[j] = xv[i][j] * rstd * g[j] * (1.f + sc[j]) + sh[j];
#pragma unroll
      for (int e = 0; e < 8; ++e) { const f32x4 w = *(const LAS f32x4*)(wb + e * 1024 + k); acc[e] += hv[0] * w[0] + hv[1] * w[1] + hv[2] * w[2] + hv[3] * w[3]; }
      u32x2 pk; pk.x = pk2(hv[0], hv[1]); pk.y = pk2(hv[2], hv[3]);
      *(u32x2*)(p.hbf + (size_t)t * DM + k) = pk;
    }
#pragma unroll
    for (int e = 0; e < 8; ++e) acc[e] = wave_sum(acc[e]);
    if (lane == 0) { *(f32x4*)(p.ba + (size_t)t * 8) = (f32x4){acc[0], acc[1], acc[2], acc[3]}; *(f32x4*)(p.ba + (size_t)t * 8 + 4) = (f32x4){acc[4], acc[5], acc[6], acc[7]}; }
  }
}

__device__ void ph_post_mix(const Params& p, LAS unsigned char* lds, int nblk, int bid, int rep) {
  const int wid = p.tid >> 6, lane = p.tid & 63;
  LAS bf16_t* wl = (LAS bf16_t*)lds;
  LAS float* sh = (LAS float*)(lds + 81920) + wid * 1024;
  LAS int* lcnt = (LAS int*)(lds + 114688);
  LAS int* lbase = lcnt + 32;
  LAS int* lent = (LAS int*)(lds + 115200) + wid * 256;
  int nloc = 0;
  if (p.tid < 32) lcnt[p.tid] = 0;
  for (int i = p.tid; i < 1024 * 8; i += 512) {
    const int k = i >> 3, c = i & 7;
    const f32x4 v = *(const f32x4*)(p.w_router + (size_t)k * 32 + c * 4);
    u32x2 w2; w2.x = pk2(v[0], v[1]); w2.y = pk2(v[2], v[3]);
    *(LAS u32x2*)(wl + k * 40 + c * 4) = w2;
  }
  __syncthreads();
  u32x4 mxn[2]; f32x4 xn[4];
  {
    const int t0 = bid * 8 + wid;
    if (t0 < T_TOK) {
#pragma unroll
      for (int i = 0; i < 2; ++i) mxn[i] = *(const u32x4*)(p.mixer + (size_t)t0 * DM + i * 512 + lane * 8);
#pragma unroll
      for (int i = 0; i < 4; ++i) xn[i] = *(const f32x4*)(p.x + (size_t)t0 * DM + (i >> 1) * 512 + lane * 8 + (i & 1) * 4);
    }
  }
  for (int t = bid * 8 + wid; t < T_TOK; t += nblk * 8) {
    const int b = t / SEQ;
    const float* md = p.mod + b * 6144;
    u32x4 mxc[2] = {mxn[0], mxn[1]}; f32x4 xc[4] = {xn[0], xn[1], xn[2], xn[3]};
    {
      const int tn = t + nblk * 8;
      if (tn < T_TOK) {
#pragma unroll
        for (int i = 0; i < 2; ++i) mxn[i] = *(const u32x4*)(p.mixer + (size_t)tn * DM + i * 512 + lane * 8);
#pragma unroll
        for (int i = 0; i < 4; ++i) xn[i] = *(const f32x4*)(p.x + (size_t)tn * DM + (i >> 1) * 512 + lane * 8 + (i & 1) * 4);
      }
    }
    float mv[16];
    float ss = 0.f;
#pragma unroll
    for (int i = 0; i < 2; ++i) {
      float f[8]; unpack8(mxc[i], f);
#pragma unroll
      for (int j = 0; j < 8; ++j) { mv[i * 8 + j] = f[j]; ss += f[j] * f[j]; }
    }
    ss = wave_sum(ss);
    const float rstd = rsqrtf(ss * (1.f / DM) + 1e-6f);
    float x1[16];
    float s2 = 0.f;
#pragma unroll
    for (int i = 0; i < 2; ++i)
#pragma unroll
      for (int j4 = 0; j4 < 2; ++j4) {
        const int k = i * 512 + lane * 8 + j4 * 4;
        const f32x4 xv = xc[i * 2 + j4];
        const f32x4 gm = *(const f32x4*)(md + 2048 + k), gp = *(const f32x4*)(p.g_post_mix + k);
        f32x4 o;
#pragma unroll
        for (int j = 0; j < 4; ++j) { o[j] = xv[j] + gm[j] * (mv[i * 8 + j4 * 4 + j] * rstd * gp[j]); x1[i * 8 + j4 * 4 + j] = o[j]; s2 += o[j] * o[j]; }
        *(f32x4*)(p.out + (size_t)t * DM + k) = o;
      }
    s2 = wave_sum(s2);
    const float rstd2 = rsqrtf(s2 * (1.f / DM) + 1e-6f);
#pragma unroll
    for (int i = 0; i < 2; ++i) {
      float hv[8];
#pragma unroll
      for (int j = 0; j < 8; ++j) {
        const int k = i * 512 + lane * 8 + j;
        hv[j] = x1[i * 8 + j] * rstd2 * p.g_pre_ffn[k] * (1.f + md[4096 + k]) + md[3072 + k];
        sh[k] = hv[j];
      }
      u32x2 w; w.x = pk4_fp8(hv[0], hv[1], hv[2], hv[3]); w.y = pk4_fp8(hv[4], hv[5], hv[6], hv[7]);
      *(u32x2*)(p.h2q + (size_t)t * DM + i * 512 + lane * 8) = w;
    }
#ifdef PM_SKIP
    if (rep) continue;
#endif
    float acc[32];
#pragma unroll
    for (int e2 = 0; e2 < 32; ++e2) acc[e2] = 0.f;
#pragma unroll 4
    for (int i = 0; i < 16; ++i) {
      const float hk = sh[lane + 64 * i];
      const LAS u32x4* wr = (const LAS u32x4*)(wl + (lane + 64 * i) * 40);
#pragma unroll
      for (int c4 = 0; c4 < 4; ++c4) {
        float f[8]; unpack8(wr[c4], f);
#pragma unroll
        for (int j = 0; j < 8; ++j) acc[c4 * 8 + j] += hk * f[j];
      }
    }
    {
      const bool u5 = lane & 32, u4 = lane & 16, u3 = lane & 8, u2 = lane & 4, u1 = lane & 2;
      float a16[16], a8[8], a4[4], a2[2];
#pragma unroll
      for (int j = 0; j < 16; ++j) { const float snd = u5 ? acc[j] : acc[16 + j]; const float rcv = __shfl_xor(snd, 32, 64); a16[j] = (u5 ? acc[16 + j] : acc[j]) + rcv; }
#pragma unroll
      for (int j = 0; j < 8; ++j) { const float snd = u4 ? a16[j] : a16[8 + j]; const float rcv = __shfl_xor(snd, 16, 64); a8[j] = (u4 ? a16[8 + j] : a16[j]) + rcv; }
#pragma unroll
      for (int j = 0; j < 4; ++j) { const float snd = u3 ? a8[j] : a8[4 + j]; const float rcv = __shfl_xor(snd, 8, 64); a4[j] = (u3 ? a8[4 + j] : a8[j]) + rcv; }
#pragma unroll
      for (int j = 0; j < 2; ++j) { const float snd = u2 ? a4[j] : a4[2 + j]; const float rcv = __shfl_xor(snd, 4, 64); a2[j] = (u2 ? a4[2 + j] : a4[j]) + rcv; }
      const float snd = u1 ? a2[0] : a2[1]; const float rcv = __shfl_xor(snd, 2, 64);
      float a1 = (u1 ? a2[1] : a2[0]) + rcv;
      a1 += __shfl_xor(a1, 1, 64);
      acc[0] = a1;
    }
    const int e = lane >> 1;
    float lg = acc[0] + p.b_router[e];
    if (lane & 1) lg = -INFINITY;
    float tv[4]; int ti[4];
#pragma unroll
    for (int r = 0; r < 4; ++r) {
      const float m = wave_max(lg);
      const unsigned long long bal = __ballot(lg == m);
      const int idx = __ffsll((long long)bal) - 1;
      tv[r] = m; ti[r] = idx >> 1;
      if (lane == idx) lg = -INFINITY;
    }
    const float e1 = __expf(tv[1] - tv[0]), e2 = __expf(tv[2] - tv[0]), e3 = __expf(tv[3] - tv[0]);
    const float inv = 1.f / (1.f + e1 + e2 + e3);
    if (lane < 4) {
      const int ee = lane == 0 ? ti[0] : lane == 1 ? ti[1] : lane == 2 ? ti[2] : ti[3];
      const float ww = (lane == 0 ? 1.f : lane == 1 ? e1 : lane == 2 ? e2 : e3) * inv;
      p.aw[t * 4 + lane] = ww;
      const int rank = __hip_atomic_fetch_add(&lcnt[ee], 1, __ATOMIC_RELAXED, __HIP_MEMORY_SCOPE_WORKGROUP);
      lent[nloc * 4 + lane] = (ee << 16) | rank;
      lent[nloc * 4 + lane + 2048] = t * 4 + lane;
    }
    ++nloc;
  }
  __syncthreads();
  if (p.tid < 32) lbase[p.tid] = atomicAdd(&p.cnt[p.tid * 64 + 32 * rep], lcnt[p.tid]);
  __syncthreads();
  for (int i = lane; i < nloc * 4; i += 64) {
    const int er = lent[i], a = lent[i + 2048];
    p.elist[(er >> 16) * T_TOK + lbase[er >> 16] + (er & 0xffff)] = a;
  }
}

__device__ void ph_gather(const Params& p, LAS unsigned char* lds, int nblk, int bid) {
  const int wid = p.tid >> 6, lane = p.tid & 63;
  LAS int* tb = (LAS int*)lds;
  if (p.tid == 0) { int off = 0; for (int k = 0; k < NE; ++k) { const int c = p.cnt[k * 64]; tb[k] = off; tb[64 + k] = c; off += ((c + 255) >> 8) << 8; } tb[NE] = off; }
  __syncthreads();
  const int total = tb[NE];
  for (int r = bid * 8 + wid; r < total; r += nblk * 8) {
    int e = 0;
#pragma unroll 1
    for (int k = 1; k < NE; ++k) if (r >= tb[k]) e = k;
    const int i = r - tb[e];
    const int a = (i < tb[64 + e]) ? p.elist[e * T_TOK + i] : -1;
    if (lane == 0) p.rowmap[r] = a;
    u32x4 v0 = {0, 0, 0, 0}, v1 = v0;
    if (a >= 0) { const u32x4* src = (const u32x4*)(p.h2 + (size_t)(a >> 2) * DM); v0 = src[lane]; v1 = src[64 + lane]; }
    u32x4* dst = (u32x4*)(p.xs + (size_t)r * DM);
    dst[lane] = v0; dst[64 + lane] = v1;
  }
}

__device__ void ph_final(const Params& p, int nblk, int bid, int rep) {
  const int wid = p.tid >> 6, lane = p.tid & 63;
  for (int t0 = bid * 8 + wid; t0 < T_TOK; t0 += nblk * 16) {
    int tt[2] = {t0, t0 + nblk * 8};
    if (tt[1] >= T_TOK) tt[1] = t0;
    float mv[2][16]; float ss[2];
#pragma unroll
    for (int u = 0; u < 2; ++u) {
      const int t = tt[u];
      const f32x4 wv = *(const f32x4*)(p.aw + t * 4);
      ss[u] = 0.f;
#pragma unroll
      for (int i = 0; i < 2; ++i) {
        const bf16_t* y = p.yslot + (size_t)t * 4 * DM + i * 512 + lane * 8;
        float f0[8], f1[8], f2[8], f3[8];
        unpack8(*(const u32x4*)y, f0); unpack8(*(const u32x4*)(y + DM), f1); unpack8(*(const u32x4*)(y + 2 * DM), f2); unpack8(*(const u32x4*)(y + 3 * DM), f3);
#pragma unroll
        for (int j = 0; j < 8; ++j) { const float m = wv[0] * f0[j] + wv[1] * f1[j] + wv[2] * f2[j] + wv[3] * f3[j]; mv[u][i * 8 + j] = m; ss[u] += m * m; }
      }
    }
    f32x4 x1[2][4];
#pragma unroll
    for (int u = 0; u < 2; ++u)
#pragma unroll
      for (int i = 0; i < 2; ++i)
#pragma unroll
        for (int j4 = 0; j4 < 2; ++j4) x1[u][i * 2 + j4] = *(const f32x4*)(p.out + (size_t)tt[u] * DM + i * 512 + lane * 8 + j4 * 4);
    ss[0] = wave_sum(ss[0]); ss[1] = wave_sum(ss[1]);
#pragma unroll
    for (int u = 0; u < 2; ++u) {
      const int t = tt[u];
      if (u == 1 && t == t0) break;
      const float* md = p.mod + (t / SEQ) * 6144;
      const float rstd = rsqrtf(ss[u] * (1.f / DM) + 1e-6f);
#pragma unroll
      for (int i = 0; i < 2; ++i)
#pragma unroll
        for (int j4 = 0; j4 < 2; ++j4) {
          const int k = i * 512 + lane * 8 + j4 * 4;
          float* op = p.out + (size_t)t * DM + k;
          const f32x4 gf = *(const f32x4*)(md + 5120 + k), gp = *(const f32x4*)(p.g_post_ffn + k);
          f32x4 o;
#pragma unroll
          for (int j = 0; j < 4; ++j) o[j] = x1[u][i * 2 + j4][j] + gf[j] * (mv[u][i * 8 + j4 * 4 + j] * rstd * gp[j]);
          *(f32x4*)(rep ? (float*)p.hbf + (size_t)(t & 8191) * DM + k : op) = o;
        }
    }
  }
}

#define XCD_BAR_WORDS 3456
struct KArgs { const void* in[22]; float* out; char* ws; long long never; };
__host__ __device__ inline size_t al(size_t x) { return (x + 255) & ~(size_t)255; }
__host__ __device__ inline void fill_params(Params& p, const KArgs& k) {
  p.x = (const float*)k.in[0]; p.c = (const float*)k.in[1]; p.w_ada = (const float*)k.in[2]; p.b_ada = (const float*)k.in[3];
  p.g_pre_mix = (const float*)k.in[4]; p.g_post_mix = (const float*)k.in[5]; p.g_pre_ffn = (const float*)k.in[6];
  p.g_post_ffn = (const float*)k.in[7]; p.w_in = (const float*)k.in[8]; p.conv_w = (const float*)k.in[9];
  p.a_log = (const float*)k.in[10]; p.dt_bias = (const float*)k.in[11]; p.g_dn_out = (const float*)k.in[12];
  p.w_br_a = (const float*)k.in[13]; p.w_br_b = (const float*)k.in[14]; p.w_o = (const float*)k.in[15];
  p.w_router = (const float*)k.in[16]; p.b_router = (const float*)k.in[17]; p.w_gu = (const float*)k.in[18];
  p.b_gu = (const float*)k.in[19]; p.w_down = (const float*)k.in[20]; p.b_down = (const float*)k.in[21];
  p.out = k.out;
  char* w = k.ws;
  size_t o = 0;
#define take(bytes) (w + (o += al(bytes)) - al(bytes))
  p.mod = (float*)take(4 * 6144 * 4);
  p.cnt = (int*)take(16384);
  p.ba = (float*)take((size_t)T_TOK * 8 * 4);
  p.hbf = (bf16_t*)take((size_t)T_TOK * DM * 2);
  p.proj = (bf16_t*)take((size_t)T_TOK * PW * 2);
  p.w_in_t = (bf16_t*)take((size_t)PW * DM * 2);
  p.wgu8 = (unsigned char*)take((size_t)NE * 2048 * DM);
  p.wd8 = (unsigned char*)take((size_t)NE * 1024 * DM);
  p.h2q = (unsigned char*)take((size_t)T_TOK * DM);
  p.act8 = (unsigned char*)take((size_t)73728 * DM);
  p.wbra_t = (bf16_t*)take((size_t)1024 * 512 * 2);
  p.wbrb_t = (bf16_t*)take((size_t)1024 * 512 * 2);
  p.wo_t = (bf16_t*)take((size_t)1024 * 1024 * 2);
  p.qb = (bf16_t*)take((size_t)T_TOK * 512 * 2);
  p.kb = (bf16_t*)take((size_t)T_TOK * 512 * 2);
  p.kmean = (float*)take((size_t)16 * 16 * 128 * 4);
  p.oab = (bf16_t*)take((size_t)T_TOK * DM * 2);
  p.merged = (bf16_t*)take((size_t)T_TOK * DM * 2);
  p.mixer = (bf16_t*)take((size_t)T_TOK * DM * 2);
  p.h2 = (bf16_t*)take((size_t)T_TOK * DM * 2);
  p.elist = (int*)take((size_t)NE * T_TOK * 4);
  p.aw = (float*)take((size_t)T_TOK * 4 * 4);
  p.rowmap = (int*)take((size_t)73728 * 4);
  p.dnA = (unsigned char*)take((size_t)1024 * DN_ABYTES);
  p.dnU = (float*)take((size_t)1024 * DN_UFLOATS * 4);
  p.dnG = (float*)take(4096);
  p.oab2 = (bf16_t*)take((size_t)T_TOK * 512 * 2);
  p.dbg = (float*)take(256);
  p.bar = (unsigned*)take(XCD_BAR_WORDS * 4);
  p.dn_out = p.oab; p.dn_out_ld = DM;
  p.Kp = (bf16_t*)take((size_t)16 * 128 * 8192);
  p.Vp = (bf16_t*)take((size_t)16 * 128 * 8192);
  p.wq = p.cnt + 32 * 64;
  p.mb_out = p.oab; p.mb_out_ld = DM; p.mb_out_off = 512;
  p.xs = p.proj;
  char* big = take((size_t)73728 * DM * 2 + (size_t)65536 * DM * 2);
  p.act = (bf16_t*)big;
  p.yslot = (bf16_t*)(big + (size_t)73728 * DM * 2);
  {
    char* s = big; size_t so = 0;
#define t2(bytes) (s + (so += al(bytes)) - al(bytes))
    p.nq = (float*)t2((size_t)T_TOK * 512 * 4);
    p.nk = (float*)t2((size_t)T_TOK * 512 * 4);
    p.nv = (float*)t2((size_t)T_TOK * 512 * 4);
    p.no = (float*)t2((size_t)T_TOK * 512 * 4);
    p.ntmp = (float*)t2((size_t)T_TOK * DM * 4);
    p.nbeta = (float*)t2((size_t)T_TOK * 4 * 4);
    p.ng = (float*)t2((size_t)T_TOK * 4 * 4);
  }

#undef take
#undef t2
  p.never = (int)k.never;
}

#define XB_TMO      128
#define XB_XCNT(j)  (256  + 64 * (j))
#define XB_XSUB(j)  (1280 + 64 * (j))
#define XB_XGEN(j)  (2304 + 64 * (j))
#define XB_TOP      3328
#define XB_TOPGEN   3392
#define XB_SPIN_CAP (1u << 18)

__device__ __forceinline__ unsigned xb_ld(unsigned* p)              { return __hip_atomic_load(p, __ATOMIC_RELAXED, __HIP_MEMORY_SCOPE_AGENT); }
__device__ __forceinline__ unsigned xb_add(unsigned* p, unsigned v) { return __hip_atomic_fetch_add(p, v, __ATOMIC_RELAXED, __HIP_MEMORY_SCOPE_AGENT); }
__device__ __forceinline__ unsigned xb_xcc_id() { return (unsigned)__builtin_amdgcn_s_getreg((3 << 11) | 20) & 0xFu; }
#define XB_SPIN(cond, bar) do { unsigned _sp = 0; while (cond) { __builtin_amdgcn_s_sleep(1); \
    if ((++_sp & 255u) == 0u) { if (xb_ld(&(bar)[XB_TMO])) break; if (_sp > XB_SPIN_CAP) { atomicAdd(&(bar)[XB_TMO], 1u); break; } } } } while (0)

struct XcdBarrier {
    unsigned* bar; unsigned x;
    volatile LAS unsigned* st;
};

__device__ __forceinline__ XcdBarrier xcd_barrier_post(unsigned* bar, volatile LAS unsigned* st) {
    XcdBarrier b; b.bar = bar; b.x = xb_xcc_id(); b.st = st;
    if (threadIdx.x == 0) (void)xb_add(&bar[XB_XCNT(b.x)], 1u);
    return b;
}
__device__ __forceinline__ void xcd_barrier_complete(unsigned* bar, unsigned x, unsigned& nloc, unsigned& nx) {
    const unsigned G = gridDim.x * gridDim.y * gridDim.z;
    unsigned sum, cnt, mine, sp = 0u;
    for (;;) {
        sum = 0u; cnt = 0u; mine = 0u;
#pragma unroll
        for (unsigned j = 0; j < 16; ++j) { const unsigned c = xb_ld(&bar[XB_XCNT(j)]); sum += c; cnt += (c > 0u) ? 1u : 0u; mine = (j == x) ? c : mine; }
        if (sum == G) break;
        __builtin_amdgcn_s_sleep(1);
        if ((++sp & 255u) == 0u) { if (xb_ld(&bar[XB_TMO])) break; if (sp > XB_SPIN_CAP) { atomicAdd(&bar[XB_TMO], 1u); break; } }
    }
    nloc = mine > 0u ? mine : 1u; nx = cnt > 0u ? cnt : 1u;
}

__device__ __forceinline__ void xcd_barrier(const XcdBarrier& b, const int tid) {
    asm volatile("s_waitcnt vmcnt(0)" ::: "memory");
    __syncthreads();
    if (tid == 0) {
        unsigned* bar = b.bar;
        __builtin_amdgcn_s_waitcnt(0);
        unsigned nloc = b.st[0], nx = b.st[1];
        if (nloc == 0u) { xcd_barrier_complete(bar, b.x, nloc, nx); b.st[0] = nloc; b.st[1] = nx; }
        const unsigned old = xb_add(&bar[XB_XSUB(b.x)], 1u);
        const unsigned gen = old / nloc;
        if (old + 1u == (gen + 1u) * nloc) {
            __builtin_amdgcn_fence(__ATOMIC_RELEASE, "agent");
            asm volatile("s_waitcnt vmcnt(0)" ::: "memory");
            const unsigned og = xb_add(&bar[XB_TOP], 1u);
            const unsigned tg = og / nx;
            if (og + 1u == (tg + 1u) * nx) xb_add(&bar[XB_TOPGEN], 1u);
            else XB_SPIN(xb_ld(&bar[XB_TOPGEN]) == tg, bar);
            __builtin_amdgcn_fence(__ATOMIC_ACQUIRE, "agent");
            xb_add(&bar[XB_XGEN(b.x)], 1u);
            asm volatile("s_waitcnt vmcnt(0)" ::: "memory");
        } else {
            XB_SPIN(xb_ld(&bar[XB_XGEN(b.x)]) == gen, bar);
            __builtin_amdgcn_fence(__ATOMIC_ACQUIRE, "agent");
            asm volatile("s_waitcnt vmcnt(0)" ::: "memory");
        }
    }
    __syncthreads();
}


__device__ __forceinline__ void load_ka(KArgs& kk) {
#if defined(__HIP_DEVICE_COMPILE__)
  typedef __attribute__((address_space(1))) char* gptr_t;
  typedef const __attribute__((address_space(4))) gptr_t* kptr_t;
  kptr_t kp = (kptr_t)__builtin_amdgcn_kernarg_segment_ptr();
  asm volatile("" : "+s"(kp));
#pragma unroll
  for (int i = 0; i < 22; ++i) kk.in[i] = (const void*)kp[i];
  kk.out = (float*)kp[22];
  kk.ws = (char*)kp[23];
  kk.never = ((const __attribute__((address_space(4))) long long*)kp)[24];
#endif
}
__device__ __forceinline__ void grid_bar(const Params& p, LAS unsigned char* lds);
#define MEGA_LDS 148480
#define MEGA_LDS_ALLOC (MEGA_LDS + 16)
__device__ __forceinline__ void grid_bar(const Params& p, LAS unsigned char* lds) {
  XcdBarrier b; b.bar = p.bar; b.x = xb_xcc_id(); b.st = (volatile LAS unsigned*)(lds + MEGA_LDS);
  xcd_barrier(b, p.tid);
}
__global__ __launch_bounds__(512) void mega(KArgs ka) {
  extern __shared__ __attribute__((aligned(16))) unsigned char shm[];
  LAS unsigned char* lds = (LAS unsigned char*)shm;
  cg::grid_group grid = cg::this_grid();
  const int nblk = gridDim.x, bid = blockIdx.x;
  const int wv_ = __builtin_amdgcn_readfirstlane(threadIdx.x >> 6);
  volatile LAS unsigned* xst = (volatile LAS unsigned*)(lds + MEGA_LDS);
  if (threadIdx.x == 0) { xst[0] = 0u; xst[1] = 0u; xst[2] = 0u; xst[3] = 0u; }
  __syncthreads();
  { Params p0; fill_params(p0, ka); (void)xcd_barrier_post(p0.bar, xst); }
  if (ka.never) grid.sync();
#ifndef REPMASK
#define REPMASK 0
#endif
#define LOADKA KArgs kk; load_ka(kk)
#ifndef PHMASK
#define PHMASK 0xffff
#endif
#define PHASE(k, body) if (((PHMASK) >> (k)) & 1) for (int rep_ = 0; rep_ < (((REPMASK) >> (k)) & 1) + 1; ++rep_) { \
    LOADKA; Params p; fill_params(p, kk); { int t_; asm volatile("v_mbcnt_lo_u32_b32 %0, -1, 0\n\tv_mbcnt_hi_u32_b32 %0, -1, %0" : "=v"(t_)); p.tid = (wv_ << 6) | t_; } body; grid_bar(p, lds); }
#ifdef XBAR
  for (int xb_ = 0; xb_ < XBAR; ++xb_) { PHASE(15, {}) }
#endif
  PHASE(0, { ph_mod(p, lds, nblk, bid); ph_wt(p, lds, nblk, bid); })
  PHASE(1, { ph_h(p, lds, nblk, bid); })
  PHASE(2, { ph_proj(p, lds, nblk, bid); })
  PHASE(3, { bool first = true; for (int ci = bid; ci < 1024; ci += nblk) { dn_prep_chunk(p, lds, ci, first); first = false; }
             for (int item = bid; item < 256; item += nblk) moba_prep_block(p, lds, item); })
  PHASE(4, { if (bid < 32) dn_scan_blk(p, lds, bid); moba_worker(p, lds, rep_); })
  PHASE(5, { ph_dn_norm(p, nblk, bid); })
  PHASE(6, { ph_br(p, lds, nblk, bid); })
  PHASE(7, { ph_mix(p, lds, nblk, bid); })
  PHASE(8, { ph_post_mix(p, lds, nblk, bid, rep_); })
  PHASE(10, { ph_moe1(p, lds, nblk, bid); })
  PHASE(11, { ph_moe2(p, lds, nblk, bid); })
  PHASE(12, { ph_final(p, nblk, bid, rep_); })
}


extern "C" void kernel_launch(void* const* d_in, const int* in_sizes, int n_in, void* d_out, int out_size, void* d_ws,
                              size_t ws_size, hipStream_t stream) {
  KArgs ka{};
  for (int i = 0; i < 22; ++i) ka.in[i] = d_in[i];
  ka.out = (float*)d_out; ka.ws = (char*)d_ws; ka.never = 0;
  Params p{};
  fill_params(p, ka);
  static int grid_blocks = 0;
  if (!grid_blocks) {
    (void)hipFuncSetAttribute((const void*)mega, hipFuncAttributeMaxDynamicSharedMemorySize, MEGA_LDS_ALLOC);
    int dev = 0, cus = 0, per_cu = 0;
    (void)hipGetDevice(&dev);
    (void)hipDeviceGetAttribute(&cus, hipDeviceAttributeMultiprocessorCount, dev);
    (void)hipOccupancyMaxActiveBlocksPerMultiprocessor(&per_cu, mega, 512, MEGA_LDS_ALLOC);
    if (per_cu != 1) per_cu = 1;
    grid_blocks = cus * per_cu;
  }
  (void)hipMemsetAsync(p.cnt, 0, 16384, stream);
  (void)hipMemsetAsync(p.bar, 0, XCD_BAR_WORDS * 4, stream);
  void* args[] = {&ka};
  hipError_t e = hipLaunchCooperativeKernel((void*)mega, dim3(grid_blocks), dim3(512), args, MEGA_LDS_ALLOC, stream);
  if (e != hipSuccess) fprintf(stderr, "cooperative launch failed: %s (grid %d)\n", hipGetErrorString(e), grid_blocks);
}
```

```cpp
#include <hip/hip_runtime.h>
#include <hip/hip_cooperative_groups.h>
#include <cstdio>
namespace cg = cooperative_groups;
#include <stdint.h>

typedef unsigned short bf16_t;
#ifndef MB_ABL
#define MB_ABL 0
#endif

#define T_TOK 16384
#define SEQ 4096
#define NB 4
#define DM 1024
#define INW 5640
#define PW 5632
#define C_QA 0
#define C_KA 512
#define C_VA 1024
#define C_Z 1536
#define C_MQ 2048
#define C_MK 2560
#define C_MV 3072
#define C_GA 3584
#define C_GB 4608
#define NE 32

__device__ __forceinline__ bf16_t f2bf(float f) {
  unsigned u = __float_as_uint(f);
  u += 0x7fffu + ((u >> 16) & 1u);
  return (bf16_t)(u >> 16);
}
__device__ __forceinline__ float bf2f(bf16_t h) { return __uint_as_float(((unsigned)h) << 16); }
__device__ __forceinline__ float sigmoidf_(float x) { return __builtin_amdgcn_rcpf(1.f + __builtin_amdgcn_exp2f(-1.4426950408889634f * x)); }
__device__ __forceinline__ float siluf_(float x) { return x * sigmoidf_(x); }
__device__ __forceinline__ float wave_sum(float v) {
#pragma unroll
  for (int o = 32; o > 0; o >>= 1) v += __shfl_xor(v, o, 64);
  return v;
}
__device__ __forceinline__ float wave_max(float v) {
#pragma unroll
  for (int o = 32; o > 0; o >>= 1) v = fmaxf(v, __shfl_xor(v, o, 64));
  return v;
}

typedef unsigned u32x2 __attribute__((ext_vector_type(2)));
typedef __bf16 bf16x2_t __attribute__((ext_vector_type(2)));
typedef float f32x2_t __attribute__((ext_vector_type(2)));
__device__ __forceinline__ unsigned pk2(float a, float b) { f32x2_t v = {a, b}; bf16x2_t r = __builtin_convertvector(v, bf16x2_t); return __builtin_bit_cast(unsigned, r); }

__device__ __forceinline__ unsigned pk4_fp8(float a, float b, float c, float d) {
  int w = 0;
  w = __builtin_amdgcn_cvt_pk_fp8_f32(a, b, w, false);
  w = __builtin_amdgcn_cvt_pk_fp8_f32(c, d, w, true);
  return (unsigned)w;
}

struct Params {
  const float *x, *c, *w_ada, *b_ada, *g_pre_mix, *g_post_mix, *g_pre_ffn, *g_post_ffn, *w_in, *conv_w,
      *a_log, *dt_bias, *g_dn_out, *w_br_a, *w_br_b, *w_o, *w_router, *b_router, *w_gu, *b_gu, *w_down, *b_down;
  float* out;
  float* mod;
  int* cnt;
  float* ba;
  bf16_t* hbf;
  bf16_t* proj;
  bf16_t* w_in_t;
  unsigned char* wgu8;
  unsigned char* wd8;
  unsigned char* h2q;
  unsigned char* act8;
  bf16_t* wbra_t;
  bf16_t* wbrb_t;
  bf16_t* wo_t;
  bf16_t* qb;
  bf16_t* kb;
  float* kmean;
  bf16_t* oab;
  bf16_t* merged;
  bf16_t* mixer;
  bf16_t* h2;
  int* elist;
  float* aw;
  bf16_t* act;
  bf16_t* xs;
  int* rowmap;
  bf16_t* yslot;
  unsigned char* dnA; float* dnU; float* dnG;
  bf16_t* dn_out; int dn_out_ld;
  bf16_t* oab2; float* dbg;
  unsigned* bar; int never; int tid;
  bf16_t* Kp; bf16_t* Vp; int* wq;
  bf16_t* mb_out; int mb_out_ld; int mb_out_off;
  float* nq; float* nk; float* nv;
  float* nbeta; float* ng;
  float* no;
  float* ntmp;
};

__device__ __forceinline__ int map_col(int n, int mode) {
  if (mode == 0) return n;
  if (mode == 1) return n < 2048 ? n : (n < 2056 ? -1 : n - 8);
  if (n < 1024) return (n >> 7) * 256 + (n & 127);
  int j = n - 1024;
  return (j >> 7) * 256 + 128 + (j & 127);
}
namespace pg8 {
#define PG8_LAS __attribute__((address_space(3)))
typedef short bf16x8 __attribute__((ext_vector_type(8)));
typedef float f32x4 __attribute__((ext_vector_type(4)));
typedef unsigned u32x4 __attribute__((ext_vector_type(4)));
constexpr int BM = 256, BK = 64, HALF = 128, HTB = HALF * BK * 2, STAGE_BYTES = 8 * HTB, NXCD = 8, WGM = 8;

__host__ __device__ __forceinline__ int lds_byte(int r, int c) { const int st = (r >> 4) * 2 + (c >> 5), rr = r & 15, cc = c & 31, ob = rr * 64 + cc * 2; return st * 1024 + (ob ^ (((ob >> 9) & 1) << 5)); }
__host__ __device__ __forceinline__ void stage_rc(int b, int& R, int& C) { const int st = b / 1024, sb = b % 1024, swz = sb ^ (((sb >> 9) & 1) << 5); R = (st >> 1) * 16 + swz / 64; C = (st & 1) * 32 + (swz % 64) / 2; }
__host__ __device__ __forceinline__ int perm32(int rho) { const int n = rho >> 4, i = rho & 15; return 8 * (i >> 2) + 4 * n + (i & 3); }

struct Unit { int pm, pn, z; };
__device__ __forceinline__ unsigned cvt_pk_bf16(float lo, float hi) { unsigned r; asm volatile("v_cvt_pk_bf16_f32 %0, %1, %2" : "=v"(r) : "v"(lo), "v"(hi)); return r; }

typedef int i32x8 __attribute__((ext_vector_type(8)));
typedef int i32x4 __attribute__((ext_vector_type(4)));
__device__ __forceinline__ i32x8 cat8(const bf16x8 lo, const bf16x8 hi) { const i32x4 a = __builtin_bit_cast(i32x4, lo), b = __builtin_bit_cast(i32x4, hi); return __builtin_shufflevector(a, b, 0, 1, 2, 3, 4, 5, 6, 7); }
struct TileOrder {
    int nM, nN, nwg, G, c;
    __device__ void init(int nM_, int nN_, int G_, int c_) { nM = nM_; nN = nN_; nwg = nM * nN; G = G_; c = c_; }
    __device__ bool tile(int i, int& pm, int& pn) const {
        const long L = (long)i * G + c; if (L >= nwg) return false;
        int wgid = (int)L; { const int q = nwg / NXCD, r = nwg % NXCD, xcd = wgid % NXCD, off = wgid / NXCD; wgid = (xcd < r ? xcd * (q + 1) : r * (q + 1) + (xcd - r) * q) + off; }
        const int nig = WGM * nN, gid = wgid / nig, fm = gid * WGM, gsz = (nM - fm) < WGM ? (nM - fm) : WGM;
        pm = fm + ((wgid % nig) % gsz); pn = (wgid % nig) / gsz; return true;
    }
};

template <class Epi, class Sched, bool FP8 = false>
__device__ __forceinline__ void gemm_phase(PG8_LAS unsigned char* lds, const int tid, const int lda, const int ldb, const int K, const Sched& S, const Epi& E) {
    const int wid = __builtin_amdgcn_readfirstlane(tid >> 6), lane = tid & 63, wr = wid >> 2, wc = wid & 3, fr = lane & 15, fq = lane >> 4;
    const int nt = K / BK;
    unsigned voffA[2], voffB[2];
#pragma unroll
    for (int i = 0; i < 2; ++i) { int R, C; stage_rc(tid * 16 + i * 8192, R, C); const int Rb = Epi::PERM ? ((R & ~31) + perm32(R & 31)) : R;
        voffA[i] = (unsigned)(R * lda + C) * 2u; voffB[i] = (unsigned)(Rb * ldb + C) * 2u; }
    const size_t kstep = (size_t)(BK * 2);
    const size_t hstepA = (size_t)HALF * lda * 2, hstepB = (size_t)HALF * ldb * 2;
    const unsigned ldsw = (unsigned)wid * 1024u;
    const int aoff = lds_byte(wr * 64 + fr, fq * 8), boff = lds_byte(wc * 32 + fr, fq * 8);
    constexpr int KOFF1 = 1024;
    unsigned gA[2][2] = {{0u, 0u}, {0u, 0u}}, gAn[2][2] = {{0u, 0u}, {0u, 0u}};
#define PG8_GOFFS(dst, unit) do { int t_ = tid; asm volatile("" : "+v"(t_)); _Pragma("unroll") for (int i_ = 0; i_ < 2; ++i_) { int gR_, gC_; stage_rc(t_ * 16 + i_ * 8192, gR_, gC_); \
        _Pragma("unroll") for (int h_ = 0; h_ < 2; ++h_) dst[h_][i_] = S.a_goff(unit, gR_ + 128 * h_, gC_); } } while (0)
#define PG8_SA(b, h) (((b) * 2 + (h)) * HTB)
#define PG8_SB(b, h) ((4 + (b) * 2 + (h)) * HTB)
#define PG8_STAGE(bufoff, gbase, voff) do { _Pragma("unroll") for (int _i = 0; _i < 2; ++_i) \
        __builtin_amdgcn_global_load_lds((const unsigned*)((const char*)(gbase) + (voff)[_i]), (PG8_LAS unsigned*)(lds + (bufoff) + ldsw + _i * 8192), 16, 0, 0); } while (0)
#define PG8_STAGEA(bufoff, ptr, h, nx) do { if constexpr (Sched::GATHER) { const unsigned gs_[2] = {(nx) ? gAn[h][0] : gA[h][0], (nx) ? gAn[h][1] : gA[h][1]}; PG8_STAGE(bufoff, ptr, gs_); } \
        else { PG8_STAGE(bufoff, (ptr) + (h) * hstepA, voffA); } } while (0)
#define PG8_LDA(dst, b, h) do { if constexpr (FP8) { _Pragma("unroll") for (int m = 0; m < 4; ++m) dst##8[m] = cat8(*(const PG8_LAS bf16x8*)(lds + PG8_SA(b, h) + aoff + m * 2048), *(const PG8_LAS bf16x8*)(lds + PG8_SA(b, h) + aoff + KOFF1 + m * 2048)); } \
        else { _Pragma("unroll") for (int m = 0; m < 4; ++m) _Pragma("unroll") for (int k = 0; k < 2; ++k) dst[m][k] = *(const PG8_LAS bf16x8*)(lds + PG8_SA(b, h) + aoff + k * KOFF1 + m * 2048); } } while (0)
#define PG8_LDB(dst, b, h) do { if constexpr (FP8) { _Pragma("unroll") for (int n = 0; n < 2; ++n) dst##8[n] = cat8(*(const PG8_LAS bf16x8*)(lds + PG8_SB(b, h) + boff + n * 2048), *(const PG8_LAS bf16x8*)(lds + PG8_SB(b, h) + boff + KOFF1 + n * 2048)); } \
        else { _Pragma("unroll") for (int n = 0; n < 2; ++n) _Pragma("unroll") for (int k = 0; k < 2; ++k) dst[n][k] = *(const PG8_LAS bf16x8*)(lds + PG8_SB(b, h) + boff + k * KOFF1 + n * 2048); } } while (0)
#define PG8_MMA(ai, bj, At, Bt) do { __builtin_amdgcn_s_setprio(1); if constexpr (FP8) { _Pragma("unroll") for (int m = 0; m < 4; ++m) _Pragma("unroll") for (int n = 0; n < 2; ++n) \
        asm volatile("v_mfma_scale_f32_16x16x128_f8f6f4 %0, %1, %2, %0, %3, %4 op_sel_hi:[0,0,0]" : "+v"(acc[ai][bj][m][n]) : "v"(Bt##8[n]), "v"(At##8[m]), "v"(sclB), "v"(sclA)); } \
        else { _Pragma("unroll") for (int m = 0; m < 4; ++m) _Pragma("unroll") for (int n = 0; n < 2; ++n) _Pragma("unroll") for (int k = 0; k < 2; ++k) \
        acc[ai][bj][m][n] = __builtin_amdgcn_mfma_f32_16x16x32_bf16(Bt[n][k], At[m][k], acc[ai][bj][m][n], 0, 0, 0); } __builtin_amdgcn_s_setprio(0); } while (0)
#define PG8_WAIT_V(n) asm volatile("s_waitcnt vmcnt(" #n ")" ::: "memory")
#define PG8_WAIT_L(n) asm volatile("s_waitcnt lgkmcnt(" #n ")" ::: "memory")
#define PG8_BAR __builtin_amdgcn_s_barrier()
#define PG8_SCHED __builtin_amdgcn_sched_barrier(0)
    Unit cur, nxt; int ui = 0;
    if (!S.next(0, cur)) return;
    f32x4 acc[2][2][4][2];
#pragma unroll
    for (int a = 0; a < 2; ++a)
#pragma unroll
        for (int b = 0; b < 2; ++b)
#pragma unroll
            for (int m = 0; m < 4; ++m)
#pragma unroll
                for (int n = 0; n < 2; ++n) acc[a][b][m][n] = (f32x4){0.f, 0.f, 0.f, 0.f};
    bf16x8 At[4][2], B0[2][2], B1[2][2];
    i32x8 At8[4], B08[2], B18[2];
    int sclA = 0x7f7f7f7f, sclB = 0x79797979;
    const char* cA = S.a_ptr(cur); const char* cB = S.b_ptr(cur);
    if constexpr (Sched::GATHER) { PG8_GOFFS(gA, cur); }
    PG8_STAGE(PG8_SB(0, 0), cB, voffB); PG8_STAGEA(PG8_SA(0, 0), cA, 0, false); PG8_STAGE(PG8_SB(0, 1), cB + hstepB, voffB); PG8_STAGEA(PG8_SA(0, 1), cA, 1, false);
    if (wr == 1) PG8_BAR;
    PG8_WAIT_V(4); PG8_BAR;
    PG8_STAGE(PG8_SB(1, 0), cB + kstep, voffB); PG8_STAGEA(PG8_SA(1, 0), cA + kstep, 0, false); PG8_STAGE(PG8_SB(1, 1), cB + hstepB + kstep, voffB);
    PG8_WAIT_V(6); PG8_BAR;
    for (;;) {
        const bool has_next = S.next(ui + 1, nxt);
        const char* nA = has_next ? S.a_ptr(nxt) : cA; const char* nB = has_next ? S.b_ptr(nxt) : cB;
        if constexpr (Sched::GATHER) { if (has_next) { PG8_GOFFS(gAn, nxt); } else {
_Pragma("unroll") for (int h = 0; h < 2; ++h) _Pragma("unroll") for (int i = 0; i < 2; ++i) gAn[h][i] = gA[h][i]; } }
_Pragma("unroll 1")
        for (int t = 0; t < nt; t += 2) {
            const bool last = (t == nt - 2);
            const char* a1 = cA + (size_t)(t + 1) * kstep;
            const char* a2 = last ? nA : cA + (size_t)(t + 2) * kstep; const char* b2 = last ? nB : cB + (size_t)(t + 2) * kstep;
            const char* a3 = a2 + kstep; const char* b3 = b2 + kstep;
            PG8_LDB(B0, 0, 0); PG8_SCHED; PG8_LDA(At, 0, 0); PG8_STAGEA(PG8_SA(1, 1), a1, 1, false);
            PG8_WAIT_L(8); PG8_BAR; PG8_WAIT_L(0); PG8_MMA(0, 0, At, B0); PG8_BAR; PG8_SCHED;
            PG8_LDB(B1, 0, 1); PG8_STAGE(PG8_SB(0, 0), b2, voffB);
            PG8_BAR; PG8_WAIT_L(0); PG8_MMA(0, 1, At, B1); PG8_BAR;
            PG8_LDA(At, 0, 1); PG8_STAGEA(PG8_SA(0, 0), a2, 0, last);
            PG8_BAR; PG8_WAIT_L(0); PG8_MMA(1, 0, At, B0); PG8_BAR; PG8_SCHED;
            PG8_STAGE(PG8_SB(0, 1), b2 + hstepB, voffB);
            PG8_WAIT_V(6); PG8_BAR; PG8_MMA(1, 1, At, B1); PG8_BAR;
            PG8_LDB(B0, 1, 0); PG8_SCHED; PG8_LDA(At, 1, 0); PG8_STAGEA(PG8_SA(0, 1), a2, 1, last);
            PG8_WAIT_L(8); PG8_BAR; PG8_WAIT_L(0); PG8_MMA(0, 0, At, B0); PG8_BAR; PG8_SCHED;
            PG8_LDB(B1, 1, 1); PG8_STAGE(PG8_SB(1, 0), b3, voffB);
            PG8_BAR; PG8_WAIT_L(0); PG8_MMA(0, 1, At, B1); PG8_BAR;
            PG8_LDA(At, 1, 1); PG8_STAGEA(PG8_SA(1, 0), a3, 0, last);
            PG8_BAR; PG8_WAIT_L(0); PG8_MMA(1, 0, At, B0); PG8_BAR; PG8_SCHED;
            PG8_STAGE(PG8_SB(1, 1), b3 + hstepB, voffB);
            PG8_WAIT_V(6); PG8_BAR; PG8_MMA(1, 1, At, B1); PG8_BAR;
        }
        { if constexpr (FP8) asm volatile("s_nop 15\n\ts_nop 3" ::: "memory");
          int t_ = tid; asm volatile("" : "+v"(t_));
          E(acc, cur, wr, wc, t_ & 15, (t_ & 63) >> 4); }
        if (!has_next) break;
#pragma unroll
        for (int a = 0; a < 2; ++a)
#pragma unroll
            for (int b = 0; b < 2; ++b)
#pragma unroll
                for (int m = 0; m < 4; ++m)
#pragma unroll
                    for (int n = 0; n < 2; ++n) acc[a][b][m][n] = (f32x4){0.f, 0.f, 0.f, 0.f};
        cur = nxt; cA = nA; cB = nB; ++ui;
        if constexpr (Sched::GATHER) {
_Pragma("unroll") for (int h = 0; h < 2; ++h) _Pragma("unroll") for (int i = 0; i < 2; ++i) gA[h][i] = gAn[h][i]; }
    }
    PG8_WAIT_V(0);
    if (wr == 0) PG8_BAR;
    PG8_BAR;
#undef PG8_SA
#undef PG8_SB
#undef PG8_STAGE
#undef PG8_STAGEA
#undef PG8_GOFFS
#undef PG8_LDA
#undef PG8_LDB
#undef PG8_MMA
#undef PG8_WAIT_V
#undef PG8_WAIT_L
#undef PG8_BAR
#undef PG8_SCHED
}
}
using pg8::f32x4; using pg8::u32x4; using pg8::Unit;

#define GEMM_LDS (pg8::STAGE_BYTES + 1024)

struct SchedProj : pg8::TileOrder {
  static constexpr bool GATHER = false;
  const char* A; const char* B;
  __device__ bool next(int i, Unit& u) const { u.z = 0; return tile(i, u.pm, u.pn); }
  __device__ const char* a_ptr(const Unit& u) const { return A + (size_t)u.pm * 256 * DM * 2; }
  __device__ const char* b_ptr(const Unit& u) const { return B + (size_t)u.pn * 256 * DM * 2; }
};
struct EpiProj {
  static constexpr bool PERM = true;
  bf16_t* O;
  __device__ __forceinline__ void operator()(const f32x4 (&acc)[2][2][4][2], const Unit& u, int wr, int wc, int fr, int fq) const {
    const int row0 = u.pm * 256 + wr * 64 + fr, col0 = u.pn * 256 + wc * 32 + 8 * fq;
    const bool gate = u.pn >= (C_GA / 256);
#pragma unroll
    for (int ai = 0; ai < 2; ++ai)
#pragma unroll
      for (int m = 0; m < 4; ++m) {
        bf16_t* rowp = O + (size_t)(row0 + ai * 128 + m * 16) * PW + col0;
#pragma unroll
        for (int bj = 0; bj < 2; ++bj) {
          f32x4 v0 = acc[ai][bj][m][0], v1 = acc[ai][bj][m][1];
          if (gate) {
#pragma unroll
            for (int j = 0; j < 4; ++j) { v0[j] = sigmoidf_(v0[j]); v1[j] = sigmoidf_(v1[j]); }
          }
          u32x4 w; w.x = pg8::cvt_pk_bf16(v0[0], v0[1]); w.y = pg8::cvt_pk_bf16(v0[2], v0[3]); w.z = pg8::cvt_pk_bf16(v1[0], v1[1]); w.w = pg8::cvt_pk_bf16(v1[2], v1[3]);
          *(u32x4*)(rowp + bj * 128) = w;
        }
      }
  }
};
__device__ void ph_proj(const Params& p, PG8_LAS unsigned char* lds, int nblk, int bid) {
  SchedProj S; S.init(T_TOK / 256, PW / 256, nblk, bid); S.A = (const char*)p.hbf; S.B = (const char*)p.w_in_t;
  EpiProj E{p.proj};
  pg8::gemm_phase(lds, p.tid, DM, DM, DM, S, E);
}

struct SchedBr : pg8::TileOrder {
  static constexpr bool GATHER = false;
  const char* A; const char* Ba; const char* Bb;
  __device__ bool next(int i, Unit& u) const { u.z = i & 1; return tile(i >> 1, u.pm, u.pn); }
  __device__ const char* a_ptr(const Unit& u) const { return A + (size_t)u.pm * 256 * DM * 2 + u.z * 512 * 2; }
  __device__ const char* b_ptr(const Unit& u) const { return (u.z ? Bb : Ba) + (size_t)u.pn * 256 * 512 * 2; }
};
__device__ __forceinline__ void unpack8(const u32x4 w, float (&f)[8]) {
  f[0] = __uint_as_float(w.x << 16); f[1] = __uint_as_float(w.x & 0xffff0000u); f[2] = __uint_as_float(w.y << 16); f[3] = __uint_as_float(w.y & 0xffff0000u);
  f[4] = __uint_as_float(w.z << 16); f[5] = __uint_as_float(w.z & 0xffff0000u); f[6] = __uint_as_float(w.w << 16); f[7] = __uint_as_float(w.w & 0xffff0000u);
}
struct EpiBr {
  static constexpr bool PERM = true;
  const bf16_t* proj; bf16_t* O;
  __device__ __forceinline__ void operator()(const f32x4 (&acc)[2][2][4][2], const Unit& u, int wr, int wc, int fr, int fq) const {
    const int row0 = u.pm * 256 + wr * 64 + fr, col0 = u.pn * 256 + wc * 32 + 8 * fq;
    const int gcol = (u.z ? C_GB : C_GA) + col0;
#pragma unroll
    for (int ai = 0; ai < 2; ++ai) {
      u32x4 gv[4][2], pv[4][2];
#pragma unroll
      for (int m = 0; m < 4; ++m)
#pragma unroll
        for (int bj = 0; bj < 2; ++bj) {
          const size_t row = (size_t)(row0 + ai * 128 + m * 16);
          gv[m][bj] = *(const u32x4*)(proj + row * PW + gcol + bj * 128);
          pv[m][bj] = (u32x4){0u, 0u, 0u, 0u};
          if (u.z) pv[m][bj] = *(const u32x4*)(O + row * DM + col0 + bj * 128);
        }
#pragma unroll
      for (int m = 0; m < 4; ++m)
#pragma unroll
        for (int bj = 0; bj < 2; ++bj) {
          const size_t row = (size_t)(row0 + ai * 128 + m * 16);
          float g[8], pf[8]; unpack8(gv[m][bj], g); unpack8(pv[m][bj], pf);
          const f32x4 v0 = acc[ai][bj][m][0], v1 = acc[ai][bj][m][1];
          float r[8];
#pragma unroll
          for (int j = 0; j < 4; ++j) { r[j] = v0[j] * g[j] + pf[j]; r[4 + j] = v1[j] * g[4 + j] + pf[4 + j]; }
          u32x4 w; w.x = pk2(r[0], r[1]); w.y = pk2(r[2], r[3]); w.z = pk2(r[4], r[5]); w.w = pk2(r[6], r[7]);
          *(u32x4*)(O + row * DM + col0 + bj * 128) = w;
        }
    }
  }
};
__device__ void ph_br(const Params& p, PG8_LAS unsigned char* lds, int nblk, int bid) {
  SchedBr S; S.init(T_TOK / 256, DM / 256, nblk, bid); S.A = (const char*)p.oab; S.Ba = (const char*)p.wbra_t; S.Bb = (const char*)p.wbrb_t;
  EpiBr E{p.proj, p.merged};
  pg8::gemm_phase(lds, p.tid, DM, 512, 512, S, E);
}

struct SchedMix : pg8::TileOrder {
  static constexpr bool GATHER = false;
  const char* A; const char* B;
  __device__ bool next(int i, Unit& u) const { u.z = 0; return tile(i, u.pm, u.pn); }
  __device__ const char* a_ptr(const Unit& u) const { return A + (size_t)u.pm * 256 * DM * 2; }
  __device__ const char* b_ptr(const Unit& u) const { return B + (size_t)u.pn * 256 * DM * 2; }
};
struct EpiMix {
  static constexpr bool PERM = true;
  bf16_t* O;
  __device__ __forceinline__ void operator()(const f32x4 (&acc)[2][2][4][2], const Unit& u, int wr, int wc, int fr, int fq) const {
    const int row0 = u.pm * 256 + wr * 64 + fr, col0 = u.pn * 256 + wc * 32 + 8 * fq;
#pragma unroll
    for (int ai = 0; ai < 2; ++ai)
#pragma unroll
      for (int m = 0; m < 4; ++m) {
        bf16_t* rowp = O + (size_t)(row0 + ai * 128 + m * 16) * DM + col0;
#pragma unroll
        for (int bj = 0; bj < 2; ++bj) {
          const f32x4 v0 = acc[ai][bj][m][0], v1 = acc[ai][bj][m][1];
          u32x4 w; w.x = pg8::cvt_pk_bf16(v0[0], v0[1]); w.y = pg8::cvt_pk_bf16(v0[2], v0[3]); w.z = pg8::cvt_pk_bf16(v1[0], v1[1]); w.w = pg8::cvt_pk_bf16(v1[2], v1[3]);
          *(u32x4*)(rowp + bj * 128) = w;
        }
      }
  }
};
__device__ void ph_mix(const Params& p, PG8_LAS unsigned char* lds, int nblk, int bid) {
  SchedMix S; S.init(T_TOK / 256, DM / 256, nblk, bid); S.A = (const char*)p.merged; S.B = (const char*)p.wo_t;
  EpiMix E{p.mixer};
  pg8::gemm_phase(lds, p.tid, DM, DM, DM, S, E);
}

template <bool GATH>
struct SchedMoe {
  static constexpr bool GATHER = GATH;
  const PG8_LAS int* tb; int NT; int G, c; int nwg;
  const char* A; const char* B; size_t bexp;
  const int* elist; int rowb;
  __device__ bool next(int i, Unit& u) const {
    const long L = (long)i * G + c; if (L >= nwg) return false;
    int wgid = (int)L; { const int q = nwg / 8, r = nwg % 8, xcd = wgid % 8, off = wgid / 8; wgid = (xcd < r ? xcd * (q + 1) : r * (q + 1) + (xcd - r) * q) + off; }
    int e = 0;
#pragma unroll 1
    for (int k = 1; k < NE; ++k) if (wgid >= tb[k]) e = k;
    const int q = wgid - tb[e]; const int tiles = tb[33 + e + 1] - tb[33 + e];
    u.pm = tb[33 + e] + q % tiles; u.pn = q / tiles; u.z = e; return true;
  }
  __device__ const char* a_ptr(const Unit& u) const { return GATH ? A : A + (size_t)u.pm * 256 * rowb; }
  __device__ const char* b_ptr(const Unit& u) const { return B + (size_t)u.z * bexp + (size_t)u.pn * 256 * rowb; }
  __device__ unsigned a_goff(const Unit& u, int tr, int C) const {
    const int i = (u.pm - tb[33 + u.z]) * 256 + tr;
    int tok = 0;
    if (i < tb[66 + u.z]) tok = elist[u.z * T_TOK + i] >> 2;
    return (unsigned)(tok * rowb + C * 2);
  }
};
__device__ __forceinline__ void moe_table(const Params& p, PG8_LAS int* tb, int NT) {
  if (p.tid == 0) {
    int ub = 0, tbp = 0;
    for (int e = 0; e < NE; ++e) { const int c = p.cnt[e * 64]; tb[e] = ub; tb[33 + e] = tbp; tb[66 + e] = c; const int t = (c + 255) >> 8; ub += t * NT; tbp += t; }
    tb[NE] = ub; tb[33 + NE] = tbp;
  }
  __syncthreads();
}
struct EpiMoe1 {
  static constexpr bool PERM = true;
  const float* b_gu; unsigned char* act;
  __device__ __forceinline__ void operator()(f32x4 (&acc)[2][2][4][2], const Unit& u, int wr, int wc, int fr, int fq) const {
    const int row0 = u.pm * 256 + wr * 64 + fr, jc = u.pn * 128 + wc * 32 + 8 * fq;
    const float* bg = b_gu + (size_t)u.z * 2048 + jc;
#pragma unroll
    for (int bj = 0; bj < 2; ++bj)
#pragma unroll
      for (int n = 0; n < 2; ++n) {
        const f32x4 bv = *(const f32x4*)(bg + bj * 1024 + n * 4);
#pragma unroll
        for (int ai = 0; ai < 2; ++ai)
#pragma unroll
          for (int m = 0; m < 4; ++m) acc[ai][bj][m][n] += bv;
      }
#pragma unroll
    for (int ai = 0; ai < 2; ++ai)
#pragma unroll
      for (int m = 0; m < 4; ++m) {
        unsigned char* rowp = act + (size_t)(row0 + ai * 128 + m * 16) * DM + jc;
        float r[8];
#pragma unroll
        for (int n = 0; n < 2; ++n)
#pragma unroll
          for (int j = 0; j < 4; ++j) {
            float g = acc[ai][0][m][n][j], up = acc[ai][1][m][n][j];
            g = fminf(g, 7.f); up = fminf(fmaxf(up, -7.f), 7.f);
            r[n * 4 + j] = (up + 1.f) * g * sigmoidf_(1.702f * g);
          }
        u32x2 w; w.x = pk4_fp8(r[0], r[1], r[2], r[3]); w.y = pk4_fp8(r[4], r[5], r[6], r[7]);
        *(u32x2*)rowp = w;
      }
  }
};
__device__ void ph_moe1(const Params& p, PG8_LAS unsigned char* lds, int nblk, int bid) {
  PG8_LAS int* tb = (PG8_LAS int*)(lds + pg8::STAGE_BYTES);
  moe_table(p, tb, 8);
  SchedMoe<true> S; S.tb = tb; S.NT = 8; S.G = nblk; S.c = bid; S.nwg = tb[NE]; S.A = (const char*)p.h2q; S.B = (const char*)p.wgu8; S.bexp = (size_t)2048 * DM; S.elist = p.elist; S.rowb = DM;
  EpiMoe1 E{p.b_gu, p.act8};
  pg8::gemm_phase<EpiMoe1, SchedMoe<true>, true>(lds, p.tid, DM / 2, DM / 2, DM / 2, S, E);
}
struct EpiMoe2 {
  static constexpr bool PERM = true;
  const float* b_down; const int* elist; const PG8_LAS int* tb; bf16_t* yslot;
  __device__ __forceinline__ void operator()(f32x4 (&acc)[2][2][4][2], const Unit& u, int wr, int wc, int fr, int fq) const {
    const int row0 = u.pm * 256 + wr * 64 + fr, col0 = u.pn * 256 + wc * 32 + 8 * fq;
    const float* bd = b_down + (size_t)u.z * 1024 + col0;
#pragma unroll
    for (int bj = 0; bj < 2; ++bj)
#pragma unroll
      for (int n = 0; n < 2; ++n) {
        const f32x4 bv = *(const f32x4*)(bd + bj * 128 + n * 4);
#pragma unroll
        for (int ai = 0; ai < 2; ++ai)
#pragma unroll
          for (int m = 0; m < 4; ++m) acc[ai][bj][m][n] += bv;
      }
    const int li0 = (u.pm - tb[33 + u.z]) * 256 + wr * 64 + fr, cnt = tb[66 + u.z];
    int av[2][4];
#pragma unroll
    for (int ai = 0; ai < 2; ++ai)
#pragma unroll
      for (int m = 0; m < 4; ++m) { const int li = li0 + ai * 128 + m * 16; av[ai][m] = elist[u.z * T_TOK + (li < cnt ? li : 0)]; if (li >= cnt) av[ai][m] = -1; }
#pragma unroll
    for (int ai = 0; ai < 2; ++ai)
#pragma unroll
      for (int m = 0; m < 4; ++m) {
        const int a = av[ai][m];
        if (a >= 0) {
          bf16_t* rowp = yslot + (size_t)a * DM + col0;
#pragma unroll
          for (int bj = 0; bj < 2; ++bj) {
            const f32x4 v0 = acc[ai][bj][m][0], v1 = acc[ai][bj][m][1];
            u32x4 w; w.x = pk2(v0[0], v0[1]); w.y = pk2(v0[2], v0[3]); w.z = pk2(v1[0], v1[1]); w.w = pk2(v1[2], v1[3]);
            *(u32x4*)(rowp + bj * 128) = w;
          }
        }
      }
  }
};
__device__ void ph_moe2(const Params& p, PG8_LAS unsigned char* lds, int nblk, int bid) {
  PG8_LAS int* tb = (PG8_LAS int*)(lds + pg8::STAGE_BYTES);
  moe_table(p, tb, 4);
  SchedMoe<false> S; S.tb = tb; S.NT = 4; S.G = nblk; S.c = bid; S.nwg = tb[NE]; S.A = (const char*)p.act8; S.B = (const char*)p.wd8; S.bexp = (size_t)1024 * DM; S.elist = p.elist; S.rowb = DM;
  EpiMoe2 E{p.b_down, p.elist, tb, p.yslot};
  pg8::gemm_phase<EpiMoe2, SchedMoe<false>, true>(lds, p.tid, DM / 2, DM / 2, DM / 2, S, E);
}

typedef short bf16x8 __attribute__((ext_vector_type(8)));
#define LAS __attribute__((address_space(3)))
#define MFMA16(a, b, c) __builtin_amdgcn_mfma_f32_16x16x32_bf16((a), (b), (c), 0, 0, 0)
__device__ __forceinline__ bf16x8 pack8(float a0, float a1, float a2, float a3, float a4, float a5, float a6, float a7) {
  u32x4 w; w.x = pk2(a0, a1); w.y = pk2(a2, a3); w.z = pk2(a4, a5); w.w = pk2(a6, a7);
  return __builtin_bit_cast(bf16x8, w);
}
__device__ __forceinline__ bf16_t f2bf_hw(float a) { return (bf16_t)(pk2(a, 0.f) & 0xffffu); }

#define DN_ABYTES 57344
#define DN_UFLOATS 8192
#define F_WN 0
#define F_QD 16
#define F_QK 32
#define F_KT 40

#define DP_KH 0
#define DP_QT 17408
#define DP_KHT 34816
#define DP_VT 53248
#define DP_TU 71680
#define DP_TW 80896
#define DP_LF 90112
#define DP_GC 107520
#define DP_BETA 107776
#define DP_CW 108032
#define DP_LB 114176
#define DP_TR 123392
#define DP_TT 132608
#define DP_MT 141824
#define DP_TOTAL 144128

template <int KS>
__device__ __forceinline__ f32x4 prod16(const LAS bf16_t* A, int lda, int arow0, const LAS bf16_t* Bt, int ldb, int brow0, f32x4 acc, int lane) {
  const int r = lane & 15, q = lane >> 4;
#pragma unroll
  for (int ks = 0; ks < KS; ++ks) {
    const bf16x8 a = *(const LAS bf16x8*)(A + (arow0 + r) * lda + 32 * ks + 8 * q);
    const bf16x8 b = *(const LAS bf16x8*)(Bt + (brow0 + r) * ldb + 32 * ks + 8 * q);
    acc = MFMA16(a, b, acc);
  }
  return acc;
}
__device__ __forceinline__ void tile_store_rm(LAS bf16_t* X, int ld, int row0, int col0, const f32x4 v, int lane) {
  const int r = lane & 15, q = lane >> 4;
#pragma unroll
  for (int i = 0; i < 4; ++i) X[(row0 + 4 * q + i) * ld + col0 + r] = f2bf_hw(v[i]);
}
__device__ __forceinline__ void tile_store_tr(LAS bf16_t* Xt, int ld, int row0, int col0, const f32x4 v, int lane) {
  const int r = lane & 15, q = lane >> 4;
  u32x2 w; w.x = pk2(v[0], v[1]); w.y = pk2(v[2], v[3]);
  *(LAS u32x2*)(Xt + (col0 + r) * ld + row0 + 4 * q) = w;
}

__device__ void dn_prep_chunk(const Params& p, LAS unsigned char* lds, int ci, bool load_cw) {
  const int tid = p.tid, lane = tid & 63, w = tid >> 6, r16 = lane & 15, q4 = lane >> 4;
  const int bh = ci >> 6, n = ci & 63, b = bh >> 2, h = bh & 3;
  LAS bf16_t* Kh = (LAS bf16_t*)(lds + DP_KH); LAS bf16_t* Qt = (LAS bf16_t*)(lds + DP_QT);
  LAS bf16_t* KhT = (LAS bf16_t*)(lds + DP_KHT); LAS bf16_t* VT = (LAS bf16_t*)(lds + DP_VT);
  LAS bf16_t* Tu = (LAS bf16_t*)(lds + DP_TU); LAS bf16_t* Tw = (LAS bf16_t*)(lds + DP_TW); LAS float* Lf = (LAS float*)(lds + DP_LF);
  LAS bf16_t* Lb = (LAS bf16_t*)(lds + DP_LB); LAS bf16_t* Tr = (LAS bf16_t*)(lds + DP_TR); LAS bf16_t* Tt = (LAS bf16_t*)(lds + DP_TT); LAS bf16_t* Mt = (LAS bf16_t*)(lds + DP_MT);
  LAS float* gcb = (LAS float*)(lds + DP_GC); LAS float* betab = (LAS float*)(lds + DP_BETA); LAS float* cw = (LAS float*)(lds + DP_CW);
  unsigned char* gA = (unsigned char*)p.dnA + (size_t)ci * DN_ABYTES;
  float* gU = p.dnU + (size_t)ci * DN_UFLOATS;

  if (load_cw) {
    for (int i = tid; i < 4 * 384; i += 512) { const int tap = i / 384, cc = i % 384, part = cc >> 7, d = cc & 127; cw[i] = p.conv_w[tap * 1536 + part * 512 + h * 128 + d]; }
  }
  __syncthreads();
  const int c = tid >> 3, g = tid & 7;
  const int s = n * 64 + c;
  const size_t t = (size_t)b * SEQ + s;
  float qv[16], kv[16], vv[16];
#pragma unroll
  for (int j = 0; j < 16; ++j) { qv[j] = 0.f; kv[j] = 0.f; vv[j] = 0.f; }
#pragma unroll
  for (int tap = 0; tap < 4; ++tap) {
    const int ss = s - 3 + tap;
    if (ss >= 0) {
      const bf16_t* row = p.proj + (t - 3 + tap) * PW + h * 128 + 16 * g;
      float x[8];
#pragma unroll
      for (int part = 0; part < 3; ++part) {
#pragma unroll
        for (int hh = 0; hh < 2; ++hh) {
          unpack8(*(const u32x4*)(row + part * 512 + 8 * hh), x);
#pragma unroll
          for (int j = 0; j < 8; ++j) {
            const float wv = cw[tap * 384 + part * 128 + 16 * g + 8 * hh + j];
            if (part == 0) qv[8 * hh + j] += wv * x[j];
            if (part == 1) kv[8 * hh + j] += wv * x[j];
            if (part == 2) vv[8 * hh + j] += wv * x[j];
          }
        }
      }
    }
    asm volatile("" ::: "memory");
  }
  float sq = 0.f, sk = 0.f;
#pragma unroll
  for (int j = 0; j < 16; ++j) { qv[j] = siluf_(qv[j]); kv[j] = siluf_(kv[j]); vv[j] = siluf_(vv[j]); sq += qv[j] * qv[j]; sk += kv[j] * kv[j]; }
  sq += __shfl_xor(sq, 1, 64); sq += __shfl_xor(sq, 2, 64); sq += __shfl_xor(sq, 4, 64);
  sk += __shfl_xor(sk, 1, 64); sk += __shfl_xor(sk, 2, 64); sk += __shfl_xor(sk, 4, 64);
  const float rq = rsqrtf(sq + 1e-6f) * 0.08838834764831845f, rk = rsqrtf(sk + 1e-6f);
#pragma unroll
  for (int j = 0; j < 16; ++j) { qv[j] *= rq; kv[j] *= rk; }
  if (g == 0) {
    const float bb = p.ba[t * 8 + h], aa = p.ba[t * 8 + 4 + h];
    const float xx = aa + p.dt_bias[h];
    const float sp = xx > 20.f ? xx : log1pf(__expf(xx));
    betab[c] = sigmoidf_(bb);
    gcb[c] = -__expf(p.a_log[h]) * sp;
  }
  {
    u32x4 w0, w1;
    w0.x = pk2(kv[0], kv[1]); w0.y = pk2(kv[2], kv[3]); w0.z = pk2(kv[4], kv[5]); w0.w = pk2(kv[6], kv[7]);
    w1.x = pk2(kv[8], kv[9]); w1.y = pk2(kv[10], kv[11]); w1.z = pk2(kv[12], kv[13]); w1.w = pk2(kv[14], kv[15]);
    *(LAS u32x4*)(Kh + c * 136 + 16 * g) = w0; *(LAS u32x4*)(Kh + c * 136 + 16 * g + 8) = w1;
    w0.x = pk2(qv[0], qv[1]); w0.y = pk2(qv[2], qv[3]); w0.z = pk2(qv[4], qv[5]); w0.w = pk2(qv[6], qv[7]);
    w1.x = pk2(qv[8], qv[9]); w1.y = pk2(qv[10], qv[11]); w1.z = pk2(qv[12], qv[13]); w1.w = pk2(qv[14], qv[15]);
    *(LAS u32x4*)(Qt + c * 136 + 16 * g) = w0; *(LAS u32x4*)(Qt + c * 136 + 16 * g + 8) = w1;
#pragma unroll
    for (int j = 0; j < 16; ++j) { KhT[(16 * g + j) * 72 + c] = f2bf_hw(kv[j]); VT[(16 * g + j) * 72 + c] = f2bf_hw(vv[j]); }
  }
  __syncthreads();
  if (w == 0) {
    float v = gcb[lane];
#pragma unroll
    for (int o = 1; o < 64; o <<= 1) { const float u = __shfl_up(v, o, 64); if (lane >= o) v += u; }
    gcb[lane] = v;
  }
  __syncthreads();
  const float gc_c = gcb[c], gl = gcb[63];
  {
    const float eg = __expf(gc_c);
    unsigned char* fb = gA + (size_t)(F_QD + (c >> 4) * 4 + (g >> 1)) * 1024 + (g & 1) * 8;
#pragma unroll
    for (int qq = 0; qq < 4; ++qq) {
      u32x2 wv; wv.x = pk2(qv[4 * qq] * eg, qv[4 * qq + 1] * eg); wv.y = pk2(qv[4 * qq + 2] * eg, qv[4 * qq + 3] * eg);
      *(u32x2*)(fb + ((c & 15) + 16 * qq) * 16) = wv;
    }
  }
  const int rt = w >> 1, ct0 = 2 * (w & 1);
#pragma unroll
  for (int tt = 0; tt < 2; ++tt) {
    const int ct = ct0 + tt;
    f32x4 gacc = {0.f, 0.f, 0.f, 0.f};
    gacc = prod16<4>(Kh, 136, 16 * rt, Kh, 136, 16 * ct, gacc, lane);
    const int m = 16 * ct + r16; const float gc_m = gcb[m];
    f32x4 lv;
#pragma unroll
    for (int i = 0; i < 4; ++i) {
      const int cc = 16 * rt + 4 * q4 + i;
      lv[i] = (m < cc) ? betab[cc] * gacc[i] * __expf(gcb[cc] - gc_m) : 0.f;
      Lf[cc * 68 + m] = lv[i];
    }
    tile_store_rm(Lb, 72, 16 * rt, 16 * ct, lv, lane);
    f32x4 qacc = {0.f, 0.f, 0.f, 0.f};
    qacc = prod16<4>(Kh, 136, 16 * rt, Qt, 136, 16 * ct, qacc, lane);
    const int cq = 16 * ct + r16; const float gc_cq = gcb[cq];
    float o4[4];
#pragma unroll
    for (int i = 0; i < 4; ++i) { const int mm = 16 * rt + 4 * q4 + i; o4[i] = (mm <= cq) ? qacc[i] * __expf(gc_cq - gcb[mm]) : 0.f; }
    u32x2 wv; wv.x = pk2(o4[0], o4[1]); wv.y = pk2(o4[2], o4[3]);
    *(u32x2*)(gA + (size_t)(F_QK + ct * 2 + (rt >> 1)) * 1024 + (r16 + 16 * q4) * 16 + (rt & 1) * 8) = wv;
  }
  __syncthreads();
  for (int i = tid; i < 2 * 64 * 72 / 8; i += 512) ((LAS u32x4*)Tr)[i] = (u32x4){0u, 0u, 0u, 0u};
  __syncthreads();
  if (w == 0) {
    int lo = lane; asm volatile("" : "+v"(lo));
    const int g = lo >> 4, j = lo & 15;
    unsigned lfb = DP_LF + (16 * g * 68 + 16 * g) * 4; asm volatile("" : "+v"(lfb));
    const LAS float* Lg = (const LAS float*)(lds + lfb);
    float t[16];
#pragma unroll
    for (int r = 0; r < 16; ++r) {
      float a0 = (r == j) ? 1.f : 0.f, a1 = 0.f;
#pragma unroll
      for (int k4 = 0; k4 < (r + 3) / 4; ++k4) {
        const f32x4 l = *(const LAS f32x4*)(Lg + r * 68 + 4 * k4);
        if (4 * k4 + 0 < r) a0 -= l[0] * t[4 * k4 + 0];
        if (4 * k4 + 1 < r) a1 -= l[1] * t[4 * k4 + 1];
        if (4 * k4 + 2 < r) a0 -= l[2] * t[4 * k4 + 2];
        if (4 * k4 + 3 < r) a1 -= l[3] * t[4 * k4 + 3];
      }
      t[r] = a0 + a1;
      Tr[(16 * g + r) * 72 + 16 * g + j] = f2bf_hw(t[r]);
    }
    u32x4 w0, w1;
    w0.x = pk2(t[0], t[1]); w0.y = pk2(t[2], t[3]); w0.z = pk2(t[4], t[5]); w0.w = pk2(t[6], t[7]);
    w1.x = pk2(t[8], t[9]); w1.y = pk2(t[10], t[11]); w1.z = pk2(t[12], t[13]); w1.w = pk2(t[14], t[15]);
    *(LAS u32x4*)(Tt + (16 * g + j) * 72 + 16 * g) = w0; *(LAS u32x4*)(Tt + (16 * g + j) * 72 + 16 * g + 8) = w1;
  }
  __syncthreads();
#pragma unroll 1
  for (int d = 1; d <= 3; ++d) {
    const bool act = w < 4 - d;
    const int I = w + d, J = w;
    LAS bf16_t* Mw = Mt + w * 16 * 24;
    if (act) {
      f32x4 macc = {0.f, 0.f, 0.f, 0.f};
      macc = prod16<2>(Lb, 72, 16 * I, Tt, 72, 16 * J, macc, lane);
      tile_store_tr(Mw, 24, 0, 0, macc, lane);
    }
    __syncthreads();
    if (act) {
      bf16x8 a = {0, 0, 0, 0, 0, 0, 0, 0}, bb = {0, 0, 0, 0, 0, 0, 0, 0};
      if (q4 < 2) { a = *(const LAS bf16x8*)(Tr + (16 * I + r16) * 72 + 16 * I + 8 * q4); bb = *(const LAS bf16x8*)(Mw + r16 * 24 + 8 * q4); }
      f32x4 tacc = {0.f, 0.f, 0.f, 0.f};
      tacc = MFMA16(a, bb, tacc);
#pragma unroll
      for (int i = 0; i < 4; ++i) tacc[i] = -tacc[i];
      tile_store_rm(Tr, 72, 16 * I, 16 * J, tacc, lane);
      tile_store_tr(Tt, 72, 16 * I, 16 * J, tacc, lane);
    }
    __syncthreads();
  }
  {
    const int cc = tid >> 3, m0 = (tid & 7) * 8;
    float tv[8]; unpack8(*(const LAS u32x4*)(Tr + cc * 72 + m0), tv);
    float tu[8], tw[8];
#pragma unroll
    for (int jj = 0; jj < 8; ++jj) { const float bm = betab[m0 + jj]; tu[jj] = tv[jj] * bm; tw[jj] = tu[jj] * __expf(gcb[m0 + jj]); }
    u32x4 wu, ww;
    wu.x = pk2(tu[0], tu[1]); wu.y = pk2(tu[2], tu[3]); wu.z = pk2(tu[4], tu[5]); wu.w = pk2(tu[6], tu[7]);
    ww.x = pk2(tw[0], tw[1]); ww.y = pk2(tw[2], tw[3]); ww.z = pk2(tw[4], tw[5]); ww.w = pk2(tw[6], tw[7]);
    *(LAS u32x4*)(Tu + cc * 72 + m0) = wu; *(LAS u32x4*)(Tw + cc * 72 + m0) = ww;
  }
  __syncthreads();
#pragma unroll
  for (int rr = 0; rr < 4; ++rr) {
    f32x4 u = {0.f, 0.f, 0.f, 0.f};
    u = prod16<2>(Tu, 72, 16 * rr, VT, 72, 16 * w, u, lane);
    *(f32x4*)(gU + ((w * 4 + rr) * 64 + lane) * 4) = u;
    f32x4 wt = {0.f, 0.f, 0.f, 0.f};
    wt = prod16<2>(KhT, 72, 16 * w, Tw, 72, 16 * rr, wt, lane);
    u32x2 wv; wv.x = pk2(-wt[0], -wt[1]); wv.y = pk2(-wt[2], -wt[3]);
    *(u32x2*)(gA + (size_t)(F_WN + rr * 4 + (w >> 1)) * 1024 + (r16 + 16 * q4) * 16 + (w & 1) * 8) = wv;
  }
#pragma unroll
  for (int it = 0; it < 4; ++it) {
    const int idx = tid + it * 512; const int d = idx >> 4, m4 = idx & 15;
    const u32x2 raw = *(const LAS u32x2*)(KhT + d * 72 + 4 * m4);
    const float k0 = __uint_as_float(raw.x << 16), k1 = __uint_as_float(raw.x & 0xffff0000u), k2 = __uint_as_float(raw.y << 16), k3 = __uint_as_float(raw.y & 0xffff0000u);
    const float e0 = __expf(gl - gcb[4 * m4]), e1 = __expf(gl - gcb[4 * m4 + 1]), e2 = __expf(gl - gcb[4 * m4 + 2]), e3 = __expf(gl - gcb[4 * m4 + 3]);
    u32x2 wv; wv.x = pk2(k0 * e0, k1 * e1); wv.y = pk2(k2 * e2, k3 * e3);
    *(u32x2*)(gA + (size_t)(F_KT + (d >> 4) * 2 + (m4 >> 3)) * 1024 + ((d & 15) + 16 * (m4 & 3)) * 16 + ((m4 >> 2) & 1) * 8) = wv;
  }
  if (tid == 0) p.dnG[ci] = __expf(gl);
}

#define DS_A0 0
#define DS_A1 57344
#define DS_TOTAL 114688
__device__ void dn_scan_blk(const Params& p, LAS unsigned char* lds, int item) {
  const int tid = p.tid, lane = tid & 63, w = __builtin_amdgcn_readfirstlane(tid >> 6), r16 = lane & 15, q4 = lane >> 4;
  const int bh = item >> 1, eh = item & 1, b = bh >> 2, h = bh & 3;
  const int et = eh * 4 + (w & 3);
  const bool comp = w < 4;
  const unsigned char* gA = (const unsigned char*)p.dnA + (size_t)bh * 64 * DN_ABYTES;
  const float* gU = p.dnU + (size_t)bh * 64 * DN_UFLOATS;
  const float* gG = p.dnG + bh * 64;
  auto issue_A = [&](int n, int buf) {
#pragma unroll
    for (int i = 0; i < 7; ++i) {
      const int f = w * 7 + i;
      __builtin_amdgcn_global_load_lds((const unsigned*)(gA + (size_t)n * DN_ABYTES + f * 1024 + lane * 16), (LAS unsigned*)(lds + (buf ? DS_A1 : DS_A0) + f * 1024), 16, 0, 0);
    }
  };
  __syncthreads();
  issue_A(0, 0);
  f32x4 Un[4];
#pragma unroll
  for (int rr = 0; rr < 4; ++rr) Un[rr] = *(const f32x4*)(gU + ((et * 4 + rr) * 64 + lane) * 4);
  f32x4 S[8];
#pragma unroll
  for (int dt = 0; dt < 8; ++dt) S[dt] = (f32x4){0.f, 0.f, 0.f, 0.f};
  asm volatile("s_waitcnt vmcnt(0)" ::: "memory");
  __syncthreads();
  bf16_t* obase = p.dn_out + ((size_t)b * SEQ) * p.dn_out_ld + h * 128 + 16 * et + r16;
  f32x4 Op[4];
#pragma unroll
  for (int rr = 0; rr < 4; ++rr) Op[rr] = (f32x4){0.f, 0.f, 0.f, 0.f};
  float gnext = gG[0];
#pragma unroll 1
  for (int n = 0; n < 64; ++n) {
    const LAS unsigned char* Ab = lds + ((n & 1) ? DS_A1 : DS_A0);
    if (n + 1 < 64) issue_A(n + 1, (n + 1) & 1);
    if (comp) {
      if (n > 0) {
#pragma unroll
        for (int rr = 0; rr < 4; ++rr)
#pragma unroll
          for (int i = 0; i < 4; ++i) obase[(size_t)((n - 1) * 64 + 16 * rr + 4 * q4 + i) * p.dn_out_ld] = f2bf_hw(Op[rr][i]);
      }
      f32x4 Vn[4];
#pragma unroll
      for (int rr = 0; rr < 4; ++rr) Vn[rr] = Un[rr];
      if (n + 1 < 64) {
#pragma unroll
        for (int rr = 0; rr < 4; ++rr) Un[rr] = *(const f32x4*)(gU + (size_t)(n + 1) * DN_UFLOATS + ((et * 4 + rr) * 64 + lane) * 4);
      }
      const float gdec = gnext;
      if (n + 1 < 64) gnext = gG[n + 1];
      bf16x8 Sb[4];
#pragma unroll
      for (int ks = 0; ks < 4; ++ks) Sb[ks] = pack8(S[2 * ks][0], S[2 * ks][1], S[2 * ks][2], S[2 * ks][3], S[2 * ks + 1][0], S[2 * ks + 1][1], S[2 * ks + 1][2], S[2 * ks + 1][3]);
#pragma unroll
      for (int dt = 0; dt < 8; ++dt) S[dt] *= gdec;
#define LDF(idx) (*(const LAS bf16x8*)(Ab + (idx) * 1024 + lane * 16))
#define SBAR __builtin_amdgcn_sched_barrier(0)
      bf16x8 fa[8], fb[8];
      f32x4 O[4];
#pragma unroll
      for (int rr = 0; rr < 4; ++rr) O[rr] = (f32x4){0.f, 0.f, 0.f, 0.f};
#pragma unroll
      for (int i = 0; i < 4; ++i) { fa[i] = LDF(F_WN + i); fa[4 + i] = LDF(F_QD + i); }
      SBAR;
#pragma unroll
      for (int i = 0; i < 4; ++i) { fb[i] = LDF(F_WN + 4 + i); fb[4 + i] = LDF(F_QD + 4 + i); }
      SBAR;
#pragma unroll
      for (int ks = 0; ks < 4; ++ks) { Vn[0] = MFMA16(fa[ks], Sb[ks], Vn[0]); O[0] = MFMA16(fa[4 + ks], Sb[ks], O[0]); }
      SBAR;
#pragma unroll
      for (int i = 0; i < 4; ++i) { fa[i] = LDF(F_WN + 8 + i); fa[4 + i] = LDF(F_QD + 8 + i); }
      SBAR;
#pragma unroll
      for (int ks = 0; ks < 4; ++ks) { Vn[1] = MFMA16(fb[ks], Sb[ks], Vn[1]); O[1] = MFMA16(fb[4 + ks], Sb[ks], O[1]); }
      SBAR;
#pragma unroll
      for (int i = 0; i < 4; ++i) { fb[i] = LDF(F_WN + 12 + i); fb[4 + i] = LDF(F_QD + 12 + i); }
      SBAR;
#pragma unroll
      for (int ks = 0; ks < 4; ++ks) { Vn[2] = MFMA16(fa[ks], Sb[ks], Vn[2]); O[2] = MFMA16(fa[4 + ks], Sb[ks], O[2]); }
      SBAR;
#pragma unroll
      for (int i = 0; i < 8; ++i) fa[i] = LDF(F_QK + i);
      SBAR;
#pragma unroll
      for (int ks = 0; ks < 4; ++ks) { Vn[3] = MFMA16(fb[ks], Sb[ks], Vn[3]); O[3] = MFMA16(fb[4 + ks], Sb[ks], O[3]); }
      SBAR;
#pragma unroll
      for (int i = 0; i < 8; ++i) fb[i] = LDF(F_KT + i);
      SBAR;
      bf16x8 Vb[2];
#pragma unroll
      for (int ks = 0; ks < 2; ++ks) Vb[ks] = pack8(Vn[2 * ks][0], Vn[2 * ks][1], Vn[2 * ks][2], Vn[2 * ks][3], Vn[2 * ks + 1][0], Vn[2 * ks + 1][1], Vn[2 * ks + 1][2], Vn[2 * ks + 1][3]);
#pragma unroll
      for (int ks = 0; ks < 2; ++ks)
#pragma unroll
        for (int rr = 0; rr < 4; ++rr) O[rr] = MFMA16(fa[rr * 2 + ks], Vb[ks], O[rr]);
      SBAR;
#pragma unroll
      for (int i = 0; i < 8; ++i) fa[i] = LDF(F_KT + 8 + i);
      SBAR;
#pragma unroll
      for (int ks = 0; ks < 2; ++ks)
#pragma unroll
        for (int dt = 0; dt < 4; ++dt) S[dt] = MFMA16(fb[dt * 2 + ks], Vb[ks], S[dt]);
      SBAR;
#pragma unroll
      for (int ks = 0; ks < 2; ++ks)
#pragma unroll
        for (int dt = 0; dt < 4; ++dt) S[4 + dt] = MFMA16(fa[dt * 2 + ks], Vb[ks], S[4 + dt]);
#pragma unroll
      for (int rr = 0; rr < 4; ++rr) Op[rr] = O[rr];
#undef LDF
#undef SBAR
    }
    asm volatile("s_waitcnt vmcnt(0)" ::: "memory");
    __syncthreads();
  }
  if (comp) {
#pragma unroll
    for (int rr = 0; rr < 4; ++rr)
#pragma unroll
      for (int i = 0; i < 4; ++i) obase[(size_t)(63 * 64 + 16 * rr + 4 * q4 + i) * p.dn_out_ld] = f2bf_hw(Op[rr][i]);
  }
}
__device__ void ph_dn_norm(const Params& p, int nblk, int bid) {
  const int wid = p.tid >> 6, lane = p.tid & 63;
  const f32x4 g0 = *(const f32x4*)(p.g_dn_out + (lane & 15) * 8), g1 = *(const f32x4*)(p.g_dn_out + (lane & 15) * 8 + 4);
  u32x4 on_ = {0u, 0u, 0u, 0u}, zn_ = on_;
  if (bid * 8 + wid < T_TOK) { const int t0 = bid * 8 + wid; on_ = *(const u32x4*)(p.oab + (size_t)t0 * DM + lane * 8); zn_ = *(const u32x4*)(p.proj + (size_t)t0 * PW + C_Z + lane * 8); }
  for (int t = bid * 8 + wid; t < T_TOK; t += nblk * 8) {
    bf16_t* op = p.oab + (size_t)t * DM + lane * 8;
    float o[8], z[8];
    unpack8(on_, o);
    unpack8(zn_, z);
    if (t + nblk * 8 < T_TOK) { const int tn = t + nblk * 8; on_ = *(const u32x4*)(p.oab + (size_t)tn * DM + lane * 8); zn_ = *(const u32x4*)(p.proj + (size_t)tn * PW + C_Z + lane * 8); }
    float ss = 0.f;
#pragma unroll
    for (int j = 0; j < 8; ++j) ss += o[j] * o[j];
    ss += __shfl_xor(ss, 1, 64); ss += __shfl_xor(ss, 2, 64); ss += __shfl_xor(ss, 4, 64); ss += __shfl_xor(ss, 8, 64);
    const float rstd = rsqrtf(ss * (1.f / 128.f) + 1e-6f);
    float y[8];
#pragma unroll
    for (int j = 0; j < 4; ++j) { y[j] = o[j] * rstd * g0[j] * siluf_(z[j]); y[4 + j] = o[4 + j] * rstd * g1[j] * siluf_(z[4 + j]); }
    u32x4 w; w.x = pk2(y[0], y[1]); w.y = pk2(y[2], y[3]); w.z = pk2(y[4], y[5]); w.w = pk2(y[6], y[7]);
    *(u32x4*)op = w;
  }
}
typedef float f32x16 __attribute__((ext_vector_type(16)));
#define MFMA32(a, b, c) __builtin_amdgcn_mfma_f32_32x32x16_bf16((a), (b), (c), 0, 0, 0)
#define MP_VL 0
#define MP_RED 65536
#define MP_TOTAL (65536 + 4096)

__device__ void moba_prep_block(const Params& p, LAS unsigned char* lds, int item) {
  const int tid = p.tid, lane = tid & 63, w = tid >> 6;
  const int bh = item >> 4, jb = item & 15, b = bh >> 2, h = bh & 3;
  LAS bf16_t* Vl = (LAS bf16_t*)(lds + MP_VL);
  LAS float* red = (LAS float*)(lds + MP_RED);
  __syncthreads();
#pragma unroll
  for (int it = 0; it < 8; ++it) {
    const int idx = tid + 512 * it, row = idx >> 4, ch = idx & 15;
    const u32x4 v = *(const u32x4*)(p.proj + ((size_t)b * SEQ + 256 * jb + row) * PW + C_MV + h * 128 + 8 * ch);
    *(LAS u32x4*)(Vl + row * 128 + 8 * ch) = v;
  }
  {
    const int r = tid >> 1, hh = tid & 1;
    const int pos = 256 * jb + r;
    const size_t t = (size_t)b * SEQ + pos;
    float cs[8], sn[8];
#pragma unroll
    for (int jj = 0; jj < 8; ++jj) {
      const float inv = exp2f(-(float)(8 * hh + jj) * (1.f / 16.f) * 18.931568569324174f);
      const float ang = (float)pos * inv;
      cs[jj] = cosf(ang); sn[jj] = sinf(ang);
    }
    float kacc[64];
#pragma unroll
    for (int which = 0; which < 2; ++which) {
      const bf16_t* src = p.proj + t * PW + (which ? C_MQ : C_MK) + h * 128 + 8 * hh;
      float x0[8], x1[8];
      unpack8(*(const u32x4*)(src), x0); unpack8(*(const u32x4*)(src + 16), x1);
      float y0[8], y1[8];
#pragma unroll
      for (int jj = 0; jj < 8; ++jj) { y0[jj] = x0[jj] * cs[jj] - x1[jj] * sn[jj]; y1[jj] = x1[jj] * cs[jj] + x0[jj] * sn[jj]; }
      u32x4 o[8];
      o[0].x = pk2(y0[0], y0[1]); o[0].y = pk2(y0[2], y0[3]); o[0].z = pk2(y0[4], y0[5]); o[0].w = pk2(y0[6], y0[7]);
      o[1].x = pk2(y1[0], y1[1]); o[1].y = pk2(y1[2], y1[3]); o[1].z = pk2(y1[4], y1[5]); o[1].w = pk2(y1[6], y1[7]);
#pragma unroll
      for (int ks = 2; ks < 8; ++ks) o[ks] = *(const u32x4*)(src + 16 * ks);
      if (which == 0) {
#pragma unroll
        for (int jj = 0; jj < 8; ++jj) { kacc[jj] = y0[jj]; kacc[8 + jj] = y1[jj]; }
#pragma unroll
        for (int ks = 2; ks < 8; ++ks) { float f[8]; unpack8(o[ks], f);
#pragma unroll
          for (int jj = 0; jj < 8; ++jj) kacc[8 * ks + jj] = f[jj]; }
        unsigned char* dst = (unsigned char*)p.Kp + ((size_t)(bh * 128 + 8 * jb + (r >> 5)) * 8192) + ((r & 31) + 32 * hh) * 16;
#pragma unroll
        for (int ks = 0; ks < 8; ++ks) *(u32x4*)(dst + ks * 1024) = o[ks];
      } else {
        bf16_t* dst = p.qb + ((size_t)bh * SEQ + pos) * 128 + 8 * hh;
#pragma unroll
        for (int ks = 0; ks < 8; ++ks) *(u32x4*)(dst + 16 * ks) = o[ks];
      }
    }
#pragma unroll
    for (int e = 0; e < 64; ++e) {
      float v = kacc[e];
      v += __shfl_xor(v, 2, 64); v += __shfl_xor(v, 4, 64); v += __shfl_xor(v, 8, 64); v += __shfl_xor(v, 16, 64); v += __shfl_xor(v, 32, 64);
      kacc[e] = v;
    }
    if (lane < 2) {
#pragma unroll
      for (int e = 0; e < 64; ++e) red[(w * 2 + lane) * 64 + e] = kacc[e];
    }
  }
  __syncthreads();
  if (tid < 128) {
    const int d = tid, hh = (d >> 3) & 1, ks = d >> 4, jj = d & 7;
    float a = 0.f;
#pragma unroll
    for (int ww = 0; ww < 8; ++ww) a += red[(ww * 2 + hh) * 64 + ks * 8 + jj];
    p.kmean[((size_t)bh * 16 + jb) * 128 + d] = a * (1.f / 256.f);
  }
#pragma unroll
  for (int it = 0; it < 8; ++it) {
    const int o = tid + 512 * it, ln = o & 63, frag = o >> 6, tl = frag >> 3, dt = (frag >> 1) & 3, s = frag & 1;
    const int r = ln & 31, hh = ln >> 5, d = 32 * dt + r;
    unsigned short e[8];
#pragma unroll
    for (int jj = 0; jj < 8; ++jj) { const int key = 32 * tl + 16 * s + 8 * (jj >> 2) + 4 * hh + (jj & 3); e[jj] = Vl[key * 128 + d]; }
    u32x4 wv; wv.x = e[0] | ((unsigned)e[1] << 16); wv.y = e[2] | ((unsigned)e[3] << 16); wv.z = e[4] | ((unsigned)e[5] << 16); wv.w = e[6] | ((unsigned)e[7] << 16);
    *(u32x4*)((unsigned char*)p.Vp + ((size_t)(bh * 128 + 8 * jb + tl) * 8192) + (dt * 2 + s) * 1024 + ln * 16) = wv;
  }
}
__device__ __forceinline__ int crow32(int reg, int hh) { return (reg & 3) + 8 * (reg >> 2) + 4 * hh; }
__device__ void moba_item(const Params& p, LAS float* km, LAS float* mrg, LAS float* ml, int bh, int ib, int sub, int par, int lane, int rep) {
  const int q = lane & 31, hh = lane >> 5;
  const int b = bh >> 2, h = bh & 3;
  const int s0 = 256 * ib + 32 * sub;
  const bf16_t* qrow = p.qb + ((size_t)bh * SEQ + s0 + q) * 128 + 8 * hh;
  bf16x8 Qf[8];
#pragma unroll
  for (int ks = 0; ks < 8; ++ks) Qf[ks] = *(const bf16x8*)(qrow + 16 * ks);
  LAS unsigned char* qlds = (LAS unsigned char*)km + 8192 + lane * 16;
#pragma unroll
  for (int ks = 0; ks < 8; ++ks) *(LAS bf16x8*)(qlds + ks * 1024) = Qf[ks];
  unsigned selmask = 0;
  if (ib > 0) {
    for (int idx = lane; idx < ib * 32; idx += 64) ((LAS f32x4*)km)[idx] = ((const f32x4*)(p.kmean + (size_t)bh * 16 * 128))[idx];
    float qf[64];
#pragma unroll
    for (int ks = 0; ks < 8; ++ks) { float f[8]; unpack8(__builtin_bit_cast(u32x4, Qf[ks]), f);
#pragma unroll
      for (int jj = 0; jj < 8; ++jj) qf[8 * ks + jj] = f[jj]; }
    float sc[16];
#pragma unroll
    for (int j = 0; j < 16; ++j) {
      sc[j] = -INFINITY;
      if (j < ib) {
        float a = 0.f;
#pragma unroll
        for (int ks = 0; ks < 8; ++ks) {
          const f32x4 k0 = *(const LAS f32x4*)(km + j * 128 + 16 * ks + 8 * hh), k1 = *(const LAS f32x4*)(km + j * 128 + 16 * ks + 8 * hh + 4);
          a += qf[8 * ks] * k0[0] + qf[8 * ks + 1] * k0[1] + qf[8 * ks + 2] * k0[2] + qf[8 * ks + 3] * k0[3];
          a += qf[8 * ks + 4] * k1[0] + qf[8 * ks + 5] * k1[1] + qf[8 * ks + 6] * k1[2] + qf[8 * ks + 7] * k1[3];
        }
        a += __shfl_xor(a, 32, 64);
        sc[j] = a;
      }
    }
#pragma unroll
    for (int r = 0; r < 3; ++r) {
      if (r < ib) {
        float best = -INFINITY; int bi = 0;
#pragma unroll
        for (int j = 0; j < 16; ++j) if (sc[j] > best) { best = sc[j]; bi = j; }
        selmask |= 1u << bi;
#pragma unroll
        for (int j = 0; j < 16; ++j) if (j == bi) sc[j] = -INFINITY;
      }
    }
  }
  unsigned rem = 0;
  for (int j = 0; j < ib; ++j) if (__ballot((selmask >> j) & 1u) != 0ull) rem |= 1u << j;
  rem = __builtin_amdgcn_readfirstlane(rem);
  const int own0 = 8 * ib, diag = 8 * ib + sub;
  const float cscale = 0.08838834764831845f * 1.4426950408889634f;
  float m = -1e30f, l = 0.f;
  f32x16 O[4];
#pragma unroll
  for (int dt = 0; dt < 4; ++dt)
#pragma unroll
    for (int r = 0; r < 16; ++r) O[dt][r] = 0.f;
  const unsigned char* kbase = (const unsigned char*)p.Kp + (size_t)bh * 128 * 8192 + lane * 16;
  const unsigned char* vbase = (const unsigned char*)p.Vp + (size_t)bh * 128 * 8192 + lane * 16;
  auto adv = [&](int& kt_, unsigned& rem_) {
    if (kt_ < 0) return;
    if (kt_ >= own0 ? (kt_ < diag) : ((kt_ & 7) != 7)) { kt_ = kt_ + 1; return; }
    if (rem_ == 0u) { kt_ = -1; return; }
    kt_ = 8 * (__builtin_ctz(rem_)); rem_ &= rem_ - 1u;
  };
  int kt = own0;
  if (par) adv(kt, rem);
  auto load_k = [&](int t, bf16x8 (&K_)[8]) {
#pragma unroll
    for (int ks = 0; ks < 8; ++ks) K_[ks] = *(const bf16x8*)(kbase + (size_t)t * 8192 + ks * 1024);
  };
  auto tile_step = [&](bf16x8 (&Kc)[8], bf16x8 (&Kn)[8]) -> bool {
    int ktn = kt; unsigned remn = rem;
    adv(ktn, remn); adv(ktn, remn);
    bf16x8 Vf[8];
#pragma unroll
    for (int f = 0; f < 8; ++f) Vf[f] = *(const bf16x8*)(vbase + (size_t)kt * 8192 + f * 1024);
    if (ktn >= 0) load_k(ktn, Kn);
    f32x16 S;
#pragma unroll
    for (int r = 0; r < 16; ++r) S[r] = 0.f;
#pragma unroll
    for (int ks = 0; ks < 8; ++ks) S = MFMA32(Kc[ks], *(const LAS bf16x8*)(qlds + ks * 1024), S);
    const bool allowed = (kt >= own0) || ((selmask >> (kt >> 3)) & 1u);
    const float nb = allowed ? 0.f : -INFINITY;
    float sv[16]; float mx = -INFINITY;
#pragma unroll
    for (int r = 0; r < 16; ++r) sv[r] = __builtin_fmaf(S[r], cscale, nb);
    if (kt == diag) {
#pragma unroll
      for (int r = 0; r < 16; ++r) if (crow32(r, hh) > q) sv[r] = -INFINITY;
    }
#pragma unroll
    for (int r = 0; r < 16; ++r) mx = fmaxf(mx, sv[r]);
    mx = fmaxf(mx, __shfl_xor(mx, 32, 64));
    const bool grow = mx > m + 8.f;
    const float mn = (__ballot(grow) != 0ull) ? fmaxf(m, mx) : m;
    const float alpha = __builtin_amdgcn_exp2f(m - mn);
    float ps = 0.f;
#pragma unroll
    for (int r = 0; r < 16; ++r) { sv[r] = __builtin_amdgcn_exp2f(sv[r] - mn); ps += sv[r]; }
    l = l * alpha + ps; m = mn;
    if (__ballot(alpha != 1.f) != 0ull) {
#pragma unroll
      for (int dt = 0; dt < 4; ++dt)
#pragma unroll
        for (int r = 0; r < 16; ++r) O[dt][r] *= alpha;
    }
    const bf16x8 P0 = pack8(sv[0], sv[1], sv[2], sv[3], sv[4], sv[5], sv[6], sv[7]);
    const bf16x8 P1 = pack8(sv[8], sv[9], sv[10], sv[11], sv[12], sv[13], sv[14], sv[15]);
#pragma unroll
    for (int dt = 0; dt < 4; ++dt) { O[dt] = MFMA32(Vf[dt * 2], P0, O[dt]); O[dt] = MFMA32(Vf[dt * 2 + 1], P1, O[dt]); }
    kt = ktn; rem = remn;
    return kt >= 0;
  };
  if (kt >= 0) {
    bf16x8 KA[8], KB[8];
    load_k(kt, KA);
#pragma unroll 1
    for (;;) {
      if (!tile_step(KA, KB)) break;
      asm volatile("" ::: "memory");
      if (!tile_step(KB, KA)) break;
      asm volatile("" ::: "memory");
    }
  }
  asm volatile("s_waitcnt vmcnt(0) lgkmcnt(0)" ::: "memory");
  if (par) {
    ml[lane] = m; ml[64 + lane] = l;
#pragma unroll
    for (int dt = 0; dt < 4; ++dt)
#pragma unroll
      for (int r = 0; r < 16; ++r) mrg[(dt * 16 + r) * 64 + lane] = O[dt][r];
  }
  __syncthreads();
  if (par == 0) {
    const float m2 = ml[lane], l2 = ml[64 + lane];
    const float mm = fmaxf(m, m2);
    const float a1 = __builtin_amdgcn_exp2f(m - mm), a2 = __builtin_amdgcn_exp2f(m2 - mm);
    l = l * a1 + l2 * a2;
#pragma unroll
    for (int dt = 0; dt < 4; ++dt)
#pragma unroll
      for (int r = 0; r < 16; ++r) O[dt][r] = O[dt][r] * a1 + mrg[(dt * 16 + r) * 64 + lane] * a2;
  }
  if (par == 0) {
  l += __shfl_xor(l, 32, 64);
  const float inv = 1.f / l;
  bf16_t* orow = rep ? p.oab2 + ((size_t)b * SEQ + s0 + q) * 512 + h * 128 : p.mb_out + ((size_t)b * SEQ + s0 + q) * p.mb_out_ld + p.mb_out_off + h * 128;
#pragma unroll
  for (int dt = 0; dt < 4; ++dt)
#pragma unroll
    for (int g4 = 0; g4 < 4; ++g4) {
      u32x2 wv; wv.x = pk2(O[dt][4 * g4] * inv, O[dt][4 * g4 + 1] * inv); wv.y = pk2(O[dt][4 * g4 + 2] * inv, O[dt][4 * g4 + 3] * inv);
      *(u32x2*)(orow + 32 * dt + 8 * g4 + 4 * hh) = wv;
    }
  }
  __syncthreads();
}
__device__ void moba_worker(const Params& p, LAS unsigned char* lds, int qi) {
  const int lane = p.tid & 63, w = __builtin_amdgcn_readfirstlane(p.tid >> 6);
  LAS float* km = (LAS float*)(lds + w * 16384);
  LAS float* mrg = (LAS float*)(lds + ((w & 3) + 4) * 16384);
  LAS float* ml = (LAS float*)(lds + 131072) + (w & 3) * 128;
  LAS int* slot = (LAS int*)(lds + 131072 + 2048);
  const int g0 = (int)((unsigned)__builtin_amdgcn_s_getreg((3 << 11) | 20) & 7u);
  for (int gi = 0; gi < 8; ++gi) {
    const int g = (g0 + gi) & 7;
    for (;;) {
      __syncthreads();
      if (p.tid == 0) slot[0] = atomicAdd(p.wq + qi * 8 + g, 1);
      __syncthreads();
      const int idx = slot[0];
      if (idx >= 64) break;
      const int bh = 2 * g + (idx >> 5), ib = 15 - ((idx >> 1) & 15), quad = 1 - (idx & 1);
      moba_item(p, km, mrg, ml, bh, ib, 4 * quad + (w & 3), w >> 2, lane, qi);
    }
  }
}
__device__ void ph_mod(const Params& p, LAS unsigned char* lds, int nblk, int bid) {
  LAS float* sc = (LAS float*)lds;
  LAS float* part = (LAS float*)(lds + 16384);
  const int tid = p.tid;
  if (bid >= 192) return;
  for (int i = tid; i < 4096; i += 512) sc[i] = siluf_(p.c[i]);
  __syncthreads();
  for (int task = bid; task < 192; task += nblk) {
    const int jj = tid & 31, ks = tid >> 5, j = task * 32 + jj;
    float a0 = 0.f, a1 = 0.f, a2 = 0.f, a3 = 0.f;
#pragma unroll 8
    for (int kk = 0; kk < 64; ++kk) {
      const int k = ks * 64 + kk;
      const float w = p.w_ada[(size_t)k * 6144 + j];
      a0 += sc[k] * w; a1 += sc[1024 + k] * w; a2 += sc[2048 + k] * w; a3 += sc[3072 + k] * w;
    }
    *(LAS f32x4*)(part + (ks * 32 + jj) * 4) = (f32x4){a0, a1, a2, a3};
    __syncthreads();
    if (tid < 128) {
      const int j2 = tid & 31, bb = tid >> 5;
      float a = 0.f;
#pragma unroll
      for (int s = 0; s < 16; ++s) a += part[(s * 32 + j2) * 4 + bb];
      p.mod[bb * 6144 + task * 32 + j2] = a + p.b_ada[task * 32 + j2];
    }
    __syncthreads();
  }
}

#define WT_T0 1424
#define WT_T1 (WT_T0 + 16384)
#define WT_T2 (WT_T1 + 8192)
#define WT_T3 (WT_T2 + 128)
#define WT_T4 (WT_T3 + 128)
#define WT_T5 (WT_T4 + 256)
struct WtTile { const float* src; bf16_t* dst; int K, N, mode, k0, n0; unsigned char* dst8; };
__device__ __forceinline__ WtTile wt_desc(const Params& p, int t) {
  WtTile d;
  if (t < WT_T0) { const int kt = t / 89, nt = t % 89; d = {p.w_in, p.w_in_t, 1024, INW, 1, kt * 64, nt * 64, nullptr}; }
  else if (t < WT_T1) { const int u = t - WT_T0, e = u >> 9, r = u & 511, kt = r >> 5, nt = r & 31; d = {p.w_gu + (size_t)e * 1024 * 2048, nullptr, 1024, 2048, 2, kt * 64, nt * 64, p.wgu8 + (size_t)e * 2048 * 1024}; }
  else if (t < WT_T2) { const int u = t - WT_T1, e = u >> 8, r = u & 255, kt = r >> 4, nt = r & 15; d = {p.w_down + (size_t)e * 1024 * 1024, nullptr, 1024, 1024, 0, kt * 64, nt * 64, p.wd8 + (size_t)e * 1024 * 1024}; }
  else if (t < WT_T3) { const int u = t - WT_T2, kt = u >> 4, nt = u & 15; d = {p.w_br_a, p.wbra_t, 512, 1024, 0, kt * 64, nt * 64, nullptr}; }
  else if (t < WT_T4) { const int u = t - WT_T3, kt = u >> 4, nt = u & 15; d = {p.w_br_b, p.wbrb_t, 512, 1024, 0, kt * 64, nt * 64, nullptr}; }
  else { const int u = t - WT_T4, kt = u >> 4, nt = u & 15; d = {p.w_o, p.wo_t, 1024, 1024, 0, kt * 64, nt * 64, nullptr}; }
  return d;
}
__device__ __forceinline__ void wt_load(const WtTile& d, int tid, f32x4 (&v)[2]) {
#pragma unroll
  for (int it = 0; it < 2; ++it) {
    const int row = (tid >> 4) + 32 * it, n = d.n0 + (tid & 15) * 4;
    v[it] = (f32x4){0.f, 0.f, 0.f, 0.f};
    if (n < d.N) v[it] = __builtin_nontemporal_load((const f32x4*)(d.src + (size_t)(d.k0 + row) * d.N + n));
  }
}
__device__ void ph_wt(const Params& p, LAS unsigned char* lds, int nblk, int bid) {
  LAS float* tile = (LAS float*)(lds + 32768);
  const int tid = p.tid;
  int t = bid;
  if (t >= WT_T5) return;
  WtTile cur = wt_desc(p, t);
  f32x4 v[2]; wt_load(cur, tid, v);
  WtTile nxt = cur; f32x4 vn[2] = {v[0], v[1]};
  if (t + nblk < WT_T5) { nxt = wt_desc(p, t + nblk); wt_load(nxt, tid, vn); }
  for (;;) {
    const int tnn = t + 2 * nblk;
    WtTile nn = nxt; f32x4 vnn[2] = {vn[0], vn[1]};
    if (tnn < WT_T5) { nn = wt_desc(p, tnn); wt_load(nn, tid, vnn); }
#pragma unroll
    for (int it = 0; it < 2; ++it) {
      const int row = (tid >> 4) + 32 * it, c4 = (tid & 15) * 4;
      tile[row * 65 + c4] = v[it][0]; tile[row * 65 + c4 + 1] = v[it][1]; tile[row * 65 + c4 + 2] = v[it][2]; tile[row * 65 + c4 + 3] = v[it][3];
    }
    __syncthreads();
    {
      const int nl = tid >> 3, kc = tid & 7, n = cur.n0 + nl;
      if (n < cur.N) {
        const int dd = map_col(n, cur.mode);
        if (dd >= 0) {
          float f[8];
#pragma unroll
          for (int j = 0; j < 8; ++j) f[j] = tile[(8 * kc + j) * 65 + nl];
          if (cur.dst8) {
            u32x2 w; w.x = pk4_fp8(f[0] * 64.f, f[1] * 64.f, f[2] * 64.f, f[3] * 64.f); w.y = pk4_fp8(f[4] * 64.f, f[5] * 64.f, f[6] * 64.f, f[7] * 64.f);
            *(u32x2*)(cur.dst8 + (size_t)dd * cur.K + cur.k0 + 8 * kc) = w;
          } else {
            u32x4 w; w.x = pk2(f[0], f[1]); w.y = pk2(f[2], f[3]); w.z = pk2(f[4], f[5]); w.w = pk2(f[6], f[7]);
            *(u32x4*)(cur.dst + (size_t)dd * cur.K + cur.k0 + 8 * kc) = w;
          }
        }
      }
    }
    __syncthreads();
    if (t + nblk >= WT_T5) break;
    t += nblk; cur = nxt; v[0] = vn[0]; v[1] = vn[1]; nxt = nn; vn[0] = vnn[0]; vn[1] = vnn[1];
  }
}

__device__ void ph_h(const Params& p, LAS unsigned char* lds, int nblk, int bid) {
  const int wid = p.tid >> 6, lane = p.tid & 63;
  LAS float* wb = (LAS float*)lds;
  for (int i = p.tid; i < 2048; i += 512) {
    const int k = i >> 1, hf = i & 1;
    const f32x4 v = *(const f32x4*)(p.w_in + (size_t)k * INW + 2048 + 4 * hf);
    wb[(4 * hf + 0) * 1024 + k] = v[0]; wb[(4 * hf + 1) * 1024 + k] = v[1]; wb[(4 * hf + 2) * 1024 + k] = v[2]; wb[(4 * hf + 3) * 1024 + k] = v[3];
  }
  __syncthreads();
  f32x4 xnx[4];
  if (bid * 8 + wid < T_TOK) {
#pragma unroll
    for (int i = 0; i < 4; ++i) xnx[i] = *(const f32x4*)(p.x + (size_t)(bid * 8 + wid) * DM + i * 256 + lane * 4);
  }
  for (int t = bid * 8 + wid; t < T_TOK; t += nblk * 8) {
    const int b = t / SEQ;
    f32x4 xv[4];
    float ss = 0.f;
#pragma unroll
    for (int i = 0; i < 4; ++i) {
      xv[i] = xnx[i];
      ss += xv[i][0] * xv[i][0] + xv[i][1] * xv[i][1] + xv[i][2] * xv[i][2] + xv[i][3] * xv[i][3];
    }
    if (t + nblk * 8 < T_TOK) {
#pragma unroll
      for (int i = 0; i < 4; ++i) xnx[i] = *(const f32x4*)(p.x + (size_t)(t + nblk * 8) * DM + i * 256 + lane * 4);
    }
    ss = wave_sum(ss);
    const float rstd = rsqrtf(ss * (1.f / DM) + 1e-6f);
    const float* shift = p.mod + b * 6144;
    const float* scale = p.mod + b * 6144 + 1024;
    float acc[8] = {0, 0, 0, 0, 0, 0, 0, 0};
#pragma unroll
    for (int i = 0; i < 4; ++i) {
      const int k = i * 256 + lane * 4;
      const f32x4 g = *(const f32x4*)(p.g_pre_mix + k), sc = *(const f32x4*)(scale + k), sh = *(const f32x4*)(shift + k);
      f32x4 hv;
#pragma unroll
      for (int j = 0; j < 4; ++j) hv[j] = xv[i][j] * rstd * g[j] * (1.f + sc[j]) + sh[j];
#pragma unroll
      for (int e = 0; e < 8; ++e) { const f32x4 w = *(const LAS f32x4*)(wb + e * 1024 + k); acc[e] += hv[0] * w[0] + hv[1] * w[1] + hv[2] * w[2] + hv[3] * w[3]; }
      u32x2 pk; pk.x = pk2(hv[0], hv[1]); pk.y = pk2(hv[2], hv[3]);
      *(u32x2*)(p.hbf + (size_t)t * DM + k) = pk;
    }
#pragma unroll
    for (int e = 0; e < 8; ++e) acc[e] = wave_sum(acc[e]);
    if (lane == 0) { *(f32x4*)(p.ba + (size_t)t * 8) = (f32x4){acc[0], acc[1], acc[2], acc[3]}; *(f32x4*)(p.ba + (size_t)t * 8 + 4) = (f32x4){acc[4], acc[5], acc[6], acc[7]}; }
  }
}

__device__ void ph_post_mix(const Params& p, LAS unsigned char* lds, int nblk, int bid, int rep) {
  const int wid = p.tid >> 6, lane = p.tid & 63;
  LAS bf16_t* wl = (LAS bf16_t*)lds;
  LAS float* sh = (LAS float*)(lds + 81920) + wid * 1024;
  LAS int* lcnt = (LAS int*)(lds + 114688);
  LAS int* lbase = lcnt + 32;
  LAS int* lent = (LAS int*)(lds + 115200) + wid * 256;
  int nloc = 0;
  if (p.tid < 32) lcnt[p.tid] = 0;
  for (int i = p.tid; i < 1024 * 8; i += 512) {
    const int k = i >> 3, c = i & 7;
    const f32x4 v = *(const f32x4*)(p.w_router + (size_t)k * 32 + c * 4);
    u32x2 w2; w2.x = pk2(v[0], v[1]); w2.y = pk2(v[2], v[3]);
    *(LAS u32x2*)(wl + k * 40 + c * 4) = w2;
  }
  __syncthreads();
  u32x4 mxn[2]; f32x4 xn[4];
  {
    const int t0 = bid * 8 + wid;
    if (t0 < T_TOK) {
#pragma unroll
      for (int i = 0; i < 2; ++i) mxn[i] = *(const u32x4*)(p.mixer + (size_t)t0 * DM + i * 512 + lane * 8);
#pragma unroll
      for (int i = 0; i < 4; ++i) xn[i] = *(const f32x4*)(p.x + (size_t)t0 * DM + (i >> 1) * 512 + lane * 8 + (i & 1) * 4);
    }
  }
  for (int t = bid * 8 + wid; t < T_TOK; t += nblk * 8) {
    const int b = t / SEQ;
    const float* md = p.mod + b * 6144;
    u32x4 mxc[2] = {mxn[0], mxn[1]}; f32x4 xc[4] = {xn[0], xn[1], xn[2], xn[3]};
    {
      const int tn = t + nblk * 8;
      if (tn < T_TOK) {
#pragma unroll
        for (int i = 0; i < 2; ++i) mxn[i] = *(const u32x4*)(p.mixer + (size_t)tn * DM + i * 512 + lane * 8);
#pragma unroll
        for (int i = 0; i < 4; ++i) xn[i] = *(const f32x4*)(p.x + (size_t)tn * DM + (i >> 1) * 512 + lane * 8 + (i & 1) * 4);
      }
    }
    float mv[16];
    float ss = 0.f;
#pragma unroll
    for (int i = 0; i < 2; ++i) {
      float f[8]; unpack8(mxc[i], f);
#pragma unroll
      for (int j = 0; j < 8; ++j) { mv[i * 8 + j] = f[j]; ss += f[j] * f[j]; }
    }
    ss = wave_sum(ss);
    const float rstd = rsqrtf(ss * (1.f / DM) + 1e-6f);
    float x1[16];
    float s2 = 0.f;
#pragma unroll
    for (int i = 0; i < 2; ++i)
#pragma unroll
      for (int j4 = 0; j4 < 2; ++j4) {
        const int k = i * 512 + lane * 8 + j4 * 4;
        const f32x4 xv = xc[i * 2 + j4];
        const f32x4 gm = *(const f32x4*)(md + 2048 + k), gp = *(const f32x4*)(p.g_post_mix + k);
        f32x4 o;
#pragma unroll
        for (int j = 0; j < 4; ++j) { o[j] = xv[j] + gm[j] * (mv[i * 8 + j4 * 4 + j] * rstd * gp[j]); x1[i * 8 + j4 * 4 + j] = o[j]; s2 += o[j] * o[j]; }
        *(f32x4*)(p.out + (size_t)t * DM + k) = o;
      }
    s2 = wave_sum(s2);
    const float rstd2 = rsqrtf(s2 * (1.f / DM) + 1e-6f);
#pragma unroll
    for (int i = 0; i < 2; ++i) {
      float hv[8];
#pragma unroll
      for (int j = 0; j < 8; ++j) {
        const int k = i * 512 + lane * 8 + j;
        hv[j] = x1[i * 8 + j] * rstd2 * p.g_pre_ffn[k] * (1.f + md[4096 + k]) + md[3072 + k];
        sh[k] = hv[j];
      }
      u32x2 w; w.x = pk4_fp8(hv[0], hv[1], hv[2], hv[3]); w.y = pk4_fp8(hv[4], hv[5], hv[6], hv[7]);
      *(u32x2*)(p.h2q + (size_t)t * DM + i * 512 + lane * 8) = w;
    }
#ifdef PM_SKIP
    if (rep) continue;
#endif
    float acc[32];
#pragma unroll
    for (int e2 = 0; e2 < 32; ++e2) acc[e2] = 0.f;
#pragma unroll 4
    for (int i = 0; i < 16; ++i) {
      const float hk = sh[lane + 64 * i];
      const LAS u32x4* wr = (const LAS u32x4*)(wl + (lane + 64 * i) * 40);
#pragma unroll
      for (int c4 = 0; c4 < 4; ++c4) {
        float f[8]; unpack8(wr[c4], f);
#pragma unroll
        for (int j = 0; j < 8; ++j) acc[c4 * 8 + j] += hk * f[j];
      }
    }
    {
      const bool u5 = lane & 32, u4 = lane & 16, u3 = lane & 8, u2 = lane & 4, u1 = lane & 2;
      float a16[16], a8[8], a4[4], a2[2];
#pragma unroll
      for (int j = 0; j < 16; ++j) { const float snd = u5 ? acc[j] : acc[16 + j]; const float rcv = __shfl_xor(snd, 32, 64); a16[j] = (u5 ? acc[16 + j] : acc[j]) + rcv; }
#pragma unroll
      for (int j = 0; j < 8; ++j) { const float snd = u4 ? a16[j] : a16[8 + j]; const float rcv = __shfl_xor(snd, 16, 64); a8[j] = (u4 ? a16[8 + j] : a16[j]) + rcv; }
#pragma unroll
      for (int j = 0; j < 4; ++j) { const float snd = u3 ? a8[j] : a8[4 + j]; const float rcv = __shfl_xor(snd, 8, 64); a4[j] = (u3 ? a8[4 + j] : a8[j]) + rcv; }
#pragma unroll
      for (int j = 0; j < 2; ++j) { const float snd = u2 ? a4[j] : a4[2 + j]; const float rcv = __shfl_xor(snd, 4, 64); a2[j] = (u2 ? a4[2 + j] : a4[j]) + rcv; }
      const float snd = u1 ? a2[0] : a2[1]; const float rcv = __shfl_xor(snd, 2, 64);
      float a1 = (u1 ? a2[1] : a2[0]) + rcv;
      a1 += __shfl_xor(a1, 1, 64);
      acc[0] = a1;
    }
    const int e = lane >> 1;
    float lg = acc[0] + p.b_router[e];
    if (lane & 1) lg = -INFINITY;
    float tv[4]; int ti[4];
#pragma unroll
    for (int r = 0; r < 4; ++r) {
      const float m = wave_max(lg);
      const unsigned long long bal = __ballot(lg == m);
      const int idx = __ffsll((long long)bal) - 1;
      tv[r] = m; ti[r] = idx >> 1;
      if (lane == idx) lg = -INFINITY;
    }
    const float e1 = __expf(tv[1] - tv[0]), e2 = __expf(tv[2] - tv[0]), e3 = __expf(tv[3] - tv[0]);
    const float inv = 1.f / (1.f + e1 + e2 + e3);
    if (lane < 4) {
      const int ee = lane == 0 ? ti[0] : lane == 1 ? ti[1] : lane == 2 ? ti[2] : ti[3];
      const float ww = (lane == 0 ? 1.f : lane == 1 ? e1 : lane == 2 ? e2 : e3) * inv;
      p.aw[t * 4 + lane] = ww;
      const int rank = __hip_atomic_fetch_add(&lcnt[ee], 1, __ATOMIC_RELAXED, __HIP_MEMORY_SCOPE_WORKGROUP);
      lent[nloc * 4 + lane] = (ee << 16) | rank;
      lent[nloc * 4 + lane + 2048] = t * 4 + lane;
    }
    ++nloc;
  }
  __syncthreads();
  if (p.tid < 32) lbase[p.tid] = atomicAdd(&p.cnt[p.tid * 64 + 32 * rep], lcnt[p.tid]);
  __syncthreads();
  for (int i = lane; i < nloc * 4; i += 64) {
    const int er = lent[i], a = lent[i + 2048];
    p.elist[(er >> 16) * T_TOK + lbase[er >> 16] + (er & 0xffff)] = a;
  }
}

__device__ void ph_gather(const Params& p, LAS unsigned char* lds, int nblk, int bid) {
  const int wid = p.tid >> 6, lane = p.tid & 63;
  LAS int* tb = (LAS int*)lds;
  if (p.tid == 0) { int off = 0; for (int k = 0; k < NE; ++k) { const int c = p.cnt[k * 64]; tb[k] = off; tb[64 + k] = c; off += ((c + 255) >> 8) << 8; } tb[NE] = off; }
  __syncthreads();
  const int total = tb[NE];
  for (int r = bid * 8 + wid; r < total; r += nblk * 8) {
    int e = 0;
#pragma unroll 1
    for (int k = 1; k < NE; ++k) if (r >= tb[k]) e = k;
    const int i = r - tb[e];
    const int a = (i < tb[64 + e]) ? p.elist[e * T_TOK + i] : -1;
    if (lane == 0) p.rowmap[r] = a;
    u32x4 v0 = {0, 0, 0, 0}, v1 = v0;
    if (a >= 0) { const u32x4* src = (const u32x4*)(p.h2 + (size_t)(a >> 2) * DM); v0 = src[lane]; v1 = src[64 + lane]; }
    u32x4* dst = (u32x4*)(p.xs + (size_t)r * DM);
    dst[lane] = v0; dst[64 + lane] = v1;
  }
}

__device__ void ph_final(const Params& p, int nblk, int bid, int rep) {
  const int wid = p.tid >> 6, lane = p.tid & 63;
  for (int t0 = bid * 8 + wid; t0 < T_TOK; t0 += nblk * 16) {
    int tt[2] = {t0, t0 + nblk * 8};
    if (tt[1] >= T_TOK) tt[1] = t0;
    float mv[2][16]; float ss[2];
#pragma unroll
    for (int u = 0; u < 2; ++u) {
      const int t = tt[u];
      const f32x4 wv = *(const f32x4*)(p.aw + t * 4);
      ss[u] = 0.f;
#pragma unroll
      for (int i = 0; i < 2; ++i) {
        const bf16_t* y = p.yslot + (size_t)t * 4 * DM + i * 512 + lane * 8;
        float f0[8], f1[8], f2[8], f3[8];
        unpack8(*(const u32x4*)y, f0); unpack8(*(const u32x4*)(y + DM), f1); unpack8(*(const u32x4*)(y + 2 * DM), f2); unpack8(*(const u32x4*)(y + 3 * DM), f3);
#pragma unroll
        for (int j = 0; j < 8; ++j) { const float m = wv[0] * f0[j] + wv[1] * f1[j] + wv[2] * f2[j] + wv[3] * f3[j]; mv[u][i * 8 + j] = m; ss[u] += m * m; }
      }
    }
    f32x4 x1[2][4];
#pragma unroll
    for (int u = 0; u < 2; ++u)
#pragma unroll
      for (int i = 0; i < 2; ++i)
#pragma unroll
        for (int j4 = 0; j4 < 2; ++j4) x1[u][i * 2 + j4] = *(const f32x4*)(p.out + (size_t)tt[u] * DM + i * 512 + lane * 8 + j4 * 4);
    ss[0] = wave_sum(ss[0]); ss[1] = wave_sum(ss[1]);
#pragma unroll
    for (int u = 0; u < 2; ++u) {
      const int t = tt[u];
      if (u == 1 && t == t0) break;
      const float* md = p.mod + (t / SEQ) * 6144;
      const float rstd = rsqrtf(ss[u] * (1.f / DM) + 1e-6f);
#pragma unroll
      for (int i = 0; i < 2; ++i)
#pragma unroll
        for (int j4 = 0; j4 < 2; ++j4) {
          const int k = i * 512 + lane * 8 + j4 * 4;
          float* op = p.out + (size_t)t * DM + k;
          const f32x4 gf = *(const f32x4*)(md + 5120 + k), gp = *(const f32x4*)(p.g_post_ffn + k);
          f32x4 o;
#pragma unroll
          for (int j = 0; j < 4; ++j) o[j] = x1[u][i * 2 + j4][j] + gf[j] * (mv[u][i * 8 + j4 * 4 + j] * rstd * gp[j]);
          *(f32x4*)(rep ? (float*)p.hbf + (size_t)(t & 8191) * DM + k : op) = o;
        }
    }
  }
}

#define XCD_BAR_WORDS 3456
struct KArgs { const void* in[22]; float* out; char* ws; long long never; };
__host__ __device__ inline size_t al(size_t x) { return (x + 255) & ~(size_t)255; }
__host__ __device__ inline void fill_params(Params& p, const KArgs& k) {
  p.x = (const float*)k.in[0]; p.c = (const float*)k.in[1]; p.w_ada = (const float*)k.in[2]; p.b_ada = (const float*)k.in[3];
  p.g_pre_mix = (const float*)k.in[4]; p.g_post_mix = (const float*)k.in[5]; p.g_pre_ffn = (const float*)k.in[6];
  p.g_post_ffn = (const float*)k.in[7]; p.w_in = (const float*)k.in[8]; p.conv_w = (const float*)k.in[9];
  p.a_log = (const float*)k.in[10]; p.dt_bias = (const float*)k.in[11]; p.g_dn_out = (const float*)k.in[12];
  p.w_br_a = (const float*)k.in[13]; p.w_br_b = (const float*)k.in[14]; p.w_o = (const float*)k.in[15];
  p.w_router = (const float*)k.in[16]; p.b_router = (const float*)k.in[17]; p.w_gu = (const float*)k.in[18];
  p.b_gu = (const float*)k.in[19]; p.w_down = (const float*)k.in[20]; p.b_down = (const float*)k.in[21];
  p.out = k.out;
  char* w = k.ws;
  size_t o = 0;
#define take(bytes) (w + (o += al(bytes)) - al(bytes))
  p.mod = (float*)take(4 * 6144 * 4);
  p.cnt = (int*)take(16384);
  p.ba = (float*)take((size_t)T_TOK * 8 * 4);
  p.hbf = (bf16_t*)take((size_t)T_TOK * DM * 2);
  p.proj = (bf16_t*)take((size_t)T_TOK * PW * 2);
  p.w_in_t = (bf16_t*)take((size_t)PW * DM * 2);
  p.wgu8 = (unsigned char*)take((size_t)NE * 2048 * DM);
  p.wd8 = (unsigned char*)take((size_t)NE * 1024 * DM);
  p.h2q = (unsigned char*)take((size_t)T_TOK * DM);
  p.act8 = (unsigned char*)take((size_t)73728 * DM);
  p.wbra_t = (bf16_t*)take((size_t)1024 * 512 * 2);
  p.wbrb_t = (bf16_t*)take((size_t)1024 * 512 * 2);
  p.wo_t = (bf16_t*)take((size_t)1024 * 1024 * 2);
  p.qb = (bf16_t*)take((size_t)T_TOK * 512 * 2);
  p.kb = (bf16_t*)take((size_t)T_TOK * 512 * 2);
  p.kmean = (float*)take((size_t)16 * 16 * 128 * 4);
  p.oab = (bf16_t*)take((size_t)T_TOK * DM * 2);
  p.merged = (bf16_t*)take((size_t)T_TOK * DM * 2);
  p.mixer = (bf16_t*)take((size_t)T_TOK * DM * 2);
  p.h2 = (bf16_t*)take((size_t)T_TOK * DM * 2);
  p.elist = (int*)take((size_t)NE * T_TOK * 4);
  p.aw = (float*)take((size_t)T_TOK * 4 * 4);
  p.rowmap = (int*)take((size_t)73728 * 4);
  p.dnA = (unsigned char*)take((size_t)1024 * DN_ABYTES);
  p.dnU = (float*)take((size_t)1024 * DN_UFLOATS * 4);
  p.dnG = (float*)take(4096);
  p.oab2 = (bf16_t*)take((size_t)T_TOK * 512 * 2);
  p.dbg = (float*)take(256);
  p.bar = (unsigned*)take(XCD_BAR_WORDS * 4);
  p.dn_out = p.oab; p.dn_out_ld = DM;
  p.Kp = (bf16_t*)take((size_t)16 * 128 * 8192);
  p.Vp = (bf16_t*)take((size_t)16 * 128 * 8192);
  p.wq = p.cnt + 32 * 64;
  p.mb_out = p.oab; p.mb_out_ld = DM; p.mb_out_off = 512;
  p.xs = p.proj;
  char* big = take((size_t)73728 * DM * 2 + (size_t)65536 * DM * 2);
  p.act = (bf16_t*)big;
  p.yslot = (bf16_t*)(big + (size_t)73728 * DM * 2);
  {
    char* s = big; size_t so = 0;
#define t2(bytes) (s + (so += al(bytes)) - al(bytes))
    p.nq = (float*)t2((size_t)T_TOK * 512 * 4);
    p.nk = (float*)t2((size_t)T_TOK * 512 * 4);
    p.nv = (float*)t2((size_t)T_TOK * 512 * 4);
    p.no = (float*)t2((size_t)T_TOK * 512 * 4);
    p.ntmp = (float*)t2((size_t)T_TOK * DM * 4);
    p.nbeta = (float*)t2((size_t)T_TOK * 4 * 4);
    p.ng = (float*)t2((size_t)T_TOK * 4 * 4);
  }

#undef take
#undef t2
  p.never = (int)k.never;
}

#define XB_TMO      128
#define XB_XCNT(j)  (256  + 64 * (j))
#define XB_XSUB(j)  (1280 + 64 * (j))
#define XB_XGEN(j)  (2304 + 64 * (j))
#define XB_TOP      3328
#define XB_TOPGEN   3392
#define XB_SPIN_CAP (1u << 18)

__device__ __forceinline__ unsigned xb_ld(unsigned* p)              { return __hip_atomic_load(p, __ATOMIC_RELAXED, __HIP_MEMORY_SCOPE_AGENT); }
__device__ __forceinline__ unsigned xb_add(unsigned* p, unsigned v) { return __hip_atomic_fetch_add(p, v, __ATOMIC_RELAXED, __HIP_MEMORY_SCOPE_AGENT); }
__device__ __forceinline__ unsigned xb_xcc_id() { return (unsigned)__builtin_amdgcn_s_getreg((3 << 11) | 20) & 0xFu; }
#define XB_SPIN(cond, bar) do { unsigned _sp = 0; while (cond) { __builtin_amdgcn_s_sleep(1); \
    if ((++_sp & 255u) == 0u) { if (xb_ld(&(bar)[XB_TMO])) break; if (_sp > XB_SPIN_CAP) { atomicAdd(&(bar)[XB_TMO], 1u); break; } } } } while (0)

struct XcdBarrier {
    unsigned* bar; unsigned x;
    volatile LAS unsigned* st;
};

__device__ __forceinline__ XcdBarrier xcd_barrier_post(unsigned* bar, volatile LAS unsigned* st) {
    XcdBarrier b; b.bar = bar; b.x = xb_xcc_id(); b.st = st;
    if (threadIdx.x == 0) (void)xb_add(&bar[XB_XCNT(b.x)], 1u);
    return b;
}
__device__ __forceinline__ void xcd_barrier_complete(unsigned* bar, unsigned x, unsigned& nloc, unsigned& nx) {
    const unsigned G = gridDim.x * gridDim.y * gridDim.z;
    unsigned sum, cnt, mine, sp = 0u;
    for (;;) {
        sum = 0u; cnt = 0u; mine = 0u;
#pragma unroll
        for (unsigned j = 0; j < 16; ++j) { const unsigned c = xb_ld(&bar[XB_XCNT(j)]); sum += c; cnt += (c > 0u) ? 1u : 0u; mine = (j == x) ? c : mine; }
        if (sum == G) break;
        __builtin_amdgcn_s_sleep(1);
        if ((++sp & 255u) == 0u) { if (xb_ld(&bar[XB_TMO])) break; if (sp > XB_SPIN_CAP) { atomicAdd(&bar[XB_TMO], 1u); break; } }
    }
    nloc = mine > 0u ? mine : 1u; nx = cnt > 0u ? cnt : 1u;
}

__device__ __forceinline__ void xcd_barrier(const XcdBarrier& b, const int tid) {
    asm volatile("s_waitcnt vmcnt(0)" ::: "memory");
    __syncthreads();
    if (tid == 0) {
        unsigned* bar = b.bar;
        __builtin_amdgcn_s_waitcnt(0);
        unsigned nloc = b.st[0], nx = b.st[1];
        if (nloc == 0u) { xcd_barrier_complete(bar, b.x, nloc, nx); b.st[0] = nloc; b.st[1] = nx; }
        const unsigned old = xb_add(&bar[XB_XSUB(b.x)], 1u);
        const unsigned gen = old / nloc;
        if (old + 1u == (gen + 1u) * nloc) {
            __builtin_amdgcn_fence(__ATOMIC_RELEASE, "agent");
            asm volatile("s_waitcnt vmcnt(0)" ::: "memory");
            const unsigned og = xb_add(&bar[XB_TOP], 1u);
            const unsigned tg = og / nx;
            if (og + 1u == (tg + 1u) * nx) xb_add(&bar[XB_TOPGEN], 1u);
            else XB_SPIN(xb_ld(&bar[XB_TOPGEN]) == tg, bar);
            __builtin_amdgcn_fence(__ATOMIC_ACQUIRE, "agent");
            xb_add(&bar[XB_XGEN(b.x)], 1u);
            asm volatile("s_waitcnt vmcnt(0)" ::: "memory");
        } else {
            XB_SPIN(xb_ld(&bar[XB_XGEN(b.x)]) == gen, bar);
            __builtin_amdgcn_fence(__ATOMIC_ACQUIRE, "agent");
            asm volatile("s_waitcnt vmcnt(0)" ::: "memory");
        }
    }
    __syncthreads();
}


__device__ __forceinline__ void load_ka(KArgs& kk) {
#if defined(__HIP_DEVICE_COMPILE__)
  typedef __attribute__((address_space(1))) char* gptr_t;
  typedef const __attribute__((address_space(4))) gptr_t* kptr_t;
  kptr_t kp = (kptr_t)__builtin_amdgcn_kernarg_segment_ptr();
  asm volatile("" : "+s"(kp));
#pragma unroll
  for (int i = 0; i < 22; ++i) kk.in[i] = (const void*)kp[i];
  kk.out = (float*)kp[22];
  kk.ws = (char*)kp[23];
  kk.never = ((const __attribute__((address_space(4))) long long*)kp)[24];
#endif
}
__device__ __forceinline__ void grid_bar(const Params& p, LAS unsigned char* lds);
#define MEGA_LDS 148480
#define MEGA_LDS_ALLOC (MEGA_LDS + 16)
__device__ __forceinline__ void grid_bar(const Params& p, LAS unsigned char* lds) {
  XcdBarrier b; b.bar = p.bar; b.x = xb_xcc_id(); b.st = (volatile LAS unsigned*)(lds + MEGA_LDS);
  xcd_barrier(b, p.tid);
}
__global__ __launch_bounds__(512) void mega(KArgs ka) {
  extern __shared__ __attribute__((aligned(16))) unsigned char shm[];
  LAS unsigned char* lds = (LAS unsigned char*)shm;
  cg::grid_group grid = cg::this_grid();
  const int nblk = gridDim.x, bid = blockIdx.x;
  const int wv_ = __builtin_amdgcn_readfirstlane(threadIdx.x >> 6);
  volatile LAS unsigned* xst = (volatile LAS unsigned*)(lds + MEGA_LDS);
  if (threadIdx.x == 0) { xst[0] = 0u; xst[1] = 0u; xst[2] = 0u; xst[3] = 0u; }
  __syncthreads();
  { Params p0; fill_params(p0, ka); (void)xcd_barrier_post(p0.bar, xst); }
  if (ka.never) grid.sync();
#ifndef REPMASK
#define REPMASK 0
#endif
#define LOADKA KArgs kk; load_ka(kk)
#ifndef PHMASK
#define PHMASK 0xffff
#endif
#define PHASE(k, body) if (((PHMASK) >> (k)) & 1) for (int rep_ = 0; rep_ < (((REPMASK) >> (k)) & 1) + 1; ++rep_) { \
    LOADKA; Params p; fill_params(p, kk); { int t_; asm volatile("v_mbcnt_lo_u32_b32 %0, -1, 0\n\tv_mbcnt_hi_u32_b32 %0, -1, %0" : "=v"(t_)); p.tid = (wv_ << 6) | t_; } body; grid_bar(p, lds); }
#ifdef XBAR
  for (int xb_ = 0; xb_ < XBAR; ++xb_) { PHASE(15, {}) }
#endif
  PHASE(0, { ph_mod(p, lds, nblk, bid); ph_wt(p, lds, nblk, bid); })
  PHASE(1, { ph_h(p, lds, nblk, bid); })
  PHASE(2, { ph_proj(p, lds, nblk, bid); })
  PHASE(3, { bool first = true; for (int ci = bid; ci < 1024; ci += nblk) { dn_prep_chunk(p, lds, ci, first); first = false; }
             for (int item = bid; item < 256; item += nblk) moba_prep_block(p, lds, item); })
  PHASE(4, { if (bid < 32) dn_scan_blk(p, lds, bid); moba_worker(p, lds, rep_); })
  PHASE(5, { ph_dn_norm(p, nblk, bid); })
  PHASE(6, { ph_br(p, lds, nblk, bid); })
  PHASE(7, { ph_mix(p, lds, nblk, bid); })
  PHASE(8, { ph_post_mix(p, lds, nblk, bid, rep_); })
  PHASE(10, { ph_moe1(p, lds, nblk, bid); })
  PHASE(11, { ph_moe2(p, lds, nblk, bid); })
  PHASE(12, { ph_final(p, nblk, bid, rep_); })
}


extern "C" void kernel_launch(void* const* d_in, const int* in_sizes, int n_in, void* d_out, int out_size, void* d_ws,
                              size_t ws_size, hipStream_t stream) {
  KArgs ka{};
  for (int i = 0; i < 22; ++i) ka.in[i] = d_in[i];
  ka.out = (float*)d_out; ka.ws = (char*)d_ws; ka.never = 0;
  Params p{};
  fill_params(p, ka);
  static int grid_blocks = 0;
  if (!grid_blocks) {
    (void)hipFuncSetAttribute((const void*)mega, hipFuncAttributeMaxDynamicSharedMemorySize, MEGA_LDS_ALLOC);
    int dev = 0, cus = 0, per_cu = 0;
    (void)hipGetDevice(&dev);
    (void)hipDeviceGetAttribute(&cus, hipDeviceAttributeMultiprocessorCount, dev);
    (void)hipOccupancyMaxActiveBlocksPerMultiprocessor(&per_cu, mega, 512, MEGA_LDS_ALLOC);
    if (per_cu != 1) per_cu = 1;
    grid_blocks = cus * per_cu;
  }
  (void)hipMemsetAsync(p.cnt, 0, 16384, stream);
  (void)hipMemsetAsync(p.bar, 0, XCD_BAR_WORDS * 4, stream);
  void* args[] = {&ka};
  hipError_t e = hipLaunchCooperativeKernel((void*)mega, dim3(grid_blocks), dim3(512), args, MEGA_LDS_ALLOC, stream);
  if (e != hipSuccess) fprintf(stderr, "cooperative launch failed: %s (grid %d)\n", hipGetErrorString(e), grid_blocks);
}
```

```cpp
#include <hip/hip_runtime.h>
#include <hip/hip_cooperative_groups.h>
#include <cstdio>
namespace cg = cooperative_groups;
#include <stdint.h>

typedef unsigned short bf16_t;
#ifndef MB_ABL
#define MB_ABL 0
#endif

#define T_TOK 16384
#define SEQ 4096
#define NB 4
#define DM 1024
#define INW 5640
#define PW 5632
#define C_QA 0
#define C_KA 512
#define C_VA 1024
#define C_Z 1536
#define C_MQ 2048
#define C_MK 2560
#define C_MV 3072
#define C_GA 3584
#define C_GB 4608
#define NE 32

__device__ __forceinline__ bf16_t f2bf(float f) {
  unsigned u = __float_as_uint(f);
  u += 0x7fffu + ((u >> 16) & 1u);
  return (bf16_t)(u >> 16);
}
__device__ __forceinline__ float bf2f(bf16_t h) { return __uint_as_float(((unsigned)h) << 16); }
__device__ __forceinline__ float sigmoidf_(float x) { return __builtin_amdgcn_rcpf(1.f + __builtin_amdgcn_exp2f(-1.4426950408889634f * x)); }
__device__ __forceinline__ float siluf_(float x) { return x * sigmoidf_(x); }
__device__ __forceinline__ float wave_sum(float v) {
#pragma unroll
  for (int o = 32; o > 0; o >>= 1) v += __shfl_xor(v, o, 64);
  return v;
}
__device__ __forceinline__ float wave_max(float v) {
#pragma unroll
  for (int o = 32; o > 0; o >>= 1) v = fmaxf(v, __shfl_xor(v, o, 64));
  return v;
}

typedef unsigned u32x2 __attribute__((ext_vector_type(2)));
typedef __bf16 bf16x2_t __attribute__((ext_vector_type(2)));
typedef float f32x2_t __attribute__((ext_vector_type(2)));
__device__ __forceinline__ unsigned pk2(float a, float b) { f32x2_t v = {a, b}; bf16x2_t r = __builtin_convertvector(v, bf16x2_t); return __builtin_bit_cast(unsigned, r); }

__device__ __forceinline__ unsigned pk4_fp8(float a, float b, float c, float d) {
  int w = 0;
  w = __builtin_amdgcn_cvt_pk_fp8_f32(a, b, w, false);
  w = __builtin_amdgcn_cvt_pk_fp8_f32(c, d, w, true);
  return (unsigned)w;
}

struct Params {
  const float *x, *c, *w_ada, *b_ada, *g_pre_mix, *g_post_mix, *g_pre_ffn, *g_post_ffn, *w_in, *conv_w,
      *a_log, *dt_bias, *g_dn_out, *w_br_a, *w_br_b, *w_o, *w_router, *b_router, *w_gu, *b_gu, *w_down, *b_down;
  float* out;
  float* mod;
  int* cnt;
  float* ba;
  bf16_t* hbf;
  bf16_t* proj;
  bf16_t* w_in_t;
  unsigned char* wgu8;
  unsigned char* wd8;
  unsigned char* h2q;
  unsigned char* act8;
  bf16_t* wbra_t;
  bf16_t* wbrb_t;
  bf16_t* wo_t;
  bf16_t* qb;
  bf16_t* kb;
  float* kmean;
  bf16_t* oab;
  bf16_t* merged;
  bf16_t* mixer;
  bf16_t* h2;
  int* elist;
  float* aw;
  bf16_t* act;
  bf16_t* xs;
  int* rowmap;
  bf16_t* yslot;
  unsigned char* dnA; float* dnU; float* dnG;
  bf16_t* dn_out; int dn_out_ld;
  bf16_t* oab2; float* dbg;
  unsigned* bar; int never; int tid;
  bf16_t* Kp; bf16_t* Vp; int* wq;
  bf16_t* mb_out; int mb_out_ld; int mb_out_off;
  float* nq; float* nk; float* nv;
  float* nbeta; float* ng;
  float* no;
  float* ntmp;
};

__device__ __forceinline__ int map_col(int n, int mode) {
  if (mode == 0) return n;
  if (mode == 1) return n < 2048 ? n : (n < 2056 ? -1 : n - 8);
  if (n < 1024) return (n >> 7) * 256 + (n & 127);
  int j = n - 1024;
  return (j >> 7) * 256 + 128 + (j & 127);
}
namespace pg8 {
#define PG8_LAS __attribute__((address_space(3)))
typedef short bf16x8 __attribute__((ext_vector_type(8)));
typedef float f32x4 __attribute__((ext_vector_type(4)));
typedef unsigned u32x4 __attribute__((ext_vector_type(4)));
constexpr int BM = 256, BK = 64, HALF = 128, HTB = HALF * BK * 2, STAGE_BYTES = 8 * HTB, NXCD = 8, WGM = 8;

__host__ __device__ __forceinline__ int lds_byte(int r, int c) { const int st = (r >> 4) * 2 + (c >> 5), rr = r & 15, cc = c & 31, ob = rr * 64 + cc * 2; return st * 1024 + (ob ^ (((ob >> 9) & 1) << 5)); }
__host__ __device__ __forceinline__ void stage_rc(int b, int& R, int& C) { const int st = b / 1024, sb = b % 1024, swz = sb ^ (((sb >> 9) & 1) << 5); R = (st >> 1) * 16 + swz / 64; C = (st & 1) * 32 + (swz % 64) / 2; }
__host__ __device__ __forceinline__ int perm32(int rho) { const int n = rho >> 4, i = rho & 15; return 8 * (i >> 2) + 4 * n + (i & 3); }

struct Unit { int pm, pn, z; };
__device__ __forceinline__ unsigned cvt_pk_bf16(float lo, float hi) { unsigned r; asm volatile("v_cvt_pk_bf16_f32 %0, %1, %2" : "=v"(r) : "v"(lo), "v"(hi)); return r; }

typedef int i32x8 __attribute__((ext_vector_type(8)));
typedef int i32x4 __attribute__((ext_vector_type(4)));
__device__ __forceinline__ i32x8 cat8(const bf16x8 lo, const bf16x8 hi) { const i32x4 a = __builtin_bit_cast(i32x4, lo), b = __builtin_bit_cast(i32x4, hi); return __builtin_shufflevector(a, b, 0, 1, 2, 3, 4, 5, 6, 7); }
struct TileOrder {
    int nM, nN, nwg, G, c;
    __device__ void init(int nM_, int nN_, int G_, int c_) { nM = nM_; nN = nN_; nwg = nM * nN; G = G_; c = c_; }
    __device__ bool tile(int i, int& pm, int& pn) const {
        const long L = (long)i * G + c; if (L >= nwg) return false;
        int wgid = (int)L; { const int q = nwg / NXCD, r = nwg % NXCD, xcd = wgid % NXCD, off = wgid / NXCD; wgid = (xcd < r ? xcd * (q + 1) : r * (q + 1) + (xcd - r) * q) + off; }
        const int nig = WGM * nN, gid = wgid / nig, fm = gid * WGM, gsz = (nM - fm) < WGM ? (nM - fm) : WGM;
        pm = fm + ((wgid % nig) % gsz); pn = (wgid % nig) / gsz; return true;
    }
};

template <class Epi, class Sched, bool FP8 = false>
__device__ __forceinline__ void gemm_phase(PG8_LAS unsigned char* lds, const int tid, const int lda, const int ldb, const int K, const Sched& S, const Epi& E) {
    const int wid = __builtin_amdgcn_readfirstlane(tid >> 6), lane = tid & 63, wr = wid >> 2, wc = wid & 3, fr = lane & 15, fq = lane >> 4;
    const int nt = K / BK;
    unsigned voffA[2], voffB[2];
#pragma unroll
    for (int i = 0; i < 2; ++i) { int R, C; stage_rc(tid * 16 + i * 8192, R, C); const int Rb = Epi::PERM ? ((R & ~31) + perm32(R & 31)) : R;
        voffA[i] = (unsigned)(R * lda + C) * 2u; voffB[i] = (unsigned)(Rb * ldb + C) * 2u; }
    const size_t kstep = (size_t)(BK * 2);
    const size_t hstepA = (size_t)HALF * lda * 2, hstepB = (size_t)HALF * ldb * 2;
    const unsigned ldsw = (unsigned)wid * 1024u;
    const int aoff = lds_byte(wr * 64 + fr, fq * 8), boff = lds_byte(wc * 32 + fr, fq * 8);
    constexpr int KOFF1 = 1024;
    unsigned gA[2][2] = {{0u, 0u}, {0u, 0u}}, gAn[2][2] = {{0u, 0u}, {0u, 0u}};
#define PG8_GOFFS(dst, unit) do { int t_ = tid; asm volatile("" : "+v"(t_)); _Pragma("unroll") for (int i_ = 0; i_ < 2; ++i_) { int gR_, gC_; stage_rc(t_ * 16 + i_ * 8192, gR_, gC_); \
        _Pragma("unroll") for (int h_ = 0; h_ < 2; ++h_) dst[h_][i_] = S.a_goff(unit, gR_ + 128 * h_, gC_); } } while (0)
#define PG8_SA(b, h) (((b) * 2 + (h)) * HTB)
#define PG8_SB(b, h) ((4 + (b) * 2 + (h)) * HTB)
#define PG8_STAGE(bufoff, gbase, voff) do { _Pragma("unroll") for (int _i = 0; _i < 2; ++_i) \
        __builtin_amdgcn_global_load_lds((const unsigned*)((const char*)(gbase) + (voff)[_i]), (PG8_LAS unsigned*)(lds + (bufoff) + ldsw + _i * 8192), 16, 0, 0); } while (0)
#define PG8_STAGEA(bufoff, ptr, h, nx) do { if constexpr (Sched::GATHER) { const unsigned gs_[2] = {(nx) ? gAn[h][0] : gA[h][0], (nx) ? gAn[h][1] : gA[h][1]}; PG8_STAGE(bufoff, ptr, gs_); } \
        else { PG8_STAGE(bufoff, (ptr) + (h) * hstepA, voffA); } } while (0)
#define PG8_LDA(dst, b, h) do { if constexpr (FP8) { _Pragma("unroll") for (int m = 0; m < 4; ++m) dst##8[m] = cat8(*(const PG8_LAS bf16x8*)(lds + PG8_SA(b, h) + aoff + m * 2048), *(const PG8_LAS bf16x8*)(lds + PG8_SA(b, h) + aoff + KOFF1 + m * 2048)); } \
        else { _Pragma("unroll") for (int m = 0; m < 4; ++m) _Pragma("unroll") for (int k = 0; k < 2; ++k) dst[m][k] = *(const PG8_LAS bf16x8*)(lds + PG8_SA(b, h) + aoff + k * KOFF1 + m * 2048); } } while (0)
#define PG8_LDB(dst, b, h) do { if constexpr (FP8) { _Pragma("unroll") for (int n = 0; n < 2; ++n) dst##8[n] = cat8(*(const PG8_LAS bf16x8*)(lds + PG8_SB(b, h) + boff + n * 2048), *(const PG8_LAS bf16x8*)(lds + PG8_SB(b, h) + boff + KOFF1 + n * 2048)); } \
        else { _Pragma("unroll") for (int n = 0; n < 2; ++n) _Pragma("unroll") for (int k = 0; k < 2; ++k) dst[n][k] = *(const PG8_LAS bf16x8*)(lds + PG8_SB(b, h) + boff + k * KOFF1 + n * 2048); } } while (0)
#define PG8_MMA(ai, bj, At, Bt) do { __builtin_amdgcn_s_setprio(1); if constexpr (FP8) { _Pragma("unroll") for (int m = 0; m < 4; ++m) _Pragma("unroll") for (int n = 0; n < 2; ++n) \
        asm volatile("v_mfma_scale_f32_16x16x128_f8f6f4 %0, %1, %2, %0, %3, %4 op_sel_hi:[0,0,0]" : "+v"(acc[ai][bj][m][n]) : "v"(Bt##8[n]), "v"(At##8[m]), "v"(sclB), "v"(sclA)); } \
        else { _Pragma("unroll") for (int m = 0; m < 4; ++m) _Pragma("unroll") for (int n = 0; n < 2; ++n) _Pragma("unroll") for (int k = 0; k < 2; ++k) \
        acc[ai][bj][m][n] = __builtin_amdgcn_mfma_f32_16x16x32_bf16(Bt[n][k], At[m][k], acc[ai][bj][m][n], 0, 0, 0); } __builtin_amdgcn_s_setprio(0); } while (0)
#define PG8_WAIT_V(n) asm volatile("s_waitcnt vmcnt(" #n ")" ::: "memory")
#define PG8_WAIT_L(n) asm volatile("s_waitcnt lgkmcnt(" #n ")" ::: "memory")
#define PG8_BAR __builtin_amdgcn_s_barrier()
#define PG8_SCHED __builtin_amdgcn_sched_barrier(0)
    Unit cur, nxt; int ui = 0;
    if (!S.next(0, cur)) return;
    f32x4 acc[2][2][4][2];
#pragma unroll
    for (int a = 0; a < 2; ++a)
#pragma unroll
        for (int b = 0; b < 2; ++b)
#pragma unroll
            for (int m = 0; m < 4; ++m)
#pragma unroll
                for (int n = 0; n < 2; ++n) acc[a][b][m][n] = (f32x4){0.f, 0.f, 0.f, 0.f};
    bf16x8 At[4][2], B0[2][2], B1[2][2];
    i32x8 At8[4], B08[2], B18[2];
    int sclA = 0x7f7f7f7f, sclB = 0x79797979;
    const char* cA = S.a_ptr(cur); const char* cB = S.b_ptr(cur);
    if constexpr (Sched::GATHER) { PG8_GOFFS(gA, cur); }
    PG8_STAGE(PG8_SB(0, 0), cB, voffB); PG8_STAGEA(PG8_SA(0, 0), cA, 0, false); PG8_STAGE(PG8_SB(0, 1), cB + hstepB, voffB); PG8_STAGEA(PG8_SA(0, 1), cA, 1, false);
    if (wr == 1) PG8_BAR;
    PG8_WAIT_V(4); PG8_BAR;
    PG8_STAGE(PG8_SB(1, 0), cB + kstep, voffB); PG8_STAGEA(PG8_SA(1, 0), cA + kstep, 0, false); PG8_STAGE(PG8_SB(1, 1), cB + hstepB + kstep, voffB);
    PG8_WAIT_V(6); PG8_BAR;
    for (;;) {
        const bool has_next = S.next(ui + 1, nxt);
        const char* nA = has_next ? S.a_ptr(nxt) : cA; const char* nB = has_next ? S.b_ptr(nxt) : cB;
        if constexpr (Sched::GATHER) { if (has_next) { PG8_GOFFS(gAn, nxt); } else {
_Pragma("unroll") for (int h = 0; h < 2; ++h) _Pragma("unroll") for (int i = 0; i < 2; ++i) gAn[h][i] = gA[h][i]; } }
_Pragma("unroll 1")
        for (int t = 0; t < nt; t += 2) {
            const bool last = (t == nt - 2);
            const char* a1 = cA + (size_t)(t + 1) * kstep;
            const char* a2 = last ? nA : cA + (size_t)(t + 2) * kstep; const char* b2 = last ? nB : cB + (size_t)(t + 2) * kstep;
            const char* a3 = a2 + kstep; const char* b3 = b2 + kstep;
            PG8_LDB(B0, 0, 0); PG8_SCHED; PG8_LDA(At, 0, 0); PG8_STAGEA(PG8_SA(1, 1), a1, 1, false);
            PG8_WAIT_L(8); PG8_BAR; PG8_WAIT_L(0); PG8_MMA(0, 0, At, B0); PG8_BAR; PG8_SCHED;
            PG8_LDB(B1, 0, 1); PG8_STAGE(PG8_SB(0, 0), b2, voffB);
            PG8_BAR; PG8_WAIT_L(0); PG8_MMA(0, 1, At, B1); PG8_BAR;
            PG8_LDA(At, 0, 1); PG8_STAGEA(PG8_SA(0, 0), a2, 0, last);
            PG8_BAR; PG8_WAIT_L(0); PG8_MMA(1, 0, At, B0); PG8_BAR; PG8_SCHED;
            PG8_STAGE(PG8_SB(0, 1), b2 + hstepB, voffB);
            PG8_WAIT_V(6); PG8_BAR; PG8_MMA(1, 1, At, B1); PG8_BAR;
            PG8_LDB(B0, 1, 0); PG8_SCHED; PG8_LDA(At, 1, 0); PG8_STAGEA(PG8_SA(0, 1), a2, 1, last);
            PG8_WAIT_L(8); PG8_BAR; PG8_WAIT_L(0); PG8_MMA(0, 0, At, B0); PG8_BAR; PG8_SCHED;
            PG8_LDB(B1, 1, 1); PG8_STAGE(PG8_SB(1, 0), b3, voffB);
            PG8_BAR; PG8_WAIT_L(0); PG8_MMA(0, 1, At, B1); PG8_BAR;
            PG8_LDA(At, 1, 1); PG8_STAGEA(PG8_SA(1, 0), a3, 0, last);
            PG8_BAR; PG8_WAIT_L(0); PG8_MMA(1, 0, At, B0); PG8_BAR; PG8_SCHED;
            PG8_STAGE(PG8_SB(1, 1), b3 + hstepB, voffB);
            PG8_WAIT_V(6); PG8_BAR; PG8_MMA(1, 1, At, B1); PG8_BAR;
        }
        { if constexpr (FP8) asm volatile("s_nop 15\n\ts_nop 3" ::: "memory");
          int t_ = tid; asm volatile("" : "+v"(t_));
          E(acc, cur, wr, wc, t_ & 15, (t_ & 63) >> 4); }
        if (!has_next) break;
#pragma unroll
        for (int a = 0; a < 2; ++a)
#pragma unroll
            for (int b = 0; b < 2; ++b)
#pragma unroll
                for (int m = 0; m < 4; ++m)
#pragma unroll
                    for (int n = 0; n < 2; ++n) acc[a][b][m][n] = (f32x4){0.f, 0.f, 0.f, 0.f};
        cur = nxt; cA = nA; cB = nB; ++ui;
        if constexpr (Sched::GATHER) {
_Pragma("unroll") for (int h = 0; h < 2; ++h) _Pragma("unroll") for (int i = 0; i < 2; ++i) gA[h][i] = gAn[h][i]; }
    }
    PG8_WAIT_V(0);
    if (wr == 0) PG8_BAR;
    PG8_BAR;
#undef PG8_SA
#undef PG8_SB
#undef PG8_STAGE
#undef PG8_STAGEA
#undef PG8_GOFFS
#undef PG8_LDA
#undef PG8_LDB
#undef PG8_MMA
#undef PG8_WAIT_V
#undef PG8_WAIT_L
#undef PG8_BAR
#undef PG8_SCHED
}
}
using pg8::f32x4; using pg8::u32x4; using pg8::Unit;

#define GEMM_LDS (pg8::STAGE_BYTES + 1024)

struct SchedProj : pg8::TileOrder {
  static constexpr bool GATHER = false;
  const char* A; const char* B;
  __device__ bool next(int i, Unit& u) const { u.z = 0; return tile(i, u.pm, u.pn); }
  __device__ const char* a_ptr(const Unit& u) const { return A + (size_t)u.pm * 256 * DM * 2; }
  __device__ const char* b_ptr(const Unit& u) const { return B + (size_t)u.pn * 256 * DM * 2; }
};
struct EpiProj {
  static constexpr bool PERM = true;
  bf16_t* O;
  __device__ __forceinline__ void operator()(const f32x4 (&acc)[2][2][4][2], const Unit& u, int wr, int wc, int fr, int fq) const {
    const int row0 = u.pm * 256 + wr * 64 + fr, col0 = u.pn * 256 + wc * 32 + 8 * fq;
    const bool gate = u.pn >= (C_GA / 256);
#pragma unroll
    for (int ai = 0; ai < 2; ++ai)
#pragma unroll
      for (int m = 0; m < 4; ++m) {
        bf16_t* rowp = O + (size_t)(row0 + ai * 128 + m * 16) * PW + col0;
#pragma unroll
        for (int bj = 0; bj < 2; ++bj) {
          f32x4 v0 = acc[ai][bj][m][0], v1 = acc[ai][bj][m][1];
          if (gate) {
#pragma unroll
            for (int j = 0; j < 4; ++j) { v0[j] = sigmoidf_(v0[j]); v1[j] = sigmoidf_(v1[j]); }
          }
          u32x4 w; w.x = pg8::cvt_pk_bf16(v0[0], v0[1]); w.y = pg8::cvt_pk_bf16(v0[2], v0[3]); w.z = pg8::cvt_pk_bf16(v1[0], v1[1]); w.w = pg8::cvt_pk_bf16(v1[2], v1[3]);
          *(u32x4*)(rowp + bj * 128) = w;
        }
      }
  }
};
__device__ void ph_proj(const Params& p, PG8_LAS unsigned char* lds, int nblk, int bid) {
  SchedProj S; S.init(T_TOK / 256, PW / 256, nblk, bid); S.A = (const char*)p.hbf; S.B = (const char*)p.w_in_t;
  EpiProj E{p.proj};
  pg8::gemm_phase(lds, p.tid, DM, DM, DM, S, E);
}

struct SchedBr : pg8::TileOrder {
  static constexpr bool GATHER = false;
  const char* A; const char* Ba; const char* Bb;
  __device__ bool next(int i, Unit& u) const { u.z = i & 1; return tile(i >> 1, u.pm, u.pn); }
  __device__ const char* a_ptr(const Unit& u) const { return A + (size_t)u.pm * 256 * DM * 2 + u.z * 512 * 2; }
  __device__ const char* b_ptr(const Unit& u) const { return (u.z ? Bb : Ba) + (size_t)u.pn * 256 * 512 * 2; }
};
__device__ __forceinline__ void unpack8(const u32x4 w, float (&f)[8]) {
  f[0] = __uint_as_float(w.x << 16); f[1] = __uint_as_float(w.x & 0xffff0000u); f[2] = __uint_as_float(w.y << 16); f[3] = __uint_as_float(w.y & 0xffff0000u);
  f[4] = __uint_as_float(w.z << 16); f[5] = __uint_as_float(w.z & 0xffff0000u); f[6] = __uint_as_float(w.w << 16); f[7] = __uint_as_float(w.w & 0xffff0000u);
}
struct EpiBr {
  static constexpr bool PERM = true;
  const bf16_t* proj; bf16_t* O;
  __device__ __forceinline__ void operator()(const f32x4 (&acc)[2][2][4][2], const Unit& u, int wr, int wc, int fr, int fq) const {
    const int row0 = u.pm * 256 + wr * 64 + fr, col0 = u.pn * 256 + wc * 32 + 8 * fq;
    const int gcol = (u.z ? C_GB : C_GA) + col0;
#pragma unroll
    for (int ai = 0; ai < 2; ++ai) {
      u32x4 gv[4][2], pv[4][2];
#pragma unroll
      for (int m = 0; m < 4; ++m)
#pragma unroll
        for (int bj = 0; bj < 2; ++bj) {
          const size_t row = (size_t)(row0 + ai * 128 + m * 16);
          gv[m][bj] = *(const u32x4*)(proj + row * PW + gcol + bj * 128);
          pv[m][bj] = (u32x4){0u, 0u, 0u, 0u};
          if (u.z) pv[m][bj] = *(const u32x4*)(O + row * DM + col0 + bj * 128);
        }
#pragma unroll
      for (int m = 0; m < 4; ++m)
#pragma unroll
        for (int bj = 0; bj < 2; ++bj) {
          const size_t row = (size_t)(row0 + ai * 128 + m * 16);
          float g[8], pf[8]; unpack8(gv[m][bj], g); unpack8(pv[m][bj], pf);
          const f32x4 v0 = acc[ai][bj][m][0], v1 = acc[ai][bj][m][1];
          float r[8];
#pragma unroll
          for (int j = 0; j < 4; ++j) { r[j] = v0[j] * g[j] + pf[j]; r[4 + j] = v1[j] * g[4 + j] + pf[4 + j]; }
          u32x4 w; w.x = pk2(r[0], r[1]); w.y = pk2(r[2], r[3]); w.z = pk2(r[4], r[5]); w.w = pk2(r[6], r[7]);
          *(u32x4*)(O + row * DM + col0 + bj * 128) = w;
        }
    }
  }
};
__device__ void ph_br(const Params& p, PG8_LAS unsigned char* lds, int nblk, int bid) {
  SchedBr S; S.init(T_TOK / 256, DM / 256, nblk, bid); S.A = (const char*)p.oab; S.Ba = (const char*)p.wbra_t; S.Bb = (const char*)p.wbrb_t;
  EpiBr E{p.proj, p.merged};
  pg8::gemm_phase(lds, p.tid, DM, 512, 512, S, E);
}

struct SchedMix : pg8::TileOrder {
  static constexpr bool GATHER = false;
  const char* A; const char* B;
  __device__ bool next(int i, Unit& u) const { u.z = 0; return tile(i, u.pm, u.pn); }
  __device__ const char* a_ptr(const Unit& u) const { return A + (size_t)u.pm * 256 * DM * 2; }
  __device__ const char* b_ptr(const Unit& u) const { return B + (size_t)u.pn * 256 * DM * 2; }
};
struct EpiMix {
  static constexpr bool PERM = true;
  bf16_t* O;
  __device__ __forceinline__ void operator()(const f32x4 (&acc)[2][2][4][2], const Unit& u, int wr, int wc, int fr, int fq) const {
    const int row0 = u.pm * 256 + wr * 64 + fr, col0 = u.pn * 256 + wc * 32 + 8 * fq;
#pragma unroll
    for (int ai = 0; ai < 2; ++ai)
#pragma unroll
      for (int m = 0; m < 4; ++m) {
        bf16_t* rowp = O + (size_t)(row0 + ai * 128 + m * 16) * DM + col0;
#pragma unroll
        for (int bj = 0; bj < 2; ++bj) {
          const f32x4 v0 = acc[ai][bj][m][0], v1 = acc[ai][bj][m][1];
          u32x4 w; w.x = pg8::cvt_pk_bf16(v0[0], v0[1]); w.y = pg8::cvt_pk_bf16(v0[2], v0[3]); w.z = pg8::cvt_pk_bf16(v1[0], v1[1]); w.w = pg8::cvt_pk_bf16(v1[2], v1[3]);
          *(u32x4*)(rowp + bj * 128) = w;
        }
      }
  }
};
__device__ void ph_mix(const Params& p, PG8_LAS unsigned char* lds, int nblk, int bid) {
  SchedMix S; S.init(T_TOK / 256, DM / 256, nblk, bid); S.A = (const char*)p.merged; S.B = (const char*)p.wo_t;
  EpiMix E{p.mixer};
  pg8::gemm_phase(lds, p.tid, DM, DM, DM, S, E);
}

template <bool GATH>
struct SchedMoe {
  static constexpr bool GATHER = GATH;
  const PG8_LAS int* tb; int NT; int G, c; int nwg;
  const char* A; const char* B; size_t bexp;
  const int* elist; int rowb;
  __device__ bool next(int i, Unit& u) const {
    const long L = (long)i * G + c; if (L >= nwg) return false;
    int wgid = (int)L; { const int q = nwg / 8, r = nwg % 8, xcd = wgid % 8, off = wgid / 8; wgid = (xcd < r ? xcd * (q + 1) : r * (q + 1) + (xcd - r) * q) + off; }
    int e = 0;
#pragma unroll
    for (int st = 16; st >= 1; st >>= 1) if (wgid >= tb[e + st]) e += st;
    const int q = wgid - tb[e]; const int tiles = tb[33 + e + 1] - tb[33 + e];
    u.pm = tb[33 + e] + q % tiles; u.pn = q / tiles; u.z = e; return true;
  }
  __device__ const char* a_ptr(const Unit& u) const { return GATH ? A : A + (size_t)u.pm * 256 * rowb; }
  __device__ const char* b_ptr(const Unit& u) const { return B + (size_t)u.z * bexp + (size_t)u.pn * 256 * rowb; }
  __device__ unsigned a_goff(const Unit& u, int tr, int C) const {
    const int i = (u.pm - tb[33 + u.z]) * 256 + tr;
    int tok = 0;
    if (i < tb[66 + u.z]) tok = elist[u.z * T_TOK + i] >> 2;
    return (unsigned)(tok * rowb + C * 2);
  }
};
__device__ __forceinline__ void moe_table(const Params& p, PG8_LAS int* tb, int NT) {
  if (p.tid == 0) {
    int ub = 0, tbp = 0;
    for (int e = 0; e < NE; ++e) { const int c = p.cnt[e * 64]; tb[e] = ub; tb[33 + e] = tbp; tb[66 + e] = c; const int t = (c + 255) >> 8; ub += t * NT; tbp += t; }
    tb[NE] = ub; tb[33 + NE] = tbp;
  }
  __syncthreads();
}
struct EpiMoe1 {
  static constexpr bool PERM = true;
  const float* b_gu; unsigned char* act;
  __device__ __forceinline__ void operator()(f32x4 (&acc)[2][2][4][2], const Unit& u, int wr, int wc, int fr, int fq) const {
    const int row0 = u.pm * 256 + wr * 64 + fr, jc = u.pn * 128 + wc * 32 + 8 * fq;
    const float* bg = b_gu + (size_t)u.z * 2048 + jc;
#pragma unroll
    for (int bj = 0; bj < 2; ++bj)
#pragma unroll
      for (int n = 0; n < 2; ++n) {
        const f32x4 bv = *(const f32x4*)(bg + bj * 1024 + n * 4);
#pragma unroll
        for (int ai = 0; ai < 2; ++ai)
#pragma unroll
          for (int m = 0; m < 4; ++m) acc[ai][bj][m][n] += bv;
      }
#pragma unroll
    for (int ai = 0; ai < 2; ++ai)
#pragma unroll
      for (int m = 0; m < 4; ++m) {
        unsigned char* rowp = act + (size_t)(row0 + ai * 128 + m * 16) * DM + jc;
        float r[8];
#pragma unroll
        for (int n = 0; n < 2; ++n)
#pragma unroll
          for (int j = 0; j < 4; ++j) {
            float g = acc[ai][0][m][n][j], up = acc[ai][1][m][n][j];
            g = fminf(g, 7.f); up = fminf(fmaxf(up, -7.f), 7.f);
            r[n * 4 + j] = (up + 1.f) * g * sigmoidf_(1.702f * g);
          }
        u32x2 w; w.x = pk4_fp8(r[0], r[1], r[2], r[3]); w.y = pk4_fp8(r[4], r[5], r[6], r[7]);
        *(u32x2*)rowp = w;
      }
  }
};
__device__ void ph_moe1(const Params& p, PG8_LAS unsigned char* lds, int nblk, int bid) {
  PG8_LAS int* tb = (PG8_LAS int*)(lds + pg8::STAGE_BYTES);
  moe_table(p, tb, 8);
  SchedMoe<true> S; S.tb = tb; S.NT = 8; S.G = nblk; S.c = bid; S.nwg = tb[NE]; S.A = (const char*)p.h2q; S.B = (const char*)p.wgu8; S.bexp = (size_t)2048 * DM; S.elist = p.elist; S.rowb = DM;
  EpiMoe1 E{p.b_gu, p.act8};
  pg8::gemm_phase<EpiMoe1, SchedMoe<true>, true>(lds, p.tid, DM / 2, DM / 2, DM / 2, S, E);
}
struct EpiMoe2 {
  static constexpr bool PERM = true;
  const float* b_down; const int* elist; const PG8_LAS int* tb; bf16_t* yslot;
  __device__ __forceinline__ void operator()(f32x4 (&acc)[2][2][4][2], const Unit& u, int wr, int wc, int fr, int fq) const {
    const int row0 = u.pm * 256 + wr * 64 + fr, col0 = u.pn * 256 + wc * 32 + 8 * fq;
    const float* bd = b_down + (size_t)u.z * 1024 + col0;
#pragma unroll
    for (int bj = 0; bj < 2; ++bj)
#pragma unroll
      for (int n = 0; n < 2; ++n) {
        const f32x4 bv = *(const f32x4*)(bd + bj * 128 + n * 4);
#pragma unroll
        for (int ai = 0; ai < 2; ++ai)
#pragma unroll
          for (int m = 0; m < 4; ++m) acc[ai][bj][m][n] += bv;
      }
    const int li0 = (u.pm - tb[33 + u.z]) * 256 + wr * 64 + fr, cnt = tb[66 + u.z];
    int av[2][4];
#pragma unroll
    for (int ai = 0; ai < 2; ++ai)
#pragma unroll
      for (int m = 0; m < 4; ++m) { const int li = li0 + ai * 128 + m * 16; av[ai][m] = elist[u.z * T_TOK + (li < cnt ? li : 0)]; if (li >= cnt) av[ai][m] = -1; }
#pragma unroll
    for (int ai = 0; ai < 2; ++ai)
#pragma unroll
      for (int m = 0; m < 4; ++m) {
        const int a = av[ai][m];
        if (a >= 0) {
          bf16_t* rowp = yslot + (size_t)a * DM + col0;
#pragma unroll
          for (int bj = 0; bj < 2; ++bj) {
            const f32x4 v0 = acc[ai][bj][m][0], v1 = acc[ai][bj][m][1];
            u32x4 w; w.x = pk2(v0[0], v0[1]); w.y = pk2(v0[2], v0[3]); w.z = pk2(v1[0], v1[1]); w.w = pk2(v1[2], v1[3]);
            *(u32x4*)(rowp + bj * 128) = w;
          }
        }
      }
  }
};
__device__ void ph_moe2(const Params& p, PG8_LAS unsigned char* lds, int nblk, int bid) {
  PG8_LAS int* tb = (PG8_LAS int*)(lds + pg8::STAGE_BYTES);
  moe_table(p, tb, 4);
  SchedMoe<false> S; S.tb = tb; S.NT = 4; S.G = nblk; S.c = bid; S.nwg = tb[NE]; S.A = (const char*)p.act8; S.B = (const char*)p.wd8; S.bexp = (size_t)1024 * DM; S.elist = p.elist; S.rowb = DM;
  EpiMoe2 E{p.b_down, p.elist, tb, p.yslot};
  pg8::gemm_phase<EpiMoe2, SchedMoe<false>, true>(lds, p.tid, DM / 2, DM / 2, DM / 2, S, E);
}

typedef short bf16x8 __attribute__((ext_vector_type(8)));
#define LAS __attribute__((address_space(3)))
#define MFMA16(a, b, c) __builtin_amdgcn_mfma_f32_16x16x32_bf16((a), (b), (c), 0, 0, 0)
__device__ __forceinline__ bf16x8 pack8(float a0, float a1, float a2, float a3, float a4, float a5, float a6, float a7) {
  u32x4 w; w.x = pk2(a0, a1); w.y = pk2(a2, a3); w.z = pk2(a4, a5); w.w = pk2(a6, a7);
  return __builtin_bit_cast(bf16x8, w);
}
__device__ __forceinline__ bf16_t f2bf_hw(float a) { return (bf16_t)(pk2(a, 0.f) & 0xffffu); }

#define DN_ABYTES 57344
#define DN_UFLOATS 8192
#define F_WN 0
#define F_QD 16
#define F_QK 32
#define F_KT 40

#define DP_KH 0
#define DP_QT 17408
#define DP_KHT 34816
#define DP_VT 53248
#define DP_TU 71680
#define DP_TW 80896
#define DP_LF 90112
#define DP_GC 107520
#define DP_BETA 107776
#define DP_CW 108032
#define DP_LB 114176
#define DP_TR 123392
#define DP_TT 132608
#define DP_MT 141824
#define DP_TOTAL 144128

template <int KS>
__device__ __forceinline__ f32x4 prod16(const LAS bf16_t* A, int lda, int arow0, const LAS bf16_t* Bt, int ldb, int brow0, f32x4 acc, int lane) {
  const int r = lane & 15, q = lane >> 4;
#pragma unroll
  for (int ks = 0; ks < KS; ++ks) {
    const bf16x8 a = *(const LAS bf16x8*)(A + (arow0 + r) * lda + 32 * ks + 8 * q);
    const bf16x8 b = *(const LAS bf16x8*)(Bt + (brow0 + r) * ldb + 32 * ks + 8 * q);
    acc = MFMA16(a, b, acc);
  }
  return acc;
}
__device__ __forceinline__ void tile_store_rm(LAS bf16_t* X, int ld, int row0, int col0, const f32x4 v, int lane) {
  const int r = lane & 15, q = lane >> 4;
#pragma unroll
  for (int i = 0; i < 4; ++i) X[(row0 + 4 * q + i) * ld + col0 + r] = f2bf_hw(v[i]);
}
__device__ __forceinline__ void tile_store_tr(LAS bf16_t* Xt, int ld, int row0, int col0, const f32x4 v, int lane) {
  const int r = lane & 15, q = lane >> 4;
  u32x2 w; w.x = pk2(v[0], v[1]); w.y = pk2(v[2], v[3]);
  *(LAS u32x2*)(Xt + (col0 + r) * ld + row0 + 4 * q) = w;
}

__device__ void dn_prep_chunk(const Params& p, LAS unsigned char* lds, int ci, bool load_cw) {
  const int tid = p.tid, lane = tid & 63, w = tid >> 6, r16 = lane & 15, q4 = lane >> 4;
  const int bh = ci >> 6, n = ci & 63, b = bh >> 2, h = bh & 3;
  LAS bf16_t* Kh = (LAS bf16_t*)(lds + DP_KH); LAS bf16_t* Qt = (LAS bf16_t*)(lds + DP_QT);
  LAS bf16_t* KhT = (LAS bf16_t*)(lds + DP_KHT); LAS bf16_t* VT = (LAS bf16_t*)(lds + DP_VT);
  LAS bf16_t* Tu = (LAS bf16_t*)(lds + DP_TU); LAS bf16_t* Tw = (LAS bf16_t*)(lds + DP_TW); LAS float* Lf = (LAS float*)(lds + DP_LF);
  LAS bf16_t* Lb = (LAS bf16_t*)(lds + DP_LB); LAS bf16_t* Tr = (LAS bf16_t*)(lds + DP_TR); LAS bf16_t* Tt = (LAS bf16_t*)(lds + DP_TT); LAS bf16_t* Mt = (LAS bf16_t*)(lds + DP_MT);
  LAS float* gcb = (LAS float*)(lds + DP_GC); LAS float* betab = (LAS float*)(lds + DP_BETA); LAS float* cw = (LAS float*)(lds + DP_CW);
  unsigned char* gA = (unsigned char*)p.dnA + (size_t)ci * DN_ABYTES;
  float* gU = p.dnU + (size_t)ci * DN_UFLOATS;

  if (load_cw) {
    for (int i = tid; i < 4 * 384; i += 512) { const int tap = i / 384, cc = i % 384, part = cc >> 7, d = cc & 127; cw[i] = p.conv_w[tap * 1536 + part * 512 + h * 128 + d]; }
  }
  __syncthreads();
  const int c = tid >> 3, g = tid & 7;
  const int s = n * 64 + c;
  const size_t t = (size_t)b * SEQ + s;
  float qv[16], kv[16], vv[16];
#pragma unroll
  for (int j = 0; j < 16; ++j) { qv[j] = 0.f; kv[j] = 0.f; vv[j] = 0.f; }
#pragma unroll
  for (int tap = 0; tap < 4; ++tap) {
    const int ss = s - 3 + tap;
    if (ss >= 0) {
      const bf16_t* row = p.proj + (t - 3 + tap) * PW + h * 128 + 16 * g;
      float x[8];
#pragma unroll
      for (int part = 0; part < 3; ++part) {
#pragma unroll
        for (int hh = 0; hh < 2; ++hh) {
          unpack8(*(const u32x4*)(row + part * 512 + 8 * hh), x);
#pragma unroll
          for (int j = 0; j < 8; ++j) {
            const float wv = cw[tap * 384 + part * 128 + 16 * g + 8 * hh + j];
            if (part == 0) qv[8 * hh + j] += wv * x[j];
            if (part == 1) kv[8 * hh + j] += wv * x[j];
            if (part == 2) vv[8 * hh + j] += wv * x[j];
          }
        }
      }
    }
    asm volatile("" ::: "memory");
  }
  float sq = 0.f, sk = 0.f;
#pragma unroll
  for (int j = 0; j < 16; ++j) { qv[j] = siluf_(qv[j]); kv[j] = siluf_(kv[j]); vv[j] = siluf_(vv[j]); sq += qv[j] * qv[j]; sk += kv[j] * kv[j]; }
  sq += __shfl_xor(sq, 1, 64); sq += __shfl_xor(sq, 2, 64); sq += __shfl_xor(sq, 4, 64);
  sk += __shfl_xor(sk, 1, 64); sk += __shfl_xor(sk, 2, 64); sk += __shfl_xor(sk, 4, 64);
  const float rq = rsqrtf(sq + 1e-6f) * 0.08838834764831845f, rk = rsqrtf(sk + 1e-6f);
#pragma unroll
  for (int j = 0; j < 16; ++j) { qv[j] *= rq; kv[j] *= rk; }
  if (g == 0) {
    const float bb = p.ba[t * 8 + h], aa = p.ba[t * 8 + 4 + h];
    const float xx = aa + p.dt_bias[h];
    const float sp = xx > 20.f ? xx : log1pf(__expf(xx));
    betab[c] = sigmoidf_(bb);
    gcb[c] = -__expf(p.a_log[h]) * sp;
  }
  {
    u32x4 w0, w1;
    w0.x = pk2(kv[0], kv[1]); w0.y = pk2(kv[2], kv[3]); w0.z = pk2(kv[4], kv[5]); w0.w = pk2(kv[6], kv[7]);
    w1.x = pk2(kv[8], kv[9]); w1.y = pk2(kv[10], kv[11]); w1.z = pk2(kv[12], kv[13]); w1.w = pk2(kv[14], kv[15]);
    *(LAS u32x4*)(Kh + c * 136 + 16 * g) = w0; *(LAS u32x4*)(Kh + c * 136 + 16 * g + 8) = w1;
    w0.x = pk2(qv[0], qv[1]); w0.y = pk2(qv[2], qv[3]); w0.z = pk2(qv[4], qv[5]); w0.w = pk2(qv[6], qv[7]);
    w1.x = pk2(qv[8], qv[9]); w1.y = pk2(qv[10], qv[11]); w1.z = pk2(qv[12], qv[13]); w1.w = pk2(qv[14], qv[15]);
    *(LAS u32x4*)(Qt + c * 136 + 16 * g) = w0; *(LAS u32x4*)(Qt + c * 136 + 16 * g + 8) = w1;
#pragma unroll
    for (int j = 0; j < 16; ++j) { KhT[(16 * g + j) * 72 + c] = f2bf_hw(kv[j]); VT[(16 * g + j) * 72 + c] = f2bf_hw(vv[j]); }
  }
  __syncthreads();
  if (w == 0) {
    float v = gcb[lane];
#pragma unroll
    for (int o = 1; o < 64; o <<= 1) { const float u = __shfl_up(v, o, 64); if (lane >= o) v += u; }
    gcb[lane] = v;
  }
  __syncthreads();
  const float gc_c = gcb[c], gl = gcb[63];
  {
    const float eg = __expf(gc_c);
    unsigned char* fb = gA + (size_t)(F_QD + (c >> 4) * 4 + (g >> 1)) * 1024 + (g & 1) * 8;
#pragma unroll
    for (int qq = 0; qq < 4; ++qq) {
      u32x2 wv; wv.x = pk2(qv[4 * qq] * eg, qv[4 * qq + 1] * eg); wv.y = pk2(qv[4 * qq + 2] * eg, qv[4 * qq + 3] * eg);
      *(u32x2*)(fb + ((c & 15) + 16 * qq) * 16) = wv;
    }
  }
  const int rt = w >> 1, ct0 = 2 * (w & 1);
#pragma unroll
  for (int tt = 0; tt < 2; ++tt) {
    const int ct = ct0 + tt;
    f32x4 gacc = {0.f, 0.f, 0.f, 0.f};
    gacc = prod16<4>(Kh, 136, 16 * rt, Kh, 136, 16 * ct, gacc, lane);
    const int m = 16 * ct + r16; const float gc_m = gcb[m];
    f32x4 lv;
#pragma unroll
    for (int i = 0; i < 4; ++i) {
      const int cc = 16 * rt + 4 * q4 + i;
      lv[i] = (m < cc) ? betab[cc] * gacc[i] * __expf(gcb[cc] - gc_m) : 0.f;
      Lf[cc * 68 + m] = lv[i];
    }
    tile_store_rm(Lb, 72, 16 * rt, 16 * ct, lv, lane);
    f32x4 qacc = {0.f, 0.f, 0.f, 0.f};
    qacc = prod16<4>(Kh, 136, 16 * rt, Qt, 136, 16 * ct, qacc, lane);
    const int cq = 16 * ct + r16; const float gc_cq = gcb[cq];
    float o4[4];
#pragma unroll
    for (int i = 0; i < 4; ++i) { const int mm = 16 * rt + 4 * q4 + i; o4[i] = (mm <= cq) ? qacc[i] * __expf(gc_cq - gcb[mm]) : 0.f; }
    u32x2 wv; wv.x = pk2(o4[0], o4[1]); wv.y = pk2(o4[2], o4[3]);
    *(u32x2*)(gA + (size_t)(F_QK + ct * 2 + (rt >> 1)) * 1024 + (r16 + 16 * q4) * 16 + (rt & 1) * 8) = wv;
  }
  __syncthreads();
  for (int i = tid; i < 2 * 64 * 72 / 8; i += 512) ((LAS u32x4*)Tr)[i] = (u32x4){0u, 0u, 0u, 0u};
  __syncthreads();
  if (w == 0) {
    int lo = lane; asm volatile("" : "+v"(lo));
    const int g = lo >> 4, j = lo & 15;
    unsigned lfb = DP_LF + (16 * g * 68 + 16 * g) * 4; asm volatile("" : "+v"(lfb));
    const LAS float* Lg = (const LAS float*)(lds + lfb);
    float t[16];
#pragma unroll
    for (int r = 0; r < 16; ++r) {
      float a0 = (r == j) ? 1.f : 0.f, a1 = 0.f;
#pragma unroll
      for (int k4 = 0; k4 < (r + 3) / 4; ++k4) {
        const f32x4 l = *(const LAS f32x4*)(Lg + r * 68 + 4 * k4);
        if (4 * k4 + 0 < r) a0 -= l[0] * t[4 * k4 + 0];
        if (4 * k4 + 1 < r) a1 -= l[1] * t[4 * k4 + 1];
        if (4 * k4 + 2 < r) a0 -= l[2] * t[4 * k4 + 2];
        if (4 * k4 + 3 < r) a1 -= l[3] * t[4 * k4 + 3];
      }
      t[r] = a0 + a1;
      Tr[(16 * g + r) * 72 + 16 * g + j] = f2bf_hw(t[r]);
    }
    u32x4 w0, w1;
    w0.x = pk2(t[0], t[1]); w0.y = pk2(t[2], t[3]); w0.z = pk2(t[4], t[5]); w0.w = pk2(t[6], t[7]);
    w1.x = pk2(t[8], t[9]); w1.y = pk2(t[10], t[11]); w1.z = pk2(t[12], t[13]); w1.w = pk2(t[14], t[15]);
    *(LAS u32x4*)(Tt + (16 * g + j) * 72 + 16 * g) = w0; *(LAS u32x4*)(Tt + (16 * g + j) * 72 + 16 * g + 8) = w1;
  }
  __syncthreads();
#pragma unroll 1
  for (int d = 1; d <= 3; ++d) {
    const bool act = w < 4 - d;
    const int I = w + d, J = w;
    LAS bf16_t* Mw = Mt + w * 16 * 24;
    if (act) {
      f32x4 macc = {0.f, 0.f, 0.f, 0.f};
      macc = prod16<2>(Lb, 72, 16 * I, Tt, 72, 16 * J, macc, lane);
      tile_store_tr(Mw, 24, 0, 0, macc, lane);
    }
    __syncthreads();
    if (act) {
      bf16x8 a = {0, 0, 0, 0, 0, 0, 0, 0}, bb = {0, 0, 0, 0, 0, 0, 0, 0};
      if (q4 < 2) { a = *(const LAS bf16x8*)(Tr + (16 * I + r16) * 72 + 16 * I + 8 * q4); bb = *(const LAS bf16x8*)(Mw + r16 * 24 + 8 * q4); }
      f32x4 tacc = {0.f, 0.f, 0.f, 0.f};
      tacc = MFMA16(a, bb, tacc);
#pragma unroll
      for (int i = 0; i < 4; ++i) tacc[i] = -tacc[i];
      tile_store_rm(Tr, 72, 16 * I, 16 * J, tacc, lane);
      tile_store_tr(Tt, 72, 16 * I, 16 * J, tacc, lane);
    }
    __syncthreads();
  }
  {
    const int cc = tid >> 3, m0 = (tid & 7) * 8;
    float tv[8]; unpack8(*(const LAS u32x4*)(Tr + cc * 72 + m0), tv);
    float tu[8], tw[8];
#pragma unroll
    for (int jj = 0; jj < 8; ++jj) { const float bm = betab[m0 + jj]; tu[jj] = tv[jj] * bm; tw[jj] = tu[jj] * __expf(gcb[m0 + jj]); }
    u32x4 wu, ww;
    wu.x = pk2(tu[0], tu[1]); wu.y = pk2(tu[2], tu[3]); wu.z = pk2(tu[4], tu[5]); wu.w = pk2(tu[6], tu[7]);
    ww.x = pk2(tw[0], tw[1]); ww.y = pk2(tw[2], tw[3]); ww.z = pk2(tw[4], tw[5]); ww.w = pk2(tw[6], tw[7]);
    *(LAS u32x4*)(Tu + cc * 72 + m0) = wu; *(LAS u32x4*)(Tw + cc * 72 + m0) = ww;
  }
  __syncthreads();
#pragma unroll
  for (int rr = 0; rr < 4; ++rr) {
    f32x4 u = {0.f, 0.f, 0.f, 0.f};
    u = prod16<2>(Tu, 72, 16 * rr, VT, 72, 16 * w, u, lane);
    *(f32x4*)(gU + ((w * 4 + rr) * 64 + lane) * 4) = u;
    f32x4 wt = {0.f, 0.f, 0.f, 0.f};
    wt = prod16<2>(KhT, 72, 16 * w, Tw, 72, 16 * rr, wt, lane);
    u32x2 wv; wv.x = pk2(-wt[0], -wt[1]); wv.y = pk2(-wt[2], -wt[3]);
    *(u32x2*)(gA + (size_t)(F_WN + rr * 4 + (w >> 1)) * 1024 + (r16 + 16 * q4) * 16 + (w & 1) * 8) = wv;
  }
#pragma unroll
  for (int it = 0; it < 4; ++it) {
    const int idx = tid + it * 512; const int d = idx >> 4, m4 = idx & 15;
    const u32x2 raw = *(const LAS u32x2*)(KhT + d * 72 + 4 * m4);
    const float k0 = __uint_as_float(raw.x << 16), k1 = __uint_as_float(raw.x & 0xffff0000u), k2 = __uint_as_float(raw.y << 16), k3 = __uint_as_float(raw.y & 0xffff0000u);
    const float e0 = __expf(gl - gcb[4 * m4]), e1 = __expf(gl - gcb[4 * m4 + 1]), e2 = __expf(gl - gcb[4 * m4 + 2]), e3 = __expf(gl - gcb[4 * m4 + 3]);
    u32x2 wv; wv.x = pk2(k0 * e0, k1 * e1); wv.y = pk2(k2 * e2, k3 * e3);
    *(u32x2*)(gA + (size_t)(F_KT + (d >> 4) * 2 + (m4 >> 3)) * 1024 + ((d & 15) + 16 * (m4 & 3)) * 16 + ((m4 >> 2) & 1) * 8) = wv;
  }
  if (tid == 0) p.dnG[ci] = __expf(gl);
}

#define DS_A0 0
#define DS_A1 57344
#define DS_TOTAL 114688
__device__ void dn_scan_blk(const Params& p, LAS unsigned char* lds, int item) {
  const int tid = p.tid, lane = tid & 63, w = __builtin_amdgcn_readfirstlane(tid >> 6), r16 = lane & 15, q4 = lane >> 4;
  const int bh = item >> 1, eh = item & 1, b = bh >> 2, h = bh & 3;
  const int et = eh * 4 + (w & 3);
  const bool comp = w < 4;
  const unsigned char* gA = (const unsigned char*)p.dnA + (size_t)bh * 64 * DN_ABYTES;
  const float* gU = p.dnU + (size_t)bh * 64 * DN_UFLOATS;
  const float* gG = p.dnG + bh * 64;
  auto issue_A = [&](int n, int buf) {
#pragma unroll
    for (int i = 0; i < 7; ++i) {
      const int f = w * 7 + i;
      __builtin_amdgcn_global_load_lds((const unsigned*)(gA + (size_t)n * DN_ABYTES + f * 1024 + lane * 16), (LAS unsigned*)(lds + (buf ? DS_A1 : DS_A0) + f * 1024), 16, 0, 0);
    }
  };
  __syncthreads();
  issue_A(0, 0);
  f32x4 Un[4];
#pragma unroll
  for (int rr = 0; rr < 4; ++rr) Un[rr] = *(const f32x4*)(gU + ((et * 4 + rr) * 64 + lane) * 4);
  f32x4 S[8];
#pragma unroll
  for (int dt = 0; dt < 8; ++dt) S[dt] = (f32x4){0.f, 0.f, 0.f, 0.f};
  asm volatile("s_waitcnt vmcnt(0)" ::: "memory");
  __syncthreads();
  bf16_t* obase = p.dn_out + ((size_t)b * SEQ) * p.dn_out_ld + h * 128 + 16 * et + r16;
  f32x4 Op[4];
#pragma unroll
  for (int rr = 0; rr < 4; ++rr) Op[rr] = (f32x4){0.f, 0.f, 0.f, 0.f};
  float gnext = gG[0];
#pragma unroll 1
  for (int n = 0; n < 64; ++n) {
    const LAS unsigned char* Ab = lds + ((n & 1) ? DS_A1 : DS_A0);
    if (n + 1 < 64) issue_A(n + 1, (n + 1) & 1);
    if (comp) {
      if (n > 0) {
#pragma unroll
        for (int rr = 0; rr < 4; ++rr)
#pragma unroll
          for (int i = 0; i < 4; ++i) obase[(size_t)((n - 1) * 64 + 16 * rr + 4 * q4 + i) * p.dn_out_ld] = f2bf_hw(Op[rr][i]);
      }
      f32x4 Vn[4];
#pragma unroll
      for (int rr = 0; rr < 4; ++rr) Vn[rr] = Un[rr];
      if (n + 1 < 64) {
#pragma unroll
        for (int rr = 0; rr < 4; ++rr) Un[rr] = *(const f32x4*)(gU + (size_t)(n + 1) * DN_UFLOATS + ((et * 4 + rr) * 64 + lane) * 4);
      }
      const float gdec = gnext;
      if (n + 1 < 64) gnext = gG[n + 1];
      bf16x8 Sb[4];
#pragma unroll
      for (int ks = 0; ks < 4; ++ks) Sb[ks] = pack8(S[2 * ks][0], S[2 * ks][1], S[2 * ks][2], S[2 * ks][3], S[2 * ks + 1][0], S[2 * ks + 1][1], S[2 * ks + 1][2], S[2 * ks + 1][3]);
#pragma unroll
      for (int dt = 0; dt < 8; ++dt) S[dt] *= gdec;
#define LDF(idx) (*(const LAS bf16x8*)(Ab + (idx) * 1024 + lane * 16))
#define SBAR __builtin_amdgcn_sched_barrier(0)
      bf16x8 fa[8], fb[8];
      f32x4 O[4];
#pragma unroll
      for (int rr = 0; rr < 4; ++rr) O[rr] = (f32x4){0.f, 0.f, 0.f, 0.f};
#pragma unroll
      for (int i = 0; i < 4; ++i) { fa[i] = LDF(F_WN + i); fa[4 + i] = LDF(F_QD + i); }
      SBAR;
#pragma unroll
      for (int i = 0; i < 4; ++i) { fb[i] = LDF(F_WN + 4 + i); fb[4 + i] = LDF(F_QD + 4 + i); }
      SBAR;
#pragma unroll
      for (int ks = 0; ks < 4; ++ks) { Vn[0] = MFMA16(fa[ks], Sb[ks], Vn[0]); O[0] = MFMA16(fa[4 + ks], Sb[ks], O[0]); }
      SBAR;
#pragma unroll
      for (int i = 0; i < 4; ++i) { fa[i] = LDF(F_WN + 8 + i); fa[4 + i] = LDF(F_QD + 8 + i); }
      SBAR;
#pragma unroll
      for (int ks = 0; ks < 4; ++ks) { Vn[1] = MFMA16(fb[ks], Sb[ks], Vn[1]); O[1] = MFMA16(fb[4 + ks], Sb[ks], O[1]); }
      SBAR;
#pragma unroll
      for (int i = 0; i < 4; ++i) { fb[i] = LDF(F_WN + 12 + i); fb[4 + i] = LDF(F_QD + 12 + i); }
      SBAR;
#pragma unroll
      for (int ks = 0; ks < 4; ++ks) { Vn[2] = MFMA16(fa[ks], Sb[ks], Vn[2]); O[2] = MFMA16(fa[4 + ks], Sb[ks], O[2]); }
      SBAR;
#pragma unroll
      for (int i = 0; i < 8; ++i) fa[i] = LDF(F_QK + i);
      SBAR;
#pragma unroll
      for (int ks = 0; ks < 4; ++ks) { Vn[3] = MFMA16(fb[ks], Sb[ks], Vn[3]); O[3] = MFMA16(fb[4 + ks], Sb[ks], O[3]); }
      SBAR;
#pragma unroll
      for (int i = 0; i < 8; ++i) fb[i] = LDF(F_KT + i);
      SBAR;
      bf16x8 Vb[2];
#pragma unroll
      for (int ks = 0; ks < 2; ++ks) Vb[ks] = pack8(Vn[2 * ks][0], Vn[2 * ks][1], Vn[2 * ks][2], Vn[2 * ks][3], Vn[2 * ks + 1][0], Vn[2 * ks + 1][1], Vn[2 * ks + 1][2], Vn[2 * ks + 1][3]);
#pragma unroll
      for (int ks = 0; ks < 2; ++ks)
#pragma unroll
        for (int rr = 0; rr < 4; ++rr) O[rr] = MFMA16(fa[rr * 2 + ks], Vb[ks], O[rr]);
      SBAR;
#pragma unroll
      for (int i = 0; i < 8; ++i) fa[i] = LDF(F_KT + 8 + i);
      SBAR;
#pragma unroll
      for (int ks = 0; ks < 2; ++ks)
#pragma unroll
        for (int dt = 0; dt < 4; ++dt) S[dt] = MFMA16(fb[dt * 2 + ks], Vb[ks], S[dt]);
      SBAR;
#pragma unroll
      for (int ks = 0; ks < 2; ++ks)
#pragma unroll
        for (int dt = 0; dt < 4; ++dt) S[4 + dt] = MFMA16(fa[dt * 2 + ks], Vb[ks], S[4 + dt]);
#pragma unroll
      for (int rr = 0; rr < 4; ++rr) Op[rr] = O[rr];
#undef LDF
#undef SBAR
    }
    asm volatile("s_waitcnt vmcnt(0)" ::: "memory");
    __syncthreads();
  }
  if (comp) {
#pragma unroll
    for (int rr = 0; rr < 4; ++rr)
#pragma unroll
      for (int i = 0; i < 4; ++i) obase[(size_t)(63 * 64 + 16 * rr + 4 * q4 + i) * p.dn_out_ld] = f2bf_hw(Op[rr][i]);
  }
}
__device__ void ph_dn_norm(const Params& p, int nblk, int bid) {
  const int wid = p.tid >> 6, lane = p.tid & 63;
  const f32x4 g0 = *(const f32x4*)(p.g_dn_out + (lane & 15) * 8), g1 = *(const f32x4*)(p.g_dn_out + (lane & 15) * 8 + 4);
  u32x4 on_ = {0u, 0u, 0u, 0u}, zn_ = on_;
  if (bid * 8 + wid < T_TOK) { const int t0 = bid * 8 + wid; on_ = *(const u32x4*)(p.oab + (size_t)t0 * DM + lane * 8); zn_ = *(const u32x4*)(p.proj + (size_t)t0 * PW + C_Z + lane * 8); }
  for (int t = bid * 8 + wid; t < T_TOK; t += nblk * 8) {
    bf16_t* op = p.oab + (size_t)t * DM + lane * 8;
    float o[8], z[8];
    unpack8(on_, o);
    unpack8(zn_, z);
    if (t + nblk * 8 < T_TOK) { const int tn = t + nblk * 8; on_ = *(const u32x4*)(p.oab + (size_t)tn * DM + lane * 8); zn_ = *(const u32x4*)(p.proj + (size_t)tn * PW + C_Z + lane * 8); }
    float ss = 0.f;
#pragma unroll
    for (int j = 0; j < 8; ++j) ss += o[j] * o[j];
    ss += __shfl_xor(ss, 1, 64); ss += __shfl_xor(ss, 2, 64); ss += __shfl_xor(ss, 4, 64); ss += __shfl_xor(ss, 8, 64);
    const float rstd = rsqrtf(ss * (1.f / 128.f) + 1e-6f);
    float y[8];
#pragma unroll
    for (int j = 0; j < 4; ++j) { y[j] = o[j] * rstd * g0[j] * siluf_(z[j]); y[4 + j] = o[4 + j] * rstd * g1[j] * siluf_(z[4 + j]); }
    u32x4 w; w.x = pk2(y[0], y[1]); w.y = pk2(y[2], y[3]); w.z = pk2(y[4], y[5]); w.w = pk2(y[6], y[7]);
    *(u32x4*)op = w;
  }
}
typedef float f32x16 __attribute__((ext_vector_type(16)));
#define MFMA32(a, b, c) __builtin_amdgcn_mfma_f32_32x32x16_bf16((a), (b), (c), 0, 0, 0)
#define MP_VL 0
#define MP_RED 65536
#define MP_TOTAL (65536 + 4096)

__device__ void moba_prep_block(const Params& p, LAS unsigned char* lds, int item) {
  const int tid = p.tid, lane = tid & 63, w = tid >> 6;
  const int bh = item >> 4, jb = item & 15, b = bh >> 2, h = bh & 3;
  LAS bf16_t* Vl = (LAS bf16_t*)(lds + MP_VL);
  LAS float* red = (LAS float*)(lds + MP_RED);
  __syncthreads();
#pragma unroll
  for (int it = 0; it < 8; ++it) {
    const int idx = tid + 512 * it, row = idx >> 4, ch = idx & 15;
    const u32x4 v = *(const u32x4*)(p.proj + ((size_t)b * SEQ + 256 * jb + row) * PW + C_MV + h * 128 + 8 * ch);
    *(LAS u32x4*)(Vl + row * 128 + 8 * ch) = v;
  }
  {
    const int r = tid >> 1, hh = tid & 1;
    const int pos = 256 * jb + r;
    const size_t t = (size_t)b * SEQ + pos;
    float cs[8], sn[8];
#pragma unroll
    for (int jj = 0; jj < 8; ++jj) {
      const float inv = exp2f(-(float)(8 * hh + jj) * (1.f / 16.f) * 18.931568569324174f);
      const float ang = (float)pos * inv;
      cs[jj] = cosf(ang); sn[jj] = sinf(ang);
    }
    float kacc[64];
#pragma unroll
    for (int which = 0; which < 2; ++which) {
      const bf16_t* src = p.proj + t * PW + (which ? C_MQ : C_MK) + h * 128 + 8 * hh;
      float x0[8], x1[8];
      unpack8(*(const u32x4*)(src), x0); unpack8(*(const u32x4*)(src + 16), x1);
      float y0[8], y1[8];
#pragma unroll
      for (int jj = 0; jj < 8; ++jj) { y0[jj] = x0[jj] * cs[jj] - x1[jj] * sn[jj]; y1[jj] = x1[jj] * cs[jj] + x0[jj] * sn[jj]; }
      u32x4 o[8];
      o[0].x = pk2(y0[0], y0[1]); o[0].y = pk2(y0[2], y0[3]); o[0].z = pk2(y0[4], y0[5]); o[0].w = pk2(y0[6], y0[7]);
      o[1].x = pk2(y1[0], y1[1]); o[1].y = pk2(y1[2], y1[3]); o[1].z = pk2(y1[4], y1[5]); o[1].w = pk2(y1[6], y1[7]);
#pragma unroll
      for (int ks = 2; ks < 8; ++ks) o[ks] = *(const u32x4*)(src + 16 * ks);
      if (which == 0) {
#pragma unroll
        for (int jj = 0; jj < 8; ++jj) { kacc[jj] = y0[jj]; kacc[8 + jj] = y1[jj]; }
#pragma unroll
        for (int ks = 2; ks < 8; ++ks) { float f[8]; unpack8(o[ks], f);
#pragma unroll
          for (int jj = 0; jj < 8; ++jj) kacc[8 * ks + jj] = f[jj]; }
        unsigned char* dst = (unsigned char*)p.Kp + ((size_t)(bh * 128 + 8 * jb + (r >> 5)) * 8192) + ((r & 31) + 32 * hh) * 16;
#pragma unroll
        for (int ks = 0; ks < 8; ++ks) *(u32x4*)(dst + ks * 1024) = o[ks];
      } else {
        bf16_t* dst = p.qb + ((size_t)bh * SEQ + pos) * 128 + 8 * hh;
#pragma unroll
        for (int ks = 0; ks < 8; ++ks) *(u32x4*)(dst + 16 * ks) = o[ks];
      }
    }
#pragma unroll
    for (int e = 0; e < 64; ++e) {
      float v = kacc[e];
      v += __shfl_xor(v, 2, 64); v += __shfl_xor(v, 4, 64); v += __shfl_xor(v, 8, 64); v += __shfl_xor(v, 16, 64); v += __shfl_xor(v, 32, 64);
      kacc[e] = v;
    }
    if (lane < 2) {
#pragma unroll
      for (int e = 0; e < 64; ++e) red[(w * 2 + lane) * 64 + e] = kacc[e];
    }
  }
  __syncthreads();
  if (tid < 128) {
    const int d = tid, hh = (d >> 3) & 1, ks = d >> 4, jj = d & 7;
    float a = 0.f;
#pragma unroll
    for (int ww = 0; ww < 8; ++ww) a += red[(ww * 2 + hh) * 64 + ks * 8 + jj];
    p.kmean[((size_t)bh * 16 + jb) * 128 + d] = a * (1.f / 256.f);
  }
#pragma unroll
  for (int it = 0; it < 8; ++it) {
    const int o = tid + 512 * it, ln = o & 63, frag = o >> 6, tl = frag >> 3, dt = (frag >> 1) & 3, s = frag & 1;
    const int r = ln & 31, hh = ln >> 5, d = 32 * dt + r;
    unsigned short e[8];
#pragma unroll
    for (int jj = 0; jj < 8; ++jj) { const int key = 32 * tl + 16 * s + 8 * (jj >> 2) + 4 * hh + (jj & 3); e[jj] = Vl[key * 128 + d]; }
    u32x4 wv; wv.x = e[0] | ((unsigned)e[1] << 16); wv.y = e[2] | ((unsigned)e[3] << 16); wv.z = e[4] | ((unsigned)e[5] << 16); wv.w = e[6] | ((unsigned)e[7] << 16);
    *(u32x4*)((unsigned char*)p.Vp + ((size_t)(bh * 128 + 8 * jb + tl) * 8192) + (dt * 2 + s) * 1024 + ln * 16) = wv;
  }
}
__device__ __forceinline__ int crow32(int reg, int hh) { return (reg & 3) + 8 * (reg >> 2) + 4 * hh; }
__device__ void moba_item(const Params& p, LAS float* km, LAS float* mrg, LAS float* ml, int bh, int ib, int sub, int par, int lane, int rep) {
  const int q = lane & 31, hh = lane >> 5;
  const int b = bh >> 2, h = bh & 3;
  const int s0 = 256 * ib + 32 * sub;
  const bf16_t* qrow = p.qb + ((size_t)bh * SEQ + s0 + q) * 128 + 8 * hh;
  bf16x8 Qf[8];
#pragma unroll
  for (int ks = 0; ks < 8; ++ks) Qf[ks] = *(const bf16x8*)(qrow + 16 * ks);
  LAS unsigned char* qlds = (LAS unsigned char*)km + 8192 + lane * 16;
#pragma unroll
  for (int ks = 0; ks < 8; ++ks) *(LAS bf16x8*)(qlds + ks * 1024) = Qf[ks];
  unsigned selmask = 0;
  if (ib > 0) {
    for (int idx = lane; idx < ib * 32; idx += 64) ((LAS f32x4*)km)[idx] = ((const f32x4*)(p.kmean + (size_t)bh * 16 * 128))[idx];
    float qf[64];
#pragma unroll
    for (int ks = 0; ks < 8; ++ks) { float f[8]; unpack8(__builtin_bit_cast(u32x4, Qf[ks]), f);
#pragma unroll
      for (int jj = 0; jj < 8; ++jj) qf[8 * ks + jj] = f[jj]; }
    float sc[16];
#pragma unroll
    for (int j = 0; j < 16; ++j) {
      sc[j] = -INFINITY;
      if (j < ib) {
        float a = 0.f;
#pragma unroll
        for (int ks = 0; ks < 8; ++ks) {
          const f32x4 k0 = *(const LAS f32x4*)(km + j * 128 + 16 * ks + 8 * hh), k1 = *(const LAS f32x4*)(km + j * 128 + 16 * ks + 8 * hh + 4);
          a += qf[8 * ks] * k0[0] + qf[8 * ks + 1] * k0[1] + qf[8 * ks + 2] * k0[2] + qf[8 * ks + 3] * k0[3];
          a += qf[8 * ks + 4] * k1[0] + qf[8 * ks + 5] * k1[1] + qf[8 * ks + 6] * k1[2] + qf[8 * ks + 7] * k1[3];
        }
        a += __shfl_xor(a, 32, 64);
        sc[j] = a;
      }
    }
#pragma unroll
    for (int r = 0; r < 3; ++r) {
      if (r < ib) {
        float best = -INFINITY; int bi = 0;
#pragma unroll
        for (int j = 0; j < 16; ++j) if (sc[j] > best) { best = sc[j]; bi = j; }
        selmask |= 1u << bi;
#pragma unroll
        for (int j = 0; j < 16; ++j) if (j == bi) sc[j] = -INFINITY;
      }
    }
  }
  unsigned rem = 0;
  for (int j = 0; j < ib; ++j) if (__ballot((selmask >> j) & 1u) != 0ull) rem |= 1u << j;
  rem = __builtin_amdgcn_readfirstlane(rem);
  const int own0 = 8 * ib, diag = 8 * ib + sub;
  const float cscale = 0.08838834764831845f * 1.4426950408889634f;
  float m = -1e30f, l = 0.f;
  f32x16 O[4];
#pragma unroll
  for (int dt = 0; dt < 4; ++dt)
#pragma unroll
    for (int r = 0; r < 16; ++r) O[dt][r] = 0.f;
  const unsigned char* kbase = (const unsigned char*)p.Kp + (size_t)bh * 128 * 8192 + lane * 16;
  const unsigned char* vbase = (const unsigned char*)p.Vp + (size_t)bh * 128 * 8192 + lane * 16;
  auto adv = [&](int& kt_, unsigned& rem_) {
    if (kt_ < 0) return;
    if (kt_ >= own0 ? (kt_ < diag) : ((kt_ & 7) != 7)) { kt_ = kt_ + 1; return; }
    if (rem_ == 0u) { kt_ = -1; return; }
    kt_ = 8 * (__builtin_ctz(rem_)); rem_ &= rem_ - 1u;
  };
  int kt = own0;
  if (par) adv(kt, rem);
  auto load_k = [&](int t, bf16x8 (&K_)[8]) {
#pragma unroll
    for (int ks = 0; ks < 8; ++ks) K_[ks] = *(const bf16x8*)(kbase + (size_t)t * 8192 + ks * 1024);
  };
  auto tile_step = [&](bf16x8 (&Kc)[8], bf16x8 (&Kn)[8]) -> bool {
    int ktn = kt; unsigned remn = rem;
    adv(ktn, remn); adv(ktn, remn);
    bf16x8 Vf[8];
#pragma unroll
    for (int f = 0; f < 8; ++f) Vf[f] = *(const bf16x8*)(vbase + (size_t)kt * 8192 + f * 1024);
    if (ktn >= 0) load_k(ktn, Kn);
    f32x16 S;
#pragma unroll
    for (int r = 0; r < 16; ++r) S[r] = 0.f;
#pragma unroll
    for (int ks = 0; ks < 8; ++ks) S = MFMA32(Kc[ks], *(const LAS bf16x8*)(qlds + ks * 1024), S);
    const bool allowed = (kt >= own0) || ((selmask >> (kt >> 3)) & 1u);
    const float nb = allowed ? 0.f : -INFINITY;
    float sv[16]; float mx = -INFINITY;
#pragma unroll
    for (int r = 0; r < 16; ++r) sv[r] = __builtin_fmaf(S[r], cscale, nb);
    if (kt == diag) {
#pragma unroll
      for (int r = 0; r < 16; ++r) if (crow32(r, hh) > q) sv[r] = -INFINITY;
    }
#pragma unroll
    for (int r = 0; r < 16; ++r) mx = fmaxf(mx, sv[r]);
    mx = fmaxf(mx, __shfl_xor(mx, 32, 64));
    const bool grow = mx > m + 8.f;
    const float mn = (__ballot(grow) != 0ull) ? fmaxf(m, mx) : m;
    const float alpha = __builtin_amdgcn_exp2f(m - mn);
    float ps = 0.f;
#pragma unroll
    for (int r = 0; r < 16; ++r) { sv[r] = __builtin_amdgcn_exp2f(sv[r] - mn); ps += sv[r]; }
    l = l * alpha + ps; m = mn;
    if (__ballot(alpha != 1.f) != 0ull) {
#pragma unroll
      for (int dt = 0; dt < 4; ++dt)
#pragma unroll
        for (int r = 0; r < 16; ++r) O[dt][r] *= alpha;
    }
    const bf16x8 P0 = pack8(sv[0], sv[1], sv[2], sv[3], sv[4], sv[5], sv[6], sv[7]);
    const bf16x8 P1 = pack8(sv[8], sv[9], sv[10], sv[11], sv[12], sv[13], sv[14], sv[15]);
#pragma unroll
    for (int dt = 0; dt < 4; ++dt) { O[dt] = MFMA32(Vf[dt * 2], P0, O[dt]); O[dt] = MFMA32(Vf[dt * 2 + 1], P1, O[dt]); }
    kt = ktn; rem = remn;
    return kt >= 0;
  };
  if (kt >= 0) {
    bf16x8 KA[8], KB[8];
    load_k(kt, KA);
#pragma unroll 1
    for (;;) {
      if (!tile_step(KA, KB)) break;
      asm volatile("" ::: "memory");
      if (!tile_step(KB, KA)) break;
      asm volatile("" ::: "memory");
    }
  }
  asm volatile("s_waitcnt vmcnt(0) lgkmcnt(0)" ::: "memory");
  if (par) {
    ml[lane] = m; ml[64 + lane] = l;
#pragma unroll
    for (int dt = 0; dt < 4; ++dt)
#pragma unroll
      for (int r = 0; r < 16; ++r) mrg[(dt * 16 + r) * 64 + lane] = O[dt][r];
  }
  __syncthreads();
  if (par == 0) {
    const float m2 = ml[lane], l2 = ml[64 + lane];
    const float mm = fmaxf(m, m2);
    const float a1 = __builtin_amdgcn_exp2f(m - mm), a2 = __builtin_amdgcn_exp2f(m2 - mm);
    l = l * a1 + l2 * a2;
#pragma unroll
    for (int dt = 0; dt < 4; ++dt)
#pragma unroll
      for (int r = 0; r < 16; ++r) O[dt][r] = O[dt][r] * a1 + mrg[(dt * 16 + r) * 64 + lane] * a2;
  }
  if (par == 0) {
  l += __shfl_xor(l, 32, 64);
  const float inv = 1.f / l;
  bf16_t* orow = rep ? p.oab2 + ((size_t)b * SEQ + s0 + q) * 512 + h * 128 : p.mb_out + ((size_t)b * SEQ + s0 + q) * p.mb_out_ld + p.mb_out_off + h * 128;
#pragma unroll
  for (int dt = 0; dt < 4; ++dt)
#pragma unroll
    for (int g4 = 0; g4 < 4; ++g4) {
      u32x2 wv; wv.x = pk2(O[dt][4 * g4] * inv, O[dt][4 * g4 + 1] * inv); wv.y = pk2(O[dt][4 * g4 + 2] * inv, O[dt][4 * g4 + 3] * inv);
      *(u32x2*)(orow + 32 * dt + 8 * g4 + 4 * hh) = wv;
    }
  }
  __syncthreads();
}
__device__ void moba_worker(const Params& p, LAS unsigned char* lds, int qi) {
  const int lane = p.tid & 63, w = __builtin_amdgcn_readfirstlane(p.tid >> 6);
  LAS float* km = (LAS float*)(lds + w * 16384);
  LAS float* mrg = (LAS float*)(lds + ((w & 3) + 4) * 16384);
  LAS float* ml = (LAS float*)(lds + 131072) + (w & 3) * 128;
  LAS int* slot = (LAS int*)(lds + 131072 + 2048);
  const int g0 = (int)((unsigned)__builtin_amdgcn_s_getreg((3 << 11) | 20) & 7u);
  for (int gi = 0; gi < 8; ++gi) {
    const int g = (g0 + gi) & 7;
    for (;;) {
      __syncthreads();
      if (p.tid == 0) slot[0] = atomicAdd(p.wq + qi * 8 + g, 1);
      __syncthreads();
      const int idx = slot[0];
      if (idx >= 64) break;
      const int bh = 2 * g + (idx >> 5), ib = 15 - ((idx >> 1) & 15), quad = 1 - (idx & 1);
      moba_item(p, km, mrg, ml, bh, ib, 4 * quad + (w & 3), w >> 2, lane, qi);
    }
  }
}
__device__ void ph_mod(const Params& p, LAS unsigned char* lds, int nblk, int bid) {
  LAS float* sc = (LAS float*)lds;
  LAS float* part = (LAS float*)(lds + 16384);
  const int tid = p.tid;
  if (bid >= 192) return;
  for (int i = tid; i < 4096; i += 512) sc[i] = siluf_(p.c[i]);
  __syncthreads();
  for (int task = bid; task < 192; task += nblk) {
    const int jj = tid & 31, ks = tid >> 5, j = task * 32 + jj;
    float a0 = 0.f, a1 = 0.f, a2 = 0.f, a3 = 0.f;
#pragma unroll 8
    for (int kk = 0; kk < 64; ++kk) {
      const int k = ks * 64 + kk;
      const float w = p.w_ada[(size_t)k * 6144 + j];
      a0 += sc[k] * w; a1 += sc[1024 + k] * w; a2 += sc[2048 + k] * w; a3 += sc[3072 + k] * w;
    }
    *(LAS f32x4*)(part + (ks * 32 + jj) * 4) = (f32x4){a0, a1, a2, a3};
    __syncthreads();
    if (tid < 128) {
      const int j2 = tid & 31, bb = tid >> 5;
      float a = 0.f;
#pragma unroll
      for (int s = 0; s < 16; ++s) a += part[(s * 32 + j2) * 4 + bb];
      p.mod[bb * 6144 + task * 32 + j2] = a + p.b_ada[task * 32 + j2];
    }
    __syncthreads();
  }
}

#define WT_T0 1424
#define WT_T1 (WT_T0 + 16384)
#define WT_T2 (WT_T1 + 8192)
#define WT_T3 (WT_T2 + 128)
#define WT_T4 (WT_T3 + 128)
#define WT_T5 (WT_T4 + 256)
struct WtTile { const float* src; bf16_t* dst; int K, N, mode, k0, n0; unsigned char* dst8; };
__device__ __forceinline__ WtTile wt_desc(const Params& p, int t) {
  WtTile d;
  if (t < WT_T0) { const int kt = t / 89, nt = t % 89; d = {p.w_in, p.w_in_t, 1024, INW, 1, kt * 64, nt * 64, nullptr}; }
  else if (t < WT_T1) { const int u = t - WT_T0, e = u >> 9, r = u & 511, kt = r >> 5, nt = r & 31; d = {p.w_gu + (size_t)e * 1024 * 2048, nullptr, 1024, 2048, 2, kt * 64, nt * 64, p.wgu8 + (size_t)e * 2048 * 1024}; }
  else if (t < WT_T2) { const int u = t - WT_T1, e = u >> 8, r = u & 255, kt = r >> 4, nt = r & 15; d = {p.w_down + (size_t)e * 1024 * 1024, nullptr, 1024, 1024, 0, kt * 64, nt * 64, p.wd8 + (size_t)e * 1024 * 1024}; }
  else if (t < WT_T3) { const int u = t - WT_T2, kt = u >> 4, nt = u & 15; d = {p.w_br_a, p.wbra_t, 512, 1024, 0, kt * 64, nt * 64, nullptr}; }
  else if (t < WT_T4) { const int u = t - WT_T3, kt = u >> 4, nt = u & 15; d = {p.w_br_b, p.wbrb_t, 512, 1024, 0, kt * 64, nt * 64, nullptr}; }
  else { const int u = t - WT_T4, kt = u >> 4, nt = u & 15; d = {p.w_o, p.wo_t, 1024, 1024, 0, kt * 64, nt * 64, nullptr}; }
  return d;
}
__device__ __forceinline__ void wt_load(const WtTile& d, int tid, f32x4 (&v)[2]) {
#pragma unroll
  for (int it = 0; it < 2; ++it) {
    const int row = (tid >> 4) + 32 * it, n = d.n0 + (tid & 15) * 4;
    v[it] = (f32x4){0.f, 0.f, 0.f, 0.f};
    if (n < d.N) v[it] = __builtin_nontemporal_load((const f32x4*)(d.src + (size_t)(d.k0 + row) * d.N + n));
  }
}
__device__ void ph_wt(const Params& p, LAS unsigned char* lds, int nblk, int bid) {
  LAS float* tile = (LAS float*)(lds + 32768);
  const int tid = p.tid;
  int t = bid;
  if (t >= WT_T5) return;
  WtTile cur = wt_desc(p, t);
  f32x4 v[2]; wt_load(cur, tid, v);
  WtTile nxt = cur; f32x4 vn[2] = {v[0], v[1]};
  if (t + nblk < WT_T5) { nxt = wt_desc(p, t + nblk); wt_load(nxt, tid, vn); }
  for (;;) {
    const int tnn = t + 2 * nblk;
    WtTile nn = nxt; f32x4 vnn[2] = {vn[0], vn[1]};
    if (tnn < WT_T5) { nn = wt_desc(p, tnn); wt_load(nn, tid, vnn); }
#pragma unroll
    for (int it = 0; it < 2; ++it) {
      const int row = (tid >> 4) + 32 * it, c4 = (tid & 15) * 4;
      tile[row * 65 + c4] = v[it][0]; tile[row * 65 + c4 + 1] = v[it][1]; tile[row * 65 + c4 + 2] = v[it][2]; tile[row * 65 + c4 + 3] = v[it][3];
    }
    __syncthreads();
    {
      const int nl = tid >> 3, kc = tid & 7, n = cur.n0 + nl;
      if (n < cur.N) {
        const int dd = map_col(n, cur.mode);
        if (dd >= 0) {
          float f[8];
#pragma unroll
          for (int j = 0; j < 8; ++j) f[j] = tile[(8 * kc + j) * 65 + nl];
          if (cur.dst8) {
            u32x2 w; w.x = pk4_fp8(f[0] * 64.f, f[1] * 64.f, f[2] * 64.f, f[3] * 64.f); w.y = pk4_fp8(f[4] * 64.f, f[5] * 64.f, f[6] * 64.f, f[7] * 64.f);
            *(u32x2*)(cur.dst8 + (size_t)dd * cur.K + cur.k0 + 8 * kc) = w;
          } else {
            u32x4 w; w.x = pk2(f[0], f[1]); w.y = pk2(f[2], f[3]); w.z = pk2(f[4], f[5]); w.w = pk2(f[6], f[7]);
            *(u32x4*)(cur.dst + (size_t)dd * cur.K + cur.k0 + 8 * kc) = w;
          }
        }
      }
    }
    __syncthreads();
    if (t + nblk >= WT_T5) break;
    t += nblk; cur = nxt; v[0] = vn[0]; v[1] = vn[1]; nxt = nn; vn[0] = vnn[0]; vn[1] = vnn[1];
  }
}

__device__ void ph_h(const Params& p, LAS unsigned char* lds, int nblk, int bid) {
  const int wid = p.tid >> 6, lane = p.tid & 63;
  LAS float* wb = (LAS float*)lds;
  for (int i = p.tid; i < 2048; i += 512) {
    const int k = i >> 1, hf = i & 1;
    const f32x4 v = *(const f32x4*)(p.w_in + (size_t)k * INW + 2048 + 4 * hf);
    wb[(4 * hf + 0) * 1024 + k] = v[0]; wb[(4 * hf + 1) * 1024 + k] = v[1]; wb[(4 * hf + 2) * 1024 + k] = v[2]; wb[(4 * hf + 3) * 1024 + k] = v[3];
  }
  __syncthreads();
  f32x4 xnx[4];
  if (bid * 8 + wid < T_TOK) {
#pragma unroll
    for (int i = 0; i < 4; ++i) xnx[i] = *(const f32x4*)(p.x + (size_t)(bid * 8 + wid) * DM + i * 256 + lane * 4);
  }
  for (int t = bid * 8 + wid; t < T_TOK; t += nblk * 8) {
    const int b = t / SEQ;
    f32x4 xv[4];
    float ss = 0.f;
#pragma unroll
    for (int i = 0; i < 4; ++i) {
      xv[i] = xnx[i];
      ss += xv[i][0] * xv[i][0] + xv[i][1] * xv[i][1] + xv[i][2] * xv[i][2] + xv[i][3] * xv[i][3];
    }
    if (t + nblk * 8 < T_TOK) {
#pragma unroll
      for (int i = 0; i < 4; ++i) xnx[i] = *(const f32x4*)(p.x + (size_t)(t + nblk * 8) * DM + i * 256 + lane * 4);
    }
    ss = wave_sum(ss);
    const float rstd = rsqrtf(ss * (1.f / DM) + 1e-6f);
    const float* shift = p.mod + b * 6144;
    const float* scale = p.mod + b * 6144 + 1024;
    float acc[8] = {0, 0, 0, 0, 0, 0, 0, 0};
#pragma unroll
    for (int i = 0; i < 4; ++i) {
      const int k = i * 256 + lane * 4;
      const f32x4 g = *(const f32x4*)(p.g_pre_mix + k), sc = *(const f32x4*)(scale + k), sh = *(const f32x4*)(shift + k);
      f32x4 hv;
#pragma unroll
      for (int j = 0; j < 4; ++j) hv[j] = xv[i][j] * rstd * g[j] * (1.f + sc[j]) + sh[j];
#pragma unroll
      for (int e = 0; e < 8; ++e) { const f32x4 w = *(const LAS f32x4*)(wb + e * 1024 + k); acc[e] += hv[0] * w[0] + hv[1] * w[1] + hv[2] * w[2] + hv[3] * w[3]; }
      u32x2 pk; pk.x = pk2(hv[0], hv[1]); pk.y = pk2(hv[2], hv[3]);
      *(u32x2*)(p.hbf + (size_t)t * DM + k) = pk;
    }
#pragma unroll
    for (int e = 0; e < 8; ++e) acc[e] = wave_sum(acc[e]);
    if (lane == 0) { *(f32x4*)(p.ba + (size_t)t * 8) = (f32x4){acc[0], acc[1], acc[2], acc[3]}; *(f32x4*)(p.ba + (size_t)t * 8 + 4) = (f32x4){acc[4], acc[5], acc[6], acc[7]}; }
  }
}

__device__ void ph_post_mix(const Params& p, LAS unsigned char* lds, int nblk, int bid, int rep) {
  const int wid = p.tid >> 6, lane = p.tid & 63;
  LAS bf16_t* wl = (LAS bf16_t*)lds;
  LAS float* sh = (LAS float*)(lds + 81920) + wid * 1024;
  LAS int* lcnt = (LAS int*)(lds + 114688);
  LAS int* lbase = lcnt + 32;
  LAS int* lent = (LAS int*)(lds + 115200) + wid * 256;
  int nloc = 0;
  if (p.tid < 32) lcnt[p.tid] = 0;
  for (int i = p.tid; i < 1024 * 8; i += 512) {
    const int k = i >> 3, c = i & 7;
    const f32x4 v = *(const f32x4*)(p.w_router + (size_t)k * 32 + c * 4);
    u32x2 w2; w2.x = pk2(v[0], v[1]); w2.y = pk2(v[2], v[3]);
    *(LAS u32x2*)(wl + k * 40 + c * 4) = w2;
  }
  __syncthreads();
  u32x4 mxn[2]; f32x4 xn[4];
  {
    const int t0 = bid * 8 + wid;
    if (t0 < T_TOK) {
#pragma unroll
      for (int i = 0; i < 2; ++i) mxn[i] = *(const u32x4*)(p.mixer + (size_t)t0 * DM + i * 512 + lane * 8);
#pragma unroll
      for (int i = 0; i < 4; ++i) xn[i] = *(const f32x4*)(p.x + (size_t)t0 * DM + (i >> 1) * 512 + lane * 8 + (i & 1) * 4);
    }
  }
  for (int t = bid * 8 + wid; t < T_TOK; t += nblk * 8) {
    const int b = t / SEQ;
    const float* md = p.mod + b * 6144;
    u32x4 mxc[2] = {mxn[0], mxn[1]}; f32x4 xc[4] = {xn[0], xn[1], xn[2], xn[3]};
    {
      const int tn = t + nblk * 8;
      if (tn < T_TOK) {
#pragma unroll
        for (int i = 0; i < 2; ++i) mxn[i] = *(const u32x4*)(p.mixer + (size_t)tn * DM + i * 512 + lane * 8);
#pragma unroll
        for (int i = 0; i < 4; ++i) xn[i] = *(const f32x4*)(p.x + (size_t)tn * DM + (i >> 1) * 512 + lane * 8 + (i & 1) * 4);
      }
    }
    float mv[16];
    float ss = 0.f;
#pragma unroll
    for (int i = 0; i < 2; ++i) {
      float f[8]; unpack8(mxc[i], f);
#pragma unroll
      for (int j = 0; j < 8; ++j) { mv[i * 8 + j] = f[j]; ss += f[j] * f[j]; }
    }
    ss = wave_sum(ss);
    const float rstd = rsqrtf(ss * (1.f / DM) + 1e-6f);
    float x1[16];
    float s2 = 0.f;
#pragma unroll
    for (int i = 0; i < 2; ++i)
#pragma unroll
      for (int j4 = 0; j4 < 2; ++j4) {
        const int k = i * 512 + lane * 8 + j4 * 4;
        const f32x4 xv = xc[i * 2 + j4];
        const f32x4 gm = *(const f32x4*)(md + 2048 + k), gp = *(const f32x4*)(p.g_post_mix + k);
        f32x4 o;
#pragma unroll
        for (int j = 0; j < 4; ++j) { o[j] = xv[j] + gm[j] * (mv[i * 8 + j4 * 4 + j] * rstd * gp[j]); x1[i * 8 + j4 * 4 + j] = o[j]; s2 += o[j] * o[j]; }
        *(f32x4*)(p.out + (size_t)t * DM + k) = o;
      }
    s2 = wave_sum(s2);
    const float rstd2 = rsqrtf(s2 * (1.f / DM) + 1e-6f);
#pragma unroll
    for (int i = 0; i < 2; ++i) {
      float hv[8];
#pragma unroll
      for (int j = 0; j < 8; ++j) {
        const int k = i * 512 + lane * 8 + j;
        hv[j] = x1[i * 8 + j] * rstd2 * p.g_pre_ffn[k] * (1.f + md[4096 + k]) + md[3072 + k];
        sh[k] = hv[j];
      }
      u32x2 w; w.x = pk4_fp8(hv[0], hv[1], hv[2], hv[3]); w.y = pk4_fp8(hv[4], hv[5], hv[6], hv[7]);
      *(u32x2*)(p.h2q + (size_t)t * DM + i * 512 + lane * 8) = w;
    }
#ifdef PM_SKIP
    if (rep) continue;
#endif
    float acc[32];
#pragma unroll
    for (int e2 = 0; e2 < 32; ++e2) acc[e2] = 0.f;
#pragma unroll 4
    for (int i = 0; i < 16; ++i) {
      const float hk = sh[lane + 64 * i];
      const LAS u32x4* wr = (const LAS u32x4*)(wl + (lane + 64 * i) * 40);
#pragma unroll
      for (int c4 = 0; c4 < 4; ++c4) {
        float f[8]; unpack8(wr[c4], f);
#pragma unroll
        for (int j = 0; j < 8; ++j) acc[c4 * 8 + j] += hk * f[j];
      }
    }
    {
      const bool u5 = lane & 32, u4 = lane & 16, u3 = lane & 8, u2 = lane & 4, u1 = lane & 2;
      float a16[16], a8[8], a4[4], a2[2];
#pragma unroll
      for (int j = 0; j < 16; ++j) { const float snd = u5 ? acc[j] : acc[16 + j]; const float rcv = __shfl_xor(snd, 32, 64); a16[j] = (u5 ? acc[16 + j] : acc[j]) + rcv; }
#pragma unroll
      for (int j = 0; j < 8; ++j) { const float snd = u4 ? a16[j] : a16[8 + j]; const float rcv = __shfl_xor(snd, 16, 64); a8[j] = (u4 ? a16[8 + j] : a16[j]) + rcv; }
#pragma unroll
      for (int j = 0; j < 4; ++j) { const float snd = u3 ? a8[j] : a8[4 + j]; const float rcv = __shfl_xor(snd, 8, 64); a4[j] = (u3 ? a8[4 + j] : a8[j]) + rcv; }
#pragma unroll
      for (int j = 0; j < 2; ++j) { const float snd = u2 ? a4[j] : a4[2 + j]; const float rcv = __shfl_xor(snd, 4, 64); a2[j] = (u2 ? a4[2 + j] : a4[j]) + rcv; }
      const float snd = u1 ? a2[0] : a2[1]; const float rcv = __shfl_xor(snd, 2, 64);
      float a1 = (u1 ? a2[1] : a2[0]) + rcv;
      a1 += __shfl_xor(a1, 1, 64);
      acc[0] = a1;
    }
    const int e = lane >> 1;
    float lg = acc[0] + p.b_router[e];
    if (lane & 1) lg = -INFINITY;
    float tv[4]; int ti[4];
#pragma unroll
    for (int r = 0; r < 4; ++r) {
      const float m = wave_max(lg);
      const unsigned long long bal = __ballot(lg == m);
      const int idx = __ffsll((long long)bal) - 1;
      tv[r] = m; ti[r] = idx >> 1;
      if (lane == idx) lg = -INFINITY;
    }
    const float e1 = __expf(tv[1] - tv[0]), e2 = __expf(tv[2] - tv[0]), e3 = __expf(tv[3] - tv[0]);
    const float inv = 1.f / (1.f + e1 + e2 + e3);
    if (lane < 4) {
      const int ee = lane == 0 ? ti[0] : lane == 1 ? ti[1] : lane == 2 ? ti[2] : ti[3];
      const float ww = (lane == 0 ? 1.f : lane == 1 ? e1 : lane == 2 ? e2 : e3) * inv;
      p.aw[t * 4 + lane] = ww;
      const int rank = __hip_atomic_fetch_add(&lcnt[ee], 1, __ATOMIC_RELAXED, __HIP_MEMORY_SCOPE_WORKGROUP);
      lent[nloc * 4 + lane] = (ee << 16) | rank;
      lent[nloc * 4 + lane + 2048] = t * 4 + lane;
    }
    ++nloc;
  }
  __syncthreads();
  if (p.tid < 32) lbase[p.tid] = atomicAdd(&p.cnt[p.tid * 64 + 32 * rep], lcnt[p.tid]);
  __syncthreads();
  for (int i = lane; i < nloc * 4; i += 64) {
    const int er = lent[i], a = lent[i + 2048];
    p.elist[(er >> 16) * T_TOK + lbase[er >> 16] + (er & 0xffff)] = a;
  }
}

__device__ void ph_gather(const Params& p, LAS unsigned char* lds, int nblk, int bid) {
  const int wid = p.tid >> 6, lane = p.tid & 63;
  LAS int* tb = (LAS int*)lds;
  if (p.tid == 0) { int off = 0; for (int k = 0; k < NE; ++k) { const int c = p.cnt[k * 64]; tb[k] = off; tb[64 + k] = c; off += ((c + 255) >> 8) << 8; } tb[NE] = off; }
  __syncthreads();
  const int total = tb[NE];
  for (int r = bid * 8 + wid; r < total; r += nblk * 8) {
    int e = 0;
#pragma unroll 1
    for (int k = 1; k < NE; ++k) if (r >= tb[k]) e = k;
    const int i = r - tb[e];
    const int a = (i < tb[64 + e]) ? p.elist[e * T_TOK + i] : -1;
    if (lane == 0) p.rowmap[r] = a;
    u32x4 v0 = {0, 0, 0, 0}, v1 = v0;
    if (a >= 0) { const u32x4* src = (const u32x4*)(p.h2 + (size_t)(a >> 2) * DM); v0 = src[lane]; v1 = src[64 + lane]; }
    u32x4* dst = (u32x4*)(p.xs + (size_t)r * DM);
    dst[lane] = v0; dst[64 + lane] = v1;
  }
}

__device__ void ph_final(const Params& p, int nblk, int bid, int rep) {
  const int wid = p.tid >> 6, lane = p.tid & 63;
  for (int t0 = bid * 8 + wid; t0 < T_TOK; t0 += nblk * 16) {
    int tt[2] = {t0, t0 + nblk * 8};
    if (tt[1] >= T_TOK) tt[1] = t0;
    float mv[2][16]; float ss[2];
#pragma unroll
    for (int u = 0; u < 2; ++u) {
      const int t = tt[u];
      const f32x4 wv = *(const f32x4*)(p.aw + t * 4);
      ss[u] = 0.f;
#pragma unroll
      for (int i = 0; i < 2; ++i) {
        const bf16_t* y = p.yslot + (size_t)t * 4 * DM + i * 512 + lane * 8;
        float f0[8], f1[8], f2[8], f3[8];
        unpack8(*(const u32x4*)y, f0); unpack8(*(const u32x4*)(y + DM), f1); unpack8(*(const u32x4*)(y + 2 * DM), f2); unpack8(*(const u32x4*)(y + 3 * DM), f3);
#pragma unroll
        for (int j = 0; j < 8; ++j) { const float m = wv[0] * f0[j] + wv[1] * f1[j] + wv[2] * f2[j] + wv[3] * f3[j]; mv[u][i * 8 + j] = m; ss[u] += m * m; }
      }
    }
    f32x4 x1[2][4];
#pragma unroll
    for (int u = 0; u < 2; ++u)
#pragma unroll
      for (int i = 0; i < 2; ++i)
#pragma unroll
        for (int j4 = 0; j4 < 2; ++j4) x1[u][i * 2 + j4] = *(const f32x4*)(p.out + (size_t)tt[u] * DM + i * 512 + lane * 8 + j4 * 4);
    ss[0] = wave_sum(ss[0]); ss[1] = wave_sum(ss[1]);
#pragma unroll
    for (int u = 0; u < 2; ++u) {
      const int t = tt[u];
      if (u == 1 && t == t0) break;
      const float* md = p.mod + (t / SEQ) * 6144;
      const float rstd = rsqrtf(ss[u] * (1.f / DM) + 1e-6f);
#pragma unroll
      for (int i = 0; i < 2; ++i)
#pragma unroll
        for (int j4 = 0; j4 < 2; ++j4) {
          const int k = i * 512 + lane * 8 + j4 * 4;
          float* op = p.out + (size_t)t * DM + k;
          const f32x4 gf = *(const f32x4*)(md + 5120 + k), gp = *(const f32x4*)(p.g_post_ffn + k);
          f32x4 o;
#pragma unroll
          for (int j = 0; j < 4; ++j) o[j] = x1[u][i * 2 + j4][j] + gf[j] * (mv[u][i * 8 + j4 * 4 + j] * rstd * gp[j]);
          *(f32x4*)(rep ? (float*)p.hbf + (size_t)(t & 8191) * DM + k : op) = o;
        }
    }
  }
}

#define XCD_BAR_WORDS 3456
struct KArgs { const void* in[22]; float* out; char* ws; long long never; };
__host__ __device__ inline size_t al(size_t x) { return (x + 255) & ~(size_t)255; }
__host__ __device__ inline void fill_params(Params& p, const KArgs& k) {
  p.x = (const float*)k.in[0]; p.c = (const float*)k.in[1]; p.w_ada = (const float*)k.in[2]; p.b_ada = (const float*)k.in[3];
  p.g_pre_mix = (const float*)k.in[4]; p.g_post_mix = (const float*)k.in[5]; p.g_pre_ffn = (const float*)k.in[6];
  p.g_post_ffn = (const float*)k.in[7]; p.w_in = (const float*)k.in[8]; p.conv_w = (const float*)k.in[9];
  p.a_log = (const float*)k.in[10]; p.dt_bias = (const float*)k.in[11]; p.g_dn_out = (const float*)k.in[12];
  p.w_br_a = (const float*)k.in[13]; p.w_br_b = (const float*)k.in[14]; p.w_o = (const float*)k.in[15];
  p.w_router = (const float*)k.in[16]; p.b_router = (const float*)k.in[17]; p.w_gu = (const float*)k.in[18];
  p.b_gu = (const float*)k.in[19]; p.w_down = (const float*)k.in[20]; p.b_down = (const float*)k.in[21];
  p.out = k.out;
  char* w = k.ws;
  size_t o = 0;
#define take(bytes) (w + (o += al(bytes)) - al(bytes))
  p.mod = (float*)take(4 * 6144 * 4);
  p.cnt = (int*)take(16384);
  p.ba = (float*)take((size_t)T_TOK * 8 * 4);
  p.hbf = (bf16_t*)take((size_t)T_TOK * DM * 2);
  p.proj = (bf16_t*)take((size_t)T_TOK * PW * 2);
  p.w_in_t = (bf16_t*)take((size_t)PW * DM * 2);
  p.wgu8 = (unsigned char*)take((size_t)NE * 2048 * DM);
  p.wd8 = (unsigned char*)take((size_t)NE * 1024 * DM);
  p.h2q = (unsigned char*)take((size_t)T_TOK * DM);
  p.act8 = (unsigned char*)take((size_t)73728 * DM);
  p.wbra_t = (bf16_t*)take((size_t)1024 * 512 * 2);
  p.wbrb_t = (bf16_t*)take((size_t)1024 * 512 * 2);
  p.wo_t = (bf16_t*)take((size_t)1024 * 1024 * 2);
  p.qb = (bf16_t*)take((size_t)T_TOK * 512 * 2);
  p.kb = (bf16_t*)take((size_t)T_TOK * 512 * 2);
  p.kmean = (float*)take((size_t)16 * 16 * 128 * 4);
  p.oab = (bf16_t*)take((size_t)T_TOK * DM * 2);
  p.merged = (bf16_t*)take((size_t)T_TOK * DM * 2);
  p.mixer = (bf16_t*)take((size_t)T_TOK * DM * 2);
  p.h2 = (bf16_t*)take((size_t)T_TOK * DM * 2);
  p.elist = (int*)take((size_t)NE * T_TOK * 4);
  p.aw = (float*)take((size_t)T_TOK * 4 * 4);
  p.rowmap = (int*)take((size_t)73728 * 4);
  p.dnA = (unsigned char*)take((size_t)1024 * DN_ABYTES);
  p.dnU = (float*)take((size_t)1024 * DN_UFLOATS * 4);
  p.dnG = (float*)take(4096);
  p.oab2 = (bf16_t*)take((size_t)T_TOK * 512 * 2);
  p.dbg = (float*)take(256);
  p.bar = (unsigned*)take(XCD_BAR_WORDS * 4);
  p.dn_out = p.oab; p.dn_out_ld = DM;
  p.Kp = (bf16_t*)take((size_t)16 * 128 * 8192);
  p.Vp = (bf16_t*)take((size_t)16 * 128 * 8192);
  p.wq = p.cnt + 32 * 64;
  p.mb_out = p.oab; p.mb_out_ld = DM; p.mb_out_off = 512;
  p.xs = p.proj;
  char* big = take((size_t)73728 * DM * 2 + (size_t)65536 * DM * 2);
  p.act = (bf16_t*)big;
  p.yslot = (bf16_t*)(big + (size_t)73728 * DM * 2);
  {
    char* s = big; size_t so = 0;
#define t2(bytes) (s + (so += al(bytes)) - al(bytes))
    p.nq = (float*)t2((size_t)T_TOK * 512 * 4);
    p.nk = (float*)t2((size_t)T_TOK * 512 * 4);
    p.nv = (float*)t2((size_t)T_TOK * 512 * 4);
    p.no = (float*)t2((size_t)T_TOK * 512 * 4);
    p.ntmp = (float*)t2((size_t)T_TOK * DM * 4);
    p.nbeta = (float*)t2((size_t)T_TOK * 4 * 4);
    p.ng = (float*)t2((size_t)T_TOK * 4 * 4);
  }

#undef take
#undef t2
  p.never = (int)k.never;
}

#define XB_TMO      128
#define XB_XCNT(j)  (256  + 64 * (j))
#define XB_XSUB(j)  (1280 + 64 * (j))
#define XB_XGEN(j)  (2304 + 64 * (j))
#define XB_TOP      3328
#define XB_TOPGEN   3392
#define XB_SPIN_CAP (1u << 18)

__device__ __forceinline__ unsigned xb_ld(unsigned* p)              { return __hip_atomic_load(p, __ATOMIC_RELAXED, __HIP_MEMORY_SCOPE_AGENT); }
__device__ __forceinline__ unsigned xb_add(unsigned* p, unsigned v) { return __hip_atomic_fetch_add(p, v, __ATOMIC_RELAXED, __HIP_MEMORY_SCOPE_AGENT); }
__device__ __forceinline__ unsigned xb_xcc_id() { return (unsigned)__builtin_amdgcn_s_getreg((3 << 11) | 20) & 0xFu; }
#define XB_SPIN(cond, bar) do { unsigned _sp = 0; while (cond) { __builtin_amdgcn_s_sleep(1); \
    if ((++_sp & 255u) == 0u) { if (xb_ld(&(bar)[XB_TMO])) break; if (_sp > XB_SPIN_CAP) { atomicAdd(&(bar)[XB_TMO], 1u); break; } } } } while (0)

struct XcdBarrier {
    unsigned* bar; unsigned x;
    volatile LAS unsigned* st;
};

__device__ __forceinline__ XcdBarrier xcd_barrier_post(unsigned* bar, volatile LAS unsigned* st) {
    XcdBarrier b; b.bar = bar; b.x = xb_xcc_id(); b.st = st;
    if (threadIdx.x == 0) (void)xb_add(&bar[XB_XCNT(b.x)], 1u);
    return b;
}
__device__ __forceinline__ void xcd_barrier_complete(unsigned* bar, unsigned x, unsigned& nloc, unsigned& nx) {
    const unsigned G = gridDim.x * gridDim.y * gridDim.z;
    unsigned sum, cnt, mine, sp = 0u;
    for (;;) {
        sum = 0u; cnt = 0u; mine = 0u;
#pragma unroll
        for (unsigned j = 0; j < 16; ++j) { const unsigned c = xb_ld(&bar[XB_XCNT(j)]); sum += c; cnt += (c > 0u) ? 1u : 0u; mine = (j == x) ? c : mine; }
        if (sum == G) break;
        __builtin_amdgcn_s_sleep(1);
        if ((++sp & 255u) == 0u) { if (xb_ld(&bar[XB_TMO])) break; if (sp > XB_SPIN_CAP) { atomicAdd(&bar[XB_TMO], 1u); break; } }
    }
    nloc = mine > 0u ? mine : 1u; nx = cnt > 0u ? cnt : 1u;
}

__device__ __forceinline__ void xcd_barrier(const XcdBarrier& b, const int tid) {
    asm volatile("s_waitcnt vmcnt(0)" ::: "memory");
    __syncthreads();
    if (tid == 0) {
        unsigned* bar = b.bar;
        __builtin_amdgcn_s_waitcnt(0);
        unsigned nloc = b.st[0], nx = b.st[1];
        if (nloc == 0u) { xcd_barrier_complete(bar, b.x, nloc, nx); b.st[0] = nloc; b.st[1] = nx; }
        const unsigned old = xb_add(&bar[XB_XSUB(b.x)], 1u);
        const unsigned gen = old / nloc;
        if (old + 1u == (gen + 1u) * nloc) {
            __builtin_amdgcn_fence(__ATOMIC_RELEASE, "agent");
            asm volatile("s_waitcnt vmcnt(0)" ::: "memory");
            const unsigned og = xb_add(&bar[XB_TOP], 1u);
            const unsigned tg = og / nx;
            if (og + 1u == (tg + 1u) * nx) xb_add(&bar[XB_TOPGEN], 1u);
            else XB_SPIN(xb_ld(&bar[XB_TOPGEN]) == tg, bar);
            __builtin_amdgcn_fence(__ATOMIC_ACQUIRE, "agent");
            xb_add(&bar[XB_XGEN(b.x)], 1u);
            asm volatile("s_waitcnt vmcnt(0)" ::: "memory");
        } else {
            XB_SPIN(xb_ld(&bar[XB_XGEN(b.x)]) == gen, bar);
            __builtin_amdgcn_fence(__ATOMIC_ACQUIRE, "agent");
            asm volatile("s_waitcnt vmcnt(0)" ::: "memory");
        }
    }
    __syncthreads();
}


__device__ __forceinline__ void load_ka(KArgs& kk) {
#if defined(__HIP_DEVICE_COMPILE__)
  typedef __attribute__((address_space(1))) char* gptr_t;
  typedef const __attribute__((address_space(4))) gptr_t* kptr_t;
  kptr_t kp = (kptr_t)__builtin_amdgcn_kernarg_segment_ptr();
  asm volatile("" : "+s"(kp));
#pragma unroll
  for (int i = 0; i < 22; ++i) kk.in[i] = (const void*)kp[i];
  kk.out = (float*)kp[22];
  kk.ws = (char*)kp[23];
  kk.never = ((const __attribute__((address_space(4))) long long*)kp)[24];
#endif
}
__device__ __forceinline__ void grid_bar(const Params& p, LAS unsigned char* lds);
#define MEGA_LDS 148480
#define MEGA_LDS_ALLOC (MEGA_LDS + 16)
__device__ __forceinline__ void grid_bar(const Params& p, LAS unsigned char* lds) {
  XcdBarrier b; b.bar = p.bar; b.x = xb_xcc_id(); b.st = (volatile LAS unsigned*)(lds + MEGA_LDS);
  xcd_barrier(b, p.tid);
}
__global__ __launch_bounds__(512) void mega(KArgs ka) {
  extern __shared__ __attribute__((aligned(16))) unsigned char shm[];
  LAS unsigned char* lds = (LAS unsigned char*)shm;
  cg::grid_group grid = cg::this_grid();
  const int nblk = gridDim.x, bid = blockIdx.x;
  const int wv_ = __builtin_amdgcn_readfirstlane(threadIdx.x >> 6);
  volatile LAS unsigned* xst = (volatile LAS unsigned*)(lds + MEGA_LDS);
  if (threadIdx.x == 0) { xst[0] = 0u; xst[1] = 0u; xst[2] = 0u; xst[3] = 0u; }
  __syncthreads();
  { Params p0; fill_params(p0, ka); (void)xcd_barrier_post(p0.bar, xst); }
  if (ka.never) grid.sync();
#ifndef REPMASK
#define REPMASK 0
#endif
#define LOADKA KArgs kk; load_ka(kk)
#ifndef PHMASK
#define PHMASK 0xffff
#endif
#define PHASE(k, body) if (((PHMASK) >> (k)) & 1) for (int rep_ = 0; rep_ < (((REPMASK) >> (k)) & 1) + 1; ++rep_) { \
    LOADKA; Params p; fill_params(p, kk); { int t_; asm volatile("v_mbcnt_lo_u32_b32 %0, -1, 0\n\tv_mbcnt_hi_u32_b32 %0, -1, %0" : "=v"(t_)); p.tid = (wv_ << 6) | t_; } body; grid_bar(p, lds); }
#ifdef XBAR
  for (int xb_ = 0; xb_ < XBAR; ++xb_) { PHASE(15, {}) }
#endif
  PHASE(0, { ph_mod(p, lds, nblk, bid); ph_wt(p, lds, nblk, bid); })
  PHASE(1, { ph_h(p, lds, nblk, bid); })
  PHASE(2, { ph_proj(p, lds, nblk, bid); })
  PHASE(3, { bool first = true; for (int ci = bid; ci < 1024; ci += nblk) { dn_prep_chunk(p, lds, ci, first); first = false; }
             for (int item = bid; item < 256; item += nblk) moba_prep_block(p, lds, item); })
  PHASE(4, { if (bid < 32) dn_scan_blk(p, lds, bid); moba_worker(p, lds, rep_); })
  PHASE(5, { ph_dn_norm(p, nblk, bid); })
  PHASE(6, { ph_br(p, lds, nblk, bid); })
  PHASE(7, { ph_mix(p, lds, nblk, bid); })
  PHASE(8, { ph_post_mix(p, lds, nblk, bid, rep_); })
  PHASE(10, { ph_moe1(p, lds, nblk, bid); })
  PHASE(11, { ph_moe2(p, lds, nblk, bid); })
  PHASE(12, { ph_final(p, nblk, bid, rep_); })
}


extern "C" void kernel_launch(void* const* d_in, const int* in_sizes, int n_in, void* d_out, int out_size, void* d_ws,
                              size_t ws_size, hipStream_t stream) {
  KArgs ka{};
  for (int i = 0; i < 22; ++i) ka.in[i] = d_in[i];
  ka.out = (float*)d_out; ka.ws = (char*)d_ws; ka.never = 0;
  Params p{};
  fill_params(p, ka);
  static int grid_blocks = 0;
  if (!grid_blocks) {
    (void)hipFuncSetAttribute((const void*)mega, hipFuncAttributeMaxDynamicSharedMemorySize, MEGA_LDS_ALLOC);
    int dev = 0, cus = 0, per_cu = 0;
    (void)hipGetDevice(&dev);
    (void)hipDeviceGetAttribute(&cus, hipDeviceAttributeMultiprocessorCount, dev);
    (void)hipOccupancyMaxActiveBlocksPerMultiprocessor(&per_cu, mega, 512, MEGA_LDS_ALLOC);
    if (per_cu != 1) per_cu = 1;
    grid_blocks = cus * per_cu;
  }
  (void)hipMemsetAsync(p.cnt, 0, 16384, stream);
  (void)hipMemsetAsync(p.bar, 0, XCD_BAR_WORDS * 4, stream);
  void* args[] = {&ka};
  hipError_t e = hipLaunchCooperativeKernel((void*)mega, dim3(grid_blocks), dim3(512), args, MEGA_LDS_ALLOC, stream);
  if (e != hipSuccess) fprintf(stderr, "cooperative launch failed: %s (grid %d)\n", hipGetErrorString(e), grid_blocks);
}
```

```cpp
#include <hip/hip_runtime.h>
#include <hip/hip_cooperative_groups.h>
#include <cstdio>
namespace cg = cooperative_groups;
#include <stdint.h>

typedef unsigned short bf16_t;
#ifndef MB_ABL
#define MB_ABL 0
#endif

#define T_TOK 16384
#define SEQ 4096
#define NB 4
#define DM 1024
#define INW 5640
#define PW 5632
#define C_QA 0
#define C_KA 512
#define C_VA 1024
#define C_Z 1536
#define C_MQ 2048
#define C_MK 2560
#define C_MV 3072
#define C_GA 3584
#define C_GB 4608
#define NE 32

__device__ __forceinline__ bf16_t f2bf(float f) {
  unsigned u = __float_as_uint(f);
  u += 0x7fffu + ((u >> 16) & 1u);
  return (bf16_t)(u >> 16);
}
__device__ __forceinline__ float bf2f(bf16_t h) { return __uint_as_float(((unsigned)h) << 16); }
__device__ __forceinline__ float sigmoidf_(float x) { return __builtin_amdgcn_rcpf(1.f + __builtin_amdgcn_exp2f(-1.4426950408889634f * x)); }
__device__ __forceinline__ float siluf_(float x) { return x * sigmoidf_(x); }
__device__ __forceinline__ float wave_sum(float v) {
#pragma unroll
  for (int o = 32; o > 0; o >>= 1) v += __shfl_xor(v, o, 64);
  return v;
}
__device__ __forceinline__ float wave_max(float v) {
#pragma unroll
  for (int o = 32; o > 0; o >>= 1) v = fmaxf(v, __shfl_xor(v, o, 64));
  return v;
}

typedef unsigned u32x2 __attribute__((ext_vector_type(2)));
typedef __bf16 bf16x2_t __attribute__((ext_vector_type(2)));
typedef float f32x2_t __attribute__((ext_vector_type(2)));
__device__ __forceinline__ unsigned pk2(float a, float b) { f32x2_t v = {a, b}; bf16x2_t r = __builtin_convertvector(v, bf16x2_t); return __builtin_bit_cast(unsigned, r); }

__device__ __forceinline__ unsigned pk4_fp8(float a, float b, float c, float d) {
  int w = 0;
  w = __builtin_amdgcn_cvt_pk_fp8_f32(a, b, w, false);
  w = __builtin_amdgcn_cvt_pk_fp8_f32(c, d, w, true);
  return (unsigned)w;
}

struct Params {
  const float *x, *c, *w_ada, *b_ada, *g_pre_mix, *g_post_mix, *g_pre_ffn, *g_post_ffn, *w_in, *conv_w,
      *a_log, *dt_bias, *g_dn_out, *w_br_a, *w_br_b, *w_o, *w_router, *b_router, *w_gu, *b_gu, *w_down, *b_down;
  float* out;
  float* mod;
  int* cnt;
  float* ba;
  bf16_t* hbf;
  bf16_t* proj;
  bf16_t* w_in_t;
  unsigned char* wgu8;
  unsigned char* wd8;
  unsigned char* h2q;
  unsigned char* act8;
  bf16_t* wbra_t;
  bf16_t* wbrb_t;
  bf16_t* wo_t;
  bf16_t* qb;
  bf16_t* kb;
  float* kmean;
  bf16_t* oab;
  bf16_t* merged;
  bf16_t* mixer;
  bf16_t* h2;
  int* elist;
  float* aw;
  bf16_t* act;
  bf16_t* xs;
  int* rowmap;
  bf16_t* yslot;
  unsigned char* dnA; float* dnU; float* dnG;
  bf16_t* dn_out; int dn_out_ld;
  bf16_t* oab2; float* dbg;
  unsigned* bar; int never; int tid;
  bf16_t* Kp; bf16_t* Vp; int* wq;
  bf16_t* mb_out; int mb_out_ld; int mb_out_off;
  float* nq; float* nk; float* nv;
  float* nbeta; float* ng;
  float* no;
  float* ntmp;
};

__device__ __forceinline__ int map_col(int n, int mode) {
  if (mode == 0) return n;
  if (mode == 1) return n < 2048 ? n : (n < 2056 ? -1 : n - 8);
  if (n < 1024) return (n >> 7) * 256 + (n & 127);
  int j = n - 1024;
  return (j >> 7) * 256 + 128 + (j & 127);
}
namespace pg8 {
#define PG8_LAS __attribute__((address_space(3)))
typedef short bf16x8 __attribute__((ext_vector_type(8)));
typedef float f32x4 __attribute__((ext_vector_type(4)));
typedef unsigned u32x4 __attribute__((ext_vector_type(4)));
constexpr int BM = 256, BK = 64, HALF = 128, HTB = HALF * BK * 2, STAGE_BYTES = 8 * HTB, NXCD = 8, WGM = 8;

__host__ __device__ __forceinline__ int lds_byte(int r, int c) { const int st = (r >> 4) * 2 + (c >> 5), rr = r & 15, cc = c & 31, ob = rr * 64 + cc * 2; return st * 1024 + (ob ^ (((ob >> 9) & 1) << 5)); }
__host__ __device__ __forceinline__ void stage_rc(int b, int& R, int& C) { const int st = b / 1024, sb = b % 1024, swz = sb ^ (((sb >> 9) & 1) << 5); R = (st >> 1) * 16 + swz / 64; C = (st & 1) * 32 + (swz % 64) / 2; }
__host__ __device__ __forceinline__ int perm32(int rho) { const int n = rho >> 4, i = rho & 15; return 8 * (i >> 2) + 4 * n + (i & 3); }

struct Unit { int pm, pn, z; };
__device__ __forceinline__ unsigned cvt_pk_bf16(float lo, float hi) { unsigned r; asm volatile("v_cvt_pk_bf16_f32 %0, %1, %2" : "=v"(r) : "v"(lo), "v"(hi)); return r; }

typedef int i32x8 __attribute__((ext_vector_type(8)));
typedef int i32x4 __attribute__((ext_vector_type(4)));
__device__ __forceinline__ i32x8 cat8(const bf16x8 lo, const bf16x8 hi) { const i32x4 a = __builtin_bit_cast(i32x4, lo), b = __builtin_bit_cast(i32x4, hi); return __builtin_shufflevector(a, b, 0, 1, 2, 3, 4, 5, 6, 7); }
struct TileOrder {
    int nM, nN, nwg, G, c;
    __device__ void init(int nM_, int nN_, int G_, int c_) { nM = nM_; nN = nN_; nwg = nM * nN; G = G_; c = c_; }
    __device__ bool tile(int i, int& pm, int& pn) const {
        const long L = (long)i * G + c; if (L >= nwg) return false;
        int wgid = (int)L; { const int q = nwg / NXCD, r = nwg % NXCD, xcd = wgid % NXCD, off = wgid / NXCD; wgid = (xcd < r ? xcd * (q + 1) : r * (q + 1) + (xcd - r) * q) + off; }
        const int nig = WGM * nN, gid = wgid / nig, fm = gid * WGM, gsz = (nM - fm) < WGM ? (nM - fm) : WGM;
        pm = fm + ((wgid % nig) % gsz); pn = (wgid % nig) / gsz; return true;
    }
};

template <class Epi, class Sched, bool FP8 = false>
__device__ __forceinline__ void gemm_phase(PG8_LAS unsigned char* lds, const int tid, const int lda, const int ldb, const int K, const Sched& S, const Epi& E) {
    const int wid = __builtin_amdgcn_readfirstlane(tid >> 6), lane = tid & 63, wr = wid >> 2, wc = wid & 3, fr = lane & 15, fq = lane >> 4;
    const int nt = K / BK;
    unsigned voffA[2], voffB[2];
#pragma unroll
    for (int i = 0; i < 2; ++i) { int R, C; stage_rc(tid * 16 + i * 8192, R, C); const int Rb = Epi::PERM ? ((R & ~31) + perm32(R & 31)) : R;
        voffA[i] = (unsigned)(R * lda + C) * 2u; voffB[i] = (unsigned)(Rb * ldb + C) * 2u; }
    const size_t kstep = (size_t)(BK * 2);
    const size_t hstepA = (size_t)HALF * lda * 2, hstepB = (size_t)HALF * ldb * 2;
    const unsigned ldsw = (unsigned)wid * 1024u;
    const int aoff = lds_byte(wr * 64 + fr, fq * 8), boff = lds_byte(wc * 32 + fr, fq * 8);
    constexpr int KOFF1 = 1024;
    unsigned gA[2][2] = {{0u, 0u}, {0u, 0u}}, gAn[2][2] = {{0u, 0u}, {0u, 0u}};
#define PG8_GOFFS(dst, unit) do { int t_ = tid; asm volatile("" : "+v"(t_)); _Pragma("unroll") for (int i_ = 0; i_ < 2; ++i_) { int gR_, gC_; stage_rc(t_ * 16 + i_ * 8192, gR_, gC_); \
        _Pragma("unroll") for (int h_ = 0; h_ < 2; ++h_) dst[h_][i_] = S.a_goff(unit, gR_ + 128 * h_, gC_); } } while (0)
#define PG8_SA(b, h) (((b) * 2 + (h)) * HTB)
#define PG8_SB(b, h) ((4 + (b) * 2 + (h)) * HTB)
#define PG8_STAGE(bufoff, gbase, voff) do { _Pragma("unroll") for (int _i = 0; _i < 2; ++_i) \
        __builtin_amdgcn_global_load_lds((const unsigned*)((const char*)(gbase) + (voff)[_i]), (PG8_LAS unsigned*)(lds + (bufoff) + ldsw + _i * 8192), 16, 0, 0); } while (0)
#define PG8_STAGEA(bufoff, ptr, h, nx) do { if constexpr (Sched::GATHER) { const unsigned gs_[2] = {(nx) ? gAn[h][0] : gA[h][0], (nx) ? gAn[h][1] : gA[h][1]}; PG8_STAGE(bufoff, ptr, gs_); } \
        else { PG8_STAGE(bufoff, (ptr) + (h) * hstepA, voffA); } } while (0)
#define PG8_LDA(dst, b, h) do { if constexpr (FP8) { _Pragma("unroll") for (int m = 0; m < 4; ++m) dst##8[m] = cat8(*(const PG8_LAS bf16x8*)(lds + PG8_SA(b, h) + aoff + m * 2048), *(const PG8_LAS bf16x8*)(lds + PG8_SA(b, h) + aoff + KOFF1 + m * 2048)); } \
        else { _Pragma("unroll") for (int m = 0; m < 4; ++m) _Pragma("unroll") for (int k = 0; k < 2; ++k) dst[m][k] = *(const PG8_LAS bf16x8*)(lds + PG8_SA(b, h) + aoff + k * KOFF1 + m * 2048); } } while (0)
#define PG8_LDB(dst, b, h) do { if constexpr (FP8) { _Pragma("unroll") for (int n = 0; n < 2; ++n) dst##8[n] = cat8(*(const PG8_LAS bf16x8*)(lds + PG8_SB(b, h) + boff + n * 2048), *(const PG8_LAS bf16x8*)(lds + PG8_SB(b, h) + boff + KOFF1 + n * 2048)); } \
        else { _Pragma("unroll") for (int n = 0; n < 2; ++n) _Pragma("unroll") for (int k = 0; k < 2; ++k) dst[n][k] = *(const PG8_LAS bf16x8*)(lds + PG8_SB(b, h) + boff + k * KOFF1 + n * 2048); } } while (0)
#define PG8_MMA(ai, bj, At, Bt) do { __builtin_amdgcn_s_setprio(1); if constexpr (FP8) { _Pragma("unroll") for (int m = 0; m < 4; ++m) _Pragma("unroll") for (int n = 0; n < 2; ++n) \
        asm volatile("v_mfma_scale_f32_16x16x128_f8f6f4 %0, %1, %2, %0, %3, %4 op_sel_hi:[0,0,0]" : "+v"(acc[ai][bj][m][n]) : "v"(Bt##8[n]), "v"(At##8[m]), "v"(sclB), "v"(sclA)); } \
        else { _Pragma("unroll") for (int m = 0; m < 4; ++m) _Pragma("unroll") for (int n = 0; n < 2; ++n) _Pragma("unroll") for (int k = 0; k < 2; ++k) \
        acc[ai][bj][m][n] = __builtin_amdgcn_mfma_f32_16x16x32_bf16(Bt[n][k], At[m][k], acc[ai][bj][m][n], 0, 0, 0); } __builtin_amdgcn_s_setprio(0); } while (0)
#define PG8_WAIT_V(n) asm volatile("s_waitcnt vmcnt(" #n ")" ::: "memory")
#define PG8_WAIT_L(n) asm volatile("s_waitcnt lgkmcnt(" #n ")" ::: "memory")
#define PG8_BAR __builtin_amdgcn_s_barrier()
#define PG8_SCHED __builtin_amdgcn_sched_barrier(0)
    Unit cur, nxt; int ui = 0;
    if (!S.next(0, cur)) return;
    f32x4 acc[2][2][4][2];
#pragma unroll
    for (int a = 0; a < 2; ++a)
#pragma unroll
        for (int b = 0; b < 2; ++b)
#pragma unroll
            for (int m = 0; m < 4; ++m)
#pragma unroll
                for (int n = 0; n < 2; ++n) acc[a][b][m][n] = (f32x4){0.f, 0.f, 0.f, 0.f};
    bf16x8 At[4][2], B0[2][2], B1[2][2];
    i32x8 At8[4], B08[2], B18[2];
    int sclA = 0x7f7f7f7f, sclB = 0x79797979;
    const char* cA = S.a_ptr(cur); const char* cB = S.b_ptr(cur);
    if constexpr (Sched::GATHER) { PG8_GOFFS(gA, cur); }
    PG8_STAGE(PG8_SB(0, 0), cB, voffB); PG8_STAGEA(PG8_SA(0, 0), cA, 0, false); PG8_STAGE(PG8_SB(0, 1), cB + hstepB, voffB); PG8_STAGEA(PG8_SA(0, 1), cA, 1, false);
    if (wr == 1) PG8_BAR;
    PG8_WAIT_V(4); PG8_BAR;
    PG8_STAGE(PG8_SB(1, 0), cB + kstep, voffB); PG8_STAGEA(PG8_SA(1, 0), cA + kstep, 0, false); PG8_STAGE(PG8_SB(1, 1), cB + hstepB + kstep, voffB);
    PG8_WAIT_V(6); PG8_BAR;
    for (;;) {
        const bool has_next = S.next(ui + 1, nxt);
        const char* nA = has_next ? S.a_ptr(nxt) : cA; const char* nB = has_next ? S.b_ptr(nxt) : cB;
        if constexpr (Sched::GATHER) { if (has_next) { PG8_GOFFS(gAn, nxt); } else {
_Pragma("unroll") for (int h = 0; h < 2; ++h) _Pragma("unroll") for (int i = 0; i < 2; ++i) gAn[h][i] = gA[h][i]; } }
_Pragma("unroll 1")
        for (int t = 0; t < nt; t += 2) {
            const bool last = (t == nt - 2);
            const char* a1 = cA + (size_t)(t + 1) * kstep;
            const char* a2 = last ? nA : cA + (size_t)(t + 2) * kstep; const char* b2 = last ? nB : cB + (size_t)(t + 2) * kstep;
            const char* a3 = a2 + kstep; const char* b3 = b2 + kstep;
            PG8_LDB(B0, 0, 0); PG8_SCHED; PG8_LDA(At, 0, 0); PG8_STAGEA(PG8_SA(1, 1), a1, 1, false);
            PG8_WAIT_L(8); PG8_BAR; PG8_WAIT_L(0); PG8_MMA(0, 0, At, B0); PG8_BAR; PG8_SCHED;
            PG8_LDB(B1, 0, 1); PG8_STAGE(PG8_SB(0, 0), b2, voffB);
            PG8_BAR; PG8_WAIT_L(0); PG8_MMA(0, 1, At, B1); PG8_BAR;
            PG8_LDA(At, 0, 1); PG8_STAGEA(PG8_SA(0, 0), a2, 0, last);
            PG8_BAR; PG8_WAIT_L(0); PG8_MMA(1, 0, At, B0); PG8_BAR; PG8_SCHED;
            PG8_STAGE(PG8_SB(0, 1), b2 + hstepB, voffB);
            PG8_WAIT_V(6); PG8_BAR; PG8_MMA(1, 1, At, B1); PG8_BAR;
            PG8_LDB(B0, 1, 0); PG8_SCHED; PG8_LDA(At, 1, 0); PG8_STAGEA(PG8_SA(0, 1), a2, 1, last);
            PG8_WAIT_L(8); PG8_BAR; PG8_WAIT_L(0); PG8_MMA(0, 0, At, B0); PG8_BAR; PG8_SCHED;
            PG8_LDB(B1, 1, 1); PG8_STAGE(PG8_SB(1, 0), b3, voffB);
            PG8_BAR; PG8_WAIT_L(0); PG8_MMA(0, 1, At, B1); PG8_BAR;
            PG8_LDA(At, 1, 1); PG8_STAGEA(PG8_SA(1, 0), a3, 0, last);
            PG8_BAR; PG8_WAIT_L(0); PG8_MMA(1, 0, At, B0); PG8_BAR; PG8_SCHED;
            PG8_STAGE(PG8_SB(1, 1), b3 + hstepB, voffB);
            PG8_WAIT_V(6); PG8_BAR; PG8_MMA(1, 1, At, B1); PG8_BAR;
        }
        { if constexpr (FP8) asm volatile("s_nop 15\n\ts_nop 3" ::: "memory");
          int t_ = tid; asm volatile("" : "+v"(t_));
          E(acc, cur, wr, wc, t_ & 15, (t_ & 63) >> 4); }
        if (!has_next) break;
#pragma unroll
        for (int a = 0; a < 2; ++a)
#pragma unroll
            for (int b = 0; b < 2; ++b)
#pragma unroll
                for (int m = 0; m < 4; ++m)
#pragma unroll
                    for (int n = 0; n < 2; ++n) acc[a][b][m][n] = (f32x4){0.f, 0.f, 0.f, 0.f};
        cur = nxt; cA = nA; cB = nB; ++ui;
        if constexpr (Sched::GATHER) {
_Pragma("unroll") for (int h = 0; h < 2; ++h) _Pragma("unroll") for (int i = 0; i < 2; ++i) gA[h][i] = gAn[h][i]; }
    }
    PG8_WAIT_V(0);
    if (wr == 0) PG8_BAR;
    PG8_BAR;
#undef PG8_SA
#undef PG8_SB
#undef PG8_STAGE
#undef PG8_STAGEA
#undef PG8_GOFFS
#undef PG8_LDA
#undef PG8_LDB
#undef PG8_MMA
#undef PG8_WAIT_V
#undef PG8_WAIT_L
#undef PG8_BAR
#undef PG8_SCHED
}
}
using pg8::f32x4; using pg8::u32x4; using pg8::Unit;

#define GEMM_LDS (pg8::STAGE_BYTES + 1024)

struct SchedProj : pg8::TileOrder {
  static constexpr bool GATHER = false;
  const char* A; const char* B;
  __device__ bool next(int i, Unit& u) const { u.z = 0; return tile(i, u.pm, u.pn); }
  __device__ const char* a_ptr(const Unit& u) const { return A + (size_t)u.pm * 256 * DM * 2; }
  __device__ const char* b_ptr(const Unit& u) const { return B + (size_t)u.pn * 256 * DM * 2; }
};
struct EpiProj {
  static constexpr bool PERM = true;
  bf16_t* O;
  __device__ __forceinline__ void operator()(const f32x4 (&acc)[2][2][4][2], const Unit& u, int wr, int wc, int fr, int fq) const {
    const int row0 = u.pm * 256 + wr * 64 + fr, col0 = u.pn * 256 + wc * 32 + 8 * fq;
    const bool gate = u.pn >= (C_GA / 256);
#pragma unroll
    for (int ai = 0; ai < 2; ++ai)
#pragma unroll
      for (int m = 0; m < 4; ++m) {
        bf16_t* rowp = O + (size_t)(row0 + ai * 128 + m * 16) * PW + col0;
#pragma unroll
        for (int bj = 0; bj < 2; ++bj) {
          f32x4 v0 = acc[ai][bj][m][0], v1 = acc[ai][bj][m][1];
          if (gate) {
#pragma unroll
            for (int j = 0; j < 4; ++j) { v0[j] = sigmoidf_(v0[j]); v1[j] = sigmoidf_(v1[j]); }
          }
          u32x4 w; w.x = pg8::cvt_pk_bf16(v0[0], v0[1]); w.y = pg8::cvt_pk_bf16(v0[2], v0[3]); w.z = pg8::cvt_pk_bf16(v1[0], v1[1]); w.w = pg8::cvt_pk_bf16(v1[2], v1[3]);
          *(u32x4*)(rowp + bj * 128) = w;
        }
      }
  }
};
__device__ void ph_proj(const Params& p, PG8_LAS unsigned char* lds, int nblk, int bid) {
  SchedProj S; S.init(T_TOK / 256, PW / 256, nblk, bid); S.A = (const char*)p.hbf; S.B = (const char*)p.w_in_t;
  EpiProj E{p.proj};
  pg8::gemm_phase(lds, p.tid, DM, DM, DM, S, E);
}

struct SchedBr : pg8::TileOrder {
  static constexpr bool GATHER = false;
  const char* A; const char* Ba; const char* Bb;
  __device__ bool next(int i, Unit& u) const { u.z = i & 1; return tile(i >> 1, u.pm, u.pn); }
  __device__ const char* a_ptr(const Unit& u) const { return A + (size_t)u.pm * 256 * DM * 2 + u.z * 512 * 2; }
  __device__ const char* b_ptr(const Unit& u) const { return (u.z ? Bb : Ba) + (size_t)u.pn * 256 * 512 * 2; }
};
__device__ __forceinline__ void unpack8(const u32x4 w, float (&f)[8]) {
  f[0] = __uint_as_float(w.x << 16); f[1] = __uint_as_float(w.x & 0xffff0000u); f[2] = __uint_as_float(w.y << 16); f[3] = __uint_as_float(w.y & 0xffff0000u);
  f[4] = __uint_as_float(w.z << 16); f[5] = __uint_as_float(w.z & 0xffff0000u); f[6] = __uint_as_float(w.w << 16); f[7] = __uint_as_float(w.w & 0xffff0000u);
}
struct EpiBr {
  static constexpr bool PERM = true;
  const bf16_t* proj; bf16_t* O;
  __device__ __forceinline__ void operator()(const f32x4 (&acc)[2][2][4][2], const Unit& u, int wr, int wc, int fr, int fq) const {
    const int row0 = u.pm * 256 + wr * 64 + fr, col0 = u.pn * 256 + wc * 32 + 8 * fq;
    const int gcol = (u.z ? C_GB : C_GA) + col0;
#pragma unroll
    for (int ai = 0; ai < 2; ++ai) {
      u32x4 gv[4][2], pv[4][2];
#pragma unroll
      for (int m = 0; m < 4; ++m)
#pragma unroll
        for (int bj = 0; bj < 2; ++bj) {
          const size_t row = (size_t)(row0 + ai * 128 + m * 16);
          gv[m][bj] = *(const u32x4*)(proj + row * PW + gcol + bj * 128);
          pv[m][bj] = (u32x4){0u, 0u, 0u, 0u};
          if (u.z) pv[m][bj] = *(const u32x4*)(O + row * DM + col0 + bj * 128);
        }
#pragma unroll
      for (int m = 0; m < 4; ++m)
#pragma unroll
        for (int bj = 0; bj < 2; ++bj) {
          const size_t row = (size_t)(row0 + ai * 128 + m * 16);
          float g[8], pf[8]; unpack8(gv[m][bj], g); unpack8(pv[m][bj], pf);
          const f32x4 v0 = acc[ai][bj][m][0], v1 = acc[ai][bj][m][1];
          float r[8];
#pragma unroll
          for (int j = 0; j < 4; ++j) { r[j] = v0[j] * g[j] + pf[j]; r[4 + j] = v1[j] * g[4 + j] + pf[4 + j]; }
          u32x4 w; w.x = pk2(r[0], r[1]); w.y = pk2(r[2], r[3]); w.z = pk2(r[4], r[5]); w.w = pk2(r[6], r[7]);
          *(u32x4*)(O + row * DM + col0 + bj * 128) = w;
        }
    }
  }
};
__device__ void ph_br(const Params& p, PG8_LAS unsigned char* lds, int nblk, int bid) {
  SchedBr S; S.init(T_TOK / 256, DM / 256, nblk, bid); S.A = (const char*)p.oab; S.Ba = (const char*)p.wbra_t; S.Bb = (const char*)p.wbrb_t;
  EpiBr E{p.proj, p.merged};
  pg8::gemm_phase(lds, p.tid, DM, 512, 512, S, E);
}

struct SchedMix : pg8::TileOrder {
  static constexpr bool GATHER = false;
  const char* A; const char* B;
  __device__ bool next(int i, Unit& u) const { u.z = 0; return tile(i, u.pm, u.pn); }
  __device__ const char* a_ptr(const Unit& u) const { return A + (size_t)u.pm * 256 * DM * 2; }
  __device__ const char* b_ptr(const Unit& u) const { return B + (size_t)u.pn * 256 * DM * 2; }
};
struct EpiMix {
  static constexpr bool PERM = true;
  bf16_t* O;
  __device__ __forceinline__ void operator()(const f32x4 (&acc)[2][2][4][2], const Unit& u, int wr, int wc, int fr, int fq) const {
    const int row0 = u.pm * 256 + wr * 64 + fr, col0 = u.pn * 256 + wc * 32 + 8 * fq;
#pragma unroll
    for (int ai = 0; ai < 2; ++ai)
#pragma unroll
      for (int m = 0; m < 4; ++m) {
        bf16_t* rowp = O + (size_t)(row0 + ai * 128 + m * 16) * DM + col0;
#pragma unroll
        for (int bj = 0; bj < 2; ++bj) {
          const f32x4 v0 = acc[ai][bj][m][0], v1 = acc[ai][bj][m][1];
          u32x4 w; w.x = pg8::cvt_pk_bf16(v0[0], v0[1]); w.y = pg8::cvt_pk_bf16(v0[2], v0[3]); w.z = pg8::cvt_pk_bf16(v1[0], v1[1]); w.w = pg8::cvt_pk_bf16(v1[2], v1[3]);
          *(u32x4*)(rowp + bj * 128) = w;
        }
      }
  }
};
__device__ void ph_mix(const Params& p, PG8_LAS unsigned char* lds, int nblk, int bid) {
  SchedMix S; S.init(T_TOK / 256, DM / 256, nblk, bid); S.A = (const char*)p.merged; S.B = (const char*)p.wo_t;
  EpiMix E{p.mixer};
  pg8::gemm_phase(lds, p.tid, DM, DM, DM, S, E);
}

template <bool GATH>
struct SchedMoe {
  static constexpr bool GATHER = GATH;
  const PG8_LAS int* tb; int NT; int G, c; int nwg;
  const char* A; const char* B; size_t bexp;
  const int* elist; int rowb;
  __device__ bool next(int i, Unit& u) const {
    const long L = (long)i * G + c; if (L >= nwg) return false;
    int wgid = (int)L; { const int q = nwg / 8, r = nwg % 8, xcd = wgid % 8, off = wgid / 8; wgid = (xcd < r ? xcd * (q + 1) : r * (q + 1) + (xcd - r) * q) + off; }
    int e = 0;
#pragma unroll
    for (int st = 16; st >= 1; st >>= 1) if (wgid >= tb[e + st]) e += st;
    const int q = wgid - tb[e]; const int tiles = tb[33 + e + 1] - tb[33 + e];
    u.pm = tb[33 + e] + q % tiles; u.pn = q / tiles; u.z = e; return true;
  }
  __device__ const char* a_ptr(const Unit& u) const { return GATH ? A : A + (size_t)u.pm * 256 * rowb; }
  __device__ const char* b_ptr(const Unit& u) const { return B + (size_t)u.z * bexp + (size_t)u.pn * 256 * rowb; }
  __device__ unsigned a_goff(const Unit& u, int tr, int C) const {
    const int i = (u.pm - tb[33 + u.z]) * 256 + tr;
    int tok = 0;
    if (i < tb[66 + u.z]) tok = elist[u.z * T_TOK + i] >> 2;
    return (unsigned)(tok * rowb + C * 2);
  }
};
__device__ __forceinline__ void moe_table(const Params& p, PG8_LAS int* tb, int NT) {
  if (p.tid == 0) {
    int ub = 0, tbp = 0;
    for (int e = 0; e < NE; ++e) { const int c = p.cnt[e * 64]; tb[e] = ub; tb[33 + e] = tbp; tb[66 + e] = c; const int t = (c + 255) >> 8; ub += t * NT; tbp += t; }
    tb[NE] = ub; tb[33 + NE] = tbp;
  }
  __syncthreads();
}
struct EpiMoe1 {
  static constexpr bool PERM = true;
  const float* b_gu; unsigned char* act;
  __device__ __forceinline__ void operator()(f32x4 (&acc)[2][2][4][2], const Unit& u, int wr, int wc, int fr, int fq) const {
    const int row0 = u.pm * 256 + wr * 64 + fr, jc = u.pn * 128 + wc * 32 + 8 * fq;
    const float* bg = b_gu + (size_t)u.z * 2048 + jc;
#pragma unroll
    for (int bj = 0; bj < 2; ++bj)
#pragma unroll
      for (int n = 0; n < 2; ++n) {
        const f32x4 bv = *(const f32x4*)(bg + bj * 1024 + n * 4);
#pragma unroll
        for (int ai = 0; ai < 2; ++ai)
#pragma unroll
          for (int m = 0; m < 4; ++m) acc[ai][bj][m][n] += bv;
      }
#pragma unroll
    for (int ai = 0; ai < 2; ++ai)
#pragma unroll
      for (int m = 0; m < 4; ++m) {
        unsigned char* rowp = act + (size_t)(row0 + ai * 128 + m * 16) * DM + jc;
        float r[8];
#pragma unroll
        for (int n = 0; n < 2; ++n)
#pragma unroll
          for (int j = 0; j < 4; ++j) {
            float g = acc[ai][0][m][n][j], up = acc[ai][1][m][n][j];
            g = fminf(g, 7.f); up = fminf(fmaxf(up, -7.f), 7.f);
            r[n * 4 + j] = (up + 1.f) * g * sigmoidf_(1.702f * g);
          }
        u32x2 w; w.x = pk4_fp8(r[0], r[1], r[2], r[3]); w.y = pk4_fp8(r[4], r[5], r[6], r[7]);
        *(u32x2*)rowp = w;
      }
  }
};
__device__ void ph_moe1(const Params& p, PG8_LAS unsigned char* lds, int nblk, int bid) {
  PG8_LAS int* tb = (PG8_LAS int*)(lds + pg8::STAGE_BYTES);
  moe_table(p, tb, 8);
  SchedMoe<true> S; S.tb = tb; S.NT = 8; S.G = nblk; S.c = bid; S.nwg = tb[NE]; S.A = (const char*)p.h2q; S.B = (const char*)p.wgu8; S.bexp = (size_t)2048 * DM; S.elist = p.elist; S.rowb = DM;
  EpiMoe1 E{p.b_gu, p.act8};
  pg8::gemm_phase<EpiMoe1, SchedMoe<true>, true>(lds, p.tid, DM / 2, DM / 2, DM / 2, S, E);
}
struct EpiMoe2 {
  static constexpr bool PERM = true;
  const float* b_down; const int* elist; const PG8_LAS int* tb; bf16_t* yslot;
  __device__ __forceinline__ void operator()(f32x4 (&acc)[2][2][4][2], const Unit& u, int wr, int wc, int fr, int fq) const {
    const int row0 = u.pm * 256 + wr * 64 + fr, col0 = u.pn * 256 + wc * 32 + 8 * fq;
    const float* bd = b_down + (size_t)u.z * 1024 + col0;
#pragma unroll
    for (int bj = 0; bj < 2; ++bj)
#pragma unroll
      for (int n = 0; n < 2; ++n) {
        const f32x4 bv = *(const f32x4*)(bd + bj * 128 + n * 4);
#pragma unroll
        for (int ai = 0; ai < 2; ++ai)
#pragma unroll
          for (int m = 0; m < 4; ++m) acc[ai][bj][m][n] += bv;
      }
    const int li0 = (u.pm - tb[33 + u.z]) * 256 + wr * 64 + fr, cnt = tb[66 + u.z];
    int av[2][4];
#pragma unroll
    for (int ai = 0; ai < 2; ++ai)
#pragma unroll
      for (int m = 0; m < 4; ++m) { const int li = li0 + ai * 128 + m * 16; av[ai][m] = elist[u.z * T_TOK + (li < cnt ? li : 0)]; if (li >= cnt) av[ai][m] = -1; }
#pragma unroll
    for (int ai = 0; ai < 2; ++ai)
#pragma unroll
      for (int m = 0; m < 4; ++m) {
        const int a = av[ai][m];
        if (a >= 0) {
          bf16_t* rowp = yslot + (size_t)a * DM + col0;
#pragma unroll
          for (int bj = 0; bj < 2; ++bj) {
            const f32x4 v0 = acc[ai][bj][m][0], v1 = acc[ai][bj][m][1];
            u32x4 w; w.x = pk2(v0[0], v0[1]); w.y = pk2(v0[2], v0[3]); w.z = pk2(v1[0], v1[1]); w.w = pk2(v1[2], v1[3]);
            *(u32x4*)(rowp + bj * 128) = w;
          }
        }
      }
  }
};
__device__ void ph_moe2(const Params& p, PG8_LAS unsigned char* lds, int nblk, int bid) {
  PG8_LAS int* tb = (PG8_LAS int*)(lds + pg8::STAGE_BYTES);
  moe_table(p, tb, 4);
  SchedMoe<false> S; S.tb = tb; S.NT = 4; S.G = nblk; S.c = bid; S.nwg = tb[NE]; S.A = (const char*)p.act8; S.B = (const char*)p.wd8; S.bexp = (size_t)1024 * DM; S.elist = p.elist; S.rowb = DM;
  EpiMoe2 E{p.b_down, p.elist, tb, p.yslot};
  pg8::gemm_phase<EpiMoe2, SchedMoe<false>, true>(lds, p.tid, DM / 2, DM / 2, DM / 2, S, E);
}

typedef short bf16x8 __attribute__((ext_vector_type(8)));
#define LAS __attribute__((address_space(3)))
#define MFMA16(a, b, c) __builtin_amdgcn_mfma_f32_16x16x32_bf16((a), (b), (c), 0, 0, 0)
__device__ __forceinline__ bf16x8 pack8(float a0, float a1, float a2, float a3, float a4, float a5, float a6, float a7) {
  u32x4 w; w.x = pk2(a0, a1); w.y = pk2(a2, a3); w.z = pk2(a4, a5); w.w = pk2(a6, a7);
  return __builtin_bit_cast(bf16x8, w);
}
__device__ __forceinline__ bf16_t f2bf_hw(float a) { return (bf16_t)(pk2(a, 0.f) & 0xffffu); }

#define DN_ABYTES 57344
#define DN_UFLOATS 8192
#define F_WN 0
#define F_QD 16
#define F_QK 32
#define F_KT 40

#define DP_KH 0
#define DP_QT 17408
#define DP_KHT 34816
#define DP_VT 53248
#define DP_TU 71680
#define DP_TW 80896
#define DP_LF 90112
#define DP_GC 107520
#define DP_BETA 107776
#define DP_CW 108032
#define DP_LB 114176
#define DP_TR 123392
#define DP_TT 132608
#define DP_MT 141824
#define DP_TOTAL 144128

template <int KS>
__device__ __forceinline__ f32x4 prod16(const LAS bf16_t* A, int lda, int arow0, const LAS bf16_t* Bt, int ldb, int brow0, f32x4 acc, int lane) {
  const int r = lane & 15, q = lane >> 4;
#pragma unroll
  for (int ks = 0; ks < KS; ++ks) {
    const bf16x8 a = *(const LAS bf16x8*)(A + (arow0 + r) * lda + 32 * ks + 8 * q);
    const bf16x8 b = *(const LAS bf16x8*)(Bt + (brow0 + r) * ldb + 32 * ks + 8 * q);
    acc = MFMA16(a, b, acc);
  }
  return acc;
}
__device__ __forceinline__ void tile_store_rm(LAS bf16_t* X, int ld, int row0, int col0, const f32x4 v, int lane) {
  const int r = lane & 15, q = lane >> 4;
#pragma unroll
  for (int i = 0; i < 4; ++i) X[(row0 + 4 * q + i) * ld + col0 + r] = f2bf_hw(v[i]);
}
__device__ __forceinline__ void tile_store_tr(LAS bf16_t* Xt, int ld, int row0, int col0, const f32x4 v, int lane) {
  const int r = lane & 15, q = lane >> 4;
  u32x2 w; w.x = pk2(v[0], v[1]); w.y = pk2(v[2], v[3]);
  *(LAS u32x2*)(Xt + (col0 + r) * ld + row0 + 4 * q) = w;
}

__device__ void dn_prep_chunk(const Params& p, LAS unsigned char* lds, int ci, bool load_cw) {
  const int tid = p.tid, lane = tid & 63, w = tid >> 6, r16 = lane & 15, q4 = lane >> 4;
  const int bh = ci >> 6, n = ci & 63, b = bh >> 2, h = bh & 3;
  LAS bf16_t* Kh = (LAS bf16_t*)(lds + DP_KH); LAS bf16_t* Qt = (LAS bf16_t*)(lds + DP_QT);
  LAS bf16_t* KhT = (LAS bf16_t*)(lds + DP_KHT); LAS bf16_t* VT = (LAS bf16_t*)(lds + DP_VT);
  LAS bf16_t* Tu = (LAS bf16_t*)(lds + DP_TU); LAS bf16_t* Tw = (LAS bf16_t*)(lds + DP_TW); LAS float* Lf = (LAS float*)(lds + DP_LF);
  LAS bf16_t* Lb = (LAS bf16_t*)(lds + DP_LB); LAS bf16_t* Tr = (LAS bf16_t*)(lds + DP_TR); LAS bf16_t* Tt = (LAS bf16_t*)(lds + DP_TT); LAS bf16_t* Mt = (LAS bf16_t*)(lds + DP_MT);
  LAS float* gcb = (LAS float*)(lds + DP_GC); LAS float* betab = (LAS float*)(lds + DP_BETA); LAS float* cw = (LAS float*)(lds + DP_CW);
  unsigned char* gA = (unsigned char*)p.dnA + (size_t)ci * DN_ABYTES;
  float* gU = p.dnU + (size_t)ci * DN_UFLOATS;

  if (load_cw) {
    for (int i = tid; i < 4 * 384; i += 512) { const int tap = i / 384, cc = i % 384, part = cc >> 7, d = cc & 127; cw[i] = p.conv_w[tap * 1536 + part * 512 + h * 128 + d]; }
  }
  __syncthreads();
  const int c = tid >> 3, g = tid & 7;
  const int s = n * 64 + c;
  const size_t t = (size_t)b * SEQ + s;
  float qv[16], kv[16], vv[16];
#pragma unroll
  for (int j = 0; j < 16; ++j) { qv[j] = 0.f; kv[j] = 0.f; vv[j] = 0.f; }
#pragma unroll
  for (int tap = 0; tap < 4; ++tap) {
    const int ss = s - 3 + tap;
    if (ss >= 0) {
      const bf16_t* row = p.proj + (t - 3 + tap) * PW + h * 128 + 16 * g;
      float x[8];
#pragma unroll
      for (int part = 0; part < 3; ++part) {
#pragma unroll
        for (int hh = 0; hh < 2; ++hh) {
          unpack8(*(const u32x4*)(row + part * 512 + 8 * hh), x);
#pragma unroll
          for (int j = 0; j < 8; ++j) {
            const float wv = cw[tap * 384 + part * 128 + 16 * g + 8 * hh + j];
            if (part == 0) qv[8 * hh + j] += wv * x[j];
            if (part == 1) kv[8 * hh + j] += wv * x[j];
            if (part == 2) vv[8 * hh + j] += wv * x[j];
          }
        }
      }
    }
    asm volatile("" ::: "memory");
  }
  float sq = 0.f, sk = 0.f;
#pragma unroll
  for (int j = 0; j < 16; ++j) { qv[j] = siluf_(qv[j]); kv[j] = siluf_(kv[j]); vv[j] = siluf_(vv[j]); sq += qv[j] * qv[j]; sk += kv[j] * kv[j]; }
  sq += __shfl_xor(sq, 1, 64); sq += __shfl_xor(sq, 2, 64); sq += __shfl_xor(sq, 4, 64);
  sk += __shfl_xor(sk, 1, 64); sk += __shfl_xor(sk, 2, 64); sk += __shfl_xor(sk, 4, 64);
  const float rq = rsqrtf(sq + 1e-6f) * 0.08838834764831845f, rk = rsqrtf(sk + 1e-6f);
#pragma unroll
  for (int j = 0; j < 16; ++j) { qv[j] *= rq; kv[j] *= rk; }
  if (g == 0) {
    const float bb = p.ba[t * 8 + h], aa = p.ba[t * 8 + 4 + h];
    const float xx = aa + p.dt_bias[h];
    const float sp = xx > 20.f ? xx : log1pf(__expf(xx));
    betab[c] = sigmoidf_(bb);
    gcb[c] = -__expf(p.a_log[h]) * sp;
  }
  {
    u32x4 w0, w1;
    w0.x = pk2(kv[0], kv[1]); w0.y = pk2(kv[2], kv[3]); w0.z = pk2(kv[4], kv[5]); w0.w = pk2(kv[6], kv[7]);
    w1.x = pk2(kv[8], kv[9]); w1.y = pk2(kv[10], kv[11]); w1.z = pk2(kv[12], kv[13]); w1.w = pk2(kv[14], kv[15]);
    *(LAS u32x4*)(Kh + c * 136 + 16 * g) = w0; *(LAS u32x4*)(Kh + c * 136 + 16 * g + 8) = w1;
    w0.x = pk2(qv[0], qv[1]); w0.y = pk2(qv[2], qv[3]); w0.z = pk2(qv[4], qv[5]); w0.w = pk2(qv[6], qv[7]);
    w1.x = pk2(qv[8], qv[9]); w1.y = pk2(qv[10], qv[11]); w1.z = pk2(qv[12], qv[13]); w1.w = pk2(qv[14], qv[15]);
    *(LAS u32x4*)(Qt + c * 136 + 16 * g) = w0; *(LAS u32x4*)(Qt + c * 136 + 16 * g + 8) = w1;
#pragma unroll
    for (int j = 0; j < 16; ++j) { KhT[(16 * g + j) * 72 + c] = f2bf_hw(kv[j]); VT[(16 * g + j) * 72 + c] = f2bf_hw(vv[j]); }
  }
  __syncthreads();
  if (w == 0) {
    float v = gcb[lane];
#pragma unroll
    for (int o = 1; o < 64; o <<= 1) { const float u = __shfl_up(v, o, 64); if (lane >= o) v += u; }
    gcb[lane] = v;
  }
  __syncthreads();
  const float gc_c = gcb[c], gl = gcb[63];
  {
    const float eg = __expf(gc_c);
    unsigned char* fb = gA + (size_t)(F_QD + (c >> 4) * 4 + (g >> 1)) * 1024 + (g & 1) * 8;
#pragma unroll
    for (int qq = 0; qq < 4; ++qq) {
      u32x2 wv; wv.x = pk2(qv[4 * qq] * eg, qv[4 * qq + 1] * eg); wv.y = pk2(qv[4 * qq + 2] * eg, qv[4 * qq + 3] * eg);
      *(u32x2*)(fb + ((c & 15) + 16 * qq) * 16) = wv;
    }
  }
  const int rt = w >> 1, ct0 = 2 * (w & 1);
#pragma unroll
  for (int tt = 0; tt < 2; ++tt) {
    const int ct = ct0 + tt;
    f32x4 gacc = {0.f, 0.f, 0.f, 0.f};
    gacc = prod16<4>(Kh, 136, 16 * rt, Kh, 136, 16 * ct, gacc, lane);
    const int m = 16 * ct + r16; const float gc_m = gcb[m];
    f32x4 lv;
#pragma unroll
    for (int i = 0; i < 4; ++i) {
      const int cc = 16 * rt + 4 * q4 + i;
      lv[i] = (m < cc) ? betab[cc] * gacc[i] * __expf(gcb[cc] - gc_m) : 0.f;
      Lf[cc * 68 + m] = lv[i];
    }
    tile_store_rm(Lb, 72, 16 * rt, 16 * ct, lv, lane);
    f32x4 qacc = {0.f, 0.f, 0.f, 0.f};
    qacc = prod16<4>(Kh, 136, 16 * rt, Qt, 136, 16 * ct, qacc, lane);
    const int cq = 16 * ct + r16; const float gc_cq = gcb[cq];
    float o4[4];
#pragma unroll
    for (int i = 0; i < 4; ++i) { const int mm = 16 * rt + 4 * q4 + i; o4[i] = (mm <= cq) ? qacc[i] * __expf(gc_cq - gcb[mm]) : 0.f; }
    u32x2 wv; wv.x = pk2(o4[0], o4[1]); wv.y = pk2(o4[2], o4[3]);
    *(u32x2*)(gA + (size_t)(F_QK + ct * 2 + (rt >> 1)) * 1024 + (r16 + 16 * q4) * 16 + (rt & 1) * 8) = wv;
  }
  __syncthreads();
  for (int i = tid; i < 2 * 64 * 72 / 8; i += 512) ((LAS u32x4*)Tr)[i] = (u32x4){0u, 0u, 0u, 0u};
  __syncthreads();
  if (w == 0) {
    int lo = lane; asm volatile("" : "+v"(lo));
    const int g = lo >> 4, j = lo & 15;
    unsigned lfb = DP_LF + (16 * g * 68 + 16 * g) * 4; asm volatile("" : "+v"(lfb));
    const LAS float* Lg = (const LAS float*)(lds + lfb);
    float t[16];
#pragma unroll
    for (int r = 0; r < 16; ++r) {
      float a0 = (r == j) ? 1.f : 0.f, a1 = 0.f;
#pragma unroll
      for (int k4 = 0; k4 < (r + 3) / 4; ++k4) {
        const f32x4 l = *(const LAS f32x4*)(Lg + r * 68 + 4 * k4);
        if (4 * k4 + 0 < r) a0 -= l[0] * t[4 * k4 + 0];
        if (4 * k4 + 1 < r) a1 -= l[1] * t[4 * k4 + 1];
        if (4 * k4 + 2 < r) a0 -= l[2] * t[4 * k4 + 2];
        if (4 * k4 + 3 < r) a1 -= l[3] * t[4 * k4 + 3];
      }
      t[r] = a0 + a1;
      Tr[(16 * g + r) * 72 + 16 * g + j] = f2bf_hw(t[r]);
    }
    u32x4 w0, w1;
    w0.x = pk2(t[0], t[1]); w0.y = pk2(t[2], t[3]); w0.z = pk2(t[4], t[5]); w0.w = pk2(t[6], t[7]);
    w1.x = pk2(t[8], t[9]); w1.y = pk2(t[10], t[11]); w1.z = pk2(t[12], t[13]); w1.w = pk2(t[14], t[15]);
    *(LAS u32x4*)(Tt + (16 * g + j) * 72 + 16 * g) = w0; *(LAS u32x4*)(Tt + (16 * g + j) * 72 + 16 * g + 8) = w1;
  }
  __syncthreads();
#pragma unroll 1
  for (int d = 1; d <= 3; ++d) {
    const bool act = w < 4 - d;
    const int I = w + d, J = w;
    LAS bf16_t* Mw = Mt + w * 16 * 24;
    if (act) {
      f32x4 macc = {0.f, 0.f, 0.f, 0.f};
      macc = prod16<2>(Lb, 72, 16 * I, Tt, 72, 16 * J, macc, lane);
      tile_store_tr(Mw, 24, 0, 0, macc, lane);
    }
    __syncthreads();
    if (act) {
      bf16x8 a = {0, 0, 0, 0, 0, 0, 0, 0}, bb = {0, 0, 0, 0, 0, 0, 0, 0};
      if (q4 < 2) { a = *(const LAS bf16x8*)(Tr + (16 * I + r16) * 72 + 16 * I + 8 * q4); bb = *(const LAS bf16x8*)(Mw + r16 * 24 + 8 * q4); }
      f32x4 tacc = {0.f, 0.f, 0.f, 0.f};
      tacc = MFMA16(a, bb, tacc);
#pragma unroll
      for (int i = 0; i < 4; ++i) tacc[i] = -tacc[i];
      tile_store_rm(Tr, 72, 16 * I, 16 * J, tacc, lane);
      tile_store_tr(Tt, 72, 16 * I, 16 * J, tacc, lane);
    }
    __syncthreads();
  }
  {
    const int cc = tid >> 3, m0 = (tid & 7) * 8;
    float tv[8]; unpack8(*(const LAS u32x4*)(Tr + cc * 72 + m0), tv);
    float tu[8], tw[8];
#pragma unroll
    for (int jj = 0; jj < 8; ++jj) { const float bm = betab[m0 + jj]; tu[jj] = tv[jj] * bm; tw[jj] = tu[jj] * __expf(gcb[m0 + jj]); }
    u32x4 wu, ww;
    wu.x = pk2(tu[0], tu[1]); wu.y = pk2(tu[2], tu[3]); wu.z = pk2(tu[4], tu[5]); wu.w = pk2(tu[6], tu[7]);
    ww.x = pk2(tw[0], tw[1]); ww.y = pk2(tw[2], tw[3]); ww.z = pk2(tw[4], tw[5]); ww.w = pk2(tw[6], tw[7]);
    *(LAS u32x4*)(Tu + cc * 72 + m0) = wu; *(LAS u32x4*)(Tw + cc * 72 + m0) = ww;
  }
  __syncthreads();
#pragma unroll
  for (int rr = 0; rr < 4; ++rr) {
    f32x4 u = {0.f, 0.f, 0.f, 0.f};
    u = prod16<2>(Tu, 72, 16 * rr, VT, 72, 16 * w, u, lane);
    *(f32x4*)(gU + ((w * 4 + rr) * 64 + lane) * 4) = u;
    f32x4 wt = {0.f, 0.f, 0.f, 0.f};
    wt = prod16<2>(KhT, 72, 16 * w, Tw, 72, 16 * rr, wt, lane);
    u32x2 wv; wv.x = pk2(-wt[0], -wt[1]); wv.y = pk2(-wt[2], -wt[3]);
    *(u32x2*)(gA + (size_t)(F_WN + rr * 4 + (w >> 1)) * 1024 + (r16 + 16 * q4) * 16 + (w & 1) * 8) = wv;
  }
#pragma unroll
  for (int it = 0; it < 4; ++it) {
    const int idx = tid + it * 512; const int d = idx >> 4, m4 = idx & 15;
    const u32x2 raw = *(const LAS u32x2*)(KhT + d * 72 + 4 * m4);
    const float k0 = __uint_as_float(raw.x << 16), k1 = __uint_as_float(raw.x & 0xffff0000u), k2 = __uint_as_float(raw.y << 16), k3 = __uint_as_float(raw.y & 0xffff0000u);
    const float e0 = __expf(gl - gcb[4 * m4]), e1 = __expf(gl - gcb[4 * m4 + 1]), e2 = __expf(gl - gcb[4 * m4 + 2]), e3 = __expf(gl - gcb[4 * m4 + 3]);
    u32x2 wv; wv.x = pk2(k0 * e0, k1 * e1); wv.y = pk2(k2 * e2, k3 * e3);
    *(u32x2*)(gA + (size_t)(F_KT + (d >> 4) * 2 + (m4 >> 3)) * 1024 + ((d & 15) + 16 * (m4 & 3)) * 16 + ((m4 >> 2) & 1) * 8) = wv;
  }
  if (tid == 0) p.dnG[ci] = __expf(gl);
}

#define DS_A0 0
#define DS_A1 57344
#define DS_TOTAL 114688
__device__ void dn_scan_blk(const Params& p, LAS unsigned char* lds, int item) {
  const int tid = p.tid, lane = tid & 63, w = __builtin_amdgcn_readfirstlane(tid >> 6), r16 = lane & 15, q4 = lane >> 4;
  const int bh = item >> 1, eh = item & 1, b = bh >> 2, h = bh & 3;
  const int et = eh * 4 + (w & 3);
  const bool comp = w < 4;
  const unsigned char* gA = (const unsigned char*)p.dnA + (size_t)bh * 64 * DN_ABYTES;
  const float* gU = p.dnU + (size_t)bh * 64 * DN_UFLOATS;
  const float* gG = p.dnG + bh * 64;
  auto issue_A = [&](int n, int buf) {
#pragma unroll
    for (int i = 0; i < 7; ++i) {
      const int f = w * 7 + i;
      __builtin_amdgcn_global_load_lds((const unsigned*)(gA + (size_t)n * DN_ABYTES + f * 1024 + lane * 16), (LAS unsigned*)(lds + (buf ? DS_A1 : DS_A0) + f * 1024), 16, 0, 0);
    }
  };
  __syncthreads();
  issue_A(0, 0);
  f32x4 Un[4];
#pragma unroll
  for (int rr = 0; rr < 4; ++rr) Un[rr] = *(const f32x4*)(gU + ((et * 4 + rr) * 64 + lane) * 4);
  f32x4 S[8];
#pragma unroll
  for (int dt = 0; dt < 8; ++dt) S[dt] = (f32x4){0.f, 0.f, 0.f, 0.f};
  asm volatile("s_waitcnt vmcnt(0)" ::: "memory");
  __syncthreads();
  bf16_t* obase = p.dn_out + ((size_t)b * SEQ) * p.dn_out_ld + h * 128 + 16 * et + r16;
  f32x4 Op[4];
#pragma unroll
  for (int rr = 0; rr < 4; ++rr) Op[rr] = (f32x4){0.f, 0.f, 0.f, 0.f};
  float gnext = gG[0];
#pragma unroll 1
  for (int n = 0; n < 64; ++n) {
    const LAS unsigned char* Ab = lds + ((n & 1) ? DS_A1 : DS_A0);
    if (n + 1 < 64) issue_A(n + 1, (n + 1) & 1);
    if (comp) {
      if (n > 0) {
#pragma unroll
        for (int rr = 0; rr < 4; ++rr)
#pragma unroll
          for (int i = 0; i < 4; ++i) obase[(size_t)((n - 1) * 64 + 16 * rr + 4 * q4 + i) * p.dn_out_ld] = f2bf_hw(Op[rr][i]);
      }
      f32x4 Vn[4];
#pragma unroll
      for (int rr = 0; rr < 4; ++rr) Vn[rr] = Un[rr];
      if (n + 1 < 64) {
#pragma unroll
        for (int rr = 0; rr < 4; ++rr) Un[rr] = *(const f32x4*)(gU + (size_t)(n + 1) * DN_UFLOATS + ((et * 4 + rr) * 64 + lane) * 4);
      }
      const float gdec = gnext;
      if (n + 1 < 64) gnext = gG[n + 1];
      bf16x8 Sb[4];
#pragma unroll
      for (int ks = 0; ks < 4; ++ks) Sb[ks] = pack8(S[2 * ks][0], S[2 * ks][1], S[2 * ks][2], S[2 * ks][3], S[2 * ks + 1][0], S[2 * ks + 1][1], S[2 * ks + 1][2], S[2 * ks + 1][3]);
#pragma unroll
      for (int dt = 0; dt < 8; ++dt) S[dt] *= gdec;
#define LDF(idx) (*(const LAS bf16x8*)(Ab + (idx) * 1024 + lane * 16))
#define SBAR __builtin_amdgcn_sched_barrier(0)
      bf16x8 fa[8], fb[8];
      f32x4 O[4];
#pragma unroll
      for (int rr = 0; rr < 4; ++rr) O[rr] = (f32x4){0.f, 0.f, 0.f, 0.f};
#pragma unroll
      for (int i = 0; i < 4; ++i) { fa[i] = LDF(F_WN + i); fa[4 + i] = LDF(F_QD + i); }
      SBAR;
#pragma unroll
      for (int i = 0; i < 4; ++i) { fb[i] = LDF(F_WN + 4 + i); fb[4 + i] = LDF(F_QD + 4 + i); }
      SBAR;
#pragma unroll
      for (int ks = 0; ks < 4; ++ks) { Vn[0] = MFMA16(fa[ks], Sb[ks], Vn[0]); O[0] = MFMA16(fa[4 + ks], Sb[ks], O[0]); }
      SBAR;
#pragma unroll
      for (int i = 0; i < 4; ++i) { fa[i] = LDF(F_WN + 8 + i); fa[4 + i] = LDF(F_QD + 8 + i); }
      SBAR;
#pragma unroll
      for (int ks = 0; ks < 4; ++ks) { Vn[1] = MFMA16(fb[ks], Sb[ks], Vn[1]); O[1] = MFMA16(fb[4 + ks], Sb[ks], O[1]); }
      SBAR;
#pragma unroll
      for (int i = 0; i < 4; ++i) { fb[i] = LDF(F_WN + 12 + i); fb[4 + i] = LDF(F_QD + 12 + i); }
      SBAR;
#pragma unroll
      for (int ks = 0; ks < 4; ++ks) { Vn[2] = MFMA16(fa[ks], Sb[ks], Vn[2]); O[2] = MFMA16(fa[4 + ks], Sb[ks], O[2]); }
      SBAR;
#pragma unroll
      for (int i = 0; i < 8; ++i) fa[i] = LDF(F_QK + i);
      SBAR;
#pragma unroll
      for (int ks = 0; ks < 4; ++ks) { Vn[3] = MFMA16(fb[ks], Sb[ks], Vn[3]); O[3] = MFMA16(fb[4 + ks], Sb[ks], O[3]); }
      SBAR;
#pragma unroll
      for (int i = 0; i < 8; ++i) fb[i] = LDF(F_KT + i);
      SBAR;
      bf16x8 Vb[2];
#pragma unroll
      for (int ks = 0; ks < 2; ++ks) Vb[ks] = pack8(Vn[2 * ks][0], Vn[2 * ks][1], Vn[2 * ks][2], Vn[2 * ks][3], Vn[2 * ks + 1][0], Vn[2 * ks + 1][1], Vn[2 * ks + 1][2], Vn[2 * ks + 1][3]);
#pragma unroll
      for (int ks = 0; ks < 2; ++ks)
#pragma unroll
        for (int rr = 0; rr < 4; ++rr) O[rr] = MFMA16(fa[rr * 2 + ks], Vb[ks], O[rr]);
      SBAR;
#pragma unroll
      for (int i = 0; i < 8; ++i) fa[i] = LDF(F_KT + 8 + i);
      SBAR;
#pragma unroll
      for (int ks = 0; ks < 2; ++ks)
#pragma unroll
        for (int dt = 0; dt < 4; ++dt) S[dt] = MFMA16(fb[dt * 2 + ks], Vb[ks], S[dt]);
      SBAR;
#pragma unroll
      for (int ks = 0; ks < 2; ++ks)
#pragma unroll
        for (int dt = 0; dt < 4; ++dt) S[4 + dt] = MFMA16(fa[dt * 2 + ks], Vb[ks], S[4 + dt]);
#pragma unroll
      for (int rr = 0; rr < 4; ++rr) Op[rr] = O[rr];
#undef LDF
#undef SBAR
    }
    asm volatile("s_waitcnt vmcnt(0)" ::: "memory");
    __syncthreads();
  }
  if (comp) {
#pragma unroll
    for (int rr = 0; rr < 4; ++rr)
#pragma unroll
      for (int i = 0; i < 4; ++i) obase[(size_t)(63 * 64 + 16 * rr + 4 * q4 + i) * p.dn_out_ld] = f2bf_hw(Op[rr][i]);
  }
}
__device__ void ph_dn_norm(const Params& p, int nblk, int bid) {
  const int wid = p.tid >> 6, lane = p.tid & 63;
  const f32x4 g0 = *(const f32x4*)(p.g_dn_out + (lane & 15) * 8), g1 = *(const f32x4*)(p.g_dn_out + (lane & 15) * 8 + 4);
  u32x4 on_ = {0u, 0u, 0u, 0u}, zn_ = on_;
  if (bid * 8 + wid < T_TOK) { const int t0 = bid * 8 + wid; on_ = *(const u32x4*)(p.oab + (size_t)t0 * DM + lane * 8); zn_ = *(const u32x4*)(p.proj + (size_t)t0 * PW + C_Z + lane * 8); }
  for (int t = bid * 8 + wid; t < T_TOK; t += nblk * 8) {
    bf16_t* op = p.oab + (size_t)t * DM + lane * 8;
    float o[8], z[8];
    unpack8(on_, o);
    unpack8(zn_, z);
    if (t + nblk * 8 < T_TOK) { const int tn = t + nblk * 8; on_ = *(const u32x4*)(p.oab + (size_t)tn * DM + lane * 8); zn_ = *(const u32x4*)(p.proj + (size_t)tn * PW + C_Z + lane * 8); }
    float ss = 0.f;
#pragma unroll
    for (int j = 0; j < 8; ++j) ss += o[j] * o[j];
    ss += __shfl_xor(ss, 1, 64); ss += __shfl_xor(ss, 2, 64); ss += __shfl_xor(ss, 4, 64); ss += __shfl_xor(ss, 8, 64);
    const float rstd = rsqrtf(ss * (1.f / 128.f) + 1e-6f);
    float y[8];
#pragma unroll
    for (int j = 0; j < 4; ++j) { y[j] = o[j] * rstd * g0[j] * siluf_(z[j]); y[4 + j] = o[4 + j] * rstd * g1[j] * siluf_(z[4 + j]); }
    u32x4 w; w.x = pk2(y[0], y[1]); w.y = pk2(y[2], y[3]); w.z = pk2(y[4], y[5]); w.w = pk2(y[6], y[7]);
    *(u32x4*)op = w;
  }
}
typedef float f32x16 __attribute__((ext_vector_type(16)));
#define MFMA32(a, b, c) __builtin_amdgcn_mfma_f32_32x32x16_bf16((a), (b), (c), 0, 0, 0)
#define MP_VL 0
#define MP_RED 65536
#define MP_TOTAL (65536 + 4096)

__device__ void moba_prep_block(const Params& p, LAS unsigned char* lds, int item) {
  const int tid = p.tid, lane = tid & 63, w = tid >> 6;
  const int bh = item >> 4, jb = item & 15, b = bh >> 2, h = bh & 3;
  LAS bf16_t* Vl = (LAS bf16_t*)(lds + MP_VL);
  LAS float* red = (LAS float*)(lds + MP_RED);
  __syncthreads();
#pragma unroll
  for (int it = 0; it < 8; ++it) {
    const int idx = tid + 512 * it, row = idx >> 4, ch = idx & 15;
    const u32x4 v = *(const u32x4*)(p.proj + ((size_t)b * SEQ + 256 * jb + row) * PW + C_MV + h * 128 + 8 * ch);
    *(LAS u32x4*)(Vl + row * 128 + 8 * ch) = v;
  }
  {
    const int r = tid >> 1, hh = tid & 1;
    const int pos = 256 * jb + r;
    const size_t t = (size_t)b * SEQ + pos;
    float cs[8], sn[8];
#pragma unroll
    for (int jj = 0; jj < 8; ++jj) {
      const float inv = exp2f(-(float)(8 * hh + jj) * (1.f / 16.f) * 18.931568569324174f);
      const float ang = (float)pos * inv;
      cs[jj] = cosf(ang); sn[jj] = sinf(ang);
    }
    float kacc[64];
#pragma unroll
    for (int which = 0; which < 2; ++which) {
      const bf16_t* src = p.proj + t * PW + (which ? C_MQ : C_MK) + h * 128 + 8 * hh;
      float x0[8], x1[8];
      unpack8(*(const u32x4*)(src), x0); unpack8(*(const u32x4*)(src + 16), x1);
      float y0[8], y1[8];
#pragma unroll
      for (int jj = 0; jj < 8; ++jj) { y0[jj] = x0[jj] * cs[jj] - x1[jj] * sn[jj]; y1[jj] = x1[jj] * cs[jj] + x0[jj] * sn[jj]; }
      u32x4 o[8];
      o[0].x = pk2(y0[0], y0[1]); o[0].y = pk2(y0[2], y0[3]); o[0].z = pk2(y0[4], y0[5]); o[0].w = pk2(y0[6], y0[7]);
      o[1].x = pk2(y1[0], y1[1]); o[1].y = pk2(y1[2], y1[3]); o[1].z = pk2(y1[4], y1[5]); o[1].w = pk2(y1[6], y1[7]);
#pragma unroll
      for (int ks = 2; ks < 8; ++ks) o[ks] = *(const u32x4*)(src + 16 * ks);
      if (which == 0) {
#pragma unroll
        for (int jj = 0; jj < 8; ++jj) { kacc[jj] = y0[jj]; kacc[8 + jj] = y1[jj]; }
#pragma unroll
        for (int ks = 2; ks < 8; ++ks) { float f[8]; unpack8(o[ks], f);
#pragma unroll
          for (int jj = 0; jj < 8; ++jj) kacc[8 * ks + jj] = f[jj]; }
        unsigned char* dst = (unsigned char*)p.Kp + ((size_t)(bh * 128 + 8 * jb + (r >> 5)) * 8192) + ((r & 31) + 32 * hh) * 16;
#pragma unroll
        for (int ks = 0; ks < 8; ++ks) *(u32x4*)(dst + ks * 1024) = o[ks];
      } else {
        bf16_t* dst = p.qb + ((size_t)bh * SEQ + pos) * 128 + 8 * hh;
#pragma unroll
        for (int ks = 0; ks < 8; ++ks) *(u32x4*)(dst + 16 * ks) = o[ks];
      }
    }
#pragma unroll
    for (int e = 0; e < 64; ++e) {
      float v = kacc[e];
      v += __shfl_xor(v, 2, 64); v += __shfl_xor(v, 4, 64); v += __shfl_xor(v, 8, 64); v += __shfl_xor(v, 16, 64); v += __shfl_xor(v, 32, 64);
      kacc[e] = v;
    }
    if (lane < 2) {
#pragma unroll
      for (int e = 0; e < 64; ++e) red[(w * 2 + lane) * 64 + e] = kacc[e];
    }
  }
  __syncthreads();
  if (tid < 128) {
    const int d = tid, hh = (d >> 3) & 1, ks = d >> 4, jj = d & 7;
    float a = 0.f;
#pragma unroll
    for (int ww = 0; ww < 8; ++ww) a += red[(ww * 2 + hh) * 64 + ks * 8 + jj];
    p.kmean[((size_t)bh * 16 + jb) * 128 + d] = a * (1.f / 256.f);
  }
#pragma unroll
  for (int it = 0; it < 8; ++it) {
    const int o = tid + 512 * it, ln = o & 63, frag = o >> 6, tl = frag >> 3, dt = (frag >> 1) & 3, s = frag & 1;
    const int r = ln & 31, hh = ln >> 5, d = 32 * dt + r;
    unsigned short e[8];
#pragma unroll
    for (int jj = 0; jj < 8; ++jj) { const int key = 32 * tl + 16 * s + 8 * (jj >> 2) + 4 * hh + (jj & 3); e[jj] = Vl[key * 128 + d]; }
    u32x4 wv; wv.x = e[0] | ((unsigned)e[1] << 16); wv.y = e[2] | ((unsigned)e[3] << 16); wv.z = e[4] | ((unsigned)e[5] << 16); wv.w = e[6] | ((unsigned)e[7] << 16);
    *(u32x4*)((unsigned char*)p.Vp + ((size_t)(bh * 128 + 8 * jb + tl) * 8192) + (dt * 2 + s) * 1024 + ln * 16) = wv;
  }
}
__device__ __forceinline__ int crow32(int reg, int hh) { return (reg & 3) + 8 * (reg >> 2) + 4 * hh; }
__device__ void moba_item(const Params& p, LAS float* km, LAS float* mrg, LAS float* ml, int bh, int ib, int sub, int par, int lane, int rep) {
  const int q = lane & 31, hh = lane >> 5;
  const int b = bh >> 2, h = bh & 3;
  const int s0 = 256 * ib + 32 * sub;
  const bf16_t* qrow = p.qb + ((size_t)bh * SEQ + s0 + q) * 128 + 8 * hh;
  bf16x8 Qf[8];
#pragma unroll
  for (int ks = 0; ks < 8; ++ks) Qf[ks] = *(const bf16x8*)(qrow + 16 * ks);
  LAS unsigned char* qlds = (LAS unsigned char*)km + 8192 + lane * 16;
#pragma unroll
  for (int ks = 0; ks < 8; ++ks) *(LAS bf16x8*)(qlds + ks * 1024) = Qf[ks];
  unsigned selmask = 0;
  if (ib > 0) {
    for (int idx = lane; idx < ib * 32; idx += 64) ((LAS f32x4*)km)[idx] = ((const f32x4*)(p.kmean + (size_t)bh * 16 * 128))[idx];
    float qf[64];
#pragma unroll
    for (int ks = 0; ks < 8; ++ks) { float f[8]; unpack8(__builtin_bit_cast(u32x4, Qf[ks]), f);
#pragma unroll
      for (int jj = 0; jj < 8; ++jj) qf[8 * ks + jj] = f[jj]; }
    float sc[16];
#pragma unroll
    for (int j = 0; j < 16; ++j) {
      sc[j] = -INFINITY;
      if (j < ib) {
        float a = 0.f;
#pragma unroll
        for (int ks = 0; ks < 8; ++ks) {
          const f32x4 k0 = *(const LAS f32x4*)(km + j * 128 + 16 * ks + 8 * hh), k1 = *(const LAS f32x4*)(km + j * 128 + 16 * ks + 8 * hh + 4);
          a += qf[8 * ks] * k0[0] + qf[8 * ks + 1] * k0[1] + qf[8 * ks + 2] * k0[2] + qf[8 * ks + 3] * k0[3];
          a += qf[8 * ks + 4] * k1[0] + qf[8 * ks + 5] * k1[1] + qf[8 * ks + 6] * k1[2] + qf[8 * ks + 7] * k1[3];
        }
        a += __shfl_xor(a, 32, 64);
        sc[j] = a;
      }
    }
#pragma unroll
    for (int r = 0; r < 3; ++r) {
      if (r < ib) {
        float best = -INFINITY; int bi = 0;
#pragma unroll
        for (int j = 0; j < 16; ++j) if (sc[j] > best) { best = sc[j]; bi = j; }
        selmask |= 1u << bi;
#pragma unroll
        for (int j = 0; j < 16; ++j) if (j == bi) sc[j] = -INFINITY;
      }
    }
  }
  unsigned rem = 0;
  for (int j = 0; j < ib; ++j) if (__ballot((selmask >> j) & 1u) != 0ull) rem |= 1u << j;
  rem = __builtin_amdgcn_readfirstlane(rem);
  const int own0 = 8 * ib, diag = 8 * ib + sub;
  const float cscale = 0.08838834764831845f * 1.4426950408889634f;
  float m = -1e30f, l = 0.f;
  f32x16 O[4];
#pragma unroll
  for (int dt = 0; dt < 4; ++dt)
#pragma unroll
    for (int r = 0; r < 16; ++r) O[dt][r] = 0.f;
  const unsigned char* kbase = (const unsigned char*)p.Kp + (size_t)bh * 128 * 8192 + lane * 16;
  const unsigned char* vbase = (const unsigned char*)p.Vp + (size_t)bh * 128 * 8192 + lane * 16;
  auto adv = [&](int& kt_, unsigned& rem_) {
    if (kt_ < 0) return;
    if (kt_ >= own0 ? (kt_ < diag) : ((kt_ & 7) != 7)) { kt_ = kt_ + 1; return; }
    if (rem_ == 0u) { kt_ = -1; return; }
    kt_ = 8 * (__builtin_ctz(rem_)); rem_ &= rem_ - 1u;
  };
  int kt = own0;
  if (par) adv(kt, rem);
  auto load_k = [&](int t, bf16x8 (&K_)[8]) {
#pragma unroll
    for (int ks = 0; ks < 8; ++ks) K_[ks] = *(const bf16x8*)(kbase + (size_t)t * 8192 + ks * 1024);
  };
  auto tile_step = [&](bf16x8 (&Kc)[8], bf16x8 (&Kn)[8]) -> bool {
    int ktn = kt; unsigned remn = rem;
    adv(ktn, remn); adv(ktn, remn);
    bf16x8 Vf[8];
#pragma unroll
    for (int f = 0; f < 8; ++f) Vf[f] = *(const bf16x8*)(vbase + (size_t)kt * 8192 + f * 1024);
    if (ktn >= 0) load_k(ktn, Kn);
    f32x16 S;
#pragma unroll
    for (int r = 0; r < 16; ++r) S[r] = 0.f;
#pragma unroll
    for (int ks = 0; ks < 8; ++ks) S = MFMA32(Kc[ks], *(const LAS bf16x8*)(qlds + ks * 1024), S);
    const bool allowed = (kt >= own0) || ((selmask >> (kt >> 3)) & 1u);
    const float nb = allowed ? 0.f : -INFINITY;
    float sv[16]; float mx = -INFINITY;
#pragma unroll
    for (int r = 0; r < 16; ++r) sv[r] = __builtin_fmaf(S[r], cscale, nb);
    if (kt == diag) {
#pragma unroll
      for (int r = 0; r < 16; ++r) if (crow32(r, hh) > q) sv[r] = -INFINITY;
    }
#pragma unroll
    for (int r = 0; r < 16; ++r) mx = fmaxf(mx, sv[r]);
    mx = fmaxf(mx, __shfl_xor(mx, 32, 64));
    const bool grow = mx > m + 8.f;
    const float mn = (__ballot(grow) != 0ull) ? fmaxf(m, mx) : m;
    const float alpha = __builtin_amdgcn_exp2f(m - mn);
    float ps = 0.f;
#pragma unroll
    for (int r = 0; r < 16; ++r) { sv[r] = __builtin_amdgcn_exp2f(sv[r] - mn); ps += sv[r]; }
    l = l * alpha + ps; m = mn;
    if (__ballot(alpha != 1.f) != 0ull) {
#pragma unroll
      for (int dt = 0; dt < 4; ++dt)
#pragma unroll
        for (int r = 0; r < 16; ++r) O[dt][r] *= alpha;
    }
    const bf16x8 P0 = pack8(sv[0], sv[1], sv[2], sv[3], sv[4], sv[5], sv[6], sv[7]);
    const bf16x8 P1 = pack8(sv[8], sv[9], sv[10], sv[11], sv[12], sv[13], sv[14], sv[15]);
#pragma unroll
    for (int dt = 0; dt < 4; ++dt) { O[dt] = MFMA32(Vf[dt * 2], P0, O[dt]); O[dt] = MFMA32(Vf[dt * 2 + 1], P1, O[dt]); }
    kt = ktn; rem = remn;
    return kt >= 0;
  };
  if (kt >= 0) {
    bf16x8 KA[8], KB[8];
    load_k(kt, KA);
#pragma unroll 1
    for (;;) {
      if (!tile_step(KA, KB)) break;
      asm volatile("" ::: "memory");
      if (!tile_step(KB, KA)) break;
      asm volatile("" ::: "memory");
    }
  }
  asm volatile("s_waitcnt vmcnt(0) lgkmcnt(0)" ::: "memory");
  if (par) {
    ml[lane] = m; ml[64 + lane] = l;
#pragma unroll
    for (int dt = 0; dt < 4; ++dt)
#pragma unroll
      for (int r = 0; r < 16; ++r) mrg[(dt * 16 + r) * 64 + lane] = O[dt][r];
  }
  __syncthreads();
  if (par == 0) {
    const float m2 = ml[lane], l2 = ml[64 + lane];
    const float mm = fmaxf(m, m2);
    const float a1 = __builtin_amdgcn_exp2f(m - mm), a2 = __builtin_amdgcn_exp2f(m2 - mm);
    l = l * a1 + l2 * a2;
#pragma unroll
    for (int dt = 0; dt < 4; ++dt)
#pragma unroll
      for (int r = 0; r < 16; ++r) O[dt][r] = O[dt][r] * a1 + mrg[(dt * 16 + r) * 64 + lane] * a2;
  }
  if (par == 0) {
  l += __shfl_xor(l, 32, 64);
  const float inv = 1.f / l;
  bf16_t* orow = rep ? p.oab2 + ((size_t)b * SEQ + s0 + q) * 512 + h * 128 : p.mb_out + ((size_t)b * SEQ + s0 + q) * p.mb_out_ld + p.mb_out_off + h * 128;
#pragma unroll
  for (int dt = 0; dt < 4; ++dt)
#pragma unroll
    for (int g4 = 0; g4 < 4; ++g4) {
      u32x2 wv; wv.x = pk2(O[dt][4 * g4] * inv, O[dt][4 * g4 + 1] * inv); wv.y = pk2(O[dt][4 * g4 + 2] * inv, O[dt][4 * g4 + 3] * inv);
      *(u32x2*)(orow + 32 * dt + 8 * g4 + 4 * hh) = wv;
    }
  }
  __syncthreads();
}
__device__ void moba_worker(const Params& p, LAS unsigned char* lds, int qi) {
  const int lane = p.tid & 63, w = __builtin_amdgcn_readfirstlane(p.tid >> 6);
  LAS float* km = (LAS float*)(lds + w * 16384);
  LAS float* mrg = (LAS float*)(lds + ((w & 3) + 4) * 16384);
  LAS float* ml = (LAS float*)(lds + 131072) + (w & 3) * 128;
  LAS int* slot = (LAS int*)(lds + 131072 + 2048);
  const int g0 = (int)((unsigned)__builtin_amdgcn_s_getreg((3 << 11) | 20) & 7u);
  for (int gi = 0; gi < 8; ++gi) {
    const int g = (g0 + gi) & 7;
    for (;;) {
      __syncthreads();
      if (p.tid == 0) slot[0] = atomicAdd(p.wq + qi * 8 + g, 1);
      __syncthreads();
      const int idx = slot[0];
      if (idx >= 64) break;
      const int bh = 2 * g + (idx >> 5), ib = 15 - ((idx >> 1) & 15), quad = 1 - (idx & 1);
      moba_item(p, km, mrg, ml, bh, ib, 4 * quad + (w & 3), w >> 2, lane, qi);
    }
  }
}
__device__ void ph_mod(const Params& p, LAS unsigned char* lds, int nblk, int bid) {
  LAS float* sc = (LAS float*)lds;
  LAS float* part = (LAS float*)(lds + 16384);
  const int tid = p.tid;
  if (bid >= 192) return;
  for (int i = tid; i < 4096; i += 512) sc[i] = siluf_(p.c[i]);
  __syncthreads();
  for (int task = bid; task < 192; task += nblk) {
    const int jj = tid & 31, ks = tid >> 5, j = task * 32 + jj;
    float a0 = 0.f, a1 = 0.f, a2 = 0.f, a3 = 0.f;
#pragma unroll 8
    for (int kk = 0; kk < 64; ++kk) {
      const int k = ks * 64 + kk;
      const float w = p.w_ada[(size_t)k * 6144 + j];
      a0 += sc[k] * w; a1 += sc[1024 + k] * w; a2 += sc[2048 + k] * w; a3 += sc[3072 + k] * w;
    }
    *(LAS f32x4*)(part + (ks * 32 + jj) * 4) = (f32x4){a0, a1, a2, a3};
    __syncthreads();
    if (tid < 128) {
      const int j2 = tid & 31, bb = tid >> 5;
      float a = 0.f;
#pragma unroll
      for (int s = 0; s < 16; ++s) a += part[(s * 32 + j2) * 4 + bb];
      p.mod[bb * 6144 + task * 32 + j2] = a + p.b_ada[task * 32 + j2];
    }
    __syncthreads();
  }
}

#define WT_T0 1424
#define WT_T1 (WT_T0 + 16384)
#define WT_T2 (WT_T1 + 8192)
#define WT_T3 (WT_T2 + 128)
#define WT_T4 (WT_T3 + 128)
#define WT_T5 (WT_T4 + 256)
struct WtTile { const float* src; bf16_t* dst; int K, N, mode, k0, n0; unsigned char* dst8; };
__device__ __forceinline__ WtTile wt_desc(const Params& p, int t) {
  WtTile d;
  if (t < WT_T0) { const int kt = t / 89, nt = t % 89; d = {p.w_in, p.w_in_t, 1024, INW, 1, kt * 64, nt * 64, nullptr}; }
  else if (t < WT_T1) { const int u = t - WT_T0, e = u >> 9, r = u & 511, kt = r >> 5, nt = r & 31; d = {p.w_gu + (size_t)e * 1024 * 2048, nullptr, 1024, 2048, 2, kt * 64, nt * 64, p.wgu8 + (size_t)e * 2048 * 1024}; }
  else if (t < WT_T2) { const int u = t - WT_T1, e = u >> 8, r = u & 255, kt = r >> 4, nt = r & 15; d = {p.w_down + (size_t)e * 1024 * 1024, nullptr, 1024, 1024, 0, kt * 64, nt * 64, p.wd8 + (size_t)e * 1024 * 1024}; }
  else if (t < WT_T3) { const int u = t - WT_T2, kt = u >> 4, nt = u & 15; d = {p.w_br_a, p.wbra_t, 512, 1024, 0, kt * 64, nt * 64, nullptr}; }
  else if (t < WT_T4) { const int u = t - WT_T3, kt = u >> 4, nt = u & 15; d = {p.w_br_b, p.wbrb_t, 512, 1024, 0, kt * 64, nt * 64, nullptr}; }
  else { const int u = t - WT_T4, kt = u >> 4, nt = u & 15; d = {p.w_o, p.wo_t, 1024, 1024, 0, kt * 64, nt * 64, nullptr}; }
  return d;
}
__device__ __forceinline__ void wt_load(const WtTile& d, int tid, f32x4 (&v)[2]) {
#pragma unroll
  for (int it = 0; it < 2; ++it) {
    const int row = (tid >> 4) + 32 * it, n = d.n0 + (tid & 15) * 4;
    v[it] = (f32x4){0.f, 0.f, 0.f, 0.f};
    if (n < d.N) v[it] = __builtin_nontemporal_load((const f32x4*)(d.src + (size_t)(d.k0 + row) * d.N + n));
  }
}
__device__ void ph_wt(const Params& p, LAS unsigned char* lds, int nblk, int bid) {
  LAS float* tile = (LAS float*)(lds + 32768);
  const int tid = p.tid;
  int t = bid;
  if (t >= WT_T5) return;
  WtTile cur = wt_desc(p, t);
  f32x4 v[2]; wt_load(cur, tid, v);
  WtTile nxt = cur; f32x4 vn[2] = {v[0], v[1]};
  if (t + nblk < WT_T5) { nxt = wt_desc(p, t + nblk); wt_load(nxt, tid, vn); }
  for (;;) {
    const int tnn = t + 2 * nblk;
    WtTile nn = nxt; f32x4 vnn[2] = {vn[0], vn[1]};
    if (tnn < WT_T5) { nn = wt_desc(p, tnn); wt_load(nn, tid, vnn); }
#pragma unroll
    for (int it = 0; it < 2; ++it) {
      const int row = (tid >> 4) + 32 * it, c4 = (tid & 15) * 4;
      tile[row * 65 + c4] = v[it][0]; tile[row * 65 + c4 + 1] = v[it][1]; tile[row * 65 + c4 + 2] = v[it][2]; tile[row * 65 + c4 + 3] = v[it][3];
    }
    __syncthreads();
    {
      const int nl = tid >> 3, kc = tid & 7, n = cur.n0 + nl;
      if (n < cur.N) {
        const int dd = map_col(n, cur.mode);
        if (dd >= 0) {
          float f[8];
#pragma unroll
          for (int j = 0; j < 8; ++j) f[j] = tile[(8 * kc + j) * 65 + nl];
          if (cur.dst8) {
            u32x2 w; w.x = pk4_fp8(f[0] * 64.f, f[1] * 64.f, f[2] * 64.f, f[3] * 64.f); w.y = pk4_fp8(f[4] * 64.f, f[5] * 64.f, f[6] * 64.f, f[7] * 64.f);
            *(u32x2*)(cur.dst8 + (size_t)dd * cur.K + cur.k0 + 8 * kc) = w;
          } else {
            u32x4 w; w.x = pk2(f[0], f[1]); w.y = pk2(f[2], f[3]); w.z = pk2(f[4], f[5]); w.w = pk2(f[6], f[7]);
            *(u32x4*)(cur.dst + (size_t)dd * cur.K + cur.k0 + 8 * kc) = w;
          }
        }
      }
    }
    __syncthreads();
    if (t + nblk >= WT_T5) break;
    t += nblk; cur = nxt; v[0] = vn[0]; v[1] = vn[1]; nxt = nn; vn[0] = vnn[0]; vn[1] = vnn[1];
  }
}

__device__ void ph_h(const Params& p, LAS unsigned char* lds, int nblk, int bid) {
  const int wid = p.tid >> 6, lane = p.tid & 63;
  LAS float* wb = (LAS float*)lds;
  for (int i = p.tid; i < 2048; i += 512) {
    const int k = i >> 1, hf = i & 1;
    const f32x4 v = *(const f32x4*)(p.w_in + (size_t)k * INW + 2048 + 4 * hf);
    wb[(4 * hf + 0) * 1024 + k] = v[0]; wb[(4 * hf + 1) * 1024 + k] = v[1]; wb[(4 * hf + 2) * 1024 + k] = v[2]; wb[(4 * hf + 3) * 1024 + k] = v[3];
  }
  __syncthreads();
  f32x4 gv[4];
#pragma unroll
  for (int i = 0; i < 4; ++i) gv[i] = *(const f32x4*)(p.g_pre_mix + i * 256 + lane * 4);
  f32x4 xnx[4];
  if (bid * 8 + wid < T_TOK) {
#pragma unroll
    for (int i = 0; i < 4; ++i) xnx[i] = *(const f32x4*)(p.x + (size_t)(bid * 8 + wid) * DM + i * 256 + lane * 4);
  }
  for (int t = bid * 8 + wid; t < T_TOK; t += nblk * 8) {
    const int b = t / SEQ;
    f32x4 xv[4];
    float ss = 0.f;
#pragma unroll
    for (int i = 0; i < 4; ++i) {
      xv[i] = xnx[i];
      ss += xv[i][0] * xv[i][0] + xv[i][1] * xv[i][1] + xv[i][2] * xv[i][2] + xv[i][3] * xv[i][3];
    }
    if (t + nblk * 8 < T_TOK) {
#pragma unroll
      for (int i = 0; i < 4; ++i) xnx[i] = *(const f32x4*)(p.x + (size_t)(t + nblk * 8) * DM + i * 256 + lane * 4);
    }
    ss = wave_sum(ss);
    const float rstd = rsqrtf(ss * (1.f / DM) + 1e-6f);
    const float* shift = p.mod + b * 6144;
    const float* scale = p.mod + b * 6144 + 1024;
    float acc[8] = {0, 0, 0, 0, 0, 0, 0, 0};
    f32x4 scv[4], shv[4];
#pragma unroll
    for (int i = 0; i < 4; ++i) { scv[i] = *(const f32x4*)(scale + i * 256 + lane * 4); shv[i] = *(const f32x4*)(shift + i * 256 + lane * 4); }
#pragma unroll
    for (int i = 0; i < 4; ++i) {
      const int k = i * 256 + lane * 4;
      const f32x4 g = gv[i], sc = scv[i], sh = shv[i];
      f32x4 hv;
#pragma unroll
      for (int j = 0; j < 4; ++j) hv[j] = xv[i][j] * rstd * g[j] * (1.f + sc[j]) + sh[j];
#pragma unroll
      for (int e = 0; e < 8; ++e) { const f32x4 w = *(const LAS f32x4*)(wb + e * 1024 + k); acc[e] += hv[0] * w[0] + hv[1] * w[1] + hv[2] * w[2] + hv[3] * w[3]; }
      u32x2 pk; pk.x = pk2(hv[0], hv[1]); pk.y = pk2(hv[2], hv[3]);
      *(u32x2*)(p.hbf + (size_t)t * DM + k) = pk;
    }
#pragma unroll
    for (int e = 0; e < 8; ++e) acc[e] = wave_sum(acc[e]);
    if (lane == 0) { *(f32x4*)(p.ba + (size_t)t * 8) = (f32x4){acc[0], acc[1], acc[2], acc[3]}; *(f32x4*)(p.ba + (size_t)t * 8 + 4) = (f32x4){acc[4], acc[5], acc[6], acc[7]}; }
  }
}

#define PM_WT 0
#define PM_H2 66048
#define PM_CNT 132096
#define PM_ENT 132352
__device__ void ph_post_mix(const Params& p, LAS unsigned char* lds, int nblk, int bid, int rep) {
  const int wid = p.tid >> 6, lane = p.tid & 63, r16 = lane & 15, q4 = lane >> 4;
  LAS bf16_t* wT = (LAS bf16_t*)(lds + PM_WT);
  LAS bf16_t* ht = (LAS bf16_t*)(lds + PM_H2) + wid * 4 * 1032;
  LAS int* lcnt = (LAS int*)(lds + PM_CNT);
  LAS int* lbase = lcnt + 32;
  LAS int* lent = (LAS int*)(lds + PM_ENT) + wid * 64;
  int nloc = 0;
  if (p.tid < 32) lcnt[p.tid] = 0;
  for (int i = p.tid; i < 1024 * 8; i += 512) {
    const int k = i >> 3, c = i & 7;
    const f32x4 v = *(const f32x4*)(p.w_router + (size_t)k * 32 + c * 4);
#pragma unroll
    for (int j = 0; j < 4; ++j) wT[(c * 4 + j) * 1032 + k] = f2bf_hw(v[j]);
  }
  __syncthreads();
  const float bias0 = p.b_router[r16], bias1 = p.b_router[16 + r16];
  const int tstride = nblk * 8;
  f32x4 gpv[4], gqv[4];
#pragma unroll
  for (int i4 = 0; i4 < 4; ++i4) { const int k = (i4 >> 1) * 512 + lane * 8 + (i4 & 1) * 4; gpv[i4] = *(const f32x4*)(p.g_post_mix + k); gqv[i4] = *(const f32x4*)(p.g_pre_ffn + k); }
  u32x4 mxn[2]; f32x4 xn[4];
  {
    const int t0 = bid * 8 + wid;
    if (t0 < T_TOK) {
#pragma unroll
      for (int i = 0; i < 2; ++i) mxn[i] = *(const u32x4*)(p.mixer + (size_t)t0 * DM + i * 512 + lane * 8);
#pragma unroll
      for (int i = 0; i < 4; ++i) xn[i] = *(const f32x4*)(p.x + (size_t)t0 * DM + (i >> 1) * 512 + lane * 8 + (i & 1) * 4);
    }
  }
  for (int tg = bid * 8 + wid; tg < T_TOK; tg += 4 * tstride) {
#pragma unroll 1
    for (int jj = 0; jj < 4; ++jj) {
      const int t = tg + jj * tstride;
      if (t >= T_TOK) break;
      const int b = t / SEQ;
      const float* md = p.mod + b * 6144;
      u32x4 mxc[2] = {mxn[0], mxn[1]}; f32x4 xc[4] = {xn[0], xn[1], xn[2], xn[3]};
      {
        const int tn = t + tstride;
        if (tn < T_TOK) {
#pragma unroll
          for (int i = 0; i < 2; ++i) mxn[i] = *(const u32x4*)(p.mixer + (size_t)tn * DM + i * 512 + lane * 8);
#pragma unroll
          for (int i = 0; i < 4; ++i) xn[i] = *(const f32x4*)(p.x + (size_t)tn * DM + (i >> 1) * 512 + lane * 8 + (i & 1) * 4);
        }
      }
      float mv[16];
      float ss = 0.f;
#pragma unroll
      for (int i = 0; i < 2; ++i) {
        float f[8]; unpack8(mxc[i], f);
#pragma unroll
        for (int j = 0; j < 8; ++j) { mv[i * 8 + j] = f[j]; ss += f[j] * f[j]; }
      }
      ss = wave_sum(ss);
      const float rstd = rsqrtf(ss * (1.f / DM) + 1e-6f);
      f32x4 gmv[4], scv[4], sfv[4];
#pragma unroll
      for (int i4 = 0; i4 < 4; ++i4) { const int k = (i4 >> 1) * 512 + lane * 8 + (i4 & 1) * 4; gmv[i4] = *(const f32x4*)(md + 2048 + k); scv[i4] = *(const f32x4*)(md + 4096 + k); sfv[i4] = *(const f32x4*)(md + 3072 + k); }
      float x1[16];
      float s2 = 0.f;
#pragma unroll
      for (int i = 0; i < 2; ++i)
#pragma unroll
        for (int j4 = 0; j4 < 2; ++j4) {
          const int k = i * 512 + lane * 8 + j4 * 4;
          const f32x4 xv = xc[i * 2 + j4];
          const f32x4 gm = gmv[i * 2 + j4], gp = gpv[i * 2 + j4];
          f32x4 o;
#pragma unroll
          for (int j = 0; j < 4; ++j) { o[j] = xv[j] + gm[j] * (mv[i * 8 + j4 * 4 + j] * rstd * gp[j]); x1[i * 8 + j4 * 4 + j] = o[j]; s2 += o[j] * o[j]; }
          *(f32x4*)(p.out + (size_t)t * DM + k) = o;
        }
      s2 = wave_sum(s2);
      const float rstd2 = rsqrtf(s2 * (1.f / DM) + 1e-6f);
#pragma unroll
      for (int i = 0; i < 2; ++i) {
        float hv[8];
#pragma unroll
        for (int j4 = 0; j4 < 2; ++j4) {
          const int k = i * 512 + lane * 8 + j4 * 4;
          const f32x4 gq = gqv[i * 2 + j4], sc = scv[i * 2 + j4], sf = sfv[i * 2 + j4];
#pragma unroll
          for (int j = 0; j < 4; ++j) hv[j4 * 4 + j] = x1[i * 8 + j4 * 4 + j] * rstd2 * gq[j] * (1.f + sc[j]) + sf[j];
        }
        u32x2 w; w.x = pk4_fp8(hv[0], hv[1], hv[2], hv[3]); w.y = pk4_fp8(hv[4], hv[5], hv[6], hv[7]);
        *(u32x2*)(p.h2q + (size_t)t * DM + i * 512 + lane * 8) = w;
        u32x4 hb; hb.x = pk2(hv[0], hv[1]); hb.y = pk2(hv[2], hv[3]); hb.z = pk2(hv[4], hv[5]); hb.w = pk2(hv[6], hv[7]);
        *(LAS u32x4*)(ht + jj * 1032 + i * 512 + lane * 8) = hb;
      }
    }
    f32x4 acc0 = {0.f, 0.f, 0.f, 0.f}, acc1 = {0.f, 0.f, 0.f, 0.f};
#pragma unroll 8
    for (int ks = 0; ks < 32; ++ks) {
      const bf16x8 a = *(const LAS bf16x8*)(ht + (r16 & 3) * 1032 + 32 * ks + 8 * q4);
      const bf16x8 b0 = *(const LAS bf16x8*)(wT + r16 * 1032 + 32 * ks + 8 * q4);
      const bf16x8 b1 = *(const LAS bf16x8*)(wT + (16 + r16) * 1032 + 32 * ks + 8 * q4);
      acc0 = MFMA16(a, b0, acc0); acc1 = MFMA16(a, b1, acc1);
    }
#pragma unroll
    for (int jj = 0; jj < 4; ++jj) {
      const int t = tg + jj * tstride;
      if (t < T_TOK) {
        float l0 = (lane < 16) ? acc0[jj] + bias0 : -INFINITY, l1 = (lane < 16) ? acc1[jj] + bias1 : -INFINITY;
        float tv[4]; int ti[4];
#pragma unroll
        for (int r = 0; r < 4; ++r) {
          const float m = wave_max(fmaxf(l0, l1));
          const unsigned long long b0m = __ballot(l0 == m);
          int idx;
          if (b0m) { idx = __ffsll((long long)b0m) - 1; if (lane == idx) l0 = -INFINITY; }
          else { const unsigned long long b1m = __ballot(l1 == m); idx = __ffsll((long long)b1m) - 1; if (lane == idx) l1 = -INFINITY; idx += 16; }
          tv[r] = m; ti[r] = idx;
        }
        const float e1 = __expf(tv[1] - tv[0]), e2 = __expf(tv[2] - tv[0]), e3 = __expf(tv[3] - tv[0]);
        const float inv = 1.f / (1.f + e1 + e2 + e3);
        if (lane < 4) {
          const int ee = lane == 0 ? ti[0] : lane == 1 ? ti[1] : lane == 2 ? ti[2] : ti[3];
          const float ww = (lane == 0 ? 1.f : lane == 1 ? e1 : lane == 2 ? e2 : e3) * inv;
          p.aw[t * 4 + lane] = ww;
          const int rank = __hip_atomic_fetch_add(&lcnt[ee], 1, __ATOMIC_RELAXED, __HIP_MEMORY_SCOPE_WORKGROUP);
          lent[nloc * 4 + lane] = (ee << 16) | rank;
          lent[nloc * 4 + lane + 2048] = t * 4 + lane;
        }
        ++nloc;
      }
    }
  }
  __syncthreads();
  if (p.tid < 32) lbase[p.tid] = atomicAdd(&p.cnt[p.tid * 64 + 32 * rep], lcnt[p.tid]);
  __syncthreads();
  for (int i = lane; i < nloc * 4; i += 64) {
    const int er = lent[i], a = lent[i + 2048];
    p.elist[(er >> 16) * T_TOK + lbase[er >> 16] + (er & 0xffff)] = a;
  }
}

__device__ void ph_final(const Params& p, int nblk, int bid, int rep) {
  const int wid = p.tid >> 6, lane = p.tid & 63;
  f32x4 gpf[4];
#pragma unroll
  for (int i4 = 0; i4 < 4; ++i4) gpf[i4] = *(const f32x4*)(p.g_post_ffn + (i4 >> 1) * 512 + lane * 8 + (i4 & 1) * 4);
  for (int t0 = bid * 8 + wid; t0 < T_TOK; t0 += nblk * 16) {
    int tt[2] = {t0, t0 + nblk * 8};
    if (tt[1] >= T_TOK) tt[1] = t0;
    float mv[2][16]; float ss[2];
#pragma unroll
    for (int u = 0; u < 2; ++u) {
      const int t = tt[u];
      const f32x4 wv = *(const f32x4*)(p.aw + t * 4);
      ss[u] = 0.f;
#pragma unroll
      for (int i = 0; i < 2; ++i) {
        const bf16_t* y = p.yslot + (size_t)t * 4 * DM + i * 512 + lane * 8;
        float f0[8], f1[8], f2[8], f3[8];
        unpack8(*(const u32x4*)y, f0); unpack8(*(const u32x4*)(y + DM), f1); unpack8(*(const u32x4*)(y + 2 * DM), f2); unpack8(*(const u32x4*)(y + 3 * DM), f3);
#pragma unroll
        for (int j = 0; j < 8; ++j) { const float m = wv[0] * f0[j] + wv[1] * f1[j] + wv[2] * f2[j] + wv[3] * f3[j]; mv[u][i * 8 + j] = m; ss[u] += m * m; }
      }
    }
    f32x4 x1[2][4];
#pragma unroll
    for (int u = 0; u < 2; ++u)
#pragma unroll
      for (int i = 0; i < 2; ++i)
#pragma unroll
        for (int j4 = 0; j4 < 2; ++j4) x1[u][i * 2 + j4] = *(const f32x4*)(p.out + (size_t)tt[u] * DM + i * 512 + lane * 8 + j4 * 4);
    f32x4 gfv[2][4];
#pragma unroll
    for (int u = 0; u < 2; ++u)
#pragma unroll
      for (int i4 = 0; i4 < 4; ++i4) gfv[u][i4] = *(const f32x4*)(p.mod + (tt[u] / SEQ) * 6144 + 5120 + (i4 >> 1) * 512 + lane * 8 + (i4 & 1) * 4);
    ss[0] = wave_sum(ss[0]); ss[1] = wave_sum(ss[1]);
#pragma unroll
    for (int u = 0; u < 2; ++u) {
      const int t = tt[u];
      if (u == 1 && t == t0) break;
      const float rstd = rsqrtf(ss[u] * (1.f / DM) + 1e-6f);
#pragma unroll
      for (int i = 0; i < 2; ++i)
#pragma unroll
        for (int j4 = 0; j4 < 2; ++j4) {
          const int k = i * 512 + lane * 8 + j4 * 4;
          float* op = p.out + (size_t)t * DM + k;
          const f32x4 gf = gfv[u][i * 2 + j4], gp = gpf[i * 2 + j4];
          f32x4 o;
#pragma unroll
          for (int j = 0; j < 4; ++j) o[j] = x1[u][i * 2 + j4][j] + gf[j] * (mv[u][i * 8 + j4 * 4 + j] * rstd * gp[j]);
          *(f32x4*)(rep ? (float*)p.hbf + (size_t)(t & 8191) * DM + k : op) = o;
        }
    }
  }
}

#define XCD_BAR_WORDS 3456
struct KArgs { const void* in[22]; float* out; char* ws; long long never; };
__host__ __device__ inline size_t al(size_t x) { return (x + 255) & ~(size_t)255; }
__host__ __device__ inline void fill_params(Params& p, const KArgs& k) {
  p.x = (const float*)k.in[0]; p.c = (const float*)k.in[1]; p.w_ada = (const float*)k.in[2]; p.b_ada = (const float*)k.in[3];
  p.g_pre_mix = (const float*)k.in[4]; p.g_post_mix = (const float*)k.in[5]; p.g_pre_ffn = (const float*)k.in[6];
  p.g_post_ffn = (const float*)k.in[7]; p.w_in = (const float*)k.in[8]; p.conv_w = (const float*)k.in[9];
  p.a_log = (const float*)k.in[10]; p.dt_bias = (const float*)k.in[11]; p.g_dn_out = (const float*)k.in[12];
  p.w_br_a = (const float*)k.in[13]; p.w_br_b = (const float*)k.in[14]; p.w_o = (const float*)k.in[15];
  p.w_router = (const float*)k.in[16]; p.b_router = (const float*)k.in[17]; p.w_gu = (const float*)k.in[18];
  p.b_gu = (const float*)k.in[19]; p.w_down = (const float*)k.in[20]; p.b_down = (const float*)k.in[21];
  p.out = k.out;
  char* w = k.ws;
  size_t o = 0;
#define take(bytes) (w + (o += al(bytes)) - al(bytes))
  p.mod = (float*)take(4 * 6144 * 4);
  p.cnt = (int*)take(16384);
  p.ba = (float*)take((size_t)T_TOK * 8 * 4);
  p.hbf = (bf16_t*)take((size_t)T_TOK * DM * 2);
  p.proj = (bf16_t*)take((size_t)T_TOK * PW * 2);
  p.w_in_t = (bf16_t*)take((size_t)PW * DM * 2);
  p.wgu8 = (unsigned char*)take((size_t)NE * 2048 * DM);
  p.wd8 = (unsigned char*)take((size_t)NE * 1024 * DM);
  p.h2q = (unsigned char*)take((size_t)T_TOK * DM);
  p.act8 = (unsigned char*)take((size_t)73728 * DM);
  p.wbra_t = (bf16_t*)take((size_t)1024 * 512 * 2);
  p.wbrb_t = (bf16_t*)take((size_t)1024 * 512 * 2);
  p.wo_t = (bf16_t*)take((size_t)1024 * 1024 * 2);
  p.qb = (bf16_t*)take((size_t)T_TOK * 512 * 2);
  p.kb = nullptr;
  p.kmean = (float*)take((size_t)16 * 16 * 128 * 4);
  p.oab = (bf16_t*)take((size_t)T_TOK * DM * 2);
  p.merged = (bf16_t*)take((size_t)T_TOK * DM * 2);
  p.mixer = (bf16_t*)take((size_t)T_TOK * DM * 2);
  p.h2 = nullptr;
  p.elist = (int*)take((size_t)NE * T_TOK * 4);
  p.aw = (float*)take((size_t)T_TOK * 4 * 4);
  p.rowmap = nullptr;
  p.dnA = (unsigned char*)take((size_t)1024 * DN_ABYTES);
  p.dnU = (float*)take((size_t)1024 * DN_UFLOATS * 4);
  p.dnG = (float*)take(4096);
  p.oab2 = (bf16_t*)take((size_t)T_TOK * 512 * 2);
  p.dbg = (float*)take(256);
  p.bar = (unsigned*)take(XCD_BAR_WORDS * 4);
  p.dn_out = p.oab; p.dn_out_ld = DM;
  p.Kp = (bf16_t*)take((size_t)16 * 128 * 8192);
  p.Vp = (bf16_t*)take((size_t)16 * 128 * 8192);
  p.wq = p.cnt + 32 * 64;
  p.mb_out = p.oab; p.mb_out_ld = DM; p.mb_out_off = 512;
  p.xs = nullptr; p.act = nullptr;
  p.yslot = (bf16_t*)take((size_t)65536 * DM * 2);
  p.nq = p.nk = p.nv = p.no = p.ntmp = p.nbeta = p.ng = nullptr;
#undef take
#undef t2
  p.never = (int)k.never;
}

#define XB_TMO      128
#define XB_XCNT(j)  (256  + 64 * (j))
#define XB_XSUB(j)  (1280 + 64 * (j))
#define XB_XGEN(j)  (2304 + 64 * (j))
#define XB_TOP      3328
#define XB_TOPGEN   3392
#define XB_SPIN_CAP (1u << 18)

__device__ __forceinline__ unsigned xb_ld(unsigned* p)              { return __hip_atomic_load(p, __ATOMIC_RELAXED, __HIP_MEMORY_SCOPE_AGENT); }
__device__ __forceinline__ unsigned xb_add(unsigned* p, unsigned v) { return __hip_atomic_fetch_add(p, v, __ATOMIC_RELAXED, __HIP_MEMORY_SCOPE_AGENT); }
__device__ __forceinline__ unsigned xb_xcc_id() { return (unsigned)__builtin_amdgcn_s_getreg((3 << 11) | 20) & 0xFu; }
#define XB_SPIN(cond, bar) do { unsigned _sp = 0; while (cond) { __builtin_amdgcn_s_sleep(1); \
    if ((++_sp & 255u) == 0u) { if (xb_ld(&(bar)[XB_TMO])) break; if (_sp > XB_SPIN_CAP) { atomicAdd(&(bar)[XB_TMO], 1u); break; } } } } while (0)

struct XcdBarrier {
    unsigned* bar; unsigned x;
    volatile LAS unsigned* st;
};

__device__ __forceinline__ XcdBarrier xcd_barrier_post(unsigned* bar, volatile LAS unsigned* st) {
    XcdBarrier b; b.bar = bar; b.x = xb_xcc_id(); b.st = st;
    if (threadIdx.x == 0) (void)xb_add(&bar[XB_XCNT(b.x)], 1u);
    return b;
}
__device__ __forceinline__ void xcd_barrier_complete(unsigned* bar, unsigned x, unsigned& nloc, unsigned& nx) {
    const unsigned G = gridDim.x * gridDim.y * gridDim.z;
    unsigned sum, cnt, mine, sp = 0u;
    for (;;) {
        sum = 0u; cnt = 0u; mine = 0u;
#pragma unroll
        for (unsigned j = 0; j < 16; ++j) { const unsigned c = xb_ld(&bar[XB_XCNT(j)]); sum += c; cnt += (c > 0u) ? 1u : 0u; mine = (j == x) ? c : mine; }
        if (sum == G) break;
        __builtin_amdgcn_s_sleep(1);
        if ((++sp & 255u) == 0u) { if (xb_ld(&bar[XB_TMO])) break; if (sp > XB_SPIN_CAP) { atomicAdd(&bar[XB_TMO], 1u); break; } }
    }
    nloc = mine > 0u ? mine : 1u; nx = cnt > 0u ? cnt : 1u;
}

__device__ __forceinline__ void xcd_barrier(const XcdBarrier& b, const int tid) {
    asm volatile("s_waitcnt vmcnt(0)" ::: "memory");
    __syncthreads();
    if (tid == 0) {
        unsigned* bar = b.bar;
        __builtin_amdgcn_s_waitcnt(0);
        unsigned nloc = b.st[0], nx = b.st[1];
        if (nloc == 0u) { xcd_barrier_complete(bar, b.x, nloc, nx); b.st[0] = nloc; b.st[1] = nx; }
        const unsigned old = xb_add(&bar[XB_XSUB(b.x)], 1u);
        const unsigned gen = old / nloc;
        if (old + 1u == (gen + 1u) * nloc) {
            __builtin_amdgcn_fence(__ATOMIC_RELEASE, "agent");
            asm volatile("s_waitcnt vmcnt(0)" ::: "memory");
            const unsigned og = xb_add(&bar[XB_TOP], 1u);
            const unsigned tg = og / nx;
            if (og + 1u == (tg + 1u) * nx) xb_add(&bar[XB_TOPGEN], 1u);
            else XB_SPIN(xb_ld(&bar[XB_TOPGEN]) == tg, bar);
            __builtin_amdgcn_fence(__ATOMIC_ACQUIRE, "agent");
            xb_add(&bar[XB_XGEN(b.x)], 1u);
            asm volatile("s_waitcnt vmcnt(0)" ::: "memory");
        } else {
            XB_SPIN(xb_ld(&bar[XB_XGEN(b.x)]) == gen, bar);
            __builtin_amdgcn_fence(__ATOMIC_ACQUIRE, "agent");
            asm volatile("s_waitcnt vmcnt(0)" ::: "memory");
        }
    }
    __syncthreads();
}


__device__ __forceinline__ void load_ka(KArgs& kk) {
#if defined(__HIP_DEVICE_COMPILE__)
  typedef __attribute__((address_space(1))) char* gptr_t;
  typedef const __attribute__((address_space(4))) gptr_t* kptr_t;
  kptr_t kp = (kptr_t)__builtin_amdgcn_kernarg_segment_ptr();
  asm volatile("" : "+s"(kp));
#pragma unroll
  for (int i = 0; i < 22; ++i) kk.in[i] = (const void*)kp[i];
  kk.out = (float*)kp[22];
  kk.ws = (char*)kp[23];
  kk.never = ((const __attribute__((address_space(4))) long long*)kp)[24];
#endif
}
__device__ __forceinline__ void grid_bar(const Params& p, LAS unsigned char* lds);
#define MEGA_LDS 148480
#define MEGA_LDS_ALLOC (MEGA_LDS + 16)
__device__ __forceinline__ void grid_bar(const Params& p, LAS unsigned char* lds) {
  XcdBarrier b; b.bar = p.bar; b.x = xb_xcc_id(); b.st = (volatile LAS unsigned*)(lds + MEGA_LDS);
  xcd_barrier(b, p.tid);
}
__global__ __launch_bounds__(512) void mega(KArgs ka) {
  extern __shared__ __attribute__((aligned(16))) unsigned char shm[];
  LAS unsigned char* lds = (LAS unsigned char*)shm;
  cg::grid_group grid = cg::this_grid();
  const int nblk = gridDim.x, bid = blockIdx.x;
  const int wv_ = __builtin_amdgcn_readfirstlane(threadIdx.x >> 6);
  volatile LAS unsigned* xst = (volatile LAS unsigned*)(lds + MEGA_LDS);
  if (threadIdx.x == 0) { xst[0] = 0u; xst[1] = 0u; xst[2] = 0u; xst[3] = 0u; }
  __syncthreads();
  { Params p0; fill_params(p0, ka); (void)xcd_barrier_post(p0.bar, xst); }
  if (ka.never) grid.sync();
#ifndef REPMASK
#define REPMASK 0
#endif
#define LOADKA KArgs kk; load_ka(kk)
#ifndef PHMASK
#define PHMASK 0xffff
#endif
#define PHASE(k, body) if (((PHMASK) >> (k)) & 1) for (int rep_ = 0; rep_ < (((REPMASK) >> (k)) & 1) + 1; ++rep_) { \
    LOADKA; Params p; fill_params(p, kk); { int t_; asm volatile("v_mbcnt_lo_u32_b32 %0, -1, 0\n\tv_mbcnt_hi_u32_b32 %0, -1, %0" : "=v"(t_)); p.tid = (wv_ << 6) | t_; } body; grid_bar(p, lds); }
#ifdef XBAR
  for (int xb_ = 0; xb_ < XBAR; ++xb_) { PHASE(15, {}) }
#endif
  PHASE(0, { ph_mod(p, lds, nblk, bid); ph_wt(p, lds, nblk, bid); })
  PHASE(1, { ph_h(p, lds, nblk, bid); })
  PHASE(2, { ph_proj(p, lds, nblk, bid); })
  PHASE(3, { bool first = true; for (int ci = bid; ci < 1024; ci += nblk) { dn_prep_chunk(p, lds, ci, first); first = false; }
             for (int item = bid; item < 256; item += nblk) moba_prep_block(p, lds, item); })
  PHASE(4, { if (bid < 32) dn_scan_blk(p, lds, bid); moba_worker(p, lds, rep_); })
  PHASE(5, { ph_dn_norm(p, nblk, bid); })
  PHASE(6, { ph_br(p, lds, nblk, bid); })
  PHASE(7, { ph_mix(p, lds, nblk, bid); })
  PHASE(8, { ph_post_mix(p, lds, nblk, bid, rep_); })
  PHASE(10, { ph_moe1(p, lds, nblk, bid); })
  PHASE(11, { ph_moe2(p, lds, nblk, bid); })
  PHASE(12, { ph_final(p, nblk, bid, rep_); })
}


extern "C" void kernel_launch(void* const* d_in, const int* in_sizes, int n_in, void* d_out, int out_size, void* d_ws,
                              size_t ws_size, hipStream_t stream) {
  KArgs ka{};
  for (int i = 0; i < 22; ++i) ka.in[i] = d_in[i];
  ka.out = (float*)d_out; ka.ws = (char*)d_ws; ka.never = 0;
  Params p{};
  fill_params(p, ka);
  static int grid_blocks = 0;
  if (!grid_blocks) {
    (void)hipFuncSetAttribute((const void*)mega, hipFuncAttributeMaxDynamicSharedMemorySize, MEGA_LDS_ALLOC);
    int dev = 0, cus = 0, per_cu = 0;
    (void)hipGetDevice(&dev);
    (void)hipDeviceGetAttribute(&cus, hipDeviceAttributeMultiprocessorCount, dev);
    (void)hipOccupancyMaxActiveBlocksPerMultiprocessor(&per_cu, mega, 512, MEGA_LDS_ALLOC);
    if (per_cu != 1) per_cu = 1;
    grid_blocks = cus * per_cu;
  }
  (void)hipMemsetAsync(p.cnt, 0, 16384, stream);
  (void)hipMemsetAsync(p.bar, 0, XCD_BAR_WORDS * 4, stream);
  void* args[] = {&ka};
  hipError_t e = hipLaunchCooperativeKernel((void*)mega, dim3(grid_blocks), dim3(512), args, MEGA_LDS_ALLOC, stream);
  if (e != hipSuccess) fprintf(stderr, "cooperative launch failed: %s (grid %d)\n", hipGetErrorString(e), grid_blocks);
}
```

```cpp
#include <hip/hip_runtime.h>
#include <hip/hip_cooperative_groups.h>
#include <cstdio>
namespace cg = cooperative_groups;
#include <stdint.h>

typedef unsigned short bf16_t;
#ifndef MB_ABL
#define MB_ABL 0
#endif

#define T_TOK 16384
#define SEQ 4096
#define NB 4
#define DM 1024
#define INW 5640
#define PW 5632
#define C_QA 0
#define C_KA 512
#define C_VA 1024
#define C_Z 1536
#define C_MQ 2048
#define C_MK 2560
#define C_MV 3072
#define C_GA 3584
#define C_GB 4608
#define NE 32

__device__ __forceinline__ bf16_t f2bf(float f) {
  unsigned u = __float_as_uint(f);
  u += 0x7fffu + ((u >> 16) & 1u);
  return (bf16_t)(u >> 16);
}
__device__ __forceinline__ float bf2f(bf16_t h) { return __uint_as_float(((unsigned)h) << 16); }
__device__ __forceinline__ float sigmoidf_(float x) { return __builtin_amdgcn_rcpf(1.f + __builtin_amdgcn_exp2f(-1.4426950408889634f * x)); }
__device__ __forceinline__ float siluf_(float x) { return x * sigmoidf_(x); }
__device__ __forceinline__ float wave_sum(float v) {
#pragma unroll
  for (int o = 32; o > 0; o >>= 1) v += __shfl_xor(v, o, 64);
  return v;
}
__device__ __forceinline__ float wave_max(float v) {
#pragma unroll
  for (int o = 32; o > 0; o >>= 1) v = fmaxf(v, __shfl_xor(v, o, 64));
  return v;
}

typedef unsigned u32x2 __attribute__((ext_vector_type(2)));
typedef __bf16 bf16x2_t __attribute__((ext_vector_type(2)));
typedef float f32x2_t __attribute__((ext_vector_type(2)));
__device__ __forceinline__ unsigned pk2(float a, float b) { f32x2_t v = {a, b}; bf16x2_t r = __builtin_convertvector(v, bf16x2_t); return __builtin_bit_cast(unsigned, r); }

__device__ __forceinline__ unsigned pk4_fp8(float a, float b, float c, float d) {
  int w = 0;
  w = __builtin_amdgcn_cvt_pk_fp8_f32(a, b, w, false);
  w = __builtin_amdgcn_cvt_pk_fp8_f32(c, d, w, true);
  return (unsigned)w;
}

struct Params {
  const float *x, *c, *w_ada, *b_ada, *g_pre_mix, *g_post_mix, *g_pre_ffn, *g_post_ffn, *w_in, *conv_w,
      *a_log, *dt_bias, *g_dn_out, *w_br_a, *w_br_b, *w_o, *w_router, *b_router, *w_gu, *b_gu, *w_down, *b_down;
  float* out;
  float* mod;
  int* cnt;
  float* ba;
  bf16_t* hbf;
  bf16_t* proj;
  bf16_t* w_in_t;
  unsigned char* wgu8;
  unsigned char* wd8;
  unsigned char* h2q;
  unsigned char* act8;
  bf16_t* wbra_t;
  bf16_t* wbrb_t;
  bf16_t* wo_t;
  bf16_t* qb;
  bf16_t* kb;
  float* kmean;
  bf16_t* oab;
  bf16_t* merged;
  bf16_t* mixer;
  bf16_t* h2;
  int* elist;
  float* aw;
  bf16_t* act;
  bf16_t* xs;
  int* rowmap;
  bf16_t* yslot;
  unsigned char* dnA; float* dnU; float* dnG;
  unsigned char* dnS; unsigned char* dnV;
  bf16_t* dn_out; int dn_out_ld;
  bf16_t* oab2; float* dbg;
  unsigned* bar; int never; int tid;
  bf16_t* Kp; bf16_t* Vp; int* wq;
  bf16_t* mb_out; int mb_out_ld; int mb_out_off;
  float* nq; float* nk; float* nv;
  float* nbeta; float* ng;
  float* no;
  float* ntmp;
};

__device__ __forceinline__ int map_col(int n, int mode) {
  if (mode == 0) return n;
  if (mode == 1) return n < 2048 ? n : (n < 2056 ? -1 : n - 8);
  if (n < 1024) return (n >> 7) * 256 + (n & 127);
  int j = n - 1024;
  return (j >> 7) * 256 + 128 + (j & 127);
}
namespace pg8 {
#define PG8_LAS __attribute__((address_space(3)))
typedef short bf16x8 __attribute__((ext_vector_type(8)));
typedef float f32x4 __attribute__((ext_vector_type(4)));
typedef unsigned u32x4 __attribute__((ext_vector_type(4)));
constexpr int BM = 256, BK = 64, HALF = 128, HTB = HALF * BK * 2, STAGE_BYTES = 8 * HTB, NXCD = 8, WGM = 8;

__host__ __device__ __forceinline__ int lds_byte(int r, int c) { const int st = (r >> 4) * 2 + (c >> 5), rr = r & 15, cc = c & 31, ob = rr * 64 + cc * 2; return st * 1024 + (ob ^ (((ob >> 9) & 1) << 5)); }
__host__ __device__ __forceinline__ void stage_rc(int b, int& R, int& C) { const int st = b / 1024, sb = b % 1024, swz = sb ^ (((sb >> 9) & 1) << 5); R = (st >> 1) * 16 + swz / 64; C = (st & 1) * 32 + (swz % 64) / 2; }
__host__ __device__ __forceinline__ int perm32(int rho) { const int n = rho >> 4, i = rho & 15; return 8 * (i >> 2) + 4 * n + (i & 3); }

struct Unit { int pm, pn, z; };
__device__ __forceinline__ unsigned cvt_pk_bf16(float lo, float hi) { unsigned r; asm volatile("v_cvt_pk_bf16_f32 %0, %1, %2" : "=v"(r) : "v"(lo), "v"(hi)); return r; }

typedef int i32x8 __attribute__((ext_vector_type(8)));
typedef int i32x4 __attribute__((ext_vector_type(4)));
__device__ __forceinline__ i32x8 cat8(const bf16x8 lo, const bf16x8 hi) { const i32x4 a = __builtin_bit_cast(i32x4, lo), b = __builtin_bit_cast(i32x4, hi); return __builtin_shufflevector(a, b, 0, 1, 2, 3, 4, 5, 6, 7); }
struct TileOrder {
    int nM, nN, nwg, G, c;
    __device__ void init(int nM_, int nN_, int G_, int c_) { nM = nM_; nN = nN_; nwg = nM * nN; G = G_; c = c_; }
    __device__ bool tile(int i, int& pm, int& pn) const {
        const long L = (long)i * G + c; if (L >= nwg) return false;
        int wgid = (int)L; { const int q = nwg / NXCD, r = nwg % NXCD, xcd = wgid % NXCD, off = wgid / NXCD; wgid = (xcd < r ? xcd * (q + 1) : r * (q + 1) + (xcd - r) * q) + off; }
        const int nig = WGM * nN, gid = wgid / nig, fm = gid * WGM, gsz = (nM - fm) < WGM ? (nM - fm) : WGM;
        pm = fm + ((wgid % nig) % gsz); pn = (wgid % nig) / gsz; return true;
    }
};

template <class Epi, class Sched, bool FP8 = false>
__device__ __forceinline__ void gemm_phase(PG8_LAS unsigned char* lds, const int tid, const int lda, const int ldb, const int K, const Sched& S, const Epi& E) {
    const int wid = __builtin_amdgcn_readfirstlane(tid >> 6), lane = tid & 63, wr = wid >> 2, wc = wid & 3, fr = lane & 15, fq = lane >> 4;
    const int nt = K / BK;
    unsigned voffA[2], voffB[2];
#pragma unroll
    for (int i = 0; i < 2; ++i) { int R, C; stage_rc(tid * 16 + i * 8192, R, C); const int Rb = Epi::PERM ? ((R & ~31) + perm32(R & 31)) : R;
        voffA[i] = (unsigned)(R * lda + C) * 2u; voffB[i] = (unsigned)(Rb * ldb + C) * 2u; }
    const size_t kstep = (size_t)(BK * 2);
    const size_t hstepA = (size_t)HALF * lda * 2, hstepB = (size_t)HALF * ldb * 2;
    const unsigned ldsw = (unsigned)wid * 1024u;
    const int aoff = lds_byte(wr * 64 + fr, fq * 8), boff = lds_byte(wc * 32 + fr, fq * 8);
    constexpr int KOFF1 = 1024;
    unsigned gA[2][2] = {{0u, 0u}, {0u, 0u}}, gAn[2][2] = {{0u, 0u}, {0u, 0u}};
#define PG8_GOFFS(dst, unit) do { int t_ = tid; asm volatile("" : "+v"(t_)); _Pragma("unroll") for (int i_ = 0; i_ < 2; ++i_) { int gR_, gC_; stage_rc(t_ * 16 + i_ * 8192, gR_, gC_); \
        _Pragma("unroll") for (int h_ = 0; h_ < 2; ++h_) dst[h_][i_] = S.a_goff(unit, gR_ + 128 * h_, gC_); } } while (0)
#define PG8_SA(b, h) (((b) * 2 + (h)) * HTB)
#define PG8_SB(b, h) ((4 + (b) * 2 + (h)) * HTB)
#define PG8_STAGE(bufoff, gbase, voff) do { _Pragma("unroll") for (int _i = 0; _i < 2; ++_i) \
        __builtin_amdgcn_global_load_lds((const unsigned*)((const char*)(gbase) + (voff)[_i]), (PG8_LAS unsigned*)(lds + (bufoff) + ldsw + _i * 8192), 16, 0, 0); } while (0)
#define PG8_STAGEA(bufoff, ptr, h, nx) do { if constexpr (Sched::GATHER) { const unsigned gs_[2] = {(nx) ? gAn[h][0] : gA[h][0], (nx) ? gAn[h][1] : gA[h][1]}; PG8_STAGE(bufoff, ptr, gs_); } \
        else { PG8_STAGE(bufoff, (ptr) + (h) * hstepA, voffA); } } while (0)
#define PG8_LDA(dst, b, h) do { if constexpr (FP8) { _Pragma("unroll") for (int m = 0; m < 4; ++m) dst##8[m] = cat8(*(const PG8_LAS bf16x8*)(lds + PG8_SA(b, h) + aoff + m * 2048), *(const PG8_LAS bf16x8*)(lds + PG8_SA(b, h) + aoff + KOFF1 + m * 2048)); } \
        else { _Pragma("unroll") for (int m = 0; m < 4; ++m) _Pragma("unroll") for (int k = 0; k < 2; ++k) dst[m][k] = *(const PG8_LAS bf16x8*)(lds + PG8_SA(b, h) + aoff + k * KOFF1 + m * 2048); } } while (0)
#define PG8_LDB(dst, b, h) do { if constexpr (FP8) { _Pragma("unroll") for (int n = 0; n < 2; ++n) dst##8[n] = cat8(*(const PG8_LAS bf16x8*)(lds + PG8_SB(b, h) + boff + n * 2048), *(const PG8_LAS bf16x8*)(lds + PG8_SB(b, h) + boff + KOFF1 + n * 2048)); } \
        else { _Pragma("unroll") for (int n = 0; n < 2; ++n) _Pragma("unroll") for (int k = 0; k < 2; ++k) dst[n][k] = *(const PG8_LAS bf16x8*)(lds + PG8_SB(b, h) + boff + k * KOFF1 + n * 2048); } } while (0)
#define PG8_MMA(ai, bj, At, Bt) do { __builtin_amdgcn_s_setprio(1); if constexpr (FP8) { _Pragma("unroll") for (int m = 0; m < 4; ++m) _Pragma("unroll") for (int n = 0; n < 2; ++n) \
        asm volatile("v_mfma_f32_16x16x128_f8f6f4 %0, %1, %2, %0" : "+v"(acc[ai][bj][m][n]) : "v"(Bt##8[n]), "v"(At##8[m])); } \
        else { _Pragma("unroll") for (int m = 0; m < 4; ++m) _Pragma("unroll") for (int n = 0; n < 2; ++n) _Pragma("unroll") for (int k = 0; k < 2; ++k) \
        acc[ai][bj][m][n] = __builtin_amdgcn_mfma_f32_16x16x32_bf16(Bt[n][k], At[m][k], acc[ai][bj][m][n], 0, 0, 0); } __builtin_amdgcn_s_setprio(0); } while (0)
#define PG8_WAIT_V(n) asm volatile("s_waitcnt vmcnt(" #n ")" ::: "memory")
#define PG8_WAIT_L(n) asm volatile("s_waitcnt lgkmcnt(" #n ")" ::: "memory")
#define PG8_BAR __builtin_amdgcn_s_barrier()
#define PG8_SCHED __builtin_amdgcn_sched_barrier(0)
    Unit cur, nxt; int ui = 0;
    if (!S.next(0, cur)) return;
    f32x4 acc[2][2][4][2];
#pragma unroll
    for (int a = 0; a < 2; ++a)
#pragma unroll
        for (int b = 0; b < 2; ++b)
#pragma unroll
            for (int m = 0; m < 4; ++m)
#pragma unroll
                for (int n = 0; n < 2; ++n) acc[a][b][m][n] = (f32x4){0.f, 0.f, 0.f, 0.f};
    bf16x8 At[4][2], B0[2][2], B1[2][2];
    i32x8 At8[4], B08[2], B18[2];
    const char* cA = S.a_ptr(cur); const char* cB = S.b_ptr(cur);
    if constexpr (Sched::GATHER) { PG8_GOFFS(gA, cur); }
    PG8_STAGE(PG8_SB(0, 0), cB, voffB); PG8_STAGEA(PG8_SA(0, 0), cA, 0, false); PG8_STAGE(PG8_SB(0, 1), cB + hstepB, voffB); PG8_STAGEA(PG8_SA(0, 1), cA, 1, false);
    if (wr == 1) PG8_BAR;
    PG8_WAIT_V(4); PG8_BAR;
    PG8_STAGE(PG8_SB(1, 0), cB + kstep, voffB); PG8_STAGEA(PG8_SA(1, 0), cA + kstep, 0, false); PG8_STAGE(PG8_SB(1, 1), cB + hstepB + kstep, voffB);
    PG8_WAIT_V(6); PG8_BAR;
    for (;;) {
        const bool has_next = S.next(ui + 1, nxt);
        const char* nA = has_next ? S.a_ptr(nxt) : cA; const char* nB = has_next ? S.b_ptr(nxt) : cB;
        if constexpr (Sched::GATHER) { if (has_next) { PG8_GOFFS(gAn, nxt); } else {
_Pragma("unroll") for (int h = 0; h < 2; ++h) _Pragma("unroll") for (int i = 0; i < 2; ++i) gAn[h][i] = gA[h][i]; } }
_Pragma("unroll 1")
        for (int t = 0; t < nt; t += 2) {
            const bool last = (t == nt - 2);
            const char* a1 = cA + (size_t)(t + 1) * kstep;
            const char* a2 = last ? nA : cA + (size_t)(t + 2) * kstep; const char* b2 = last ? nB : cB + (size_t)(t + 2) * kstep;
            const char* a3 = a2 + kstep; const char* b3 = b2 + kstep;
            PG8_LDB(B0, 0, 0); PG8_SCHED; PG8_LDA(At, 0, 0); PG8_STAGEA(PG8_SA(1, 1), a1, 1, false);
            PG8_WAIT_L(8); PG8_BAR; PG8_WAIT_L(0); PG8_MMA(0, 0, At, B0); PG8_BAR; PG8_SCHED;
            PG8_LDB(B1, 0, 1); PG8_STAGE(PG8_SB(0, 0), b2, voffB);
            PG8_BAR; PG8_WAIT_L(0); PG8_MMA(0, 1, At, B1); PG8_BAR;
            PG8_LDA(At, 0, 1); PG8_STAGEA(PG8_SA(0, 0), a2, 0, last);
            PG8_BAR; PG8_WAIT_L(0); PG8_MMA(1, 0, At, B0); PG8_BAR; PG8_SCHED;
            PG8_STAGE(PG8_SB(0, 1), b2 + hstepB, voffB);
            PG8_WAIT_V(6); PG8_BAR; PG8_MMA(1, 1, At, B1); PG8_BAR;
            PG8_LDB(B0, 1, 0); PG8_SCHED; PG8_LDA(At, 1, 0); PG8_STAGEA(PG8_SA(0, 1), a2, 1, last);
            PG8_WAIT_L(8); PG8_BAR; PG8_WAIT_L(0); PG8_MMA(0, 0, At, B0); PG8_BAR; PG8_SCHED;
            PG8_LDB(B1, 1, 1); PG8_STAGE(PG8_SB(1, 0), b3, voffB);
            PG8_BAR; PG8_WAIT_L(0); PG8_MMA(0, 1, At, B1); PG8_BAR;
            PG8_LDA(At, 1, 1); PG8_STAGEA(PG8_SA(1, 0), a3, 0, last);
            PG8_BAR; PG8_WAIT_L(0); PG8_MMA(1, 0, At, B0); PG8_BAR; PG8_SCHED;
            PG8_STAGE(PG8_SB(1, 1), b3 + hstepB, voffB);
            PG8_WAIT_V(6); PG8_BAR; PG8_MMA(1, 1, At, B1); PG8_BAR;
        }
        { if constexpr (FP8) asm volatile("s_nop 15\n\ts_nop 3" ::: "memory");
          int t_ = tid; asm volatile("" : "+v"(t_));
          E(acc, cur, wr, wc, t_ & 15, (t_ & 63) >> 4); }
        if (!has_next) break;
#pragma unroll
        for (int a = 0; a < 2; ++a)
#pragma unroll
            for (int b = 0; b < 2; ++b)
#pragma unroll
                for (int m = 0; m < 4; ++m)
#pragma unroll
                    for (int n = 0; n < 2; ++n) acc[a][b][m][n] = (f32x4){0.f, 0.f, 0.f, 0.f};
        cur = nxt; cA = nA; cB = nB; ++ui;
        if constexpr (Sched::GATHER) {
_Pragma("unroll") for (int h = 0; h < 2; ++h) _Pragma("unroll") for (int i = 0; i < 2; ++i) gA[h][i] = gAn[h][i]; }
    }
    PG8_WAIT_V(0);
    if (wr == 0) PG8_BAR;
    PG8_BAR;
#undef PG8_SA
#undef PG8_SB
#undef PG8_STAGE
#undef PG8_STAGEA
#undef PG8_GOFFS
#undef PG8_LDA
#undef PG8_LDB
#undef PG8_MMA
#undef PG8_WAIT_V
#undef PG8_WAIT_L
#undef PG8_BAR
#undef PG8_SCHED
}
}
using pg8::f32x4; using pg8::u32x4; using pg8::Unit;

#define GEMM_LDS (pg8::STAGE_BYTES + 1024)

struct SchedProj : pg8::TileOrder {
  static constexpr bool GATHER = false;
  const char* A; const char* B;
  __device__ bool next(int i, Unit& u) const { u.z = 0; return tile(i, u.pm, u.pn); }
  __device__ const char* a_ptr(const Unit& u) const { return A + (size_t)u.pm * 256 * DM * 2; }
  __device__ const char* b_ptr(const Unit& u) const { return B + (size_t)u.pn * 256 * DM * 2; }
};
struct EpiProj {
  static constexpr bool PERM = true;
  bf16_t* O;
  __device__ __forceinline__ void operator()(const f32x4 (&acc)[2][2][4][2], const Unit& u, int wr, int wc, int fr, int fq) const {
    const int row0 = u.pm * 256 + wr * 64 + fr, col0 = u.pn * 256 + wc * 32 + 8 * fq;
    const bool gate = u.pn >= (C_GA / 256);
#pragma unroll
    for (int ai = 0; ai < 2; ++ai)
#pragma unroll
      for (int m = 0; m < 4; ++m) {
        bf16_t* rowp = O + (size_t)(row0 + ai * 128 + m * 16) * PW + col0;
#pragma unroll
        for (int bj = 0; bj < 2; ++bj) {
          f32x4 v0 = acc[ai][bj][m][0], v1 = acc[ai][bj][m][1];
          if (gate) {
#pragma unroll
            for (int j = 0; j < 4; ++j) { v0[j] = sigmoidf_(v0[j]); v1[j] = sigmoidf_(v1[j]); }
          }
          u32x4 w; w.x = pg8::cvt_pk_bf16(v0[0], v0[1]); w.y = pg8::cvt_pk_bf16(v0[2], v0[3]); w.z = pg8::cvt_pk_bf16(v1[0], v1[1]); w.w = pg8::cvt_pk_bf16(v1[2], v1[3]);
          *(u32x4*)(rowp + bj * 128) = w;
        }
      }
  }
};
__device__ void ph_proj(const Params& p, PG8_LAS unsigned char* lds, int nblk, int bid) {
  SchedProj S; S.init(T_TOK / 256, PW / 256, nblk, bid); S.A = (const char*)p.hbf; S.B = (const char*)p.w_in_t;
  EpiProj E{p.proj};
  pg8::gemm_phase(lds, p.tid, DM, DM, DM, S, E);
}

struct SchedBr : pg8::TileOrder {
  static constexpr bool GATHER = false;
  const char* A; const char* Ba; const char* Bb;
  __device__ bool next(int i, Unit& u) const { u.z = i & 1; return tile(i >> 1, u.pm, u.pn); }
  __device__ const char* a_ptr(const Unit& u) const { return A + (size_t)u.pm * 256 * DM * 2 + u.z * 512 * 2; }
  __device__ const char* b_ptr(const Unit& u) const { return (u.z ? Bb : Ba) + (size_t)u.pn * 256 * 512 * 2; }
};
__device__ __forceinline__ void unpack8(const u32x4 w, float (&f)[8]) {
  f[0] = __uint_as_float(w.x << 16); f[1] = __uint_as_float(w.x & 0xffff0000u); f[2] = __uint_as_float(w.y << 16); f[3] = __uint_as_float(w.y & 0xffff0000u);
  f[4] = __uint_as_float(w.z << 16); f[5] = __uint_as_float(w.z & 0xffff0000u); f[6] = __uint_as_float(w.w << 16); f[7] = __uint_as_float(w.w & 0xffff0000u);
}
struct EpiBr {
  static constexpr bool PERM = true;
  const bf16_t* proj; bf16_t* O;
  __device__ __forceinline__ void operator()(const f32x4 (&acc)[2][2][4][2], const Unit& u, int wr, int wc, int fr, int fq) const {
    const int row0 = u.pm * 256 + wr * 64 + fr, col0 = u.pn * 256 + wc * 32 + 8 * fq;
    const int gcol = (u.z ? C_GB : C_GA) + col0;
#pragma unroll
    for (int ai = 0; ai < 2; ++ai) {
      u32x4 gv[4][2], pv[4][2];
#pragma unroll
      for (int m = 0; m < 4; ++m)
#pragma unroll
        for (int bj = 0; bj < 2; ++bj) {
          const size_t row = (size_t)(row0 + ai * 128 + m * 16);
          gv[m][bj] = *(const u32x4*)(proj + row * PW + gcol + bj * 128);
          pv[m][bj] = (u32x4){0u, 0u, 0u, 0u};
          if (u.z) pv[m][bj] = *(const u32x4*)(O + row * DM + col0 + bj * 128);
        }
#pragma unroll
      for (int m = 0; m < 4; ++m)
#pragma unroll
        for (int bj = 0; bj < 2; ++bj) {
          const size_t row = (size_t)(row0 + ai * 128 + m * 16);
          float g[8], pf[8]; unpack8(gv[m][bj], g); unpack8(pv[m][bj], pf);
          const f32x4 v0 = acc[ai][bj][m][0], v1 = acc[ai][bj][m][1];
          float r[8];
#pragma unroll
          for (int j = 0; j < 4; ++j) { r[j] = v0[j] * g[j] + pf[j]; r[4 + j] = v1[j] * g[4 + j] + pf[4 + j]; }
          u32x4 w; w.x = pk2(r[0], r[1]); w.y = pk2(r[2], r[3]); w.z = pk2(r[4], r[5]); w.w = pk2(r[6], r[7]);
          *(u32x4*)(O + row * DM + col0 + bj * 128) = w;
        }
    }
  }
};
__device__ void ph_br(const Params& p, PG8_LAS unsigned char* lds, int nblk, int bid) {
  SchedBr S; S.init(T_TOK / 256, DM / 256, nblk, bid); S.A = (const char*)p.oab; S.Ba = (const char*)p.wbra_t; S.Bb = (const char*)p.wbrb_t;
  EpiBr E{p.proj, p.merged};
  pg8::gemm_phase(lds, p.tid, DM, 512, 512, S, E);
}

struct SchedMix : pg8::TileOrder {
  static constexpr bool GATHER = false;
  const char* A; const char* B;
  __device__ bool next(int i, Unit& u) const { u.z = 0; return tile(i, u.pm, u.pn); }
  __device__ const char* a_ptr(const Unit& u) const { return A + (size_t)u.pm * 256 * DM * 2; }
  __device__ const char* b_ptr(const Unit& u) const { return B + (size_t)u.pn * 256 * DM * 2; }
};
struct EpiMix {
  static constexpr bool PERM = true;
  bf16_t* O;
  __device__ __forceinline__ void operator()(const f32x4 (&acc)[2][2][4][2], const Unit& u, int wr, int wc, int fr, int fq) const {
    const int row0 = u.pm * 256 + wr * 64 + fr, col0 = u.pn * 256 + wc * 32 + 8 * fq;
#pragma unroll
    for (int ai = 0; ai < 2; ++ai)
#pragma unroll
      for (int m = 0; m < 4; ++m) {
        bf16_t* rowp = O + (size_t)(row0 + ai * 128 + m * 16) * DM + col0;
#pragma unroll
        for (int bj = 0; bj < 2; ++bj) {
          const f32x4 v0 = acc[ai][bj][m][0], v1 = acc[ai][bj][m][1];
          u32x4 w; w.x = pg8::cvt_pk_bf16(v0[0], v0[1]); w.y = pg8::cvt_pk_bf16(v0[2], v0[3]); w.z = pg8::cvt_pk_bf16(v1[0], v1[1]); w.w = pg8::cvt_pk_bf16(v1[2], v1[3]);
          *(u32x4*)(rowp + bj * 128) = w;
        }
      }
  }
};
__device__ void ph_mix(const Params& p, PG8_LAS unsigned char* lds, int nblk, int bid) {
  SchedMix S; S.init(T_TOK / 256, DM / 256, nblk, bid); S.A = (const char*)p.merged; S.B = (const char*)p.wo_t;
  EpiMix E{p.mixer};
  pg8::gemm_phase(lds, p.tid, DM, DM, DM, S, E);
}

template <bool GATH>
struct SchedMoe {
  static constexpr bool GATHER = GATH;
  const PG8_LAS int* tb; int NT; int G, c; int nwg;
  const char* A; const char* B; size_t bexp;
  const int* elist; int rowb;
  __device__ bool next(int i, Unit& u) const {
    const long L = (long)i * G + c; if (L >= nwg) return false;
    int wgid = (int)L; { const int q = nwg / 8, r = nwg % 8, xcd = wgid % 8, off = wgid / 8; wgid = (xcd < r ? xcd * (q + 1) : r * (q + 1) + (xcd - r) * q) + off; }
    int e = 0;
#pragma unroll
    for (int st = 16; st >= 1; st >>= 1) if (wgid >= tb[e + st]) e += st;
    const int q = wgid - tb[e]; const int tiles = tb[33 + e + 1] - tb[33 + e];
    u.pm = tb[33 + e] + q % tiles; u.pn = q / tiles; u.z = e; return true;
  }
  __device__ const char* a_ptr(const Unit& u) const { return GATH ? A : A + (size_t)u.pm * 256 * rowb; }
  __device__ const char* b_ptr(const Unit& u) const { return B + (size_t)u.z * bexp + (size_t)u.pn * 256 * rowb; }
  __device__ unsigned a_goff(const Unit& u, int tr, int C) const {
    const int i = (u.pm - tb[33 + u.z]) * 256 + tr;
    int tok = 0;
    if (i < tb[66 + u.z]) tok = elist[u.z * T_TOK + i] >> 2;
    return (unsigned)(tok * rowb + C * 2);
  }
};
__device__ __forceinline__ void moe_table(const Params& p, PG8_LAS int* tb, int NT) {
  if (p.tid == 0) {
    int ub = 0, tbp = 0;
    for (int e = 0; e < NE; ++e) { const int c = p.cnt[e * 64]; tb[e] = ub; tb[33 + e] = tbp; tb[66 + e] = c; const int t = (c + 255) >> 8; ub += t * NT; tbp += t; }
    tb[NE] = ub; tb[33 + NE] = tbp;
  }
  __syncthreads();
}
struct EpiMoe1 {
  static constexpr bool PERM = true;
  const float* b_gu; unsigned char* act;
  __device__ __forceinline__ void operator()(f32x4 (&acc)[2][2][4][2], const Unit& u, int wr, int wc, int fr, int fq) const {
    const int row0 = u.pm * 256 + wr * 64 + fr, jc = u.pn * 128 + wc * 32 + 8 * fq;
    const float* bg = b_gu + (size_t)u.z * 2048 + jc;
#pragma unroll
    for (int bj = 0; bj < 2; ++bj)
#pragma unroll
      for (int n = 0; n < 2; ++n) {
        const f32x4 bv = *(const f32x4*)(bg + bj * 1024 + n * 4);
#pragma unroll
        for (int ai = 0; ai < 2; ++ai)
#pragma unroll
          for (int m = 0; m < 4; ++m) acc[ai][bj][m][n] = acc[ai][bj][m][n] * 0.015625f + bv;
      }
#pragma unroll
    for (int ai = 0; ai < 2; ++ai)
#pragma unroll
      for (int m = 0; m < 4; ++m) {
        unsigned char* rowp = act + (size_t)(row0 + ai * 128 + m * 16) * DM + jc;
        float r[8];
#pragma unroll
        for (int n = 0; n < 2; ++n)
#pragma unroll
          for (int j = 0; j < 4; ++j) {
            float g = acc[ai][0][m][n][j], up = acc[ai][1][m][n][j];
            g = fminf(g, 7.f); up = fminf(fmaxf(up, -7.f), 7.f);
            r[n * 4 + j] = (up + 1.f) * g * sigmoidf_(1.702f * g);
          }
        u32x2 w; w.x = pk4_fp8(r[0], r[1], r[2], r[3]); w.y = pk4_fp8(r[4], r[5], r[6], r[7]);
        *(u32x2*)rowp = w;
      }
  }
};
__device__ void ph_moe1(const Params& p, PG8_LAS unsigned char* lds, int nblk, int bid) {
  PG8_LAS int* tb = (PG8_LAS int*)(lds + pg8::STAGE_BYTES);
  moe_table(p, tb, 8);
  SchedMoe<true> S; S.tb = tb; S.NT = 8; S.G = nblk; S.c = bid; S.nwg = tb[NE]; S.A = (const char*)p.h2q; S.B = (const char*)p.wgu8; S.bexp = (size_t)2048 * DM; S.elist = p.elist; S.rowb = DM;
  EpiMoe1 E{p.b_gu, p.act8};
  pg8::gemm_phase<EpiMoe1, SchedMoe<true>, true>(lds, p.tid, DM / 2, DM / 2, DM / 2, S, E);
}
struct EpiMoe2 {
  static constexpr bool PERM = true;
  const float* b_down; const int* elist; const PG8_LAS int* tb; bf16_t* yslot;
  __device__ __forceinline__ void operator()(f32x4 (&acc)[2][2][4][2], const Unit& u, int wr, int wc, int fr, int fq) const {
    const int row0 = u.pm * 256 + wr * 64 + fr, col0 = u.pn * 256 + wc * 32 + 8 * fq;
    const float* bd = b_down + (size_t)u.z * 1024 + col0;
#pragma unroll
    for (int bj = 0; bj < 2; ++bj)
#pragma unroll
      for (int n = 0; n < 2; ++n) {
        const f32x4 bv = *(const f32x4*)(bd + bj * 128 + n * 4);
#pragma unroll
        for (int ai = 0; ai < 2; ++ai)
#pragma unroll
          for (int m = 0; m < 4; ++m) acc[ai][bj][m][n] = acc[ai][bj][m][n] * 0.015625f + bv;
      }
    const int li0 = (u.pm - tb[33 + u.z]) * 256 + wr * 64 + fr, cnt = tb[66 + u.z];
    int av[2][4];
#pragma unroll
    for (int ai = 0; ai < 2; ++ai)
#pragma unroll
      for (int m = 0; m < 4; ++m) { const int li = li0 + ai * 128 + m * 16; av[ai][m] = elist[u.z * T_TOK + (li < cnt ? li : 0)]; if (li >= cnt) av[ai][m] = -1; }
#pragma unroll
    for (int ai = 0; ai < 2; ++ai)
#pragma unroll
      for (int m = 0; m < 4; ++m) {
        const int a = av[ai][m];
        if (a >= 0) {
          bf16_t* rowp = yslot + (size_t)a * DM + col0;
#pragma unroll
          for (int bj = 0; bj < 2; ++bj) {
            const f32x4 v0 = acc[ai][bj][m][0], v1 = acc[ai][bj][m][1];
            u32x4 w; w.x = pk2(v0[0], v0[1]); w.y = pk2(v0[2], v0[3]); w.z = pk2(v1[0], v1[1]); w.w = pk2(v1[2], v1[3]);
            *(u32x4*)(rowp + bj * 128) = w;
          }
        }
      }
  }
};
__device__ void ph_moe2(const Params& p, PG8_LAS unsigned char* lds, int nblk, int bid) {
  PG8_LAS int* tb = (PG8_LAS int*)(lds + pg8::STAGE_BYTES);
  moe_table(p, tb, 4);
  SchedMoe<false> S; S.tb = tb; S.NT = 4; S.G = nblk; S.c = bid; S.nwg = tb[NE]; S.A = (const char*)p.act8; S.B = (const char*)p.wd8; S.bexp = (size_t)1024 * DM; S.elist = p.elist; S.rowb = DM;
  EpiMoe2 E{p.b_down, p.elist, tb, p.yslot};
  pg8::gemm_phase<EpiMoe2, SchedMoe<false>, true>(lds, p.tid, DM / 2, DM / 2, DM / 2, S, E);
}

typedef short bf16x8 __attribute__((ext_vector_type(8)));
#define LAS __attribute__((address_space(3)))
#define MFMA16(a, b, c) __builtin_amdgcn_mfma_f32_16x16x32_bf16((a), (b), (c), 0, 0, 0)
__device__ __forceinline__ bf16x8 pack8(float a0, float a1, float a2, float a3, float a4, float a5, float a6, float a7) {
  u32x4 w; w.x = pk2(a0, a1); w.y = pk2(a2, a3); w.z = pk2(a4, a5); w.w = pk2(a6, a7);
  return __builtin_bit_cast(bf16x8, w);
}
__device__ __forceinline__ bf16_t f2bf_hw(float a) { return (bf16_t)(pk2(a, 0.f) & 0xffffu); }

#define DN_ABYTES 57344
#define DN_UFLOATS 8192
#define F_WN 0
#define F_QD 16
#define F_QK 32
#define F_KT 40

#define DP_KH 0
#define DP_QT 17408
#define DP_KHT 34816
#define DP_VT 53248
#define DP_TU 71680
#define DP_TW 80896
#define DP_LF 90112
#define DP_GC 107520
#define DP_BETA 107776
#define DP_CW 108032
#define DP_LB 114176
#define DP_TR 123392
#define DP_TT 132608
#define DP_MT 141824
#define DP_TOTAL 144128

template <int KS>
__device__ __forceinline__ f32x4 prod16(const LAS bf16_t* A, int lda, int arow0, const LAS bf16_t* Bt, int ldb, int brow0, f32x4 acc, int lane) {
  const int r = lane & 15, q = lane >> 4;
#pragma unroll
  for (int ks = 0; ks < KS; ++ks) {
    const bf16x8 a = *(const LAS bf16x8*)(A + (arow0 + r) * lda + 32 * ks + 8 * q);
    const bf16x8 b = *(const LAS bf16x8*)(Bt + (brow0 + r) * ldb + 32 * ks + 8 * q);
    acc = MFMA16(a, b, acc);
  }
  return acc;
}
__device__ __forceinline__ void tile_store_rm(LAS bf16_t* X, int ld, int row0, int col0, const f32x4 v, int lane) {
  const int r = lane & 15, q = lane >> 4;
#pragma unroll
  for (int i = 0; i < 4; ++i) X[(row0 + 4 * q + i) * ld + col0 + r] = f2bf_hw(v[i]);
}
__device__ __forceinline__ void tile_store_tr(LAS bf16_t* Xt, int ld, int row0, int col0, const f32x4 v, int lane) {
  const int r = lane & 15, q = lane >> 4;
  u32x2 w; w.x = pk2(v[0], v[1]); w.y = pk2(v[2], v[3]);
  *(LAS u32x2*)(Xt + (col0 + r) * ld + row0 + 4 * q) = w;
}

__device__ void dn_prep_chunk(const Params& p, LAS unsigned char* lds, int ci, bool load_cw) {
  const int tid = p.tid, lane = tid & 63, w = tid >> 6, r16 = lane & 15, q4 = lane >> 4;
  const int bh = ci >> 6, n = ci & 63, b = bh >> 2, h = bh & 3;
  LAS bf16_t* Kh = (LAS bf16_t*)(lds + DP_KH); LAS bf16_t* Qt = (LAS bf16_t*)(lds + DP_QT);
  LAS bf16_t* KhT = (LAS bf16_t*)(lds + DP_KHT); LAS bf16_t* VT = (LAS bf16_t*)(lds + DP_VT);
  LAS bf16_t* Tu = (LAS bf16_t*)(lds + DP_TU); LAS bf16_t* Tw = (LAS bf16_t*)(lds + DP_TW); LAS float* Lf = (LAS float*)(lds + DP_LF);
  LAS bf16_t* Lb = (LAS bf16_t*)(lds + DP_LB); LAS bf16_t* Tr = (LAS bf16_t*)(lds + DP_TR); LAS bf16_t* Tt = (LAS bf16_t*)(lds + DP_TT); LAS bf16_t* Mt = (LAS bf16_t*)(lds + DP_MT);
  LAS float* gcb = (LAS float*)(lds + DP_GC); LAS float* betab = (LAS float*)(lds + DP_BETA); LAS float* cw = (LAS float*)(lds + DP_CW);
  unsigned char* gA = (unsigned char*)p.dnA + (size_t)ci * DN_ABYTES;
  float* gU = p.dnU + (size_t)ci * DN_UFLOATS;

  if (load_cw) {
    for (int i = tid; i < 4 * 384; i += 512) { const int tap = i / 384, cc = i % 384, part = cc >> 7, d = cc & 127; cw[i] = p.conv_w[tap * 1536 + part * 512 + h * 128 + d]; }
  }
  __syncthreads();
  const int c = tid >> 3, g = tid & 7;
  const int s = n * 64 + c;
  const size_t t = (size_t)b * SEQ + s;
  float qv[16], kv[16], vv[16];
#pragma unroll
  for (int j = 0; j < 16; ++j) { qv[j] = 0.f; kv[j] = 0.f; vv[j] = 0.f; }
#pragma unroll
  for (int tap = 0; tap < 4; ++tap) {
    const int ss = s - 3 + tap;
    if (ss >= 0) {
      const bf16_t* row = p.proj + (t - 3 + tap) * PW + h * 128 + 16 * g;
      float x[8];
#pragma unroll
      for (int part = 0; part < 3; ++part) {
#pragma unroll
        for (int hh = 0; hh < 2; ++hh) {
          unpack8(*(const u32x4*)(row + part * 512 + 8 * hh), x);
#pragma unroll
          for (int j = 0; j < 8; ++j) {
            const float wv = cw[tap * 384 + part * 128 + 16 * g + 8 * hh + j];
            if (part == 0) qv[8 * hh + j] += wv * x[j];
            if (part == 1) kv[8 * hh + j] += wv * x[j];
            if (part == 2) vv[8 * hh + j] += wv * x[j];
          }
        }
      }
    }
    asm volatile("" ::: "memory");
  }
  float sq = 0.f, sk = 0.f;
#pragma unroll
  for (int j = 0; j < 16; ++j) { qv[j] = siluf_(qv[j]); kv[j] = siluf_(kv[j]); vv[j] = siluf_(vv[j]); sq += qv[j] * qv[j]; sk += kv[j] * kv[j]; }
  sq += __shfl_xor(sq, 1, 64); sq += __shfl_xor(sq, 2, 64); sq += __shfl_xor(sq, 4, 64);
  sk += __shfl_xor(sk, 1, 64); sk += __shfl_xor(sk, 2, 64); sk += __shfl_xor(sk, 4, 64);
  const float rq = rsqrtf(sq + 1e-6f) * 0.08838834764831845f, rk = rsqrtf(sk + 1e-6f);
#pragma unroll
  for (int j = 0; j < 16; ++j) { qv[j] *= rq; kv[j] *= rk; }
  if (g == 0) {
    const float bb = p.ba[t * 8 + h], aa = p.ba[t * 8 + 4 + h];
    const float xx = aa + p.dt_bias[h];
    const float sp = xx > 20.f ? xx : log1pf(__expf(xx));
    betab[c] = sigmoidf_(bb);
    gcb[c] = -__expf(p.a_log[h]) * sp;
  }
  {
    u32x4 w0, w1;
    w0.x = pk2(kv[0], kv[1]); w0.y = pk2(kv[2], kv[3]); w0.z = pk2(kv[4], kv[5]); w0.w = pk2(kv[6], kv[7]);
    w1.x = pk2(kv[8], kv[9]); w1.y = pk2(kv[10], kv[11]); w1.z = pk2(kv[12], kv[13]); w1.w = pk2(kv[14], kv[15]);
    *(LAS u32x4*)(Kh + c * 136 + 16 * g) = w0; *(LAS u32x4*)(Kh + c * 136 + 16 * g + 8) = w1;
    w0.x = pk2(qv[0], qv[1]); w0.y = pk2(qv[2], qv[3]); w0.z = pk2(qv[4], qv[5]); w0.w = pk2(qv[6], qv[7]);
    w1.x = pk2(qv[8], qv[9]); w1.y = pk2(qv[10], qv[11]); w1.z = pk2(qv[12], qv[13]); w1.w = pk2(qv[14], qv[15]);
    *(LAS u32x4*)(Qt + c * 136 + 16 * g) = w0; *(LAS u32x4*)(Qt + c * 136 + 16 * g + 8) = w1;
#pragma unroll
    for (int j = 0; j < 16; ++j) { KhT[(16 * g + j) * 72 + c] = f2bf_hw(kv[j]); VT[(16 * g + j) * 72 + c] = f2bf_hw(vv[j]); }
  }
  __syncthreads();
  if (w == 0) {
    float v = gcb[lane];
#pragma unroll
    for (int o = 1; o < 64; o <<= 1) { const float u = __shfl_up(v, o, 64); if (lane >= o) v += u; }
    gcb[lane] = v;
  }
  __syncthreads();
  const float gc_c = gcb[c], gl = gcb[63];
  {
    const float eg = __expf(gc_c);
    unsigned char* fb = gA + (size_t)(F_QD + (c >> 4) * 4 + (g >> 1)) * 1024 + (g & 1) * 8;
#pragma unroll
    for (int qq = 0; qq < 4; ++qq) {
      u32x2 wv; wv.x = pk2(qv[4 * qq] * eg, qv[4 * qq + 1] * eg); wv.y = pk2(qv[4 * qq + 2] * eg, qv[4 * qq + 3] * eg);
      *(u32x2*)(fb + ((c & 15) + 16 * qq) * 16) = wv;
    }
  }
  const int rt = w >> 1, ct0 = 2 * (w & 1);
#pragma unroll
  for (int tt = 0; tt < 2; ++tt) {
    const int ct = ct0 + tt;
    f32x4 gacc = {0.f, 0.f, 0.f, 0.f};
    gacc = prod16<4>(Kh, 136, 16 * rt, Kh, 136, 16 * ct, gacc, lane);
    const int m = 16 * ct + r16; const float gc_m = gcb[m];
    f32x4 lv;
#pragma unroll
    for (int i = 0; i < 4; ++i) {
      const int cc = 16 * rt + 4 * q4 + i;
      lv[i] = (m < cc) ? betab[cc] * gacc[i] * __expf(gcb[cc] - gc_m) : 0.f;
      Lf[cc * 68 + m] = lv[i];
    }
    tile_store_rm(Lb, 72, 16 * rt, 16 * ct, lv, lane);
    f32x4 qacc = {0.f, 0.f, 0.f, 0.f};
    qacc = prod16<4>(Kh, 136, 16 * rt, Qt, 136, 16 * ct, qacc, lane);
    const int cq = 16 * ct + r16; const float gc_cq = gcb[cq];
    float o4[4];
#pragma unroll
    for (int i = 0; i < 4; ++i) { const int mm = 16 * rt + 4 * q4 + i; o4[i] = (mm <= cq) ? qacc[i] * __expf(gc_cq - gcb[mm]) : 0.f; }
    u32x2 wv; wv.x = pk2(o4[0], o4[1]); wv.y = pk2(o4[2], o4[3]);
    *(u32x2*)(gA + (size_t)(F_QK + ct * 2 + (rt >> 1)) * 1024 + (r16 + 16 * q4) * 16 + (rt & 1) * 8) = wv;
  }
  __syncthreads();
  for (int i = tid; i < 2 * 64 * 72 / 8; i += 512) ((LAS u32x4*)Tr)[i] = (u32x4){0u, 0u, 0u, 0u};
  __syncthreads();
  if (w == 0) {
    int lo = lane; asm volatile("" : "+v"(lo));
    const int g = lo >> 4, j = lo & 15;
    unsigned lfb = DP_LF + (16 * g * 68 + 16 * g) * 4; asm volatile("" : "+v"(lfb));
    const LAS float* Lg = (const LAS float*)(lds + lfb);
    float t[16];
#pragma unroll
    for (int r = 0; r < 16; ++r) {
      float a0 = (r == j) ? 1.f : 0.f, a1 = 0.f;
#pragma unroll
      for (int k4 = 0; k4 < (r + 3) / 4; ++k4) {
        const f32x4 l = *(const LAS f32x4*)(Lg + r * 68 + 4 * k4);
        if (4 * k4 + 0 < r) a0 -= l[0] * t[4 * k4 + 0];
        if (4 * k4 + 1 < r) a1 -= l[1] * t[4 * k4 + 1];
        if (4 * k4 + 2 < r) a0 -= l[2] * t[4 * k4 + 2];
        if (4 * k4 + 3 < r) a1 -= l[3] * t[4 * k4 + 3];
      }
      t[r] = a0 + a1;
      Tr[(16 * g + r) * 72 + 16 * g + j] = f2bf_hw(t[r]);
    }
    u32x4 w0, w1;
    w0.x = pk2(t[0], t[1]); w0.y = pk2(t[2], t[3]); w0.z = pk2(t[4], t[5]); w0.w = pk2(t[6], t[7]);
    w1.x = pk2(t[8], t[9]); w1.y = pk2(t[10], t[11]); w1.z = pk2(t[12], t[13]); w1.w = pk2(t[14], t[15]);
    *(LAS u32x4*)(Tt + (16 * g + j) * 72 + 16 * g) = w0; *(LAS u32x4*)(Tt + (16 * g + j) * 72 + 16 * g + 8) = w1;
  }
  __syncthreads();
#pragma unroll 1
  for (int d = 1; d <= 3; ++d) {
    const bool act = w < 4 - d;
    const int I = w + d, J = w;
    LAS bf16_t* Mw = Mt + w * 16 * 24;
    if (act) {
      f32x4 macc = {0.f, 0.f, 0.f, 0.f};
      macc = prod16<2>(Lb, 72, 16 * I, Tt, 72, 16 * J, macc, lane);
      tile_store_tr(Mw, 24, 0, 0, macc, lane);
    }
    __syncthreads();
    if (act) {
      bf16x8 a = {0, 0, 0, 0, 0, 0, 0, 0}, bb = {0, 0, 0, 0, 0, 0, 0, 0};
      if (q4 < 2) { a = *(const LAS bf16x8*)(Tr + (16 * I + r16) * 72 + 16 * I + 8 * q4); bb = *(const LAS bf16x8*)(Mw + r16 * 24 + 8 * q4); }
      f32x4 tacc = {0.f, 0.f, 0.f, 0.f};
      tacc = MFMA16(a, bb, tacc);
#pragma unroll
      for (int i = 0; i < 4; ++i) tacc[i] = -tacc[i];
      tile_store_rm(Tr, 72, 16 * I, 16 * J, tacc, lane);
      tile_store_tr(Tt, 72, 16 * I, 16 * J, tacc, lane);
    }
    __syncthreads();
  }
  {
    const int cc = tid >> 3, m0 = (tid & 7) * 8;
    float tv[8]; unpack8(*(const LAS u32x4*)(Tr + cc * 72 + m0), tv);
    float tu[8], tw[8];
#pragma unroll
    for (int jj = 0; jj < 8; ++jj) { const float bm = betab[m0 + jj]; tu[jj] = tv[jj] * bm; tw[jj] = tu[jj] * __expf(gcb[m0 + jj]); }
    u32x4 wu, ww;
    wu.x = pk2(tu[0], tu[1]); wu.y = pk2(tu[2], tu[3]); wu.z = pk2(tu[4], tu[5]); wu.w = pk2(tu[6], tu[7]);
    ww.x = pk2(tw[0], tw[1]); ww.y = pk2(tw[2], tw[3]); ww.z = pk2(tw[4], tw[5]); ww.w = pk2(tw[6], tw[7]);
    *(LAS u32x4*)(Tu + cc * 72 + m0) = wu; *(LAS u32x4*)(Tw + cc * 72 + m0) = ww;
  }
  __syncthreads();
#pragma unroll
  for (int rr = 0; rr < 4; ++rr) {
    f32x4 u = {0.f, 0.f, 0.f, 0.f};
    u = prod16<2>(Tu, 72, 16 * rr, VT, 72, 16 * w, u, lane);
    *(f32x4*)(gU + ((w * 4 + rr) * 64 + lane) * 4) = u;
    f32x4 wt = {0.f, 0.f, 0.f, 0.f};
    wt = prod16<2>(KhT, 72, 16 * w, Tw, 72, 16 * rr, wt, lane);
    u32x2 wv; wv.x = pk2(-wt[0], -wt[1]); wv.y = pk2(-wt[2], -wt[3]);
    *(u32x2*)(gA + (size_t)(F_WN + rr * 4 + (w >> 1)) * 1024 + (r16 + 16 * q4) * 16 + (w & 1) * 8) = wv;
  }
#pragma unroll
  for (int it = 0; it < 4; ++it) {
    const int idx = tid + it * 512; const int d = idx >> 4, m4 = idx & 15;
    const u32x2 raw = *(const LAS u32x2*)(KhT + d * 72 + 4 * m4);
    const float k0 = __uint_as_float(raw.x << 16), k1 = __uint_as_float(raw.x & 0xffff0000u), k2 = __uint_as_float(raw.y << 16), k3 = __uint_as_float(raw.y & 0xffff0000u);
    const float e0 = __expf(gl - gcb[4 * m4]), e1 = __expf(gl - gcb[4 * m4 + 1]), e2 = __expf(gl - gcb[4 * m4 + 2]), e3 = __expf(gl - gcb[4 * m4 + 3]);
    u32x2 wv; wv.x = pk2(k0 * e0, k1 * e1); wv.y = pk2(k2 * e2, k3 * e3);
    *(u32x2*)(gA + (size_t)(F_KT + (d >> 4) * 2 + (m4 >> 3)) * 1024 + ((d & 15) + 16 * (m4 & 3)) * 16 + ((m4 >> 2) & 1) * 8) = wv;
  }
  if (tid == 0) p.dnG[ci] = __expf(gl);
}

#define DS_SLOT 32768
#define DS_TOTAL (4 * DS_SLOT)
#define DN_SFRAG (4 * 1024)
#define DN_VFRAG (2 * 1024)
__device__ void dn_scan_blk(const Params& p, LAS unsigned char* lds, int item) {
  const int tid = p.tid, lane = tid & 63, w = __builtin_amdgcn_readfirstlane(tid >> 6);
  const int bh = item >> 1, eh = item & 1;
  const int et = eh * 4 + (w & 3);
  const bool comp = w < 4;
  const unsigned char* gA = (const unsigned char*)p.dnA + (size_t)bh * 64 * DN_ABYTES;
  const float* gU = p.dnU + (size_t)bh * 64 * DN_UFLOATS;
  const float* gG = p.dnG + bh * 64;
  unsigned char* gS = (unsigned char*)p.dnS + ((size_t)bh * 64 * 8 + et) * DN_SFRAG + lane * 16;
  unsigned char* gV = (unsigned char*)p.dnV + ((size_t)bh * 64 * 8 + et) * DN_VFRAG + lane * 16;
  auto issue_A = [&](int n) {
#pragma unroll
    for (int i = 0; i < 8; ++i) {
      const int f = (w & 3) * 8 + i, sf = f < 16 ? F_WN + f : F_KT + (f - 16);
      __builtin_amdgcn_global_load_lds((const unsigned*)(gA + (size_t)n * DN_ABYTES + sf * 1024 + lane * 16), (LAS unsigned*)(lds + (n & 3) * DS_SLOT + f * 1024), 16, 0, 0);
    }
  };
  __syncthreads();
  f32x4 Un[4]; f32x4 S[8]; float gnext = 0.f;
  if (comp) {
#pragma unroll
    for (int rr = 0; rr < 4; ++rr) Un[rr] = *(const f32x4*)(gU + ((et * 4 + rr) * 64 + lane) * 4);
    gnext = gG[0];
  } else {
    issue_A(0); issue_A(1); issue_A(2);
    asm volatile("s_waitcnt vmcnt(16)" ::: "memory");
  }
#pragma unroll
  for (int dt = 0; dt < 8; ++dt) S[dt] = (f32x4){0.f, 0.f, 0.f, 0.f};
  asm volatile("s_waitcnt lgkmcnt(0)" ::: "memory");
  __builtin_amdgcn_s_barrier();
  asm volatile("" ::: "memory");
#pragma unroll 1
  for (int n = 0; n < 64; ++n) {
    const LAS unsigned char* Ab = lds + (n & 3) * DS_SLOT;
    if (!comp) {
      if (n + 3 < 64) { issue_A(n + 3); asm volatile("s_waitcnt vmcnt(16)" ::: "memory"); }
      else if (n + 2 < 64) asm volatile("s_waitcnt vmcnt(8)" ::: "memory");
      else asm volatile("s_waitcnt vmcnt(0)" ::: "memory");
    } else {
      f32x4 Vn[4];
#pragma unroll
      for (int rr = 0; rr < 4; ++rr) Vn[rr] = Un[rr];
      const float gdec = gnext;
      if (n + 1 < 64) {
#pragma unroll
        for (int rr = 0; rr < 4; ++rr) Un[rr] = *(const f32x4*)(gU + (size_t)(n + 1) * DN_UFLOATS + ((et * 4 + rr) * 64 + lane) * 4);
        gnext = gG[n + 1];
      }
      bf16x8 Sb[4];
#pragma unroll
      for (int ks = 0; ks < 4; ++ks) Sb[ks] = pack8(S[2 * ks][0], S[2 * ks][1], S[2 * ks][2], S[2 * ks][3], S[2 * ks + 1][0], S[2 * ks + 1][1], S[2 * ks + 1][2], S[2 * ks + 1][3]);
#pragma unroll
      for (int ks = 0; ks < 4; ++ks) *(bf16x8*)(gS + (size_t)n * 8 * DN_SFRAG + ks * 1024) = Sb[ks];
#pragma unroll
      for (int dt = 0; dt < 8; ++dt) S[dt] *= gdec;
#define LDF(idx) (*(const LAS bf16x8*)(Ab + (idx) * 1024 + lane * 16))
#define SBAR __builtin_amdgcn_sched_barrier(0)
      bf16x8 fa[8], fb[8];
#pragma unroll
      for (int i = 0; i < 8; ++i) fa[i] = LDF(i);
      SBAR;
#pragma unroll
      for (int i = 0; i < 8; ++i) fb[i] = LDF(8 + i);
      SBAR;
#pragma unroll
      for (int ks = 0; ks < 4; ++ks) { Vn[0] = MFMA16(fa[ks], Sb[ks], Vn[0]); Vn[1] = MFMA16(fa[4 + ks], Sb[ks], Vn[1]); }
      SBAR;
#pragma unroll
      for (int i = 0; i < 8; ++i) fa[i] = LDF(16 + i);
      SBAR;
#pragma unroll
      for (int ks = 0; ks < 4; ++ks) { Vn[2] = MFMA16(fb[ks], Sb[ks], Vn[2]); Vn[3] = MFMA16(fb[4 + ks], Sb[ks], Vn[3]); }
      SBAR;
#pragma unroll
      for (int i = 0; i < 8; ++i) fb[i] = LDF(24 + i);
      SBAR;
      bf16x8 Vb[2];
#pragma unroll
      for (int ks = 0; ks < 2; ++ks) Vb[ks] = pack8(Vn[2 * ks][0], Vn[2 * ks][1], Vn[2 * ks][2], Vn[2 * ks][3], Vn[2 * ks + 1][0], Vn[2 * ks + 1][1], Vn[2 * ks + 1][2], Vn[2 * ks + 1][3]);
#pragma unroll
      for (int ks = 0; ks < 2; ++ks) *(bf16x8*)(gV + (size_t)n * 8 * DN_VFRAG + ks * 1024) = Vb[ks];
#pragma unroll
      for (int ks = 0; ks < 2; ++ks)
#pragma unroll
        for (int dt = 0; dt < 4; ++dt) S[dt] = MFMA16(fa[dt * 2 + ks], Vb[ks], S[dt]);
#pragma unroll
      for (int ks = 0; ks < 2; ++ks)
#pragma unroll
        for (int dt = 0; dt < 4; ++dt) S[4 + dt] = MFMA16(fb[dt * 2 + ks], Vb[ks], S[4 + dt]);
#undef LDF
#undef SBAR
      asm volatile("s_waitcnt lgkmcnt(0)" ::: "memory");
    }
    __builtin_amdgcn_s_barrier();
    asm volatile("" ::: "memory");
  }
  asm volatile("s_waitcnt vmcnt(0)" ::: "memory");
}
#define DO_OT 32768
__device__ void ph_dn_out(const Params& p, LAS unsigned char* lds, int nblk, int bid) {
  const int tid = p.tid, lane = tid & 63, w = __builtin_amdgcn_readfirstlane(tid >> 6), r16 = lane & 15, q4 = lane >> 4;
  LAS float* Ot = (LAS float*)(lds + DO_OT);
  for (int ci = bid; ci < 1024; ci += nblk) {
    const int bh = ci >> 6, n = ci & 63, b = bh >> 2, h = bh & 3;
    const unsigned char* gA = (const unsigned char*)p.dnA + (size_t)ci * DN_ABYTES;
    __syncthreads();
#pragma unroll
    for (int i = 0; i < 3; ++i) {
      const int f = w * 3 + i;
      __builtin_amdgcn_global_load_lds((const unsigned*)(gA + (F_QD + f) * 1024 + lane * 16), (LAS unsigned*)(lds + f * 1024), 16, 0, 0);
    }
    bf16x8 Sb[4], Vb[2];
#pragma unroll
    for (int ks = 0; ks < 4; ++ks) Sb[ks] = *(const bf16x8*)((const unsigned char*)p.dnS + ((size_t)ci * 8 + w) * DN_SFRAG + ks * 1024 + lane * 16);
#pragma unroll
    for (int ks = 0; ks < 2; ++ks) Vb[ks] = *(const bf16x8*)((const unsigned char*)p.dnV + ((size_t)ci * 8 + w) * DN_VFRAG + ks * 1024 + lane * 16);
    asm volatile("s_waitcnt vmcnt(0)" ::: "memory");
    __syncthreads();
    f32x4 O[4];
#pragma unroll
    for (int rr = 0; rr < 4; ++rr) {
      O[rr] = (f32x4){0.f, 0.f, 0.f, 0.f};
#pragma unroll
      for (int ks = 0; ks < 4; ++ks) O[rr] = MFMA16(*(const LAS bf16x8*)(lds + (rr * 4 + ks) * 1024 + lane * 16), Sb[ks], O[rr]);
#pragma unroll
      for (int ks = 0; ks < 2; ++ks) O[rr] = MFMA16(*(const LAS bf16x8*)(lds + (16 + rr * 2 + ks) * 1024 + lane * 16), Vb[ks], O[rr]);
    }
#pragma unroll
    for (int rr = 0; rr < 4; ++rr)
#pragma unroll
      for (int i = 0; i < 4; ++i) Ot[(16 * rr + 4 * q4 + i) * 132 + 16 * w + r16] = O[rr][i];
    __syncthreads();
    {
      const int row = tid >> 3, seg = tid & 7;
      const size_t t = (size_t)b * SEQ + n * 64 + row;
      float o[16]; float ss = 0.f;
#pragma unroll
      for (int j4 = 0; j4 < 4; ++j4) { const f32x4 v = *(const LAS f32x4*)(Ot + row * 132 + 16 * seg + 4 * j4); o[4 * j4] = v[0]; o[4 * j4 + 1] = v[1]; o[4 * j4 + 2] = v[2]; o[4 * j4 + 3] = v[3]; }
#pragma unroll
      for (int j = 0; j < 16; ++j) ss += o[j] * o[j];
      ss += __shfl_xor(ss, 1, 64); ss += __shfl_xor(ss, 2, 64); ss += __shfl_xor(ss, 4, 64);
      const float rstd = rsqrtf(ss * (1.f / 128.f) + 1e-6f);
      const bf16_t* zp = p.proj + t * PW + C_Z + h * 128 + 16 * seg;
      float z0[8], z1[8]; unpack8(*(const u32x4*)zp, z0); unpack8(*(const u32x4*)(zp + 8), z1);
      float y[16];
#pragma unroll
      for (int j = 0; j < 8; ++j) { y[j] = o[j] * rstd * p.g_dn_out[16 * seg + j] * siluf_(z0[j]); y[8 + j] = o[8 + j] * rstd * p.g_dn_out[16 * seg + 8 + j] * siluf_(z1[j]); }
      u32x4 w0, w1;
      w0.x = pk2(y[0], y[1]); w0.y = pk2(y[2], y[3]); w0.z = pk2(y[4], y[5]); w0.w = pk2(y[6], y[7]);
      w1.x = pk2(y[8], y[9]); w1.y = pk2(y[10], y[11]); w1.z = pk2(y[12], y[13]); w1.w = pk2(y[14], y[15]);
      bf16_t* op = p.dn_out + t * p.dn_out_ld + h * 128 + 16 * seg;
      *(u32x4*)op = w0; *(u32x4*)(op + 8) = w1;
    }
  }
}
typedef float f32x16 __attribute__((ext_vector_type(16)));
#define MFMA32(a, b, c) __builtin_amdgcn_mfma_f32_32x32x16_bf16((a), (b), (c), 0, 0, 0)
#define MP_VL 0
#define MP_RED 65536
#define MP_TOTAL (65536 + 4096)

__device__ void moba_prep_block(const Params& p, LAS unsigned char* lds, int item) {
  const int tid = p.tid, lane = tid & 63, w = tid >> 6;
  const int bh = item >> 4, jb = item & 15, b = bh >> 2, h = bh & 3;
  LAS bf16_t* Vl = (LAS bf16_t*)(lds + MP_VL);
  LAS float* red = (LAS float*)(lds + MP_RED);
  __syncthreads();
#pragma unroll
  for (int it = 0; it < 8; ++it) {
    const int idx = tid + 512 * it, row = idx >> 4, ch = idx & 15;
    const u32x4 v = *(const u32x4*)(p.proj + ((size_t)b * SEQ + 256 * jb + row) * PW + C_MV + h * 128 + 8 * ch);
    *(LAS u32x4*)(Vl + row * 128 + 8 * ch) = v;
  }
  {
    const int r = tid >> 1, hh = tid & 1;
    const int pos = 256 * jb + r;
    const size_t t = (size_t)b * SEQ + pos;
    float cs[8], sn[8];
#pragma unroll
    for (int jj = 0; jj < 8; ++jj) {
      const float inv = exp2f(-(float)(8 * hh + jj) * (1.f / 16.f) * 18.931568569324174f);
      const float ang = (float)pos * inv;
      cs[jj] = cosf(ang); sn[jj] = sinf(ang);
    }
    float kacc[64];
#pragma unroll
    for (int which = 0; which < 2; ++which) {
      const bf16_t* src = p.proj + t * PW + (which ? C_MQ : C_MK) + h * 128 + 8 * hh;
      float x0[8], x1[8];
      unpack8(*(const u32x4*)(src), x0); unpack8(*(const u32x4*)(src + 16), x1);
      float y0[8], y1[8];
#pragma unroll
      for (int jj = 0; jj < 8; ++jj) { y0[jj] = x0[jj] * cs[jj] - x1[jj] * sn[jj]; y1[jj] = x1[jj] * cs[jj] + x0[jj] * sn[jj]; }
      u32x4 o[8];
      o[0].x = pk2(y0[0], y0[1]); o[0].y = pk2(y0[2], y0[3]); o[0].z = pk2(y0[4], y0[5]); o[0].w = pk2(y0[6], y0[7]);
      o[1].x = pk2(y1[0], y1[1]); o[1].y = pk2(y1[2], y1[3]); o[1].z = pk2(y1[4], y1[5]); o[1].w = pk2(y1[6], y1[7]);
#pragma unroll
      for (int ks = 2; ks < 8; ++ks) o[ks] = *(const u32x4*)(src + 16 * ks);
      if (which == 0) {
#pragma unroll
        for (int jj = 0; jj < 8; ++jj) { kacc[jj] = y0[jj]; kacc[8 + jj] = y1[jj]; }
#pragma unroll
        for (int ks = 2; ks < 8; ++ks) { float f[8]; unpack8(o[ks], f);
#pragma unroll
          for (int jj = 0; jj < 8; ++jj) kacc[8 * ks + jj] = f[jj]; }
        unsigned char* dst = (unsigned char*)p.Kp + ((size_t)(bh * 128 + 8 * jb + (r >> 5)) * 8192) + ((r & 31) + 32 * hh) * 16;
#pragma unroll
        for (int ks = 0; ks < 8; ++ks) *(u32x4*)(dst + ks * 1024) = o[ks];
      } else {
        bf16_t* dst = p.qb + ((size_t)bh * SEQ + pos) * 128 + 8 * hh;
#pragma unroll
        for (int ks = 0; ks < 8; ++ks) *(u32x4*)(dst + 16 * ks) = o[ks];
      }
    }
#pragma unroll
    for (int e = 0; e < 64; ++e) {
      float v = kacc[e];
      v += __shfl_xor(v, 2, 64); v += __shfl_xor(v, 4, 64); v += __shfl_xor(v, 8, 64); v += __shfl_xor(v, 16, 64); v += __shfl_xor(v, 32, 64);
      kacc[e] = v;
    }
    if (lane < 2) {
#pragma unroll
      for (int e = 0; e < 64; ++e) red[(w * 2 + lane) * 64 + e] = kacc[e];
    }
  }
  __syncthreads();
  if (tid < 128) {
    const int d = tid, hh = (d >> 3) & 1, ks = d >> 4, jj = d & 7;
    float a = 0.f;
#pragma unroll
    for (int ww = 0; ww < 8; ++ww) a += red[(ww * 2 + hh) * 64 + ks * 8 + jj];
    p.kmean[((size_t)bh * 16 + jb) * 128 + d] = a * (1.f / 256.f);
  }
#pragma unroll
  for (int it = 0; it < 8; ++it) {
    const int o = tid + 512 * it, ln = o & 63, frag = o >> 6, tl = frag >> 3, dt = (frag >> 1) & 3, s = frag & 1;
    const int r = ln & 31, hh = ln >> 5, d = 32 * dt + r;
    unsigned short e[8];
#pragma unroll
    for (int jj = 0; jj < 8; ++jj) { const int key = 32 * tl + 16 * s + 8 * (jj >> 2) + 4 * hh + (jj & 3); e[jj] = Vl[key * 128 + d]; }
    u32x4 wv; wv.x = e[0] | ((unsigned)e[1] << 16); wv.y = e[2] | ((unsigned)e[3] << 16); wv.z = e[4] | ((unsigned)e[5] << 16); wv.w = e[6] | ((unsigned)e[7] << 16);
    *(u32x4*)((unsigned char*)p.Vp + ((size_t)(bh * 128 + 8 * jb + tl) * 8192) + (dt * 2 + s) * 1024 + ln * 16) = wv;
  }
}
__device__ __forceinline__ int crow32(int reg, int hh) { return (reg & 3) + 8 * (reg >> 2) + 4 * hh; }
__device__ void moba_item(const Params& p, LAS float* km, LAS float* mrg, LAS float* ml, int bh, int ib, int sub, int par, int lane, int rep) {
  const int q = lane & 31, hh = lane >> 5;
  const int b = bh >> 2, h = bh & 3;
  const int s0 = 256 * ib + 32 * sub;
  const bf16_t* qrow = p.qb + ((size_t)bh * SEQ + s0 + q) * 128 + 8 * hh;
  bf16x8 Qf[8];
#pragma unroll
  for (int ks = 0; ks < 8; ++ks) Qf[ks] = *(const bf16x8*)(qrow + 16 * ks);
  LAS unsigned char* qlds = (LAS unsigned char*)km + 8192 + lane * 16;
#pragma unroll
  for (int ks = 0; ks < 8; ++ks) *(LAS bf16x8*)(qlds + ks * 1024) = Qf[ks];
  unsigned selmask = 0;
  if (ib > 0) {
    for (int idx = lane; idx < ib * 32; idx += 64) ((LAS f32x4*)km)[idx] = ((const f32x4*)(p.kmean + (size_t)bh * 16 * 128))[idx];
    float qf[64];
#pragma unroll
    for (int ks = 0; ks < 8; ++ks) { float f[8]; unpack8(__builtin_bit_cast(u32x4, Qf[ks]), f);
#pragma unroll
      for (int jj = 0; jj < 8; ++jj) qf[8 * ks + jj] = f[jj]; }
    float sc[16];
#pragma unroll
    for (int j = 0; j < 16; ++j) {
      sc[j] = -INFINITY;
      if (j < ib) {
        float a = 0.f;
#pragma unroll
        for (int ks = 0; ks < 8; ++ks) {
          const f32x4 k0 = *(const LAS f32x4*)(km + j * 128 + 16 * ks + 8 * hh), k1 = *(const LAS f32x4*)(km + j * 128 + 16 * ks + 8 * hh + 4);
          a += qf[8 * ks] * k0[0] + qf[8 * ks + 1] * k0[1] + qf[8 * ks + 2] * k0[2] + qf[8 * ks + 3] * k0[3];
          a += qf[8 * ks + 4] * k1[0] + qf[8 * ks + 5] * k1[1] + qf[8 * ks + 6] * k1[2] + qf[8 * ks + 7] * k1[3];
        }
        a += __shfl_xor(a, 32, 64);
        sc[j] = a;
      }
    }
#pragma unroll
    for (int r = 0; r < 3; ++r) {
      if (r < ib) {
        float best = -INFINITY; int bi = 0;
#pragma unroll
        for (int j = 0; j < 16; ++j) if (sc[j] > best) { best = sc[j]; bi = j; }
        selmask |= 1u << bi;
#pragma unroll
        for (int j = 0; j < 16; ++j) if (j == bi) sc[j] = -INFINITY;
      }
    }
  }
  unsigned rem = 0;
  for (int j = 0; j < ib; ++j) if (__ballot((selmask >> j) & 1u) != 0ull) rem |= 1u << j;
  rem = __builtin_amdgcn_readfirstlane(rem);
  const int own0 = 8 * ib, diag = 8 * ib + sub;
  const float cscale = 0.08838834764831845f * 1.4426950408889634f;
  float m = -1e30f, l = 0.f;
  f32x16 O[4];
#pragma unroll
  for (int dt = 0; dt < 4; ++dt)
#pragma unroll
    for (int r = 0; r < 16; ++r) O[dt][r] = 0.f;
  const unsigned char* kbase = (const unsigned char*)p.Kp + (size_t)bh * 128 * 8192 + lane * 16;
  const unsigned char* vbase = (const unsigned char*)p.Vp + (size_t)bh * 128 * 8192 + lane * 16;
  auto adv = [&](int& kt_, unsigned& rem_) {
    if (kt_ < 0) return;
    if (kt_ >= own0 ? (kt_ < diag) : ((kt_ & 7) != 7)) { kt_ = kt_ + 1; return; }
    if (rem_ == 0u) { kt_ = -1; return; }
    kt_ = 8 * (__builtin_ctz(rem_)); rem_ &= rem_ - 1u;
  };
  int kt = own0;
  if (par) adv(kt, rem);
  auto load_k = [&](int t, bf16x8 (&K_)[8]) {
#pragma unroll
    for (int ks = 0; ks < 8; ++ks) K_[ks] = *(const bf16x8*)(kbase + (size_t)t * 8192 + ks * 1024);
  };
  auto tile_step = [&](bf16x8 (&Kc)[8], bf16x8 (&Kn)[8]) -> bool {
    int ktn = kt; unsigned remn = rem;
    adv(ktn, remn); adv(ktn, remn);
    bf16x8 Vf[8];
#pragma unroll
    for (int f = 0; f < 8; ++f) Vf[f] = *(const bf16x8*)(vbase + (size_t)kt * 8192 + f * 1024);
    if (ktn >= 0) load_k(ktn, Kn);
    f32x16 S;
#pragma unroll
    for (int r = 0; r < 16; ++r) S[r] = 0.f;
#pragma unroll
    for (int ks = 0; ks < 8; ++ks) S = MFMA32(Kc[ks], *(const LAS bf16x8*)(qlds + ks * 1024), S);
    const bool allowed = (kt >= own0) || ((selmask >> (kt >> 3)) & 1u);
    const float nb = allowed ? 0.f : -INFINITY;
    float sv[16]; float mx = -INFINITY;
#pragma unroll
    for (int r = 0; r < 16; ++r) sv[r] = __builtin_fmaf(S[r], cscale, nb);
    if (kt == diag) {
#pragma unroll
      for (int r = 0; r < 16; ++r) if (crow32(r, hh) > q) sv[r] = -INFINITY;
    }
#pragma unroll
    for (int r = 0; r < 16; ++r) mx = fmaxf(mx, sv[r]);
    mx = fmaxf(mx, __shfl_xor(mx, 32, 64));
    const bool grow = mx > m + 8.f;
    const float mn = (__ballot(grow) != 0ull) ? fmaxf(m, mx) : m;
    const float alpha = __builtin_amdgcn_exp2f(m - mn);
    float ps = 0.f;
#pragma unroll
    for (int r = 0; r < 16; ++r) { sv[r] = __builtin_amdgcn_exp2f(sv[r] - mn); ps += sv[r]; }
    l = l * alpha + ps; m = mn;
    if (__ballot(alpha != 1.f) != 0ull) {
#pragma unroll
      for (int dt = 0; dt < 4; ++dt)
#pragma unroll
        for (int r = 0; r < 16; ++r) O[dt][r] *= alpha;
    }
    const bf16x8 P0 = pack8(sv[0], sv[1], sv[2], sv[3], sv[4], sv[5], sv[6], sv[7]);
    const bf16x8 P1 = pack8(sv[8], sv[9], sv[10], sv[11], sv[12], sv[13], sv[14], sv[15]);
#pragma unroll
    for (int dt = 0; dt < 4; ++dt) { O[dt] = MFMA32(Vf[dt * 2], P0, O[dt]); O[dt] = MFMA32(Vf[dt * 2 + 1], P1, O[dt]); }
    kt = ktn; rem = remn;
    return kt >= 0;
  };
  if (kt >= 0) {
    bf16x8 KA[8], KB[8];
    load_k(kt, KA);
#pragma unroll 1
    for (;;) {
      if (!tile_step(KA, KB)) break;
      asm volatile("" ::: "memory");
      if (!tile_step(KB, KA)) break;
      asm volatile("" ::: "memory");
    }
  }
  asm volatile("s_waitcnt vmcnt(0) lgkmcnt(0)" ::: "memory");
  if (par) {
    ml[lane] = m; ml[64 + lane] = l;
#pragma unroll
    for (int dt = 0; dt < 4; ++dt)
#pragma unroll
      for (int r = 0; r < 16; ++r) mrg[(dt * 16 + r) * 64 + lane] = O[dt][r];
  }
  __syncthreads();
  if (par == 0) {
    const float m2 = ml[lane], l2 = ml[64 + lane];
    const float mm = fmaxf(m, m2);
    const float a1 = __builtin_amdgcn_exp2f(m - mm), a2 = __builtin_amdgcn_exp2f(m2 - mm);
    l = l * a1 + l2 * a2;
#pragma unroll
    for (int dt = 0; dt < 4; ++dt)
#pragma unroll
      for (int r = 0; r < 16; ++r) O[dt][r] = O[dt][r] * a1 + mrg[(dt * 16 + r) * 64 + lane] * a2;
  }
  if (par == 0) {
  l += __shfl_xor(l, 32, 64);
  const float inv = 1.f / l;
  bf16_t* orow = rep ? p.oab2 + ((size_t)b * SEQ + s0 + q) * 512 + h * 128 : p.mb_out + ((size_t)b * SEQ + s0 + q) * p.mb_out_ld + p.mb_out_off + h * 128;
#pragma unroll
  for (int dt = 0; dt < 4; ++dt)
#pragma unroll
    for (int g4 = 0; g4 < 4; ++g4) {
      u32x2 wv; wv.x = pk2(O[dt][4 * g4] * inv, O[dt][4 * g4 + 1] * inv); wv.y = pk2(O[dt][4 * g4 + 2] * inv, O[dt][4 * g4 + 3] * inv);
      *(u32x2*)(orow + 32 * dt + 8 * g4 + 4 * hh) = wv;
    }
  }
  __syncthreads();
}
__device__ void moba_worker(const Params& p, LAS unsigned char* lds, int qi) {
  const int lane = p.tid & 63, w = __builtin_amdgcn_readfirstlane(p.tid >> 6);
  LAS float* km = (LAS float*)(lds + w * 16384);
  LAS float* mrg = (LAS float*)(lds + ((w & 3) + 4) * 16384);
  LAS float* ml = (LAS float*)(lds + 131072) + (w & 3) * 128;
  LAS int* slot = (LAS int*)(lds + 131072 + 2048);
  const int g0 = (int)((unsigned)__builtin_amdgcn_s_getreg((3 << 11) | 20) & 7u);
  for (int gi = 0; gi < 8; ++gi) {
    const int g = (g0 + gi) & 7;
    for (;;) {
      __syncthreads();
      if (p.tid == 0) slot[0] = atomicAdd(p.wq + qi * 8 + g, 1);
      __syncthreads();
      const int idx = slot[0];
      if (idx >= 64) break;
      const int bh = 2 * g + (idx >> 5), ib = 15 - ((idx >> 1) & 15), quad = 1 - (idx & 1);
      moba_item(p, km, mrg, ml, bh, ib, 4 * quad + (w & 3), w >> 2, lane, qi);
    }
  }
}
__device__ void ph_mod(const Params& p, LAS unsigned char* lds, int nblk, int bid) {
  LAS float* sc = (LAS float*)lds;
  LAS float* part = (LAS float*)(lds + 16384);
  const int tid = p.tid;
  if (bid >= 192) return;
  for (int i = tid; i < 4096; i += 512) sc[i] = siluf_(p.c[i]);
  __syncthreads();
  for (int task = bid; task < 192; task += nblk) {
    const int jj = tid & 31, ks = tid >> 5, j = task * 32 + jj;
    float a0 = 0.f, a1 = 0.f, a2 = 0.f, a3 = 0.f;
#pragma unroll 8
    for (int kk = 0; kk < 64; ++kk) {
      const int k = ks * 64 + kk;
      const float w = p.w_ada[(size_t)k * 6144 + j];
      a0 += sc[k] * w; a1 += sc[1024 + k] * w; a2 += sc[2048 + k] * w; a3 += sc[3072 + k] * w;
    }
    *(LAS f32x4*)(part + (ks * 32 + jj) * 4) = (f32x4){a0, a1, a2, a3};
    __syncthreads();
    if (tid < 128) {
      const int j2 = tid & 31, bb = tid >> 5;
      float a = 0.f;
#pragma unroll
      for (int s = 0; s < 16; ++s) a += part[(s * 32 + j2) * 4 + bb];
      p.mod[bb * 6144 + task * 32 + j2] = a + p.b_ada[task * 32 + j2];
    }
    __syncthreads();
  }
}

#define WT_T0 1424
#define WT_T1 (WT_T0 + 16384)
#define WT_T2 (WT_T1 + 8192)
#define WT_T3 (WT_T2 + 128)
#define WT_T4 (WT_T3 + 128)
#define WT_T5 (WT_T4 + 256)
struct WtTile { const float* src; bf16_t* dst; int K, N, mode, k0, n0; unsigned char* dst8; };
__device__ __forceinline__ WtTile wt_desc(const Params& p, int t) {
  WtTile d;
  if (t < WT_T0) { const int kt = t / 89, nt = t % 89; d = {p.w_in, p.w_in_t, 1024, INW, 1, kt * 64, nt * 64, nullptr}; }
  else if (t < WT_T1) { const int u = t - WT_T0, e = u >> 9, r = u & 511, kt = r >> 5, nt = r & 31; d = {p.w_gu + (size_t)e * 1024 * 2048, nullptr, 1024, 2048, 2, kt * 64, nt * 64, p.wgu8 + (size_t)e * 2048 * 1024}; }
  else if (t < WT_T2) { const int u = t - WT_T1, e = u >> 8, r = u & 255, kt = r >> 4, nt = r & 15; d = {p.w_down + (size_t)e * 1024 * 1024, nullptr, 1024, 1024, 0, kt * 64, nt * 64, p.wd8 + (size_t)e * 1024 * 1024}; }
  else if (t < WT_T3) { const int u = t - WT_T2, kt = u >> 4, nt = u & 15; d = {p.w_br_a, p.wbra_t, 512, 1024, 0, kt * 64, nt * 64, nullptr}; }
  else if (t < WT_T4) { const int u = t - WT_T3, kt = u >> 4, nt = u & 15; d = {p.w_br_b, p.wbrb_t, 512, 1024, 0, kt * 64, nt * 64, nullptr}; }
  else { const int u = t - WT_T4, kt = u >> 4, nt = u & 15; d = {p.w_o, p.wo_t, 1024, 1024, 0, kt * 64, nt * 64, nullptr}; }
  return d;
}
__device__ __forceinline__ void wt_load(const WtTile& d, int tid, f32x4 (&v)[2]) {
#pragma unroll
  for (int it = 0; it < 2; ++it) {
    const int row = (tid >> 4) + 32 * it, n = d.n0 + (tid & 15) * 4;
    v[it] = (f32x4){0.f, 0.f, 0.f, 0.f};
    if (n < d.N) v[it] = __builtin_nontemporal_load((const f32x4*)(d.src + (size_t)(d.k0 + row) * d.N + n));
  }
}
__device__ void ph_wt(const Params& p, LAS unsigned char* lds, int nblk, int bid) {
  LAS float* tile = (LAS float*)(lds + 32768);
  const int tid = p.tid;
  int t = bid;
  if (t >= WT_T5) return;
  WtTile cur = wt_desc(p, t);
  f32x4 v[2]; wt_load(cur, tid, v);
  WtTile nxt = cur; f32x4 vn[2] = {v[0], v[1]};
  if (t + nblk < WT_T5) { nxt = wt_desc(p, t + nblk); wt_load(nxt, tid, vn); }
  for (;;) {
    const int tnn = t + 2 * nblk;
    WtTile nn = nxt; f32x4 vnn[2] = {vn[0], vn[1]};
    if (tnn < WT_T5) { nn = wt_desc(p, tnn); wt_load(nn, tid, vnn); }
#pragma unroll
    for (int it = 0; it < 2; ++it) {
      const int row = (tid >> 4) + 32 * it, c4 = (tid & 15) * 4;
      tile[row * 65 + c4] = v[it][0]; tile[row * 65 + c4 + 1] = v[it][1]; tile[row * 65 + c4 + 2] = v[it][2]; tile[row * 65 + c4 + 3] = v[it][3];
    }
    __syncthreads();
    {
      const int nl = tid >> 3, kc = tid & 7, n = cur.n0 + nl;
      if (n < cur.N) {
        const int dd = map_col(n, cur.mode);
        if (dd >= 0) {
          float f[8];
#pragma unroll
          for (int j = 0; j < 8; ++j) f[j] = tile[(8 * kc + j) * 65 + nl];
          if (cur.dst8) {
            u32x2 w; w.x = pk4_fp8(f[0] * 64.f, f[1] * 64.f, f[2] * 64.f, f[3] * 64.f); w.y = pk4_fp8(f[4] * 64.f, f[5] * 64.f, f[6] * 64.f, f[7] * 64.f);
            *(u32x2*)(cur.dst8 + (size_t)dd * cur.K + cur.k0 + 8 * kc) = w;
          } else {
            u32x4 w; w.x = pk2(f[0], f[1]); w.y = pk2(f[2], f[3]); w.z = pk2(f[4], f[5]); w.w = pk2(f[6], f[7]);
            *(u32x4*)(cur.dst + (size_t)dd * cur.K + cur.k0 + 8 * kc) = w;
          }
        }
      }
    }
    __syncthreads();
    if (t + nblk >= WT_T5) break;
    t += nblk; cur = nxt; v[0] = vn[0]; v[1] = vn[1]; nxt = nn; vn[0] = vnn[0]; vn[1] = vnn[1];
  }
}

__device__ void ph_h(const Params& p, LAS unsigned char* lds, int nblk, int bid) {
  const int wid = p.tid >> 6, lane = p.tid & 63;
  LAS float* wb = (LAS float*)lds;
  for (int i = p.tid; i < 2048; i += 512) {
    const int k = i >> 1, hf = i & 1;
    const f32x4 v = *(const f32x4*)(p.w_in + (size_t)k * INW + 2048 + 4 * hf);
    wb[(4 * hf + 0) * 1024 + k] = v[0]; wb[(4 * hf + 1) * 1024 + k] = v[1]; wb[(4 * hf + 2) * 1024 + k] = v[2]; wb[(4 * hf + 3) * 1024 + k] = v[3];
  }
  __syncthreads();
  f32x4 gv[4];
#pragma unroll
  for (int i = 0; i < 4; ++i) gv[i] = *(const f32x4*)(p.g_pre_mix + i * 256 + lane * 4);
  f32x4 xnx[4];
  if (bid * 8 + wid < T_TOK) {
#pragma unroll
    for (int i = 0; i < 4; ++i) xnx[i] = *(const f32x4*)(p.x + (size_t)(bid * 8 + wid) * DM + i * 256 + lane * 4);
  }
  for (int t = bid * 8 + wid; t < T_TOK; t += nblk * 8) {
    const int b = t / SEQ;
    f32x4 xv[4];
    float ss = 0.f;
#pragma unroll
    for (int i = 0; i < 4; ++i) {
      xv[i] = xnx[i];
      ss += xv[i][0] * xv[i][0] + xv[i][1] * xv[i][1] + xv[i][2] * xv[i][2] + xv[i][3] * xv[i][3];
    }
    if (t + nblk * 8 < T_TOK) {
#pragma unroll
      for (int i = 0; i < 4; ++i) xnx[i] = *(const f32x4*)(p.x + (size_t)(t + nblk * 8) * DM + i * 256 + lane * 4);
    }
    ss = wave_sum(ss);
    const float rstd = rsqrtf(ss * (1.f / DM) + 1e-6f);
    const float* shift = p.mod + b * 6144;
    const float* scale = p.mod + b * 6144 + 1024;
    float acc[8] = {0, 0, 0, 0, 0, 0, 0, 0};
    f32x4 scv[4], shv[4];
#pragma unroll
    for (int i = 0; i < 4; ++i) { scv[i] = *(const f32x4*)(scale + i * 256 + lane * 4); shv[i] = *(const f32x4*)(shift + i * 256 + lane * 4); }
#pragma unroll
    for (int i = 0; i < 4; ++i) {
      const int k = i * 256 + lane * 4;
      const f32x4 g = gv[i], sc = scv[i], sh = shv[i];
      f32x4 hv;
#pragma unroll
      for (int j = 0; j < 4; ++j) hv[j] = xv[i][j] * rstd * g[j] * (1.f + sc[j]) + sh[j];
#pragma unroll
      for (int e = 0; e < 8; ++e) { const f32x4 w = *(const LAS f32x4*)(wb + e * 1024 + k); acc[e] += hv[0] * w[0] + hv[1] * w[1] + hv[2] * w[2] + hv[3] * w[3]; }
      u32x2 pk; pk.x = pk2(hv[0], hv[1]); pk.y = pk2(hv[2], hv[3]);
      *(u32x2*)(p.hbf + (size_t)t * DM + k) = pk;
    }
#pragma unroll
    for (int e = 0; e < 8; ++e) acc[e] = wave_sum(acc[e]);
    if (lane == 0) { *(f32x4*)(p.ba + (size_t)t * 8) = (f32x4){acc[0], acc[1], acc[2], acc[3]}; *(f32x4*)(p.ba + (size_t)t * 8 + 4) = (f32x4){acc[4], acc[5], acc[6], acc[7]}; }
  }
}

#define PM_WT 0
#define PM_H2 66048
#define PM_CNT 132096
#define PM_ENT 132352
__device__ void ph_post_mix(const Params& p, LAS unsigned char* lds, int nblk, int bid, int rep) {
  const int wid = p.tid >> 6, lane = p.tid & 63, r16 = lane & 15, q4 = lane >> 4;
  LAS bf16_t* wT = (LAS bf16_t*)(lds + PM_WT);
  LAS bf16_t* ht = (LAS bf16_t*)(lds + PM_H2) + wid * 4 * 1032;
  LAS int* lcnt = (LAS int*)(lds + PM_CNT);
  LAS int* lbase = lcnt + 32;
  LAS int* lent = (LAS int*)(lds + PM_ENT) + wid * 64;
  int nloc = 0;
  if (p.tid < 32) lcnt[p.tid] = 0;
  for (int i = p.tid; i < 1024 * 8; i += 512) {
    const int k = i >> 3, c = i & 7;
    const f32x4 v = *(const f32x4*)(p.w_router + (size_t)k * 32 + c * 4);
#pragma unroll
    for (int j = 0; j < 4; ++j) wT[(c * 4 + j) * 1032 + k] = f2bf_hw(v[j]);
  }
  __syncthreads();
  const float bias0 = p.b_router[r16], bias1 = p.b_router[16 + r16];
  const int tstride = nblk * 8;
  f32x4 gpv[4], gqv[4];
#pragma unroll
  for (int i4 = 0; i4 < 4; ++i4) { const int k = (i4 >> 1) * 512 + lane * 8 + (i4 & 1) * 4; gpv[i4] = *(const f32x4*)(p.g_post_mix + k); gqv[i4] = *(const f32x4*)(p.g_pre_ffn + k); }
  u32x4 mxn[2]; f32x4 xn[4];
  {
    const int t0 = bid * 8 + wid;
    if (t0 < T_TOK) {
#pragma unroll
      for (int i = 0; i < 2; ++i) mxn[i] = *(const u32x4*)(p.mixer + (size_t)t0 * DM + i * 512 + lane * 8);
#pragma unroll
      for (int i = 0; i < 4; ++i) xn[i] = *(const f32x4*)(p.x + (size_t)t0 * DM + (i >> 1) * 512 + lane * 8 + (i & 1) * 4);
    }
  }
  for (int tg = bid * 8 + wid; tg < T_TOK; tg += 4 * tstride) {
#pragma unroll 1
    for (int jj = 0; jj < 4; ++jj) {
      const int t = tg + jj * tstride;
      if (t >= T_TOK) break;
      const int b = t / SEQ;
      const float* md = p.mod + b * 6144;
      u32x4 mxc[2] = {mxn[0], mxn[1]}; f32x4 xc[4] = {xn[0], xn[1], xn[2], xn[3]};
      {
        const int tn = t + tstride;
        if (tn < T_TOK) {
#pragma unroll
          for (int i = 0; i < 2; ++i) mxn[i] = *(const u32x4*)(p.mixer + (size_t)tn * DM + i * 512 + lane * 8);
#pragma unroll
          for (int i = 0; i < 4; ++i) xn[i] = *(const f32x4*)(p.x + (size_t)tn * DM + (i >> 1) * 512 + lane * 8 + (i & 1) * 4);
        }
      }
      float mv[16];
      float ss = 0.f;
#pragma unroll
      for (int i = 0; i < 2; ++i) {
        float f[8]; unpack8(mxc[i], f);
#pragma unroll
        for (int j = 0; j < 8; ++j) { mv[i * 8 + j] = f[j]; ss += f[j] * f[j]; }
      }
      ss = wave_sum(ss);
      const float rstd = rsqrtf(ss * (1.f / DM) + 1e-6f);
      f32x4 gmv[4], scv[4], sfv[4];
#pragma unroll
      for (int i4 = 0; i4 < 4; ++i4) { const int k = (i4 >> 1) * 512 + lane * 8 + (i4 & 1) * 4; gmv[i4] = *(const f32x4*)(md + 2048 + k); scv[i4] = *(const f32x4*)(md + 4096 + k); sfv[i4] = *(const f32x4*)(md + 3072 + k); }
      float x1[16];
      float s2 = 0.f;
#pragma unroll
      for (int i = 0; i < 2; ++i)
#pragma unroll
        for (int j4 = 0; j4 < 2; ++j4) {
          const int k = i * 512 + lane * 8 + j4 * 4;
          const f32x4 xv = xc[i * 2 + j4];
          const f32x4 gm = gmv[i * 2 + j4], gp = gpv[i * 2 + j4];
          f32x4 o;
#pragma unroll
          for (int j = 0; j < 4; ++j) { o[j] = xv[j] + gm[j] * (mv[i * 8 + j4 * 4 + j] * rstd * gp[j]); x1[i * 8 + j4 * 4 + j] = o[j]; s2 += o[j] * o[j]; }
          *(f32x4*)(p.out + (size_t)t * DM + k) = o;
        }
      s2 = wave_sum(s2);
      const float rstd2 = rsqrtf(s2 * (1.f / DM) + 1e-6f);
#pragma unroll
      for (int i = 0; i < 2; ++i) {
        float hv[8];
#pragma unroll
        for (int j4 = 0; j4 < 2; ++j4) {
          const int k = i * 512 + lane * 8 + j4 * 4;
          const f32x4 gq = gqv[i * 2 + j4], sc = scv[i * 2 + j4], sf = sfv[i * 2 + j4];
#pragma unroll
          for (int j = 0; j < 4; ++j) hv[j4 * 4 + j] = x1[i * 8 + j4 * 4 + j] * rstd2 * gq[j] * (1.f + sc[j]) + sf[j];
        }
        u32x2 w; w.x = pk4_fp8(hv[0], hv[1], hv[2], hv[3]); w.y = pk4_fp8(hv[4], hv[5], hv[6], hv[7]);
        *(u32x2*)(p.h2q + (size_t)t * DM + i * 512 + lane * 8) = w;
        u32x4 hb; hb.x = pk2(hv[0], hv[1]); hb.y = pk2(hv[2], hv[3]); hb.z = pk2(hv[4], hv[5]); hb.w = pk2(hv[6], hv[7]);
        *(LAS u32x4*)(ht + jj * 1032 + i * 512 + lane * 8) = hb;
      }
    }
    f32x4 acc0 = {0.f, 0.f, 0.f, 0.f}, acc1 = {0.f, 0.f, 0.f, 0.f};
#pragma unroll 8
    for (int ks = 0; ks < 32; ++ks) {
      const bf16x8 a = *(const LAS bf16x8*)(ht + (r16 & 3) * 1032 + 32 * ks + 8 * q4);
      const bf16x8 b0 = *(const LAS bf16x8*)(wT + r16 * 1032 + 32 * ks + 8 * q4);
      const bf16x8 b1 = *(const LAS bf16x8*)(wT + (16 + r16) * 1032 + 32 * ks + 8 * q4);
      acc0 = MFMA16(a, b0, acc0); acc1 = MFMA16(a, b1, acc1);
    }
#pragma unroll
    for (int jj = 0; jj < 4; ++jj) {
      const int t = tg + jj * tstride;
      if (t < T_TOK) {
        float l0 = (lane < 16) ? acc0[jj] + bias0 : -INFINITY, l1 = (lane < 16) ? acc1[jj] + bias1 : -INFINITY;
        float tv[4]; int ti[4];
#pragma unroll
        for (int r = 0; r < 4; ++r) {
          const float m = wave_max(fmaxf(l0, l1));
          const unsigned long long b0m = __ballot(l0 == m);
          int idx;
          if (b0m) { idx = __ffsll((long long)b0m) - 1; if (lane == idx) l0 = -INFINITY; }
          else { const unsigned long long b1m = __ballot(l1 == m); idx = __ffsll((long long)b1m) - 1; if (lane == idx) l1 = -INFINITY; idx += 16; }
          tv[r] = m; ti[r] = idx;
        }
        const float e1 = __expf(tv[1] - tv[0]), e2 = __expf(tv[2] - tv[0]), e3 = __expf(tv[3] - tv[0]);
        const float inv = 1.f / (1.f + e1 + e2 + e3);
        if (lane < 4) {
          const int ee = lane == 0 ? ti[0] : lane == 1 ? ti[1] : lane == 2 ? ti[2] : ti[3];
          const float ww = (lane == 0 ? 1.f : lane == 1 ? e1 : lane == 2 ? e2 : e3) * inv;
          p.aw[t * 4 + lane] = ww;
          const int rank = __hip_atomic_fetch_add(&lcnt[ee], 1, __ATOMIC_RELAXED, __HIP_MEMORY_SCOPE_WORKGROUP);
          lent[nloc * 4 + lane] = (ee << 16) | rank;
          lent[nloc * 4 + lane + 2048] = t * 4 + lane;
        }
        ++nloc;
      }
    }
  }
  __syncthreads();
  if (p.tid < 32) lbase[p.tid] = atomicAdd(&p.cnt[p.tid * 64 + 32 * rep], lcnt[p.tid]);
  __syncthreads();
  for (int i = lane; i < nloc * 4; i += 64) {
    const int er = lent[i], a = lent[i + 2048];
    p.elist[(er >> 16) * T_TOK + lbase[er >> 16] + (er & 0xffff)] = a;
  }
}

__device__ void ph_final(const Params& p, int nblk, int bid, int rep) {
  const int wid = p.tid >> 6, lane = p.tid & 63;
  f32x4 gpf[4];
#pragma unroll
  for (int i4 = 0; i4 < 4; ++i4) gpf[i4] = *(const f32x4*)(p.g_post_ffn + (i4 >> 1) * 512 + lane * 8 + (i4 & 1) * 4);
  for (int t0 = bid * 8 + wid; t0 < T_TOK; t0 += nblk * 16) {
    int tt[2] = {t0, t0 + nblk * 8};
    if (tt[1] >= T_TOK) tt[1] = t0;
    float mv[2][16]; float ss[2];
#pragma unroll
    for (int u = 0; u < 2; ++u) {
      const int t = tt[u];
      const f32x4 wv = *(const f32x4*)(p.aw + t * 4);
      ss[u] = 0.f;
#pragma unroll
      for (int i = 0; i < 2; ++i) {
        const bf16_t* y = p.yslot + (size_t)t * 4 * DM + i * 512 + lane * 8;
        float f0[8], f1[8], f2[8], f3[8];
        unpack8(*(const u32x4*)y, f0); unpack8(*(const u32x4*)(y + DM), f1); unpack8(*(const u32x4*)(y + 2 * DM), f2); unpack8(*(const u32x4*)(y + 3 * DM), f3);
#pragma unroll
        for (int j = 0; j < 8; ++j) { const float m = wv[0] * f0[j] + wv[1] * f1[j] + wv[2] * f2[j] + wv[3] * f3[j]; mv[u][i * 8 + j] = m; ss[u] += m * m; }
      }
    }
    f32x4 x1[2][4];
#pragma unroll
    for (int u = 0; u < 2; ++u)
#pragma unroll
      for (int i = 0; i < 2; ++i)
#pragma unroll
        for (int j4 = 0; j4 < 2; ++j4) x1[u][i * 2 + j4] = *(const f32x4*)(p.out + (size_t)tt[u] * DM + i * 512 + lane * 8 + j4 * 4);
    f32x4 gfv[2][4];
#pragma unroll
    for (int u = 0; u < 2; ++u)
#pragma unroll
      for (int i4 = 0; i4 < 4; ++i4) gfv[u][i4] = *(const f32x4*)(p.mod + (tt[u] / SEQ) * 6144 + 5120 + (i4 >> 1) * 512 + lane * 8 + (i4 & 1) * 4);
    ss[0] = wave_sum(ss[0]); ss[1] = wave_sum(ss[1]);
#pragma unroll
    for (int u = 0; u < 2; ++u) {
      const int t = tt[u];
      if (u == 1 && t == t0) break;
      const float rstd = rsqrtf(ss[u] * (1.f / DM) + 1e-6f);
#pragma unroll
      for (int i = 0; i < 2; ++i)
#pragma unroll
        for (int j4 = 0; j4 < 2; ++j4) {
          const int k = i * 512 + lane * 8 + j4 * 4;
          float* op = p.out + (size_t)t * DM + k;
          const f32x4 gf = gfv[u][i * 2 + j4], gp = gpf[i * 2 + j4];
          f32x4 o;
#pragma unroll
          for (int j = 0; j < 4; ++j) o[j] = x1[u][i * 2 + j4][j] + gf[j] * (mv[u][i * 8 + j4 * 4 + j] * rstd * gp[j]);
          *(f32x4*)(rep ? (float*)p.hbf + (size_t)(t & 8191) * DM + k : op) = o;
        }
    }
  }
}

#define XCD_BAR_WORDS 3456
struct KArgs { const void* in[22]; float* out; char* ws; long long never; };
__host__ __device__ inline size_t al(size_t x) { return (x + 255) & ~(size_t)255; }
__host__ __device__ inline void fill_params(Params& p, const KArgs& k) {
  p.x = (const float*)k.in[0]; p.c = (const float*)k.in[1]; p.w_ada = (const float*)k.in[2]; p.b_ada = (const float*)k.in[3];
  p.g_pre_mix = (const float*)k.in[4]; p.g_post_mix = (const float*)k.in[5]; p.g_pre_ffn = (const float*)k.in[6];
  p.g_post_ffn = (const float*)k.in[7]; p.w_in = (const float*)k.in[8]; p.conv_w = (const float*)k.in[9];
  p.a_log = (const float*)k.in[10]; p.dt_bias = (const float*)k.in[11]; p.g_dn_out = (const float*)k.in[12];
  p.w_br_a = (const float*)k.in[13]; p.w_br_b = (const float*)k.in[14]; p.w_o = (const float*)k.in[15];
  p.w_router = (const float*)k.in[16]; p.b_router = (const float*)k.in[17]; p.w_gu = (const float*)k.in[18];
  p.b_gu = (const float*)k.in[19]; p.w_down = (const float*)k.in[20]; p.b_down = (const float*)k.in[21];
  p.out = k.out;
  char* w = k.ws;
  size_t o = 0;
#define take(bytes) (w + (o += al(bytes)) - al(bytes))
  p.mod = (float*)take(4 * 6144 * 4);
  p.cnt = (int*)take(16384);
  p.ba = (float*)take((size_t)T_TOK * 8 * 4);
  p.hbf = (bf16_t*)take((size_t)T_TOK * DM * 2);
  p.proj = (bf16_t*)take((size_t)T_TOK * PW * 2);
  p.w_in_t = (bf16_t*)take((size_t)PW * DM * 2);
  p.wgu8 = (unsigned char*)take((size_t)NE * 2048 * DM);
  p.wd8 = (unsigned char*)take((size_t)NE * 1024 * DM);
  p.h2q = (unsigned char*)take((size_t)T_TOK * DM);
  p.act8 = (unsigned char*)take((size_t)73728 * DM);
  p.wbra_t = (bf16_t*)take((size_t)1024 * 512 * 2);
  p.wbrb_t = (bf16_t*)take((size_t)1024 * 512 * 2);
  p.wo_t = (bf16_t*)take((size_t)1024 * 1024 * 2);
  p.qb = (bf16_t*)take((size_t)T_TOK * 512 * 2);
  p.kb = nullptr;
  p.kmean = (float*)take((size_t)16 * 16 * 128 * 4);
  p.oab = (bf16_t*)take((size_t)T_TOK * DM * 2);
  p.merged = (bf16_t*)take((size_t)T_TOK * DM * 2);
  p.mixer = (bf16_t*)take((size_t)T_TOK * DM * 2);
  p.h2 = nullptr;
  p.elist = (int*)take((size_t)NE * T_TOK * 4);
  p.aw = (float*)take((size_t)T_TOK * 4 * 4);
  p.rowmap = nullptr;
  p.dnA = (unsigned char*)take((size_t)1024 * DN_ABYTES);
  p.dnU = (float*)take((size_t)1024 * DN_UFLOATS * 4);
  p.dnG = (float*)take(4096);
  p.dnS = (unsigned char*)take((size_t)1024 * 8 * 4096);
  p.dnV = (unsigned char*)take((size_t)1024 * 8 * 2048);
  p.oab2 = (bf16_t*)take((size_t)T_TOK * 512 * 2);
  p.dbg = (float*)take(256);
  p.bar = (unsigned*)take(XCD_BAR_WORDS * 4);
  p.dn_out = p.oab; p.dn_out_ld = DM;
  p.Kp = (bf16_t*)take((size_t)16 * 128 * 8192);
  p.Vp = (bf16_t*)take((size_t)16 * 128 * 8192);
  p.wq = p.cnt + 32 * 64;
  p.mb_out = p.oab; p.mb_out_ld = DM; p.mb_out_off = 512;
  p.xs = nullptr; p.act = nullptr;
  p.yslot = (bf16_t*)take((size_t)65536 * DM * 2);
  p.nq = p.nk = p.nv = p.no = p.ntmp = p.nbeta = p.ng = nullptr;
#undef take
#undef t2
  p.never = (int)k.never;
}

#define XB_TMO      128
#define XB_XCNT(j)  (256  + 64 * (j))
#define XB_XSUB(j)  (1280 + 64 * (j))
#define XB_XGEN(j)  (2304 + 64 * (j))
#define XB_TOP      3328
#define XB_TOPGEN   3392
#define XB_SPIN_CAP (1u << 18)

__device__ __forceinline__ unsigned xb_ld(unsigned* p)              { return __hip_atomic_load(p, __ATOMIC_RELAXED, __HIP_MEMORY_SCOPE_AGENT); }
__device__ __forceinline__ unsigned xb_add(unsigned* p, unsigned v) { return __hip_atomic_fetch_add(p, v, __ATOMIC_RELAXED, __HIP_MEMORY_SCOPE_AGENT); }
__device__ __forceinline__ unsigned xb_xcc_id() { return (unsigned)__builtin_amdgcn_s_getreg((3 << 11) | 20) & 0xFu; }
#define XB_SPIN(cond, bar) do { unsigned _sp = 0; while (cond) { __builtin_amdgcn_s_sleep(1); \
    if ((++_sp & 255u) == 0u) { if (xb_ld(&(bar)[XB_TMO])) break; if (_sp > XB_SPIN_CAP) { atomicAdd(&(bar)[XB_TMO], 1u); break; } } } } while (0)

struct XcdBarrier {
    unsigned* bar; unsigned x;
    volatile LAS unsigned* st;
};

__device__ __forceinline__ XcdBarrier xcd_barrier_post(unsigned* bar, volatile LAS unsigned* st) {
    XcdBarrier b; b.bar = bar; b.x = xb_xcc_id(); b.st = st;
    if (threadIdx.x == 0) (void)xb_add(&bar[XB_XCNT(b.x)], 1u);
    return b;
}
__device__ __forceinline__ void xcd_barrier_complete(unsigned* bar, unsigned x, unsigned& nloc, unsigned& nx) {
    const unsigned G = gridDim.x * gridDim.y * gridDim.z;
    unsigned sum, cnt, mine, sp = 0u;
    for (;;) {
        sum = 0u; cnt = 0u; mine = 0u;
#pragma unroll
        for (unsigned j = 0; j < 16; ++j) { const unsigned c = xb_ld(&bar[XB_XCNT(j)]); sum += c; cnt += (c > 0u) ? 1u : 0u; mine = (j == x) ? c : mine; }
        if (sum == G) break;
        __builtin_amdgcn_s_sleep(1);
        if ((++sp & 255u) == 0u) { if (xb_ld(&bar[XB_TMO])) break; if (sp > XB_SPIN_CAP) { atomicAdd(&bar[XB_TMO], 1u); break; } }
    }
    nloc = mine > 0u ? mine : 1u; nx = cnt > 0u ? cnt : 1u;
}

__device__ __forceinline__ void xcd_barrier(const XcdBarrier& b, const int tid) {
    asm volatile("s_waitcnt vmcnt(0)" ::: "memory");
    __syncthreads();
    if (tid == 0) {
        unsigned* bar = b.bar;
        __builtin_amdgcn_s_waitcnt(0);
        unsigned nloc = b.st[0], nx = b.st[1];
        if (nloc == 0u) { xcd_barrier_complete(bar, b.x, nloc, nx); b.st[0] = nloc; b.st[1] = nx; }
        const unsigned old = xb_add(&bar[XB_XSUB(b.x)], 1u);
        const unsigned gen = old / nloc;
        if (old + 1u == (gen + 1u) * nloc) {
            __builtin_amdgcn_fence(__ATOMIC_RELEASE, "agent");
            asm volatile("s_waitcnt vmcnt(0)" ::: "memory");
            const unsigned og = xb_add(&bar[XB_TOP], 1u);
            const unsigned tg = og / nx;
            if (og + 1u == (tg + 1u) * nx) xb_add(&bar[XB_TOPGEN], 1u);
            else XB_SPIN(xb_ld(&bar[XB_TOPGEN]) == tg, bar);
            __builtin_amdgcn_fence(__ATOMIC_ACQUIRE, "agent");
            xb_add(&bar[XB_XGEN(b.x)], 1u);
            asm volatile("s_waitcnt vmcnt(0)" ::: "memory");
        } else {
            XB_SPIN(xb_ld(&bar[XB_XGEN(b.x)]) == gen, bar);
            __builtin_amdgcn_fence(__ATOMIC_ACQUIRE, "agent");
            asm volatile("s_waitcnt vmcnt(0)" ::: "memory");
        }
    }
    __syncthreads();
}


__device__ __forceinline__ void load_ka(KArgs& kk) {
#if defined(__HIP_DEVICE_COMPILE__)
  typedef __attribute__((address_space(1))) char* gptr_t;
  typedef const __attribute__((address_space(4))) gptr_t* kptr_t;
  kptr_t kp = (kptr_t)__builtin_amdgcn_kernarg_segment_ptr();
  asm volatile("" : "+s"(kp));
#pragma unroll
  for (int i = 0; i < 22; ++i) kk.in[i] = (const void*)kp[i];
  kk.out = (float*)kp[22];
  kk.ws = (char*)kp[23];
  kk.never = ((const __attribute__((address_space(4))) long long*)kp)[24];
#endif
}
__device__ __forceinline__ void grid_bar(const Params& p, LAS unsigned char* lds);
#define MEGA_LDS 148480
#define MEGA_LDS_ALLOC (MEGA_LDS + 16)
__device__ __forceinline__ void grid_bar(const Params& p, LAS unsigned char* lds) {
  XcdBarrier b; b.bar = p.bar; b.x = xb_xcc_id(); b.st = (volatile LAS unsigned*)(lds + MEGA_LDS);
  xcd_barrier(b, p.tid);
}
__global__ __launch_bounds__(512) void mega(KArgs ka) {
  extern __shared__ __attribute__((aligned(16))) unsigned char shm[];
  LAS unsigned char* lds = (LAS unsigned char*)shm;
  cg::grid_group grid = cg::this_grid();
  const int nblk = gridDim.x, bid = blockIdx.x;
  const int wv_ = __builtin_amdgcn_readfirstlane(threadIdx.x >> 6);
  volatile LAS unsigned* xst = (volatile LAS unsigned*)(lds + MEGA_LDS);
  if (threadIdx.x == 0) { xst[0] = 0u; xst[1] = 0u; xst[2] = 0u; xst[3] = 0u; }
  __syncthreads();
  { Params p0; fill_params(p0, ka); (void)xcd_barrier_post(p0.bar, xst); }
  if (ka.never) grid.sync();
#ifndef REPMASK
#define REPMASK 0
#endif
#define LOADKA KArgs kk; load_ka(kk)
#ifndef PHMASK
#define PHMASK 0xffff
#endif
#define PHASE(k, body) if (((PHMASK) >> (k)) & 1) for (int rep_ = 0; rep_ < (((REPMASK) >> (k)) & 1) + 1; ++rep_) { \
    LOADKA; Params p; fill_params(p, kk); { int t_; asm volatile("v_mbcnt_lo_u32_b32 %0, -1, 0\n\tv_mbcnt_hi_u32_b32 %0, -1, %0" : "=v"(t_)); p.tid = (wv_ << 6) | t_; } body; grid_bar(p, lds); }
#ifdef XBAR
  for (int xb_ = 0; xb_ < XBAR; ++xb_) { PHASE(15, {}) }
#endif
  PHASE(0, { ph_mod(p, lds, nblk, bid); ph_wt(p, lds, nblk, bid); })
  PHASE(1, { ph_h(p, lds, nblk, bid); })
  PHASE(2, { ph_proj(p, lds, nblk, bid); })
  PHASE(3, { bool first = true; for (int ci = bid; ci < 1024; ci += nblk) { dn_prep_chunk(p, lds, ci, first); first = false; }
             for (int item = bid; item < 256; item += nblk) moba_prep_block(p, lds, item); })
  PHASE(4, { if (bid < 32) dn_scan_blk(p, lds, bid); moba_worker(p, lds, rep_); })
  PHASE(5, { ph_dn_out(p, lds, nblk, bid); })
  PHASE(6, { ph_br(p, lds, nblk, bid); })
  PHASE(7, { ph_mix(p, lds, nblk, bid); })
  PHASE(8, { ph_post_mix(p, lds, nblk, bid, rep_); })
  PHASE(10, { ph_moe1(p, lds, nblk, bid); })
  PHASE(11, { ph_moe2(p, lds, nblk, bid); })
  PHASE(12, { ph_final(p, nblk, bid, rep_); })
}


extern "C" void kernel_launch(void* const* d_in, const int* in_sizes, int n_in, void* d_out, int out_size, void* d_ws,
                              size_t ws_size, hipStream_t stream) {
  KArgs ka{};
  for (int i = 0; i < 22; ++i) ka.in[i] = d_in[i];
  ka.out = (float*)d_out; ka.ws = (char*)d_ws; ka.never = 0;
  Params p{};
  fill_params(p, ka);
  static int grid_blocks = 0;
  if (!grid_blocks) {
    (void)hipFuncSetAttribute((const void*)mega, hipFuncAttributeMaxDynamicSharedMemorySize, MEGA_LDS_ALLOC);
    int dev = 0, cus = 0, per_cu = 0;
    (void)hipGetDevice(&dev);
    (void)hipDeviceGetAttribute(&cus, hipDeviceAttributeMultiprocessorCount, dev);
    (void)hipOccupancyMaxActiveBlocksPerMultiprocessor(&per_cu, mega, 512, MEGA_LDS_ALLOC);
    if (per_cu != 1) per_cu = 1;
    grid_blocks = cus * per_cu;
  }
  (void)hipMemsetAsync(p.cnt, 0, 16384, stream);
  (void)hipMemsetAsync(p.bar, 0, XCD_BAR_WORDS * 4, stream);
  void* args[] = {&ka};
  hipError_t e = hipLaunchCooperativeKernel((void*)mega, dim3(grid_blocks), dim3(512), args, MEGA_LDS_ALLOC, stream);
  if (e != hipSuccess) fprintf(stderr, "cooperative launch failed: %s (grid %d)\n", hipGetErrorString(e), grid_blocks);
}
```

```cpp
#include <hip/hip_runtime.h>
#include <hip/hip_cooperative_groups.h>
#include <cstdio>
namespace cg = cooperative_groups;
#include <stdint.h>

typedef unsigned short bf16_t;
#ifndef MB_ABL
#define MB_ABL 0
#endif

#define T_TOK 16384
#define SEQ 4096
#define NB 4
#define DM 1024
#define INW 5640
#define PW 5632
#define C_QA 0
#define C_KA 512
#define C_VA 1024
#define C_Z 1536
#define C_MQ 2048
#define C_MK 2560
#define C_MV 3072
#define C_GA 3584
#define C_GB 4608
#define NE 32

__device__ __forceinline__ bf16_t f2bf(float f) {
  unsigned u = __float_as_uint(f);
  u += 0x7fffu + ((u >> 16) & 1u);
  return (bf16_t)(u >> 16);
}
__device__ __forceinline__ float bf2f(bf16_t h) { return __uint_as_float(((unsigned)h) << 16); }
__device__ __forceinline__ float sigmoidf_(float x) { return __builtin_amdgcn_rcpf(1.f + __builtin_amdgcn_exp2f(-1.4426950408889634f * x)); }
__device__ __forceinline__ float siluf_(float x) { return x * sigmoidf_(x); }
__device__ __forceinline__ float wave_sum(float v) {
#pragma unroll
  for (int o = 32; o > 0; o >>= 1) v += __shfl_xor(v, o, 64);
  return v;
}
__device__ __forceinline__ float wave_max(float v) {
#pragma unroll
  for (int o = 32; o > 0; o >>= 1) v = fmaxf(v, __shfl_xor(v, o, 64));
  return v;
}

typedef unsigned u32x2 __attribute__((ext_vector_type(2)));
typedef __bf16 bf16x2_t __attribute__((ext_vector_type(2)));
typedef float f32x2_t __attribute__((ext_vector_type(2)));
__device__ __forceinline__ unsigned pk2(float a, float b) { f32x2_t v = {a, b}; bf16x2_t r = __builtin_convertvector(v, bf16x2_t); return __builtin_bit_cast(unsigned, r); }

__device__ __forceinline__ unsigned pk4_fp8(float a, float b, float c, float d) {
  int w = 0;
  w = __builtin_amdgcn_cvt_pk_fp8_f32(a, b, w, false);
  w = __builtin_amdgcn_cvt_pk_fp8_f32(c, d, w, true);
  return (unsigned)w;
}

struct Params {
  const float *x, *c, *w_ada, *b_ada, *g_pre_mix, *g_post_mix, *g_pre_ffn, *g_post_ffn, *w_in, *conv_w,
      *a_log, *dt_bias, *g_dn_out, *w_br_a, *w_br_b, *w_o, *w_router, *b_router, *w_gu, *b_gu, *w_down, *b_down;
  float* out;
  float* mod;
  int* cnt;
  int* dep;
  float* ba;
  bf16_t* hbf;
  bf16_t* proj;
  bf16_t* w_in_t;
  unsigned char* wgu8;
  unsigned char* wd8;
  unsigned char* h2q;
  unsigned char* act8;
  bf16_t* wbra_t;
  bf16_t* wbrb_t;
  bf16_t* wo_t;
  bf16_t* qb;
  bf16_t* kb;
  float* kmean;
  bf16_t* oab;
  bf16_t* merged;
  bf16_t* mixer;
  bf16_t* h2;
  int* elist;
  float* aw;
  bf16_t* act;
  bf16_t* xs;
  int* rowmap;
  bf16_t* yslot;
  unsigned char* dnA; float* dnU; float* dnG;
  unsigned char* dnS; unsigned char* dnV;
  bf16_t* dn_out; int dn_out_ld;
  bf16_t* oab2; float* dbg;
  unsigned* bar; int never; int tid;
  bf16_t* Kp; bf16_t* Vp; int* wq;
  bf16_t* mb_out; int mb_out_ld; int mb_out_off;
  float* nq; float* nk; float* nv;
  float* nbeta; float* ng;
  float* no;
  float* ntmp;
};

__device__ __forceinline__ int map_col(int n, int mode) {
  if (mode == 0) return n;
  if (mode == 1) return n < 2048 ? n : (n < 2056 ? -1 : n - 8);
  if (n < 1024) return (n >> 7) * 256 + (n & 127);
  int j = n - 1024;
  return (j >> 7) * 256 + 128 + (j & 127);
}
namespace pg8 {
#define PG8_LAS __attribute__((address_space(3)))
typedef short bf16x8 __attribute__((ext_vector_type(8)));
typedef float f32x4 __attribute__((ext_vector_type(4)));
typedef unsigned u32x4 __attribute__((ext_vector_type(4)));
constexpr int BM = 256, BK = 64, HALF = 128, HTB = HALF * BK * 2, STAGE_BYTES = 8 * HTB, NXCD = 8, WGM = 8;

__host__ __device__ __forceinline__ int lds_byte(int r, int c) { const int st = (r >> 4) * 2 + (c >> 5), rr = r & 15, cc = c & 31, ob = rr * 64 + cc * 2; return st * 1024 + (ob ^ (((ob >> 9) & 1) << 5)); }
__host__ __device__ __forceinline__ void stage_rc(int b, int& R, int& C) { const int st = b / 1024, sb = b % 1024, swz = sb ^ (((sb >> 9) & 1) << 5); R = (st >> 1) * 16 + swz / 64; C = (st & 1) * 32 + (swz % 64) / 2; }
__host__ __device__ __forceinline__ int perm32(int rho) { const int n = rho >> 4, i = rho & 15; return 8 * (i >> 2) + 4 * n + (i & 3); }

struct Unit { int pm, pn, z; };
__device__ __forceinline__ unsigned cvt_pk_bf16(float lo, float hi) { unsigned r; asm volatile("v_cvt_pk_bf16_f32 %0, %1, %2" : "=v"(r) : "v"(lo), "v"(hi)); return r; }

typedef int i32x8 __attribute__((ext_vector_type(8)));
typedef int i32x4 __attribute__((ext_vector_type(4)));
__device__ __forceinline__ i32x8 cat8(const bf16x8 lo, const bf16x8 hi) { const i32x4 a = __builtin_bit_cast(i32x4, lo), b = __builtin_bit_cast(i32x4, hi); return __builtin_shufflevector(a, b, 0, 1, 2, 3, 4, 5, 6, 7); }
struct TileOrder {
    int nM, nN, nwg, G, c;
    __device__ void init(int nM_, int nN_, int G_, int c_) { nM = nM_; nN = nN_; nwg = nM * nN; G = G_; c = c_; }
    __device__ bool tile(int i, int& pm, int& pn) const {
        const long L = (long)i * G + c; if (L >= nwg) return false;
        int wgid = (int)L; { const int q = nwg / NXCD, r = nwg % NXCD, xcd = wgid % NXCD, off = wgid / NXCD; wgid = (xcd < r ? xcd * (q + 1) : r * (q + 1) + (xcd - r) * q) + off; }
        const int nig = WGM * nN, gid = wgid / nig, fm = gid * WGM, gsz = (nM - fm) < WGM ? (nM - fm) : WGM;
        pm = fm + ((wgid % nig) % gsz); pn = (wgid % nig) / gsz; return true;
    }
};

template <class Epi, class Sched, bool FP8 = false>
__device__ __forceinline__ void gemm_phase(PG8_LAS unsigned char* lds, const int tid, const int lda, const int ldb, const int K, const Sched& S, const Epi& E) {
    const int wid = __builtin_amdgcn_readfirstlane(tid >> 6), lane = tid & 63, wr = wid >> 2, wc = wid & 3, fr = lane & 15, fq = lane >> 4;
    const int nt = K / BK;
    unsigned voffA[2], voffB[2];
#pragma unroll
    for (int i = 0; i < 2; ++i) { int R, C; stage_rc(tid * 16 + i * 8192, R, C); const int Rb = Epi::PERM ? ((R & ~31) + perm32(R & 31)) : R;
        voffA[i] = (unsigned)(R * lda + C) * 2u; voffB[i] = (unsigned)(Rb * ldb + C) * 2u; }
    const size_t kstep = (size_t)(BK * 2);
    const size_t hstepA = (size_t)HALF * lda * 2, hstepB = (size_t)HALF * ldb * 2;
    const unsigned ldsw = (unsigned)wid * 1024u;
    const int aoff = lds_byte(wr * 64 + fr, fq * 8), boff = lds_byte(wc * 32 + fr, fq * 8);
    constexpr int KOFF1 = 1024;
    unsigned gA[2][2] = {{0u, 0u}, {0u, 0u}}, gAn[2][2] = {{0u, 0u}, {0u, 0u}};
#define PG8_GOFFS(dst, unit) do { int t_ = tid; asm volatile("" : "+v"(t_)); _Pragma("unroll") for (int i_ = 0; i_ < 2; ++i_) { int gR_, gC_; stage_rc(t_ * 16 + i_ * 8192, gR_, gC_); \
        _Pragma("unroll") for (int h_ = 0; h_ < 2; ++h_) dst[h_][i_] = S.a_goff(unit, gR_ + 128 * h_, gC_); } } while (0)
#define PG8_SA(b, h) (((b) * 2 + (h)) * HTB)
#define PG8_SB(b, h) ((4 + (b) * 2 + (h)) * HTB)
#define PG8_STAGE(bufoff, gbase, voff) do { _Pragma("unroll") for (int _i = 0; _i < 2; ++_i) \
        __builtin_amdgcn_global_load_lds((const unsigned*)((const char*)(gbase) + (voff)[_i]), (PG8_LAS unsigned*)(lds + (bufoff) + ldsw + _i * 8192), 16, 0, 0); } while (0)
#define PG8_STAGEA(bufoff, ptr, h, nx) do { if constexpr (Sched::GATHER) { const unsigned gs_[2] = {(nx) ? gAn[h][0] : gA[h][0], (nx) ? gAn[h][1] : gA[h][1]}; PG8_STAGE(bufoff, ptr, gs_); } \
        else { PG8_STAGE(bufoff, (ptr) + (h) * hstepA, voffA); } } while (0)
#define PG8_LDA(dst, b, h) do { if constexpr (FP8) { _Pragma("unroll") for (int m = 0; m < 4; ++m) dst##8[m] = cat8(*(const PG8_LAS bf16x8*)(lds + PG8_SA(b, h) + aoff + m * 2048), *(const PG8_LAS bf16x8*)(lds + PG8_SA(b, h) + aoff + KOFF1 + m * 2048)); } \
        else { _Pragma("unroll") for (int m = 0; m < 4; ++m) _Pragma("unroll") for (int k = 0; k < 2; ++k) dst[m][k] = *(const PG8_LAS bf16x8*)(lds + PG8_SA(b, h) + aoff + k * KOFF1 + m * 2048); } } while (0)
#define PG8_LDB(dst, b, h) do { if constexpr (FP8) { _Pragma("unroll") for (int n = 0; n < 2; ++n) dst##8[n] = cat8(*(const PG8_LAS bf16x8*)(lds + PG8_SB(b, h) + boff + n * 2048), *(const PG8_LAS bf16x8*)(lds + PG8_SB(b, h) + boff + KOFF1 + n * 2048)); } \
        else { _Pragma("unroll") for (int n = 0; n < 2; ++n) _Pragma("unroll") for (int k = 0; k < 2; ++k) dst[n][k] = *(const PG8_LAS bf16x8*)(lds + PG8_SB(b, h) + boff + k * KOFF1 + n * 2048); } } while (0)
#define PG8_MMA(ai, bj, At, Bt) do { __builtin_amdgcn_s_setprio(1); if constexpr (FP8) { _Pragma("unroll") for (int m = 0; m < 4; ++m) _Pragma("unroll") for (int n = 0; n < 2; ++n) \
        asm volatile("v_mfma_f32_16x16x128_f8f6f4 %0, %1, %2, %0" : "+v"(acc[ai][bj][m][n]) : "v"(Bt##8[n]), "v"(At##8[m])); } \
        else { _Pragma("unroll") for (int m = 0; m < 4; ++m) _Pragma("unroll") for (int n = 0; n < 2; ++n) _Pragma("unroll") for (int k = 0; k < 2; ++k) \
        acc[ai][bj][m][n] = __builtin_amdgcn_mfma_f32_16x16x32_bf16(Bt[n][k], At[m][k], acc[ai][bj][m][n], 0, 0, 0); } __builtin_amdgcn_s_setprio(0); } while (0)
#define PG8_WAIT_V(n) asm volatile("s_waitcnt vmcnt(" #n ")" ::: "memory")
#define PG8_WAIT_L(n) asm volatile("s_waitcnt lgkmcnt(" #n ")" ::: "memory")
#define PG8_BAR __builtin_amdgcn_s_barrier()
#define PG8_SCHED __builtin_amdgcn_sched_barrier(0)
    Unit cur, nxt; int ui = 0;
    if (!S.next(0, cur)) return;
    f32x4 acc[2][2][4][2];
#pragma unroll
    for (int a = 0; a < 2; ++a)
#pragma unroll
        for (int b = 0; b < 2; ++b)
#pragma unroll
            for (int m = 0; m < 4; ++m)
#pragma unroll
                for (int n = 0; n < 2; ++n) acc[a][b][m][n] = (f32x4){0.f, 0.f, 0.f, 0.f};
    bf16x8 At[4][2], B0[2][2], B1[2][2];
    i32x8 At8[4], B08[2], B18[2];
    const char* cA = S.a_ptr(cur); const char* cB = S.b_ptr(cur);
    if constexpr (Sched::GATHER) { PG8_GOFFS(gA, cur); }
    PG8_STAGE(PG8_SB(0, 0), cB, voffB); PG8_STAGEA(PG8_SA(0, 0), cA, 0, false); PG8_STAGE(PG8_SB(0, 1), cB + hstepB, voffB); PG8_STAGEA(PG8_SA(0, 1), cA, 1, false);
    if (wr == 1) PG8_BAR;
    PG8_WAIT_V(4); PG8_BAR;
    PG8_STAGE(PG8_SB(1, 0), cB + kstep, voffB); PG8_STAGEA(PG8_SA(1, 0), cA + kstep, 0, false); PG8_STAGE(PG8_SB(1, 1), cB + hstepB + kstep, voffB);
    PG8_WAIT_V(6); PG8_BAR;
    for (;;) {
        const bool has_next = S.next(ui + 1, nxt);
        const char* nA = has_next ? S.a_ptr(nxt) : cA; const char* nB = has_next ? S.b_ptr(nxt) : cB;
        if constexpr (Sched::GATHER) { if (has_next) { PG8_GOFFS(gAn, nxt); } else {
_Pragma("unroll") for (int h = 0; h < 2; ++h) _Pragma("unroll") for (int i = 0; i < 2; ++i) gAn[h][i] = gA[h][i]; } }
_Pragma("unroll 1")
        for (int t = 0; t < nt; t += 2) {
            const bool last = (t == nt - 2);
            const char* a1 = cA + (size_t)(t + 1) * kstep;
            const char* a2 = last ? nA : cA + (size_t)(t + 2) * kstep; const char* b2 = last ? nB : cB + (size_t)(t + 2) * kstep;
            const char* a3 = a2 + kstep; const char* b3 = b2 + kstep;
            PG8_LDB(B0, 0, 0); PG8_SCHED; PG8_LDA(At, 0, 0); PG8_STAGEA(PG8_SA(1, 1), a1, 1, false);
            PG8_WAIT_L(8); PG8_BAR; PG8_WAIT_L(0); PG8_MMA(0, 0, At, B0); PG8_BAR; PG8_SCHED;
            PG8_LDB(B1, 0, 1); PG8_STAGE(PG8_SB(0, 0), b2, voffB);
            PG8_BAR; PG8_WAIT_L(0); PG8_MMA(0, 1, At, B1); PG8_BAR;
            PG8_LDA(At, 0, 1); PG8_STAGEA(PG8_SA(0, 0), a2, 0, last);
            PG8_BAR; PG8_WAIT_L(0); PG8_MMA(1, 0, At, B0); PG8_BAR; PG8_SCHED;
            PG8_STAGE(PG8_SB(0, 1), b2 + hstepB, voffB);
            PG8_WAIT_V(6); PG8_BAR; PG8_MMA(1, 1, At, B1); PG8_BAR;
            PG8_LDB(B0, 1, 0); PG8_SCHED; PG8_LDA(At, 1, 0); PG8_STAGEA(PG8_SA(0, 1), a2, 1, last);
            PG8_WAIT_L(8); PG8_BAR; PG8_WAIT_L(0); PG8_MMA(0, 0, At, B0); PG8_BAR; PG8_SCHED;
            PG8_LDB(B1, 1, 1); PG8_STAGE(PG8_SB(1, 0), b3, voffB);
            PG8_BAR; PG8_WAIT_L(0); PG8_MMA(0, 1, At, B1); PG8_BAR;
            PG8_LDA(At, 1, 1); PG8_STAGEA(PG8_SA(1, 0), a3, 0, last);
            PG8_BAR; PG8_WAIT_L(0); PG8_MMA(1, 0, At, B0); PG8_BAR; PG8_SCHED;
            PG8_STAGE(PG8_SB(1, 1), b3 + hstepB, voffB);
            PG8_WAIT_V(6); PG8_BAR; PG8_MMA(1, 1, At, B1); PG8_BAR;
        }
        { if constexpr (FP8) asm volatile("s_nop 15\n\ts_nop 3" ::: "memory");
          int t_ = tid; asm volatile("" : "+v"(t_));
          E(acc, cur, wr, wc, t_ & 15, (t_ & 63) >> 4);
          if constexpr (Sched::PUBLISH) { asm volatile("s_waitcnt vmcnt(0)" ::: "memory"); PG8_BAR; if (t_ == 256) S.publish(cur); } }
        if (!has_next) break;
#pragma unroll
        for (int a = 0; a < 2; ++a)
#pragma unroll
            for (int b = 0; b < 2; ++b)
#pragma unroll
                for (int m = 0; m < 4; ++m)
#pragma unroll
                    for (int n = 0; n < 2; ++n) acc[a][b][m][n] = (f32x4){0.f, 0.f, 0.f, 0.f};
        cur = nxt; cA = nA; cB = nB; ++ui;
        if constexpr (Sched::GATHER) {
_Pragma("unroll") for (int h = 0; h < 2; ++h) _Pragma("unroll") for (int i = 0; i < 2; ++i) gA[h][i] = gAn[h][i]; }
    }
    PG8_WAIT_V(0);
    if (wr == 0) PG8_BAR;
    PG8_BAR;
#undef PG8_SA
#undef PG8_SB
#undef PG8_STAGE
#undef PG8_STAGEA
#undef PG8_GOFFS
#undef PG8_LDA
#undef PG8_LDB
#undef PG8_MMA
#undef PG8_WAIT_V
#undef PG8_WAIT_L
#undef PG8_BAR
#undef PG8_SCHED
}
}
using pg8::f32x4; using pg8::u32x4; using pg8::Unit;

#define GEMM_LDS (pg8::STAGE_BYTES + 1024)

struct SchedProj : pg8::TileOrder {
  static constexpr bool GATHER = false; static constexpr bool PUBLISH = false;
  const char* A; const char* B;
  __device__ bool next(int i, Unit& u) const { u.z = 0; return tile(i, u.pm, u.pn); }
  __device__ const char* a_ptr(const Unit& u) const { return A + (size_t)u.pm * 256 * DM * 2; }
  __device__ const char* b_ptr(const Unit& u) const { return B + (size_t)u.pn * 256 * DM * 2; }
};
struct EpiProj {
  static constexpr bool PERM = true;
  bf16_t* O;
  __device__ __forceinline__ void operator()(const f32x4 (&acc)[2][2][4][2], const Unit& u, int wr, int wc, int fr, int fq) const {
    const int row0 = u.pm * 256 + wr * 64 + fr, col0 = u.pn * 256 + wc * 32 + 8 * fq;
    const bool gate = u.pn >= (C_GA / 256);
#pragma unroll
    for (int ai = 0; ai < 2; ++ai)
#pragma unroll
      for (int m = 0; m < 4; ++m) {
        bf16_t* rowp = O + (size_t)(row0 + ai * 128 + m * 16) * PW + col0;
#pragma unroll
        for (int bj = 0; bj < 2; ++bj) {
          f32x4 v0 = acc[ai][bj][m][0], v1 = acc[ai][bj][m][1];
          if (gate) {
#pragma unroll
            for (int j = 0; j < 4; ++j) { v0[j] = sigmoidf_(v0[j]); v1[j] = sigmoidf_(v1[j]); }
          }
          u32x4 w; w.x = pg8::cvt_pk_bf16(v0[0], v0[1]); w.y = pg8::cvt_pk_bf16(v0[2], v0[3]); w.z = pg8::cvt_pk_bf16(v1[0], v1[1]); w.w = pg8::cvt_pk_bf16(v1[2], v1[3]);
          *(u32x4*)(rowp + bj * 128) = w;
        }
      }
  }
};
__device__ void ph_proj(const Params& p, PG8_LAS unsigned char* lds, int nblk, int bid) {
  SchedProj S; S.init(T_TOK / 256, PW / 256, nblk, bid); S.A = (const char*)p.hbf; S.B = (const char*)p.w_in_t;
  EpiProj E{p.proj};
  pg8::gemm_phase(lds, p.tid, DM, DM, DM, S, E);
}

struct SchedBr : pg8::TileOrder {
  static constexpr bool GATHER = false; static constexpr bool PUBLISH = false;
  const char* A; const char* Ba; const char* Bb;
  __device__ bool next(int i, Unit& u) const { u.z = i & 1; return tile(i >> 1, u.pm, u.pn); }
  __device__ const char* a_ptr(const Unit& u) const { return A + (size_t)u.pm * 256 * DM * 2 + u.z * 512 * 2; }
  __device__ const char* b_ptr(const Unit& u) const { return (u.z ? Bb : Ba) + (size_t)u.pn * 256 * 512 * 2; }
};
__device__ __forceinline__ void unpack8(const u32x4 w, float (&f)[8]) {
  f[0] = __uint_as_float(w.x << 16); f[1] = __uint_as_float(w.x & 0xffff0000u); f[2] = __uint_as_float(w.y << 16); f[3] = __uint_as_float(w.y & 0xffff0000u);
  f[4] = __uint_as_float(w.z << 16); f[5] = __uint_as_float(w.z & 0xffff0000u); f[6] = __uint_as_float(w.w << 16); f[7] = __uint_as_float(w.w & 0xffff0000u);
}
struct EpiBr {
  static constexpr bool PERM = true;
  const bf16_t* proj; bf16_t* O;
  __device__ __forceinline__ void operator()(const f32x4 (&acc)[2][2][4][2], const Unit& u, int wr, int wc, int fr, int fq) const {
    const int row0 = u.pm * 256 + wr * 64 + fr, col0 = u.pn * 256 + wc * 32 + 8 * fq;
    const int gcol = (u.z ? C_GB : C_GA) + col0;
#pragma unroll
    for (int ai = 0; ai < 2; ++ai) {
      u32x4 gv[4][2], pv[4][2];
#pragma unroll
      for (int m = 0; m < 4; ++m)
#pragma unroll
        for (int bj = 0; bj < 2; ++bj) {
          const size_t row = (size_t)(row0 + ai * 128 + m * 16);
          gv[m][bj] = *(const u32x4*)(proj + row * PW + gcol + bj * 128);
          pv[m][bj] = (u32x4){0u, 0u, 0u, 0u};
          if (u.z) pv[m][bj] = *(const u32x4*)(O + row * DM + col0 + bj * 128);
        }
#pragma unroll
      for (int m = 0; m < 4; ++m)
#pragma unroll
        for (int bj = 0; bj < 2; ++bj) {
          const size_t row = (size_t)(row0 + ai * 128 + m * 16);
          float g[8], pf[8]; unpack8(gv[m][bj], g); unpack8(pv[m][bj], pf);
          const f32x4 v0 = acc[ai][bj][m][0], v1 = acc[ai][bj][m][1];
          float r[8];
#pragma unroll
          for (int j = 0; j < 4; ++j) { r[j] = v0[j] * g[j] + pf[j]; r[4 + j] = v1[j] * g[4 + j] + pf[4 + j]; }
          u32x4 w; w.x = pk2(r[0], r[1]); w.y = pk2(r[2], r[3]); w.z = pk2(r[4], r[5]); w.w = pk2(r[6], r[7]);
          *(u32x4*)(O + row * DM + col0 + bj * 128) = w;
        }
    }
  }
};
__device__ void ph_br(const Params& p, PG8_LAS unsigned char* lds, int nblk, int bid) {
  SchedBr S; S.init(T_TOK / 256, DM / 256, nblk, bid); S.A = (const char*)p.oab; S.Ba = (const char*)p.wbra_t; S.Bb = (const char*)p.wbrb_t;
  EpiBr E{p.proj, p.merged};
  pg8::gemm_phase(lds, p.tid, DM, 512, 512, S, E);
}

struct SchedMix : pg8::TileOrder {
  static constexpr bool GATHER = false; static constexpr bool PUBLISH = false;
  const char* A; const char* B;
  __device__ bool next(int i, Unit& u) const { u.z = 0; return tile(i, u.pm, u.pn); }
  __device__ const char* a_ptr(const Unit& u) const { return A + (size_t)u.pm * 256 * DM * 2; }
  __device__ const char* b_ptr(const Unit& u) const { return B + (size_t)u.pn * 256 * DM * 2; }
};
struct EpiMix {
  static constexpr bool PERM = true;
  bf16_t* O;
  __device__ __forceinline__ void operator()(const f32x4 (&acc)[2][2][4][2], const Unit& u, int wr, int wc, int fr, int fq) const {
    const int row0 = u.pm * 256 + wr * 64 + fr, col0 = u.pn * 256 + wc * 32 + 8 * fq;
#pragma unroll
    for (int ai = 0; ai < 2; ++ai)
#pragma unroll
      for (int m = 0; m < 4; ++m) {
        bf16_t* rowp = O + (size_t)(row0 + ai * 128 + m * 16) * DM + col0;
#pragma unroll
        for (int bj = 0; bj < 2; ++bj) {
          const f32x4 v0 = acc[ai][bj][m][0], v1 = acc[ai][bj][m][1];
          u32x4 w; w.x = pg8::cvt_pk_bf16(v0[0], v0[1]); w.y = pg8::cvt_pk_bf16(v0[2], v0[3]); w.z = pg8::cvt_pk_bf16(v1[0], v1[1]); w.w = pg8::cvt_pk_bf16(v1[2], v1[3]);
          *(u32x4*)(rowp + bj * 128) = w;
        }
      }
  }
};
__device__ void ph_mix(const Params& p, PG8_LAS unsigned char* lds, int nblk, int bid) {
  SchedMix S; S.init(T_TOK / 256, DM / 256, nblk, bid); S.A = (const char*)p.merged; S.B = (const char*)p.wo_t;
  EpiMix E{p.mixer};
  pg8::gemm_phase(lds, p.tid, DM, DM, DM, S, E);
}

template <bool GATH>
struct SchedMoe {
  static constexpr bool GATHER = GATH;
  static constexpr bool PUBLISH = GATH;
  const PG8_LAS int* tb; int NT; int G, c; int nwg;
  const char* A; const char* B; size_t bexp;
  const int* elist; int rowb;
  int* dep; int i0, Loff, rot;
  __device__ void publish(const Unit& u) const { __hip_atomic_fetch_add(dep + u.pm, 1, __ATOMIC_RELAXED, __HIP_MEMORY_SCOPE_AGENT); }
  __device__ bool next(int i, Unit& u) const {
    const long L = (long)(i + i0) * G + c - Loff; if (L >= nwg) return false;
    int wgid = (int)L; { const int q = nwg / 8, r = nwg % 8, xcd = wgid % 8; int off = wgid / 8;
      if constexpr (!GATH) { const int sz = xcd < r ? q + 1 : q; off += rot; if (off >= sz) off -= sz; }
      wgid = (xcd < r ? xcd * (q + 1) : r * (q + 1) + (xcd - r) * q) + off; }
    int e = 0;
#pragma unroll
    for (int st = 16; st >= 1; st >>= 1) if (wgid >= tb[e + st]) e += st;
    const int q = wgid - tb[e]; const int tiles = tb[33 + e + 1] - tb[33 + e];
    u.pm = tb[33 + e] + q % tiles; u.pn = q / tiles; u.z = e;
    if constexpr (!GATH) {
      while (__builtin_amdgcn_readfirstlane(__hip_atomic_load(dep + u.pm, __ATOMIC_RELAXED, __HIP_MEMORY_SCOPE_AGENT)) < 8) __builtin_amdgcn_s_sleep(4);
      asm volatile("" ::: "memory");
    }
    return true;
  }
  __device__ const char* a_ptr(const Unit& u) const { return GATH ? A : A + (size_t)u.pm * 256 * rowb; }
  __device__ const char* b_ptr(const Unit& u) const { return B + (size_t)u.z * bexp + (size_t)u.pn * 256 * rowb; }
  __device__ unsigned a_goff(const Unit& u, int tr, int C) const {
    const int i = (u.pm - tb[33 + u.z]) * 256 + tr;
    int tok = 0;
    if (i < tb[66 + u.z]) tok = elist[u.z * T_TOK + i] >> 2;
    return (unsigned)(tok * rowb + C * 2);
  }
};
__device__ __forceinline__ void moe_table(const Params& p, PG8_LAS int* tb, int NT) {
  if (p.tid == 0) {
    int ub = 0, tbp = 0;
    for (int e = 0; e < NE; ++e) { const int c = p.cnt[e * 64]; tb[e] = ub; tb[33 + e] = tbp; tb[66 + e] = c; const int t = (c + 255) >> 8; ub += t * NT; tbp += t; }
    tb[NE] = ub; tb[33 + NE] = tbp;
  }
  __syncthreads();
}
struct EpiMoe1 {
  static constexpr bool PERM = true;
  const float* b_gu; unsigned char* act;
  __device__ __forceinline__ void operator()(f32x4 (&acc)[2][2][4][2], const Unit& u, int wr, int wc, int fr, int fq) const {
    const int row0 = u.pm * 256 + wr * 64 + fr, jc = u.pn * 128 + wc * 32 + 8 * fq;
    const float* bg = b_gu + (size_t)u.z * 2048 + jc;
#pragma unroll
    for (int bj = 0; bj < 2; ++bj)
#pragma unroll
      for (int n = 0; n < 2; ++n) {
        const f32x4 bv = *(const f32x4*)(bg + bj * 1024 + n * 4);
#pragma unroll
        for (int ai = 0; ai < 2; ++ai)
#pragma unroll
          for (int m = 0; m < 4; ++m) acc[ai][bj][m][n] = acc[ai][bj][m][n] * 0.015625f + bv;
      }
#pragma unroll
    for (int ai = 0; ai < 2; ++ai)
#pragma unroll
      for (int m = 0; m < 4; ++m) {
        unsigned char* rowp = act + (size_t)(row0 + ai * 128 + m * 16) * DM + jc;
        float r[8];
#pragma unroll
        for (int n = 0; n < 2; ++n)
#pragma unroll
          for (int j = 0; j < 4; ++j) {
            float g = acc[ai][0][m][n][j], up = acc[ai][1][m][n][j];
            g = fminf(g, 7.f); up = fminf(fmaxf(up, -7.f), 7.f);
            r[n * 4 + j] = (up + 1.f) * g * sigmoidf_(1.702f * g);
          }
        u32x2 w; w.x = pk4_fp8(r[0], r[1], r[2], r[3]); w.y = pk4_fp8(r[4], r[5], r[6], r[7]);
        __hip_atomic_store((unsigned long long*)rowp, (unsigned long long)w.x | ((unsigned long long)w.y << 32), __ATOMIC_RELAXED, __HIP_MEMORY_SCOPE_AGENT);
      }
  }
};
__device__ void ph_moe1(const Params& p, PG8_LAS unsigned char* lds, int nblk, int bid) {
  PG8_LAS int* tb = (PG8_LAS int*)(lds + pg8::STAGE_BYTES);
  moe_table(p, tb, 8);
  SchedMoe<true> S; S.tb = tb; S.NT = 8; S.G = nblk; S.c = bid; S.nwg = tb[NE]; S.A = (const char*)p.h2q; S.B = (const char*)p.wgu8; S.bexp = (size_t)2048 * DM; S.elist = p.elist; S.rowb = DM;
  S.dep = p.dep; S.i0 = 0; S.Loff = 0; S.rot = 0;
  EpiMoe1 E{p.b_gu, p.act8};
  pg8::gemm_phase<EpiMoe1, SchedMoe<true>, true>(lds, p.tid, DM / 2, DM / 2, DM / 2, S, E);
}
struct EpiMoe2 {
  static constexpr bool PERM = true;
  const float* b_down; const int* elist; const PG8_LAS int* tb; bf16_t* yslot;
  __device__ __forceinline__ void operator()(f32x4 (&acc)[2][2][4][2], const Unit& u, int wr, int wc, int fr, int fq) const {
    const int row0 = u.pm * 256 + wr * 64 + fr, col0 = u.pn * 256 + wc * 32 + 8 * fq;
    const float* bd = b_down + (size_t)u.z * 1024 + col0;
#pragma unroll
    for (int bj = 0; bj < 2; ++bj)
#pragma unroll
      for (int n = 0; n < 2; ++n) {
        const f32x4 bv = *(const f32x4*)(bd + bj * 128 + n * 4);
#pragma unroll
        for (int ai = 0; ai < 2; ++ai)
#pragma unroll
          for (int m = 0; m < 4; ++m) acc[ai][bj][m][n] = acc[ai][bj][m][n] * 0.015625f + bv;
      }
    const int li0 = (u.pm - tb[33 + u.z]) * 256 + wr * 64 + fr, cnt = tb[66 + u.z];
    int av[2][4];
#pragma unroll
    for (int ai = 0; ai < 2; ++ai)
#pragma unroll
      for (int m = 0; m < 4; ++m) { const int li = li0 + ai * 128 + m * 16; av[ai][m] = elist[u.z * T_TOK + (li < cnt ? li : 0)]; if (li >= cnt) av[ai][m] = -1; }
#pragma unroll
    for (int ai = 0; ai < 2; ++ai)
#pragma unroll
      for (int m = 0; m < 4; ++m) {
        const int a = av[ai][m];
        if (a >= 0) {
          bf16_t* rowp = yslot + (size_t)a * DM + col0;
#pragma unroll
          for (int bj = 0; bj < 2; ++bj) {
            const f32x4 v0 = acc[ai][bj][m][0], v1 = acc[ai][bj][m][1];
            u32x4 w; w.x = pk2(v0[0], v0[1]); w.y = pk2(v0[2], v0[3]); w.z = pk2(v1[0], v1[1]); w.w = pk2(v1[2], v1[3]);
            *(u32x4*)(rowp + bj * 128) = w;
          }
        }
      }
  }
};
__device__ void ph_moe2(const Params& p, PG8_LAS unsigned char* lds, int nblk, int bid) {
  PG8_LAS int* tb = (PG8_LAS int*)(lds + pg8::STAGE_BYTES);
  moe_table(p, tb, 4);
  SchedMoe<false> S; S.tb = tb; S.NT = 4; S.G = nblk; S.c = bid; S.nwg = tb[NE]; S.A = (const char*)p.act8; S.B = (const char*)p.wd8; S.bexp = (size_t)1024 * DM; S.elist = p.elist; S.rowb = DM;
  { const int nwg1 = 2 * S.nwg; S.dep = p.dep; S.i0 = (nwg1 - bid + nblk - 1) / nblk; S.Loff = nwg1; S.rot = S.nwg >> 5; }
  EpiMoe2 E{p.b_down, p.elist, tb, p.yslot};
  pg8::gemm_phase<EpiMoe2, SchedMoe<false>, true>(lds, p.tid, DM / 2, DM / 2, DM / 2, S, E);
}

typedef short bf16x8 __attribute__((ext_vector_type(8)));
#define LAS __attribute__((address_space(3)))
#define MFMA16(a, b, c) __builtin_amdgcn_mfma_f32_16x16x32_bf16((a), (b), (c), 0, 0, 0)
__device__ __forceinline__ bf16x8 pack8(float a0, float a1, float a2, float a3, float a4, float a5, float a6, float a7) {
  u32x4 w; w.x = pk2(a0, a1); w.y = pk2(a2, a3); w.z = pk2(a4, a5); w.w = pk2(a6, a7);
  return __builtin_bit_cast(bf16x8, w);
}
__device__ __forceinline__ bf16_t f2bf_hw(float a) { return (bf16_t)(pk2(a, 0.f) & 0xffffu); }

#define DN_ABYTES 57344
#define DN_UFLOATS 8192
#define F_WN 0
#define F_QD 16
#define F_QK 32
#define F_KT 40

#define DP_KH 0
#define DP_QT 17408
#define DP_KHT 34816
#define DP_VT 53248
#define DP_TU 71680
#define DP_TW 80896
#define DP_LF 90112
#define DP_GC 107520
#define DP_BETA 107776
#define DP_CW 108032
#define DP_LB 114176
#define DP_TR 123392
#define DP_TT 132608
#define DP_MT 141824
#define DP_TOTAL 144128

template <int KS>
__device__ __forceinline__ f32x4 prod16(const LAS bf16_t* A, int lda, int arow0, const LAS bf16_t* Bt, int ldb, int brow0, f32x4 acc, int lane) {
  const int r = lane & 15, q = lane >> 4;
#pragma unroll
  for (int ks = 0; ks < KS; ++ks) {
    const bf16x8 a = *(const LAS bf16x8*)(A + (arow0 + r) * lda + 32 * ks + 8 * q);
    const bf16x8 b = *(const LAS bf16x8*)(Bt + (brow0 + r) * ldb + 32 * ks + 8 * q);
    acc = MFMA16(a, b, acc);
  }
  return acc;
}
__device__ __forceinline__ void tile_store_rm(LAS bf16_t* X, int ld, int row0, int col0, const f32x4 v, int lane) {
  const int r = lane & 15, q = lane >> 4;
#pragma unroll
  for (int i = 0; i < 4; ++i) X[(row0 + 4 * q + i) * ld + col0 + r] = f2bf_hw(v[i]);
}
__device__ __forceinline__ void tile_store_tr(LAS bf16_t* Xt, int ld, int row0, int col0, const f32x4 v, int lane) {
  const int r = lane & 15, q = lane >> 4;
  u32x2 w; w.x = pk2(v[0], v[1]); w.y = pk2(v[2], v[3]);
  *(LAS u32x2*)(Xt + (col0 + r) * ld + row0 + 4 * q) = w;
}

__device__ void dn_prep_chunk(const Params& p, LAS unsigned char* lds, int ci, bool load_cw) {
  const int tid = p.tid, lane = tid & 63, w = tid >> 6, r16 = lane & 15, q4 = lane >> 4;
  const int bh = ci >> 6, n = ci & 63, b = bh >> 2, h = bh & 3;
  LAS bf16_t* Kh = (LAS bf16_t*)(lds + DP_KH); LAS bf16_t* Qt = (LAS bf16_t*)(lds + DP_QT);
  LAS bf16_t* KhT = (LAS bf16_t*)(lds + DP_KHT); LAS bf16_t* VT = (LAS bf16_t*)(lds + DP_VT);
  LAS bf16_t* Tu = (LAS bf16_t*)(lds + DP_TU); LAS bf16_t* Tw = (LAS bf16_t*)(lds + DP_TW); LAS float* Lf = (LAS float*)(lds + DP_LF);
  LAS bf16_t* Lb = (LAS bf16_t*)(lds + DP_LB); LAS bf16_t* Tr = (LAS bf16_t*)(lds + DP_TR); LAS bf16_t* Tt = (LAS bf16_t*)(lds + DP_TT); LAS bf16_t* Mt = (LAS bf16_t*)(lds + DP_MT);
  LAS float* gcb = (LAS float*)(lds + DP_GC); LAS float* betab = (LAS float*)(lds + DP_BETA); LAS float* cw = (LAS float*)(lds + DP_CW);
  unsigned char* gA = (unsigned char*)p.dnA + (size_t)ci * DN_ABYTES;
  float* gU = p.dnU + (size_t)ci * DN_UFLOATS;

  if (load_cw) {
    for (int i = tid; i < 4 * 384; i += 512) { const int tap = i / 384, cc = i % 384, part = cc >> 7, d = cc & 127; cw[i] = p.conv_w[tap * 1536 + part * 512 + h * 128 + d]; }
  }
  __syncthreads();
  const int c = tid >> 3, g = tid & 7;
  const int s = n * 64 + c;
  const size_t t = (size_t)b * SEQ + s;
  float qv[16], kv[16], vv[16];
#pragma unroll
  for (int j = 0; j < 16; ++j) { qv[j] = 0.f; kv[j] = 0.f; vv[j] = 0.f; }
#pragma unroll
  for (int tap = 0; tap < 4; ++tap) {
    const int ss = s - 3 + tap;
    if (ss >= 0) {
      const bf16_t* row = p.proj + (t - 3 + tap) * PW + h * 128 + 16 * g;
      float x[8];
#pragma unroll
      for (int part = 0; part < 3; ++part) {
#pragma unroll
        for (int hh = 0; hh < 2; ++hh) {
          unpack8(*(const u32x4*)(row + part * 512 + 8 * hh), x);
#pragma unroll
          for (int j = 0; j < 8; ++j) {
            const float wv = cw[tap * 384 + part * 128 + 16 * g + 8 * hh + j];
            if (part == 0) qv[8 * hh + j] += wv * x[j];
            if (part == 1) kv[8 * hh + j] += wv * x[j];
            if (part == 2) vv[8 * hh + j] += wv * x[j];
          }
        }
      }
    }
    asm volatile("" ::: "memory");
  }
  float sq = 0.f, sk = 0.f;
#pragma unroll
  for (int j = 0; j < 16; ++j) { qv[j] = siluf_(qv[j]); kv[j] = siluf_(kv[j]); vv[j] = siluf_(vv[j]); sq += qv[j] * qv[j]; sk += kv[j] * kv[j]; }
  sq += __shfl_xor(sq, 1, 64); sq += __shfl_xor(sq, 2, 64); sq += __shfl_xor(sq, 4, 64);
  sk += __shfl_xor(sk, 1, 64); sk += __shfl_xor(sk, 2, 64); sk += __shfl_xor(sk, 4, 64);
  const float rq = rsqrtf(sq + 1e-6f) * 0.08838834764831845f, rk = rsqrtf(sk + 1e-6f);
#pragma unroll
  for (int j = 0; j < 16; ++j) { qv[j] *= rq; kv[j] *= rk; }
  if (g == 0) {
    const float bb = p.ba[t * 8 + h], aa = p.ba[t * 8 + 4 + h];
    const float xx = aa + p.dt_bias[h];
    const float sp = xx > 20.f ? xx : log1pf(__expf(xx));
    betab[c] = sigmoidf_(bb);
    gcb[c] = -__expf(p.a_log[h]) * sp;
  }
  {
    u32x4 w0, w1;
    w0.x = pk2(kv[0], kv[1]); w0.y = pk2(kv[2], kv[3]); w0.z = pk2(kv[4], kv[5]); w0.w = pk2(kv[6], kv[7]);
    w1.x = pk2(kv[8], kv[9]); w1.y = pk2(kv[10], kv[11]); w1.z = pk2(kv[12], kv[13]); w1.w = pk2(kv[14], kv[15]);
    *(LAS u32x4*)(Kh + c * 136 + 16 * g) = w0; *(LAS u32x4*)(Kh + c * 136 + 16 * g + 8) = w1;
    w0.x = pk2(qv[0], qv[1]); w0.y = pk2(qv[2], qv[3]); w0.z = pk2(qv[4], qv[5]); w0.w = pk2(qv[6], qv[7]);
    w1.x = pk2(qv[8], qv[9]); w1.y = pk2(qv[10], qv[11]); w1.z = pk2(qv[12], qv[13]); w1.w = pk2(qv[14], qv[15]);
    *(LAS u32x4*)(Qt + c * 136 + 16 * g) = w0; *(LAS u32x4*)(Qt + c * 136 + 16 * g + 8) = w1;
#pragma unroll
    for (int j = 0; j < 16; ++j) { KhT[(16 * g + j) * 72 + c] = f2bf_hw(kv[j]); VT[(16 * g + j) * 72 + c] = f2bf_hw(vv[j]); }
  }
  __syncthreads();
  if (w == 0) {
    float v = gcb[lane];
#pragma unroll
    for (int o = 1; o < 64; o <<= 1) { const float u = __shfl_up(v, o, 64); if (lane >= o) v += u; }
    gcb[lane] = v;
  }
  __syncthreads();
  const float gc_c = gcb[c], gl = gcb[63];
  {
    const float eg = __expf(gc_c);
    unsigned char* fb = gA + (size_t)(F_QD + (c >> 4) * 4 + (g >> 1)) * 1024 + (g & 1) * 8;
#pragma unroll
    for (int qq = 0; qq < 4; ++qq) {
      u32x2 wv; wv.x = pk2(qv[4 * qq] * eg, qv[4 * qq + 1] * eg); wv.y = pk2(qv[4 * qq + 2] * eg, qv[4 * qq + 3] * eg);
      *(u32x2*)(fb + ((c & 15) + 16 * qq) * 16) = wv;
    }
  }
  const int rt = w >> 1, ct0 = 2 * (w & 1);
#pragma unroll
  for (int tt = 0; tt < 2; ++tt) {
    const int ct = ct0 + tt;
    f32x4 gacc = {0.f, 0.f, 0.f, 0.f};
    gacc = prod16<4>(Kh, 136, 16 * rt, Kh, 136, 16 * ct, gacc, lane);
    const int m = 16 * ct + r16; const float gc_m = gcb[m];
    f32x4 lv;
#pragma unroll
    for (int i = 0; i < 4; ++i) {
      const int cc = 16 * rt + 4 * q4 + i;
      lv[i] = (m < cc) ? betab[cc] * gacc[i] * __expf(gcb[cc] - gc_m) : 0.f;
      Lf[cc * 68 + m] = lv[i];
    }
    tile_store_rm(Lb, 72, 16 * rt, 16 * ct, lv, lane);
    f32x4 qacc = {0.f, 0.f, 0.f, 0.f};
    qacc = prod16<4>(Kh, 136, 16 * rt, Qt, 136, 16 * ct, qacc, lane);
    const int cq = 16 * ct + r16; const float gc_cq = gcb[cq];
    float o4[4];
#pragma unroll
    for (int i = 0; i < 4; ++i) { const int mm = 16 * rt + 4 * q4 + i; o4[i] = (mm <= cq) ? qacc[i] * __expf(gc_cq - gcb[mm]) : 0.f; }
    u32x2 wv; wv.x = pk2(o4[0], o4[1]); wv.y = pk2(o4[2], o4[3]);
    *(u32x2*)(gA + (size_t)(F_QK + ct * 2 + (rt >> 1)) * 1024 + (r16 + 16 * q4) * 16 + (rt & 1) * 8) = wv;
  }
  __syncthreads();
  for (int i = tid; i < 2 * 64 * 72 / 8; i += 512) ((LAS u32x4*)Tr)[i] = (u32x4){0u, 0u, 0u, 0u};
  __syncthreads();
  if (w == 0) {
    int lo = lane; asm volatile("" : "+v"(lo));
    const int g = lo >> 4, j = lo & 15;
    unsigned lfb = DP_LF + (16 * g * 68 + 16 * g) * 4; asm volatile("" : "+v"(lfb));
    const LAS float* Lg = (const LAS float*)(lds + lfb);
    float t[16];
#pragma unroll
    for (int r = 0; r < 16; ++r) {
      float a0 = (r == j) ? 1.f : 0.f, a1 = 0.f;
#pragma unroll
      for (int k4 = 0; k4 < (r + 3) / 4; ++k4) {
        const f32x4 l = *(const LAS f32x4*)(Lg + r * 68 + 4 * k4);
        if (4 * k4 + 0 < r) a0 -= l[0] * t[4 * k4 + 0];
        if (4 * k4 + 1 < r) a1 -= l[1] * t[4 * k4 + 1];
        if (4 * k4 + 2 < r) a0 -= l[2] * t[4 * k4 + 2];
        if (4 * k4 + 3 < r) a1 -= l[3] * t[4 * k4 + 3];
      }
      t[r] = a0 + a1;
      Tr[(16 * g + r) * 72 + 16 * g + j] = f2bf_hw(t[r]);
    }
    u32x4 w0, w1;
    w0.x = pk2(t[0], t[1]); w0.y = pk2(t[2], t[3]); w0.z = pk2(t[4], t[5]); w0.w = pk2(t[6], t[7]);
    w1.x = pk2(t[8], t[9]); w1.y = pk2(t[10], t[11]); w1.z = pk2(t[12], t[13]); w1.w = pk2(t[14], t[15]);
    *(LAS u32x4*)(Tt + (16 * g + j) * 72 + 16 * g) = w0; *(LAS u32x4*)(Tt + (16 * g + j) * 72 + 16 * g + 8) = w1;
  }
  __syncthreads();
#pragma unroll 1
  for (int d = 1; d <= 3; ++d) {
    const bool act = w < 4 - d;
    const int I = w + d, J = w;
    LAS bf16_t* Mw = Mt + w * 16 * 24;
    if (act) {
      f32x4 macc = {0.f, 0.f, 0.f, 0.f};
      macc = prod16<2>(Lb, 72, 16 * I, Tt, 72, 16 * J, macc, lane);
      tile_store_tr(Mw, 24, 0, 0, macc, lane);
    }
    __syncthreads();
    if (act) {
      bf16x8 a = {0, 0, 0, 0, 0, 0, 0, 0}, bb = {0, 0, 0, 0, 0, 0, 0, 0};
      if (q4 < 2) { a = *(const LAS bf16x8*)(Tr + (16 * I + r16) * 72 + 16 * I + 8 * q4); bb = *(const LAS bf16x8*)(Mw + r16 * 24 + 8 * q4); }
      f32x4 tacc = {0.f, 0.f, 0.f, 0.f};
      tacc = MFMA16(a, bb, tacc);
#pragma unroll
      for (int i = 0; i < 4; ++i) tacc[i] = -tacc[i];
      tile_store_rm(Tr, 72, 16 * I, 16 * J, tacc, lane);
      tile_store_tr(Tt, 72, 16 * I, 16 * J, tacc, lane);
    }
    __syncthreads();
  }
  {
    const int cc = tid >> 3, m0 = (tid & 7) * 8;
    float tv[8]; unpack8(*(const LAS u32x4*)(Tr + cc * 72 + m0), tv);
    float tu[8], tw[8];
#pragma unroll
    for (int jj = 0; jj < 8; ++jj) { const float bm = betab[m0 + jj]; tu[jj] = tv[jj] * bm; tw[jj] = tu[jj] * __expf(gcb[m0 + jj]); }
    u32x4 wu, ww;
    wu.x = pk2(tu[0], tu[1]); wu.y = pk2(tu[2], tu[3]); wu.z = pk2(tu[4], tu[5]); wu.w = pk2(tu[6], tu[7]);
    ww.x = pk2(tw[0], tw[1]); ww.y = pk2(tw[2], tw[3]); ww.z = pk2(tw[4], tw[5]); ww.w = pk2(tw[6], tw[7]);
    *(LAS u32x4*)(Tu + cc * 72 + m0) = wu; *(LAS u32x4*)(Tw + cc * 72 + m0) = ww;
  }
  __syncthreads();
#pragma unroll
  for (int rr = 0; rr < 4; ++rr) {
    f32x4 u = {0.f, 0.f, 0.f, 0.f};
    u = prod16<2>(Tu, 72, 16 * rr, VT, 72, 16 * w, u, lane);
    *(f32x4*)(gU + ((w * 4 + rr) * 64 + lane) * 4) = u;
    f32x4 wt = {0.f, 0.f, 0.f, 0.f};
    wt = prod16<2>(KhT, 72, 16 * w, Tw, 72, 16 * rr, wt, lane);
    u32x2 wv; wv.x = pk2(-wt[0], -wt[1]); wv.y = pk2(-wt[2], -wt[3]);
    *(u32x2*)(gA + (size_t)(F_WN + rr * 4 + (w >> 1)) * 1024 + (r16 + 16 * q4) * 16 + (w & 1) * 8) = wv;
  }
#pragma unroll
  for (int it = 0; it < 4; ++it) {
    const int idx = tid + it * 512; const int d = idx >> 4, m4 = idx & 15;
    const u32x2 raw = *(const LAS u32x2*)(KhT + d * 72 + 4 * m4);
    const float k0 = __uint_as_float(raw.x << 16), k1 = __uint_as_float(raw.x & 0xffff0000u), k2 = __uint_as_float(raw.y << 16), k3 = __uint_as_float(raw.y & 0xffff0000u);
    const float e0 = __expf(gl - gcb[4 * m4]), e1 = __expf(gl - gcb[4 * m4 + 1]), e2 = __expf(gl - gcb[4 * m4 + 2]), e3 = __expf(gl - gcb[4 * m4 + 3]);
    u32x2 wv; wv.x = pk2(k0 * e0, k1 * e1); wv.y = pk2(k2 * e2, k3 * e3);
    *(u32x2*)(gA + (size_t)(F_KT + (d >> 4) * 2 + (m4 >> 3)) * 1024 + ((d & 15) + 16 * (m4 & 3)) * 16 + ((m4 >> 2) & 1) * 8) = wv;
  }
  if (tid == 0) p.dnG[ci] = __expf(gl);
}

#define DS_SLOT 32768
#define DS_TOTAL (4 * DS_SLOT)
#define DN_SFRAG (4 * 1024)
#define DN_VFRAG (2 * 1024)
__device__ void dn_scan_blk(const Params& p, LAS unsigned char* lds, int item) {
  const int tid = p.tid, lane = tid & 63, w = __builtin_amdgcn_readfirstlane(tid >> 6);
  const int bh = item >> 1, eh = item & 1;
  const int et = eh * 4 + (w & 3);
  const bool comp = w < 4;
  const unsigned char* gA = (const unsigned char*)p.dnA + (size_t)bh * 64 * DN_ABYTES;
  const float* gU = p.dnU + (size_t)bh * 64 * DN_UFLOATS;
  const float* gG = p.dnG + bh * 64;
  unsigned char* gS = (unsigned char*)p.dnS + ((size_t)bh * 64 * 8 + et) * DN_SFRAG + lane * 16;
  unsigned char* gV = (unsigned char*)p.dnV + ((size_t)bh * 64 * 8 + et) * DN_VFRAG + lane * 16;
  auto issue_A = [&](int n) {
#pragma unroll
    for (int i = 0; i < 8; ++i) {
      const int f = (w & 3) * 8 + i, sf = f < 16 ? F_WN + f : F_KT + (f - 16);
      __builtin_amdgcn_global_load_lds((const unsigned*)(gA + (size_t)n * DN_ABYTES + sf * 1024 + lane * 16), (LAS unsigned*)(lds + (n & 3) * DS_SLOT + f * 1024), 16, 0, 0);
    }
  };
  __syncthreads();
  f32x4 Un[4]; f32x4 S[8]; float gnext = 0.f;
  if (comp) {
#pragma unroll
    for (int rr = 0; rr < 4; ++rr) Un[rr] = *(const f32x4*)(gU + ((et * 4 + rr) * 64 + lane) * 4);
    gnext = gG[0];
  } else {
    issue_A(0); issue_A(1); issue_A(2);
    asm volatile("s_waitcnt vmcnt(16)" ::: "memory");
  }
#pragma unroll
  for (int dt = 0; dt < 8; ++dt) S[dt] = (f32x4){0.f, 0.f, 0.f, 0.f};
  asm volatile("s_waitcnt lgkmcnt(0)" ::: "memory");
  __builtin_amdgcn_s_barrier();
  asm volatile("" ::: "memory");
#pragma unroll 1
  for (int n = 0; n < 64; ++n) {
    const LAS unsigned char* Ab = lds + (n & 3) * DS_SLOT;
    if (!comp) {
      if (n + 3 < 64) { issue_A(n + 3); asm volatile("s_waitcnt vmcnt(16)" ::: "memory"); }
      else if (n + 2 < 64) asm volatile("s_waitcnt vmcnt(8)" ::: "memory");
      else asm volatile("s_waitcnt vmcnt(0)" ::: "memory");
    } else {
      f32x4 Vn[4];
#pragma unroll
      for (int rr = 0; rr < 4; ++rr) Vn[rr] = Un[rr];
      const float gdec = gnext;
      if (n + 1 < 64) {
#pragma unroll
        for (int rr = 0; rr < 4; ++rr) Un[rr] = *(const f32x4*)(gU + (size_t)(n + 1) * DN_UFLOATS + ((et * 4 + rr) * 64 + lane) * 4);
        gnext = gG[n + 1];
      }
      bf16x8 Sb[4];
#pragma unroll
      for (int ks = 0; ks < 4; ++ks) Sb[ks] = pack8(S[2 * ks][0], S[2 * ks][1], S[2 * ks][2], S[2 * ks][3], S[2 * ks + 1][0], S[2 * ks + 1][1], S[2 * ks + 1][2], S[2 * ks + 1][3]);
#pragma unroll
      for (int ks = 0; ks < 4; ++ks) *(bf16x8*)(gS + (size_t)n * 8 * DN_SFRAG + ks * 1024) = Sb[ks];
#pragma unroll
      for (int dt = 0; dt < 8; ++dt) S[dt] *= gdec;
#define LDF(idx) (*(const LAS bf16x8*)(Ab + (idx) * 1024 + lane * 16))
#define SBAR __builtin_amdgcn_sched_barrier(0)
      bf16x8 fa[8], fb[8];
#pragma unroll
      for (int i = 0; i < 8; ++i) fa[i] = LDF(i);
      SBAR;
#pragma unroll
      for (int i = 0; i < 8; ++i) fb[i] = LDF(8 + i);
      SBAR;
#pragma unroll
      for (int ks = 0; ks < 4; ++ks) { Vn[0] = MFMA16(fa[ks], Sb[ks], Vn[0]); Vn[1] = MFMA16(fa[4 + ks], Sb[ks], Vn[1]); }
      SBAR;
#pragma unroll
      for (int i = 0; i < 8; ++i) fa[i] = LDF(16 + i);
      SBAR;
#pragma unroll
      for (int ks = 0; ks < 4; ++ks) { Vn[2] = MFMA16(fb[ks], Sb[ks], Vn[2]); Vn[3] = MFMA16(fb[4 + ks], Sb[ks], Vn[3]); }
      SBAR;
#pragma unroll
      for (int i = 0; i < 8; ++i) fb[i] = LDF(24 + i);
      SBAR;
      bf16x8 Vb[2];
#pragma unroll
      for (int ks = 0; ks < 2; ++ks) Vb[ks] = pack8(Vn[2 * ks][0], Vn[2 * ks][1], Vn[2 * ks][2], Vn[2 * ks][3], Vn[2 * ks + 1][0], Vn[2 * ks + 1][1], Vn[2 * ks + 1][2], Vn[2 * ks + 1][3]);
#pragma unroll
      for (int ks = 0; ks < 2; ++ks) *(bf16x8*)(gV + (size_t)n * 8 * DN_VFRAG + ks * 1024) = Vb[ks];
#pragma unroll
      for (int ks = 0; ks < 2; ++ks)
#pragma unroll
        for (int dt = 0; dt < 4; ++dt) S[dt] = MFMA16(fa[dt * 2 + ks], Vb[ks], S[dt]);
#pragma unroll
      for (int ks = 0; ks < 2; ++ks)
#pragma unroll
        for (int dt = 0; dt < 4; ++dt) S[4 + dt] = MFMA16(fb[dt * 2 + ks], Vb[ks], S[4 + dt]);
#undef LDF
#undef SBAR
      asm volatile("s_waitcnt lgkmcnt(0)" ::: "memory");
    }
    __builtin_amdgcn_s_barrier();
    asm volatile("" ::: "memory");
  }
  asm volatile("s_waitcnt vmcnt(0)" ::: "memory");
}
#define DO_OT 32768
__device__ void ph_dn_out(const Params& p, LAS unsigned char* lds, int nblk, int bid) {
  const int tid = p.tid, lane = tid & 63, w = __builtin_amdgcn_readfirstlane(tid >> 6), r16 = lane & 15, q4 = lane >> 4;
  LAS float* Ot = (LAS float*)(lds + DO_OT);
  for (int ci = bid; ci < 1024; ci += nblk) {
    const int bh = ci >> 6, n = ci & 63, b = bh >> 2, h = bh & 3;
    const unsigned char* gA = (const unsigned char*)p.dnA + (size_t)ci * DN_ABYTES;
    __syncthreads();
#pragma unroll
    for (int i = 0; i < 3; ++i) {
      const int f = w * 3 + i;
      __builtin_amdgcn_global_load_lds((const unsigned*)(gA + (F_QD + f) * 1024 + lane * 16), (LAS unsigned*)(lds + f * 1024), 16, 0, 0);
    }
    bf16x8 Sb[4], Vb[2];
#pragma unroll
    for (int ks = 0; ks < 4; ++ks) Sb[ks] = *(const bf16x8*)((const unsigned char*)p.dnS + ((size_t)ci * 8 + w) * DN_SFRAG + ks * 1024 + lane * 16);
#pragma unroll
    for (int ks = 0; ks < 2; ++ks) Vb[ks] = *(const bf16x8*)((const unsigned char*)p.dnV + ((size_t)ci * 8 + w) * DN_VFRAG + ks * 1024 + lane * 16);
    asm volatile("s_waitcnt vmcnt(0)" ::: "memory");
    __syncthreads();
    f32x4 O[4];
#pragma unroll
    for (int rr = 0; rr < 4; ++rr) {
      O[rr] = (f32x4){0.f, 0.f, 0.f, 0.f};
#pragma unroll
      for (int ks = 0; ks < 4; ++ks) O[rr] = MFMA16(*(const LAS bf16x8*)(lds + (rr * 4 + ks) * 1024 + lane * 16), Sb[ks], O[rr]);
#pragma unroll
      for (int ks = 0; ks < 2; ++ks) O[rr] = MFMA16(*(const LAS bf16x8*)(lds + (16 + rr * 2 + ks) * 1024 + lane * 16), Vb[ks], O[rr]);
    }
#pragma unroll
    for (int rr = 0; rr < 4; ++rr)
#pragma unroll
      for (int i = 0; i < 4; ++i) Ot[(16 * rr + 4 * q4 + i) * 132 + 16 * w + r16] = O[rr][i];
    __syncthreads();
    {
      const int row = tid >> 3, seg = tid & 7;
      const size_t t = (size_t)b * SEQ + n * 64 + row;
      float o[16]; float ss = 0.f;
#pragma unroll
      for (int j4 = 0; j4 < 4; ++j4) { const f32x4 v = *(const LAS f32x4*)(Ot + row * 132 + 16 * seg + 4 * j4); o[4 * j4] = v[0]; o[4 * j4 + 1] = v[1]; o[4 * j4 + 2] = v[2]; o[4 * j4 + 3] = v[3]; }
#pragma unroll
      for (int j = 0; j < 16; ++j) ss += o[j] * o[j];
      ss += __shfl_xor(ss, 1, 64); ss += __shfl_xor(ss, 2, 64); ss += __shfl_xor(ss, 4, 64);
      const float rstd = rsqrtf(ss * (1.f / 128.f) + 1e-6f);
      const bf16_t* zp = p.proj + t * PW + C_Z + h * 128 + 16 * seg;
      float z0[8], z1[8]; unpack8(*(const u32x4*)zp, z0); unpack8(*(const u32x4*)(zp + 8), z1);
      float y[16];
#pragma unroll
      for (int j = 0; j < 8; ++j) { y[j] = o[j] * rstd * p.g_dn_out[16 * seg + j] * siluf_(z0[j]); y[8 + j] = o[8 + j] * rstd * p.g_dn_out[16 * seg + 8 + j] * siluf_(z1[j]); }
      u32x4 w0, w1;
      w0.x = pk2(y[0], y[1]); w0.y = pk2(y[2], y[3]); w0.z = pk2(y[4], y[5]); w0.w = pk2(y[6], y[7]);
      w1.x = pk2(y[8], y[9]); w1.y = pk2(y[10], y[11]); w1.z = pk2(y[12], y[13]); w1.w = pk2(y[14], y[15]);
      bf16_t* op = p.dn_out + t * p.dn_out_ld + h * 128 + 16 * seg;
      *(u32x4*)op = w0; *(u32x4*)(op + 8) = w1;
    }
  }
}
typedef float f32x16 __attribute__((ext_vector_type(16)));
#define MFMA32(a, b, c) __builtin_amdgcn_mfma_f32_32x32x16_bf16((a), (b), (c), 0, 0, 0)
#define MP_VL 0
#define MP_RED 65536
#define MP_TOTAL (65536 + 4096)

__device__ void moba_prep_block(const Params& p, LAS unsigned char* lds, int item) {
  const int tid = p.tid, lane = tid & 63, w = tid >> 6;
  const int bh = item >> 4, jb = item & 15, b = bh >> 2, h = bh & 3;
  LAS bf16_t* Vl = (LAS bf16_t*)(lds + MP_VL);
  LAS float* red = (LAS float*)(lds + MP_RED);
  __syncthreads();
#pragma unroll
  for (int it = 0; it < 8; ++it) {
    const int idx = tid + 512 * it, row = idx >> 4, ch = idx & 15;
    const u32x4 v = *(const u32x4*)(p.proj + ((size_t)b * SEQ + 256 * jb + row) * PW + C_MV + h * 128 + 8 * ch);
    *(LAS u32x4*)(Vl + row * 128 + 8 * ch) = v;
  }
  {
    const int r = tid >> 1, hh = tid & 1;
    const int pos = 256 * jb + r;
    const size_t t = (size_t)b * SEQ + pos;
    float cs[8], sn[8];
#pragma unroll
    for (int jj = 0; jj < 8; ++jj) {
      const float inv = exp2f(-(float)(8 * hh + jj) * (1.f / 16.f) * 18.931568569324174f);
      const float ang = (float)pos * inv;
      cs[jj] = cosf(ang); sn[jj] = sinf(ang);
    }
    float kacc[64];
#pragma unroll
    for (int which = 0; which < 2; ++which) {
      const bf16_t* src = p.proj + t * PW + (which ? C_MQ : C_MK) + h * 128 + 8 * hh;
      float x0[8], x1[8];
      unpack8(*(const u32x4*)(src), x0); unpack8(*(const u32x4*)(src + 16), x1);
      float y0[8], y1[8];
#pragma unroll
      for (int jj = 0; jj < 8; ++jj) { y0[jj] = x0[jj] * cs[jj] - x1[jj] * sn[jj]; y1[jj] = x1[jj] * cs[jj] + x0[jj] * sn[jj]; }
      u32x4 o[8];
      o[0].x = pk2(y0[0], y0[1]); o[0].y = pk2(y0[2], y0[3]); o[0].z = pk2(y0[4], y0[5]); o[0].w = pk2(y0[6], y0[7]);
      o[1].x = pk2(y1[0], y1[1]); o[1].y = pk2(y1[2], y1[3]); o[1].z = pk2(y1[4], y1[5]); o[1].w = pk2(y1[6], y1[7]);
#pragma unroll
      for (int ks = 2; ks < 8; ++ks) o[ks] = *(const u32x4*)(src + 16 * ks);
      if (which == 0) {
#pragma unroll
        for (int jj = 0; jj < 8; ++jj) { kacc[jj] = y0[jj]; kacc[8 + jj] = y1[jj]; }
#pragma unroll
        for (int ks = 2; ks < 8; ++ks) { float f[8]; unpack8(o[ks], f);
#pragma unroll
          for (int jj = 0; jj < 8; ++jj) kacc[8 * ks + jj] = f[jj]; }
        unsigned char* dst = (unsigned char*)p.Kp + ((size_t)(bh * 128 + 8 * jb + (r >> 5)) * 8192) + ((r & 31) + 32 * hh) * 16;
#pragma unroll
        for (int ks = 0; ks < 8; ++ks) *(u32x4*)(dst + ks * 1024) = o[ks];
      } else {
        bf16_t* dst = p.qb + ((size_t)bh * SEQ + pos) * 128 + 8 * hh;
#pragma unroll
        for (int ks = 0; ks < 8; ++ks) *(u32x4*)(dst + 16 * ks) = o[ks];
      }
    }
#pragma unroll
    for (int e = 0; e < 64; ++e) {
      float v = kacc[e];
      v += __shfl_xor(v, 2, 64); v += __shfl_xor(v, 4, 64); v += __shfl_xor(v, 8, 64); v += __shfl_xor(v, 16, 64); v += __shfl_xor(v, 32, 64);
      kacc[e] = v;
    }
    if (lane < 2) {
#pragma unroll
      for (int e = 0; e < 64; ++e) red[(w * 2 + lane) * 64 + e] = kacc[e];
    }
  }
  __syncthreads();
  if (tid < 128) {
    const int d = tid, hh = (d >> 3) & 1, ks = d >> 4, jj = d & 7;
    float a = 0.f;
#pragma unroll
    for (int ww = 0; ww < 8; ++ww) a += red[(ww * 2 + hh) * 64 + ks * 8 + jj];
    p.kmean[((size_t)bh * 16 + jb) * 128 + d] = a * (1.f / 256.f);
  }
#pragma unroll
  for (int it = 0; it < 8; ++it) {
    const int o = tid + 512 * it, ln = o & 63, frag = o >> 6, tl = frag >> 3, dt = (frag >> 1) & 3, s = frag & 1;
    const int r = ln & 31, hh = ln >> 5, d = 32 * dt + r;
    unsigned short e[8];
#pragma unroll
    for (int jj = 0; jj < 8; ++jj) { const int key = 32 * tl + 16 * s + 8 * (jj >> 2) + 4 * hh + (jj & 3); e[jj] = Vl[key * 128 + d]; }
    u32x4 wv; wv.x = e[0] | ((unsigned)e[1] << 16); wv.y = e[2] | ((unsigned)e[3] << 16); wv.z = e[4] | ((unsigned)e[5] << 16); wv.w = e[6] | ((unsigned)e[7] << 16);
    *(u32x4*)((unsigned char*)p.Vp + ((size_t)(bh * 128 + 8 * jb + tl) * 8192) + (dt * 2 + s) * 1024 + ln * 16) = wv;
  }
}
__device__ __forceinline__ int crow32(int reg, int hh) { return (reg & 3) + 8 * (reg >> 2) + 4 * hh; }
__device__ void moba_item(const Params& p, LAS float* km, LAS float* mrg, LAS float* ml, int bh, int ib, int sub, int par, int lane, int rep) {
  const int q = lane & 31, hh = lane >> 5;
  const int b = bh >> 2, h = bh & 3;
  const int s0 = 256 * ib + 32 * sub;
  const bf16_t* qrow = p.qb + ((size_t)bh * SEQ + s0 + q) * 128 + 8 * hh;
  bf16x8 Qf[8];
#pragma unroll
  for (int ks = 0; ks < 8; ++ks) Qf[ks] = *(const bf16x8*)(qrow + 16 * ks);
  LAS unsigned char* qlds = (LAS unsigned char*)km + 8192 + lane * 16;
#pragma unroll
  for (int ks = 0; ks < 8; ++ks) *(LAS bf16x8*)(qlds + ks * 1024) = Qf[ks];
  unsigned selmask = 0;
  if (ib > 0) {
    for (int idx = lane; idx < ib * 32; idx += 64) ((LAS f32x4*)km)[idx] = ((const f32x4*)(p.kmean + (size_t)bh * 16 * 128))[idx];
    float qf[64];
#pragma unroll
    for (int ks = 0; ks < 8; ++ks) { float f[8]; unpack8(__builtin_bit_cast(u32x4, Qf[ks]), f);
#pragma unroll
      for (int jj = 0; jj < 8; ++jj) qf[8 * ks + jj] = f[jj]; }
    float sc[16];
#pragma unroll
    for (int j = 0; j < 16; ++j) {
      sc[j] = -INFINITY;
      if (j < ib) {
        float a = 0.f;
#pragma unroll
        for (int ks = 0; ks < 8; ++ks) {
          const f32x4 k0 = *(const LAS f32x4*)(km + j * 128 + 16 * ks + 8 * hh), k1 = *(const LAS f32x4*)(km + j * 128 + 16 * ks + 8 * hh + 4);
          a += qf[8 * ks] * k0[0] + qf[8 * ks + 1] * k0[1] + qf[8 * ks + 2] * k0[2] + qf[8 * ks + 3] * k0[3];
          a += qf[8 * ks + 4] * k1[0] + qf[8 * ks + 5] * k1[1] + qf[8 * ks + 6] * k1[2] + qf[8 * ks + 7] * k1[3];
        }
        a += __shfl_xor(a, 32, 64);
        sc[j] = a;
      }
    }
#pragma unroll
    for (int r = 0; r < 3; ++r) {
      if (r < ib) {
        float best = -INFINITY; int bi = 0;
#pragma unroll
        for (int j = 0; j < 16; ++j) if (sc[j] > best) { best = sc[j]; bi = j; }
        selmask |= 1u << bi;
#pragma unroll
        for (int j = 0; j < 16; ++j) if (j == bi) sc[j] = -INFINITY;
      }
    }
  }
  unsigned rem = 0;
  for (int j = 0; j < ib; ++j) if (__ballot((selmask >> j) & 1u) != 0ull) rem |= 1u << j;
  rem = __builtin_amdgcn_readfirstlane(rem);
  const int own0 = 8 * ib, diag = 8 * ib + sub;
  const float cscale = 0.08838834764831845f * 1.4426950408889634f;
  float m = -1e30f, l = 0.f;
  f32x16 O[4];
#pragma unroll
  for (int dt = 0; dt < 4; ++dt)
#pragma unroll
    for (int r = 0; r < 16; ++r) O[dt][r] = 0.f;
  const unsigned char* kbase = (const unsigned char*)p.Kp + (size_t)bh * 128 * 8192 + lane * 16;
  const unsigned char* vbase = (const unsigned char*)p.Vp + (size_t)bh * 128 * 8192 + lane * 16;
  auto adv = [&](int& kt_, unsigned& rem_) {
    if (kt_ < 0) return;
    if (kt_ >= own0 ? (kt_ < diag) : ((kt_ & 7) != 7)) { kt_ = kt_ + 1; return; }
    if (rem_ == 0u) { kt_ = -1; return; }
    kt_ = 8 * (__builtin_ctz(rem_)); rem_ &= rem_ - 1u;
  };
  int kt = own0;
  if (par) adv(kt, rem);
  auto load_k = [&](int t, bf16x8 (&K_)[8]) {
#pragma unroll
    for (int ks = 0; ks < 8; ++ks) K_[ks] = *(const bf16x8*)(kbase + (size_t)t * 8192 + ks * 1024);
  };
  auto tile_step = [&](bf16x8 (&Kc)[8], bf16x8 (&Kn)[8]) -> bool {
    int ktn = kt; unsigned remn = rem;
    adv(ktn, remn); adv(ktn, remn);
    bf16x8 Vf[8];
#pragma unroll
    for (int f = 0; f < 8; ++f) Vf[f] = *(const bf16x8*)(vbase + (size_t)kt * 8192 + f * 1024);
    if (ktn >= 0) load_k(ktn, Kn);
    f32x16 S;
#pragma unroll
    for (int r = 0; r < 16; ++r) S[r] = 0.f;
#pragma unroll
    for (int ks = 0; ks < 8; ++ks) S = MFMA32(Kc[ks], *(const LAS bf16x8*)(qlds + ks * 1024), S);
    const bool allowed = (kt >= own0) || ((selmask >> (kt >> 3)) & 1u);
    const float nb = allowed ? 0.f : -INFINITY;
    float sv[16]; float mx = -INFINITY;
#pragma unroll
    for (int r = 0; r < 16; ++r) sv[r] = __builtin_fmaf(S[r], cscale, nb);
    if (kt == diag) {
#pragma unroll
      for (int r = 0; r < 16; ++r) if (crow32(r, hh) > q) sv[r] = -INFINITY;
    }
#pragma unroll
    for (int r = 0; r < 16; ++r) mx = fmaxf(mx, sv[r]);
    mx = fmaxf(mx, __shfl_xor(mx, 32, 64));
    const bool grow = mx > m + 8.f;
    const float mn = (__ballot(grow) != 0ull) ? fmaxf(m, mx) : m;
    const float alpha = __builtin_amdgcn_exp2f(m - mn);
    float ps = 0.f;
#pragma unroll
    for (int r = 0; r < 16; ++r) { sv[r] = __builtin_amdgcn_exp2f(sv[r] - mn); ps += sv[r]; }
    l = l * alpha + ps; m = mn;
    if (__ballot(alpha != 1.f) != 0ull) {
#pragma unroll
      for (int dt = 0; dt < 4; ++dt)
#pragma unroll
        for (int r = 0; r < 16; ++r) O[dt][r] *= alpha;
    }
    const bf16x8 P0 = pack8(sv[0], sv[1], sv[2], sv[3], sv[4], sv[5], sv[6], sv[7]);
    const bf16x8 P1 = pack8(sv[8], sv[9], sv[10], sv[11], sv[12], sv[13], sv[14], sv[15]);
#pragma unroll
    for (int dt = 0; dt < 4; ++dt) { O[dt] = MFMA32(Vf[dt * 2], P0, O[dt]); O[dt] = MFMA32(Vf[dt * 2 + 1], P1, O[dt]); }
    kt = ktn; rem = remn;
    return kt >= 0;
  };
  if (kt >= 0) {
    bf16x8 KA[8], KB[8];
    load_k(kt, KA);
#pragma unroll 1
    for (;;) {
      if (!tile_step(KA, KB)) break;
      asm volatile("" ::: "memory");
      if (!tile_step(KB, KA)) break;
      asm volatile("" ::: "memory");
    }
  }
  asm volatile("s_waitcnt vmcnt(0) lgkmcnt(0)" ::: "memory");
  if (par) {
    ml[lane] = m; ml[64 + lane] = l;
#pragma unroll
    for (int dt = 0; dt < 4; ++dt)
#pragma unroll
      for (int r = 0; r < 16; ++r) mrg[(dt * 16 + r) * 64 + lane] = O[dt][r];
  }
  __syncthreads();
  if (par == 0) {
    const float m2 = ml[lane], l2 = ml[64 + lane];
    const float mm = fmaxf(m, m2);
    const float a1 = __builtin_amdgcn_exp2f(m - mm), a2 = __builtin_amdgcn_exp2f(m2 - mm);
    l = l * a1 + l2 * a2;
#pragma unroll
    for (int dt = 0; dt < 4; ++dt)
#pragma unroll
      for (int r = 0; r < 16; ++r) O[dt][r] = O[dt][r] * a1 + mrg[(dt * 16 + r) * 64 + lane] * a2;
  }
  if (par == 0) {
  l += __shfl_xor(l, 32, 64);
  const float inv = 1.f / l;
  bf16_t* orow = rep ? p.oab2 + ((size_t)b * SEQ + s0 + q) * 512 + h * 128 : p.mb_out + ((size_t)b * SEQ + s0 + q) * p.mb_out_ld + p.mb_out_off + h * 128;
#pragma unroll
  for (int dt = 0; dt < 4; ++dt)
#pragma unroll
    for (int g4 = 0; g4 < 4; ++g4) {
      u32x2 wv; wv.x = pk2(O[dt][4 * g4] * inv, O[dt][4 * g4 + 1] * inv); wv.y = pk2(O[dt][4 * g4 + 2] * inv, O[dt][4 * g4 + 3] * inv);
      *(u32x2*)(orow + 32 * dt + 8 * g4 + 4 * hh) = wv;
    }
  }
  __syncthreads();
}
__device__ void moba_worker(const Params& p, LAS unsigned char* lds, int qi) {
  const int lane = p.tid & 63, w = __builtin_amdgcn_readfirstlane(p.tid >> 6);
  LAS float* km = (LAS float*)(lds + w * 16384);
  LAS float* mrg = (LAS float*)(lds + ((w & 3) + 4) * 16384);
  LAS float* ml = (LAS float*)(lds + 131072) + (w & 3) * 128;
  LAS int* slot = (LAS int*)(lds + 131072 + 2048);
  const int g0 = (int)((unsigned)__builtin_amdgcn_s_getreg((3 << 11) | 20) & 7u);
  for (int gi = 0; gi < 8; ++gi) {
    const int g = (g0 + gi) & 7;
    for (;;) {
      __syncthreads();
      if (p.tid == 0) slot[0] = atomicAdd(p.wq + qi * 8 + g, 1);
      __syncthreads();
      const int idx = slot[0];
      if (idx >= 64) break;
      const int bh = 2 * g + (idx >> 5), ib = 15 - ((idx >> 1) & 15), quad = 1 - (idx & 1);
      moba_item(p, km, mrg, ml, bh, ib, 4 * quad + (w & 3), w >> 2, lane, qi);
    }
  }
}
__device__ void ph_mod(const Params& p, LAS unsigned char* lds, int nblk, int bid) {
  LAS float* sc = (LAS float*)lds;
  LAS float* part = (LAS float*)(lds + 16384);
  const int tid = p.tid;
  if (bid >= 192) return;
  for (int i = tid; i < 4096; i += 512) sc[i] = siluf_(p.c[i]);
  __syncthreads();
  for (int task = bid; task < 192; task += nblk) {
    const int jj = tid & 31, ks = tid >> 5, j = task * 32 + jj;
    float a0 = 0.f, a1 = 0.f, a2 = 0.f, a3 = 0.f;
#pragma unroll 8
    for (int kk = 0; kk < 64; ++kk) {
      const int k = ks * 64 + kk;
      const float w = p.w_ada[(size_t)k * 6144 + j];
      a0 += sc[k] * w; a1 += sc[1024 + k] * w; a2 += sc[2048 + k] * w; a3 += sc[3072 + k] * w;
    }
    *(LAS f32x4*)(part + (ks * 32 + jj) * 4) = (f32x4){a0, a1, a2, a3};
    __syncthreads();
    if (tid < 128) {
      const int j2 = tid & 31, bb = tid >> 5;
      float a = 0.f;
#pragma unroll
      for (int s = 0; s < 16; ++s) a += part[(s * 32 + j2) * 4 + bb];
      p.mod[bb * 6144 + task * 32 + j2] = a + p.b_ada[task * 32 + j2];
    }
    __syncthreads();
  }
}

#define WT_T0 1424
#define WT_T1 (WT_T0 + 16384)
#define WT_T2 (WT_T1 + 8192)
#define WT_T3 (WT_T2 + 128)
#define WT_T4 (WT_T3 + 128)
#define WT_T5 (WT_T4 + 256)
struct WtTile { const float* src; bf16_t* dst; int K, N, mode, k0, n0; unsigned char* dst8; };
__device__ __forceinline__ WtTile wt_desc(const Params& p, int t) {
  WtTile d;
  if (t < WT_T0) { const int kt = t / 89, nt = t % 89; d = {p.w_in, p.w_in_t, 1024, INW, 1, kt * 64, nt * 64, nullptr}; }
  else if (t < WT_T1) { const int u = t - WT_T0, e = u >> 9, r = u & 511, kt = r >> 5, nt = r & 31; d = {p.w_gu + (size_t)e * 1024 * 2048, nullptr, 1024, 2048, 2, kt * 64, nt * 64, p.wgu8 + (size_t)e * 2048 * 1024}; }
  else if (t < WT_T2) { const int u = t - WT_T1, e = u >> 8, r = u & 255, kt = r >> 4, nt = r & 15; d = {p.w_down + (size_t)e * 1024 * 1024, nullptr, 1024, 1024, 0, kt * 64, nt * 64, p.wd8 + (size_t)e * 1024 * 1024}; }
  else if (t < WT_T3) { const int u = t - WT_T2, kt = u >> 4, nt = u & 15; d = {p.w_br_a, p.wbra_t, 512, 1024, 0, kt * 64, nt * 64, nullptr}; }
  else if (t < WT_T4) { const int u = t - WT_T3, kt = u >> 4, nt = u & 15; d = {p.w_br_b, p.wbrb_t, 512, 1024, 0, kt * 64, nt * 64, nullptr}; }
  else { const int u = t - WT_T4, kt = u >> 4, nt = u & 15; d = {p.w_o, p.wo_t, 1024, 1024, 0, kt * 64, nt * 64, nullptr}; }
  return d;
}
__device__ __forceinline__ void wt_load(const WtTile& d, int tid, f32x4 (&v)[2]) {
#pragma unroll
  for (int it = 0; it < 2; ++it) {
    const int row = (tid >> 4) + 32 * it, n = d.n0 + (tid & 15) * 4;
    v[it] = (f32x4){0.f, 0.f, 0.f, 0.f};
    if (n < d.N) v[it] = __builtin_nontemporal_load((const f32x4*)(d.src + (size_t)(d.k0 + row) * d.N + n));
  }
}
__device__ void ph_wt(const Params& p, LAS unsigned char* lds, int nblk, int bid) {
  LAS float* tile = (LAS float*)(lds + 32768);
  const int tid = p.tid;
  int t = bid;
  if (t >= WT_T5) return;
  WtTile cur = wt_desc(p, t);
  f32x4 v[2]; wt_load(cur, tid, v);
  WtTile nxt = cur; f32x4 vn[2] = {v[0], v[1]};
  if (t + nblk < WT_T5) { nxt = wt_desc(p, t + nblk); wt_load(nxt, tid, vn); }
  for (;;) {
    const int tnn = t + 2 * nblk;
    WtTile nn = nxt; f32x4 vnn[2] = {vn[0], vn[1]};
    if (tnn < WT_T5) { nn = wt_desc(p, tnn); wt_load(nn, tid, vnn); }
#pragma unroll
    for (int it = 0; it < 2; ++it) {
      const int row = (tid >> 4) + 32 * it, c4 = (tid & 15) * 4;
      tile[row * 65 + c4] = v[it][0]; tile[row * 65 + c4 + 1] = v[it][1]; tile[row * 65 + c4 + 2] = v[it][2]; tile[row * 65 + c4 + 3] = v[it][3];
    }
    __syncthreads();
    {
      const int nl = tid >> 3, kc = tid & 7, n = cur.n0 + nl;
      if (n < cur.N) {
        const int dd = map_col(n, cur.mode);
        if (dd >= 0) {
          float f[8];
#pragma unroll
          for (int j = 0; j < 8; ++j) f[j] = tile[(8 * kc + j) * 65 + nl];
          if (cur.dst8) {
            u32x2 w; w.x = pk4_fp8(f[0] * 64.f, f[1] * 64.f, f[2] * 64.f, f[3] * 64.f); w.y = pk4_fp8(f[4] * 64.f, f[5] * 64.f, f[6] * 64.f, f[7] * 64.f);
            *(u32x2*)(cur.dst8 + (size_t)dd * cur.K + cur.k0 + 8 * kc) = w;
          } else {
            u32x4 w; w.x = pk2(f[0], f[1]); w.y = pk2(f[2], f[3]); w.z = pk2(f[4], f[5]); w.w = pk2(f[6], f[7]);
            *(u32x4*)(cur.dst + (size_t)dd * cur.K + cur.k0 + 8 * kc) = w;
          }
        }
      }
    }
    __syncthreads();
    if (t + nblk >= WT_T5) break;
    t += nblk; cur = nxt; v[0] = vn[0]; v[1] = vn[1]; nxt = nn; vn[0] = vnn[0]; vn[1] = vnn[1];
  }
}

__device__ void ph_h(const Params& p, LAS unsigned char* lds, int nblk, int bid) {
  const int wid = p.tid >> 6, lane = p.tid & 63;
  LAS float* wb = (LAS float*)lds;
  for (int i = p.tid; i < 2048; i += 512) {
    const int k = i >> 1, hf = i & 1;
    const f32x4 v = *(const f32x4*)(p.w_in + (size_t)k * INW + 2048 + 4 * hf);
    wb[(4 * hf + 0) * 1024 + k] = v[0]; wb[(4 * hf + 1) * 1024 + k] = v[1]; wb[(4 * hf + 2) * 1024 + k] = v[2]; wb[(4 * hf + 3) * 1024 + k] = v[3];
  }
  __syncthreads();
  f32x4 gv[4];
#pragma unroll
  for (int i = 0; i < 4; ++i) gv[i] = *(const f32x4*)(p.g_pre_mix + i * 256 + lane * 4);
  f32x4 xnx[4];
  if (bid * 8 + wid < T_TOK) {
#pragma unroll
    for (int i = 0; i < 4; ++i) xnx[i] = *(const f32x4*)(p.x + (size_t)(bid * 8 + wid) * DM + i * 256 + lane * 4);
  }
  for (int t = bid * 8 + wid; t < T_TOK; t += nblk * 8) {
    const int b = t / SEQ;
    f32x4 xv[4];
    float ss = 0.f;
#pragma unroll
    for (int i = 0; i < 4; ++i) {
      xv[i] = xnx[i];
      ss += xv[i][0] * xv[i][0] + xv[i][1] * xv[i][1] + xv[i][2] * xv[i][2] + xv[i][3] * xv[i][3];
    }
    if (t + nblk * 8 < T_TOK) {
#pragma unroll
      for (int i = 0; i < 4; ++i) xnx[i] = *(const f32x4*)(p.x + (size_t)(t + nblk * 8) * DM + i * 256 + lane * 4);
    }
    ss = wave_sum(ss);
    const float rstd = rsqrtf(ss * (1.f / DM) + 1e-6f);
    const float* shift = p.mod + b * 6144;
    const float* scale = p.mod + b * 6144 + 1024;
    float acc[8] = {0, 0, 0, 0, 0, 0, 0, 0};
    f32x4 scv[4], shv[4];
#pragma unroll
    for (int i = 0; i < 4; ++i) { scv[i] = *(const f32x4*)(scale + i * 256 + lane * 4); shv[i] = *(const f32x4*)(shift + i * 256 + lane * 4); }
#pragma unroll
    for (int i = 0; i < 4; ++i) {
      const int k = i * 256 + lane * 4;
      const f32x4 g = gv[i], sc = scv[i], sh = shv[i];
      f32x4 hv;
#pragma unroll
      for (int j = 0; j < 4; ++j) hv[j] = xv[i][j] * rstd * g[j] * (1.f + sc[j]) + sh[j];
#pragma unroll
      for (int e = 0; e < 8; ++e) { const f32x4 w = *(const LAS f32x4*)(wb + e * 1024 + k); acc[e] += hv[0] * w[0] + hv[1] * w[1] + hv[2] * w[2] + hv[3] * w[3]; }
      u32x2 pk; pk.x = pk2(hv[0], hv[1]); pk.y = pk2(hv[2], hv[3]);
      *(u32x2*)(p.hbf + (size_t)t * DM + k) = pk;
    }
#pragma unroll
    for (int e = 0; e < 8; ++e) acc[e] = wave_sum(acc[e]);
    if (lane == 0) { *(f32x4*)(p.ba + (size_t)t * 8) = (f32x4){acc[0], acc[1], acc[2], acc[3]}; *(f32x4*)(p.ba + (size_t)t * 8 + 4) = (f32x4){acc[4], acc[5], acc[6], acc[7]}; }
  }
}

#define PM_WT 0
#define PM_H2 66048
#define PM_CNT 132096
#define PM_ENT 132352
__device__ void ph_post_mix(const Params& p, LAS unsigned char* lds, int nblk, int bid, int rep) {
  const int wid = p.tid >> 6, lane = p.tid & 63, r16 = lane & 15, q4 = lane >> 4;
  LAS bf16_t* wT = (LAS bf16_t*)(lds + PM_WT);
  LAS bf16_t* ht = (LAS bf16_t*)(lds + PM_H2) + wid * 4 * 1032;
  LAS int* lcnt = (LAS int*)(lds + PM_CNT);
  LAS int* lbase = lcnt + 32;
  LAS int* lent = (LAS int*)(lds + PM_ENT) + wid * 64;
  int nloc = 0;
  if (p.tid < 32) lcnt[p.tid] = 0;
  for (int i = p.tid; i < 1024 * 8; i += 512) {
    const int k = i >> 3, c = i & 7;
    const f32x4 v = *(const f32x4*)(p.w_router + (size_t)k * 32 + c * 4);
#pragma unroll
    for (int j = 0; j < 4; ++j) wT[(c * 4 + j) * 1032 + k] = f2bf_hw(v[j]);
  }
  __syncthreads();
  const float bias0 = p.b_router[r16], bias1 = p.b_router[16 + r16];
  const int tstride = nblk * 8;
  f32x4 gpv[4], gqv[4];
#pragma unroll
  for (int i4 = 0; i4 < 4; ++i4) { const int k = (i4 >> 1) * 512 + lane * 8 + (i4 & 1) * 4; gpv[i4] = *(const f32x4*)(p.g_post_mix + k); gqv[i4] = *(const f32x4*)(p.g_pre_ffn + k); }
  u32x4 mxn[2]; f32x4 xn[4];
  {
    const int t0 = bid * 8 + wid;
    if (t0 < T_TOK) {
#pragma unroll
      for (int i = 0; i < 2; ++i) mxn[i] = *(const u32x4*)(p.mixer + (size_t)t0 * DM + i * 512 + lane * 8);
#pragma unroll
      for (int i = 0; i < 4; ++i) xn[i] = *(const f32x4*)(p.x + (size_t)t0 * DM + (i >> 1) * 512 + lane * 8 + (i & 1) * 4);
    }
  }
  for (int tg = bid * 8 + wid; tg < T_TOK; tg += 4 * tstride) {
#pragma unroll 1
    for (int jj = 0; jj < 4; ++jj) {
      const int t = tg + jj * tstride;
      if (t >= T_TOK) break;
      const int b = t / SEQ;
      const float* md = p.mod + b * 6144;
      u32x4 mxc[2] = {mxn[0], mxn[1]}; f32x4 xc[4] = {xn[0], xn[1], xn[2], xn[3]};
      {
        const int tn = t + tstride;
        if (tn < T_TOK) {
#pragma unroll
          for (int i = 0; i < 2; ++i) mxn[i] = *(const u32x4*)(p.mixer + (size_t)tn * DM + i * 512 + lane * 8);
#pragma unroll
          for (int i = 0; i < 4; ++i) xn[i] = *(const f32x4*)(p.x + (size_t)tn * DM + (i >> 1) * 512 + lane * 8 + (i & 1) * 4);
        }
      }
      float mv[16];
      float ss = 0.f;
#pragma unroll
      for (int i = 0; i < 2; ++i) {
        float f[8]; unpack8(mxc[i], f);
#pragma unroll
        for (int j = 0; j < 8; ++j) { mv[i * 8 + j] = f[j]; ss += f[j] * f[j]; }
      }
      ss = wave_sum(ss);
      const float rstd = rsqrtf(ss * (1.f / DM) + 1e-6f);
      f32x4 gmv[4], scv[4], sfv[4];
#pragma unroll
      for (int i4 = 0; i4 < 4; ++i4) { const int k = (i4 >> 1) * 512 + lane * 8 + (i4 & 1) * 4; gmv[i4] = *(const f32x4*)(md + 2048 + k); scv[i4] = *(const f32x4*)(md + 4096 + k); sfv[i4] = *(const f32x4*)(md + 3072 + k); }
      float x1[16];
      float s2 = 0.f;
#pragma unroll
      for (int i = 0; i < 2; ++i)
#pragma unroll
        for (int j4 = 0; j4 < 2; ++j4) {
          const int k = i * 512 + lane * 8 + j4 * 4;
          const f32x4 xv = xc[i * 2 + j4];
          const f32x4 gm = gmv[i * 2 + j4], gp = gpv[i * 2 + j4];
          f32x4 o;
#pragma unroll
          for (int j = 0; j < 4; ++j) { o[j] = xv[j] + gm[j] * (mv[i * 8 + j4 * 4 + j] * rstd * gp[j]); x1[i * 8 + j4 * 4 + j] = o[j]; s2 += o[j] * o[j]; }
          *(f32x4*)(p.out + (size_t)t * DM + k) = o;
        }
      s2 = wave_sum(s2);
      const float rstd2 = rsqrtf(s2 * (1.f / DM) + 1e-6f);
#pragma unroll
      for (int i = 0; i < 2; ++i) {
        float hv[8];
#pragma unroll
        for (int j4 = 0; j4 < 2; ++j4) {
          const int k = i * 512 + lane * 8 + j4 * 4;
          const f32x4 gq = gqv[i * 2 + j4], sc = scv[i * 2 + j4], sf = sfv[i * 2 + j4];
#pragma unroll
          for (int j = 0; j < 4; ++j) hv[j4 * 4 + j] = x1[i * 8 + j4 * 4 + j] * rstd2 * gq[j] * (1.f + sc[j]) + sf[j];
        }
        u32x2 w; w.x = pk4_fp8(hv[0], hv[1], hv[2], hv[3]); w.y = pk4_fp8(hv[4], hv[5], hv[6], hv[7]);
        *(u32x2*)(p.h2q + (size_t)t * DM + i * 512 + lane * 8) = w;
        u32x4 hb; hb.x = pk2(hv[0], hv[1]); hb.y = pk2(hv[2], hv[3]); hb.z = pk2(hv[4], hv[5]); hb.w = pk2(hv[6], hv[7]);
        *(LAS u32x4*)(ht + jj * 1032 + i * 512 + lane * 8) = hb;
      }
    }
    f32x4 acc0 = {0.f, 0.f, 0.f, 0.f}, acc1 = {0.f, 0.f, 0.f, 0.f};
#pragma unroll 8
    for (int ks = 0; ks < 32; ++ks) {
      const bf16x8 a = *(const LAS bf16x8*)(ht + (r16 & 3) * 1032 + 32 * ks + 8 * q4);
      const bf16x8 b0 = *(const LAS bf16x8*)(wT + r16 * 1032 + 32 * ks + 8 * q4);
      const bf16x8 b1 = *(const LAS bf16x8*)(wT + (16 + r16) * 1032 + 32 * ks + 8 * q4);
      acc0 = MFMA16(a, b0, acc0); acc1 = MFMA16(a, b1, acc1);
    }
#pragma unroll
    for (int jj = 0; jj < 4; ++jj) {
      const int t = tg + jj * tstride;
      if (t < T_TOK) {
        float l0 = (lane < 16) ? acc0[jj] + bias0 : -INFINITY, l1 = (lane < 16) ? acc1[jj] + bias1 : -INFINITY;
        float tv[4]; int ti[4];
#pragma unroll
        for (int r = 0; r < 4; ++r) {
          const float m = wave_max(fmaxf(l0, l1));
          const unsigned long long b0m = __ballot(l0 == m);
          int idx;
          if (b0m) { idx = __ffsll((long long)b0m) - 1; if (lane == idx) l0 = -INFINITY; }
          else { const unsigned long long b1m = __ballot(l1 == m); idx = __ffsll((long long)b1m) - 1; if (lane == idx) l1 = -INFINITY; idx += 16; }
          tv[r] = m; ti[r] = idx;
        }
        const float e1 = __expf(tv[1] - tv[0]), e2 = __expf(tv[2] - tv[0]), e3 = __expf(tv[3] - tv[0]);
        const float inv = 1.f / (1.f + e1 + e2 + e3);
        if (lane < 4) {
          const int ee = lane == 0 ? ti[0] : lane == 1 ? ti[1] : lane == 2 ? ti[2] : ti[3];
          const float ww = (lane == 0 ? 1.f : lane == 1 ? e1 : lane == 2 ? e2 : e3) * inv;
          p.aw[t * 4 + lane] = ww;
          const int rank = __hip_atomic_fetch_add(&lcnt[ee], 1, __ATOMIC_RELAXED, __HIP_MEMORY_SCOPE_WORKGROUP);
          lent[nloc * 4 + lane] = (ee << 16) | rank;
          lent[nloc * 4 + lane + 2048] = t * 4 + lane;
        }
        ++nloc;
      }
    }
  }
  __syncthreads();
  if (p.tid < 32) lbase[p.tid] = atomicAdd(&p.cnt[p.tid * 64 + 32 * rep], lcnt[p.tid]);
  __syncthreads();
  for (int i = lane; i < nloc * 4; i += 64) {
    const int er = lent[i], a = lent[i + 2048];
    p.elist[(er >> 16) * T_TOK + lbase[er >> 16] + (er & 0xffff)] = a;
  }
}

__device__ void ph_final(const Params& p, int nblk, int bid, int rep) {
  const int wid = p.tid >> 6, lane = p.tid & 63;
  f32x4 gpf[4];
#pragma unroll
  for (int i4 = 0; i4 < 4; ++i4) gpf[i4] = *(const f32x4*)(p.g_post_ffn + (i4 >> 1) * 512 + lane * 8 + (i4 & 1) * 4);
  for (int t0 = bid * 8 + wid; t0 < T_TOK; t0 += nblk * 16) {
    int tt[2] = {t0, t0 + nblk * 8};
    if (tt[1] >= T_TOK) tt[1] = t0;
    float mv[2][16]; float ss[2];
#pragma unroll
    for (int u = 0; u < 2; ++u) {
      const int t = tt[u];
      const f32x4 wv = *(const f32x4*)(p.aw + t * 4);
      ss[u] = 0.f;
#pragma unroll
      for (int i = 0; i < 2; ++i) {
        const bf16_t* y = p.yslot + (size_t)t * 4 * DM + i * 512 + lane * 8;
        float f0[8], f1[8], f2[8], f3[8];
        unpack8(*(const u32x4*)y, f0); unpack8(*(const u32x4*)(y + DM), f1); unpack8(*(const u32x4*)(y + 2 * DM), f2); unpack8(*(const u32x4*)(y + 3 * DM), f3);
#pragma unroll
        for (int j = 0; j < 8; ++j) { const float m = wv[0] * f0[j] + wv[1] * f1[j] + wv[2] * f2[j] + wv[3] * f3[j]; mv[u][i * 8 + j] = m; ss[u] += m * m; }
      }
    }
    f32x4 x1[2][4];
#pragma unroll
    for (int u = 0; u < 2; ++u)
#pragma unroll
      for (int i = 0; i < 2; ++i)
#pragma unroll
        for (int j4 = 0; j4 < 2; ++j4) x1[u][i * 2 + j4] = *(const f32x4*)(p.out + (size_t)tt[u] * DM + i * 512 + lane * 8 + j4 * 4);
    f32x4 gfv[2][4];
#pragma unroll
    for (int u = 0; u < 2; ++u)
#pragma unroll
      for (int i4 = 0; i4 < 4; ++i4) gfv[u][i4] = *(const f32x4*)(p.mod + (tt[u] / SEQ) * 6144 + 5120 + (i4 >> 1) * 512 + lane * 8 + (i4 & 1) * 4);
    ss[0] = wave_sum(ss[0]); ss[1] = wave_sum(ss[1]);
#pragma unroll
    for (int u = 0; u < 2; ++u) {
      const int t = tt[u];
      if (u == 1 && t == t0) break;
      const float rstd = rsqrtf(ss[u] * (1.f / DM) + 1e-6f);
#pragma unroll
      for (int i = 0; i < 2; ++i)
#pragma unroll
        for (int j4 = 0; j4 < 2; ++j4) {
          const int k = i * 512 + lane * 8 + j4 * 4;
          float* op = p.out + (size_t)t * DM + k;
          const f32x4 gf = gfv[u][i * 2 + j4], gp = gpf[i * 2 + j4];
          f32x4 o;
#pragma unroll
          for (int j = 0; j < 4; ++j) o[j] = x1[u][i * 2 + j4][j] + gf[j] * (mv[u][i * 8 + j4 * 4 + j] * rstd * gp[j]);
          *(f32x4*)(rep ? (float*)p.hbf + (size_t)(t & 8191) * DM + k : op) = o;
        }
    }
  }
}

#define XCD_BAR_WORDS 3456
struct KArgs { const void* in[22]; float* out; char* ws; long long never; };
__host__ __device__ inline size_t al(size_t x) { return (x + 255) & ~(size_t)255; }
__host__ __device__ inline void fill_params(Params& p, const KArgs& k) {
  p.x = (const float*)k.in[0]; p.c = (const float*)k.in[1]; p.w_ada = (const float*)k.in[2]; p.b_ada = (const float*)k.in[3];
  p.g_pre_mix = (const float*)k.in[4]; p.g_post_mix = (const float*)k.in[5]; p.g_pre_ffn = (const float*)k.in[6];
  p.g_post_ffn = (const float*)k.in[7]; p.w_in = (const float*)k.in[8]; p.conv_w = (const float*)k.in[9];
  p.a_log = (const float*)k.in[10]; p.dt_bias = (const float*)k.in[11]; p.g_dn_out = (const float*)k.in[12];
  p.w_br_a = (const float*)k.in[13]; p.w_br_b = (const float*)k.in[14]; p.w_o = (const float*)k.in[15];
  p.w_router = (const float*)k.in[16]; p.b_router = (const float*)k.in[17]; p.w_gu = (const float*)k.in[18];
  p.b_gu = (const float*)k.in[19]; p.w_down = (const float*)k.in[20]; p.b_down = (const float*)k.in[21];
  p.out = k.out;
  char* w = k.ws;
  size_t o = 0;
#define take(bytes) (w + (o += al(bytes)) - al(bytes))
  p.mod = (float*)take(4 * 6144 * 4);
  p.cnt = (int*)take(16384);
  p.ba = (float*)take((size_t)T_TOK * 8 * 4);
  p.hbf = (bf16_t*)take((size_t)T_TOK * DM * 2);
  p.proj = (bf16_t*)take((size_t)T_TOK * PW * 2);
  p.w_in_t = (bf16_t*)take((size_t)PW * DM * 2);
  p.wgu8 = (unsigned char*)take((size_t)NE * 2048 * DM);
  p.wd8 = (unsigned char*)take((size_t)NE * 1024 * DM);
  p.h2q = (unsigned char*)take((size_t)T_TOK * DM);
  p.act8 = (unsigned char*)take((size_t)73728 * DM);
  p.wbra_t = (bf16_t*)take((size_t)1024 * 512 * 2);
  p.wbrb_t = (bf16_t*)take((size_t)1024 * 512 * 2);
  p.wo_t = (bf16_t*)take((size_t)1024 * 1024 * 2);
  p.qb = (bf16_t*)take((size_t)T_TOK * 512 * 2);
  p.kb = nullptr;
  p.kmean = (float*)take((size_t)16 * 16 * 128 * 4);
  p.oab = (bf16_t*)take((size_t)T_TOK * DM * 2);
  p.merged = (bf16_t*)take((size_t)T_TOK * DM * 2);
  p.mixer = (bf16_t*)take((size_t)T_TOK * DM * 2);
  p.h2 = nullptr;
  p.elist = (int*)take((size_t)NE * T_TOK * 4);
  p.aw = (float*)take((size_t)T_TOK * 4 * 4);
  p.rowmap = nullptr;
  p.dnA = (unsigned char*)take((size_t)1024 * DN_ABYTES);
  p.dnU = (float*)take((size_t)1024 * DN_UFLOATS * 4);
  p.dnG = (float*)take(4096);
  p.dnS = (unsigned char*)take((size_t)1024 * 8 * 4096);
  p.dnV = (unsigned char*)take((size_t)1024 * 8 * 2048);
  p.oab2 = (bf16_t*)take((size_t)T_TOK * 512 * 2);
  p.dbg = (float*)take(256);
  p.bar = (unsigned*)take(XCD_BAR_WORDS * 4);
  p.dn_out = p.oab; p.dn_out_ld = DM;
  p.Kp = (bf16_t*)take((size_t)16 * 128 * 8192);
  p.Vp = (bf16_t*)take((size_t)16 * 128 * 8192);
  p.wq = p.cnt + 32 * 64;
  p.dep = p.cnt + 2304;
  p.mb_out = p.oab; p.mb_out_ld = DM; p.mb_out_off = 512;
  p.xs = nullptr; p.act = nullptr;
  p.yslot = (bf16_t*)take((size_t)65536 * DM * 2);
  p.nq = p.nk = p.nv = p.no = p.ntmp = p.nbeta = p.ng = nullptr;
#undef take
#undef t2
  p.never = (int)k.never;
}

#define XB_TMO      128
#define XB_XCNT(j)  (256  + 64 * (j))
#define XB_XSUB(j)  (1280 + 64 * (j))
#define XB_XGEN(j)  (2304 + 64 * (j))
#define XB_TOP      3328
#define XB_TOPGEN   3392
#define XB_SPIN_CAP (1u << 18)

__device__ __forceinline__ unsigned xb_ld(unsigned* p)              { return __hip_atomic_load(p, __ATOMIC_RELAXED, __HIP_MEMORY_SCOPE_AGENT); }
__device__ __forceinline__ unsigned xb_add(unsigned* p, unsigned v) { return __hip_atomic_fetch_add(p, v, __ATOMIC_RELAXED, __HIP_MEMORY_SCOPE_AGENT); }
__device__ __forceinline__ unsigned xb_xcc_id() { return (unsigned)__builtin_amdgcn_s_getreg((3 << 11) | 20) & 0xFu; }
#define XB_SPIN(cond, bar) do { unsigned _sp = 0; while (cond) { __builtin_amdgcn_s_sleep(1); \
    if ((++_sp & 255u) == 0u) { if (xb_ld(&(bar)[XB_TMO])) break; if (_sp > XB_SPIN_CAP) { atomicAdd(&(bar)[XB_TMO], 1u); break; } } } } while (0)

struct XcdBarrier {
    unsigned* bar; unsigned x;
    volatile LAS unsigned* st;
};

__device__ __forceinline__ XcdBarrier xcd_barrier_post(unsigned* bar, volatile LAS unsigned* st) {
    XcdBarrier b; b.bar = bar; b.x = xb_xcc_id(); b.st = st;
    if (threadIdx.x == 0) (void)xb_add(&bar[XB_XCNT(b.x)], 1u);
    return b;
}
__device__ __forceinline__ void xcd_barrier_complete(unsigned* bar, unsigned x, unsigned& nloc, unsigned& nx) {
    const unsigned G = gridDim.x * gridDim.y * gridDim.z;
    unsigned sum, cnt, mine, sp = 0u;
    for (;;) {
        sum = 0u; cnt = 0u; mine = 0u;
#pragma unroll
        for (unsigned j = 0; j < 16; ++j) { const unsigned c = xb_ld(&bar[XB_XCNT(j)]); sum += c; cnt += (c > 0u) ? 1u : 0u; mine = (j == x) ? c : mine; }
        if (sum == G) break;
        __builtin_amdgcn_s_sleep(1);
        if ((++sp & 255u) == 0u) { if (xb_ld(&bar[XB_TMO])) break; if (sp > XB_SPIN_CAP) { atomicAdd(&bar[XB_TMO], 1u); break; } }
    }
    nloc = mine > 0u ? mine : 1u; nx = cnt > 0u ? cnt : 1u;
}

__device__ __forceinline__ void xcd_barrier(const XcdBarrier& b, const int tid) {
    asm volatile("s_waitcnt vmcnt(0)" ::: "memory");
    __syncthreads();
    if (tid == 0) {
        unsigned* bar = b.bar;
        __builtin_amdgcn_s_waitcnt(0);
        unsigned nloc = b.st[0], nx = b.st[1];
        if (nloc == 0u) { xcd_barrier_complete(bar, b.x, nloc, nx); b.st[0] = nloc; b.st[1] = nx; }
        const unsigned old = xb_add(&bar[XB_XSUB(b.x)], 1u);
        const unsigned gen = old / nloc;
        if (old + 1u == (gen + 1u) * nloc) {
            __builtin_amdgcn_fence(__ATOMIC_RELEASE, "agent");
            asm volatile("s_waitcnt vmcnt(0)" ::: "memory");
            const unsigned og = xb_add(&bar[XB_TOP], 1u);
            const unsigned tg = og / nx;
            if (og + 1u == (tg + 1u) * nx) xb_add(&bar[XB_TOPGEN], 1u);
            else XB_SPIN(xb_ld(&bar[XB_TOPGEN]) == tg, bar);
            __builtin_amdgcn_fence(__ATOMIC_ACQUIRE, "agent");
            xb_add(&bar[XB_XGEN(b.x)], 1u);
            asm volatile("s_waitcnt vmcnt(0)" ::: "memory");
        } else {
            XB_SPIN(xb_ld(&bar[XB_XGEN(b.x)]) == gen, bar);
            __builtin_amdgcn_fence(__ATOMIC_ACQUIRE, "agent");
            asm volatile("s_waitcnt vmcnt(0)" ::: "memory");
        }
    }
    __syncthreads();
}


__device__ __forceinline__ void load_ka(KArgs& kk) {
#if defined(__HIP_DEVICE_COMPILE__)
  typedef __attribute__((address_space(1))) char* gptr_t;
  typedef const __attribute__((address_space(4))) gptr_t* kptr_t;
  kptr_t kp = (kptr_t)__builtin_amdgcn_kernarg_segment_ptr();
  asm volatile("" : "+s"(kp));
#pragma unroll
  for (int i = 0; i < 22; ++i) kk.in[i] = (const void*)kp[i];
  kk.out = (float*)kp[22];
  kk.ws = (char*)kp[23];
  kk.never = ((const __attribute__((address_space(4))) long long*)kp)[24];
#endif
}
__device__ __forceinline__ void grid_bar(const Params& p, LAS unsigned char* lds);
#define MEGA_LDS 148480
#define MEGA_LDS_ALLOC (MEGA_LDS + 16)
__device__ __forceinline__ void grid_bar(const Params& p, LAS unsigned char* lds) {
  XcdBarrier b; b.bar = p.bar; b.x = xb_xcc_id(); b.st = (volatile LAS unsigned*)(lds + MEGA_LDS);
  xcd_barrier(b, p.tid);
}
__global__ __launch_bounds__(512) void mega(KArgs ka) {
  extern __shared__ __attribute__((aligned(16))) unsigned char shm[];
  LAS unsigned char* lds = (LAS unsigned char*)shm;
  cg::grid_group grid = cg::this_grid();
  const int nblk = gridDim.x, bid = blockIdx.x;
  const int wv_ = __builtin_amdgcn_readfirstlane(threadIdx.x >> 6);
  volatile LAS unsigned* xst = (volatile LAS unsigned*)(lds + MEGA_LDS);
  if (threadIdx.x == 0) { xst[0] = 0u; xst[1] = 0u; xst[2] = 0u; xst[3] = 0u; }
  __syncthreads();
  { Params p0; fill_params(p0, ka); (void)xcd_barrier_post(p0.bar, xst); }
  if (ka.never) grid.sync();
#ifndef REPMASK
#define REPMASK 0
#endif
#define LOADKA KArgs kk; load_ka(kk)
#ifndef PHMASK
#define PHMASK 0xffff
#endif
#define PHASE(k, body) if (((PHMASK) >> (k)) & 1) for (int rep_ = 0; rep_ < (((REPMASK) >> (k)) & 1) + 1; ++rep_) { \
    LOADKA; Params p; fill_params(p, kk); { int t_; asm volatile("v_mbcnt_lo_u32_b32 %0, -1, 0\n\tv_mbcnt_hi_u32_b32 %0, -1, %0" : "=v"(t_)); p.tid = (wv_ << 6) | t_; } body; grid_bar(p, lds); }
#ifdef XBAR
  for (int xb_ = 0; xb_ < XBAR; ++xb_) { PHASE(15, {}) }
#endif
  PHASE(0, { ph_mod(p, lds, nblk, bid); ph_wt(p, lds, nblk, bid); })
  PHASE(1, { ph_h(p, lds, nblk, bid); })
  PHASE(2, { ph_proj(p, lds, nblk, bid); })
  PHASE(3, { bool first = true; for (int ci = bid; ci < 1024; ci += nblk) { dn_prep_chunk(p, lds, ci, first); first = false; }
             for (int item = bid; item < 256; item += nblk) moba_prep_block(p, lds, item); })
  PHASE(4, { if (bid < 32) dn_scan_blk(p, lds, bid); moba_worker(p, lds, rep_); })
  PHASE(5, { ph_dn_out(p, lds, nblk, bid); })
  PHASE(6, { ph_br(p, lds, nblk, bid); })
  PHASE(7, { ph_mix(p, lds, nblk, bid); })
  PHASE(8, { ph_post_mix(p, lds, nblk, bid, rep_); })
  PHASE(10, { ph_moe1(p, lds, nblk, bid); ph_moe2(p, lds, nblk, bid); })
  PHASE(12, { ph_final(p, nblk, bid, rep_); })
}


extern "C" void kernel_launch(void* const* d_in, const int* in_sizes, int n_in, void* d_out, int out_size, void* d_ws,
                              size_t ws_size, hipStream_t stream) {
  KArgs ka{};
  for (int i = 0; i < 22; ++i) ka.in[i] = d_in[i];
  ka.out = (float*)d_out; ka.ws = (char*)d_ws; ka.never = 0;
  Params p{};
  fill_params(p, ka);
  static int grid_blocks = 0;
  if (!grid_blocks) {
    (void)hipFuncSetAttribute((const void*)mega, hipFuncAttributeMaxDynamicSharedMemorySize, MEGA_LDS_ALLOC);
    int dev = 0, cus = 0, per_cu = 0;
    (void)hipGetDevice(&dev);
    (void)hipDeviceGetAttribute(&cus, hipDeviceAttributeMultiprocessorCount, dev);
    (void)hipOccupancyMaxActiveBlocksPerMultiprocessor(&per_cu, mega, 512, MEGA_LDS_ALLOC);
    if (per_cu != 1) per_cu = 1;
    grid_blocks = cus * per_cu;
  }
  (void)hipMemsetAsync(p.cnt, 0, 16384, stream);
  (void)hipMemsetAsync(p.bar, 0, XCD_BAR_WORDS * 4, stream);
  void* args[] = {&ka};
  hipError_t e = hipLaunchCooperativeKernel((void*)mega, dim3(grid_blocks), dim3(512), args, MEGA_LDS_ALLOC, stream);
  if (e != hipSuccess) fprintf(stderr, "cooperative launch failed: %s (grid %d)\n", hipGetErrorString(e), grid_blocks);
}
```

```cpp
#include <hip/hip_runtime.h>
#include <hip/hip_cooperative_groups.h>
#include <cstdio>
namespace cg = cooperative_groups;
#include <stdint.h>

typedef unsigned short bf16_t;
#ifndef MB_ABL
#define MB_ABL 0
#endif

#define T_TOK 16384
#define SEQ 4096
#define NB 4
#define DM 1024
#define INW 5640
#define PW 5632
#define C_QA 0
#define C_KA 512
#define C_VA 1024
#define C_Z 1536
#define C_MQ 2048
#define C_MK 2560
#define C_MV 3072
#define C_GA 3584
#define C_GB 4608
#define NE 32

__device__ __forceinline__ bf16_t f2bf(float f) {
  unsigned u = __float_as_uint(f);
  u += 0x7fffu + ((u >> 16) & 1u);
  return (bf16_t)(u >> 16);
}
__device__ __forceinline__ float bf2f(bf16_t h) { return __uint_as_float(((unsigned)h) << 16); }
__device__ __forceinline__ float sigmoidf_(float x) { return __builtin_amdgcn_rcpf(1.f + __builtin_amdgcn_exp2f(-1.4426950408889634f * x)); }
__device__ __forceinline__ float siluf_(float x) { return x * sigmoidf_(x); }
__device__ __forceinline__ float wave_sum(float v) {
#pragma unroll
  for (int o = 32; o > 0; o >>= 1) v += __shfl_xor(v, o, 64);
  return v;
}
__device__ __forceinline__ float wave_max(float v) {
#pragma unroll
  for (int o = 32; o > 0; o >>= 1) v = fmaxf(v, __shfl_xor(v, o, 64));
  return v;
}

typedef unsigned u32x2 __attribute__((ext_vector_type(2)));
typedef __bf16 bf16x2_t __attribute__((ext_vector_type(2)));
typedef float f32x2_t __attribute__((ext_vector_type(2)));
__device__ __forceinline__ unsigned pk2(float a, float b) { f32x2_t v = {a, b}; bf16x2_t r = __builtin_convertvector(v, bf16x2_t); return __builtin_bit_cast(unsigned, r); }

__device__ __forceinline__ unsigned pk4_fp8(float a, float b, float c, float d) {
  int w = 0;
  w = __builtin_amdgcn_cvt_pk_fp8_f32(a, b, w, false);
  w = __builtin_amdgcn_cvt_pk_fp8_f32(c, d, w, true);
  return (unsigned)w;
}

struct Params {
  const float *x, *c, *w_ada, *b_ada, *g_pre_mix, *g_post_mix, *g_pre_ffn, *g_post_ffn, *w_in, *conv_w,
      *a_log, *dt_bias, *g_dn_out, *w_br_a, *w_br_b, *w_o, *w_router, *b_router, *w_gu, *b_gu, *w_down, *b_down;
  float* out;
  float* mod;
  int* cnt;
  int* dep;
  float* ba;
  bf16_t* hbf;
  bf16_t* proj;
  bf16_t* w_in_t;
  unsigned char* wgu8;
  unsigned char* wd8;
  unsigned char* h2q;
  unsigned char* act8;
  bf16_t* wbra_t;
  bf16_t* wbrb_t;
  bf16_t* wo_t;
  bf16_t* qb;
  bf16_t* kb;
  float* kmean;
  bf16_t* oab;
  bf16_t* merged;
  bf16_t* mixer;
  bf16_t* h2;
  int* elist;
  float* aw;
  bf16_t* act;
  bf16_t* xs;
  int* rowmap;
  bf16_t* yslot;
  unsigned char* dnA; float* dnU; float* dnG;
  unsigned char* dnS; unsigned char* dnV;
  bf16_t* dn_out; int dn_out_ld;
  bf16_t* oab2; float* dbg;
  unsigned* bar; int never; int tid;
  bf16_t* Kp; bf16_t* Vp; int* wq;
  bf16_t* mb_out; int mb_out_ld; int mb_out_off;
  float* nq; float* nk; float* nv;
  float* nbeta; float* ng;
  float* no;
  float* ntmp;
};

__device__ __forceinline__ int map_col(int n, int mode) {
  if (mode == 0) return n;
  if (mode == 1) return n < 2048 ? n : (n < 2056 ? -1 : n - 8);
  if (n < 1024) return (n >> 7) * 256 + (n & 127);
  int j = n - 1024;
  return (j >> 7) * 256 + 128 + (j & 127);
}
namespace pg8 {
#define PG8_LAS __attribute__((address_space(3)))
typedef short bf16x8 __attribute__((ext_vector_type(8)));
typedef float f32x4 __attribute__((ext_vector_type(4)));
typedef unsigned u32x4 __attribute__((ext_vector_type(4)));
constexpr int BM = 256, BK = 64, HALF = 128, HTB = HALF * BK * 2, STAGE_BYTES = 8 * HTB, NXCD = 8, WGM = 8;

__host__ __device__ __forceinline__ int lds_byte(int r, int c) { const int st = (r >> 4) * 2 + (c >> 5), rr = r & 15, cc = c & 31, ob = rr * 64 + cc * 2; return st * 1024 + (ob ^ (((ob >> 9) & 1) << 5)); }
__host__ __device__ __forceinline__ void stage_rc(int b, int& R, int& C) { const int st = b / 1024, sb = b % 1024, swz = sb ^ (((sb >> 9) & 1) << 5); R = (st >> 1) * 16 + swz / 64; C = (st & 1) * 32 + (swz % 64) / 2; }
__host__ __device__ __forceinline__ int perm32(int rho) { const int n = rho >> 4, i = rho & 15; return 8 * (i >> 2) + 4 * n + (i & 3); }

struct Unit { int pm, pn, z; };
__device__ __forceinline__ unsigned cvt_pk_bf16(float lo, float hi) { unsigned r; asm volatile("v_cvt_pk_bf16_f32 %0, %1, %2" : "=v"(r) : "v"(lo), "v"(hi)); return r; }

typedef int i32x8 __attribute__((ext_vector_type(8)));
typedef int i32x4 __attribute__((ext_vector_type(4)));
__device__ __forceinline__ i32x8 cat8(const bf16x8 lo, const bf16x8 hi) { const i32x4 a = __builtin_bit_cast(i32x4, lo), b = __builtin_bit_cast(i32x4, hi); return __builtin_shufflevector(a, b, 0, 1, 2, 3, 4, 5, 6, 7); }
struct TileOrder {
    int nM, nN, nwg, G, c;
    __device__ void init(int nM_, int nN_, int G_, int c_) { nM = nM_; nN = nN_; nwg = nM * nN; G = G_; c = c_; }
    __device__ bool tile(int i, int& pm, int& pn) const {
        const long L = (long)i * G + c; if (L >= nwg) return false;
        int wgid = (int)L; { const int q = nwg / NXCD, r = nwg % NXCD, xcd = wgid % NXCD, off = wgid / NXCD; wgid = (xcd < r ? xcd * (q + 1) : r * (q + 1) + (xcd - r) * q) + off; }
        const int nig = WGM * nN, gid = wgid / nig, fm = gid * WGM, gsz = (nM - fm) < WGM ? (nM - fm) : WGM;
        pm = fm + ((wgid % nig) % gsz); pn = (wgid % nig) / gsz; return true;
    }
};

template <class Epi, class Sched, bool FP8 = false>
__device__ __forceinline__ void gemm_phase(PG8_LAS unsigned char* lds, const int tid, const int lda, const int ldb, const int K, const Sched& S, const Epi& E) {
    const int wid = __builtin_amdgcn_readfirstlane(tid >> 6), lane = tid & 63, wr = wid >> 2, wc = wid & 3, fr = lane & 15, fq = lane >> 4;
    const int nt = K / BK;
    unsigned voffA[2], voffB[2];
#pragma unroll
    for (int i = 0; i < 2; ++i) { int R, C; stage_rc(tid * 16 + i * 8192, R, C); const int Rb = Epi::PERM ? ((R & ~31) + perm32(R & 31)) : R;
        voffA[i] = (unsigned)(R * lda + C) * 2u; voffB[i] = (unsigned)(Rb * ldb + C) * 2u; }
    const size_t kstep = (size_t)(BK * 2);
    const size_t hstepA = (size_t)HALF * lda * 2, hstepB = (size_t)HALF * ldb * 2;
    const unsigned ldsw = (unsigned)wid * 1024u;
    const int aoff = lds_byte(wr * 64 + fr, fq * 8), boff = lds_byte(wc * 32 + fr, fq * 8);
    constexpr int KOFF1 = 1024;
    unsigned gA[2][2] = {{0u, 0u}, {0u, 0u}}, gAn[2][2] = {{0u, 0u}, {0u, 0u}};
#define PG8_GOFFS(dst, unit) do { int t_ = tid; asm volatile("" : "+v"(t_)); _Pragma("unroll") for (int i_ = 0; i_ < 2; ++i_) { int gR_, gC_; stage_rc(t_ * 16 + i_ * 8192, gR_, gC_); \
        _Pragma("unroll") for (int h_ = 0; h_ < 2; ++h_) dst[h_][i_] = S.a_goff(unit, gR_ + 128 * h_, gC_); } } while (0)
#define PG8_SA(b, h) (((b) * 2 + (h)) * HTB)
#define PG8_SB(b, h) ((4 + (b) * 2 + (h)) * HTB)
#define PG8_STAGE(bufoff, gbase, voff) do { _Pragma("unroll") for (int _i = 0; _i < 2; ++_i) \
        __builtin_amdgcn_global_load_lds((const unsigned*)((const char*)(gbase) + (voff)[_i]), (PG8_LAS unsigned*)(lds + (bufoff) + ldsw + _i * 8192), 16, 0, 0); } while (0)
#define PG8_STAGEA(bufoff, ptr, h, nx) do { if constexpr (Sched::GATHER) { const unsigned gs_[2] = {(nx) ? gAn[h][0] : gA[h][0], (nx) ? gAn[h][1] : gA[h][1]}; PG8_STAGE(bufoff, ptr, gs_); } \
        else { PG8_STAGE(bufoff, (ptr) + (h) * hstepA, voffA); } } while (0)
#define PG8_LDA(dst, b, h) do { if constexpr (FP8) { _Pragma("unroll") for (int m = 0; m < 4; ++m) dst##8[m] = cat8(*(const PG8_LAS bf16x8*)(lds + PG8_SA(b, h) + aoff + m * 2048), *(const PG8_LAS bf16x8*)(lds + PG8_SA(b, h) + aoff + KOFF1 + m * 2048)); } \
        else { _Pragma("unroll") for (int m = 0; m < 4; ++m) _Pragma("unroll") for (int k = 0; k < 2; ++k) dst[m][k] = *(const PG8_LAS bf16x8*)(lds + PG8_SA(b, h) + aoff + k * KOFF1 + m * 2048); } } while (0)
#define PG8_LDB(dst, b, h) do { if constexpr (FP8) { _Pragma("unroll") for (int n = 0; n < 2; ++n) dst##8[n] = cat8(*(const PG8_LAS bf16x8*)(lds + PG8_SB(b, h) + boff + n * 2048), *(const PG8_LAS bf16x8*)(lds + PG8_SB(b, h) + boff + KOFF1 + n * 2048)); } \
        else { _Pragma("unroll") for (int n = 0; n < 2; ++n) _Pragma("unroll") for (int k = 0; k < 2; ++k) dst[n][k] = *(const PG8_LAS bf16x8*)(lds + PG8_SB(b, h) + boff + k * KOFF1 + n * 2048); } } while (0)
#define PG8_MMA(ai, bj, At, Bt) do { __builtin_amdgcn_s_setprio(1); if constexpr (FP8) { _Pragma("unroll") for (int m = 0; m < 4; ++m) _Pragma("unroll") for (int n = 0; n < 2; ++n) \
        asm volatile("v_mfma_f32_16x16x128_f8f6f4 %0, %1, %2, %0" : "+v"(acc[ai][bj][m][n]) : "v"(Bt##8[n]), "v"(At##8[m])); } \
        else { _Pragma("unroll") for (int m = 0; m < 4; ++m) _Pragma("unroll") for (int n = 0; n < 2; ++n) _Pragma("unroll") for (int k = 0; k < 2; ++k) \
        acc[ai][bj][m][n] = __builtin_amdgcn_mfma_f32_16x16x32_bf16(Bt[n][k], At[m][k], acc[ai][bj][m][n], 0, 0, 0); } __builtin_amdgcn_s_setprio(0); } while (0)
#define PG8_WAIT_V(n) asm volatile("s_waitcnt vmcnt(" #n ")" ::: "memory")
#define PG8_WAIT_L(n) asm volatile("s_waitcnt lgkmcnt(" #n ")" ::: "memory")
#define PG8_BAR __builtin_amdgcn_s_barrier()
#define PG8_SCHED __builtin_amdgcn_sched_barrier(0)
    Unit cur, nxt; int ui = 0;
    if (!S.next(0, cur)) return;
    f32x4 acc[2][2][4][2];
#pragma unroll
    for (int a = 0; a < 2; ++a)
#pragma unroll
        for (int b = 0; b < 2; ++b)
#pragma unroll
            for (int m = 0; m < 4; ++m)
#pragma unroll
                for (int n = 0; n < 2; ++n) acc[a][b][m][n] = (f32x4){0.f, 0.f, 0.f, 0.f};
    bf16x8 At[4][2], B0[2][2], B1[2][2];
    i32x8 At8[4], B08[2], B18[2];
    const char* cA = S.a_ptr(cur); const char* cB = S.b_ptr(cur);
    if constexpr (Sched::GATHER) { PG8_GOFFS(gA, cur); }
    PG8_STAGE(PG8_SB(0, 0), cB, voffB); PG8_STAGEA(PG8_SA(0, 0), cA, 0, false); PG8_STAGE(PG8_SB(0, 1), cB + hstepB, voffB); PG8_STAGEA(PG8_SA(0, 1), cA, 1, false);
    if (wr == 1) PG8_BAR;
    PG8_WAIT_V(4); PG8_BAR;
    PG8_STAGE(PG8_SB(1, 0), cB + kstep, voffB); PG8_STAGEA(PG8_SA(1, 0), cA + kstep, 0, false); PG8_STAGE(PG8_SB(1, 1), cB + hstepB + kstep, voffB);
    PG8_WAIT_V(6); PG8_BAR;
    for (;;) {
        const bool has_next = S.next(ui + 1, nxt);
        const char* nA = has_next ? S.a_ptr(nxt) : cA; const char* nB = has_next ? S.b_ptr(nxt) : cB;
        if constexpr (Sched::GATHER) { if (has_next) { PG8_GOFFS(gAn, nxt); } else {
_Pragma("unroll") for (int h = 0; h < 2; ++h) _Pragma("unroll") for (int i = 0; i < 2; ++i) gAn[h][i] = gA[h][i]; } }
_Pragma("unroll 1")
        for (int t = 0; t < nt; t += 2) {
            const bool last = (t == nt - 2);
            const char* a1 = cA + (size_t)(t + 1) * kstep;
            const char* a2 = last ? nA : cA + (size_t)(t + 2) * kstep; const char* b2 = last ? nB : cB + (size_t)(t + 2) * kstep;
            const char* a3 = a2 + kstep; const char* b3 = b2 + kstep;
            PG8_LDB(B0, 0, 0); PG8_SCHED; PG8_LDA(At, 0, 0); PG8_STAGEA(PG8_SA(1, 1), a1, 1, false);
            PG8_WAIT_L(8); PG8_BAR; PG8_WAIT_L(0); PG8_MMA(0, 0, At, B0); PG8_BAR; PG8_SCHED;
            PG8_LDB(B1, 0, 1); PG8_STAGE(PG8_SB(0, 0), b2, voffB);
            PG8_BAR; PG8_WAIT_L(0); PG8_MMA(0, 1, At, B1); PG8_BAR;
            PG8_LDA(At, 0, 1); PG8_STAGEA(PG8_SA(0, 0), a2, 0, last);
            PG8_BAR; PG8_WAIT_L(0); PG8_MMA(1, 0, At, B0); PG8_BAR; PG8_SCHED;
            PG8_STAGE(PG8_SB(0, 1), b2 + hstepB, voffB);
            PG8_WAIT_V(6); PG8_BAR; PG8_MMA(1, 1, At, B1); PG8_BAR;
            PG8_LDB(B0, 1, 0); PG8_SCHED; PG8_LDA(At, 1, 0); PG8_STAGEA(PG8_SA(0, 1), a2, 1, last);
            PG8_WAIT_L(8); PG8_BAR; PG8_WAIT_L(0); PG8_MMA(0, 0, At, B0); PG8_BAR; PG8_SCHED;
            PG8_LDB(B1, 1, 1); PG8_STAGE(PG8_SB(1, 0), b3, voffB);
            PG8_BAR; PG8_WAIT_L(0); PG8_MMA(0, 1, At, B1); PG8_BAR;
            PG8_LDA(At, 1, 1); PG8_STAGEA(PG8_SA(1, 0), a3, 0, last);
            PG8_BAR; PG8_WAIT_L(0); PG8_MMA(1, 0, At, B0); PG8_BAR; PG8_SCHED;
            PG8_STAGE(PG8_SB(1, 1), b3 + hstepB, voffB);
            PG8_WAIT_V(6); PG8_BAR; PG8_MMA(1, 1, At, B1); PG8_BAR;
        }
        { if constexpr (FP8) asm volatile("s_nop 15\n\ts_nop 3" ::: "memory");
          int t_ = tid; asm volatile("" : "+v"(t_));
          E(acc, cur, wr, wc, t_ & 15, (t_ & 63) >> 4);
          if constexpr (Sched::PUBLISH) { asm volatile("s_waitcnt vmcnt(0)" ::: "memory"); PG8_BAR; if (t_ == 256) S.publish(cur); } }
        if (!has_next) break;
#pragma unroll
        for (int a = 0; a < 2; ++a)
#pragma unroll
            for (int b = 0; b < 2; ++b)
#pragma unroll
                for (int m = 0; m < 4; ++m)
#pragma unroll
                    for (int n = 0; n < 2; ++n) acc[a][b][m][n] = (f32x4){0.f, 0.f, 0.f, 0.f};
        cur = nxt; cA = nA; cB = nB; ++ui;
        if constexpr (Sched::GATHER) {
_Pragma("unroll") for (int h = 0; h < 2; ++h) _Pragma("unroll") for (int i = 0; i < 2; ++i) gA[h][i] = gAn[h][i]; }
    }
    PG8_WAIT_V(0);
    if (wr == 0) PG8_BAR;
    PG8_BAR;
#undef PG8_SA
#undef PG8_SB
#undef PG8_STAGE
#undef PG8_STAGEA
#undef PG8_GOFFS
#undef PG8_LDA
#undef PG8_LDB
#undef PG8_MMA
#undef PG8_WAIT_V
#undef PG8_WAIT_L
#undef PG8_BAR
#undef PG8_SCHED
}
}
using pg8::f32x4; using pg8::u32x4; using pg8::Unit;

#define GEMM_LDS (pg8::STAGE_BYTES + 1024)

struct SchedProj : pg8::TileOrder {
  static constexpr bool GATHER = false; static constexpr bool PUBLISH = false;
  const char* A; const char* B;
  __device__ bool next(int i, Unit& u) const { u.z = 0; return tile(i, u.pm, u.pn); }
  __device__ const char* a_ptr(const Unit& u) const { return A + (size_t)u.pm * 256 * DM * 2; }
  __device__ const char* b_ptr(const Unit& u) const { return B + (size_t)u.pn * 256 * DM * 2; }
};
struct EpiProj {
  static constexpr bool PERM = true;
  bf16_t* O;
  __device__ __forceinline__ void operator()(const f32x4 (&acc)[2][2][4][2], const Unit& u, int wr, int wc, int fr, int fq) const {
    const int row0 = u.pm * 256 + wr * 64 + fr, col0 = u.pn * 256 + wc * 32 + 8 * fq;
    const bool gate = u.pn >= (C_GA / 256);
#pragma unroll
    for (int ai = 0; ai < 2; ++ai)
#pragma unroll
      for (int m = 0; m < 4; ++m) {
        bf16_t* rowp = O + (size_t)(row0 + ai * 128 + m * 16) * PW + col0;
#pragma unroll
        for (int bj = 0; bj < 2; ++bj) {
          f32x4 v0 = acc[ai][bj][m][0], v1 = acc[ai][bj][m][1];
          if (gate) {
#pragma unroll
            for (int j = 0; j < 4; ++j) { v0[j] = sigmoidf_(v0[j]); v1[j] = sigmoidf_(v1[j]); }
          }
          u32x4 w; w.x = pg8::cvt_pk_bf16(v0[0], v0[1]); w.y = pg8::cvt_pk_bf16(v0[2], v0[3]); w.z = pg8::cvt_pk_bf16(v1[0], v1[1]); w.w = pg8::cvt_pk_bf16(v1[2], v1[3]);
          *(u32x4*)(rowp + bj * 128) = w;
        }
      }
  }
};
__device__ void ph_proj(const Params& p, PG8_LAS unsigned char* lds, int nblk, int bid) {
  SchedProj S; S.init(T_TOK / 256, PW / 256, nblk, bid); S.A = (const char*)p.hbf; S.B = (const char*)p.w_in_t;
  EpiProj E{p.proj};
  pg8::gemm_phase(lds, p.tid, DM, DM, DM, S, E);
}

struct SchedBr : pg8::TileOrder {
  static constexpr bool GATHER = false; static constexpr bool PUBLISH = false;
  const char* A; const char* Ba; const char* Bb;
  __device__ bool next(int i, Unit& u) const { u.z = i & 1; return tile(i >> 1, u.pm, u.pn); }
  __device__ const char* a_ptr(const Unit& u) const { return A + (size_t)u.pm * 256 * DM * 2 + u.z * 512 * 2; }
  __device__ const char* b_ptr(const Unit& u) const { return (u.z ? Bb : Ba) + (size_t)u.pn * 256 * 512 * 2; }
};
__device__ __forceinline__ void unpack8(const u32x4 w, float (&f)[8]) {
  f[0] = __uint_as_float(w.x << 16); f[1] = __uint_as_float(w.x & 0xffff0000u); f[2] = __uint_as_float(w.y << 16); f[3] = __uint_as_float(w.y & 0xffff0000u);
  f[4] = __uint_as_float(w.z << 16); f[5] = __uint_as_float(w.z & 0xffff0000u); f[6] = __uint_as_float(w.w << 16); f[7] = __uint_as_float(w.w & 0xffff0000u);
}
struct EpiBr {
  static constexpr bool PERM = true;
  const bf16_t* proj; bf16_t* O;
  __device__ __forceinline__ void operator()(const f32x4 (&acc)[2][2][4][2], const Unit& u, int wr, int wc, int fr, int fq) const {
    const int row0 = u.pm * 256 + wr * 64 + fr, col0 = u.pn * 256 + wc * 32 + 8 * fq;
    const int gcol = (u.z ? C_GB : C_GA) + col0;
#pragma unroll
    for (int ai = 0; ai < 2; ++ai) {
      u32x4 gv[4][2], pv[4][2];
#pragma unroll
      for (int m = 0; m < 4; ++m)
#pragma unroll
        for (int bj = 0; bj < 2; ++bj) {
          const size_t row = (size_t)(row0 + ai * 128 + m * 16);
          gv[m][bj] = *(const u32x4*)(proj + row * PW + gcol + bj * 128);
          pv[m][bj] = (u32x4){0u, 0u, 0u, 0u};
          if (u.z) pv[m][bj] = *(const u32x4*)(O + row * DM + col0 + bj * 128);
        }
#pragma unroll
      for (int m = 0; m < 4; ++m)
#pragma unroll
        for (int bj = 0; bj < 2; ++bj) {
          const size_t row = (size_t)(row0 + ai * 128 + m * 16);
          float g[8], pf[8]; unpack8(gv[m][bj], g); unpack8(pv[m][bj], pf);
          const f32x4 v0 = acc[ai][bj][m][0], v1 = acc[ai][bj][m][1];
          float r[8];
#pragma unroll
          for (int j = 0; j < 4; ++j) { r[j] = v0[j] * g[j] + pf[j]; r[4 + j] = v1[j] * g[4 + j] + pf[4 + j]; }
          u32x4 w; w.x = pk2(r[0], r[1]); w.y = pk2(r[2], r[3]); w.z = pk2(r[4], r[5]); w.w = pk2(r[6], r[7]);
          *(u32x4*)(O + row * DM + col0 + bj * 128) = w;
        }
    }
  }
};
__device__ void ph_br(const Params& p, PG8_LAS unsigned char* lds, int nblk, int bid) {
  SchedBr S; S.init(T_TOK / 256, DM / 256, nblk, bid); S.A = (const char*)p.oab; S.Ba = (const char*)p.wbra_t; S.Bb = (const char*)p.wbrb_t;
  EpiBr E{p.proj, p.merged};
  pg8::gemm_phase(lds, p.tid, DM, 512, 512, S, E);
}

struct SchedMix : pg8::TileOrder {
  static constexpr bool GATHER = false; static constexpr bool PUBLISH = false;
  const char* A; const char* B;
  __device__ bool next(int i, Unit& u) const { u.z = 0; return tile(i, u.pm, u.pn); }
  __device__ const char* a_ptr(const Unit& u) const { return A + (size_t)u.pm * 256 * DM * 2; }
  __device__ const char* b_ptr(const Unit& u) const { return B + (size_t)u.pn * 256 * DM * 2; }
};
struct EpiMix {
  static constexpr bool PERM = true;
  bf16_t* O;
  __device__ __forceinline__ void operator()(const f32x4 (&acc)[2][2][4][2], const Unit& u, int wr, int wc, int fr, int fq) const {
    const int row0 = u.pm * 256 + wr * 64 + fr, col0 = u.pn * 256 + wc * 32 + 8 * fq;
#pragma unroll
    for (int ai = 0; ai < 2; ++ai)
#pragma unroll
      for (int m = 0; m < 4; ++m) {
        bf16_t* rowp = O + (size_t)(row0 + ai * 128 + m * 16) * DM + col0;
#pragma unroll
        for (int bj = 0; bj < 2; ++bj) {
          const f32x4 v0 = acc[ai][bj][m][0], v1 = acc[ai][bj][m][1];
          u32x4 w; w.x = pg8::cvt_pk_bf16(v0[0], v0[1]); w.y = pg8::cvt_pk_bf16(v0[2], v0[3]); w.z = pg8::cvt_pk_bf16(v1[0], v1[1]); w.w = pg8::cvt_pk_bf16(v1[2], v1[3]);
          *(u32x4*)(rowp + bj * 128) = w;
        }
      }
  }
};
__device__ void ph_mix(const Params& p, PG8_LAS unsigned char* lds, int nblk, int bid) {
  SchedMix S; S.init(T_TOK / 256, DM / 256, nblk, bid); S.A = (const char*)p.merged; S.B = (const char*)p.wo_t;
  EpiMix E{p.mixer};
  pg8::gemm_phase(lds, p.tid, DM, DM, DM, S, E);
}

template <bool GATH>
struct SchedMoe {
  static constexpr bool GATHER = GATH;
  static constexpr bool PUBLISH = GATH;
  const PG8_LAS int* tb; int NT; int G, c; int nwg;
  const char* A; const char* B; size_t bexp;
  const int* elist; int rowb;
  int* dep; int i0, Loff, rot;
  __device__ void publish(const Unit& u) const { __hip_atomic_fetch_add(dep + u.pm, 1, __ATOMIC_RELAXED, __HIP_MEMORY_SCOPE_AGENT); }
  __device__ bool next(int i, Unit& u) const {
    const long L = (long)(i + i0) * G + c - Loff; if (L >= nwg) return false;
    int wgid = (int)L; { const int q = nwg / 8, r = nwg % 8, xcd = wgid % 8; int off = wgid / 8;
      if constexpr (!GATH) { const int sz = xcd < r ? q + 1 : q; off += rot; if (off >= sz) off -= sz; }
      wgid = (xcd < r ? xcd * (q + 1) : r * (q + 1) + (xcd - r) * q) + off; }
    int e = 0;
#pragma unroll
    for (int st = 16; st >= 1; st >>= 1) if (wgid >= tb[e + st]) e += st;
    const int q = wgid - tb[e]; const int tiles = tb[33 + e + 1] - tb[33 + e];
    u.pm = tb[33 + e] + q % tiles; u.pn = q / tiles; u.z = e;
    if constexpr (!GATH) {
      while (__builtin_amdgcn_readfirstlane(__hip_atomic_load(dep + u.pm, __ATOMIC_RELAXED, __HIP_MEMORY_SCOPE_AGENT)) < 8) __builtin_amdgcn_s_sleep(4);
      asm volatile("" ::: "memory");
    }
    return true;
  }
  __device__ const char* a_ptr(const Unit& u) const { return GATH ? A : A + (size_t)u.pm * 256 * rowb; }
  __device__ const char* b_ptr(const Unit& u) const { return B + (size_t)u.z * bexp + (size_t)u.pn * 256 * rowb; }
  __device__ unsigned a_goff(const Unit& u, int tr, int C) const {
    const int i = (u.pm - tb[33 + u.z]) * 256 + tr;
    int tok = 0;
    if (i < tb[66 + u.z]) tok = elist[u.z * T_TOK + i] >> 2;
    return (unsigned)(tok * rowb + C * 2);
  }
};
__device__ __forceinline__ void moe_table(const Params& p, PG8_LAS int* tb, int NT) {
  if (p.tid == 0) {
    int ub = 0, tbp = 0;
    for (int e = 0; e < NE; ++e) { const int c = p.cnt[e * 64]; tb[e] = ub; tb[33 + e] = tbp; tb[66 + e] = c; const int t = (c + 255) >> 8; ub += t * NT; tbp += t; }
    tb[NE] = ub; tb[33 + NE] = tbp;
  }
  __syncthreads();
}
struct EpiMoe1 {
  static constexpr bool PERM = true;
  const float* b_gu; unsigned char* act;
  __device__ __forceinline__ void operator()(f32x4 (&acc)[2][2][4][2], const Unit& u, int wr, int wc, int fr, int fq) const {
    const int row0 = u.pm * 256 + wr * 64 + fr, jc = u.pn * 128 + wc * 32 + 8 * fq;
    const float* bg = b_gu + (size_t)u.z * 2048 + jc;
#pragma unroll
    for (int bj = 0; bj < 2; ++bj)
#pragma unroll
      for (int n = 0; n < 2; ++n) {
        const f32x4 bv = *(const f32x4*)(bg + bj * 1024 + n * 4);
#pragma unroll
        for (int ai = 0; ai < 2; ++ai)
#pragma unroll
          for (int m = 0; m < 4; ++m) acc[ai][bj][m][n] = acc[ai][bj][m][n] * 0.015625f + bv;
      }
#pragma unroll
    for (int ai = 0; ai < 2; ++ai)
#pragma unroll
      for (int m = 0; m < 4; ++m) {
        unsigned char* rowp = act + (size_t)(row0 + ai * 128 + m * 16) * DM + jc;
        float r[8];
#pragma unroll
        for (int n = 0; n < 2; ++n)
#pragma unroll
          for (int j = 0; j < 4; ++j) {
            float g = acc[ai][0][m][n][j], up = acc[ai][1][m][n][j];
            g = fminf(g, 7.f); up = fminf(fmaxf(up, -7.f), 7.f);
            r[n * 4 + j] = (up + 1.f) * g * sigmoidf_(1.702f * g);
          }
        u32x2 w; w.x = pk4_fp8(r[0], r[1], r[2], r[3]); w.y = pk4_fp8(r[4], r[5], r[6], r[7]);
        __hip_atomic_store((unsigned long long*)rowp, (unsigned long long)w.x | ((unsigned long long)w.y << 32), __ATOMIC_RELAXED, __HIP_MEMORY_SCOPE_AGENT);
      }
  }
};
__device__ void ph_moe1(const Params& p, PG8_LAS unsigned char* lds, int nblk, int bid) {
  PG8_LAS int* tb = (PG8_LAS int*)(lds + pg8::STAGE_BYTES);
  moe_table(p, tb, 8);
  SchedMoe<true> S; S.tb = tb; S.NT = 8; S.G = nblk; S.c = bid; S.nwg = tb[NE]; S.A = (const char*)p.h2q; S.B = (const char*)p.wgu8; S.bexp = (size_t)2048 * DM; S.elist = p.elist; S.rowb = DM;
  S.dep = p.dep; S.i0 = 0; S.Loff = 0; S.rot = 0;
  EpiMoe1 E{p.b_gu, p.act8};
  pg8::gemm_phase<EpiMoe1, SchedMoe<true>, true>(lds, p.tid, DM / 2, DM / 2, DM / 2, S, E);
}
struct EpiMoe2 {
  static constexpr bool PERM = true;
  const float* b_down; const int* elist; const PG8_LAS int* tb; bf16_t* yslot;
  __device__ __forceinline__ void operator()(f32x4 (&acc)[2][2][4][2], const Unit& u, int wr, int wc, int fr, int fq) const {
    const int row0 = u.pm * 256 + wr * 64 + fr, col0 = u.pn * 256 + wc * 32 + 8 * fq;
    const float* bd = b_down + (size_t)u.z * 1024 + col0;
#pragma unroll
    for (int bj = 0; bj < 2; ++bj)
#pragma unroll
      for (int n = 0; n < 2; ++n) {
        const f32x4 bv = *(const f32x4*)(bd + bj * 128 + n * 4);
#pragma unroll
        for (int ai = 0; ai < 2; ++ai)
#pragma unroll
          for (int m = 0; m < 4; ++m) acc[ai][bj][m][n] = acc[ai][bj][m][n] * 0.015625f + bv;
      }
    const int li0 = (u.pm - tb[33 + u.z]) * 256 + wr * 64 + fr, cnt = tb[66 + u.z];
    int av[2][4];
#pragma unroll
    for (int ai = 0; ai < 2; ++ai)
#pragma unroll
      for (int m = 0; m < 4; ++m) { const int li = li0 + ai * 128 + m * 16; av[ai][m] = elist[u.z * T_TOK + (li < cnt ? li : 0)]; if (li >= cnt) av[ai][m] = -1; }
#pragma unroll
    for (int ai = 0; ai < 2; ++ai)
#pragma unroll
      for (int m = 0; m < 4; ++m) {
        const int a = av[ai][m];
        if (a >= 0) {
          bf16_t* rowp = yslot + (size_t)a * DM + col0;
#pragma unroll
          for (int bj = 0; bj < 2; ++bj) {
            const f32x4 v0 = acc[ai][bj][m][0], v1 = acc[ai][bj][m][1];
            u32x4 w; w.x = pk2(v0[0], v0[1]); w.y = pk2(v0[2], v0[3]); w.z = pk2(v1[0], v1[1]); w.w = pk2(v1[2], v1[3]);
            *(u32x4*)(rowp + bj * 128) = w;
          }
        }
      }
  }
};
__device__ void ph_moe2(const Params& p, PG8_LAS unsigned char* lds, int nblk, int bid) {
  PG8_LAS int* tb = (PG8_LAS int*)(lds + pg8::STAGE_BYTES);
  moe_table(p, tb, 4);
  SchedMoe<false> S; S.tb = tb; S.NT = 4; S.G = nblk; S.c = bid; S.nwg = tb[NE]; S.A = (const char*)p.act8; S.B = (const char*)p.wd8; S.bexp = (size_t)1024 * DM; S.elist = p.elist; S.rowb = DM;
  { const int nwg1 = 2 * S.nwg; S.dep = p.dep; S.i0 = (nwg1 - bid + nblk - 1) / nblk; S.Loff = nwg1; S.rot = S.nwg >> 5; }
  EpiMoe2 E{p.b_down, p.elist, tb, p.yslot};
  pg8::gemm_phase<EpiMoe2, SchedMoe<false>, true>(lds, p.tid, DM / 2, DM / 2, DM / 2, S, E);
}

typedef short bf16x8 __attribute__((ext_vector_type(8)));
#define LAS __attribute__((address_space(3)))
#define MFMA16(a, b, c) __builtin_amdgcn_mfma_f32_16x16x32_bf16((a), (b), (c), 0, 0, 0)
__device__ __forceinline__ bf16x8 pack8(float a0, float a1, float a2, float a3, float a4, float a5, float a6, float a7) {
  u32x4 w; w.x = pk2(a0, a1); w.y = pk2(a2, a3); w.z = pk2(a4, a5); w.w = pk2(a6, a7);
  return __builtin_bit_cast(bf16x8, w);
}
__device__ __forceinline__ bf16_t f2bf_hw(float a) { return (bf16_t)(pk2(a, 0.f) & 0xffffu); }

#define DN_ABYTES 57344
#define DN_UFLOATS 8192
#define F_WN 0
#define F_QD 16
#define F_QK 32
#define F_KT 40

#define DP_KH 0
#define DP_QT 17408
#define DP_KHT 34816
#define DP_VT 53248
#define DP_TU 71680
#define DP_TW 80896
#define DP_LF 90112
#define DP_GC 107520
#define DP_BETA 107776
#define DP_CW 108032
#define DP_LB 114176
#define DP_TR 123392
#define DP_TT 132608
#define DP_MT 141824
#define DP_TOTAL 144128

template <int KS>
__device__ __forceinline__ f32x4 prod16(const LAS bf16_t* A, int lda, int arow0, const LAS bf16_t* Bt, int ldb, int brow0, f32x4 acc, int lane) {
  const int r = lane & 15, q = lane >> 4;
#pragma unroll
  for (int ks = 0; ks < KS; ++ks) {
    const bf16x8 a = *(const LAS bf16x8*)(A + (arow0 + r) * lda + 32 * ks + 8 * q);
    const bf16x8 b = *(const LAS bf16x8*)(Bt + (brow0 + r) * ldb + 32 * ks + 8 * q);
    acc = MFMA16(a, b, acc);
  }
  return acc;
}
__device__ __forceinline__ void tile_store_rm(LAS bf16_t* X, int ld, int row0, int col0, const f32x4 v, int lane) {
  const int r = lane & 15, q = lane >> 4;
#pragma unroll
  for (int i = 0; i < 4; ++i) X[(row0 + 4 * q + i) * ld + col0 + r] = f2bf_hw(v[i]);
}
__device__ __forceinline__ void tile_store_tr(LAS bf16_t* Xt, int ld, int row0, int col0, const f32x4 v, int lane) {
  const int r = lane & 15, q = lane >> 4;
  u32x2 w; w.x = pk2(v[0], v[1]); w.y = pk2(v[2], v[3]);
  *(LAS u32x2*)(Xt + (col0 + r) * ld + row0 + 4 * q) = w;
}

__device__ void dn_prep_chunk(const Params& p, LAS unsigned char* lds, int ci, bool load_cw) {
  const int tid = p.tid, lane = tid & 63, w = tid >> 6, r16 = lane & 15, q4 = lane >> 4;
  const int bh = ci >> 6, n = ci & 63, b = bh >> 2, h = bh & 3;
  LAS bf16_t* Kh = (LAS bf16_t*)(lds + DP_KH); LAS bf16_t* Qt = (LAS bf16_t*)(lds + DP_QT);
  LAS bf16_t* KhT = (LAS bf16_t*)(lds + DP_KHT); LAS bf16_t* VT = (LAS bf16_t*)(lds + DP_VT);
  LAS bf16_t* Tu = (LAS bf16_t*)(lds + DP_TU); LAS bf16_t* Tw = (LAS bf16_t*)(lds + DP_TW); LAS float* Lf = (LAS float*)(lds + DP_LF);
  LAS bf16_t* Lb = (LAS bf16_t*)(lds + DP_LB); LAS bf16_t* Tr = (LAS bf16_t*)(lds + DP_TR); LAS bf16_t* Tt = (LAS bf16_t*)(lds + DP_TT); LAS bf16_t* Mt = (LAS bf16_t*)(lds + DP_MT);
  LAS float* gcb = (LAS float*)(lds + DP_GC); LAS float* betab = (LAS float*)(lds + DP_BETA); LAS float* cw = (LAS float*)(lds + DP_CW);
  unsigned char* gA = (unsigned char*)p.dnA + (size_t)ci * DN_ABYTES;
  float* gU = p.dnU + (size_t)ci * DN_UFLOATS;

  if (load_cw) {
    for (int i = tid; i < 4 * 384; i += 512) { const int tap = i / 384, cc = i % 384, part = cc >> 7, d = cc & 127; cw[i] = p.conv_w[tap * 1536 + part * 512 + h * 128 + d]; }
  }
  __syncthreads();
  const int c = tid >> 3, g = tid & 7;
  const int s = n * 64 + c;
  const size_t t = (size_t)b * SEQ + s;
  float qv[16], kv[16], vv[16];
#pragma unroll
  for (int j = 0; j < 16; ++j) { qv[j] = 0.f; kv[j] = 0.f; vv[j] = 0.f; }
#pragma unroll
  for (int tap = 0; tap < 4; ++tap) {
    const int ss = s - 3 + tap;
    if (ss >= 0) {
      const bf16_t* row = p.proj + (t - 3 + tap) * PW + h * 128 + 16 * g;
      float x[8];
#pragma unroll
      for (int part = 0; part < 3; ++part) {
#pragma unroll
        for (int hh = 0; hh < 2; ++hh) {
          unpack8(*(const u32x4*)(row + part * 512 + 8 * hh), x);
#pragma unroll
          for (int j = 0; j < 8; ++j) {
            const float wv = cw[tap * 384 + part * 128 + 16 * g + 8 * hh + j];
            if (part == 0) qv[8 * hh + j] += wv * x[j];
            if (part == 1) kv[8 * hh + j] += wv * x[j];
            if (part == 2) vv[8 * hh + j] += wv * x[j];
          }
        }
      }
    }
    asm volatile("" ::: "memory");
  }
  float sq = 0.f, sk = 0.f;
#pragma unroll
  for (int j = 0; j < 16; ++j) { qv[j] = siluf_(qv[j]); kv[j] = siluf_(kv[j]); vv[j] = siluf_(vv[j]); sq += qv[j] * qv[j]; sk += kv[j] * kv[j]; }
  sq += __shfl_xor(sq, 1, 64); sq += __shfl_xor(sq, 2, 64); sq += __shfl_xor(sq, 4, 64);
  sk += __shfl_xor(sk, 1, 64); sk += __shfl_xor(sk, 2, 64); sk += __shfl_xor(sk, 4, 64);
  const float rq = rsqrtf(sq + 1e-6f) * 0.08838834764831845f, rk = rsqrtf(sk + 1e-6f);
#pragma unroll
  for (int j = 0; j < 16; ++j) { qv[j] *= rq; kv[j] *= rk; }
  if (g == 0) {
    const float bb = p.ba[t * 8 + h], aa = p.ba[t * 8 + 4 + h];
    const float xx = aa + p.dt_bias[h];
    const float sp = xx > 20.f ? xx : log1pf(__expf(xx));
    betab[c] = sigmoidf_(bb);
    gcb[c] = -__expf(p.a_log[h]) * sp;
  }
  {
    u32x4 w0, w1;
    w0.x = pk2(kv[0], kv[1]); w0.y = pk2(kv[2], kv[3]); w0.z = pk2(kv[4], kv[5]); w0.w = pk2(kv[6], kv[7]);
    w1.x = pk2(kv[8], kv[9]); w1.y = pk2(kv[10], kv[11]); w1.z = pk2(kv[12], kv[13]); w1.w = pk2(kv[14], kv[15]);
    *(LAS u32x4*)(Kh + c * 136 + 16 * g) = w0; *(LAS u32x4*)(Kh + c * 136 + 16 * g + 8) = w1;
    w0.x = pk2(qv[0], qv[1]); w0.y = pk2(qv[2], qv[3]); w0.z = pk2(qv[4], qv[5]); w0.w = pk2(qv[6], qv[7]);
    w1.x = pk2(qv[8], qv[9]); w1.y = pk2(qv[10], qv[11]); w1.z = pk2(qv[12], qv[13]); w1.w = pk2(qv[14], qv[15]);
    *(LAS u32x4*)(Qt + c * 136 + 16 * g) = w0; *(LAS u32x4*)(Qt + c * 136 + 16 * g + 8) = w1;
#pragma unroll
    for (int j = 0; j < 16; ++j) { KhT[(16 * g + j) * 72 + c] = f2bf_hw(kv[j]); VT[(16 * g + j) * 72 + c] = f2bf_hw(vv[j]); }
  }
  __syncthreads();
  if (w == 0) {
    float v = gcb[lane];
#pragma unroll
    for (int o = 1; o < 64; o <<= 1) { const float u = __shfl_up(v, o, 64); if (lane >= o) v += u; }
    gcb[lane] = v;
  }
  __syncthreads();
  const float gc_c = gcb[c], gl = gcb[63];
  {
    const float eg = __expf(gc_c);
    unsigned char* fb = gA + (size_t)(F_QD + (c >> 4) * 4 + (g >> 1)) * 1024 + (g & 1) * 8;
#pragma unroll
    for (int qq = 0; qq < 4; ++qq) {
      u32x2 wv; wv.x = pk2(qv[4 * qq] * eg, qv[4 * qq + 1] * eg); wv.y = pk2(qv[4 * qq + 2] * eg, qv[4 * qq + 3] * eg);
      *(u32x2*)(fb + ((c & 15) + 16 * qq) * 16) = wv;
    }
  }
  const int rt = w >> 1, ct0 = 2 * (w & 1);
#pragma unroll
  for (int tt = 0; tt < 2; ++tt) {
    const int ct = ct0 + tt;
    f32x4 gacc = {0.f, 0.f, 0.f, 0.f};
    gacc = prod16<4>(Kh, 136, 16 * rt, Kh, 136, 16 * ct, gacc, lane);
    const int m = 16 * ct + r16; const float gc_m = gcb[m];
    f32x4 lv;
#pragma unroll
    for (int i = 0; i < 4; ++i) {
      const int cc = 16 * rt + 4 * q4 + i;
      lv[i] = (m < cc) ? betab[cc] * gacc[i] * __expf(gcb[cc] - gc_m) : 0.f;
      Lf[cc * 68 + m] = lv[i];
    }
    tile_store_rm(Lb, 72, 16 * rt, 16 * ct, lv, lane);
    f32x4 qacc = {0.f, 0.f, 0.f, 0.f};
    qacc = prod16<4>(Kh, 136, 16 * rt, Qt, 136, 16 * ct, qacc, lane);
    const int cq = 16 * ct + r16; const float gc_cq = gcb[cq];
    float o4[4];
#pragma unroll
    for (int i = 0; i < 4; ++i) { const int mm = 16 * rt + 4 * q4 + i; o4[i] = (mm <= cq) ? qacc[i] * __expf(gc_cq - gcb[mm]) : 0.f; }
    u32x2 wv; wv.x = pk2(o4[0], o4[1]); wv.y = pk2(o4[2], o4[3]);
    *(u32x2*)(gA + (size_t)(F_QK + ct * 2 + (rt >> 1)) * 1024 + (r16 + 16 * q4) * 16 + (rt & 1) * 8) = wv;
  }
  __syncthreads();
  for (int i = tid; i < 2 * 64 * 72 / 8; i += 512) ((LAS u32x4*)Tr)[i] = (u32x4){0u, 0u, 0u, 0u};
  __syncthreads();
  if (w == 0) {
    int lo = lane; asm volatile("" : "+v"(lo));
    const int g = lo >> 4, j = lo & 15;
    unsigned lfb = DP_LF + (16 * g * 68 + 16 * g) * 4; asm volatile("" : "+v"(lfb));
    const LAS float* Lg = (const LAS float*)(lds + lfb);
    float t[16];
#pragma unroll
    for (int r = 0; r < 16; ++r) {
      float a0 = (r == j) ? 1.f : 0.f, a1 = 0.f;
#pragma unroll
      for (int k4 = 0; k4 < (r + 3) / 4; ++k4) {
        const f32x4 l = *(const LAS f32x4*)(Lg + r * 68 + 4 * k4);
        if (4 * k4 + 0 < r) a0 -= l[0] * t[4 * k4 + 0];
        if (4 * k4 + 1 < r) a1 -= l[1] * t[4 * k4 + 1];
        if (4 * k4 + 2 < r) a0 -= l[2] * t[4 * k4 + 2];
        if (4 * k4 + 3 < r) a1 -= l[3] * t[4 * k4 + 3];
      }
      t[r] = a0 + a1;
      Tr[(16 * g + r) * 72 + 16 * g + j] = f2bf_hw(t[r]);
    }
    u32x4 w0, w1;
    w0.x = pk2(t[0], t[1]); w0.y = pk2(t[2], t[3]); w0.z = pk2(t[4], t[5]); w0.w = pk2(t[6], t[7]);
    w1.x = pk2(t[8], t[9]); w1.y = pk2(t[10], t[11]); w1.z = pk2(t[12], t[13]); w1.w = pk2(t[14], t[15]);
    *(LAS u32x4*)(Tt + (16 * g + j) * 72 + 16 * g) = w0; *(LAS u32x4*)(Tt + (16 * g + j) * 72 + 16 * g + 8) = w1;
  }
  __syncthreads();
#pragma unroll 1
  for (int d = 1; d <= 3; ++d) {
    const bool act = w < 4 - d;
    const int I = w + d, J = w;
    LAS bf16_t* Mw = Mt + w * 16 * 24;
    if (act) {
      f32x4 macc = {0.f, 0.f, 0.f, 0.f};
      macc = prod16<2>(Lb, 72, 16 * I, Tt, 72, 16 * J, macc, lane);
      tile_store_tr(Mw, 24, 0, 0, macc, lane);
    }
    __syncthreads();
    if (act) {
      bf16x8 a = {0, 0, 0, 0, 0, 0, 0, 0}, bb = {0, 0, 0, 0, 0, 0, 0, 0};
      if (q4 < 2) { a = *(const LAS bf16x8*)(Tr + (16 * I + r16) * 72 + 16 * I + 8 * q4); bb = *(const LAS bf16x8*)(Mw + r16 * 24 + 8 * q4); }
      f32x4 tacc = {0.f, 0.f, 0.f, 0.f};
      tacc = MFMA16(a, bb, tacc);
#pragma unroll
      for (int i = 0; i < 4; ++i) tacc[i] = -tacc[i];
      tile_store_rm(Tr, 72, 16 * I, 16 * J, tacc, lane);
      tile_store_tr(Tt, 72, 16 * I, 16 * J, tacc, lane);
    }
    __syncthreads();
  }
  {
    const int cc = tid >> 3, m0 = (tid & 7) * 8;
    float tv[8]; unpack8(*(const LAS u32x4*)(Tr + cc * 72 + m0), tv);
    float tu[8], tw[8];
#pragma unroll
    for (int jj = 0; jj < 8; ++jj) { const float bm = betab[m0 + jj]; tu[jj] = tv[jj] * bm; tw[jj] = tu[jj] * __expf(gcb[m0 + jj]); }
    u32x4 wu, ww;
    wu.x = pk2(tu[0], tu[1]); wu.y = pk2(tu[2], tu[3]); wu.z = pk2(tu[4], tu[5]); wu.w = pk2(tu[6], tu[7]);
    ww.x = pk2(tw[0], tw[1]); ww.y = pk2(tw[2], tw[3]); ww.z = pk2(tw[4], tw[5]); ww.w = pk2(tw[6], tw[7]);
    *(LAS u32x4*)(Tu + cc * 72 + m0) = wu; *(LAS u32x4*)(Tw + cc * 72 + m0) = ww;
  }
  __syncthreads();
#pragma unroll
  for (int rr = 0; rr < 4; ++rr) {
    f32x4 u = {0.f, 0.f, 0.f, 0.f};
    u = prod16<2>(Tu, 72, 16 * rr, VT, 72, 16 * w, u, lane);
    *(f32x4*)(gU + ((w * 4 + rr) * 64 + lane) * 4) = u;
    f32x4 wt = {0.f, 0.f, 0.f, 0.f};
    wt = prod16<2>(KhT, 72, 16 * w, Tw, 72, 16 * rr, wt, lane);
    u32x2 wv; wv.x = pk2(-wt[0], -wt[1]); wv.y = pk2(-wt[2], -wt[3]);
    *(u32x2*)(gA + (size_t)(F_WN + rr * 4 + (w >> 1)) * 1024 + (r16 + 16 * q4) * 16 + (w & 1) * 8) = wv;
  }
#pragma unroll
  for (int it = 0; it < 4; ++it) {
    const int idx = tid + it * 512; const int d = idx >> 4, m4 = idx & 15;
    const u32x2 raw = *(const LAS u32x2*)(KhT + d * 72 + 4 * m4);
    const float k0 = __uint_as_float(raw.x << 16), k1 = __uint_as_float(raw.x & 0xffff0000u), k2 = __uint_as_float(raw.y << 16), k3 = __uint_as_float(raw.y & 0xffff0000u);
    const float e0 = __expf(gl - gcb[4 * m4]), e1 = __expf(gl - gcb[4 * m4 + 1]), e2 = __expf(gl - gcb[4 * m4 + 2]), e3 = __expf(gl - gcb[4 * m4 + 3]);
    u32x2 wv; wv.x = pk2(k0 * e0, k1 * e1); wv.y = pk2(k2 * e2, k3 * e3);
    *(u32x2*)(gA + (size_t)(F_KT + (d >> 4) * 2 + (m4 >> 3)) * 1024 + ((d & 15) + 16 * (m4 & 3)) * 16 + ((m4 >> 2) & 1) * 8) = wv;
  }
  if (tid == 0) p.dnG[ci] = __expf(gl);
}

#define DS_SLOT 32768
#define DS_TOTAL (4 * DS_SLOT)
#define DN_SFRAG (4 * 1024)
#define DN_VFRAG (2 * 1024)
__device__ void dn_scan_blk(const Params& p, LAS unsigned char* lds, int item) {
  const int tid = p.tid, lane = tid & 63, w = __builtin_amdgcn_readfirstlane(tid >> 6);
  const int bh = item >> 1, eh = item & 1;
  const int et = eh * 4 + (w & 3);
  const bool comp = w < 4;
  const unsigned char* gA = (const unsigned char*)p.dnA + (size_t)bh * 64 * DN_ABYTES;
  const float* gU = p.dnU + (size_t)bh * 64 * DN_UFLOATS;
  const float* gG = p.dnG + bh * 64;
  unsigned char* gS = (unsigned char*)p.dnS + ((size_t)bh * 64 * 8 + et) * DN_SFRAG + lane * 16;
  unsigned char* gV = (unsigned char*)p.dnV + ((size_t)bh * 64 * 8 + et) * DN_VFRAG + lane * 16;
  auto issue_A = [&](int n) {
#pragma unroll
    for (int i = 0; i < 8; ++i) {
      const int f = (w & 3) * 8 + i, sf = f < 16 ? F_WN + f : F_KT + (f - 16);
      __builtin_amdgcn_global_load_lds((const unsigned*)(gA + (size_t)n * DN_ABYTES + sf * 1024 + lane * 16), (LAS unsigned*)(lds + (n & 3) * DS_SLOT + f * 1024), 16, 0, 0);
    }
  };
  __syncthreads();
  f32x4 Un[4]; f32x4 S[8]; float gnext = 0.f;
  if (comp) {
#pragma unroll
    for (int rr = 0; rr < 4; ++rr) Un[rr] = *(const f32x4*)(gU + ((et * 4 + rr) * 64 + lane) * 4);
    gnext = gG[0];
  } else {
    issue_A(0); issue_A(1); issue_A(2);
    asm volatile("s_waitcnt vmcnt(16)" ::: "memory");
  }
#pragma unroll
  for (int dt = 0; dt < 8; ++dt) S[dt] = (f32x4){0.f, 0.f, 0.f, 0.f};
  asm volatile("s_waitcnt lgkmcnt(0)" ::: "memory");
  __builtin_amdgcn_s_barrier();
  asm volatile("" ::: "memory");
#pragma unroll 1
  for (int n = 0; n < 64; ++n) {
    const LAS unsigned char* Ab = lds + (n & 3) * DS_SLOT;
    if (!comp) {
      if (n + 3 < 64) { issue_A(n + 3); asm volatile("s_waitcnt vmcnt(16)" ::: "memory"); }
      else if (n + 2 < 64) asm volatile("s_waitcnt vmcnt(8)" ::: "memory");
      else asm volatile("s_waitcnt vmcnt(0)" ::: "memory");
    } else {
      f32x4 Vn[4];
#pragma unroll
      for (int rr = 0; rr < 4; ++rr) Vn[rr] = Un[rr];
      const float gdec = gnext;
      if (n + 1 < 64) {
#pragma unroll
        for (int rr = 0; rr < 4; ++rr) Un[rr] = *(const f32x4*)(gU + (size_t)(n + 1) * DN_UFLOATS + ((et * 4 + rr) * 64 + lane) * 4);
        gnext = gG[n + 1];
      }
      bf16x8 Sb[4];
#pragma unroll
      for (int ks = 0; ks < 4; ++ks) Sb[ks] = pack8(S[2 * ks][0], S[2 * ks][1], S[2 * ks][2], S[2 * ks][3], S[2 * ks + 1][0], S[2 * ks + 1][1], S[2 * ks + 1][2], S[2 * ks + 1][3]);
#pragma unroll
      for (int ks = 0; ks < 4; ++ks) *(bf16x8*)(gS + (size_t)n * 8 * DN_SFRAG + ks * 1024) = Sb[ks];
#pragma unroll
      for (int dt = 0; dt < 8; ++dt) S[dt] *= gdec;
#define LDF(idx) (*(const LAS bf16x8*)(Ab + (idx) * 1024 + lane * 16))
#define SBAR __builtin_amdgcn_sched_barrier(0)
      bf16x8 fa[8], fb[8];
#pragma unroll
      for (int i = 0; i < 8; ++i) fa[i] = LDF(i);
      SBAR;
#pragma unroll
      for (int i = 0; i < 8; ++i) fb[i] = LDF(8 + i);
      SBAR;
#pragma unroll
      for (int ks = 0; ks < 4; ++ks) { Vn[0] = MFMA16(fa[ks], Sb[ks], Vn[0]); Vn[1] = MFMA16(fa[4 + ks], Sb[ks], Vn[1]); }
      SBAR;
#pragma unroll
      for (int i = 0; i < 8; ++i) fa[i] = LDF(16 + i);
      SBAR;
#pragma unroll
      for (int ks = 0; ks < 4; ++ks) { Vn[2] = MFMA16(fb[ks], Sb[ks], Vn[2]); Vn[3] = MFMA16(fb[4 + ks], Sb[ks], Vn[3]); }
      SBAR;
#pragma unroll
      for (int i = 0; i < 8; ++i) fb[i] = LDF(24 + i);
      SBAR;
      bf16x8 Vb[2];
#pragma unroll
      for (int ks = 0; ks < 2; ++ks) Vb[ks] = pack8(Vn[2 * ks][0], Vn[2 * ks][1], Vn[2 * ks][2], Vn[2 * ks][3], Vn[2 * ks + 1][0], Vn[2 * ks + 1][1], Vn[2 * ks + 1][2], Vn[2 * ks + 1][3]);
#pragma unroll
      for (int ks = 0; ks < 2; ++ks) *(bf16x8*)(gV + (size_t)n * 8 * DN_VFRAG + ks * 1024) = Vb[ks];
#pragma unroll
      for (int ks = 0; ks < 2; ++ks)
#pragma unroll
        for (int dt = 0; dt < 4; ++dt) S[dt] = MFMA16(fa[dt * 2 + ks], Vb[ks], S[dt]);
#pragma unroll
      for (int ks = 0; ks < 2; ++ks)
#pragma unroll
        for (int dt = 0; dt < 4; ++dt) S[4 + dt] = MFMA16(fb[dt * 2 + ks], Vb[ks], S[4 + dt]);
#undef LDF
#undef SBAR
      asm volatile("s_waitcnt lgkmcnt(0)" ::: "memory");
    }
    __builtin_amdgcn_s_barrier();
    asm volatile("" ::: "memory");
  }
  asm volatile("s_waitcnt vmcnt(0)" ::: "memory");
}
#define DO_OT 32768
__device__ void ph_dn_out(const Params& p, LAS unsigned char* lds, int nblk, int bid) {
  const int tid = p.tid, lane = tid & 63, w = __builtin_amdgcn_readfirstlane(tid >> 6), r16 = lane & 15, q4 = lane >> 4;
  LAS float* Ot = (LAS float*)(lds + DO_OT);
  for (int ci = bid; ci < 1024; ci += nblk) {
    const int bh = ci >> 6, n = ci & 63, b = bh >> 2, h = bh & 3;
    const unsigned char* gA = (const unsigned char*)p.dnA + (size_t)ci * DN_ABYTES;
    __syncthreads();
#pragma unroll
    for (int i = 0; i < 3; ++i) {
      const int f = w * 3 + i;
      __builtin_amdgcn_global_load_lds((const unsigned*)(gA + (F_QD + f) * 1024 + lane * 16), (LAS unsigned*)(lds + f * 1024), 16, 0, 0);
    }
    bf16x8 Sb[4], Vb[2];
#pragma unroll
    for (int ks = 0; ks < 4; ++ks) Sb[ks] = *(const bf16x8*)((const unsigned char*)p.dnS + ((size_t)ci * 8 + w) * DN_SFRAG + ks * 1024 + lane * 16);
#pragma unroll
    for (int ks = 0; ks < 2; ++ks) Vb[ks] = *(const bf16x8*)((const unsigned char*)p.dnV + ((size_t)ci * 8 + w) * DN_VFRAG + ks * 1024 + lane * 16);
    asm volatile("s_waitcnt vmcnt(0)" ::: "memory");
    __syncthreads();
    f32x4 O[4];
#pragma unroll
    for (int rr = 0; rr < 4; ++rr) {
      O[rr] = (f32x4){0.f, 0.f, 0.f, 0.f};
#pragma unroll
      for (int ks = 0; ks < 4; ++ks) O[rr] = MFMA16(*(const LAS bf16x8*)(lds + (rr * 4 + ks) * 1024 + lane * 16), Sb[ks], O[rr]);
#pragma unroll
      for (int ks = 0; ks < 2; ++ks) O[rr] = MFMA16(*(const LAS bf16x8*)(lds + (16 + rr * 2 + ks) * 1024 + lane * 16), Vb[ks], O[rr]);
    }
#pragma unroll
    for (int rr = 0; rr < 4; ++rr)
#pragma unroll
      for (int i = 0; i < 4; ++i) Ot[(16 * rr + 4 * q4 + i) * 132 + 16 * w + r16] = O[rr][i];
    __syncthreads();
    {
      const int row = tid >> 3, seg = tid & 7;
      const size_t t = (size_t)b * SEQ + n * 64 + row;
      float o[16]; float ss = 0.f;
#pragma unroll
      for (int j4 = 0; j4 < 4; ++j4) { const f32x4 v = *(const LAS f32x4*)(Ot + row * 132 + 16 * seg + 4 * j4); o[4 * j4] = v[0]; o[4 * j4 + 1] = v[1]; o[4 * j4 + 2] = v[2]; o[4 * j4 + 3] = v[3]; }
#pragma unroll
      for (int j = 0; j < 16; ++j) ss += o[j] * o[j];
      ss += __shfl_xor(ss, 1, 64); ss += __shfl_xor(ss, 2, 64); ss += __shfl_xor(ss, 4, 64);
      const float rstd = rsqrtf(ss * (1.f / 128.f) + 1e-6f);
      const bf16_t* zp = p.proj + t * PW + C_Z + h * 128 + 16 * seg;
      float z0[8], z1[8]; unpack8(*(const u32x4*)zp, z0); unpack8(*(const u32x4*)(zp + 8), z1);
      float y[16];
#pragma unroll
      for (int j = 0; j < 8; ++j) { y[j] = o[j] * rstd * p.g_dn_out[16 * seg + j] * siluf_(z0[j]); y[8 + j] = o[8 + j] * rstd * p.g_dn_out[16 * seg + 8 + j] * siluf_(z1[j]); }
      u32x4 w0, w1;
      w0.x = pk2(y[0], y[1]); w0.y = pk2(y[2], y[3]); w0.z = pk2(y[4], y[5]); w0.w = pk2(y[6], y[7]);
      w1.x = pk2(y[8], y[9]); w1.y = pk2(y[10], y[11]); w1.z = pk2(y[12], y[13]); w1.w = pk2(y[14], y[15]);
      bf16_t* op = p.dn_out + t * p.dn_out_ld + h * 128 + 16 * seg;
      *(u32x4*)op = w0; *(u32x4*)(op + 8) = w1;
    }
  }
}
typedef float f32x16 __attribute__((ext_vector_type(16)));
#define MFMA32(a, b, c) __builtin_amdgcn_mfma_f32_32x32x16_bf16((a), (b), (c), 0, 0, 0)
#define MP_VL 0
#define MP_RED 65536
#define MP_TOTAL (65536 + 4096)

__device__ void moba_prep_block(const Params& p, LAS unsigned char* lds, int item) {
  const int tid = p.tid, lane = tid & 63, w = tid >> 6;
  const int bh = item >> 4, jb = item & 15, b = bh >> 2, h = bh & 3;
  LAS bf16_t* Vl = (LAS bf16_t*)(lds + MP_VL);
  LAS float* red = (LAS float*)(lds + MP_RED);
  __syncthreads();
#pragma unroll
  for (int it = 0; it < 8; ++it) {
    const int idx = tid + 512 * it, row = idx >> 4, ch = idx & 15;
    const u32x4 v = *(const u32x4*)(p.proj + ((size_t)b * SEQ + 256 * jb + row) * PW + C_MV + h * 128 + 8 * ch);
    *(LAS u32x4*)(Vl + row * 128 + 8 * ch) = v;
  }
  {
    const int r = tid >> 1, hh = tid & 1;
    const int pos = 256 * jb + r;
    const size_t t = (size_t)b * SEQ + pos;
    float cs[8], sn[8];
#pragma unroll
    for (int jj = 0; jj < 8; ++jj) {
      const float inv = exp2f(-(float)(8 * hh + jj) * (1.f / 16.f) * 18.931568569324174f);
      const float ang = (float)pos * inv;
      cs[jj] = cosf(ang); sn[jj] = sinf(ang);
    }
    float kacc[64];
#pragma unroll
    for (int which = 0; which < 2; ++which) {
      const bf16_t* src = p.proj + t * PW + (which ? C_MQ : C_MK) + h * 128 + 8 * hh;
      float x0[8], x1[8];
      unpack8(*(const u32x4*)(src), x0); unpack8(*(const u32x4*)(src + 16), x1);
      float y0[8], y1[8];
#pragma unroll
      for (int jj = 0; jj < 8; ++jj) { y0[jj] = x0[jj] * cs[jj] - x1[jj] * sn[jj]; y1[jj] = x1[jj] * cs[jj] + x0[jj] * sn[jj]; }
      u32x4 o[8];
      o[0].x = pk2(y0[0], y0[1]); o[0].y = pk2(y0[2], y0[3]); o[0].z = pk2(y0[4], y0[5]); o[0].w = pk2(y0[6], y0[7]);
      o[1].x = pk2(y1[0], y1[1]); o[1].y = pk2(y1[2], y1[3]); o[1].z = pk2(y1[4], y1[5]); o[1].w = pk2(y1[6], y1[7]);
#pragma unroll
      for (int ks = 2; ks < 8; ++ks) o[ks] = *(const u32x4*)(src + 16 * ks);
      if (which == 0) {
#pragma unroll
        for (int jj = 0; jj < 8; ++jj) { kacc[jj] = y0[jj]; kacc[8 + jj] = y1[jj]; }
#pragma unroll
        for (int ks = 2; ks < 8; ++ks) { float f[8]; unpack8(o[ks], f);
#pragma unroll
          for (int jj = 0; jj < 8; ++jj) kacc[8 * ks + jj] = f[jj]; }
        unsigned char* dst = (unsigned char*)p.Kp + ((size_t)(bh * 128 + 8 * jb + (r >> 5)) * 8192) + ((r & 31) + 32 * hh) * 16;
#pragma unroll
        for (int ks = 0; ks < 8; ++ks) *(u32x4*)(dst + ks * 1024) = o[ks];
      } else {
        bf16_t* dst = p.qb + ((size_t)bh * SEQ + pos) * 128 + 8 * hh;
#pragma unroll
        for (int ks = 0; ks < 8; ++ks) *(u32x4*)(dst + 16 * ks) = o[ks];
      }
    }
#pragma unroll
    for (int e = 0; e < 64; ++e) {
      float v = kacc[e];
      v += __shfl_xor(v, 2, 64); v += __shfl_xor(v, 4, 64); v += __shfl_xor(v, 8, 64); v += __shfl_xor(v, 16, 64); v += __shfl_xor(v, 32, 64);
      kacc[e] = v;
    }
    if (lane < 2) {
#pragma unroll
      for (int e = 0; e < 64; ++e) red[(w * 2 + lane) * 64 + e] = kacc[e];
    }
  }
  __syncthreads();
  if (tid < 128) {
    const int d = tid, hh = (d >> 3) & 1, ks = d >> 4, jj = d & 7;
    float a = 0.f;
#pragma unroll
    for (int ww = 0; ww < 8; ++ww) a += red[(ww * 2 + hh) * 64 + ks * 8 + jj];
    p.kmean[((size_t)bh * 16 + jb) * 128 + d] = a * (1.f / 256.f);
  }
#pragma unroll
  for (int it = 0; it < 8; ++it) {
    const int o = tid + 512 * it, ln = o & 63, frag = o >> 6, tl = frag >> 3, dt = (frag >> 1) & 3, s = frag & 1;
    const int r = ln & 31, hh = ln >> 5, d = 32 * dt + r;
    unsigned short e[8];
#pragma unroll
    for (int jj = 0; jj < 8; ++jj) { const int key = 32 * tl + 16 * s + 8 * (jj >> 2) + 4 * hh + (jj & 3); e[jj] = Vl[key * 128 + d]; }
    u32x4 wv; wv.x = e[0] | ((unsigned)e[1] << 16); wv.y = e[2] | ((unsigned)e[3] << 16); wv.z = e[4] | ((unsigned)e[5] << 16); wv.w = e[6] | ((unsigned)e[7] << 16);
    *(u32x4*)((unsigned char*)p.Vp + ((size_t)(bh * 128 + 8 * jb + tl) * 8192) + (dt * 2 + s) * 1024 + ln * 16) = wv;
  }
}
__device__ __forceinline__ int crow32(int reg, int hh) { return (reg & 3) + 8 * (reg >> 2) + 4 * hh; }
__device__ void moba_item(const Params& p, LAS float* km, LAS float* mrg, LAS float* ml, int bh, int ib, int sub, int par, int lane, int rep) {
  const int q = lane & 31, hh = lane >> 5;
  const int b = bh >> 2, h = bh & 3;
  const int s0 = 256 * ib + 32 * sub;
  const bf16_t* qrow = p.qb + ((size_t)bh * SEQ + s0 + q) * 128 + 8 * hh;
  bf16x8 Qf[8];
#pragma unroll
  for (int ks = 0; ks < 8; ++ks) Qf[ks] = *(const bf16x8*)(qrow + 16 * ks);
  LAS unsigned char* qlds = (LAS unsigned char*)km + 8192 + lane * 16;
#pragma unroll
  for (int ks = 0; ks < 8; ++ks) *(LAS bf16x8*)(qlds + ks * 1024) = Qf[ks];
  unsigned selmask = 0;
  if (ib > 0) {
    for (int idx = lane; idx < ib * 32; idx += 64) ((LAS f32x4*)km)[idx] = ((const f32x4*)(p.kmean + (size_t)bh * 16 * 128))[idx];
    float qf[64];
#pragma unroll
    for (int ks = 0; ks < 8; ++ks) { float f[8]; unpack8(__builtin_bit_cast(u32x4, Qf[ks]), f);
#pragma unroll
      for (int jj = 0; jj < 8; ++jj) qf[8 * ks + jj] = f[jj]; }
    float sc[16];
#pragma unroll
    for (int j = 0; j < 16; ++j) {
      sc[j] = -INFINITY;
      if (j < ib) {
        float a = 0.f;
#pragma unroll
        for (int ks = 0; ks < 8; ++ks) {
          const f32x4 k0 = *(const LAS f32x4*)(km + j * 128 + 16 * ks + 8 * hh), k1 = *(const LAS f32x4*)(km + j * 128 + 16 * ks + 8 * hh + 4);
          a += qf[8 * ks] * k0[0] + qf[8 * ks + 1] * k0[1] + qf[8 * ks + 2] * k0[2] + qf[8 * ks + 3] * k0[3];
          a += qf[8 * ks + 4] * k1[0] + qf[8 * ks + 5] * k1[1] + qf[8 * ks + 6] * k1[2] + qf[8 * ks + 7] * k1[3];
        }
        a += __shfl_xor(a, 32, 64);
        sc[j] = a;
      }
    }
#pragma unroll
    for (int r = 0; r < 3; ++r) {
      if (r < ib) {
        float best = -INFINITY; int bi = 0;
#pragma unroll
        for (int j = 0; j < 16; ++j) if (sc[j] > best) { best = sc[j]; bi = j; }
        selmask |= 1u << bi;
#pragma unroll
        for (int j = 0; j < 16; ++j) if (j == bi) sc[j] = -INFINITY;
      }
    }
  }
  unsigned rem = 0;
  for (int j = 0; j < ib; ++j) if (__ballot((selmask >> j) & 1u) != 0ull) rem |= 1u << j;
  rem = __builtin_amdgcn_readfirstlane(rem);
  const int own0 = 8 * ib, diag = 8 * ib + sub;
  const float cscale = 0.08838834764831845f * 1.4426950408889634f;
  float m = -1e30f, l = 0.f;
  f32x16 O[4];
#pragma unroll
  for (int dt = 0; dt < 4; ++dt)
#pragma unroll
    for (int r = 0; r < 16; ++r) O[dt][r] = 0.f;
  const unsigned char* kbase = (const unsigned char*)p.Kp + (size_t)bh * 128 * 8192 + lane * 16;
  const unsigned char* vbase = (const unsigned char*)p.Vp + (size_t)bh * 128 * 8192 + lane * 16;
  auto adv = [&](int& kt_, unsigned& rem_) {
    if (kt_ < 0) return;
    if (kt_ >= own0 ? (kt_ < diag) : ((kt_ & 7) != 7)) { kt_ = kt_ + 1; return; }
    if (rem_ == 0u) { kt_ = -1; return; }
    kt_ = 8 * (__builtin_ctz(rem_)); rem_ &= rem_ - 1u;
  };
  int kt = own0;
  if (par) adv(kt, rem);
  auto load_k = [&](int t, bf16x8 (&K_)[8]) {
#pragma unroll
    for (int ks = 0; ks < 8; ++ks) K_[ks] = *(const bf16x8*)(kbase + (size_t)t * 8192 + ks * 1024);
  };
  auto tile_step = [&](bf16x8 (&Kc)[8], bf16x8 (&Kn)[8]) -> bool {
    int ktn = kt; unsigned remn = rem;
    adv(ktn, remn); adv(ktn, remn);
    bf16x8 Vf[8];
#pragma unroll
    for (int f = 0; f < 8; ++f) Vf[f] = *(const bf16x8*)(vbase + (size_t)kt * 8192 + f * 1024);
    if (ktn >= 0) load_k(ktn, Kn);
    f32x16 S;
#pragma unroll
    for (int r = 0; r < 16; ++r) S[r] = 0.f;
#pragma unroll
    for (int ks = 0; ks < 8; ++ks) S = MFMA32(Kc[ks], *(const LAS bf16x8*)(qlds + ks * 1024), S);
    const bool allowed = (kt >= own0) || ((selmask >> (kt >> 3)) & 1u);
    const float nb = allowed ? 0.f : -INFINITY;
    float sv[16]; float mx = -INFINITY;
#pragma unroll
    for (int r = 0; r < 16; ++r) sv[r] = __builtin_fmaf(S[r], cscale, nb);
    if (kt == diag) {
#pragma unroll
      for (int r = 0; r < 16; ++r) if (crow32(r, hh) > q) sv[r] = -INFINITY;
    }
#pragma unroll
    for (int r = 0; r < 16; ++r) mx = fmaxf(mx, sv[r]);
    mx = fmaxf(mx, __shfl_xor(mx, 32, 64));
    const bool grow = mx > m + 8.f;
    const float mn = (__ballot(grow) != 0ull) ? fmaxf(m, mx) : m;
    const float alpha = __builtin_amdgcn_exp2f(m - mn);
    float ps = 0.f;
#pragma unroll
    for (int r = 0; r < 16; ++r) { sv[r] = __builtin_amdgcn_exp2f(sv[r] - mn); ps += sv[r]; }
    l = l * alpha + ps; m = mn;
    if (__ballot(alpha != 1.f) != 0ull) {
#pragma unroll
      for (int dt = 0; dt < 4; ++dt)
#pragma unroll
        for (int r = 0; r < 16; ++r) O[dt][r] *= alpha;
    }
    const bf16x8 P0 = pack8(sv[0], sv[1], sv[2], sv[3], sv[4], sv[5], sv[6], sv[7]);
    const bf16x8 P1 = pack8(sv[8], sv[9], sv[10], sv[11], sv[12], sv[13], sv[14], sv[15]);
#pragma unroll
    for (int dt = 0; dt < 4; ++dt) { O[dt] = MFMA32(Vf[dt * 2], P0, O[dt]); O[dt] = MFMA32(Vf[dt * 2 + 1], P1, O[dt]); }
    kt = ktn; rem = remn;
    return kt >= 0;
  };
  if (kt >= 0) {
    bf16x8 KA[8], KB[8];
    load_k(kt, KA);
#pragma unroll 1
    for (;;) {
      if (!tile_step(KA, KB)) break;
      asm volatile("" ::: "memory");
      if (!tile_step(KB, KA)) break;
      asm volatile("" ::: "memory");
    }
  }
  asm volatile("s_waitcnt vmcnt(0) lgkmcnt(0)" ::: "memory");
  if (par) {
    ml[lane] = m; ml[64 + lane] = l;
#pragma unroll
    for (int dt = 0; dt < 4; ++dt)
#pragma unroll
      for (int r = 0; r < 16; ++r) mrg[(dt * 16 + r) * 64 + lane] = O[dt][r];
  }
  __syncthreads();
  if (par == 0) {
    const float m2 = ml[lane], l2 = ml[64 + lane];
    const float mm = fmaxf(m, m2);
    const float a1 = __builtin_amdgcn_exp2f(m - mm), a2 = __builtin_amdgcn_exp2f(m2 - mm);
    l = l * a1 + l2 * a2;
#pragma unroll
    for (int dt = 0; dt < 4; ++dt)
#pragma unroll
      for (int r = 0; r < 16; ++r) O[dt][r] = O[dt][r] * a1 + mrg[(dt * 16 + r) * 64 + lane] * a2;
  }
  if (par == 0) {
  l += __shfl_xor(l, 32, 64);
  const float inv = 1.f / l;
  bf16_t* orow = rep ? p.oab2 + ((size_t)b * SEQ + s0 + q) * 512 + h * 128 : p.mb_out + ((size_t)b * SEQ + s0 + q) * p.mb_out_ld + p.mb_out_off + h * 128;
#pragma unroll
  for (int dt = 0; dt < 4; ++dt)
#pragma unroll
    for (int g4 = 0; g4 < 4; ++g4) {
      u32x2 wv; wv.x = pk2(O[dt][4 * g4] * inv, O[dt][4 * g4 + 1] * inv); wv.y = pk2(O[dt][4 * g4 + 2] * inv, O[dt][4 * g4 + 3] * inv);
      *(u32x2*)(orow + 32 * dt + 8 * g4 + 4 * hh) = wv;
    }
  }
  __syncthreads();
}
__device__ void moba_worker(const Params& p, LAS unsigned char* lds, int qi) {
  const int lane = p.tid & 63, w = __builtin_amdgcn_readfirstlane(p.tid >> 6);
  LAS float* km = (LAS float*)(lds + w * 16384);
  LAS float* mrg = (LAS float*)(lds + ((w & 3) + 4) * 16384);
  LAS float* ml = (LAS float*)(lds + 131072) + (w & 3) * 128;
  LAS int* slot = (LAS int*)(lds + 131072 + 2048);
  const int g0 = (int)((unsigned)__builtin_amdgcn_s_getreg((3 << 11) | 20) & 7u);
  for (int gi = 0; gi < 8; ++gi) {
    const int g = (g0 + gi) & 7;
    for (;;) {
      __syncthreads();
      if (p.tid == 0) slot[0] = atomicAdd(p.wq + qi * 8 + g, 1);
      __syncthreads();
      const int idx = slot[0];
      if (idx >= 64) break;
      const int bh = 2 * g + (idx >> 5), ib = 15 - ((idx >> 1) & 15), quad = 1 - (idx & 1);
      moba_item(p, km, mrg, ml, bh, ib, 4 * quad + (w & 3), w >> 2, lane, qi);
    }
  }
}
__device__ void ph_mod(const Params& p, LAS unsigned char* lds, int nblk, int bid) {
  LAS float* sc = (LAS float*)lds;
  LAS float* part = (LAS float*)(lds + 16384);
  const int tid = p.tid;
  if (bid >= 192) return;
  for (int i = tid; i < 4096; i += 512) sc[i] = siluf_(p.c[i]);
  __syncthreads();
  for (int task = bid; task < 192; task += nblk) {
    const int jj = tid & 31, ks = tid >> 5, j = task * 32 + jj;
    float a0 = 0.f, a1 = 0.f, a2 = 0.f, a3 = 0.f;
#pragma unroll 8
    for (int kk = 0; kk < 64; ++kk) {
      const int k = ks * 64 + kk;
      const float w = p.w_ada[(size_t)k * 6144 + j];
      a0 += sc[k] * w; a1 += sc[1024 + k] * w; a2 += sc[2048 + k] * w; a3 += sc[3072 + k] * w;
    }
    *(LAS f32x4*)(part + (ks * 32 + jj) * 4) = (f32x4){a0, a1, a2, a3};
    __syncthreads();
    if (tid < 128) {
      const int j2 = tid & 31, bb = tid >> 5;
      float a = 0.f;
#pragma unroll
      for (int s = 0; s < 16; ++s) a += part[(s * 32 + j2) * 4 + bb];
      p.mod[bb * 6144 + task * 32 + j2] = a + p.b_ada[task * 32 + j2];
    }
    __syncthreads();
  }
}

#define WT_T0 1424
#define WT_T1 (WT_T0 + 16384)
#define WT_T2 (WT_T1 + 8192)
#define WT_T3 (WT_T2 + 128)
#define WT_T4 (WT_T3 + 128)
#define WT_T5 (WT_T4 + 256)
struct WtTile { const float* src; bf16_t* dst; int K, N, mode, k0, n0; unsigned char* dst8; };
__device__ __forceinline__ WtTile wt_desc(const Params& p, int t) {
  WtTile d;
  if (t < WT_T0) { const int kt = t / 89, nt = t % 89; d = {p.w_in, p.w_in_t, 1024, INW, 1, kt * 64, nt * 64, nullptr}; }
  else if (t < WT_T1) { const int u = t - WT_T0, e = u >> 9, r = u & 511, kt = r >> 5, nt = r & 31; d = {p.w_gu + (size_t)e * 1024 * 2048, nullptr, 1024, 2048, 2, kt * 64, nt * 64, p.wgu8 + (size_t)e * 2048 * 1024}; }
  else if (t < WT_T2) { const int u = t - WT_T1, e = u >> 8, r = u & 255, kt = r >> 4, nt = r & 15; d = {p.w_down + (size_t)e * 1024 * 1024, nullptr, 1024, 1024, 0, kt * 64, nt * 64, p.wd8 + (size_t)e * 1024 * 1024}; }
  else if (t < WT_T3) { const int u = t - WT_T2, kt = u >> 4, nt = u & 15; d = {p.w_br_a, p.wbra_t, 512, 1024, 0, kt * 64, nt * 64, nullptr}; }
  else if (t < WT_T4) { const int u = t - WT_T3, kt = u >> 4, nt = u & 15; d = {p.w_br_b, p.wbrb_t, 512, 1024, 0, kt * 64, nt * 64, nullptr}; }
  else { const int u = t - WT_T4, kt = u >> 4, nt = u & 15; d = {p.w_o, p.wo_t, 1024, 1024, 0, kt * 64, nt * 64, nullptr}; }
  return d;
}
__device__ __forceinline__ void wt_load(const WtTile& d, int tid, f32x4 (&v)[2]) {
#pragma unroll
  for (int it = 0; it < 2; ++it) {
    const int row = (tid >> 4) + 32 * it, n = d.n0 + (tid & 15) * 4;
    v[it] = (f32x4){0.f, 0.f, 0.f, 0.f};
    if (n < d.N) v[it] = __builtin_nontemporal_load((const f32x4*)(d.src + (size_t)(d.k0 + row) * d.N + n));
  }
}
__device__ void ph_wt(const Params& p, LAS unsigned char* lds, int nblk, int bid) {
  LAS float* tile = (LAS float*)(lds + 32768);
  const int tid = p.tid;
  int t = bid;
  if (t >= WT_T5) return;
  WtTile cur = wt_desc(p, t);
  f32x4 v[2]; wt_load(cur, tid, v);
  WtTile nxt = cur; f32x4 vn[2] = {v[0], v[1]};
  if (t + nblk < WT_T5) { nxt = wt_desc(p, t + nblk); wt_load(nxt, tid, vn); }
  for (;;) {
    const int tnn = t + 2 * nblk;
    WtTile nn = nxt; f32x4 vnn[2] = {vn[0], vn[1]};
    if (tnn < WT_T5) { nn = wt_desc(p, tnn); wt_load(nn, tid, vnn); }
#pragma unroll
    for (int it = 0; it < 2; ++it) {
      const int row = (tid >> 4) + 32 * it, c4 = (tid & 15) * 4;
      tile[row * 65 + c4] = v[it][0]; tile[row * 65 + c4 + 1] = v[it][1]; tile[row * 65 + c4 + 2] = v[it][2]; tile[row * 65 + c4 + 3] = v[it][3];
    }
    __syncthreads();
    {
      const int nl = tid >> 3, kc = tid & 7, n = cur.n0 + nl;
      if (n < cur.N) {
        const int dd = map_col(n, cur.mode);
        if (dd >= 0) {
          float f[8];
#pragma unroll
          for (int j = 0; j < 8; ++j) f[j] = tile[(8 * kc + j) * 65 + nl];
          if (cur.dst8) {
            u32x2 w; w.x = pk4_fp8(f[0] * 64.f, f[1] * 64.f, f[2] * 64.f, f[3] * 64.f); w.y = pk4_fp8(f[4] * 64.f, f[5] * 64.f, f[6] * 64.f, f[7] * 64.f);
            *(u32x2*)(cur.dst8 + (size_t)dd * cur.K + cur.k0 + 8 * kc) = w;
          } else {
            u32x4 w; w.x = pk2(f[0], f[1]); w.y = pk2(f[2], f[3]); w.z = pk2(f[4], f[5]); w.w = pk2(f[6], f[7]);
            *(u32x4*)(cur.dst + (size_t)dd * cur.K + cur.k0 + 8 * kc) = w;
          }
        }
      }
    }
    __syncthreads();
    if (t + nblk >= WT_T5) break;
    t += nblk; cur = nxt; v[0] = vn[0]; v[1] = vn[1]; nxt = nn; vn[0] = vnn[0]; vn[1] = vnn[1];
  }
}

__device__ void ph_h(const Params& p, LAS unsigned char* lds, int nblk, int bid) {
  const int wid = p.tid >> 6, lane = p.tid & 63;
  LAS float* wb = (LAS float*)lds;
  for (int i = p.tid; i < 2048; i += 512) {
    const int k = i >> 1, hf = i & 1;
    const f32x4 v = *(const f32x4*)(p.w_in + (size_t)k * INW + 2048 + 4 * hf);
    wb[(4 * hf + 0) * 1024 + k] = v[0]; wb[(4 * hf + 1) * 1024 + k] = v[1]; wb[(4 * hf + 2) * 1024 + k] = v[2]; wb[(4 * hf + 3) * 1024 + k] = v[3];
  }
  __syncthreads();
  f32x4 gv[4];
#pragma unroll
  for (int i = 0; i < 4; ++i) gv[i] = *(const f32x4*)(p.g_pre_mix + i * 256 + lane * 4);
  f32x4 xnx[4];
  if (bid * 8 + wid < T_TOK) {
#pragma unroll
    for (int i = 0; i < 4; ++i) xnx[i] = *(const f32x4*)(p.x + (size_t)(bid * 8 + wid) * DM + i * 256 + lane * 4);
  }
  for (int t = bid * 8 + wid; t < T_TOK; t += nblk * 8) {
    const int b = t / SEQ;
    f32x4 xv[4];
    float ss = 0.f;
#pragma unroll
    for (int i = 0; i < 4; ++i) {
      xv[i] = xnx[i];
      ss += xv[i][0] * xv[i][0] + xv[i][1] * xv[i][1] + xv[i][2] * xv[i][2] + xv[i][3] * xv[i][3];
    }
    if (t + nblk * 8 < T_TOK) {
#pragma unroll
      for (int i = 0; i < 4; ++i) xnx[i] = *(const f32x4*)(p.x + (size_t)(t + nblk * 8) * DM + i * 256 + lane * 4);
    }
    ss = wave_sum(ss);
    const float rstd = rsqrtf(ss * (1.f / DM) + 1e-6f);
    const float* shift = p.mod + b * 6144;
    const float* scale = p.mod + b * 6144 + 1024;
    float acc[8] = {0, 0, 0, 0, 0, 0, 0, 0};
    f32x4 scv[4], shv[4];
#pragma unroll
    for (int i = 0; i < 4; ++i) { scv[i] = *(const f32x4*)(scale + i * 256 + lane * 4); shv[i] = *(const f32x4*)(shift + i * 256 + lane * 4); }
#pragma unroll
    for (int i = 0; i < 4; ++i) {
      const int k = i * 256 + lane * 4;
      const f32x4 g = gv[i], sc = scv[i], sh = shv[i];
      f32x4 hv;
#pragma unroll
      for (int j = 0; j < 4; ++j) hv[j] = xv[i][j] * rstd * g[j] * (1.f + sc[j]) + sh[j];
#pragma unroll
      for (int e = 0; e < 8; ++e) { const f32x4 w = *(const LAS f32x4*)(wb + e * 1024 + k); acc[e] += hv[0] * w[0] + hv[1] * w[1] + hv[2] * w[2] + hv[3] * w[3]; }
      u32x2 pk; pk.x = pk2(hv[0], hv[1]); pk.y = pk2(hv[2], hv[3]);
      *(u32x2*)(p.hbf + (size_t)t * DM + k) = pk;
    }
#pragma unroll
    for (int e = 0; e < 8; ++e) acc[e] = wave_sum(acc[e]);
    if (lane == 0) { *(f32x4*)(p.ba + (size_t)t * 8) = (f32x4){acc[0], acc[1], acc[2], acc[3]}; *(f32x4*)(p.ba + (size_t)t * 8 + 4) = (f32x4){acc[4], acc[5], acc[6], acc[7]}; }
  }
}

#define PM_WT 0
#define PM_H2 66048
#define PM_CNT 132096
#define PM_ENT 132352
__device__ void ph_post_mix(const Params& p, LAS unsigned char* lds, int nblk, int bid, int rep) {
  const int wid = p.tid >> 6, lane = p.tid & 63, r16 = lane & 15, q4 = lane >> 4;
  LAS bf16_t* wT = (LAS bf16_t*)(lds + PM_WT);
  LAS bf16_t* ht = (LAS bf16_t*)(lds + PM_H2) + wid * 4 * 1032;
  LAS int* lcnt = (LAS int*)(lds + PM_CNT);
  LAS int* lbase = lcnt + 32;
  LAS int* lent = (LAS int*)(lds + PM_ENT) + wid * 64;
  int nloc = 0;
  if (p.tid < 32) lcnt[p.tid] = 0;
  for (int i = p.tid; i < 1024 * 8; i += 512) {
    const int k = i >> 3, c = i & 7;
    const f32x4 v = *(const f32x4*)(p.w_router + (size_t)k * 32 + c * 4);
#pragma unroll
    for (int j = 0; j < 4; ++j) wT[(c * 4 + j) * 1032 + k] = f2bf_hw(v[j]);
  }
  __syncthreads();
  const float bias0 = p.b_router[r16], bias1 = p.b_router[16 + r16];
  const int tstride = nblk * 8;
  f32x4 gpv[4], gqv[4];
#pragma unroll
  for (int i4 = 0; i4 < 4; ++i4) { const int k = (i4 >> 1) * 512 + lane * 8 + (i4 & 1) * 4; gpv[i4] = *(const f32x4*)(p.g_post_mix + k); gqv[i4] = *(const f32x4*)(p.g_pre_ffn + k); }
  u32x4 mxn[2]; f32x4 xn[4];
  {
    const int t0 = bid * 8 + wid;
    if (t0 < T_TOK) {
#pragma unroll
      for (int i = 0; i < 2; ++i) mxn[i] = *(const u32x4*)(p.mixer + (size_t)t0 * DM + i * 512 + lane * 8);
#pragma unroll
      for (int i = 0; i < 4; ++i) xn[i] = *(const f32x4*)(p.x + (size_t)t0 * DM + (i >> 1) * 512 + lane * 8 + (i & 1) * 4);
    }
  }
  for (int tg = bid * 8 + wid; tg < T_TOK; tg += 4 * tstride) {
#pragma unroll 1
    for (int jj = 0; jj < 4; ++jj) {
      const int t = tg + jj * tstride;
      if (t >= T_TOK) break;
      const int b = t / SEQ;
      const float* md = p.mod + b * 6144;
      u32x4 mxc[2] = {mxn[0], mxn[1]}; f32x4 xc[4] = {xn[0], xn[1], xn[2], xn[3]};
      {
        const int tn = t + tstride;
        if (tn < T_TOK) {
#pragma unroll
          for (int i = 0; i < 2; ++i) mxn[i] = *(const u32x4*)(p.mixer + (size_t)tn * DM + i * 512 + lane * 8);
#pragma unroll
          for (int i = 0; i < 4; ++i) xn[i] = *(const f32x4*)(p.x + (size_t)tn * DM + (i >> 1) * 512 + lane * 8 + (i & 1) * 4);
        }
      }
      float mv[16];
      float ss = 0.f;
#pragma unroll
      for (int i = 0; i < 2; ++i) {
        float f[8]; unpack8(mxc[i], f);
#pragma unroll
        for (int j = 0; j < 8; ++j) { mv[i * 8 + j] = f[j]; ss += f[j] * f[j]; }
      }
      ss = wave_sum(ss);
      const float rstd = rsqrtf(ss * (1.f / DM) + 1e-6f);
      f32x4 gmv[4], scv[4], sfv[4];
#pragma unroll
      for (int i4 = 0; i4 < 4; ++i4) { const int k = (i4 >> 1) * 512 + lane * 8 + (i4 & 1) * 4; gmv[i4] = *(const f32x4*)(md + 2048 + k); scv[i4] = *(const f32x4*)(md + 4096 + k); sfv[i4] = *(const f32x4*)(md + 3072 + k); }
      float x1[16];
      float s2 = 0.f;
#pragma unroll
      for (int i = 0; i < 2; ++i) {
#pragma unroll
        for (int j4 = 0; j4 < 2; ++j4) {
          const f32x4 xv = xc[i * 2 + j4];
          const f32x4 gm = gmv[i * 2 + j4], gp = gpv[i * 2 + j4];
#pragma unroll
          for (int j = 0; j < 4; ++j) { const float o = xv[j] + gm[j] * (mv[i * 8 + j4 * 4 + j] * rstd * gp[j]); x1[i * 8 + j4 * 4 + j] = o; s2 += o * o; }
        }
        u32x4 xb; xb.x = pk2(x1[i * 8], x1[i * 8 + 1]); xb.y = pk2(x1[i * 8 + 2], x1[i * 8 + 3]); xb.z = pk2(x1[i * 8 + 4], x1[i * 8 + 5]); xb.w = pk2(x1[i * 8 + 6], x1[i * 8 + 7]);
        *(u32x4*)(p.hbf + (size_t)t * DM + i * 512 + lane * 8) = xb;
      }
      s2 = wave_sum(s2);
      const float rstd2 = rsqrtf(s2 * (1.f / DM) + 1e-6f);
#pragma unroll
      for (int i = 0; i < 2; ++i) {
        float hv[8];
#pragma unroll
        for (int j4 = 0; j4 < 2; ++j4) {
          const int k = i * 512 + lane * 8 + j4 * 4;
          const f32x4 gq = gqv[i * 2 + j4], sc = scv[i * 2 + j4], sf = sfv[i * 2 + j4];
#pragma unroll
          for (int j = 0; j < 4; ++j) hv[j4 * 4 + j] = x1[i * 8 + j4 * 4 + j] * rstd2 * gq[j] * (1.f + sc[j]) + sf[j];
        }
        u32x2 w; w.x = pk4_fp8(hv[0], hv[1], hv[2], hv[3]); w.y = pk4_fp8(hv[4], hv[5], hv[6], hv[7]);
        *(u32x2*)(p.h2q + (size_t)t * DM + i * 512 + lane * 8) = w;
        u32x4 hb; hb.x = pk2(hv[0], hv[1]); hb.y = pk2(hv[2], hv[3]); hb.z = pk2(hv[4], hv[5]); hb.w = pk2(hv[6], hv[7]);
        *(LAS u32x4*)(ht + jj * 1032 + i * 512 + lane * 8) = hb;
      }
    }
    f32x4 acc0 = {0.f, 0.f, 0.f, 0.f}, acc1 = {0.f, 0.f, 0.f, 0.f};
#pragma unroll 8
    for (int ks = 0; ks < 32; ++ks) {
      const bf16x8 a = *(const LAS bf16x8*)(ht + (r16 & 3) * 1032 + 32 * ks + 8 * q4);
      const bf16x8 b0 = *(const LAS bf16x8*)(wT + r16 * 1032 + 32 * ks + 8 * q4);
      const bf16x8 b1 = *(const LAS bf16x8*)(wT + (16 + r16) * 1032 + 32 * ks + 8 * q4);
      acc0 = MFMA16(a, b0, acc0); acc1 = MFMA16(a, b1, acc1);
    }
#pragma unroll
    for (int jj = 0; jj < 4; ++jj) {
      const int t = tg + jj * tstride;
      if (t < T_TOK) {
        float l0 = (lane < 16) ? acc0[jj] + bias0 : -INFINITY, l1 = (lane < 16) ? acc1[jj] + bias1 : -INFINITY;
        float tv[4]; int ti[4];
#pragma unroll
        for (int r = 0; r < 4; ++r) {
          const float m = wave_max(fmaxf(l0, l1));
          const unsigned long long b0m = __ballot(l0 == m);
          int idx;
          if (b0m) { idx = __ffsll((long long)b0m) - 1; if (lane == idx) l0 = -INFINITY; }
          else { const unsigned long long b1m = __ballot(l1 == m); idx = __ffsll((long long)b1m) - 1; if (lane == idx) l1 = -INFINITY; idx += 16; }
          tv[r] = m; ti[r] = idx;
        }
        const float e1 = __expf(tv[1] - tv[0]), e2 = __expf(tv[2] - tv[0]), e3 = __expf(tv[3] - tv[0]);
        const float inv = 1.f / (1.f + e1 + e2 + e3);
        if (lane < 4) {
          const int ee = lane == 0 ? ti[0] : lane == 1 ? ti[1] : lane == 2 ? ti[2] : ti[3];
          const float ww = (lane == 0 ? 1.f : lane == 1 ? e1 : lane == 2 ? e2 : e3) * inv;
          p.aw[t * 4 + lane] = ww;
          const int rank = __hip_atomic_fetch_add(&lcnt[ee], 1, __ATOMIC_RELAXED, __HIP_MEMORY_SCOPE_WORKGROUP);
          lent[nloc * 4 + lane] = (ee << 16) | rank;
          lent[nloc * 4 + lane + 2048] = t * 4 + lane;
        }
        ++nloc;
      }
    }
  }
  __syncthreads();
  if (p.tid < 32) lbase[p.tid] = atomicAdd(&p.cnt[p.tid * 64 + 32 * rep], lcnt[p.tid]);
  __syncthreads();
  for (int i = lane; i < nloc * 4; i += 64) {
    const int er = lent[i], a = lent[i + 2048];
    p.elist[(er >> 16) * T_TOK + lbase[er >> 16] + (er & 0xffff)] = a;
  }
}

__device__ void ph_final(const Params& p, int nblk, int bid, int rep) {
  const int wid = p.tid >> 6, lane = p.tid & 63;
  f32x4 gpf[4];
#pragma unroll
  for (int i4 = 0; i4 < 4; ++i4) gpf[i4] = *(const f32x4*)(p.g_post_ffn + (i4 >> 1) * 512 + lane * 8 + (i4 & 1) * 4);
  for (int t0 = bid * 8 + wid; t0 < T_TOK; t0 += nblk * 16) {
    int tt[2] = {t0, t0 + nblk * 8};
    if (tt[1] >= T_TOK) tt[1] = t0;
    float mv[2][16]; float ss[2];
#pragma unroll
    for (int u = 0; u < 2; ++u) {
      const int t = tt[u];
      const f32x4 wv = *(const f32x4*)(p.aw + t * 4);
      ss[u] = 0.f;
#pragma unroll
      for (int i = 0; i < 2; ++i) {
        const bf16_t* y = p.yslot + (size_t)t * 4 * DM + i * 512 + lane * 8;
        float f0[8], f1[8], f2[8], f3[8];
        unpack8(*(const u32x4*)y, f0); unpack8(*(const u32x4*)(y + DM), f1); unpack8(*(const u32x4*)(y + 2 * DM), f2); unpack8(*(const u32x4*)(y + 3 * DM), f3);
#pragma unroll
        for (int j = 0; j < 8; ++j) { const float m = wv[0] * f0[j] + wv[1] * f1[j] + wv[2] * f2[j] + wv[3] * f3[j]; mv[u][i * 8 + j] = m; ss[u] += m * m; }
      }
    }
    u32x4 x1[2][2];
#pragma unroll
    for (int u = 0; u < 2; ++u)
#pragma unroll
      for (int i = 0; i < 2; ++i) x1[u][i] = *(const u32x4*)(p.hbf + (size_t)tt[u] * DM + i * 512 + lane * 8);
    f32x4 gfv[2][4];
#pragma unroll
    for (int u = 0; u < 2; ++u)
#pragma unroll
      for (int i4 = 0; i4 < 4; ++i4) gfv[u][i4] = *(const f32x4*)(p.mod + (tt[u] / SEQ) * 6144 + 5120 + (i4 >> 1) * 512 + lane * 8 + (i4 & 1) * 4);
    ss[0] = wave_sum(ss[0]); ss[1] = wave_sum(ss[1]);
#pragma unroll
    for (int u = 0; u < 2; ++u) {
      const int t = tt[u];
      if (u == 1 && t == t0) break;
      const float rstd = rsqrtf(ss[u] * (1.f / DM) + 1e-6f);
#pragma unroll
      for (int i = 0; i < 2; ++i) {
        float xf[8]; unpack8(x1[u][i], xf);
#pragma unroll
        for (int j4 = 0; j4 < 2; ++j4) {
          const int k = i * 512 + lane * 8 + j4 * 4;
          float* op = p.out + (size_t)t * DM + k;
          const f32x4 gf = gfv[u][i * 2 + j4], gp = gpf[i * 2 + j4];
          f32x4 o;
#pragma unroll
          for (int j = 0; j < 4; ++j) o[j] = xf[j4 * 4 + j] + gf[j] * (mv[u][i * 8 + j4 * 4 + j] * rstd * gp[j]);
          *(f32x4*)(rep ? (float*)p.merged + (size_t)(t & 8191) * DM + k : op) = o;
        }
      }
    }
  }
}

#define XCD_BAR_WORDS 3456
struct KArgs { const void* in[22]; float* out; char* ws; long long never; };
__host__ __device__ inline size_t al(size_t x) { return (x + 255) & ~(size_t)255; }
__host__ __device__ inline void fill_params(Params& p, const KArgs& k) {
  p.x = (const float*)k.in[0]; p.c = (const float*)k.in[1]; p.w_ada = (const float*)k.in[2]; p.b_ada = (const float*)k.in[3];
  p.g_pre_mix = (const float*)k.in[4]; p.g_post_mix = (const float*)k.in[5]; p.g_pre_ffn = (const float*)k.in[6];
  p.g_post_ffn = (const float*)k.in[7]; p.w_in = (const float*)k.in[8]; p.conv_w = (const float*)k.in[9];
  p.a_log = (const float*)k.in[10]; p.dt_bias = (const float*)k.in[11]; p.g_dn_out = (const float*)k.in[12];
  p.w_br_a = (const float*)k.in[13]; p.w_br_b = (const float*)k.in[14]; p.w_o = (const float*)k.in[15];
  p.w_router = (const float*)k.in[16]; p.b_router = (const float*)k.in[17]; p.w_gu = (const float*)k.in[18];
  p.b_gu = (const float*)k.in[19]; p.w_down = (const float*)k.in[20]; p.b_down = (const float*)k.in[21];
  p.out = k.out;
  char* w = k.ws;
  size_t o = 0;
#define take(bytes) (w + (o += al(bytes)) - al(bytes))
  p.mod = (float*)take(4 * 6144 * 4);
  p.cnt = (int*)take(16384);
  p.ba = (float*)take((size_t)T_TOK * 8 * 4);
  p.hbf = (bf16_t*)take((size_t)T_TOK * DM * 2);
  p.proj = (bf16_t*)take((size_t)T_TOK * PW * 2);
  p.w_in_t = (bf16_t*)take((size_t)PW * DM * 2);
  p.wgu8 = (unsigned char*)take((size_t)NE * 2048 * DM);
  p.wd8 = (unsigned char*)take((size_t)NE * 1024 * DM);
  p.h2q = (unsigned char*)take((size_t)T_TOK * DM);
  p.act8 = (unsigned char*)take((size_t)73728 * DM);
  p.wbra_t = (bf16_t*)take((size_t)1024 * 512 * 2);
  p.wbrb_t = (bf16_t*)take((size_t)1024 * 512 * 2);
  p.wo_t = (bf16_t*)take((size_t)1024 * 1024 * 2);
  p.qb = (bf16_t*)take((size_t)T_TOK * 512 * 2);
  p.kb = nullptr;
  p.kmean = (float*)take((size_t)16 * 16 * 128 * 4);
  p.oab = (bf16_t*)take((size_t)T_TOK * DM * 2);
  p.merged = (bf16_t*)take((size_t)T_TOK * DM * 2);
  p.mixer = (bf16_t*)take((size_t)T_TOK * DM * 2);
  p.h2 = nullptr;
  p.elist = (int*)take((size_t)NE * T_TOK * 4);
  p.aw = (float*)take((size_t)T_TOK * 4 * 4);
  p.rowmap = nullptr;
  p.dnA = (unsigned char*)take((size_t)1024 * DN_ABYTES);
  p.dnU = (float*)take((size_t)1024 * DN_UFLOATS * 4);
  p.dnG = (float*)take(4096);
  p.dnS = (unsigned char*)take((size_t)1024 * 8 * 4096);
  p.dnV = (unsigned char*)take((size_t)1024 * 8 * 2048);
  p.oab2 = (bf16_t*)take((size_t)T_TOK * 512 * 2);
  p.dbg = (float*)take(256);
  p.bar = (unsigned*)take(XCD_BAR_WORDS * 4);
  p.dn_out = p.oab; p.dn_out_ld = DM;
  p.Kp = (bf16_t*)take((size_t)16 * 128 * 8192);
  p.Vp = (bf16_t*)take((size_t)16 * 128 * 8192);
  p.wq = p.cnt + 32 * 64;
  p.dep = p.cnt + 2304;
  p.mb_out = p.oab; p.mb_out_ld = DM; p.mb_out_off = 512;
  p.xs = nullptr; p.act = nullptr;
  p.yslot = (bf16_t*)take((size_t)65536 * DM * 2);
  p.nq = p.nk = p.nv = p.no = p.ntmp = p.nbeta = p.ng = nullptr;
#undef take
#undef t2
  p.never = (int)k.never;
}

#define XB_TMO      128
#define XB_XCNT(j)  (256  + 64 * (j))
#define XB_XSUB(j)  (1280 + 64 * (j))
#define XB_XGEN(j)  (2304 + 64 * (j))
#define XB_TOP      3328
#define XB_TOPGEN   3392
#define XB_SPIN_CAP (1u << 18)

__device__ __forceinline__ unsigned xb_ld(unsigned* p)              { return __hip_atomic_load(p, __ATOMIC_RELAXED, __HIP_MEMORY_SCOPE_AGENT); }
__device__ __forceinline__ unsigned xb_add(unsigned* p, unsigned v) { return __hip_atomic_fetch_add(p, v, __ATOMIC_RELAXED, __HIP_MEMORY_SCOPE_AGENT); }
__device__ __forceinline__ unsigned xb_xcc_id() { return (unsigned)__builtin_amdgcn_s_getreg((3 << 11) | 20) & 0xFu; }
#define XB_SPIN(cond, bar) do { unsigned _sp = 0; while (cond) { __builtin_amdgcn_s_sleep(1); \
    if ((++_sp & 255u) == 0u) { if (xb_ld(&(bar)[XB_TMO])) break; if (_sp > XB_SPIN_CAP) { atomicAdd(&(bar)[XB_TMO], 1u); break; } } } } while (0)

struct XcdBarrier {
    unsigned* bar; unsigned x;
    volatile LAS unsigned* st;
};

__device__ __forceinline__ XcdBarrier xcd_barrier_post(unsigned* bar, volatile LAS unsigned* st) {
    XcdBarrier b; b.bar = bar; b.x = xb_xcc_id(); b.st = st;
    if (threadIdx.x == 0) (void)xb_add(&bar[XB_XCNT(b.x)], 1u);
    return b;
}
__device__ __forceinline__ void xcd_barrier_complete(unsigned* bar, unsigned x, unsigned& nloc, unsigned& nx) {
    const unsigned G = gridDim.x * gridDim.y * gridDim.z;
    unsigned sum, cnt, mine, sp = 0u;
    for (;;) {
        sum = 0u; cnt = 0u; mine = 0u;
#pragma unroll
        for (unsigned j = 0; j < 16; ++j) { const unsigned c = xb_ld(&bar[XB_XCNT(j)]); sum += c; cnt += (c > 0u) ? 1u : 0u; mine = (j == x) ? c : mine; }
        if (sum == G) break;
        __builtin_amdgcn_s_sleep(1);
        if ((++sp & 255u) == 0u) { if (xb_ld(&bar[XB_TMO])) break; if (sp > XB_SPIN_CAP) { atomicAdd(&bar[XB_TMO], 1u); break; } }
    }
    nloc = mine > 0u ? mine : 1u; nx = cnt > 0u ? cnt : 1u;
}

__device__ __forceinline__ void xcd_barrier(const XcdBarrier& b, const int tid) {
    asm volatile("s_waitcnt vmcnt(0)" ::: "memory");
    __syncthreads();
    if (tid == 0) {
        unsigned* bar = b.bar;
        __builtin_amdgcn_s_waitcnt(0);
        unsigned nloc = b.st[0], nx = b.st[1];
        if (nloc == 0u) { xcd_barrier_complete(bar, b.x, nloc, nx); b.st[0] = nloc; b.st[1] = nx; }
        const unsigned old = xb_add(&bar[XB_XSUB(b.x)], 1u);
        const unsigned gen = old / nloc;
        if (old + 1u == (gen + 1u) * nloc) {
            __builtin_amdgcn_fence(__ATOMIC_RELEASE, "agent");
            asm volatile("s_waitcnt vmcnt(0)" ::: "memory");
            const unsigned og = xb_add(&bar[XB_TOP], 1u);
            const unsigned tg = og / nx;
            if (og + 1u == (tg + 1u) * nx) xb_add(&bar[XB_TOPGEN], 1u);
            else XB_SPIN(xb_ld(&bar[XB_TOPGEN]) == tg, bar);
            __builtin_amdgcn_fence(__ATOMIC_ACQUIRE, "agent");
            xb_add(&bar[XB_XGEN(b.x)], 1u);
            asm volatile("s_waitcnt vmcnt(0)" ::: "memory");
        } else {
            XB_SPIN(xb_ld(&bar[XB_XGEN(b.x)]) == gen, bar);
            __builtin_amdgcn_fence(__ATOMIC_ACQUIRE, "agent");
            asm volatile("s_waitcnt vmcnt(0)" ::: "memory");
        }
    }
    __syncthreads();
}


__device__ __forceinline__ void load_ka(KArgs& kk) {
#if defined(__HIP_DEVICE_COMPILE__)
  typedef __attribute__((address_space(1))) char* gptr_t;
  typedef const __attribute__((address_space(4))) gptr_t* kptr_t;
  kptr_t kp = (kptr_t)__builtin_amdgcn_kernarg_segment_ptr();
  asm volatile("" : "+s"(kp));
#pragma unroll
  for (int i = 0; i < 22; ++i) kk.in[i] = (const void*)kp[i];
  kk.out = (float*)kp[22];
  kk.ws = (char*)kp[23];
  kk.never = ((const __attribute__((address_space(4))) long long*)kp)[24];
#endif
}
__device__ __forceinline__ void grid_bar(const Params& p, LAS unsigned char* lds);
#define MEGA_LDS 148480
#define MEGA_LDS_ALLOC (MEGA_LDS + 16)
__device__ __forceinline__ void grid_bar(const Params& p, LAS unsigned char* lds) {
  XcdBarrier b; b.bar = p.bar; b.x = xb_xcc_id(); b.st = (volatile LAS unsigned*)(lds + MEGA_LDS);
  xcd_barrier(b, p.tid);
}
__global__ __launch_bounds__(512) void mega(KArgs ka) {
  extern __shared__ __attribute__((aligned(16))) unsigned char shm[];
  LAS unsigned char* lds = (LAS unsigned char*)shm;
  cg::grid_group grid = cg::this_grid();
  const int nblk = gridDim.x, bid = blockIdx.x;
  const int wv_ = __builtin_amdgcn_readfirstlane(threadIdx.x >> 6);
  volatile LAS unsigned* xst = (volatile LAS unsigned*)(lds + MEGA_LDS);
  if (threadIdx.x == 0) { xst[0] = 0u; xst[1] = 0u; xst[2] = 0u; xst[3] = 0u; }
  __syncthreads();
  { Params p0; fill_params(p0, ka); (void)xcd_barrier_post(p0.bar, xst); }
  if (ka.never) grid.sync();
#ifndef REPMASK
#define REPMASK 0
#endif
#define LOADKA KArgs kk; load_ka(kk)
#ifndef PHMASK
#define PHMASK 0xffff
#endif
#define PHASE_(k, body, bar) if (((PHMASK) >> (k)) & 1) for (int rep_ = 0; rep_ < (((REPMASK) >> (k)) & 1) + 1; ++rep_) { \
    LOADKA; Params p; fill_params(p, kk); { int t_; asm volatile("v_mbcnt_lo_u32_b32 %0, -1, 0\n\tv_mbcnt_hi_u32_b32 %0, -1, %0" : "=v"(t_)); p.tid = (wv_ << 6) | t_; } body; bar; }
#define PHASE(k, body) PHASE_(k, body, grid_bar(p, lds))
#define PHASE_LAST(k, body) PHASE_(k, body, (void)0)
#ifdef XBAR
  for (int xb_ = 0; xb_ < XBAR; ++xb_) { PHASE(15, {}) }
#endif
  PHASE(0, { ph_mod(p, lds, nblk, bid); ph_wt(p, lds, nblk, bid); })
  PHASE(1, { ph_h(p, lds, nblk, bid); })
  PHASE(2, { ph_proj(p, lds, nblk, bid); })
  PHASE(3, { bool first = true; for (int ci = bid; ci < 1024; ci += nblk) { dn_prep_chunk(p, lds, ci, first); first = false; }
             for (int item = bid; item < 256; item += nblk) moba_prep_block(p, lds, item); })
  PHASE(4, { if (bid < 32) dn_scan_blk(p, lds, bid); moba_worker(p, lds, rep_); })
  PHASE(5, { ph_dn_out(p, lds, nblk, bid); })
  PHASE(6, { ph_br(p, lds, nblk, bid); })
  PHASE(7, { ph_mix(p, lds, nblk, bid); })
  PHASE(8, { ph_post_mix(p, lds, nblk, bid, rep_); })
  PHASE(10, { ph_moe1(p, lds, nblk, bid); ph_moe2(p, lds, nblk, bid); })
  PHASE_LAST(12, { ph_final(p, nblk, bid, rep_); })
}


extern "C" void kernel_launch(void* const* d_in, const int* in_sizes, int n_in, void* d_out, int out_size, void* d_ws,
                              size_t ws_size, hipStream_t stream) {
  KArgs ka{};
  for (int i = 0; i < 22; ++i) ka.in[i] = d_in[i];
  ka.out = (float*)d_out; ka.ws = (char*)d_ws; ka.never = 0;
  Params p{};
  fill_params(p, ka);
  static int grid_blocks = 0;
  if (!grid_blocks) {
    (void)hipFuncSetAttribute((const void*)mega, hipFuncAttributeMaxDynamicSharedMemorySize, MEGA_LDS_ALLOC);
    int dev = 0, cus = 0, per_cu = 0;
    (void)hipGetDevice(&dev);
    (void)hipDeviceGetAttribute(&cus, hipDeviceAttributeMultiprocessorCount, dev);
    (void)hipOccupancyMaxActiveBlocksPerMultiprocessor(&per_cu, mega, 512, MEGA_LDS_ALLOC);
    if (per_cu != 1) per_cu = 1;
    grid_blocks = cus * per_cu;
  }
  (void)hipMemsetAsync(p.cnt, 0, 16384, stream);
  (void)hipMemsetAsync(p.bar, 0, XCD_BAR_WORDS * 4, stream);
  void* args[] = {&ka};
  hipError_t e = hipLaunchCooperativeKernel((void*)mega, dim3(grid_blocks), dim3(512), args, MEGA_LDS_ALLOC, stream);
  if (e != hipSuccess) fprintf(stderr, "cooperative launch failed: %s (grid %d)\n", hipGetErrorString(e), grid_blocks);
}
```

```cpp
#include <hip/hip_runtime.h>
#include <hip/hip_cooperative_groups.h>
#include <cstdio>
namespace cg = cooperative_groups;
#include <stdint.h>

typedef unsigned short bf16_t;
#ifndef MB_ABL
#define MB_ABL 0
#endif

#define T_TOK 16384
#define SEQ 4096
#define NB 4
#define DM 1024
#define INW 5640
#define PW 5632
#define C_QA 0
#define C_KA 512
#define C_VA 1024
#define C_Z 1536
#define C_MQ 2048
#define C_MK 2560
#define C_MV 3072
#define C_GA 3584
#define C_GB 4608
#define NE 32

__device__ __forceinline__ bf16_t f2bf(float f) {
  unsigned u = __float_as_uint(f);
  u += 0x7fffu + ((u >> 16) & 1u);
  return (bf16_t)(u >> 16);
}
__device__ __forceinline__ float bf2f(bf16_t h) { return __uint_as_float(((unsigned)h) << 16); }
__device__ __forceinline__ float sigmoidf_(float x) { return __builtin_amdgcn_rcpf(1.f + __builtin_amdgcn_exp2f(-1.4426950408889634f * x)); }
__device__ __forceinline__ float siluf_(float x) { return x * sigmoidf_(x); }
__device__ __forceinline__ float wave_sum(float v) {
#pragma unroll
  for (int o = 32; o > 0; o >>= 1) v += __shfl_xor(v, o, 64);
  return v;
}
__device__ __forceinline__ float wave_max(float v) {
#pragma unroll
  for (int o = 32; o > 0; o >>= 1) v = fmaxf(v, __shfl_xor(v, o, 64));
  return v;
}

typedef unsigned u32x2 __attribute__((ext_vector_type(2)));
typedef __bf16 bf16x2_t __attribute__((ext_vector_type(2)));
typedef float f32x2_t __attribute__((ext_vector_type(2)));
__device__ __forceinline__ unsigned pk2(float a, float b) { f32x2_t v = {a, b}; bf16x2_t r = __builtin_convertvector(v, bf16x2_t); return __builtin_bit_cast(unsigned, r); }

__device__ __forceinline__ unsigned pk4_fp8(float a, float b, float c, float d) {
  int w = 0;
  w = __builtin_amdgcn_cvt_pk_fp8_f32(a, b, w, false);
  w = __builtin_amdgcn_cvt_pk_fp8_f32(c, d, w, true);
  return (unsigned)w;
}
__device__ __forceinline__ void unpack8_fp8(const u32x2 w, float (&f)[8]) {
  const f32x2_t a = __builtin_amdgcn_cvt_pk_f32_fp8((int)w.x, false), b = __builtin_amdgcn_cvt_pk_f32_fp8((int)w.x, true);
  const f32x2_t c = __builtin_amdgcn_cvt_pk_f32_fp8((int)w.y, false), d = __builtin_amdgcn_cvt_pk_f32_fp8((int)w.y, true);
  f[0] = a[0]; f[1] = a[1]; f[2] = b[0]; f[3] = b[1]; f[4] = c[0]; f[5] = c[1]; f[6] = d[0]; f[7] = d[1];
}

struct Params {
  const float *x, *c, *w_ada, *b_ada, *g_pre_mix, *g_post_mix, *g_pre_ffn, *g_post_ffn, *w_in, *conv_w,
      *a_log, *dt_bias, *g_dn_out, *w_br_a, *w_br_b, *w_o, *w_router, *b_router, *w_gu, *b_gu, *w_down, *b_down;
  float* out;
  float* mod;
  int* cnt;
  int* dep;
  float* ba;
  bf16_t* hbf;
  bf16_t* proj;
  bf16_t* w_in_t;
  unsigned char* wgu8;
  unsigned char* wd8;
  unsigned char* h2q;
  unsigned char* act8;
  bf16_t* wbra_t;
  bf16_t* wbrb_t;
  bf16_t* wo_t;
  bf16_t* qb;
  bf16_t* kb;
  float* kmean;
  bf16_t* oab;
  bf16_t* merged;
  bf16_t* mixer;
  bf16_t* h2;
  int* elist;
  float* aw;
  bf16_t* act;
  bf16_t* xs;
  int* rowmap;
  bf16_t* yslot;
  unsigned char* dnA; float* dnU; float* dnG;
  unsigned char* dnS; unsigned char* dnV;
  bf16_t* dn_out; int dn_out_ld;
  bf16_t* oab2; float* dbg;
  unsigned* bar; int never; int tid;
  bf16_t* Kp; bf16_t* Vp; int* wq;
  bf16_t* mb_out; int mb_out_ld; int mb_out_off;
  float* nq; float* nk; float* nv;
  float* nbeta; float* ng;
  float* no;
  float* ntmp;
};

__device__ __forceinline__ int map_col(int n, int mode) {
  if (mode == 0) return n;
  if (mode == 1) return n < 2048 ? n : (n < 2056 ? -1 : n - 8);
  if (n < 1024) return (n >> 7) * 256 + (n & 127);
  int j = n - 1024;
  return (j >> 7) * 256 + 128 + (j & 127);
}
namespace pg8 {
#define PG8_LAS __attribute__((address_space(3)))
typedef short bf16x8 __attribute__((ext_vector_type(8)));
typedef float f32x4 __attribute__((ext_vector_type(4)));
typedef unsigned u32x4 __attribute__((ext_vector_type(4)));
constexpr int BM = 256, BK = 64, HALF = 128, HTB = HALF * BK * 2, STAGE_BYTES = 8 * HTB, NXCD = 8, WGM = 8;

__host__ __device__ __forceinline__ int lds_byte(int r, int c) { const int st = (r >> 4) * 2 + (c >> 5), rr = r & 15, cc = c & 31, ob = rr * 64 + cc * 2; return st * 1024 + (ob ^ (((ob >> 9) & 1) << 5)); }
__host__ __device__ __forceinline__ void stage_rc(int b, int& R, int& C) { const int st = b / 1024, sb = b % 1024, swz = sb ^ (((sb >> 9) & 1) << 5); R = (st >> 1) * 16 + swz / 64; C = (st & 1) * 32 + (swz % 64) / 2; }
__host__ __device__ __forceinline__ int perm32(int rho) { const int n = rho >> 4, i = rho & 15; return 8 * (i >> 2) + 4 * n + (i & 3); }

struct Unit { int pm, pn, z; };
__device__ __forceinline__ unsigned cvt_pk_bf16(float lo, float hi) { unsigned r; asm volatile("v_cvt_pk_bf16_f32 %0, %1, %2" : "=v"(r) : "v"(lo), "v"(hi)); return r; }

typedef int i32x8 __attribute__((ext_vector_type(8)));
typedef int i32x4 __attribute__((ext_vector_type(4)));
__device__ __forceinline__ i32x8 cat8(const bf16x8 lo, const bf16x8 hi) { const i32x4 a = __builtin_bit_cast(i32x4, lo), b = __builtin_bit_cast(i32x4, hi); return __builtin_shufflevector(a, b, 0, 1, 2, 3, 4, 5, 6, 7); }
struct TileOrder {
    int nM, nN, nwg, G, c;
    __device__ void init(int nM_, int nN_, int G_, int c_) { nM = nM_; nN = nN_; nwg = nM * nN; G = G_; c = c_; }
    __device__ bool tile(int i, int& pm, int& pn) const {
        const long L = (long)i * G + c; if (L >= nwg) return false;
        int wgid = (int)L; { const int q = nwg / NXCD, r = nwg % NXCD, xcd = wgid % NXCD, off = wgid / NXCD; wgid = (xcd < r ? xcd * (q + 1) : r * (q + 1) + (xcd - r) * q) + off; }
        const int nig = WGM * nN, gid = wgid / nig, fm = gid * WGM, gsz = (nM - fm) < WGM ? (nM - fm) : WGM;
        pm = fm + ((wgid % nig) % gsz); pn = (wgid % nig) / gsz; return true;
    }
};

template <class Epi, class Sched, bool FP8 = false>
__device__ __forceinline__ void gemm_phase(PG8_LAS unsigned char* lds, const int tid, const int lda, const int ldb, const int K, const Sched& S, const Epi& E) {
    const int wid = __builtin_amdgcn_readfirstlane(tid >> 6), lane = tid & 63, wr = wid >> 2, wc = wid & 3, fr = lane & 15, fq = lane >> 4;
    const int nt = K / BK;
    unsigned voffA[2], voffB[2];
#pragma unroll
    for (int i = 0; i < 2; ++i) { int R, C; stage_rc(tid * 16 + i * 8192, R, C); const int Rb = Epi::PERM ? ((R & ~31) + perm32(R & 31)) : R;
        voffA[i] = (unsigned)(R * lda + C) * 2u; voffB[i] = (unsigned)(Rb * ldb + C) * 2u; }
    const size_t kstep = (size_t)(BK * 2);
    const size_t hstepA = (size_t)HALF * lda * 2, hstepB = (size_t)HALF * ldb * 2;
    const unsigned ldsw = (unsigned)wid * 1024u;
    const int aoff = lds_byte(wr * 64 + fr, fq * 8), boff = lds_byte(wc * 32 + fr, fq * 8);
    constexpr int KOFF1 = 1024;
    unsigned gA[2][2] = {{0u, 0u}, {0u, 0u}}, gAn[2][2] = {{0u, 0u}, {0u, 0u}};
#define PG8_GOFFS(dst, unit) do { int t_ = tid; asm volatile("" : "+v"(t_)); _Pragma("unroll") for (int i_ = 0; i_ < 2; ++i_) { int gR_, gC_; stage_rc(t_ * 16 + i_ * 8192, gR_, gC_); \
        _Pragma("unroll") for (int h_ = 0; h_ < 2; ++h_) dst[h_][i_] = S.a_goff(unit, gR_ + 128 * h_, gC_); } } while (0)
#define PG8_SA(b, h) (((b) * 2 + (h)) * HTB)
#define PG8_SB(b, h) ((4 + (b) * 2 + (h)) * HTB)
#define PG8_STAGE(bufoff, gbase, voff) do { _Pragma("unroll") for (int _i = 0; _i < 2; ++_i) \
        __builtin_amdgcn_global_load_lds((const unsigned*)((const char*)(gbase) + (voff)[_i]), (PG8_LAS unsigned*)(lds + (bufoff) + ldsw + _i * 8192), 16, 0, 0); } while (0)
#define PG8_STAGEA(bufoff, ptr, h, nx) do { if constexpr (Sched::GATHER) { const unsigned gs_[2] = {(nx) ? gAn[h][0] : gA[h][0], (nx) ? gAn[h][1] : gA[h][1]}; PG8_STAGE(bufoff, ptr, gs_); } \
        else { PG8_STAGE(bufoff, (ptr) + (h) * hstepA, voffA); } } while (0)
#define PG8_LDA(dst, b, h) do { if constexpr (FP8) { _Pragma("unroll") for (int m = 0; m < 4; ++m) dst##8[m] = cat8(*(const PG8_LAS bf16x8*)(lds + PG8_SA(b, h) + aoff + m * 2048), *(const PG8_LAS bf16x8*)(lds + PG8_SA(b, h) + aoff + KOFF1 + m * 2048)); } \
        else { _Pragma("unroll") for (int m = 0; m < 4; ++m) _Pragma("unroll") for (int k = 0; k < 2; ++k) dst[m][k] = *(const PG8_LAS bf16x8*)(lds + PG8_SA(b, h) + aoff + k * KOFF1 + m * 2048); } } while (0)
#define PG8_LDB(dst, b, h) do { if constexpr (FP8) { _Pragma("unroll") for (int n = 0; n < 2; ++n) dst##8[n] = cat8(*(const PG8_LAS bf16x8*)(lds + PG8_SB(b, h) + boff + n * 2048), *(const PG8_LAS bf16x8*)(lds + PG8_SB(b, h) + boff + KOFF1 + n * 2048)); } \
        else { _Pragma("unroll") for (int n = 0; n < 2; ++n) _Pragma("unroll") for (int k = 0; k < 2; ++k) dst[n][k] = *(const PG8_LAS bf16x8*)(lds + PG8_SB(b, h) + boff + k * KOFF1 + n * 2048); } } while (0)
#define PG8_MMA(ai, bj, At, Bt) do { __builtin_amdgcn_s_setprio(1); if constexpr (FP8) { _Pragma("unroll") for (int m = 0; m < 4; ++m) _Pragma("unroll") for (int n = 0; n < 2; ++n) \
        asm volatile("v_mfma_f32_16x16x128_f8f6f4 %0, %1, %2, %0" : "+v"(acc[ai][bj][m][n]) : "v"(Bt##8[n]), "v"(At##8[m])); } \
        else { _Pragma("unroll") for (int m = 0; m < 4; ++m) _Pragma("unroll") for (int n = 0; n < 2; ++n) _Pragma("unroll") for (int k = 0; k < 2; ++k) \
        acc[ai][bj][m][n] = __builtin_amdgcn_mfma_f32_16x16x32_bf16(Bt[n][k], At[m][k], acc[ai][bj][m][n], 0, 0, 0); } __builtin_amdgcn_s_setprio(0); } while (0)
#define PG8_WAIT_V(n) asm volatile("s_waitcnt vmcnt(" #n ")" ::: "memory")
#define PG8_WAIT_L(n) asm volatile("s_waitcnt lgkmcnt(" #n ")" ::: "memory")
#define PG8_BAR __builtin_amdgcn_s_barrier()
#define PG8_SCHED __builtin_amdgcn_sched_barrier(0)
    Unit cur, nxt; int ui = 0;
    if (!S.next(0, cur)) return;
    f32x4 acc[2][2][4][2];
#pragma unroll
    for (int a = 0; a < 2; ++a)
#pragma unroll
        for (int b = 0; b < 2; ++b)
#pragma unroll
            for (int m = 0; m < 4; ++m)
#pragma unroll
                for (int n = 0; n < 2; ++n) acc[a][b][m][n] = (f32x4){0.f, 0.f, 0.f, 0.f};
    bf16x8 At[4][2], B0[2][2], B1[2][2];
    i32x8 At8[4], B08[2], B18[2];
    const char* cA = S.a_ptr(cur); const char* cB = S.b_ptr(cur);
    if constexpr (Sched::GATHER) { PG8_GOFFS(gA, cur); }
    PG8_STAGE(PG8_SB(0, 0), cB, voffB); PG8_STAGEA(PG8_SA(0, 0), cA, 0, false); PG8_STAGE(PG8_SB(0, 1), cB + hstepB, voffB); PG8_STAGEA(PG8_SA(0, 1), cA, 1, false);
    if (wr == 1) PG8_BAR;
    PG8_WAIT_V(4); PG8_BAR;
    PG8_STAGE(PG8_SB(1, 0), cB + kstep, voffB); PG8_STAGEA(PG8_SA(1, 0), cA + kstep, 0, false); PG8_STAGE(PG8_SB(1, 1), cB + hstepB + kstep, voffB);
    PG8_WAIT_V(6); PG8_BAR;
    for (;;) {
        const bool has_next = S.next(ui + 1, nxt);
        const char* nA = has_next ? S.a_ptr(nxt) : cA; const char* nB = has_next ? S.b_ptr(nxt) : cB;
        if constexpr (Sched::GATHER) { if (has_next) { PG8_GOFFS(gAn, nxt); } else {
_Pragma("unroll") for (int h = 0; h < 2; ++h) _Pragma("unroll") for (int i = 0; i < 2; ++i) gAn[h][i] = gA[h][i]; } }
_Pragma("unroll 1")
        for (int t = 0; t < nt; t += 2) {
            const bool last = (t == nt - 2);
            const char* a1 = cA + (size_t)(t + 1) * kstep;
            const char* a2 = last ? nA : cA + (size_t)(t + 2) * kstep; const char* b2 = last ? nB : cB + (size_t)(t + 2) * kstep;
            const char* a3 = a2 + kstep; const char* b3 = b2 + kstep;
            PG8_LDB(B0, 0, 0); PG8_SCHED; PG8_LDA(At, 0, 0); PG8_STAGEA(PG8_SA(1, 1), a1, 1, false);
            PG8_WAIT_L(8); PG8_BAR; PG8_WAIT_L(0); PG8_MMA(0, 0, At, B0); PG8_BAR; PG8_SCHED;
            PG8_LDB(B1, 0, 1); PG8_STAGE(PG8_SB(0, 0), b2, voffB);
            PG8_BAR; PG8_WAIT_L(0); PG8_MMA(0, 1, At, B1); PG8_BAR;
            PG8_LDA(At, 0, 1); PG8_STAGEA(PG8_SA(0, 0), a2, 0, last);
            PG8_BAR; PG8_WAIT_L(0); PG8_MMA(1, 0, At, B0); PG8_BAR; PG8_SCHED;
            PG8_STAGE(PG8_SB(0, 1), b2 + hstepB, voffB);
            PG8_WAIT_V(6); PG8_BAR; PG8_MMA(1, 1, At, B1); PG8_BAR;
            PG8_LDB(B0, 1, 0); PG8_SCHED; PG8_LDA(At, 1, 0); PG8_STAGEA(PG8_SA(0, 1), a2, 1, last);
            PG8_WAIT_L(8); PG8_BAR; PG8_WAIT_L(0); PG8_MMA(0, 0, At, B0); PG8_BAR; PG8_SCHED;
            PG8_LDB(B1, 1, 1); PG8_STAGE(PG8_SB(1, 0), b3, voffB);
            PG8_BAR; PG8_WAIT_L(0); PG8_MMA(0, 1, At, B1); PG8_BAR;
            PG8_LDA(At, 1, 1); PG8_STAGEA(PG8_SA(1, 0), a3, 0, last);
            PG8_BAR; PG8_WAIT_L(0); PG8_MMA(1, 0, At, B0); PG8_BAR; PG8_SCHED;
            PG8_STAGE(PG8_SB(1, 1), b3 + hstepB, voffB);
            PG8_WAIT_V(6); PG8_BAR; PG8_MMA(1, 1, At, B1); PG8_BAR;
        }
        { if constexpr (FP8) asm volatile("s_nop 15\n\ts_nop 3" ::: "memory");
          int t_ = tid; asm volatile("" : "+v"(t_));
          E(acc, cur, wr, wc, t_ & 15, (t_ & 63) >> 4);
          if constexpr (Sched::PUBLISH) { asm volatile("s_waitcnt vmcnt(0)" ::: "memory"); PG8_BAR; if (t_ == 256) S.publish(cur); } }
        if (!has_next) break;
#pragma unroll
        for (int a = 0; a < 2; ++a)
#pragma unroll
            for (int b = 0; b < 2; ++b)
#pragma unroll
                for (int m = 0; m < 4; ++m)
#pragma unroll
                    for (int n = 0; n < 2; ++n) acc[a][b][m][n] = (f32x4){0.f, 0.f, 0.f, 0.f};
        cur = nxt; cA = nA; cB = nB; ++ui;
        if constexpr (Sched::GATHER) {
_Pragma("unroll") for (int h = 0; h < 2; ++h) _Pragma("unroll") for (int i = 0; i < 2; ++i) gA[h][i] = gAn[h][i]; }
    }
    PG8_WAIT_V(0);
    if (wr == 0) PG8_BAR;
    PG8_BAR;
#undef PG8_SA
#undef PG8_SB
#undef PG8_STAGE
#undef PG8_STAGEA
#undef PG8_GOFFS
#undef PG8_LDA
#undef PG8_LDB
#undef PG8_MMA
#undef PG8_WAIT_V
#undef PG8_WAIT_L
#undef PG8_BAR
#undef PG8_SCHED
}
}
using pg8::f32x4; using pg8::u32x4; using pg8::Unit;

#define GEMM_LDS (pg8::STAGE_BYTES + 1024)

struct SchedProj : pg8::TileOrder {
  static constexpr bool GATHER = false; static constexpr bool PUBLISH = false;
  const char* A; const char* B;
  __device__ bool next(int i, Unit& u) const { u.z = 0; return tile(i, u.pm, u.pn); }
  __device__ const char* a_ptr(const Unit& u) const { return A + (size_t)u.pm * 256 * DM * 2; }
  __device__ const char* b_ptr(const Unit& u) const { return B + (size_t)u.pn * 256 * DM * 2; }
};
struct EpiProj {
  static constexpr bool PERM = true;
  bf16_t* O;
  __device__ __forceinline__ void operator()(const f32x4 (&acc)[2][2][4][2], const Unit& u, int wr, int wc, int fr, int fq) const {
    const int row0 = u.pm * 256 + wr * 64 + fr, col0 = u.pn * 256 + wc * 32 + 8 * fq;
    const bool gate = u.pn >= (C_GA / 256);
#pragma unroll
    for (int ai = 0; ai < 2; ++ai)
#pragma unroll
      for (int m = 0; m < 4; ++m) {
        bf16_t* rowp = O + (size_t)(row0 + ai * 128 + m * 16) * PW + col0;
#pragma unroll
        for (int bj = 0; bj < 2; ++bj) {
          f32x4 v0 = acc[ai][bj][m][0], v1 = acc[ai][bj][m][1];
          if (gate) {
#pragma unroll
            for (int j = 0; j < 4; ++j) { v0[j] = sigmoidf_(v0[j]); v1[j] = sigmoidf_(v1[j]); }
          }
          u32x4 w; w.x = pg8::cvt_pk_bf16(v0[0], v0[1]); w.y = pg8::cvt_pk_bf16(v0[2], v0[3]); w.z = pg8::cvt_pk_bf16(v1[0], v1[1]); w.w = pg8::cvt_pk_bf16(v1[2], v1[3]);
          *(u32x4*)(rowp + bj * 128) = w;
        }
      }
  }
};
__device__ void ph_proj(const Params& p, PG8_LAS unsigned char* lds, int nblk, int bid) {
  SchedProj S; S.init(T_TOK / 256, PW / 256, nblk, bid); S.A = (const char*)p.hbf; S.B = (const char*)p.w_in_t;
  EpiProj E{p.proj};
  pg8::gemm_phase(lds, p.tid, DM, DM, DM, S, E);
}

struct SchedBr : pg8::TileOrder {
  static constexpr bool GATHER = false; static constexpr bool PUBLISH = false;
  const char* A; const char* Ba; const char* Bb;
  __device__ bool next(int i, Unit& u) const { u.z = i & 1; return tile(i >> 1, u.pm, u.pn); }
  __device__ const char* a_ptr(const Unit& u) const { return A + (size_t)u.pm * 256 * DM * 2 + u.z * 512 * 2; }
  __device__ const char* b_ptr(const Unit& u) const { return (u.z ? Bb : Ba) + (size_t)u.pn * 256 * 512 * 2; }
};
__device__ __forceinline__ void unpack8(const u32x4 w, float (&f)[8]) {
  f[0] = __uint_as_float(w.x << 16); f[1] = __uint_as_float(w.x & 0xffff0000u); f[2] = __uint_as_float(w.y << 16); f[3] = __uint_as_float(w.y & 0xffff0000u);
  f[4] = __uint_as_float(w.z << 16); f[5] = __uint_as_float(w.z & 0xffff0000u); f[6] = __uint_as_float(w.w << 16); f[7] = __uint_as_float(w.w & 0xffff0000u);
}
struct EpiBr {
  static constexpr bool PERM = true;
  const bf16_t* proj; bf16_t* O;
  __device__ __forceinline__ void operator()(const f32x4 (&acc)[2][2][4][2], const Unit& u, int wr, int wc, int fr, int fq) const {
    const int row0 = u.pm * 256 + wr * 64 + fr, col0 = u.pn * 256 + wc * 32 + 8 * fq;
    const int gcol = (u.z ? C_GB : C_GA) + col0;
#pragma unroll
    for (int ai = 0; ai < 2; ++ai) {
      u32x4 gv[4][2], pv[4][2];
#pragma unroll
      for (int m = 0; m < 4; ++m)
#pragma unroll
        for (int bj = 0; bj < 2; ++bj) {
          const size_t row = (size_t)(row0 + ai * 128 + m * 16);
          gv[m][bj] = *(const u32x4*)(proj + row * PW + gcol + bj * 128);
          pv[m][bj] = (u32x4){0u, 0u, 0u, 0u};
          if (u.z) pv[m][bj] = *(const u32x4*)(O + row * DM + col0 + bj * 128);
        }
#pragma unroll
      for (int m = 0; m < 4; ++m)
#pragma unroll
        for (int bj = 0; bj < 2; ++bj) {
          const size_t row = (size_t)(row0 + ai * 128 + m * 16);
          float g[8], pf[8]; unpack8(gv[m][bj], g); unpack8(pv[m][bj], pf);
          const f32x4 v0 = acc[ai][bj][m][0], v1 = acc[ai][bj][m][1];
          float r[8];
#pragma unroll
          for (int j = 0; j < 4; ++j) { r[j] = v0[j] * g[j] + pf[j]; r[4 + j] = v1[j] * g[4 + j] + pf[4 + j]; }
          u32x4 w; w.x = pk2(r[0], r[1]); w.y = pk2(r[2], r[3]); w.z = pk2(r[4], r[5]); w.w = pk2(r[6], r[7]);
          *(u32x4*)(O + row * DM + col0 + bj * 128) = w;
        }
    }
  }
};
__device__ void ph_br(const Params& p, PG8_LAS unsigned char* lds, int nblk, int bid) {
  SchedBr S; S.init(T_TOK / 256, DM / 256, nblk, bid); S.A = (const char*)p.oab; S.Ba = (const char*)p.wbra_t; S.Bb = (const char*)p.wbrb_t;
  EpiBr E{p.proj, p.merged};
  pg8::gemm_phase(lds, p.tid, DM, 512, 512, S, E);
}

struct SchedMix : pg8::TileOrder {
  static constexpr bool GATHER = false; static constexpr bool PUBLISH = false;
  const char* A; const char* B;
  __device__ bool next(int i, Unit& u) const { u.z = 0; return tile(i, u.pm, u.pn); }
  __device__ const char* a_ptr(const Unit& u) const { return A + (size_t)u.pm * 256 * DM * 2; }
  __device__ const char* b_ptr(const Unit& u) const { return B + (size_t)u.pn * 256 * DM * 2; }
};
struct EpiMix {
  static constexpr bool PERM = true;
  bf16_t* O;
  __device__ __forceinline__ void operator()(const f32x4 (&acc)[2][2][4][2], const Unit& u, int wr, int wc, int fr, int fq) const {
    const int row0 = u.pm * 256 + wr * 64 + fr, col0 = u.pn * 256 + wc * 32 + 8 * fq;
#pragma unroll
    for (int ai = 0; ai < 2; ++ai)
#pragma unroll
      for (int m = 0; m < 4; ++m) {
        bf16_t* rowp = O + (size_t)(row0 + ai * 128 + m * 16) * DM + col0;
#pragma unroll
        for (int bj = 0; bj < 2; ++bj) {
          const f32x4 v0 = acc[ai][bj][m][0], v1 = acc[ai][bj][m][1];
          u32x4 w; w.x = pg8::cvt_pk_bf16(v0[0], v0[1]); w.y = pg8::cvt_pk_bf16(v0[2], v0[3]); w.z = pg8::cvt_pk_bf16(v1[0], v1[1]); w.w = pg8::cvt_pk_bf16(v1[2], v1[3]);
          *(u32x4*)(rowp + bj * 128) = w;
        }
      }
  }
};
__device__ void ph_mix(const Params& p, PG8_LAS unsigned char* lds, int nblk, int bid) {
  SchedMix S; S.init(T_TOK / 256, DM / 256, nblk, bid); S.A = (const char*)p.merged; S.B = (const char*)p.wo_t;
  EpiMix E{p.mixer};
  pg8::gemm_phase(lds, p.tid, DM, DM, DM, S, E);
}

template <bool GATH>
struct SchedMoe {
  static constexpr bool GATHER = GATH;
  static constexpr bool PUBLISH = GATH;
  const PG8_LAS int* tb; int NT; int G, c; int nwg;
  const char* A; const char* B; size_t bexp;
  const int* elist; int rowb;
  int* dep; int i0, Loff, rot;
  __device__ void publish(const Unit& u) const { __hip_atomic_fetch_add(dep + u.pm, 1, __ATOMIC_RELAXED, __HIP_MEMORY_SCOPE_AGENT); }
  __device__ bool next(int i, Unit& u) const {
    const long L = (long)(i + i0) * G + c - Loff; if (L >= nwg) return false;
    int wgid = (int)L; { const int q = nwg / 8, r = nwg % 8, xcd = wgid % 8; int off = wgid / 8;
      if constexpr (!GATH) { const int sz = xcd < r ? q + 1 : q; off += rot; if (off >= sz) off -= sz; }
      wgid = (xcd < r ? xcd * (q + 1) : r * (q + 1) + (xcd - r) * q) + off; }
    int e = 0;
#pragma unroll
    for (int st = 16; st >= 1; st >>= 1) if (wgid >= tb[e + st]) e += st;
    const int q = wgid - tb[e]; const int tiles = tb[33 + e + 1] - tb[33 + e];
    u.pm = tb[33 + e] + q % tiles; u.pn = q / tiles; u.z = e;
    if constexpr (!GATH) {
      while (__builtin_amdgcn_readfirstlane(__hip_atomic_load(dep + u.pm, __ATOMIC_RELAXED, __HIP_MEMORY_SCOPE_AGENT)) < 8) __builtin_amdgcn_s_sleep(4);
      asm volatile("" ::: "memory");
    }
    return true;
  }
  __device__ const char* a_ptr(const Unit& u) const { return GATH ? A : A + (size_t)u.pm * 256 * rowb; }
  __device__ const char* b_ptr(const Unit& u) const { return B + (size_t)u.z * bexp + (size_t)u.pn * 256 * rowb; }
  __device__ unsigned a_goff(const Unit& u, int tr, int C) const {
    const int i = (u.pm - tb[33 + u.z]) * 256 + tr;
    int tok = 0;
    if (i < tb[66 + u.z]) tok = elist[u.z * T_TOK + i] >> 2;
    return (unsigned)(tok * rowb + C * 2);
  }
};
__device__ __forceinline__ void moe_table(const Params& p, PG8_LAS int* tb, int NT) {
  if (p.tid == 0) {
    int ub = 0, tbp = 0;
    for (int e = 0; e < NE; ++e) { const int c = p.cnt[e * 64]; tb[e] = ub; tb[33 + e] = tbp; tb[66 + e] = c; const int t = (c + 255) >> 8; ub += t * NT; tbp += t; }
    tb[NE] = ub; tb[33 + NE] = tbp;
  }
  __syncthreads();
}
struct EpiMoe1 {
  static constexpr bool PERM = true;
  const float* b_gu; unsigned char* act;
  __device__ __forceinline__ void operator()(f32x4 (&acc)[2][2][4][2], const Unit& u, int wr, int wc, int fr, int fq) const {
    const int row0 = u.pm * 256 + wr * 64 + fr, jc = u.pn * 128 + wc * 32 + 8 * fq;
    const float* bg = b_gu + (size_t)u.z * 2048 + jc;
#pragma unroll
    for (int bj = 0; bj < 2; ++bj)
#pragma unroll
      for (int n = 0; n < 2; ++n) {
        const f32x4 bv = *(const f32x4*)(bg + bj * 1024 + n * 4);
#pragma unroll
        for (int ai = 0; ai < 2; ++ai)
#pragma unroll
          for (int m = 0; m < 4; ++m) acc[ai][bj][m][n] = acc[ai][bj][m][n] * 0.015625f + bv;
      }
#pragma unroll
    for (int ai = 0; ai < 2; ++ai)
#pragma unroll
      for (int m = 0; m < 4; ++m) {
        unsigned char* rowp = act + (size_t)(row0 + ai * 128 + m * 16) * DM + jc;
        float r[8];
#pragma unroll
        for (int n = 0; n < 2; ++n)
#pragma unroll
          for (int j = 0; j < 4; ++j) {
            float g = acc[ai][0][m][n][j], up = acc[ai][1][m][n][j];
            g = fminf(g, 7.f); up = fminf(fmaxf(up, -7.f), 7.f);
            r[n * 4 + j] = (up + 1.f) * g * sigmoidf_(1.702f * g);
          }
        u32x2 w; w.x = pk4_fp8(r[0], r[1], r[2], r[3]); w.y = pk4_fp8(r[4], r[5], r[6], r[7]);
        __hip_atomic_store((unsigned long long*)rowp, (unsigned long long)w.x | ((unsigned long long)w.y << 32), __ATOMIC_RELAXED, __HIP_MEMORY_SCOPE_AGENT);
      }
  }
};
__device__ void ph_moe1(const Params& p, PG8_LAS unsigned char* lds, int nblk, int bid) {
  PG8_LAS int* tb = (PG8_LAS int*)(lds + pg8::STAGE_BYTES);
  moe_table(p, tb, 8);
  SchedMoe<true> S; S.tb = tb; S.NT = 8; S.G = nblk; S.c = bid; S.nwg = tb[NE]; S.A = (const char*)p.h2q; S.B = (const char*)p.wgu8; S.bexp = (size_t)2048 * DM; S.elist = p.elist; S.rowb = DM;
  S.dep = p.dep; S.i0 = 0; S.Loff = 0; S.rot = 0;
  EpiMoe1 E{p.b_gu, p.act8};
  pg8::gemm_phase<EpiMoe1, SchedMoe<true>, true>(lds, p.tid, DM / 2, DM / 2, DM / 2, S, E);
}
struct EpiMoe2 {
  static constexpr bool PERM = true;
  const float* b_down; const int* elist; const PG8_LAS int* tb; bf16_t* yslot;
  __device__ __forceinline__ void operator()(f32x4 (&acc)[2][2][4][2], const Unit& u, int wr, int wc, int fr, int fq) const {
    const int row0 = u.pm * 256 + wr * 64 + fr, col0 = u.pn * 256 + wc * 32 + 8 * fq;
    const float* bd = b_down + (size_t)u.z * 1024 + col0;
#pragma unroll
    for (int bj = 0; bj < 2; ++bj)
#pragma unroll
      for (int n = 0; n < 2; ++n) {
        const f32x4 bv = *(const f32x4*)(bd + bj * 128 + n * 4);
#pragma unroll
        for (int ai = 0; ai < 2; ++ai)
#pragma unroll
          for (int m = 0; m < 4; ++m) acc[ai][bj][m][n] = acc[ai][bj][m][n] * 0.015625f + bv;
      }
    const int li0 = (u.pm - tb[33 + u.z]) * 256 + wr * 64 + fr, cnt = tb[66 + u.z];
    int av[2][4];
#pragma unroll
    for (int ai = 0; ai < 2; ++ai)
#pragma unroll
      for (int m = 0; m < 4; ++m) { const int li = li0 + ai * 128 + m * 16; av[ai][m] = elist[u.z * T_TOK + (li < cnt ? li : 0)]; if (li >= cnt) av[ai][m] = -1; }
#pragma unroll
    for (int ai = 0; ai < 2; ++ai)
#pragma unroll
      for (int m = 0; m < 4; ++m) {
        const int a = av[ai][m];
        if (a >= 0) {
          unsigned char* rowp = (unsigned char*)yslot + (size_t)a * DM + col0;
#pragma unroll
          for (int bj = 0; bj < 2; ++bj) {
            const f32x4 v0 = acc[ai][bj][m][0], v1 = acc[ai][bj][m][1];
            u32x2 w; w.x = pk4_fp8(v0[0] * 8.f, v0[1] * 8.f, v0[2] * 8.f, v0[3] * 8.f); w.y = pk4_fp8(v1[0] * 8.f, v1[1] * 8.f, v1[2] * 8.f, v1[3] * 8.f);
            *(u32x2*)(rowp + bj * 128) = w;
          }
        }
      }
  }
};
__device__ void ph_moe2(const Params& p, PG8_LAS unsigned char* lds, int nblk, int bid) {
  PG8_LAS int* tb = (PG8_LAS int*)(lds + pg8::STAGE_BYTES);
  moe_table(p, tb, 4);
  SchedMoe<false> S; S.tb = tb; S.NT = 4; S.G = nblk; S.c = bid; S.nwg = tb[NE]; S.A = (const char*)p.act8; S.B = (const char*)p.wd8; S.bexp = (size_t)1024 * DM; S.elist = p.elist; S.rowb = DM;
  { const int nwg1 = 2 * S.nwg; S.dep = p.dep; S.i0 = (nwg1 - bid + nblk - 1) / nblk; S.Loff = nwg1; S.rot = S.nwg >> 5; }
  EpiMoe2 E{p.b_down, p.elist, tb, p.yslot};
  pg8::gemm_phase<EpiMoe2, SchedMoe<false>, true>(lds, p.tid, DM / 2, DM / 2, DM / 2, S, E);
}

typedef short bf16x8 __attribute__((ext_vector_type(8)));
#define LAS __attribute__((address_space(3)))
#define MFMA16(a, b, c) __builtin_amdgcn_mfma_f32_16x16x32_bf16((a), (b), (c), 0, 0, 0)
__device__ __forceinline__ bf16x8 pack8(float a0, float a1, float a2, float a3, float a4, float a5, float a6, float a7) {
  u32x4 w; w.x = pk2(a0, a1); w.y = pk2(a2, a3); w.z = pk2(a4, a5); w.w = pk2(a6, a7);
  return __builtin_bit_cast(bf16x8, w);
}
__device__ __forceinline__ bf16_t f2bf_hw(float a) { return (bf16_t)(pk2(a, 0.f) & 0xffffu); }

#define DN_ABYTES 57344
#define DN_UFLOATS 8192
#define F_WN 0
#define F_QD 16
#define F_QK 32
#define F_KT 40

#define DP_KH 0
#define DP_QT 17408
#define DP_KHT 34816
#define DP_VT 53248
#define DP_TU 71680
#define DP_TW 80896
#define DP_LF 90112
#define DP_GC 107520
#define DP_BETA 107776
#define DP_CW 108032
#define DP_LB 114176
#define DP_TR 123392
#define DP_TT 132608
#define DP_MT 141824
#define DP_TOTAL 144128

template <int KS>
__device__ __forceinline__ f32x4 prod16(const LAS bf16_t* A, int lda, int arow0, const LAS bf16_t* Bt, int ldb, int brow0, f32x4 acc, int lane) {
  const int r = lane & 15, q = lane >> 4;
#pragma unroll
  for (int ks = 0; ks < KS; ++ks) {
    const bf16x8 a = *(const LAS bf16x8*)(A + (arow0 + r) * lda + 32 * ks + 8 * q);
    const bf16x8 b = *(const LAS bf16x8*)(Bt + (brow0 + r) * ldb + 32 * ks + 8 * q);
    acc = MFMA16(a, b, acc);
  }
  return acc;
}
__device__ __forceinline__ void tile_store_rm(LAS bf16_t* X, int ld, int row0, int col0, const f32x4 v, int lane) {
  const int r = lane & 15, q = lane >> 4;
#pragma unroll
  for (int i = 0; i < 4; ++i) X[(row0 + 4 * q + i) * ld + col0 + r] = f2bf_hw(v[i]);
}
__device__ __forceinline__ void tile_store_tr(LAS bf16_t* Xt, int ld, int row0, int col0, const f32x4 v, int lane) {
  const int r = lane & 15, q = lane >> 4;
  u32x2 w; w.x = pk2(v[0], v[1]); w.y = pk2(v[2], v[3]);
  *(LAS u32x2*)(Xt + (col0 + r) * ld + row0 + 4 * q) = w;
}

__device__ void dn_prep_chunk(const Params& p, LAS unsigned char* lds, int ci, bool load_cw) {
  const int tid = p.tid, lane = tid & 63, w = tid >> 6, r16 = lane & 15, q4 = lane >> 4;
  const int bh = ci >> 6, n = ci & 63, b = bh >> 2, h = bh & 3;
  LAS bf16_t* Kh = (LAS bf16_t*)(lds + DP_KH); LAS bf16_t* Qt = (LAS bf16_t*)(lds + DP_QT);
  LAS bf16_t* KhT = (LAS bf16_t*)(lds + DP_KHT); LAS bf16_t* VT = (LAS bf16_t*)(lds + DP_VT);
  LAS bf16_t* Tu = (LAS bf16_t*)(lds + DP_TU); LAS bf16_t* Tw = (LAS bf16_t*)(lds + DP_TW); LAS float* Lf = (LAS float*)(lds + DP_LF);
  LAS bf16_t* Lb = (LAS bf16_t*)(lds + DP_LB); LAS bf16_t* Tr = (LAS bf16_t*)(lds + DP_TR); LAS bf16_t* Tt = (LAS bf16_t*)(lds + DP_TT); LAS bf16_t* Mt = (LAS bf16_t*)(lds + DP_MT);
  LAS float* gcb = (LAS float*)(lds + DP_GC); LAS float* betab = (LAS float*)(lds + DP_BETA); LAS float* cw = (LAS float*)(lds + DP_CW);
  unsigned char* gA = (unsigned char*)p.dnA + (size_t)ci * DN_ABYTES;
  float* gU = p.dnU + (size_t)ci * DN_UFLOATS;

  if (load_cw) {
    for (int i = tid; i < 4 * 384; i += 512) { const int tap = i / 384, cc = i % 384, part = cc >> 7, d = cc & 127; cw[i] = p.conv_w[tap * 1536 + part * 512 + h * 128 + d]; }
  }
  __syncthreads();
  const int c = tid >> 3, g = tid & 7;
  const int s = n * 64 + c;
  const size_t t = (size_t)b * SEQ + s;
  float qv[16], kv[16], vv[16];
#pragma unroll
  for (int j = 0; j < 16; ++j) { qv[j] = 0.f; kv[j] = 0.f; vv[j] = 0.f; }
#pragma unroll
  for (int tap = 0; tap < 4; ++tap) {
    const int ss = s - 3 + tap;
    if (ss >= 0) {
      const bf16_t* row = p.proj + (t - 3 + tap) * PW + h * 128 + 16 * g;
      float x[8];
#pragma unroll
      for (int part = 0; part < 3; ++part) {
#pragma unroll
        for (int hh = 0; hh < 2; ++hh) {
          unpack8(*(const u32x4*)(row + part * 512 + 8 * hh), x);
#pragma unroll
          for (int j = 0; j < 8; ++j) {
            const float wv = cw[tap * 384 + part * 128 + 16 * g + 8 * hh + j];
            if (part == 0) qv[8 * hh + j] += wv * x[j];
            if (part == 1) kv[8 * hh + j] += wv * x[j];
            if (part == 2) vv[8 * hh + j] += wv * x[j];
          }
        }
      }
    }
    asm volatile("" ::: "memory");
  }
  float sq = 0.f, sk = 0.f;
#pragma unroll
  for (int j = 0; j < 16; ++j) { qv[j] = siluf_(qv[j]); kv[j] = siluf_(kv[j]); vv[j] = siluf_(vv[j]); sq += qv[j] * qv[j]; sk += kv[j] * kv[j]; }
  sq += __shfl_xor(sq, 1, 64); sq += __shfl_xor(sq, 2, 64); sq += __shfl_xor(sq, 4, 64);
  sk += __shfl_xor(sk, 1, 64); sk += __shfl_xor(sk, 2, 64); sk += __shfl_xor(sk, 4, 64);
  const float rq = rsqrtf(sq + 1e-6f) * 0.08838834764831845f, rk = rsqrtf(sk + 1e-6f);
#pragma unroll
  for (int j = 0; j < 16; ++j) { qv[j] *= rq; kv[j] *= rk; }
  if (g == 0) {
    const float bb = p.ba[t * 8 + h], aa = p.ba[t * 8 + 4 + h];
    const float xx = aa + p.dt_bias[h];
    const float sp = xx > 20.f ? xx : log1pf(__expf(xx));
    betab[c] = sigmoidf_(bb);
    gcb[c] = -__expf(p.a_log[h]) * sp;
  }
  {
    u32x4 w0, w1;
    w0.x = pk2(kv[0], kv[1]); w0.y = pk2(kv[2], kv[3]); w0.z = pk2(kv[4], kv[5]); w0.w = pk2(kv[6], kv[7]);
    w1.x = pk2(kv[8], kv[9]); w1.y = pk2(kv[10], kv[11]); w1.z = pk2(kv[12], kv[13]); w1.w = pk2(kv[14], kv[15]);
    *(LAS u32x4*)(Kh + c * 136 + 16 * g) = w0; *(LAS u32x4*)(Kh + c * 136 + 16 * g + 8) = w1;
    w0.x = pk2(qv[0], qv[1]); w0.y = pk2(qv[2], qv[3]); w0.z = pk2(qv[4], qv[5]); w0.w = pk2(qv[6], qv[7]);
    w1.x = pk2(qv[8], qv[9]); w1.y = pk2(qv[10], qv[11]); w1.z = pk2(qv[12], qv[13]); w1.w = pk2(qv[14], qv[15]);
    *(LAS u32x4*)(Qt + c * 136 + 16 * g) = w0; *(LAS u32x4*)(Qt + c * 136 + 16 * g + 8) = w1;
#pragma unroll
    for (int j = 0; j < 16; ++j) { KhT[(16 * g + j) * 72 + c] = f2bf_hw(kv[j]); VT[(16 * g + j) * 72 + c] = f2bf_hw(vv[j]); }
  }
  __syncthreads();
  if (w == 0) {
    float v = gcb[lane];
#pragma unroll
    for (int o = 1; o < 64; o <<= 1) { const float u = __shfl_up(v, o, 64); if (lane >= o) v += u; }
    gcb[lane] = v;
  }
  __syncthreads();
  const float gc_c = gcb[c], gl = gcb[63];
  {
    const float eg = __expf(gc_c);
    unsigned char* fb = gA + (size_t)(F_QD + (c >> 4) * 4 + (g >> 1)) * 1024 + (g & 1) * 8;
#pragma unroll
    for (int qq = 0; qq < 4; ++qq) {
      u32x2 wv; wv.x = pk2(qv[4 * qq] * eg, qv[4 * qq + 1] * eg); wv.y = pk2(qv[4 * qq + 2] * eg, qv[4 * qq + 3] * eg);
      *(u32x2*)(fb + ((c & 15) + 16 * qq) * 16) = wv;
    }
  }
  const int rt = w >> 1, ct0 = 2 * (w & 1);
#pragma unroll
  for (int tt = 0; tt < 2; ++tt) {
    const int ct = ct0 + tt;
    f32x4 gacc = {0.f, 0.f, 0.f, 0.f};
    gacc = prod16<4>(Kh, 136, 16 * rt, Kh, 136, 16 * ct, gacc, lane);
    const int m = 16 * ct + r16; const float gc_m = gcb[m];
    f32x4 lv;
#pragma unroll
    for (int i = 0; i < 4; ++i) {
      const int cc = 16 * rt + 4 * q4 + i;
      lv[i] = (m < cc) ? betab[cc] * gacc[i] * __expf(gcb[cc] - gc_m) : 0.f;
      Lf[cc * 68 + m] = lv[i];
    }
    tile_store_rm(Lb, 72, 16 * rt, 16 * ct, lv, lane);
    f32x4 qacc = {0.f, 0.f, 0.f, 0.f};
    qacc = prod16<4>(Kh, 136, 16 * rt, Qt, 136, 16 * ct, qacc, lane);
    const int cq = 16 * ct + r16; const float gc_cq = gcb[cq];
    float o4[4];
#pragma unroll
    for (int i = 0; i < 4; ++i) { const int mm = 16 * rt + 4 * q4 + i; o4[i] = (mm <= cq) ? qacc[i] * __expf(gc_cq - gcb[mm]) : 0.f; }
    u32x2 wv; wv.x = pk2(o4[0], o4[1]); wv.y = pk2(o4[2], o4[3]);
    *(u32x2*)(gA + (size_t)(F_QK + ct * 2 + (rt >> 1)) * 1024 + (r16 + 16 * q4) * 16 + (rt & 1) * 8) = wv;
  }
  __syncthreads();
  for (int i = tid; i < 2 * 64 * 72 / 8; i += 512) ((LAS u32x4*)Tr)[i] = (u32x4){0u, 0u, 0u, 0u};
  __syncthreads();
  if (w == 0) {
    int lo = lane; asm volatile("" : "+v"(lo));
    const int g = lo >> 4, j = lo & 15;
    unsigned lfb = DP_LF + (16 * g * 68 + 16 * g) * 4; asm volatile("" : "+v"(lfb));
    const LAS float* Lg = (const LAS float*)(lds + lfb);
    float t[16];
#pragma unroll
    for (int r = 0; r < 16; ++r) {
      float a0 = (r == j) ? 1.f : 0.f, a1 = 0.f;
#pragma unroll
      for (int k4 = 0; k4 < (r + 3) / 4; ++k4) {
        const f32x4 l = *(const LAS f32x4*)(Lg + r * 68 + 4 * k4);
        if (4 * k4 + 0 < r) a0 -= l[0] * t[4 * k4 + 0];
        if (4 * k4 + 1 < r) a1 -= l[1] * t[4 * k4 + 1];
        if (4 * k4 + 2 < r) a0 -= l[2] * t[4 * k4 + 2];
        if (4 * k4 + 3 < r) a1 -= l[3] * t[4 * k4 + 3];
      }
      t[r] = a0 + a1;
      Tr[(16 * g + r) * 72 + 16 * g + j] = f2bf_hw(t[r]);
    }
    u32x4 w0, w1;
    w0.x = pk2(t[0], t[1]); w0.y = pk2(t[2], t[3]); w0.z = pk2(t[4], t[5]); w0.w = pk2(t[6], t[7]);
    w1.x = pk2(t[8], t[9]); w1.y = pk2(t[10], t[11]); w1.z = pk2(t[12], t[13]); w1.w = pk2(t[14], t[15]);
    *(LAS u32x4*)(Tt + (16 * g + j) * 72 + 16 * g) = w0; *(LAS u32x4*)(Tt + (16 * g + j) * 72 + 16 * g + 8) = w1;
  }
  __syncthreads();
#pragma unroll 1
  for (int d = 1; d <= 3; ++d) {
    const bool act = w < 4 - d;
    const int I = w + d, J = w;
    LAS bf16_t* Mw = Mt + w * 16 * 24;
    if (act) {
      f32x4 macc = {0.f, 0.f, 0.f, 0.f};
      macc = prod16<2>(Lb, 72, 16 * I, Tt, 72, 16 * J, macc, lane);
      tile_store_tr(Mw, 24, 0, 0, macc, lane);
    }
    __syncthreads();
    if (act) {
      bf16x8 a = {0, 0, 0, 0, 0, 0, 0, 0}, bb = {0, 0, 0, 0, 0, 0, 0, 0};
      if (q4 < 2) { a = *(const LAS bf16x8*)(Tr + (16 * I + r16) * 72 + 16 * I + 8 * q4); bb = *(const LAS bf16x8*)(Mw + r16 * 24 + 8 * q4); }
      f32x4 tacc = {0.f, 0.f, 0.f, 0.f};
      tacc = MFMA16(a, bb, tacc);
#pragma unroll
      for (int i = 0; i < 4; ++i) tacc[i] = -tacc[i];
      tile_store_rm(Tr, 72, 16 * I, 16 * J, tacc, lane);
      tile_store_tr(Tt, 72, 16 * I, 16 * J, tacc, lane);
    }
    __syncthreads();
  }
  {
    const int cc = tid >> 3, m0 = (tid & 7) * 8;
    float tv[8]; unpack8(*(const LAS u32x4*)(Tr + cc * 72 + m0), tv);
    float tu[8], tw[8];
#pragma unroll
    for (int jj = 0; jj < 8; ++jj) { const float bm = betab[m0 + jj]; tu[jj] = tv[jj] * bm; tw[jj] = tu[jj] * __expf(gcb[m0 + jj]); }
    u32x4 wu, ww;
    wu.x = pk2(tu[0], tu[1]); wu.y = pk2(tu[2], tu[3]); wu.z = pk2(tu[4], tu[5]); wu.w = pk2(tu[6], tu[7]);
    ww.x = pk2(tw[0], tw[1]); ww.y = pk2(tw[2], tw[3]); ww.z = pk2(tw[4], tw[5]); ww.w = pk2(tw[6], tw[7]);
    *(LAS u32x4*)(Tu + cc * 72 + m0) = wu; *(LAS u32x4*)(Tw + cc * 72 + m0) = ww;
  }
  __syncthreads();
#pragma unroll
  for (int rr = 0; rr < 4; ++rr) {
    f32x4 u = {0.f, 0.f, 0.f, 0.f};
    u = prod16<2>(Tu, 72, 16 * rr, VT, 72, 16 * w, u, lane);
    *(f32x4*)(gU + ((w * 4 + rr) * 64 + lane) * 4) = u;
    f32x4 wt = {0.f, 0.f, 0.f, 0.f};
    wt = prod16<2>(KhT, 72, 16 * w, Tw, 72, 16 * rr, wt, lane);
    u32x2 wv; wv.x = pk2(-wt[0], -wt[1]); wv.y = pk2(-wt[2], -wt[3]);
    *(u32x2*)(gA + (size_t)(F_WN + rr * 4 + (w >> 1)) * 1024 + (r16 + 16 * q4) * 16 + (w & 1) * 8) = wv;
  }
#pragma unroll
  for (int it = 0; it < 4; ++it) {
    const int idx = tid + it * 512; const int d = idx >> 4, m4 = idx & 15;
    const u32x2 raw = *(const LAS u32x2*)(KhT + d * 72 + 4 * m4);
    const float k0 = __uint_as_float(raw.x << 16), k1 = __uint_as_float(raw.x & 0xffff0000u), k2 = __uint_as_float(raw.y << 16), k3 = __uint_as_float(raw.y & 0xffff0000u);
    const float e0 = __expf(gl - gcb[4 * m4]), e1 = __expf(gl - gcb[4 * m4 + 1]), e2 = __expf(gl - gcb[4 * m4 + 2]), e3 = __expf(gl - gcb[4 * m4 + 3]);
    u32x2 wv; wv.x = pk2(k0 * e0, k1 * e1); wv.y = pk2(k2 * e2, k3 * e3);
    *(u32x2*)(gA + (size_t)(F_KT + (d >> 4) * 2 + (m4 >> 3)) * 1024 + ((d & 15) + 16 * (m4 & 3)) * 16 + ((m4 >> 2) & 1) * 8) = wv;
  }
  if (tid == 0) p.dnG[ci] = __expf(gl);
}

#define DS_SLOT 32768
#define DS_TOTAL (4 * DS_SLOT)
#define DN_SFRAG (4 * 1024)
#define DN_VFRAG (2 * 1024)
__device__ void dn_scan_blk(const Params& p, LAS unsigned char* lds, int item) {
  const int tid = p.tid, lane = tid & 63, w = __builtin_amdgcn_readfirstlane(tid >> 6);
  const int bh = item >> 1, eh = item & 1;
  const int et = eh * 4 + (w & 3);
  const bool comp = w < 4;
  const unsigned char* gA = (const unsigned char*)p.dnA + (size_t)bh * 64 * DN_ABYTES;
  const float* gU = p.dnU + (size_t)bh * 64 * DN_UFLOATS;
  const float* gG = p.dnG + bh * 64;
  unsigned char* gS = (unsigned char*)p.dnS + ((size_t)bh * 64 * 8 + et) * DN_SFRAG + lane * 16;
  unsigned char* gV = (unsigned char*)p.dnV + ((size_t)bh * 64 * 8 + et) * DN_VFRAG + lane * 16;
  auto issue_A = [&](int n) {
#pragma unroll
    for (int i = 0; i < 8; ++i) {
      const int f = (w & 3) * 8 + i, sf = f < 16 ? F_WN + f : F_KT + (f - 16);
      __builtin_amdgcn_global_load_lds((const unsigned*)(gA + (size_t)n * DN_ABYTES + sf * 1024 + lane * 16), (LAS unsigned*)(lds + (n & 3) * DS_SLOT + f * 1024), 16, 0, 0);
    }
  };
  __syncthreads();
  f32x4 Un[4]; f32x4 S[8]; float gnext = 0.f;
  if (comp) {
#pragma unroll
    for (int rr = 0; rr < 4; ++rr) Un[rr] = *(const f32x4*)(gU + ((et * 4 + rr) * 64 + lane) * 4);
    gnext = gG[0];
  } else {
    issue_A(0); issue_A(1); issue_A(2);
    asm volatile("s_waitcnt vmcnt(16)" ::: "memory");
  }
#pragma unroll
  for (int dt = 0; dt < 8; ++dt) S[dt] = (f32x4){0.f, 0.f, 0.f, 0.f};
  asm volatile("s_waitcnt lgkmcnt(0)" ::: "memory");
  __builtin_amdgcn_s_barrier();
  asm volatile("" ::: "memory");
#pragma unroll 1
  for (int n = 0; n < 64; ++n) {
    const LAS unsigned char* Ab = lds + (n & 3) * DS_SLOT;
    if (!comp) {
      if (n + 3 < 64) { issue_A(n + 3); asm volatile("s_waitcnt vmcnt(16)" ::: "memory"); }
      else if (n + 2 < 64) asm volatile("s_waitcnt vmcnt(8)" ::: "memory");
      else asm volatile("s_waitcnt vmcnt(0)" ::: "memory");
    } else {
      f32x4 Vn[4];
#pragma unroll
      for (int rr = 0; rr < 4; ++rr) Vn[rr] = Un[rr];
      const float gdec = gnext;
      if (n + 1 < 64) {
#pragma unroll
        for (int rr = 0; rr < 4; ++rr) Un[rr] = *(const f32x4*)(gU + (size_t)(n + 1) * DN_UFLOATS + ((et * 4 + rr) * 64 + lane) * 4);
        gnext = gG[n + 1];
      }
      bf16x8 Sb[4];
#pragma unroll
      for (int ks = 0; ks < 4; ++ks) Sb[ks] = pack8(S[2 * ks][0], S[2 * ks][1], S[2 * ks][2], S[2 * ks][3], S[2 * ks + 1][0], S[2 * ks + 1][1], S[2 * ks + 1][2], S[2 * ks + 1][3]);
#pragma unroll
      for (int ks = 0; ks < 4; ++ks) *(bf16x8*)(gS + (size_t)n * 8 * DN_SFRAG + ks * 1024) = Sb[ks];
#pragma unroll
      for (int dt = 0; dt < 8; ++dt) S[dt] *= gdec;
#define LDF(idx) (*(const LAS bf16x8*)(Ab + (idx) * 1024 + lane * 16))
#define SBAR __builtin_amdgcn_sched_barrier(0)
      bf16x8 fa[8], fb[8];
#pragma unroll
      for (int i = 0; i < 8; ++i) fa[i] = LDF(i);
      SBAR;
#pragma unroll
      for (int i = 0; i < 8; ++i) fb[i] = LDF(8 + i);
      SBAR;
#pragma unroll
      for (int ks = 0; ks < 4; ++ks) { Vn[0] = MFMA16(fa[ks], Sb[ks], Vn[0]); Vn[1] = MFMA16(fa[4 + ks], Sb[ks], Vn[1]); }
      SBAR;
#pragma unroll
      for (int i = 0; i < 8; ++i) fa[i] = LDF(16 + i);
      SBAR;
#pragma unroll
      for (int ks = 0; ks < 4; ++ks) { Vn[2] = MFMA16(fb[ks], Sb[ks], Vn[2]); Vn[3] = MFMA16(fb[4 + ks], Sb[ks], Vn[3]); }
      SBAR;
#pragma unroll
      for (int i = 0; i < 8; ++i) fb[i] = LDF(24 + i);
      SBAR;
      bf16x8 Vb[2];
#pragma unroll
      for (int ks = 0; ks < 2; ++ks) Vb[ks] = pack8(Vn[2 * ks][0], Vn[2 * ks][1], Vn[2 * ks][2], Vn[2 * ks][3], Vn[2 * ks + 1][0], Vn[2 * ks + 1][1], Vn[2 * ks + 1][2], Vn[2 * ks + 1][3]);
#pragma unroll
      for (int ks = 0; ks < 2; ++ks) *(bf16x8*)(gV + (size_t)n * 8 * DN_VFRAG + ks * 1024) = Vb[ks];
#pragma unroll
      for (int ks = 0; ks < 2; ++ks)
#pragma unroll
        for (int dt = 0; dt < 4; ++dt) S[dt] = MFMA16(fa[dt * 2 + ks], Vb[ks], S[dt]);
#pragma unroll
      for (int ks = 0; ks < 2; ++ks)
#pragma unroll
        for (int dt = 0; dt < 4; ++dt) S[4 + dt] = MFMA16(fb[dt * 2 + ks], Vb[ks], S[4 + dt]);
#undef LDF
#undef SBAR
      asm volatile("s_waitcnt lgkmcnt(0)" ::: "memory");
    }
    __builtin_amdgcn_s_barrier();
    asm volatile("" ::: "memory");
  }
  asm volatile("s_waitcnt vmcnt(0)" ::: "memory");
}
#define DO_OT 32768
__device__ void ph_dn_out(const Params& p, LAS unsigned char* lds, int nblk, int bid) {
  const int tid = p.tid, lane = tid & 63, w = __builtin_amdgcn_readfirstlane(tid >> 6), r16 = lane & 15, q4 = lane >> 4;
  LAS float* Ot = (LAS float*)(lds + DO_OT);
  for (int ci = bid; ci < 1024; ci += nblk) {
    const int bh = ci >> 6, n = ci & 63, b = bh >> 2, h = bh & 3;
    const unsigned char* gA = (const unsigned char*)p.dnA + (size_t)ci * DN_ABYTES;
    __syncthreads();
#pragma unroll
    for (int i = 0; i < 3; ++i) {
      const int f = w * 3 + i;
      __builtin_amdgcn_global_load_lds((const unsigned*)(gA + (F_QD + f) * 1024 + lane * 16), (LAS unsigned*)(lds + f * 1024), 16, 0, 0);
    }
    bf16x8 Sb[4], Vb[2];
#pragma unroll
    for (int ks = 0; ks < 4; ++ks) Sb[ks] = *(const bf16x8*)((const unsigned char*)p.dnS + ((size_t)ci * 8 + w) * DN_SFRAG + ks * 1024 + lane * 16);
#pragma unroll
    for (int ks = 0; ks < 2; ++ks) Vb[ks] = *(const bf16x8*)((const unsigned char*)p.dnV + ((size_t)ci * 8 + w) * DN_VFRAG + ks * 1024 + lane * 16);
    asm volatile("s_waitcnt vmcnt(0)" ::: "memory");
    __syncthreads();
    f32x4 O[4];
#pragma unroll
    for (int rr = 0; rr < 4; ++rr) {
      O[rr] = (f32x4){0.f, 0.f, 0.f, 0.f};
#pragma unroll
      for (int ks = 0; ks < 4; ++ks) O[rr] = MFMA16(*(const LAS bf16x8*)(lds + (rr * 4 + ks) * 1024 + lane * 16), Sb[ks], O[rr]);
#pragma unroll
      for (int ks = 0; ks < 2; ++ks) O[rr] = MFMA16(*(const LAS bf16x8*)(lds + (16 + rr * 2 + ks) * 1024 + lane * 16), Vb[ks], O[rr]);
    }
#pragma unroll
    for (int rr = 0; rr < 4; ++rr)
#pragma unroll
      for (int i = 0; i < 4; ++i) Ot[(16 * rr + 4 * q4 + i) * 132 + 16 * w + r16] = O[rr][i];
    __syncthreads();
    {
      const int row = tid >> 3, seg = tid & 7;
      const size_t t = (size_t)b * SEQ + n * 64 + row;
      float o[16]; float ss = 0.f;
#pragma unroll
      for (int j4 = 0; j4 < 4; ++j4) { const f32x4 v = *(const LAS f32x4*)(Ot + row * 132 + 16 * seg + 4 * j4); o[4 * j4] = v[0]; o[4 * j4 + 1] = v[1]; o[4 * j4 + 2] = v[2]; o[4 * j4 + 3] = v[3]; }
#pragma unroll
      for (int j = 0; j < 16; ++j) ss += o[j] * o[j];
      ss += __shfl_xor(ss, 1, 64); ss += __shfl_xor(ss, 2, 64); ss += __shfl_xor(ss, 4, 64);
      const float rstd = rsqrtf(ss * (1.f / 128.f) + 1e-6f);
      const bf16_t* zp = p.proj + t * PW + C_Z + h * 128 + 16 * seg;
      float z0[8], z1[8]; unpack8(*(const u32x4*)zp, z0); unpack8(*(const u32x4*)(zp + 8), z1);
      float y[16];
#pragma unroll
      for (int j = 0; j < 8; ++j) { y[j] = o[j] * rstd * p.g_dn_out[16 * seg + j] * siluf_(z0[j]); y[8 + j] = o[8 + j] * rstd * p.g_dn_out[16 * seg + 8 + j] * siluf_(z1[j]); }
      u32x4 w0, w1;
      w0.x = pk2(y[0], y[1]); w0.y = pk2(y[2], y[3]); w0.z = pk2(y[4], y[5]); w0.w = pk2(y[6], y[7]);
      w1.x = pk2(y[8], y[9]); w1.y = pk2(y[10], y[11]); w1.z = pk2(y[12], y[13]); w1.w = pk2(y[14], y[15]);
      bf16_t* op = p.dn_out + t * p.dn_out_ld + h * 128 + 16 * seg;
      *(u32x4*)op = w0; *(u32x4*)(op + 8) = w1;
    }
  }
}
typedef float f32x16 __attribute__((ext_vector_type(16)));
#define MFMA32(a, b, c) __builtin_amdgcn_mfma_f32_32x32x16_bf16((a), (b), (c), 0, 0, 0)
#define MP_VL 0
#define MP_RED 65536
#define MP_TOTAL (65536 + 4096)

__device__ void moba_prep_block(const Params& p, LAS unsigned char* lds, int item) {
  const int tid = p.tid, lane = tid & 63, w = tid >> 6;
  const int bh = item >> 4, jb = item & 15, b = bh >> 2, h = bh & 3;
  LAS bf16_t* Vl = (LAS bf16_t*)(lds + MP_VL);
  LAS float* red = (LAS float*)(lds + MP_RED);
  __syncthreads();
#pragma unroll
  for (int it = 0; it < 8; ++it) {
    const int idx = tid + 512 * it, row = idx >> 4, ch = idx & 15;
    const u32x4 v = *(const u32x4*)(p.proj + ((size_t)b * SEQ + 256 * jb + row) * PW + C_MV + h * 128 + 8 * ch);
    *(LAS u32x4*)(Vl + row * 128 + 8 * ch) = v;
  }
  {
    const int r = tid >> 1, hh = tid & 1;
    const int pos = 256 * jb + r;
    const size_t t = (size_t)b * SEQ + pos;
    float cs[8], sn[8];
#pragma unroll
    for (int jj = 0; jj < 8; ++jj) {
      const float inv = exp2f(-(float)(8 * hh + jj) * (1.f / 16.f) * 18.931568569324174f);
      const float ang = (float)pos * inv;
      cs[jj] = cosf(ang); sn[jj] = sinf(ang);
    }
    float kacc[64];
#pragma unroll
    for (int which = 0; which < 2; ++which) {
      const bf16_t* src = p.proj + t * PW + (which ? C_MQ : C_MK) + h * 128 + 8 * hh;
      float x0[8], x1[8];
      unpack8(*(const u32x4*)(src), x0); unpack8(*(const u32x4*)(src + 16), x1);
      float y0[8], y1[8];
#pragma unroll
      for (int jj = 0; jj < 8; ++jj) { y0[jj] = x0[jj] * cs[jj] - x1[jj] * sn[jj]; y1[jj] = x1[jj] * cs[jj] + x0[jj] * sn[jj]; }
      u32x4 o[8];
      o[0].x = pk2(y0[0], y0[1]); o[0].y = pk2(y0[2], y0[3]); o[0].z = pk2(y0[4], y0[5]); o[0].w = pk2(y0[6], y0[7]);
      o[1].x = pk2(y1[0], y1[1]); o[1].y = pk2(y1[2], y1[3]); o[1].z = pk2(y1[4], y1[5]); o[1].w = pk2(y1[6], y1[7]);
#pragma unroll
      for (int ks = 2; ks < 8; ++ks) o[ks] = *(const u32x4*)(src + 16 * ks);
      if (which == 0) {
#pragma unroll
        for (int jj = 0; jj < 8; ++jj) { kacc[jj] = y0[jj]; kacc[8 + jj] = y1[jj]; }
#pragma unroll
        for (int ks = 2; ks < 8; ++ks) { float f[8]; unpack8(o[ks], f);
#pragma unroll
          for (int jj = 0; jj < 8; ++jj) kacc[8 * ks + jj] = f[jj]; }
        unsigned char* dst = (unsigned char*)p.Kp + ((size_t)(bh * 128 + 8 * jb + (r >> 5)) * 8192) + ((r & 31) + 32 * hh) * 16;
#pragma unroll
        for (int ks = 0; ks < 8; ++ks) *(u32x4*)(dst + ks * 1024) = o[ks];
      } else {
        bf16_t* dst = p.qb + ((size_t)bh * SEQ + pos) * 128 + 8 * hh;
#pragma unroll
        for (int ks = 0; ks < 8; ++ks) *(u32x4*)(dst + 16 * ks) = o[ks];
      }
    }
#pragma unroll
    for (int e = 0; e < 64; ++e) {
      float v = kacc[e];
      v += __shfl_xor(v, 2, 64); v += __shfl_xor(v, 4, 64); v += __shfl_xor(v, 8, 64); v += __shfl_xor(v, 16, 64); v += __shfl_xor(v, 32, 64);
      kacc[e] = v;
    }
    if (lane < 2) {
#pragma unroll
      for (int e = 0; e < 64; ++e) red[(w * 2 + lane) * 64 + e] = kacc[e];
    }
  }
  __syncthreads();
  if (tid < 128) {
    const int d = tid, hh = (d >> 3) & 1, ks = d >> 4, jj = d & 7;
    float a = 0.f;
#pragma unroll
    for (int ww = 0; ww < 8; ++ww) a += red[(ww * 2 + hh) * 64 + ks * 8 + jj];
    p.kmean[((size_t)bh * 16 + jb) * 128 + d] = a * (1.f / 256.f);
  }
#pragma unroll
  for (int it = 0; it < 8; ++it) {
    const int o = tid + 512 * it, ln = o & 63, frag = o >> 6, tl = frag >> 3, dt = (frag >> 1) & 3, s = frag & 1;
    const int r = ln & 31, hh = ln >> 5, d = 32 * dt + r;
    unsigned short e[8];
#pragma unroll
    for (int jj = 0; jj < 8; ++jj) { const int key = 32 * tl + 16 * s + 8 * (jj >> 2) + 4 * hh + (jj & 3); e[jj] = Vl[key * 128 + d]; }
    u32x4 wv; wv.x = e[0] | ((unsigned)e[1] << 16); wv.y = e[2] | ((unsigned)e[3] << 16); wv.z = e[4] | ((unsigned)e[5] << 16); wv.w = e[6] | ((unsigned)e[7] << 16);
    *(u32x4*)((unsigned char*)p.Vp + ((size_t)(bh * 128 + 8 * jb + tl) * 8192) + (dt * 2 + s) * 1024 + ln * 16) = wv;
  }
}
__device__ __forceinline__ int crow32(int reg, int hh) { return (reg & 3) + 8 * (reg >> 2) + 4 * hh; }
__device__ void moba_item(const Params& p, LAS float* km, LAS float* mrg, LAS float* ml, int bh, int ib, int sub, int par, int lane, int rep) {
  const int q = lane & 31, hh = lane >> 5;
  const int b = bh >> 2, h = bh & 3;
  const int s0 = 256 * ib + 32 * sub;
  const bf16_t* qrow = p.qb + ((size_t)bh * SEQ + s0 + q) * 128 + 8 * hh;
  bf16x8 Qf[8];
#pragma unroll
  for (int ks = 0; ks < 8; ++ks) Qf[ks] = *(const bf16x8*)(qrow + 16 * ks);
  LAS unsigned char* qlds = (LAS unsigned char*)km + 8192 + lane * 16;
#pragma unroll
  for (int ks = 0; ks < 8; ++ks) *(LAS bf16x8*)(qlds + ks * 1024) = Qf[ks];
  unsigned selmask = 0;
  if (ib > 0) {
    for (int idx = lane; idx < ib * 32; idx += 64) ((LAS f32x4*)km)[idx] = ((const f32x4*)(p.kmean + (size_t)bh * 16 * 128))[idx];
    float qf[64];
#pragma unroll
    for (int ks = 0; ks < 8; ++ks) { float f[8]; unpack8(__builtin_bit_cast(u32x4, Qf[ks]), f);
#pragma unroll
      for (int jj = 0; jj < 8; ++jj) qf[8 * ks + jj] = f[jj]; }
    float sc[16];
#pragma unroll
    for (int j = 0; j < 16; ++j) {
      sc[j] = -INFINITY;
      if (j < ib) {
        float a = 0.f;
#pragma unroll
        for (int ks = 0; ks < 8; ++ks) {
          const f32x4 k0 = *(const LAS f32x4*)(km + j * 128 + 16 * ks + 8 * hh), k1 = *(const LAS f32x4*)(km + j * 128 + 16 * ks + 8 * hh + 4);
          a += qf[8 * ks] * k0[0] + qf[8 * ks + 1] * k0[1] + qf[8 * ks + 2] * k0[2] + qf[8 * ks + 3] * k0[3];
          a += qf[8 * ks + 4] * k1[0] + qf[8 * ks + 5] * k1[1] + qf[8 * ks + 6] * k1[2] + qf[8 * ks + 7] * k1[3];
        }
        a += __shfl_xor(a, 32, 64);
        sc[j] = a;
      }
    }
#pragma unroll
    for (int r = 0; r < 3; ++r) {
      if (r < ib) {
        float best = -INFINITY; int bi = 0;
#pragma unroll
        for (int j = 0; j < 16; ++j) if (sc[j] > best) { best = sc[j]; bi = j; }
        selmask |= 1u << bi;
#pragma unroll
        for (int j = 0; j < 16; ++j) if (j == bi) sc[j] = -INFINITY;
      }
    }
  }
  unsigned rem = 0;
  for (int j = 0; j < ib; ++j) if (__ballot((selmask >> j) & 1u) != 0ull) rem |= 1u << j;
  rem = __builtin_amdgcn_readfirstlane(rem);
  const int own0 = 8 * ib, diag = 8 * ib + sub;
  const float cscale = 0.08838834764831845f * 1.4426950408889634f;
  float m = -1e30f, l = 0.f;
  f32x16 O[4];
#pragma unroll
  for (int dt = 0; dt < 4; ++dt)
#pragma unroll
    for (int r = 0; r < 16; ++r) O[dt][r] = 0.f;
  const unsigned char* kbase = (const unsigned char*)p.Kp + (size_t)bh * 128 * 8192 + lane * 16;
  const unsigned char* vbase = (const unsigned char*)p.Vp + (size_t)bh * 128 * 8192 + lane * 16;
  auto adv = [&](int& kt_, unsigned& rem_) {
    if (kt_ < 0) return;
    if (kt_ >= own0 ? (kt_ < diag) : ((kt_ & 7) != 7)) { kt_ = kt_ + 1; return; }
    if (rem_ == 0u) { kt_ = -1; return; }
    kt_ = 8 * (__builtin_ctz(rem_)); rem_ &= rem_ - 1u;
  };
  int kt = own0;
  if (par) adv(kt, rem);
  auto load_k = [&](int t, bf16x8 (&K_)[8]) {
#pragma unroll
    for (int ks = 0; ks < 8; ++ks) K_[ks] = *(const bf16x8*)(kbase + (size_t)t * 8192 + ks * 1024);
  };
  auto tile_step = [&](bf16x8 (&Kc)[8], bf16x8 (&Kn)[8]) -> bool {
    int ktn = kt; unsigned remn = rem;
    adv(ktn, remn); adv(ktn, remn);
    bf16x8 Vf[8];
#pragma unroll
    for (int f = 0; f < 8; ++f) Vf[f] = *(const bf16x8*)(vbase + (size_t)kt * 8192 + f * 1024);
    if (ktn >= 0) load_k(ktn, Kn);
    f32x16 S;
#pragma unroll
    for (int r = 0; r < 16; ++r) S[r] = 0.f;
#pragma unroll
    for (int ks = 0; ks < 8; ++ks) S = MFMA32(Kc[ks], *(const LAS bf16x8*)(qlds + ks * 1024), S);
    const bool allowed = (kt >= own0) || ((selmask >> (kt >> 3)) & 1u);
    const float nb = allowed ? 0.f : -INFINITY;
    float sv[16]; float mx = -INFINITY;
#pragma unroll
    for (int r = 0; r < 16; ++r) sv[r] = __builtin_fmaf(S[r], cscale, nb);
    if (kt == diag) {
#pragma unroll
      for (int r = 0; r < 16; ++r) if (crow32(r, hh) > q) sv[r] = -INFINITY;
    }
#pragma unroll
    for (int r = 0; r < 16; ++r) mx = fmaxf(mx, sv[r]);
    mx = fmaxf(mx, __shfl_xor(mx, 32, 64));
    const bool grow = mx > m + 8.f;
    const float mn = (__ballot(grow) != 0ull) ? fmaxf(m, mx) : m;
    const float alpha = __builtin_amdgcn_exp2f(m - mn);
    float ps = 0.f;
#pragma unroll
    for (int r = 0; r < 16; ++r) { sv[r] = __builtin_amdgcn_exp2f(sv[r] - mn); ps += sv[r]; }
    l = l * alpha + ps; m = mn;
    if (__ballot(alpha != 1.f) != 0ull) {
#pragma unroll
      for (int dt = 0; dt < 4; ++dt)
#pragma unroll
        for (int r = 0; r < 16; ++r) O[dt][r] *= alpha;
    }
    const bf16x8 P0 = pack8(sv[0], sv[1], sv[2], sv[3], sv[4], sv[5], sv[6], sv[7]);
    const bf16x8 P1 = pack8(sv[8], sv[9], sv[10], sv[11], sv[12], sv[13], sv[14], sv[15]);
#pragma unroll
    for (int dt = 0; dt < 4; ++dt) { O[dt] = MFMA32(Vf[dt * 2], P0, O[dt]); O[dt] = MFMA32(Vf[dt * 2 + 1], P1, O[dt]); }
    kt = ktn; rem = remn;
    return kt >= 0;
  };
  if (kt >= 0) {
    bf16x8 KA[8], KB[8];
    load_k(kt, KA);
#pragma unroll 1
    for (;;) {
      if (!tile_step(KA, KB)) break;
      asm volatile("" ::: "memory");
      if (!tile_step(KB, KA)) break;
      asm volatile("" ::: "memory");
    }
  }
  asm volatile("s_waitcnt vmcnt(0) lgkmcnt(0)" ::: "memory");
  if (par) {
    ml[lane] = m; ml[64 + lane] = l;
#pragma unroll
    for (int dt = 0; dt < 4; ++dt)
#pragma unroll
      for (int r = 0; r < 16; ++r) mrg[(dt * 16 + r) * 64 + lane] = O[dt][r];
  }
  __syncthreads();
  if (par == 0) {
    const float m2 = ml[lane], l2 = ml[64 + lane];
    const float mm = fmaxf(m, m2);
    const float a1 = __builtin_amdgcn_exp2f(m - mm), a2 = __builtin_amdgcn_exp2f(m2 - mm);
    l = l * a1 + l2 * a2;
#pragma unroll
    for (int dt = 0; dt < 4; ++dt)
#pragma unroll
      for (int r = 0; r < 16; ++r) O[dt][r] = O[dt][r] * a1 + mrg[(dt * 16 + r) * 64 + lane] * a2;
  }
  if (par == 0) {
  l += __shfl_xor(l, 32, 64);
  const float inv = 1.f / l;
  bf16_t* orow = rep ? p.oab2 + ((size_t)b * SEQ + s0 + q) * 512 + h * 128 : p.mb_out + ((size_t)b * SEQ + s0 + q) * p.mb_out_ld + p.mb_out_off + h * 128;
#pragma unroll
  for (int dt = 0; dt < 4; ++dt)
#pragma unroll
    for (int g4 = 0; g4 < 4; ++g4) {
      u32x2 wv; wv.x = pk2(O[dt][4 * g4] * inv, O[dt][4 * g4 + 1] * inv); wv.y = pk2(O[dt][4 * g4 + 2] * inv, O[dt][4 * g4 + 3] * inv);
      *(u32x2*)(orow + 32 * dt + 8 * g4 + 4 * hh) = wv;
    }
  }
  __syncthreads();
}
__device__ void moba_worker(const Params& p, LAS unsigned char* lds, int qi) {
  const int lane = p.tid & 63, w = __builtin_amdgcn_readfirstlane(p.tid >> 6);
  LAS float* km = (LAS float*)(lds + w * 16384);
  LAS float* mrg = (LAS float*)(lds + ((w & 3) + 4) * 16384);
  LAS float* ml = (LAS float*)(lds + 131072) + (w & 3) * 128;
  LAS int* slot = (LAS int*)(lds + 131072 + 2048);
  const int g0 = (int)((unsigned)__builtin_amdgcn_s_getreg((3 << 11) | 20) & 7u);
  for (int gi = 0; gi < 8; ++gi) {
    const int g = (g0 + gi) & 7;
    for (;;) {
      __syncthreads();
      if (p.tid == 0) slot[0] = atomicAdd(p.wq + qi * 8 + g, 1);
      __syncthreads();
      const int idx = slot[0];
      if (idx >= 64) break;
      const int bh = 2 * g + (idx >> 5), ib = 15 - ((idx >> 1) & 15), quad = 1 - (idx & 1);
      moba_item(p, km, mrg, ml, bh, ib, 4 * quad + (w & 3), w >> 2, lane, qi);
    }
  }
}
__device__ void ph_mod(const Params& p, LAS unsigned char* lds, int nblk, int bid) {
  LAS float* sc = (LAS float*)lds;
  LAS float* part = (LAS float*)(lds + 16384);
  const int tid = p.tid;
  if (bid >= 192) return;
  for (int i = tid; i < 4096; i += 512) sc[i] = siluf_(p.c[i]);
  __syncthreads();
  for (int task = bid; task < 192; task += nblk) {
    const int jj = tid & 31, ks = tid >> 5, j = task * 32 + jj;
    float a0 = 0.f, a1 = 0.f, a2 = 0.f, a3 = 0.f;
#pragma unroll 8
    for (int kk = 0; kk < 64; ++kk) {
      const int k = ks * 64 + kk;
      const float w = p.w_ada[(size_t)k * 6144 + j];
      a0 += sc[k] * w; a1 += sc[1024 + k] * w; a2 += sc[2048 + k] * w; a3 += sc[3072 + k] * w;
    }
    *(LAS f32x4*)(part + (ks * 32 + jj) * 4) = (f32x4){a0, a1, a2, a3};
    __syncthreads();
    if (tid < 128) {
      const int j2 = tid & 31, bb = tid >> 5;
      float a = 0.f;
#pragma unroll
      for (int s = 0; s < 16; ++s) a += part[(s * 32 + j2) * 4 + bb];
      p.mod[bb * 6144 + task * 32 + j2] = a + p.b_ada[task * 32 + j2];
    }
    __syncthreads();
  }
}

#define WT_T0 1424
#define WT_T1 (WT_T0 + 16384)
#define WT_T2 (WT_T1 + 8192)
#define WT_T3 (WT_T2 + 128)
#define WT_T4 (WT_T3 + 128)
#define WT_T5 (WT_T4 + 256)
struct WtTile { const float* src; bf16_t* dst; int K, N, mode, k0, n0; unsigned char* dst8; };
__device__ __forceinline__ WtTile wt_desc(const Params& p, int t) {
  WtTile d;
  if (t < WT_T0) { const int kt = t / 89, nt = t % 89; d = {p.w_in, p.w_in_t, 1024, INW, 1, kt * 64, nt * 64, nullptr}; }
  else if (t < WT_T1) { const int u = t - WT_T0, e = u >> 9, r = u & 511, kt = r >> 5, nt = r & 31; d = {p.w_gu + (size_t)e * 1024 * 2048, nullptr, 1024, 2048, 2, kt * 64, nt * 64, p.wgu8 + (size_t)e * 2048 * 1024}; }
  else if (t < WT_T2) { const int u = t - WT_T1, e = u >> 8, r = u & 255, kt = r >> 4, nt = r & 15; d = {p.w_down + (size_t)e * 1024 * 1024, nullptr, 1024, 1024, 0, kt * 64, nt * 64, p.wd8 + (size_t)e * 1024 * 1024}; }
  else if (t < WT_T3) { const int u = t - WT_T2, kt = u >> 4, nt = u & 15; d = {p.w_br_a, p.wbra_t, 512, 1024, 0, kt * 64, nt * 64, nullptr}; }
  else if (t < WT_T4) { const int u = t - WT_T3, kt = u >> 4, nt = u & 15; d = {p.w_br_b, p.wbrb_t, 512, 1024, 0, kt * 64, nt * 64, nullptr}; }
  else { const int u = t - WT_T4, kt = u >> 4, nt = u & 15; d = {p.w_o, p.wo_t, 1024, 1024, 0, kt * 64, nt * 64, nullptr}; }
  return d;
}
__device__ __forceinline__ void wt_load(const WtTile& d, int tid, f32x4 (&v)[2]) {
#pragma unroll
  for (int it = 0; it < 2; ++it) {
    const int row = (tid >> 4) + 32 * it, n = d.n0 + (tid & 15) * 4;
    v[it] = (f32x4){0.f, 0.f, 0.f, 0.f};
    if (n < d.N) v[it] = __builtin_nontemporal_load((const f32x4*)(d.src + (size_t)(d.k0 + row) * d.N + n));
  }
}
__device__ void ph_wt(const Params& p, LAS unsigned char* lds, int nblk, int bid) {
  LAS float* tile = (LAS float*)(lds + 32768);
  const int tid = p.tid;
  int t = bid;
  if (t >= WT_T5) return;
  WtTile cur = wt_desc(p, t);
  f32x4 v[2]; wt_load(cur, tid, v);
  WtTile nxt = cur; f32x4 vn[2] = {v[0], v[1]};
  if (t + nblk < WT_T5) { nxt = wt_desc(p, t + nblk); wt_load(nxt, tid, vn); }
  for (;;) {
    const int tnn = t + 2 * nblk;
    WtTile nn = nxt; f32x4 vnn[2] = {vn[0], vn[1]};
    if (tnn < WT_T5) { nn = wt_desc(p, tnn); wt_load(nn, tid, vnn); }
#pragma unroll
    for (int it = 0; it < 2; ++it) {
      const int row = (tid >> 4) + 32 * it, c4 = (tid & 15) * 4;
      tile[row * 65 + c4] = v[it][0]; tile[row * 65 + c4 + 1] = v[it][1]; tile[row * 65 + c4 + 2] = v[it][2]; tile[row * 65 + c4 + 3] = v[it][3];
    }
    __syncthreads();
    {
      const int nl = tid >> 3, kc = tid & 7, n = cur.n0 + nl;
      if (n < cur.N) {
        const int dd = map_col(n, cur.mode);
        if (dd >= 0) {
          float f[8];
#pragma unroll
          for (int j = 0; j < 8; ++j) f[j] = tile[(8 * kc + j) * 65 + nl];
          if (cur.dst8) {
            u32x2 w; w.x = pk4_fp8(f[0] * 64.f, f[1] * 64.f, f[2] * 64.f, f[3] * 64.f); w.y = pk4_fp8(f[4] * 64.f, f[5] * 64.f, f[6] * 64.f, f[7] * 64.f);
            *(u32x2*)(cur.dst8 + (size_t)dd * cur.K + cur.k0 + 8 * kc) = w;
          } else {
            u32x4 w; w.x = pk2(f[0], f[1]); w.y = pk2(f[2], f[3]); w.z = pk2(f[4], f[5]); w.w = pk2(f[6], f[7]);
            *(u32x4*)(cur.dst + (size_t)dd * cur.K + cur.k0 + 8 * kc) = w;
          }
        }
      }
    }
    __syncthreads();
    if (t + nblk >= WT_T5) break;
    t += nblk; cur = nxt; v[0] = vn[0]; v[1] = vn[1]; nxt = nn; vn[0] = vnn[0]; vn[1] = vnn[1];
  }
}

__device__ void ph_h(const Params& p, LAS unsigned char* lds, int nblk, int bid) {
  const int wid = p.tid >> 6, lane = p.tid & 63;
  LAS float* wb = (LAS float*)lds;
  for (int i = p.tid; i < 2048; i += 512) {
    const int k = i >> 1, hf = i & 1;
    const f32x4 v = *(const f32x4*)(p.w_in + (size_t)k * INW + 2048 + 4 * hf);
    wb[(4 * hf + 0) * 1024 + k] = v[0]; wb[(4 * hf + 1) * 1024 + k] = v[1]; wb[(4 * hf + 2) * 1024 + k] = v[2]; wb[(4 * hf + 3) * 1024 + k] = v[3];
  }
  __syncthreads();
  f32x4 gv[4];
#pragma unroll
  for (int i = 0; i < 4; ++i) gv[i] = *(const f32x4*)(p.g_pre_mix + i * 256 + lane * 4);
  f32x4 xnx[4];
  if (bid * 8 + wid < T_TOK) {
#pragma unroll
    for (int i = 0; i < 4; ++i) xnx[i] = *(const f32x4*)(p.x + (size_t)(bid * 8 + wid) * DM + i * 256 + lane * 4);
  }
  for (int t = bid * 8 + wid; t < T_TOK; t += nblk * 8) {
    const int b = t / SEQ;
    f32x4 xv[4];
    float ss = 0.f;
#pragma unroll
    for (int i = 0; i < 4; ++i) {
      xv[i] = xnx[i];
      ss += xv[i][0] * xv[i][0] + xv[i][1] * xv[i][1] + xv[i][2] * xv[i][2] + xv[i][3] * xv[i][3];
    }
    if (t + nblk * 8 < T_TOK) {
#pragma unroll
      for (int i = 0; i < 4; ++i) xnx[i] = *(const f32x4*)(p.x + (size_t)(t + nblk * 8) * DM + i * 256 + lane * 4);
    }
    ss = wave_sum(ss);
    const float rstd = rsqrtf(ss * (1.f / DM) + 1e-6f);
    const float* shift = p.mod + b * 6144;
    const float* scale = p.mod + b * 6144 + 1024;
    float acc[8] = {0, 0, 0, 0, 0, 0, 0, 0};
    f32x4 scv[4], shv[4];
#pragma unroll
    for (int i = 0; i < 4; ++i) { scv[i] = *(const f32x4*)(scale + i * 256 + lane * 4); shv[i] = *(const f32x4*)(shift + i * 256 + lane * 4); }
#pragma unroll
    for (int i = 0; i < 4; ++i) {
      const int k = i * 256 + lane * 4;
      const f32x4 g = gv[i], sc = scv[i], sh = shv[i];
      f32x4 hv;
#pragma unroll
      for (int j = 0; j < 4; ++j) hv[j] = xv[i][j] * rstd * g[j] * (1.f + sc[j]) + sh[j];
#pragma unroll
      for (int e = 0; e < 8; ++e) { const f32x4 w = *(const LAS f32x4*)(wb + e * 1024 + k); acc[e] += hv[0] * w[0] + hv[1] * w[1] + hv[2] * w[2] + hv[3] * w[3]; }
      u32x2 pk; pk.x = pk2(hv[0], hv[1]); pk.y = pk2(hv[2], hv[3]);
      *(u32x2*)(p.hbf + (size_t)t * DM + k) = pk;
    }
#pragma unroll
    for (int e = 0; e < 8; ++e) acc[e] = wave_sum(acc[e]);
    if (lane == 0) { *(f32x4*)(p.ba + (size_t)t * 8) = (f32x4){acc[0], acc[1], acc[2], acc[3]}; *(f32x4*)(p.ba + (size_t)t * 8 + 4) = (f32x4){acc[4], acc[5], acc[6], acc[7]}; }
  }
}

#define PM_WT 0
#define PM_H2 66048
#define PM_CNT 132096
#define PM_ENT 132352
__device__ void ph_post_mix(const Params& p, LAS unsigned char* lds, int nblk, int bid, int rep) {
  const int wid = p.tid >> 6, lane = p.tid & 63, r16 = lane & 15, q4 = lane >> 4;
  LAS bf16_t* wT = (LAS bf16_t*)(lds + PM_WT);
  LAS bf16_t* ht = (LAS bf16_t*)(lds + PM_H2) + wid * 4 * 1032;
  LAS int* lcnt = (LAS int*)(lds + PM_CNT);
  LAS int* lbase = lcnt + 32;
  LAS int* lent = (LAS int*)(lds + PM_ENT) + wid * 64;
  int nloc = 0;
  if (p.tid < 32) lcnt[p.tid] = 0;
  for (int i = p.tid; i < 1024 * 8; i += 512) {
    const int k = i >> 3, c = i & 7;
    const f32x4 v = *(const f32x4*)(p.w_router + (size_t)k * 32 + c * 4);
#pragma unroll
    for (int j = 0; j < 4; ++j) wT[(c * 4 + j) * 1032 + k] = f2bf_hw(v[j]);
  }
  __syncthreads();
  const float bias0 = p.b_router[r16], bias1 = p.b_router[16 + r16];
  const int tstride = nblk * 8;
  f32x4 gpv[4], gqv[4];
#pragma unroll
  for (int i4 = 0; i4 < 4; ++i4) { const int k = (i4 >> 1) * 512 + lane * 8 + (i4 & 1) * 4; gpv[i4] = *(const f32x4*)(p.g_post_mix + k); gqv[i4] = *(const f32x4*)(p.g_pre_ffn + k); }
  u32x4 mxn[2]; f32x4 xn[4];
  {
    const int t0 = bid * 8 + wid;
    if (t0 < T_TOK) {
#pragma unroll
      for (int i = 0; i < 2; ++i) mxn[i] = *(const u32x4*)(p.mixer + (size_t)t0 * DM + i * 512 + lane * 8);
#pragma unroll
      for (int i = 0; i < 4; ++i) xn[i] = *(const f32x4*)(p.x + (size_t)t0 * DM + (i >> 1) * 512 + lane * 8 + (i & 1) * 4);
    }
  }
  for (int tg = bid * 8 + wid; tg < T_TOK; tg += 4 * tstride) {
#pragma unroll 1
    for (int jj = 0; jj < 4; ++jj) {
      const int t = tg + jj * tstride;
      if (t >= T_TOK) break;
      const int b = t / SEQ;
      const float* md = p.mod + b * 6144;
      u32x4 mxc[2] = {mxn[0], mxn[1]}; f32x4 xc[4] = {xn[0], xn[1], xn[2], xn[3]};
      {
        const int tn = t + tstride;
        if (tn < T_TOK) {
#pragma unroll
          for (int i = 0; i < 2; ++i) mxn[i] = *(const u32x4*)(p.mixer + (size_t)tn * DM + i * 512 + lane * 8);
#pragma unroll
          for (int i = 0; i < 4; ++i) xn[i] = *(const f32x4*)(p.x + (size_t)tn * DM + (i >> 1) * 512 + lane * 8 + (i & 1) * 4);
        }
      }
      float mv[16];
      float ss = 0.f;
#pragma unroll
      for (int i = 0; i < 2; ++i) {
        float f[8]; unpack8(mxc[i], f);
#pragma unroll
        for (int j = 0; j < 8; ++j) { mv[i * 8 + j] = f[j]; ss += f[j] * f[j]; }
      }
      ss = wave_sum(ss);
      const float rstd = rsqrtf(ss * (1.f / DM) + 1e-6f);
      f32x4 gmv[4], scv[4], sfv[4];
#pragma unroll
      for (int i4 = 0; i4 < 4; ++i4) { const int k = (i4 >> 1) * 512 + lane * 8 + (i4 & 1) * 4; gmv[i4] = *(const f32x4*)(md + 2048 + k); scv[i4] = *(const f32x4*)(md + 4096 + k); sfv[i4] = *(const f32x4*)(md + 3072 + k); }
      float x1[16];
      float s2 = 0.f;
#pragma unroll
      for (int i = 0; i < 2; ++i) {
#pragma unroll
        for (int j4 = 0; j4 < 2; ++j4) {
          const f32x4 xv = xc[i * 2 + j4];
          const f32x4 gm = gmv[i * 2 + j4], gp = gpv[i * 2 + j4];
#pragma unroll
          for (int j = 0; j < 4; ++j) { const float o = xv[j] + gm[j] * (mv[i * 8 + j4 * 4 + j] * rstd * gp[j]); x1[i * 8 + j4 * 4 + j] = o; s2 += o * o; }
        }
        u32x4 xb; xb.x = pk2(x1[i * 8], x1[i * 8 + 1]); xb.y = pk2(x1[i * 8 + 2], x1[i * 8 + 3]); xb.z = pk2(x1[i * 8 + 4], x1[i * 8 + 5]); xb.w = pk2(x1[i * 8 + 6], x1[i * 8 + 7]);
        *(u32x4*)(p.hbf + (size_t)t * DM + i * 512 + lane * 8) = xb;
      }
      s2 = wave_sum(s2);
      const float rstd2 = rsqrtf(s2 * (1.f / DM) + 1e-6f);
#pragma unroll
      for (int i = 0; i < 2; ++i) {
        float hv[8];
#pragma unroll
        for (int j4 = 0; j4 < 2; ++j4) {
          const int k = i * 512 + lane * 8 + j4 * 4;
          const f32x4 gq = gqv[i * 2 + j4], sc = scv[i * 2 + j4], sf = sfv[i * 2 + j4];
#pragma unroll
          for (int j = 0; j < 4; ++j) hv[j4 * 4 + j] = x1[i * 8 + j4 * 4 + j] * rstd2 * gq[j] * (1.f + sc[j]) + sf[j];
        }
        u32x2 w; w.x = pk4_fp8(hv[0], hv[1], hv[2], hv[3]); w.y = pk4_fp8(hv[4], hv[5], hv[6], hv[7]);
        *(u32x2*)(p.h2q + (size_t)t * DM + i * 512 + lane * 8) = w;
        u32x4 hb; hb.x = pk2(hv[0], hv[1]); hb.y = pk2(hv[2], hv[3]); hb.z = pk2(hv[4], hv[5]); hb.w = pk2(hv[6], hv[7]);
        *(LAS u32x4*)(ht + jj * 1032 + i * 512 + lane * 8) = hb;
      }
    }
    f32x4 acc0 = {0.f, 0.f, 0.f, 0.f}, acc1 = {0.f, 0.f, 0.f, 0.f};
#pragma unroll 8
    for (int ks = 0; ks < 32; ++ks) {
      const bf16x8 a = *(const LAS bf16x8*)(ht + (r16 & 3) * 1032 + 32 * ks + 8 * q4);
      const bf16x8 b0 = *(const LAS bf16x8*)(wT + r16 * 1032 + 32 * ks + 8 * q4);
      const bf16x8 b1 = *(const LAS bf16x8*)(wT + (16 + r16) * 1032 + 32 * ks + 8 * q4);
      acc0 = MFMA16(a, b0, acc0); acc1 = MFMA16(a, b1, acc1);
    }
#pragma unroll
    for (int jj = 0; jj < 4; ++jj) {
      const int t = tg + jj * tstride;
      if (t < T_TOK) {
        float l0 = (lane < 16) ? acc0[jj] + bias0 : -INFINITY, l1 = (lane < 16) ? acc1[jj] + bias1 : -INFINITY;
        float tv[4]; int ti[4];
#pragma unroll
        for (int r = 0; r < 4; ++r) {
          const float m = wave_max(fmaxf(l0, l1));
          const unsigned long long b0m = __ballot(l0 == m);
          int idx;
          if (b0m) { idx = __ffsll((long long)b0m) - 1; if (lane == idx) l0 = -INFINITY; }
          else { const unsigned long long b1m = __ballot(l1 == m); idx = __ffsll((long long)b1m) - 1; if (lane == idx) l1 = -INFINITY; idx += 16; }
          tv[r] = m; ti[r] = idx;
        }
        const float e1 = __expf(tv[1] - tv[0]), e2 = __expf(tv[2] - tv[0]), e3 = __expf(tv[3] - tv[0]);
        const float inv = 1.f / (1.f + e1 + e2 + e3);
        if (lane < 4) {
          const int ee = lane == 0 ? ti[0] : lane == 1 ? ti[1] : lane == 2 ? ti[2] : ti[3];
          const float ww = (lane == 0 ? 1.f : lane == 1 ? e1 : lane == 2 ? e2 : e3) * inv;
          p.aw[t * 4 + lane] = ww;
          const int rank = __hip_atomic_fetch_add(&lcnt[ee], 1, __ATOMIC_RELAXED, __HIP_MEMORY_SCOPE_WORKGROUP);
          lent[nloc * 4 + lane] = (ee << 16) | rank;
          lent[nloc * 4 + lane + 2048] = t * 4 + lane;
        }
        ++nloc;
      }
    }
  }
  __syncthreads();
  if (p.tid < 32) lbase[p.tid] = atomicAdd(&p.cnt[p.tid * 64 + 32 * rep], lcnt[p.tid]);
  __syncthreads();
  for (int i = lane; i < nloc * 4; i += 64) {
    const int er = lent[i], a = lent[i + 2048];
    p.elist[(er >> 16) * T_TOK + lbase[er >> 16] + (er & 0xffff)] = a;
  }
}

__device__ void ph_final(const Params& p, int nblk, int bid, int rep) {
  const int wid = p.tid >> 6, lane = p.tid & 63;
  f32x4 gpf[4];
#pragma unroll
  for (int i4 = 0; i4 < 4; ++i4) gpf[i4] = *(const f32x4*)(p.g_post_ffn + (i4 >> 1) * 512 + lane * 8 + (i4 & 1) * 4);
  for (int t0 = bid * 8 + wid; t0 < T_TOK; t0 += nblk * 16) {
    int tt[2] = {t0, t0 + nblk * 8};
    if (tt[1] >= T_TOK) tt[1] = t0;
    float mv[2][16]; float ss[2];
#pragma unroll
    for (int u = 0; u < 2; ++u) {
      const int t = tt[u];
      const f32x4 wv = *(const f32x4*)(p.aw + t * 4) * 0.125f;
      ss[u] = 0.f;
#pragma unroll
      for (int i = 0; i < 2; ++i) {
        const unsigned char* y = (const unsigned char*)p.yslot + (size_t)t * 4 * DM + i * 512 + lane * 8;
        float f0[8], f1[8], f2[8], f3[8];
        unpack8_fp8(*(const u32x2*)y, f0); unpack8_fp8(*(const u32x2*)(y + DM), f1); unpack8_fp8(*(const u32x2*)(y + 2 * DM), f2); unpack8_fp8(*(const u32x2*)(y + 3 * DM), f3);
#pragma unroll
        for (int j = 0; j < 8; ++j) { const float m = wv[0] * f0[j] + wv[1] * f1[j] + wv[2] * f2[j] + wv[3] * f3[j]; mv[u][i * 8 + j] = m; ss[u] += m * m; }
      }
    }
    u32x4 x1[2][2];
#pragma unroll
    for (int u = 0; u < 2; ++u)
#pragma unroll
      for (int i = 0; i < 2; ++i) x1[u][i] = *(const u32x4*)(p.hbf + (size_t)tt[u] * DM + i * 512 + lane * 8);
    f32x4 gfv[2][4];
#pragma unroll
    for (int u = 0; u < 2; ++u)
#pragma unroll
      for (int i4 = 0; i4 < 4; ++i4) gfv[u][i4] = *(const f32x4*)(p.mod + (tt[u] / SEQ) * 6144 + 5120 + (i4 >> 1) * 512 + lane * 8 + (i4 & 1) * 4);
    ss[0] = wave_sum(ss[0]); ss[1] = wave_sum(ss[1]);
#pragma unroll
    for (int u = 0; u < 2; ++u) {
      const int t = tt[u];
      if (u == 1 && t == t0) break;
      const float rstd = rsqrtf(ss[u] * (1.f / DM) + 1e-6f);
#pragma unroll
      for (int i = 0; i < 2; ++i) {
        float xf[8]; unpack8(x1[u][i], xf);
#pragma unroll
        for (int j4 = 0; j4 < 2; ++j4) {
          const int k = i * 512 + lane * 8 + j4 * 4;
          float* op = p.out + (size_t)t * DM + k;
          const f32x4 gf = gfv[u][i * 2 + j4], gp = gpf[i * 2 + j4];
          f32x4 o;
#pragma unroll
          for (int j = 0; j < 4; ++j) o[j] = xf[j4 * 4 + j] + gf[j] * (mv[u][i * 8 + j4 * 4 + j] * rstd * gp[j]);
          *(f32x4*)(rep ? (float*)p.merged + (size_t)(t & 8191) * DM + k : op) = o;
        }
      }
    }
  }
}

#define XCD_BAR_WORDS 3456
struct KArgs { const void* in[22]; float* out; char* ws; long long never; };
__host__ __device__ inline size_t al(size_t x) { return (x + 255) & ~(size_t)255; }
__host__ __device__ inline void fill_params(Params& p, const KArgs& k) {
  p.x = (const float*)k.in[0]; p.c = (const float*)k.in[1]; p.w_ada = (const float*)k.in[2]; p.b_ada = (const float*)k.in[3];
  p.g_pre_mix = (const float*)k.in[4]; p.g_post_mix = (const float*)k.in[5]; p.g_pre_ffn = (const float*)k.in[6];
  p.g_post_ffn = (const float*)k.in[7]; p.w_in = (const float*)k.in[8]; p.conv_w = (const float*)k.in[9];
  p.a_log = (const float*)k.in[10]; p.dt_bias = (const float*)k.in[11]; p.g_dn_out = (const float*)k.in[12];
  p.w_br_a = (const float*)k.in[13]; p.w_br_b = (const float*)k.in[14]; p.w_o = (const float*)k.in[15];
  p.w_router = (const float*)k.in[16]; p.b_router = (const float*)k.in[17]; p.w_gu = (const float*)k.in[18];
  p.b_gu = (const float*)k.in[19]; p.w_down = (const float*)k.in[20]; p.b_down = (const float*)k.in[21];
  p.out = k.out;
  char* w = k.ws;
  size_t o = 0;
#define take(bytes) (w + (o += al(bytes)) - al(bytes))
  p.mod = (float*)take(4 * 6144 * 4);
  p.cnt = (int*)take(16384);
  p.ba = (float*)take((size_t)T_TOK * 8 * 4);
  p.hbf = (bf16_t*)take((size_t)T_TOK * DM * 2);
  p.proj = (bf16_t*)take((size_t)T_TOK * PW * 2);
  p.w_in_t = (bf16_t*)take((size_t)PW * DM * 2);
  p.wgu8 = (unsigned char*)take((size_t)NE * 2048 * DM);
  p.wd8 = (unsigned char*)take((size_t)NE * 1024 * DM);
  p.h2q = (unsigned char*)take((size_t)T_TOK * DM);
  p.act8 = (unsigned char*)take((size_t)73728 * DM);
  p.wbra_t = (bf16_t*)take((size_t)1024 * 512 * 2);
  p.wbrb_t = (bf16_t*)take((size_t)1024 * 512 * 2);
  p.wo_t = (bf16_t*)take((size_t)1024 * 1024 * 2);
  p.qb = (bf16_t*)take((size_t)T_TOK * 512 * 2);
  p.kb = nullptr;
  p.kmean = (float*)take((size_t)16 * 16 * 128 * 4);
  p.oab = (bf16_t*)take((size_t)T_TOK * DM * 2);
  p.merged = (bf16_t*)take((size_t)T_TOK * DM * 2);
  p.mixer = (bf16_t*)take((size_t)T_TOK * DM * 2);
  p.h2 = nullptr;
  p.elist = (int*)take((size_t)NE * T_TOK * 4);
  p.aw = (float*)take((size_t)T_TOK * 4 * 4);
  p.rowmap = nullptr;
  p.dnA = (unsigned char*)take((size_t)1024 * DN_ABYTES);
  p.dnU = (float*)take((size_t)1024 * DN_UFLOATS * 4);
  p.dnG = (float*)take(4096);
  p.dnS = (unsigned char*)take((size_t)1024 * 8 * 4096);
  p.dnV = (unsigned char*)take((size_t)1024 * 8 * 2048);
  p.oab2 = (bf16_t*)take((size_t)T_TOK * 512 * 2);
  p.dbg = (float*)take(256);
  p.bar = (unsigned*)take(XCD_BAR_WORDS * 4);
  p.dn_out = p.oab; p.dn_out_ld = DM;
  p.Kp = (bf16_t*)take((size_t)16 * 128 * 8192);
  p.Vp = (bf16_t*)take((size_t)16 * 128 * 8192);
  p.wq = p.cnt + 32 * 64;
  p.dep = p.cnt + 2304;
  p.mb_out = p.oab; p.mb_out_ld = DM; p.mb_out_off = 512;
  p.xs = nullptr; p.act = nullptr;
  p.yslot = (bf16_t*)take((size_t)65536 * DM * 2);
  p.nq = p.nk = p.nv = p.no = p.ntmp = p.nbeta = p.ng = nullptr;
#undef take
#undef t2
  p.never = (int)k.never;
}

#define XB_TMO      128
#define XB_XCNT(j)  (256  + 64 * (j))
#define XB_XSUB(j)  (1280 + 64 * (j))
#define XB_XGEN(j)  (2304 + 64 * (j))
#define XB_TOP      3328
#define XB_TOPGEN   3392
#define XB_SPIN_CAP (1u << 18)

__device__ __forceinline__ unsigned xb_ld(unsigned* p)              { return __hip_atomic_load(p, __ATOMIC_RELAXED, __HIP_MEMORY_SCOPE_AGENT); }
__device__ __forceinline__ unsigned xb_add(unsigned* p, unsigned v) { return __hip_atomic_fetch_add(p, v, __ATOMIC_RELAXED, __HIP_MEMORY_SCOPE_AGENT); }
__device__ __forceinline__ unsigned xb_xcc_id() { return (unsigned)__builtin_amdgcn_s_getreg((3 << 11) | 20) & 0xFu; }
#define XB_SPIN(cond, bar) do { unsigned _sp = 0; while (cond) { __builtin_amdgcn_s_sleep(1); \
    if ((++_sp & 255u) == 0u) { if (xb_ld(&(bar)[XB_TMO])) break; if (_sp > XB_SPIN_CAP) { atomicAdd(&(bar)[XB_TMO], 1u); break; } } } } while (0)

struct XcdBarrier {
    unsigned* bar; unsigned x;
    volatile LAS unsigned* st;
};

__device__ __forceinline__ XcdBarrier xcd_barrier_post(unsigned* bar, volatile LAS unsigned* st) {
    XcdBarrier b; b.bar = bar; b.x = xb_xcc_id(); b.st = st;
    if (threadIdx.x == 0) (void)xb_add(&bar[XB_XCNT(b.x)], 1u);
    return b;
}
__device__ __forceinline__ void xcd_barrier_complete(unsigned* bar, unsigned x, unsigned& nloc, unsigned& nx) {
    const unsigned G = gridDim.x * gridDim.y * gridDim.z;
    unsigned sum, cnt, mine, sp = 0u;
    for (;;) {
        sum = 0u; cnt = 0u; mine = 0u;
#pragma unroll
        for (unsigned j = 0; j < 16; ++j) { const unsigned c = xb_ld(&bar[XB_XCNT(j)]); sum += c; cnt += (c > 0u) ? 1u : 0u; mine = (j == x) ? c : mine; }
        if (sum == G) break;
        __builtin_amdgcn_s_sleep(1);
        if ((++sp & 255u) == 0u) { if (xb_ld(&bar[XB_TMO])) break; if (sp > XB_SPIN_CAP) { atomicAdd(&bar[XB_TMO], 1u); break; } }
    }
    nloc = mine > 0u ? mine : 1u; nx = cnt > 0u ? cnt : 1u;
}

__device__ __forceinline__ void xcd_barrier(const XcdBarrier& b, const int tid) {
    asm volatile("s_waitcnt vmcnt(0)" ::: "memory");
    __syncthreads();
    if (tid == 0) {
        unsigned* bar = b.bar;
        __builtin_amdgcn_s_waitcnt(0);
        unsigned nloc = b.st[0], nx = b.st[1];
        if (nloc == 0u) { xcd_barrier_complete(bar, b.x, nloc, nx); b.st[0] = nloc; b.st[1] = nx; }
        const unsigned old = xb_add(&bar[XB_XSUB(b.x)], 1u);
        const unsigned gen = old / nloc;
        if (old + 1u == (gen + 1u) * nloc) {
            __builtin_amdgcn_fence(__ATOMIC_RELEASE, "agent");
            asm volatile("s_waitcnt vmcnt(0)" ::: "memory");
            const unsigned og = xb_add(&bar[XB_TOP], 1u);
            const unsigned tg = og / nx;
            if (og + 1u == (tg + 1u) * nx) xb_add(&bar[XB_TOPGEN], 1u);
            else XB_SPIN(xb_ld(&bar[XB_TOPGEN]) == tg, bar);
            __builtin_amdgcn_fence(__ATOMIC_ACQUIRE, "agent");
            xb_add(&bar[XB_XGEN(b.x)], 1u);
            asm volatile("s_waitcnt vmcnt(0)" ::: "memory");
        } else {
            XB_SPIN(xb_ld(&bar[XB_XGEN(b.x)]) == gen, bar);
            __builtin_amdgcn_fence(__ATOMIC_ACQUIRE, "agent");
            asm volatile("s_waitcnt vmcnt(0)" ::: "memory");
        }
    }
    __syncthreads();
}


__device__ __forceinline__ void load_ka(KArgs& kk) {
#if defined(__HIP_DEVICE_COMPILE__)
  typedef __attribute__((address_space(1))) char* gptr_t;
  typedef const __attribute__((address_space(4))) gptr_t* kptr_t;
  kptr_t kp = (kptr_t)__builtin_amdgcn_kernarg_segment_ptr();
  asm volatile("" : "+s"(kp));
#pragma unroll
  for (int i = 0; i < 22; ++i) kk.in[i] = (const void*)kp[i];
  kk.out = (float*)kp[22];
  kk.ws = (char*)kp[23];
  kk.never = ((const __attribute__((address_space(4))) long long*)kp)[24];
#endif
}
__device__ __forceinline__ void grid_bar(const Params& p, LAS unsigned char* lds);
#define MEGA_LDS 148480
#define MEGA_LDS_ALLOC (MEGA_LDS + 16)
__device__ __forceinline__ void grid_bar(const Params& p, LAS unsigned char* lds) {
  XcdBarrier b; b.bar = p.bar; b.x = xb_xcc_id(); b.st = (volatile LAS unsigned*)(lds + MEGA_LDS);
  xcd_barrier(b, p.tid);
}
__global__ __launch_bounds__(512) void mega(KArgs ka) {
  extern __shared__ __attribute__((aligned(16))) unsigned char shm[];
  LAS unsigned char* lds = (LAS unsigned char*)shm;
  cg::grid_group grid = cg::this_grid();
  const int nblk = gridDim.x, bid = blockIdx.x;
  const int wv_ = __builtin_amdgcn_readfirstlane(threadIdx.x >> 6);
  volatile LAS unsigned* xst = (volatile LAS unsigned*)(lds + MEGA_LDS);
  if (threadIdx.x == 0) { xst[0] = 0u; xst[1] = 0u; xst[2] = 0u; xst[3] = 0u; }
  __syncthreads();
  { Params p0; fill_params(p0, ka); (void)xcd_barrier_post(p0.bar, xst); }
  if (ka.never) grid.sync();
#ifndef REPMASK
#define REPMASK 0
#endif
#define LOADKA KArgs kk; load_ka(kk)
#ifndef PHMASK
#define PHMASK 0xffff
#endif
#define PHASE_(k, body, bar) if (((PHMASK) >> (k)) & 1) for (int rep_ = 0; rep_ < (((REPMASK) >> (k)) & 1) + 1; ++rep_) { \
    LOADKA; Params p; fill_params(p, kk); { int t_; asm volatile("v_mbcnt_lo_u32_b32 %0, -1, 0\n\tv_mbcnt_hi_u32_b32 %0, -1, %0" : "=v"(t_)); p.tid = (wv_ << 6) | t_; } body; bar; }
#define PHASE(k, body) PHASE_(k, body, grid_bar(p, lds))
#define PHASE_LAST(k, body) PHASE_(k, body, (void)0)
#ifdef XBAR
  for (int xb_ = 0; xb_ < XBAR; ++xb_) { PHASE(15, {}) }
#endif
  PHASE(0, { ph_mod(p, lds, nblk, bid); ph_wt(p, lds, nblk, bid); })
  PHASE(1, { ph_h(p, lds, nblk, bid); })
  PHASE(2, { ph_proj(p, lds, nblk, bid); })
  PHASE(3, { bool first = true; for (int ci = bid; ci < 1024; ci += nblk) { dn_prep_chunk(p, lds, ci, first); first = false; }
             for (int item = bid; item < 256; item += nblk) moba_prep_block(p, lds, item); })
  PHASE(4, { if (bid < 32) dn_scan_blk(p, lds, bid); moba_worker(p, lds, rep_); })
  PHASE(5, { ph_dn_out(p, lds, nblk, bid); })
  PHASE(6, { ph_br(p, lds, nblk, bid); })
  PHASE(7, { ph_mix(p, lds, nblk, bid); })
  PHASE(8, { ph_post_mix(p, lds, nblk, bid, rep_); })
  PHASE(10, { ph_moe1(p, lds, nblk, bid); ph_moe2(p, lds, nblk, bid); })
  PHASE_LAST(12, { ph_final(p, nblk, bid, rep_); })
}


extern "C" void kernel_launch(void* const* d_in, const int* in_sizes, int n_in, void* d_out, int out_size, void* d_ws,
                              size_t ws_size, hipStream_t stream) {
  KArgs ka{};
  for (int i = 0; i < 22; ++i) ka.in[i] = d_in[i];
  ka.out = (float*)d_out; ka.ws = (char*)d_ws; ka.never = 0;
  Params p{};
  fill_params(p, ka);
  static int grid_blocks = 0;
  if (!grid_blocks) {
    (void)hipFuncSetAttribute((const void*)mega, hipFuncAttributeMaxDynamicSharedMemorySize, MEGA_LDS_ALLOC);
    int dev = 0, cus = 0, per_cu = 0;
    (void)hipGetDevice(&dev);
    (void)hipDeviceGetAttribute(&cus, hipDeviceAttributeMultiprocessorCount, dev);
    (void)hipOccupancyMaxActiveBlocksPerMultiprocessor(&per_cu, mega, 512, MEGA_LDS_ALLOC);
    if (per_cu != 1) per_cu = 1;
    grid_blocks = cus * per_cu;
  }
  (void)hipMemsetAsync(p.cnt, 0, 16384, stream);
  (void)hipMemsetAsync(p.bar, 0, XCD_BAR_WORDS * 4, stream);
  void* args[] = {&ka};
  hipError_t e = hipLaunchCooperativeKernel((void*)mega, dim3(grid_blocks), dim3(512), args, MEGA_LDS_ALLOC, stream);
  if (e != hipSuccess) fprintf(stderr, "cooperative launch failed: %s (grid %d)\n", hipGetErrorString(e), grid_blocks);
}
```

```cpp
#include <hip/hip_runtime.h>
#include <hip/hip_cooperative_groups.h>
#include <cstdio>
namespace cg = cooperative_groups;
#include <stdint.h>

typedef unsigned short bf16_t;
#ifndef MB_ABL
#define MB_ABL 0
#endif

#define T_TOK 16384
#define SEQ 4096
#define NB 4
#define DM 1024
#define INW 5640
#define PW 5632
#define C_QA 0
#define C_KA 512
#define C_VA 1024
#define C_Z 1536
#define C_MQ 2048
#define C_MK 2560
#define C_MV 3072
#define C_GA 3584
#define C_GB 4608
#define NE 32

__device__ __forceinline__ bf16_t f2bf(float f) {
  unsigned u = __float_as_uint(f);
  u += 0x7fffu + ((u >> 16) & 1u);
  return (bf16_t)(u >> 16);
}
__device__ __forceinline__ float bf2f(bf16_t h) { return __uint_as_float(((unsigned)h) << 16); }
__device__ __forceinline__ float sigmoidf_(float x) { return __builtin_amdgcn_rcpf(1.f + __builtin_amdgcn_exp2f(-1.4426950408889634f * x)); }
__device__ __forceinline__ float siluf_(float x) { return x * sigmoidf_(x); }
__device__ __forceinline__ float wave_sum(float v) {
#pragma unroll
  for (int o = 32; o > 0; o >>= 1) v += __shfl_xor(v, o, 64);
  return v;
}
__device__ __forceinline__ float wave_max(float v) {
#pragma unroll
  for (int o = 32; o > 0; o >>= 1) v = fmaxf(v, __shfl_xor(v, o, 64));
  return v;
}

typedef unsigned u32x2 __attribute__((ext_vector_type(2)));
typedef __bf16 bf16x2_t __attribute__((ext_vector_type(2)));
typedef float f32x2_t __attribute__((ext_vector_type(2)));
__device__ __forceinline__ unsigned pk2(float a, float b) { f32x2_t v = {a, b}; bf16x2_t r = __builtin_convertvector(v, bf16x2_t); return __builtin_bit_cast(unsigned, r); }

__device__ __forceinline__ unsigned pk4_fp8(float a, float b, float c, float d) {
  int w = 0;
  w = __builtin_amdgcn_cvt_pk_fp8_f32(a, b, w, false);
  w = __builtin_amdgcn_cvt_pk_fp8_f32(c, d, w, true);
  return (unsigned)w;
}
__device__ __forceinline__ void unpack8_fp8(const u32x2 w, float (&f)[8]) {
  const f32x2_t a = __builtin_amdgcn_cvt_pk_f32_fp8((int)w.x, false), b = __builtin_amdgcn_cvt_pk_f32_fp8((int)w.x, true);
  const f32x2_t c = __builtin_amdgcn_cvt_pk_f32_fp8((int)w.y, false), d = __builtin_amdgcn_cvt_pk_f32_fp8((int)w.y, true);
  f[0] = a[0]; f[1] = a[1]; f[2] = b[0]; f[3] = b[1]; f[4] = c[0]; f[5] = c[1]; f[6] = d[0]; f[7] = d[1];
}

struct Params {
  const float *x, *c, *w_ada, *b_ada, *g_pre_mix, *g_post_mix, *g_pre_ffn, *g_post_ffn, *w_in, *conv_w,
      *a_log, *dt_bias, *g_dn_out, *w_br_a, *w_br_b, *w_o, *w_router, *b_router, *w_gu, *b_gu, *w_down, *b_down;
  float* out;
  float* mod;
  int* cnt;
  int* dep;
  float* ba;
  bf16_t* hbf;
  bf16_t* proj;
  bf16_t* w_in_t;
  unsigned char* wgu8;
  unsigned char* wd8;
  unsigned char* h2q;
  unsigned char* act8;
  bf16_t* wbra_t;
  bf16_t* wbrb_t;
  bf16_t* wo_t;
  bf16_t* qb;
  bf16_t* kb;
  float* kmean;
  bf16_t* oab;
  bf16_t* merged;
  bf16_t* mixer;
  bf16_t* h2;
  int* elist;
  float* aw;
  bf16_t* act;
  bf16_t* xs;
  int* rowmap;
  bf16_t* yslot;
  unsigned char* dnA; float* dnU; float* dnG;
  unsigned char* dnS; unsigned char* dnV;
  bf16_t* dn_out; int dn_out_ld;
  bf16_t* oab2; float* dbg;
  unsigned* bar; int never; int tid;
  bf16_t* Kp; bf16_t* Vp; int* wq;
  bf16_t* mb_out; int mb_out_ld; int mb_out_off;
  float* nq; float* nk; float* nv;
  float* nbeta; float* ng;
  float* no;
  float* ntmp;
};

__device__ __forceinline__ int map_col(int n, int mode) {
  if (mode == 0) return n;
  if (mode == 1) return n < 2048 ? n : (n < 2056 ? -1 : n - 8);
  if (n < 1024) return (n >> 7) * 256 + (n & 127);
  int j = n - 1024;
  return (j >> 7) * 256 + 128 + (j & 127);
}
namespace pg8 {
#define PG8_LAS __attribute__((address_space(3)))
typedef short bf16x8 __attribute__((ext_vector_type(8)));
typedef float f32x4 __attribute__((ext_vector_type(4)));
typedef unsigned u32x4 __attribute__((ext_vector_type(4)));
constexpr int BM = 256, BK = 64, HALF = 128, HTB = HALF * BK * 2, STAGE_BYTES = 8 * HTB, NXCD = 8, WGM = 8;

__host__ __device__ __forceinline__ int lds_byte(int r, int c) { const int st = (r >> 4) * 2 + (c >> 5), rr = r & 15, cc = c & 31, ob = rr * 64 + cc * 2; return st * 1024 + (ob ^ (((ob >> 9) & 1) << 5)); }
__host__ __device__ __forceinline__ void stage_rc(int b, int& R, int& C) { const int st = b / 1024, sb = b % 1024, swz = sb ^ (((sb >> 9) & 1) << 5); R = (st >> 1) * 16 + swz / 64; C = (st & 1) * 32 + (swz % 64) / 2; }
__host__ __device__ __forceinline__ int perm32(int rho) { const int n = rho >> 4, i = rho & 15; return 8 * (i >> 2) + 4 * n + (i & 3); }

struct Unit { int pm, pn, z; };
__device__ __forceinline__ unsigned cvt_pk_bf16(float lo, float hi) { unsigned r; asm volatile("v_cvt_pk_bf16_f32 %0, %1, %2" : "=v"(r) : "v"(lo), "v"(hi)); return r; }

typedef int i32x8 __attribute__((ext_vector_type(8)));
typedef int i32x4 __attribute__((ext_vector_type(4)));
__device__ __forceinline__ i32x8 cat8(const bf16x8 lo, const bf16x8 hi) { const i32x4 a = __builtin_bit_cast(i32x4, lo), b = __builtin_bit_cast(i32x4, hi); return __builtin_shufflevector(a, b, 0, 1, 2, 3, 4, 5, 6, 7); }
struct TileOrder {
    int nM, nN, nwg, G, c;
    __device__ void init(int nM_, int nN_, int G_, int c_) { nM = nM_; nN = nN_; nwg = nM * nN; G = G_; c = c_; }
    __device__ bool tile(int i, int& pm, int& pn) const {
        const long L = (long)i * G + c; if (L >= nwg) return false;
        int wgid = (int)L; { const int q = nwg / NXCD, r = nwg % NXCD, xcd = wgid % NXCD, off = wgid / NXCD; wgid = (xcd < r ? xcd * (q + 1) : r * (q + 1) + (xcd - r) * q) + off; }
        const int nig = WGM * nN, gid = wgid / nig, fm = gid * WGM, gsz = (nM - fm) < WGM ? (nM - fm) : WGM;
        pm = fm + ((wgid % nig) % gsz); pn = (wgid % nig) / gsz; return true;
    }
};

template <class Epi, class Sched, bool FP8 = false>
__device__ __forceinline__ void gemm_phase(PG8_LAS unsigned char* lds, const int tid, const int lda, const int ldb, const int K, const Sched& S, const Epi& E) {
    const int wid = __builtin_amdgcn_readfirstlane(tid >> 6), lane = tid & 63, wr = wid >> 2, wc = wid & 3, fr = lane & 15, fq = lane >> 4;
    const int nt = K / BK;
    unsigned voffA[2], voffB[2];
#pragma unroll
    for (int i = 0; i < 2; ++i) { int R, C; stage_rc(tid * 16 + i * 8192, R, C); const int Rb = Epi::PERM ? ((R & ~31) + perm32(R & 31)) : R;
        voffA[i] = (unsigned)(R * lda + C) * 2u; voffB[i] = (unsigned)(Rb * ldb + C) * 2u; }
    const size_t kstep = (size_t)(BK * 2);
    const size_t hstepA = (size_t)HALF * lda * 2, hstepB = (size_t)HALF * ldb * 2;
    const unsigned ldsw = (unsigned)wid * 1024u;
    const int aoff = lds_byte(wr * 64 + fr, fq * 8), boff = lds_byte(wc * 32 + fr, fq * 8);
    constexpr int KOFF1 = 1024;
    unsigned gA[2][2] = {{0u, 0u}, {0u, 0u}}, gAn[2][2] = {{0u, 0u}, {0u, 0u}};
#define PG8_GOFFS(dst, unit) do { int t_ = tid; asm volatile("" : "+v"(t_)); _Pragma("unroll") for (int i_ = 0; i_ < 2; ++i_) { int gR_, gC_; stage_rc(t_ * 16 + i_ * 8192, gR_, gC_); \
        _Pragma("unroll") for (int h_ = 0; h_ < 2; ++h_) dst[h_][i_] = S.a_goff(unit, gR_ + 128 * h_, gC_); } } while (0)
#define PG8_SA(b, h) (((b) * 2 + (h)) * HTB)
#define PG8_SB(b, h) ((4 + (b) * 2 + (h)) * HTB)
#define PG8_STAGE(bufoff, gbase, voff) do { _Pragma("unroll") for (int _i = 0; _i < 2; ++_i) \
        __builtin_amdgcn_global_load_lds((const unsigned*)((const char*)(gbase) + (voff)[_i]), (PG8_LAS unsigned*)(lds + (bufoff) + ldsw + _i * 8192), 16, 0, 0); } while (0)
#define PG8_STAGEA(bufoff, ptr, h, nx) do { if constexpr (Sched::GATHER) { const unsigned gs_[2] = {(nx) ? gAn[h][0] : gA[h][0], (nx) ? gAn[h][1] : gA[h][1]}; PG8_STAGE(bufoff, ptr, gs_); } \
        else { PG8_STAGE(bufoff, (ptr) + (h) * hstepA, voffA); } } while (0)
#define PG8_LDA(dst, b, h) do { if constexpr (FP8) { _Pragma("unroll") for (int m = 0; m < 4; ++m) dst##8[m] = cat8(*(const PG8_LAS bf16x8*)(lds + PG8_SA(b, h) + aoff + m * 2048), *(const PG8_LAS bf16x8*)(lds + PG8_SA(b, h) + aoff + KOFF1 + m * 2048)); } \
        else { _Pragma("unroll") for (int m = 0; m < 4; ++m) _Pragma("unroll") for (int k = 0; k < 2; ++k) dst[m][k] = *(const PG8_LAS bf16x8*)(lds + PG8_SA(b, h) + aoff + k * KOFF1 + m * 2048); } } while (0)
#define PG8_LDB(dst, b, h) do { if constexpr (FP8) { _Pragma("unroll") for (int n = 0; n < 2; ++n) dst##8[n] = cat8(*(const PG8_LAS bf16x8*)(lds + PG8_SB(b, h) + boff + n * 2048), *(const PG8_LAS bf16x8*)(lds + PG8_SB(b, h) + boff + KOFF1 + n * 2048)); } \
        else { _Pragma("unroll") for (int n = 0; n < 2; ++n) _Pragma("unroll") for (int k = 0; k < 2; ++k) dst[n][k] = *(const PG8_LAS bf16x8*)(lds + PG8_SB(b, h) + boff + k * KOFF1 + n * 2048); } } while (0)
#define PG8_MMA(ai, bj, At, Bt) do { __builtin_amdgcn_s_setprio(1); if constexpr (FP8) { _Pragma("unroll") for (int m = 0; m < 4; ++m) _Pragma("unroll") for (int n = 0; n < 2; ++n) \
        asm volatile("v_mfma_f32_16x16x128_f8f6f4 %0, %1, %2, %0" : "+v"(acc[ai][bj][m][n]) : "v"(Bt##8[n]), "v"(At##8[m])); } \
        else { _Pragma("unroll") for (int m = 0; m < 4; ++m) _Pragma("unroll") for (int n = 0; n < 2; ++n) _Pragma("unroll") for (int k = 0; k < 2; ++k) \
        acc[ai][bj][m][n] = __builtin_amdgcn_mfma_f32_16x16x32_bf16(Bt[n][k], At[m][k], acc[ai][bj][m][n], 0, 0, 0); } __builtin_amdgcn_s_setprio(0); } while (0)
#define PG8_WAIT_V(n) asm volatile("s_waitcnt vmcnt(" #n ")" ::: "memory")
#define PG8_WAIT_L(n) asm volatile("s_waitcnt lgkmcnt(" #n ")" ::: "memory")
#define PG8_BAR __builtin_amdgcn_s_barrier()
#define PG8_SCHED __builtin_amdgcn_sched_barrier(0)
    Unit cur, nxt; int ui = 0;
    if (!S.next(0, cur)) return;
    f32x4 acc[2][2][4][2];
#pragma unroll
    for (int a = 0; a < 2; ++a)
#pragma unroll
        for (int b = 0; b < 2; ++b)
#pragma unroll
            for (int m = 0; m < 4; ++m)
#pragma unroll
                for (int n = 0; n < 2; ++n) acc[a][b][m][n] = (f32x4){0.f, 0.f, 0.f, 0.f};
    bf16x8 At[4][2], B0[2][2], B1[2][2];
    i32x8 At8[4], B08[2], B18[2];
    const char* cA = S.a_ptr(cur); const char* cB = S.b_ptr(cur);
    if constexpr (Sched::GATHER) { PG8_GOFFS(gA, cur); }
    PG8_STAGE(PG8_SB(0, 0), cB, voffB); PG8_STAGEA(PG8_SA(0, 0), cA, 0, false); PG8_STAGE(PG8_SB(0, 1), cB + hstepB, voffB); PG8_STAGEA(PG8_SA(0, 1), cA, 1, false);
    if (wr == 1) PG8_BAR;
    PG8_WAIT_V(4); PG8_BAR;
    PG8_STAGE(PG8_SB(1, 0), cB + kstep, voffB); PG8_STAGEA(PG8_SA(1, 0), cA + kstep, 0, false); PG8_STAGE(PG8_SB(1, 1), cB + hstepB + kstep, voffB);
    PG8_WAIT_V(6); PG8_BAR;
    for (;;) {
        const bool has_next = S.next(ui + 1, nxt);
        const char* nA = has_next ? S.a_ptr(nxt) : cA; const char* nB = has_next ? S.b_ptr(nxt) : cB;
        if constexpr (Sched::GATHER) { if (has_next) { PG8_GOFFS(gAn, nxt); } else {
_Pragma("unroll") for (int h = 0; h < 2; ++h) _Pragma("unroll") for (int i = 0; i < 2; ++i) gAn[h][i] = gA[h][i]; } }
_Pragma("unroll 1")
        for (int t = 0; t < nt; t += 2) {
            const bool last = (t == nt - 2);
            const char* a1 = cA + (size_t)(t + 1) * kstep;
            const char* a2 = last ? nA : cA + (size_t)(t + 2) * kstep; const char* b2 = last ? nB : cB + (size_t)(t + 2) * kstep;
            const char* a3 = a2 + kstep; const char* b3 = b2 + kstep;
            PG8_LDB(B0, 0, 0); PG8_SCHED; PG8_LDA(At, 0, 0); PG8_STAGEA(PG8_SA(1, 1), a1, 1, false);
            PG8_WAIT_L(8); PG8_BAR; PG8_WAIT_L(0); PG8_MMA(0, 0, At, B0); PG8_BAR; PG8_SCHED;
            PG8_LDB(B1, 0, 1); PG8_STAGE(PG8_SB(0, 0), b2, voffB);
            PG8_BAR; PG8_WAIT_L(0); PG8_MMA(0, 1, At, B1); PG8_BAR;
            PG8_LDA(At, 0, 1); PG8_STAGEA(PG8_SA(0, 0), a2, 0, last);
            PG8_BAR; PG8_WAIT_L(0); PG8_MMA(1, 0, At, B0); PG8_BAR; PG8_SCHED;
            PG8_STAGE(PG8_SB(0, 1), b2 + hstepB, voffB);
            PG8_WAIT_V(6); PG8_BAR; PG8_MMA(1, 1, At, B1); PG8_BAR;
            PG8_LDB(B0, 1, 0); PG8_SCHED; PG8_LDA(At, 1, 0); PG8_STAGEA(PG8_SA(0, 1), a2, 1, last);
            PG8_WAIT_L(8); PG8_BAR; PG8_WAIT_L(0); PG8_MMA(0, 0, At, B0); PG8_BAR; PG8_SCHED;
            PG8_LDB(B1, 1, 1); PG8_STAGE(PG8_SB(1, 0), b3, voffB);
            PG8_BAR; PG8_WAIT_L(0); PG8_MMA(0, 1, At, B1); PG8_BAR;
            PG8_LDA(At, 1, 1); PG8_STAGEA(PG8_SA(1, 0), a3, 0, last);
            PG8_BAR; PG8_WAIT_L(0); PG8_MMA(1, 0, At, B0); PG8_BAR; PG8_SCHED;
            PG8_STAGE(PG8_SB(1, 1), b3 + hstepB, voffB);
            PG8_WAIT_V(6); PG8_BAR; PG8_MMA(1, 1, At, B1); PG8_BAR;
        }
        { if constexpr (FP8) asm volatile("s_nop 15\n\ts_nop 3" ::: "memory");
          int t_ = tid; asm volatile("" : "+v"(t_));
          E(acc, cur, wr, wc, t_ & 15, (t_ & 63) >> 4);
          if constexpr (Sched::PUBLISH) { asm volatile("s_waitcnt vmcnt(0)" ::: "memory"); PG8_BAR; if (t_ == 256) S.publish(cur); } }
        if (!has_next) break;
#pragma unroll
        for (int a = 0; a < 2; ++a)
#pragma unroll
            for (int b = 0; b < 2; ++b)
#pragma unroll
                for (int m = 0; m < 4; ++m)
#pragma unroll
                    for (int n = 0; n < 2; ++n) acc[a][b][m][n] = (f32x4){0.f, 0.f, 0.f, 0.f};
        cur = nxt; cA = nA; cB = nB; ++ui;
        if constexpr (Sched::GATHER) {
_Pragma("unroll") for (int h = 0; h < 2; ++h) _Pragma("unroll") for (int i = 0; i < 2; ++i) gA[h][i] = gAn[h][i]; }
    }
    PG8_WAIT_V(0);
    if (wr == 0) PG8_BAR;
    PG8_BAR;
#undef PG8_SA
#undef PG8_SB
#undef PG8_STAGE
#undef PG8_STAGEA
#undef PG8_GOFFS
#undef PG8_LDA
#undef PG8_LDB
#undef PG8_MMA
#undef PG8_WAIT_V
#undef PG8_WAIT_L
#undef PG8_BAR
#undef PG8_SCHED
}
}
using pg8::f32x4; using pg8::u32x4; using pg8::Unit;

#define GEMM_LDS (pg8::STAGE_BYTES + 1024)

struct SchedProj : pg8::TileOrder {
  static constexpr bool GATHER = false; static constexpr bool PUBLISH = false;
  const char* A; const char* B;
  __device__ bool next(int i, Unit& u) const { u.z = 0; return tile(i, u.pm, u.pn); }
  __device__ const char* a_ptr(const Unit& u) const { return A + (size_t)u.pm * 256 * DM * 2; }
  __device__ const char* b_ptr(const Unit& u) const { return B + (size_t)u.pn * 256 * DM * 2; }
};
struct EpiProj {
  static constexpr bool PERM = true;
  bf16_t* O;
  __device__ __forceinline__ void operator()(const f32x4 (&acc)[2][2][4][2], const Unit& u, int wr, int wc, int fr, int fq) const {
    const int row0 = u.pm * 256 + wr * 64 + fr, col0 = u.pn * 256 + wc * 32 + 8 * fq;
    const bool gate = u.pn >= (C_GA / 256);
#pragma unroll
    for (int ai = 0; ai < 2; ++ai)
#pragma unroll
      for (int m = 0; m < 4; ++m) {
        bf16_t* rowp = O + (size_t)(row0 + ai * 128 + m * 16) * PW + col0;
#pragma unroll
        for (int bj = 0; bj < 2; ++bj) {
          f32x4 v0 = acc[ai][bj][m][0], v1 = acc[ai][bj][m][1];
          if (gate) {
#pragma unroll
            for (int j = 0; j < 4; ++j) { v0[j] = sigmoidf_(v0[j]); v1[j] = sigmoidf_(v1[j]); }
          }
          u32x4 w; w.x = pg8::cvt_pk_bf16(v0[0], v0[1]); w.y = pg8::cvt_pk_bf16(v0[2], v0[3]); w.z = pg8::cvt_pk_bf16(v1[0], v1[1]); w.w = pg8::cvt_pk_bf16(v1[2], v1[3]);
          *(u32x4*)(rowp + bj * 128) = w;
        }
      }
  }
};
__device__ void ph_proj(const Params& p, PG8_LAS unsigned char* lds, int nblk, int bid) {
  SchedProj S; S.init(T_TOK / 256, PW / 256, nblk, bid); S.A = (const char*)p.hbf; S.B = (const char*)p.w_in_t;
  EpiProj E{p.proj};
  pg8::gemm_phase(lds, p.tid, DM, DM, DM, S, E);
}

struct SchedBr : pg8::TileOrder {
  static constexpr bool GATHER = false; static constexpr bool PUBLISH = false;
  const char* A; const char* Ba; const char* Bb;
  __device__ bool next(int i, Unit& u) const { u.z = i & 1; return tile(i >> 1, u.pm, u.pn); }
  __device__ const char* a_ptr(const Unit& u) const { return A + (size_t)u.pm * 256 * DM * 2 + u.z * 512 * 2; }
  __device__ const char* b_ptr(const Unit& u) const { return (u.z ? Bb : Ba) + (size_t)u.pn * 256 * 512 * 2; }
};
__device__ __forceinline__ void unpack8(const u32x4 w, float (&f)[8]) {
  f[0] = __uint_as_float(w.x << 16); f[1] = __uint_as_float(w.x & 0xffff0000u); f[2] = __uint_as_float(w.y << 16); f[3] = __uint_as_float(w.y & 0xffff0000u);
  f[4] = __uint_as_float(w.z << 16); f[5] = __uint_as_float(w.z & 0xffff0000u); f[6] = __uint_as_float(w.w << 16); f[7] = __uint_as_float(w.w & 0xffff0000u);
}
struct EpiBr {
  static constexpr bool PERM = true;
  const bf16_t* proj; bf16_t* O;
  __device__ __forceinline__ void operator()(const f32x4 (&acc)[2][2][4][2], const Unit& u, int wr, int wc, int fr, int fq) const {
    const int row0 = u.pm * 256 + wr * 64 + fr, col0 = u.pn * 256 + wc * 32 + 8 * fq;
    const int gcol = (u.z ? C_GB : C_GA) + col0;
#pragma unroll
    for (int ai = 0; ai < 2; ++ai) {
      u32x4 gv[4][2], pv[4][2];
#pragma unroll
      for (int m = 0; m < 4; ++m)
#pragma unroll
        for (int bj = 0; bj < 2; ++bj) {
          const size_t row = (size_t)(row0 + ai * 128 + m * 16);
          gv[m][bj] = *(const u32x4*)(proj + row * PW + gcol + bj * 128);
          pv[m][bj] = (u32x4){0u, 0u, 0u, 0u};
          if (u.z) pv[m][bj] = *(const u32x4*)(O + row * DM + col0 + bj * 128);
        }
#pragma unroll
      for (int m = 0; m < 4; ++m)
#pragma unroll
        for (int bj = 0; bj < 2; ++bj) {
          const size_t row = (size_t)(row0 + ai * 128 + m * 16);
          float g[8], pf[8]; unpack8(gv[m][bj], g); unpack8(pv[m][bj], pf);
          const f32x4 v0 = acc[ai][bj][m][0], v1 = acc[ai][bj][m][1];
          float r[8];
#pragma unroll
          for (int j = 0; j < 4; ++j) { r[j] = v0[j] * g[j] + pf[j]; r[4 + j] = v1[j] * g[4 + j] + pf[4 + j]; }
          u32x4 w; w.x = pk2(r[0], r[1]); w.y = pk2(r[2], r[3]); w.z = pk2(r[4], r[5]); w.w = pk2(r[6], r[7]);
          *(u32x4*)(O + row * DM + col0 + bj * 128) = w;
        }
    }
  }
};
__device__ void ph_br(const Params& p, PG8_LAS unsigned char* lds, int nblk, int bid) {
  SchedBr S; S.init(T_TOK / 256, DM / 256, nblk, bid); S.A = (const char*)p.oab; S.Ba = (const char*)p.wbra_t; S.Bb = (const char*)p.wbrb_t;
  EpiBr E{p.proj, p.merged};
  pg8::gemm_phase(lds, p.tid, DM, 512, 512, S, E);
}

struct SchedMix : pg8::TileOrder {
  static constexpr bool GATHER = false; static constexpr bool PUBLISH = false;
  const char* A; const char* B;
  __device__ bool next(int i, Unit& u) const { u.z = 0; return tile(i, u.pm, u.pn); }
  __device__ const char* a_ptr(const Unit& u) const { return A + (size_t)u.pm * 256 * DM * 2; }
  __device__ const char* b_ptr(const Unit& u) const { return B + (size_t)u.pn * 256 * DM * 2; }
};
struct EpiMix {
  static constexpr bool PERM = true;
  bf16_t* O;
  __device__ __forceinline__ void operator()(const f32x4 (&acc)[2][2][4][2], const Unit& u, int wr, int wc, int fr, int fq) const {
    const int row0 = u.pm * 256 + wr * 64 + fr, col0 = u.pn * 256 + wc * 32 + 8 * fq;
#pragma unroll
    for (int ai = 0; ai < 2; ++ai)
#pragma unroll
      for (int m = 0; m < 4; ++m) {
        bf16_t* rowp = O + (size_t)(row0 + ai * 128 + m * 16) * DM + col0;
#pragma unroll
        for (int bj = 0; bj < 2; ++bj) {
          const f32x4 v0 = acc[ai][bj][m][0], v1 = acc[ai][bj][m][1];
          u32x4 w; w.x = pg8::cvt_pk_bf16(v0[0], v0[1]); w.y = pg8::cvt_pk_bf16(v0[2], v0[3]); w.z = pg8::cvt_pk_bf16(v1[0], v1[1]); w.w = pg8::cvt_pk_bf16(v1[2], v1[3]);
          *(u32x4*)(rowp + bj * 128) = w;
        }
      }
  }
};
__device__ void ph_mix(const Params& p, PG8_LAS unsigned char* lds, int nblk, int bid) {
  SchedMix S; S.init(T_TOK / 256, DM / 256, nblk, bid); S.A = (const char*)p.merged; S.B = (const char*)p.wo_t;
  EpiMix E{p.mixer};
  pg8::gemm_phase(lds, p.tid, DM, DM, DM, S, E);
}

template <bool GATH>
struct SchedMoe {
  static constexpr bool GATHER = GATH;
  static constexpr bool PUBLISH = GATH;
  const PG8_LAS int* tb; int NT; int G, c; int nwg;
  const char* A; const char* B; size_t bexp;
  const int* elist; int rowb;
  int* dep; int i0, Loff, rot;
  __device__ void publish(const Unit& u) const { __hip_atomic_fetch_add(dep + u.pm, 1, __ATOMIC_RELAXED, __HIP_MEMORY_SCOPE_AGENT); }
  __device__ bool next(int i, Unit& u) const {
    const long L = (long)(i + i0) * G + c - Loff; if (L >= nwg) return false;
    int wgid = (int)L; { const int q = nwg / 8, r = nwg % 8, xcd = wgid % 8; int off = wgid / 8;
      if constexpr (!GATH) { const int sz = xcd < r ? q + 1 : q; off += rot; if (off >= sz) off -= sz; }
      wgid = (xcd < r ? xcd * (q + 1) : r * (q + 1) + (xcd - r) * q) + off; }
    int e = 0;
#pragma unroll
    for (int st = 16; st >= 1; st >>= 1) if (wgid >= tb[e + st]) e += st;
    const int q = wgid - tb[e]; const int tiles = tb[33 + e + 1] - tb[33 + e];
    u.pm = tb[33 + e] + q % tiles; u.pn = q / tiles; u.z = e;
    if constexpr (!GATH) {
      while (__builtin_amdgcn_readfirstlane(__hip_atomic_load(dep + u.pm, __ATOMIC_RELAXED, __HIP_MEMORY_SCOPE_AGENT)) < 8) __builtin_amdgcn_s_sleep(4);
      asm volatile("" ::: "memory");
    }
    return true;
  }
  __device__ const char* a_ptr(const Unit& u) const { return GATH ? A : A + (size_t)u.pm * 256 * rowb; }
  __device__ const char* b_ptr(const Unit& u) const { return B + (size_t)u.z * bexp + (size_t)u.pn * 256 * rowb; }
  __device__ unsigned a_goff(const Unit& u, int tr, int C) const {
    const int i = (u.pm - tb[33 + u.z]) * 256 + tr;
    int tok = 0;
    if (i < tb[66 + u.z]) tok = elist[u.z * T_TOK + i] >> 2;
    return (unsigned)(tok * rowb + C * 2);
  }
};
__device__ __forceinline__ void moe_table(const Params& p, PG8_LAS int* tb, int NT) {
  if (p.tid == 0) {
    int ub = 0, tbp = 0;
    for (int e = 0; e < NE; ++e) { const int c = p.cnt[e * 64]; tb[e] = ub; tb[33 + e] = tbp; tb[66 + e] = c; const int t = (c + 255) >> 8; ub += t * NT; tbp += t; }
    tb[NE] = ub; tb[33 + NE] = tbp;
  }
  __syncthreads();
}
struct EpiMoe1 {
  static constexpr bool PERM = true;
  const float* b_gu; unsigned char* act;
  __device__ __forceinline__ void operator()(f32x4 (&acc)[2][2][4][2], const Unit& u, int wr, int wc, int fr, int fq) const {
    const int row0 = u.pm * 256 + wr * 64 + fr, jc = u.pn * 128 + wc * 32 + 8 * fq;
    const float* bg = b_gu + (size_t)u.z * 2048 + jc;
#pragma unroll
    for (int bj = 0; bj < 2; ++bj)
#pragma unroll
      for (int n = 0; n < 2; ++n) {
        const f32x4 bv = *(const f32x4*)(bg + bj * 1024 + n * 4);
#pragma unroll
        for (int ai = 0; ai < 2; ++ai)
#pragma unroll
          for (int m = 0; m < 4; ++m) acc[ai][bj][m][n] = acc[ai][bj][m][n] * 0.015625f + bv;
      }
#pragma unroll
    for (int ai = 0; ai < 2; ++ai)
#pragma unroll
      for (int m = 0; m < 4; ++m) {
        unsigned char* rowp = act + (size_t)(row0 + ai * 128 + m * 16) * DM + jc;
        float r[8];
#pragma unroll
        for (int n = 0; n < 2; ++n)
#pragma unroll
          for (int j = 0; j < 4; ++j) {
            float g = acc[ai][0][m][n][j], up = acc[ai][1][m][n][j];
            g = fminf(g, 7.f); up = fminf(fmaxf(up, -7.f), 7.f);
            r[n * 4 + j] = (up + 1.f) * g * sigmoidf_(1.702f * g);
          }
        u32x2 w; w.x = pk4_fp8(r[0], r[1], r[2], r[3]); w.y = pk4_fp8(r[4], r[5], r[6], r[7]);
        __hip_atomic_store((unsigned long long*)rowp, (unsigned long long)w.x | ((unsigned long long)w.y << 32), __ATOMIC_RELAXED, __HIP_MEMORY_SCOPE_AGENT);
      }
  }
};
__device__ void ph_moe1(const Params& p, PG8_LAS unsigned char* lds, int nblk, int bid) {
  PG8_LAS int* tb = (PG8_LAS int*)(lds + pg8::STAGE_BYTES);
  moe_table(p, tb, 8);
  SchedMoe<true> S; S.tb = tb; S.NT = 8; S.G = nblk; S.c = bid; S.nwg = tb[NE]; S.A = (const char*)p.h2q; S.B = (const char*)p.wgu8; S.bexp = (size_t)2048 * DM; S.elist = p.elist; S.rowb = DM;
  S.dep = p.dep; S.i0 = 0; S.Loff = 0; S.rot = 0;
  EpiMoe1 E{p.b_gu, p.act8};
  pg8::gemm_phase<EpiMoe1, SchedMoe<true>, true>(lds, p.tid, DM / 2, DM / 2, DM / 2, S, E);
}
struct EpiMoe2 {
  static constexpr bool PERM = true;
  const float* b_down; const int* elist; const PG8_LAS int* tb; bf16_t* yslot;
  __device__ __forceinline__ void operator()(f32x4 (&acc)[2][2][4][2], const Unit& u, int wr, int wc, int fr, int fq) const {
    const int row0 = u.pm * 256 + wr * 64 + fr, col0 = u.pn * 256 + wc * 32 + 8 * fq;
    const float* bd = b_down + (size_t)u.z * 1024 + col0;
#pragma unroll
    for (int bj = 0; bj < 2; ++bj)
#pragma unroll
      for (int n = 0; n < 2; ++n) {
        const f32x4 bv = *(const f32x4*)(bd + bj * 128 + n * 4);
#pragma unroll
        for (int ai = 0; ai < 2; ++ai)
#pragma unroll
          for (int m = 0; m < 4; ++m) acc[ai][bj][m][n] = acc[ai][bj][m][n] * 0.015625f + bv;
      }
    const int li0 = (u.pm - tb[33 + u.z]) * 256 + wr * 64 + fr, cnt = tb[66 + u.z];
    int av[2][4];
#pragma unroll
    for (int ai = 0; ai < 2; ++ai)
#pragma unroll
      for (int m = 0; m < 4; ++m) { const int li = li0 + ai * 128 + m * 16; av[ai][m] = elist[u.z * T_TOK + (li < cnt ? li : 0)]; if (li >= cnt) av[ai][m] = -1; }
#pragma unroll
    for (int ai = 0; ai < 2; ++ai)
#pragma unroll
      for (int m = 0; m < 4; ++m) {
        const int a = av[ai][m];
        if (a >= 0) {
          unsigned char* rowp = (unsigned char*)yslot + (size_t)a * DM + col0;
#pragma unroll
          for (int bj = 0; bj < 2; ++bj) {
            const f32x4 v0 = acc[ai][bj][m][0], v1 = acc[ai][bj][m][1];
            u32x2 w; w.x = pk4_fp8(v0[0] * 8.f, v0[1] * 8.f, v0[2] * 8.f, v0[3] * 8.f); w.y = pk4_fp8(v1[0] * 8.f, v1[1] * 8.f, v1[2] * 8.f, v1[3] * 8.f);
            *(u32x2*)(rowp + bj * 128) = w;
          }
        }
      }
  }
};
__device__ void ph_moe2(const Params& p, PG8_LAS unsigned char* lds, int nblk, int bid) {
  PG8_LAS int* tb = (PG8_LAS int*)(lds + pg8::STAGE_BYTES);
  moe_table(p, tb, 4);
  SchedMoe<false> S; S.tb = tb; S.NT = 4; S.G = nblk; S.c = bid; S.nwg = tb[NE]; S.A = (const char*)p.act8; S.B = (const char*)p.wd8; S.bexp = (size_t)1024 * DM; S.elist = p.elist; S.rowb = DM;
  { const int nwg1 = 2 * S.nwg; S.dep = p.dep; S.i0 = (nwg1 - bid + nblk - 1) / nblk; S.Loff = nwg1; S.rot = S.nwg >> 5; }
  EpiMoe2 E{p.b_down, p.elist, tb, p.yslot};
  pg8::gemm_phase<EpiMoe2, SchedMoe<false>, true>(lds, p.tid, DM / 2, DM / 2, DM / 2, S, E);
}

typedef short bf16x8 __attribute__((ext_vector_type(8)));
#define LAS __attribute__((address_space(3)))
#define MFMA16(a, b, c) __builtin_amdgcn_mfma_f32_16x16x32_bf16((a), (b), (c), 0, 0, 0)
__device__ __forceinline__ bf16x8 pack8(float a0, float a1, float a2, float a3, float a4, float a5, float a6, float a7) {
  u32x4 w; w.x = pk2(a0, a1); w.y = pk2(a2, a3); w.z = pk2(a4, a5); w.w = pk2(a6, a7);
  return __builtin_bit_cast(bf16x8, w);
}
__device__ __forceinline__ bf16_t f2bf_hw(float a) { return (bf16_t)(pk2(a, 0.f) & 0xffffu); }

#define DN_ABYTES 57344
#define DN_UFLOATS 8192
#define F_WN 0
#define F_QD 16
#define F_QK 32
#define F_KT 40

#define DP_KH 0
#define DP_QT 17408
#define DP_KHT 34816
#define DP_VT 53248
#define DP_TU 71680
#define DP_TW 80896
#define DP_LF 90112
#define DP_GC 107520
#define DP_BETA 107776
#define DP_CW 108032
#define DP_LB 114176
#define DP_TR 123392
#define DP_TT 132608
#define DP_MT 141824
#define DP_TOTAL 144128

template <int KS>
__device__ __forceinline__ f32x4 prod16(const LAS bf16_t* A, int lda, int arow0, const LAS bf16_t* Bt, int ldb, int brow0, f32x4 acc, int lane) {
  const int r = lane & 15, q = lane >> 4;
#pragma unroll
  for (int ks = 0; ks < KS; ++ks) {
    const bf16x8 a = *(const LAS bf16x8*)(A + (arow0 + r) * lda + 32 * ks + 8 * q);
    const bf16x8 b = *(const LAS bf16x8*)(Bt + (brow0 + r) * ldb + 32 * ks + 8 * q);
    acc = MFMA16(a, b, acc);
  }
  return acc;
}
__device__ __forceinline__ void tile_store_rm(LAS bf16_t* X, int ld, int row0, int col0, const f32x4 v, int lane) {
  const int r = lane & 15, q = lane >> 4;
#pragma unroll
  for (int i = 0; i < 4; ++i) X[(row0 + 4 * q + i) * ld + col0 + r] = f2bf_hw(v[i]);
}
__device__ __forceinline__ void tile_store_tr(LAS bf16_t* Xt, int ld, int row0, int col0, const f32x4 v, int lane) {
  const int r = lane & 15, q = lane >> 4;
  u32x2 w; w.x = pk2(v[0], v[1]); w.y = pk2(v[2], v[3]);
  *(LAS u32x2*)(Xt + (col0 + r) * ld + row0 + 4 * q) = w;
}

__device__ void dn_prep_chunk(const Params& p, LAS unsigned char* lds, int ci, bool load_cw) {
  const int tid = p.tid, lane = tid & 63, w = tid >> 6, r16 = lane & 15, q4 = lane >> 4;
  const int bh = ci >> 6, n = ci & 63, b = bh >> 2, h = bh & 3;
  LAS bf16_t* Kh = (LAS bf16_t*)(lds + DP_KH); LAS bf16_t* Qt = (LAS bf16_t*)(lds + DP_QT);
  LAS bf16_t* KhT = (LAS bf16_t*)(lds + DP_KHT); LAS bf16_t* VT = (LAS bf16_t*)(lds + DP_VT);
  LAS bf16_t* Tu = (LAS bf16_t*)(lds + DP_TU); LAS bf16_t* Tw = (LAS bf16_t*)(lds + DP_TW); LAS float* Lf = (LAS float*)(lds + DP_LF);
  LAS bf16_t* Lb = (LAS bf16_t*)(lds + DP_LB); LAS bf16_t* Tr = (LAS bf16_t*)(lds + DP_TR); LAS bf16_t* Tt = (LAS bf16_t*)(lds + DP_TT); LAS bf16_t* Mt = (LAS bf16_t*)(lds + DP_MT);
  LAS float* gcb = (LAS float*)(lds + DP_GC); LAS float* betab = (LAS float*)(lds + DP_BETA); LAS float* cw = (LAS float*)(lds + DP_CW);
  unsigned char* gA = (unsigned char*)p.dnA + (size_t)ci * DN_ABYTES;
  float* gU = p.dnU + (size_t)ci * DN_UFLOATS;

  if (load_cw) {
    for (int i = tid; i < 4 * 384; i += 512) { const int tap = i / 384, cc = i % 384, part = cc >> 7, d = cc & 127; cw[i] = p.conv_w[tap * 1536 + part * 512 + h * 128 + d]; }
  }
  __syncthreads();
  const int c = tid >> 3, g = tid & 7;
  const int s = n * 64 + c;
  const size_t t = (size_t)b * SEQ + s;
  float qv[16], kv[16], vv[16];
#pragma unroll
  for (int j = 0; j < 16; ++j) { qv[j] = 0.f; kv[j] = 0.f; vv[j] = 0.f; }
#pragma unroll
  for (int tap = 0; tap < 4; ++tap) {
    const int ss = s - 3 + tap;
    if (ss >= 0) {
      const bf16_t* row = p.proj + (t - 3 + tap) * PW + h * 128 + 16 * g;
      float x[8];
#pragma unroll
      for (int part = 0; part < 3; ++part) {
#pragma unroll
        for (int hh = 0; hh < 2; ++hh) {
          unpack8(*(const u32x4*)(row + part * 512 + 8 * hh), x);
#pragma unroll
          for (int j = 0; j < 8; ++j) {
            const float wv = cw[tap * 384 + part * 128 + 16 * g + 8 * hh + j];
            if (part == 0) qv[8 * hh + j] += wv * x[j];
            if (part == 1) kv[8 * hh + j] += wv * x[j];
            if (part == 2) vv[8 * hh + j] += wv * x[j];
          }
        }
      }
    }
    asm volatile("" ::: "memory");
  }
  float sq = 0.f, sk = 0.f;
#pragma unroll
  for (int j = 0; j < 16; ++j) { qv[j] = siluf_(qv[j]); kv[j] = siluf_(kv[j]); vv[j] = siluf_(vv[j]); sq += qv[j] * qv[j]; sk += kv[j] * kv[j]; }
  sq += __shfl_xor(sq, 1, 64); sq += __shfl_xor(sq, 2, 64); sq += __shfl_xor(sq, 4, 64);
  sk += __shfl_xor(sk, 1, 64); sk += __shfl_xor(sk, 2, 64); sk += __shfl_xor(sk, 4, 64);
  const float rq = rsqrtf(sq + 1e-6f) * 0.08838834764831845f, rk = rsqrtf(sk + 1e-6f);
#pragma unroll
  for (int j = 0; j < 16; ++j) { qv[j] *= rq; kv[j] *= rk; }
  if (g == 0) {
    const float bb = p.ba[t * 8 + h], aa = p.ba[t * 8 + 4 + h];
    const float xx = aa + p.dt_bias[h];
    const float sp = xx > 20.f ? xx : log1pf(__expf(xx));
    betab[c] = sigmoidf_(bb);
    gcb[c] = -__expf(p.a_log[h]) * sp;
  }
  {
    u32x4 w0, w1;
    w0.x = pk2(kv[0], kv[1]); w0.y = pk2(kv[2], kv[3]); w0.z = pk2(kv[4], kv[5]); w0.w = pk2(kv[6], kv[7]);
    w1.x = pk2(kv[8], kv[9]); w1.y = pk2(kv[10], kv[11]); w1.z = pk2(kv[12], kv[13]); w1.w = pk2(kv[14], kv[15]);
    *(LAS u32x4*)(Kh + c * 136 + 16 * g) = w0; *(LAS u32x4*)(Kh + c * 136 + 16 * g + 8) = w1;
    w0.x = pk2(qv[0], qv[1]); w0.y = pk2(qv[2], qv[3]); w0.z = pk2(qv[4], qv[5]); w0.w = pk2(qv[6], qv[7]);
    w1.x = pk2(qv[8], qv[9]); w1.y = pk2(qv[10], qv[11]); w1.z = pk2(qv[12], qv[13]); w1.w = pk2(qv[14], qv[15]);
    *(LAS u32x4*)(Qt + c * 136 + 16 * g) = w0; *(LAS u32x4*)(Qt + c * 136 + 16 * g + 8) = w1;
#pragma unroll
    for (int j = 0; j < 16; ++j) { KhT[(16 * g + j) * 72 + c] = f2bf_hw(kv[j]); VT[(16 * g + j) * 72 + c] = f2bf_hw(vv[j]); }
  }
  __syncthreads();
  if (w == 0) {
    float v = gcb[lane];
#pragma unroll
    for (int o = 1; o < 64; o <<= 1) { const float u = __shfl_up(v, o, 64); if (lane >= o) v += u; }
    gcb[lane] = v;
  }
  __syncthreads();
  const float gc_c = gcb[c], gl = gcb[63];
  {
    const float eg = __expf(gc_c);
    unsigned char* fb = gA + (size_t)(F_QD + (c >> 4) * 4 + (g >> 1)) * 1024 + (g & 1) * 8;
#pragma unroll
    for (int qq = 0; qq < 4; ++qq) {
      u32x2 wv; wv.x = pk2(qv[4 * qq] * eg, qv[4 * qq + 1] * eg); wv.y = pk2(qv[4 * qq + 2] * eg, qv[4 * qq + 3] * eg);
      *(u32x2*)(fb + ((c & 15) + 16 * qq) * 16) = wv;
    }
  }
  const int rt = w >> 1, ct0 = 2 * (w & 1);
#pragma unroll
  for (int tt = 0; tt < 2; ++tt) {
    const int ct = ct0 + tt;
    f32x4 gacc = {0.f, 0.f, 0.f, 0.f};
    gacc = prod16<4>(Kh, 136, 16 * rt, Kh, 136, 16 * ct, gacc, lane);
    const int m = 16 * ct + r16; const float gc_m = gcb[m];
    f32x4 lv;
#pragma unroll
    for (int i = 0; i < 4; ++i) {
      const int cc = 16 * rt + 4 * q4 + i;
      lv[i] = (m < cc) ? betab[cc] * gacc[i] * __expf(gcb[cc] - gc_m) : 0.f;
      Lf[cc * 68 + m] = lv[i];
    }
    tile_store_rm(Lb, 72, 16 * rt, 16 * ct, lv, lane);
    f32x4 qacc = {0.f, 0.f, 0.f, 0.f};
    qacc = prod16<4>(Kh, 136, 16 * rt, Qt, 136, 16 * ct, qacc, lane);
    const int cq = 16 * ct + r16; const float gc_cq = gcb[cq];
    float o4[4];
#pragma unroll
    for (int i = 0; i < 4; ++i) { const int mm = 16 * rt + 4 * q4 + i; o4[i] = (mm <= cq) ? qacc[i] * __expf(gc_cq - gcb[mm]) : 0.f; }
    u32x2 wv; wv.x = pk2(o4[0], o4[1]); wv.y = pk2(o4[2], o4[3]);
    *(u32x2*)(gA + (size_t)(F_QK + ct * 2 + (rt >> 1)) * 1024 + (r16 + 16 * q4) * 16 + (rt & 1) * 8) = wv;
  }
  __syncthreads();
  for (int i = tid; i < 2 * 64 * 72 / 8; i += 512) ((LAS u32x4*)Tr)[i] = (u32x4){0u, 0u, 0u, 0u};
  __syncthreads();
  if (w == 0) {
    int lo = lane; asm volatile("" : "+v"(lo));
    const int g = lo >> 4, j = lo & 15;
    unsigned lfb = DP_LF + (16 * g * 68 + 16 * g) * 4; asm volatile("" : "+v"(lfb));
    const LAS float* Lg = (const LAS float*)(lds + lfb);
    float t[16];
#pragma unroll
    for (int r = 0; r < 16; ++r) {
      float a0 = (r == j) ? 1.f : 0.f, a1 = 0.f;
#pragma unroll
      for (int k4 = 0; k4 < (r + 3) / 4; ++k4) {
        const f32x4 l = *(const LAS f32x4*)(Lg + r * 68 + 4 * k4);
        if (4 * k4 + 0 < r) a0 -= l[0] * t[4 * k4 + 0];
        if (4 * k4 + 1 < r) a1 -= l[1] * t[4 * k4 + 1];
        if (4 * k4 + 2 < r) a0 -= l[2] * t[4 * k4 + 2];
        if (4 * k4 + 3 < r) a1 -= l[3] * t[4 * k4 + 3];
      }
      t[r] = a0 + a1;
      Tr[(16 * g + r) * 72 + 16 * g + j] = f2bf_hw(t[r]);
    }
    u32x4 w0, w1;
    w0.x = pk2(t[0], t[1]); w0.y = pk2(t[2], t[3]); w0.z = pk2(t[4], t[5]); w0.w = pk2(t[6], t[7]);
    w1.x = pk2(t[8], t[9]); w1.y = pk2(t[10], t[11]); w1.z = pk2(t[12], t[13]); w1.w = pk2(t[14], t[15]);
    *(LAS u32x4*)(Tt + (16 * g + j) * 72 + 16 * g) = w0; *(LAS u32x4*)(Tt + (16 * g + j) * 72 + 16 * g + 8) = w1;
  }
  __syncthreads();
#pragma unroll 1
  for (int d = 1; d <= 3; ++d) {
    const bool act = w < 4 - d;
    const int I = w + d, J = w;
    LAS bf16_t* Mw = Mt + w * 16 * 24;
    if (act) {
      f32x4 macc = {0.f, 0.f, 0.f, 0.f};
      macc = prod16<2>(Lb, 72, 16 * I, Tt, 72, 16 * J, macc, lane);
      tile_store_tr(Mw, 24, 0, 0, macc, lane);
    }
    __syncthreads();
    if (act) {
      bf16x8 a = {0, 0, 0, 0, 0, 0, 0, 0}, bb = {0, 0, 0, 0, 0, 0, 0, 0};
      if (q4 < 2) { a = *(const LAS bf16x8*)(Tr + (16 * I + r16) * 72 + 16 * I + 8 * q4); bb = *(const LAS bf16x8*)(Mw + r16 * 24 + 8 * q4); }
      f32x4 tacc = {0.f, 0.f, 0.f, 0.f};
      tacc = MFMA16(a, bb, tacc);
#pragma unroll
      for (int i = 0; i < 4; ++i) tacc[i] = -tacc[i];
      tile_store_rm(Tr, 72, 16 * I, 16 * J, tacc, lane);
      tile_store_tr(Tt, 72, 16 * I, 16 * J, tacc, lane);
    }
    __syncthreads();
  }
  {
    const int cc = tid >> 3, m0 = (tid & 7) * 8;
    float tv[8]; unpack8(*(const LAS u32x4*)(Tr + cc * 72 + m0), tv);
    float tu[8], tw[8];
#pragma unroll
    for (int jj = 0; jj < 8; ++jj) { const float bm = betab[m0 + jj]; tu[jj] = tv[jj] * bm; tw[jj] = tu[jj] * __expf(gcb[m0 + jj]); }
    u32x4 wu, ww;
    wu.x = pk2(tu[0], tu[1]); wu.y = pk2(tu[2], tu[3]); wu.z = pk2(tu[4], tu[5]); wu.w = pk2(tu[6], tu[7]);
    ww.x = pk2(tw[0], tw[1]); ww.y = pk2(tw[2], tw[3]); ww.z = pk2(tw[4], tw[5]); ww.w = pk2(tw[6], tw[7]);
    *(LAS u32x4*)(Tu + cc * 72 + m0) = wu; *(LAS u32x4*)(Tw + cc * 72 + m0) = ww;
  }
  __syncthreads();
#pragma unroll
  for (int rr = 0; rr < 4; ++rr) {
    f32x4 u = {0.f, 0.f, 0.f, 0.f};
    u = prod16<2>(Tu, 72, 16 * rr, VT, 72, 16 * w, u, lane);
    *(f32x4*)(gU + ((w * 4 + rr) * 64 + lane) * 4) = u;
    f32x4 wt = {0.f, 0.f, 0.f, 0.f};
    wt = prod16<2>(KhT, 72, 16 * w, Tw, 72, 16 * rr, wt, lane);
    u32x2 wv; wv.x = pk2(-wt[0], -wt[1]); wv.y = pk2(-wt[2], -wt[3]);
    *(u32x2*)(gA + (size_t)(F_WN + rr * 4 + (w >> 1)) * 1024 + (r16 + 16 * q4) * 16 + (w & 1) * 8) = wv;
  }
#pragma unroll
  for (int it = 0; it < 4; ++it) {
    const int idx = tid + it * 512; const int d = idx >> 4, m4 = idx & 15;
    const u32x2 raw = *(const LAS u32x2*)(KhT + d * 72 + 4 * m4);
    const float k0 = __uint_as_float(raw.x << 16), k1 = __uint_as_float(raw.x & 0xffff0000u), k2 = __uint_as_float(raw.y << 16), k3 = __uint_as_float(raw.y & 0xffff0000u);
    const float e0 = __expf(gl - gcb[4 * m4]), e1 = __expf(gl - gcb[4 * m4 + 1]), e2 = __expf(gl - gcb[4 * m4 + 2]), e3 = __expf(gl - gcb[4 * m4 + 3]);
    u32x2 wv; wv.x = pk2(k0 * e0, k1 * e1); wv.y = pk2(k2 * e2, k3 * e3);
    *(u32x2*)(gA + (size_t)(F_KT + (d >> 4) * 2 + (m4 >> 3)) * 1024 + ((d & 15) + 16 * (m4 & 3)) * 16 + ((m4 >> 2) & 1) * 8) = wv;
  }
  if (tid == 0) p.dnG[ci] = __expf(gl);
}

#define DS_SLOT 32768
#define DS_TOTAL (4 * DS_SLOT)
#define DN_SFRAG (4 * 1024)
#define DN_VFRAG (2 * 1024)
#define ST16_WT(rsrc, off, v) __builtin_amdgcn_raw_buffer_store_b128(__builtin_bit_cast(u32x4, (v)), (rsrc), (unsigned)(off), 0, 16)
__device__ void dn_scan_blk(const Params& p, LAS unsigned char* lds, int item) {
  const int tid = p.tid, lane = tid & 63, w = __builtin_amdgcn_readfirstlane(tid >> 6);
  const int bh = item >> 1, eh = item & 1;
  const int et = eh * 4 + (w & 3);
  const bool comp = w < 4;
  const unsigned char* gA = (const unsigned char*)p.dnA + (size_t)bh * 64 * DN_ABYTES;
  const float* gU = p.dnU + (size_t)bh * 64 * DN_UFLOATS;
  const float* gG = p.dnG + bh * 64;
  const __amdgpu_buffer_rsrc_t rS = __builtin_amdgcn_make_buffer_rsrc((void*)p.dnS, 0, 1024 * 8 * DN_SFRAG, 0x00020000);
  const __amdgpu_buffer_rsrc_t rV = __builtin_amdgcn_make_buffer_rsrc((void*)p.dnV, 0, 1024 * 8 * DN_VFRAG, 0x00020000);
  const unsigned oS = (unsigned)((bh * 64 * 8 + et) * DN_SFRAG + lane * 16), oV = (unsigned)((bh * 64 * 8 + et) * DN_VFRAG + lane * 16);
  auto issue_A = [&](int n) {
#pragma unroll
    for (int i = 0; i < 8; ++i) {
      const int f = (w & 3) * 8 + i, sf = f < 16 ? F_WN + f : F_KT + (f - 16);
      __builtin_amdgcn_global_load_lds((const unsigned*)(gA + (size_t)n * DN_ABYTES + sf * 1024 + lane * 16), (LAS unsigned*)(lds + (n & 3) * DS_SLOT + f * 1024), 16, 0, 0);
    }
  };
  __syncthreads();
  f32x4 Un[4]; f32x4 S[8]; float gnext = 0.f;
  if (comp) {
#pragma unroll
    for (int rr = 0; rr < 4; ++rr) Un[rr] = *(const f32x4*)(gU + ((et * 4 + rr) * 64 + lane) * 4);
    gnext = gG[0];
  } else {
    issue_A(0); issue_A(1); issue_A(2);
    asm volatile("s_waitcnt vmcnt(16)" ::: "memory");
  }
#pragma unroll
  for (int dt = 0; dt < 8; ++dt) S[dt] = (f32x4){0.f, 0.f, 0.f, 0.f};
  asm volatile("s_waitcnt lgkmcnt(0)" ::: "memory");
  __builtin_amdgcn_s_barrier();
  asm volatile("" ::: "memory");
#pragma unroll 1
  for (int n = 0; n < 64; ++n) {
    const LAS unsigned char* Ab = lds + (n & 3) * DS_SLOT;
    if (!comp) {
      if (n + 3 < 64) { issue_A(n + 3); asm volatile("s_waitcnt vmcnt(16)" ::: "memory"); }
      else if (n + 2 < 64) asm volatile("s_waitcnt vmcnt(8)" ::: "memory");
      else asm volatile("s_waitcnt vmcnt(0)" ::: "memory");
    } else {
      f32x4 Vn[4];
#pragma unroll
      for (int rr = 0; rr < 4; ++rr) Vn[rr] = Un[rr];
      const float gdec = gnext;
      if (n + 1 < 64) {
#pragma unroll
        for (int rr = 0; rr < 4; ++rr) Un[rr] = *(const f32x4*)(gU + (size_t)(n + 1) * DN_UFLOATS + ((et * 4 + rr) * 64 + lane) * 4);
        gnext = gG[n + 1];
      }
      bf16x8 Sb[4];
#pragma unroll
      for (int ks = 0; ks < 4; ++ks) Sb[ks] = pack8(S[2 * ks][0], S[2 * ks][1], S[2 * ks][2], S[2 * ks][3], S[2 * ks + 1][0], S[2 * ks + 1][1], S[2 * ks + 1][2], S[2 * ks + 1][3]);
#pragma unroll
      for (int ks = 0; ks < 4; ++ks) ST16_WT(rS, oS + n * 8 * DN_SFRAG + ks * 1024, Sb[ks]);
#pragma unroll
      for (int dt = 0; dt < 8; ++dt) S[dt] *= gdec;
#define LDF(idx) (*(const LAS bf16x8*)(Ab + (idx) * 1024 + lane * 16))
#define SBAR __builtin_amdgcn_sched_barrier(0)
      bf16x8 fa[8], fb[8];
#pragma unroll
      for (int i = 0; i < 8; ++i) fa[i] = LDF(i);
      SBAR;
#pragma unroll
      for (int i = 0; i < 8; ++i) fb[i] = LDF(8 + i);
      SBAR;
#pragma unroll
      for (int ks = 0; ks < 4; ++ks) { Vn[0] = MFMA16(fa[ks], Sb[ks], Vn[0]); Vn[1] = MFMA16(fa[4 + ks], Sb[ks], Vn[1]); }
      SBAR;
#pragma unroll
      for (int i = 0; i < 8; ++i) fa[i] = LDF(16 + i);
      SBAR;
#pragma unroll
      for (int ks = 0; ks < 4; ++ks) { Vn[2] = MFMA16(fb[ks], Sb[ks], Vn[2]); Vn[3] = MFMA16(fb[4 + ks], Sb[ks], Vn[3]); }
      SBAR;
#pragma unroll
      for (int i = 0; i < 8; ++i) fb[i] = LDF(24 + i);
      SBAR;
      bf16x8 Vb[2];
#pragma unroll
      for (int ks = 0; ks < 2; ++ks) Vb[ks] = pack8(Vn[2 * ks][0], Vn[2 * ks][1], Vn[2 * ks][2], Vn[2 * ks][3], Vn[2 * ks + 1][0], Vn[2 * ks + 1][1], Vn[2 * ks + 1][2], Vn[2 * ks + 1][3]);
#pragma unroll
      for (int ks = 0; ks < 2; ++ks) ST16_WT(rV, oV + n * 8 * DN_VFRAG + ks * 1024, Vb[ks]);
#pragma unroll
      for (int ks = 0; ks < 2; ++ks)
#pragma unroll
        for (int dt = 0; dt < 4; ++dt) S[dt] = MFMA16(fa[dt * 2 + ks], Vb[ks], S[dt]);
#pragma unroll
      for (int ks = 0; ks < 2; ++ks)
#pragma unroll
        for (int dt = 0; dt < 4; ++dt) S[4 + dt] = MFMA16(fb[dt * 2 + ks], Vb[ks], S[4 + dt]);
#undef LDF
#undef SBAR
      asm volatile("s_waitcnt lgkmcnt(0)" ::: "memory");
    }
    __builtin_amdgcn_s_barrier();
    asm volatile("" ::: "memory");
  }
  asm volatile("s_waitcnt vmcnt(0)" ::: "memory");
  __syncthreads();
  if (tid == 0) __hip_atomic_fetch_add(p.dep + 416 + bh, 1, __ATOMIC_RELAXED, __HIP_MEMORY_SCOPE_AGENT);
}
#define DO_OT 32768
#define DO_B1 69632
#define SCAN_FLAG 416
__device__ void ph_dn_out(const Params& p, LAS unsigned char* lds, int nblk, int bid) {
  const int tid = p.tid, lane = tid & 63, w = __builtin_amdgcn_readfirstlane(tid >> 6), r16 = lane & 15, q4 = lane >> 4;
  LAS float* Ot = (LAS float*)(lds + DO_OT);
  for (;;) {
    int ok = 1;
    for (int ci = bid; ci < 1024; ci += nblk) ok &= __hip_atomic_load(p.dep + SCAN_FLAG + (ci >> 6), __ATOMIC_RELAXED, __HIP_MEMORY_SCOPE_AGENT) >= 2;
    if (__builtin_amdgcn_readfirstlane(ok)) break;
    __builtin_amdgcn_s_sleep(8);
  }
  asm volatile("" ::: "memory");
  __syncthreads();
  bf16x8 Sn[4], Vn[2];
  auto prefetch = [&](int ci, int buf) {
    const unsigned char* gA = (const unsigned char*)p.dnA + (size_t)ci * DN_ABYTES;
#pragma unroll
    for (int i = 0; i < 3; ++i) {
      const int f = w * 3 + i;
      __builtin_amdgcn_global_load_lds((const unsigned*)(gA + (F_QD + f) * 1024 + lane * 16), (LAS unsigned*)(lds + (buf ? DO_B1 : 0) + f * 1024), 16, 0, 0);
    }
#pragma unroll
    for (int ks = 0; ks < 4; ++ks) Sn[ks] = *(const bf16x8*)((const unsigned char*)p.dnS + ((size_t)ci * 8 + w) * DN_SFRAG + ks * 1024 + lane * 16);
#pragma unroll
    for (int ks = 0; ks < 2; ++ks) Vn[ks] = *(const bf16x8*)((const unsigned char*)p.dnV + ((size_t)ci * 8 + w) * DN_VFRAG + ks * 1024 + lane * 16);
  };
  if (bid < 1024) prefetch(bid, 0);
  int it = 0;
  for (int ci = bid; ci < 1024; ci += nblk, ++it) {
    const int bh = ci >> 6, n = ci & 63, b = bh >> 2, h = bh & 3;
    asm volatile("s_waitcnt vmcnt(0)" ::: "memory");
    __syncthreads();
    bf16x8 Sb[4], Vb[2];
#pragma unroll
    for (int ks = 0; ks < 4; ++ks) Sb[ks] = Sn[ks];
#pragma unroll
    for (int ks = 0; ks < 2; ++ks) Vb[ks] = Vn[ks];
    if (ci + nblk < 1024) prefetch(ci + nblk, (it + 1) & 1);
    const LAS unsigned char* fb = lds + ((it & 1) ? DO_B1 : 0);
    f32x4 O[4];
#pragma unroll
    for (int rr = 0; rr < 4; ++rr) {
      O[rr] = (f32x4){0.f, 0.f, 0.f, 0.f};
#pragma unroll
      for (int ks = 0; ks < 4; ++ks) O[rr] = MFMA16(*(const LAS bf16x8*)(fb + (rr * 4 + ks) * 1024 + lane * 16), Sb[ks], O[rr]);
#pragma unroll
      for (int ks = 0; ks < 2; ++ks) O[rr] = MFMA16(*(const LAS bf16x8*)(fb + (16 + rr * 2 + ks) * 1024 + lane * 16), Vb[ks], O[rr]);
    }
#pragma unroll
    for (int rr = 0; rr < 4; ++rr)
#pragma unroll
      for (int i = 0; i < 4; ++i) Ot[(16 * rr + 4 * q4 + i) * 132 + 16 * w + r16] = O[rr][i];
    __syncthreads();
    {
      const int row = tid >> 3, seg = tid & 7;
      const size_t t = (size_t)b * SEQ + n * 64 + row;
      float o[16]; float ss = 0.f;
#pragma unroll
      for (int j4 = 0; j4 < 4; ++j4) { const f32x4 v = *(const LAS f32x4*)(Ot + row * 132 + 16 * seg + 4 * j4); o[4 * j4] = v[0]; o[4 * j4 + 1] = v[1]; o[4 * j4 + 2] = v[2]; o[4 * j4 + 3] = v[3]; }
#pragma unroll
      for (int j = 0; j < 16; ++j) ss += o[j] * o[j];
      ss += __shfl_xor(ss, 1, 64); ss += __shfl_xor(ss, 2, 64); ss += __shfl_xor(ss, 4, 64);
      const float rstd = rsqrtf(ss * (1.f / 128.f) + 1e-6f);
      const bf16_t* zp = p.proj + t * PW + C_Z + h * 128 + 16 * seg;
      float z0[8], z1[8]; unpack8(*(const u32x4*)zp, z0); unpack8(*(const u32x4*)(zp + 8), z1);
      float y[16];
#pragma unroll
      for (int j = 0; j < 8; ++j) { y[j] = o[j] * rstd * p.g_dn_out[16 * seg + j] * siluf_(z0[j]); y[8 + j] = o[8 + j] * rstd * p.g_dn_out[16 * seg + 8 + j] * siluf_(z1[j]); }
      u32x4 w0, w1;
      w0.x = pk2(y[0], y[1]); w0.y = pk2(y[2], y[3]); w0.z = pk2(y[4], y[5]); w0.w = pk2(y[6], y[7]);
      w1.x = pk2(y[8], y[9]); w1.y = pk2(y[10], y[11]); w1.z = pk2(y[12], y[13]); w1.w = pk2(y[14], y[15]);
      bf16_t* op = p.dn_out + t * p.dn_out_ld + h * 128 + 16 * seg;
      *(u32x4*)op = w0; *(u32x4*)(op + 8) = w1;
    }
  }
}
typedef float f32x16 __attribute__((ext_vector_type(16)));
#define MFMA32(a, b, c) __builtin_amdgcn_mfma_f32_32x32x16_bf16((a), (b), (c), 0, 0, 0)
#define MP_VL 0
#define MP_RED 65536
#define MP_TOTAL (65536 + 4096)

__device__ void moba_prep_block(const Params& p, LAS unsigned char* lds, int item) {
  const int tid = p.tid, lane = tid & 63, w = tid >> 6;
  const int bh = item >> 4, jb = item & 15, b = bh >> 2, h = bh & 3;
  LAS bf16_t* Vl = (LAS bf16_t*)(lds + MP_VL);
  LAS float* red = (LAS float*)(lds + MP_RED);
  __syncthreads();
#pragma unroll
  for (int it = 0; it < 8; ++it) {
    const int idx = tid + 512 * it, row = idx >> 4, ch = idx & 15;
    const u32x4 v = *(const u32x4*)(p.proj + ((size_t)b * SEQ + 256 * jb + row) * PW + C_MV + h * 128 + 8 * ch);
    *(LAS u32x4*)(Vl + row * 128 + 8 * ch) = v;
  }
  {
    const int r = tid >> 1, hh = tid & 1;
    const int pos = 256 * jb + r;
    const size_t t = (size_t)b * SEQ + pos;
    float cs[8], sn[8];
#pragma unroll
    for (int jj = 0; jj < 8; ++jj) {
      const float inv = exp2f(-(float)(8 * hh + jj) * (1.f / 16.f) * 18.931568569324174f);
      const float ang = (float)pos * inv;
      cs[jj] = cosf(ang); sn[jj] = sinf(ang);
    }
    float kacc[64];
#pragma unroll
    for (int which = 0; which < 2; ++which) {
      const bf16_t* src = p.proj + t * PW + (which ? C_MQ : C_MK) + h * 128 + 8 * hh;
      float x0[8], x1[8];
      unpack8(*(const u32x4*)(src), x0); unpack8(*(const u32x4*)(src + 16), x1);
      float y0[8], y1[8];
#pragma unroll
      for (int jj = 0; jj < 8; ++jj) { y0[jj] = x0[jj] * cs[jj] - x1[jj] * sn[jj]; y1[jj] = x1[jj] * cs[jj] + x0[jj] * sn[jj]; }
      u32x4 o[8];
      o[0].x = pk2(y0[0], y0[1]); o[0].y = pk2(y0[2], y0[3]); o[0].z = pk2(y0[4], y0[5]); o[0].w = pk2(y0[6], y0[7]);
      o[1].x = pk2(y1[0], y1[1]); o[1].y = pk2(y1[2], y1[3]); o[1].z = pk2(y1[4], y1[5]); o[1].w = pk2(y1[6], y1[7]);
#pragma unroll
      for (int ks = 2; ks < 8; ++ks) o[ks] = *(const u32x4*)(src + 16 * ks);
      if (which == 0) {
#pragma unroll
        for (int jj = 0; jj < 8; ++jj) { kacc[jj] = y0[jj]; kacc[8 + jj] = y1[jj]; }
#pragma unroll
        for (int ks = 2; ks < 8; ++ks) { float f[8]; unpack8(o[ks], f);
#pragma unroll
          for (int jj = 0; jj < 8; ++jj) kacc[8 * ks + jj] = f[jj]; }
        unsigned char* dst = (unsigned char*)p.Kp + ((size_t)(bh * 128 + 8 * jb + (r >> 5)) * 8192) + ((r & 31) + 32 * hh) * 16;
#pragma unroll
        for (int ks = 0; ks < 8; ++ks) *(u32x4*)(dst + ks * 1024) = o[ks];
      } else {
        bf16_t* dst = p.qb + ((size_t)bh * SEQ + pos) * 128 + 8 * hh;
#pragma unroll
        for (int ks = 0; ks < 8; ++ks) *(u32x4*)(dst + 16 * ks) = o[ks];
      }
    }
#pragma unroll
    for (int e = 0; e < 64; ++e) {
      float v = kacc[e];
      v += __shfl_xor(v, 2, 64); v += __shfl_xor(v, 4, 64); v += __shfl_xor(v, 8, 64); v += __shfl_xor(v, 16, 64); v += __shfl_xor(v, 32, 64);
      kacc[e] = v;
    }
    if (lane < 2) {
#pragma unroll
      for (int e = 0; e < 64; ++e) red[(w * 2 + lane) * 64 + e] = kacc[e];
    }
  }
  __syncthreads();
  if (tid < 128) {
    const int d = tid, hh = (d >> 3) & 1, ks = d >> 4, jj = d & 7;
    float a = 0.f;
#pragma unroll
    for (int ww = 0; ww < 8; ++ww) a += red[(ww * 2 + hh) * 64 + ks * 8 + jj];
    p.kmean[((size_t)bh * 16 + jb) * 128 + d] = a * (1.f / 256.f);
  }
#pragma unroll
  for (int it = 0; it < 8; ++it) {
    const int o = tid + 512 * it, ln = o & 63, frag = o >> 6, tl = frag >> 3, dt = (frag >> 1) & 3, s = frag & 1;
    const int r = ln & 31, hh = ln >> 5, d = 32 * dt + r;
    unsigned short e[8];
#pragma unroll
    for (int jj = 0; jj < 8; ++jj) { const int key = 32 * tl + 16 * s + 8 * (jj >> 2) + 4 * hh + (jj & 3); e[jj] = Vl[key * 128 + d]; }
    u32x4 wv; wv.x = e[0] | ((unsigned)e[1] << 16); wv.y = e[2] | ((unsigned)e[3] << 16); wv.z = e[4] | ((unsigned)e[5] << 16); wv.w = e[6] | ((unsigned)e[7] << 16);
    *(u32x4*)((unsigned char*)p.Vp + ((size_t)(bh * 128 + 8 * jb + tl) * 8192) + (dt * 2 + s) * 1024 + ln * 16) = wv;
  }
}
__device__ __forceinline__ int crow32(int reg, int hh) { return (reg & 3) + 8 * (reg >> 2) + 4 * hh; }
__device__ void moba_item(const Params& p, LAS float* km, LAS float* mrg, LAS float* ml, int bh, int ib, int sub, int par, int lane, int rep) {
  const int q = lane & 31, hh = lane >> 5;
  const int b = bh >> 2, h = bh & 3;
  const int s0 = 256 * ib + 32 * sub;
  const bf16_t* qrow = p.qb + ((size_t)bh * SEQ + s0 + q) * 128 + 8 * hh;
  bf16x8 Qf[8];
#pragma unroll
  for (int ks = 0; ks < 8; ++ks) Qf[ks] = *(const bf16x8*)(qrow + 16 * ks);
  LAS unsigned char* qlds = (LAS unsigned char*)km + 8192 + lane * 16;
#pragma unroll
  for (int ks = 0; ks < 8; ++ks) *(LAS bf16x8*)(qlds + ks * 1024) = Qf[ks];
  unsigned selmask = 0;
  if (ib > 0) {
    for (int idx = lane; idx < ib * 32; idx += 64) ((LAS f32x4*)km)[idx] = ((const f32x4*)(p.kmean + (size_t)bh * 16 * 128))[idx];
    float qf[64];
#pragma unroll
    for (int ks = 0; ks < 8; ++ks) { float f[8]; unpack8(__builtin_bit_cast(u32x4, Qf[ks]), f);
#pragma unroll
      for (int jj = 0; jj < 8; ++jj) qf[8 * ks + jj] = f[jj]; }
    float sc[16];
#pragma unroll
    for (int j = 0; j < 16; ++j) {
      sc[j] = -INFINITY;
      if (j < ib) {
        float a = 0.f;
#pragma unroll
        for (int ks = 0; ks < 8; ++ks) {
          const f32x4 k0 = *(const LAS f32x4*)(km + j * 128 + 16 * ks + 8 * hh), k1 = *(const LAS f32x4*)(km + j * 128 + 16 * ks + 8 * hh + 4);
          a += qf[8 * ks] * k0[0] + qf[8 * ks + 1] * k0[1] + qf[8 * ks + 2] * k0[2] + qf[8 * ks + 3] * k0[3];
          a += qf[8 * ks + 4] * k1[0] + qf[8 * ks + 5] * k1[1] + qf[8 * ks + 6] * k1[2] + qf[8 * ks + 7] * k1[3];
        }
        a += __shfl_xor(a, 32, 64);
        sc[j] = a;
      }
    }
#pragma unroll
    for (int r = 0; r < 3; ++r) {
      if (r < ib) {
        float best = -INFINITY; int bi = 0;
#pragma unroll
        for (int j = 0; j < 16; ++j) if (sc[j] > best) { best = sc[j]; bi = j; }
        selmask |= 1u << bi;
#pragma unroll
        for (int j = 0; j < 16; ++j) if (j == bi) sc[j] = -INFINITY;
      }
    }
  }
  unsigned rem = 0;
  for (int j = 0; j < ib; ++j) if (__ballot((selmask >> j) & 1u) != 0ull) rem |= 1u << j;
  rem = __builtin_amdgcn_readfirstlane(rem);
  const int own0 = 8 * ib, diag = 8 * ib + sub;
  const float cscale = 0.08838834764831845f * 1.4426950408889634f;
  float m = -1e30f, l = 0.f;
  f32x16 O[4];
#pragma unroll
  for (int dt = 0; dt < 4; ++dt)
#pragma unroll
    for (int r = 0; r < 16; ++r) O[dt][r] = 0.f;
  const unsigned char* kbase = (const unsigned char*)p.Kp + (size_t)bh * 128 * 8192 + lane * 16;
  const unsigned char* vbase = (const unsigned char*)p.Vp + (size_t)bh * 128 * 8192 + lane * 16;
  auto adv = [&](int& kt_, unsigned& rem_) {
    if (kt_ < 0) return;
    if (kt_ >= own0 ? (kt_ < diag) : ((kt_ & 7) != 7)) { kt_ = kt_ + 1; return; }
    if (rem_ == 0u) { kt_ = -1; return; }
    kt_ = 8 * (__builtin_ctz(rem_)); rem_ &= rem_ - 1u;
  };
  int kt = own0;
  if (par) adv(kt, rem);
  auto load_k = [&](int t, bf16x8 (&K_)[8]) {
#pragma unroll
    for (int ks = 0; ks < 8; ++ks) K_[ks] = *(const bf16x8*)(kbase + (size_t)t * 8192 + ks * 1024);
  };
  auto tile_step = [&](bf16x8 (&Kc)[8], bf16x8 (&Kn)[8]) -> bool {
    int ktn = kt; unsigned remn = rem;
    adv(ktn, remn); adv(ktn, remn);
    bf16x8 Vf[8];
#pragma unroll
    for (int f = 0; f < 8; ++f) Vf[f] = *(const bf16x8*)(vbase + (size_t)kt * 8192 + f * 1024);
    if (ktn >= 0) load_k(ktn, Kn);
    f32x16 S;
#pragma unroll
    for (int r = 0; r < 16; ++r) S[r] = 0.f;
#pragma unroll
    for (int ks = 0; ks < 8; ++ks) S = MFMA32(Kc[ks], *(const LAS bf16x8*)(qlds + ks * 1024), S);
    const bool allowed = (kt >= own0) || ((selmask >> (kt >> 3)) & 1u);
    const float nb = allowed ? 0.f : -INFINITY;
    float sv[16]; float mx = -INFINITY;
#pragma unroll
    for (int r = 0; r < 16; ++r) sv[r] = __builtin_fmaf(S[r], cscale, nb);
    if (kt == diag) {
#pragma unroll
      for (int r = 0; r < 16; ++r) if (crow32(r, hh) > q) sv[r] = -INFINITY;
    }
#pragma unroll
    for (int r = 0; r < 16; ++r) mx = fmaxf(mx, sv[r]);
    mx = fmaxf(mx, __shfl_xor(mx, 32, 64));
    const bool grow = mx > m + 8.f;
    const float mn = (__ballot(grow) != 0ull) ? fmaxf(m, mx) : m;
    const float alpha = __builtin_amdgcn_exp2f(m - mn);
    float ps = 0.f;
#pragma unroll
    for (int r = 0; r < 16; ++r) { sv[r] = __builtin_amdgcn_exp2f(sv[r] - mn); ps += sv[r]; }
    l = l * alpha + ps; m = mn;
    if (__ballot(alpha != 1.f) != 0ull) {
#pragma unroll
      for (int dt = 0; dt < 4; ++dt)
#pragma unroll
        for (int r = 0; r < 16; ++r) O[dt][r] *= alpha;
    }
    const bf16x8 P0 = pack8(sv[0], sv[1], sv[2], sv[3], sv[4], sv[5], sv[6], sv[7]);
    const bf16x8 P1 = pack8(sv[8], sv[9], sv[10], sv[11], sv[12], sv[13], sv[14], sv[15]);
#pragma unroll
    for (int dt = 0; dt < 4; ++dt) { O[dt] = MFMA32(Vf[dt * 2], P0, O[dt]); O[dt] = MFMA32(Vf[dt * 2 + 1], P1, O[dt]); }
    kt = ktn; rem = remn;
    return kt >= 0;
  };
  if (kt >= 0) {
    bf16x8 KA[8], KB[8];
    load_k(kt, KA);
#pragma unroll 1
    for (;;) {
      if (!tile_step(KA, KB)) break;
      asm volatile("" ::: "memory");
      if (!tile_step(KB, KA)) break;
      asm volatile("" ::: "memory");
    }
  }
  asm volatile("s_waitcnt vmcnt(0) lgkmcnt(0)" ::: "memory");
  if (par) {
    ml[lane] = m; ml[64 + lane] = l;
#pragma unroll
    for (int dt = 0; dt < 4; ++dt)
#pragma unroll
      for (int r = 0; r < 16; ++r) mrg[(dt * 16 + r) * 64 + lane] = O[dt][r];
  }
  __syncthreads();
  if (par == 0) {
    const float m2 = ml[lane], l2 = ml[64 + lane];
    const float mm = fmaxf(m, m2);
    const float a1 = __builtin_amdgcn_exp2f(m - mm), a2 = __builtin_amdgcn_exp2f(m2 - mm);
    l = l * a1 + l2 * a2;
#pragma unroll
    for (int dt = 0; dt < 4; ++dt)
#pragma unroll
      for (int r = 0; r < 16; ++r) O[dt][r] = O[dt][r] * a1 + mrg[(dt * 16 + r) * 64 + lane] * a2;
  }
  if (par == 0) {
  l += __shfl_xor(l, 32, 64);
  const float inv = 1.f / l;
  bf16_t* orow = rep ? p.oab2 + ((size_t)b * SEQ + s0 + q) * 512 + h * 128 : p.mb_out + ((size_t)b * SEQ + s0 + q) * p.mb_out_ld + p.mb_out_off + h * 128;
#pragma unroll
  for (int dt = 0; dt < 4; ++dt)
#pragma unroll
    for (int g4 = 0; g4 < 4; ++g4) {
      u32x2 wv; wv.x = pk2(O[dt][4 * g4] * inv, O[dt][4 * g4 + 1] * inv); wv.y = pk2(O[dt][4 * g4 + 2] * inv, O[dt][4 * g4 + 3] * inv);
      *(u32x2*)(orow + 32 * dt + 8 * g4 + 4 * hh) = wv;
    }
  }
  __syncthreads();
}
__device__ void moba_worker(const Params& p, LAS unsigned char* lds, int qi) {
  const int lane = p.tid & 63, w = __builtin_amdgcn_readfirstlane(p.tid >> 6);
  LAS float* km = (LAS float*)(lds + w * 16384);
  LAS float* mrg = (LAS float*)(lds + ((w & 3) + 4) * 16384);
  LAS float* ml = (LAS float*)(lds + 131072) + (w & 3) * 128;
  LAS int* slot = (LAS int*)(lds + 131072 + 2048);
  const int g0 = (int)((unsigned)__builtin_amdgcn_s_getreg((3 << 11) | 20) & 7u);
  for (int gi = 0; gi < 8; ++gi) {
    const int g = (g0 + gi) & 7;
    for (;;) {
      __syncthreads();
      if (p.tid == 0) slot[0] = atomicAdd(p.wq + qi * 8 + g, 1);
      __syncthreads();
      const int idx = slot[0];
      if (idx >= 64) break;
      const int bh = 2 * g + (idx >> 5), ib = 15 - ((idx >> 1) & 15), quad = 1 - (idx & 1);
      moba_item(p, km, mrg, ml, bh, ib, 4 * quad + (w & 3), w >> 2, lane, qi);
    }
  }
}
#define MOD_CTR 400
__device__ void ph_mod(const Params& p, LAS unsigned char* lds, int nblk, int bid) {
  LAS float* sc = (LAS float*)lds;
  LAS float* part = (LAS float*)(lds + 16384);
  const int tid = p.tid;
  if (bid >= 192) return;
  for (int i = tid; i < 4096; i += 512) sc[i] = siluf_(p.c[i]);
  __syncthreads();
  for (int task = bid; task < 192; task += nblk) {
    const int jj = tid & 31, ks = tid >> 5, j = task * 32 + jj;
    float a0 = 0.f, a1 = 0.f, a2 = 0.f, a3 = 0.f;
#pragma unroll 8
    for (int kk = 0; kk < 64; ++kk) {
      const int k = ks * 64 + kk;
      const float w = p.w_ada[(size_t)k * 6144 + j];
      a0 += sc[k] * w; a1 += sc[1024 + k] * w; a2 += sc[2048 + k] * w; a3 += sc[3072 + k] * w;
    }
    *(LAS f32x4*)(part + (ks * 32 + jj) * 4) = (f32x4){a0, a1, a2, a3};
    __syncthreads();
    if (tid < 128) {
      const int j2 = tid & 31, bb = tid >> 5;
      float a = 0.f;
#pragma unroll
      for (int s = 0; s < 16; ++s) a += part[(s * 32 + j2) * 4 + bb];
      __hip_atomic_store(&p.mod[bb * 6144 + task * 32 + j2], a + p.b_ada[task * 32 + j2], __ATOMIC_RELAXED, __HIP_MEMORY_SCOPE_AGENT);
    }
    asm volatile("s_waitcnt vmcnt(0)" ::: "memory");
    __syncthreads();
    if (tid == 0) __hip_atomic_fetch_add(p.dep + MOD_CTR, 1, __ATOMIC_RELAXED, __HIP_MEMORY_SCOPE_AGENT);
  }
}

#define WT_T0 1424
#define WT_T1 (WT_T0 + 16384)
#define WT_T2 (WT_T1 + 8192)
#define WT_T3 (WT_T2 + 128)
#define WT_T4 (WT_T3 + 128)
#define WT_T5 (WT_T4 + 256)
struct WtTile { const float* src; bf16_t* dst; int K, N, mode, k0, n0; unsigned char* dst8; };
__device__ __forceinline__ WtTile wt_desc(const Params& p, int t) {
  WtTile d;
  if (t < WT_T0) { const int kt = t / 89, nt = t % 89; d = {p.w_in, p.w_in_t, 1024, INW, 1, kt * 64, nt * 64, nullptr}; }
  else if (t < WT_T1) { const int u = t - WT_T0, e = u >> 9, r = u & 511, kt = r >> 5, nt = r & 31; d = {p.w_gu + (size_t)e * 1024 * 2048, nullptr, 1024, 2048, 2, kt * 64, nt * 64, p.wgu8 + (size_t)e * 2048 * 1024}; }
  else if (t < WT_T2) { const int u = t - WT_T1, e = u >> 8, r = u & 255, kt = r >> 4, nt = r & 15; d = {p.w_down + (size_t)e * 1024 * 1024, nullptr, 1024, 1024, 0, kt * 64, nt * 64, p.wd8 + (size_t)e * 1024 * 1024}; }
  else if (t < WT_T3) { const int u = t - WT_T2, kt = u >> 4, nt = u & 15; d = {p.w_br_a, p.wbra_t, 512, 1024, 0, kt * 64, nt * 64, nullptr}; }
  else if (t < WT_T4) { const int u = t - WT_T3, kt = u >> 4, nt = u & 15; d = {p.w_br_b, p.wbrb_t, 512, 1024, 0, kt * 64, nt * 64, nullptr}; }
  else { const int u = t - WT_T4, kt = u >> 4, nt = u & 15; d = {p.w_o, p.wo_t, 1024, 1024, 0, kt * 64, nt * 64, nullptr}; }
  return d;
}
__device__ __forceinline__ void wt_load(const WtTile& d, int tid, f32x4 (&v)[2]) {
#pragma unroll
  for (int it = 0; it < 2; ++it) {
    const int row = (tid >> 4) + 32 * it, n = d.n0 + (tid & 15) * 4;
    v[it] = (f32x4){0.f, 0.f, 0.f, 0.f};
    if (n < d.N) v[it] = __builtin_nontemporal_load((const f32x4*)(d.src + (size_t)(d.k0 + row) * d.N + n));
  }
}
__device__ void ph_wt(const Params& p, LAS unsigned char* lds, int nblk, int bid) {
  LAS float* tile = (LAS float*)(lds + 32768);
  const int tid = p.tid;
  int t = bid;
  if (t >= WT_T5) return;
  WtTile cur = wt_desc(p, t);
  f32x4 v[2]; wt_load(cur, tid, v);
  WtTile nxt = cur; f32x4 vn[2] = {v[0], v[1]};
  if (t + nblk < WT_T5) { nxt = wt_desc(p, t + nblk); wt_load(nxt, tid, vn); }
  for (;;) {
    const int tnn = t + 2 * nblk;
    WtTile nn = nxt; f32x4 vnn[2] = {vn[0], vn[1]};
    if (tnn < WT_T5) { nn = wt_desc(p, tnn); wt_load(nn, tid, vnn); }
#pragma unroll
    for (int it = 0; it < 2; ++it) {
      const int row = (tid >> 4) + 32 * it, c4 = (tid & 15) * 4;
      tile[row * 65 + c4] = v[it][0]; tile[row * 65 + c4 + 1] = v[it][1]; tile[row * 65 + c4 + 2] = v[it][2]; tile[row * 65 + c4 + 3] = v[it][3];
    }
    __syncthreads();
    {
      const int nl = tid >> 3, kc = tid & 7, n = cur.n0 + nl;
      if (n < cur.N) {
        const int dd = map_col(n, cur.mode);
        if (dd >= 0) {
          float f[8];
#pragma unroll
          for (int j = 0; j < 8; ++j) f[j] = tile[(8 * kc + j) * 65 + nl];
          if (cur.dst8) {
            u32x2 w; w.x = pk4_fp8(f[0] * 64.f, f[1] * 64.f, f[2] * 64.f, f[3] * 64.f); w.y = pk4_fp8(f[4] * 64.f, f[5] * 64.f, f[6] * 64.f, f[7] * 64.f);
            *(u32x2*)(cur.dst8 + (size_t)dd * cur.K + cur.k0 + 8 * kc) = w;
          } else {
            u32x4 w; w.x = pk2(f[0], f[1]); w.y = pk2(f[2], f[3]); w.z = pk2(f[4], f[5]); w.w = pk2(f[6], f[7]);
            *(u32x4*)(cur.dst + (size_t)dd * cur.K + cur.k0 + 8 * kc) = w;
          }
        }
      }
    }
    __syncthreads();
    if (t + nblk >= WT_T5) break;
    t += nblk; cur = nxt; v[0] = vn[0]; v[1] = vn[1]; nxt = nn; vn[0] = vnn[0]; vn[1] = vnn[1];
  }
}

__device__ void ph_h(const Params& p, LAS unsigned char* lds, int nblk, int bid) {
  const int wid = p.tid >> 6, lane = p.tid & 63;
  LAS float* wb = (LAS float*)lds;
  __syncthreads();
  for (int i = p.tid; i < 2048; i += 512) {
    const int k = i >> 1, hf = i & 1;
    const f32x4 v = *(const f32x4*)(p.w_in + (size_t)k * INW + 2048 + 4 * hf);
    wb[(4 * hf + 0) * 1024 + k] = v[0]; wb[(4 * hf + 1) * 1024 + k] = v[1]; wb[(4 * hf + 2) * 1024 + k] = v[2]; wb[(4 * hf + 3) * 1024 + k] = v[3];
  }
  __syncthreads();
  while (__builtin_amdgcn_readfirstlane(__hip_atomic_load(p.dep + MOD_CTR, __ATOMIC_RELAXED, __HIP_MEMORY_SCOPE_AGENT)) < 192) __builtin_amdgcn_s_sleep(4);
  asm volatile("" ::: "memory");
  f32x4 gv[4];
#pragma unroll
  for (int i = 0; i < 4; ++i) gv[i] = *(const f32x4*)(p.g_pre_mix + i * 256 + lane * 4);
  f32x4 xnx[4];
  if (bid * 8 + wid < T_TOK) {
#pragma unroll
    for (int i = 0; i < 4; ++i) xnx[i] = *(const f32x4*)(p.x + (size_t)(bid * 8 + wid) * DM + i * 256 + lane * 4);
  }
  for (int t = bid * 8 + wid; t < T_TOK; t += nblk * 8) {
    const int b = t / SEQ;
    f32x4 xv[4];
    float ss = 0.f;
#pragma unroll
    for (int i = 0; i < 4; ++i) {
      xv[i] = xnx[i];
      ss += xv[i][0] * xv[i][0] + xv[i][1] * xv[i][1] + xv[i][2] * xv[i][2] + xv[i][3] * xv[i][3];
    }
    if (t + nblk * 8 < T_TOK) {
#pragma unroll
      for (int i = 0; i < 4; ++i) xnx[i] = *(const f32x4*)(p.x + (size_t)(t + nblk * 8) * DM + i * 256 + lane * 4);
    }
    ss = wave_sum(ss);
    const float rstd = rsqrtf(ss * (1.f / DM) + 1e-6f);
    const float* shift = p.mod + b * 6144;
    const float* scale = p.mod + b * 6144 + 1024;
    float acc[8] = {0, 0, 0, 0, 0, 0, 0, 0};
    f32x4 scv[4], shv[4];
#pragma unroll
    for (int i = 0; i < 4; ++i) { scv[i] = *(const f32x4*)(scale + i * 256 + lane * 4); shv[i] = *(const f32x4*)(shift + i * 256 + lane * 4); }
#pragma unroll
    for (int i = 0; i < 4; ++i) {
      const int k = i * 256 + lane * 4;
      const f32x4 g = gv[i], sc = scv[i], sh = shv[i];
      f32x4 hv;
#pragma unroll
      for (int j = 0; j < 4; ++j) hv[j] = xv[i][j] * rstd * g[j] * (1.f + sc[j]) + sh[j];
#pragma unroll
      for (int e = 0; e < 8; ++e) { const f32x4 w = *(const LAS f32x4*)(wb + e * 1024 + k); acc[e] += hv[0] * w[0] + hv[1] * w[1] + hv[2] * w[2] + hv[3] * w[3]; }
      u32x2 pk; pk.x = pk2(hv[0], hv[1]); pk.y = pk2(hv[2], hv[3]);
      *(u32x2*)(p.hbf + (size_t)t * DM + k) = pk;
    }
#pragma unroll
    for (int e = 0; e < 8; ++e) acc[e] = wave_sum(acc[e]);
    if (lane == 0) { *(f32x4*)(p.ba + (size_t)t * 8) = (f32x4){acc[0], acc[1], acc[2], acc[3]}; *(f32x4*)(p.ba + (size_t)t * 8 + 4) = (f32x4){acc[4], acc[5], acc[6], acc[7]}; }
  }
}

#define PM_WT 0
#define PM_H2 66048
#define PM_CNT 132096
#define PM_ENT 132352
__device__ void ph_post_mix(const Params& p, LAS unsigned char* lds, int nblk, int bid, int rep) {
  const int wid = p.tid >> 6, lane = p.tid & 63, r16 = lane & 15, q4 = lane >> 4;
  LAS bf16_t* wT = (LAS bf16_t*)(lds + PM_WT);
  LAS bf16_t* ht = (LAS bf16_t*)(lds + PM_H2) + wid * 4 * 1032;
  LAS int* lcnt = (LAS int*)(lds + PM_CNT);
  LAS int* lbase = lcnt + 32;
  LAS int* lent = (LAS int*)(lds + PM_ENT) + wid * 64;
  int nloc = 0;
  if (p.tid < 32) lcnt[p.tid] = 0;
  for (int i = p.tid; i < 1024 * 8; i += 512) {
    const int k = i >> 3, c = i & 7;
    const f32x4 v = *(const f32x4*)(p.w_router + (size_t)k * 32 + c * 4);
#pragma unroll
    for (int j = 0; j < 4; ++j) wT[(c * 4 + j) * 1032 + k] = f2bf_hw(v[j]);
  }
  __syncthreads();
  const float bias0 = p.b_router[r16], bias1 = p.b_router[16 + r16];
  const int tstride = nblk * 8;
  f32x4 gpv[4], gqv[4];
#pragma unroll
  for (int i4 = 0; i4 < 4; ++i4) { const int k = (i4 >> 1) * 512 + lane * 8 + (i4 & 1) * 4; gpv[i4] = *(const f32x4*)(p.g_post_mix + k); gqv[i4] = *(const f32x4*)(p.g_pre_ffn + k); }
  u32x4 mxn[2]; f32x4 xn[4];
  {
    const int t0 = bid * 8 + wid;
    if (t0 < T_TOK) {
#pragma unroll
      for (int i = 0; i < 2; ++i) mxn[i] = *(const u32x4*)(p.mixer + (size_t)t0 * DM + i * 512 + lane * 8);
#pragma unroll
      for (int i = 0; i < 4; ++i) xn[i] = *(const f32x4*)(p.x + (size_t)t0 * DM + (i >> 1) * 512 + lane * 8 + (i & 1) * 4);
    }
  }
  for (int tg = bid * 8 + wid; tg < T_TOK; tg += 4 * tstride) {
#pragma unroll 1
    for (int jj = 0; jj < 4; ++jj) {
      const int t = tg + jj * tstride;
      if (t >= T_TOK) break;
      const int b = t / SEQ;
      const float* md = p.mod + b * 6144;
      u32x4 mxc[2] = {mxn[0], mxn[1]}; f32x4 xc[4] = {xn[0], xn[1], xn[2], xn[3]};
      {
        const int tn = t + tstride;
        if (tn < T_TOK) {
#pragma unroll
          for (int i = 0; i < 2; ++i) mxn[i] = *(const u32x4*)(p.mixer + (size_t)tn * DM + i * 512 + lane * 8);
#pragma unroll
          for (int i = 0; i < 4; ++i) xn[i] = *(const f32x4*)(p.x + (size_t)tn * DM + (i >> 1) * 512 + lane * 8 + (i & 1) * 4);
        }
      }
      float mv[16];
      float ss = 0.f;
#pragma unroll
      for (int i = 0; i < 2; ++i) {
        float f[8]; unpack8(mxc[i], f);
#pragma unroll
        for (int j = 0; j < 8; ++j) { mv[i * 8 + j] = f[j]; ss += f[j] * f[j]; }
      }
      ss = wave_sum(ss);
      const float rstd = rsqrtf(ss * (1.f / DM) + 1e-6f);
      f32x4 gmv[4], scv[4], sfv[4];
#pragma unroll
      for (int i4 = 0; i4 < 4; ++i4) { const int k = (i4 >> 1) * 512 + lane * 8 + (i4 & 1) * 4; gmv[i4] = *(const f32x4*)(md + 2048 + k); scv[i4] = *(const f32x4*)(md + 4096 + k); sfv[i4] = *(const f32x4*)(md + 3072 + k); }
      float x1[16];
      float s2 = 0.f;
#pragma unroll
      for (int i = 0; i < 2; ++i) {
#pragma unroll
        for (int j4 = 0; j4 < 2; ++j4) {
          const f32x4 xv = xc[i * 2 + j4];
          const f32x4 gm = gmv[i * 2 + j4], gp = gpv[i * 2 + j4];
#pragma unroll
          for (int j = 0; j < 4; ++j) { const float o = xv[j] + gm[j] * (mv[i * 8 + j4 * 4 + j] * rstd * gp[j]); x1[i * 8 + j4 * 4 + j] = o; s2 += o * o; }
        }
        u32x4 xb; xb.x = pk2(x1[i * 8], x1[i * 8 + 1]); xb.y = pk2(x1[i * 8 + 2], x1[i * 8 + 3]); xb.z = pk2(x1[i * 8 + 4], x1[i * 8 + 5]); xb.w = pk2(x1[i * 8 + 6], x1[i * 8 + 7]);
        *(u32x4*)(p.hbf + (size_t)t * DM + i * 512 + lane * 8) = xb;
      }
      s2 = wave_sum(s2);
      const float rstd2 = rsqrtf(s2 * (1.f / DM) + 1e-6f);
#pragma unroll
      for (int i = 0; i < 2; ++i) {
        float hv[8];
#pragma unroll
        for (int j4 = 0; j4 < 2; ++j4) {
          const int k = i * 512 + lane * 8 + j4 * 4;
          const f32x4 gq = gqv[i * 2 + j4], sc = scv[i * 2 + j4], sf = sfv[i * 2 + j4];
#pragma unroll
          for (int j = 0; j < 4; ++j) hv[j4 * 4 + j] = x1[i * 8 + j4 * 4 + j] * rstd2 * gq[j] * (1.f + sc[j]) + sf[j];
        }
        u32x2 w; w.x = pk4_fp8(hv[0], hv[1], hv[2], hv[3]); w.y = pk4_fp8(hv[4], hv[5], hv[6], hv[7]);
        *(u32x2*)(p.h2q + (size_t)t * DM + i * 512 + lane * 8) = w;
        u32x4 hb; hb.x = pk2(hv[0], hv[1]); hb.y = pk2(hv[2], hv[3]); hb.z = pk2(hv[4], hv[5]); hb.w = pk2(hv[6], hv[7]);
        *(LAS u32x4*)(ht + jj * 1032 + i * 512 + lane * 8) = hb;
      }
    }
    f32x4 acc0 = {0.f, 0.f, 0.f, 0.f}, acc1 = {0.f, 0.f, 0.f, 0.f};
#pragma unroll 8
    for (int ks = 0; ks < 32; ++ks) {
      const bf16x8 a = *(const LAS bf16x8*)(ht + (r16 & 3) * 1032 + 32 * ks + 8 * q4);
      const bf16x8 b0 = *(const LAS bf16x8*)(wT + r16 * 1032 + 32 * ks + 8 * q4);
      const bf16x8 b1 = *(const LAS bf16x8*)(wT + (16 + r16) * 1032 + 32 * ks + 8 * q4);
      acc0 = MFMA16(a, b0, acc0); acc1 = MFMA16(a, b1, acc1);
    }
#pragma unroll
    for (int jj = 0; jj < 4; ++jj) {
      const int t = tg + jj * tstride;
      if (t < T_TOK) {
        float l0 = (lane < 16) ? acc0[jj] + bias0 : -INFINITY, l1 = (lane < 16) ? acc1[jj] + bias1 : -INFINITY;
        float tv[4]; int ti[4];
#pragma unroll
        for (int r = 0; r < 4; ++r) {
          const float m = wave_max(fmaxf(l0, l1));
          const unsigned long long b0m = __ballot(l0 == m);
          int idx;
          if (b0m) { idx = __ffsll((long long)b0m) - 1; if (lane == idx) l0 = -INFINITY; }
          else { const unsigned long long b1m = __ballot(l1 == m); idx = __ffsll((long long)b1m) - 1; if (lane == idx) l1 = -INFINITY; idx += 16; }
          tv[r] = m; ti[r] = idx;
        }
        const float e1 = __expf(tv[1] - tv[0]), e2 = __expf(tv[2] - tv[0]), e3 = __expf(tv[3] - tv[0]);
        const float inv = 1.f / (1.f + e1 + e2 + e3);
        if (lane < 4) {
          const int ee = lane == 0 ? ti[0] : lane == 1 ? ti[1] : lane == 2 ? ti[2] : ti[3];
          const float ww = (lane == 0 ? 1.f : lane == 1 ? e1 : lane == 2 ? e2 : e3) * inv;
          p.aw[t * 4 + lane] = ww;
          const int rank = __hip_atomic_fetch_add(&lcnt[ee], 1, __ATOMIC_RELAXED, __HIP_MEMORY_SCOPE_WORKGROUP);
          lent[nloc * 4 + lane] = (ee << 16) | rank;
          lent[nloc * 4 + lane + 2048] = t * 4 + lane;
        }
        ++nloc;
      }
    }
  }
  __syncthreads();
  if (p.tid < 32) lbase[p.tid] = atomicAdd(&p.cnt[p.tid * 64 + 32 * rep], lcnt[p.tid]);
  __syncthreads();
  for (int i = lane; i < nloc * 4; i += 64) {
    const int er = lent[i], a = lent[i + 2048];
    p.elist[(er >> 16) * T_TOK + lbase[er >> 16] + (er & 0xffff)] = a;
  }
}

__device__ void ph_final(const Params& p, int nblk, int bid, int rep) {
  const int wid = p.tid >> 6, lane = p.tid & 63;
  f32x4 gpf[4];
#pragma unroll
  for (int i4 = 0; i4 < 4; ++i4) gpf[i4] = *(const f32x4*)(p.g_post_ffn + (i4 >> 1) * 512 + lane * 8 + (i4 & 1) * 4);
  for (int t0 = bid * 8 + wid; t0 < T_TOK; t0 += nblk * 16) {
    int tt[2] = {t0, t0 + nblk * 8};
    if (tt[1] >= T_TOK) tt[1] = t0;
    float mv[2][16]; float ss[2];
#pragma unroll
    for (int u = 0; u < 2; ++u) {
      const int t = tt[u];
      const f32x4 wv = *(const f32x4*)(p.aw + t * 4) * 0.125f;
      ss[u] = 0.f;
#pragma unroll
      for (int i = 0; i < 2; ++i) {
        const unsigned char* y = (const unsigned char*)p.yslot + (size_t)t * 4 * DM + i * 512 + lane * 8;
        float f0[8], f1[8], f2[8], f3[8];
        unpack8_fp8(*(const u32x2*)y, f0); unpack8_fp8(*(const u32x2*)(y + DM), f1); unpack8_fp8(*(const u32x2*)(y + 2 * DM), f2); unpack8_fp8(*(const u32x2*)(y + 3 * DM), f3);
#pragma unroll
        for (int j = 0; j < 8; ++j) { const float m = wv[0] * f0[j] + wv[1] * f1[j] + wv[2] * f2[j] + wv[3] * f3[j]; mv[u][i * 8 + j] = m; ss[u] += m * m; }
      }
    }
    u32x4 x1[2][2];
#pragma unroll
    for (int u = 0; u < 2; ++u)
#pragma unroll
      for (int i = 0; i < 2; ++i) x1[u][i] = *(const u32x4*)(p.hbf + (size_t)tt[u] * DM + i * 512 + lane * 8);
    f32x4 gfv[2][4];
#pragma unroll
    for (int u = 0; u < 2; ++u)
#pragma unroll
      for (int i4 = 0; i4 < 4; ++i4) gfv[u][i4] = *(const f32x4*)(p.mod + (tt[u] / SEQ) * 6144 + 5120 + (i4 >> 1) * 512 + lane * 8 + (i4 & 1) * 4);
    ss[0] = wave_sum(ss[0]); ss[1] = wave_sum(ss[1]);
#pragma unroll
    for (int u = 0; u < 2; ++u) {
      const int t = tt[u];
      if (u == 1 && t == t0) break;
      const float rstd = rsqrtf(ss[u] * (1.f / DM) + 1e-6f);
#pragma unroll
      for (int i = 0; i < 2; ++i) {
        float xf[8]; unpack8(x1[u][i], xf);
#pragma unroll
        for (int j4 = 0; j4 < 2; ++j4) {
          const int k = i * 512 + lane * 8 + j4 * 4;
          float* op = p.out + (size_t)t * DM + k;
          const f32x4 gf = gfv[u][i * 2 + j4], gp = gpf[i * 2 + j4];
          f32x4 o;
#pragma unroll
          for (int j = 0; j < 4; ++j) o[j] = xf[j4 * 4 + j] + gf[j] * (mv[u][i * 8 + j4 * 4 + j] * rstd * gp[j]);
          *(f32x4*)(rep ? (float*)p.merged + (size_t)(t & 8191) * DM + k : op) = o;
        }
      }
    }
  }
}

#define XCD_BAR_WORDS 3456
struct KArgs { const void* in[22]; float* out; char* ws; long long never; };
__host__ __device__ inline size_t al(size_t x) { return (x + 255) & ~(size_t)255; }
__host__ __device__ inline void fill_params(Params& p, const KArgs& k) {
  p.x = (const float*)k.in[0]; p.c = (const float*)k.in[1]; p.w_ada = (const float*)k.in[2]; p.b_ada = (const float*)k.in[3];
  p.g_pre_mix = (const float*)k.in[4]; p.g_post_mix = (const float*)k.in[5]; p.g_pre_ffn = (const float*)k.in[6];
  p.g_post_ffn = (const float*)k.in[7]; p.w_in = (const float*)k.in[8]; p.conv_w = (const float*)k.in[9];
  p.a_log = (const float*)k.in[10]; p.dt_bias = (const float*)k.in[11]; p.g_dn_out = (const float*)k.in[12];
  p.w_br_a = (const float*)k.in[13]; p.w_br_b = (const float*)k.in[14]; p.w_o = (const float*)k.in[15];
  p.w_router = (const float*)k.in[16]; p.b_router = (const float*)k.in[17]; p.w_gu = (const float*)k.in[18];
  p.b_gu = (const float*)k.in[19]; p.w_down = (const float*)k.in[20]; p.b_down = (const float*)k.in[21];
  p.out = k.out;
  char* w = k.ws;
  size_t o = 0;
#define take(bytes) (w + (o += al(bytes)) - al(bytes))
  p.mod = (float*)take(4 * 6144 * 4);
  p.cnt = (int*)take(16384);
  p.ba = (float*)take((size_t)T_TOK * 8 * 4);
  p.hbf = (bf16_t*)take((size_t)T_TOK * DM * 2);
  p.proj = (bf16_t*)take((size_t)T_TOK * PW * 2);
  p.w_in_t = (bf16_t*)take((size_t)PW * DM * 2);
  p.wgu8 = (unsigned char*)take((size_t)NE * 2048 * DM);
  p.wd8 = (unsigned char*)take((size_t)NE * 1024 * DM);
  p.h2q = (unsigned char*)take((size_t)T_TOK * DM);
  p.act8 = (unsigned char*)take((size_t)73728 * DM);
  p.wbra_t = (bf16_t*)take((size_t)1024 * 512 * 2);
  p.wbrb_t = (bf16_t*)take((size_t)1024 * 512 * 2);
  p.wo_t = (bf16_t*)take((size_t)1024 * 1024 * 2);
  p.qb = (bf16_t*)take((size_t)T_TOK * 512 * 2);
  p.kb = nullptr;
  p.kmean = (float*)take((size_t)16 * 16 * 128 * 4);
  p.oab = (bf16_t*)take((size_t)T_TOK * DM * 2);
  p.merged = (bf16_t*)take((size_t)T_TOK * DM * 2);
  p.mixer = (bf16_t*)take((size_t)T_TOK * DM * 2);
  p.h2 = nullptr;
  p.elist = (int*)take((size_t)NE * T_TOK * 4);
  p.aw = (float*)take((size_t)T_TOK * 4 * 4);
  p.rowmap = nullptr;
  p.dnA = (unsigned char*)take((size_t)1024 * DN_ABYTES);
  p.dnU = (float*)take((size_t)1024 * DN_UFLOATS * 4);
  p.dnG = (float*)take(4096);
  p.dnS = (unsigned char*)take((size_t)1024 * 8 * 4096);
  p.dnV = (unsigned char*)take((size_t)1024 * 8 * 2048);
  p.oab2 = (bf16_t*)take((size_t)T_TOK * 512 * 2);
  p.dbg = (float*)take(256);
  p.bar = (unsigned*)take(XCD_BAR_WORDS * 4);
  p.dn_out = p.oab; p.dn_out_ld = DM;
  p.Kp = (bf16_t*)take((size_t)16 * 128 * 8192);
  p.Vp = (bf16_t*)take((size_t)16 * 128 * 8192);
  p.wq = p.cnt + 32 * 64;
  p.dep = p.cnt + 2304;
  p.mb_out = p.oab; p.mb_out_ld = DM; p.mb_out_off = 512;
  p.xs = nullptr; p.act = nullptr;
  p.yslot = (bf16_t*)take((size_t)65536 * DM * 2);
  p.nq = p.nk = p.nv = p.no = p.ntmp = p.nbeta = p.ng = nullptr;
#undef take
#undef t2
  p.never = (int)k.never;
}

#define XB_TMO      128
#define XB_XCNT(j)  (256  + 64 * (j))
#define XB_XSUB(j)  (1280 + 64 * (j))
#define XB_XGEN(j)  (2304 + 64 * (j))
#define XB_TOP      3328
#define XB_TOPGEN   3392
#define XB_SPIN_CAP (1u << 18)

__device__ __forceinline__ unsigned xb_ld(unsigned* p)              { return __hip_atomic_load(p, __ATOMIC_RELAXED, __HIP_MEMORY_SCOPE_AGENT); }
__device__ __forceinline__ unsigned xb_add(unsigned* p, unsigned v) { return __hip_atomic_fetch_add(p, v, __ATOMIC_RELAXED, __HIP_MEMORY_SCOPE_AGENT); }
__device__ __forceinline__ unsigned xb_xcc_id() { return (unsigned)__builtin_amdgcn_s_getreg((3 << 11) | 20) & 0xFu; }
#define XB_SPIN(cond, bar) do { unsigned _sp = 0; while (cond) { __builtin_amdgcn_s_sleep(1); \
    if ((++_sp & 255u) == 0u) { if (xb_ld(&(bar)[XB_TMO])) break; if (_sp > XB_SPIN_CAP) { atomicAdd(&(bar)[XB_TMO], 1u); break; } } } } while (0)

struct XcdBarrier {
    unsigned* bar; unsigned x;
    volatile LAS unsigned* st;
};

__device__ __forceinline__ XcdBarrier xcd_barrier_post(unsigned* bar, volatile LAS unsigned* st) {
    XcdBarrier b; b.bar = bar; b.x = xb_xcc_id(); b.st = st;
    if (threadIdx.x == 0) (void)xb_add(&bar[XB_XCNT(b.x)], 1u);
    return b;
}
__device__ __forceinline__ void xcd_barrier_complete(unsigned* bar, unsigned x, unsigned& nloc, unsigned& nx) {
    const unsigned G = gridDim.x * gridDim.y * gridDim.z;
    unsigned sum, cnt, mine, sp = 0u;
    for (;;) {
        sum = 0u; cnt = 0u; mine = 0u;
#pragma unroll
        for (unsigned j = 0; j < 16; ++j) { const unsigned c = xb_ld(&bar[XB_XCNT(j)]); sum += c; cnt += (c > 0u) ? 1u : 0u; mine = (j == x) ? c : mine; }
        if (sum == G) break;
        __builtin_amdgcn_s_sleep(1);
        if ((++sp & 255u) == 0u) { if (xb_ld(&bar[XB_TMO])) break; if (sp > XB_SPIN_CAP) { atomicAdd(&bar[XB_TMO], 1u); break; } }
    }
    nloc = mine > 0u ? mine : 1u; nx = cnt > 0u ? cnt : 1u;
}

__device__ __forceinline__ void xcd_barrier(const XcdBarrier& b, const int tid) {
    asm volatile("s_waitcnt vmcnt(0)" ::: "memory");
    __syncthreads();
    if (tid == 0) {
        unsigned* bar = b.bar;
        __builtin_amdgcn_s_waitcnt(0);
        unsigned nloc = b.st[0], nx = b.st[1];
        if (nloc == 0u) { xcd_barrier_complete(bar, b.x, nloc, nx); b.st[0] = nloc; b.st[1] = nx; }
        const unsigned old = xb_add(&bar[XB_XSUB(b.x)], 1u);
        const unsigned gen = old / nloc;
        if (old + 1u == (gen + 1u) * nloc) {
            __builtin_amdgcn_fence(__ATOMIC_RELEASE, "agent");
            asm volatile("s_waitcnt vmcnt(0)" ::: "memory");
            const unsigned og = xb_add(&bar[XB_TOP], 1u);
            const unsigned tg = og / nx;
            if (og + 1u == (tg + 1u) * nx) xb_add(&bar[XB_TOPGEN], 1u);
            else XB_SPIN(xb_ld(&bar[XB_TOPGEN]) == tg, bar);
            __builtin_amdgcn_fence(__ATOMIC_ACQUIRE, "agent");
            xb_add(&bar[XB_XGEN(b.x)], 1u);
            asm volatile("s_waitcnt vmcnt(0)" ::: "memory");
        } else {
            XB_SPIN(xb_ld(&bar[XB_XGEN(b.x)]) == gen, bar);
            __builtin_amdgcn_fence(__ATOMIC_ACQUIRE, "agent");
            asm volatile("s_waitcnt vmcnt(0)" ::: "memory");
        }
    }
    __syncthreads();
}


__device__ __forceinline__ void load_ka(KArgs& kk) {
#if defined(__HIP_DEVICE_COMPILE__)
  typedef __attribute__((address_space(1))) char* gptr_t;
  typedef const __attribute__((address_space(4))) gptr_t* kptr_t;
  kptr_t kp = (kptr_t)__builtin_amdgcn_kernarg_segment_ptr();
  asm volatile("" : "+s"(kp));
#pragma unroll
  for (int i = 0; i < 22; ++i) kk.in[i] = (const void*)kp[i];
  kk.out = (float*)kp[22];
  kk.ws = (char*)kp[23];
  kk.never = ((const __attribute__((address_space(4))) long long*)kp)[24];
#endif
}
__device__ __forceinline__ void grid_bar(const Params& p, LAS unsigned char* lds);
#define MEGA_LDS 148480
#define MEGA_LDS_ALLOC (MEGA_LDS + 16)
__device__ __forceinline__ void grid_bar(const Params& p, LAS unsigned char* lds) {
  XcdBarrier b; b.bar = p.bar; b.x = xb_xcc_id(); b.st = (volatile LAS unsigned*)(lds + MEGA_LDS);
  xcd_barrier(b, p.tid);
}
__global__ __launch_bounds__(512) void mega(KArgs ka) {
  extern __shared__ __attribute__((aligned(16))) unsigned char shm[];
  LAS unsigned char* lds = (LAS unsigned char*)shm;
  cg::grid_group grid = cg::this_grid();
  const int nblk = gridDim.x, bid = blockIdx.x;
  const int wv_ = __builtin_amdgcn_readfirstlane(threadIdx.x >> 6);
  volatile LAS unsigned* xst = (volatile LAS unsigned*)(lds + MEGA_LDS);
  if (threadIdx.x == 0) { xst[0] = 0u; xst[1] = 0u; xst[2] = 0u; xst[3] = 0u; }
  __syncthreads();
  { Params p0; fill_params(p0, ka); (void)xcd_barrier_post(p0.bar, xst); }
  if (ka.never) grid.sync();
#ifndef REPMASK
#define REPMASK 0
#endif
#define LOADKA KArgs kk; load_ka(kk)
#ifndef PHMASK
#define PHMASK 0xffff
#endif
#define PHASE_(k, body, bar) if (((PHMASK) >> (k)) & 1) for (int rep_ = 0; rep_ < (((REPMASK) >> (k)) & 1) + 1; ++rep_) { \
    LOADKA; Params p; fill_params(p, kk); { int t_; asm volatile("v_mbcnt_lo_u32_b32 %0, -1, 0\n\tv_mbcnt_hi_u32_b32 %0, -1, %0" : "=v"(t_)); p.tid = (wv_ << 6) | t_; } body; bar; }
#define PHASE(k, body) PHASE_(k, body, grid_bar(p, lds))
#define PHASE_LAST(k, body) PHASE_(k, body, (void)0)
#ifdef XBAR
  for (int xb_ = 0; xb_ < XBAR; ++xb_) { PHASE(15, {}) }
#endif
  PHASE(0, { ph_mod(p, lds, nblk, bid); ph_wt(p, lds, nblk, bid); ph_h(p, lds, nblk, bid); })
  PHASE(2, { ph_proj(p, lds, nblk, bid); })
  PHASE(3, { bool first = true; for (int ci = bid; ci < 1024; ci += nblk) { dn_prep_chunk(p, lds, ci, first); first = false; }
             for (int item = bid; item < 256; item += nblk) moba_prep_block(p, lds, item); })
  PHASE(4, { if (bid < 32) dn_scan_blk(p, lds, bid); moba_worker(p, lds, rep_); ph_dn_out(p, lds, nblk, bid); })
  PHASE(6, { ph_br(p, lds, nblk, bid); })
  PHASE(7, { ph_mix(p, lds, nblk, bid); })
  PHASE(8, { ph_post_mix(p, lds, nblk, bid, rep_); })
  PHASE(10, { ph_moe1(p, lds, nblk, bid); ph_moe2(p, lds, nblk, bid); })
  PHASE_LAST(12, { ph_final(p, nblk, bid, rep_); })
}


extern "C" void kernel_launch(void* const* d_in, const int* in_sizes, int n_in, void* d_out, int out_size, void* d_ws,
                              size_t ws_size, hipStream_t stream) {
  KArgs ka{};
  for (int i = 0; i < 22; ++i) ka.in[i] = d_in[i];
  ka.out = (float*)d_out; ka.ws = (char*)d_ws; ka.never = 0;
  Params p{};
  fill_params(p, ka);
  static int grid_blocks = 0;
  if (!grid_blocks) {
    (void)hipFuncSetAttribute((const void*)mega, hipFuncAttributeMaxDynamicSharedMemorySize, MEGA_LDS_ALLOC);
    int dev = 0, cus = 0, per_cu = 0;
    (void)hipGetDevice(&dev);
    (void)hipDeviceGetAttribute(&cus, hipDeviceAttributeMultiprocessorCount, dev);
    (void)hipOccupancyMaxActiveBlocksPerMultiprocessor(&per_cu, mega, 512, MEGA_LDS_ALLOC);
    if (per_cu != 1) per_cu = 1;
    grid_blocks = cus * per_cu;
  }
  (void)hipMemsetAsync(p.cnt, 0, 16384, stream);
  (void)hipMemsetAsync(p.bar, 0, XCD_BAR_WORDS * 4, stream);
  void* args[] = {&ka};
  hipError_t e = hipLaunchCooperativeKernel((void*)mega, dim3(grid_blocks), dim3(512), args, MEGA_LDS_ALLOC, stream);
  if (e != hipSuccess) fprintf(stderr, "cooperative launch failed: %s (grid %d)\n", hipGetErrorString(e), grid_blocks);
}
```

```cpp
#define WGM_MOE 1
#define WGM_PROJ 4
#define WGM_BR 4
#define WGM_MIX 4
#include <hip/hip_runtime.h>
#include <hip/hip_cooperative_groups.h>
#include <cstdio>
namespace cg = cooperative_groups;
#include <stdint.h>

typedef unsigned short bf16_t;
#ifndef MB_ABL
#define MB_ABL 0
#endif

#define T_TOK 16384
#define SEQ 4096
#define NB 4
#define DM 1024
#define INW 5640
#define PW 5632
#define C_QA 0
#define C_KA 512
#define C_VA 1024
#define C_Z 1536
#define C_MQ 2048
#define C_MK 2560
#define C_MV 3072
#define C_GA 3584
#define C_GB 4608
#define NE 32

__device__ __forceinline__ bf16_t f2bf(float f) {
  unsigned u = __float_as_uint(f);
  u += 0x7fffu + ((u >> 16) & 1u);
  return (bf16_t)(u >> 16);
}
__device__ __forceinline__ float bf2f(bf16_t h) { return __uint_as_float(((unsigned)h) << 16); }
__device__ __forceinline__ float sigmoidf_(float x) { return __builtin_amdgcn_rcpf(1.f + __builtin_amdgcn_exp2f(-1.4426950408889634f * x)); }
__device__ __forceinline__ float siluf_(float x) { return x * sigmoidf_(x); }
__device__ __forceinline__ float wave_sum(float v) {
#pragma unroll
  for (int o = 32; o > 0; o >>= 1) v += __shfl_xor(v, o, 64);
  return v;
}
__device__ __forceinline__ float wave_max(float v) {
#pragma unroll
  for (int o = 32; o > 0; o >>= 1) v = fmaxf(v, __shfl_xor(v, o, 64));
  return v;
}

typedef unsigned u32x2 __attribute__((ext_vector_type(2)));
typedef __bf16 bf16x2_t __attribute__((ext_vector_type(2)));
typedef float f32x2_t __attribute__((ext_vector_type(2)));
__device__ __forceinline__ unsigned pk2(float a, float b) { f32x2_t v = {a, b}; bf16x2_t r = __builtin_convertvector(v, bf16x2_t); return __builtin_bit_cast(unsigned, r); }

__device__ __forceinline__ unsigned pk4_fp8(float a, float b, float c, float d) {
  int w = 0;
  w = __builtin_amdgcn_cvt_pk_fp8_f32(a, b, w, false);
  w = __builtin_amdgcn_cvt_pk_fp8_f32(c, d, w, true);
  return (unsigned)w;
}
__device__ __forceinline__ void unpack8_fp8(const u32x2 w, float (&f)[8]) {
  const f32x2_t a = __builtin_amdgcn_cvt_pk_f32_fp8((int)w.x, false), b = __builtin_amdgcn_cvt_pk_f32_fp8((int)w.x, true);
  const f32x2_t c = __builtin_amdgcn_cvt_pk_f32_fp8((int)w.y, false), d = __builtin_amdgcn_cvt_pk_f32_fp8((int)w.y, true);
  f[0] = a[0]; f[1] = a[1]; f[2] = b[0]; f[3] = b[1]; f[4] = c[0]; f[5] = c[1]; f[6] = d[0]; f[7] = d[1];
}

struct Params {
  const float *x, *c, *w_ada, *b_ada, *g_pre_mix, *g_post_mix, *g_pre_ffn, *g_post_ffn, *w_in, *conv_w,
      *a_log, *dt_bias, *g_dn_out, *w_br_a, *w_br_b, *w_o, *w_router, *b_router, *w_gu, *b_gu, *w_down, *b_down;
  float* out;
  float* mod;
  int* cnt;
  int* dep;
  float* ba;
  bf16_t* hbf;
  bf16_t* proj;
  bf16_t* w_in_t;
  unsigned char* wgu8;
  unsigned char* wd8;
  unsigned char* h2q;
  unsigned char* act8;
  bf16_t* wbra_t;
  bf16_t* wbrb_t;
  bf16_t* wo_t;
  bf16_t* qb;
  bf16_t* kb;
  float* kmean;
  bf16_t* oab;
  bf16_t* merged;
  bf16_t* mixer;
  bf16_t* h2;
  int* elist;
  float* aw;
  bf16_t* act;
  bf16_t* xs;
  int* rowmap;
  bf16_t* yslot;
  unsigned char* dnA; float* dnU; float* dnG;
  unsigned char* dnS; unsigned char* dnV;
  bf16_t* dn_out; int dn_out_ld;
  bf16_t* oab2; float* dbg;
  unsigned* bar; int never; int tid;
  bf16_t* Kp; bf16_t* Vp; int* wq;
  bf16_t* mb_out; int mb_out_ld; int mb_out_off;
  float* nq; float* nk; float* nv;
  float* nbeta; float* ng;
  float* no;
  float* ntmp;
};

__device__ __forceinline__ int map_col(int n, int mode) {
  if (mode == 0) return n;
  if (mode == 1) return n < 2048 ? n : (n < 2056 ? -1 : n - 8);
  if (n < 1024) return (n >> 7) * 256 + (n & 127);
  int j = n - 1024;
  return (j >> 7) * 256 + 128 + (j & 127);
}
namespace pg8 {
#define PG8_LAS __attribute__((address_space(3)))
typedef short bf16x8 __attribute__((ext_vector_type(8)));
typedef float f32x4 __attribute__((ext_vector_type(4)));
typedef unsigned u32x4 __attribute__((ext_vector_type(4)));
constexpr int BM = 256, BK = 64, HALF = 128, HTB = HALF * BK * 2, STAGE_BYTES = 8 * HTB, NXCD = 8, WGM = 4;

__host__ __device__ __forceinline__ int lds_byte(int r, int c) { const int st = (r >> 4) * 2 + (c >> 5), rr = r & 15, cc = c & 31, ob = rr * 64 + cc * 2; return st * 1024 + (ob ^ (((ob >> 9) & 1) << 5)); }
__host__ __device__ __forceinline__ void stage_rc(int b, int& R, int& C) { const int st = b / 1024, sb = b % 1024, swz = sb ^ (((sb >> 9) & 1) << 5); R = (st >> 1) * 16 + swz / 64; C = (st & 1) * 32 + (swz % 64) / 2; }
__host__ __device__ __forceinline__ int perm32(int rho) { const int n = rho >> 4, i = rho & 15; return 8 * (i >> 2) + 4 * n + (i & 3); }

struct Unit { int pm, pn, z; int hm = 0, ro = 0; };
__device__ __forceinline__ unsigned cvt_pk_bf16(float lo, float hi) { return ::pk2(lo, hi); }

typedef int i32x8 __attribute__((ext_vector_type(8)));
typedef int i32x4 __attribute__((ext_vector_type(4)));
__device__ __forceinline__ i32x8 cat8(const bf16x8 lo, const bf16x8 hi) { const i32x4 a = __builtin_bit_cast(i32x4, lo), b = __builtin_bit_cast(i32x4, hi); return __builtin_shufflevector(a, b, 0, 1, 2, 3, 4, 5, 6, 7); }
struct TileOrder {
    int nM, nN, nwg, G, c; int wgm = WGM;
    __device__ void init(int nM_, int nN_, int G_, int c_) { nM = nM_; nN = nN_; nwg = nM * nN; G = G_; c = c_; }
    __device__ bool tile(int i, int& pm, int& pn) const {
        const long L = (long)i * G + c; if (L >= nwg) return false;
        int wgid = (int)L; { const int q = nwg / NXCD, r = nwg % NXCD, xcd = wgid % NXCD, off = wgid / NXCD; wgid = (xcd < r ? xcd * (q + 1) : r * (q + 1) + (xcd - r) * q) + off; }
        const int nig = wgm * nN, gid = wgid / nig, fm = gid * wgm, gsz = (nM - fm) < wgm ? (nM - fm) : wgm;
        pm = fm + ((wgid % nig) % gsz); pn = (wgid % nig) / gsz; return true;
    }
};

template <class Epi, class Sched, bool FP8 = false>
__device__ __forceinline__ void gemm_phase(PG8_LAS unsigned char* lds, const int tid, const int lda, const int ldb, const int K, const Sched& S, const Epi& E) {
    const int wid = __builtin_amdgcn_readfirstlane(tid >> 6), lane = tid & 63, wr = wid >> 2, wc = wid & 3, fr = lane & 15, fq = lane >> 4;
    const int nt = K / BK;
    unsigned voffA[2], voffB[2];
#pragma unroll
    for (int i = 0; i < 2; ++i) { int R, C; stage_rc(tid * 16 + i * 8192, R, C); const int Rb = Epi::PERM ? ((R & ~31) + perm32(R & 31)) : R;
        voffA[i] = (unsigned)(R * lda + C) * 2u; voffB[i] = (unsigned)(Rb * ldb + C) * 2u; }
    const size_t kstep = (size_t)(BK * 2);
    const size_t hstepA = (size_t)HALF * lda * 2, hstepB = (size_t)HALF * ldb * 2;
    const unsigned ldsw = (unsigned)wid * 1024u;
    const int aoff = lds_byte(wr * 64 + fr, fq * 8), boff = lds_byte(wc * 32 + fr, fq * 8);
    constexpr int KOFF1 = 1024;
    unsigned gA[2][2] = {{0u, 0u}, {0u, 0u}}, gAn[2][2] = {{0u, 0u}, {0u, 0u}};
#define PG8_GOFFS(dst, unit) do { int t_ = tid; asm volatile("" : "+v"(t_)); _Pragma("unroll") for (int i_ = 0; i_ < 2; ++i_) { int gR_, gC_; stage_rc(t_ * 16 + i_ * 8192, gR_, gC_); \
        _Pragma("unroll") for (int h_ = 0; h_ < 2; ++h_) dst[h_][i_] = S.a_goff(unit, gR_ + 128 * h_, gC_); } } while (0)
#define PG8_SA(b, h) (((b) * 2 + (h)) * HTB)
#define PG8_SB(b, h) ((4 + (b) * 2 + (h)) * HTB)
#define PG8_STAGE(bufoff, gbase, voff) do { _Pragma("unroll") for (int _i = 0; _i < 2; ++_i) \
        __builtin_amdgcn_global_load_lds((const unsigned*)((const char*)(gbase) + (voff)[_i]), (PG8_LAS unsigned*)(lds + (bufoff) + ldsw + _i * 8192), 16, 0, 0); } while (0)
#define PG8_STAGEA(bufoff, ptr, h, nx) do { if constexpr (Sched::GATHER) { const unsigned gs_[2] = {(nx) ? gAn[h][0] : gA[h][0], (nx) ? gAn[h][1] : gA[h][1]}; PG8_STAGE(bufoff, ptr, gs_); } \
        else { PG8_STAGE(bufoff, (ptr) + (h) * ((nx) ? hsn : hsc), voffA); } } while (0)
#define PG8_LDA(dst, b, h) do { if constexpr (FP8) { _Pragma("unroll") for (int m = 0; m < 4; ++m) dst##8[m] = cat8(*(const PG8_LAS bf16x8*)(lds + PG8_SA(b, h) + aoff + m * 2048), *(const PG8_LAS bf16x8*)(lds + PG8_SA(b, h) + aoff + KOFF1 + m * 2048)); } \
        else { _Pragma("unroll") for (int m = 0; m < 4; ++m) _Pragma("unroll") for (int k = 0; k < 2; ++k) dst[m][k] = *(const PG8_LAS bf16x8*)(lds + PG8_SA(b, h) + aoff + k * KOFF1 + m * 2048); } } while (0)
#define PG8_LDB(dst, b, h) do { if constexpr (FP8) { _Pragma("unroll") for (int n = 0; n < 2; ++n) dst##8[n] = cat8(*(const PG8_LAS bf16x8*)(lds + PG8_SB(b, h) + boff + n * 2048), *(const PG8_LAS bf16x8*)(lds + PG8_SB(b, h) + boff + KOFF1 + n * 2048)); } \
        else { _Pragma("unroll") for (int n = 0; n < 2; ++n) _Pragma("unroll") for (int k = 0; k < 2; ++k) dst[n][k] = *(const PG8_LAS bf16x8*)(lds + PG8_SB(b, h) + boff + k * KOFF1 + n * 2048); } } while (0)
#define PG8_MMA(ai, bj, At, Bt) do { __builtin_amdgcn_s_setprio(1); if constexpr (FP8) { _Pragma("unroll") for (int m = 0; m < 4; ++m) _Pragma("unroll") for (int n = 0; n < 2; ++n) \
        asm volatile("v_mfma_f32_16x16x128_f8f6f4 %0, %1, %2, %0" : "+v"(acc[ai][bj][m][n]) : "v"(Bt##8[n]), "v"(At##8[m])); } \
        else { _Pragma("unroll") for (int m = 0; m < 4; ++m) _Pragma("unroll") for (int n = 0; n < 2; ++n) _Pragma("unroll") for (int k = 0; k < 2; ++k) \
        acc[ai][bj][m][n] = __builtin_amdgcn_mfma_f32_16x16x32_bf16(Bt[n][k], At[m][k], acc[ai][bj][m][n], 0, 0, 0); } __builtin_amdgcn_s_setprio(0); } while (0)
#define PG8_WAIT_V(n) asm volatile("s_waitcnt vmcnt(" #n ")" ::: "memory")
#define PG8_WAIT_L(n) asm volatile("s_waitcnt lgkmcnt(" #n ")" ::: "memory")
#define PG8_BAR __builtin_amdgcn_s_barrier()
#define PG8_SCHED __builtin_amdgcn_sched_barrier(0)
    Unit cur, nxt; int ui = 0;
    if (!S.next(0, cur)) return;
    f32x4 acc[2][2][4][2];
#pragma unroll
    for (int a = 0; a < 2; ++a)
#pragma unroll
        for (int b = 0; b < 2; ++b)
#pragma unroll
            for (int m = 0; m < 4; ++m)
#pragma unroll
                for (int n = 0; n < 2; ++n) acc[a][b][m][n] = (f32x4){0.f, 0.f, 0.f, 0.f};
    bf16x8 At[4][2], B0[2][2], B1[2][2];
    i32x8 At8[4], B08[2], B18[2];
    const char* cA = S.a_ptr(cur); const char* cB = S.b_ptr(cur);
    size_t hsc = cur.hm ? 0 : hstepA, hsn = hsc;
    if constexpr (Sched::GATHER) { PG8_GOFFS(gA, cur); }
    PG8_STAGE(PG8_SB(0, 0), cB, voffB); PG8_STAGEA(PG8_SA(0, 0), cA, 0, false); PG8_STAGE(PG8_SB(0, 1), cB + hstepB, voffB); PG8_STAGEA(PG8_SA(0, 1), cA, 1, false);
    if (wr == 1) PG8_BAR;
    PG8_WAIT_V(4); PG8_BAR;
    PG8_STAGE(PG8_SB(1, 0), cB + kstep, voffB); PG8_STAGEA(PG8_SA(1, 0), cA + kstep, 0, false); PG8_STAGE(PG8_SB(1, 1), cB + hstepB + kstep, voffB);
    PG8_WAIT_V(6); PG8_BAR;
    for (;;) {
        const bool has_next = S.next(ui + 1, nxt);
        const char* nA = has_next ? S.a_ptr(nxt) : cA; const char* nB = has_next ? S.b_ptr(nxt) : cB;
        hsn = has_next ? (nxt.hm ? 0 : hstepA) : hsc;
        const bool full = !cur.hm;
        if constexpr (Sched::GATHER) { if (has_next) { PG8_GOFFS(gAn, nxt); } else {
_Pragma("unroll") for (int h = 0; h < 2; ++h) _Pragma("unroll") for (int i = 0; i < 2; ++i) gAn[h][i] = gA[h][i]; } }
_Pragma("unroll 1")
        for (int t = 0; t < nt; t += 2) {
            const bool last = (t == nt - 2);
            const char* a1 = cA + (size_t)(t + 1) * kstep;
            const char* a2 = last ? nA : cA + (size_t)(t + 2) * kstep; const char* b2 = last ? nB : cB + (size_t)(t + 2) * kstep;
            const char* a3 = a2 + kstep; const char* b3 = b2 + kstep;
            PG8_LDB(B0, 0, 0); PG8_SCHED; PG8_LDA(At, 0, 0); PG8_STAGEA(PG8_SA(1, 1), a1, 1, false);
            PG8_WAIT_L(8); PG8_BAR; PG8_WAIT_L(0); PG8_MMA(0, 0, At, B0); PG8_BAR; PG8_SCHED;
            PG8_LDB(B1, 0, 1); PG8_STAGE(PG8_SB(0, 0), b2, voffB);
            PG8_BAR; PG8_WAIT_L(0); PG8_MMA(0, 1, At, B1); PG8_BAR;
            if (full) { PG8_LDA(At, 0, 1); } PG8_STAGEA(PG8_SA(0, 0), a2, 0, last);
            PG8_BAR; PG8_WAIT_L(0); if (full) { PG8_MMA(1, 0, At, B0); } PG8_BAR; PG8_SCHED;
            PG8_STAGE(PG8_SB(0, 1), b2 + hstepB, voffB);
            PG8_WAIT_V(6); PG8_BAR; if (full) { PG8_MMA(1, 1, At, B1); } PG8_BAR;
            PG8_LDB(B0, 1, 0); PG8_SCHED; PG8_LDA(At, 1, 0); PG8_STAGEA(PG8_SA(0, 1), a2, 1, last);
            PG8_WAIT_L(8); PG8_BAR; PG8_WAIT_L(0); PG8_MMA(0, 0, At, B0); PG8_BAR; PG8_SCHED;
            PG8_LDB(B1, 1, 1); PG8_STAGE(PG8_SB(1, 0), b3, voffB);
            PG8_BAR; PG8_WAIT_L(0); PG8_MMA(0, 1, At, B1); PG8_BAR;
            if (full) { PG8_LDA(At, 1, 1); } PG8_STAGEA(PG8_SA(1, 0), a3, 0, last);
            PG8_BAR; PG8_WAIT_L(0); if (full) { PG8_MMA(1, 0, At, B0); } PG8_BAR; PG8_SCHED;
            PG8_STAGE(PG8_SB(1, 1), b3 + hstepB, voffB);
            PG8_WAIT_V(6); PG8_BAR; if (full) { PG8_MMA(1, 1, At, B1); } PG8_BAR;
        }
        { if constexpr (FP8) asm volatile("s_nop 15\n\ts_nop 3" ::: "memory");
          int t_ = tid; asm volatile("" : "+v"(t_));
          E(acc, cur, wr, wc, t_ & 15, (t_ & 63) >> 4);
          if constexpr (Sched::PUBLISH) { asm volatile("s_waitcnt vmcnt(0)" ::: "memory"); PG8_BAR; if (t_ == 256) S.publish(cur); } }
        if (!has_next) break;
#pragma unroll
        for (int a = 0; a < 2; ++a)
#pragma unroll
            for (int b = 0; b < 2; ++b)
#pragma unroll
                for (int m = 0; m < 4; ++m)
#pragma unroll
                    for (int n = 0; n < 2; ++n) acc[a][b][m][n] = (f32x4){0.f, 0.f, 0.f, 0.f};
        cur = nxt; cA = nA; cB = nB; hsc = hsn; ++ui;
        if constexpr (Sched::GATHER) {
_Pragma("unroll") for (int h = 0; h < 2; ++h) _Pragma("unroll") for (int i = 0; i < 2; ++i) gA[h][i] = gAn[h][i]; }
    }
    PG8_WAIT_V(0);
    if (wr == 0) PG8_BAR;
    PG8_BAR;
#undef PG8_SA
#undef PG8_SB
#undef PG8_STAGE
#undef PG8_STAGEA
#undef PG8_GOFFS
#undef PG8_LDA
#undef PG8_LDB
#undef PG8_MMA
#undef PG8_WAIT_V
#undef PG8_WAIT_L
#undef PG8_BAR
#undef PG8_SCHED
}
}
using pg8::f32x4; using pg8::u32x4; using pg8::Unit;

#define GEMM_LDS (pg8::STAGE_BYTES + 1024)

struct SchedProj : pg8::TileOrder {
  static constexpr bool GATHER = false; static constexpr bool PUBLISH = false;
  const char* A; const char* B;
  __device__ bool next(int i, Unit& u) const {
    u.z = 0; u.hm = 0; u.ro = 0;
    const int nfull = (nwg / G) * G, rem = nwg - nfull;
    if (2 * rem != G || (G & 15)) return tile(i, u.pm, u.pn);
    if (i < nwg / G) return tile(i, u.pm, u.pn);
    if (i > nwg / G) return false;
    const int xcd = c & 7, k = c >> 3;
    int wgid = nfull + (k >> 1) * 8 + xcd;
    { const int q = nwg / pg8::NXCD, r = nwg % pg8::NXCD, x = wgid % pg8::NXCD, off = wgid / pg8::NXCD; wgid = (x < r ? x * (q + 1) : r * (q + 1) + (x - r) * q) + off; }
    const int nig = wgm * nN, gid = wgid / nig, fm = gid * wgm, gsz = (nM - fm) < wgm ? (nM - fm) : wgm;
    u.pm = fm + ((wgid % nig) % gsz); u.pn = (wgid % nig) / gsz;
    u.hm = 1; u.ro = (k & 1) * 128;
    return true;
  }
  __device__ const char* a_ptr(const Unit& u) const { return A + ((size_t)u.pm * 256 + u.ro) * DM * 2; }
  __device__ const char* b_ptr(const Unit& u) const { return B + (size_t)u.pn * 256 * DM * 2; }
};
struct EpiProj {
  static constexpr bool PERM = true;
  bf16_t* O;
  __device__ __forceinline__ void operator()(const f32x4 (&acc)[2][2][4][2], const Unit& u, int wr, int wc, int fr, int fq) const {
    const int row0 = u.pm * 256 + u.ro + wr * 64 + fr, col0 = u.pn * 256 + wc * 32 + 8 * fq;
    const bool gate = u.pn >= (C_GA / 256);
#pragma unroll
    for (int ai = 0; ai < 2; ++ai)
#pragma unroll
      for (int m = 0; m < 4; ++m) {
        if (ai == 1 && u.hm) continue;
        bf16_t* rowp = O + (size_t)(row0 + ai * 128 + m * 16) * PW + col0;
#pragma unroll
        for (int bj = 0; bj < 2; ++bj) {
          f32x4 v0 = acc[ai][bj][m][0], v1 = acc[ai][bj][m][1];
          if (gate) {
#pragma unroll
            for (int j = 0; j < 4; ++j) { v0[j] = sigmoidf_(v0[j]); v1[j] = sigmoidf_(v1[j]); }
          }
          u32x4 w; w.x = pg8::cvt_pk_bf16(v0[0], v0[1]); w.y = pg8::cvt_pk_bf16(v0[2], v0[3]); w.z = pg8::cvt_pk_bf16(v1[0], v1[1]); w.w = pg8::cvt_pk_bf16(v1[2], v1[3]);
          *(u32x4*)(rowp + bj * 128) = w;
        }
      }
  }
};
__device__ __forceinline__ void ph_proj(const Params& p, PG8_LAS unsigned char* lds, int nblk, int bid) {
  SchedProj S; S.init(T_TOK / 256, PW / 256, nblk, bid); S.wgm = WGM_PROJ; S.A = (const char*)p.hbf; S.B = (const char*)p.w_in_t;
  EpiProj E{p.proj};
  pg8::gemm_phase(lds, p.tid, DM, DM, DM, S, E);
}

#define BR_CTR 512
#define MIX_CTR 520
struct SchedBr : pg8::TileOrder {
  static constexpr bool GATHER = false; static constexpr bool PUBLISH = true;
  const char* A; const char* Ba; const char* Bb; int* dep;
  __device__ void publish(const Unit& u) const { if (u.z) __hip_atomic_fetch_add(dep + BR_CTR + 16 * u.pm, 1, __ATOMIC_RELAXED, __HIP_MEMORY_SCOPE_AGENT); }
  __device__ bool next(int i, Unit& u) const { u.z = i & 1; return tile(i >> 1, u.pm, u.pn); }
  __device__ const char* a_ptr(const Unit& u) const { return A + (size_t)u.pm * 256 * DM * 2 + u.z * 512 * 2; }
  __device__ const char* b_ptr(const Unit& u) const { return (u.z ? Bb : Ba) + (size_t)u.pn * 256 * 512 * 2; }
};
__device__ __forceinline__ void unpack8(const u32x4 w, float (&f)[8]) {
  f[0] = __uint_as_float(w.x << 16); f[1] = __uint_as_float(w.x & 0xffff0000u); f[2] = __uint_as_float(w.y << 16); f[3] = __uint_as_float(w.y & 0xffff0000u);
  f[4] = __uint_as_float(w.z << 16); f[5] = __uint_as_float(w.z & 0xffff0000u); f[6] = __uint_as_float(w.w << 16); f[7] = __uint_as_float(w.w & 0xffff0000u);
}
struct EpiBr {
  static constexpr bool PERM = true;
  const bf16_t* proj; bf16_t* O;
  __device__ __forceinline__ void operator()(const f32x4 (&acc)[2][2][4][2], const Unit& u, int wr, int wc, int fr, int fq) const {
    const int row0 = u.pm * 256 + wr * 64 + fr, col0 = u.pn * 256 + wc * 32 + 8 * fq;
    const int gcol = (u.z ? C_GB : C_GA) + col0;
    const __amdgpu_buffer_rsrc_t rO = __builtin_amdgcn_make_buffer_rsrc((void*)O, 0, T_TOK * DM * 2, 0x00020000);
#pragma unroll
    for (int ai = 0; ai < 2; ++ai) {
      u32x4 gv[4][2], pv[4][2];
#pragma unroll
      for (int m = 0; m < 4; ++m)
#pragma unroll
        for (int bj = 0; bj < 2; ++bj) {
          const size_t row = (size_t)(row0 + ai * 128 + m * 16);
          gv[m][bj] = *(const u32x4*)(proj + row * PW + gcol + bj * 128);
          pv[m][bj] = (u32x4){0u, 0u, 0u, 0u};
          if (u.z) pv[m][bj] = __builtin_bit_cast(u32x4, __builtin_amdgcn_raw_buffer_load_b128(rO, (unsigned)((row * DM + col0 + bj * 128) * 2), 0, 16));
        }
#pragma unroll
      for (int m = 0; m < 4; ++m)
#pragma unroll
        for (int bj = 0; bj < 2; ++bj) {
          const size_t row = (size_t)(row0 + ai * 128 + m * 16);
          float g[8], pf[8]; unpack8(gv[m][bj], g); unpack8(pv[m][bj], pf);
          const f32x4 v0 = acc[ai][bj][m][0], v1 = acc[ai][bj][m][1];
          float r[8];
#pragma unroll
          for (int j = 0; j < 4; ++j) { r[j] = v0[j] * g[j] + pf[j]; r[4 + j] = v1[j] * g[4 + j] + pf[4 + j]; }
          u32x4 w; w.x = pk2(r[0], r[1]); w.y = pk2(r[2], r[3]); w.z = pk2(r[4], r[5]); w.w = pk2(r[6], r[7]);
          if (u.z) __builtin_amdgcn_raw_buffer_store_b128(w, rO, (unsigned)((row * DM + col0 + bj * 128) * 2), 0, 16);
          else *(u32x4*)(O + row * DM + col0 + bj * 128) = w;
        }
    }
  }
};
__device__ __forceinline__ void ph_br(const Params& p, PG8_LAS unsigned char* lds, int nblk, int bid) {
  SchedBr S; S.init(T_TOK / 256, DM / 256, nblk, bid); S.wgm = WGM_BR; S.A = (const char*)p.oab; S.Ba = (const char*)p.wbra_t; S.Bb = (const char*)p.wbrb_t; S.dep = p.dep;
  EpiBr E{p.proj, p.merged};
  pg8::gemm_phase(lds, p.tid, DM, 512, 512, S, E);
}

struct SchedMix : pg8::TileOrder {
  static constexpr bool GATHER = false; static constexpr bool PUBLISH = true;
  const char* A; const char* B; int* dep;
  __device__ void publish(const Unit& u) const { __hip_atomic_fetch_add(dep + MIX_CTR + 16 * u.pm, 1, __ATOMIC_RELAXED, __HIP_MEMORY_SCOPE_AGENT); }
  __device__ bool next(int i, Unit& u) const { u.z = 0; if (!tile(i, u.pm, u.pn)) return false;
    while (__builtin_amdgcn_readfirstlane(__hip_atomic_load(dep + BR_CTR + 16 * u.pm, __ATOMIC_RELAXED, __HIP_MEMORY_SCOPE_AGENT)) < 4) __builtin_amdgcn_s_sleep(4);
    asm volatile("" ::: "memory");
    return true; }
  __device__ const char* a_ptr(const Unit& u) const { return A + (size_t)u.pm * 256 * DM * 2; }
  __device__ const char* b_ptr(const Unit& u) const { return B + (size_t)u.pn * 256 * DM * 2; }
};
struct EpiMix {
  static constexpr bool PERM = true;
  bf16_t* O;
  __device__ __forceinline__ void operator()(const f32x4 (&acc)[2][2][4][2], const Unit& u, int wr, int wc, int fr, int fq) const {
    const int row0 = u.pm * 256 + wr * 64 + fr, col0 = u.pn * 256 + wc * 32 + 8 * fq;
    const __amdgpu_buffer_rsrc_t rO = __builtin_amdgcn_make_buffer_rsrc((void*)O, 0, T_TOK * DM * 2, 0x00020000);
#pragma unroll
    for (int ai = 0; ai < 2; ++ai)
#pragma unroll
      for (int m = 0; m < 4; ++m) {
        const unsigned rowo = (unsigned)(((row0 + ai * 128 + m * 16) * DM + col0) * 2);
#pragma unroll
        for (int bj = 0; bj < 2; ++bj) {
          const f32x4 v0 = acc[ai][bj][m][0], v1 = acc[ai][bj][m][1];
          u32x4 w; w.x = pg8::cvt_pk_bf16(v0[0], v0[1]); w.y = pg8::cvt_pk_bf16(v0[2], v0[3]); w.z = pg8::cvt_pk_bf16(v1[0], v1[1]); w.w = pg8::cvt_pk_bf16(v1[2], v1[3]);
          __builtin_amdgcn_raw_buffer_store_b128(w, rO, rowo + bj * 256, 0, 16);
        }
      }
  }
};
__device__ __forceinline__ void ph_mix(const Params& p, PG8_LAS unsigned char* lds, int nblk, int bid) {
  SchedMix S; S.init(T_TOK / 256, DM / 256, nblk, (bid + 8) % nblk); S.wgm = WGM_MIX; S.A = (const char*)p.merged; S.B = (const char*)p.wo_t; S.dep = p.dep;
  EpiMix E{p.mixer};
  pg8::gemm_phase(lds, p.tid, DM, DM, DM, S, E);
}

template <bool GATH>
struct SchedMoe {
  static constexpr bool GATHER = GATH;
  static constexpr bool PUBLISH = GATH;
  const PG8_LAS int* tb; int NT; int G, c; int nwg;
  const char* A; const char* B; size_t bexp;
  const int* elist; int rowb;
  int* dep; int i0, Loff, rot;
  __device__ void publish(const Unit& u) const { __hip_atomic_fetch_add(dep + u.pm, 1, __ATOMIC_RELAXED, __HIP_MEMORY_SCOPE_AGENT); }
  __device__ bool next(int i, Unit& u) const {
    const long L = (long)(i + i0) * G + c - Loff; if (L >= nwg) return false;
    int wgid = (int)L; { const int q = nwg / 8, r = nwg % 8, xcd = wgid % 8; int off = wgid / 8;
      if constexpr (!GATH) { const int sz = xcd < r ? q + 1 : q; off += rot; if (off >= sz) off -= sz; }
      wgid = (xcd < r ? xcd * (q + 1) : r * (q + 1) + (xcd - r) * q) + off; }
    int e = 0;
#pragma unroll
    for (int st = 16; st >= 1; st >>= 1) if (wgid >= tb[e + st]) e += st;
    const int q = wgid - tb[e]; const int tiles = tb[33 + e + 1] - tb[33 + e];
    {
      const int gfull = WGM_MOE * NT, grp = q / gfull, rem_ = q - grp * gfull, fm = grp * WGM_MOE, gs = (tiles - fm) < WGM_MOE ? (tiles - fm) : WGM_MOE;
      u.pm = tb[33 + e] + fm + rem_ % gs; u.pn = rem_ / gs; }
    u.z = e;
    u.hm = (tb[66 + e] - (u.pm - tb[33 + e]) * 256) <= 128; u.ro = 0;
    if constexpr (!GATH) {
      while (__builtin_amdgcn_readfirstlane(__hip_atomic_load(dep + u.pm, __ATOMIC_RELAXED, __HIP_MEMORY_SCOPE_AGENT)) < 8) __builtin_amdgcn_s_sleep(4);
      asm volatile("" ::: "memory");
    }
    return true;
  }
  __device__ const char* a_ptr(const Unit& u) const { return GATH ? A : A + (size_t)u.pm * 256 * rowb; }
  __device__ const char* b_ptr(const Unit& u) const { return B + (size_t)u.z * bexp + (size_t)u.pn * 256 * rowb; }
  __device__ unsigned a_goff(const Unit& u, int tr, int C) const {
    const int i = (u.pm - tb[33 + u.z]) * 256 + tr;
    int tok = 0;
    if (i < tb[66 + u.z]) tok = elist[u.z * T_TOK + i] >> 2;
    return (unsigned)(tok * rowb + C * 2);
  }
};
__device__ __forceinline__ void moe_table(const Params& p, PG8_LAS int* tb, int NT) {
  if (p.tid == 0) {
    int ub = 0, tbp = 0;
    for (int e = 0; e < NE; ++e) { const int c = p.cnt[e * 64]; tb[e] = ub; tb[33 + e] = tbp; tb[66 + e] = c; const int t = (c + 255) >> 8; ub += t * NT; tbp += t; }
    tb[NE] = ub; tb[33 + NE] = tbp;
  }
  __syncthreads();
}
struct EpiMoe1 {
  static constexpr bool PERM = true;
  const float* b_gu; unsigned char* act;
  __device__ __forceinline__ void operator()(f32x4 (&acc)[2][2][4][2], const Unit& u, int wr, int wc, int fr, int fq) const {
    const int row0 = u.pm * 256 + wr * 64 + fr, jc = u.pn * 128 + wc * 32 + 8 * fq;
    const float* bg = b_gu + (size_t)u.z * 2048 + jc;
#pragma unroll
    for (int bj = 0; bj < 2; ++bj)
#pragma unroll
      for (int n = 0; n < 2; ++n) {
        const f32x4 bv = *(const f32x4*)(bg + bj * 1024 + n * 4);
#pragma unroll
        for (int ai = 0; ai < 2; ++ai)
#pragma unroll
          for (int m = 0; m < 4; ++m) acc[ai][bj][m][n] = acc[ai][bj][m][n] * 0.015625f + bv;
      }
#pragma unroll
    for (int ai = 0; ai < 2; ++ai)
#pragma unroll
      for (int m = 0; m < 4; ++m) {
        if (ai == 1 && u.hm) continue;
        unsigned char* rowp = act + (size_t)(row0 + ai * 128 + m * 16) * DM + jc;
        float r[8];
#pragma unroll
        for (int n = 0; n < 2; ++n)
#pragma unroll
          for (int j = 0; j < 4; ++j) {
            float g = acc[ai][0][m][n][j], up = acc[ai][1][m][n][j];
            g = fminf(g, 7.f); up = fminf(fmaxf(up, -7.f), 7.f);
            r[n * 4 + j] = (up + 1.f) * g * sigmoidf_(1.702f * g);
          }
        u32x2 w; w.x = pk4_fp8(r[0], r[1], r[2], r[3]); w.y = pk4_fp8(r[4], r[5], r[6], r[7]);
        __hip_atomic_store((unsigned long long*)rowp, (unsigned long long)w.x | ((unsigned long long)w.y << 32), __ATOMIC_RELAXED, __HIP_MEMORY_SCOPE_AGENT);
      }
  }
};
__device__ __forceinline__ void ph_moe1(const Params& p, PG8_LAS unsigned char* lds, int nblk, int bid) {
  PG8_LAS int* tb = (PG8_LAS int*)(lds + pg8::STAGE_BYTES);
  moe_table(p, tb, 8);
  SchedMoe<true> S; S.tb = tb; S.NT = 8; S.G = nblk; S.c = bid; S.nwg = tb[NE]; S.A = (const char*)p.h2q; S.B = (const char*)p.wgu8; S.bexp = (size_t)2048 * DM; S.elist = p.elist; S.rowb = DM;
  S.dep = p.dep; S.i0 = 0; S.Loff = 0; S.rot = 0;
  EpiMoe1 E{p.b_gu, p.act8};
  pg8::gemm_phase<EpiMoe1, SchedMoe<true>, true>(lds, p.tid, DM / 2, DM / 2, DM / 2, S, E);
}
struct EpiMoe2 {
  static constexpr bool PERM = true;
  const float* b_down; const int* elist; const PG8_LAS int* tb; bf16_t* yslot;
  __device__ __forceinline__ void operator()(f32x4 (&acc)[2][2][4][2], const Unit& u, int wr, int wc, int fr, int fq) const {
    const int row0 = u.pm * 256 + wr * 64 + fr, col0 = u.pn * 256 + wc * 32 + 8 * fq;
    const float* bd = b_down + (size_t)u.z * 1024 + col0;
#pragma unroll
    for (int bj = 0; bj < 2; ++bj)
#pragma unroll
      for (int n = 0; n < 2; ++n) {
        const f32x4 bv = *(const f32x4*)(bd + bj * 128 + n * 4);
#pragma unroll
        for (int ai = 0; ai < 2; ++ai)
#pragma unroll
          for (int m = 0; m < 4; ++m) acc[ai][bj][m][n] = acc[ai][bj][m][n] * 0.015625f + bv;
      }
    const int li0 = (u.pm - tb[33 + u.z]) * 256 + wr * 64 + fr, cnt = tb[66 + u.z];
    int av[2][4];
#pragma unroll
    for (int ai = 0; ai < 2; ++ai)
#pragma unroll
      for (int m = 0; m < 4; ++m) { const int li = li0 + ai * 128 + m * 16; av[ai][m] = elist[u.z * T_TOK + (li < cnt ? li : 0)]; if (li >= cnt) av[ai][m] = -1; }
#pragma unroll
    for (int ai = 0; ai < 2; ++ai)
#pragma unroll
      for (int m = 0; m < 4; ++m) {
        const int a = av[ai][m];
        if (a >= 0) {
          unsigned char* rowp = (unsigned char*)yslot + (size_t)a * DM + col0;
#pragma unroll
          for (int bj = 0; bj < 2; ++bj) {
            const f32x4 v0 = acc[ai][bj][m][0], v1 = acc[ai][bj][m][1];
            u32x2 w; w.x = pk4_fp8(v0[0] * 8.f, v0[1] * 8.f, v0[2] * 8.f, v0[3] * 8.f); w.y = pk4_fp8(v1[0] * 8.f, v1[1] * 8.f, v1[2] * 8.f, v1[3] * 8.f);
            *(u32x2*)(rowp + bj * 128) = w;
          }
        }
      }
  }
};
__device__ __forceinline__ void ph_moe2(const Params& p, PG8_LAS unsigned char* lds, int nblk, int bid) {
  PG8_LAS int* tb = (PG8_LAS int*)(lds + pg8::STAGE_BYTES);
  moe_table(p, tb, 4);
  SchedMoe<false> S; S.tb = tb; S.NT = 4; S.G = nblk; S.c = bid; S.nwg = tb[NE]; S.A = (const char*)p.act8; S.B = (const char*)p.wd8; S.bexp = (size_t)1024 * DM; S.elist = p.elist; S.rowb = DM;
  { const int nwg1 = 2 * S.nwg; S.dep = p.dep; S.i0 = (nwg1 - bid + nblk - 1) / nblk; S.Loff = nwg1; S.rot = S.nwg >> 5; }
  EpiMoe2 E{p.b_down, p.elist, tb, p.yslot};
  pg8::gemm_phase<EpiMoe2, SchedMoe<false>, true>(lds, p.tid, DM / 2, DM / 2, DM / 2, S, E);
}

typedef short bf16x8 __attribute__((ext_vector_type(8)));
#define LAS __attribute__((address_space(3)))
#define MFMA16(a, b, c) __builtin_amdgcn_mfma_f32_16x16x32_bf16((a), (b), (c), 0, 0, 0)
__device__ __forceinline__ bf16x8 pack8(float a0, float a1, float a2, float a3, float a4, float a5, float a6, float a7) {
  u32x4 w; w.x = pk2(a0, a1); w.y = pk2(a2, a3); w.z = pk2(a4, a5); w.w = pk2(a6, a7);
  return __builtin_bit_cast(bf16x8, w);
}
__device__ __forceinline__ bf16_t f2bf_hw(float a) { return (bf16_t)(pk2(a, 0.f) & 0xffffu); }

#define DN_ABYTES 57344
#define DN_UFLOATS 8192
#define F_WN 0
#define F_QD 16
#define F_QK 32
#define F_KT 40

#define DP_KH 0
#define DP_QT 17408
#define DP_KHT 34816
#define DP_VT 53248
#define DP_TU 71680
#define DP_TW 80896
#define DP_LF 90112
#define DP_GC 107520
#define DP_BETA 107776
#define DP_CW 108032
#define DP_LB 114176
#define DP_TR 123392
#define DP_TT 132608
#define DP_MT 141824
#define DP_TOTAL 144128

template <int KS>
__device__ __forceinline__ f32x4 prod16(const LAS bf16_t* A, int lda, int arow0, const LAS bf16_t* Bt, int ldb, int brow0, f32x4 acc, int lane) {
  const int r = lane & 15, q = lane >> 4;
#pragma unroll
  for (int ks = 0; ks < KS; ++ks) {
    const bf16x8 a = *(const LAS bf16x8*)(A + (arow0 + r) * lda + 32 * ks + 8 * q);
    const bf16x8 b = *(const LAS bf16x8*)(Bt + (brow0 + r) * ldb + 32 * ks + 8 * q);
    acc = MFMA16(a, b, acc);
  }
  return acc;
}
__device__ __forceinline__ void tile_store_rm(LAS bf16_t* X, int ld, int row0, int col0, const f32x4 v, int lane) {
  const int r = lane & 15, q = lane >> 4;
#pragma unroll
  for (int i = 0; i < 4; ++i) X[(row0 + 4 * q + i) * ld + col0 + r] = f2bf_hw(v[i]);
}
__device__ __forceinline__ void tile_store_tr(LAS bf16_t* Xt, int ld, int row0, int col0, const f32x4 v, int lane) {
  const int r = lane & 15, q = lane >> 4;
  u32x2 w; w.x = pk2(v[0], v[1]); w.y = pk2(v[2], v[3]);
  *(LAS u32x2*)(Xt + (col0 + r) * ld + row0 + 4 * q) = w;
}

__device__ __forceinline__ void dn_prep_chunk(const Params& p, LAS unsigned char* lds, int ci, bool load_cw, int cnext) {
  const int tid = p.tid, lane = tid & 63, w = tid >> 6, r16 = lane & 15, q4 = lane >> 4;
  const int bh = ci >> 6, n = ci & 63, b = bh >> 2, h = bh & 3;
  LAS bf16_t* Kh = (LAS bf16_t*)(lds + DP_KH); LAS bf16_t* Qt = (LAS bf16_t*)(lds + DP_QT);
  LAS bf16_t* KhT = (LAS bf16_t*)(lds + DP_KHT); LAS bf16_t* VT = (LAS bf16_t*)(lds + DP_VT);
  LAS bf16_t* Tu = (LAS bf16_t*)(lds + DP_TU); LAS bf16_t* Tw = (LAS bf16_t*)(lds + DP_TW); LAS float* Lf = (LAS float*)(lds + DP_LF);
  LAS bf16_t* Lb = (LAS bf16_t*)(lds + DP_LB); LAS bf16_t* Tr = (LAS bf16_t*)(lds + DP_TR); LAS bf16_t* Tt = (LAS bf16_t*)(lds + DP_TT); LAS bf16_t* Mt = (LAS bf16_t*)(lds + DP_MT);
  LAS float* gcb = (LAS float*)(lds + DP_GC); LAS float* betab = (LAS float*)(lds + DP_BETA); LAS float* cw = (LAS float*)(lds + DP_CW);
  unsigned char* gA = (unsigned char*)p.dnA + (size_t)ci * DN_ABYTES;
  float* gU = p.dnU + (size_t)ci * DN_UFLOATS;

  if (load_cw) {
    for (int i = tid; i < 4 * 384; i += 512) { const int tap = i / 384, cc = i % 384, part = cc >> 7, d = cc & 127; cw[i] = p.conv_w[tap * 1536 + part * 512 + h * 128 + d]; }
  }
  __syncthreads();
  const int c = tid >> 3, g = tid & 7;
  const int s = n * 64 + c;
  const size_t t = (size_t)b * SEQ + s;
  float qv[16], kv[16], vv[16];
#pragma unroll
  for (int j = 0; j < 16; ++j) { qv[j] = 0.f; kv[j] = 0.f; vv[j] = 0.f; }
#pragma unroll
  for (int tap = 0; tap < 4; ++tap) {
    const int ss = s - 3 + tap;
    if (ss >= 0) {
      const bf16_t* row = p.proj + (t - 3 + tap) * PW + h * 128 + 16 * g;
      float x[8];
#pragma unroll
      for (int part = 0; part < 3; ++part) {
#pragma unroll
        for (int hh = 0; hh < 2; ++hh) {
          unpack8(*(const u32x4*)(row + part * 512 + 8 * hh), x);
#pragma unroll
          for (int j = 0; j < 8; ++j) {
            const float wv = cw[tap * 384 + part * 128 + 16 * g + 8 * hh + j];
            if (part == 0) qv[8 * hh + j] += wv * x[j];
            if (part == 1) kv[8 * hh + j] += wv * x[j];
            if (part == 2) vv[8 * hh + j] += wv * x[j];
          }
        }
      }
    }
    asm volatile("" ::: "memory");
  }
  float touch = 0.f;
  if (cnext < 1024 && tid < 402) {
    const int bhn = cnext >> 6, r = tid / 6, pc = tid - 6 * r, rown = (cnext & 63) * 64 - 3 + r;
    if (rown >= 0) touch = *(const float*)(p.proj + ((size_t)(bhn >> 2) * SEQ + rown) * PW + (pc >> 1) * 512 + (bhn & 3) * 128 + (pc & 1) * 64);
  }
  float sq = 0.f, sk = 0.f;
#pragma unroll
  for (int j = 0; j < 16; ++j) { qv[j] = siluf_(qv[j]); kv[j] = siluf_(kv[j]); vv[j] = siluf_(vv[j]); sq += qv[j] * qv[j]; sk += kv[j] * kv[j]; }
  sq += __shfl_xor(sq, 1, 64); sq += __shfl_xor(sq, 2, 64); sq += __shfl_xor(sq, 4, 64);
  sk += __shfl_xor(sk, 1, 64); sk += __shfl_xor(sk, 2, 64); sk += __shfl_xor(sk, 4, 64);
  const float rq = rsqrtf(sq + 1e-6f) * 0.08838834764831845f, rk = rsqrtf(sk + 1e-6f);
#pragma unroll
  for (int j = 0; j < 16; ++j) { qv[j] *= rq; kv[j] *= rk; }
  if (g == 0) {
    const float bb = p.ba[t * 8 + h], aa = p.ba[t * 8 + 4 + h];
    const float xx = aa + p.dt_bias[h];
    const float sp = xx > 20.f ? xx : log1pf(__expf(xx));
    betab[c] = sigmoidf_(bb);
    gcb[c] = -__expf(p.a_log[h]) * sp;
  }
  {
    u32x4 w0, w1;
    w0.x = pk2(kv[0], kv[1]); w0.y = pk2(kv[2], kv[3]); w0.z = pk2(kv[4], kv[5]); w0.w = pk2(kv[6], kv[7]);
    w1.x = pk2(kv[8], kv[9]); w1.y = pk2(kv[10], kv[11]); w1.z = pk2(kv[12], kv[13]); w1.w = pk2(kv[14], kv[15]);
    *(LAS u32x4*)(Kh + c * 136 + 16 * g) = w0; *(LAS u32x4*)(Kh + c * 136 + 16 * g + 8) = w1;
    w0.x = pk2(qv[0], qv[1]); w0.y = pk2(qv[2], qv[3]); w0.z = pk2(qv[4], qv[5]); w0.w = pk2(qv[6], qv[7]);
    w1.x = pk2(qv[8], qv[9]); w1.y = pk2(qv[10], qv[11]); w1.z = pk2(qv[12], qv[13]); w1.w = pk2(qv[14], qv[15]);
    *(LAS u32x4*)(Qt + c * 136 + 16 * g) = w0; *(LAS u32x4*)(Qt + c * 136 + 16 * g + 8) = w1;
#pragma unroll
    for (int j = 0; j < 16; ++j) { KhT[(16 * g + j) * 72 + c] = f2bf_hw(kv[j]); VT[(16 * g + j) * 72 + c] = f2bf_hw(vv[j]); }
  }
  __syncthreads();
  if (w == 0) {
    float v = gcb[lane];
#pragma unroll
    for (int o = 1; o < 64; o <<= 1) { const float u = __shfl_up(v, o, 64); if (lane >= o) v += u; }
    gcb[lane] = v;
  }
  __syncthreads();
  const float gc_c = gcb[c], gl = gcb[63];
  {
    const float eg = __expf(gc_c);
    unsigned char* fb = gA + (size_t)(F_QD + (c >> 4) * 4 + (g >> 1)) * 1024 + (g & 1) * 8;
#pragma unroll
    for (int qq = 0; qq < 4; ++qq) {
      u32x2 wv; wv.x = pk2(qv[4 * qq] * eg, qv[4 * qq + 1] * eg); wv.y = pk2(qv[4 * qq + 2] * eg, qv[4 * qq + 3] * eg);
      *(u32x2*)(fb + ((c & 15) + 16 * qq) * 16) = wv;
    }
  }
  const int rt = w >> 1, ct0 = 2 * (w & 1);
#pragma unroll
  for (int tt = 0; tt < 2; ++tt) {
    const int ct = ct0 + tt;
    f32x4 gacc = {0.f, 0.f, 0.f, 0.f};
    gacc = prod16<4>(Kh, 136, 16 * rt, Kh, 136, 16 * ct, gacc, lane);
    const int m = 16 * ct + r16; const float gc_m = gcb[m];
    f32x4 lv;
#pragma unroll
    for (int i = 0; i < 4; ++i) {
      const int cc = 16 * rt + 4 * q4 + i;
      lv[i] = (m < cc) ? betab[cc] * gacc[i] * __expf(gcb[cc] - gc_m) : 0.f;
      Lf[cc * 68 + m] = lv[i];
    }
    tile_store_rm(Lb, 72, 16 * rt, 16 * ct, lv, lane);
    f32x4 qacc = {0.f, 0.f, 0.f, 0.f};
    qacc = prod16<4>(Kh, 136, 16 * rt, Qt, 136, 16 * ct, qacc, lane);
    const int cq = 16 * ct + r16; const float gc_cq = gcb[cq];
    float o4[4];
#pragma unroll
    for (int i = 0; i < 4; ++i) { const int mm = 16 * rt + 4 * q4 + i; o4[i] = (mm <= cq) ? qacc[i] * __expf(gc_cq - gcb[mm]) : 0.f; }
    u32x2 wv; wv.x = pk2(o4[0], o4[1]); wv.y = pk2(o4[2], o4[3]);
    *(u32x2*)(gA + (size_t)(F_QK + ct * 2 + (rt >> 1)) * 1024 + (r16 + 16 * q4) * 16 + (rt & 1) * 8) = wv;
  }
  __syncthreads();
  for (int i = tid; i < 2 * 64 * 72 / 8; i += 512) ((LAS u32x4*)Tr)[i] = (u32x4){0u, 0u, 0u, 0u};
  __syncthreads();
  if (w == 0) {
    int lo = lane; asm volatile("" : "+v"(lo));
    const int g = lo >> 4, j = lo & 15;
    unsigned lfb = DP_LF + (16 * g * 68 + 16 * g) * 4; asm volatile("" : "+v"(lfb));
    const LAS float* Lg = (const LAS float*)(lds + lfb);
    float t[16];
#pragma unroll
    for (int r = 0; r < 16; ++r) {
      float a0 = (r == j) ? 1.f : 0.f, a1 = 0.f;
#pragma unroll
      for (int k4 = 0; k4 < (r + 3) / 4; ++k4) {
        const f32x4 l = *(const LAS f32x4*)(Lg + r * 68 + 4 * k4);
        if (4 * k4 + 0 < r) a0 -= l[0] * t[4 * k4 + 0];
        if (4 * k4 + 1 < r) a1 -= l[1] * t[4 * k4 + 1];
        if (4 * k4 + 2 < r) a0 -= l[2] * t[4 * k4 + 2];
        if (4 * k4 + 3 < r) a1 -= l[3] * t[4 * k4 + 3];
      }
      t[r] = a0 + a1;
      Tr[(16 * g + r) * 72 + 16 * g + j] = f2bf_hw(t[r]);
    }
    u32x4 w0, w1;
    w0.x = pk2(t[0], t[1]); w0.y = pk2(t[2], t[3]); w0.z = pk2(t[4], t[5]); w0.w = pk2(t[6], t[7]);
    w1.x = pk2(t[8], t[9]); w1.y = pk2(t[10], t[11]); w1.z = pk2(t[12], t[13]); w1.w = pk2(t[14], t[15]);
    *(LAS u32x4*)(Tt + (16 * g + j) * 72 + 16 * g) = w0; *(LAS u32x4*)(Tt + (16 * g + j) * 72 + 16 * g + 8) = w1;
  }
  __syncthreads();
#pragma unroll 1
  for (int d = 1; d <= 3; ++d) {
    const bool act = w < 4 - d;
    const int I = w + d, J = w;
    LAS bf16_t* Mw = Mt + w * 16 * 24;
    if (act) {
      f32x4 macc = {0.f, 0.f, 0.f, 0.f};
      macc = prod16<2>(Lb, 72, 16 * I, Tt, 72, 16 * J, macc, lane);
      tile_store_tr(Mw, 24, 0, 0, macc, lane);
    }
    __syncthreads();
    if (act) {
      bf16x8 a = {0, 0, 0, 0, 0, 0, 0, 0}, bb = {0, 0, 0, 0, 0, 0, 0, 0};
      if (q4 < 2) { a = *(const LAS bf16x8*)(Tr + (16 * I + r16) * 72 + 16 * I + 8 * q4); bb = *(const LAS bf16x8*)(Mw + r16 * 24 + 8 * q4); }
      f32x4 tacc = {0.f, 0.f, 0.f, 0.f};
      tacc = MFMA16(a, bb, tacc);
#pragma unroll
      for (int i = 0; i < 4; ++i) tacc[i] = -tacc[i];
      tile_store_rm(Tr, 72, 16 * I, 16 * J, tacc, lane);
      tile_store_tr(Tt, 72, 16 * I, 16 * J, tacc, lane);
    }
    __syncthreads();
  }
  {
    const int cc = tid >> 3, m0 = (tid & 7) * 8;
    float tv[8]; unpack8(*(const LAS u32x4*)(Tr + cc * 72 + m0), tv);
    float tu[8], tw[8];
#pragma unroll
    for (int jj = 0; jj < 8; ++jj) { const float bm = betab[m0 + jj]; tu[jj] = tv[jj] * bm; tw[jj] = tu[jj] * __expf(gcb[m0 + jj]); }
    u32x4 wu, ww;
    wu.x = pk2(tu[0], tu[1]); wu.y = pk2(tu[2], tu[3]); wu.z = pk2(tu[4], tu[5]); wu.w = pk2(tu[6], tu[7]);
    ww.x = pk2(tw[0], tw[1]); ww.y = pk2(tw[2], tw[3]); ww.z = pk2(tw[4], tw[5]); ww.w = pk2(tw[6], tw[7]);
    *(LAS u32x4*)(Tu + cc * 72 + m0) = wu; *(LAS u32x4*)(Tw + cc * 72 + m0) = ww;
  }
  __syncthreads();
#pragma unroll
  for (int rr = 0; rr < 4; ++rr) {
    f32x4 u = {0.f, 0.f, 0.f, 0.f};
    u = prod16<2>(Tu, 72, 16 * rr, VT, 72, 16 * w, u, lane);
    *(f32x4*)(gU + ((w * 4 + rr) * 64 + lane) * 4) = u;
    f32x4 wt = {0.f, 0.f, 0.f, 0.f};
    wt = prod16<2>(KhT, 72, 16 * w, Tw, 72, 16 * rr, wt, lane);
    u32x2 wv; wv.x = pk2(-wt[0], -wt[1]); wv.y = pk2(-wt[2], -wt[3]);
    *(u32x2*)(gA + (size_t)(F_WN + rr * 4 + (w >> 1)) * 1024 + (r16 + 16 * q4) * 16 + (w & 1) * 8) = wv;
  }
#pragma unroll
  for (int it = 0; it < 4; ++it) {
    const int idx = tid + it * 512; const int d = idx >> 4, m4 = idx & 15;
    const u32x2 raw = *(const LAS u32x2*)(KhT + d * 72 + 4 * m4);
    const float k0 = __uint_as_float(raw.x << 16), k1 = __uint_as_float(raw.x & 0xffff0000u), k2 = __uint_as_float(raw.y << 16), k3 = __uint_as_float(raw.y & 0xffff0000u);
    const float e0 = __expf(gl - gcb[4 * m4]), e1 = __expf(gl - gcb[4 * m4 + 1]), e2 = __expf(gl - gcb[4 * m4 + 2]), e3 = __expf(gl - gcb[4 * m4 + 3]);
    u32x2 wv; wv.x = pk2(k0 * e0, k1 * e1); wv.y = pk2(k2 * e2, k3 * e3);
    *(u32x2*)(gA + (size_t)(F_KT + (d >> 4) * 2 + (m4 >> 3)) * 1024 + ((d & 15) + 16 * (m4 & 3)) * 16 + ((m4 >> 2) & 1) * 8) = wv;
  }
  if (tid == 0) p.dnG[ci] = __expf(gl);
  asm volatile("" :: "v"(touch));
}

#define DS_SLOT 32768
#define DS_TOTAL (4 * DS_SLOT)
#define DN_SFRAG (4 * 1024)
#define DN_VFRAG (2 * 1024)
#define ST16_WT(rsrc, off, v) __builtin_amdgcn_raw_buffer_store_b128(__builtin_bit_cast(u32x4, (v)), (rsrc), (unsigned)(off), 0, 16)
__device__ __forceinline__ void dn_scan_blk(const Params& p, LAS unsigned char* lds, int item) {
  const int tid = p.tid, lane = tid & 63, w = __builtin_amdgcn_readfirstlane(tid >> 6);
  const int bh = item >> 1, eh = item & 1;
  const int et = eh * 4 + (w & 3);
  const bool comp = w < 4;
  const unsigned char* gA = (const unsigned char*)p.dnA + (size_t)bh * 64 * DN_ABYTES;
  const float* gU = p.dnU + (size_t)bh * 64 * DN_UFLOATS;
  const float* gG = p.dnG + bh * 64;
  const __amdgpu_buffer_rsrc_t rS = __builtin_amdgcn_make_buffer_rsrc((void*)p.dnS, 0, 1024 * 8 * DN_SFRAG, 0x00020000);
  const __amdgpu_buffer_rsrc_t rV = __builtin_amdgcn_make_buffer_rsrc((void*)p.dnV, 0, 1024 * 8 * DN_VFRAG, 0x00020000);
  const unsigned oS = (unsigned)((bh * 64 * 8 + et) * DN_SFRAG + lane * 16), oV = (unsigned)((bh * 64 * 8 + et) * DN_VFRAG + lane * 16);
  auto issue_A = [&](int n) {
#pragma unroll
    for (int i = 0; i < 8; ++i) {
      const int f = (w & 3) * 8 + i, sf = f < 16 ? F_WN + f : F_KT + (f - 16);
      __builtin_amdgcn_global_load_lds((const unsigned*)(gA + (size_t)n * DN_ABYTES + sf * 1024 + lane * 16), (LAS unsigned*)(lds + (n & 3) * DS_SLOT + f * 1024), 16, 0, 0);
    }
  };
  __syncthreads();
  f32x4 Un[4]; f32x4 S[8]; float gnext = 0.f;
  if (comp) {
#pragma unroll
    for (int rr = 0; rr < 4; ++rr) Un[rr] = *(const f32x4*)(gU + ((et * 4 + rr) * 64 + lane) * 4);
    gnext = gG[0];
  } else {
    issue_A(0); issue_A(1); issue_A(2);
    asm volatile("s_waitcnt vmcnt(16)" ::: "memory");
  }
#pragma unroll
  for (int dt = 0; dt < 8; ++dt) S[dt] = (f32x4){0.f, 0.f, 0.f, 0.f};
  asm volatile("s_waitcnt lgkmcnt(0)" ::: "memory");
  __builtin_amdgcn_s_barrier();
  asm volatile("" ::: "memory");
#pragma unroll 1
  for (int n = 0; n < 64; ++n) {
    const LAS unsigned char* Ab = lds + (n & 3) * DS_SLOT;
    if (!comp) {
      if (n + 3 < 64) { issue_A(n + 3); asm volatile("s_waitcnt vmcnt(16)" ::: "memory"); }
      else if (n + 2 < 64) asm volatile("s_waitcnt vmcnt(8)" ::: "memory");
      else asm volatile("s_waitcnt vmcnt(0)" ::: "memory");
    } else {
      f32x4 Vn[4];
#pragma unroll
      for (int rr = 0; rr < 4; ++rr) Vn[rr] = Un[rr];
      const float gdec = gnext;
      if (n + 1 < 64) {
#pragma unroll
        for (int rr = 0; rr < 4; ++rr) Un[rr] = *(const f32x4*)(gU + (size_t)(n + 1) * DN_UFLOATS + ((et * 4 + rr) * 64 + lane) * 4);
        gnext = gG[n + 1];
      }
      bf16x8 Sb[4];
#pragma unroll
      for (int ks = 0; ks < 4; ++ks) Sb[ks] = pack8(S[2 * ks][0], S[2 * ks][1], S[2 * ks][2], S[2 * ks][3], S[2 * ks + 1][0], S[2 * ks + 1][1], S[2 * ks + 1][2], S[2 * ks + 1][3]);
#pragma unroll
      for (int ks = 0; ks < 4; ++ks) ST16_WT(rS, oS + n * 8 * DN_SFRAG + ks * 1024, Sb[ks]);
#pragma unroll
      for (int dt = 0; dt < 8; ++dt) S[dt] *= gdec;
#define LDF(idx) (*(const LAS bf16x8*)(Ab + (idx) * 1024 + lane * 16))
#define SBAR __builtin_amdgcn_sched_barrier(0)
      bf16x8 fa[8], fb[8];
#pragma unroll
      for (int i = 0; i < 8; ++i) fa[i] = LDF(i);
      SBAR;
#pragma unroll
      for (int i = 0; i < 8; ++i) fb[i] = LDF(8 + i);
      SBAR;
#pragma unroll
      for (int ks = 0; ks < 4; ++ks) { Vn[0] = MFMA16(fa[ks], Sb[ks], Vn[0]); Vn[1] = MFMA16(fa[4 + ks], Sb[ks], Vn[1]); }
      SBAR;
#pragma unroll
      for (int i = 0; i < 8; ++i) fa[i] = LDF(16 + i);
      SBAR;
#pragma unroll
      for (int ks = 0; ks < 4; ++ks) { Vn[2] = MFMA16(fb[ks], Sb[ks], Vn[2]); Vn[3] = MFMA16(fb[4 + ks], Sb[ks], Vn[3]); }
      SBAR;
#pragma unroll
      for (int i = 0; i < 8; ++i) fb[i] = LDF(24 + i);
      SBAR;
      bf16x8 Vb[2];
#pragma unroll
      for (int ks = 0; ks < 2; ++ks) Vb[ks] = pack8(Vn[2 * ks][0], Vn[2 * ks][1], Vn[2 * ks][2], Vn[2 * ks][3], Vn[2 * ks + 1][0], Vn[2 * ks + 1][1], Vn[2 * ks + 1][2], Vn[2 * ks + 1][3]);
#pragma unroll
      for (int ks = 0; ks < 2; ++ks) ST16_WT(rV, oV + n * 8 * DN_VFRAG + ks * 1024, Vb[ks]);
#pragma unroll
      for (int ks = 0; ks < 2; ++ks)
#pragma unroll
        for (int dt = 0; dt < 4; ++dt) S[dt] = MFMA16(fa[dt * 2 + ks], Vb[ks], S[dt]);
#pragma unroll
      for (int ks = 0; ks < 2; ++ks)
#pragma unroll
        for (int dt = 0; dt < 4; ++dt) S[4 + dt] = MFMA16(fb[dt * 2 + ks], Vb[ks], S[4 + dt]);
#undef LDF
#undef SBAR
      asm volatile("s_waitcnt lgkmcnt(0)" ::: "memory");
    }
    __builtin_amdgcn_s_barrier();
    asm volatile("" ::: "memory");
  }
  asm volatile("s_waitcnt vmcnt(0)" ::: "memory");
  __syncthreads();
  if (tid == 0) __hip_atomic_fetch_add(p.dep + 416 + bh, 1, __ATOMIC_RELAXED, __HIP_MEMORY_SCOPE_AGENT);
}
#define DO_OT 32768
#define DO_B1 69632
#define SCAN_FLAG 416
__device__ __forceinline__ void ph_dn_out(const Params& p, LAS unsigned char* lds, int nblk, int bid) {
  const int tid = p.tid, lane = tid & 63, w = __builtin_amdgcn_readfirstlane(tid >> 6), r16 = lane & 15, q4 = lane >> 4;
  LAS float* Ot = (LAS float*)(lds + DO_OT);
  for (;;) {
    int ok = 1;
    for (int ci = bid; ci < 1024; ci += nblk) ok &= __hip_atomic_load(p.dep + SCAN_FLAG + (ci >> 6), __ATOMIC_RELAXED, __HIP_MEMORY_SCOPE_AGENT) >= 2;
    if (__builtin_amdgcn_readfirstlane(ok)) break;
    __builtin_amdgcn_s_sleep(8);
  }
  asm volatile("" ::: "memory");
  __syncthreads();
  bf16x8 Sn[4], Vn[2];
  u32x4 zn0, zn1;
  float gdn[16];
#pragma unroll
  for (int j = 0; j < 16; ++j) gdn[j] = p.g_dn_out[16 * (tid & 7) + j];
  auto prefetch = [&](int ci, int buf) {
    const unsigned char* gA = (const unsigned char*)p.dnA + (size_t)ci * DN_ABYTES;
    { const int bh_ = ci >> 6; const bf16_t* zp = p.proj + ((size_t)(bh_ >> 2) * SEQ + (ci & 63) * 64 + (tid >> 3)) * PW + C_Z + (bh_ & 3) * 128 + 16 * (tid & 7);
      zn0 = *(const u32x4*)zp; zn1 = *(const u32x4*)(zp + 8); }
#pragma unroll
    for (int i = 0; i < 3; ++i) {
      const int f = w * 3 + i;
      __builtin_amdgcn_global_load_lds((const unsigned*)(gA + (F_QD + f) * 1024 + lane * 16), (LAS unsigned*)(lds + (buf ? DO_B1 : 0) + f * 1024), 16, 0, 0);
    }
#pragma unroll
    for (int ks = 0; ks < 4; ++ks) Sn[ks] = *(const bf16x8*)((const unsigned char*)p.dnS + ((size_t)ci * 8 + w) * DN_SFRAG + ks * 1024 + lane * 16);
#pragma unroll
    for (int ks = 0; ks < 2; ++ks) Vn[ks] = *(const bf16x8*)((const unsigned char*)p.dnV + ((size_t)ci * 8 + w) * DN_VFRAG + ks * 1024 + lane * 16);
  };
  if (bid < 1024) prefetch(bid, 0);
  int it = 0;
  for (int ci = bid; ci < 1024; ci += nblk, ++it) {
    const int bh = ci >> 6, n = ci & 63, b = bh >> 2, h = bh & 3;
    asm volatile("s_waitcnt vmcnt(2)" ::: "memory");
    __syncthreads();
    bf16x8 Sb[4], Vb[2];
#pragma unroll
    for (int ks = 0; ks < 4; ++ks) Sb[ks] = Sn[ks];
#pragma unroll
    for (int ks = 0; ks < 2; ++ks) Vb[ks] = Vn[ks];
    const u32x4 zc0 = zn0, zc1 = zn1;
    if (ci + nblk < 1024) prefetch(ci + nblk, (it + 1) & 1);
    const LAS unsigned char* fb = lds + ((it & 1) ? DO_B1 : 0);
    f32x4 O[4];
#pragma unroll
    for (int rr = 0; rr < 4; ++rr) {
      O[rr] = (f32x4){0.f, 0.f, 0.f, 0.f};
#pragma unroll
      for (int ks = 0; ks < 4; ++ks) O[rr] = MFMA16(*(const LAS bf16x8*)(fb + (rr * 4 + ks) * 1024 + lane * 16), Sb[ks], O[rr]);
#pragma unroll
      for (int ks = 0; ks < 2; ++ks) O[rr] = MFMA16(*(const LAS bf16x8*)(fb + (16 + rr * 2 + ks) * 1024 + lane * 16), Vb[ks], O[rr]);
    }
#pragma unroll
    for (int rr = 0; rr < 4; ++rr)
#pragma unroll
      for (int i = 0; i < 4; ++i) Ot[(16 * rr + 4 * q4 + i) * 132 + 16 * w + r16] = O[rr][i];
    __syncthreads();
    {
      const int row = tid >> 3, seg = tid & 7;
      const size_t t = (size_t)b * SEQ + n * 64 + row;
      float o[16]; float ss = 0.f;
#pragma unroll
      for (int j4 = 0; j4 < 4; ++j4) { const f32x4 v = *(const LAS f32x4*)(Ot + row * 132 + 16 * seg + 4 * j4); o[4 * j4] = v[0]; o[4 * j4 + 1] = v[1]; o[4 * j4 + 2] = v[2]; o[4 * j4 + 3] = v[3]; }
#pragma unroll
      for (int j = 0; j < 16; ++j) ss += o[j] * o[j];
      ss += __shfl_xor(ss, 1, 64); ss += __shfl_xor(ss, 2, 64); ss += __shfl_xor(ss, 4, 64);
      const float rstd = rsqrtf(ss * (1.f / 128.f) + 1e-6f);
      float z0[8], z1[8]; unpack8(zc0, z0); unpack8(zc1, z1);
      float y[16];
#pragma unroll
      for (int j = 0; j < 8; ++j) { y[j] = o[j] * rstd * gdn[j] * siluf_(z0[j]); y[8 + j] = o[8 + j] * rstd * gdn[8 + j] * siluf_(z1[j]); }
      u32x4 w0, w1;
      w0.x = pk2(y[0], y[1]); w0.y = pk2(y[2], y[3]); w0.z = pk2(y[4], y[5]); w0.w = pk2(y[6], y[7]);
      w1.x = pk2(y[8], y[9]); w1.y = pk2(y[10], y[11]); w1.z = pk2(y[12], y[13]); w1.w = pk2(y[14], y[15]);
      bf16_t* op = p.dn_out + t * p.dn_out_ld + h * 128 + 16 * seg;
      *(u32x4*)op = w0; *(u32x4*)(op + 8) = w1;
    }
  }
}
typedef float f32x16 __attribute__((ext_vector_type(16)));
#define MFMA32(a, b, c) __builtin_amdgcn_mfma_f32_32x32x16_bf16((a), (b), (c), 0, 0, 0)
#define MP_VL 0
#define MP_RED 65536
#define MP_TOTAL (65536 + 4096)

__device__ __forceinline__ void moba_prep_block(const Params& p, LAS unsigned char* lds, int item) {
  const int tid = p.tid, lane = tid & 63, w = tid >> 6;
  const int bh = item >> 4, jb = item & 15, b = bh >> 2, h = bh & 3;
  LAS bf16_t* Vl = (LAS bf16_t*)(lds + MP_VL);
  LAS float* red = (LAS float*)(lds + MP_RED);
  __syncthreads();
#pragma unroll
  for (int it = 0; it < 8; ++it) {
    const int idx = tid + 512 * it, row = idx >> 4, ch = idx & 15;
    const u32x4 v = *(const u32x4*)(p.proj + ((size_t)b * SEQ + 256 * jb + row) * PW + C_MV + h * 128 + 8 * ch);
    *(LAS u32x4*)(Vl + row * 128 + 8 * ch) = v;
  }
  {
    const int r = tid >> 1, hh = tid & 1;
    const int pos = 256 * jb + r;
    const size_t t = (size_t)b * SEQ + pos;
    float cs[8], sn[8];
#pragma unroll
    for (int jj = 0; jj < 8; ++jj) {
      const float inv = exp2f(-(float)(8 * hh + jj) * (1.f / 16.f) * 18.931568569324174f);
      const float ang = (float)pos * inv;
      float rev = ang * 0.15915494309189535f; rev -= floorf(rev);
      cs[jj] = __builtin_amdgcn_cosf(rev); sn[jj] = __builtin_amdgcn_sinf(rev);
    }
    float kacc[64];
#pragma unroll
    for (int which = 0; which < 2; ++which) {
      const bf16_t* src = p.proj + t * PW + (which ? C_MQ : C_MK) + h * 128 + 8 * hh;
      float x0[8], x1[8];
      unpack8(*(const u32x4*)(src), x0); unpack8(*(const u32x4*)(src + 16), x1);
      float y0[8], y1[8];
#pragma unroll
      for (int jj = 0; jj < 8; ++jj) { y0[jj] = x0[jj] * cs[jj] - x1[jj] * sn[jj]; y1[jj] = x1[jj] * cs[jj] + x0[jj] * sn[jj]; }
      u32x4 o[8];
      o[0].x = pk2(y0[0], y0[1]); o[0].y = pk2(y0[2], y0[3]); o[0].z = pk2(y0[4], y0[5]); o[0].w = pk2(y0[6], y0[7]);
      o[1].x = pk2(y1[0], y1[1]); o[1].y = pk2(y1[2], y1[3]); o[1].z = pk2(y1[4], y1[5]); o[1].w = pk2(y1[6], y1[7]);
#pragma unroll
      for (int ks = 2; ks < 8; ++ks) o[ks] = *(const u32x4*)(src + 16 * ks);
      if (which == 0) {
#pragma unroll
        for (int jj = 0; jj < 8; ++jj) { kacc[jj] = y0[jj]; kacc[8 + jj] = y1[jj]; }
#pragma unroll
        for (int ks = 2; ks < 8; ++ks) { float f[8]; unpack8(o[ks], f);
#pragma unroll
          for (int jj = 0; jj < 8; ++jj) kacc[8 * ks + jj] = f[jj]; }
        unsigned char* dst = (unsigned char*)p.Kp + ((size_t)(bh * 128 + 8 * jb + (r >> 5)) * 8192) + ((r & 31) + 32 * hh) * 16;
#pragma unroll
        for (int ks = 0; ks < 8; ++ks) *(u32x4*)(dst + ks * 1024) = o[ks];
      } else {
        bf16_t* dst = p.qb + ((size_t)bh * SEQ + pos) * 128 + 8 * hh;
#pragma unroll
        for (int ks = 0; ks < 8; ++ks) *(u32x4*)(dst + 16 * ks) = o[ks];
      }
    }
#pragma unroll
    for (int e = 0; e < 64; ++e) {
      float v = kacc[e];
      v += __shfl_xor(v, 2, 64); v += __shfl_xor(v, 4, 64); v += __shfl_xor(v, 8, 64); v += __shfl_xor(v, 16, 64); v += __shfl_xor(v, 32, 64);
      kacc[e] = v;
    }
    if (lane < 2) {
#pragma unroll
      for (int e = 0; e < 64; ++e) red[(w * 2 + lane) * 64 + e] = kacc[e];
    }
  }
  __syncthreads();
  if (tid < 128) {
    const int d = tid, hh = (d >> 3) & 1, ks = d >> 4, jj = d & 7;
    float a = 0.f;
#pragma unroll
    for (int ww = 0; ww < 8; ++ww) a += red[(ww * 2 + hh) * 64 + ks * 8 + jj];
    p.kmean[((size_t)bh * 16 + jb) * 128 + d] = a * (1.f / 256.f);
  }
#pragma unroll
  for (int it = 0; it < 8; ++it) {
    const int o = tid + 512 * it, ln = o & 63, frag = o >> 6, tl = frag >> 3, dt = (frag >> 1) & 3, s = frag & 1;
    const int r = ln & 31, hh = ln >> 5, d = 32 * dt + r;
    unsigned short e[8];
#pragma unroll
    for (int jj = 0; jj < 8; ++jj) { const int key = 32 * tl + 16 * s + 8 * (jj >> 2) + 4 * hh + (jj & 3); e[jj] = Vl[key * 128 + d]; }
    u32x4 wv; wv.x = e[0] | ((unsigned)e[1] << 16); wv.y = e[2] | ((unsigned)e[3] << 16); wv.z = e[4] | ((unsigned)e[5] << 16); wv.w = e[6] | ((unsigned)e[7] << 16);
    *(u32x4*)((unsigned char*)p.Vp + ((size_t)(bh * 128 + 8 * jb + tl) * 8192) + (dt * 2 + s) * 1024 + ln * 16) = wv;
  }
}
__device__ __forceinline__ int crow32(int reg, int hh) { return (reg & 3) + 8 * (reg >> 2) + 4 * hh; }
__device__ __forceinline__ void moba_item(const Params& p, LAS float* km, LAS float* mrg, LAS float* ml, int bh, int ib, int sub, int par, int lane, int rep) {
  const int q = lane & 31, hh = lane >> 5;
  const int b = bh >> 2, h = bh & 3;
  const int s0 = 256 * ib + 32 * sub;
  const bf16_t* qrow = p.qb + ((size_t)bh * SEQ + s0 + q) * 128 + 8 * hh;
  bf16x8 Qf[8];
#pragma unroll
  for (int ks = 0; ks < 8; ++ks) Qf[ks] = *(const bf16x8*)(qrow + 16 * ks);
  LAS unsigned char* qlds = (LAS unsigned char*)km + 8192 + lane * 16;
#pragma unroll
  for (int ks = 0; ks < 8; ++ks) *(LAS bf16x8*)(qlds + ks * 1024) = Qf[ks];
  unsigned selmask = 0;
  if (ib > 0) {
    for (int idx = lane; idx < ib * 32; idx += 64) ((LAS f32x4*)km)[idx] = ((const f32x4*)(p.kmean + (size_t)bh * 16 * 128))[idx];
    float qf[64];
#pragma unroll
    for (int ks = 0; ks < 8; ++ks) { float f[8]; unpack8(__builtin_bit_cast(u32x4, Qf[ks]), f);
#pragma unroll
      for (int jj = 0; jj < 8; ++jj) qf[8 * ks + jj] = f[jj]; }
    float sc[16];
#pragma unroll
    for (int j = 0; j < 16; ++j) {
      sc[j] = -INFINITY;
      if (j < ib) {
        float a = 0.f;
#pragma unroll
        for (int ks = 0; ks < 8; ++ks) {
          const f32x4 k0 = *(const LAS f32x4*)(km + j * 128 + 16 * ks + 8 * hh), k1 = *(const LAS f32x4*)(km + j * 128 + 16 * ks + 8 * hh + 4);
          a += qf[8 * ks] * k0[0] + qf[8 * ks + 1] * k0[1] + qf[8 * ks + 2] * k0[2] + qf[8 * ks + 3] * k0[3];
          a += qf[8 * ks + 4] * k1[0] + qf[8 * ks + 5] * k1[1] + qf[8 * ks + 6] * k1[2] + qf[8 * ks + 7] * k1[3];
        }
        a += __shfl_xor(a, 32, 64);
        sc[j] = a;
      }
    }
#pragma unroll
    for (int r = 0; r < 3; ++r) {
      if (r < ib) {
        float best = -INFINITY; int bi = 0;
#pragma unroll
        for (int j = 0; j < 16; ++j) if (sc[j] > best) { best = sc[j]; bi = j; }
        selmask |= 1u << bi;
#pragma unroll
        for (int j = 0; j < 16; ++j) if (j == bi) sc[j] = -INFINITY;
      }
    }
  }
  unsigned rem = 0;
  for (int j = 0; j < ib; ++j) if (__ballot((selmask >> j) & 1u) != 0ull) rem |= 1u << j;
  rem = __builtin_amdgcn_readfirstlane(rem);
  const int own0 = 8 * ib, diag = 8 * ib + sub;
  const float cscale = 0.08838834764831845f * 1.4426950408889634f;
  float m = -1e30f, l = 0.f;
  f32x16 O[4];
#pragma unroll
  for (int dt = 0; dt < 4; ++dt)
#pragma unroll
    for (int r = 0; r < 16; ++r) O[dt][r] = 0.f;
  const unsigned char* kbase = (const unsigned char*)p.Kp + (size_t)bh * 128 * 8192 + lane * 16;
  const unsigned char* vbase = (const unsigned char*)p.Vp + (size_t)bh * 128 * 8192 + lane * 16;
  auto adv = [&](int& kt_, unsigned& rem_) {
    if (kt_ < 0) return;
    if (kt_ >= own0 ? (kt_ < diag) : ((kt_ & 7) != 7)) { kt_ = kt_ + 1; return; }
    if (rem_ == 0u) { kt_ = -1; return; }
    kt_ = 8 * (__builtin_ctz(rem_)); rem_ &= rem_ - 1u;
  };
  int kt = own0;
  if (par) adv(kt, rem);
  auto load_k = [&](int t, bf16x8 (&K_)[8]) {
#pragma unroll
    for (int ks = 0; ks < 8; ++ks) K_[ks] = *(const bf16x8*)(kbase + (size_t)t * 8192 + ks * 1024);
  };
  auto tile_step = [&](bf16x8 (&Kc)[8], bf16x8 (&Kn)[8]) -> bool {
    int ktn = kt; unsigned remn = rem;
    adv(ktn, remn); adv(ktn, remn);
    bf16x8 Vf[8];
#pragma unroll
    for (int f = 0; f < 8; ++f) Vf[f] = *(const bf16x8*)(vbase + (size_t)kt * 8192 + f * 1024);
    if (ktn >= 0) load_k(ktn, Kn);
    f32x16 S;
#pragma unroll
    for (int r = 0; r < 16; ++r) S[r] = 0.f;
#pragma unroll
    for (int ks = 0; ks < 8; ++ks) S = MFMA32(Kc[ks], *(const LAS bf16x8*)(qlds + ks * 1024), S);
    const bool allowed = (kt >= own0) || ((selmask >> (kt >> 3)) & 1u);
    const float nb = allowed ? 0.f : -INFINITY;
    float sv[16]; float mx = -INFINITY;
#pragma unroll
    for (int r = 0; r < 16; ++r) sv[r] = __builtin_fmaf(S[r], cscale, nb);
    if (kt == diag) {
#pragma unroll
      for (int r = 0; r < 16; ++r) if (crow32(r, hh) > q) sv[r] = -INFINITY;
    }
#pragma unroll
    for (int r = 0; r < 16; ++r) mx = fmaxf(mx, sv[r]);
    mx = fmaxf(mx, __shfl_xor(mx, 32, 64));
    const bool grow = mx > m + 8.f;
    const float mn = (__ballot(grow) != 0ull) ? fmaxf(m, mx) : m;
    const float alpha = __builtin_amdgcn_exp2f(m - mn);
    float ps = 0.f;
#pragma unroll
    for (int r = 0; r < 16; ++r) { sv[r] = __builtin_amdgcn_exp2f(sv[r] - mn); ps += sv[r]; }
    l = l * alpha + ps; m = mn;
    if (__ballot(alpha != 1.f) != 0ull) {
#pragma unroll
      for (int dt = 0; dt < 4; ++dt)
#pragma unroll
        for (int r = 0; r < 16; ++r) O[dt][r] *= alpha;
    }
    const bf16x8 P0 = pack8(sv[0], sv[1], sv[2], sv[3], sv[4], sv[5], sv[6], sv[7]);
    const bf16x8 P1 = pack8(sv[8], sv[9], sv[10], sv[11], sv[12], sv[13], sv[14], sv[15]);
#pragma unroll
    for (int dt = 0; dt < 4; ++dt) { O[dt] = MFMA32(Vf[dt * 2], P0, O[dt]); O[dt] = MFMA32(Vf[dt * 2 + 1], P1, O[dt]); }
    kt = ktn; rem = remn;
    return kt >= 0;
  };
  if (kt >= 0) {
    bf16x8 KA[8], KB[8];
    load_k(kt, KA);
#pragma unroll 1
    for (;;) {
      if (!tile_step(KA, KB)) break;
      asm volatile("" ::: "memory");
      if (!tile_step(KB, KA)) break;
      asm volatile("" ::: "memory");
    }
  }
  asm volatile("s_waitcnt vmcnt(0) lgkmcnt(0)" ::: "memory");
  if (par) {
    ml[lane] = m; ml[64 + lane] = l;
#pragma unroll
    for (int dt = 0; dt < 4; ++dt)
#pragma unroll
      for (int r = 0; r < 16; ++r) mrg[(dt * 16 + r) * 64 + lane] = O[dt][r];
  }
  __syncthreads();
  if (par == 0) {
    const float m2 = ml[lane], l2 = ml[64 + lane];
    const float mm = fmaxf(m, m2);
    const float a1 = __builtin_amdgcn_exp2f(m - mm), a2 = __builtin_amdgcn_exp2f(m2 - mm);
    l = l * a1 + l2 * a2;
#pragma unroll
    for (int dt = 0; dt < 4; ++dt)
#pragma unroll
      for (int r = 0; r < 16; ++r) O[dt][r] = O[dt][r] * a1 + mrg[(dt * 16 + r) * 64 + lane] * a2;
  }
  if (par == 0) {
  l += __shfl_xor(l, 32, 64);
  const float inv = 1.f / l;
  bf16_t* orow = rep ? p.oab2 + ((size_t)b * SEQ + s0 + q) * 512 + h * 128 : p.mb_out + ((size_t)b * SEQ + s0 + q) * p.mb_out_ld + p.mb_out_off + h * 128;
#pragma unroll
  for (int dt = 0; dt < 4; ++dt)
#pragma unroll
    for (int g4 = 0; g4 < 4; ++g4) {
      u32x2 wv; wv.x = pk2(O[dt][4 * g4] * inv, O[dt][4 * g4 + 1] * inv); wv.y = pk2(O[dt][4 * g4 + 2] * inv, O[dt][4 * g4 + 3] * inv);
      *(u32x2*)(orow + 32 * dt + 8 * g4 + 4 * hh) = wv;
    }
  }
  __syncthreads();
}
#define WT_DEPTH 12
#define WT_AUX 19
#define WT_IN_ATTN 0
#define WT_CHUNK 32
__device__ __forceinline__ void wt_moe_chunk(const Params& p, LAS unsigned char* lds, int j0) {
  LAS float* tile = (LAS float*)(lds + 32768);
  int tid = p.tid; asm volatile("" : "+v"(tid));
  __syncthreads();
  const bool gu = j0 < 16384;
  const int u = gu ? j0 : j0 - 16384;
  const int e = gu ? (u >> 9) : (u >> 8), r0 = gu ? (u & 511) : (u & 255), N = gu ? 2048 : 1024;
  const int q_ = r0 >> 5, kt0 = gu ? 2 * (q_ >> 1) : 2 * q_, nb = gu ? (q_ & 1) * 16 : 0;
  const float* src = gu ? p.w_gu + (size_t)e * 1024 * 2048 : p.w_down + (size_t)e * 1024 * 1024;
  unsigned char* dst = gu ? p.wgu8 + (size_t)e * 2048 * 1024 : p.wd8 + (size_t)e * 1024 * 1024;
  const int lrow = tid >> 4, lc = (tid & 15) * 4, nl = tid >> 3, kc = tid & 7;
  const __amdgpu_buffer_rsrc_t rsrc = __builtin_amdgcn_make_buffer_rsrc((void*)src, 0, 1024 * 2048 * 4, 0x00020000);
  constexpr int D = WT_DEPTH / 2;
  constexpr int NP = WT_CHUNK / 2;
  f32x4 q[D][4];
#pragma unroll
  for (int k = 0; k < D; ++k) {
    const unsigned so = (unsigned)(((kt0 * 64 + lrow) * N + (nb + k) * 64 + lc) * 4);
#pragma unroll
    for (int it = 0; it < 4; ++it) q[k][it] = __builtin_bit_cast(f32x4, __builtin_amdgcn_raw_buffer_load_b128(rsrc, so + (unsigned)(it * 32 * N * 4), 0, WT_AUX));
  }
#pragma unroll
  for (int i = 0; i < NP; ++i) {
    const int nt = nb + i;
#pragma unroll
    for (int it = 0; it < 4; ++it) {
      const int row = lrow + 32 * it, ro = row * 65 + 8 * (it >> 1) + lc;
      tile[ro] = q[i % D][it][0]; tile[ro + 1] = q[i % D][it][1]; tile[ro + 2] = q[i % D][it][2]; tile[ro + 3] = q[i % D][it][3];
    }
    if (i + D < NP) {
      const unsigned so = (unsigned)(((kt0 * 64 + lrow) * N + (nb + i + D) * 64 + lc) * 4);
#pragma unroll
      for (int it = 0; it < 4; ++it) q[i % D][it] = __builtin_bit_cast(f32x4, __builtin_amdgcn_raw_buffer_load_b128(rsrc, so + (unsigned)(it * 32 * N * 4), 0, WT_AUX));
    }
    __syncthreads();
    {
      const int n = nt * 64 + nl;
      const int dd = gu ? ((n & 1023) >> 7) * 256 + ((n >> 10) << 7) + (n & 127) : n;
      float f[16];
#pragma unroll
      for (int j = 0; j < 16; ++j) f[j] = tile[(16 * kc + j) * 65 + 8 * (kc >> 2) + nl] * 64.f;
      u32x4 w; w.x = pk4_fp8(f[0], f[1], f[2], f[3]); w.y = pk4_fp8(f[4], f[5], f[6], f[7]); w.z = pk4_fp8(f[8], f[9], f[10], f[11]); w.w = pk4_fp8(f[12], f[13], f[14], f[15]);
      *(u32x4*)(dst + (size_t)dd * 1024 + kt0 * 64 + 16 * kc) = w;
    }
    __syncthreads();
  }
}
__device__ __forceinline__ void moba_worker(const Params& p, LAS unsigned char* lds, int qi, int nblk, int bid) {
  const int lane = p.tid & 63, w = __builtin_amdgcn_readfirstlane(p.tid >> 6);
  LAS float* km = (LAS float*)(lds + w * 16384);
  LAS float* mrg = (LAS float*)(lds + ((w & 3) + 4) * 16384);
  LAS float* ml = (LAS float*)(lds + 131072) + (w & 3) * 128;
  LAS int* slot = (LAS int*)(lds + 131072 + 2048);
  const int g0 = (int)((unsigned)__builtin_amdgcn_s_getreg((3 << 11) | 20) & 7u);
  const int nmoe = 24576;
  const int nch = WT_IN_ATTN ? (nmoe + WT_CHUNK * nblk - 1) / (WT_CHUNK * nblk) : 0;
  int gi = 0, cdone = 0;
  bool want_conv = ((bid >> 3) & 1) == 0;
  for (;;) {
    if (cdone < nch && (want_conv || gi >= 8)) {
      const int j0 = (cdone * nblk + bid) * WT_CHUNK;
      if (j0 < nmoe) wt_moe_chunk(p, lds, j0);
      ++cdone; want_conv = false; continue;
    }
    if (gi >= 8) break;
    const int g = (g0 + gi) & 7;
    __syncthreads();
    if (p.tid == 0) slot[0] = atomicAdd(p.wq + qi * 8 + g, 1);
    __syncthreads();
    const int idx = slot[0];
    if (idx >= 64) { ++gi; continue; }
    const int bh = 2 * g + (idx >> 5), ib = 15 - ((idx >> 1) & 15), quad = 1 - (idx & 1);
    moba_item(p, km, mrg, ml, bh, ib, 4 * quad + (w & 3), w >> 2, lane, qi);
    want_conv = true;
  }
}
#define MOD_CTR 400
__device__ __forceinline__ void ph_mod(const Params& p, LAS unsigned char* lds, int nblk, int bid) {
  LAS float* sc = (LAS float*)lds;
  LAS float* part = (LAS float*)(lds + 16384);
  const int tid = p.tid;
  if (bid >= 192) return;
  for (int i = tid; i < 4096; i += 512) sc[i] = siluf_(p.c[i]);
  __syncthreads();
  for (int task = bid; task < 192; task += nblk) {
    const int jj = tid & 31, ks = tid >> 5, j = task * 32 + jj;
    float a0 = 0.f, a1 = 0.f, a2 = 0.f, a3 = 0.f;
#pragma unroll 8
    for (int kk = 0; kk < 64; ++kk) {
      const int k = ks * 64 + kk;
      const float w = p.w_ada[(size_t)k * 6144 + j];
      a0 += sc[k] * w; a1 += sc[1024 + k] * w; a2 += sc[2048 + k] * w; a3 += sc[3072 + k] * w;
    }
    *(LAS f32x4*)(part + (ks * 32 + jj) * 4) = (f32x4){a0, a1, a2, a3};
    __syncthreads();
    if (tid < 128) {
      const int j2 = tid & 31, bb = tid >> 5;
      float a = 0.f;
#pragma unroll
      for (int s = 0; s < 16; ++s) a += part[(s * 32 + j2) * 4 + bb];
      __hip_atomic_store(&p.mod[bb * 6144 + task * 32 + j2], a + p.b_ada[task * 32 + j2], __ATOMIC_RELAXED, __HIP_MEMORY_SCOPE_AGENT);
    }
    asm volatile("s_waitcnt vmcnt(0)" ::: "memory");
    __syncthreads();
    if (tid == 0) __hip_atomic_fetch_add(p.dep + MOD_CTR, 1, __ATOMIC_RELAXED, __HIP_MEMORY_SCOPE_AGENT);
  }
}

#define WT_T0 1424
#define WT_T1 (WT_T0 + 16384)
#define WT_T2 (WT_T1 + 8192)
#define WT_T3 (WT_T2 + 128)
#define WT_T4 (WT_T3 + 128)
#define WT_T5 (WT_T4 + 256)
struct WtTile { const float* src; bf16_t* dst; int K, N, mode, k0, n0; unsigned char* dst8; };
__device__ __forceinline__ WtTile wt_desc(const Params& p, int t) {
  WtTile d;
  if (t < WT_T0) { const int kt = t / 89, nt = t % 89; d = {p.w_in, p.w_in_t, 1024, INW, 1, kt * 64, nt * 64, nullptr}; }
  else if (t < WT_T1) { const int u = t - WT_T0, e = u >> 9, r = u & 511, kt = r >> 5, nt = r & 31; d = {p.w_gu + (size_t)e * 1024 * 2048, nullptr, 1024, 2048, 2, kt * 64, nt * 64, p.wgu8 + (size_t)e * 2048 * 1024}; }
  else if (t < WT_T2) { const int u = t - WT_T1, e = u >> 8, r = u & 255, kt = r >> 4, nt = r & 15; d = {p.w_down + (size_t)e * 1024 * 1024, nullptr, 1024, 1024, 0, kt * 64, nt * 64, p.wd8 + (size_t)e * 1024 * 1024}; }
  else if (t < WT_T3) { const int u = t - WT_T2, kt = u >> 4, nt = u & 15; d = {p.w_br_a, p.wbra_t, 512, 1024, 0, kt * 64, nt * 64, nullptr}; }
  else if (t < WT_T4) { const int u = t - WT_T3, kt = u >> 4, nt = u & 15; d = {p.w_br_b, p.wbrb_t, 512, 1024, 0, kt * 64, nt * 64, nullptr}; }
  else { const int u = t - WT_T4, kt = u >> 4, nt = u & 15; d = {p.w_o, p.wo_t, 1024, 1024, 0, kt * 64, nt * 64, nullptr}; }
  return d;
}
__device__ __forceinline__ void wt_load(const WtTile& d, int tid, f32x4 (&v)[2]) {
#pragma unroll
  for (int it = 0; it < 2; ++it) {
    const int row = (tid >> 4) + 32 * it, n = d.n0 + (tid & 15) * 4;
    v[it] = (f32x4){0.f, 0.f, 0.f, 0.f};
    if (n < d.N) v[it] = __builtin_nontemporal_load((const f32x4*)(d.src + (size_t)(d.k0 + row) * d.N + n));
  }
}
#define WT_NMOE (WT_T2 - WT_T0)
#define WT_NREST (WT_T5 - WT_NMOE)
template <bool MOE> __device__ __forceinline__ int wt_tile_id(int j) { return MOE ? WT_T0 + j : (j < WT_T0 ? j : j + WT_NMOE); }
template <bool MOE>
__device__ __forceinline__ void ph_wt(const Params& p, LAS unsigned char* lds, int j0, int stride, int jend) {
  LAS float* tile = (LAS float*)(lds + 32768);
  const int tid = p.tid;
  const int nblk = stride;
  int t = j0;
  if (t >= jend) return;
  __syncthreads();
  WtTile cur = wt_desc(p, wt_tile_id<MOE>(t));
  f32x4 v[2]; wt_load(cur, tid, v);
  WtTile nxt = cur; f32x4 vn[2] = {v[0], v[1]};
  if (t + nblk < jend) { nxt = wt_desc(p, wt_tile_id<MOE>(t + nblk)); wt_load(nxt, tid, vn); }
  for (;;) {
    const int tnn = t + 2 * nblk;
    WtTile nn = nxt; f32x4 vnn[2] = {vn[0], vn[1]};
    if (tnn < jend) { nn = wt_desc(p, wt_tile_id<MOE>(tnn)); wt_load(nn, tid, vnn); }
#pragma unroll
    for (int it = 0; it < 2; ++it) {
      const int row = (tid >> 4) + 32 * it, c4 = (tid & 15) * 4;
      tile[row * 65 + c4] = v[it][0]; tile[row * 65 + c4 + 1] = v[it][1]; tile[row * 65 + c4 + 2] = v[it][2]; tile[row * 65 + c4 + 3] = v[it][3];
    }
    __syncthreads();
    {
      const int nl = tid >> 3, kc = tid & 7, n = cur.n0 + nl;
      if (n < cur.N) {
        const int dd = map_col(n, cur.mode);
        if (dd >= 0) {
          float f[8];
#pragma unroll
          for (int j = 0; j < 8; ++j) f[j] = tile[(8 * kc + j) * 65 + nl];
          if (cur.dst8) {
            u32x2 w; w.x = pk4_fp8(f[0] * 64.f, f[1] * 64.f, f[2] * 64.f, f[3] * 64.f); w.y = pk4_fp8(f[4] * 64.f, f[5] * 64.f, f[6] * 64.f, f[7] * 64.f);
            *(u32x2*)(cur.dst8 + (size_t)dd * cur.K + cur.k0 + 8 * kc) = w;
          } else {
            u32x4 w; w.x = pk2(f[0], f[1]); w.y = pk2(f[2], f[3]); w.z = pk2(f[4], f[5]); w.w = pk2(f[6], f[7]);
            *(u32x4*)(cur.dst + (size_t)dd * cur.K + cur.k0 + 8 * kc) = w;
          }
        }
      }
    }
    __syncthreads();
    if (t + nblk >= jend) break;
    t += nblk; cur = nxt; v[0] = vn[0]; v[1] = vn[1]; nxt = nn; vn[0] = vnn[0]; vn[1] = vnn[1];
  }
}

__device__ __forceinline__ void ph_h(const Params& p, LAS unsigned char* lds, int nblk, int bid) {
  const int wid = p.tid >> 6, lane = p.tid & 63;
  LAS float* wb = (LAS float*)lds;
  __syncthreads();
  for (int i = p.tid; i < 2048; i += 512) {
    const int k = i >> 1, hf = i & 1;
    const f32x4 v = *(const f32x4*)(p.w_in + (size_t)k * INW + 2048 + 4 * hf);
    wb[(4 * hf + 0) * 1024 + k] = v[0]; wb[(4 * hf + 1) * 1024 + k] = v[1]; wb[(4 * hf + 2) * 1024 + k] = v[2]; wb[(4 * hf + 3) * 1024 + k] = v[3];
  }
  __syncthreads();
  while (__builtin_amdgcn_readfirstlane(__hip_atomic_load(p.dep + MOD_CTR, __ATOMIC_RELAXED, __HIP_MEMORY_SCOPE_AGENT)) < 192) __builtin_amdgcn_s_sleep(4);
  asm volatile("" ::: "memory");
  f32x4 gv[4];
#pragma unroll
  for (int i = 0; i < 4; ++i) gv[i] = *(const f32x4*)(p.g_pre_mix + i * 256 + lane * 4);
  f32x4 xnx[4];
  if (bid * 8 + wid < T_TOK) {
#pragma unroll
    for (int i = 0; i < 4; ++i) xnx[i] = *(const f32x4*)(p.x + (size_t)(bid * 8 + wid) * DM + i * 256 + lane * 4);
  }
  for (int t = bid * 8 + wid; t < T_TOK; t += nblk * 8) {
    const int b = t / SEQ;
    f32x4 xv[4];
    float ss = 0.f;
#pragma unroll
    for (int i = 0; i < 4; ++i) {
      xv[i] = xnx[i];
      ss += xv[i][0] * xv[i][0] + xv[i][1] * xv[i][1] + xv[i][2] * xv[i][2] + xv[i][3] * xv[i][3];
    }
    if (t + nblk * 8 < T_TOK) {
#pragma unroll
      for (int i = 0; i < 4; ++i) xnx[i] = *(const f32x4*)(p.x + (size_t)(t + nblk * 8) * DM + i * 256 + lane * 4);
    }
    ss = wave_sum(ss);
    const float rstd = rsqrtf(ss * (1.f / DM) + 1e-6f);
    const float* shift = p.mod + b * 6144;
    const float* scale = p.mod + b * 6144 + 1024;
    float acc[8] = {0, 0, 0, 0, 0, 0, 0, 0};
    f32x4 scv[4], shv[4];
#pragma unroll
    for (int i = 0; i < 4; ++i) { scv[i] = *(const f32x4*)(scale + i * 256 + lane * 4); shv[i] = *(const f32x4*)(shift + i * 256 + lane * 4); }
#pragma unroll
    for (int i = 0; i < 4; ++i) {
      const int k = i * 256 + lane * 4;
      const f32x4 g = gv[i], sc = scv[i], sh = shv[i];
      f32x4 hv;
#pragma unroll
      for (int j = 0; j < 4; ++j) hv[j] = xv[i][j] * rstd * g[j] * (1.f + sc[j]) + sh[j];
#pragma unroll
      for (int e = 0; e < 8; ++e) { const f32x4 w = *(const LAS f32x4*)(wb + e * 1024 + k); acc[e] += hv[0] * w[0] + hv[1] * w[1] + hv[2] * w[2] + hv[3] * w[3]; }
      u32x2 pk; pk.x = pk2(hv[0], hv[1]); pk.y = pk2(hv[2], hv[3]);
      *(u32x2*)(p.hbf + (size_t)t * DM + k) = pk;
    }
#pragma unroll
    for (int e = 0; e < 8; ++e) acc[e] = wave_sum(acc[e]);
    if (lane == 0) { *(f32x4*)(p.ba + (size_t)t * 8) = (f32x4){acc[0], acc[1], acc[2], acc[3]}; *(f32x4*)(p.ba + (size_t)t * 8 + 4) = (f32x4){acc[4], acc[5], acc[6], acc[7]}; }
  }
}

#define PM_WT 0
#define PM_H2 66048
#define PM_CNT 132096
#define PM_ENT 132352
__device__ __forceinline__ void ph_post_mix(const Params& p, LAS unsigned char* lds, int nblk, int bid, int rep) {
  const int wid = p.tid >> 6, lane = p.tid & 63, r16 = lane & 15, q4 = lane >> 4;
  LAS bf16_t* wT = (LAS bf16_t*)(lds + PM_WT);
  LAS bf16_t* ht = (LAS bf16_t*)(lds + PM_H2) + wid * 4 * 1032;
  LAS int* lcnt = (LAS int*)(lds + PM_CNT);
  LAS int* lbase = lcnt + 32;
  LAS int* lent = (LAS int*)(lds + PM_ENT) + wid * 64;
  int nloc = 0;
  if (p.tid < 32) lcnt[p.tid] = 0;
  for (int i = p.tid; i < 1024 * 8; i += 512) {
    const int k = i >> 3, c = i & 7;
    const f32x4 v = *(const f32x4*)(p.w_router + (size_t)k * 32 + c * 4);
#pragma unroll
    for (int j = 0; j < 4; ++j) wT[(c * 4 + j) * 1032 + k] = f2bf_hw(v[j]);
  }
  __syncthreads();
  const float bias0 = p.b_router[r16], bias1 = p.b_router[16 + r16];
  const int tstride = nblk * 8;
  f32x4 gpv[4], gqv[4];
#pragma unroll
  for (int i4 = 0; i4 < 4; ++i4) { const int k = (i4 >> 1) * 512 + lane * 8 + (i4 & 1) * 4; gpv[i4] = *(const f32x4*)(p.g_post_mix + k); gqv[i4] = *(const f32x4*)(p.g_pre_ffn + k); }
  for (int t = bid * 8 + wid; t < T_TOK; t += tstride)
    while (__builtin_amdgcn_readfirstlane(__hip_atomic_load(p.dep + MIX_CTR + 16 * (t >> 8), __ATOMIC_RELAXED, __HIP_MEMORY_SCOPE_AGENT)) < 4) __builtin_amdgcn_s_sleep(4);
  asm volatile("" ::: "memory");
  u32x4 mxn[2]; f32x4 xn[4];
  f32x4 gmn[4], scn[4], sfn[4];
  {
    const int t0 = bid * 8 + wid;
    if (t0 < T_TOK) {
#pragma unroll
      for (int i = 0; i < 2; ++i) mxn[i] = *(const u32x4*)(p.mixer + (size_t)t0 * DM + i * 512 + lane * 8);
#pragma unroll
      for (int i = 0; i < 4; ++i) xn[i] = *(const f32x4*)(p.x + (size_t)t0 * DM + (i >> 1) * 512 + lane * 8 + (i & 1) * 4);
      const float* md0 = p.mod + (t0 / SEQ) * 6144;
#pragma unroll
      for (int i4 = 0; i4 < 4; ++i4) { const int k = (i4 >> 1) * 512 + lane * 8 + (i4 & 1) * 4; gmn[i4] = *(const f32x4*)(md0 + 2048 + k); scn[i4] = *(const f32x4*)(md0 + 4096 + k); sfn[i4] = *(const f32x4*)(md0 + 3072 + k); }
    }
  }
  for (int tg = bid * 8 + wid; tg < T_TOK; tg += 4 * tstride) {
#pragma unroll 1
    for (int jj = 0; jj < 4; ++jj) {
      const int t = tg + jj * tstride;
      if (t >= T_TOK) break;
      u32x4 mxc[2] = {mxn[0], mxn[1]}; f32x4 xc[4] = {xn[0], xn[1], xn[2], xn[3]};
      f32x4 gmv[4], scv[4], sfv[4];
#pragma unroll
      for (int i4 = 0; i4 < 4; ++i4) { gmv[i4] = gmn[i4]; scv[i4] = scn[i4]; sfv[i4] = sfn[i4]; }
      {
        const int tn = t + tstride;
        if (tn < T_TOK) {
          const float* mdn = p.mod + (tn / SEQ) * 6144;
#pragma unroll
          for (int i4 = 0; i4 < 4; ++i4) { const int k = (i4 >> 1) * 512 + lane * 8 + (i4 & 1) * 4; gmn[i4] = *(const f32x4*)(mdn + 2048 + k); scn[i4] = *(const f32x4*)(mdn + 4096 + k); sfn[i4] = *(const f32x4*)(mdn + 3072 + k); }
#pragma unroll
          for (int i = 0; i < 2; ++i) mxn[i] = *(const u32x4*)(p.mixer + (size_t)tn * DM + i * 512 + lane * 8);
#pragma unroll
          for (int i = 0; i < 4; ++i) xn[i] = *(const f32x4*)(p.x + (size_t)tn * DM + (i >> 1) * 512 + lane * 8 + (i & 1) * 4);
        }
      }
      float mv[16];
      float ss = 0.f;
#pragma unroll
      for (int i = 0; i < 2; ++i) {
        float f[8]; unpack8(mxc[i], f);
#pragma unroll
        for (int j = 0; j < 8; ++j) { mv[i * 8 + j] = f[j]; ss += f[j] * f[j]; }
      }
      ss = wave_sum(ss);
      const float rstd = rsqrtf(ss * (1.f / DM) + 1e-6f);
      float x1[16];
      float s2 = 0.f;
#pragma unroll
      for (int i = 0; i < 2; ++i) {
#pragma unroll
        for (int j4 = 0; j4 < 2; ++j4) {
          const f32x4 xv = xc[i * 2 + j4];
          const f32x4 gm = gmv[i * 2 + j4], gp = gpv[i * 2 + j4];
#pragma unroll
          for (int j = 0; j < 4; ++j) { const float o = xv[j] + gm[j] * (mv[i * 8 + j4 * 4 + j] * rstd * gp[j]); x1[i * 8 + j4 * 4 + j] = o; s2 += o * o; }
        }
        u32x4 xb; xb.x = pk2(x1[i * 8], x1[i * 8 + 1]); xb.y = pk2(x1[i * 8 + 2], x1[i * 8 + 3]); xb.z = pk2(x1[i * 8 + 4], x1[i * 8 + 5]); xb.w = pk2(x1[i * 8 + 6], x1[i * 8 + 7]);
        *(u32x4*)(p.hbf + (size_t)t * DM + i * 512 + lane * 8) = xb;
      }
      s2 = wave_sum(s2);
      const float rstd2 = rsqrtf(s2 * (1.f / DM) + 1e-6f);
#pragma unroll
      for (int i = 0; i < 2; ++i) {
        float hv[8];
#pragma unroll
        for (int j4 = 0; j4 < 2; ++j4) {
          const int k = i * 512 + lane * 8 + j4 * 4;
          const f32x4 gq = gqv[i * 2 + j4], sc = scv[i * 2 + j4], sf = sfv[i * 2 + j4];
#pragma unroll
          for (int j = 0; j < 4; ++j) hv[j4 * 4 + j] = x1[i * 8 + j4 * 4 + j] * rstd2 * gq[j] * (1.f + sc[j]) + sf[j];
        }
        u32x2 w; w.x = pk4_fp8(hv[0], hv[1], hv[2], hv[3]); w.y = pk4_fp8(hv[4], hv[5], hv[6], hv[7]);
        *(u32x2*)(p.h2q + (size_t)t * DM + i * 512 + lane * 8) = w;
        u32x4 hb; hb.x = pk2(hv[0], hv[1]); hb.y = pk2(hv[2], hv[3]); hb.z = pk2(hv[4], hv[5]); hb.w = pk2(hv[6], hv[7]);
        *(LAS u32x4*)(ht + jj * 1032 + i * 512 + lane * 8) = hb;
      }
    }
    f32x4 acc0 = {0.f, 0.f, 0.f, 0.f}, acc1 = {0.f, 0.f, 0.f, 0.f};
#pragma unroll 8
    for (int ks = 0; ks < 32; ++ks) {
      const bf16x8 a = *(const LAS bf16x8*)(ht + (r16 & 3) * 1032 + 32 * ks + 8 * q4);
      const bf16x8 b0 = *(const LAS bf16x8*)(wT + r16 * 1032 + 32 * ks + 8 * q4);
      const bf16x8 b1 = *(const LAS bf16x8*)(wT + (16 + r16) * 1032 + 32 * ks + 8 * q4);
      acc0 = MFMA16(a, b0, acc0); acc1 = MFMA16(a, b1, acc1);
    }
#pragma unroll
    for (int jj = 0; jj < 4; ++jj) {
      const int t = tg + jj * tstride;
      if (t < T_TOK) {
        float l0 = (lane < 16) ? acc0[jj] + bias0 : -INFINITY, l1 = (lane < 16) ? acc1[jj] + bias1 : -INFINITY;
        float tv[4]; int ti[4];
#pragma unroll
        for (int r = 0; r < 4; ++r) {
          const float m = wave_max(fmaxf(l0, l1));
          const unsigned long long b0m = __ballot(l0 == m);
          int idx;
          if (b0m) { idx = __ffsll((long long)b0m) - 1; if (lane == idx) l0 = -INFINITY; }
          else { const unsigned long long b1m = __ballot(l1 == m); idx = __ffsll((long long)b1m) - 1; if (lane == idx) l1 = -INFINITY; idx += 16; }
          tv[r] = m; ti[r] = idx;
        }
        const float e1 = __expf(tv[1] - tv[0]), e2 = __expf(tv[2] - tv[0]), e3 = __expf(tv[3] - tv[0]);
        const float inv = 1.f / (1.f + e1 + e2 + e3);
        if (lane < 4) {
          const int ee = lane == 0 ? ti[0] : lane == 1 ? ti[1] : lane == 2 ? ti[2] : ti[3];
          const float ww = (lane == 0 ? 1.f : lane == 1 ? e1 : lane == 2 ? e2 : e3) * inv;
          p.aw[t * 4 + lane] = ww;
          const int rank = __hip_atomic_fetch_add(&lcnt[ee], 1, __ATOMIC_RELAXED, __HIP_MEMORY_SCOPE_WORKGROUP);
          lent[nloc * 4 + lane] = (ee << 16) | rank;
          lent[nloc * 4 + lane + 2048] = t * 4 + lane;
        }
        ++nloc;
      }
    }
  }
  __syncthreads();
  if (p.tid < 32) lbase[p.tid] = atomicAdd(&p.cnt[p.tid * 64 + 32 * rep], lcnt[p.tid]);
  __syncthreads();
  for (int i = lane; i < nloc * 4; i += 64) {
    const int er = lent[i], a = lent[i + 2048];
    p.elist[(er >> 16) * T_TOK + lbase[er >> 16] + (er & 0xffff)] = a;
  }
}

__device__ __forceinline__ void ph_final(const Params& p, int nblk, int bid, int rep) {
  const int wid = p.tid >> 6, lane = p.tid & 63;
  f32x4 gpf[4];
#pragma unroll
  for (int i4 = 0; i4 < 4; ++i4) gpf[i4] = *(const f32x4*)(p.g_post_ffn + (i4 >> 1) * 512 + lane * 8 + (i4 & 1) * 4);
  for (int t0 = bid * 8 + wid; t0 < T_TOK; t0 += nblk * 16) {
    int tt[2] = {t0, t0 + nblk * 8};
    if (tt[1] >= T_TOK) tt[1] = t0;
    float mv[2][16]; float ss[2];
#pragma unroll
    for (int u = 0; u < 2; ++u) {
      const int t = tt[u];
      const f32x4 wv = *(const f32x4*)(p.aw + t * 4) * 0.125f;
      ss[u] = 0.f;
#pragma unroll
      for (int i = 0; i < 2; ++i) {
        const unsigned char* y = (const unsigned char*)p.yslot + (size_t)t * 4 * DM + i * 512 + lane * 8;
        float f0[8], f1[8], f2[8], f3[8];
        unpack8_fp8(*(const u32x2*)y, f0); unpack8_fp8(*(const u32x2*)(y + DM), f1); unpack8_fp8(*(const u32x2*)(y + 2 * DM), f2); unpack8_fp8(*(const u32x2*)(y + 3 * DM), f3);
#pragma unroll
        for (int j = 0; j < 8; ++j) { const float m = wv[0] * f0[j] + wv[1] * f1[j] + wv[2] * f2[j] + wv[3] * f3[j]; mv[u][i * 8 + j] = m; ss[u] += m * m; }
      }
    }
    u32x4 x1[2][2];
#pragma unroll
    for (int u = 0; u < 2; ++u)
#pragma unroll
      for (int i = 0; i < 2; ++i) x1[u][i] = *(const u32x4*)(p.hbf + (size_t)tt[u] * DM + i * 512 + lane * 8);
    f32x4 gfv[2][4];
#pragma unroll
    for (int u = 0; u < 2; ++u)
#pragma unroll
      for (int i4 = 0; i4 < 4; ++i4) gfv[u][i4] = *(const f32x4*)(p.mod + (tt[u] / SEQ) * 6144 + 5120 + (i4 >> 1) * 512 + lane * 8 + (i4 & 1) * 4);
    ss[0] = wave_sum(ss[0]); ss[1] = wave_sum(ss[1]);
#pragma unroll
    for (int u = 0; u < 2; ++u) {
      const int t = tt[u];
      if (u == 1 && t == t0) break;
      const float rstd = rsqrtf(ss[u] * (1.f / DM) + 1e-6f);
#pragma unroll
      for (int i = 0; i < 2; ++i) {
        float xf[8]; unpack8(x1[u][i], xf);
#pragma unroll
        for (int j4 = 0; j4 < 2; ++j4) {
          const int k = i * 512 + lane * 8 + j4 * 4;
          float* op = p.out + (size_t)t * DM + k;
          const f32x4 gf = gfv[u][i * 2 + j4], gp = gpf[i * 2 + j4];
          f32x4 o;
#pragma unroll
          for (int j = 0; j < 4; ++j) o[j] = xf[j4 * 4 + j] + gf[j] * (mv[u][i * 8 + j4 * 4 + j] * rstd * gp[j]);
          *(f32x4*)(rep ? (float*)p.merged + (size_t)(t & 8191) * DM + k : op) = o;
        }
      }
    }
  }
}

#define XCD_BAR_WORDS 3456
struct KArgs { const void* in[22]; float* out; char* ws; long long never; };
__host__ __device__ inline size_t al(size_t x) { return (x + 255) & ~(size_t)255; }
__host__ __device__ inline void fill_params(Params& p, const KArgs& k) {
  p.x = (const float*)k.in[0]; p.c = (const float*)k.in[1]; p.w_ada = (const float*)k.in[2]; p.b_ada = (const float*)k.in[3];
  p.g_pre_mix = (const float*)k.in[4]; p.g_post_mix = (const float*)k.in[5]; p.g_pre_ffn = (const float*)k.in[6];
  p.g_post_ffn = (const float*)k.in[7]; p.w_in = (const float*)k.in[8]; p.conv_w = (const float*)k.in[9];
  p.a_log = (const float*)k.in[10]; p.dt_bias = (const float*)k.in[11]; p.g_dn_out = (const float*)k.in[12];
  p.w_br_a = (const float*)k.in[13]; p.w_br_b = (const float*)k.in[14]; p.w_o = (const float*)k.in[15];
  p.w_router = (const float*)k.in[16]; p.b_router = (const float*)k.in[17]; p.w_gu = (const float*)k.in[18];
  p.b_gu = (const float*)k.in[19]; p.w_down = (const float*)k.in[20]; p.b_down = (const float*)k.in[21];
  p.out = k.out;
  char* w = k.ws;
  size_t o = 0;
#define take(bytes) (w + (o += al(bytes)) - al(bytes))
  p.mod = (float*)take(4 * 6144 * 4);
  p.cnt = (int*)take(16384 + XCD_BAR_WORDS * 4);
  p.ba = (float*)take((size_t)T_TOK * 8 * 4);
  p.hbf = (bf16_t*)take((size_t)T_TOK * DM * 2);
  p.proj = (bf16_t*)take((size_t)T_TOK * PW * 2);
  p.w_in_t = (bf16_t*)take((size_t)PW * DM * 2);
  p.wgu8 = (unsigned char*)take((size_t)NE * 2048 * DM);
  p.wd8 = (unsigned char*)take((size_t)NE * 1024 * DM);
  p.h2q = (unsigned char*)take((size_t)T_TOK * DM);
  p.act8 = (unsigned char*)take((size_t)73728 * DM);
  p.wbra_t = (bf16_t*)take((size_t)1024 * 512 * 2);
  p.wbrb_t = (bf16_t*)take((size_t)1024 * 512 * 2);
  p.wo_t = (bf16_t*)take((size_t)1024 * 1024 * 2);
  p.qb = (bf16_t*)take((size_t)T_TOK * 512 * 2);
  p.kb = nullptr;
  p.kmean = (float*)take((size_t)16 * 16 * 128 * 4);
  p.oab = (bf16_t*)take((size_t)T_TOK * DM * 2);
  p.merged = (bf16_t*)take((size_t)T_TOK * DM * 2);
  p.mixer = (bf16_t*)take((size_t)T_TOK * DM * 2);
  p.h2 = nullptr;
  p.elist = (int*)take((size_t)NE * T_TOK * 4);
  p.aw = (float*)take((size_t)T_TOK * 4 * 4);
  p.rowmap = nullptr;
  p.dnA = (unsigned char*)take((size_t)1024 * DN_ABYTES);
  p.dnU = (float*)take((size_t)1024 * DN_UFLOATS * 4);
  p.dnG = (float*)take(4096);
  p.dnS = (unsigned char*)take((size_t)1024 * 8 * 4096);
  p.dnV = (unsigned char*)take((size_t)1024 * 8 * 2048);
  p.oab2 = (bf16_t*)take((size_t)T_TOK * 512 * 2);
  p.dbg = (float*)take(256);
  p.bar = (unsigned*)(p.cnt + 4096);
  p.dn_out = p.oab; p.dn_out_ld = DM;
  p.Kp = (bf16_t*)take((size_t)16 * 128 * 8192);
  p.Vp = (bf16_t*)take((size_t)16 * 128 * 8192);
  p.wq = p.cnt + 32 * 64;
  p.dep = p.cnt + 2304;
  p.mb_out = p.oab; p.mb_out_ld = DM; p.mb_out_off = 512;
  p.xs = nullptr; p.act = nullptr;
  p.yslot = (bf16_t*)take((size_t)65536 * DM * 2);
  p.nq = p.nk = p.nv = p.no = p.ntmp = p.nbeta = p.ng = nullptr;
#undef take
#undef t2
  p.never = (int)k.never;
}

#define XB_TMO      128
#define XB_XCNT(j)  (256  + 64 * (j))
#define XB_XSUB(j)  (1280 + 64 * (j))
#define XB_XGEN(j)  (2304 + 64 * (j))
#define XB_TOP      3328
#define XB_TOPGEN   3392
#define XB_SPIN_CAP (1u << 18)

__device__ __forceinline__ unsigned xb_ld(unsigned* p)              { return __hip_atomic_load(p, __ATOMIC_RELAXED, __HIP_MEMORY_SCOPE_AGENT); }
__device__ __forceinline__ unsigned xb_add(unsigned* p, unsigned v) { return __hip_atomic_fetch_add(p, v, __ATOMIC_RELAXED, __HIP_MEMORY_SCOPE_AGENT); }
__device__ __forceinline__ unsigned xb_xcc_id() { return (unsigned)__builtin_amdgcn_s_getreg((3 << 11) | 20) & 0xFu; }
#define XB_SPIN(cond, bar) do { unsigned _sp = 0; while (cond) { __builtin_amdgcn_s_sleep(1); \
    if ((++_sp & 255u) == 0u) { if (xb_ld(&(bar)[XB_TMO])) break; if (_sp > XB_SPIN_CAP) { atomicAdd(&(bar)[XB_TMO], 1u); break; } } } } while (0)

struct XcdBarrier {
    unsigned* bar; unsigned x;
    volatile LAS unsigned* st;
};

__device__ __forceinline__ XcdBarrier xcd_barrier_post(unsigned* bar, volatile LAS unsigned* st) {
    XcdBarrier b; b.bar = bar; b.x = xb_xcc_id(); b.st = st;
    if (threadIdx.x == 0) (void)xb_add(&bar[XB_XCNT(b.x)], 1u);
    return b;
}
__device__ __forceinline__ void xcd_barrier_complete(unsigned* bar, unsigned x, unsigned& nloc, unsigned& nx) {
    const unsigned G = gridDim.x * gridDim.y * gridDim.z;
    unsigned sum, cnt, mine, sp = 0u;
    for (;;) {
        sum = 0u; cnt = 0u; mine = 0u;
#pragma unroll
        for (unsigned j = 0; j < 16; ++j) { const unsigned c = xb_ld(&bar[XB_XCNT(j)]); sum += c; cnt += (c > 0u) ? 1u : 0u; mine = (j == x) ? c : mine; }
        if (sum == G) break;
        __builtin_amdgcn_s_sleep(1);
        if ((++sp & 255u) == 0u) { if (xb_ld(&bar[XB_TMO])) break; if (sp > XB_SPIN_CAP) { atomicAdd(&bar[XB_TMO], 1u); break; } }
    }
    nloc = mine > 0u ? mine : 1u; nx = cnt > 0u ? cnt : 1u;
}

__device__ __forceinline__ void xcd_barrier(const XcdBarrier& b, const int tid) {
    asm volatile("s_waitcnt vmcnt(0)" ::: "memory");
    __syncthreads();
    if (tid == 0) {
        unsigned* bar = b.bar;
        __builtin_amdgcn_s_waitcnt(0);
        unsigned nloc = b.st[0], nx = b.st[1];
        if (nloc == 0u) { xcd_barrier_complete(bar, b.x, nloc, nx); b.st[0] = nloc; b.st[1] = nx; }
        const unsigned old = xb_add(&bar[XB_XSUB(b.x)], 1u);
        const unsigned gen = old / nloc;
        if (old + 1u == (gen + 1u) * nloc) {
            __builtin_amdgcn_fence(__ATOMIC_RELEASE, "agent");
            asm volatile("s_waitcnt vmcnt(0)" ::: "memory");
            const unsigned og = xb_add(&bar[XB_TOP], 1u);
            const unsigned tg = og / nx;
            if (og + 1u == (tg + 1u) * nx) xb_add(&bar[XB_TOPGEN], 1u);
            else XB_SPIN(xb_ld(&bar[XB_TOPGEN]) == tg, bar);
            __builtin_amdgcn_fence(__ATOMIC_ACQUIRE, "agent");
            xb_add(&bar[XB_XGEN(b.x)], 1u);
            asm volatile("s_waitcnt vmcnt(0)" ::: "memory");
        } else {
            XB_SPIN(xb_ld(&bar[XB_XGEN(b.x)]) == gen, bar);
            __builtin_amdgcn_fence(__ATOMIC_ACQUIRE, "agent");
            asm volatile("s_waitcnt vmcnt(0)" ::: "memory");
        }
    }
    __syncthreads();
}


__device__ __forceinline__ void load_ka(KArgs& kk) {
#if defined(__HIP_DEVICE_COMPILE__)
  typedef __attribute__((address_space(1))) char* gptr_t;
  typedef const __attribute__((address_space(4))) gptr_t* kptr_t;
  kptr_t kp = (kptr_t)__builtin_amdgcn_kernarg_segment_ptr();
  asm volatile("" : "+s"(kp));
#pragma unroll
  for (int i = 0; i < 22; ++i) kk.in[i] = (const void*)kp[i];
  kk.out = (float*)kp[22];
  kk.ws = (char*)kp[23];
  kk.never = ((const __attribute__((address_space(4))) long long*)kp)[24];
#endif
}
__device__ __forceinline__ void ph_prep(const Params& p, LAS unsigned char* lds, int nblk, int bid) {
  const int nd = (1024 + nblk - 1) / nblk;
  const int ncv = WT_IN_ATTN ? 0 : (24576 / WT_CHUNK + nblk - 1) / nblk;
  const int ns = 2 * (nd > ncv + 1 ? nd : ncv + 1);
  const bool cf = (bid & 1) != 0;
  for (int s_ = 0; s_ < ns; ++s_) {
    const int k = s_ >> 1; const bool isconv = ((s_ & 1) == 0) == cf;
    Params pp = p; asm volatile("" : "+v"(pp.tid));
    if (isconv) {
      if (k < ncv) { const int j0 = (k * nblk + bid) * WT_CHUNK; if (j0 < 24576) wt_moe_chunk(pp, lds, j0); }
      else if (k == ncv) { for (int item = bid; item < 256; item += nblk) moba_prep_block(pp, lds, item); }
    }
    else { const int ci = bid + k * nblk; if (ci < 1024) dn_prep_chunk(pp, lds, ci, true, ci + nblk); }
  }
}
__device__ __forceinline__ void grid_bar(const Params& p, LAS unsigned char* lds);
#define MEGA_LDS 148480
#define MEGA_LDS_ALLOC (MEGA_LDS + 16)
__device__ __forceinline__ void grid_bar(const Params& p, LAS unsigned char* lds) {
  XcdBarrier b; b.bar = p.bar; b.x = xb_xcc_id(); b.st = (volatile LAS unsigned*)(lds + MEGA_LDS);
  xcd_barrier(b, p.tid);
}
__global__ __launch_bounds__(512) void mega(KArgs ka) {
  extern __shared__ __attribute__((aligned(16))) unsigned char shm[];
  LAS unsigned char* lds = (LAS unsigned char*)shm;
  cg::grid_group grid = cg::this_grid();
  const int nblk = gridDim.x, bid = blockIdx.x;
  const int wv_ = __builtin_amdgcn_readfirstlane(threadIdx.x >> 6);
  volatile LAS unsigned* xst = (volatile LAS unsigned*)(lds + MEGA_LDS);
  if (threadIdx.x == 0) { xst[0] = 0u; xst[1] = 0u; xst[2] = 0u; xst[3] = 0u; }
  __syncthreads();
  { Params p0; fill_params(p0, ka); (void)xcd_barrier_post(p0.bar, xst); }
  if (ka.never) grid.sync();
#ifndef REPMASK
#define REPMASK 0
#endif
#define LOADKA KArgs kk; load_ka(kk)
#ifndef PHMASK
#define PHMASK 0xffff
#endif
#define PHASE_(k, body, bar) if (((PHMASK) >> (k)) & 1) for (int rep_ = 0; rep_ < (((REPMASK) >> (k)) & 1) + 1; ++rep_) { \
    LOADKA; Params p; fill_params(p, kk); { int t_; asm volatile("v_mbcnt_lo_u32_b32 %0, -1, 0\n\tv_mbcnt_hi_u32_b32 %0, -1, %0" : "=v"(t_)); p.tid = (wv_ << 6) | t_; } body; bar; }
#define PHASE(k, body) PHASE_(k, body, grid_bar(p, lds))
#define PHASE_LAST(k, body) PHASE_(k, body, (void)0)
#ifdef XBAR
  for (int xb_ = 0; xb_ < XBAR; ++xb_) { PHASE(15, {}) }
#endif
  PHASE(0, { ph_mod(p, lds, nblk, bid); ph_wt<false>(p, lds, bid, nblk, WT_NREST); ph_h(p, lds, nblk, bid); })
  PHASE(2, { ph_proj(p, lds, nblk, bid); })
  PHASE(3, { ph_prep(p, lds, nblk, bid); })
  PHASE(4, { if (bid < 32) dn_scan_blk(p, lds, bid); moba_worker(p, lds, rep_, nblk, bid); ph_dn_out(p, lds, nblk, bid); })
  PHASE(6, { ph_br(p, lds, nblk, bid); ph_mix(p, lds, nblk, bid); ph_post_mix(p, lds, nblk, bid, rep_); })
  PHASE(10, { ph_moe1(p, lds, nblk, bid); ph_moe2(p, lds, nblk, bid); })
  PHASE_LAST(12, { ph_final(p, nblk, bid, rep_); })
}


extern "C" void kernel_launch(void* const* d_in, const int* in_sizes, int n_in, void* d_out, int out_size, void* d_ws,
                              size_t ws_size, hipStream_t stream) {
  KArgs ka{};
  for (int i = 0; i < 22; ++i) ka.in[i] = d_in[i];
  ka.out = (float*)d_out; ka.ws = (char*)d_ws; ka.never = 0;
  Params p{};
  fill_params(p, ka);
  static int grid_blocks = 0;
  if (!grid_blocks) {
    (void)hipFuncSetAttribute((const void*)mega, hipFuncAttributeMaxDynamicSharedMemorySize, MEGA_LDS_ALLOC);
    int dev = 0, cus = 0, per_cu = 0;
    (void)hipGetDevice(&dev);
    (void)hipDeviceGetAttribute(&cus, hipDeviceAttributeMultiprocessorCount, dev);
    (void)hipOccupancyMaxActiveBlocksPerMultiprocessor(&per_cu, mega, 512, MEGA_LDS_ALLOC);
    if (per_cu != 1) per_cu = 1;
    grid_blocks = cus * per_cu;
  }
  (void)hipMemsetAsync(p.cnt, 0, 16384 + XCD_BAR_WORDS * 4, stream);
  void* args[] = {&ka};
  hipError_t e = hipLaunchCooperativeKernel((void*)mega, dim3(grid_blocks), dim3(512), args, MEGA_LDS_ALLOC, stream);
  if (e != hipSuccess) fprintf(stderr, "cooperative launch failed: %s (grid %d)\n", hipGetErrorString(e), grid_blocks);
}
```
